# Optimizing an MI355X kernel written in HIP

```python
import jax, jax.numpy as jnp
from jax import lax
import numpy as np

D_MODEL = 1024
BATCH = 4
SEQ = 4096
DEPTH = 4
DEC_BATCH = 32
DEC_SEQ = 8
PAST_LEN = 8192
PAGE_SIZE = 128

N_MIXERS = 2
N_RWKV = (DEPTH + 1) // 2
N_DSA = DEPTH // 2
NORM_EPS = 1e-6
D_FF = 4 * D_MODEL
RW_HEAD = 64
RW_HEADS = D_MODEL // RW_HEAD
LORA_DECAY = 64
LORA_AAA = 64
LORA_MV = 32
LORA_GATE = 160
GN_EPS = 64e-5
ATT_HEADS = 16
ATT_HEAD_DIM = 64
KV_HEADS = 4
GROUPS = ATT_HEADS // KV_HEADS
IDX_HEADS = 8
IDX_DIM = 64
TOPK_MAX = 256
QBLK = 128
ROPE_THETA = 500000.0
ROT_FRAC = 4
Q_W = ATT_HEADS * ATT_HEAD_DIM
KV_W = KV_HEADS * ATT_HEAD_DIM
IQ_W = IDX_HEADS * IDX_DIM
P_IN = Q_W + 2 * KV_W + IQ_W + IDX_DIM + IDX_HEADS
SPLITS = [Q_W, Q_W + KV_W, Q_W + 2 * KV_W, Q_W + 2 * KV_W + IQ_W, Q_W + 2 * KV_W + IQ_W + IDX_DIM]
F32 = jnp.float32

kernel_name = 'rwkv7_dsa_hybrid_step'


def rms_norm(x, g):
    xf = x.astype(F32)
    y = xf * lax.rsqrt(jnp.mean(xf * xf, axis=-1, keepdims=True) + NORM_EPS)
    return (y * g.astype(F32)).astype(x.dtype)


def ada_mods(c, w, b):
    m = jax.nn.silu(c) @ w + b
    return jnp.split(m[:, None, :], 6, axis=-1)


def rope_partial(x, pos):
    d = x.shape[-1]
    rd = d // ROT_FRAC
    half = rd // 2
    inv = ROPE_THETA ** (-jnp.arange(half, dtype=F32) * 2.0 / rd)
    ang = pos.astype(F32)[:, None] * inv[None, :]
    cos = jnp.cos(ang)[None, :, None, :]
    sin = jnp.sin(ang)[None, :, None, :]
    xf = x.astype(F32)
    x1 = xf[..., :half]
    x2 = xf[..., half:rd]
    out = jnp.concatenate([x1 * cos - x2 * sin, x2 * cos + x1 * sin, xf[..., rd:]], axis=-1)
    return out.astype(x.dtype)


def gather_rows(rows, idx):
    return jax.vmap(lambda r, i: r[i])(rows, idx)


def wkv7_scan(S0, r, w, k, v, a, b):
    def step(S, inp):
        r_t, w_t, k_t, v_t, a_t, b_t = inp
        sa = jnp.einsum('bhvk,bhk->bhv', S, a_t)
        S = S * w_t[:, :, None, :] + sa[..., None] * b_t[:, :, None, :] + v_t[..., None] * k_t[:, :, None, :]
        y = jnp.einsum('bhvk,bhk->bhv', S, r_t)
        return S, y
    xs = tuple(jnp.moveaxis(t.astype(F32), 1, 0) for t in (r, w, k, v, a, b))
    S, ys = lax.scan(step, S0.astype(F32), xs)
    return S, jnp.moveaxis(ys, 0, 1)


def rwkv7_mix(h, shift_prev, S0, v_first, P, j):
    B, T, D = h.shape
    hd = lambda t: t.reshape(B, T, RW_HEADS, RW_HEAD)
    mix = P['rw_mix'][j]
    h_prev = jnp.concatenate([shift_prev[:, None, :].astype(h.dtype), h[:, :-1]], axis=1)
    dx = h_prev - h
    xr, xw, xk, xv, xa, xg = [h + dx * mix[n] for n in range(6)]
    w_rkv = P['rw_w_rkv'][j]
    r = xr @ w_rkv[0]
    k = xk @ w_rkv[1]
    v = xv @ w_rkv[2]
    w_pre = (P['rw_w0'][j] + jnp.tanh(xw @ P['rw_w1'][j]) @ P['rw_w2'][j]).astype(F32)
    decay = jnp.exp(-jnp.exp(-jax.nn.softplus(-w_pre) - 0.5))
    if j == 0:
        v_first = v
    else:
        v = v + (v_first - v) * jax.nn.sigmoid(P['rw_v0'][j - 1] + (xv @ P['rw_v1'][j - 1]) @ P['rw_v2'][j - 1])
    a = jax.nn.sigmoid(P['rw_a0'][j] + (xa @ P['rw_a1'][j]) @ P['rw_a2'][j])
    g = jax.nn.sigmoid(xg @ P['rw_g1'][j]) @ P['rw_g2'][j]
    kk = hd(k * P['rw_k_k'][j]).astype(F32)
    kk = kk * lax.rsqrt(jnp.maximum(jnp.sum(kk * kk, axis=-1, keepdims=True), 1e-24))
    k = k * (1 + (a - 1) * P['rw_k_a'][j])
    S, y = wkv7_scan(S0, hd(r), hd(decay), hd(k), hd(v), -kk, kk * hd(a).astype(F32))
    mu = jnp.mean(y, axis=-1, keepdims=True)
    var = jnp.mean(jnp.square(y - mu), axis=-1, keepdims=True)
    y = ((y - mu) * lax.rsqrt(var + GN_EPS)).reshape(B, T, D)
    y = y * P['rw_lnx_w'][j].astype(F32) + P['rw_lnx_b'][j].astype(F32)
    bonus = jnp.sum(hd(r * k).astype(F32) * P['rw_r_k'][j].astype(F32), axis=-1, keepdims=True) * hd(v).astype(F32)
    y = (y + bonus.reshape(B, T, D)).astype(h.dtype)
    out = (y * g) @ P['rw_w_o'][j]
    return out, v_first, S, h[:, -1]


def dsa_project(h, pos, P, j):
    B, T, _ = h.shape
    q, k, v, qi, ki, wi = jnp.split(h @ P['att_w_in'][j], SPLITS, axis=-1)
    q = rope_partial(rms_norm(q.reshape(B, T, ATT_HEADS, ATT_HEAD_DIM), P['att_q_norm'][j]), pos)
    k = rope_partial(rms_norm(k.reshape(B, T, KV_HEADS, ATT_HEAD_DIM), P['att_k_norm'][j]), pos)
    v = v.reshape(B, T, KV_HEADS, ATT_HEAD_DIM)
    qi = rope_partial(qi.reshape(B, T, IDX_HEADS, IDX_DIM), pos)
    ki = rope_partial(rms_norm(ki, P['idx_k_norm'][j])[:, :, None, :], pos)[:, :, 0, :]
    wi = wi * IDX_HEADS ** -0.5
    return q, k, v, qi, ki, wi


def select_keys(qi, wi, ki, pos_q, topk):
    L = ki.shape[1]
    logits = jnp.einsum('bthd,bsd->bths', qi.astype(F32), ki.astype(F32)) * IDX_DIM ** -0.5
    score = jnp.einsum('bths,bth->bts', jax.nn.relu(logits), wi.astype(F32))
    pos_k = jnp.arange(L)
    adm = pos_k[None, None, :] <= pos_q[None, :, None]
    _, idx = lax.top_k(jnp.where(adm, score, -jnp.inf), topk)
    valid = idx <= pos_q[None, :, None]
    return idx, valid


def sparse_attend(q, kg, vg, valid):
    B, T = q.shape[:2]
    qg = q.reshape(B, T, KV_HEADS, GROUPS, ATT_HEAD_DIM).astype(F32)
    s = jnp.einsum('bthgd,btshd->bthgs', qg, kg.astype(F32)) * ATT_HEAD_DIM ** -0.5
    s = jnp.where(valid[:, :, None, None, :], s, -jnp.inf)
    p = jax.nn.softmax(s, axis=-1)
    o = jnp.einsum('bthgs,btshd->bthgd', p, vg.astype(F32))
    return o.reshape(B, T, Q_W).astype(q.dtype)


def dsa_prompt(q, k, v, qi, ki, wi):
    B, S = q.shape[:2]
    topk = min(TOPK_MAX, S // 4)
    def block(i):
        start = i * QBLK
        sl = lambda t: lax.dynamic_slice_in_dim(t, start, QBLK, axis=1)
        pos_q = start + jnp.arange(QBLK)
        idx, valid = select_keys(sl(qi), sl(wi), ki, pos_q, topk)
        return sparse_attend(sl(q), gather_rows(k, idx), gather_rows(v, idx), valid)
    o = lax.map(block, jnp.arange(S // QBLK))
    return jnp.moveaxis(o, 0, 1).reshape(B, S, Q_W)


def dsa_sample(q, k, v, qi, ki, wi, pool_k, pool_v, pool_ki, page_table):
    B, T = q.shape[:2]
    n_pages = PAST_LEN // PAGE_SIZE
    L = PAST_LEN + T
    topk = min(TOPK_MAX, L // 4)
    ki_past = pool_ki[page_table].reshape(B, PAST_LEN, IDX_DIM)
    ki_all = jnp.concatenate([ki_past, ki.astype(ki_past.dtype)], axis=1)
    pos_q = PAST_LEN + jnp.arange(T)
    idx, valid = select_keys(qi, wi, ki_all, pos_q, topk)
    in_past = (idx < PAST_LEN)[..., None, None]
    page = jnp.minimum(idx // PAGE_SIZE, n_pages - 1)
    phys = gather_rows(page_table, page) * PAGE_SIZE + idx % PAGE_SIZE
    loc = jnp.clip(idx - PAST_LEN, 0, T - 1)
    k_flat = pool_k.reshape(-1, KV_HEADS, ATT_HEAD_DIM)
    v_flat = pool_v.reshape(-1, KV_HEADS, ATT_HEAD_DIM)
    kg = jnp.where(in_past, k_flat[phys], gather_rows(k, loc))
    vg = jnp.where(in_past, v_flat[phys], gather_rows(v, loc))
    return sparse_attend(q, kg, vg, valid)


def run_trunk(x, c, pos, wkv0, shift0, attn_fn, P):
    v_first = None
    ks, vs, kis, wkvs, shifts = [], [], [], [], []
    for i in range(DEPTH):
        j = i // N_MIXERS
        sh_a, sc_a, g_a, sh_f, sc_f, g_f = ada_mods(c, P['w_ada'][i], P['b_ada'][i])
        h = rms_norm(x, P['norm_g'][i, 0]) * (1 + sc_a) + sh_a
        if i % N_MIXERS == 0:
            o, v_first, S, last = rwkv7_mix(h, shift0[j], wkv0[j], v_first, P, j)
            wkvs.append(S)
            shifts.append(last)
        else:
            q, k, v, qi, ki, wi = dsa_project(h, pos, P, j)
            o = attn_fn(j, q, k, v, qi, ki, wi) @ P['att_w_o'][j]
            ks.append(k)
            vs.append(v)
            kis.append(ki)
        x = x + g_a * o
        h = rms_norm(x, P['norm_g'][i, 1]) * (1 + sc_f) + sh_f
        u = jax.nn.relu(h @ P['w_up'][i])
        x = x + g_f * ((u * u) @ P['w_down'][i])
    return x, jnp.stack(ks), jnp.stack(vs), jnp.stack(kis), jnp.stack(wkvs), jnp.stack(shifts)


def setup_inputs(seed: int = 0) -> dict:
    key = jax.random.key(seed)
    ks = iter(jax.random.split(key, 48))
    D = D_MODEL
    def nrm(shape, scale):
        return scale * jax.random.normal(next(ks), shape, F32)
    n_pages = PAST_LEN // PAGE_SIZE
    in_use = DEC_BATCH * n_pages
    pool = in_use + (in_use + 3) // 4
    x_prompt = nrm((BATCH, SEQ, D), 1.0)
    x_sample = nrm((DEC_BATCH, DEC_SEQ, D), 1.0)
    cache_k = nrm((N_DSA, pool, PAGE_SIZE, KV_HEADS, ATT_HEAD_DIM), 1.0)
    cache_v = nrm((N_DSA, pool, PAGE_SIZE, KV_HEADS, ATT_HEAD_DIM), 1.0)
    cache_idx_k = nrm((N_DSA, pool, PAGE_SIZE, IDX_DIM), 1.0)
    state_wkv = nrm((N_RWKV, DEC_BATCH, RW_HEADS, RW_HEAD, RW_HEAD), 0.3)
    state_shift = nrm((N_RWKV, DEC_BATCH, D), 1.0)
    page_table = jax.random.permutation(next(ks), pool)[:in_use].reshape(DEC_BATCH, n_pages).astype(jnp.int32)
    c_prompt = nrm((BATCH, D), 1.0)
    c_sample = nrm((DEC_BATCH, D), 1.0)
    norm_g = 1.0 + nrm((DEPTH, 2, D), 0.05)
    w_ada = nrm((DEPTH, D, 6 * D), 0.5 * D ** -0.5)
    b_ada = nrm((DEPTH, 6 * D), 0.02)
    w_up = nrm((DEPTH, D, D_FF), D ** -0.5)
    w_down = nrm((DEPTH, D_FF, D), D_FF ** -0.5)
    rw_mix = jax.random.uniform(next(ks), (N_RWKV, 6, D), F32, 0.0, 1.0)
    rw_w_rkv = nrm((N_RWKV, 3, D, D), D ** -0.5)
    rw_w_o = nrm((N_RWKV, D, D), D ** -0.5)
    rw_w0 = jnp.linspace(-6.5, -1.5, D, dtype=F32)[None, :] + nrm((N_RWKV, D), 0.1)
    rw_w1 = nrm((N_RWKV, D, LORA_DECAY), D ** -0.5)
    rw_w2 = nrm((N_RWKV, LORA_DECAY, D), 0.3 * LORA_DECAY ** -0.5)
    rw_a0 = nrm((N_RWKV, D), 0.1)
    rw_a1 = nrm((N_RWKV, D, LORA_AAA), D ** -0.5)
    rw_a2 = nrm((N_RWKV, LORA_AAA, D), 0.5 * LORA_AAA ** -0.5)
    rw_v0 = 1.0 + nrm((N_RWKV - 1, D), 0.1)
    rw_v1 = nrm((N_RWKV - 1, D, LORA_MV), D ** -0.5)
    rw_v2 = nrm((N_RWKV - 1, LORA_MV, D), 0.5 * LORA_MV ** -0.5)
    rw_g1 = nrm((N_RWKV, D, LORA_GATE), D ** -0.5)
    rw_g2 = nrm((N_RWKV, LORA_GATE, D), LORA_GATE ** -0.5)
    rw_k_k = 0.85 + nrm((N_RWKV, D), 0.05)
    rw_k_a = 1.0 + nrm((N_RWKV, D), 0.05)
    rw_r_k = nrm((N_RWKV, RW_HEADS, RW_HEAD), 0.1)
    rw_lnx_w = 1.0 + nrm((N_RWKV, D), 0.05)
    rw_lnx_b = nrm((N_RWKV, D), 0.02)
    att_w_in = nrm((N_DSA, D, P_IN), D ** -0.5)
    att_w_o = nrm((N_DSA, Q_W, D), Q_W ** -0.5)
    att_q_norm = 1.0 + nrm((N_DSA, ATT_HEAD_DIM), 0.05)
    att_k_norm = 1.0 + nrm((N_DSA, ATT_HEAD_DIM), 0.05)
    idx_k_norm = 1.0 + nrm((N_DSA, IDX_DIM), 0.05)
    return {'x_prompt': x_prompt, 'x_sample': x_sample, 'cache_k': cache_k, 'cache_v': cache_v,
            'cache_idx_k': cache_idx_k, 'state_wkv': state_wkv, 'state_shift': state_shift,
            'page_table': page_table, 'c_prompt': c_prompt, 'c_sample': c_sample,
            'norm_g': norm_g, 'w_ada': w_ada, 'b_ada': b_ada, 'w_up': w_up, 'w_down': w_down,
            'rw_mix': rw_mix, 'rw_w_rkv': rw_w_rkv, 'rw_w_o': rw_w_o, 'rw_w0': rw_w0, 'rw_w1': rw_w1,
            'rw_w2': rw_w2, 'rw_a0': rw_a0, 'rw_a1': rw_a1, 'rw_a2': rw_a2, 'rw_v0': rw_v0,
            'rw_v1': rw_v1, 'rw_v2': rw_v2, 'rw_g1': rw_g1, 'rw_g2': rw_g2, 'rw_k_k': rw_k_k,
            'rw_k_a': rw_k_a, 'rw_r_k': rw_r_k, 'rw_lnx_w': rw_lnx_w, 'rw_lnx_b': rw_lnx_b,
            'att_w_in': att_w_in, 'att_w_o': att_w_o, 'att_q_norm': att_q_norm,
            'att_k_norm': att_k_norm, 'idx_k_norm': idx_k_norm}


def reference(x_prompt, x_sample, cache_k, cache_v, cache_idx_k, state_wkv, state_shift, page_table,
              c_prompt, c_sample, norm_g, w_ada, b_ada, w_up, w_down, rw_mix, rw_w_rkv, rw_w_o,
              rw_w0, rw_w1, rw_w2, rw_a0, rw_a1, rw_a2, rw_v0, rw_v1, rw_v2, rw_g1, rw_g2,
              rw_k_k, rw_k_a, rw_r_k, rw_lnx_w, rw_lnx_b, att_w_in, att_w_o, att_q_norm,
              att_k_norm, idx_k_norm):
    P = dict(norm_g=norm_g, w_ada=w_ada, b_ada=b_ada, w_up=w_up, w_down=w_down,
             rw_mix=rw_mix, rw_w_rkv=rw_w_rkv, rw_w_o=rw_w_o, rw_w0=rw_w0, rw_w1=rw_w1,
             rw_w2=rw_w2, rw_a0=rw_a0, rw_a1=rw_a1, rw_a2=rw_a2, rw_v0=rw_v0, rw_v1=rw_v1,
             rw_v2=rw_v2, rw_g1=rw_g1, rw_g2=rw_g2, rw_k_k=rw_k_k, rw_k_a=rw_k_a, rw_r_k=rw_r_k,
             rw_lnx_w=rw_lnx_w, rw_lnx_b=rw_lnx_b, att_w_in=att_w_in, att_w_o=att_w_o,
             att_q_norm=att_q_norm, att_k_norm=att_k_norm, idx_k_norm=idx_k_norm)

    def prompt_attn(j, q, k, v, qi, ki, wi):
        return dsa_prompt(q, k, v, qi, ki, wi)

    def sample_attn(j, q, k, v, qi, ki, wi):
        return dsa_sample(q, k, v, qi, ki, wi, cache_k[j], cache_v[j], cache_idx_k[j], page_table)

    wkv0 = jnp.zeros((N_RWKV, BATCH, RW_HEADS, RW_HEAD, RW_HEAD), F32)
    shift0 = jnp.zeros((N_RWKV, BATCH, D_MODEL), x_prompt.dtype)
    y_prompt, k_p, v_p, ki_p, wkv_p, shift_p = run_trunk(
        x_prompt, c_prompt, jnp.arange(SEQ), wkv0, shift0, prompt_attn, P)
    y_sample, k_s, v_s, ki_s, wkv_s, shift_s = run_trunk(
        x_sample, c_sample, PAST_LEN + jnp.arange(DEC_SEQ), state_wkv, state_shift, sample_attn, P)
    return (y_prompt, y_sample, k_p, v_p, ki_p, wkv_p, shift_p, k_s, v_s, ki_s, wkv_s, shift_s)
```

```cpp
#define ONE_LAUNCH 1
#include <hip/hip_runtime.h>
#include <cstdio>
#include <cstdint>
#include <cstring>

#define LAS __attribute__((address_space(3)))
typedef unsigned short bf16_t;
typedef short bf16x8 __attribute__((ext_vector_type(8)));
typedef float f32x4 __attribute__((ext_vector_type(4)));
typedef float f32x2 __attribute__((ext_vector_type(2)));
typedef unsigned u32x4 __attribute__((ext_vector_type(4)));
typedef unsigned u32x2 __attribute__((ext_vector_type(2)));

constexpr int D = 1024, NP = 16384, NS = 256, NT = NP + NS, SEQL = 4096, PAST = 8192, NSEQ = 36, DFF = 4096;
constexpr int PIN = 2120, PINP = 2304;
constexpr int TOPK = 256, SCS_LD = 8320;
constexpr size_t O_YP = 0, O_YS = 16777216, O_KP = 17039360, O_VP = 25427968, O_IKP = 33816576, O_WKVP = 35913728, O_SHP = 36438016,
                 O_KS = 36446208, O_VS = 36577280, O_IKS = 36708352, O_WKVS = 36741120, O_SHS = 40935424, O_END = 41000960;
constexpr size_t al256(size_t x) { return (x + 255) & ~(size_t)255; }
constexpr size_t WS_BAR = 0;
constexpr size_t WS_MODS = 65536;
constexpr size_t WS_WUP_T = al256(WS_MODS + (size_t)4 * NSEQ * 6144 * 4);
constexpr size_t WS_WDN_T = WS_WUP_T + (size_t)4 * DFF * D * 2;
constexpr size_t WS_WRW_T = WS_WDN_T + (size_t)4 * DFF * D * 2;
constexpr size_t WS_WO_T = WS_WRW_T + (size_t)2 * 4096 * D * 2;
constexpr size_t WS_WIN_T = WS_WO_T + (size_t)2 * D * D * 2;
constexpr size_t WS_WAO_T = WS_WIN_T + (size_t)2 * PINP * D * 2;
constexpr size_t WS_W2T = WS_WAO_T + (size_t)2 * D * D * 2;
constexpr size_t WS_A2T = WS_W2T + (size_t)2 * D * 64 * 2;
constexpr size_t WS_V2T = WS_A2T + (size_t)2 * D * 64 * 2;
constexpr size_t WS_G2T = WS_V2T + (size_t)D * 32 * 2;
constexpr size_t WS_XR = WS_G2T + (size_t)2 * D * 160 * 2;
constexpr size_t XR_STRIDE = (size_t)NT * D;
constexpr size_t WS_RB = WS_XR + 6 * XR_STRIDE * 2;
constexpr size_t WS_KB = WS_RB + XR_STRIDE * 2;
constexpr size_t WS_VB = WS_KB + XR_STRIDE * 2;
constexpr size_t WS_TW = WS_VB + XR_STRIDE * 2;
constexpr size_t WS_TA = WS_TW + (size_t)NT * 64 * 2;
constexpr size_t WS_TV = WS_TA + (size_t)NT * 64 * 2;
constexpr size_t WS_TG = WS_TV + (size_t)NT * 32 * 2;
constexpr size_t WS_WP = al256(WS_TG + (size_t)NT * 160 * 2);
constexpr size_t F32A = (size_t)NT * D * 4;
constexpr size_t WS_AP = WS_WP + F32A, WS_VP = WS_AP + F32A, WS_GG = WS_VP + F32A, WS_VFIRST = WS_GG + F32A;
constexpr size_t WS_DEC = WS_VFIRST + F32A, WS_KM = WS_DEC + F32A, WS_VM = WS_KM + F32A, WS_AV = WS_VM + F32A, WS_BV = WS_AV + F32A, WS_Y = WS_BV + F32A;
constexpr size_t WS_YG = WS_Y + F32A;
constexpr size_t WS_U = WS_YG + XR_STRIDE * 2;
constexpr size_t WS_PR = WS_U + (size_t)NT * DFF * 2;
constexpr size_t WS_Q = WS_PR + (size_t)NT * PINP * 4;
constexpr size_t WS_QI = WS_Q + F32A;
constexpr size_t WS_WI = WS_QI + (size_t)NT * 512 * 4;
constexpr size_t WS_SC = al256(WS_WI + (size_t)NT * 8 * 4);
constexpr size_t WS_SCS = WS_SC + (size_t)4 * 4096 * 4096 * 4;
constexpr size_t WS_SEL = al256(WS_SCS + (size_t)NS * SCS_LD * 4);
constexpr size_t WS_CNT = WS_SEL + (size_t)NT * 256 * 4;
constexpr size_t WS_KBF = al256(WS_CNT + (size_t)NT * 4);
constexpr size_t WS_VBF = WS_KBF + (size_t)NT * 256 * 2;
constexpr size_t WS_QIB = WS_VBF + (size_t)NT * 256 * 2;
constexpr size_t WS_KIB = WS_QIB + (size_t)NT * 512 * 2;
constexpr size_t WS_K8 = al256(WS_KIB + (size_t)NT * 64 * 2);
constexpr size_t WS_V8 = WS_K8 + (size_t)NT * 256;
constexpr size_t WS_END = al256(WS_V8 + (size_t)NT * 256);

constexpr int LCH = 64, NCH = SEQL / LCH;
constexpr size_t WS_PCH = WS_SC, WS_CCH = WS_PCH + (size_t)64 * NCH * 4096 * 4, WS_SST = WS_CCH + (size_t)64 * NCH * 4096 * 4;
static_assert(WS_SST + (size_t)64 * NCH * 4096 * 4 <= WS_SCS, "scan buffers must fit the aliased region");
constexpr int LDS_BYTES = 147456;
constexpr int LDS_MISC = 131072;

typedef __bf16 bf16x2_t __attribute__((ext_vector_type(2)));
__device__ __forceinline__ unsigned pk_bf16(float lo, float hi) { const f32x2 v = {lo, hi}; const bf16x2_t b = __builtin_convertvector(v, bf16x2_t); return __builtin_bit_cast(unsigned, b); }
__device__ __forceinline__ unsigned pk_fp8x4(f32x4 v) { int w = 0; w = __builtin_amdgcn_cvt_pk_fp8_f32(v[0], v[1], w, false); w = __builtin_amdgcn_cvt_pk_fp8_f32(v[2], v[3], w, true); return (unsigned)w; }
__device__ __forceinline__ f32x4 fp8x4_f32(unsigned w) { return (f32x4){__builtin_amdgcn_cvt_f32_fp8((int)w, 0), __builtin_amdgcn_cvt_f32_fp8((int)w, 1), __builtin_amdgcn_cvt_f32_fp8((int)w, 2), __builtin_amdgcn_cvt_f32_fp8((int)w, 3)}; }
__device__ __forceinline__ float bf2f(unsigned short x) { return __uint_as_float((unsigned)x << 16); }
__device__ __forceinline__ float bflo(unsigned x) { return __uint_as_float(x << 16); }
__device__ __forceinline__ float bfhi(unsigned x) { return __uint_as_float(x & 0xffff0000u); }
__device__ __forceinline__ f32x4 ld_bf4(const bf16_t* p) { const u32x2 v = *(const u32x2*)p; return (f32x4){bflo(v.x), bfhi(v.x), bflo(v.y), bfhi(v.y)}; }
__device__ __forceinline__ void st_bf4(bf16_t* p, f32x4 v) { u32x2 w; w.x = pk_bf16(v[0], v[1]); w.y = pk_bf16(v[2], v[3]); *(u32x2*)p = w; }
template <int CTRL> __device__ __forceinline__ float dppf(float v) { return __int_as_float(__builtin_amdgcn_update_dpp(0, __float_as_int(v), CTRL, 0xf, 0xf, false)); }
template <int CTRL> __device__ __forceinline__ int dppi(int v) { return __builtin_amdgcn_update_dpp(0, v, CTRL, 0xf, 0xf, false); }
__device__ __forceinline__ float g16_sum(float v) { v += dppf<0xB1>(v); v += dppf<0x4E>(v); v += dppf<0x141>(v); v += dppf<0x140>(v); return v; }
__device__ __forceinline__ float g16_max(float v) { v = fmaxf(v, dppf<0xB1>(v)); v = fmaxf(v, dppf<0x4E>(v)); v = fmaxf(v, dppf<0x141>(v)); v = fmaxf(v, dppf<0x140>(v)); return v; }
__device__ __forceinline__ int g16_sum_i(int v) { v += dppi<0xB1>(v); v += dppi<0x4E>(v); v += dppi<0x141>(v); v += dppi<0x140>(v); return v; }
__device__ __forceinline__ int g16_min_i(int v) { v = min(v, dppi<0xB1>(v)); v = min(v, dppi<0x4E>(v)); v = min(v, dppi<0x141>(v)); v = min(v, dppi<0x140>(v)); return v; }
__device__ __forceinline__ float rlf(float v, int k) { return __int_as_float(__builtin_amdgcn_readlane(__float_as_int(v), k)); }
__device__ __forceinline__ float wave_sum(float v) { v = g16_sum(v); return (rlf(v, 0) + rlf(v, 16)) + (rlf(v, 32) + rlf(v, 48)); }
__device__ __forceinline__ float wave_max(float v) { v = g16_max(v); return fmaxf(fmaxf(rlf(v, 0), rlf(v, 16)), fmaxf(rlf(v, 32), rlf(v, 48))); }
__device__ __forceinline__ int wave_sum_i(int v) { v = g16_sum_i(v); return (__builtin_amdgcn_readlane(v, 0) + __builtin_amdgcn_readlane(v, 16)) + (__builtin_amdgcn_readlane(v, 32) + __builtin_amdgcn_readlane(v, 48)); }
__device__ __forceinline__ int wave_min_i(int v) { v = g16_min_i(v); return min(min(__builtin_amdgcn_readlane(v, 0), __builtin_amdgcn_readlane(v, 16)), min(__builtin_amdgcn_readlane(v, 32), __builtin_amdgcn_readlane(v, 48))); }
__device__ __forceinline__ float sigmoidf_(float x) { return 1.0f / (1.0f + expf(-x)); }
__device__ __forceinline__ float fsig(float x) { return __builtin_amdgcn_rcpf(1.0f + __expf(-x)); }
__device__ __forceinline__ float ftanh(float x) { return 2.0f * fsig(2.0f * x) - 1.0f; }
__device__ __forceinline__ int row_seq(int row) { return row < NP ? (row >> 12) : 4 + ((row - NP) >> 3); }
__device__ __forceinline__ int row_pos(int row) { return row < NP ? (row & 4095) : PAST + ((row - NP) & 7); }
__device__ __forceinline__ int TID() { int t = threadIdx.x; asm volatile("" : "+v"(t)); return t; }
__device__ __forceinline__ int BID() { int b = blockIdx.x; asm volatile("" : "+s"(b)); return b; }
__device__ __forceinline__ void wave_lds_fence() { __builtin_amdgcn_fence(__ATOMIC_RELEASE, "wavefront"); __builtin_amdgcn_wave_barrier(); __builtin_amdgcn_fence(__ATOMIC_ACQUIRE, "wavefront"); }

#define XB_TMO      128
#define XB_XCNT(j)  (256  + 64 * (j))
#define XB_XSUB(j)  (1280 + 64 * (j))
#define XB_XGEN(j)  (2304 + 64 * (j))
#define XB_TOP      3328
#define XB_TOPGEN   3392
#define XCD_BAR_WORDS 3456
#define XB_SPIN_CAP (1u << 22)
__device__ __forceinline__ unsigned xb_ld(unsigned* p)              { return __hip_atomic_load(p, __ATOMIC_RELAXED, __HIP_MEMORY_SCOPE_AGENT); }
__device__ __forceinline__ unsigned xb_add(unsigned* p, unsigned v) { return __hip_atomic_fetch_add(p, v, __ATOMIC_RELAXED, __HIP_MEMORY_SCOPE_AGENT); }
__device__ __forceinline__ unsigned xb_xcc_id() { return (unsigned)__builtin_amdgcn_s_getreg((3 << 11) | 20) & 0xFu; }
#define XB_SPIN(cond, bar) do { unsigned _sp = 0; while (cond) { __builtin_amdgcn_s_sleep(1); \
    if ((++_sp & 255u) == 0u) { if (xb_ld(&(bar)[XB_TMO])) break; if (_sp > XB_SPIN_CAP) { atomicAdd(&(bar)[XB_TMO], 1u); break; } } } } while (0)
struct XcdBarrier { unsigned* bar; unsigned x; volatile LAS unsigned* st; };
__device__ __forceinline__ XcdBarrier xcd_barrier_post(unsigned* bar, volatile LAS unsigned* st) {
    XcdBarrier b; b.bar = bar; b.x = xb_xcc_id(); b.st = st;
    if (threadIdx.x == 0) (void)xb_add(&bar[XB_XCNT(b.x)], 1u);
    return b;
}
__device__ __forceinline__ void xcd_barrier_complete(unsigned* bar, unsigned x, unsigned& nloc, unsigned& nx) {
    const unsigned G = gridDim.x * gridDim.y * gridDim.z;
    unsigned sum, cnt, mine, sp = 0u;
    for (;;) {
        sum = 0u; cnt = 0u; mine = 0u;
#pragma unroll
        for (unsigned j = 0; j < 16; ++j) { const unsigned c = xb_ld(&bar[XB_XCNT(j)]); sum += c; cnt += (c > 0u) ? 1u : 0u; mine = (j == x) ? c : mine; }
        if (sum == G) break;
        __builtin_amdgcn_s_sleep(1);
        if ((++sp & 255u) == 0u) { if (xb_ld(&bar[XB_TMO])) break; if (sp > XB_SPIN_CAP) { atomicAdd(&bar[XB_TMO], 1u); break; } }
    }
    nloc = mine > 0u ? mine : 1u; nx = cnt > 0u ? cnt : 1u;
}
__device__ __forceinline__ void xcd_barrier(const XcdBarrier& b) {
    asm volatile("s_waitcnt vmcnt(0)" ::: "memory");
    __syncthreads();
    if (threadIdx.x == 0) {
        unsigned* bar = b.bar;
        __builtin_amdgcn_s_waitcnt(0);
        unsigned nloc = b.st[0], nx = b.st[1];
        if (nloc == 0u) { xcd_barrier_complete(bar, b.x, nloc, nx); b.st[0] = nloc; b.st[1] = nx; }
        const unsigned old = xb_add(&bar[XB_XSUB(b.x)], 1u);
        const unsigned gen = old / nloc;
        if (old + 1u == (gen + 1u) * nloc) {
            __builtin_amdgcn_fence(__ATOMIC_RELEASE, "agent");
            asm volatile("s_waitcnt vmcnt(0)" ::: "memory");
            const unsigned og = xb_add(&bar[XB_TOP], 1u);
            const unsigned tg = og / nx;
            if (og + 1u == (tg + 1u) * nx) xb_add(&bar[XB_TOPGEN], 1u);
            else XB_SPIN(xb_ld(&bar[XB_TOPGEN]) == tg, bar);
            __builtin_amdgcn_fence(__ATOMIC_ACQUIRE, "agent");
            xb_add(&bar[XB_XGEN(b.x)], 1u);
            asm volatile("s_waitcnt vmcnt(0)" ::: "memory");
        } else {
            XB_SPIN(xb_ld(&bar[XB_XGEN(b.x)]) == gen, bar);
            __builtin_amdgcn_fence(__ATOMIC_ACQUIRE, "agent");
            asm volatile("s_waitcnt vmcnt(0)" ::: "memory");
        }
    }
    __syncthreads();
}

struct P {
    const float *x_prompt, *x_sample, *cache_k, *cache_v, *cache_ik, *state_wkv, *state_shift; const int* page_table;
    const float *c_prompt, *c_sample, *norm_g, *w_ada, *b_ada, *w_up, *w_down, *rw_mix, *rw_w_rkv, *rw_w_o, *rw_w0, *rw_w1, *rw_w2, *rw_a0, *rw_a1, *rw_a2,
                *rw_v0, *rw_v1, *rw_v2, *rw_g1, *rw_g2, *rw_k_k, *rw_k_a, *rw_r_k, *rw_lnx_w, *rw_lnx_b, *att_w_in, *att_w_o, *att_q_norm, *att_k_norm, *idx_k_norm;
    float* out; unsigned char* ws; int ph_lo, ph_hi;
};
typedef const P __attribute__((address_space(4)))* KP;
#define WSP(T, off) ((T*)(p->ws + (off)))
__device__ __forceinline__ KP kargs() { KP k = (KP)__builtin_amdgcn_kernarg_segment_ptr(); asm volatile("" : "+s"(k)); return k; }

namespace pg8 {
constexpr int BM = 256, BK = 64, HALF = 128, HTB = HALF * BK * 2, STAGE_BYTES = 8 * HTB, NXCD = 8, WGM = 8;
__device__ __forceinline__ int lds_byte(int r, int c) { const int st = (r >> 4) * 2 + (c >> 5), rr = r & 15, cc = c & 31, ob = rr * 64 + cc * 2; return st * 1024 + (ob ^ (((ob >> 9) & 1) << 5)); }
__device__ __forceinline__ void stage_rc(int b, int& R, int& C) { const int st = b / 1024, sb = b % 1024, swz = sb ^ (((sb >> 9) & 1) << 5); R = (st >> 1) * 16 + swz / 64; C = (st & 1) * 32 + (swz % 64) / 2; }
__device__ __forceinline__ int perm32(int rho) { const int n = rho >> 4, i = rho & 15; return 8 * (i >> 2) + 4 * n + (i & 3); }
struct Unit { int pm, pn; };
struct Gemm { const bf16_t* A; const bf16_t* Bt; int M, N, K, mode; size_t agrp; };
__device__ __forceinline__ int phys_pn(const Gemm& g, int pn) { return (g.mode == 2 && pn >= 12) ? pn + 1 : pn; }
__device__ __forceinline__ const char* a_ptr(const Gemm& g, const Unit& u, size_t tstep) {
    int grp = 0; if (g.mode) grp = u.pn < 12 ? (u.pn >> 2) : (u.pn == 12 ? 2 : u.pn - 10);
    return (const char*)g.A + (size_t)grp * g.agrp * 2 + (size_t)u.pm * tstep; }
struct StaticOrder {
    int nM, nN, nwg, G, c;
    __device__ void init(int M, int N, int G_, int c_) { nM = M / BM; nN = N / BM; nwg = nM * nN; G = G_; c = c_; }
    __device__ bool next(int i, Unit& u) const {
        const long L = (long)i * G + c; if (L >= nwg) return false;
        int wgid = (int)L; { const int q = nwg / NXCD, r = nwg % NXCD, xcd = wgid % NXCD, off = wgid / NXCD; wgid = (xcd < r ? xcd * (q + 1) : r * (q + 1) + (xcd - r) * q) + off; }
        const int nig = WGM * nN, gid = wgid / nig, fm = gid * WGM, gsz = (nM - fm) < WGM ? (nM - fm) : WGM;
        u.pm = fm + ((wgid % nig) % gsz); u.pn = (wgid % nig) / gsz; return true;
    }
};
template <class F, bool PERM_> struct EpiAdapt {
    static constexpr bool PERM = PERM_;
    F f;
    __device__ __forceinline__ void operator()(const f32x4 (&acc)[2][2][4][2], const Unit& u, int wr, int wc, int fr, int fq) const {
        const int row0 = u.pm * BM + wr * 64 + fr, col0 = u.pn * BM + wc * 32 + (PERM ? 8 * fq : 4 * fq);
#pragma unroll
        for (int ai = 0; ai < 2; ++ai)
#pragma unroll
            for (int m = 0; m < 4; ++m)
#pragma unroll
                for (int bj = 0; bj < 2; ++bj) {
                    if constexpr (PERM) f.vec8(row0 + ai * HALF + m * 16, col0 + bj * HALF, acc[ai][bj][m][0], acc[ai][bj][m][1]);
                    else {
#pragma unroll
                        for (int n = 0; n < 2; ++n) f.vec4(row0 + ai * HALF + m * 16, col0 + bj * HALF + 16 * n, acc[ai][bj][m][n]);
                    }
                }
    }
};

template <class Epi>
__device__ __forceinline__ void gemm_phase(LAS unsigned char* lds, const Gemm g, const StaticOrder& S, const Epi& E) {
    const int tid = TID(), wid = __builtin_amdgcn_readfirstlane(tid >> 6), lane = tid & 63, wr = wid >> 2, wc = wid & 3, fr = lane & 15, fq = lane >> 4;
    const int K = g.K, nt = K / BK;
    unsigned voffA[2], voffB[2];
#pragma unroll
    for (int i = 0; i < 2; ++i) { int R, C; stage_rc(tid * 16 + i * 8192, R, C); const int Rb = Epi::PERM ? ((R & ~31) + perm32(R & 31)) : R;
        voffA[i] = (unsigned)(R * K + C) * 2u; voffB[i] = (unsigned)(Rb * K + C) * 2u; }
    const size_t kstep = (size_t)(BK * 2);
    const size_t hstep = (size_t)HALF * K * 2;
    const size_t tstep = 2 * hstep;
    const unsigned ldsw = (unsigned)wid * 1024u;
    const int aoff = lds_byte(wr * 64 + fr, fq * 8), boff = lds_byte(wc * 32 + fr, fq * 8);
#define PG8_SA(b, h) (((b) * 2 + (h)) * HTB)
#define PG8_SB(b, h) ((4 + (b) * 2 + (h)) * HTB)
#define PG8_STAGE(bufoff, gbase, voff) do { _Pragma("unroll") for (int _i = 0; _i < 2; ++_i) \
        __builtin_amdgcn_global_load_lds((const unsigned*)((const char*)(gbase) + (voff)[_i]), (LAS unsigned*)(lds + (bufoff) + ldsw + _i * 8192), 16, 0, 0); } while (0)
#define PG8_LDA(dst, b, h) do { _Pragma("unroll") for (int m = 0; m < 4; ++m) _Pragma("unroll") for (int k = 0; k < 2; ++k) dst[m][k] = *(const LAS bf16x8*)(lds + PG8_SA(b, h) + aoff + m * 2048 + k * 1024); } while (0)
#define PG8_LDB(dst, b, h) do { _Pragma("unroll") for (int n = 0; n < 2; ++n) _Pragma("unroll") for (int k = 0; k < 2; ++k) dst[n][k] = *(const LAS bf16x8*)(lds + PG8_SB(b, h) + boff + n * 2048 + k * 1024); } while (0)
#define PG8_MMA(ai, bj, At, Bt) do { __builtin_amdgcn_s_setprio(1); _Pragma("unroll") for (int m = 0; m < 4; ++m) _Pragma("unroll") for (int n = 0; n < 2; ++n) _Pragma("unroll") for (int k = 0; k < 2; ++k) \
        acc[ai][bj][m][n] = __builtin_amdgcn_mfma_f32_16x16x32_bf16(Bt[n][k], At[m][k], acc[ai][bj][m][n], 0, 0, 0); __builtin_amdgcn_s_setprio(0); } while (0)
#define PG8_WAIT_V(n) asm volatile("s_waitcnt vmcnt(" #n ")" ::: "memory")
#define PG8_WAIT_L(n) asm volatile("s_waitcnt lgkmcnt(" #n ")" ::: "memory")
#define PG8_BAR __builtin_amdgcn_s_barrier()
#define PG8_SCHED __builtin_amdgcn_sched_barrier(0)
    Unit cur, nxt; int ui = 0;
    if (!S.next(0, cur)) return;
    cur.pn = phys_pn(g, cur.pn);
    f32x4 acc[2][2][4][2];
#pragma unroll
    for (int a = 0; a < 2; ++a)
#pragma unroll
        for (int b = 0; b < 2; ++b)
#pragma unroll
            for (int m = 0; m < 4; ++m)
#pragma unroll
                for (int n = 0; n < 2; ++n) acc[a][b][m][n] = (f32x4){0.f, 0.f, 0.f, 0.f};
    bf16x8 At[4][2], B0[2][2], B1[2][2];
    const char* cA = a_ptr(g, cur, tstep); const char* cB = (const char*)g.Bt + (size_t)cur.pn * tstep;
    PG8_STAGE(PG8_SB(0, 0), cB, voffB); PG8_STAGE(PG8_SA(0, 0), cA, voffA); PG8_STAGE(PG8_SB(0, 1), cB + hstep, voffB); PG8_STAGE(PG8_SA(0, 1), cA + hstep, voffA);
    if (wr == 1) PG8_BAR;
    PG8_WAIT_V(4); PG8_BAR;
    PG8_STAGE(PG8_SB(1, 0), cB + kstep, voffB); PG8_STAGE(PG8_SA(1, 0), cA + kstep, voffA); PG8_STAGE(PG8_SB(1, 1), cB + hstep + kstep, voffB);
    PG8_WAIT_V(6); PG8_BAR;
    for (;;) {
        const bool has_next = S.next(ui + 1, nxt);
        if (has_next) nxt.pn = phys_pn(g, nxt.pn);
        const char* nA = has_next ? a_ptr(g, nxt, tstep) : cA; const char* nB = has_next ? (const char*)g.Bt + (size_t)nxt.pn * tstep : cB;
        for (int t = 0; t < nt; t += 2) {
            const bool last = (t == nt - 2);
            const char* a1 = cA + (size_t)(t + 1) * kstep;
            const char* a2 = last ? nA : cA + (size_t)(t + 2) * kstep; const char* b2 = last ? nB : cB + (size_t)(t + 2) * kstep;
            const char* a3 = a2 + kstep; const char* b3 = b2 + kstep;
            PG8_LDB(B0, 0, 0); PG8_SCHED; PG8_LDA(At, 0, 0); PG8_STAGE(PG8_SA(1, 1), a1 + hstep, voffA);
            PG8_WAIT_L(8); PG8_BAR; PG8_WAIT_L(0); PG8_MMA(0, 0, At, B0); PG8_BAR; PG8_SCHED;
            PG8_LDB(B1, 0, 1); PG8_STAGE(PG8_SB(0, 0), b2, voffB);
            PG8_BAR; PG8_WAIT_L(0); PG8_MMA(0, 1, At, B1); PG8_BAR;
            PG8_LDA(At, 0, 1); PG8_STAGE(PG8_SA(0, 0), a2, voffA);
            PG8_BAR; PG8_WAIT_L(0); PG8_MMA(1, 0, At, B0); PG8_BAR; PG8_SCHED;
            PG8_STAGE(PG8_SB(0, 1), b2 + hstep, voffB);
            PG8_WAIT_V(6); PG8_BAR; PG8_MMA(1, 1, At, B1); PG8_BAR;
            PG8_LDB(B0, 1, 0); PG8_SCHED; PG8_LDA(At, 1, 0); PG8_STAGE(PG8_SA(0, 1), a2 + hstep, voffA);
            PG8_WAIT_L(8); PG8_BAR; PG8_WAIT_L(0); PG8_MMA(0, 0, At, B0); PG8_BAR; PG8_SCHED;
            PG8_LDB(B1, 1, 1); PG8_STAGE(PG8_SB(1, 0), b3, voffB);
            PG8_BAR; PG8_WAIT_L(0); PG8_MMA(0, 1, At, B1); PG8_BAR;
            PG8_LDA(At, 1, 1); PG8_STAGE(PG8_SA(1, 0), a3, voffA);
            PG8_BAR; PG8_WAIT_L(0); PG8_MMA(1, 0, At, B0); PG8_BAR; PG8_SCHED;
            PG8_STAGE(PG8_SB(1, 1), b3 + hstep, voffB);
            PG8_WAIT_V(6); PG8_BAR; PG8_MMA(1, 1, At, B1); PG8_BAR;
        }
        E(acc, cur, wr, wc, fr, fq);
        if (!has_next) break;
#pragma unroll
        for (int a = 0; a < 2; ++a)
#pragma unroll
            for (int b = 0; b < 2; ++b)
#pragma unroll
                for (int m = 0; m < 4; ++m)
#pragma unroll
                    for (int n = 0; n < 2; ++n) acc[a][b][m][n] = (f32x4){0.f, 0.f, 0.f, 0.f};
        cur = nxt; cA = nA; cB = nB; ++ui;
    }
    PG8_WAIT_V(0);
    if (wr == 0) PG8_BAR;
    PG8_BAR;
#undef PG8_SA
#undef PG8_SB
#undef PG8_STAGE
#undef PG8_LDA
#undef PG8_LDB
#undef PG8_MMA
#undef PG8_WAIT_V
#undef PG8_WAIT_L
#undef PG8_BAR
#undef PG8_SCHED
}
}

template <class F>
__device__ __forceinline__ void sgemm_bf(LAS unsigned char* lds, const bf16_t* A, int lda, int row0, int M, const float* W, int ldw, int N, int K, int coloff, const F& f) {
    LAS float* As = (LAS float*)lds;
    LAS float* Ws = (LAS float*)(lds + 32 * 68 * 4);
    const int tid = TID(), ty = tid >> 4, tx = tid & 15;
    const int ntn = (N + 63) / 64, ntiles = (M / 64) * ntn;
    for (int tile = BID(); tile < ntiles; tile += gridDim.x) {
        const int tm = tile / ntn, tn = tile % ntn, r0 = row0 + tm * 64, n0 = tn * 64;
        f32x4 c0 = {0.f, 0.f, 0.f, 0.f}, c1 = {0.f, 0.f, 0.f, 0.f};
        for (int k0 = 0; k0 < K; k0 += 32) {
            __syncthreads();
            { const int r = tid >> 3, q = tid & 7; const f32x4 a = ld_bf4(A + (size_t)(r0 + r) * lda + k0 + 4 * q);
              As[(4 * q + 0) * 68 + r] = a[0]; As[(4 * q + 1) * 68 + r] = a[1]; As[(4 * q + 2) * 68 + r] = a[2]; As[(4 * q + 3) * 68 + r] = a[3]; }
            { const int kr = tid >> 4, c = tid & 15; f32x4 w = {0.f, 0.f, 0.f, 0.f}; if (n0 + 4 * c < N) w = *(const f32x4*)(W + (size_t)(k0 + kr) * ldw + n0 + 4 * c);
              *(LAS f32x4*)(Ws + kr * 68 + 4 * c) = w; }
            __syncthreads();
#pragma unroll 8
            for (int kk = 0; kk < 32; ++kk) {
                const f32x2 a = *(const LAS f32x2*)(As + kk * 68 + 2 * ty); const f32x4 b = *(const LAS f32x4*)(Ws + kk * 68 + 4 * tx);
                c0 += a.x * b; c1 += a.y * b;
            }
        }
        if (n0 + 4 * tx < N) { f.vec4(r0 + 2 * ty, n0 + 4 * tx + coloff, c0); f.vec4(r0 + 2 * ty + 1, n0 + 4 * tx + coloff, c1); }
    }
    __syncthreads();
}

typedef float f32x16 __attribute__((ext_vector_type(16)));
__device__ __forceinline__ int rw_group(int n0) { const int t = n0 >> 8; return t < 12 ? (t >> 2) : (t == 12 ? 2 : t - 10); }
template <bool RWGRP, class F>
__device__ __forceinline__ void wgemm_ks(LAS unsigned char* lds, const bf16_t* A, int lda, size_t agrp, int row0, int M, const bf16_t* Bt, int K, int N, const F& f) {
    const int tid = TID(), wave = tid >> 6, lane = tid & 63, lr = lane & 31, lh = lane >> 5;
    LAS float* red = (LAS float*)lds;
    const int ntn = N / 64, nitems = (M / 32) * ntn, kw = K / 8, steps = kw / 16;
    for (int item = BID(); item < nitems; item += gridDim.x) {
        const int tm = item / ntn, tn = item % ntn, r0 = row0 + tm * 32, n0 = tn * 64;
        const bf16_t* Ab = A + (RWGRP ? (size_t)rw_group(n0) * agrp : 0) + (size_t)(r0 + lr) * lda + wave * kw + lh * 8;
        const bf16_t* B0 = Bt + (size_t)(n0 + lr) * K + wave * kw + lh * 8; const bf16_t* B1 = B0 + (size_t)32 * K;
        f32x16 acc0, acc1;
#pragma unroll
        for (int r = 0; r < 16; ++r) { acc0[r] = 0.f; acc1[r] = 0.f; }
#pragma unroll 8
        for (int st = 0; st < steps; ++st) {
            const bf16x8 a = *(const bf16x8*)(Ab + 16 * st), b0 = *(const bf16x8*)(B0 + 16 * st), b1 = *(const bf16x8*)(B1 + 16 * st);
            acc0 = __builtin_amdgcn_mfma_f32_32x32x16_bf16(b0, a, acc0, 0, 0, 0);
            acc1 = __builtin_amdgcn_mfma_f32_32x32x16_bf16(b1, a, acc1, 0, 0, 0);
        }
        __syncthreads();
#pragma unroll
        for (int r = 0; r < 16; ++r) { red[((wave * 2 + 0) * 16 + r) * 64 + lane] = acc0[r]; red[((wave * 2 + 1) * 16 + r) * 64 + lane] = acc1[r]; }
        __syncthreads();
        { const int t = tid >> 8, r4 = (tid >> 6) & 3, l2 = tid & 63; f32x4 v = {0.f, 0.f, 0.f, 0.f};
#pragma unroll
          for (int w = 0; w < 8; ++w)
#pragma unroll
              for (int e = 0; e < 4; ++e) v[e] += red[((w * 2 + t) * 16 + 4 * r4 + e) * 64 + l2];
          f.vec4(r0 + (l2 & 31), n0 + 32 * t + 8 * r4 + 4 * (l2 >> 5), v); }
    }
    __syncthreads();
}
template <class F>
__device__ __forceinline__ void wgemm_w(const bf16_t* A, int lda, int row0, int M, const bf16_t* Bt, int K, int N, const F& f) {
    const int lane = TID() & 63, lr = lane & 31, lh = lane >> 5, gw = BID() * 8 + (TID() >> 6), nw = gridDim.x * 8;
    const int ntn = N / 64, nitems = (M / 32) * ntn, steps = K / 16;
    for (int item = gw; item < nitems; item += nw) {
        const int tm = item / ntn, tn = item % ntn, r0 = row0 + tm * 32, n0 = tn * 64;
        const bf16_t* Ab = A + (size_t)(r0 + lr) * lda + lh * 8;
        const bf16_t* B0 = Bt + (size_t)(n0 + lr) * K + lh * 8; const bf16_t* B1 = B0 + (size_t)32 * K;
        f32x16 acc0, acc1;
#pragma unroll
        for (int r = 0; r < 16; ++r) { acc0[r] = 0.f; acc1[r] = 0.f; }
        for (int st = 0; st < steps; ++st) {
            const bf16x8 a = *(const bf16x8*)(Ab + 16 * st), b0 = *(const bf16x8*)(B0 + 16 * st), b1 = *(const bf16x8*)(B1 + 16 * st);
            acc0 = __builtin_amdgcn_mfma_f32_32x32x16_bf16(b0, a, acc0, 0, 0, 0);
            acc1 = __builtin_amdgcn_mfma_f32_32x32x16_bf16(b1, a, acc1, 0, 0, 0);
        }
#pragma unroll
        for (int r4 = 0; r4 < 4; ++r4) {
            f.vec4(r0 + lr, n0 + 8 * r4 + 4 * lh, (f32x4){acc0[4 * r4], acc0[4 * r4 + 1], acc0[4 * r4 + 2], acc0[4 * r4 + 3]});
            f.vec4(r0 + lr, n0 + 32 + 8 * r4 + 4 * lh, (f32x4){acc1[4 * r4], acc1[4 * r4 + 1], acc1[4 * r4 + 2], acc1[4 * r4 + 3]});
        }
    }
}

struct FRwkvIn {
    bf16_t *rb, *kb, *vb, *tw, *ta, *tv, *tg;
    __device__ __forceinline__ void vec8(int row, int col, f32x4 a, f32x4 b) const {
        if (col < 3072) { u32x4 w; w.x = pk_bf16(a[0], a[1]); w.y = pk_bf16(a[2], a[3]); w.z = pk_bf16(b[0], b[1]); w.w = pk_bf16(b[2], b[3]);
            *(u32x4*)(rb + (size_t)(col >> 10) * XR_STRIDE + (size_t)row * D + (col & 1023)) = w; }
        else { vec4(row, col, a); vec4(row, col + 4, b); } }
    __device__ __forceinline__ void vec4(int row, int col, f32x4 v) const {
        if (col < 3072) { st_bf4(rb + (size_t)(col >> 10) * XR_STRIDE + (size_t)row * D + (col & 1023), v); }
        else if (col < 3328) { const int c = col - 3072; if (c < 32) st_bf4(tv + (size_t)row * 32 + c, v); }
        else if (col < 3584) { const int c = col - 3328; if (c < 64) { f32x4 t = {ftanh(v[0]), ftanh(v[1]), ftanh(v[2]), ftanh(v[3])}; st_bf4(tw + (size_t)row * 64 + c, t); } }
        else if (col < 3840) { const int c = col - 3584; if (c < 64) st_bf4(ta + (size_t)row * 64 + c, v); }
        else { const int c = col - 3840; if (c < 160) { f32x4 t = {fsig(v[0]), fsig(v[1]), fsig(v[2]), fsig(v[3])}; st_bf4(tg + (size_t)row * 160 + c, t); } }
    }
};
struct FStoreF32 { float* C; int ldc; int ncols; __device__ __forceinline__ void vec4(int row, int col, f32x4 v) const { if (col < ncols) *(f32x4*)(C + (size_t)row * ldc + col) = v; } };
struct FResid {
    float* X; const float* gate;
    const float* xin_p; const float* xin_s;
    __device__ __forceinline__ void vec4(int row, int col, f32x4 v) const {
        const f32x4 g = *(const f32x4*)(gate + (size_t)row_seq(row) * 6144 + col); float* xp = X + (size_t)row * D + col;
        const float* ip = xin_p ? (row < NP ? xin_p + (size_t)row * D + col : xin_s + (size_t)(row - NP) * D + col) : xp;
        const f32x4 x = *(const f32x4*)ip; *(f32x4*)xp = x + g * v; }
};
struct FRelu2 { bf16_t* U;
    __device__ __forceinline__ void vec8(int row, int col, f32x4 a, f32x4 b) const {
        f32x4 s, t; for (int e = 0; e < 4; ++e) { const float x = fmaxf(a[e], 0.f), y = fmaxf(b[e], 0.f); s[e] = x * x; t[e] = y * y; }
        u32x4 w; w.x = pk_bf16(s[0], s[1]); w.y = pk_bf16(s[2], s[3]); w.z = pk_bf16(t[0], t[1]); w.w = pk_bf16(t[2], t[3]); *(u32x4*)(U + (size_t)row * DFF + col) = w; }
    __device__ __forceinline__ void vec4(int row, int col, f32x4 v) const {
        f32x4 t; for (int e = 0; e < 4; ++e) { const float r = fmaxf(v[e], 0.f); t[e] = r * r; } st_bf4(U + (size_t)row * DFF + col, t); } };

__device__ __forceinline__ void phase_copy_x(KP p) {
    const size_t n4p = (size_t)NP * D / 4, n4 = (size_t)NT * D / 4;
    for (size_t i = (size_t)BID() * 512 + TID(); i < n4; i += (size_t)gridDim.x * 512)
        ((f32x4*)p->out)[i] = i < n4p ? ((const f32x4*)p->x_prompt)[i] : ((const f32x4*)p->x_sample)[i - n4p];
}

struct TJob { const float* src; bf16_t* dst; int K, N, drow0; };
__device__ __forceinline__ TJob tjob(KP p, int i) {
    TJob t; t.drow0 = 0;
    if (i < 4) { t.src = p->w_up + (size_t)i * D * DFF; t.dst = WSP(bf16_t, WS_WUP_T) + (size_t)i * DFF * D; t.K = D; t.N = DFF; return t; }
    if (i < 8) { const int l = i - 4; t.src = p->w_down + (size_t)l * DFF * D; t.dst = WSP(bf16_t, WS_WDN_T) + (size_t)l * DFF * D; t.K = DFF; t.N = D; return t; }
    i -= 8; const int j = i / 14, k = i % 14; bf16_t* wrw = WSP(bf16_t, WS_WRW_T) + (size_t)j * 4096 * D;
    t.K = D; t.N = D;
    switch (k) {
        case 0: case 1: case 2: t.src = p->rw_w_rkv + ((size_t)j * 3 + k) * D * D; t.dst = wrw; t.drow0 = k * 1024; break;
        case 3: t.src = p->rw_v1; t.dst = wrw; t.drow0 = 3072; t.N = j == 1 ? 32 : 0; break;
        case 4: t.src = p->rw_w1 + (size_t)j * D * 64; t.dst = wrw; t.drow0 = 3328; t.N = 64; break;
        case 5: t.src = p->rw_a1 + (size_t)j * D * 64; t.dst = wrw; t.drow0 = 3584; t.N = 64; break;
        case 6: t.src = p->rw_g1 + (size_t)j * D * 160; t.dst = wrw; t.drow0 = 3840; t.N = 160; break;
        case 7: t.src = p->rw_w_o + (size_t)j * D * D; t.dst = WSP(bf16_t, WS_WO_T) + (size_t)j * D * D; break;
        case 8: t.src = p->rw_w2 + (size_t)j * 64 * D; t.dst = WSP(bf16_t, WS_W2T) + (size_t)j * D * 64; t.K = 64; break;
        case 9: t.src = p->rw_a2 + (size_t)j * 64 * D; t.dst = WSP(bf16_t, WS_A2T) + (size_t)j * D * 64; t.K = 64; break;
        case 10: t.src = p->rw_g2 + (size_t)j * 160 * D; t.dst = WSP(bf16_t, WS_G2T) + (size_t)j * D * 160; t.K = 160; break;
        case 11: t.src = p->rw_v2; t.dst = WSP(bf16_t, WS_V2T); t.K = 32; t.N = j == 1 ? D : 0; break;
        case 12: t.src = p->att_w_in + (size_t)j * D * PIN; t.dst = WSP(bf16_t, WS_WIN_T) + (size_t)j * PINP * D; t.N = PIN; break;
        default: t.src = p->att_w_o + (size_t)j * D * D; t.dst = WSP(bf16_t, WS_WAO_T) + (size_t)j * D * D; break;
    }
    return t;
}
__device__ __forceinline__ int tjob_tiles(const TJob& t) { return ((t.K + 63) / 64) * ((t.N + 63) / 64); }
__device__ __forceinline__ void phase_weights(KP p, LAS unsigned char* lds) {
    LAS float* T = (LAS float*)lds;
    const int tid = TID();
    int total = 0;
    for (int i = 0; i < 36; ++i) total += tjob_tiles(tjob(p, i));
    const int ngrp = (total + 3) / 4;
    for (int g = BID(); g < ngrp; g += gridDim.x) {
        __syncthreads();
        TJob tj[4]; int k0[4], n0[4];
        { int i = 0, start = 0, cnt = tjob_tiles(tjob(p, 0));
#pragma unroll
          for (int u = 0; u < 4; ++u) { const int gt = 4 * g + u;
              while (i < 35 && gt >= start + cnt) { start += cnt; ++i; cnt = tjob_tiles(tjob(p, i)); }
              tj[u] = tjob(p, i); const int lt = gt - start, nkt = (tj[u].K + 63) / 64;
              if (gt >= total || lt >= cnt) { tj[u] = tjob(p, 0); k0[u] = 1 << 20; n0[u] = 1 << 20; } else { k0[u] = (lt % nkt) * 64; n0[u] = (lt / nkt) * 64; } }
        }
        f32x4 v[4][2];
        const int kk = tid >> 4, n4 = (tid & 15) * 4;
#pragma unroll
        for (int u = 0; u < 4; ++u)
#pragma unroll
            for (int hh = 0; hh < 2; ++hh) { const int k = k0[u] + kk + 32 * hh, n = n0[u] + n4; const bool ok = k < tj[u].K && n < tj[u].N;
                const f32x4 t_ = *(const f32x4*)(tj[u].src + (size_t)min(k, tj[u].K - 1) * tj[u].N + min(n, tj[u].N - 4));
                v[u][hh] = ok ? t_ : (f32x4){0.f, 0.f, 0.f, 0.f}; }
#pragma unroll
        for (int u = 0; u < 4; ++u)
#pragma unroll
            for (int hh = 0; hh < 2; ++hh)
#pragma unroll
                for (int e = 0; e < 4; ++e) T[(u * 64 + kk + 32 * hh) * 65 + n4 + e] = v[u][hh][e];
        __syncthreads();
        const int nn = tid >> 3, k8 = (tid & 7) * 8;
#pragma unroll
        for (int u = 0; u < 4; ++u) {
            if (n0[u] + nn < tj[u].N && k0[u] + k8 < tj[u].K) {
                u32x4 w;
                w.x = pk_bf16(T[(u * 64 + k8 + 0) * 65 + nn], T[(u * 64 + k8 + 1) * 65 + nn]); w.y = pk_bf16(T[(u * 64 + k8 + 2) * 65 + nn], T[(u * 64 + k8 + 3) * 65 + nn]);
                w.z = pk_bf16(T[(u * 64 + k8 + 4) * 65 + nn], T[(u * 64 + k8 + 5) * 65 + nn]); w.w = pk_bf16(T[(u * 64 + k8 + 6) * 65 + nn], T[(u * 64 + k8 + 7) * 65 + nn]);
                *(u32x4*)(tj[u].dst + (size_t)(tj[u].drow0 + n0[u] + nn) * tj[u].K + k0[u] + k8) = w;
            }
        }
    }
    __syncthreads();
}

__device__ __forceinline__ void phase_ada(KP p, LAS unsigned char* lds) {
    float* mods = WSP(float, WS_MODS);
    LAS float* sil = (LAS float*)lds;
    LAS float* red = (LAS float*)(lds + 36864);
    const int tid = TID(), c = tid & 127, ds = tid >> 7;
    for (int item = BID(); item < 192; item += gridDim.x) {
        const int l = item / 48, col = (item % 48) * 128 + c;
        float acc[36];
#pragma unroll
        for (int s = 0; s < 36; ++s) acc[s] = 0.f;
        for (int cc = 0; cc < 4; ++cc) {
            __syncthreads();
            for (int e = tid; e < 4 * 64 * 36; e += 512) { const int s = e % 36, dd = (e / 36) % 64, sl = e / (36 * 64), d = 256 * sl + 64 * cc + dd;
                const float cv = s < 4 ? p->c_prompt[s * D + d] : p->c_sample[(s - 4) * D + d]; sil[e] = cv / (1.0f + expf(-cv)); }
            __syncthreads();
            const float* wp = p->w_ada + ((size_t)l * D + 256 * ds + 64 * cc) * 6144 + col;
            for (int dd = 0; dd < 64; ++dd) {
                const float w = wp[(size_t)dd * 6144];
                const LAS float* sp = sil + (ds * 64 + dd) * 36;
#pragma unroll
                for (int s = 0; s < 36; ++s) acc[s] += sp[s] * w;
            }
        }
        __syncthreads();
#pragma unroll
        for (int s = 0; s < 36; ++s) red[(ds * 128 + c) * 36 + s] = acc[s];
        __syncthreads();
        for (int k = 0; k < 9; ++k) { const int s = 9 * ds + k;
            const float v = red[(0 * 128 + c) * 36 + s] + red[(1 * 128 + c) * 36 + s] + red[(2 * 128 + c) * 36 + s] + red[(3 * 128 + c) * 36 + s];
            mods[((size_t)l * 36 + s) * 6144 + col] = v + p->b_ada[l * 6144 + col]; }
    }
    __syncthreads();
}

template <bool MIX>
__device__ __forceinline__ void phase_prep(KP p, int layer, int which, int j, bool first = false) {
    const float* X = p->out;
    const float* mods = WSP(float, WS_MODS) + (size_t)layer * 36 * 6144;
    const float* g = p->norm_g + (layer * 2 + which) * D;
    bf16_t* XR = WSP(bf16_t, WS_XR);
    const int lane = TID() & 63, gw = BID() * 8 + (TID() >> 6), nw = gridDim.x * 8;
    for (int run = gw; run < NT / 8; run += nw) {
        const int row0 = run * 8, seq = row_seq(row0);
        const float* sh = mods + (size_t)seq * 6144 + (which ? 3 : 0) * D; const float* sc = sh + D;
        f32x4 gv[4], scv[4], shv[4], hp[4];
#pragma unroll
        for (int i = 0; i < 4; ++i) { const int col = 512 * (i >> 1) + 8 * lane + 4 * (i & 1); gv[i] = *(const f32x4*)(g + col); scv[i] = *(const f32x4*)(sc + col) + 1.0f; shv[i] = *(const f32x4*)(sh + col); hp[i] = (f32x4){0.f, 0.f, 0.f, 0.f}; }
        int rstart = 0;
        if (MIX) {
            if (row0 >= NP) {
#pragma unroll
                for (int i = 0; i < 4; ++i) hp[i] = *(const f32x4*)(p->state_shift + ((size_t)j * 32 + (seq - 4)) * D + 512 * (i >> 1) + 8 * lane + 4 * (i & 1));
            } else if ((row0 & 4095) != 0) rstart = -1;
        }
        for (int r = rstart; r < 8; ++r) {
            const int row = row0 + r;
            f32x4 x[4]; float ss = 0.f;
            const float* xr = first ? (row < NP ? p->x_prompt + (size_t)row * D : p->x_sample + (size_t)(row - NP) * D) : X + (size_t)row * D;
#pragma unroll
            for (int i = 0; i < 4; ++i) { x[i] = *(const f32x4*)(xr + 512 * (i >> 1) + 8 * lane + 4 * (i & 1)); ss += x[i][0] * x[i][0] + x[i][1] * x[i][1] + x[i][2] * x[i][2] + x[i][3] * x[i][3]; }
            ss = wave_sum(ss);
            const float rstd = rsqrtf(ss * (1.0f / 1024.0f) + 1e-6f);
            f32x4 h[4];
#pragma unroll
            for (int i = 0; i < 4; ++i) h[i] = x[i] * rstd * gv[i] * scv[i] + shv[i];
            if (MIX) {
                if (r >= 0) {
#pragma unroll
                    for (int n = 0; n < 6; ++n) {
                        const int mi = n == 0 ? 0 : (n == 1 ? 2 : (n == 2 ? 3 : (n == 3 ? 1 : n)));
                        const float* mx = p->rw_mix + ((size_t)j * 6 + mi) * D;
#pragma unroll
                        for (int i2 = 0; i2 < 2; ++i2) { const int col = 512 * i2 + 8 * lane; const f32x4 m0 = *(const f32x4*)(mx + col), m1 = *(const f32x4*)(mx + col + 4);
                            const f32x4 a = h[2 * i2] + (hp[2 * i2] - h[2 * i2]) * m0, b2 = h[2 * i2 + 1] + (hp[2 * i2 + 1] - h[2 * i2 + 1]) * m1;
                            u32x4 w; w.x = pk_bf16(a[0], a[1]); w.y = pk_bf16(a[2], a[3]); w.z = pk_bf16(b2[0], b2[1]); w.w = pk_bf16(b2[2], b2[3]);
                            *(u32x4*)(XR + (size_t)n * XR_STRIDE + (size_t)row * D + col) = w; }
                    }
                    const bool lastp = row < NP && (row & 4095) == 4095, lasts = row >= NP && ((row - NP) & 7) == 7;
                    if (lastp || lasts) {
                        float* so = lastp ? p->out + O_SHP + ((size_t)j * 4 + seq) * D : p->out + O_SHS + ((size_t)j * 32 + (seq - 4)) * D;
#pragma unroll
                        for (int i = 0; i < 4; ++i) *(f32x4*)(so + 512 * (i >> 1) + 8 * lane + 4 * (i & 1)) = h[i];
                    }
                }
#pragma unroll
                for (int i = 0; i < 4; ++i) hp[i] = h[i];
            } else {
#pragma unroll
                for (int i2 = 0; i2 < 2; ++i2) { const f32x4 a = h[2 * i2], b2 = h[2 * i2 + 1]; u32x4 w; w.x = pk_bf16(a[0], a[1]); w.y = pk_bf16(a[2], a[3]); w.z = pk_bf16(b2[0], b2[1]); w.w = pk_bf16(b2[2], b2[3]);
                    *(u32x4*)(XR + (size_t)row * D + 512 * i2 + 8 * lane) = w; }
            }
        }
    }
}

__device__ __forceinline__ void phase_scanprep(KP p, int j) {
    const bf16_t *KB = WSP(bf16_t, WS_KB), *VB = WSP(bf16_t, WS_VB);
    const float *WPp = WSP(float, WS_WP), *APp = WSP(float, WS_AP), *VPp = WSP(float, WS_VP);
    float *VF = WSP(float, WS_VFIRST), *DEC = WSP(float, WS_DEC), *KM = WSP(float, WS_KM), *VM = WSP(float, WS_VM), *AV = WSP(float, WS_AV), *BV = WSP(float, WS_BV);
    const int lane = TID() & 63, gw = BID() * 8 + (TID() >> 6), nw = gridDim.x * 8;
    for (int row = gw; row < NT; row += nw) {
#pragma unroll
        for (int i = 0; i < 4; ++i) {
            const int col = 256 * i + 4 * lane; const size_t o = (size_t)row * D + col;
            const f32x4 k = ld_bf4(KB + o), v = ld_bf4(VB + o), wp = *(const f32x4*)(WPp + o), ap = *(const f32x4*)(APp + o);
            const f32x4 w0 = *(const f32x4*)(p->rw_w0 + j * D + col), a0 = *(const f32x4*)(p->rw_a0 + j * D + col), kkw = *(const f32x4*)(p->rw_k_k + j * D + col), kaw = *(const f32x4*)(p->rw_k_a + j * D + col);
            f32x4 dec, a, vm, kk, km;
#pragma unroll
            for (int e = 0; e < 4; ++e) {
                const float wpre = w0[e] + wp[e], z = -wpre, sp = fmaxf(z, 0.f) + log1pf(expf(-fabsf(z)));
                dec[e] = expf(-expf(-sp - 0.5f));
                a[e] = sigmoidf_(a0[e] + ap[e]);
                kk[e] = k[e] * kkw[e];
                km[e] = k[e] * (1.0f + (a[e] - 1.0f) * kaw[e]);
            }
            if (j == 0) { vm = v; *(f32x4*)(VF + o) = v; }
            else { const f32x4 vf = *(const f32x4*)(VF + o), vp = *(const f32x4*)(VPp + o), v0 = *(const f32x4*)(p->rw_v0 + (j - 1) * D + col);
#pragma unroll
                for (int e = 0; e < 4; ++e) vm[e] = v[e] + (vf[e] - v[e]) * sigmoidf_(v0[e] + vp[e]); }
            float ss = kk[0] * kk[0] + kk[1] * kk[1] + kk[2] * kk[2] + kk[3] * kk[3];
            ss = g16_sum(ss);
            const float inv = rsqrtf(fmaxf(ss, 1e-24f));
            kk = kk * inv;
            *(f32x4*)(DEC + o) = dec; *(f32x4*)(KM + o) = km; *(f32x4*)(VM + o) = vm; *(f32x4*)(AV + o) = -kk; *(f32x4*)(BV + o) = kk * a;
        }
    }
}

__device__ __forceinline__ float rl(float v, int k) { return __int_as_float(__builtin_amdgcn_readlane(__float_as_int(v), k)); }
__device__ __forceinline__ void scan_run(KP p, size_t row_base, int nsteps, int colbase, float (&S)[64]) {
    const float *DEC = WSP(float, WS_DEC), *KM = WSP(float, WS_KM), *VM = WSP(float, WS_VM), *AV = WSP(float, WS_AV), *BV = WSP(float, WS_BV);
    const bf16_t* RB = WSP(bf16_t, WS_RB); float* Y = WSP(float, WS_Y);
    const int lane = TID() & 63;
    size_t o = row_base * D + colbase + lane;
    float w = DEC[o], kx = KM[o], v = VM[o], a = AV[o], b = BV[o], r = bf2f(RB[o]);
    for (int t = 0; t < nsteps; ++t) {
        const size_t on = (t + 1 < nsteps) ? o + D : o;
        const float wn = DEC[on], kn = KM[on], vn = VM[on], an = AV[on], bn = BV[on], rn = bf2f(RB[on]);
        float sa = 0.f;
#pragma unroll
        for (int k = 0; k < 64; ++k) sa += S[k] * rl(a, k);
#pragma unroll
        for (int k = 0; k < 64; ++k) S[k] = S[k] * rl(w, k) + sa * rl(b, k) + v * rl(kx, k);
        float y = 0.f;
#pragma unroll
        for (int k = 0; k < 64; ++k) y += S[k] * rl(r, k);
        Y[o] = y;
        o = on; w = wn; kx = kn; v = vn; a = an; b = bn; r = rn;
    }
}
__device__ __forceinline__ void phase_scanA(KP p) {
    const float *DEC = WSP(float, WS_DEC), *KM = WSP(float, WS_KM), *VM = WSP(float, WS_VM), *AV = WSP(float, WS_AV), *BV = WSP(float, WS_BV);
    float *PCH = WSP(float, WS_PCH), *CCH = WSP(float, WS_CCH);
    const int lane = TID() & 63, gw = BID() * 8 + (TID() >> 6), nw = gridDim.x * 8;
    for (int it = gw; it < 64 * NCH; it += nw) {
        const int sh = it / NCH, c = it % NCH, b = sh >> 4, h = sh & 15;
        float SP[64], SC[64];
#pragma unroll
        for (int k = 0; k < 64; ++k) { SP[k] = (k == lane) ? 1.f : 0.f; SC[k] = 0.f; }
        size_t o = ((size_t)b * 4096 + (size_t)c * LCH) * D + h * 64 + lane;
        float w = DEC[o], kx = KM[o], v = VM[o], a = AV[o], bb = BV[o];
        for (int t = 0; t < LCH; ++t) {
            const size_t on = (t + 1 < LCH) ? o + D : o;
            const float wn = DEC[on], kn = KM[on], vn = VM[on], an = AV[on], bn = BV[on];
            float saP = 0.f, saC = 0.f;
#pragma unroll
            for (int k = 0; k < 64; ++k) { const float ak = rl(a, k); saP += SP[k] * ak; saC += SC[k] * ak; }
#pragma unroll
            for (int k = 0; k < 64; ++k) { const float wk = rl(w, k), bk = rl(bb, k); SP[k] = SP[k] * wk + saP * bk; SC[k] = SC[k] * wk + saC * bk + v * rl(kx, k); }
            o = on; w = wn; kx = kn; v = vn; a = an; bb = bn;
        }
        float* po = PCH + ((size_t)it * 64 + lane) * 64; float* co = CCH + ((size_t)it * 64 + lane) * 64;
#pragma unroll
        for (int k = 0; k < 64; k += 4) { *(f32x4*)(po + k) = (f32x4){SP[k], SP[k + 1], SP[k + 2], SP[k + 3]}; *(f32x4*)(co + k) = (f32x4){SC[k], SC[k + 1], SC[k + 2], SC[k + 3]}; }
    }
}
__device__ __forceinline__ void phase_scanB(KP p, int j, LAS unsigned char* lds) {
    const int tid = TID(), lane = tid & 63, wave = tid >> 6;
    if (BID() < 32) {
        const float *PCH = WSP(float, WS_PCH), *CCH = WSP(float, WS_CCH); float* SST = WSP(float, WS_SST);
        const int sh = BID() * 2 + (wave >> 2), q = wave & 3, row0 = 32 * (q >> 1), col0 = 32 * (q & 1), b = sh >> 4, h = sh & 15;
        LAS float* Sl = (LAS float*)lds + (wave >> 2) * (2 * 64 * 65);
        const int lr = lane & 31, lh = lane >> 5;
        f32x16 acc;
#pragma unroll
        for (int r = 0; r < 16; ++r) acc[r] = 0.f;
        for (int c = 0; c <= NCH; ++c) {
            LAS float* Sw = Sl + (c & 1) * (64 * 65);
            float* go = c < NCH ? SST + ((size_t)sh * NCH + c) * 4096 : p->out + O_WKVP + (((size_t)j * 4 + b) * 16 + h) * 4096;
#pragma unroll
            for (int r = 0; r < 16; ++r) { const int row = row0 + (r & 3) + 8 * (r >> 2) + 4 * lh; Sw[row * 65 + col0 + lr] = acc[r]; go[row * 64 + col0 + lr] = acc[r]; }
            if (c == NCH) break;
            const float* Pc = PCH + ((size_t)sh * NCH + c) * 4096; const float* Cc = CCH + ((size_t)sh * NCH + c) * 4096;
            float bv[32];
#pragma unroll
            for (int kk = 0; kk < 32; ++kk) bv[kk] = Pc[(2 * kk + lh) * 64 + col0 + lr];
#pragma unroll
            for (int r = 0; r < 16; ++r) acc[r] = Cc[(row0 + (r & 3) + 8 * (r >> 2) + 4 * lh) * 64 + col0 + lr];
            __syncthreads();
#pragma unroll
            for (int kk = 0; kk < 32; ++kk) acc = __builtin_amdgcn_mfma_f32_32x32x2f32(Sw[(row0 + lr) * 65 + 2 * kk + lh], bv[kk], acc, 0, 0, 0);
        }
    } else {
        for (int it = (BID() - 32) * 8 + wave; it < 512; it += (gridDim.x - 32) * 8) {
            const int b = it >> 4, h = it & 15;
            const float* s0 = p->state_wkv + (((size_t)j * 32 + b) * 16 + h) * 4096 + lane * 64;
            float S[64];
#pragma unroll
            for (int k = 0; k < 64; k += 4) { const f32x4 t = *(const f32x4*)(s0 + k); S[k] = t[0]; S[k + 1] = t[1]; S[k + 2] = t[2]; S[k + 3] = t[3]; }
            scan_run(p, (size_t)NP + b * 8, 8, h * 64, S);
            float* o = p->out + O_WKVS + (((size_t)j * 32 + b) * 16 + h) * 4096 + lane * 64;
#pragma unroll
            for (int k = 0; k < 64; k += 4) *(f32x4*)(o + k) = (f32x4){S[k], S[k + 1], S[k + 2], S[k + 3]};
        }
    }
    __syncthreads();
}
__device__ __forceinline__ void phase_scanC(KP p) {
    const float* SST = WSP(float, WS_SST);
    const int lane = TID() & 63, gw = BID() * 8 + (TID() >> 6), nw = gridDim.x * 8;
    for (int it = gw; it < 64 * NCH; it += nw) {
        const int sh = it / NCH, c = it % NCH, b = sh >> 4, h = sh & 15;
        const float* s0 = SST + ((size_t)it * 64 + lane) * 64;
        float S[64];
#pragma unroll
        for (int k = 0; k < 64; k += 4) { const f32x4 t = *(const f32x4*)(s0 + k); S[k] = t[0]; S[k + 1] = t[1]; S[k + 2] = t[2]; S[k + 3] = t[3]; }
        scan_run(p, (size_t)b * 4096 + (size_t)c * LCH, LCH, h * 64, S);
    }
}


constexpr int CST = 72;
constexpr int CMAT = 64 * CST * 2;
constexpr int CH_F32 = 11 * CMAT, CH_PART = CH_F32 + 64 * 68 * 4, CH_GL = CH_PART + 64 * 4 * 4;
__device__ __forceinline__ bf16x8 cfrag(const LAS bf16_t* M, int row, int ks, int c4) { return *(const LAS bf16x8*)(M + row * CST + 32 * ks + 8 * c4); }
__device__ __forceinline__ f32x4 cmm(const LAS bf16_t* A, int arow, const LAS bf16_t* B, int brow, int c4, f32x4 acc) {
    acc = __builtin_amdgcn_mfma_f32_16x16x32_bf16(cfrag(A, arow, 0, c4), cfrag(B, brow, 0, c4), acc, 0, 0, 0);
    return __builtin_amdgcn_mfma_f32_16x16x32_bf16(cfrag(A, arow, 1, c4), cfrag(B, brow, 1, c4), acc, 0, 0, 0); }
__device__ __forceinline__ unsigned short f2bf(float x) { return (unsigned short)(pk_bf16(x, 0.f) & 0xffffu); }
__device__ __forceinline__ void st_t4(LAS bf16_t* Mt, int d, int t0, f32x4 v) { u32x2 w; w.x = pk_bf16(v[0], v[1]); w.y = pk_bf16(v[2], v[3]); *(LAS u32x2*)(Mt + d * CST + t0) = w; }

__device__ __forceinline__ void phase_chunk(KP p, int j, LAS unsigned char* lds) {
    LAS bf16_t* Mx = (LAS bf16_t*)lds;
#define CM(i) (Mx + (i) * (64 * CST))
    LAS float* F32 = (LAS float*)(lds + CH_F32);
    asm volatile("" : "+v"(F32));
    LAS float* part = (LAS float*)(lds + CH_PART);
    LAS float* gLs = (LAS float*)(lds + CH_GL);
    const bf16_t *RB = WSP(bf16_t, WS_RB), *KB = WSP(bf16_t, WS_KB), *VB = WSP(bf16_t, WS_VB), *TW = WSP(bf16_t, WS_TW), *TA_ = WSP(bf16_t, WS_TA), *TV = WSP(bf16_t, WS_TV);
    const bf16_t *W2T = WSP(bf16_t, WS_W2T) + (size_t)j * D * 64, *A2T = WSP(bf16_t, WS_A2T) + (size_t)j * D * 64, *V2T = WSP(bf16_t, WS_V2T);
    float* VF = WSP(float, WS_VFIRST); float *PCH = WSP(float, WS_PCH), *CCH = WSP(float, WS_CCH), *Y0 = WSP(float, WS_Y), *BON = WSP(float, WS_AV);
    bf16_t *GM = WSP(bf16_t, WS_DEC), *VM2 = WSP(bf16_t, WS_KM);
#define CH_BAR() do { asm volatile("s_waitcnt lgkmcnt(0)" ::: "memory"); __builtin_amdgcn_s_barrier(); asm volatile("" ::: "memory"); } while (0)
    bf16x8 f_aw[2], f_aa[2], f_av; unsigned short e_k[2][4], e_v[2][4], e_r[2][4];
    f_av = (bf16x8){0, 0, 0, 0, 0, 0, 0, 0};
#define CH_PREFETCH(itx) do { const int tid_ = TID(), lane_ = tid_ & 63, w_ = tid_ >> 6, n_ = lane_ & 15, c4_ = lane_ >> 4, tr_ = w_ >> 1, tcb_ = 2 * (w_ & 1); \
        const int sh_ = (itx) / NCH, c_ = (itx) % NCH, R0_ = (sh_ >> 4) * 4096 + c_ * LCH, hc_ = (sh_ & 15) * 64; const int ar_ = 16 * tr_ + n_; \
        _Pragma("unroll") for (int ks = 0; ks < 2; ++ks) { f_aw[ks] = *(const bf16x8*)(TW + (size_t)R0_ * 64 + ar_ * 64 + 32 * ks + 8 * c4_); f_aa[ks] = *(const bf16x8*)(TA_ + (size_t)R0_ * 64 + ar_ * 64 + 32 * ks + 8 * c4_); } \
        if (j == 1) f_av = *(const bf16x8*)(TV + (size_t)R0_ * 32 + ar_ * 32 + 8 * c4_); \
        _Pragma("unroll") for (int ti = 0; ti < 2; ++ti) _Pragma("unroll") for (int r = 0; r < 4; ++r) { const size_t o_ = (size_t)R0_ * D + hc_ + (16 * tr_ + 4 * c4_ + r) * D + 16 * (tcb_ + ti) + n_; \
            e_k[ti][r] = KB[o_]; e_v[ti][r] = VB[o_]; e_r[ti][r] = RB[o_]; } } while (0)
    if (BID() < 64 * NCH) CH_PREFETCH(BID());
    for (int it = BID(); it < 64 * NCH; it += gridDim.x) {
        const int tid = TID(), lane = tid & 63, w = tid >> 6, n = lane & 15, c4 = lane >> 4, tr = w >> 1, tcb = 2 * (w & 1);
        const int sh = it / NCH, c = it % NCH, b = sh >> 4, h = sh & 15, R0 = b * 4096 + c * LCH, hc = h * 64;
        const bf16_t *KBb = KB + (size_t)R0 * D + hc, *VBb = VB + (size_t)R0 * D + hc, *RBb = RB + (size_t)R0 * D + hc;
        float* VFb = VF + (size_t)R0 * D + hc; bf16_t* VM2b = VM2 + (size_t)R0 * D + hc; bf16_t* GMb = GM + (size_t)R0 * D + hc; float* Y0b = Y0 + (size_t)R0 * D + hc;
        float* PCb = PCH + (size_t)it * 4096; float* CCb = CCH + (size_t)it * 4096; float* BONb = BON + (size_t)R0 * 16 + h;
        const bf16_t *TWb = TW + (size_t)R0 * 64, *TAb = TA_ + (size_t)R0 * 64, *TVb = TV + (size_t)R0 * 32, *W2b = W2T + (size_t)hc * 64, *A2b = A2T + (size_t)hc * 64, *V2b = V2T + (size_t)hc * 32;
        const float *w0b = p->rw_w0 + j * D + hc, *a0b = p->rw_a0 + j * D + hc, *kkb = p->rw_k_k + j * D + hc, *kab = p->rw_k_a + j * D + hc, *rkb = p->rw_r_k + j * D + hc, *v0b = p->rw_v0 + (j ? (j - 1) : 0) * D + hc;
        f32x4 wp[2], ap[2], vp[2];
#pragma unroll
        for (int ti = 0; ti < 2; ++ti) { wp[ti] = (f32x4){0.f, 0.f, 0.f, 0.f}; ap[ti] = wp[ti]; vp[ti] = wp[ti]; }
        {   const int ar = 16 * tr + n;
#pragma unroll
            for (int ks = 0; ks < 2; ++ks) {
                const bf16x8 aw = f_aw[ks], aa = f_aa[ks];
#pragma unroll
                for (int ti = 0; ti < 2; ++ti) { const int br = 16 * (tcb + ti) + n;
                    wp[ti] = __builtin_amdgcn_mfma_f32_16x16x32_bf16(aw, *(const bf16x8*)(W2b + br * 64 + 32 * ks + 8 * c4), wp[ti], 0, 0, 0);
                    ap[ti] = __builtin_amdgcn_mfma_f32_16x16x32_bf16(aa, *(const bf16x8*)(A2b + br * 64 + 32 * ks + 8 * c4), ap[ti], 0, 0, 0); }
            }
            if (j == 1) { const bf16x8 av = f_av;
#pragma unroll
                for (int ti = 0; ti < 2; ++ti) vp[ti] = __builtin_amdgcn_mfma_f32_16x16x32_bf16(av, *(const bf16x8*)(V2b + (16 * (tcb + ti) + n) * 32 + 8 * c4), vp[ti], 0, 0, 0); }
        }
        f32x4 lw[2], asg[2], kkv[2], kpr[2], vpr[2], rr[2];
        float ssq[4] = {0.f, 0.f, 0.f, 0.f}, bon[4] = {0.f, 0.f, 0.f, 0.f};
        float vf8[2][4];
#pragma unroll
        for (int ti = 0; ti < 2; ++ti)
#pragma unroll
            for (int r = 0; r < 4; ++r) vf8[ti][r] = 0.f;
        if (j == 1) {
#pragma unroll
            for (int ti = 0; ti < 2; ++ti)
#pragma unroll
                for (int r = 0; r < 4; ++r) vf8[ti][r] = VFb[(16 * tr + 4 * c4 + r) * D + 16 * (tcb + ti) + n];
        }
#pragma unroll
        for (int ti = 0; ti < 2; ++ti) {
            const int d = 16 * (tcb + ti) + n;
            const float w0 = w0b[d], a0 = a0b[d], kkw = kkb[d], kaw = kab[d], rkw = rkb[d];
            const float v0 = j ? v0b[d] : 0.f;
#pragma unroll
            for (int r = 0; r < 4; ++r) {
                const int o = (16 * tr + 4 * c4 + r) * D + d;
                const float kx = bf2f(e_k[ti][r]), vx = bf2f(e_v[ti][r]), rx = bf2f(e_r[ti][r]);
                const float z = -(w0 + wp[ti][r]), sp = fmaxf(z, 0.f) + __logf(1.0f + __expf(-fabsf(z)));
                lw[ti][r] = -__expf(-sp - 0.5f);
                const float a = fsig(a0 + ap[ti][r]);
                asg[ti][r] = a;
                float vv = vx;
                if (j == 0) VFb[o] = vx; else { const float vf = vf8[ti][r]; vv = vx + (vf - vx) * fsig(v0 + vp[ti][r]); }
                vpr[ti][r] = vv; rr[ti][r] = rx;
                const float kk = kx * kkw; kkv[ti][r] = kk; ssq[r] += kk * kk;
                const float kp = kx * (1.0f + (a - 1.0f) * kaw); kpr[ti][r] = kp; bon[r] += rx * kp * rkw;
                F32[(16 * tr + 4 * c4 + r) * 68 + d] = lw[ti][r];
                VM2b[o] = f2bf(vv);
            }
        }
#pragma unroll
        for (int r = 0; r < 4; ++r) { ssq[r] = g16_sum(ssq[r]); bon[r] = g16_sum(bon[r]); }
        if (n == 0) {
#pragma unroll
            for (int r = 0; r < 4; ++r) { const int t = 16 * tr + 4 * c4 + r; part[(t * 2 + (w & 1)) * 2 + 0] = ssq[r]; part[(t * 2 + (w & 1)) * 2 + 1] = bon[r]; }
        }
        if (it + (int)gridDim.x < 64 * NCH) CH_PREFETCH(it + (int)gridDim.x);
        CH_BAR();
        f32x4 cs[2];
#pragma unroll
        for (int ti = 0; ti < 2; ++ti) {
            f32x4 acc = {0.f, 0.f, 0.f, 0.f};
            for (int q = 0; q < 4 * (tr + 1); ++q) {
                const float av = (4 * q + c4 <= 16 * tr + n) ? 1.0f : 0.0f;
                acc = __builtin_amdgcn_mfma_f32_16x16x4f32(av, F32[(4 * q + c4) * 68 + 16 * (tcb + ti) + n], acc, 0, 0, 0);
            }
            cs[ti] = acc;
        }
        float inv[4];
#pragma unroll
        for (int r = 0; r < 4; ++r) { const int t = 16 * tr + 4 * c4 + r; inv[r] = rsqrtf(fmaxf(part[(t * 2 + 0) * 2] + part[(t * 2 + 1) * 2], 1e-24f));
            if (n == 0 && (w & 1) == 0) BONb[t * 16] = part[(t * 2 + 0) * 2 + 1] + part[(t * 2 + 1) * 2 + 1]; }
        f32x4 rt[2];
#pragma unroll
        for (int ti = 0; ti < 2; ++ti) {
            const int d = 16 * (tcb + ti) + n, t0 = 16 * tr + 4 * c4;
            f32x4 at, bt, kt;
#pragma unroll
            for (int r = 0; r < 4; ++r) {
                const float g = __expf(cs[ti][r]), gi = __expf(-cs[ti][r]), gm = __expf(cs[ti][r] - lw[ti][r]);
                const float kk = kkv[ti][r] * inv[r];
                at[r] = -kk * gm; bt[r] = kk * asg[ti][r] * gi; kt[r] = kpr[ti][r] * gi; rt[ti][r] = rr[ti][r] * g;
                CM(0)[(t0 + r) * CST + d] = f2bf(at[r]); CM(1)[(t0 + r) * CST + d] = f2bf(bt[r]); CM(2)[(t0 + r) * CST + d] = f2bf(kt[r]); CM(3)[(t0 + r) * CST + d] = f2bf(rt[ti][r]);
                if (t0 + r == 63) gLs[d] = g;
            }
            st_t4(CM(4), d, t0, at); st_t4(CM(5), d, t0, bt); st_t4(CM(6), d, t0, kt); st_t4(CM(7), d, t0, vpr[ti]);
        }
        CH_BAR();
#pragma unroll
        for (int ti = 0; ti < 2; ++ti) {
            const int tc = tcb + ti, s = 16 * tc + n, t0 = 16 * tr + 4 * c4;
            if (tc <= tr) {
                { f32x4 m = {0.f, 0.f, 0.f, 0.f}; m = cmm(CM(0), 16 * tr + n, CM(1), 16 * tc + n, c4, m);
#pragma unroll
                  for (int r = 0; r < 4; ++r) F32[(t0 + r) * 68 + s] = (s < t0 + r) ? m[r] : 0.f; }
                asm volatile("" ::: "memory");
                { f32x4 m = {0.f, 0.f, 0.f, 0.f}; m = cmm(CM(0), 16 * tr + n, CM(2), 16 * tc + n, c4, m);
#pragma unroll
                  for (int r = 0; r < 4; ++r) CM(8)[(t0 + r) * CST + s] = f2bf((s < t0 + r) ? m[r] : 0.f); }
                asm volatile("" ::: "memory");
                { f32x4 m = {0.f, 0.f, 0.f, 0.f}; m = cmm(CM(3), 16 * tr + n, CM(1), 16 * tc + n, c4, m);
#pragma unroll
                  for (int r = 0; r < 4; ++r) CM(9)[(t0 + r) * CST + s] = f2bf((s <= t0 + r) ? m[r] : 0.f); }
                asm volatile("" ::: "memory");
                { f32x4 m = {0.f, 0.f, 0.f, 0.f}; m = cmm(CM(3), 16 * tr + n, CM(2), 16 * tc + n, c4, m);
#pragma unroll
                  for (int r = 0; r < 4; ++r) CM(10)[(t0 + r) * CST + s] = f2bf((s <= t0 + r) ? m[r] : 0.f); }
                asm volatile("" ::: "memory");
            } else {
#pragma unroll
                for (int r = 0; r < 4; ++r) { F32[(t0 + r) * 68 + s] = 0.f; CM(8)[(t0 + r) * CST + s] = 0; CM(9)[(t0 + r) * CST + s] = 0; CM(10)[(t0 + r) * CST + s] = 0; }
            }
        }
        CH_BAR();
        { const int e0 = tid * 8;
#pragma unroll
          for (int e = 0; e < 8; ++e) { const int t = (e0 + e) >> 6, s_ = (e0 + e) & 63; CM(2)[t * CST + s_] = f2bf(F32[t * 68 + s_]); }
          unsigned z_ = 0u; asm volatile("" : "+v"(z_));
          *(LAS u32x4*)(CM(0) + (e0 >> 6) * CST + (e0 & 63)) = (u32x4){z_, z_, z_, z_}; }
        CH_BAR();
        if (w < 4) {
            const int cw = 16 * w;
            LAS float* scr = (LAS float*)CM(1) + w * (16 * 17);
#pragma unroll 1
            for (int I = 0; I < 4; ++I) {
                f32x4 rh = {0.f, 0.f, 0.f, 0.f};
                if (I > 0) { rh = __builtin_amdgcn_mfma_f32_16x16x32_bf16(cfrag(CM(2), 16 * I + n, 0, c4), cfrag(CM(0), cw + n, 0, c4), rh, 0, 0, 0);
                    if (I > 2) rh = __builtin_amdgcn_mfma_f32_16x16x32_bf16(cfrag(CM(2), 16 * I + n, 1, c4), cfrag(CM(0), cw + n, 1, c4), rh, 0, 0, 0); }
#pragma unroll
                for (int r = 0; r < 4; ++r) scr[(4 * c4 + r) * 17 + n] = rh[r] + ((16 * I + 4 * c4 + r) == (cw + n) ? 1.f : 0.f);
                wave_lds_fence();
                float x[16];
#pragma unroll
                for (int i = 0; i < 16; ++i) x[i] = scr[i * 17 + n];
                f32x4 mc[4], mn[4];
                mc[0] = *(const LAS f32x4*)(F32 + (16 * I + 1) * 68 + 16 * I);
#pragma unroll
                for (int i = 1; i < 16; ++i) {
                    if (i + 1 < 16) {
#pragma unroll
                        for (int j4 = 0; j4 < (i + 4) / 4; ++j4) mn[j4] = *(const LAS f32x4*)(F32 + (16 * I + i + 1) * 68 + 16 * I + 4 * j4);
                    }
                    float a0 = 0.f, a1 = 0.f;
#pragma unroll
                    for (int j4 = 0; j4 < (i + 3) / 4; ++j4) {
                        if (4 * j4 + 0 < i) a0 += mc[j4][0] * x[4 * j4 + 0];
                        if (4 * j4 + 1 < i) a1 += mc[j4][1] * x[4 * j4 + 1];
                        if (4 * j4 + 2 < i) a0 += mc[j4][2] * x[4 * j4 + 2];
                        if (4 * j4 + 3 < i) a1 += mc[j4][3] * x[4 * j4 + 3];
                    }
                    x[i] += a0 + a1;
#pragma unroll
                    for (int j4 = 0; j4 < 4; ++j4) mc[j4] = mn[j4];
                    asm volatile("" ::: "memory");
                }
                if (c4 == 0) {
#pragma unroll
                    for (int i = 0; i < 16; ++i) CM(3)[(16 * I + i) * CST + cw + n] = f2bf(x[i]);
                    u32x4 t0, t1;
                    t0.x = pk_bf16(x[0], x[1]); t0.y = pk_bf16(x[2], x[3]); t0.z = pk_bf16(x[4], x[5]); t0.w = pk_bf16(x[6], x[7]);
                    t1.x = pk_bf16(x[8], x[9]); t1.y = pk_bf16(x[10], x[11]); t1.z = pk_bf16(x[12], x[13]); t1.w = pk_bf16(x[14], x[15]);
                    *(LAS u32x4*)(CM(0) + (cw + n) * CST + 16 * I) = t0; *(LAS u32x4*)(CM(0) + (cw + n) * CST + 16 * I + 8) = t1;
                }
                wave_lds_fence();
            }
        }
        CH_BAR();
#pragma unroll
        for (int ti = 0; ti < 2; ++ti) {
            const int d = 16 * (tcb + ti) + n;
            { f32x4 x1 = {0.f, 0.f, 0.f, 0.f}; x1 = cmm(CM(8), 16 * tr + n, CM(7), 16 * (tcb + ti) + n, c4, x1); st_t4(CM(0), d, 16 * tr + 4 * c4, x1); }
            asm volatile("" ::: "memory");
            { f32x4 ta = {0.f, 0.f, 0.f, 0.f}; ta = cmm(CM(3), 16 * tr + n, CM(4), 16 * (tcb + ti) + n, c4, ta); st_t4(CM(1), d, 16 * tr + 4 * c4, ta); }
            asm volatile("" ::: "memory");
        }
        CH_BAR();
#pragma unroll
        for (int ti = 0; ti < 2; ++ti) {
            f32x4 uv = {0.f, 0.f, 0.f, 0.f};
            uv = cmm(CM(3), 16 * tr + n, CM(0), 16 * (tcb + ti) + n, c4, uv);
            st_t4(CM(2), 16 * (tcb + ti) + n, 16 * tr + 4 * c4, uv);
        }
        CH_BAR();
#pragma unroll
        for (int ti = 0; ti < 2; ++ti) {
            const int cc = 16 * (tcb + ti) + n, r0 = 16 * tr + 4 * c4;
            const float gl = gLs[cc];
            { f32x4 pm = {0.f, 0.f, 0.f, 0.f}; pm = cmm(CM(1), 16 * tr + n, CM(5), cc, c4, pm);
#pragma unroll
              for (int r = 0; r < 4; ++r) PCb[(r0 + r) * 64 + cc] = (pm[r] + ((r0 + r) == cc ? 1.f : 0.f)) * gl; }
            asm volatile("" ::: "memory");
            { f32x4 cm_ = {0.f, 0.f, 0.f, 0.f}; cm_ = cmm(CM(2), 16 * tr + n, CM(5), cc, c4, cm_); cm_ = cmm(CM(7), 16 * tr + n, CM(6), cc, c4, cm_);
#pragma unroll
              for (int r = 0; r < 4; ++r) CCb[(r0 + r) * 64 + cc] = cm_[r] * gl; }
            asm volatile("" ::: "memory");
            { f32x4 gg = {0.f, 0.f, 0.f, 0.f}; gg = cmm(CM(9), 16 * tr + n, CM(1), cc, c4, gg);
#pragma unroll
              for (int r = 0; r < 4; ++r) GMb[(r0 + r) * D + cc] = f2bf(gg[r] + rt[ti][r]); }
            asm volatile("" ::: "memory");
            { f32x4 y0 = {0.f, 0.f, 0.f, 0.f}; y0 = cmm(CM(9), 16 * tr + n, CM(2), cc, c4, y0); y0 = cmm(CM(10), 16 * tr + n, CM(7), cc, c4, y0);
#pragma unroll
              for (int r = 0; r < 4; ++r) Y0b[(r0 + r) * D + cc] = y0[r]; }
            asm volatile("" ::: "memory");
        }
        CH_BAR();
    }
#undef CM
#undef CH_PREFETCH
#undef CH_BAR
}

__device__ __forceinline__ void phase_sample_mixer_w(KP p, int j, int first, int stride) {
    const int tid = TID(), lane = tid & 63;
    {
        const bf16_t *RB = WSP(bf16_t, WS_RB), *KB = WSP(bf16_t, WS_KB), *VB = WSP(bf16_t, WS_VB); bf16_t* YG = WSP(bf16_t, WS_YG);
        const float *WPp = WSP(float, WS_WP), *APp = WSP(float, WS_AP), *VPp = WSP(float, WS_VP), *GG = WSP(float, WS_GG); float* VF = WSP(float, WS_VFIRST);
        for (int it = first; it < 512; it += stride) {
            const int b = it >> 4, h = it & 15, col = h * 64 + lane;
            const float* s0 = p->state_wkv + (((size_t)j * 32 + b) * 16 + h) * 4096 + lane * 64;
            float S[64];
#pragma unroll
            for (int k = 0; k < 64; k += 4) { const f32x4 t = *(const f32x4*)(s0 + k); S[k] = t[0]; S[k + 1] = t[1]; S[k + 2] = t[2]; S[k + 3] = t[3]; }
            const float w0 = p->rw_w0[j * D + col], a0 = p->rw_a0[j * D + col], kkw = p->rw_k_k[j * D + col], kaw = p->rw_k_a[j * D + col], rkw = p->rw_r_k[j * D + col];
            const float v0 = j ? p->rw_v0[(j - 1) * D + col] : 0.f, lnw = p->rw_lnx_w[j * D + col], lnb = p->rw_lnx_b[j * D + col];
            for (int t = 0; t < 8; ++t) {
                const size_t o = (size_t)(NP + b * 8 + t) * D + col;
                const float kx = bf2f(KB[o]), vx = bf2f(VB[o]), r = bf2f(RB[o]);
                const float z = -(w0 + WPp[o]), sp = fmaxf(z, 0.f) + log1pf(expf(-fabsf(z)));
                const float wd = expf(-expf(-sp - 0.5f)), asg = sigmoidf_(a0 + APp[o]);
                float v = vx;
                if (j == 0) VF[o] = vx; else { const float vf = VF[o]; v = vx + (vf - vx) * sigmoidf_(v0 + VPp[o]); }
                float kk = kx * kkw; const float ss = wave_sum(kk * kk); kk *= rsqrtf(fmaxf(ss, 1e-24f));
                const float kp = kx * (1.0f + (asg - 1.0f) * kaw), a = -kk, bq = kk * asg;
                float sa = 0.f;
#pragma unroll
                for (int k = 0; k < 64; ++k) sa += S[k] * rl(a, k);
#pragma unroll
                for (int k = 0; k < 64; ++k) S[k] = S[k] * rl(wd, k) + sa * rl(bq, k) + v * rl(kp, k);
                float y = 0.f;
#pragma unroll
                for (int k = 0; k < 64; ++k) y += S[k] * rl(r, k);
                const float mu = wave_sum(y) * (1.0f / 64.0f), dy = y - mu, var = wave_sum(dy * dy) * (1.0f / 64.0f);
                const float bonus = wave_sum(r * kp * rkw);
                YG[o] = f2bf((dy * rsqrtf(var + 64e-5f) * lnw + lnb + bonus * v) * GG[o]);
            }
            float* so = p->out + O_WKVS + (((size_t)j * 32 + b) * 16 + h) * 4096 + lane * 64;
#pragma unroll
            for (int k = 0; k < 64; k += 4) *(f32x4*)(so + k) = (f32x4){S[k], S[k + 1], S[k + 2], S[k + 3]};
        }
    }
}
__device__ __forceinline__ void phase_carry(KP p, int j, LAS unsigned char* lds) {
    const float *PCH = WSP(float, WS_PCH), *CCH = WSP(float, WS_CCH); float* SST = WSP(float, WS_SST);
    LAS float* Sl = (LAS float*)lds;
    LAS unsigned* cflag = (LAS unsigned*)(lds + 9216);
    if (TID() == 0) *cflag = 0u;
    __syncthreads();
    unsigned arrivals = 0u;
    if ((TID() >> 6) >= 4) { phase_sample_mixer_w(p, j, BID() * 4 + ((TID() >> 6) - 4), (int)gridDim.x * 4); }
    else
    for (int it = BID(); it < 256; it += gridDim.x) {
        const int wave = TID() >> 6, sh = it >> 2, row0 = 16 * (it & 3), col0 = 16 * (wave & 3), b = sh >> 4, h = sh & 15;
        const bool act = true;
        f32x4 acc = {0.f, 0.f, 0.f, 0.f}, c0, c1, c2;
        float b0[16], b1[16], b2[16];
#define CARRY_LOAD(BX, CX, cc_) do { const int l_ = TID() & 63, ln = l_ & 15, lq = l_ >> 4; \
            const float* Pc = PCH + ((size_t)sh * NCH + (cc_)) * 4096; const float* Cc = CCH + ((size_t)sh * NCH + (cc_)) * 4096; \
            _Pragma("unroll") for (int q = 0; q < 16; ++q) BX[q] = Pc[(4 * q + lq) * 64 + col0 + ln]; \
            _Pragma("unroll") for (int r = 0; r < 4; ++r) CX[r] = Cc[(row0 + 4 * lq + r) * 64 + col0 + ln]; } while (0)
#define CARRY_STEP(BX, CX, BL, CL, c_) do { const int l_ = TID() & 63, ln = l_ & 15, lq = l_ >> 4; \
            LAS float* Sw = Sl + ((c_) & 1) * (16 * 68); float* go = SST + ((size_t)sh * NCH + (c_)) * 4096; \
            if (act) { _Pragma("unroll") for (int r = 0; r < 4; ++r) Sw[(4 * lq + r) * 68 + col0 + ln] = acc[r]; } \
            const f32x4 sc = acc; acc = CX; \
            asm volatile("s_waitcnt lgkmcnt(0)" ::: "memory"); arrivals += 4u; \
            if ((TID() & 63) == 0) __hip_atomic_fetch_add(cflag, 1u, __ATOMIC_RELAXED, __HIP_MEMORY_SCOPE_WORKGROUP); \
            { unsigned sp_ = 0; while (__builtin_amdgcn_readfirstlane(__hip_atomic_load(cflag, __ATOMIC_RELAXED, __HIP_MEMORY_SCOPE_WORKGROUP)) < arrivals && ++sp_ < (1u << 22)) __builtin_amdgcn_s_sleep(0); } \
            asm volatile("" ::: "memory"); \
            if (act) { \
                _Pragma("unroll") for (int r = 0; r < 4; ++r) go[(row0 + 4 * lq + r) * 64 + col0 + ln] = sc[r]; \
                if ((c_) + 2 < NCH) CARRY_LOAD(BL, CL, (c_) + 2); \
                float av[16]; _Pragma("unroll") for (int q = 0; q < 16; ++q) av[q] = Sw[ln * 68 + 4 * q + lq]; \
                asm volatile("s_waitcnt lgkmcnt(0)" ::: "memory"); \
                _Pragma("unroll") for (int q = 0; q < 16; ++q) acc = __builtin_amdgcn_mfma_f32_16x16x4f32(av[q], BX[q], acc, 0, 0, 0); } } while (0)
        if (act) { CARRY_LOAD(b0, c0, 0); CARRY_LOAD(b1, c1, 1); }
        for (int c = 0; c < NCH; c += 3) {
            CARRY_STEP(b0, c0, b2, c2, c);
            if (c + 1 < NCH) CARRY_STEP(b1, c1, b0, c0, c + 1);
            if (c + 2 < NCH) CARRY_STEP(b2, c2, b1, c1, c + 2);
        }
        if (act) { const int l_ = TID() & 63, ln = l_ & 15, lq = l_ >> 4; float* go = p->out + O_WKVP + (((size_t)j * 4 + b) * 16 + h) * 4096;
#pragma unroll
            for (int r = 0; r < 4; ++r) go[(row0 + 4 * lq + r) * 64 + col0 + ln] = acc[r]; }
#undef CARRY_LOAD
#undef CARRY_STEP
    }
    __syncthreads();
}
__device__ __forceinline__ void phase_sample_mixer(KP p, int j) {
    const int tid = TID(), lane = tid & 63, wave = tid >> 6;
    {
        const bf16_t *RB = WSP(bf16_t, WS_RB), *KB = WSP(bf16_t, WS_KB), *VB = WSP(bf16_t, WS_VB); bf16_t* YG = WSP(bf16_t, WS_YG);
        const float *WPp = WSP(float, WS_WP), *APp = WSP(float, WS_AP), *VPp = WSP(float, WS_VP), *GG = WSP(float, WS_GG); float* VF = WSP(float, WS_VFIRST);
        for (int it = BID() * 8 + wave; it < 512; it += gridDim.x * 8) {
            const int b = it >> 4, h = it & 15, col = h * 64 + lane;
            const float* s0 = p->state_wkv + (((size_t)j * 32 + b) * 16 + h) * 4096 + lane * 64;
            float S[64];
#pragma unroll
            for (int k = 0; k < 64; k += 4) { const f32x4 t = *(const f32x4*)(s0 + k); S[k] = t[0]; S[k + 1] = t[1]; S[k + 2] = t[2]; S[k + 3] = t[3]; }
            const float w0 = p->rw_w0[j * D + col], a0 = p->rw_a0[j * D + col], kkw = p->rw_k_k[j * D + col], kaw = p->rw_k_a[j * D + col], rkw = p->rw_r_k[j * D + col];
            const float v0 = j ? p->rw_v0[(j - 1) * D + col] : 0.f, lnw = p->rw_lnx_w[j * D + col], lnb = p->rw_lnx_b[j * D + col];
            for (int t = 0; t < 8; ++t) {
                const size_t o = (size_t)(NP + b * 8 + t) * D + col;
                const float kx = bf2f(KB[o]), vx = bf2f(VB[o]), r = bf2f(RB[o]);
                const float z = -(w0 + WPp[o]), sp = fmaxf(z, 0.f) + log1pf(expf(-fabsf(z)));
                const float wd = expf(-expf(-sp - 0.5f)), asg = sigmoidf_(a0 + APp[o]);
                float v = vx;
                if (j == 0) VF[o] = vx; else { const float vf = VF[o]; v = vx + (vf - vx) * sigmoidf_(v0 + VPp[o]); }
                float kk = kx * kkw; const float ss = wave_sum(kk * kk); kk *= rsqrtf(fmaxf(ss, 1e-24f));
                const float kp = kx * (1.0f + (asg - 1.0f) * kaw), a = -kk, bq = kk * asg;
                float sa = 0.f;
#pragma unroll
                for (int k = 0; k < 64; ++k) sa += S[k] * rl(a, k);
#pragma unroll
                for (int k = 0; k < 64; ++k) S[k] = S[k] * rl(wd, k) + sa * rl(bq, k) + v * rl(kp, k);
                float y = 0.f;
#pragma unroll
                for (int k = 0; k < 64; ++k) y += S[k] * rl(r, k);
                const float mu = wave_sum(y) * (1.0f / 64.0f), dy = y - mu, var = wave_sum(dy * dy) * (1.0f / 64.0f);
                const float bonus = wave_sum(r * kp * rkw);
                YG[o] = f2bf((dy * rsqrtf(var + 64e-5f) * lnw + lnb + bonus * v) * GG[o]);
            }
            float* so = p->out + O_WKVS + (((size_t)j * 32 + b) * 16 + h) * 4096 + lane * 64;
#pragma unroll
            for (int k = 0; k < 64; k += 4) *(f32x4*)(so + k) = (f32x4){S[k], S[k + 1], S[k + 2], S[k + 3]};
        }
    }
}
__device__ __forceinline__ void phase_post2(KP p, int j, LAS unsigned char* lds) {
    LAS float* part = (LAS float*)lds;
    const bf16_t *GM = WSP(bf16_t, WS_DEC), *VM2 = WSP(bf16_t, WS_KM), *TG = WSP(bf16_t, WS_TG), *G2T = WSP(bf16_t, WS_G2T) + (size_t)j * D * 160;
    const float *Y0 = WSP(float, WS_Y), *BON = WSP(float, WS_AV), *SST = WSP(float, WS_SST); bf16_t* YG = WSP(bf16_t, WS_YG);
    for (int it = BID(); it < 64 * NCH; it += gridDim.x) {
        const int tid = TID(), lane = tid & 63, w = tid >> 6, n = lane & 15, c4 = lane >> 4, tr = w >> 1, tcb = 2 * (w & 1);
        const int sh = it / NCH, c = it % NCH, b = sh >> 4, h = sh & 15, R0 = b * 4096 + c * LCH, hc = h * 64;
        f32x4 y[2], g[2];
        const size_t ar = (size_t)(R0 + 16 * tr + n);
#pragma unroll
        for (int ti = 0; ti < 2; ++ti) {
            const int dv = 16 * (tcb + ti) + n;
            f32x4 acc = {0.f, 0.f, 0.f, 0.f}, gacc = acc;
#pragma unroll
            for (int ks = 0; ks < 2; ++ks) {
                const bf16x8 af = *(const bf16x8*)(GM + ar * D + hc + 32 * ks + 8 * c4);
                const float* sp = SST + ((size_t)it * 64 + dv) * 64 + 32 * ks + 8 * c4; const f32x4 s0 = *(const f32x4*)sp, s1 = *(const f32x4*)(sp + 4);
                const u32x4 bw = {pk_bf16(s0[0], s0[1]), pk_bf16(s0[2], s0[3]), pk_bf16(s1[0], s1[1]), pk_bf16(s1[2], s1[3])};
                acc = __builtin_amdgcn_mfma_f32_16x16x32_bf16(af, __builtin_bit_cast(bf16x8, bw), acc, 0, 0, 0);
            }
#pragma unroll
            for (int ks = 0; ks < 5; ++ks)
                gacc = __builtin_amdgcn_mfma_f32_16x16x32_bf16(*(const bf16x8*)(TG + ar * 160 + 32 * ks + 8 * c4), *(const bf16x8*)(G2T + (size_t)(hc + dv) * 160 + 32 * ks + 8 * c4), gacc, 0, 0, 0);
#pragma unroll
            for (int r = 0; r < 4; ++r) acc[r] += Y0[(size_t)(R0 + 16 * tr + 4 * c4 + r) * D + hc + dv];
            y[ti] = acc; g[ti] = gacc;
        }
        float bonus4[4]; unsigned short vm4[2][4]; float lnw2[2], lnb2[2];
#pragma unroll
        for (int r = 0; r < 4; ++r) bonus4[r] = BON[(size_t)(R0 + 16 * tr + 4 * c4 + r) * 16 + h];
#pragma unroll
        for (int ti = 0; ti < 2; ++ti) { const int col = hc + 16 * (tcb + ti) + n; lnw2[ti] = p->rw_lnx_w[j * D + col]; lnb2[ti] = p->rw_lnx_b[j * D + col];
#pragma unroll
            for (int r = 0; r < 4; ++r) vm4[ti][r] = VM2[(size_t)(R0 + 16 * tr + 4 * c4 + r) * D + col]; }
        float s1[4], s2[4];
#pragma unroll
        for (int r = 0; r < 4; ++r) { s1[r] = g16_sum(y[0][r] + y[1][r]); s2[r] = g16_sum(y[0][r] * y[0][r] + y[1][r] * y[1][r]); }
        asm volatile("s_waitcnt lgkmcnt(0)" ::: "memory"); __builtin_amdgcn_s_barrier(); asm volatile("" ::: "memory");
        if (n == 0) {
#pragma unroll
            for (int r = 0; r < 4; ++r) { const int t = 16 * tr + 4 * c4 + r; part[(t * 2 + (w & 1)) * 2 + 0] = s1[r]; part[(t * 2 + (w & 1)) * 2 + 1] = s2[r]; }
        }
        asm volatile("s_waitcnt lgkmcnt(0)" ::: "memory"); __builtin_amdgcn_s_barrier(); asm volatile("" ::: "memory");
#pragma unroll
        for (int r = 0; r < 4; ++r) {
            const int t = 16 * tr + 4 * c4 + r;
            const float mu = (part[(t * 2 + 0) * 2] + part[(t * 2 + 1) * 2]) * (1.0f / 64.0f), ex2 = (part[(t * 2 + 0) * 2 + 1] + part[(t * 2 + 1) * 2 + 1]) * (1.0f / 64.0f);
            const float rs = rsqrtf(fmaxf(ex2 - mu * mu, 0.f) + 64e-5f), bonus = bonus4[r];
#pragma unroll
            for (int ti = 0; ti < 2; ++ti) {
                const int col = hc + 16 * (tcb + ti) + n; const size_t o = (size_t)(R0 + t) * D + col;
                YG[o] = f2bf(((y[ti][r] - mu) * rs * lnw2[ti] + lnb2[ti] + bonus * bf2f(vm4[ti][r])) * g[ti][r]);
            }
        }
    }
    __syncthreads();
}

__device__ __forceinline__ void phase_post(KP p, int j) {
    const float *Y = WSP(float, WS_Y), *KM = WSP(float, WS_KM), *VM = WSP(float, WS_VM), *GG = WSP(float, WS_GG);
    const bf16_t* RB = WSP(bf16_t, WS_RB); bf16_t* YG = WSP(bf16_t, WS_YG);
    const int lane = TID() & 63, gw = BID() * 8 + (TID() >> 6), nw = gridDim.x * 8;
    for (int row = gw; row < NT; row += nw) {
#pragma unroll
        for (int i = 0; i < 4; ++i) {
            const int col = 256 * i + 4 * lane; const size_t o = (size_t)row * D + col;
            const f32x4 y = *(const f32x4*)(Y + o), r = ld_bf4(RB + o), km = *(const f32x4*)(KM + o), vm = *(const f32x4*)(VM + o), gg = *(const f32x4*)(GG + o);
            const f32x4 lw = *(const f32x4*)(p->rw_lnx_w + j * D + col), lb = *(const f32x4*)(p->rw_lnx_b + j * D + col), rk = *(const f32x4*)(p->rw_r_k + j * D + col);
            const float mu = g16_sum(y[0] + y[1] + y[2] + y[3]) * (1.0f / 64.0f);
            const f32x4 d = y - mu;
            const float var = g16_sum(d[0] * d[0] + d[1] * d[1] + d[2] * d[2] + d[3] * d[3]) * (1.0f / 64.0f);
            const float rs = rsqrtf(var + 64e-5f);
            const float bon = g16_sum(r[0] * km[0] * rk[0] + r[1] * km[1] * rk[1] + r[2] * km[2] * rk[2] + r[3] * km[3] * rk[3]);
            st_bf4(YG + o, (d * rs * lw + lb + bon * vm) * gg);
        }
    }
}

__constant__ double kRopeInv[8] = {1.0, 0.19392274474868576, 0.03760603093086393, 0.007292664737217109, 0.001414213562373095, 0.0002742481756762073, 5.318295896944988e-05, 1.031338537721246e-05};
__device__ __forceinline__ void phase_dsapost(KP p, int j) {
    const float* PR = WSP(float, WS_PR); float *Q = WSP(float, WS_Q), *QI = WSP(float, WS_QI), *WI = WSP(float, WS_WI);
    const int lane = TID() & 63, l16 = lane & 15, gw = BID() * 8 + (TID() >> 6), nw = gridDim.x * 8;
    const f32x4 qn = *(const f32x4*)(p->att_q_norm + j * 64 + 4 * l16), kn = *(const f32x4*)(p->att_k_norm + j * 64 + 4 * l16), in = *(const f32x4*)(p->idx_k_norm + j * 64 + 4 * l16);
    for (int row = gw; row < NT; row += nw) {
        const int pos = row_pos(row);
        const float* pr = PR + (size_t)row * PINP;
        f32x4 cs = {1.f, 1.f, 1.f, 1.f}, sn = {0.f, 0.f, 0.f, 0.f};
        if (l16 < 4) {
#pragma unroll
            for (int e = 0; e < 4; ++e) { double ang = (double)pos * kRopeInv[4 * (l16 & 1) + e]; ang -= floor(ang * 0.15915494309189535) * 6.283185307179586; const float af = (float)ang; cs[e] = cosf(af); sn[e] = sinf(af); }
        }
        const float sgn = (l16 < 2) ? -1.0f : 1.0f;
#define ROPE4(v) do { f32x4 _o; _o[0] = __shfl_xor((v)[0], 2); _o[1] = __shfl_xor((v)[1], 2); _o[2] = __shfl_xor((v)[2], 2); _o[3] = __shfl_xor((v)[3], 2); if (l16 < 4) (v) = (v) * cs + sgn * (_o * sn); } while (0)
#define HNORM4(v, w) do { const float _ss = g16_sum((v)[0] * (v)[0] + (v)[1] * (v)[1] + (v)[2] * (v)[2] + (v)[3] * (v)[3]); (v) = (v) * rsqrtf(_ss * (1.0f / 64.0f) + 1e-6f) * (w); } while (0)
#pragma unroll
        for (int i = 0; i < 4; ++i) { f32x4 v = *(const f32x4*)(pr + 256 * i + 4 * lane); HNORM4(v, qn); ROPE4(v); *(f32x4*)(Q + (size_t)row * D + 256 * i + 4 * lane) = v; }
        { f32x4 v = *(const f32x4*)(pr + 1024 + 4 * lane); HNORM4(v, kn); ROPE4(v);
          float* ko = row < NP ? p->out + O_KP + ((size_t)j * NP + row) * 256 : p->out + O_KS + ((size_t)j * NS + (row - NP)) * 256; *(f32x4*)(ko + 4 * lane) = v; st_bf4(WSP(bf16_t, WS_KBF) + (size_t)row * 256 + 4 * lane, v); *(unsigned*)(WSP(unsigned char, WS_K8) + (size_t)row * 256 + 4 * lane) = pk_fp8x4(v); }
        { const f32x4 v = *(const f32x4*)(pr + 1280 + 4 * lane);
          float* vo = row < NP ? p->out + O_VP + ((size_t)j * NP + row) * 256 : p->out + O_VS + ((size_t)j * NS + (row - NP)) * 256; *(f32x4*)(vo + 4 * lane) = v; st_bf4(WSP(bf16_t, WS_VBF) + (size_t)row * 256 + 4 * lane, v); *(unsigned*)(WSP(unsigned char, WS_V8) + (size_t)row * 256 + 4 * lane) = pk_fp8x4(v); }
#pragma unroll
        for (int i = 0; i < 2; ++i) { f32x4 v = *(const f32x4*)(pr + 1536 + 256 * i + 4 * lane); ROPE4(v); st_bf4(WSP(bf16_t, WS_QIB) + (size_t)row * 512 + 256 * i + 4 * lane, v); }
        { f32x4 v = *(const f32x4*)(pr + 2048 + 4 * l16); HNORM4(v, in); ROPE4(v);
          float* io = row < NP ? p->out + O_IKP + ((size_t)j * NP + row) * 64 : p->out + O_IKS + ((size_t)j * NS + (row - NP)) * 64; if (lane < 16) { *(f32x4*)(io + 4 * lane) = v; st_bf4(WSP(bf16_t, WS_KIB) + (size_t)row * 64 + 4 * lane, v); } }
        if (lane < 2) { const f32x4 v = *(const f32x4*)(pr + 2112 + 4 * lane); *(f32x4*)(WI + (size_t)row * 8 + 4 * lane) = v * 0.35355339059327373f; }
#undef ROPE4
#undef HNORM4
    }
}

template <bool SAMPLE>
__device__ __forceinline__ void phase_idx(KP p, int j, LAS unsigned char* lds) {
    LAS float* Qs = (LAS float*)lds;
    LAS float* Ks = (LAS float*)(lds + 32768);
    const float *QI = WSP(float, WS_QI), *WI = WSP(float, WS_WI);
    const int tid = TID(), q = tid >> 5, kx = tid & 31;
    const int nitems = SAMPLE ? 32 * 65 : 1024;
    for (int it = BID(); it < nitems; it += gridDim.x) {
        int b, t0, rowbase, nkt, kt0 = 0;
        if (SAMPLE) { b = it / 65; kt0 = it % 65; t0 = 0; rowbase = NP + b * 8; nkt = kt0 + 1; }
        else { const int k4 = it >> 8, w = it & 255, i = (k4 & 1) ? (k4 * 256 + 255 - w) : (k4 * 256 + w); b = i & 3; t0 = (i >> 2) * 16; rowbase = b * 4096 + t0; nkt = (t0 + 15) / 128 + 1; }
        const int nq = SAMPLE ? 8 : 16;
        __syncthreads();
#pragma unroll
        for (int n = 0; n < 16; ++n) { const int e = tid + 512 * n, qq = e >> 9, c = e & 511, h = c >> 6, d = c & 63;
            Qs[(d * 16 + qq) * 8 + h] = qq < nq ? QI[(size_t)(rowbase + qq) * 512 + c] : 0.f; }
        float wi[8];
#pragma unroll
        for (int h = 0; h < 8; ++h) wi[h] = q < nq ? WI[(size_t)(rowbase + q) * 8 + h] : 0.f;
        for (int kt = kt0; kt < nkt; ++kt) {
            __syncthreads();
#pragma unroll
            for (int n = 0; n < 16; ++n) { const int e = tid + 512 * n, key = e >> 6, d = e & 63, s = kt * 128 + key; float v = 0.f;
                if (SAMPLE) {
                    if (s < PAST) { const int pg = p->page_table[b * 64 + (s >> 7)]; v = p->cache_ik[(((size_t)j * 2560 + pg) * 128 + (s & 127)) * 64 + d]; }
                    else if (s < PAST + 8) v = p->out[O_IKS + ((size_t)j * NS + b * 8 + (s - PAST)) * 64 + d];
                } else v = p->out[O_IKP + ((size_t)j * NP + b * 4096 + s) * 64 + d];
                Ks[d * 132 + key] = v; }
            __syncthreads();
            f32x4 acc[8];
#pragma unroll
            for (int h = 0; h < 8; ++h) acc[h] = (f32x4){0.f, 0.f, 0.f, 0.f};
#pragma unroll 4
            for (int d = 0; d < 64; ++d) {
                const f32x4 qa = *(const LAS f32x4*)(Qs + (d * 16 + q) * 8), qb = *(const LAS f32x4*)(Qs + (d * 16 + q) * 8 + 4), kv = *(const LAS f32x4*)(Ks + d * 132 + 4 * kx);
                acc[0] += qa[0] * kv; acc[1] += qa[1] * kv; acc[2] += qa[2] * kv; acc[3] += qa[3] * kv;
                acc[4] += qb[0] * kv; acc[5] += qb[1] * kv; acc[6] += qb[2] * kv; acc[7] += qb[3] * kv;
            }
            f32x4 sc = {0.f, 0.f, 0.f, 0.f};
#pragma unroll
            for (int h = 0; h < 8; ++h)
#pragma unroll
                for (int e = 0; e < 4; ++e) sc[e] += fmaxf(acc[h][e] * 0.125f, 0.f) * wi[h];
            if (q < nq) {
                if (SAMPLE) *(f32x4*)(WSP(float, WS_SCS) + (size_t)(b * 8 + q) * SCS_LD + kt * 128 + 4 * kx) = sc;
                else *(f32x4*)(WSP(float, WS_SC) + ((size_t)b * 4096 + t0 + q) * 4096 + kt * 128 + 4 * kx) = sc;
            }
        }
    }
    __syncthreads();
}

template <bool SAMPLE>
__device__ __forceinline__ void phase_idx2(KP p, int j) {
    const bf16_t *QIB = WSP(bf16_t, WS_QIB), *KIB = WSP(bf16_t, WS_KIB); const float* WI = WSP(float, WS_WI);
    const int lane = TID() & 63, lr = lane & 31, lh = lane >> 5, gw = BID() * 8 + (TID() >> 6), nw = gridDim.x * 8;
    const int nitems = SAMPLE ? 32 * 17 : 4096;
    for (int it = gw; it < nitems; it += nw) {
        int b, rowbase, tile0, ntile;
        if (SAMPLE) { b = it / 17; rowbase = NP + b * 8; tile0 = (it % 17) * 16; ntile = min(16, 257 - tile0); }
        else { const int sub = it >= 2048, w_ = it & 2047; b = w_ & 3; const int wb = w_ >> 2, kk = sub ? 511 - wb : wb, nt = (kk * 8 + 7) / 32 + 1;
            rowbase = b * 4096 + kk * 8; tile0 = sub ? (nt >> 1) : 0; ntile = sub ? nt - (nt >> 1) : (nt >> 1); }
        if (ntile <= 0) continue;
        bf16x8 af[2][4]; float w[2][2][8];
        { const int hd = (lr & 3) + 4 * ((lr >> 3) & 1), jq = 2 * ((lr >> 2) & 1) + (lr >> 4);
#pragma unroll
          for (int st = 0; st < 2; ++st)
#pragma unroll
              for (int ks = 0; ks < 4; ++ks) af[st][ks] = *(const bf16x8*)(QIB + (size_t)(rowbase + 4 * st + jq) * 512 + hd * 64 + 16 * ks + 8 * lh);
#pragma unroll
          for (int st = 0; st < 2; ++st)
#pragma unroll
              for (int q = 0; q < 2; ++q) { const f32x4 w0 = *(const f32x4*)(WI + (size_t)(rowbase + 4 * st + 2 * lh + q) * 8), w1 = *(const f32x4*)(WI + (size_t)(rowbase + 4 * st + 2 * lh + q) * 8 + 4);
#pragma unroll
                  for (int e = 0; e < 4; ++e) { w[st][q][e] = w0[e] * 0.125f; w[st][q][4 + e] = w1[e] * 0.125f; } } }
#define IDX_LOADB(BF, tl_) do { const int s_ = (tile0 + (tl_)) * 32 + lr; \
            if (!SAMPLE) { _Pragma("unroll") for (int ks = 0; ks < 4; ++ks) BF[ks] = *(const bf16x8*)(KIB + ((size_t)b * 4096 + s_) * 64 + 16 * ks + 8 * lh); } \
            else { const float* kp = p->out + O_IKS + ((size_t)j * NS + b * 8) * 64; \
                if (s_ < PAST) kp = p->cache_ik + (((size_t)j * 2560 + p->page_table[b * 64 + (s_ >> 7)]) * 128 + (s_ & 127)) * 64; else kp += (size_t)min(s_ - PAST, 7) * 64; \
                _Pragma("unroll") for (int ks = 0; ks < 4; ++ks) { const f32x4 x0 = *(const f32x4*)(kp + 16 * ks + 8 * lh), x1 = *(const f32x4*)(kp + 16 * ks + 8 * lh + 4); \
                    const u32x4 wv = {pk_bf16(x0[0], x0[1]), pk_bf16(x0[2], x0[3]), pk_bf16(x1[0], x1[1]), pk_bf16(x1[2], x1[3])}; BF[ks] = __builtin_bit_cast(bf16x8, wv); } } } while (0)
        bf16x8 bnx[4];
        IDX_LOADB(bnx, 0);
        for (int tl = 0; tl < ntile; ++tl) {
            const int s = (tile0 + tl) * 32 + lr;
            bf16x8 bfr[4];
#pragma unroll
            for (int ks = 0; ks < 4; ++ks) bfr[ks] = bnx[ks];
            if (tl + 1 < ntile) IDX_LOADB(bnx, tl + 1);
            __builtin_amdgcn_sched_barrier(0);
#pragma unroll
            for (int st = 0; st < 2; ++st) {
                f32x16 acc;
#pragma unroll
                for (int r = 0; r < 16; ++r) acc[r] = 0.f;
#pragma unroll
                for (int ks = 0; ks < 4; ++ks) acc = __builtin_amdgcn_mfma_f32_32x32x16_bf16(af[st][ks], bfr[ks], acc, 0, 0, 0);
#pragma unroll
                for (int q = 0; q < 2; ++q) {
                    float sc = 0.f;
#pragma unroll
                    for (int hh = 0; hh < 2; ++hh)
#pragma unroll
                        for (int hl = 0; hl < 4; ++hl) sc += fmaxf(acc[4 * (2 * q + hh) + hl], 0.f) * w[st][q][hl + 4 * hh];
                    if (SAMPLE) WSP(float, WS_SCS)[(size_t)(b * 8 + 4 * st + 2 * lh + q) * SCS_LD + s] = sc;
                    else WSP(float, WS_SC)[((size_t)rowbase + 4 * st + 2 * lh + q) * 4096 + s] = sc;
                }
            }
        }
    }
#undef IDX_LOADB
}

__device__ __forceinline__ unsigned fkey(float f) { f = (f == 0.f) ? 0.f : f; const unsigned u = __float_as_uint(f); return (u & 0x80000000u) ? ~u : (u | 0x80000000u); }
__device__ __forceinline__ void phase_topk_prompt(KP p) {
    const float* SC = WSP(float, WS_SC); int* SEL = WSP(int, WS_SEL); int* CNT = WSP(int, WS_CNT);
    const int lane = TID() & 63, gw = BID() * 8 + (TID() >> 6), nw = gridDim.x * 8;
    for (int qi = gw; qi < NP; qi += nw) {
        const int b = qi & 3, tt = qi >> 2, t = (tt & 1) ? 4095 - (tt >> 1) : (tt >> 1), row = b * 4096 + t, n = t + 1;
        int* sel = SEL + (size_t)row * 256;
        if (n <= TOPK) { for (int s = lane; s < n; s += 64) sel[s] = s; if (lane == 0) CNT[row] = n; continue; }
        const float* base = SC + (size_t)row * 4096;
        unsigned u[64];
#pragma unroll
        for (int m = 0; m < 64; ++m) u[m] = __float_as_uint(base[lane + 64 * m]);
#pragma unroll
        for (int m = 0; m < 64; ++m) { const unsigned k_ = fkey(__uint_as_float(u[m])); u[m] = (lane + 64 * m < n) ? k_ : 0u; }
        unsigned tau = 0u;
#pragma unroll 1
        for (int bit = 31; bit >= 0; --bit) {
            const unsigned cand = tau | (1u << bit); int c = 0;
#pragma unroll
            for (int m = 0; m < 64; ++m) c += (u[m] >= cand) ? 1 : 0;
            c = wave_sum_i(c);
            if (c >= TOPK) tau = cand;
            if (c == TOPK) break;
        }
        int cg = 0, ct = 0; unsigned tlo = 0u, thi = 0u;
#pragma unroll
        for (int m = 31; m >= 0; --m) { cg += (u[m] > tau) ? 1 : 0; const unsigned tie = (u[m] == tau) ? 1u : 0u; ct += (int)tie; tlo = (tlo << 1) | tie; }
#pragma unroll
        for (int m = 63; m >= 32; --m) { cg += (u[m] > tau) ? 1 : 0; const unsigned tie = (u[m] == tau) ? 1u : 0u; ct += (int)tie; thi = (thi << 1) | tie; }
        unsigned long long tmask = ((unsigned long long)thi << 32) | tlo;
        const int totg = wave_sum_i(cg), tott = wave_sum_i(ct);
        const int need = TOPK - totg;
        unsigned long long smask = 0ull;
        if (tott == need) smask = tmask;
        else {
#pragma unroll 1
            for (int it = 0; it < need; ++it) {
                const int m0 = tmask ? (int)__builtin_ctzll(tmask) : 64;
                const int cand = tmask ? (lane + 64 * m0) : 0x7fffffff, best = wave_min_i(cand);
                if (cand == best && tmask) { smask |= (1ull << m0); tmask &= ~(1ull << m0); }
            }
        }
        const int mine = cg + __popcll(smask);
        int incl = mine;
#pragma unroll
        for (int d = 1; d < 64; d <<= 1) { const int o = __shfl_up(incl, d); if (lane >= d) incl += o; }
        int off = incl - mine;
#pragma unroll
        for (int m = 0; m < 64; ++m) { if ((u[m] > tau) || ((smask >> m) & 1ull)) { sel[off] = lane + 64 * m; ++off; } }
        if (lane == 0) CNT[row] = TOPK;
    }
}
__device__ __forceinline__ void phase_topk_sample(KP p, LAS unsigned char* lds) {
    LAS unsigned* ckey = (LAS unsigned*)lds;
    LAS int* cidx = (LAS int*)(lds + 8192);
    const float* SCS = WSP(float, WS_SCS); int* SEL = WSP(int, WS_SEL); int* CNT = WSP(int, WS_CNT);
    for (int qq = BID(); qq < NS; qq += gridDim.x) {
        const int tid = TID(), lane = tid & 63, wave = tid >> 6;
        const int n = PAST + 1 + (qq & 7), row = NP + qq, s0 = 1088 * wave;
        const float* base = SCS + (size_t)qq * SCS_LD;
        unsigned u[17];
#pragma unroll
        for (int m = 0; m < 17; ++m) { const int s = s0 + lane + 64 * m; u[m] = __float_as_uint(base[s < SCS_LD ? s : 0]); }
#pragma unroll
        for (int m = 0; m < 17; ++m) { const unsigned k_ = fkey(__uint_as_float(u[m])); u[m] = (s0 + lane + 64 * m < n) ? k_ : 0u; }
        __syncthreads();
        {
            int nvalid = 0;
#pragma unroll
            for (int m = 0; m < 17; ++m) nvalid += (u[m] != 0u) ? 1 : 0;
            nvalid = wave_sum_i(nvalid);
            unsigned tau = 0u; int need = 0; unsigned tmask = 0u, smask = 0u;
            if (nvalid > TOPK) {
#pragma unroll 1
                for (int bit = 31; bit >= 0; --bit) {
                    const unsigned cand = tau | (1u << bit); int c = 0;
#pragma unroll
                    for (int m = 0; m < 17; ++m) c += (u[m] >= cand) ? 1 : 0;
                    c = wave_sum_i(c);
                    if (c >= TOPK) tau = cand;
                    if (c == TOPK) break;
                }
                int cg = 0, ct = 0;
#pragma unroll
                for (int m = 0; m < 17; ++m) { cg += (u[m] > tau) ? 1 : 0; const bool tie = (u[m] == tau); ct += tie ? 1 : 0; tmask |= tie ? (1u << m) : 0u; }
                cg = wave_sum_i(cg); ct = wave_sum_i(ct);
                need = TOPK - cg;
                if (ct == need) smask = tmask;
                else {
#pragma unroll 1
                    for (int it = 0; it < need; ++it) {
                        const int m0 = tmask ? (int)__builtin_ctz(tmask) : 32;
                        const int cand = tmask ? (lane + 64 * m0) : 0x7fffffff, best = wave_min_i(cand);
                        if (cand == best && tmask) { smask |= (1u << m0); tmask &= ~(1u << m0); }
                    }
                }
            } else { tau = 0u; smask = 0u; }
            int mine = 0;
#pragma unroll
            for (int m = 0; m < 17; ++m) mine += ((u[m] > tau) || ((smask >> m) & 1u)) ? 1 : 0;
            int incl = mine;
#pragma unroll
            for (int d = 1; d < 64; d <<= 1) { const int o = __shfl_up(incl, d); if (lane >= d) incl += o; }
            int off = incl - mine;
            const int total = __builtin_amdgcn_readlane(incl, 63);
#pragma unroll
            for (int m = 0; m < 17; ++m) { if ((u[m] > tau) || ((smask >> m) & 1u)) { ckey[wave * 256 + off] = u[m]; cidx[wave * 256 + off] = s0 + lane + 64 * m; ++off; } }
            for (int e = total + lane; e < 256; e += 64) { ckey[wave * 256 + e] = 0u; cidx[wave * 256 + e] = 0x7fffffff; }
        }
        __syncthreads();
        if (wave == 0) {
            unsigned v[32]; int ix[32];
#pragma unroll
            for (int m = 0; m < 32; ++m) { v[m] = ckey[lane + 64 * m]; ix[m] = cidx[lane + 64 * m]; }
            unsigned tau = 0u;
#pragma unroll 1
            for (int bit = 31; bit >= 0; --bit) {
                const unsigned cand = tau | (1u << bit); int c = 0;
#pragma unroll
                for (int m = 0; m < 32; ++m) c += (v[m] >= cand) ? 1 : 0;
                c = wave_sum_i(c);
                if (c >= TOPK) tau = cand;
                if (c == TOPK) break;
            }
            int cg = 0, ct = 0; unsigned tmask = 0u, smask = 0u;
#pragma unroll
            for (int m = 31; m >= 0; --m) { cg += (v[m] > tau) ? 1 : 0; const unsigned tie = (v[m] == tau) ? 1u : 0u; ct += (int)tie; tmask = (tmask << 1) | tie; }
            cg = wave_sum_i(cg); ct = wave_sum_i(ct);
            const int need = TOPK - cg;
            if (ct == need) smask = tmask;
            else {
#pragma unroll 1
                for (int it = 0; it < need; ++it) {
                    int bi = 0x7fffffff, bm = 0;
#pragma unroll
                    for (int m = 0; m < 32; ++m) { const bool t_ = (tmask >> m) & 1u; if (t_ && ix[m] < bi) { bi = ix[m]; bm = m; } }
                    const int best = wave_min_i(bi);
                    if (bi == best && bi != 0x7fffffff) { smask |= (1u << bm); tmask &= ~(1u << bm); }
                }
            }
            int mine = 0;
#pragma unroll
            for (int m = 0; m < 32; ++m) mine += ((v[m] > tau) || ((smask >> m) & 1u)) ? 1 : 0;
            int incl = mine;
#pragma unroll
            for (int d = 1; d < 64; d <<= 1) { const int o = __shfl_up(incl, d); if (lane >= d) incl += o; }
            int off = incl - mine;
            int* sel = SEL + (size_t)row * 256;
#pragma unroll
            for (int m = 0; m < 32; ++m) { if ((v[m] > tau) || ((smask >> m) & 1u)) { if (off < TOPK) sel[off] = ix[m]; ++off; } }
            if (lane == 0) CNT[row] = TOPK;
        }
    }
    __syncthreads();
}

template <bool SAMPLE>
__device__ __forceinline__ void phase_attn(KP p, int j, LAS unsigned char* lds) {
    const int tid = TID(), lane = tid & 63, wave = tid >> 6, n16 = lane & 15, c4 = lane >> 4;
    LAS bf16_t* ps = (LAS bf16_t*)(lds + wave * 16384);
    LAS int* is = (LAS int*)(lds + wave * 16384 + 8192);
    LAS bf16_t* qs = (LAS bf16_t*)(lds + wave * 16384 + 9216);
    LAS float* invs = (LAS float*)(lds + wave * 16384 + 11264);
    const float* Q = WSP(float, WS_Q); const int* SEL = WSP(int, WS_SEL); const int* CNT = WSP(int, WS_CNT); bf16_t* O = WSP(bf16_t, WS_YG);
    const bf16_t *KBF = WSP(bf16_t, WS_KBF), *VBF = WSP(bf16_t, WS_VBF);
    const float* kc = p->cache_k + (size_t)j * 2560 * 128 * 256; const float* vc = p->cache_v + (size_t)j * 2560 * 128 * 256;
    const float* knew = p->out + O_KS + (size_t)j * NS * 256; const float* vnew = p->out + O_VS + (size_t)j * NS * 256;
    const int gw = BID() * 8 + wave, nw = gridDim.x * 8, nq = SAMPLE ? NS : NP;
    unsigned* qctr = WSP(unsigned, WS_BAR + 40960) + (size_t)j * 256;
    int qb = 0, qnext = 0, qsub = 2, qcur = 0;
    if (!SAMPLE) { unsigned v_ = 0u; if (lane == 0) v_ = __hip_atomic_fetch_add(qctr + 16 * ((BID() + qb) & 3), 2u, __ATOMIC_RELAXED, __HIP_MEMORY_SCOPE_AGENT); qnext = (int)__builtin_amdgcn_readfirstlane(v_); }
    for (int qi = gw; SAMPLE ? (qi < nq) : true; qi += nw) {
        int row;
        if (SAMPLE) row = NP + qi;
        else {
            if (qsub == 2) {
                for (;;) {
                    qcur = qnext; qsub = 0;
                    if (qcur < 4096 || qb == 3) break;
                    ++qb; unsigned v_ = 0u; if (lane == 0) v_ = __hip_atomic_fetch_add(qctr + 16 * ((BID() + qb) & 3), 2u, __ATOMIC_RELAXED, __HIP_MEMORY_SCOPE_AGENT); qnext = (int)__builtin_amdgcn_readfirstlane(v_);
                }
                if (qcur >= 4096) break;
                { unsigned v_ = 0u; if (lane == 0) v_ = __hip_atomic_fetch_add(qctr + 16 * ((BID() + qb) & 3), 2u, __ATOMIC_RELAXED, __HIP_MEMORY_SCOPE_AGENT); qnext = (int)__builtin_amdgcn_readfirstlane(v_); }
            }
            row = ((BID() + qb) & 3) * 4096 + (4095 - (qcur + qsub)); ++qsub;
        }
        const int n = CNT[row];
        wave_lds_fence();
#pragma unroll
        for (int c = 0; c < 4; ++c) { const int slot = lane + 64 * c;
            int s = SEL[(size_t)row * 256 + slot]; const bool ok = slot < n;
            int r;
            if (SAMPLE) { const int bb = (row - NP) >> 3; s = ok ? s : 0; const int sp = min(max(s, 0), PAST - 1); const int pg = p->page_table[bb * 64 + (sp >> 7)];
                r = (s < PAST) ? pg * 128 + (s & 127) : (0x40000000 | (bb * 8 + min(s - PAST, 7))); }
            else r = (row & ~4095) + (ok ? s : 0);
            is[slot] = r; }
#pragma unroll
        for (int i = 0; i < 4; ++i) { const f32x4 q4 = *(const f32x4*)(Q + (size_t)row * D + 256 * i + 4 * lane);
            if (SAMPLE) { const f32x4 q8 = q4 * 0.125f; u32x2 w; w.x = pk_bf16(q8[0], q8[1]); w.y = pk_bf16(q8[2], q8[3]); *(LAS u32x2*)(qs + 256 * i + 4 * lane) = w; }
            else *(LAS unsigned*)((LAS unsigned char*)qs + 256 * i + 4 * lane) = pk_fp8x4(q4); }
        wave_lds_fence();
        {
            float mx = -__builtin_huge_valf();
#define ATT_EMIT(t_, acc_) do { f32x4 l_ = (acc_); _Pragma("unroll") for (int r = 0; r < 4; ++r) { if (16 * (t_) + 4 * c4 + r >= n) l_[r] = -__builtin_huge_valf(); mx = fmaxf(mx, l_[r]); } \
                u32x2 w_; w_.x = pk_bf16(l_[0], l_[1]); w_.y = pk_bf16(l_[2], l_[3]); *(LAS u32x2*)(ps + n16 * 256 + 16 * (t_) + 4 * c4) = w_; } while (0)
            if (SAMPLE) {
                const u32x4 qf0 = *(const LAS u32x4*)(qs + n16 * 64 + 8 * c4), qf1 = *(const LAS u32x4*)(qs + n16 * 64 + 32 + 8 * c4);
                u32x4 bq[8];
#pragma unroll
                for (int ks = 0; ks < 8; ++ks) { const bool on = (n16 >> 2) == (ks >> 1); const u32x4 qv = (ks & 1) ? qf1 : qf0; bq[ks] = (u32x4){on ? qv.x : 0u, on ? qv.y : 0u, on ? qv.z : 0u, on ? qv.w : 0u}; }
#pragma unroll 2
                for (int t = 0; t < 16; ++t) {
                    const int r = is[16 * t + n16];
                    const float* kp = ((r & 0x40000000) ? knew + (size_t)(r & 0xffff) * 256 : kc + (size_t)r * 256) + 8 * c4;
                    f32x4 acc = {0.f, 0.f, 0.f, 0.f};
#pragma unroll
                    for (int ks = 0; ks < 8; ++ks) { const f32x4 x0 = *(const f32x4*)(kp + 32 * ks), x1 = *(const f32x4*)(kp + 32 * ks + 4);
                        const u32x4 ka = {pk_bf16(x0[0], x0[1]), pk_bf16(x0[2], x0[3]), pk_bf16(x1[0], x1[1]), pk_bf16(x1[2], x1[3])};
                        acc = __builtin_amdgcn_mfma_f32_16x16x32_bf16(__builtin_bit_cast(bf16x8, ka), __builtin_bit_cast(bf16x8, bq[ks]), acc, 0, 0, 0); }
                    ATT_EMIT(t, acc);
                }
            } else {
                const LAS unsigned char* q8 = (const LAS unsigned char*)qs;
                long bq[8];
                { const bool on = (n16 >> 2) == c4;
#pragma unroll
                  for (int h2 = 0; h2 < 4; ++h2) { const u32x4 qv = *(const LAS u32x4*)(q8 + n16 * 64 + 16 * h2);
                      const u32x2 z0 = {on ? qv.x : 0u, on ? qv.y : 0u}, z1 = {on ? qv.z : 0u, on ? qv.w : 0u}; bq[2 * h2] = __builtin_bit_cast(long, z0); bq[2 * h2 + 1] = __builtin_bit_cast(long, z1); } }
                const unsigned char* K8 = WSP(unsigned char, WS_K8);
#pragma unroll
                for (int th = 0; th < 2; ++th) {
                    if (th) asm volatile("" ::: "memory");
                    u32x4 ka[8][4];
#pragma unroll
                    for (int t8 = 0; t8 < 8; ++t8) {
                        const int r = is[16 * (8 * th + t8) + n16];
                        const unsigned char* kp = K8 + (size_t)r * 256 + 64 * c4;
#pragma unroll
                        for (int h2 = 0; h2 < 4; ++h2) ka[t8][h2] = *(const u32x4*)(kp + 16 * h2);
                    }
                    __builtin_amdgcn_sched_barrier(0);
#pragma unroll
                    for (int t8 = 0; t8 < 8; ++t8) {
                        f32x4 acc = {0.f, 0.f, 0.f, 0.f};
#pragma unroll
                        for (int h2 = 0; h2 < 4; ++h2) { const u32x2 lo = {ka[t8][h2].x, ka[t8][h2].y}, hi = {ka[t8][h2].z, ka[t8][h2].w};
                            acc = __builtin_amdgcn_mfma_f32_16x16x32_fp8_fp8(__builtin_bit_cast(long, lo), bq[2 * h2], acc, 0, 0, 0);
                            acc = __builtin_amdgcn_mfma_f32_16x16x32_fp8_fp8(__builtin_bit_cast(long, hi), bq[2 * h2 + 1], acc, 0, 0, 0); }
                        ATT_EMIT(8 * th + t8, acc * 0.125f);
                    }
                }
            }
#undef ATT_EMIT
            mx = fmaxf(mx, __shfl_xor(mx, 16)); mx = fmaxf(mx, __shfl_xor(mx, 32));
            float sm = 0.f;
#pragma unroll
            for (int t = 0; t < 16; ++t) {
                LAS u32x2* pp = (LAS u32x2*)(ps + n16 * 256 + 16 * t + 4 * c4); const u32x2 w = *pp;
                const float e0 = __expf(bflo(w.x) - mx), e1 = __expf(bfhi(w.x) - mx), e2 = __expf(bflo(w.y) - mx), e3 = __expf(bfhi(w.y) - mx);
                sm += (e0 + e1) + (e2 + e3);
                u32x2 o_; o_.x = pk_bf16(e0, e1); o_.y = pk_bf16(e2, e3); *pp = o_;
            }
            sm += __shfl_xor(sm, 16); sm += __shfl_xor(sm, 32);
            if (c4 == 0) invs[n16] = 1.0f / sm;
        }
        wave_lds_fence();
        if (!SAMPLE) {
            const unsigned char* V8 = WSP(unsigned char, WS_V8);
            const int rs = c4, kvh = n16 >> 2, nst = n > 64 ? 64 : n;
            f32x4 oa[4][4];
#pragma unroll
            for (int g = 0; g < 4; ++g)
#pragma unroll
                for (int q = 0; q < 4; ++q) oa[g][q] = (f32x4){0.f, 0.f, 0.f, 0.f};
            for (int m0 = 0; m0 < nst; m0 += 8) {
                u32x4 vr[8];
#pragma unroll
                for (int i = 0; i < 8; ++i) vr[i] = *(const u32x4*)(V8 + (size_t)is[64 * rs + m0 + i] * 256 + 16 * n16);
                __builtin_amdgcn_sched_barrier(0);
#pragma unroll
                for (int h4 = 0; h4 < 2; ++h4) {
                    u32x2 pg[4];
#pragma unroll
                    for (int g = 0; g < 4; ++g) pg[g] = *(const LAS u32x2*)(ps + (kvh * 4 + g) * 256 + 64 * rs + m0 + 4 * h4);
#pragma unroll
                    for (int i = 0; i < 4; ++i) {
                        const u32x4 v_ = vr[4 * h4 + i];
                        const f32x4 v0 = fp8x4_f32(v_.x), v1 = fp8x4_f32(v_.y), v2 = fp8x4_f32(v_.z), v3 = fp8x4_f32(v_.w);
#pragma unroll
                        for (int g = 0; g < 4; ++g) { const unsigned pw = (i < 2) ? pg[g].x : pg[g].y; const float pf = (i & 1) ? bfhi(pw) : bflo(pw);
                            oa[g][0] += pf * v0; oa[g][1] += pf * v1; oa[g][2] += pf * v2; oa[g][3] += pf * v3; }
                    }
                }
            }
#pragma unroll
            for (int g = 0; g < 4; ++g)
#pragma unroll
                for (int q = 0; q < 4; ++q)
#pragma unroll
                    for (int e_ = 0; e_ < 4; ++e_) { float x = oa[g][q][e_]; x += __shfl_xor(x, 16); x += __shfl_xor(x, 32); oa[g][q][e_] = x; }
            if (rs == 0) {
                const f32x4 iv = *(const LAS f32x4*)(invs + 4 * kvh);
#pragma unroll
                for (int g = 0; g < 4; ++g) { bf16_t* op = O + (size_t)row * D + (kvh * 4 + g) * 64 + 16 * (n16 & 3);
                    u32x4 w0, w1; const float sc_ = iv[g];
                    w0.x = pk_bf16(oa[g][0][0] * sc_, oa[g][0][1] * sc_); w0.y = pk_bf16(oa[g][0][2] * sc_, oa[g][0][3] * sc_); w0.z = pk_bf16(oa[g][1][0] * sc_, oa[g][1][1] * sc_); w0.w = pk_bf16(oa[g][1][2] * sc_, oa[g][1][3] * sc_);
                    w1.x = pk_bf16(oa[g][2][0] * sc_, oa[g][2][1] * sc_); w1.y = pk_bf16(oa[g][2][2] * sc_, oa[g][2][3] * sc_); w1.z = pk_bf16(oa[g][3][0] * sc_, oa[g][3][1] * sc_); w1.w = pk_bf16(oa[g][3][2] * sc_, oa[g][3][3] * sc_);
                    *(u32x4*)op = w0; *(u32x4*)(op + 8) = w1; }
            }
        } else {
        f32x4 o0 = {0.f, 0.f, 0.f, 0.f}, o1 = o0, o2 = o0, o3 = o0;
        constexpr int GV = SAMPLE ? 16 : 32;
        const int ng = (n + GV - 1) / GV;
        unsigned vb[SAMPLE ? 1 : GV], vbn[SAMPLE ? 1 : GV]; f32x4 vf[SAMPLE ? GV : 1];
        const unsigned char* V8 = WSP(unsigned char, WS_V8);
        if (!SAMPLE) {
#pragma unroll
            for (int i = 0; i < GV; ++i) vbn[i] = *(const unsigned*)(V8 + (size_t)is[i] * 256 + 4 * lane);
        }
#pragma unroll 1
        for (int g = 0; g < ng; ++g) {
            if (!SAMPLE) {
#pragma unroll
                for (int i = 0; i < GV; ++i) vb[i] = vbn[i];
                if (g + 1 < ng) {
#pragma unroll
                    for (int i = 0; i < GV; ++i) vbn[i] = *(const unsigned*)(V8 + (size_t)is[GV * (g + 1) + i] * 256 + 4 * lane);
                }
                __builtin_amdgcn_sched_barrier(0);
            } else {
#pragma unroll
                for (int i = 0; i < GV; ++i) { const int r = is[GV * g + i]; vf[i] = *(const f32x4*)(((r & 0x40000000) ? vnew + (size_t)(r & 0xffff) * 256 : vc + (size_t)r * 256) + 4 * lane); }
            }
#pragma unroll
            for (int i4 = 0; i4 < GV / 4; ++i4) {
                const u32x2 p0 = *(const LAS u32x2*)(ps + (c4 * 4 + 0) * 256 + GV * g + 4 * i4), p1 = *(const LAS u32x2*)(ps + (c4 * 4 + 1) * 256 + GV * g + 4 * i4),
                            p2 = *(const LAS u32x2*)(ps + (c4 * 4 + 2) * 256 + GV * g + 4 * i4), p3 = *(const LAS u32x2*)(ps + (c4 * 4 + 3) * 256 + GV * g + 4 * i4);
                f32x4 v0, v1, v2, v3;
                if (!SAMPLE) { v0 = fp8x4_f32(vb[4 * i4]); v1 = fp8x4_f32(vb[4 * i4 + 1]); v2 = fp8x4_f32(vb[4 * i4 + 2]); v3 = fp8x4_f32(vb[4 * i4 + 3]); }
                else { v0 = vf[4 * i4]; v1 = vf[4 * i4 + 1]; v2 = vf[4 * i4 + 2]; v3 = vf[4 * i4 + 3]; }
                o0 += bflo(p0.x) * v0 + bfhi(p0.x) * v1 + bflo(p0.y) * v2 + bfhi(p0.y) * v3;
                o1 += bflo(p1.x) * v0 + bfhi(p1.x) * v1 + bflo(p1.y) * v2 + bfhi(p1.y) * v3;
                o2 += bflo(p2.x) * v0 + bfhi(p2.x) * v1 + bflo(p2.y) * v2 + bfhi(p2.y) * v3;
                o3 += bflo(p3.x) * v0 + bfhi(p3.x) * v1 + bflo(p3.y) * v2 + bfhi(p3.y) * v3;
            }
        }
        { const f32x4 iv = *(const LAS f32x4*)(invs + 4 * c4); bf16_t* op = O + (size_t)row * D + c4 * 256 + 4 * n16; st_bf4(op, o0 * iv[0]); st_bf4(op + 64, o1 * iv[1]); st_bf4(op + 128, o2 * iv[2]); st_bf4(op + 192, o3 * iv[3]); }
        }
    }
}

__global__ void __launch_bounds__(512, 2) mega(P p_unused) {
    extern __shared__ __attribute__((aligned(16))) unsigned char lds_raw[];
    LAS unsigned char* lds = (LAS unsigned char*)lds_raw;
    volatile LAS unsigned* misc = (volatile LAS unsigned*)(lds + LDS_MISC);
    if (TID() < 4) misc[TID()] = 0u;
    __syncthreads();
    KP p = kargs();
    const bool multi = (p->ph_hi - p->ph_lo) > 1;
    XcdBarrier bar; bar.bar = WSP(unsigned, WS_BAR); bar.x = 0; bar.st = misc;
    if (multi) bar = xcd_barrier_post(WSP(unsigned, WS_BAR), misc);
    int ph = 0;
    const int lo = p->ph_lo, hi = p->ph_hi;
#ifndef REPMASK
#define REPMASK 0ull
#endif
#define PH_BEGIN if (ph >= lo && ph < hi) { KP p = kargs(); const int nrep_ = ((REPMASK >> ph) & 1ull) ? 3 : 1; for (int rep_ = 0; rep_ < nrep_; ++rep_) {
#define PH_END   if (ph + 1 < hi || rep_ + 1 < nrep_) xcd_barrier(bar); } } ++ph;

    PH_BEGIN phase_ada(p, lds); phase_weights(p, lds); PH_END

    for (int layer = 0; layer < 4; ++layer) {
        const int j = layer >> 1;
        if ((layer & 1) == 0) {
            PH_BEGIN phase_prep<true>(p, layer, 0, j, layer == 0); PH_END
            PH_BEGIN {
                FRwkvIn f{WSP(bf16_t, WS_RB), WSP(bf16_t, WS_KB), WSP(bf16_t, WS_VB), WSP(bf16_t, WS_TW), WSP(bf16_t, WS_TA), WSP(bf16_t, WS_TV), WSP(bf16_t, WS_TG)};
                pg8::Gemm g{WSP(bf16_t, WS_XR), WSP(bf16_t, WS_WRW_T) + (size_t)j * 4096 * D, NP, j == 0 ? 3840 : 4096, D, j == 0 ? 2 : 1, XR_STRIDE};
                pg8::StaticOrder S; S.init(NP, g.N, (int)gridDim.x, BID());
                pg8::EpiAdapt<FRwkvIn, true> E{f};
                pg8::gemm_phase(lds, g, S, E);
                wgemm_ks<true>(lds, WSP(bf16_t, WS_XR), D, XR_STRIDE, NP, NS, WSP(bf16_t, WS_WRW_T) + (size_t)j * 4096 * D, D, 4096, f);
            } PH_END
            PH_BEGIN {
                FStoreF32 fw{WSP(float, WS_WP), D, D}, fa{WSP(float, WS_AP), D, D}, fv{WSP(float, WS_VP), D, D}, fg{WSP(float, WS_GG), D, D};
                wgemm_w(WSP(bf16_t, WS_TW), 64, NP, NS, WSP(bf16_t, WS_W2T) + (size_t)j * D * 64, 64, D, fw);
                wgemm_w(WSP(bf16_t, WS_TA), 64, NP, NS, WSP(bf16_t, WS_A2T) + (size_t)j * D * 64, 64, D, fa);
                if (j == 1) wgemm_w(WSP(bf16_t, WS_TV), 32, NP, NS, WSP(bf16_t, WS_V2T), 32, D, fv);
                wgemm_w(WSP(bf16_t, WS_TG), 160, NP, NS, WSP(bf16_t, WS_G2T) + (size_t)j * D * 160, 160, D, fg);
                phase_chunk(p, j, lds);
            } PH_END
            PH_BEGIN phase_carry(p, j, lds); PH_END
            PH_BEGIN phase_post2(p, j, lds); PH_END
        } else {
            PH_BEGIN phase_prep<false>(p, layer, 0, j); PH_END
            PH_BEGIN {
                FStoreF32 f{WSP(float, WS_PR), PINP, PINP};
                pg8::Gemm g{WSP(bf16_t, WS_XR), WSP(bf16_t, WS_WIN_T) + (size_t)j * PINP * D, NP, PINP, D, 0, 0};
                pg8::StaticOrder S; S.init(NP, PINP, (int)gridDim.x, BID());
                pg8::EpiAdapt<FStoreF32, false> E{f};
                pg8::gemm_phase(lds, g, S, E);
                FStoreF32 fs{WSP(float, WS_PR), PINP, PIN};
                wgemm_ks<false>(lds, WSP(bf16_t, WS_XR), D, 0, NP, NS, WSP(bf16_t, WS_WIN_T) + (size_t)j * PINP * D, D, PINP, fs);
            } PH_END
            PH_BEGIN phase_dsapost(p, j); PH_END
            PH_BEGIN phase_idx2<false>(p, j); phase_idx2<true>(p, j); PH_END
            PH_BEGIN phase_topk_prompt(p); phase_topk_sample(p, lds); PH_END
            PH_BEGIN phase_attn<true>(p, j, lds); phase_attn<false>(p, j, lds); PH_END
        }
        PH_BEGIN {
            FResid f{p->out, WSP(float, WS_MODS) + (size_t)layer * 36 * 6144 + 2 * D, layer == 0 ? p->x_prompt : nullptr, layer == 0 ? p->x_sample : nullptr};
            const bf16_t* Wt = ((layer & 1) == 0 ? WSP(bf16_t, WS_WO_T) : WSP(bf16_t, WS_WAO_T)) + (size_t)j * D * D;
            pg8::Gemm g{WSP(bf16_t, WS_YG), Wt, NP, D, D, 0, 0};
            pg8::StaticOrder S; S.init(NP, D, (int)gridDim.x, BID());
            pg8::EpiAdapt<FResid, false> E{f};
            pg8::gemm_phase(lds, g, S, E);
            wgemm_ks<false>(lds, WSP(bf16_t, WS_YG), D, 0, NP, NS, Wt, D, D, f);
        } PH_END
        PH_BEGIN phase_prep<false>(p, layer, 1, j); PH_END
        PH_BEGIN {
            FRelu2 f{WSP(bf16_t, WS_U)};
            pg8::Gemm g{WSP(bf16_t, WS_XR), WSP(bf16_t, WS_WUP_T) + (size_t)layer * DFF * D, NP, DFF, D, 0, 0};
            pg8::StaticOrder S; S.init(NP, DFF, (int)gridDim.x, BID());
            pg8::EpiAdapt<FRelu2, true> E{f};
            pg8::gemm_phase(lds, g, S, E);
            wgemm_ks<false>(lds, WSP(bf16_t, WS_XR), D, 0, NP, NS, WSP(bf16_t, WS_WUP_T) + (size_t)layer * DFF * D, D, DFF, f);
        } PH_END
        PH_BEGIN {
            FResid f{p->out, WSP(float, WS_MODS) + (size_t)layer * 36 * 6144 + 5 * D, nullptr, nullptr};
            pg8::Gemm g{WSP(bf16_t, WS_U), WSP(bf16_t, WS_WDN_T) + (size_t)layer * DFF * D, NP, D, DFF, 0, 0};
            pg8::StaticOrder S; S.init(NP, D, (int)gridDim.x, BID());
            pg8::EpiAdapt<FResid, false> E{f};
            pg8::gemm_phase(lds, g, S, E);
            wgemm_ks<false>(lds, WSP(bf16_t, WS_U), DFF, 0, NP, NS, WSP(bf16_t, WS_WDN_T) + (size_t)layer * DFF * D, DFF, D, f);
        } PH_END
    }
#undef PH_BEGIN
#undef PH_END
}

static int count_phases() { int n = 1; for (int layer = 0; layer < 4; ++layer) { n += ((layer & 1) == 0) ? 5 : 6; n += 4; } return n; }

extern "C" void kernel_launch(void* const* d_in, const int* in_sizes, int n_in, void* d_out, int out_size, void* d_ws, size_t ws_size, hipStream_t stream) {
    static int grid = 0;
    if (grid == 0) {
        if (n_in != 39 || out_size != (int)O_END || ws_size < WS_END) { fprintf(stderr, "kernel_launch: unexpected shapes n_in %d out %d ws %zu (need %zu)\n", n_in, out_size, ws_size, (size_t)WS_END); grid = -1; return; }
        int dev = 0, cus = 0, per_cu = 0;
        if (hipGetDevice(&dev) != hipSuccess || hipDeviceGetAttribute(&cus, hipDeviceAttributeMultiprocessorCount, dev) != hipSuccess) { grid = -1; return; }
        if (hipFuncSetAttribute((const void*)mega, hipFuncAttributeMaxDynamicSharedMemorySize, LDS_BYTES) != hipSuccess) { fprintf(stderr, "kernel_launch: hipFuncSetAttribute failed\n"); grid = -1; return; }
        if (hipOccupancyMaxActiveBlocksPerMultiprocessor(&per_cu, (const void*)mega, 512, LDS_BYTES) != hipSuccess || per_cu < 1) fprintf(stderr, "kernel_launch: occupancy query says %d\n", per_cu);
        (void)hipGetLastError();
        grid = cus;
    }
    if (grid < 0) return;
    (void)hipMemsetAsync((char*)d_ws + WS_BAR, 0, 65536, stream);
    P p{};
    memcpy((void*)&p, (const void*)d_in, 39 * sizeof(void*));
    p.out = (float*)d_out; p.ws = (unsigned char*)d_ws;
#ifndef STOP_PH
#define STOP_PH 1000
#endif
    const int nph = count_phases() < STOP_PH ? count_phases() : STOP_PH;
#ifndef ONE_LAUNCH
    for (int ph = 0; ph < nph; ++ph) { p.ph_lo = ph; p.ph_hi = ph + 1; hipLaunchKernelGGL(mega, dim3(grid), dim3(512), LDS_BYTES, stream, p); }
#else
    p.ph_lo = 0; p.ph_hi = nph; hipLaunchKernelGGL(mega, dim3(grid), dim3(512), LDS_BYTES, stream, p);
#endif
}
```

```cpp
#define ONE_LAUNCH 1
#include <hip/hip_runtime.h>
#include <cstdio>
#include <cstdint>
#include <cstring>

#define LAS __attribute__((address_space(3)))
typedef unsigned short bf16_t;
typedef short bf16x8 __attribute__((ext_vector_type(8)));
typedef float f32x4 __attribute__((ext_vector_type(4)));
typedef float f32x2 __attribute__((ext_vector_type(2)));
typedef unsigned u32x4 __attribute__((ext_vector_type(4)));
typedef unsigned u32x2 __attribute__((ext_vector_type(2)));

constexpr int D = 1024, NP = 16384, NS = 256, NT = NP + NS, SEQL = 4096, PAST = 8192, NSEQ = 36, DFF = 4096;
constexpr int PIN = 2120, PINP = 2304;
constexpr int TOPK = 256, SCS_LD = 8320;
constexpr size_t O_YP = 0, O_YS = 16777216, O_KP = 17039360, O_VP = 25427968, O_IKP = 33816576, O_WKVP = 35913728, O_SHP = 36438016,
                 O_KS = 36446208, O_VS = 36577280, O_IKS = 36708352, O_WKVS = 36741120, O_SHS = 40935424, O_END = 41000960;
constexpr size_t al256(size_t x) { return (x + 255) & ~(size_t)255; }
constexpr size_t WS_BAR = 0;
constexpr size_t WS_MODS = 65536;
constexpr size_t WS_WUP_T = al256(WS_MODS + (size_t)4 * NSEQ * 6144 * 4);
constexpr size_t WS_WDN_T = WS_WUP_T + (size_t)4 * DFF * D * 2;
constexpr size_t WS_WRW_T = WS_WDN_T + (size_t)4 * DFF * D * 2;
constexpr size_t WS_WO_T = WS_WRW_T + (size_t)2 * 4096 * D * 2;
constexpr size_t WS_WIN_T = WS_WO_T + (size_t)2 * D * D * 2;
constexpr size_t WS_WAO_T = WS_WIN_T + (size_t)2 * PINP * D * 2;
constexpr size_t WS_W2T = WS_WAO_T + (size_t)2 * D * D * 2;
constexpr size_t WS_A2T = WS_W2T + (size_t)2 * D * 64 * 2;
constexpr size_t WS_V2T = WS_A2T + (size_t)2 * D * 64 * 2;
constexpr size_t WS_G2T = WS_V2T + (size_t)D * 32 * 2;
constexpr size_t WS_XR = WS_G2T + (size_t)2 * D * 160 * 2;
constexpr size_t XR_STRIDE = (size_t)NT * D;
constexpr size_t WS_RB = WS_XR + 6 * XR_STRIDE * 2;
constexpr size_t WS_KB = WS_RB + XR_STRIDE * 2;
constexpr size_t WS_VB = WS_KB + XR_STRIDE * 2;
constexpr size_t WS_TW = WS_VB + XR_STRIDE * 2;
constexpr size_t WS_TA = WS_TW + (size_t)NT * 64 * 2;
constexpr size_t WS_TV = WS_TA + (size_t)NT * 64 * 2;
constexpr size_t WS_TG = WS_TV + (size_t)NT * 32 * 2;
constexpr size_t WS_WP = al256(WS_TG + (size_t)NT * 160 * 2);
constexpr size_t F32A = (size_t)NT * D * 4;
constexpr size_t WS_AP = WS_WP + F32A, WS_VP = WS_AP + F32A, WS_GG = WS_VP + F32A, WS_VFIRST = WS_GG + F32A;
constexpr size_t WS_DEC = WS_VFIRST + F32A, WS_KM = WS_DEC + F32A, WS_VM = WS_KM + F32A, WS_AV = WS_VM + F32A, WS_BV = WS_AV + F32A, WS_Y = WS_BV + F32A;
constexpr size_t WS_YG = WS_Y + F32A;
constexpr size_t WS_U = WS_YG + XR_STRIDE * 2;
constexpr size_t WS_PR = WS_U + (size_t)NT * DFF * 2;
constexpr size_t WS_Q = WS_PR + (size_t)NT * PINP * 4;
constexpr size_t WS_QI = WS_Q + F32A;
constexpr size_t WS_WI = WS_QI + (size_t)NT * 512 * 4;
constexpr size_t WS_SC = al256(WS_WI + (size_t)NT * 8 * 4);
constexpr size_t WS_SCS = WS_SC + (size_t)4 * 4096 * 4096 * 4;
constexpr size_t WS_SEL = al256(WS_SCS + (size_t)NS * SCS_LD * 4);
constexpr size_t WS_CNT = WS_SEL + (size_t)NT * 256 * 4;
constexpr size_t WS_KBF = al256(WS_CNT + (size_t)NT * 4);
constexpr size_t WS_VBF = WS_KBF + (size_t)NT * 256 * 2;
constexpr size_t WS_QIB = WS_VBF + (size_t)NT * 256 * 2;
constexpr size_t WS_KIB = WS_QIB + (size_t)NT * 512 * 2;
constexpr size_t WS_K8 = al256(WS_KIB + (size_t)NT * 64 * 2);
constexpr size_t WS_V8 = WS_K8 + (size_t)NT * 256;
constexpr size_t WS_END = al256(WS_V8 + (size_t)NT * 256);

constexpr int LCH = 64, NCH = SEQL / LCH;
constexpr size_t WS_PCH = WS_SC, WS_CCH = WS_PCH + (size_t)64 * NCH * 4096 * 4, WS_SST = WS_CCH + (size_t)64 * NCH * 4096 * 4;
static_assert(WS_SST + (size_t)64 * NCH * 4096 * 4 <= WS_SCS, "scan buffers must fit the aliased region");
constexpr int LDS_BYTES = 147456;
constexpr int LDS_MISC = 131072;

typedef __bf16 bf16x2_t __attribute__((ext_vector_type(2)));
__device__ __forceinline__ unsigned pk_bf16(float lo, float hi) { const f32x2 v = {lo, hi}; const bf16x2_t b = __builtin_convertvector(v, bf16x2_t); return __builtin_bit_cast(unsigned, b); }
__device__ __forceinline__ unsigned pk_fp8x4(f32x4 v) { int w = 0; w = __builtin_amdgcn_cvt_pk_fp8_f32(v[0], v[1], w, false); w = __builtin_amdgcn_cvt_pk_fp8_f32(v[2], v[3], w, true); return (unsigned)w; }
__device__ __forceinline__ f32x4 fp8x4_f32(unsigned w) { return (f32x4){__builtin_amdgcn_cvt_f32_fp8((int)w, 0), __builtin_amdgcn_cvt_f32_fp8((int)w, 1), __builtin_amdgcn_cvt_f32_fp8((int)w, 2), __builtin_amdgcn_cvt_f32_fp8((int)w, 3)}; }
__device__ __forceinline__ float bf2f(unsigned short x) { return __uint_as_float((unsigned)x << 16); }
__device__ __forceinline__ float bflo(unsigned x) { return __uint_as_float(x << 16); }
__device__ __forceinline__ float bfhi(unsigned x) { return __uint_as_float(x & 0xffff0000u); }
__device__ __forceinline__ f32x4 ld_bf4(const bf16_t* p) { const u32x2 v = *(const u32x2*)p; return (f32x4){bflo(v.x), bfhi(v.x), bflo(v.y), bfhi(v.y)}; }
__device__ __forceinline__ void st_bf4(bf16_t* p, f32x4 v) { u32x2 w; w.x = pk_bf16(v[0], v[1]); w.y = pk_bf16(v[2], v[3]); *(u32x2*)p = w; }
template <int CTRL> __device__ __forceinline__ float dppf(float v) { return __int_as_float(__builtin_amdgcn_update_dpp(0, __float_as_int(v), CTRL, 0xf, 0xf, false)); }
template <int CTRL> __device__ __forceinline__ int dppi(int v) { return __builtin_amdgcn_update_dpp(0, v, CTRL, 0xf, 0xf, false); }
__device__ __forceinline__ float g16_sum(float v) { v += dppf<0xB1>(v); v += dppf<0x4E>(v); v += dppf<0x141>(v); v += dppf<0x140>(v); return v; }
__device__ __forceinline__ float g16_max(float v) { v = fmaxf(v, dppf<0xB1>(v)); v = fmaxf(v, dppf<0x4E>(v)); v = fmaxf(v, dppf<0x141>(v)); v = fmaxf(v, dppf<0x140>(v)); return v; }
__device__ __forceinline__ int g16_sum_i(int v) { v += dppi<0xB1>(v); v += dppi<0x4E>(v); v += dppi<0x141>(v); v += dppi<0x140>(v); return v; }
__device__ __forceinline__ int g16_min_i(int v) { v = min(v, dppi<0xB1>(v)); v = min(v, dppi<0x4E>(v)); v = min(v, dppi<0x141>(v)); v = min(v, dppi<0x140>(v)); return v; }
__device__ __forceinline__ float rlf(float v, int k) { return __int_as_float(__builtin_amdgcn_readlane(__float_as_int(v), k)); }
__device__ __forceinline__ float wave_sum(float v) { v = g16_sum(v); return (rlf(v, 0) + rlf(v, 16)) + (rlf(v, 32) + rlf(v, 48)); }
__device__ __forceinline__ float wave_max(float v) { v = g16_max(v); return fmaxf(fmaxf(rlf(v, 0), rlf(v, 16)), fmaxf(rlf(v, 32), rlf(v, 48))); }
__device__ __forceinline__ int wave_sum_i(int v) { v = g16_sum_i(v); return (__builtin_amdgcn_readlane(v, 0) + __builtin_amdgcn_readlane(v, 16)) + (__builtin_amdgcn_readlane(v, 32) + __builtin_amdgcn_readlane(v, 48)); }
__device__ __forceinline__ int wave_min_i(int v) { v = g16_min_i(v); return min(min(__builtin_amdgcn_readlane(v, 0), __builtin_amdgcn_readlane(v, 16)), min(__builtin_amdgcn_readlane(v, 32), __builtin_amdgcn_readlane(v, 48))); }
__device__ __forceinline__ float sigmoidf_(float x) { return 1.0f / (1.0f + expf(-x)); }
__device__ __forceinline__ float fsig(float x) { return __builtin_amdgcn_rcpf(1.0f + __expf(-x)); }
__device__ __forceinline__ float ftanh(float x) { return 2.0f * fsig(2.0f * x) - 1.0f; }
__device__ __forceinline__ int row_seq(int row) { return row < NP ? (row >> 12) : 4 + ((row - NP) >> 3); }
__device__ __forceinline__ int row_pos(int row) { return row < NP ? (row & 4095) : PAST + ((row - NP) & 7); }
__device__ __forceinline__ int TID() { int t = threadIdx.x; asm volatile("" : "+v"(t)); return t; }
__device__ __forceinline__ int BID() { int b = blockIdx.x; asm volatile("" : "+s"(b)); return b; }
__device__ __forceinline__ void wave_lds_fence() { __builtin_amdgcn_fence(__ATOMIC_RELEASE, "wavefront"); __builtin_amdgcn_wave_barrier(); __builtin_amdgcn_fence(__ATOMIC_ACQUIRE, "wavefront"); }

#define XB_TMO      128
#define XB_XCNT(j)  (256  + 64 * (j))
#define XB_XSUB(j)  (1280 + 64 * (j))
#define XB_XGEN(j)  (2304 + 64 * (j))
#define XB_TOP      3328
#define XB_TOPGEN   3392
#define XCD_BAR_WORDS 3456
#define XB_SPIN_CAP (1u << 22)
__device__ __forceinline__ unsigned xb_ld(unsigned* p)              { return __hip_atomic_load(p, __ATOMIC_RELAXED, __HIP_MEMORY_SCOPE_AGENT); }
__device__ __forceinline__ unsigned xb_add(unsigned* p, unsigned v) { return __hip_atomic_fetch_add(p, v, __ATOMIC_RELAXED, __HIP_MEMORY_SCOPE_AGENT); }
__device__ __forceinline__ unsigned xb_xcc_id() { return (unsigned)__builtin_amdgcn_s_getreg((3 << 11) | 20) & 0xFu; }
#define XB_SPIN(cond, bar) do { unsigned _sp = 0; while (cond) { __builtin_amdgcn_s_sleep(1); \
    if ((++_sp & 255u) == 0u) { if (xb_ld(&(bar)[XB_TMO])) break; if (_sp > XB_SPIN_CAP) { atomicAdd(&(bar)[XB_TMO], 1u); break; } } } } while (0)
struct XcdBarrier { unsigned* bar; unsigned x; volatile LAS unsigned* st; };
__device__ __forceinline__ XcdBarrier xcd_barrier_post(unsigned* bar, volatile LAS unsigned* st) {
    XcdBarrier b; b.bar = bar; b.x = xb_xcc_id(); b.st = st;
    if (threadIdx.x == 0) (void)xb_add(&bar[XB_XCNT(b.x)], 1u);
    return b;
}
__device__ __forceinline__ void xcd_barrier_complete(unsigned* bar, unsigned x, unsigned& nloc, unsigned& nx) {
    const unsigned G = gridDim.x * gridDim.y * gridDim.z;
    unsigned sum, cnt, mine, sp = 0u;
    for (;;) {
        sum = 0u; cnt = 0u; mine = 0u;
#pragma unroll
        for (unsigned j = 0; j < 16; ++j) { const unsigned c = xb_ld(&bar[XB_XCNT(j)]); sum += c; cnt += (c > 0u) ? 1u : 0u; mine = (j == x) ? c : mine; }
        if (sum == G) break;
        __builtin_amdgcn_s_sleep(1);
        if ((++sp & 255u) == 0u) { if (xb_ld(&bar[XB_TMO])) break; if (sp > XB_SPIN_CAP) { atomicAdd(&bar[XB_TMO], 1u); break; } }
    }
    nloc = mine > 0u ? mine : 1u; nx = cnt > 0u ? cnt : 1u;
}
__device__ __forceinline__ void xcd_barrier(const XcdBarrier& b) {
    asm volatile("s_waitcnt vmcnt(0)" ::: "memory");
    __syncthreads();
    if (threadIdx.x == 0) {
        unsigned* bar = b.bar;
        __builtin_amdgcn_s_waitcnt(0);
        unsigned nloc = b.st[0], nx = b.st[1];
        if (nloc == 0u) { xcd_barrier_complete(bar, b.x, nloc, nx); b.st[0] = nloc; b.st[1] = nx; }
        const unsigned old = xb_add(&bar[XB_XSUB(b.x)], 1u);
        const unsigned gen = old / nloc;
        if (old + 1u == (gen + 1u) * nloc) {
            __builtin_amdgcn_fence(__ATOMIC_RELEASE, "agent");
            asm volatile("s_waitcnt vmcnt(0)" ::: "memory");
            const unsigned og = xb_add(&bar[XB_TOP], 1u);
            const unsigned tg = og / nx;
            if (og + 1u == (tg + 1u) * nx) xb_add(&bar[XB_TOPGEN], 1u);
            else XB_SPIN(xb_ld(&bar[XB_TOPGEN]) == tg, bar);
            __builtin_amdgcn_fence(__ATOMIC_ACQUIRE, "agent");
            xb_add(&bar[XB_XGEN(b.x)], 1u);
            asm volatile("s_waitcnt vmcnt(0)" ::: "memory");
        } else {
            XB_SPIN(xb_ld(&bar[XB_XGEN(b.x)]) == gen, bar);
            __builtin_amdgcn_fence(__ATOMIC_ACQUIRE, "agent");
            asm volatile("s_waitcnt vmcnt(0)" ::: "memory");
        }
    }
    __syncthreads();
}

struct P {
    const float *x_prompt, *x_sample, *cache_k, *cache_v, *cache_ik, *state_wkv, *state_shift; const int* page_table;
    const float *c_prompt, *c_sample, *norm_g, *w_ada, *b_ada, *w_up, *w_down, *rw_mix, *rw_w_rkv, *rw_w_o, *rw_w0, *rw_w1, *rw_w2, *rw_a0, *rw_a1, *rw_a2,
                *rw_v0, *rw_v1, *rw_v2, *rw_g1, *rw_g2, *rw_k_k, *rw_k_a, *rw_r_k, *rw_lnx_w, *rw_lnx_b, *att_w_in, *att_w_o, *att_q_norm, *att_k_norm, *idx_k_norm;
    float* out; unsigned char* ws; int ph_lo, ph_hi;
};
typedef const P __attribute__((address_space(4)))* KP;
#define WSP(T, off) ((T*)(p->ws + (off)))
__device__ __forceinline__ KP kargs() { KP k = (KP)__builtin_amdgcn_kernarg_segment_ptr(); asm volatile("" : "+s"(k)); return k; }

namespace pg8 {
constexpr int BM = 256, BK = 64, HALF = 128, HTB = HALF * BK * 2, STAGE_BYTES = 8 * HTB, NXCD = 8, WGM = 8;
__device__ __forceinline__ int lds_byte(int r, int c) { const int st = (r >> 4) * 2 + (c >> 5), rr = r & 15, cc = c & 31, ob = rr * 64 + cc * 2; return st * 1024 + (ob ^ (((ob >> 9) & 1) << 5)); }
__device__ __forceinline__ void stage_rc(int b, int& R, int& C) { const int st = b / 1024, sb = b % 1024, swz = sb ^ (((sb >> 9) & 1) << 5); R = (st >> 1) * 16 + swz / 64; C = (st & 1) * 32 + (swz % 64) / 2; }
__device__ __forceinline__ int perm32(int rho) { const int n = rho >> 4, i = rho & 15; return 8 * (i >> 2) + 4 * n + (i & 3); }
struct Unit { int pm, pn; };
struct Gemm { const bf16_t* A; const bf16_t* Bt; int M, N, K, mode; size_t agrp; };
__device__ __forceinline__ int phys_pn(const Gemm& g, int pn) { return (g.mode == 2 && pn >= 12) ? pn + 1 : pn; }
__device__ __forceinline__ const char* a_ptr(const Gemm& g, const Unit& u, size_t tstep) {
    int grp = 0; if (g.mode) grp = u.pn < 12 ? (u.pn >> 2) : (u.pn == 12 ? 2 : u.pn - 10);
    return (const char*)g.A + (size_t)grp * g.agrp * 2 + (size_t)u.pm * tstep; }
struct StaticOrder {
    int nM, nN, nwg, G, c;
    __device__ void init(int M, int N, int G_, int c_) { nM = M / BM; nN = N / BM; nwg = nM * nN; G = G_; c = c_; }
    __device__ bool next(int i, Unit& u) const {
        const long L = (long)i * G + c; if (L >= nwg) return false;
        int wgid = (int)L; { const int q = nwg / NXCD, r = nwg % NXCD, xcd = wgid % NXCD, off = wgid / NXCD; wgid = (xcd < r ? xcd * (q + 1) : r * (q + 1) + (xcd - r) * q) + off; }
        const int nig = WGM * nN, gid = wgid / nig, fm = gid * WGM, gsz = (nM - fm) < WGM ? (nM - fm) : WGM;
        u.pm = fm + ((wgid % nig) % gsz); u.pn = (wgid % nig) / gsz; return true;
    }
};
template <class F, bool PERM_> struct EpiAdapt {
    static constexpr bool PERM = PERM_;
    F f;
    __device__ __forceinline__ void operator()(const f32x4 (&acc)[2][2][4][2], const Unit& u, int wr, int wc, int fr, int fq) const {
        const int row0 = u.pm * BM + wr * 64 + fr, col0 = u.pn * BM + wc * 32 + (PERM ? 8 * fq : 4 * fq);
#pragma unroll
        for (int ai = 0; ai < 2; ++ai)
#pragma unroll
            for (int m = 0; m < 4; ++m)
#pragma unroll
                for (int bj = 0; bj < 2; ++bj) {
                    if constexpr (PERM) f.vec8(row0 + ai * HALF + m * 16, col0 + bj * HALF, acc[ai][bj][m][0], acc[ai][bj][m][1]);
                    else {
#pragma unroll
                        for (int n = 0; n < 2; ++n) f.vec4(row0 + ai * HALF + m * 16, col0 + bj * HALF + 16 * n, acc[ai][bj][m][n]);
                    }
                }
    }
};

template <class Epi>
__device__ __forceinline__ void gemm_phase(LAS unsigned char* lds, const Gemm g, const StaticOrder& S, const Epi& E) {
    const int tid = TID(), wid = __builtin_amdgcn_readfirstlane(tid >> 6), lane = tid & 63, wr = wid >> 2, wc = wid & 3, fr = lane & 15, fq = lane >> 4;
    const int K = g.K, nt = K / BK;
    unsigned voffA[2], voffB[2];
#pragma unroll
    for (int i = 0; i < 2; ++i) { int R, C; stage_rc(tid * 16 + i * 8192, R, C); const int Rb = Epi::PERM ? ((R & ~31) + perm32(R & 31)) : R;
        voffA[i] = (unsigned)(R * K + C) * 2u; voffB[i] = (unsigned)(Rb * K + C) * 2u; }
    const size_t kstep = (size_t)(BK * 2);
    const size_t hstep = (size_t)HALF * K * 2;
    const size_t tstep = 2 * hstep;
    const unsigned ldsw = (unsigned)wid * 1024u;
    const int aoff = lds_byte(wr * 64 + fr, fq * 8), boff = lds_byte(wc * 32 + fr, fq * 8);
#define PG8_SA(b, h) (((b) * 2 + (h)) * HTB)
#define PG8_SB(b, h) ((4 + (b) * 2 + (h)) * HTB)
#define PG8_STAGE(bufoff, gbase, voff) do { _Pragma("unroll") for (int _i = 0; _i < 2; ++_i) \
        __builtin_amdgcn_global_load_lds((const unsigned*)((const char*)(gbase) + (voff)[_i]), (LAS unsigned*)(lds + (bufoff) + ldsw + _i * 8192), 16, 0, 0); } while (0)
#define PG8_LDA(dst, b, h) do { _Pragma("unroll") for (int m = 0; m < 4; ++m) _Pragma("unroll") for (int k = 0; k < 2; ++k) dst[m][k] = *(const LAS bf16x8*)(lds + PG8_SA(b, h) + aoff + m * 2048 + k * 1024); } while (0)
#define PG8_LDB(dst, b, h) do { _Pragma("unroll") for (int n = 0; n < 2; ++n) _Pragma("unroll") for (int k = 0; k < 2; ++k) dst[n][k] = *(const LAS bf16x8*)(lds + PG8_SB(b, h) + boff + n * 2048 + k * 1024); } while (0)
#define PG8_MMA(ai, bj, At, Bt) do { __builtin_amdgcn_s_setprio(1); _Pragma("unroll") for (int m = 0; m < 4; ++m) _Pragma("unroll") for (int n = 0; n < 2; ++n) _Pragma("unroll") for (int k = 0; k < 2; ++k) \
        acc[ai][bj][m][n] = __builtin_amdgcn_mfma_f32_16x16x32_bf16(Bt[n][k], At[m][k], acc[ai][bj][m][n], 0, 0, 0); __builtin_amdgcn_s_setprio(0); } while (0)
#define PG8_WAIT_V(n) asm volatile("s_waitcnt vmcnt(" #n ")" ::: "memory")
#define PG8_WAIT_L(n) asm volatile("s_waitcnt lgkmcnt(" #n ")" ::: "memory")
#define PG8_BAR __builtin_amdgcn_s_barrier()
#define PG8_SCHED __builtin_amdgcn_sched_barrier(0)
    Unit cur, nxt; int ui = 0;
    if (!S.next(0, cur)) return;
    cur.pn = phys_pn(g, cur.pn);
    f32x4 acc[2][2][4][2];
#pragma unroll
    for (int a = 0; a < 2; ++a)
#pragma unroll
        for (int b = 0; b < 2; ++b)
#pragma unroll
            for (int m = 0; m < 4; ++m)
#pragma unroll
                for (int n = 0; n < 2; ++n) acc[a][b][m][n] = (f32x4){0.f, 0.f, 0.f, 0.f};
    bf16x8 At[4][2], B0[2][2], B1[2][2];
    const char* cA = a_ptr(g, cur, tstep); const char* cB = (const char*)g.Bt + (size_t)cur.pn * tstep;
    PG8_STAGE(PG8_SB(0, 0), cB, voffB); PG8_STAGE(PG8_SA(0, 0), cA, voffA); PG8_STAGE(PG8_SB(0, 1), cB + hstep, voffB); PG8_STAGE(PG8_SA(0, 1), cA + hstep, voffA);
    if (wr == 1) PG8_BAR;
    PG8_WAIT_V(4); PG8_BAR;
    PG8_STAGE(PG8_SB(1, 0), cB + kstep, voffB); PG8_STAGE(PG8_SA(1, 0), cA + kstep, voffA); PG8_STAGE(PG8_SB(1, 1), cB + hstep + kstep, voffB);
    PG8_WAIT_V(6); PG8_BAR;
    for (;;) {
        const bool has_next = S.next(ui + 1, nxt);
        if (has_next) nxt.pn = phys_pn(g, nxt.pn);
        const char* nA = has_next ? a_ptr(g, nxt, tstep) : cA; const char* nB = has_next ? (const char*)g.Bt + (size_t)nxt.pn * tstep : cB;
        for (int t = 0; t < nt; t += 2) {
            const bool last = (t == nt - 2);
            const char* a1 = cA + (size_t)(t + 1) * kstep;
            const char* a2 = last ? nA : cA + (size_t)(t + 2) * kstep; const char* b2 = last ? nB : cB + (size_t)(t + 2) * kstep;
            const char* a3 = a2 + kstep; const char* b3 = b2 + kstep;
            PG8_LDB(B0, 0, 0); PG8_SCHED; PG8_LDA(At, 0, 0); PG8_STAGE(PG8_SA(1, 1), a1 + hstep, voffA);
            PG8_WAIT_L(8); PG8_BAR; PG8_WAIT_L(0); PG8_MMA(0, 0, At, B0); PG8_BAR; PG8_SCHED;
            PG8_LDB(B1, 0, 1); PG8_STAGE(PG8_SB(0, 0), b2, voffB);
            PG8_BAR; PG8_WAIT_L(0); PG8_MMA(0, 1, At, B1); PG8_BAR;
            PG8_LDA(At, 0, 1); PG8_STAGE(PG8_SA(0, 0), a2, voffA);
            PG8_BAR; PG8_WAIT_L(0); PG8_MMA(1, 0, At, B0); PG8_BAR; PG8_SCHED;
            PG8_STAGE(PG8_SB(0, 1), b2 + hstep, voffB);
            PG8_WAIT_V(6); PG8_BAR; PG8_MMA(1, 1, At, B1); PG8_BAR;
            PG8_LDB(B0, 1, 0); PG8_SCHED; PG8_LDA(At, 1, 0); PG8_STAGE(PG8_SA(0, 1), a2 + hstep, voffA);
            PG8_WAIT_L(8); PG8_BAR; PG8_WAIT_L(0); PG8_MMA(0, 0, At, B0); PG8_BAR; PG8_SCHED;
            PG8_LDB(B1, 1, 1); PG8_STAGE(PG8_SB(1, 0), b3, voffB);
            PG8_BAR; PG8_WAIT_L(0); PG8_MMA(0, 1, At, B1); PG8_BAR;
            PG8_LDA(At, 1, 1); PG8_STAGE(PG8_SA(1, 0), a3, voffA);
            PG8_BAR; PG8_WAIT_L(0); PG8_MMA(1, 0, At, B0); PG8_BAR; PG8_SCHED;
            PG8_STAGE(PG8_SB(1, 1), b3 + hstep, voffB);
            PG8_WAIT_V(6); PG8_BAR; PG8_MMA(1, 1, At, B1); PG8_BAR;
        }
        E(acc, cur, wr, wc, fr, fq);
        if (!has_next) break;
#pragma unroll
        for (int a = 0; a < 2; ++a)
#pragma unroll
            for (int b = 0; b < 2; ++b)
#pragma unroll
                for (int m = 0; m < 4; ++m)
#pragma unroll
                    for (int n = 0; n < 2; ++n) acc[a][b][m][n] = (f32x4){0.f, 0.f, 0.f, 0.f};
        cur = nxt; cA = nA; cB = nB; ++ui;
    }
    PG8_WAIT_V(0);
    if (wr == 0) PG8_BAR;
    PG8_BAR;
#undef PG8_SA
#undef PG8_SB
#undef PG8_STAGE
#undef PG8_LDA
#undef PG8_LDB
#undef PG8_MMA
#undef PG8_WAIT_V
#undef PG8_WAIT_L
#undef PG8_BAR
#undef PG8_SCHED
}
}

template <class F>
__device__ __forceinline__ void sgemm_bf(LAS unsigned char* lds, const bf16_t* A, int lda, int row0, int M, const float* W, int ldw, int N, int K, int coloff, const F& f) {
    LAS float* As = (LAS float*)lds;
    LAS float* Ws = (LAS float*)(lds + 32 * 68 * 4);
    const int tid = TID(), ty = tid >> 4, tx = tid & 15;
    const int ntn = (N + 63) / 64, ntiles = (M / 64) * ntn;
    for (int tile = BID(); tile < ntiles; tile += gridDim.x) {
        const int tm = tile / ntn, tn = tile % ntn, r0 = row0 + tm * 64, n0 = tn * 64;
        f32x4 c0 = {0.f, 0.f, 0.f, 0.f}, c1 = {0.f, 0.f, 0.f, 0.f};
        for (int k0 = 0; k0 < K; k0 += 32) {
            __syncthreads();
            { const int r = tid >> 3, q = tid & 7; const f32x4 a = ld_bf4(A + (size_t)(r0 + r) * lda + k0 + 4 * q);
              As[(4 * q + 0) * 68 + r] = a[0]; As[(4 * q + 1) * 68 + r] = a[1]; As[(4 * q + 2) * 68 + r] = a[2]; As[(4 * q + 3) * 68 + r] = a[3]; }
            { const int kr = tid >> 4, c = tid & 15; f32x4 w = {0.f, 0.f, 0.f, 0.f}; if (n0 + 4 * c < N) w = *(const f32x4*)(W + (size_t)(k0 + kr) * ldw + n0 + 4 * c);
              *(LAS f32x4*)(Ws + kr * 68 + 4 * c) = w; }
            __syncthreads();
#pragma unroll 8
            for (int kk = 0; kk < 32; ++kk) {
                const f32x2 a = *(const LAS f32x2*)(As + kk * 68 + 2 * ty); const f32x4 b = *(const LAS f32x4*)(Ws + kk * 68 + 4 * tx);
                c0 += a.x * b; c1 += a.y * b;
            }
        }
        if (n0 + 4 * tx < N) { f.vec4(r0 + 2 * ty, n0 + 4 * tx + coloff, c0); f.vec4(r0 + 2 * ty + 1, n0 + 4 * tx + coloff, c1); }
    }
    __syncthreads();
}

typedef float f32x16 __attribute__((ext_vector_type(16)));
__device__ __forceinline__ int rw_group(int n0) { const int t = n0 >> 8; return t < 12 ? (t >> 2) : (t == 12 ? 2 : t - 10); }
template <bool RWGRP, class F>
__device__ __forceinline__ void wgemm_ks(LAS unsigned char* lds, const bf16_t* A, int lda, size_t agrp, int row0, int M, const bf16_t* Bt, int K, int N, const F& f) {
    const int tid = TID(), wave = tid >> 6, lane = tid & 63, lr = lane & 31, lh = lane >> 5;
    LAS float* red = (LAS float*)lds;
    const int ntn = N / 64, nitems = (M / 32) * ntn, kw = K / 8, steps = kw / 16;
    for (int item = BID(); item < nitems; item += gridDim.x) {
        const int tm = item / ntn, tn = item % ntn, r0 = row0 + tm * 32, n0 = tn * 64;
        const bf16_t* Ab = A + (RWGRP ? (size_t)rw_group(n0) * agrp : 0) + (size_t)(r0 + lr) * lda + wave * kw + lh * 8;
        const bf16_t* B0 = Bt + (size_t)(n0 + lr) * K + wave * kw + lh * 8; const bf16_t* B1 = B0 + (size_t)32 * K;
        f32x16 acc0, acc1;
#pragma unroll
        for (int r = 0; r < 16; ++r) { acc0[r] = 0.f; acc1[r] = 0.f; }
#pragma unroll 8
        for (int st = 0; st < steps; ++st) {
            const bf16x8 a = *(const bf16x8*)(Ab + 16 * st), b0 = *(const bf16x8*)(B0 + 16 * st), b1 = *(const bf16x8*)(B1 + 16 * st);
            acc0 = __builtin_amdgcn_mfma_f32_32x32x16_bf16(b0, a, acc0, 0, 0, 0);
            acc1 = __builtin_amdgcn_mfma_f32_32x32x16_bf16(b1, a, acc1, 0, 0, 0);
        }
        __syncthreads();
#pragma unroll
        for (int r = 0; r < 16; ++r) { red[((wave * 2 + 0) * 16 + r) * 64 + lane] = acc0[r]; red[((wave * 2 + 1) * 16 + r) * 64 + lane] = acc1[r]; }
        __syncthreads();
        { const int t = tid >> 8, r4 = (tid >> 6) & 3, l2 = tid & 63; f32x4 v = {0.f, 0.f, 0.f, 0.f};
#pragma unroll
          for (int w = 0; w < 8; ++w)
#pragma unroll
              for (int e = 0; e < 4; ++e) v[e] += red[((w * 2 + t) * 16 + 4 * r4 + e) * 64 + l2];
          f.vec4(r0 + (l2 & 31), n0 + 32 * t + 8 * r4 + 4 * (l2 >> 5), v); }
    }
    __syncthreads();
}
template <class F>
__device__ __forceinline__ void wgemm_w(const bf16_t* A, int lda, int row0, int M, const bf16_t* Bt, int K, int N, const F& f) {
    const int lane = TID() & 63, lr = lane & 31, lh = lane >> 5, gw = BID() * 8 + (TID() >> 6), nw = gridDim.x * 8;
    const int ntn = N / 64, nitems = (M / 32) * ntn, steps = K / 16;
    for (int item = gw; item < nitems; item += nw) {
        const int tm = item / ntn, tn = item % ntn, r0 = row0 + tm * 32, n0 = tn * 64;
        const bf16_t* Ab = A + (size_t)(r0 + lr) * lda + lh * 8;
        const bf16_t* B0 = Bt + (size_t)(n0 + lr) * K + lh * 8; const bf16_t* B1 = B0 + (size_t)32 * K;
        f32x16 acc0, acc1;
#pragma unroll
        for (int r = 0; r < 16; ++r) { acc0[r] = 0.f; acc1[r] = 0.f; }
        for (int st = 0; st < steps; ++st) {
            const bf16x8 a = *(const bf16x8*)(Ab + 16 * st), b0 = *(const bf16x8*)(B0 + 16 * st), b1 = *(const bf16x8*)(B1 + 16 * st);
            acc0 = __builtin_amdgcn_mfma_f32_32x32x16_bf16(b0, a, acc0, 0, 0, 0);
            acc1 = __builtin_amdgcn_mfma_f32_32x32x16_bf16(b1, a, acc1, 0, 0, 0);
        }
#pragma unroll
        for (int r4 = 0; r4 < 4; ++r4) {
            f.vec4(r0 + lr, n0 + 8 * r4 + 4 * lh, (f32x4){acc0[4 * r4], acc0[4 * r4 + 1], acc0[4 * r4 + 2], acc0[4 * r4 + 3]});
            f.vec4(r0 + lr, n0 + 32 + 8 * r4 + 4 * lh, (f32x4){acc1[4 * r4], acc1[4 * r4 + 1], acc1[4 * r4 + 2], acc1[4 * r4 + 3]});
        }
    }
}

struct FRwkvIn {
    bf16_t *rb, *kb, *vb, *tw, *ta, *tv, *tg;
    __device__ __forceinline__ void vec8(int row, int col, f32x4 a, f32x4 b) const {
        if (col < 3072) { u32x4 w; w.x = pk_bf16(a[0], a[1]); w.y = pk_bf16(a[2], a[3]); w.z = pk_bf16(b[0], b[1]); w.w = pk_bf16(b[2], b[3]);
            *(u32x4*)(rb + (size_t)(col >> 10) * XR_STRIDE + (size_t)row * D + (col & 1023)) = w; }
        else { vec4(row, col, a); vec4(row, col + 4, b); } }
    __device__ __forceinline__ void vec4(int row, int col, f32x4 v) const {
        if (col < 3072) { st_bf4(rb + (size_t)(col >> 10) * XR_STRIDE + (size_t)row * D + (col & 1023), v); }
        else if (col < 3328) { const int c = col - 3072; if (c < 32) st_bf4(tv + (size_t)row * 32 + c, v); }
        else if (col < 3584) { const int c = col - 3328; if (c < 64) { f32x4 t = {ftanh(v[0]), ftanh(v[1]), ftanh(v[2]), ftanh(v[3])}; st_bf4(tw + (size_t)row * 64 + c, t); } }
        else if (col < 3840) { const int c = col - 3584; if (c < 64) st_bf4(ta + (size_t)row * 64 + c, v); }
        else { const int c = col - 3840; if (c < 160) { f32x4 t = {fsig(v[0]), fsig(v[1]), fsig(v[2]), fsig(v[3])}; st_bf4(tg + (size_t)row * 160 + c, t); } }
    }
};
struct FStoreF32 { float* C; int ldc; int ncols; __device__ __forceinline__ void vec4(int row, int col, f32x4 v) const { if (col < ncols) *(f32x4*)(C + (size_t)row * ldc + col) = v; } };
struct FResid {
    float* X; const float* gate;
    const float* xin_p; const float* xin_s;
    __device__ __forceinline__ void vec4(int row, int col, f32x4 v) const {
        const f32x4 g = *(const f32x4*)(gate + (size_t)row_seq(row) * 6144 + col); float* xp = X + (size_t)row * D + col;
        const float* ip = xin_p ? (row < NP ? xin_p + (size_t)row * D + col : xin_s + (size_t)(row - NP) * D + col) : xp;
        const f32x4 x = *(const f32x4*)ip; *(f32x4*)xp = x + g * v; }
};
struct FRelu2 { bf16_t* U;
    __device__ __forceinline__ void vec8(int row, int col, f32x4 a, f32x4 b) const {
        f32x4 s, t; for (int e = 0; e < 4; ++e) { const float x = fmaxf(a[e], 0.f), y = fmaxf(b[e], 0.f); s[e] = x * x; t[e] = y * y; }
        u32x4 w; w.x = pk_bf16(s[0], s[1]); w.y = pk_bf16(s[2], s[3]); w.z = pk_bf16(t[0], t[1]); w.w = pk_bf16(t[2], t[3]); *(u32x4*)(U + (size_t)row * DFF + col) = w; }
    __device__ __forceinline__ void vec4(int row, int col, f32x4 v) const {
        f32x4 t; for (int e = 0; e < 4; ++e) { const float r = fmaxf(v[e], 0.f); t[e] = r * r; } st_bf4(U + (size_t)row * DFF + col, t); } };

__device__ __forceinline__ void phase_copy_x(KP p) {
    const size_t n4p = (size_t)NP * D / 4, n4 = (size_t)NT * D / 4;
    for (size_t i = (size_t)BID() * 512 + TID(); i < n4; i += (size_t)gridDim.x * 512)
        ((f32x4*)p->out)[i] = i < n4p ? ((const f32x4*)p->x_prompt)[i] : ((const f32x4*)p->x_sample)[i - n4p];
}

struct TJob { const float* src; bf16_t* dst; int K, N, drow0; };
__device__ __forceinline__ TJob tjob(KP p, int i) {
    TJob t; t.drow0 = 0;
    if (i < 4) { t.src = p->w_up + (size_t)i * D * DFF; t.dst = WSP(bf16_t, WS_WUP_T) + (size_t)i * DFF * D; t.K = D; t.N = DFF; return t; }
    if (i < 8) { const int l = i - 4; t.src = p->w_down + (size_t)l * DFF * D; t.dst = WSP(bf16_t, WS_WDN_T) + (size_t)l * DFF * D; t.K = DFF; t.N = D; return t; }
    i -= 8; const int j = i / 14, k = i % 14; bf16_t* wrw = WSP(bf16_t, WS_WRW_T) + (size_t)j * 4096 * D;
    t.K = D; t.N = D;
    switch (k) {
        case 0: case 1: case 2: t.src = p->rw_w_rkv + ((size_t)j * 3 + k) * D * D; t.dst = wrw; t.drow0 = k * 1024; break;
        case 3: t.src = p->rw_v1; t.dst = wrw; t.drow0 = 3072; t.N = j == 1 ? 32 : 0; break;
        case 4: t.src = p->rw_w1 + (size_t)j * D * 64; t.dst = wrw; t.drow0 = 3328; t.N = 64; break;
        case 5: t.src = p->rw_a1 + (size_t)j * D * 64; t.dst = wrw; t.drow0 = 3584; t.N = 64; break;
        case 6: t.src = p->rw_g1 + (size_t)j * D * 160; t.dst = wrw; t.drow0 = 3840; t.N = 160; break;
        case 7: t.src = p->rw_w_o + (size_t)j * D * D; t.dst = WSP(bf16_t, WS_WO_T) + (size_t)j * D * D; break;
        case 8: t.src = p->rw_w2 + (size_t)j * 64 * D; t.dst = WSP(bf16_t, WS_W2T) + (size_t)j * D * 64; t.K = 64; break;
        case 9: t.src = p->rw_a2 + (size_t)j * 64 * D; t.dst = WSP(bf16_t, WS_A2T) + (size_t)j * D * 64; t.K = 64; break;
        case 10: t.src = p->rw_g2 + (size_t)j * 160 * D; t.dst = WSP(bf16_t, WS_G2T) + (size_t)j * D * 160; t.K = 160; break;
        case 11: t.src = p->rw_v2; t.dst = WSP(bf16_t, WS_V2T); t.K = 32; t.N = j == 1 ? D : 0; break;
        case 12: t.src = p->att_w_in + (size_t)j * D * PIN; t.dst = WSP(bf16_t, WS_WIN_T) + (size_t)j * PINP * D; t.N = PIN; break;
        default: t.src = p->att_w_o + (size_t)j * D * D; t.dst = WSP(bf16_t, WS_WAO_T) + (size_t)j * D * D; break;
    }
    return t;
}
__device__ __forceinline__ int tjob_tiles(const TJob& t) { return ((t.K + 63) / 64) * ((t.N + 63) / 64); }
__device__ __forceinline__ void phase_weights(KP p, LAS unsigned char* lds) {
    LAS float* T = (LAS float*)lds;
    const int tid = TID();
    int total = 0;
    for (int i = 0; i < 36; ++i) total += tjob_tiles(tjob(p, i));
    const int ngrp = (total + 3) / 4;
    for (int g = BID(); g < ngrp; g += gridDim.x) {
        __syncthreads();
        TJob tj[4]; int k0[4], n0[4];
        { int i = 0, start = 0, cnt = tjob_tiles(tjob(p, 0));
#pragma unroll
          for (int u = 0; u < 4; ++u) { const int gt = 4 * g + u;
              while (i < 35 && gt >= start + cnt) { start += cnt; ++i; cnt = tjob_tiles(tjob(p, i)); }
              tj[u] = tjob(p, i); const int lt = gt - start, nkt = (tj[u].K + 63) / 64;
              if (gt >= total || lt >= cnt) { tj[u] = tjob(p, 0); k0[u] = 1 << 20; n0[u] = 1 << 20; } else { k0[u] = (lt % nkt) * 64; n0[u] = (lt / nkt) * 64; } }
        }
        f32x4 v[4][2];
        const int kk = tid >> 4, n4 = (tid & 15) * 4;
#pragma unroll
        for (int u = 0; u < 4; ++u)
#pragma unroll
            for (int hh = 0; hh < 2; ++hh) { const int k = k0[u] + kk + 32 * hh, n = n0[u] + n4; const bool ok = k < tj[u].K && n < tj[u].N;
                const f32x4 t_ = *(const f32x4*)(tj[u].src + (size_t)min(k, tj[u].K - 1) * tj[u].N + min(n, tj[u].N - 4));
                v[u][hh] = ok ? t_ : (f32x4){0.f, 0.f, 0.f, 0.f}; }
#pragma unroll
        for (int u = 0; u < 4; ++u)
#pragma unroll
            for (int hh = 0; hh < 2; ++hh)
#pragma unroll
                for (int e = 0; e < 4; ++e) T[(u * 64 + kk + 32 * hh) * 65 + n4 + e] = v[u][hh][e];
        __syncthreads();
        const int nn = tid >> 3, k8 = (tid & 7) * 8;
#pragma unroll
        for (int u = 0; u < 4; ++u) {
            if (n0[u] + nn < tj[u].N && k0[u] + k8 < tj[u].K) {
                u32x4 w;
                w.x = pk_bf16(T[(u * 64 + k8 + 0) * 65 + nn], T[(u * 64 + k8 + 1) * 65 + nn]); w.y = pk_bf16(T[(u * 64 + k8 + 2) * 65 + nn], T[(u * 64 + k8 + 3) * 65 + nn]);
                w.z = pk_bf16(T[(u * 64 + k8 + 4) * 65 + nn], T[(u * 64 + k8 + 5) * 65 + nn]); w.w = pk_bf16(T[(u * 64 + k8 + 6) * 65 + nn], T[(u * 64 + k8 + 7) * 65 + nn]);
                *(u32x4*)(tj[u].dst + (size_t)(tj[u].drow0 + n0[u] + nn) * tj[u].K + k0[u] + k8) = w;
            }
        }
    }
    __syncthreads();
}

__device__ __forceinline__ void phase_ada(KP p, LAS unsigned char* lds) {
    float* mods = WSP(float, WS_MODS);
    LAS float* sil = (LAS float*)lds;
    LAS float* red = (LAS float*)(lds + 36864);
    const int tid = TID(), c = tid & 127, ds = tid >> 7;
    for (int item = BID(); item < 192; item += gridDim.x) {
        const int l = item / 48, col = (item % 48) * 128 + c;
        float acc[36];
#pragma unroll
        for (int s = 0; s < 36; ++s) acc[s] = 0.f;
        for (int cc = 0; cc < 4; ++cc) {
            __syncthreads();
            for (int e = tid; e < 4 * 64 * 36; e += 512) { const int s = e % 36, dd = (e / 36) % 64, sl = e / (36 * 64), d = 256 * sl + 64 * cc + dd;
                const float cv = s < 4 ? p->c_prompt[s * D + d] : p->c_sample[(s - 4) * D + d]; sil[e] = cv / (1.0f + expf(-cv)); }
            __syncthreads();
            const float* wp = p->w_ada + ((size_t)l * D + 256 * ds + 64 * cc) * 6144 + col;
            for (int dd = 0; dd < 64; ++dd) {
                const float w = wp[(size_t)dd * 6144];
                const LAS float* sp = sil + (ds * 64 + dd) * 36;
#pragma unroll
                for (int s = 0; s < 36; ++s) acc[s] += sp[s] * w;
            }
        }
        __syncthreads();
#pragma unroll
        for (int s = 0; s < 36; ++s) red[(ds * 128 + c) * 36 + s] = acc[s];
        __syncthreads();
        for (int k = 0; k < 9; ++k) { const int s = 9 * ds + k;
            const float v = red[(0 * 128 + c) * 36 + s] + red[(1 * 128 + c) * 36 + s] + red[(2 * 128 + c) * 36 + s] + red[(3 * 128 + c) * 36 + s];
            mods[((size_t)l * 36 + s) * 6144 + col] = v + p->b_ada[l * 6144 + col]; }
    }
    __syncthreads();
}

template <bool MIX>
__device__ __forceinline__ void phase_prep(KP p, int layer, int which, int j, bool first = false) {
    const float* X = p->out;
    const float* mods = WSP(float, WS_MODS) + (size_t)layer * 36 * 6144;
    const float* g = p->norm_g + (layer * 2 + which) * D;
    bf16_t* XR = WSP(bf16_t, WS_XR);
    const int lane = TID() & 63, gw = BID() * 8 + (TID() >> 6), nw = gridDim.x * 8;
    for (int run = gw; run < NT / 8; run += nw) {
        const int row0 = run * 8, seq = row_seq(row0);
        const float* sh = mods + (size_t)seq * 6144 + (which ? 3 : 0) * D; const float* sc = sh + D;
        f32x4 gv[4], scv[4], shv[4], hp[4];
#pragma unroll
        for (int i = 0; i < 4; ++i) { const int col = 512 * (i >> 1) + 8 * lane + 4 * (i & 1); gv[i] = *(const f32x4*)(g + col); scv[i] = *(const f32x4*)(sc + col) + 1.0f; shv[i] = *(const f32x4*)(sh + col); hp[i] = (f32x4){0.f, 0.f, 0.f, 0.f}; }
        int rstart = 0;
        if (MIX) {
            if (row0 >= NP) {
#pragma unroll
                for (int i = 0; i < 4; ++i) hp[i] = *(const f32x4*)(p->state_shift + ((size_t)j * 32 + (seq - 4)) * D + 512 * (i >> 1) + 8 * lane + 4 * (i & 1));
            } else if ((row0 & 4095) != 0) rstart = -1;
        }
        for (int r = rstart; r < 8; ++r) {
            const int row = row0 + r;
            f32x4 x[4]; float ss = 0.f;
            const float* xr = first ? (row < NP ? p->x_prompt + (size_t)row * D : p->x_sample + (size_t)(row - NP) * D) : X + (size_t)row * D;
#pragma unroll
            for (int i = 0; i < 4; ++i) { x[i] = *(const f32x4*)(xr + 512 * (i >> 1) + 8 * lane + 4 * (i & 1)); ss += x[i][0] * x[i][0] + x[i][1] * x[i][1] + x[i][2] * x[i][2] + x[i][3] * x[i][3]; }
            ss = wave_sum(ss);
            const float rstd = rsqrtf(ss * (1.0f / 1024.0f) + 1e-6f);
            f32x4 h[4];
#pragma unroll
            for (int i = 0; i < 4; ++i) h[i] = x[i] * rstd * gv[i] * scv[i] + shv[i];
            if (MIX) {
                if (r >= 0) {
#pragma unroll
                    for (int n = 0; n < 6; ++n) {
                        const int mi = n == 0 ? 0 : (n == 1 ? 2 : (n == 2 ? 3 : (n == 3 ? 1 : n)));
                        const float* mx = p->rw_mix + ((size_t)j * 6 + mi) * D;
#pragma unroll
                        for (int i2 = 0; i2 < 2; ++i2) { const int col = 512 * i2 + 8 * lane; const f32x4 m0 = *(const f32x4*)(mx + col), m1 = *(const f32x4*)(mx + col + 4);
                            const f32x4 a = h[2 * i2] + (hp[2 * i2] - h[2 * i2]) * m0, b2 = h[2 * i2 + 1] + (hp[2 * i2 + 1] - h[2 * i2 + 1]) * m1;
                            u32x4 w; w.x = pk_bf16(a[0], a[1]); w.y = pk_bf16(a[2], a[3]); w.z = pk_bf16(b2[0], b2[1]); w.w = pk_bf16(b2[2], b2[3]);
                            *(u32x4*)(XR + (size_t)n * XR_STRIDE + (size_t)row * D + col) = w; }
                    }
                    const bool lastp = row < NP && (row & 4095) == 4095, lasts = row >= NP && ((row - NP) & 7) == 7;
                    if (lastp || lasts) {
                        float* so = lastp ? p->out + O_SHP + ((size_t)j * 4 + seq) * D : p->out + O_SHS + ((size_t)j * 32 + (seq - 4)) * D;
#pragma unroll
                        for (int i = 0; i < 4; ++i) *(f32x4*)(so + 512 * (i >> 1) + 8 * lane + 4 * (i & 1)) = h[i];
                    }
                }
#pragma unroll
                for (int i = 0; i < 4; ++i) hp[i] = h[i];
            } else {
#pragma unroll
                for (int i2 = 0; i2 < 2; ++i2) { const f32x4 a = h[2 * i2], b2 = h[2 * i2 + 1]; u32x4 w; w.x = pk_bf16(a[0], a[1]); w.y = pk_bf16(a[2], a[3]); w.z = pk_bf16(b2[0], b2[1]); w.w = pk_bf16(b2[2], b2[3]);
                    *(u32x4*)(XR + (size_t)row * D + 512 * i2 + 8 * lane) = w; }
            }
        }
    }
}

__device__ __forceinline__ void phase_scanprep(KP p, int j) {
    const bf16_t *KB = WSP(bf16_t, WS_KB), *VB = WSP(bf16_t, WS_VB);
    const float *WPp = WSP(float, WS_WP), *APp = WSP(float, WS_AP), *VPp = WSP(float, WS_VP);
    float *VF = WSP(float, WS_VFIRST), *DEC = WSP(float, WS_DEC), *KM = WSP(float, WS_KM), *VM = WSP(float, WS_VM), *AV = WSP(float, WS_AV), *BV = WSP(float, WS_BV);
    const int lane = TID() & 63, gw = BID() * 8 + (TID() >> 6), nw = gridDim.x * 8;
    for (int row = gw; row < NT; row += nw) {
#pragma unroll
        for (int i = 0; i < 4; ++i) {
            const int col = 256 * i + 4 * lane; const size_t o = (size_t)row * D + col;
            const f32x4 k = ld_bf4(KB + o), v = ld_bf4(VB + o), wp = *(const f32x4*)(WPp + o), ap = *(const f32x4*)(APp + o);
            const f32x4 w0 = *(const f32x4*)(p->rw_w0 + j * D + col), a0 = *(const f32x4*)(p->rw_a0 + j * D + col), kkw = *(const f32x4*)(p->rw_k_k + j * D + col), kaw = *(const f32x4*)(p->rw_k_a + j * D + col);
            f32x4 dec, a, vm, kk, km;
#pragma unroll
            for (int e = 0; e < 4; ++e) {
                const float wpre = w0[e] + wp[e], z = -wpre, sp = fmaxf(z, 0.f) + log1pf(expf(-fabsf(z)));
                dec[e] = expf(-expf(-sp - 0.5f));
                a[e] = sigmoidf_(a0[e] + ap[e]);
                kk[e] = k[e] * kkw[e];
                km[e] = k[e] * (1.0f + (a[e] - 1.0f) * kaw[e]);
            }
            if (j == 0) { vm = v; *(f32x4*)(VF + o) = v; }
            else { const f32x4 vf = *(const f32x4*)(VF + o), vp = *(const f32x4*)(VPp + o), v0 = *(const f32x4*)(p->rw_v0 + (j - 1) * D + col);
#pragma unroll
                for (int e = 0; e < 4; ++e) vm[e] = v[e] + (vf[e] - v[e]) * sigmoidf_(v0[e] + vp[e]); }
            float ss = kk[0] * kk[0] + kk[1] * kk[1] + kk[2] * kk[2] + kk[3] * kk[3];
            ss = g16_sum(ss);
            const float inv = rsqrtf(fmaxf(ss, 1e-24f));
            kk = kk * inv;
            *(f32x4*)(DEC + o) = dec; *(f32x4*)(KM + o) = km; *(f32x4*)(VM + o) = vm; *(f32x4*)(AV + o) = -kk; *(f32x4*)(BV + o) = kk * a;
        }
    }
}

__device__ __forceinline__ float rl(float v, int k) { return __int_as_float(__builtin_amdgcn_readlane(__float_as_int(v), k)); }
__device__ __forceinline__ void scan_run(KP p, size_t row_base, int nsteps, int colbase, float (&S)[64]) {
    const float *DEC = WSP(float, WS_DEC), *KM = WSP(float, WS_KM), *VM = WSP(float, WS_VM), *AV = WSP(float, WS_AV), *BV = WSP(float, WS_BV);
    const bf16_t* RB = WSP(bf16_t, WS_RB); float* Y = WSP(float, WS_Y);
    const int lane = TID() & 63;
    size_t o = row_base * D + colbase + lane;
    float w = DEC[o], kx = KM[o], v = VM[o], a = AV[o], b = BV[o], r = bf2f(RB[o]);
    for (int t = 0; t < nsteps; ++t) {
        const size_t on = (t + 1 < nsteps) ? o + D : o;
        const float wn = DEC[on], kn = KM[on], vn = VM[on], an = AV[on], bn = BV[on], rn = bf2f(RB[on]);
        float sa = 0.f;
#pragma unroll
        for (int k = 0; k < 64; ++k) sa += S[k] * rl(a, k);
#pragma unroll
        for (int k = 0; k < 64; ++k) S[k] = S[k] * rl(w, k) + sa * rl(b, k) + v * rl(kx, k);
        float y = 0.f;
#pragma unroll
        for (int k = 0; k < 64; ++k) y += S[k] * rl(r, k);
        Y[o] = y;
        o = on; w = wn; kx = kn; v = vn; a = an; b = bn; r = rn;
    }
}
__device__ __forceinline__ void phase_scanA(KP p) {
    const float *DEC = WSP(float, WS_DEC), *KM = WSP(float, WS_KM), *VM = WSP(float, WS_VM), *AV = WSP(float, WS_AV), *BV = WSP(float, WS_BV);
    float *PCH = WSP(float, WS_PCH), *CCH = WSP(float, WS_CCH);
    const int lane = TID() & 63, gw = BID() * 8 + (TID() >> 6), nw = gridDim.x * 8;
    for (int it = gw; it < 64 * NCH; it += nw) {
        const int sh = it / NCH, c = it % NCH, b = sh >> 4, h = sh & 15;
        float SP[64], SC[64];
#pragma unroll
        for (int k = 0; k < 64; ++k) { SP[k] = (k == lane) ? 1.f : 0.f; SC[k] = 0.f; }
        size_t o = ((size_t)b * 4096 + (size_t)c * LCH) * D + h * 64 + lane;
        float w = DEC[o], kx = KM[o], v = VM[o], a = AV[o], bb = BV[o];
        for (int t = 0; t < LCH; ++t) {
            const size_t on = (t + 1 < LCH) ? o + D : o;
            const float wn = DEC[on], kn = KM[on], vn = VM[on], an = AV[on], bn = BV[on];
            float saP = 0.f, saC = 0.f;
#pragma unroll
            for (int k = 0; k < 64; ++k) { const float ak = rl(a, k); saP += SP[k] * ak; saC += SC[k] * ak; }
#pragma unroll
            for (int k = 0; k < 64; ++k) { const float wk = rl(w, k), bk = rl(bb, k); SP[k] = SP[k] * wk + saP * bk; SC[k] = SC[k] * wk + saC * bk + v * rl(kx, k); }
            o = on; w = wn; kx = kn; v = vn; a = an; bb = bn;
        }
        float* po = PCH + ((size_t)it * 64 + lane) * 64; float* co = CCH + ((size_t)it * 64 + lane) * 64;
#pragma unroll
        for (int k = 0; k < 64; k += 4) { *(f32x4*)(po + k) = (f32x4){SP[k], SP[k + 1], SP[k + 2], SP[k + 3]}; *(f32x4*)(co + k) = (f32x4){SC[k], SC[k + 1], SC[k + 2], SC[k + 3]}; }
    }
}
__device__ __forceinline__ void phase_scanB(KP p, int j, LAS unsigned char* lds) {
    const int tid = TID(), lane = tid & 63, wave = tid >> 6;
    if (BID() < 32) {
        const float *PCH = WSP(float, WS_PCH), *CCH = WSP(float, WS_CCH); float* SST = WSP(float, WS_SST);
        const int sh = BID() * 2 + (wave >> 2), q = wave & 3, row0 = 32 * (q >> 1), col0 = 32 * (q & 1), b = sh >> 4, h = sh & 15;
        LAS float* Sl = (LAS float*)lds + (wave >> 2) * (2 * 64 * 65);
        const int lr = lane & 31, lh = lane >> 5;
        f32x16 acc;
#pragma unroll
        for (int r = 0; r < 16; ++r) acc[r] = 0.f;
        for (int c = 0; c <= NCH; ++c) {
            LAS float* Sw = Sl + (c & 1) * (64 * 65);
            float* go = c < NCH ? SST + ((size_t)sh * NCH + c) * 4096 : p->out + O_WKVP + (((size_t)j * 4 + b) * 16 + h) * 4096;
#pragma unroll
            for (int r = 0; r < 16; ++r) { const int row = row0 + (r & 3) + 8 * (r >> 2) + 4 * lh; Sw[row * 65 + col0 + lr] = acc[r]; go[row * 64 + col0 + lr] = acc[r]; }
            if (c == NCH) break;
            const float* Pc = PCH + ((size_t)sh * NCH + c) * 4096; const float* Cc = CCH + ((size_t)sh * NCH + c) * 4096;
            float bv[32];
#pragma unroll
            for (int kk = 0; kk < 32; ++kk) bv[kk] = Pc[(2 * kk + lh) * 64 + col0 + lr];
#pragma unroll
            for (int r = 0; r < 16; ++r) acc[r] = Cc[(row0 + (r & 3) + 8 * (r >> 2) + 4 * lh) * 64 + col0 + lr];
            __syncthreads();
#pragma unroll
            for (int kk = 0; kk < 32; ++kk) acc = __builtin_amdgcn_mfma_f32_32x32x2f32(Sw[(row0 + lr) * 65 + 2 * kk + lh], bv[kk], acc, 0, 0, 0);
        }
    } else {
        for (int it = (BID() - 32) * 8 + wave; it < 512; it += (gridDim.x - 32) * 8) {
            const int b = it >> 4, h = it & 15;
            const float* s0 = p->state_wkv + (((size_t)j * 32 + b) * 16 + h) * 4096 + lane * 64;
            float S[64];
#pragma unroll
            for (int k = 0; k < 64; k += 4) { const f32x4 t = *(const f32x4*)(s0 + k); S[k] = t[0]; S[k + 1] = t[1]; S[k + 2] = t[2]; S[k + 3] = t[3]; }
            scan_run(p, (size_t)NP + b * 8, 8, h * 64, S);
            float* o = p->out + O_WKVS + (((size_t)j * 32 + b) * 16 + h) * 4096 + lane * 64;
#pragma unroll
            for (int k = 0; k < 64; k += 4) *(f32x4*)(o + k) = (f32x4){S[k], S[k + 1], S[k + 2], S[k + 3]};
        }
    }
    __syncthreads();
}
__device__ __forceinline__ void phase_scanC(KP p) {
    const float* SST = WSP(float, WS_SST);
    const int lane = TID() & 63, gw = BID() * 8 + (TID() >> 6), nw = gridDim.x * 8;
    for (int it = gw; it < 64 * NCH; it += nw) {
        const int sh = it / NCH, c = it % NCH, b = sh >> 4, h = sh & 15;
        const float* s0 = SST + ((size_t)it * 64 + lane) * 64;
        float S[64];
#pragma unroll
        for (int k = 0; k < 64; k += 4) { const f32x4 t = *(const f32x4*)(s0 + k); S[k] = t[0]; S[k + 1] = t[1]; S[k + 2] = t[2]; S[k + 3] = t[3]; }
        scan_run(p, (size_t)b * 4096 + (size_t)c * LCH, LCH, h * 64, S);
    }
}


constexpr int CST = 72;
constexpr int CMAT = 64 * CST * 2;
constexpr int CH_F32 = 11 * CMAT, CH_PART = CH_F32 + 64 * 68 * 4, CH_GL = CH_PART + 64 * 4 * 4;
__device__ __forceinline__ bf16x8 cfrag(const LAS bf16_t* M, int row, int ks, int c4) { return *(const LAS bf16x8*)(M + row * CST + 32 * ks + 8 * c4); }
__device__ __forceinline__ f32x4 cmm(const LAS bf16_t* A, int arow, const LAS bf16_t* B, int brow, int c4, f32x4 acc) {
    acc = __builtin_amdgcn_mfma_f32_16x16x32_bf16(cfrag(A, arow, 0, c4), cfrag(B, brow, 0, c4), acc, 0, 0, 0);
    return __builtin_amdgcn_mfma_f32_16x16x32_bf16(cfrag(A, arow, 1, c4), cfrag(B, brow, 1, c4), acc, 0, 0, 0); }
__device__ __forceinline__ unsigned short f2bf(float x) { return (unsigned short)(pk_bf16(x, 0.f) & 0xffffu); }
__device__ __forceinline__ void st_t4(LAS bf16_t* Mt, int d, int t0, f32x4 v) { u32x2 w; w.x = pk_bf16(v[0], v[1]); w.y = pk_bf16(v[2], v[3]); *(LAS u32x2*)(Mt + d * CST + t0) = w; }

__device__ __forceinline__ void phase_chunk(KP p, int j, LAS unsigned char* lds) {
    LAS bf16_t* Mx = (LAS bf16_t*)lds;
#define CM(i) (Mx + (i) * (64 * CST))
    LAS float* F32 = (LAS float*)(lds + CH_F32);
    asm volatile("" : "+v"(F32));
    LAS float* part = (LAS float*)(lds + CH_PART);
    LAS float* gLs = (LAS float*)(lds + CH_GL);
    const bf16_t *RB = WSP(bf16_t, WS_RB), *KB = WSP(bf16_t, WS_KB), *VB = WSP(bf16_t, WS_VB), *TW = WSP(bf16_t, WS_TW), *TA_ = WSP(bf16_t, WS_TA), *TV = WSP(bf16_t, WS_TV);
    const bf16_t *W2T = WSP(bf16_t, WS_W2T) + (size_t)j * D * 64, *A2T = WSP(bf16_t, WS_A2T) + (size_t)j * D * 64, *V2T = WSP(bf16_t, WS_V2T);
    float* VF = WSP(float, WS_VFIRST); float *PCH = WSP(float, WS_PCH), *CCH = WSP(float, WS_CCH), *Y0 = WSP(float, WS_Y), *BON = WSP(float, WS_AV);
    bf16_t *GM = WSP(bf16_t, WS_DEC), *VM2 = WSP(bf16_t, WS_KM);
#define CH_BAR() do { asm volatile("s_waitcnt lgkmcnt(0)" ::: "memory"); __builtin_amdgcn_s_barrier(); asm volatile("" ::: "memory"); } while (0)
    bf16x8 f_aw[2], f_aa[2], f_av; unsigned short e_k[2][4], e_v[2][4], e_r[2][4];
    f_av = (bf16x8){0, 0, 0, 0, 0, 0, 0, 0};
#define CH_PREFETCH(itx) do { const int tid_ = TID(), lane_ = tid_ & 63, w_ = tid_ >> 6, n_ = lane_ & 15, c4_ = lane_ >> 4, tr_ = w_ >> 1, tcb_ = 2 * (w_ & 1); \
        const int sh_ = (itx) / NCH, c_ = (itx) % NCH, R0_ = (sh_ >> 4) * 4096 + c_ * LCH, hc_ = (sh_ & 15) * 64; const int ar_ = 16 * tr_ + n_; \
        _Pragma("unroll") for (int ks = 0; ks < 2; ++ks) { f_aw[ks] = *(const bf16x8*)(TW + (size_t)R0_ * 64 + ar_ * 64 + 32 * ks + 8 * c4_); f_aa[ks] = *(const bf16x8*)(TA_ + (size_t)R0_ * 64 + ar_ * 64 + 32 * ks + 8 * c4_); } \
        if (j == 1) f_av = *(const bf16x8*)(TV + (size_t)R0_ * 32 + ar_ * 32 + 8 * c4_); \
        _Pragma("unroll") for (int ti = 0; ti < 2; ++ti) _Pragma("unroll") for (int r = 0; r < 4; ++r) { const size_t o_ = (size_t)R0_ * D + hc_ + (16 * tr_ + 4 * c4_ + r) * D + 16 * (tcb_ + ti) + n_; \
            e_k[ti][r] = KB[o_]; e_v[ti][r] = VB[o_]; e_r[ti][r] = RB[o_]; } } while (0)
    if (BID() < 64 * NCH) CH_PREFETCH(BID());
    for (int it = BID(); it < 64 * NCH; it += gridDim.x) {
        const int tid = TID(), lane = tid & 63, w = tid >> 6, n = lane & 15, c4 = lane >> 4, tr = w >> 1, tcb = 2 * (w & 1);
        const int sh = it / NCH, c = it % NCH, b = sh >> 4, h = sh & 15, R0 = b * 4096 + c * LCH, hc = h * 64;
        const bf16_t *KBb = KB + (size_t)R0 * D + hc, *VBb = VB + (size_t)R0 * D + hc, *RBb = RB + (size_t)R0 * D + hc;
        float* VFb = VF + (size_t)R0 * D + hc; bf16_t* VM2b = VM2 + (size_t)R0 * D + hc; bf16_t* GMb = GM + (size_t)R0 * D + hc; float* Y0b = Y0 + (size_t)R0 * D + hc;
        float* PCb = PCH + (size_t)it * 4096; float* CCb = CCH + (size_t)it * 4096; float* BONb = BON + (size_t)R0 * 16 + h;
        const bf16_t *TWb = TW + (size_t)R0 * 64, *TAb = TA_ + (size_t)R0 * 64, *TVb = TV + (size_t)R0 * 32, *W2b = W2T + (size_t)hc * 64, *A2b = A2T + (size_t)hc * 64, *V2b = V2T + (size_t)hc * 32;
        const float *w0b = p->rw_w0 + j * D + hc, *a0b = p->rw_a0 + j * D + hc, *kkb = p->rw_k_k + j * D + hc, *kab = p->rw_k_a + j * D + hc, *rkb = p->rw_r_k + j * D + hc, *v0b = p->rw_v0 + (j ? (j - 1) : 0) * D + hc;
        f32x4 wp[2], ap[2], vp[2];
#pragma unroll
        for (int ti = 0; ti < 2; ++ti) { wp[ti] = (f32x4){0.f, 0.f, 0.f, 0.f}; ap[ti] = wp[ti]; vp[ti] = wp[ti]; }
        {   const int ar = 16 * tr + n;
#pragma unroll
            for (int ks = 0; ks < 2; ++ks) {
                const bf16x8 aw = f_aw[ks], aa = f_aa[ks];
#pragma unroll
                for (int ti = 0; ti < 2; ++ti) { const int br = 16 * (tcb + ti) + n;
                    wp[ti] = __builtin_amdgcn_mfma_f32_16x16x32_bf16(aw, *(const bf16x8*)(W2b + br * 64 + 32 * ks + 8 * c4), wp[ti], 0, 0, 0);
                    ap[ti] = __builtin_amdgcn_mfma_f32_16x16x32_bf16(aa, *(const bf16x8*)(A2b + br * 64 + 32 * ks + 8 * c4), ap[ti], 0, 0, 0); }
            }
            if (j == 1) { const bf16x8 av = f_av;
#pragma unroll
                for (int ti = 0; ti < 2; ++ti) vp[ti] = __builtin_amdgcn_mfma_f32_16x16x32_bf16(av, *(const bf16x8*)(V2b + (16 * (tcb + ti) + n) * 32 + 8 * c4), vp[ti], 0, 0, 0); }
        }
        f32x4 lw[2], asg[2], kkv[2], kpr[2], vpr[2], rr[2];
        float ssq[4] = {0.f, 0.f, 0.f, 0.f}, bon[4] = {0.f, 0.f, 0.f, 0.f};
        float vf8[2][4];
#pragma unroll
        for (int ti = 0; ti < 2; ++ti)
#pragma unroll
            for (int r = 0; r < 4; ++r) vf8[ti][r] = 0.f;
        if (j == 1) {
#pragma unroll
            for (int ti = 0; ti < 2; ++ti)
#pragma unroll
                for (int r = 0; r < 4; ++r) vf8[ti][r] = VFb[(16 * tr + 4 * c4 + r) * D + 16 * (tcb + ti) + n];
        }
#pragma unroll
        for (int ti = 0; ti < 2; ++ti) {
            const int d = 16 * (tcb + ti) + n;
            const float w0 = w0b[d], a0 = a0b[d], kkw = kkb[d], kaw = kab[d], rkw = rkb[d];
            const float v0 = j ? v0b[d] : 0.f;
#pragma unroll
            for (int r = 0; r < 4; ++r) {
                const int o = (16 * tr + 4 * c4 + r) * D + d;
                const float kx = bf2f(e_k[ti][r]), vx = bf2f(e_v[ti][r]), rx = bf2f(e_r[ti][r]);
                const float z = -(w0 + wp[ti][r]), sp = fmaxf(z, 0.f) + __logf(1.0f + __expf(-fabsf(z)));
                lw[ti][r] = -__expf(-sp - 0.5f);
                const float a = fsig(a0 + ap[ti][r]);
                asg[ti][r] = a;
                float vv = vx;
                if (j == 0) VFb[o] = vx; else { const float vf = vf8[ti][r]; vv = vx + (vf - vx) * fsig(v0 + vp[ti][r]); }
                vpr[ti][r] = vv; rr[ti][r] = rx;
                const float kk = kx * kkw; kkv[ti][r] = kk; ssq[r] += kk * kk;
                const float kp = kx * (1.0f + (a - 1.0f) * kaw); kpr[ti][r] = kp; bon[r] += rx * kp * rkw;
                F32[(16 * tr + 4 * c4 + r) * 68 + d] = lw[ti][r];
                VM2b[o] = f2bf(vv);
            }
        }
#pragma unroll
        for (int r = 0; r < 4; ++r) { ssq[r] = g16_sum(ssq[r]); bon[r] = g16_sum(bon[r]); }
        if (n == 0) {
#pragma unroll
            for (int r = 0; r < 4; ++r) { const int t = 16 * tr + 4 * c4 + r; part[(t * 2 + (w & 1)) * 2 + 0] = ssq[r]; part[(t * 2 + (w & 1)) * 2 + 1] = bon[r]; }
        }
        if (it + (int)gridDim.x < 64 * NCH) CH_PREFETCH(it + (int)gridDim.x);
        CH_BAR();
        f32x4 cs[2];
#pragma unroll
        for (int ti = 0; ti < 2; ++ti) {
            f32x4 acc = {0.f, 0.f, 0.f, 0.f};
            for (int q = 0; q < 4 * (tr + 1); ++q) {
                const float av = (4 * q + c4 <= 16 * tr + n) ? 1.0f : 0.0f;
                acc = __builtin_amdgcn_mfma_f32_16x16x4f32(av, F32[(4 * q + c4) * 68 + 16 * (tcb + ti) + n], acc, 0, 0, 0);
            }
            cs[ti] = acc;
        }
        float inv[4];
#pragma unroll
        for (int r = 0; r < 4; ++r) { const int t = 16 * tr + 4 * c4 + r; inv[r] = rsqrtf(fmaxf(part[(t * 2 + 0) * 2] + part[(t * 2 + 1) * 2], 1e-24f));
            if (n == 0 && (w & 1) == 0) BONb[t * 16] = part[(t * 2 + 0) * 2 + 1] + part[(t * 2 + 1) * 2 + 1]; }
        f32x4 rt[2];
#pragma unroll
        for (int ti = 0; ti < 2; ++ti) {
            const int d = 16 * (tcb + ti) + n, t0 = 16 * tr + 4 * c4;
            f32x4 at, bt, kt;
#pragma unroll
            for (int r = 0; r < 4; ++r) {
                const float g = __expf(cs[ti][r]), gi = __expf(-cs[ti][r]), gm = __expf(cs[ti][r] - lw[ti][r]);
                const float kk = kkv[ti][r] * inv[r];
                at[r] = -kk * gm; bt[r] = kk * asg[ti][r] * gi; kt[r] = kpr[ti][r] * gi; rt[ti][r] = rr[ti][r] * g;
                CM(0)[(t0 + r) * CST + d] = f2bf(at[r]); CM(1)[(t0 + r) * CST + d] = f2bf(bt[r]); CM(2)[(t0 + r) * CST + d] = f2bf(kt[r]); CM(3)[(t0 + r) * CST + d] = f2bf(rt[ti][r]);
                if (t0 + r == 63) gLs[d] = g;
            }
            st_t4(CM(4), d, t0, at); st_t4(CM(5), d, t0, bt); st_t4(CM(6), d, t0, kt); st_t4(CM(7), d, t0, vpr[ti]);
        }
        CH_BAR();
#pragma unroll
        for (int ti = 0; ti < 2; ++ti) {
            const int tc = tcb + ti, s = 16 * tc + n, t0 = 16 * tr + 4 * c4;
            if (tc <= tr) {
                { f32x4 m = {0.f, 0.f, 0.f, 0.f}; m = cmm(CM(0), 16 * tr + n, CM(1), 16 * tc + n, c4, m);
#pragma unroll
                  for (int r = 0; r < 4; ++r) F32[(t0 + r) * 68 + s] = (s < t0 + r) ? m[r] : 0.f; }
                asm volatile("" ::: "memory");
                { f32x4 m = {0.f, 0.f, 0.f, 0.f}; m = cmm(CM(0), 16 * tr + n, CM(2), 16 * tc + n, c4, m);
#pragma unroll
                  for (int r = 0; r < 4; ++r) CM(8)[(t0 + r) * CST + s] = f2bf((s < t0 + r) ? m[r] : 0.f); }
                asm volatile("" ::: "memory");
                { f32x4 m = {0.f, 0.f, 0.f, 0.f}; m = cmm(CM(3), 16 * tr + n, CM(1), 16 * tc + n, c4, m);
#pragma unroll
                  for (int r = 0; r < 4; ++r) CM(9)[(t0 + r) * CST + s] = f2bf((s <= t0 + r) ? m[r] : 0.f); }
                asm volatile("" ::: "memory");
                { f32x4 m = {0.f, 0.f, 0.f, 0.f}; m = cmm(CM(3), 16 * tr + n, CM(2), 16 * tc + n, c4, m);
#pragma unroll
                  for (int r = 0; r < 4; ++r) CM(10)[(t0 + r) * CST + s] = f2bf((s <= t0 + r) ? m[r] : 0.f); }
                asm volatile("" ::: "memory");
            } else {
#pragma unroll
                for (int r = 0; r < 4; ++r) { F32[(t0 + r) * 68 + s] = 0.f; CM(8)[(t0 + r) * CST + s] = 0; CM(9)[(t0 + r) * CST + s] = 0; CM(10)[(t0 + r) * CST + s] = 0; }
            }
        }
        CH_BAR();
        { const int e0 = tid * 8;
#pragma unroll
          for (int e = 0; e < 8; ++e) { const int t = (e0 + e) >> 6, s_ = (e0 + e) & 63; CM(2)[t * CST + s_] = f2bf(F32[t * 68 + s_]); }
          unsigned z_ = 0u; asm volatile("" : "+v"(z_));
          *(LAS u32x4*)(CM(0) + (e0 >> 6) * CST + (e0 & 63)) = (u32x4){z_, z_, z_, z_}; }
        CH_BAR();
        if (w < 4) {
            const int cw = 16 * w;
            LAS float* scr = (LAS float*)CM(1) + w * (16 * 17);
#pragma unroll 1
            for (int I = 0; I < 4; ++I) {
                f32x4 rh = {0.f, 0.f, 0.f, 0.f};
                if (I > 0) { rh = __builtin_amdgcn_mfma_f32_16x16x32_bf16(cfrag(CM(2), 16 * I + n, 0, c4), cfrag(CM(0), cw + n, 0, c4), rh, 0, 0, 0);
                    if (I > 2) rh = __builtin_amdgcn_mfma_f32_16x16x32_bf16(cfrag(CM(2), 16 * I + n, 1, c4), cfrag(CM(0), cw + n, 1, c4), rh, 0, 0, 0); }
#pragma unroll
                for (int r = 0; r < 4; ++r) scr[(4 * c4 + r) * 17 + n] = rh[r] + ((16 * I + 4 * c4 + r) == (cw + n) ? 1.f : 0.f);
                wave_lds_fence();
                float x[16];
#pragma unroll
                for (int i = 0; i < 16; ++i) x[i] = scr[i * 17 + n];
                f32x4 mc[4], mn[4];
                mc[0] = *(const LAS f32x4*)(F32 + (16 * I + 1) * 68 + 16 * I);
#pragma unroll
                for (int i = 1; i < 16; ++i) {
                    if (i + 1 < 16) {
#pragma unroll
                        for (int j4 = 0; j4 < (i + 4) / 4; ++j4) mn[j4] = *(const LAS f32x4*)(F32 + (16 * I + i + 1) * 68 + 16 * I + 4 * j4);
                    }
                    float a0 = 0.f, a1 = 0.f;
#pragma unroll
                    for (int j4 = 0; j4 < (i + 3) / 4; ++j4) {
                        if (4 * j4 + 0 < i) a0 += mc[j4][0] * x[4 * j4 + 0];
                        if (4 * j4 + 1 < i) a1 += mc[j4][1] * x[4 * j4 + 1];
                        if (4 * j4 + 2 < i) a0 += mc[j4][2] * x[4 * j4 + 2];
                        if (4 * j4 + 3 < i) a1 += mc[j4][3] * x[4 * j4 + 3];
                    }
                    x[i] += a0 + a1;
#pragma unroll
                    for (int j4 = 0; j4 < 4; ++j4) mc[j4] = mn[j4];
                    asm volatile("" ::: "memory");
                }
                if (c4 == 0) {
#pragma unroll
                    for (int i = 0; i < 16; ++i) CM(3)[(16 * I + i) * CST + cw + n] = f2bf(x[i]);
                    u32x4 t0, t1;
                    t0.x = pk_bf16(x[0], x[1]); t0.y = pk_bf16(x[2], x[3]); t0.z = pk_bf16(x[4], x[5]); t0.w = pk_bf16(x[6], x[7]);
                    t1.x = pk_bf16(x[8], x[9]); t1.y = pk_bf16(x[10], x[11]); t1.z = pk_bf16(x[12], x[13]); t1.w = pk_bf16(x[14], x[15]);
                    *(LAS u32x4*)(CM(0) + (cw + n) * CST + 16 * I) = t0; *(LAS u32x4*)(CM(0) + (cw + n) * CST + 16 * I + 8) = t1;
                }
                wave_lds_fence();
            }
        }
        CH_BAR();
#pragma unroll
        for (int ti = 0; ti < 2; ++ti) {
            const int d = 16 * (tcb + ti) + n;
            { f32x4 x1 = {0.f, 0.f, 0.f, 0.f}; x1 = cmm(CM(8), 16 * tr + n, CM(7), 16 * (tcb + ti) + n, c4, x1); st_t4(CM(0), d, 16 * tr + 4 * c4, x1); }
            asm volatile("" ::: "memory");
            { f32x4 ta = {0.f, 0.f, 0.f, 0.f}; ta = cmm(CM(3), 16 * tr + n, CM(4), 16 * (tcb + ti) + n, c4, ta); st_t4(CM(1), d, 16 * tr + 4 * c4, ta); }
            asm volatile("" ::: "memory");
        }
        CH_BAR();
#pragma unroll
        for (int ti = 0; ti < 2; ++ti) {
            f32x4 uv = {0.f, 0.f, 0.f, 0.f};
            uv = cmm(CM(3), 16 * tr + n, CM(0), 16 * (tcb + ti) + n, c4, uv);
            st_t4(CM(2), 16 * (tcb + ti) + n, 16 * tr + 4 * c4, uv);
        }
        CH_BAR();
#pragma unroll
        for (int ti = 0; ti < 2; ++ti) {
            const int cc = 16 * (tcb + ti) + n, r0 = 16 * tr + 4 * c4;
            const float gl = gLs[cc];
            { f32x4 pm = {0.f, 0.f, 0.f, 0.f}; pm = cmm(CM(1), 16 * tr + n, CM(5), cc, c4, pm);
#pragma unroll
              for (int r = 0; r < 4; ++r) PCb[(r0 + r) * 64 + cc] = (pm[r] + ((r0 + r) == cc ? 1.f : 0.f)) * gl; }
            asm volatile("" ::: "memory");
            { f32x4 cm_ = {0.f, 0.f, 0.f, 0.f}; cm_ = cmm(CM(2), 16 * tr + n, CM(5), cc, c4, cm_); cm_ = cmm(CM(7), 16 * tr + n, CM(6), cc, c4, cm_);
#pragma unroll
              for (int r = 0; r < 4; ++r) CCb[(r0 + r) * 64 + cc] = cm_[r] * gl; }
            asm volatile("" ::: "memory");
            { f32x4 gg = {0.f, 0.f, 0.f, 0.f}; gg = cmm(CM(9), 16 * tr + n, CM(1), cc, c4, gg);
#pragma unroll
              for (int r = 0; r < 4; ++r) GMb[(r0 + r) * D + cc] = f2bf(gg[r] + rt[ti][r]); }
            asm volatile("" ::: "memory");
            { f32x4 y0 = {0.f, 0.f, 0.f, 0.f}; y0 = cmm(CM(9), 16 * tr + n, CM(2), cc, c4, y0); y0 = cmm(CM(10), 16 * tr + n, CM(7), cc, c4, y0);
#pragma unroll
              for (int r = 0; r < 4; ++r) Y0b[(r0 + r) * D + cc] = y0[r]; }
            asm volatile("" ::: "memory");
        }
        CH_BAR();
    }
#undef CM
#undef CH_PREFETCH
#undef CH_BAR
}

__device__ __forceinline__ void phase_sample_mixer_w(KP p, int j, int first, int stride) {
    const int tid = TID(), lane = tid & 63;
    {
        const bf16_t *RB = WSP(bf16_t, WS_RB), *KB = WSP(bf16_t, WS_KB), *VB = WSP(bf16_t, WS_VB); bf16_t* YG = WSP(bf16_t, WS_YG);
        const float *WPp = WSP(float, WS_WP), *APp = WSP(float, WS_AP), *VPp = WSP(float, WS_VP), *GG = WSP(float, WS_GG); float* VF = WSP(float, WS_VFIRST);
        for (int it = first; it < 512; it += stride) {
            const int b = it >> 4, h = it & 15, col = h * 64 + lane;
            const float* s0 = p->state_wkv + (((size_t)j * 32 + b) * 16 + h) * 4096 + lane * 64;
            float S[64];
#pragma unroll
            for (int k = 0; k < 64; k += 4) { const f32x4 t = *(const f32x4*)(s0 + k); S[k] = t[0]; S[k + 1] = t[1]; S[k + 2] = t[2]; S[k + 3] = t[3]; }
            const float w0 = p->rw_w0[j * D + col], a0 = p->rw_a0[j * D + col], kkw = p->rw_k_k[j * D + col], kaw = p->rw_k_a[j * D + col], rkw = p->rw_r_k[j * D + col];
            const float v0 = j ? p->rw_v0[(j - 1) * D + col] : 0.f, lnw = p->rw_lnx_w[j * D + col], lnb = p->rw_lnx_b[j * D + col];
            for (int t = 0; t < 8; ++t) {
                const size_t o = (size_t)(NP + b * 8 + t) * D + col;
                const float kx = bf2f(KB[o]), vx = bf2f(VB[o]), r = bf2f(RB[o]);
                const float z = -(w0 + WPp[o]), sp = fmaxf(z, 0.f) + log1pf(expf(-fabsf(z)));
                const float wd = expf(-expf(-sp - 0.5f)), asg = sigmoidf_(a0 + APp[o]);
                float v = vx;
                if (j == 0) VF[o] = vx; else { const float vf = VF[o]; v = vx + (vf - vx) * sigmoidf_(v0 + VPp[o]); }
                float kk = kx * kkw; const float ss = wave_sum(kk * kk); kk *= rsqrtf(fmaxf(ss, 1e-24f));
                const float kp = kx * (1.0f + (asg - 1.0f) * kaw), a = -kk, bq = kk * asg;
                float sa = 0.f;
#pragma unroll
                for (int k = 0; k < 64; ++k) sa += S[k] * rl(a, k);
#pragma unroll
                for (int k = 0; k < 64; ++k) S[k] = S[k] * rl(wd, k) + sa * rl(bq, k) + v * rl(kp, k);
                float y = 0.f;
#pragma unroll
                for (int k = 0; k < 64; ++k) y += S[k] * rl(r, k);
                const float mu = wave_sum(y) * (1.0f / 64.0f), dy = y - mu, var = wave_sum(dy * dy) * (1.0f / 64.0f);
                const float bonus = wave_sum(r * kp * rkw);
                YG[o] = f2bf((dy * rsqrtf(var + 64e-5f) * lnw + lnb + bonus * v) * GG[o]);
            }
            float* so = p->out + O_WKVS + (((size_t)j * 32 + b) * 16 + h) * 4096 + lane * 64;
#pragma unroll
            for (int k = 0; k < 64; k += 4) *(f32x4*)(so + k) = (f32x4){S[k], S[k + 1], S[k + 2], S[k + 3]};
        }
    }
}
__device__ __forceinline__ void phase_carry(KP p, int j, LAS unsigned char* lds) {
    const float *PCH = WSP(float, WS_PCH), *CCH = WSP(float, WS_CCH); float* SST = WSP(float, WS_SST);
    LAS float* Sl = (LAS float*)lds;
    LAS unsigned* cflag = (LAS unsigned*)(lds + 9216);
    if (TID() == 0) *cflag = 0u;
    __syncthreads();
    unsigned arrivals = 0u;
    if ((TID() >> 6) >= 4) { phase_sample_mixer_w(p, j, BID() * 4 + ((TID() >> 6) - 4), (int)gridDim.x * 4); }
    else
    for (int it = BID(); it < 256; it += gridDim.x) {
        const int wave = TID() >> 6, sh = it >> 2, row0 = 16 * (it & 3), col0 = 16 * (wave & 3), b = sh >> 4, h = sh & 15;
        const bool act = true;
        f32x4 acc = {0.f, 0.f, 0.f, 0.f}, c0, c1, c2;
        float b0[16], b1[16], b2[16];
#define CARRY_LOAD(BX, CX, cc_) do { const int l_ = TID() & 63, ln = l_ & 15, lq = l_ >> 4; \
            const float* Pc = PCH + ((size_t)sh * NCH + (cc_)) * 4096; const float* Cc = CCH + ((size_t)sh * NCH + (cc_)) * 4096; \
            _Pragma("unroll") for (int q = 0; q < 16; ++q) BX[q] = Pc[(4 * q + lq) * 64 + col0 + ln]; \
            _Pragma("unroll") for (int r = 0; r < 4; ++r) CX[r] = Cc[(row0 + 4 * lq + r) * 64 + col0 + ln]; } while (0)
#define CARRY_STEP(BX, CX, BL, CL, c_) do { const int l_ = TID() & 63, ln = l_ & 15, lq = l_ >> 4; \
            LAS float* Sw = Sl + ((c_) & 1) * (16 * 68); float* go = SST + ((size_t)sh * NCH + (c_)) * 4096; \
            if (act) { _Pragma("unroll") for (int r = 0; r < 4; ++r) Sw[(4 * lq + r) * 68 + col0 + ln] = acc[r]; } \
            const f32x4 sc = acc; acc = CX; \
            asm volatile("s_waitcnt lgkmcnt(0)" ::: "memory"); arrivals += 4u; \
            if ((TID() & 63) == 0) __hip_atomic_fetch_add(cflag, 1u, __ATOMIC_RELAXED, __HIP_MEMORY_SCOPE_WORKGROUP); \
            { unsigned sp_ = 0; while (__builtin_amdgcn_readfirstlane(__hip_atomic_load(cflag, __ATOMIC_RELAXED, __HIP_MEMORY_SCOPE_WORKGROUP)) < arrivals && ++sp_ < (1u << 22)) __builtin_amdgcn_s_sleep(0); } \
            asm volatile("" ::: "memory"); \
            if (act) { \
                _Pragma("unroll") for (int r = 0; r < 4; ++r) go[(row0 + 4 * lq + r) * 64 + col0 + ln] = sc[r]; \
                if ((c_) + 2 < NCH) CARRY_LOAD(BL, CL, (c_) + 2); \
                float av[16]; _Pragma("unroll") for (int q = 0; q < 16; ++q) av[q] = Sw[ln * 68 + 4 * q + lq]; \
                asm volatile("s_waitcnt lgkmcnt(0)" ::: "memory"); \
                _Pragma("unroll") for (int q = 0; q < 16; ++q) acc = __builtin_amdgcn_mfma_f32_16x16x4f32(av[q], BX[q], acc, 0, 0, 0); } } while (0)
        if (act) { CARRY_LOAD(b0, c0, 0); CARRY_LOAD(b1, c1, 1); }
        for (int c = 0; c < NCH; c += 3) {
            CARRY_STEP(b0, c0, b2, c2, c);
            if (c + 1 < NCH) CARRY_STEP(b1, c1, b0, c0, c + 1);
            if (c + 2 < NCH) CARRY_STEP(b2, c2, b1, c1, c + 2);
        }
        if (act) { const int l_ = TID() & 63, ln = l_ & 15, lq = l_ >> 4; float* go = p->out + O_WKVP + (((size_t)j * 4 + b) * 16 + h) * 4096;
#pragma unroll
            for (int r = 0; r < 4; ++r) go[(row0 + 4 * lq + r) * 64 + col0 + ln] = acc[r]; }
#undef CARRY_LOAD
#undef CARRY_STEP
    }
    __syncthreads();
}
__device__ __forceinline__ void phase_sample_mixer(KP p, int j) {
    const int tid = TID(), lane = tid & 63, wave = tid >> 6;
    {
        const bf16_t *RB = WSP(bf16_t, WS_RB), *KB = WSP(bf16_t, WS_KB), *VB = WSP(bf16_t, WS_VB); bf16_t* YG = WSP(bf16_t, WS_YG);
        const float *WPp = WSP(float, WS_WP), *APp = WSP(float, WS_AP), *VPp = WSP(float, WS_VP), *GG = WSP(float, WS_GG); float* VF = WSP(float, WS_VFIRST);
        for (int it = BID() * 8 + wave; it < 512; it += gridDim.x * 8) {
            const int b = it >> 4, h = it & 15, col = h * 64 + lane;
            const float* s0 = p->state_wkv + (((size_t)j * 32 + b) * 16 + h) * 4096 + lane * 64;
            float S[64];
#pragma unroll
            for (int k = 0; k < 64; k += 4) { const f32x4 t = *(const f32x4*)(s0 + k); S[k] = t[0]; S[k + 1] = t[1]; S[k + 2] = t[2]; S[k + 3] = t[3]; }
            const float w0 = p->rw_w0[j * D + col], a0 = p->rw_a0[j * D + col], kkw = p->rw_k_k[j * D + col], kaw = p->rw_k_a[j * D + col], rkw = p->rw_r_k[j * D + col];
            const float v0 = j ? p->rw_v0[(j - 1) * D + col] : 0.f, lnw = p->rw_lnx_w[j * D + col], lnb = p->rw_lnx_b[j * D + col];
            for (int t = 0; t < 8; ++t) {
                const size_t o = (size_t)(NP + b * 8 + t) * D + col;
                const float kx = bf2f(KB[o]), vx = bf2f(VB[o]), r = bf2f(RB[o]);
                const float z = -(w0 + WPp[o]), sp = fmaxf(z, 0.f) + log1pf(expf(-fabsf(z)));
                const float wd = expf(-expf(-sp - 0.5f)), asg = sigmoidf_(a0 + APp[o]);
                float v = vx;
                if (j == 0) VF[o] = vx; else { const float vf = VF[o]; v = vx + (vf - vx) * sigmoidf_(v0 + VPp[o]); }
                float kk = kx * kkw; const float ss = wave_sum(kk * kk); kk *= rsqrtf(fmaxf(ss, 1e-24f));
                const float kp = kx * (1.0f + (asg - 1.0f) * kaw), a = -kk, bq = kk * asg;
                float sa = 0.f;
#pragma unroll
                for (int k = 0; k < 64; ++k) sa += S[k] * rl(a, k);
#pragma unroll
                for (int k = 0; k < 64; ++k) S[k] = S[k] * rl(wd, k) + sa * rl(bq, k) + v * rl(kp, k);
                float y = 0.f;
#pragma unroll
                for (int k = 0; k < 64; ++k) y += S[k] * rl(r, k);
                const float mu = wave_sum(y) * (1.0f / 64.0f), dy = y - mu, var = wave_sum(dy * dy) * (1.0f / 64.0f);
                const float bonus = wave_sum(r * kp * rkw);
                YG[o] = f2bf((dy * rsqrtf(var + 64e-5f) * lnw + lnb + bonus * v) * GG[o]);
            }
            float* so = p->out + O_WKVS + (((size_t)j * 32 + b) * 16 + h) * 4096 + lane * 64;
#pragma unroll
            for (int k = 0; k < 64; k += 4) *(f32x4*)(so + k) = (f32x4){S[k], S[k + 1], S[k + 2], S[k + 3]};
        }
    }
}
__device__ __forceinline__ void phase_post2(KP p, int j, LAS unsigned char* lds) {
    LAS float* part = (LAS float*)lds;
    const bf16_t *GM = WSP(bf16_t, WS_DEC), *VM2 = WSP(bf16_t, WS_KM), *TG = WSP(bf16_t, WS_TG), *G2T = WSP(bf16_t, WS_G2T) + (size_t)j * D * 160;
    const float *Y0 = WSP(float, WS_Y), *BON = WSP(float, WS_AV), *SST = WSP(float, WS_SST); bf16_t* YG = WSP(bf16_t, WS_YG);
    for (int it = BID(); it < 64 * NCH; it += gridDim.x) {
        const int tid = TID(), lane = tid & 63, w = tid >> 6, n = lane & 15, c4 = lane >> 4, tr = w >> 1, tcb = 2 * (w & 1);
        const int sh = it / NCH, c = it % NCH, b = sh >> 4, h = sh & 15, R0 = b * 4096 + c * LCH, hc = h * 64;
        f32x4 y[2], g[2];
        const size_t ar = (size_t)(R0 + 16 * tr + n);
#pragma unroll
        for (int ti = 0; ti < 2; ++ti) {
            const int dv = 16 * (tcb + ti) + n;
            f32x4 acc = {0.f, 0.f, 0.f, 0.f}, gacc = acc;
#pragma unroll
            for (int ks = 0; ks < 2; ++ks) {
                const bf16x8 af = *(const bf16x8*)(GM + ar * D + hc + 32 * ks + 8 * c4);
                const float* sp = SST + ((size_t)it * 64 + dv) * 64 + 32 * ks + 8 * c4; const f32x4 s0 = *(const f32x4*)sp, s1 = *(const f32x4*)(sp + 4);
                const u32x4 bw = {pk_bf16(s0[0], s0[1]), pk_bf16(s0[2], s0[3]), pk_bf16(s1[0], s1[1]), pk_bf16(s1[2], s1[3])};
                acc = __builtin_amdgcn_mfma_f32_16x16x32_bf16(af, __builtin_bit_cast(bf16x8, bw), acc, 0, 0, 0);
            }
#pragma unroll
            for (int ks = 0; ks < 5; ++ks)
                gacc = __builtin_amdgcn_mfma_f32_16x16x32_bf16(*(const bf16x8*)(TG + ar * 160 + 32 * ks + 8 * c4), *(const bf16x8*)(G2T + (size_t)(hc + dv) * 160 + 32 * ks + 8 * c4), gacc, 0, 0, 0);
#pragma unroll
            for (int r = 0; r < 4; ++r) acc[r] += Y0[(size_t)(R0 + 16 * tr + 4 * c4 + r) * D + hc + dv];
            y[ti] = acc; g[ti] = gacc;
        }
        float bonus4[4]; unsigned short vm4[2][4]; float lnw2[2], lnb2[2];
#pragma unroll
        for (int r = 0; r < 4; ++r) bonus4[r] = BON[(size_t)(R0 + 16 * tr + 4 * c4 + r) * 16 + h];
#pragma unroll
        for (int ti = 0; ti < 2; ++ti) { const int col = hc + 16 * (tcb + ti) + n; lnw2[ti] = p->rw_lnx_w[j * D + col]; lnb2[ti] = p->rw_lnx_b[j * D + col];
#pragma unroll
            for (int r = 0; r < 4; ++r) vm4[ti][r] = VM2[(size_t)(R0 + 16 * tr + 4 * c4 + r) * D + col]; }
        float s1[4], s2[4];
#pragma unroll
        for (int r = 0; r < 4; ++r) { s1[r] = g16_sum(y[0][r] + y[1][r]); s2[r] = g16_sum(y[0][r] * y[0][r] + y[1][r] * y[1][r]); }
        asm volatile("s_waitcnt lgkmcnt(0)" ::: "memory"); __builtin_amdgcn_s_barrier(); asm volatile("" ::: "memory");
        if (n == 0) {
#pragma unroll
            for (int r = 0; r < 4; ++r) { const int t = 16 * tr + 4 * c4 + r; part[(t * 2 + (w & 1)) * 2 + 0] = s1[r]; part[(t * 2 + (w & 1)) * 2 + 1] = s2[r]; }
        }
        asm volatile("s_waitcnt lgkmcnt(0)" ::: "memory"); __builtin_amdgcn_s_barrier(); asm volatile("" ::: "memory");
#pragma unroll
        for (int r = 0; r < 4; ++r) {
            const int t = 16 * tr + 4 * c4 + r;
            const float mu = (part[(t * 2 + 0) * 2] + part[(t * 2 + 1) * 2]) * (1.0f / 64.0f), ex2 = (part[(t * 2 + 0) * 2 + 1] + part[(t * 2 + 1) * 2 + 1]) * (1.0f / 64.0f);
            const float rs = rsqrtf(fmaxf(ex2 - mu * mu, 0.f) + 64e-5f), bonus = bonus4[r];
#pragma unroll
            for (int ti = 0; ti < 2; ++ti) {
                const int col = hc + 16 * (tcb + ti) + n; const size_t o = (size_t)(R0 + t) * D + col;
                YG[o] = f2bf(((y[ti][r] - mu) * rs * lnw2[ti] + lnb2[ti] + bonus * bf2f(vm4[ti][r])) * g[ti][r]);
            }
        }
    }
    __syncthreads();
}

__device__ __forceinline__ void phase_post(KP p, int j) {
    const float *Y = WSP(float, WS_Y), *KM = WSP(float, WS_KM), *VM = WSP(float, WS_VM), *GG = WSP(float, WS_GG);
    const bf16_t* RB = WSP(bf16_t, WS_RB); bf16_t* YG = WSP(bf16_t, WS_YG);
    const int lane = TID() & 63, gw = BID() * 8 + (TID() >> 6), nw = gridDim.x * 8;
    for (int row = gw; row < NT; row += nw) {
#pragma unroll
        for (int i = 0; i < 4; ++i) {
            const int col = 256 * i + 4 * lane; const size_t o = (size_t)row * D + col;
            const f32x4 y = *(const f32x4*)(Y + o), r = ld_bf4(RB + o), km = *(const f32x4*)(KM + o), vm = *(const f32x4*)(VM + o), gg = *(const f32x4*)(GG + o);
            const f32x4 lw = *(const f32x4*)(p->rw_lnx_w + j * D + col), lb = *(const f32x4*)(p->rw_lnx_b + j * D + col), rk = *(const f32x4*)(p->rw_r_k + j * D + col);
            const float mu = g16_sum(y[0] + y[1] + y[2] + y[3]) * (1.0f / 64.0f);
            const f32x4 d = y - mu;
            const float var = g16_sum(d[0] * d[0] + d[1] * d[1] + d[2] * d[2] + d[3] * d[3]) * (1.0f / 64.0f);
            const float rs = rsqrtf(var + 64e-5f);
            const float bon = g16_sum(r[0] * km[0] * rk[0] + r[1] * km[1] * rk[1] + r[2] * km[2] * rk[2] + r[3] * km[3] * rk[3]);
            st_bf4(YG + o, (d * rs * lw + lb + bon * vm) * gg);
        }
    }
}

__constant__ double kRopeInv[8] = {1.0, 0.19392274474868576, 0.03760603093086393, 0.007292664737217109, 0.001414213562373095, 0.0002742481756762073, 5.318295896944988e-05, 1.031338537721246e-05};
__device__ __forceinline__ void phase_dsapost(KP p, int j) {
    const float* PR = WSP(float, WS_PR); float *Q = WSP(float, WS_Q), *QI = WSP(float, WS_QI), *WI = WSP(float, WS_WI);
    const int lane = TID() & 63, l16 = lane & 15, gw = BID() * 8 + (TID() >> 6), nw = gridDim.x * 8;
    const f32x4 qn = *(const f32x4*)(p->att_q_norm + j * 64 + 4 * l16), kn = *(const f32x4*)(p->att_k_norm + j * 64 + 4 * l16), in = *(const f32x4*)(p->idx_k_norm + j * 64 + 4 * l16);
    for (int row = gw; row < NT; row += nw) {
        const int pos = row_pos(row);
        const float* pr = PR + (size_t)row * PINP;
        f32x4 cs = {1.f, 1.f, 1.f, 1.f}, sn = {0.f, 0.f, 0.f, 0.f};
        if (l16 < 4) {
#pragma unroll
            for (int e = 0; e < 4; ++e) { double ang = (double)pos * kRopeInv[4 * (l16 & 1) + e]; ang -= floor(ang * 0.15915494309189535) * 6.283185307179586; const float af = (float)ang; cs[e] = cosf(af); sn[e] = sinf(af); }
        }
        const float sgn = (l16 < 2) ? -1.0f : 1.0f;
#define ROPE4(v) do { f32x4 _o; _o[0] = __shfl_xor((v)[0], 2); _o[1] = __shfl_xor((v)[1], 2); _o[2] = __shfl_xor((v)[2], 2); _o[3] = __shfl_xor((v)[3], 2); if (l16 < 4) (v) = (v) * cs + sgn * (_o * sn); } while (0)
#define HNORM4(v, w) do { const float _ss = g16_sum((v)[0] * (v)[0] + (v)[1] * (v)[1] + (v)[2] * (v)[2] + (v)[3] * (v)[3]); (v) = (v) * rsqrtf(_ss * (1.0f / 64.0f) + 1e-6f) * (w); } while (0)
#pragma unroll
        for (int i = 0; i < 4; ++i) { f32x4 v = *(const f32x4*)(pr + 256 * i + 4 * lane); HNORM4(v, qn); ROPE4(v); *(f32x4*)(Q + (size_t)row * D + 256 * i + 4 * lane) = v; }
        { f32x4 v = *(const f32x4*)(pr + 1024 + 4 * lane); HNORM4(v, kn); ROPE4(v);
          float* ko = row < NP ? p->out + O_KP + ((size_t)j * NP + row) * 256 : p->out + O_KS + ((size_t)j * NS + (row - NP)) * 256; *(f32x4*)(ko + 4 * lane) = v; st_bf4(WSP(bf16_t, WS_KBF) + (size_t)row * 256 + 4 * lane, v); *(unsigned*)(WSP(unsigned char, WS_K8) + (size_t)row * 256 + 4 * lane) = pk_fp8x4(v); }
        { const f32x4 v = *(const f32x4*)(pr + 1280 + 4 * lane);
          float* vo = row < NP ? p->out + O_VP + ((size_t)j * NP + row) * 256 : p->out + O_VS + ((size_t)j * NS + (row - NP)) * 256; *(f32x4*)(vo + 4 * lane) = v; st_bf4(WSP(bf16_t, WS_VBF) + (size_t)row * 256 + 4 * lane, v); *(unsigned*)(WSP(unsigned char, WS_V8) + (size_t)row * 256 + 4 * lane) = pk_fp8x4(v); }
#pragma unroll
        for (int i = 0; i < 2; ++i) { f32x4 v = *(const f32x4*)(pr + 1536 + 256 * i + 4 * lane); ROPE4(v); st_bf4(WSP(bf16_t, WS_QIB) + (size_t)row * 512 + 256 * i + 4 * lane, v); }
        { f32x4 v = *(const f32x4*)(pr + 2048 + 4 * l16); HNORM4(v, in); ROPE4(v);
          float* io = row < NP ? p->out + O_IKP + ((size_t)j * NP + row) * 64 : p->out + O_IKS + ((size_t)j * NS + (row - NP)) * 64; if (lane < 16) { *(f32x4*)(io + 4 * lane) = v; st_bf4(WSP(bf16_t, WS_KIB) + (size_t)row * 64 + 4 * lane, v); } }
        if (lane < 2) { const f32x4 v = *(const f32x4*)(pr + 2112 + 4 * lane); *(f32x4*)(WI + (size_t)row * 8 + 4 * lane) = v * 0.35355339059327373f; }
#undef ROPE4
#undef HNORM4
    }
}

template <bool SAMPLE>
__device__ __forceinline__ void phase_idx(KP p, int j, LAS unsigned char* lds) {
    LAS float* Qs = (LAS float*)lds;
    LAS float* Ks = (LAS float*)(lds + 32768);
    const float *QI = WSP(float, WS_QI), *WI = WSP(float, WS_WI);
    const int tid = TID(), q = tid >> 5, kx = tid & 31;
    const int nitems = SAMPLE ? 32 * 65 : 1024;
    for (int it = BID(); it < nitems; it += gridDim.x) {
        int b, t0, rowbase, nkt, kt0 = 0;
        if (SAMPLE) { b = it / 65; kt0 = it % 65; t0 = 0; rowbase = NP + b * 8; nkt = kt0 + 1; }
        else { const int k4 = it >> 8, w = it & 255, i = (k4 & 1) ? (k4 * 256 + 255 - w) : (k4 * 256 + w); b = i & 3; t0 = (i >> 2) * 16; rowbase = b * 4096 + t0; nkt = (t0 + 15) / 128 + 1; }
        const int nq = SAMPLE ? 8 : 16;
        __syncthreads();
#pragma unroll
        for (int n = 0; n < 16; ++n) { const int e = tid + 512 * n, qq = e >> 9, c = e & 511, h = c >> 6, d = c & 63;
            Qs[(d * 16 + qq) * 8 + h] = qq < nq ? QI[(size_t)(rowbase + qq) * 512 + c] : 0.f; }
        float wi[8];
#pragma unroll
        for (int h = 0; h < 8; ++h) wi[h] = q < nq ? WI[(size_t)(rowbase + q) * 8 + h] : 0.f;
        for (int kt = kt0; kt < nkt; ++kt) {
            __syncthreads();
#pragma unroll
            for (int n = 0; n < 16; ++n) { const int e = tid + 512 * n, key = e >> 6, d = e & 63, s = kt * 128 + key; float v = 0.f;
                if (SAMPLE) {
                    if (s < PAST) { const int pg = p->page_table[b * 64 + (s >> 7)]; v = p->cache_ik[(((size_t)j * 2560 + pg) * 128 + (s & 127)) * 64 + d]; }
                    else if (s < PAST + 8) v = p->out[O_IKS + ((size_t)j * NS + b * 8 + (s - PAST)) * 64 + d];
                } else v = p->out[O_IKP + ((size_t)j * NP + b * 4096 + s) * 64 + d];
                Ks[d * 132 + key] = v; }
            __syncthreads();
            f32x4 acc[8];
#pragma unroll
            for (int h = 0; h < 8; ++h) acc[h] = (f32x4){0.f, 0.f, 0.f, 0.f};
#pragma unroll 4
            for (int d = 0; d < 64; ++d) {
                const f32x4 qa = *(const LAS f32x4*)(Qs + (d * 16 + q) * 8), qb = *(const LAS f32x4*)(Qs + (d * 16 + q) * 8 + 4), kv = *(const LAS f32x4*)(Ks + d * 132 + 4 * kx);
                acc[0] += qa[0] * kv; acc[1] += qa[1] * kv; acc[2] += qa[2] * kv; acc[3] += qa[3] * kv;
                acc[4] += qb[0] * kv; acc[5] += qb[1] * kv; acc[6] += qb[2] * kv; acc[7] += qb[3] * kv;
            }
            f32x4 sc = {0.f, 0.f, 0.f, 0.f};
#pragma unroll
            for (int h = 0; h < 8; ++h)
#pragma unroll
                for (int e = 0; e < 4; ++e) sc[e] += fmaxf(acc[h][e] * 0.125f, 0.f) * wi[h];
            if (q < nq) {
                if (SAMPLE) *(f32x4*)(WSP(float, WS_SCS) + (size_t)(b * 8 + q) * SCS_LD + kt * 128 + 4 * kx) = sc;
                else *(f32x4*)(WSP(float, WS_SC) + ((size_t)b * 4096 + t0 + q) * 4096 + kt * 128 + 4 * kx) = sc;
            }
        }
    }
    __syncthreads();
}

template <bool SAMPLE>
__device__ __forceinline__ void phase_idx2(KP p, int j) {
    const bf16_t *QIB = WSP(bf16_t, WS_QIB), *KIB = WSP(bf16_t, WS_KIB); const float* WI = WSP(float, WS_WI);
    const int lane = TID() & 63, lr = lane & 31, lh = lane >> 5, gw = BID() * 8 + (TID() >> 6), nw = gridDim.x * 8;
    const int nitems = SAMPLE ? 32 * 65 : 4096;
    for (int it = gw; it < nitems; it += nw) {
        int b, rowbase, tile0, ntile;
        if (SAMPLE) { b = it / 65; rowbase = NP + b * 8; tile0 = (it % 65) * 4; ntile = min(4, 257 - tile0); }
        else { const int sub = it >= 2048, w_ = it & 2047; b = w_ & 3; const int wb = w_ >> 2, kk = sub ? 511 - wb : wb, nt = (kk * 8 + 7) / 32 + 1;
            rowbase = b * 4096 + kk * 8; tile0 = sub ? (nt >> 1) : 0; ntile = sub ? nt - (nt >> 1) : (nt >> 1); }
        if (ntile <= 0) continue;
        bf16x8 af[2][4]; float w[2][2][8];
        { const int hd = (lr & 3) + 4 * ((lr >> 3) & 1), jq = 2 * ((lr >> 2) & 1) + (lr >> 4);
#pragma unroll
          for (int st = 0; st < 2; ++st)
#pragma unroll
              for (int ks = 0; ks < 4; ++ks) af[st][ks] = *(const bf16x8*)(QIB + (size_t)(rowbase + 4 * st + jq) * 512 + hd * 64 + 16 * ks + 8 * lh);
#pragma unroll
          for (int st = 0; st < 2; ++st)
#pragma unroll
              for (int q = 0; q < 2; ++q) { const f32x4 w0 = *(const f32x4*)(WI + (size_t)(rowbase + 4 * st + 2 * lh + q) * 8), w1 = *(const f32x4*)(WI + (size_t)(rowbase + 4 * st + 2 * lh + q) * 8 + 4);
#pragma unroll
                  for (int e = 0; e < 4; ++e) { w[st][q][e] = w0[e] * 0.125f; w[st][q][4 + e] = w1[e] * 0.125f; } } }
#define IDX_LOADB(BF, tl_) do { const int s_ = (tile0 + (tl_)) * 32 + lr; \
            if (!SAMPLE) { _Pragma("unroll") for (int ks = 0; ks < 4; ++ks) BF[ks] = *(const bf16x8*)(KIB + ((size_t)b * 4096 + s_) * 64 + 16 * ks + 8 * lh); } \
            else { const float* kp = p->out + O_IKS + ((size_t)j * NS + b * 8) * 64; \
                if (s_ < PAST) kp = p->cache_ik + (((size_t)j * 2560 + p->page_table[b * 64 + (s_ >> 7)]) * 128 + (s_ & 127)) * 64; else kp += (size_t)min(s_ - PAST, 7) * 64; \
                _Pragma("unroll") for (int ks = 0; ks < 4; ++ks) { const f32x4 x0 = *(const f32x4*)(kp + 16 * ks + 8 * lh), x1 = *(const f32x4*)(kp + 16 * ks + 8 * lh + 4); \
                    const u32x4 wv = {pk_bf16(x0[0], x0[1]), pk_bf16(x0[2], x0[3]), pk_bf16(x1[0], x1[1]), pk_bf16(x1[2], x1[3])}; BF[ks] = __builtin_bit_cast(bf16x8, wv); } } } while (0)
        bf16x8 bnx[4];
        IDX_LOADB(bnx, 0);
        for (int tl = 0; tl < ntile; ++tl) {
            const int s = (tile0 + tl) * 32 + lr;
            bf16x8 bfr[4];
#pragma unroll
            for (int ks = 0; ks < 4; ++ks) bfr[ks] = bnx[ks];
            if (tl + 1 < ntile) IDX_LOADB(bnx, tl + 1);
            __builtin_amdgcn_sched_barrier(0);
#pragma unroll
            for (int st = 0; st < 2; ++st) {
                f32x16 acc;
#pragma unroll
                for (int r = 0; r < 16; ++r) acc[r] = 0.f;
#pragma unroll
                for (int ks = 0; ks < 4; ++ks) acc = __builtin_amdgcn_mfma_f32_32x32x16_bf16(af[st][ks], bfr[ks], acc, 0, 0, 0);
#pragma unroll
                for (int q = 0; q < 2; ++q) {
                    float sc = 0.f;
#pragma unroll
                    for (int hh = 0; hh < 2; ++hh)
#pragma unroll
                        for (int hl = 0; hl < 4; ++hl) sc += fmaxf(acc[4 * (2 * q + hh) + hl], 0.f) * w[st][q][hl + 4 * hh];
                    if (SAMPLE) WSP(float, WS_SCS)[(size_t)(b * 8 + 4 * st + 2 * lh + q) * SCS_LD + s] = sc;
                    else WSP(float, WS_SC)[((size_t)rowbase + 4 * st + 2 * lh + q) * 4096 + s] = sc;
                }
            }
        }
    }
#undef IDX_LOADB
}

__device__ __forceinline__ unsigned fkey(float f) { f = (f == 0.f) ? 0.f : f; const unsigned u = __float_as_uint(f); return (u & 0x80000000u) ? ~u : (u | 0x80000000u); }
__device__ __forceinline__ void phase_topk_prompt(KP p) {
    const float* SC = WSP(float, WS_SC); int* SEL = WSP(int, WS_SEL); int* CNT = WSP(int, WS_CNT);
    const int lane = TID() & 63, gw = BID() * 8 + (TID() >> 6), nw = gridDim.x * 8;
    for (int qi = gw; qi < NP; qi += nw) {
        const int b = qi & 3, tt = qi >> 2, t = (tt & 1) ? 4095 - (tt >> 1) : (tt >> 1), row = b * 4096 + t, n = t + 1;
        int* sel = SEL + (size_t)row * 256;
        if (n <= TOPK) { for (int s = lane; s < n; s += 64) sel[s] = s; if (lane == 0) CNT[row] = n; continue; }
        const float* base = SC + (size_t)row * 4096;
        unsigned u[64];
#pragma unroll
        for (int m = 0; m < 64; ++m) u[m] = __float_as_uint(base[lane + 64 * m]);
#pragma unroll
        for (int m = 0; m < 64; ++m) { const unsigned k_ = fkey(__uint_as_float(u[m])); u[m] = (lane + 64 * m < n) ? k_ : 0u; }
        unsigned tau = 0u;
#pragma unroll 1
        for (int bit = 31; bit >= 0; --bit) {
            const unsigned cand = tau | (1u << bit); int c = 0;
#pragma unroll
            for (int m = 0; m < 64; ++m) c += (u[m] >= cand) ? 1 : 0;
            c = wave_sum_i(c);
            if (c >= TOPK) tau = cand;
            if (c == TOPK) break;
        }
        int cg = 0, ct = 0; unsigned tlo = 0u, thi = 0u;
#pragma unroll
        for (int m = 31; m >= 0; --m) { cg += (u[m] > tau) ? 1 : 0; const unsigned tie = (u[m] == tau) ? 1u : 0u; ct += (int)tie; tlo = (tlo << 1) | tie; }
#pragma unroll
        for (int m = 63; m >= 32; --m) { cg += (u[m] > tau) ? 1 : 0; const unsigned tie = (u[m] == tau) ? 1u : 0u; ct += (int)tie; thi = (thi << 1) | tie; }
        unsigned long long tmask = ((unsigned long long)thi << 32) | tlo;
        const int totg = wave_sum_i(cg), tott = wave_sum_i(ct);
        const int need = TOPK - totg;
        unsigned long long smask = 0ull;
        if (tott == need) smask = tmask;
        else {
#pragma unroll 1
            for (int it = 0; it < need; ++it) {
                const int m0 = tmask ? (int)__builtin_ctzll(tmask) : 64;
                const int cand = tmask ? (lane + 64 * m0) : 0x7fffffff, best = wave_min_i(cand);
                if (cand == best && tmask) { smask |= (1ull << m0); tmask &= ~(1ull << m0); }
            }
        }
        const int mine = cg + __popcll(smask);
        int incl = mine;
#pragma unroll
        for (int d = 1; d < 64; d <<= 1) { const int o = __shfl_up(incl, d); if (lane >= d) incl += o; }
        int off = incl - mine;
#pragma unroll
        for (int m = 0; m < 64; ++m) { if ((u[m] > tau) || ((smask >> m) & 1ull)) { sel[off] = lane + 64 * m; ++off; } }
        if (lane == 0) CNT[row] = TOPK;
    }
}
__device__ __forceinline__ void phase_topk_sample(KP p, LAS unsigned char* lds) {
    LAS unsigned* ckey = (LAS unsigned*)lds;
    LAS int* cidx = (LAS int*)(lds + 8192);
    const float* SCS = WSP(float, WS_SCS); int* SEL = WSP(int, WS_SEL); int* CNT = WSP(int, WS_CNT);
    for (int qq = BID(); qq < NS; qq += gridDim.x) {
        const int tid = TID(), lane = tid & 63, wave = tid >> 6;
        const int n = PAST + 1 + (qq & 7), row = NP + qq, s0 = 1088 * wave;
        const float* base = SCS + (size_t)qq * SCS_LD;
        unsigned u[17];
#pragma unroll
        for (int m = 0; m < 17; ++m) { const int s = s0 + lane + 64 * m; u[m] = __float_as_uint(base[s < SCS_LD ? s : 0]); }
#pragma unroll
        for (int m = 0; m < 17; ++m) { const unsigned k_ = fkey(__uint_as_float(u[m])); u[m] = (s0 + lane + 64 * m < n) ? k_ : 0u; }
        __syncthreads();
        {
            int nvalid = 0;
#pragma unroll
            for (int m = 0; m < 17; ++m) nvalid += (u[m] != 0u) ? 1 : 0;
            nvalid = wave_sum_i(nvalid);
            unsigned tau = 0u; int need = 0; unsigned tmask = 0u, smask = 0u;
            if (nvalid > TOPK) {
#pragma unroll 1
                for (int bit = 31; bit >= 0; --bit) {
                    const unsigned cand = tau | (1u << bit); int c = 0;
#pragma unroll
                    for (int m = 0; m < 17; ++m) c += (u[m] >= cand) ? 1 : 0;
                    c = wave_sum_i(c);
                    if (c >= TOPK) tau = cand;
                    if (c == TOPK) break;
                }
                int cg = 0, ct = 0;
#pragma unroll
                for (int m = 0; m < 17; ++m) { cg += (u[m] > tau) ? 1 : 0; const bool tie = (u[m] == tau); ct += tie ? 1 : 0; tmask |= tie ? (1u << m) : 0u; }
                cg = wave_sum_i(cg); ct = wave_sum_i(ct);
                need = TOPK - cg;
                if (ct == need) smask = tmask;
                else {
#pragma unroll 1
                    for (int it = 0; it < need; ++it) {
                        const int m0 = tmask ? (int)__builtin_ctz(tmask) : 32;
                        const int cand = tmask ? (lane + 64 * m0) : 0x7fffffff, best = wave_min_i(cand);
                        if (cand == best && tmask) { smask |= (1u << m0); tmask &= ~(1u << m0); }
                    }
                }
            } else { tau = 0u; smask = 0u; }
            int mine = 0;
#pragma unroll
            for (int m = 0; m < 17; ++m) mine += ((u[m] > tau) || ((smask >> m) & 1u)) ? 1 : 0;
            int incl = mine;
#pragma unroll
            for (int d = 1; d < 64; d <<= 1) { const int o = __shfl_up(incl, d); if (lane >= d) incl += o; }
            int off = incl - mine;
            const int total = __builtin_amdgcn_readlane(incl, 63);
#pragma unroll
            for (int m = 0; m < 17; ++m) { if ((u[m] > tau) || ((smask >> m) & 1u)) { ckey[wave * 256 + off] = u[m]; cidx[wave * 256 + off] = s0 + lane + 64 * m; ++off; } }
            for (int e = total + lane; e < 256; e += 64) { ckey[wave * 256 + e] = 0u; cidx[wave * 256 + e] = 0x7fffffff; }
        }
        __syncthreads();
        if (wave == 0) {
            unsigned v[32]; int ix[32];
#pragma unroll
            for (int m = 0; m < 32; ++m) { v[m] = ckey[lane + 64 * m]; ix[m] = cidx[lane + 64 * m]; }
            unsigned tau = 0u;
#pragma unroll 1
            for (int bit = 31; bit >= 0; --bit) {
                const unsigned cand = tau | (1u << bit); int c = 0;
#pragma unroll
                for (int m = 0; m < 32; ++m) c += (v[m] >= cand) ? 1 : 0;
                c = wave_sum_i(c);
                if (c >= TOPK) tau = cand;
                if (c == TOPK) break;
            }
            int cg = 0, ct = 0; unsigned tmask = 0u, smask = 0u;
#pragma unroll
            for (int m = 31; m >= 0; --m) { cg += (v[m] > tau) ? 1 : 0; const unsigned tie = (v[m] == tau) ? 1u : 0u; ct += (int)tie; tmask = (tmask << 1) | tie; }
            cg = wave_sum_i(cg); ct = wave_sum_i(ct);
            const int need = TOPK - cg;
            if (ct == need) smask = tmask;
            else {
#pragma unroll 1
                for (int it = 0; it < need; ++it) {
                    int bi = 0x7fffffff, bm = 0;
#pragma unroll
                    for (int m = 0; m < 32; ++m) { const bool t_ = (tmask >> m) & 1u; if (t_ && ix[m] < bi) { bi = ix[m]; bm = m; } }
                    const int best = wave_min_i(bi);
                    if (bi == best && bi != 0x7fffffff) { smask |= (1u << bm); tmask &= ~(1u << bm); }
                }
            }
            int mine = 0;
#pragma unroll
            for (int m = 0; m < 32; ++m) mine += ((v[m] > tau) || ((smask >> m) & 1u)) ? 1 : 0;
            int incl = mine;
#pragma unroll
            for (int d = 1; d < 64; d <<= 1) { const int o = __shfl_up(incl, d); if (lane >= d) incl += o; }
            int off = incl - mine;
            int* sel = SEL + (size_t)row * 256;
#pragma unroll
            for (int m = 0; m < 32; ++m) { if ((v[m] > tau) || ((smask >> m) & 1u)) { if (off < TOPK) sel[off] = ix[m]; ++off; } }
            if (lane == 0) CNT[row] = TOPK;
        }
    }
    __syncthreads();
}

template <bool SAMPLE>
__device__ __forceinline__ void phase_attn(KP p, int j, LAS unsigned char* lds) {
    const int tid = TID(), lane = tid & 63, wave = tid >> 6, n16 = lane & 15, c4 = lane >> 4;
    LAS bf16_t* ps = (LAS bf16_t*)(lds + wave * 16384);
    LAS int* is = (LAS int*)(lds + wave * 16384 + 8192);
    LAS bf16_t* qs = (LAS bf16_t*)(lds + wave * 16384 + 9216);
    LAS float* invs = (LAS float*)(lds + wave * 16384 + 11264);
    const float* Q = WSP(float, WS_Q); const int* SEL = WSP(int, WS_SEL); const int* CNT = WSP(int, WS_CNT); bf16_t* O = WSP(bf16_t, WS_YG);
    const bf16_t *KBF = WSP(bf16_t, WS_KBF), *VBF = WSP(bf16_t, WS_VBF);
    const float* kc = p->cache_k + (size_t)j * 2560 * 128 * 256; const float* vc = p->cache_v + (size_t)j * 2560 * 128 * 256;
    const float* knew = p->out + O_KS + (size_t)j * NS * 256; const float* vnew = p->out + O_VS + (size_t)j * NS * 256;
    const int gw = BID() * 8 + wave, nw = gridDim.x * 8, nq = SAMPLE ? NS : NP;
    unsigned* qctr = WSP(unsigned, WS_BAR + 40960) + (size_t)j * 256;
    int qb = 0, qnext = 0, qsub = 2, qcur = 0;
    if (!SAMPLE) { unsigned v_ = 0u; if (lane == 0) v_ = __hip_atomic_fetch_add(qctr + 16 * ((BID() + qb) & 3), 2u, __ATOMIC_RELAXED, __HIP_MEMORY_SCOPE_AGENT); qnext = (int)__builtin_amdgcn_readfirstlane(v_); }
    for (int qi = gw; SAMPLE ? (qi < nq) : true; qi += nw) {
        int row;
        if (SAMPLE) row = NP + qi;
        else {
            if (qsub == 2) {
                for (;;) {
                    qcur = qnext; qsub = 0;
                    if (qcur < 4096 || qb == 3) break;
                    ++qb; unsigned v_ = 0u; if (lane == 0) v_ = __hip_atomic_fetch_add(qctr + 16 * ((BID() + qb) & 3), 2u, __ATOMIC_RELAXED, __HIP_MEMORY_SCOPE_AGENT); qnext = (int)__builtin_amdgcn_readfirstlane(v_);
                }
                if (qcur >= 4096) break;
                { unsigned v_ = 0u; if (lane == 0) v_ = __hip_atomic_fetch_add(qctr + 16 * ((BID() + qb) & 3), 2u, __ATOMIC_RELAXED, __HIP_MEMORY_SCOPE_AGENT); qnext = (int)__builtin_amdgcn_readfirstlane(v_); }
            }
            row = ((BID() + qb) & 3) * 4096 + (4095 - (qcur + qsub)); ++qsub;
        }
        const int n = CNT[row];
        wave_lds_fence();
#pragma unroll
        for (int c = 0; c < 4; ++c) { const int slot = lane + 64 * c;
            int s = SEL[(size_t)row * 256 + slot]; const bool ok = slot < n;
            int r;
            if (SAMPLE) { const int bb = (row - NP) >> 3; s = ok ? s : 0; const int sp = min(max(s, 0), PAST - 1); const int pg = p->page_table[bb * 64 + (sp >> 7)];
                r = (s < PAST) ? pg * 128 + (s & 127) : (0x40000000 | (bb * 8 + min(s - PAST, 7))); }
            else r = (row & ~4095) + (ok ? s : 0);
            is[slot] = r; }
#pragma unroll
        for (int i = 0; i < 4; ++i) { const f32x4 q4 = *(const f32x4*)(Q + (size_t)row * D + 256 * i + 4 * lane);
            if (SAMPLE) { const f32x4 q8 = q4 * 0.125f; u32x2 w; w.x = pk_bf16(q8[0], q8[1]); w.y = pk_bf16(q8[2], q8[3]); *(LAS u32x2*)(qs + 256 * i + 4 * lane) = w; }
            else *(LAS unsigned*)((LAS unsigned char*)qs + 256 * i + 4 * lane) = pk_fp8x4(q4); }
        wave_lds_fence();
        {
            float mx = -__builtin_huge_valf();
#define ATT_EMIT(t_, acc_) do { f32x4 l_ = (acc_); _Pragma("unroll") for (int r = 0; r < 4; ++r) { if (16 * (t_) + 4 * c4 + r >= n) l_[r] = -__builtin_huge_valf(); mx = fmaxf(mx, l_[r]); } \
                u32x2 w_; w_.x = pk_bf16(l_[0], l_[1]); w_.y = pk_bf16(l_[2], l_[3]); *(LAS u32x2*)(ps + n16 * 256 + 16 * (t_) + 4 * c4) = w_; } while (0)
            if (SAMPLE) {
                const u32x4 qf0 = *(const LAS u32x4*)(qs + n16 * 64 + 8 * c4), qf1 = *(const LAS u32x4*)(qs + n16 * 64 + 32 + 8 * c4);
                u32x4 bq[8];
#pragma unroll
                for (int ks = 0; ks < 8; ++ks) { const bool on = (n16 >> 2) == (ks >> 1); const u32x4 qv = (ks & 1) ? qf1 : qf0; bq[ks] = (u32x4){on ? qv.x : 0u, on ? qv.y : 0u, on ? qv.z : 0u, on ? qv.w : 0u}; }
#pragma unroll 2
                for (int t = 0; t < 16; ++t) {
                    const int r = is[16 * t + n16];
                    const float* kp = ((r & 0x40000000) ? knew + (size_t)(r & 0xffff) * 256 : kc + (size_t)r * 256) + 8 * c4;
                    f32x4 acc = {0.f, 0.f, 0.f, 0.f};
#pragma unroll
                    for (int ks = 0; ks < 8; ++ks) { const f32x4 x0 = *(const f32x4*)(kp + 32 * ks), x1 = *(const f32x4*)(kp + 32 * ks + 4);
                        const u32x4 ka = {pk_bf16(x0[0], x0[1]), pk_bf16(x0[2], x0[3]), pk_bf16(x1[0], x1[1]), pk_bf16(x1[2], x1[3])};
                        acc = __builtin_amdgcn_mfma_f32_16x16x32_bf16(__builtin_bit_cast(bf16x8, ka), __builtin_bit_cast(bf16x8, bq[ks]), acc, 0, 0, 0); }
                    ATT_EMIT(t, acc);
                }
            } else {
                const LAS unsigned char* q8 = (const LAS unsigned char*)qs;
                long bq[8];
                { const bool on = (n16 >> 2) == c4;
#pragma unroll
                  for (int h2 = 0; h2 < 4; ++h2) { const u32x4 qv = *(const LAS u32x4*)(q8 + n16 * 64 + 16 * h2);
                      const u32x2 z0 = {on ? qv.x : 0u, on ? qv.y : 0u}, z1 = {on ? qv.z : 0u, on ? qv.w : 0u}; bq[2 * h2] = __builtin_bit_cast(long, z0); bq[2 * h2 + 1] = __builtin_bit_cast(long, z1); } }
                const unsigned char* K8 = WSP(unsigned char, WS_K8);
#pragma unroll
                for (int th = 0; th < 2; ++th) {
                    if (th) asm volatile("" ::: "memory");
                    u32x4 ka[8][4];
#pragma unroll
                    for (int t8 = 0; t8 < 8; ++t8) {
                        const int r = is[16 * (8 * th + t8) + n16];
                        const unsigned char* kp = K8 + (size_t)r * 256 + 64 * c4;
#pragma unroll
                        for (int h2 = 0; h2 < 4; ++h2) ka[t8][h2] = *(const u32x4*)(kp + 16 * h2);
                    }
                    __builtin_amdgcn_sched_barrier(0);
#pragma unroll
                    for (int t8 = 0; t8 < 8; ++t8) {
                        f32x4 acc = {0.f, 0.f, 0.f, 0.f};
#pragma unroll
                        for (int h2 = 0; h2 < 4; ++h2) { const u32x2 lo = {ka[t8][h2].x, ka[t8][h2].y}, hi = {ka[t8][h2].z, ka[t8][h2].w};
                            acc = __builtin_amdgcn_mfma_f32_16x16x32_fp8_fp8(__builtin_bit_cast(long, lo), bq[2 * h2], acc, 0, 0, 0);
                            acc = __builtin_amdgcn_mfma_f32_16x16x32_fp8_fp8(__builtin_bit_cast(long, hi), bq[2 * h2 + 1], acc, 0, 0, 0); }
                        ATT_EMIT(8 * th + t8, acc * 0.125f);
                    }
                }
            }
#undef ATT_EMIT
            mx = fmaxf(mx, __shfl_xor(mx, 16)); mx = fmaxf(mx, __shfl_xor(mx, 32));
            float sm = 0.f;
            u32x2 lw_[16];
#pragma unroll
            for (int t = 0; t < 16; ++t) lw_[t] = *(const LAS u32x2*)(ps + n16 * 256 + 16 * t + 4 * c4);
#pragma unroll
            for (int t = 0; t < 16; ++t) {
                const u32x2 w = lw_[t];
                const float e0 = __expf(bflo(w.x) - mx), e1 = __expf(bfhi(w.x) - mx), e2 = __expf(bflo(w.y) - mx), e3 = __expf(bfhi(w.y) - mx);
                sm += (e0 + e1) + (e2 + e3);
                u32x2 o_; o_.x = pk_bf16(e0, e1); o_.y = pk_bf16(e2, e3); *(LAS u32x2*)(ps + n16 * 256 + 16 * t + 4 * c4) = o_;
            }
            sm += __shfl_xor(sm, 16); sm += __shfl_xor(sm, 32);
            if (c4 == 0) invs[n16] = 1.0f / sm;
        }
        wave_lds_fence();
        if (!SAMPLE) {
            const unsigned char* V8 = WSP(unsigned char, WS_V8);
            const int rs = c4, kvh = n16 >> 2, nst = n > 64 ? 64 : n;
            f32x4 oa[4][4];
#pragma unroll
            for (int g = 0; g < 4; ++g)
#pragma unroll
                for (int q = 0; q < 4; ++q) oa[g][q] = (f32x4){0.f, 0.f, 0.f, 0.f};
            u32x4 vr[8], vn[8];
#pragma unroll
            for (int i = 0; i < 8; ++i) vn[i] = *(const u32x4*)(V8 + (size_t)is[64 * rs + i] * 256 + 16 * n16);
            for (int m0 = 0; m0 < nst; m0 += 8) {
#pragma unroll
                for (int i = 0; i < 8; ++i) vr[i] = vn[i];
                if (m0 + 8 < nst) {
#pragma unroll
                    for (int i = 0; i < 8; ++i) vn[i] = *(const u32x4*)(V8 + (size_t)is[64 * rs + m0 + 8 + i] * 256 + 16 * n16);
                }
                __builtin_amdgcn_sched_barrier(0);
#pragma unroll
                for (int h4 = 0; h4 < 2; ++h4) {
                    u32x2 pg[4];
#pragma unroll
                    for (int g = 0; g < 4; ++g) pg[g] = *(const LAS u32x2*)(ps + (kvh * 4 + g) * 256 + 64 * rs + m0 + 4 * h4);
#pragma unroll
                    for (int i = 0; i < 4; ++i) {
                        const u32x4 v_ = vr[4 * h4 + i];
                        const f32x4 v0 = fp8x4_f32(v_.x), v1 = fp8x4_f32(v_.y), v2 = fp8x4_f32(v_.z), v3 = fp8x4_f32(v_.w);
#pragma unroll
                        for (int g = 0; g < 4; ++g) { const unsigned pw = (i < 2) ? pg[g].x : pg[g].y; const float pf = (i & 1) ? bfhi(pw) : bflo(pw);
                            oa[g][0] += pf * v0; oa[g][1] += pf * v1; oa[g][2] += pf * v2; oa[g][3] += pf * v3; }
                    }
                }
            }
#pragma unroll
            for (int g = 0; g < 4; ++g)
#pragma unroll
                for (int q = 0; q < 4; ++q)
#pragma unroll
                    for (int e_ = 0; e_ < 4; ++e_) { float x = oa[g][q][e_]; x += __shfl_xor(x, 16); x += __shfl_xor(x, 32); oa[g][q][e_] = x; }
            if (rs == 0) {
                const f32x4 iv = *(const LAS f32x4*)(invs + 4 * kvh);
#pragma unroll
                for (int g = 0; g < 4; ++g) { bf16_t* op = O + (size_t)row * D + (kvh * 4 + g) * 64 + 16 * (n16 & 3);
                    u32x4 w0, w1; const float sc_ = iv[g];
                    w0.x = pk_bf16(oa[g][0][0] * sc_, oa[g][0][1] * sc_); w0.y = pk_bf16(oa[g][0][2] * sc_, oa[g][0][3] * sc_); w0.z = pk_bf16(oa[g][1][0] * sc_, oa[g][1][1] * sc_); w0.w = pk_bf16(oa[g][1][2] * sc_, oa[g][1][3] * sc_);
                    w1.x = pk_bf16(oa[g][2][0] * sc_, oa[g][2][1] * sc_); w1.y = pk_bf16(oa[g][2][2] * sc_, oa[g][2][3] * sc_); w1.z = pk_bf16(oa[g][3][0] * sc_, oa[g][3][1] * sc_); w1.w = pk_bf16(oa[g][3][2] * sc_, oa[g][3][3] * sc_);
                    *(u32x4*)op = w0; *(u32x4*)(op + 8) = w1; }
            }
        } else {
        f32x4 o0 = {0.f, 0.f, 0.f, 0.f}, o1 = o0, o2 = o0, o3 = o0;
        constexpr int GV = SAMPLE ? 16 : 32;
        const int ng = (n + GV - 1) / GV;
        unsigned vb[SAMPLE ? 1 : GV], vbn[SAMPLE ? 1 : GV]; f32x4 vf[SAMPLE ? GV : 1];
        const unsigned char* V8 = WSP(unsigned char, WS_V8);
        if (!SAMPLE) {
#pragma unroll
            for (int i = 0; i < GV; ++i) vbn[i] = *(const unsigned*)(V8 + (size_t)is[i] * 256 + 4 * lane);
        }
#pragma unroll 1
        for (int g = 0; g < ng; ++g) {
            if (!SAMPLE) {
#pragma unroll
                for (int i = 0; i < GV; ++i) vb[i] = vbn[i];
                if (g + 1 < ng) {
#pragma unroll
                    for (int i = 0; i < GV; ++i) vbn[i] = *(const unsigned*)(V8 + (size_t)is[GV * (g + 1) + i] * 256 + 4 * lane);
                }
                __builtin_amdgcn_sched_barrier(0);
            } else {
#pragma unroll
                for (int i = 0; i < GV; ++i) { const int r = is[GV * g + i]; vf[i] = *(const f32x4*)(((r & 0x40000000) ? vnew + (size_t)(r & 0xffff) * 256 : vc + (size_t)r * 256) + 4 * lane); }
            }
#pragma unroll
            for (int i4 = 0; i4 < GV / 4; ++i4) {
                const u32x2 p0 = *(const LAS u32x2*)(ps + (c4 * 4 + 0) * 256 + GV * g + 4 * i4), p1 = *(const LAS u32x2*)(ps + (c4 * 4 + 1) * 256 + GV * g + 4 * i4),
                            p2 = *(const LAS u32x2*)(ps + (c4 * 4 + 2) * 256 + GV * g + 4 * i4), p3 = *(const LAS u32x2*)(ps + (c4 * 4 + 3) * 256 + GV * g + 4 * i4);
                f32x4 v0, v1, v2, v3;
                if (!SAMPLE) { v0 = fp8x4_f32(vb[4 * i4]); v1 = fp8x4_f32(vb[4 * i4 + 1]); v2 = fp8x4_f32(vb[4 * i4 + 2]); v3 = fp8x4_f32(vb[4 * i4 + 3]); }
                else { v0 = vf[4 * i4]; v1 = vf[4 * i4 + 1]; v2 = vf[4 * i4 + 2]; v3 = vf[4 * i4 + 3]; }
                o0 += bflo(p0.x) * v0 + bfhi(p0.x) * v1 + bflo(p0.y) * v2 + bfhi(p0.y) * v3;
                o1 += bflo(p1.x) * v0 + bfhi(p1.x) * v1 + bflo(p1.y) * v2 + bfhi(p1.y) * v3;
                o2 += bflo(p2.x) * v0 + bfhi(p2.x) * v1 + bflo(p2.y) * v2 + bfhi(p2.y) * v3;
                o3 += bflo(p3.x) * v0 + bfhi(p3.x) * v1 + bflo(p3.y) * v2 + bfhi(p3.y) * v3;
            }
        }
        { const f32x4 iv = *(const LAS f32x4*)(invs + 4 * c4); bf16_t* op = O + (size_t)row * D + c4 * 256 + 4 * n16; st_bf4(op, o0 * iv[0]); st_bf4(op + 64, o1 * iv[1]); st_bf4(op + 128, o2 * iv[2]); st_bf4(op + 192, o3 * iv[3]); }
        }
    }
}

__global__ void __launch_bounds__(512, 2) mega(P p_unused) {
    extern __shared__ __attribute__((aligned(16))) unsigned char lds_raw[];
    LAS unsigned char* lds = (LAS unsigned char*)lds_raw;
    volatile LAS unsigned* misc = (volatile LAS unsigned*)(lds + LDS_MISC);
    if (TID() < 4) misc[TID()] = 0u;
    __syncthreads();
    KP p = kargs();
    const bool multi = (p->ph_hi - p->ph_lo) > 1;
    XcdBarrier bar; bar.bar = WSP(unsigned, WS_BAR); bar.x = 0; bar.st = misc;
    if (multi) bar = xcd_barrier_post(WSP(unsigned, WS_BAR), misc);
    int ph = 0;
    const int lo = p->ph_lo, hi = p->ph_hi;
#ifndef REPMASK
#define REPMASK 0ull
#endif
#define PH_BEGIN if (ph >= lo && ph < hi) { KP p = kargs(); const int nrep_ = ((REPMASK >> ph) & 1ull) ? 3 : 1; for (int rep_ = 0; rep_ < nrep_; ++rep_) {
#define PH_END   if (ph + 1 < hi || rep_ + 1 < nrep_) xcd_barrier(bar); } } ++ph;

    PH_BEGIN phase_ada(p, lds); phase_weights(p, lds); PH_END

    for (int layer = 0; layer < 4; ++layer) {
        const int j = layer >> 1;
        if ((layer & 1) == 0) {
            PH_BEGIN phase_prep<true>(p, layer, 0, j, layer == 0); PH_END
            PH_BEGIN {
                FRwkvIn f{WSP(bf16_t, WS_RB), WSP(bf16_t, WS_KB), WSP(bf16_t, WS_VB), WSP(bf16_t, WS_TW), WSP(bf16_t, WS_TA), WSP(bf16_t, WS_TV), WSP(bf16_t, WS_TG)};
                pg8::Gemm g{WSP(bf16_t, WS_XR), WSP(bf16_t, WS_WRW_T) + (size_t)j * 4096 * D, NP, j == 0 ? 3840 : 4096, D, j == 0 ? 2 : 1, XR_STRIDE};
                pg8::StaticOrder S; S.init(NP, g.N, (int)gridDim.x, BID());
                pg8::EpiAdapt<FRwkvIn, true> E{f};
                pg8::gemm_phase(lds, g, S, E);
                wgemm_ks<true>(lds, WSP(bf16_t, WS_XR), D, XR_STRIDE, NP, NS, WSP(bf16_t, WS_WRW_T) + (size_t)j * 4096 * D, D, 4096, f);
            } PH_END
            PH_BEGIN {
                FStoreF32 fw{WSP(float, WS_WP), D, D}, fa{WSP(float, WS_AP), D, D}, fv{WSP(float, WS_VP), D, D}, fg{WSP(float, WS_GG), D, D};
                wgemm_w(WSP(bf16_t, WS_TW), 64, NP, NS, WSP(bf16_t, WS_W2T) + (size_t)j * D * 64, 64, D, fw);
                wgemm_w(WSP(bf16_t, WS_TA), 64, NP, NS, WSP(bf16_t, WS_A2T) + (size_t)j * D * 64, 64, D, fa);
                if (j == 1) wgemm_w(WSP(bf16_t, WS_TV), 32, NP, NS, WSP(bf16_t, WS_V2T), 32, D, fv);
                wgemm_w(WSP(bf16_t, WS_TG), 160, NP, NS, WSP(bf16_t, WS_G2T) + (size_t)j * D * 160, 160, D, fg);
                phase_chunk(p, j, lds);
            } PH_END
            PH_BEGIN phase_carry(p, j, lds); PH_END
            PH_BEGIN phase_post2(p, j, lds); PH_END
        } else {
            PH_BEGIN phase_prep<false>(p, layer, 0, j); PH_END
            PH_BEGIN {
                FStoreF32 f{WSP(float, WS_PR), PINP, PINP};
                pg8::Gemm g{WSP(bf16_t, WS_XR), WSP(bf16_t, WS_WIN_T) + (size_t)j * PINP * D, NP, PINP, D, 0, 0};
                pg8::StaticOrder S; S.init(NP, PINP, (int)gridDim.x, BID());
                pg8::EpiAdapt<FStoreF32, false> E{f};
                pg8::gemm_phase(lds, g, S, E);
                FStoreF32 fs{WSP(float, WS_PR), PINP, PIN};
                wgemm_ks<false>(lds, WSP(bf16_t, WS_XR), D, 0, NP, NS, WSP(bf16_t, WS_WIN_T) + (size_t)j * PINP * D, D, PINP, fs);
            } PH_END
            PH_BEGIN phase_dsapost(p, j); PH_END
            PH_BEGIN phase_idx2<false>(p, j); phase_idx2<true>(p, j); PH_END
            PH_BEGIN phase_topk_prompt(p); phase_topk_sample(p, lds); PH_END
            PH_BEGIN phase_attn<true>(p, j, lds); phase_attn<false>(p, j, lds); PH_END
        }
        PH_BEGIN {
            FResid f{p->out, WSP(float, WS_MODS) + (size_t)layer * 36 * 6144 + 2 * D, layer == 0 ? p->x_prompt : nullptr, layer == 0 ? p->x_sample : nullptr};
            const bf16_t* Wt = ((layer & 1) == 0 ? WSP(bf16_t, WS_WO_T) : WSP(bf16_t, WS_WAO_T)) + (size_t)j * D * D;
            pg8::Gemm g{WSP(bf16_t, WS_YG), Wt, NP, D, D, 0, 0};
            pg8::StaticOrder S; S.init(NP, D, (int)gridDim.x, BID());
            pg8::EpiAdapt<FResid, false> E{f};
            pg8::gemm_phase(lds, g, S, E);
            wgemm_ks<false>(lds, WSP(bf16_t, WS_YG), D, 0, NP, NS, Wt, D, D, f);
        } PH_END
        PH_BEGIN phase_prep<false>(p, layer, 1, j); PH_END
        PH_BEGIN {
            FRelu2 f{WSP(bf16_t, WS_U)};
            pg8::Gemm g{WSP(bf16_t, WS_XR), WSP(bf16_t, WS_WUP_T) + (size_t)layer * DFF * D, NP, DFF, D, 0, 0};
            pg8::StaticOrder S; S.init(NP, DFF, (int)gridDim.x, BID());
            pg8::EpiAdapt<FRelu2, true> E{f};
            pg8::gemm_phase(lds, g, S, E);
            wgemm_ks<false>(lds, WSP(bf16_t, WS_XR), D, 0, NP, NS, WSP(bf16_t, WS_WUP_T) + (size_t)layer * DFF * D, D, DFF, f);
        } PH_END
        PH_BEGIN {
            FResid f{p->out, WSP(float, WS_MODS) + (size_t)layer * 36 * 6144 + 5 * D, nullptr, nullptr};
            pg8::Gemm g{WSP(bf16_t, WS_U), WSP(bf16_t, WS_WDN_T) + (size_t)layer * DFF * D, NP, D, DFF, 0, 0};
            pg8::StaticOrder S; S.init(NP, D, (int)gridDim.x, BID());
            pg8::EpiAdapt<FResid, false> E{f};
            pg8::gemm_phase(lds, g, S, E);
            wgemm_ks<false>(lds, WSP(bf16_t, WS_U), DFF, 0, NP, NS, WSP(bf16_t, WS_WDN_T) + (size_t)layer * DFF * D, DFF, D, f);
        } PH_END
    }
#undef PH_BEGIN
#undef PH_END
}

static int count_phases() { int n = 1; for (int layer = 0; layer < 4; ++layer) { n += ((layer & 1) == 0) ? 5 : 6; n += 4; } return n; }

extern "C" void kernel_launch(void* const* d_in, const int* in_sizes, int n_in, void* d_out, int out_size, void* d_ws, size_t ws_size, hipStream_t stream) {
    static int grid = 0;
    if (grid == 0) {
        if (n_in != 39 || out_size != (int)O_END || ws_size < WS_END) { fprintf(stderr, "kernel_launch: unexpected shapes n_in %d out %d ws %zu (need %zu)\n", n_in, out_size, ws_size, (size_t)WS_END); grid = -1; return; }
        int dev = 0, cus = 0, per_cu = 0;
        if (hipGetDevice(&dev) != hipSuccess || hipDeviceGetAttribute(&cus, hipDeviceAttributeMultiprocessorCount, dev) != hipSuccess) { grid = -1; return; }
        if (hipFuncSetAttribute((const void*)mega, hipFuncAttributeMaxDynamicSharedMemorySize, LDS_BYTES) != hipSuccess) { fprintf(stderr, "kernel_launch: hipFuncSetAttribute failed\n"); grid = -1; return; }
        if (hipOccupancyMaxActiveBlocksPerMultiprocessor(&per_cu, (const void*)mega, 512, LDS_BYTES) != hipSuccess || per_cu < 1) fprintf(stderr, "kernel_launch: occupancy query says %d\n", per_cu);
        (void)hipGetLastError();
        grid = cus;
    }
    if (grid < 0) return;
    (void)hipMemsetAsync((char*)d_ws + WS_BAR, 0, 65536, stream);
    P p{};
    memcpy((void*)&p, (const void*)d_in, 39 * sizeof(void*));
    p.out = (float*)d_out; p.ws = (unsigned char*)d_ws;
#ifndef STOP_PH
#define STOP_PH 1000
#endif
    const int nph = count_phases() < STOP_PH ? count_phases() : STOP_PH;
#ifndef ONE_LAUNCH
    for (int ph = 0; ph < nph; ++ph) { p.ph_lo = ph; p.ph_hi = ph + 1; hipLaunchKernelGGL(mega, dim3(grid), dim3(512), LDS_BYTES, stream, p); }
#else
    p.ph_lo = 0; p.ph_hi = nph; hipLaunchKernelGGL(mega, dim3(grid), dim3(512), LDS_BYTES, stream, p);
#endif
}
```

```cpp
#define ONE_LAUNCH 1
#include <hip/hip_runtime.h>
#include <cstdio>
#include <cstdint>
#include <cstring>

#define LAS __attribute__((address_space(3)))
typedef unsigned short bf16_t;
typedef short bf16x8 __attribute__((ext_vector_type(8)));
typedef float f32x4 __attribute__((ext_vector_type(4)));
typedef float f32x2 __attribute__((ext_vector_type(2)));
typedef unsigned u32x4 __attribute__((ext_vector_type(4)));
typedef unsigned u32x2 __attribute__((ext_vector_type(2)));

constexpr int D = 1024, NP = 16384, NS = 256, NT = NP + NS, SEQL = 4096, PAST = 8192, NSEQ = 36, DFF = 4096;
constexpr int PIN = 2120, PINP = 2304;
constexpr int TOPK = 256, SCS_LD = 8320;
constexpr size_t O_YP = 0, O_YS = 16777216, O_KP = 17039360, O_VP = 25427968, O_IKP = 33816576, O_WKVP = 35913728, O_SHP = 36438016,
                 O_KS = 36446208, O_VS = 36577280, O_IKS = 36708352, O_WKVS = 36741120, O_SHS = 40935424, O_END = 41000960;
constexpr size_t al256(size_t x) { return (x + 255) & ~(size_t)255; }
constexpr size_t WS_BAR = 0;
constexpr size_t WS_MODS = 65536;
constexpr size_t WS_WUP_T = al256(WS_MODS + (size_t)4 * NSEQ * 6144 * 4);
constexpr size_t WS_WDN_T = WS_WUP_T + (size_t)4 * DFF * D * 2;
constexpr size_t WS_WRW_T = WS_WDN_T + (size_t)4 * DFF * D * 2;
constexpr size_t WS_WO_T = WS_WRW_T + (size_t)2 * 4096 * D * 2;
constexpr size_t WS_WIN_T = WS_WO_T + (size_t)2 * D * D * 2;
constexpr size_t WS_WAO_T = WS_WIN_T + (size_t)2 * PINP * D * 2;
constexpr size_t WS_W2T = WS_WAO_T + (size_t)2 * D * D * 2;
constexpr size_t WS_A2T = WS_W2T + (size_t)2 * D * 64 * 2;
constexpr size_t WS_V2T = WS_A2T + (size_t)2 * D * 64 * 2;
constexpr size_t WS_G2T = WS_V2T + (size_t)D * 32 * 2;
constexpr size_t WS_XR = WS_G2T + (size_t)2 * D * 160 * 2;
constexpr size_t XR_STRIDE = (size_t)NT * D;
constexpr size_t WS_RB = WS_XR + 6 * XR_STRIDE * 2;
constexpr size_t WS_KB = WS_RB + XR_STRIDE * 2;
constexpr size_t WS_VB = WS_KB + XR_STRIDE * 2;
constexpr size_t WS_TW = WS_VB + XR_STRIDE * 2;
constexpr size_t WS_TA = WS_TW + (size_t)NT * 64 * 2;
constexpr size_t WS_TV = WS_TA + (size_t)NT * 64 * 2;
constexpr size_t WS_TG = WS_TV + (size_t)NT * 32 * 2;
constexpr size_t WS_WP = al256(WS_TG + (size_t)NT * 160 * 2);
constexpr size_t F32A = (size_t)NT * D * 4;
constexpr size_t WS_AP = WS_WP + F32A, WS_VP = WS_AP + F32A, WS_GG = WS_VP + F32A, WS_VFIRST = WS_GG + F32A;
constexpr size_t WS_DEC = WS_VFIRST + F32A, WS_KM = WS_DEC + F32A, WS_VM = WS_KM + F32A, WS_AV = WS_VM + F32A, WS_BV = WS_AV + F32A, WS_Y = WS_BV + F32A;
constexpr size_t WS_YG = WS_Y + F32A;
constexpr size_t WS_U = WS_YG + XR_STRIDE * 2;
constexpr size_t WS_PR = WS_U + (size_t)NT * DFF * 2;
constexpr size_t WS_Q = WS_PR + (size_t)NT * PINP * 4;
constexpr size_t WS_QI = WS_Q + F32A;
constexpr size_t WS_WI = WS_QI + (size_t)NT * 512 * 4;
constexpr size_t WS_SC = al256(WS_WI + (size_t)NT * 8 * 4);
constexpr size_t WS_SCS = WS_SC + (size_t)4 * 4096 * 4096 * 4;
constexpr size_t WS_SEL = al256(WS_SCS + (size_t)NS * SCS_LD * 4);
constexpr size_t WS_CNT = WS_SEL + (size_t)NT * 256 * 4;
constexpr size_t WS_KBF = al256(WS_CNT + (size_t)NT * 4);
constexpr size_t WS_VBF = WS_KBF + (size_t)NT * 256 * 2;
constexpr size_t WS_QIB = WS_VBF + (size_t)NT * 256 * 2;
constexpr size_t WS_KIB = WS_QIB + (size_t)NT * 512 * 2;
constexpr size_t WS_K8 = al256(WS_KIB + (size_t)NT * 64 * 2);
constexpr size_t WS_V8 = WS_K8 + (size_t)NT * 256;
constexpr size_t WS_END = al256(WS_V8 + (size_t)NT * 256);

constexpr int LCH = 64, NCH = SEQL / LCH;
constexpr size_t WS_PCH = WS_SC, WS_CCH = WS_PCH + (size_t)64 * NCH * 4096 * 4, WS_SST = WS_CCH + (size_t)64 * NCH * 4096 * 4;
static_assert(WS_SST + (size_t)64 * NCH * 4096 * 4 <= WS_SCS, "scan buffers must fit the aliased region");
constexpr int LDS_BYTES = 147456;
constexpr int LDS_MISC = 131072;

typedef __bf16 bf16x2_t __attribute__((ext_vector_type(2)));
__device__ __forceinline__ unsigned pk_bf16(float lo, float hi) { const f32x2 v = {lo, hi}; const bf16x2_t b = __builtin_convertvector(v, bf16x2_t); return __builtin_bit_cast(unsigned, b); }
__device__ __forceinline__ unsigned pk_fp8x4(f32x4 v) { int w = 0; w = __builtin_amdgcn_cvt_pk_fp8_f32(v[0], v[1], w, false); w = __builtin_amdgcn_cvt_pk_fp8_f32(v[2], v[3], w, true); return (unsigned)w; }
__device__ __forceinline__ f32x4 fp8x4_f32(unsigned w) { return (f32x4){__builtin_amdgcn_cvt_f32_fp8((int)w, 0), __builtin_amdgcn_cvt_f32_fp8((int)w, 1), __builtin_amdgcn_cvt_f32_fp8((int)w, 2), __builtin_amdgcn_cvt_f32_fp8((int)w, 3)}; }
__device__ __forceinline__ float bf2f(unsigned short x) { return __uint_as_float((unsigned)x << 16); }
__device__ __forceinline__ float bflo(unsigned x) { return __uint_as_float(x << 16); }
__device__ __forceinline__ float bfhi(unsigned x) { return __uint_as_float(x & 0xffff0000u); }
__device__ __forceinline__ f32x4 ld_bf4(const bf16_t* p) { const u32x2 v = *(const u32x2*)p; return (f32x4){bflo(v.x), bfhi(v.x), bflo(v.y), bfhi(v.y)}; }
__device__ __forceinline__ void st_bf4(bf16_t* p, f32x4 v) { u32x2 w; w.x = pk_bf16(v[0], v[1]); w.y = pk_bf16(v[2], v[3]); *(u32x2*)p = w; }
template <int CTRL> __device__ __forceinline__ float dppf(float v) { return __int_as_float(__builtin_amdgcn_update_dpp(0, __float_as_int(v), CTRL, 0xf, 0xf, false)); }
template <int CTRL> __device__ __forceinline__ int dppi(int v) { return __builtin_amdgcn_update_dpp(0, v, CTRL, 0xf, 0xf, false); }
__device__ __forceinline__ float g16_sum(float v) { v += dppf<0xB1>(v); v += dppf<0x4E>(v); v += dppf<0x141>(v); v += dppf<0x140>(v); return v; }
__device__ __forceinline__ float g16_max(float v) { v = fmaxf(v, dppf<0xB1>(v)); v = fmaxf(v, dppf<0x4E>(v)); v = fmaxf(v, dppf<0x141>(v)); v = fmaxf(v, dppf<0x140>(v)); return v; }
__device__ __forceinline__ int g16_sum_i(int v) { v += dppi<0xB1>(v); v += dppi<0x4E>(v); v += dppi<0x141>(v); v += dppi<0x140>(v); return v; }
__device__ __forceinline__ int g16_min_i(int v) { v = min(v, dppi<0xB1>(v)); v = min(v, dppi<0x4E>(v)); v = min(v, dppi<0x141>(v)); v = min(v, dppi<0x140>(v)); return v; }
__device__ __forceinline__ float rlf(float v, int k) { return __int_as_float(__builtin_amdgcn_readlane(__float_as_int(v), k)); }
__device__ __forceinline__ float wave_sum(float v) { v = g16_sum(v); return (rlf(v, 0) + rlf(v, 16)) + (rlf(v, 32) + rlf(v, 48)); }
__device__ __forceinline__ float wave_max(float v) { v = g16_max(v); return fmaxf(fmaxf(rlf(v, 0), rlf(v, 16)), fmaxf(rlf(v, 32), rlf(v, 48))); }
__device__ __forceinline__ int wave_sum_i(int v) { v = g16_sum_i(v); return (__builtin_amdgcn_readlane(v, 0) + __builtin_amdgcn_readlane(v, 16)) + (__builtin_amdgcn_readlane(v, 32) + __builtin_amdgcn_readlane(v, 48)); }
__device__ __forceinline__ int wave_min_i(int v) { v = g16_min_i(v); return min(min(__builtin_amdgcn_readlane(v, 0), __builtin_amdgcn_readlane(v, 16)), min(__builtin_amdgcn_readlane(v, 32), __builtin_amdgcn_readlane(v, 48))); }
__device__ __forceinline__ float sigmoidf_(float x) { return 1.0f / (1.0f + expf(-x)); }
__device__ __forceinline__ float fsig(float x) { return __builtin_amdgcn_rcpf(1.0f + __expf(-x)); }
__device__ __forceinline__ float ftanh(float x) { return 2.0f * fsig(2.0f * x) - 1.0f; }
__device__ __forceinline__ int row_seq(int row) { return row < NP ? (row >> 12) : 4 + ((row - NP) >> 3); }
__device__ __forceinline__ int row_pos(int row) { return row < NP ? (row & 4095) : PAST + ((row - NP) & 7); }
__device__ __forceinline__ int TID() { int t = threadIdx.x; asm volatile("" : "+v"(t)); return t; }
__device__ __forceinline__ int BID() { int b = blockIdx.x; asm volatile("" : "+s"(b)); return b; }
__device__ __forceinline__ void wave_lds_fence() { __builtin_amdgcn_fence(__ATOMIC_RELEASE, "wavefront"); __builtin_amdgcn_wave_barrier(); __builtin_amdgcn_fence(__ATOMIC_ACQUIRE, "wavefront"); }

#define XB_TMO      128
#define XB_XCNT(j)  (256  + 64 * (j))
#define XB_XSUB(j)  (1280 + 64 * (j))
#define XB_XGEN(j)  (2304 + 64 * (j))
#define XB_TOP      3328
#define XB_TOPGEN   3392
#define XCD_BAR_WORDS 3456
#define XB_SPIN_CAP (1u << 22)
__device__ __forceinline__ unsigned xb_ld(unsigned* p)              { return __hip_atomic_load(p, __ATOMIC_RELAXED, __HIP_MEMORY_SCOPE_AGENT); }
__device__ __forceinline__ unsigned xb_add(unsigned* p, unsigned v) { return __hip_atomic_fetch_add(p, v, __ATOMIC_RELAXED, __HIP_MEMORY_SCOPE_AGENT); }
__device__ __forceinline__ unsigned xb_xcc_id() { return (unsigned)__builtin_amdgcn_s_getreg((3 << 11) | 20) & 0xFu; }
#define XB_SPIN(cond, bar) do { unsigned _sp = 0; while (cond) { __builtin_amdgcn_s_sleep(1); \
    if ((++_sp & 255u) == 0u) { if (xb_ld(&(bar)[XB_TMO])) break; if (_sp > XB_SPIN_CAP) { atomicAdd(&(bar)[XB_TMO], 1u); break; } } } } while (0)
struct XcdBarrier { unsigned* bar; unsigned x; volatile LAS unsigned* st; };
__device__ __forceinline__ XcdBarrier xcd_barrier_post(unsigned* bar, volatile LAS unsigned* st) {
    XcdBarrier b; b.bar = bar; b.x = xb_xcc_id(); b.st = st;
    if (threadIdx.x == 0) (void)xb_add(&bar[XB_XCNT(b.x)], 1u);
    return b;
}
__device__ __forceinline__ void xcd_barrier_complete(unsigned* bar, unsigned x, unsigned& nloc, unsigned& nx) {
    const unsigned G = gridDim.x * gridDim.y * gridDim.z;
    unsigned sum, cnt, mine, sp = 0u;
    for (;;) {
        sum = 0u; cnt = 0u; mine = 0u;
#pragma unroll
        for (unsigned j = 0; j < 16; ++j) { const unsigned c = xb_ld(&bar[XB_XCNT(j)]); sum += c; cnt += (c > 0u) ? 1u : 0u; mine = (j == x) ? c : mine; }
        if (sum == G) break;
        __builtin_amdgcn_s_sleep(1);
        if ((++sp & 255u) == 0u) { if (xb_ld(&bar[XB_TMO])) break; if (sp > XB_SPIN_CAP) { atomicAdd(&bar[XB_TMO], 1u); break; } }
    }
    nloc = mine > 0u ? mine : 1u; nx = cnt > 0u ? cnt : 1u;
}
__device__ __forceinline__ void xcd_barrier(const XcdBarrier& b) {
    asm volatile("s_waitcnt vmcnt(0)" ::: "memory");
    __syncthreads();
    if (threadIdx.x == 0) {
        unsigned* bar = b.bar;
        __builtin_amdgcn_s_waitcnt(0);
        unsigned nloc = b.st[0], nx = b.st[1];
        if (nloc == 0u) { xcd_barrier_complete(bar, b.x, nloc, nx); b.st[0] = nloc; b.st[1] = nx; }
        const unsigned old = xb_add(&bar[XB_XSUB(b.x)], 1u);
        const unsigned gen = old / nloc;
        if (old + 1u == (gen + 1u) * nloc) {
            __builtin_amdgcn_fence(__ATOMIC_RELEASE, "agent");
            asm volatile("s_waitcnt vmcnt(0)" ::: "memory");
            const unsigned og = xb_add(&bar[XB_TOP], 1u);
            const unsigned tg = og / nx;
            if (og + 1u == (tg + 1u) * nx) xb_add(&bar[XB_TOPGEN], 1u);
            else XB_SPIN(xb_ld(&bar[XB_TOPGEN]) == tg, bar);
            __builtin_amdgcn_fence(__ATOMIC_ACQUIRE, "agent");
            xb_add(&bar[XB_XGEN(b.x)], 1u);
            asm volatile("s_waitcnt vmcnt(0)" ::: "memory");
        } else {
            XB_SPIN(xb_ld(&bar[XB_XGEN(b.x)]) == gen, bar);
            __builtin_amdgcn_fence(__ATOMIC_ACQUIRE, "agent");
            asm volatile("s_waitcnt vmcnt(0)" ::: "memory");
        }
    }
    __syncthreads();
}

struct P {
    const float *x_prompt, *x_sample, *cache_k, *cache_v, *cache_ik, *state_wkv, *state_shift; const int* page_table;
    const float *c_prompt, *c_sample, *norm_g, *w_ada, *b_ada, *w_up, *w_down, *rw_mix, *rw_w_rkv, *rw_w_o, *rw_w0, *rw_w1, *rw_w2, *rw_a0, *rw_a1, *rw_a2,
                *rw_v0, *rw_v1, *rw_v2, *rw_g1, *rw_g2, *rw_k_k, *rw_k_a, *rw_r_k, *rw_lnx_w, *rw_lnx_b, *att_w_in, *att_w_o, *att_q_norm, *att_k_norm, *idx_k_norm;
    float* out; unsigned char* ws; int ph_lo, ph_hi;
};
typedef const P __attribute__((address_space(4)))* KP;
#define WSP(T, off) ((T*)(p->ws + (off)))
__device__ __forceinline__ KP kargs() { KP k = (KP)__builtin_amdgcn_kernarg_segment_ptr(); asm volatile("" : "+s"(k)); return k; }

namespace pg8 {
constexpr int BM = 256, BK = 64, HALF = 128, HTB = HALF * BK * 2, STAGE_BYTES = 8 * HTB, NXCD = 8, WGM = 8;
__device__ __forceinline__ int lds_byte(int r, int c) { const int st = (r >> 4) * 2 + (c >> 5), rr = r & 15, cc = c & 31, ob = rr * 64 + cc * 2; return st * 1024 + (ob ^ (((ob >> 9) & 1) << 5)); }
__device__ __forceinline__ void stage_rc(int b, int& R, int& C) { const int st = b / 1024, sb = b % 1024, swz = sb ^ (((sb >> 9) & 1) << 5); R = (st >> 1) * 16 + swz / 64; C = (st & 1) * 32 + (swz % 64) / 2; }
__device__ __forceinline__ int perm32(int rho) { const int n = rho >> 4, i = rho & 15; return 8 * (i >> 2) + 4 * n + (i & 3); }
struct Unit { int pm, pn; };
struct Gemm { const bf16_t* A; const bf16_t* Bt; int M, N, K, mode; size_t agrp; };
__device__ __forceinline__ int phys_pn(const Gemm& g, int pn) { return (g.mode == 2 && pn >= 12) ? pn + 1 : pn; }
__device__ __forceinline__ const char* a_ptr(const Gemm& g, const Unit& u, size_t tstep) {
    int grp = 0; if (g.mode) grp = u.pn < 12 ? (u.pn >> 2) : (u.pn == 12 ? 2 : u.pn - 10);
    return (const char*)g.A + (size_t)grp * g.agrp * 2 + (size_t)u.pm * tstep; }
struct StaticOrder {
    int nM, nN, nwg, G, c;
    __device__ void init(int M, int N, int G_, int c_) { nM = M / BM; nN = N / BM; nwg = nM * nN; G = G_; c = c_; }
    __device__ bool next(int i, Unit& u) const {
        const long L = (long)i * G + c; if (L >= nwg) return false;
        int wgid = (int)L; { const int q = nwg / NXCD, r = nwg % NXCD, xcd = wgid % NXCD, off = wgid / NXCD; wgid = (xcd < r ? xcd * (q + 1) : r * (q + 1) + (xcd - r) * q) + off; }
        const int nig = WGM * nN, gid = wgid / nig, fm = gid * WGM, gsz = (nM - fm) < WGM ? (nM - fm) : WGM;
        u.pm = fm + ((wgid % nig) % gsz); u.pn = (wgid % nig) / gsz; return true;
    }
};
template <class F, bool PERM_> struct EpiAdapt {
    static constexpr bool PERM = PERM_;
    F f;
    __device__ __forceinline__ void operator()(const f32x4 (&acc)[2][2][4][2], const Unit& u, int wr, int wc, int fr, int fq) const {
        const int row0 = u.pm * BM + wr * 64 + fr, col0 = u.pn * BM + wc * 32 + (PERM ? 8 * fq : 4 * fq);
#pragma unroll
        for (int ai = 0; ai < 2; ++ai)
#pragma unroll
            for (int m = 0; m < 4; ++m)
#pragma unroll
                for (int bj = 0; bj < 2; ++bj) {
                    if constexpr (PERM) f.vec8(row0 + ai * HALF + m * 16, col0 + bj * HALF, acc[ai][bj][m][0], acc[ai][bj][m][1]);
                    else {
#pragma unroll
                        for (int n = 0; n < 2; ++n) f.vec4(row0 + ai * HALF + m * 16, col0 + bj * HALF + 16 * n, acc[ai][bj][m][n]);
                    }
                }
    }
};

template <class Epi>
__device__ __forceinline__ void gemm_phase(LAS unsigned char* lds, const Gemm g, const StaticOrder& S, const Epi& E) {
    const int tid = TID(), wid = __builtin_amdgcn_readfirstlane(tid >> 6), lane = tid & 63, wr = wid >> 2, wc = wid & 3, fr = lane & 15, fq = lane >> 4;
    const int K = g.K, nt = K / BK;
    unsigned voffA[2], voffB[2];
#pragma unroll
    for (int i = 0; i < 2; ++i) { int R, C; stage_rc(tid * 16 + i * 8192, R, C); const int Rb = Epi::PERM ? ((R & ~31) + perm32(R & 31)) : R;
        voffA[i] = (unsigned)(R * K + C) * 2u; voffB[i] = (unsigned)(Rb * K + C) * 2u; }
    const size_t kstep = (size_t)(BK * 2);
    const size_t hstep = (size_t)HALF * K * 2;
    const size_t tstep = 2 * hstep;
    const unsigned ldsw = (unsigned)wid * 1024u;
    const int aoff = lds_byte(wr * 64 + fr, fq * 8), boff = lds_byte(wc * 32 + fr, fq * 8);
#define PG8_SA(b, h) (((b) * 2 + (h)) * HTB)
#define PG8_SB(b, h) ((4 + (b) * 2 + (h)) * HTB)
#define PG8_STAGE(bufoff, gbase, voff) do { _Pragma("unroll") for (int _i = 0; _i < 2; ++_i) \
        __builtin_amdgcn_global_load_lds((const unsigned*)((const char*)(gbase) + (voff)[_i]), (LAS unsigned*)(lds + (bufoff) + ldsw + _i * 8192), 16, 0, 0); } while (0)
#define PG8_LDA(dst, b, h) do { _Pragma("unroll") for (int m = 0; m < 4; ++m) _Pragma("unroll") for (int k = 0; k < 2; ++k) dst[m][k] = *(const LAS bf16x8*)(lds + PG8_SA(b, h) + aoff + m * 2048 + k * 1024); } while (0)
#define PG8_LDB(dst, b, h) do { _Pragma("unroll") for (int n = 0; n < 2; ++n) _Pragma("unroll") for (int k = 0; k < 2; ++k) dst[n][k] = *(const LAS bf16x8*)(lds + PG8_SB(b, h) + boff + n * 2048 + k * 1024); } while (0)
#define PG8_MMA(ai, bj, At, Bt) do { __builtin_amdgcn_s_setprio(1); _Pragma("unroll") for (int m = 0; m < 4; ++m) _Pragma("unroll") for (int n = 0; n < 2; ++n) _Pragma("unroll") for (int k = 0; k < 2; ++k) \
        acc[ai][bj][m][n] = __builtin_amdgcn_mfma_f32_16x16x32_bf16(Bt[n][k], At[m][k], acc[ai][bj][m][n], 0, 0, 0); __builtin_amdgcn_s_setprio(0); } while (0)
#define PG8_WAIT_V(n) asm volatile("s_waitcnt vmcnt(" #n ")" ::: "memory")
#define PG8_WAIT_L(n) asm volatile("s_waitcnt lgkmcnt(" #n ")" ::: "memory")
#define PG8_BAR __builtin_amdgcn_s_barrier()
#define PG8_SCHED __builtin_amdgcn_sched_barrier(0)
    Unit cur, nxt; int ui = 0;
    if (!S.next(0, cur)) return;
    cur.pn = phys_pn(g, cur.pn);
    f32x4 acc[2][2][4][2];
#pragma unroll
    for (int a = 0; a < 2; ++a)
#pragma unroll
        for (int b = 0; b < 2; ++b)
#pragma unroll
            for (int m = 0; m < 4; ++m)
#pragma unroll
                for (int n = 0; n < 2; ++n) acc[a][b][m][n] = (f32x4){0.f, 0.f, 0.f, 0.f};
    bf16x8 At[4][2], B0[2][2], B1[2][2];
    const char* cA = a_ptr(g, cur, tstep); const char* cB = (const char*)g.Bt + (size_t)cur.pn * tstep;
    PG8_STAGE(PG8_SB(0, 0), cB, voffB); PG8_STAGE(PG8_SA(0, 0), cA, voffA); PG8_STAGE(PG8_SB(0, 1), cB + hstep, voffB); PG8_STAGE(PG8_SA(0, 1), cA + hstep, voffA);
    if (wr == 1) PG8_BAR;
    PG8_WAIT_V(4); PG8_BAR;
    PG8_STAGE(PG8_SB(1, 0), cB + kstep, voffB); PG8_STAGE(PG8_SA(1, 0), cA + kstep, voffA); PG8_STAGE(PG8_SB(1, 1), cB + hstep + kstep, voffB);
    PG8_WAIT_V(6); PG8_BAR;
    for (;;) {
        const bool has_next = S.next(ui + 1, nxt);
        if (has_next) nxt.pn = phys_pn(g, nxt.pn);
        const char* nA = has_next ? a_ptr(g, nxt, tstep) : cA; const char* nB = has_next ? (const char*)g.Bt + (size_t)nxt.pn * tstep : cB;
        for (int t = 0; t < nt; t += 2) {
            const bool last = (t == nt - 2);
            const char* a1 = cA + (size_t)(t + 1) * kstep;
            const char* a2 = last ? nA : cA + (size_t)(t + 2) * kstep; const char* b2 = last ? nB : cB + (size_t)(t + 2) * kstep;
            const char* a3 = a2 + kstep; const char* b3 = b2 + kstep;
            PG8_LDB(B0, 0, 0); PG8_SCHED; PG8_LDA(At, 0, 0); PG8_STAGE(PG8_SA(1, 1), a1 + hstep, voffA);
            PG8_WAIT_L(8); PG8_BAR; PG8_WAIT_L(0); PG8_MMA(0, 0, At, B0); PG8_BAR; PG8_SCHED;
            PG8_LDB(B1, 0, 1); PG8_STAGE(PG8_SB(0, 0), b2, voffB);
            PG8_BAR; PG8_WAIT_L(0); PG8_MMA(0, 1, At, B1); PG8_BAR;
            PG8_LDA(At, 0, 1); PG8_STAGE(PG8_SA(0, 0), a2, voffA);
            PG8_BAR; PG8_WAIT_L(0); PG8_MMA(1, 0, At, B0); PG8_BAR; PG8_SCHED;
            PG8_STAGE(PG8_SB(0, 1), b2 + hstep, voffB);
            PG8_WAIT_V(6); PG8_BAR; PG8_MMA(1, 1, At, B1); PG8_BAR;
            PG8_LDB(B0, 1, 0); PG8_SCHED; PG8_LDA(At, 1, 0); PG8_STAGE(PG8_SA(0, 1), a2 + hstep, voffA);
            PG8_WAIT_L(8); PG8_BAR; PG8_WAIT_L(0); PG8_MMA(0, 0, At, B0); PG8_BAR; PG8_SCHED;
            PG8_LDB(B1, 1, 1); PG8_STAGE(PG8_SB(1, 0), b3, voffB);
            PG8_BAR; PG8_WAIT_L(0); PG8_MMA(0, 1, At, B1); PG8_BAR;
            PG8_LDA(At, 1, 1); PG8_STAGE(PG8_SA(1, 0), a3, voffA);
            PG8_BAR; PG8_WAIT_L(0); PG8_MMA(1, 0, At, B0); PG8_BAR; PG8_SCHED;
            PG8_STAGE(PG8_SB(1, 1), b3 + hstep, voffB);
            PG8_WAIT_V(6); PG8_BAR; PG8_MMA(1, 1, At, B1); PG8_BAR;
        }
        E(acc, cur, wr, wc, fr, fq);
        if (!has_next) break;
#pragma unroll
        for (int a = 0; a < 2; ++a)
#pragma unroll
            for (int b = 0; b < 2; ++b)
#pragma unroll
                for (int m = 0; m < 4; ++m)
#pragma unroll
                    for (int n = 0; n < 2; ++n) acc[a][b][m][n] = (f32x4){0.f, 0.f, 0.f, 0.f};
        cur = nxt; cA = nA; cB = nB; ++ui;
    }
    PG8_WAIT_V(0);
    if (wr == 0) PG8_BAR;
    PG8_BAR;
#undef PG8_SA
#undef PG8_SB
#undef PG8_STAGE
#undef PG8_LDA
#undef PG8_LDB
#undef PG8_MMA
#undef PG8_WAIT_V
#undef PG8_WAIT_L
#undef PG8_BAR
#undef PG8_SCHED
}
}

template <class F>
__device__ __forceinline__ void sgemm_bf(LAS unsigned char* lds, const bf16_t* A, int lda, int row0, int M, const float* W, int ldw, int N, int K, int coloff, const F& f) {
    LAS float* As = (LAS float*)lds;
    LAS float* Ws = (LAS float*)(lds + 32 * 68 * 4);
    const int tid = TID(), ty = tid >> 4, tx = tid & 15;
    const int ntn = (N + 63) / 64, ntiles = (M / 64) * ntn;
    for (int tile = BID(); tile < ntiles; tile += gridDim.x) {
        const int tm = tile / ntn, tn = tile % ntn, r0 = row0 + tm * 64, n0 = tn * 64;
        f32x4 c0 = {0.f, 0.f, 0.f, 0.f}, c1 = {0.f, 0.f, 0.f, 0.f};
        for (int k0 = 0; k0 < K; k0 += 32) {
            __syncthreads();
            { const int r = tid >> 3, q = tid & 7; const f32x4 a = ld_bf4(A + (size_t)(r0 + r) * lda + k0 + 4 * q);
              As[(4 * q + 0) * 68 + r] = a[0]; As[(4 * q + 1) * 68 + r] = a[1]; As[(4 * q + 2) * 68 + r] = a[2]; As[(4 * q + 3) * 68 + r] = a[3]; }
            { const int kr = tid >> 4, c = tid & 15; f32x4 w = {0.f, 0.f, 0.f, 0.f}; if (n0 + 4 * c < N) w = *(const f32x4*)(W + (size_t)(k0 + kr) * ldw + n0 + 4 * c);
              *(LAS f32x4*)(Ws + kr * 68 + 4 * c) = w; }
            __syncthreads();
#pragma unroll 8
            for (int kk = 0; kk < 32; ++kk) {
                const f32x2 a = *(const LAS f32x2*)(As + kk * 68 + 2 * ty); const f32x4 b = *(const LAS f32x4*)(Ws + kk * 68 + 4 * tx);
                c0 += a.x * b; c1 += a.y * b;
            }
        }
        if (n0 + 4 * tx < N) { f.vec4(r0 + 2 * ty, n0 + 4 * tx + coloff, c0); f.vec4(r0 + 2 * ty + 1, n0 + 4 * tx + coloff, c1); }
    }
    __syncthreads();
}

typedef float f32x16 __attribute__((ext_vector_type(16)));
__device__ __forceinline__ int rw_group(int n0) { const int t = n0 >> 8; return t < 12 ? (t >> 2) : (t == 12 ? 2 : t - 10); }
template <bool RWGRP, class F>
__device__ __forceinline__ void wgemm_ks(LAS unsigned char* lds, const bf16_t* A, int lda, size_t agrp, int row0, int M, const bf16_t* Bt, int K, int N, const F& f) {
    const int tid = TID(), wave = tid >> 6, lane = tid & 63, lr = lane & 31, lh = lane >> 5;
    LAS float* red = (LAS float*)lds;
    const int ntn = N / 64, nitems = (M / 32) * ntn, kw = K / 8, steps = kw / 16;
    for (int item = BID(); item < nitems; item += gridDim.x) {
        const int tm = item / ntn, tn = item % ntn, r0 = row0 + tm * 32, n0 = tn * 64;
        const bf16_t* Ab = A + (RWGRP ? (size_t)rw_group(n0) * agrp : 0) + (size_t)(r0 + lr) * lda + wave * kw + lh * 8;
        const bf16_t* B0 = Bt + (size_t)(n0 + lr) * K + wave * kw + lh * 8; const bf16_t* B1 = B0 + (size_t)32 * K;
        f32x16 acc0, acc1;
#pragma unroll
        for (int r = 0; r < 16; ++r) { acc0[r] = 0.f; acc1[r] = 0.f; }
#pragma unroll 8
        for (int st = 0; st < steps; ++st) {
            const bf16x8 a = *(const bf16x8*)(Ab + 16 * st), b0 = *(const bf16x8*)(B0 + 16 * st), b1 = *(const bf16x8*)(B1 + 16 * st);
            acc0 = __builtin_amdgcn_mfma_f32_32x32x16_bf16(b0, a, acc0, 0, 0, 0);
            acc1 = __builtin_amdgcn_mfma_f32_32x32x16_bf16(b1, a, acc1, 0, 0, 0);
        }
        __syncthreads();
#pragma unroll
        for (int r = 0; r < 16; ++r) { red[((wave * 2 + 0) * 16 + r) * 64 + lane] = acc0[r]; red[((wave * 2 + 1) * 16 + r) * 64 + lane] = acc1[r]; }
        __syncthreads();
        { const int t = tid >> 8, r4 = (tid >> 6) & 3, l2 = tid & 63; f32x4 v = {0.f, 0.f, 0.f, 0.f};
#pragma unroll
          for (int w = 0; w < 8; ++w)
#pragma unroll
              for (int e = 0; e < 4; ++e) v[e] += red[((w * 2 + t) * 16 + 4 * r4 + e) * 64 + l2];
          f.vec4(r0 + (l2 & 31), n0 + 32 * t + 8 * r4 + 4 * (l2 >> 5), v); }
    }
    __syncthreads();
}
template <class F>
__device__ __forceinline__ void wgemm_w(const bf16_t* A, int lda, int row0, int M, const bf16_t* Bt, int K, int N, const F& f) {
    const int lane = TID() & 63, lr = lane & 31, lh = lane >> 5, gw = BID() * 8 + (TID() >> 6), nw = gridDim.x * 8;
    const int ntn = N / 64, nitems = (M / 32) * ntn, steps = K / 16;
    for (int item = gw; item < nitems; item += nw) {
        const int tm = item / ntn, tn = item % ntn, r0 = row0 + tm * 32, n0 = tn * 64;
        const bf16_t* Ab = A + (size_t)(r0 + lr) * lda + lh * 8;
        const bf16_t* B0 = Bt + (size_t)(n0 + lr) * K + lh * 8; const bf16_t* B1 = B0 + (size_t)32 * K;
        f32x16 acc0, acc1;
#pragma unroll
        for (int r = 0; r < 16; ++r) { acc0[r] = 0.f; acc1[r] = 0.f; }
        for (int st = 0; st < steps; ++st) {
            const bf16x8 a = *(const bf16x8*)(Ab + 16 * st), b0 = *(const bf16x8*)(B0 + 16 * st), b1 = *(const bf16x8*)(B1 + 16 * st);
            acc0 = __builtin_amdgcn_mfma_f32_32x32x16_bf16(b0, a, acc0, 0, 0, 0);
            acc1 = __builtin_amdgcn_mfma_f32_32x32x16_bf16(b1, a, acc1, 0, 0, 0);
        }
#pragma unroll
        for (int r4 = 0; r4 < 4; ++r4) {
            f.vec4(r0 + lr, n0 + 8 * r4 + 4 * lh, (f32x4){acc0[4 * r4], acc0[4 * r4 + 1], acc0[4 * r4 + 2], acc0[4 * r4 + 3]});
            f.vec4(r0 + lr, n0 + 32 + 8 * r4 + 4 * lh, (f32x4){acc1[4 * r4], acc1[4 * r4 + 1], acc1[4 * r4 + 2], acc1[4 * r4 + 3]});
        }
    }
}

struct FRwkvIn {
    bf16_t *rb, *kb, *vb, *tw, *ta, *tv, *tg;
    __device__ __forceinline__ void vec8(int row, int col, f32x4 a, f32x4 b) const {
        if (col < 3072) { u32x4 w; w.x = pk_bf16(a[0], a[1]); w.y = pk_bf16(a[2], a[3]); w.z = pk_bf16(b[0], b[1]); w.w = pk_bf16(b[2], b[3]);
            *(u32x4*)(rb + (size_t)(col >> 10) * XR_STRIDE + (size_t)row * D + (col & 1023)) = w; }
        else { vec4(row, col, a); vec4(row, col + 4, b); } }
    __device__ __forceinline__ void vec4(int row, int col, f32x4 v) const {
        if (col < 3072) { st_bf4(rb + (size_t)(col >> 10) * XR_STRIDE + (size_t)row * D + (col & 1023), v); }
        else if (col < 3328) { const int c = col - 3072; if (c < 32) st_bf4(tv + (size_t)row * 32 + c, v); }
        else if (col < 3584) { const int c = col - 3328; if (c < 64) { f32x4 t = {ftanh(v[0]), ftanh(v[1]), ftanh(v[2]), ftanh(v[3])}; st_bf4(tw + (size_t)row * 64 + c, t); } }
        else if (col < 3840) { const int c = col - 3584; if (c < 64) st_bf4(ta + (size_t)row * 64 + c, v); }
        else { const int c = col - 3840; if (c < 160) { f32x4 t = {fsig(v[0]), fsig(v[1]), fsig(v[2]), fsig(v[3])}; st_bf4(tg + (size_t)row * 160 + c, t); } }
    }
};
struct FStoreF32 { float* C; int ldc; int ncols; __device__ __forceinline__ void vec4(int row, int col, f32x4 v) const { if (col < ncols) *(f32x4*)(C + (size_t)row * ldc + col) = v; } };
struct FStoreBf16 { bf16_t* C; int ldc; int ncols;
    __device__ __forceinline__ void vec4(int row, int col, f32x4 v) const { if (col < ncols) st_bf4(C + (size_t)row * ldc + col, v); }
    __device__ __forceinline__ void vec8(int row, int col, f32x4 a, f32x4 b) const { if (col < ncols) { u32x4 w; w.x = pk_bf16(a[0], a[1]); w.y = pk_bf16(a[2], a[3]); w.z = pk_bf16(b[0], b[1]); w.w = pk_bf16(b[2], b[3]); *(u32x4*)(C + (size_t)row * ldc + col) = w; } } };
struct FResid {
    float* X; const float* gate;
    const float* xin_p; const float* xin_s;
    __device__ __forceinline__ void vec4(int row, int col, f32x4 v) const {
        const f32x4 g = *(const f32x4*)(gate + (size_t)row_seq(row) * 6144 + col); float* xp = X + (size_t)row * D + col;
        const float* ip = xin_p ? (row < NP ? xin_p + (size_t)row * D + col : xin_s + (size_t)(row - NP) * D + col) : xp;
        const f32x4 x = *(const f32x4*)ip; *(f32x4*)xp = x + g * v; }
};
struct FRelu2 { bf16_t* U;
    __device__ __forceinline__ void vec8(int row, int col, f32x4 a, f32x4 b) const {
        f32x4 s, t; for (int e = 0; e < 4; ++e) { const float x = fmaxf(a[e], 0.f), y = fmaxf(b[e], 0.f); s[e] = x * x; t[e] = y * y; }
        u32x4 w; w.x = pk_bf16(s[0], s[1]); w.y = pk_bf16(s[2], s[3]); w.z = pk_bf16(t[0], t[1]); w.w = pk_bf16(t[2], t[3]); *(u32x4*)(U + (size_t)row * DFF + col) = w; }
    __device__ __forceinline__ void vec4(int row, int col, f32x4 v) const {
        f32x4 t; for (int e = 0; e < 4; ++e) { const float r = fmaxf(v[e], 0.f); t[e] = r * r; } st_bf4(U + (size_t)row * DFF + col, t); } };

__device__ __forceinline__ void phase_copy_x(KP p) {
    const size_t n4p = (size_t)NP * D / 4, n4 = (size_t)NT * D / 4;
    for (size_t i = (size_t)BID() * 512 + TID(); i < n4; i += (size_t)gridDim.x * 512)
        ((f32x4*)p->out)[i] = i < n4p ? ((const f32x4*)p->x_prompt)[i] : ((const f32x4*)p->x_sample)[i - n4p];
}

struct TJob { const float* src; bf16_t* dst; int K, N, drow0; };
__device__ __forceinline__ TJob tjob(KP p, int i) {
    TJob t; t.drow0 = 0;
    if (i < 4) { t.src = p->w_up + (size_t)i * D * DFF; t.dst = WSP(bf16_t, WS_WUP_T) + (size_t)i * DFF * D; t.K = D; t.N = DFF; return t; }
    if (i < 8) { const int l = i - 4; t.src = p->w_down + (size_t)l * DFF * D; t.dst = WSP(bf16_t, WS_WDN_T) + (size_t)l * DFF * D; t.K = DFF; t.N = D; return t; }
    i -= 8; const int j = i / 14, k = i % 14; bf16_t* wrw = WSP(bf16_t, WS_WRW_T) + (size_t)j * 4096 * D;
    t.K = D; t.N = D;
    switch (k) {
        case 0: case 1: case 2: t.src = p->rw_w_rkv + ((size_t)j * 3 + k) * D * D; t.dst = wrw; t.drow0 = k * 1024; break;
        case 3: t.src = p->rw_v1; t.dst = wrw; t.drow0 = 3072; t.N = j == 1 ? 32 : 0; break;
        case 4: t.src = p->rw_w1 + (size_t)j * D * 64; t.dst = wrw; t.drow0 = 3328; t.N = 64; break;
        case 5: t.src = p->rw_a1 + (size_t)j * D * 64; t.dst = wrw; t.drow0 = 3584; t.N = 64; break;
        case 6: t.src = p->rw_g1 + (size_t)j * D * 160; t.dst = wrw; t.drow0 = 3840; t.N = 160; break;
        case 7: t.src = p->rw_w_o + (size_t)j * D * D; t.dst = WSP(bf16_t, WS_WO_T) + (size_t)j * D * D; break;
        case 8: t.src = p->rw_w2 + (size_t)j * 64 * D; t.dst = WSP(bf16_t, WS_W2T) + (size_t)j * D * 64; t.K = 64; break;
        case 9: t.src = p->rw_a2 + (size_t)j * 64 * D; t.dst = WSP(bf16_t, WS_A2T) + (size_t)j * D * 64; t.K = 64; break;
        case 10: t.src = p->rw_g2 + (size_t)j * 160 * D; t.dst = WSP(bf16_t, WS_G2T) + (size_t)j * D * 160; t.K = 160; break;
        case 11: t.src = p->rw_v2; t.dst = WSP(bf16_t, WS_V2T); t.K = 32; t.N = j == 1 ? D : 0; break;
        case 12: t.src = p->att_w_in + (size_t)j * D * PIN; t.dst = WSP(bf16_t, WS_WIN_T) + (size_t)j * PINP * D; t.N = PIN; break;
        default: t.src = p->att_w_o + (size_t)j * D * D; t.dst = WSP(bf16_t, WS_WAO_T) + (size_t)j * D * D; break;
    }
    return t;
}
__device__ __forceinline__ int tjob_tiles(const TJob& t) { return ((t.K + 63) / 64) * ((t.N + 63) / 64); }
__device__ __forceinline__ void phase_weights(KP p, LAS unsigned char* lds) {
    LAS float* T = (LAS float*)lds;
    const int tid = TID();
    int total = 0;
    for (int i = 0; i < 36; ++i) total += tjob_tiles(tjob(p, i));
    const int ngrp = (total + 3) / 4;
    for (int g = BID(); g < ngrp; g += gridDim.x) {
        __syncthreads();
        TJob tj[4]; int k0[4], n0[4];
        { int i = 0, start = 0, cnt = tjob_tiles(tjob(p, 0));
#pragma unroll
          for (int u = 0; u < 4; ++u) { const int gt = 4 * g + u;
              while (i < 35 && gt >= start + cnt) { start += cnt; ++i; cnt = tjob_tiles(tjob(p, i)); }
              tj[u] = tjob(p, i); const int lt = gt - start, nkt = (tj[u].K + 63) / 64;
              if (gt >= total || lt >= cnt) { tj[u] = tjob(p, 0); k0[u] = 1 << 20; n0[u] = 1 << 20; } else { k0[u] = (lt % nkt) * 64; n0[u] = (lt / nkt) * 64; } }
        }
        f32x4 v[4][2];
        const int kk = tid >> 4, n4 = (tid & 15) * 4;
#pragma unroll
        for (int u = 0; u < 4; ++u)
#pragma unroll
            for (int hh = 0; hh < 2; ++hh) { const int k = k0[u] + kk + 32 * hh, n = n0[u] + n4; const bool ok = k < tj[u].K && n < tj[u].N;
                const f32x4 t_ = *(const f32x4*)(tj[u].src + (size_t)min(k, tj[u].K - 1) * tj[u].N + min(n, tj[u].N - 4));
                v[u][hh] = ok ? t_ : (f32x4){0.f, 0.f, 0.f, 0.f}; }
#pragma unroll
        for (int u = 0; u < 4; ++u)
#pragma unroll
            for (int hh = 0; hh < 2; ++hh)
#pragma unroll
                for (int e = 0; e < 4; ++e) T[(u * 64 + kk + 32 * hh) * 65 + n4 + e] = v[u][hh][e];
        __syncthreads();
        const int nn = tid >> 3, k8 = (tid & 7) * 8;
#pragma unroll
        for (int u = 0; u < 4; ++u) {
            if (n0[u] + nn < tj[u].N && k0[u] + k8 < tj[u].K) {
                u32x4 w;
                w.x = pk_bf16(T[(u * 64 + k8 + 0) * 65 + nn], T[(u * 64 + k8 + 1) * 65 + nn]); w.y = pk_bf16(T[(u * 64 + k8 + 2) * 65 + nn], T[(u * 64 + k8 + 3) * 65 + nn]);
                w.z = pk_bf16(T[(u * 64 + k8 + 4) * 65 + nn], T[(u * 64 + k8 + 5) * 65 + nn]); w.w = pk_bf16(T[(u * 64 + k8 + 6) * 65 + nn], T[(u * 64 + k8 + 7) * 65 + nn]);
                *(u32x4*)(tj[u].dst + (size_t)(tj[u].drow0 + n0[u] + nn) * tj[u].K + k0[u] + k8) = w;
            }
        }
    }
    __syncthreads();
}

__device__ __forceinline__ void phase_ada(KP p, LAS unsigned char* lds) {
    float* mods = WSP(float, WS_MODS);
    LAS float* sil = (LAS float*)lds;
    LAS float* red = (LAS float*)(lds + 36864);
    const int tid = TID(), c = tid & 127, ds = tid >> 7;
    for (int item = BID(); item < 192; item += gridDim.x) {
        const int l = item / 48, col = (item % 48) * 128 + c;
        float acc[36];
#pragma unroll
        for (int s = 0; s < 36; ++s) acc[s] = 0.f;
        for (int cc = 0; cc < 4; ++cc) {
            __syncthreads();
            for (int e = tid; e < 4 * 64 * 36; e += 512) { const int s = e % 36, dd = (e / 36) % 64, sl = e / (36 * 64), d = 256 * sl + 64 * cc + dd;
                const float cv = s < 4 ? p->c_prompt[s * D + d] : p->c_sample[(s - 4) * D + d]; sil[e] = cv / (1.0f + expf(-cv)); }
            __syncthreads();
            const float* wp = p->w_ada + ((size_t)l * D + 256 * ds + 64 * cc) * 6144 + col;
            for (int dd = 0; dd < 64; ++dd) {
                const float w = wp[(size_t)dd * 6144];
                const LAS float* sp = sil + (ds * 64 + dd) * 36;
#pragma unroll
                for (int s = 0; s < 36; ++s) acc[s] += sp[s] * w;
            }
        }
        __syncthreads();
#pragma unroll
        for (int s = 0; s < 36; ++s) red[(ds * 128 + c) * 36 + s] = acc[s];
        __syncthreads();
        for (int k = 0; k < 9; ++k) { const int s = 9 * ds + k;
            const float v = red[(0 * 128 + c) * 36 + s] + red[(1 * 128 + c) * 36 + s] + red[(2 * 128 + c) * 36 + s] + red[(3 * 128 + c) * 36 + s];
            mods[((size_t)l * 36 + s) * 6144 + col] = v + p->b_ada[l * 6144 + col]; }
    }
    __syncthreads();
}

template <bool MIX>
__device__ __forceinline__ void phase_prep(KP p, int layer, int which, int j, bool first = false) {
    const float* X = p->out;
    const float* mods = WSP(float, WS_MODS) + (size_t)layer * 36 * 6144;
    const float* g = p->norm_g + (layer * 2 + which) * D;
    bf16_t* XR = WSP(bf16_t, WS_XR);
    const int lane = TID() & 63, gw = BID() * 8 + (TID() >> 6), nw = gridDim.x * 8;
    for (int run = gw; run < NT / 8; run += nw) {
        const int row0 = run * 8, seq = row_seq(row0);
        const float* sh = mods + (size_t)seq * 6144 + (which ? 3 : 0) * D; const float* sc = sh + D;
        f32x4 gv[4], scv[4], shv[4], hp[4];
#pragma unroll
        for (int i = 0; i < 4; ++i) { const int col = 512 * (i >> 1) + 8 * lane + 4 * (i & 1); gv[i] = *(const f32x4*)(g + col); scv[i] = *(const f32x4*)(sc + col) + 1.0f; shv[i] = *(const f32x4*)(sh + col); hp[i] = (f32x4){0.f, 0.f, 0.f, 0.f}; }
        int rstart = 0;
        if (MIX) {
            if (row0 >= NP) {
#pragma unroll
                for (int i = 0; i < 4; ++i) hp[i] = *(const f32x4*)(p->state_shift + ((size_t)j * 32 + (seq - 4)) * D + 512 * (i >> 1) + 8 * lane + 4 * (i & 1));
            } else if ((row0 & 4095) != 0) rstart = -1;
        }
        for (int r = rstart; r < 8; ++r) {
            const int row = row0 + r;
            f32x4 x[4]; float ss = 0.f;
            const float* xr = first ? (row < NP ? p->x_prompt + (size_t)row * D : p->x_sample + (size_t)(row - NP) * D) : X + (size_t)row * D;
#pragma unroll
            for (int i = 0; i < 4; ++i) { x[i] = *(const f32x4*)(xr + 512 * (i >> 1) + 8 * lane + 4 * (i & 1)); ss += x[i][0] * x[i][0] + x[i][1] * x[i][1] + x[i][2] * x[i][2] + x[i][3] * x[i][3]; }
            ss = wave_sum(ss);
            const float rstd = rsqrtf(ss * (1.0f / 1024.0f) + 1e-6f);
            f32x4 h[4];
#pragma unroll
            for (int i = 0; i < 4; ++i) h[i] = x[i] * rstd * gv[i] * scv[i] + shv[i];
            if (MIX) {
                if (r >= 0) {
#pragma unroll
                    for (int n = 0; n < 6; ++n) {
                        const int mi = n == 0 ? 0 : (n == 1 ? 2 : (n == 2 ? 3 : (n == 3 ? 1 : n)));
                        const float* mx = p->rw_mix + ((size_t)j * 6 + mi) * D;
#pragma unroll
                        for (int i2 = 0; i2 < 2; ++i2) { const int col = 512 * i2 + 8 * lane; const f32x4 m0 = *(const f32x4*)(mx + col), m1 = *(const f32x4*)(mx + col + 4);
                            const f32x4 a = h[2 * i2] + (hp[2 * i2] - h[2 * i2]) * m0, b2 = h[2 * i2 + 1] + (hp[2 * i2 + 1] - h[2 * i2 + 1]) * m1;
                            u32x4 w; w.x = pk_bf16(a[0], a[1]); w.y = pk_bf16(a[2], a[3]); w.z = pk_bf16(b2[0], b2[1]); w.w = pk_bf16(b2[2], b2[3]);
                            *(u32x4*)(XR + (size_t)n * XR_STRIDE + (size_t)row * D + col) = w; }
                    }
                    const bool lastp = row < NP && (row & 4095) == 4095, lasts = row >= NP && ((row - NP) & 7) == 7;
                    if (lastp || lasts) {
                        float* so = lastp ? p->out + O_SHP + ((size_t)j * 4 + seq) * D : p->out + O_SHS + ((size_t)j * 32 + (seq - 4)) * D;
#pragma unroll
                        for (int i = 0; i < 4; ++i) *(f32x4*)(so + 512 * (i >> 1) + 8 * lane + 4 * (i & 1)) = h[i];
                    }
                }
#pragma unroll
                for (int i = 0; i < 4; ++i) hp[i] = h[i];
            } else {
#pragma unroll
                for (int i2 = 0; i2 < 2; ++i2) { const f32x4 a = h[2 * i2], b2 = h[2 * i2 + 1]; u32x4 w; w.x = pk_bf16(a[0], a[1]); w.y = pk_bf16(a[2], a[3]); w.z = pk_bf16(b2[0], b2[1]); w.w = pk_bf16(b2[2], b2[3]);
                    *(u32x4*)(XR + (size_t)row * D + 512 * i2 + 8 * lane) = w; }
            }
        }
    }
}

__device__ __forceinline__ void phase_scanprep(KP p, int j) {
    const bf16_t *KB = WSP(bf16_t, WS_KB), *VB = WSP(bf16_t, WS_VB);
    const float *WPp = WSP(float, WS_WP), *APp = WSP(float, WS_AP), *VPp = WSP(float, WS_VP);
    float *VF = WSP(float, WS_VFIRST), *DEC = WSP(float, WS_DEC), *KM = WSP(float, WS_KM), *VM = WSP(float, WS_VM), *AV = WSP(float, WS_AV), *BV = WSP(float, WS_BV);
    const int lane = TID() & 63, gw = BID() * 8 + (TID() >> 6), nw = gridDim.x * 8;
    for (int row = gw; row < NT; row += nw) {
#pragma unroll
        for (int i = 0; i < 4; ++i) {
            const int col = 256 * i + 4 * lane; const size_t o = (size_t)row * D + col;
            const f32x4 k = ld_bf4(KB + o), v = ld_bf4(VB + o), wp = *(const f32x4*)(WPp + o), ap = *(const f32x4*)(APp + o);
            const f32x4 w0 = *(const f32x4*)(p->rw_w0 + j * D + col), a0 = *(const f32x4*)(p->rw_a0 + j * D + col), kkw = *(const f32x4*)(p->rw_k_k + j * D + col), kaw = *(const f32x4*)(p->rw_k_a + j * D + col);
            f32x4 dec, a, vm, kk, km;
#pragma unroll
            for (int e = 0; e < 4; ++e) {
                const float wpre = w0[e] + wp[e], z = -wpre, sp = fmaxf(z, 0.f) + log1pf(expf(-fabsf(z)));
                dec[e] = expf(-expf(-sp - 0.5f));
                a[e] = sigmoidf_(a0[e] + ap[e]);
                kk[e] = k[e] * kkw[e];
                km[e] = k[e] * (1.0f + (a[e] - 1.0f) * kaw[e]);
            }
            if (j == 0) { vm = v; *(f32x4*)(VF + o) = v; }
            else { const f32x4 vf = *(const f32x4*)(VF + o), vp = *(const f32x4*)(VPp + o), v0 = *(const f32x4*)(p->rw_v0 + (j - 1) * D + col);
#pragma unroll
                for (int e = 0; e < 4; ++e) vm[e] = v[e] + (vf[e] - v[e]) * sigmoidf_(v0[e] + vp[e]); }
            float ss = kk[0] * kk[0] + kk[1] * kk[1] + kk[2] * kk[2] + kk[3] * kk[3];
            ss = g16_sum(ss);
            const float inv = rsqrtf(fmaxf(ss, 1e-24f));
            kk = kk * inv;
            *(f32x4*)(DEC + o) = dec; *(f32x4*)(KM + o) = km; *(f32x4*)(VM + o) = vm; *(f32x4*)(AV + o) = -kk; *(f32x4*)(BV + o) = kk * a;
        }
    }
}

__device__ __forceinline__ float rl(float v, int k) { return __int_as_float(__builtin_amdgcn_readlane(__float_as_int(v), k)); }
__device__ __forceinline__ void scan_run(KP p, size_t row_base, int nsteps, int colbase, float (&S)[64]) {
    const float *DEC = WSP(float, WS_DEC), *KM = WSP(float, WS_KM), *VM = WSP(float, WS_VM), *AV = WSP(float, WS_AV), *BV = WSP(float, WS_BV);
    const bf16_t* RB = WSP(bf16_t, WS_RB); float* Y = WSP(float, WS_Y);
    const int lane = TID() & 63;
    size_t o = row_base * D + colbase + lane;
    float w = DEC[o], kx = KM[o], v = VM[o], a = AV[o], b = BV[o], r = bf2f(RB[o]);
    for (int t = 0; t < nsteps; ++t) {
        const size_t on = (t + 1 < nsteps) ? o + D : o;
        const float wn = DEC[on], kn = KM[on], vn = VM[on], an = AV[on], bn = BV[on], rn = bf2f(RB[on]);
        float sa = 0.f;
#pragma unroll
        for (int k = 0; k < 64; ++k) sa += S[k] * rl(a, k);
#pragma unroll
        for (int k = 0; k < 64; ++k) S[k] = S[k] * rl(w, k) + sa * rl(b, k) + v * rl(kx, k);
        float y = 0.f;
#pragma unroll
        for (int k = 0; k < 64; ++k) y += S[k] * rl(r, k);
        Y[o] = y;
        o = on; w = wn; kx = kn; v = vn; a = an; b = bn; r = rn;
    }
}
__device__ __forceinline__ void phase_scanA(KP p) {
    const float *DEC = WSP(float, WS_DEC), *KM = WSP(float, WS_KM), *VM = WSP(float, WS_VM), *AV = WSP(float, WS_AV), *BV = WSP(float, WS_BV);
    float *PCH = WSP(float, WS_PCH), *CCH = WSP(float, WS_CCH);
    const int lane = TID() & 63, gw = BID() * 8 + (TID() >> 6), nw = gridDim.x * 8;
    for (int it = gw; it < 64 * NCH; it += nw) {
        const int sh = it / NCH, c = it % NCH, b = sh >> 4, h = sh & 15;
        float SP[64], SC[64];
#pragma unroll
        for (int k = 0; k < 64; ++k) { SP[k] = (k == lane) ? 1.f : 0.f; SC[k] = 0.f; }
        size_t o = ((size_t)b * 4096 + (size_t)c * LCH) * D + h * 64 + lane;
        float w = DEC[o], kx = KM[o], v = VM[o], a = AV[o], bb = BV[o];
        for (int t = 0; t < LCH; ++t) {
            const size_t on = (t + 1 < LCH) ? o + D : o;
            const float wn = DEC[on], kn = KM[on], vn = VM[on], an = AV[on], bn = BV[on];
            float saP = 0.f, saC = 0.f;
#pragma unroll
            for (int k = 0; k < 64; ++k) { const float ak = rl(a, k); saP += SP[k] * ak; saC += SC[k] * ak; }
#pragma unroll
            for (int k = 0; k < 64; ++k) { const float wk = rl(w, k), bk = rl(bb, k); SP[k] = SP[k] * wk + saP * bk; SC[k] = SC[k] * wk + saC * bk + v * rl(kx, k); }
            o = on; w = wn; kx = kn; v = vn; a = an; bb = bn;
        }
        float* po = PCH + ((size_t)it * 64 + lane) * 64; float* co = CCH + ((size_t)it * 64 + lane) * 64;
#pragma unroll
        for (int k = 0; k < 64; k += 4) { *(f32x4*)(po + k) = (f32x4){SP[k], SP[k + 1], SP[k + 2], SP[k + 3]}; *(f32x4*)(co + k) = (f32x4){SC[k], SC[k + 1], SC[k + 2], SC[k + 3]}; }
    }
}
__device__ __forceinline__ void phase_scanB(KP p, int j, LAS unsigned char* lds) {
    const int tid = TID(), lane = tid & 63, wave = tid >> 6;
    if (BID() < 32) {
        const float *PCH = WSP(float, WS_PCH), *CCH = WSP(float, WS_CCH); float* SST = WSP(float, WS_SST);
        const int sh = BID() * 2 + (wave >> 2), q = wave & 3, row0 = 32 * (q >> 1), col0 = 32 * (q & 1), b = sh >> 4, h = sh & 15;
        LAS float* Sl = (LAS float*)lds + (wave >> 2) * (2 * 64 * 65);
        const int lr = lane & 31, lh = lane >> 5;
        f32x16 acc;
#pragma unroll
        for (int r = 0; r < 16; ++r) acc[r] = 0.f;
        for (int c = 0; c <= NCH; ++c) {
            LAS float* Sw = Sl + (c & 1) * (64 * 65);
            float* go = c < NCH ? SST + ((size_t)sh * NCH + c) * 4096 : p->out + O_WKVP + (((size_t)j * 4 + b) * 16 + h) * 4096;
#pragma unroll
            for (int r = 0; r < 16; ++r) { const int row = row0 + (r & 3) + 8 * (r >> 2) + 4 * lh; Sw[row * 65 + col0 + lr] = acc[r]; go[row * 64 + col0 + lr] = acc[r]; }
            if (c == NCH) break;
            const float* Pc = PCH + ((size_t)sh * NCH + c) * 4096; const float* Cc = CCH + ((size_t)sh * NCH + c) * 4096;
            float bv[32];
#pragma unroll
            for (int kk = 0; kk < 32; ++kk) bv[kk] = Pc[(2 * kk + lh) * 64 + col0 + lr];
#pragma unroll
            for (int r = 0; r < 16; ++r) acc[r] = Cc[(row0 + (r & 3) + 8 * (r >> 2) + 4 * lh) * 64 + col0 + lr];
            __syncthreads();
#pragma unroll
            for (int kk = 0; kk < 32; ++kk) acc = __builtin_amdgcn_mfma_f32_32x32x2f32(Sw[(row0 + lr) * 65 + 2 * kk + lh], bv[kk], acc, 0, 0, 0);
        }
    } else {
        for (int it = (BID() - 32) * 8 + wave; it < 512; it += (gridDim.x - 32) * 8) {
            const int b = it >> 4, h = it & 15;
            const float* s0 = p->state_wkv + (((size_t)j * 32 + b) * 16 + h) * 4096 + lane * 64;
            float S[64];
#pragma unroll
            for (int k = 0; k < 64; k += 4) { const f32x4 t = *(const f32x4*)(s0 + k); S[k] = t[0]; S[k + 1] = t[1]; S[k + 2] = t[2]; S[k + 3] = t[3]; }
            scan_run(p, (size_t)NP + b * 8, 8, h * 64, S);
            float* o = p->out + O_WKVS + (((size_t)j * 32 + b) * 16 + h) * 4096 + lane * 64;
#pragma unroll
            for (int k = 0; k < 64; k += 4) *(f32x4*)(o + k) = (f32x4){S[k], S[k + 1], S[k + 2], S[k + 3]};
        }
    }
    __syncthreads();
}
__device__ __forceinline__ void phase_scanC(KP p) {
    const float* SST = WSP(float, WS_SST);
    const int lane = TID() & 63, gw = BID() * 8 + (TID() >> 6), nw = gridDim.x * 8;
    for (int it = gw; it < 64 * NCH; it += nw) {
        const int sh = it / NCH, c = it % NCH, b = sh >> 4, h = sh & 15;
        const float* s0 = SST + ((size_t)it * 64 + lane) * 64;
        float S[64];
#pragma unroll
        for (int k = 0; k < 64; k += 4) { const f32x4 t = *(const f32x4*)(s0 + k); S[k] = t[0]; S[k + 1] = t[1]; S[k + 2] = t[2]; S[k + 3] = t[3]; }
        scan_run(p, (size_t)b * 4096 + (size_t)c * LCH, LCH, h * 64, S);
    }
}


constexpr int CST = 72;
constexpr int CMAT = 64 * CST * 2;
constexpr int CH_F32 = 11 * CMAT, CH_PART = CH_F32 + 64 * 68 * 4, CH_GL = CH_PART + 64 * 4 * 4;
__device__ __forceinline__ bf16x8 cfrag(const LAS bf16_t* M, int row, int ks, int c4) { return *(const LAS bf16x8*)(M + row * CST + 32 * ks + 8 * c4); }
__device__ __forceinline__ f32x4 cmm(const LAS bf16_t* A, int arow, const LAS bf16_t* B, int brow, int c4, f32x4 acc) {
    acc = __builtin_amdgcn_mfma_f32_16x16x32_bf16(cfrag(A, arow, 0, c4), cfrag(B, brow, 0, c4), acc, 0, 0, 0);
    return __builtin_amdgcn_mfma_f32_16x16x32_bf16(cfrag(A, arow, 1, c4), cfrag(B, brow, 1, c4), acc, 0, 0, 0); }
__device__ __forceinline__ unsigned short f2bf(float x) { return (unsigned short)(pk_bf16(x, 0.f) & 0xffffu); }
__device__ __forceinline__ void st_t4(LAS bf16_t* Mt, int d, int t0, f32x4 v) { u32x2 w; w.x = pk_bf16(v[0], v[1]); w.y = pk_bf16(v[2], v[3]); *(LAS u32x2*)(Mt + d * CST + t0) = w; }

__device__ __forceinline__ void phase_chunk(KP p, int j, LAS unsigned char* lds) {
    LAS bf16_t* Mx = (LAS bf16_t*)lds;
#define CM(i) (Mx + (i) * (64 * CST))
    LAS float* F32 = (LAS float*)(lds + CH_F32);
    asm volatile("" : "+v"(F32));
    LAS float* part = (LAS float*)(lds + CH_PART);
    LAS float* gLs = (LAS float*)(lds + CH_GL);
    const bf16_t *RB = WSP(bf16_t, WS_RB), *KB = WSP(bf16_t, WS_KB), *VB = WSP(bf16_t, WS_VB), *TW = WSP(bf16_t, WS_TW), *TA_ = WSP(bf16_t, WS_TA), *TV = WSP(bf16_t, WS_TV);
    const bf16_t *W2T = WSP(bf16_t, WS_W2T) + (size_t)j * D * 64, *A2T = WSP(bf16_t, WS_A2T) + (size_t)j * D * 64, *V2T = WSP(bf16_t, WS_V2T);
    float* VF = WSP(float, WS_VFIRST); float *PCH = WSP(float, WS_PCH), *CCH = WSP(float, WS_CCH), *Y0 = WSP(float, WS_Y), *BON = WSP(float, WS_AV);
    bf16_t *GM = WSP(bf16_t, WS_DEC), *VM2 = WSP(bf16_t, WS_KM);
#define CH_BAR() do { asm volatile("s_waitcnt lgkmcnt(0)" ::: "memory"); __builtin_amdgcn_s_barrier(); asm volatile("" ::: "memory"); } while (0)
    bf16x8 f_aw[2], f_aa[2], f_av; unsigned short e_k[2][4], e_v[2][4], e_r[2][4];
    f_av = (bf16x8){0, 0, 0, 0, 0, 0, 0, 0};
#define CH_PREFETCH(itx) do { const int tid_ = TID(), lane_ = tid_ & 63, w_ = tid_ >> 6, n_ = lane_ & 15, c4_ = lane_ >> 4, tr_ = w_ >> 1, tcb_ = 2 * (w_ & 1); \
        const int sh_ = (itx) / NCH, c_ = (itx) % NCH, R0_ = (sh_ >> 4) * 4096 + c_ * LCH, hc_ = (sh_ & 15) * 64; const int ar_ = 16 * tr_ + n_; \
        _Pragma("unroll") for (int ks = 0; ks < 2; ++ks) { f_aw[ks] = *(const bf16x8*)(TW + (size_t)R0_ * 64 + ar_ * 64 + 32 * ks + 8 * c4_); f_aa[ks] = *(const bf16x8*)(TA_ + (size_t)R0_ * 64 + ar_ * 64 + 32 * ks + 8 * c4_); } \
        if (j == 1) f_av = *(const bf16x8*)(TV + (size_t)R0_ * 32 + ar_ * 32 + 8 * c4_); \
        _Pragma("unroll") for (int ti = 0; ti < 2; ++ti) _Pragma("unroll") for (int r = 0; r < 4; ++r) { const size_t o_ = (size_t)R0_ * D + hc_ + (16 * tr_ + 4 * c4_ + r) * D + 16 * (tcb_ + ti) + n_; \
            e_k[ti][r] = KB[o_]; e_v[ti][r] = VB[o_]; e_r[ti][r] = RB[o_]; } } while (0)
    if (BID() < 64 * NCH) CH_PREFETCH(BID());
    for (int it = BID(); it < 64 * NCH; it += gridDim.x) {
        const int tid = TID(), lane = tid & 63, w = tid >> 6, n = lane & 15, c4 = lane >> 4, tr = w >> 1, tcb = 2 * (w & 1);
        const int sh = it / NCH, c = it % NCH, b = sh >> 4, h = sh & 15, R0 = b * 4096 + c * LCH, hc = h * 64;
        const bf16_t *KBb = KB + (size_t)R0 * D + hc, *VBb = VB + (size_t)R0 * D + hc, *RBb = RB + (size_t)R0 * D + hc;
        float* VFb = VF + (size_t)R0 * D + hc; bf16_t* VM2b = VM2 + (size_t)R0 * D + hc; bf16_t* GMb = GM + (size_t)R0 * D + hc; float* Y0b = Y0 + (size_t)R0 * D + hc;
        float* PCb = PCH + (size_t)it * 4096; float* CCb = CCH + (size_t)it * 4096; float* BONb = BON + (size_t)R0 * 16 + h;
        const bf16_t *TWb = TW + (size_t)R0 * 64, *TAb = TA_ + (size_t)R0 * 64, *TVb = TV + (size_t)R0 * 32, *W2b = W2T + (size_t)hc * 64, *A2b = A2T + (size_t)hc * 64, *V2b = V2T + (size_t)hc * 32;
        const float *w0b = p->rw_w0 + j * D + hc, *a0b = p->rw_a0 + j * D + hc, *kkb = p->rw_k_k + j * D + hc, *kab = p->rw_k_a + j * D + hc, *rkb = p->rw_r_k + j * D + hc, *v0b = p->rw_v0 + (j ? (j - 1) : 0) * D + hc;
        f32x4 wp[2], ap[2], vp[2];
#pragma unroll
        for (int ti = 0; ti < 2; ++ti) { wp[ti] = (f32x4){0.f, 0.f, 0.f, 0.f}; ap[ti] = wp[ti]; vp[ti] = wp[ti]; }
        {   const int ar = 16 * tr + n;
#pragma unroll
            for (int ks = 0; ks < 2; ++ks) {
                const bf16x8 aw = f_aw[ks], aa = f_aa[ks];
#pragma unroll
                for (int ti = 0; ti < 2; ++ti) { const int br = 16 * (tcb + ti) + n;
                    wp[ti] = __builtin_amdgcn_mfma_f32_16x16x32_bf16(aw, *(const bf16x8*)(W2b + br * 64 + 32 * ks + 8 * c4), wp[ti], 0, 0, 0);
                    ap[ti] = __builtin_amdgcn_mfma_f32_16x16x32_bf16(aa, *(const bf16x8*)(A2b + br * 64 + 32 * ks + 8 * c4), ap[ti], 0, 0, 0); }
            }
            if (j == 1) { const bf16x8 av = f_av;
#pragma unroll
                for (int ti = 0; ti < 2; ++ti) vp[ti] = __builtin_amdgcn_mfma_f32_16x16x32_bf16(av, *(const bf16x8*)(V2b + (16 * (tcb + ti) + n) * 32 + 8 * c4), vp[ti], 0, 0, 0); }
        }
        f32x4 lw[2], asg[2], kkv[2], kpr[2], vpr[2], rr[2];
        float ssq[4] = {0.f, 0.f, 0.f, 0.f}, bon[4] = {0.f, 0.f, 0.f, 0.f};
        float vf8[2][4];
#pragma unroll
        for (int ti = 0; ti < 2; ++ti)
#pragma unroll
            for (int r = 0; r < 4; ++r) vf8[ti][r] = 0.f;
        if (j == 1) {
#pragma unroll
            for (int ti = 0; ti < 2; ++ti)
#pragma unroll
                for (int r = 0; r < 4; ++r) vf8[ti][r] = VFb[(16 * tr + 4 * c4 + r) * D + 16 * (tcb + ti) + n];
        }
#pragma unroll
        for (int ti = 0; ti < 2; ++ti) {
            const int d = 16 * (tcb + ti) + n;
            const float w0 = w0b[d], a0 = a0b[d], kkw = kkb[d], kaw = kab[d], rkw = rkb[d];
            const float v0 = j ? v0b[d] : 0.f;
#pragma unroll
            for (int r = 0; r < 4; ++r) {
                const int o = (16 * tr + 4 * c4 + r) * D + d;
                const float kx = bf2f(e_k[ti][r]), vx = bf2f(e_v[ti][r]), rx = bf2f(e_r[ti][r]);
                const float z = -(w0 + wp[ti][r]), sp = fmaxf(z, 0.f) + __logf(1.0f + __expf(-fabsf(z)));
                lw[ti][r] = -__expf(-sp - 0.5f);
                const float a = fsig(a0 + ap[ti][r]);
                asg[ti][r] = a;
                float vv = vx;
                if (j == 0) VFb[o] = vx; else { const float vf = vf8[ti][r]; vv = vx + (vf - vx) * fsig(v0 + vp[ti][r]); }
                vpr[ti][r] = vv; rr[ti][r] = rx;
                const float kk = kx * kkw; kkv[ti][r] = kk; ssq[r] += kk * kk;
                const float kp = kx * (1.0f + (a - 1.0f) * kaw); kpr[ti][r] = kp; bon[r] += rx * kp * rkw;
                F32[(16 * tr + 4 * c4 + r) * 68 + d] = lw[ti][r];
                VM2b[o] = f2bf(vv);
            }
        }
#pragma unroll
        for (int r = 0; r < 4; ++r) { ssq[r] = g16_sum(ssq[r]); bon[r] = g16_sum(bon[r]); }
        if (n == 0) {
#pragma unroll
            for (int r = 0; r < 4; ++r) { const int t = 16 * tr + 4 * c4 + r; part[(t * 2 + (w & 1)) * 2 + 0] = ssq[r]; part[(t * 2 + (w & 1)) * 2 + 1] = bon[r]; }
        }
        if (it + (int)gridDim.x < 64 * NCH) CH_PREFETCH(it + (int)gridDim.x);
        CH_BAR();
        f32x4 cs[2];
#pragma unroll
        for (int ti = 0; ti < 2; ++ti) {
            f32x4 acc = {0.f, 0.f, 0.f, 0.f};
            for (int q = 0; q < 4 * (tr + 1); ++q) {
                const float av = (4 * q + c4 <= 16 * tr + n) ? 1.0f : 0.0f;
                acc = __builtin_amdgcn_mfma_f32_16x16x4f32(av, F32[(4 * q + c4) * 68 + 16 * (tcb + ti) + n], acc, 0, 0, 0);
            }
            cs[ti] = acc;
        }
        float inv[4];
#pragma unroll
        for (int r = 0; r < 4; ++r) { const int t = 16 * tr + 4 * c4 + r; inv[r] = rsqrtf(fmaxf(part[(t * 2 + 0) * 2] + part[(t * 2 + 1) * 2], 1e-24f));
            if (n == 0 && (w & 1) == 0) BONb[t * 16] = part[(t * 2 + 0) * 2 + 1] + part[(t * 2 + 1) * 2 + 1]; }
        f32x4 rt[2];
#pragma unroll
        for (int ti = 0; ti < 2; ++ti) {
            const int d = 16 * (tcb + ti) + n, t0 = 16 * tr + 4 * c4;
            f32x4 at, bt, kt;
#pragma unroll
            for (int r = 0; r < 4; ++r) {
                const float g = __expf(cs[ti][r]), gi = __expf(-cs[ti][r]), gm = __expf(cs[ti][r] - lw[ti][r]);
                const float kk = kkv[ti][r] * inv[r];
                at[r] = -kk * gm; bt[r] = kk * asg[ti][r] * gi; kt[r] = kpr[ti][r] * gi; rt[ti][r] = rr[ti][r] * g;
                CM(0)[(t0 + r) * CST + d] = f2bf(at[r]); CM(1)[(t0 + r) * CST + d] = f2bf(bt[r]); CM(2)[(t0 + r) * CST + d] = f2bf(kt[r]); CM(3)[(t0 + r) * CST + d] = f2bf(rt[ti][r]);
                if (t0 + r == 63) gLs[d] = g;
            }
            st_t4(CM(4), d, t0, at); st_t4(CM(5), d, t0, bt); st_t4(CM(6), d, t0, kt); st_t4(CM(7), d, t0, vpr[ti]);
        }
        CH_BAR();
#pragma unroll
        for (int ti = 0; ti < 2; ++ti) {
            const int tc = tcb + ti, s = 16 * tc + n, t0 = 16 * tr + 4 * c4;
            if (tc <= tr) {
                { f32x4 m = {0.f, 0.f, 0.f, 0.f}; m = cmm(CM(0), 16 * tr + n, CM(1), 16 * tc + n, c4, m);
#pragma unroll
                  for (int r = 0; r < 4; ++r) F32[(t0 + r) * 68 + s] = (s < t0 + r) ? m[r] : 0.f; }
                asm volatile("" ::: "memory");
                { f32x4 m = {0.f, 0.f, 0.f, 0.f}; m = cmm(CM(0), 16 * tr + n, CM(2), 16 * tc + n, c4, m);
#pragma unroll
                  for (int r = 0; r < 4; ++r) CM(8)[(t0 + r) * CST + s] = f2bf((s < t0 + r) ? m[r] : 0.f); }
                asm volatile("" ::: "memory");
                { f32x4 m = {0.f, 0.f, 0.f, 0.f}; m = cmm(CM(3), 16 * tr + n, CM(1), 16 * tc + n, c4, m);
#pragma unroll
                  for (int r = 0; r < 4; ++r) CM(9)[(t0 + r) * CST + s] = f2bf((s <= t0 + r) ? m[r] : 0.f); }
                asm volatile("" ::: "memory");
                { f32x4 m = {0.f, 0.f, 0.f, 0.f}; m = cmm(CM(3), 16 * tr + n, CM(2), 16 * tc + n, c4, m);
#pragma unroll
                  for (int r = 0; r < 4; ++r) CM(10)[(t0 + r) * CST + s] = f2bf((s <= t0 + r) ? m[r] : 0.f); }
                asm volatile("" ::: "memory");
            } else {
#pragma unroll
                for (int r = 0; r < 4; ++r) { F32[(t0 + r) * 68 + s] = 0.f; CM(8)[(t0 + r) * CST + s] = 0; CM(9)[(t0 + r) * CST + s] = 0; CM(10)[(t0 + r) * CST + s] = 0; }
            }
        }
        CH_BAR();
        { const int e0 = tid * 8;
#pragma unroll
          for (int e = 0; e < 8; ++e) { const int t = (e0 + e) >> 6, s_ = (e0 + e) & 63; CM(2)[t * CST + s_] = f2bf(F32[t * 68 + s_]); }
          unsigned z_ = 0u; asm volatile("" : "+v"(z_));
          *(LAS u32x4*)(CM(0) + (e0 >> 6) * CST + (e0 & 63)) = (u32x4){z_, z_, z_, z_}; }
        CH_BAR();
        if (w < 4) {
            const int cw = 16 * w;
            LAS float* scr = (LAS float*)CM(1) + w * (16 * 17);
#pragma unroll 1
            for (int I = 0; I < 4; ++I) {
                f32x4 rh = {0.f, 0.f, 0.f, 0.f};
                if (I > 0) { rh = __builtin_amdgcn_mfma_f32_16x16x32_bf16(cfrag(CM(2), 16 * I + n, 0, c4), cfrag(CM(0), cw + n, 0, c4), rh, 0, 0, 0);
                    if (I > 2) rh = __builtin_amdgcn_mfma_f32_16x16x32_bf16(cfrag(CM(2), 16 * I + n, 1, c4), cfrag(CM(0), cw + n, 1, c4), rh, 0, 0, 0); }
#pragma unroll
                for (int r = 0; r < 4; ++r) scr[(4 * c4 + r) * 17 + n] = rh[r] + ((16 * I + 4 * c4 + r) == (cw + n) ? 1.f : 0.f);
                wave_lds_fence();
                float x[16];
#pragma unroll
                for (int i = 0; i < 16; ++i) x[i] = scr[i * 17 + n];
                f32x4 mc[4], mn[4];
                mc[0] = *(const LAS f32x4*)(F32 + (16 * I + 1) * 68 + 16 * I);
#pragma unroll
                for (int i = 1; i < 16; ++i) {
                    if (i + 1 < 16) {
#pragma unroll
                        for (int j4 = 0; j4 < (i + 4) / 4; ++j4) mn[j4] = *(const LAS f32x4*)(F32 + (16 * I + i + 1) * 68 + 16 * I + 4 * j4);
                    }
                    float a0 = 0.f, a1 = 0.f;
#pragma unroll
                    for (int j4 = 0; j4 < (i + 3) / 4; ++j4) {
                        if (4 * j4 + 0 < i) a0 += mc[j4][0] * x[4 * j4 + 0];
                        if (4 * j4 + 1 < i) a1 += mc[j4][1] * x[4 * j4 + 1];
                        if (4 * j4 + 2 < i) a0 += mc[j4][2] * x[4 * j4 + 2];
                        if (4 * j4 + 3 < i) a1 += mc[j4][3] * x[4 * j4 + 3];
                    }
                    x[i] += a0 + a1;
#pragma unroll
                    for (int j4 = 0; j4 < 4; ++j4) mc[j4] = mn[j4];
                    asm volatile("" ::: "memory");
                }
                if (c4 == 0) {
#pragma unroll
                    for (int i = 0; i < 16; ++i) CM(3)[(16 * I + i) * CST + cw + n] = f2bf(x[i]);
                    u32x4 t0, t1;
                    t0.x = pk_bf16(x[0], x[1]); t0.y = pk_bf16(x[2], x[3]); t0.z = pk_bf16(x[4], x[5]); t0.w = pk_bf16(x[6], x[7]);
                    t1.x = pk_bf16(x[8], x[9]); t1.y = pk_bf16(x[10], x[11]); t1.z = pk_bf16(x[12], x[13]); t1.w = pk_bf16(x[14], x[15]);
                    *(LAS u32x4*)(CM(0) + (cw + n) * CST + 16 * I) = t0; *(LAS u32x4*)(CM(0) + (cw + n) * CST + 16 * I + 8) = t1;
                }
                wave_lds_fence();
            }
        }
        CH_BAR();
#pragma unroll
        for (int ti = 0; ti < 2; ++ti) {
            const int d = 16 * (tcb + ti) + n;
            { f32x4 x1 = {0.f, 0.f, 0.f, 0.f}; x1 = cmm(CM(8), 16 * tr + n, CM(7), 16 * (tcb + ti) + n, c4, x1); st_t4(CM(0), d, 16 * tr + 4 * c4, x1); }
            asm volatile("" ::: "memory");
            { f32x4 ta = {0.f, 0.f, 0.f, 0.f}; ta = cmm(CM(3), 16 * tr + n, CM(4), 16 * (tcb + ti) + n, c4, ta); st_t4(CM(1), d, 16 * tr + 4 * c4, ta); }
            asm volatile("" ::: "memory");
        }
        CH_BAR();
#pragma unroll
        for (int ti = 0; ti < 2; ++ti) {
            f32x4 uv = {0.f, 0.f, 0.f, 0.f};
            uv = cmm(CM(3), 16 * tr + n, CM(0), 16 * (tcb + ti) + n, c4, uv);
            st_t4(CM(2), 16 * (tcb + ti) + n, 16 * tr + 4 * c4, uv);
        }
        CH_BAR();
#pragma unroll
        for (int ti = 0; ti < 2; ++ti) {
            const int cc = 16 * (tcb + ti) + n, r0 = 16 * tr + 4 * c4;
            const float gl = gLs[cc];
            { f32x4 pm = {0.f, 0.f, 0.f, 0.f}; pm = cmm(CM(1), 16 * tr + n, CM(5), cc, c4, pm);
#pragma unroll
              for (int r = 0; r < 4; ++r) PCb[(r0 + r) * 64 + cc] = (pm[r] + ((r0 + r) == cc ? 1.f : 0.f)) * gl; }
            asm volatile("" ::: "memory");
            { f32x4 cm_ = {0.f, 0.f, 0.f, 0.f}; cm_ = cmm(CM(2), 16 * tr + n, CM(5), cc, c4, cm_); cm_ = cmm(CM(7), 16 * tr + n, CM(6), cc, c4, cm_);
#pragma unroll
              for (int r = 0; r < 4; ++r) CCb[(r0 + r) * 64 + cc] = cm_[r] * gl; }
            asm volatile("" ::: "memory");
            { f32x4 gg = {0.f, 0.f, 0.f, 0.f}; gg = cmm(CM(9), 16 * tr + n, CM(1), cc, c4, gg);
#pragma unroll
              for (int r = 0; r < 4; ++r) GMb[(r0 + r) * D + cc] = f2bf(gg[r] + rt[ti][r]); }
            asm volatile("" ::: "memory");
            { f32x4 y0 = {0.f, 0.f, 0.f, 0.f}; y0 = cmm(CM(9), 16 * tr + n, CM(2), cc, c4, y0); y0 = cmm(CM(10), 16 * tr + n, CM(7), cc, c4, y0);
#pragma unroll
              for (int r = 0; r < 4; ++r) Y0b[(r0 + r) * D + cc] = y0[r]; }
            asm volatile("" ::: "memory");
        }
        CH_BAR();
    }
#undef CM
#undef CH_PREFETCH
#undef CH_BAR
}

__device__ __forceinline__ void phase_sample_mixer_w(KP p, int j, int first, int stride) {
    const int tid = TID(), lane = tid & 63;
    {
        const bf16_t *RB = WSP(bf16_t, WS_RB), *KB = WSP(bf16_t, WS_KB), *VB = WSP(bf16_t, WS_VB); bf16_t* YG = WSP(bf16_t, WS_YG);
        const float *WPp = WSP(float, WS_WP), *APp = WSP(float, WS_AP), *VPp = WSP(float, WS_VP), *GG = WSP(float, WS_GG); float* VF = WSP(float, WS_VFIRST);
        for (int it = first; it < 512; it += stride) {
            const int b = it >> 4, h = it & 15, col = h * 64 + lane;
            const float* s0 = p->state_wkv + (((size_t)j * 32 + b) * 16 + h) * 4096 + lane * 64;
            float S[64];
#pragma unroll
            for (int k = 0; k < 64; k += 4) { const f32x4 t = *(const f32x4*)(s0 + k); S[k] = t[0]; S[k + 1] = t[1]; S[k + 2] = t[2]; S[k + 3] = t[3]; }
            const float w0 = p->rw_w0[j * D + col], a0 = p->rw_a0[j * D + col], kkw = p->rw_k_k[j * D + col], kaw = p->rw_k_a[j * D + col], rkw = p->rw_r_k[j * D + col];
            const float v0 = j ? p->rw_v0[(j - 1) * D + col] : 0.f, lnw = p->rw_lnx_w[j * D + col], lnb = p->rw_lnx_b[j * D + col];
            for (int t = 0; t < 8; ++t) {
                const size_t o = (size_t)(NP + b * 8 + t) * D + col;
                const float kx = bf2f(KB[o]), vx = bf2f(VB[o]), r = bf2f(RB[o]);
                const float z = -(w0 + WPp[o]), sp = fmaxf(z, 0.f) + log1pf(expf(-fabsf(z)));
                const float wd = expf(-expf(-sp - 0.5f)), asg = sigmoidf_(a0 + APp[o]);
                float v = vx;
                if (j == 0) VF[o] = vx; else { const float vf = VF[o]; v = vx + (vf - vx) * sigmoidf_(v0 + VPp[o]); }
                float kk = kx * kkw; const float ss = wave_sum(kk * kk); kk *= rsqrtf(fmaxf(ss, 1e-24f));
                const float kp = kx * (1.0f + (asg - 1.0f) * kaw), a = -kk, bq = kk * asg;
                float sa = 0.f;
#pragma unroll
                for (int k = 0; k < 64; ++k) sa += S[k] * rl(a, k);
#pragma unroll
                for (int k = 0; k < 64; ++k) S[k] = S[k] * rl(wd, k) + sa * rl(bq, k) + v * rl(kp, k);
                float y = 0.f;
#pragma unroll
                for (int k = 0; k < 64; ++k) y += S[k] * rl(r, k);
                const float mu = wave_sum(y) * (1.0f / 64.0f), dy = y - mu, var = wave_sum(dy * dy) * (1.0f / 64.0f);
                const float bonus = wave_sum(r * kp * rkw);
                YG[o] = f2bf((dy * rsqrtf(var + 64e-5f) * lnw + lnb + bonus * v) * GG[o]);
            }
            float* so = p->out + O_WKVS + (((size_t)j * 32 + b) * 16 + h) * 4096 + lane * 64;
#pragma unroll
            for (int k = 0; k < 64; k += 4) *(f32x4*)(so + k) = (f32x4){S[k], S[k + 1], S[k + 2], S[k + 3]};
        }
    }
}
__device__ __forceinline__ void phase_carry(KP p, int j, LAS unsigned char* lds) {
    const float *PCH = WSP(float, WS_PCH), *CCH = WSP(float, WS_CCH); float* SST = WSP(float, WS_SST);
    LAS float* Sl = (LAS float*)lds;
    LAS unsigned* cflag = (LAS unsigned*)(lds + 9216);
    if (TID() == 0) *cflag = 0u;
    __syncthreads();
    unsigned arrivals = 0u;
    if ((TID() >> 6) >= 4) { phase_sample_mixer_w(p, j, BID() * 4 + ((TID() >> 6) - 4), (int)gridDim.x * 4); }
    else
    for (int it = BID(); it < 256; it += gridDim.x) {
        const int wave = TID() >> 6, sh = it >> 2, row0 = 16 * (it & 3), col0 = 16 * (wave & 3), b = sh >> 4, h = sh & 15;
        const bool act = true;
        f32x4 acc = {0.f, 0.f, 0.f, 0.f}, c0, c1, c2;
        float b0[16], b1[16], b2[16];
#define CARRY_LOAD(BX, CX, cc_) do { const int l_ = TID() & 63, ln = l_ & 15, lq = l_ >> 4; \
            const float* Pc = PCH + ((size_t)sh * NCH + (cc_)) * 4096; const float* Cc = CCH + ((size_t)sh * NCH + (cc_)) * 4096; \
            _Pragma("unroll") for (int q = 0; q < 16; ++q) BX[q] = Pc[(4 * q + lq) * 64 + col0 + ln]; \
            _Pragma("unroll") for (int r = 0; r < 4; ++r) CX[r] = Cc[(row0 + 4 * lq + r) * 64 + col0 + ln]; } while (0)
#define CARRY_STEP(BX, CX, BL, CL, c_) do { const int l_ = TID() & 63, ln = l_ & 15, lq = l_ >> 4; \
            LAS float* Sw = Sl + ((c_) & 1) * (16 * 68); float* go = SST + ((size_t)sh * NCH + (c_)) * 4096; \
            if (act) { _Pragma("unroll") for (int r = 0; r < 4; ++r) Sw[(4 * lq + r) * 68 + col0 + ln] = acc[r]; } \
            const f32x4 sc = acc; acc = CX; \
            asm volatile("s_waitcnt lgkmcnt(0)" ::: "memory"); arrivals += 4u; \
            if ((TID() & 63) == 0) __hip_atomic_fetch_add(cflag, 1u, __ATOMIC_RELAXED, __HIP_MEMORY_SCOPE_WORKGROUP); \
            { unsigned sp_ = 0; while (__builtin_amdgcn_readfirstlane(__hip_atomic_load(cflag, __ATOMIC_RELAXED, __HIP_MEMORY_SCOPE_WORKGROUP)) < arrivals && ++sp_ < (1u << 22)) __builtin_amdgcn_s_sleep(0); } \
            asm volatile("" ::: "memory"); \
            if (act) { \
                _Pragma("unroll") for (int r = 0; r < 4; ++r) go[(row0 + 4 * lq + r) * 64 + col0 + ln] = sc[r]; \
                if ((c_) + 2 < NCH) CARRY_LOAD(BL, CL, (c_) + 2); \
                float av[16]; _Pragma("unroll") for (int q = 0; q < 16; ++q) av[q] = Sw[ln * 68 + 4 * q + lq]; \
                asm volatile("s_waitcnt lgkmcnt(0)" ::: "memory"); \
                _Pragma("unroll") for (int q = 0; q < 16; ++q) acc = __builtin_amdgcn_mfma_f32_16x16x4f32(av[q], BX[q], acc, 0, 0, 0); } } while (0)
        if (act) { CARRY_LOAD(b0, c0, 0); CARRY_LOAD(b1, c1, 1); }
        for (int c = 0; c < NCH; c += 3) {
            CARRY_STEP(b0, c0, b2, c2, c);
            if (c + 1 < NCH) CARRY_STEP(b1, c1, b0, c0, c + 1);
            if (c + 2 < NCH) CARRY_STEP(b2, c2, b1, c1, c + 2);
        }
        if (act) { const int l_ = TID() & 63, ln = l_ & 15, lq = l_ >> 4; float* go = p->out + O_WKVP + (((size_t)j * 4 + b) * 16 + h) * 4096;
#pragma unroll
            for (int r = 0; r < 4; ++r) go[(row0 + 4 * lq + r) * 64 + col0 + ln] = acc[r]; }
#undef CARRY_LOAD
#undef CARRY_STEP
    }
    __syncthreads();
}
__device__ __forceinline__ void phase_sample_mixer(KP p, int j) {
    const int tid = TID(), lane = tid & 63, wave = tid >> 6;
    {
        const bf16_t *RB = WSP(bf16_t, WS_RB), *KB = WSP(bf16_t, WS_KB), *VB = WSP(bf16_t, WS_VB); bf16_t* YG = WSP(bf16_t, WS_YG);
        const float *WPp = WSP(float, WS_WP), *APp = WSP(float, WS_AP), *VPp = WSP(float, WS_VP), *GG = WSP(float, WS_GG); float* VF = WSP(float, WS_VFIRST);
        for (int it = BID() * 8 + wave; it < 512; it += gridDim.x * 8) {
            const int b = it >> 4, h = it & 15, col = h * 64 + lane;
            const float* s0 = p->state_wkv + (((size_t)j * 32 + b) * 16 + h) * 4096 + lane * 64;
            float S[64];
#pragma unroll
            for (int k = 0; k < 64; k += 4) { const f32x4 t = *(const f32x4*)(s0 + k); S[k] = t[0]; S[k + 1] = t[1]; S[k + 2] = t[2]; S[k + 3] = t[3]; }
            const float w0 = p->rw_w0[j * D + col], a0 = p->rw_a0[j * D + col], kkw = p->rw_k_k[j * D + col], kaw = p->rw_k_a[j * D + col], rkw = p->rw_r_k[j * D + col];
            const float v0 = j ? p->rw_v0[(j - 1) * D + col] : 0.f, lnw = p->rw_lnx_w[j * D + col], lnb = p->rw_lnx_b[j * D + col];
            for (int t = 0; t < 8; ++t) {
                const size_t o = (size_t)(NP + b * 8 + t) * D + col;
                const float kx = bf2f(KB[o]), vx = bf2f(VB[o]), r = bf2f(RB[o]);
                const float z = -(w0 + WPp[o]), sp = fmaxf(z, 0.f) + log1pf(expf(-fabsf(z)));
                const float wd = expf(-expf(-sp - 0.5f)), asg = sigmoidf_(a0 + APp[o]);
                float v = vx;
                if (j == 0) VF[o] = vx; else { const float vf = VF[o]; v = vx + (vf - vx) * sigmoidf_(v0 + VPp[o]); }
                float kk = kx * kkw; const float ss = wave_sum(kk * kk); kk *= rsqrtf(fmaxf(ss, 1e-24f));
                const float kp = kx * (1.0f + (asg - 1.0f) * kaw), a = -kk, bq = kk * asg;
                float sa = 0.f;
#pragma unroll
                for (int k = 0; k < 64; ++k) sa += S[k] * rl(a, k);
#pragma unroll
                for (int k = 0; k < 64; ++k) S[k] = S[k] * rl(wd, k) + sa * rl(bq, k) + v * rl(kp, k);
                float y = 0.f;
#pragma unroll
                for (int k = 0; k < 64; ++k) y += S[k] * rl(r, k);
                const float mu = wave_sum(y) * (1.0f / 64.0f), dy = y - mu, var = wave_sum(dy * dy) * (1.0f / 64.0f);
                const float bonus = wave_sum(r * kp * rkw);
                YG[o] = f2bf((dy * rsqrtf(var + 64e-5f) * lnw + lnb + bonus * v) * GG[o]);
            }
            float* so = p->out + O_WKVS + (((size_t)j * 32 + b) * 16 + h) * 4096 + lane * 64;
#pragma unroll
            for (int k = 0; k < 64; k += 4) *(f32x4*)(so + k) = (f32x4){S[k], S[k + 1], S[k + 2], S[k + 3]};
        }
    }
}
__device__ __forceinline__ void phase_post2(KP p, int j, LAS unsigned char* lds) {
    LAS float* part = (LAS float*)lds;
    const bf16_t *GM = WSP(bf16_t, WS_DEC), *VM2 = WSP(bf16_t, WS_KM), *TG = WSP(bf16_t, WS_TG), *G2T = WSP(bf16_t, WS_G2T) + (size_t)j * D * 160;
    const float *Y0 = WSP(float, WS_Y), *BON = WSP(float, WS_AV), *SST = WSP(float, WS_SST); bf16_t* YG = WSP(bf16_t, WS_YG);
    for (int it = BID(); it < 64 * NCH; it += gridDim.x) {
        const int tid = TID(), lane = tid & 63, w = tid >> 6, n = lane & 15, c4 = lane >> 4, tr = w >> 1, tcb = 2 * (w & 1);
        const int sh = it / NCH, c = it % NCH, b = sh >> 4, h = sh & 15, R0 = b * 4096 + c * LCH, hc = h * 64;
        f32x4 y[2], g[2];
        const size_t ar = (size_t)(R0 + 16 * tr + n);
#pragma unroll
        for (int ti = 0; ti < 2; ++ti) {
            const int dv = 16 * (tcb + ti) + n;
            f32x4 acc = {0.f, 0.f, 0.f, 0.f}, gacc = acc;
#pragma unroll
            for (int ks = 0; ks < 2; ++ks) {
                const bf16x8 af = *(const bf16x8*)(GM + ar * D + hc + 32 * ks + 8 * c4);
                const float* sp = SST + ((size_t)it * 64 + dv) * 64 + 32 * ks + 8 * c4; const f32x4 s0 = *(const f32x4*)sp, s1 = *(const f32x4*)(sp + 4);
                const u32x4 bw = {pk_bf16(s0[0], s0[1]), pk_bf16(s0[2], s0[3]), pk_bf16(s1[0], s1[1]), pk_bf16(s1[2], s1[3])};
                acc = __builtin_amdgcn_mfma_f32_16x16x32_bf16(af, __builtin_bit_cast(bf16x8, bw), acc, 0, 0, 0);
            }
#pragma unroll
            for (int ks = 0; ks < 5; ++ks)
                gacc = __builtin_amdgcn_mfma_f32_16x16x32_bf16(*(const bf16x8*)(TG + ar * 160 + 32 * ks + 8 * c4), *(const bf16x8*)(G2T + (size_t)(hc + dv) * 160 + 32 * ks + 8 * c4), gacc, 0, 0, 0);
#pragma unroll
            for (int r = 0; r < 4; ++r) acc[r] += Y0[(size_t)(R0 + 16 * tr + 4 * c4 + r) * D + hc + dv];
            y[ti] = acc; g[ti] = gacc;
        }
        float bonus4[4]; unsigned short vm4[2][4]; float lnw2[2], lnb2[2];
#pragma unroll
        for (int r = 0; r < 4; ++r) bonus4[r] = BON[(size_t)(R0 + 16 * tr + 4 * c4 + r) * 16 + h];
#pragma unroll
        for (int ti = 0; ti < 2; ++ti) { const int col = hc + 16 * (tcb + ti) + n; lnw2[ti] = p->rw_lnx_w[j * D + col]; lnb2[ti] = p->rw_lnx_b[j * D + col];
#pragma unroll
            for (int r = 0; r < 4; ++r) vm4[ti][r] = VM2[(size_t)(R0 + 16 * tr + 4 * c4 + r) * D + col]; }
        float s1[4], s2[4];
#pragma unroll
        for (int r = 0; r < 4; ++r) { s1[r] = g16_sum(y[0][r] + y[1][r]); s2[r] = g16_sum(y[0][r] * y[0][r] + y[1][r] * y[1][r]); }
        asm volatile("s_waitcnt lgkmcnt(0)" ::: "memory"); __builtin_amdgcn_s_barrier(); asm volatile("" ::: "memory");
        if (n == 0) {
#pragma unroll
            for (int r = 0; r < 4; ++r) { const int t = 16 * tr + 4 * c4 + r; part[(t * 2 + (w & 1)) * 2 + 0] = s1[r]; part[(t * 2 + (w & 1)) * 2 + 1] = s2[r]; }
        }
        asm volatile("s_waitcnt lgkmcnt(0)" ::: "memory"); __builtin_amdgcn_s_barrier(); asm volatile("" ::: "memory");
#pragma unroll
        for (int r = 0; r < 4; ++r) {
            const int t = 16 * tr + 4 * c4 + r;
            const float mu = (part[(t * 2 + 0) * 2] + part[(t * 2 + 1) * 2]) * (1.0f / 64.0f), ex2 = (part[(t * 2 + 0) * 2 + 1] + part[(t * 2 + 1) * 2 + 1]) * (1.0f / 64.0f);
            const float rs = rsqrtf(fmaxf(ex2 - mu * mu, 0.f) + 64e-5f), bonus = bonus4[r];
#pragma unroll
            for (int ti = 0; ti < 2; ++ti) {
                const int col = hc + 16 * (tcb + ti) + n; const size_t o = (size_t)(R0 + t) * D + col;
                YG[o] = f2bf(((y[ti][r] - mu) * rs * lnw2[ti] + lnb2[ti] + bonus * bf2f(vm4[ti][r])) * g[ti][r]);
            }
        }
    }
    __syncthreads();
}

__device__ __forceinline__ void phase_post(KP p, int j) {
    const float *Y = WSP(float, WS_Y), *KM = WSP(float, WS_KM), *VM = WSP(float, WS_VM), *GG = WSP(float, WS_GG);
    const bf16_t* RB = WSP(bf16_t, WS_RB); bf16_t* YG = WSP(bf16_t, WS_YG);
    const int lane = TID() & 63, gw = BID() * 8 + (TID() >> 6), nw = gridDim.x * 8;
    for (int row = gw; row < NT; row += nw) {
#pragma unroll
        for (int i = 0; i < 4; ++i) {
            const int col = 256 * i + 4 * lane; const size_t o = (size_t)row * D + col;
            const f32x4 y = *(const f32x4*)(Y + o), r = ld_bf4(RB + o), km = *(const f32x4*)(KM + o), vm = *(const f32x4*)(VM + o), gg = *(const f32x4*)(GG + o);
            const f32x4 lw = *(const f32x4*)(p->rw_lnx_w + j * D + col), lb = *(const f32x4*)(p->rw_lnx_b + j * D + col), rk = *(const f32x4*)(p->rw_r_k + j * D + col);
            const float mu = g16_sum(y[0] + y[1] + y[2] + y[3]) * (1.0f / 64.0f);
            const f32x4 d = y - mu;
            const float var = g16_sum(d[0] * d[0] + d[1] * d[1] + d[2] * d[2] + d[3] * d[3]) * (1.0f / 64.0f);
            const float rs = rsqrtf(var + 64e-5f);
            const float bon = g16_sum(r[0] * km[0] * rk[0] + r[1] * km[1] * rk[1] + r[2] * km[2] * rk[2] + r[3] * km[3] * rk[3]);
            st_bf4(YG + o, (d * rs * lw + lb + bon * vm) * gg);
        }
    }
}

__constant__ double kRopeInv[8] = {1.0, 0.19392274474868576, 0.03760603093086393, 0.007292664737217109, 0.001414213562373095, 0.0002742481756762073, 5.318295896944988e-05, 1.031338537721246e-05};
__device__ __forceinline__ void phase_dsapost(KP p, int j) {
    const bf16_t* PR = WSP(bf16_t, WS_PR); float *Q = WSP(float, WS_Q), *QI = WSP(float, WS_QI), *WI = WSP(float, WS_WI);
    const int lane = TID() & 63, l16 = lane & 15, gw = BID() * 8 + (TID() >> 6), nw = gridDim.x * 8;
    const f32x4 qn = *(const f32x4*)(p->att_q_norm + j * 64 + 4 * l16), kn = *(const f32x4*)(p->att_k_norm + j * 64 + 4 * l16), in = *(const f32x4*)(p->idx_k_norm + j * 64 + 4 * l16);
    for (int row = gw; row < NT; row += nw) {
        const int pos = row_pos(row);
        const bf16_t* pr = PR + (size_t)row * PINP;
        f32x4 cs = {1.f, 1.f, 1.f, 1.f}, sn = {0.f, 0.f, 0.f, 0.f};
        if (l16 < 4) {
#pragma unroll
            for (int e = 0; e < 4; ++e) { double ang = (double)pos * kRopeInv[4 * (l16 & 1) + e]; ang -= floor(ang * 0.15915494309189535) * 6.283185307179586; const float af = (float)ang; cs[e] = cosf(af); sn[e] = sinf(af); }
        }
        const float sgn = (l16 < 2) ? -1.0f : 1.0f;
#define ROPE4(v) do { f32x4 _o; _o[0] = __shfl_xor((v)[0], 2); _o[1] = __shfl_xor((v)[1], 2); _o[2] = __shfl_xor((v)[2], 2); _o[3] = __shfl_xor((v)[3], 2); if (l16 < 4) (v) = (v) * cs + sgn * (_o * sn); } while (0)
#define HNORM4(v, w) do { const float _ss = g16_sum((v)[0] * (v)[0] + (v)[1] * (v)[1] + (v)[2] * (v)[2] + (v)[3] * (v)[3]); (v) = (v) * rsqrtf(_ss * (1.0f / 64.0f) + 1e-6f) * (w); } while (0)
#pragma unroll
        for (int i = 0; i < 4; ++i) { f32x4 v = ld_bf4(pr + 256 * i + 4 * lane); HNORM4(v, qn); ROPE4(v); st_bf4((bf16_t*)Q + (size_t)row * D + 256 * i + 4 * lane, v); }
        { f32x4 v = ld_bf4(pr + 1024 + 4 * lane); HNORM4(v, kn); ROPE4(v);
          float* ko = row < NP ? p->out + O_KP + ((size_t)j * NP + row) * 256 : p->out + O_KS + ((size_t)j * NS + (row - NP)) * 256; *(f32x4*)(ko + 4 * lane) = v; st_bf4(WSP(bf16_t, WS_KBF) + (size_t)row * 256 + 4 * lane, v); *(unsigned*)(WSP(unsigned char, WS_K8) + (size_t)row * 256 + 4 * lane) = pk_fp8x4(v); }
        { const f32x4 v = ld_bf4(pr + 1280 + 4 * lane);
          float* vo = row < NP ? p->out + O_VP + ((size_t)j * NP + row) * 256 : p->out + O_VS + ((size_t)j * NS + (row - NP)) * 256; *(f32x4*)(vo + 4 * lane) = v; st_bf4(WSP(bf16_t, WS_VBF) + (size_t)row * 256 + 4 * lane, v); *(unsigned*)(WSP(unsigned char, WS_V8) + (size_t)row * 256 + 4 * lane) = pk_fp8x4(v); }
#pragma unroll
        for (int i = 0; i < 2; ++i) { f32x4 v = ld_bf4(pr + 1536 + 256 * i + 4 * lane); ROPE4(v); st_bf4(WSP(bf16_t, WS_QIB) + (size_t)row * 512 + 256 * i + 4 * lane, v); }
        { f32x4 v = ld_bf4(pr + 2048 + 4 * l16); HNORM4(v, in); ROPE4(v);
          float* io = row < NP ? p->out + O_IKP + ((size_t)j * NP + row) * 64 : p->out + O_IKS + ((size_t)j * NS + (row - NP)) * 64; if (lane < 16) { *(f32x4*)(io + 4 * lane) = v; st_bf4(WSP(bf16_t, WS_KIB) + (size_t)row * 64 + 4 * lane, v); } }
        if (lane < 2) { const f32x4 v = ld_bf4(pr + 2112 + 4 * lane); *(f32x4*)(WI + (size_t)row * 8 + 4 * lane) = v * 0.35355339059327373f; }
#undef ROPE4
#undef HNORM4
    }
}

template <bool SAMPLE>
__device__ __forceinline__ void phase_idx(KP p, int j, LAS unsigned char* lds) {
    LAS float* Qs = (LAS float*)lds;
    LAS float* Ks = (LAS float*)(lds + 32768);
    const float *QI = WSP(float, WS_QI), *WI = WSP(float, WS_WI);
    const int tid = TID(), q = tid >> 5, kx = tid & 31;
    const int nitems = SAMPLE ? 32 * 65 : 1024;
    for (int it = BID(); it < nitems; it += gridDim.x) {
        int b, t0, rowbase, nkt, kt0 = 0;
        if (SAMPLE) { b = it / 65; kt0 = it % 65; t0 = 0; rowbase = NP + b * 8; nkt = kt0 + 1; }
        else { const int k4 = it >> 8, w = it & 255, i = (k4 & 1) ? (k4 * 256 + 255 - w) : (k4 * 256 + w); b = i & 3; t0 = (i >> 2) * 16; rowbase = b * 4096 + t0; nkt = (t0 + 15) / 128 + 1; }
        const int nq = SAMPLE ? 8 : 16;
        __syncthreads();
#pragma unroll
        for (int n = 0; n < 16; ++n) { const int e = tid + 512 * n, qq = e >> 9, c = e & 511, h = c >> 6, d = c & 63;
            Qs[(d * 16 + qq) * 8 + h] = qq < nq ? QI[(size_t)(rowbase + qq) * 512 + c] : 0.f; }
        float wi[8];
#pragma unroll
        for (int h = 0; h < 8; ++h) wi[h] = q < nq ? WI[(size_t)(rowbase + q) * 8 + h] : 0.f;
        for (int kt = kt0; kt < nkt; ++kt) {
            __syncthreads();
#pragma unroll
            for (int n = 0; n < 16; ++n) { const int e = tid + 512 * n, key = e >> 6, d = e & 63, s = kt * 128 + key; float v = 0.f;
                if (SAMPLE) {
                    if (s < PAST) { const int pg = p->page_table[b * 64 + (s >> 7)]; v = p->cache_ik[(((size_t)j * 2560 + pg) * 128 + (s & 127)) * 64 + d]; }
                    else if (s < PAST + 8) v = p->out[O_IKS + ((size_t)j * NS + b * 8 + (s - PAST)) * 64 + d];
                } else v = p->out[O_IKP + ((size_t)j * NP + b * 4096 + s) * 64 + d];
                Ks[d * 132 + key] = v; }
            __syncthreads();
            f32x4 acc[8];
#pragma unroll
            for (int h = 0; h < 8; ++h) acc[h] = (f32x4){0.f, 0.f, 0.f, 0.f};
#pragma unroll 4
            for (int d = 0; d < 64; ++d) {
                const f32x4 qa = *(const LAS f32x4*)(Qs + (d * 16 + q) * 8), qb = *(const LAS f32x4*)(Qs + (d * 16 + q) * 8 + 4), kv = *(const LAS f32x4*)(Ks + d * 132 + 4 * kx);
                acc[0] += qa[0] * kv; acc[1] += qa[1] * kv; acc[2] += qa[2] * kv; acc[3] += qa[3] * kv;
                acc[4] += qb[0] * kv; acc[5] += qb[1] * kv; acc[6] += qb[2] * kv; acc[7] += qb[3] * kv;
            }
            f32x4 sc = {0.f, 0.f, 0.f, 0.f};
#pragma unroll
            for (int h = 0; h < 8; ++h)
#pragma unroll
                for (int e = 0; e < 4; ++e) sc[e] += fmaxf(acc[h][e] * 0.125f, 0.f) * wi[h];
            if (q < nq) {
                if (SAMPLE) *(f32x4*)(WSP(float, WS_SCS) + (size_t)(b * 8 + q) * SCS_LD + kt * 128 + 4 * kx) = sc;
                else *(f32x4*)(WSP(float, WS_SC) + ((size_t)b * 4096 + t0 + q) * 4096 + kt * 128 + 4 * kx) = sc;
            }
        }
    }
    __syncthreads();
}

template <bool SAMPLE>
__device__ __forceinline__ void phase_idx2(KP p, int j) {
    const bf16_t *QIB = WSP(bf16_t, WS_QIB), *KIB = WSP(bf16_t, WS_KIB); const float* WI = WSP(float, WS_WI);
    const int lane = TID() & 63, lr = lane & 31, lh = lane >> 5, gw = BID() * 8 + (TID() >> 6), nw = gridDim.x * 8;
    const int nitems = SAMPLE ? 32 * 65 : 4096;
    for (int it = gw; it < nitems; it += nw) {
        int b, rowbase, tile0, ntile;
        if (SAMPLE) { b = it / 65; rowbase = NP + b * 8; tile0 = (it % 65) * 4; ntile = min(4, 257 - tile0); }
        else { const int sub = it >= 2048, w_ = it & 2047; b = w_ & 3; const int wb = w_ >> 2, kk = sub ? 511 - wb : wb, nt = (kk * 8 + 7) / 32 + 1;
            rowbase = b * 4096 + kk * 8; tile0 = sub ? (nt >> 1) : 0; ntile = sub ? nt - (nt >> 1) : (nt >> 1); }
        if (ntile <= 0) continue;
        bf16x8 af[2][4]; float w[2][2][8];
        { const int hd = (lr & 3) + 4 * ((lr >> 3) & 1), jq = 2 * ((lr >> 2) & 1) + (lr >> 4);
#pragma unroll
          for (int st = 0; st < 2; ++st)
#pragma unroll
              for (int ks = 0; ks < 4; ++ks) af[st][ks] = *(const bf16x8*)(QIB + (size_t)(rowbase + 4 * st + jq) * 512 + hd * 64 + 16 * ks + 8 * lh);
#pragma unroll
          for (int st = 0; st < 2; ++st)
#pragma unroll
              for (int q = 0; q < 2; ++q) { const f32x4 w0 = *(const f32x4*)(WI + (size_t)(rowbase + 4 * st + 2 * lh + q) * 8), w1 = *(const f32x4*)(WI + (size_t)(rowbase + 4 * st + 2 * lh + q) * 8 + 4);
#pragma unroll
                  for (int e = 0; e < 4; ++e) { w[st][q][e] = w0[e] * 0.125f; w[st][q][4 + e] = w1[e] * 0.125f; } } }
#define IDX_LOADB(BF, tl_) do { const int s_ = (tile0 + (tl_)) * 32 + lr; \
            if (!SAMPLE) { _Pragma("unroll") for (int ks = 0; ks < 4; ++ks) BF[ks] = *(const bf16x8*)(KIB + ((size_t)b * 4096 + s_) * 64 + 16 * ks + 8 * lh); } \
            else { const float* kp = p->out + O_IKS + ((size_t)j * NS + b * 8) * 64; \
                if (s_ < PAST) kp = p->cache_ik + (((size_t)j * 2560 + p->page_table[b * 64 + (s_ >> 7)]) * 128 + (s_ & 127)) * 64; else kp += (size_t)min(s_ - PAST, 7) * 64; \
                _Pragma("unroll") for (int ks = 0; ks < 4; ++ks) { const f32x4 x0 = *(const f32x4*)(kp + 16 * ks + 8 * lh), x1 = *(const f32x4*)(kp + 16 * ks + 8 * lh + 4); \
                    const u32x4 wv = {pk_bf16(x0[0], x0[1]), pk_bf16(x0[2], x0[3]), pk_bf16(x1[0], x1[1]), pk_bf16(x1[2], x1[3])}; BF[ks] = __builtin_bit_cast(bf16x8, wv); } } } while (0)
        bf16x8 bnx[4];
        IDX_LOADB(bnx, 0);
        for (int tl = 0; tl < ntile; ++tl) {
            const int s = (tile0 + tl) * 32 + lr;
            bf16x8 bfr[4];
#pragma unroll
            for (int ks = 0; ks < 4; ++ks) bfr[ks] = bnx[ks];
            if (tl + 1 < ntile) IDX_LOADB(bnx, tl + 1);
            __builtin_amdgcn_sched_barrier(0);
#pragma unroll
            for (int st = 0; st < 2; ++st) {
                f32x16 acc;
#pragma unroll
                for (int r = 0; r < 16; ++r) acc[r] = 0.f;
#pragma unroll
                for (int ks = 0; ks < 4; ++ks) acc = __builtin_amdgcn_mfma_f32_32x32x16_bf16(af[st][ks], bfr[ks], acc, 0, 0, 0);
#pragma unroll
                for (int q = 0; q < 2; ++q) {
                    float sc = 0.f;
#pragma unroll
                    for (int hh = 0; hh < 2; ++hh)
#pragma unroll
                        for (int hl = 0; hl < 4; ++hl) sc += fmaxf(acc[4 * (2 * q + hh) + hl], 0.f) * w[st][q][hl + 4 * hh];
                    if (SAMPLE) WSP(float, WS_SCS)[(size_t)(b * 8 + 4 * st + 2 * lh + q) * SCS_LD + s] = sc;
                    else WSP(float, WS_SC)[((size_t)rowbase + 4 * st + 2 * lh + q) * 4096 + s] = sc;
                }
            }
        }
    }
#undef IDX_LOADB
}

__device__ __forceinline__ unsigned fkey(float f) { f = (f == 0.f) ? 0.f : f; const unsigned u = __float_as_uint(f); return (u & 0x80000000u) ? ~u : (u | 0x80000000u); }
__device__ __forceinline__ void phase_topk_prompt(KP p) {
    const float* SC = WSP(float, WS_SC); int* SEL = WSP(int, WS_SEL); int* CNT = WSP(int, WS_CNT);
    const int lane = TID() & 63, gw = BID() * 8 + (TID() >> 6), nw = gridDim.x * 8;
    for (int qi = gw; qi < NP; qi += nw) {
        const int b = qi & 3, tt = qi >> 2, t = (tt & 1) ? 4095 - (tt >> 1) : (tt >> 1), row = b * 4096 + t, n = t + 1;
        int* sel = SEL + (size_t)row * 256;
        if (n <= TOPK) { for (int s = lane; s < n; s += 64) sel[s] = s; if (lane == 0) CNT[row] = n; continue; }
        const float* base = SC + (size_t)row * 4096;
        unsigned u[64];
#pragma unroll
        for (int m = 0; m < 64; ++m) u[m] = __float_as_uint(base[lane + 64 * m]);
#pragma unroll
        for (int m = 0; m < 64; ++m) { const unsigned k_ = fkey(__uint_as_float(u[m])); u[m] = (lane + 64 * m < n) ? k_ : 0u; }
        unsigned tau = 0u;
#pragma unroll 1
        for (int bit = 31; bit >= 0; --bit) {
            const unsigned cand = tau | (1u << bit); int c = 0;
#pragma unroll
            for (int m = 0; m < 64; ++m) c += (u[m] >= cand) ? 1 : 0;
            c = wave_sum_i(c);
            if (c >= TOPK) tau = cand;
            if (c == TOPK) break;
        }
        int cg = 0, ct = 0; unsigned tlo = 0u, thi = 0u;
#pragma unroll
        for (int m = 31; m >= 0; --m) { cg += (u[m] > tau) ? 1 : 0; const unsigned tie = (u[m] == tau) ? 1u : 0u; ct += (int)tie; tlo = (tlo << 1) | tie; }
#pragma unroll
        for (int m = 63; m >= 32; --m) { cg += (u[m] > tau) ? 1 : 0; const unsigned tie = (u[m] == tau) ? 1u : 0u; ct += (int)tie; thi = (thi << 1) | tie; }
        unsigned long long tmask = ((unsigned long long)thi << 32) | tlo;
        const int totg = wave_sum_i(cg), tott = wave_sum_i(ct);
        const int need = TOPK - totg;
        unsigned long long smask = 0ull;
        if (tott == need) smask = tmask;
        else {
#pragma unroll 1
            for (int it = 0; it < need; ++it) {
                const int m0 = tmask ? (int)__builtin_ctzll(tmask) : 64;
                const int cand = tmask ? (lane + 64 * m0) : 0x7fffffff, best = wave_min_i(cand);
                if (cand == best && tmask) { smask |= (1ull << m0); tmask &= ~(1ull << m0); }
            }
        }
        const int mine = cg + __popcll(smask);
        int incl = mine;
#pragma unroll
        for (int d = 1; d < 64; d <<= 1) { const int o = __shfl_up(incl, d); if (lane >= d) incl += o; }
        int off = incl - mine;
#pragma unroll
        for (int m = 0; m < 64; ++m) { if ((u[m] > tau) || ((smask >> m) & 1ull)) { sel[off] = lane + 64 * m; ++off; } }
        if (lane == 0) CNT[row] = TOPK;
    }
}
__device__ __forceinline__ void phase_topk_sample(KP p, LAS unsigned char* lds) {
    LAS unsigned* ckey = (LAS unsigned*)lds;
    LAS int* cidx = (LAS int*)(lds + 8192);
    const float* SCS = WSP(float, WS_SCS); int* SEL = WSP(int, WS_SEL); int* CNT = WSP(int, WS_CNT);
    for (int qq = BID(); qq < NS; qq += gridDim.x) {
        const int tid = TID(), lane = tid & 63, wave = tid >> 6;
        const int n = PAST + 1 + (qq & 7), row = NP + qq, s0 = 1088 * wave;
        const float* base = SCS + (size_t)qq * SCS_LD;
        unsigned u[17];
#pragma unroll
        for (int m = 0; m < 17; ++m) { const int s = s0 + lane + 64 * m; u[m] = __float_as_uint(base[s < SCS_LD ? s : 0]); }
#pragma unroll
        for (int m = 0; m < 17; ++m) { const unsigned k_ = fkey(__uint_as_float(u[m])); u[m] = (s0 + lane + 64 * m < n) ? k_ : 0u; }
        __syncthreads();
        {
            int nvalid = 0;
#pragma unroll
            for (int m = 0; m < 17; ++m) nvalid += (u[m] != 0u) ? 1 : 0;
            nvalid = wave_sum_i(nvalid);
            unsigned tau = 0u; int need = 0; unsigned tmask = 0u, smask = 0u;
            if (nvalid > TOPK) {
#pragma unroll 1
                for (int bit = 31; bit >= 0; --bit) {
                    const unsigned cand = tau | (1u << bit); int c = 0;
#pragma unroll
                    for (int m = 0; m < 17; ++m) c += (u[m] >= cand) ? 1 : 0;
                    c = wave_sum_i(c);
                    if (c >= TOPK) tau = cand;
                    if (c == TOPK) break;
                }
                int cg = 0, ct = 0;
#pragma unroll
                for (int m = 0; m < 17; ++m) { cg += (u[m] > tau) ? 1 : 0; const bool tie = (u[m] == tau); ct += tie ? 1 : 0; tmask |= tie ? (1u << m) : 0u; }
                cg = wave_sum_i(cg); ct = wave_sum_i(ct);
                need = TOPK - cg;
                if (ct == need) smask = tmask;
                else {
#pragma unroll 1
                    for (int it = 0; it < need; ++it) {
                        const int m0 = tmask ? (int)__builtin_ctz(tmask) : 32;
                        const int cand = tmask ? (lane + 64 * m0) : 0x7fffffff, best = wave_min_i(cand);
                        if (cand == best && tmask) { smask |= (1u << m0); tmask &= ~(1u << m0); }
                    }
                }
            } else { tau = 0u; smask = 0u; }
            int mine = 0;
#pragma unroll
            for (int m = 0; m < 17; ++m) mine += ((u[m] > tau) || ((smask >> m) & 1u)) ? 1 : 0;
            int incl = mine;
#pragma unroll
            for (int d = 1; d < 64; d <<= 1) { const int o = __shfl_up(incl, d); if (lane >= d) incl += o; }
            int off = incl - mine;
            const int total = __builtin_amdgcn_readlane(incl, 63);
#pragma unroll
            for (int m = 0; m < 17; ++m) { if ((u[m] > tau) || ((smask >> m) & 1u)) { ckey[wave * 256 + off] = u[m]; cidx[wave * 256 + off] = s0 + lane + 64 * m; ++off; } }
            for (int e = total + lane; e < 256; e += 64) { ckey[wave * 256 + e] = 0u; cidx[wave * 256 + e] = 0x7fffffff; }
        }
        __syncthreads();
        if (wave == 0) {
            unsigned v[32]; int ix[32];
#pragma unroll
            for (int m = 0; m < 32; ++m) { v[m] = ckey[lane + 64 * m]; ix[m] = cidx[lane + 64 * m]; }
            unsigned tau = 0u;
#pragma unroll 1
            for (int bit = 31; bit >= 0; --bit) {
                const unsigned cand = tau | (1u << bit); int c = 0;
#pragma unroll
                for (int m = 0; m < 32; ++m) c += (v[m] >= cand) ? 1 : 0;
                c = wave_sum_i(c);
                if (c >= TOPK) tau = cand;
                if (c == TOPK) break;
            }
            int cg = 0, ct = 0; unsigned tmask = 0u, smask = 0u;
#pragma unroll
            for (int m = 31; m >= 0; --m) { cg += (v[m] > tau) ? 1 : 0; const unsigned tie = (v[m] == tau) ? 1u : 0u; ct += (int)tie; tmask = (tmask << 1) | tie; }
            cg = wave_sum_i(cg); ct = wave_sum_i(ct);
            const int need = TOPK - cg;
            if (ct == need) smask = tmask;
            else {
#pragma unroll 1
                for (int it = 0; it < need; ++it) {
                    int bi = 0x7fffffff, bm = 0;
#pragma unroll
                    for (int m = 0; m < 32; ++m) { const bool t_ = (tmask >> m) & 1u; if (t_ && ix[m] < bi) { bi = ix[m]; bm = m; } }
                    const int best = wave_min_i(bi);
                    if (bi == best && bi != 0x7fffffff) { smask |= (1u << bm); tmask &= ~(1u << bm); }
                }
            }
            int mine = 0;
#pragma unroll
            for (int m = 0; m < 32; ++m) mine += ((v[m] > tau) || ((smask >> m) & 1u)) ? 1 : 0;
            int incl = mine;
#pragma unroll
            for (int d = 1; d < 64; d <<= 1) { const int o = __shfl_up(incl, d); if (lane >= d) incl += o; }
            int off = incl - mine;
            int* sel = SEL + (size_t)row * 256;
#pragma unroll
            for (int m = 0; m < 32; ++m) { if ((v[m] > tau) || ((smask >> m) & 1u)) { if (off < TOPK) sel[off] = ix[m]; ++off; } }
            if (lane == 0) CNT[row] = TOPK;
        }
    }
    __syncthreads();
}

template <bool SAMPLE>
__device__ __forceinline__ void phase_attn(KP p, int j, LAS unsigned char* lds) {
    const int tid = TID(), lane = tid & 63, wave = tid >> 6, n16 = lane & 15, c4 = lane >> 4;
    LAS bf16_t* ps = (LAS bf16_t*)(lds + wave * 16384);
    LAS int* is = (LAS int*)(lds + wave * 16384 + 8192);
    LAS bf16_t* qs = (LAS bf16_t*)(lds + wave * 16384 + 9216);
    LAS float* invs = (LAS float*)(lds + wave * 16384 + 11264);
    const float* Q = WSP(float, WS_Q); const int* SEL = WSP(int, WS_SEL); const int* CNT = WSP(int, WS_CNT); bf16_t* O = WSP(bf16_t, WS_YG);
    const bf16_t *KBF = WSP(bf16_t, WS_KBF), *VBF = WSP(bf16_t, WS_VBF);
    const float* kc = p->cache_k + (size_t)j * 2560 * 128 * 256; const float* vc = p->cache_v + (size_t)j * 2560 * 128 * 256;
    const float* knew = p->out + O_KS + (size_t)j * NS * 256; const float* vnew = p->out + O_VS + (size_t)j * NS * 256;
    const int gw = BID() * 8 + wave, nw = gridDim.x * 8, nq = SAMPLE ? NS : NP;
    unsigned* qctr = WSP(unsigned, WS_BAR + 40960) + (size_t)j * 256;
    int qb = 0, qnext = 0, qsub = 2, qcur = 0;
    if (!SAMPLE) { unsigned v_ = 0u; if (lane == 0) v_ = __hip_atomic_fetch_add(qctr + 16 * ((BID() + qb) & 3), 2u, __ATOMIC_RELAXED, __HIP_MEMORY_SCOPE_AGENT); qnext = (int)__builtin_amdgcn_readfirstlane(v_); }
    for (int qi = gw; SAMPLE ? (qi < nq) : true; qi += nw) {
        int row;
        if (SAMPLE) row = NP + qi;
        else {
            if (qsub == 2) {
                for (;;) {
                    qcur = qnext; qsub = 0;
                    if (qcur < 4096 || qb == 3) break;
                    ++qb; unsigned v_ = 0u; if (lane == 0) v_ = __hip_atomic_fetch_add(qctr + 16 * ((BID() + qb) & 3), 2u, __ATOMIC_RELAXED, __HIP_MEMORY_SCOPE_AGENT); qnext = (int)__builtin_amdgcn_readfirstlane(v_);
                }
                if (qcur >= 4096) break;
                { unsigned v_ = 0u; if (lane == 0) v_ = __hip_atomic_fetch_add(qctr + 16 * ((BID() + qb) & 3), 2u, __ATOMIC_RELAXED, __HIP_MEMORY_SCOPE_AGENT); qnext = (int)__builtin_amdgcn_readfirstlane(v_); }
            }
            row = ((BID() + qb) & 3) * 4096 + (4095 - (qcur + qsub)); ++qsub;
        }
        const int n = CNT[row];
        wave_lds_fence();
#pragma unroll
        for (int c = 0; c < 4; ++c) { const int slot = lane + 64 * c;
            int s = SEL[(size_t)row * 256 + slot]; const bool ok = slot < n;
            int r;
            if (SAMPLE) { const int bb = (row - NP) >> 3; s = ok ? s : 0; const int sp = min(max(s, 0), PAST - 1); const int pg = p->page_table[bb * 64 + (sp >> 7)];
                r = (s < PAST) ? pg * 128 + (s & 127) : (0x40000000 | (bb * 8 + min(s - PAST, 7))); }
            else r = (row & ~4095) + (ok ? s : 0);
            is[slot] = r; }
#pragma unroll
        for (int i = 0; i < 4; ++i) { const f32x4 q4 = ld_bf4((const bf16_t*)Q + (size_t)row * D + 256 * i + 4 * lane);
            if (SAMPLE) { const f32x4 q8 = q4 * 0.125f; u32x2 w; w.x = pk_bf16(q8[0], q8[1]); w.y = pk_bf16(q8[2], q8[3]); *(LAS u32x2*)(qs + 256 * i + 4 * lane) = w; }
            else *(LAS unsigned*)((LAS unsigned char*)qs + 256 * i + 4 * lane) = pk_fp8x4(q4); }
        wave_lds_fence();
        {
            float mx = -__builtin_huge_valf();
#define ATT_EMIT(t_, acc_) do { f32x4 l_ = (acc_); _Pragma("unroll") for (int r = 0; r < 4; ++r) { if (16 * (t_) + 4 * c4 + r >= n) l_[r] = -__builtin_huge_valf(); mx = fmaxf(mx, l_[r]); } \
                u32x2 w_; w_.x = pk_bf16(l_[0], l_[1]); w_.y = pk_bf16(l_[2], l_[3]); *(LAS u32x2*)(ps + n16 * 256 + 16 * (t_) + 4 * c4) = w_; } while (0)
            if (SAMPLE) {
                const u32x4 qf0 = *(const LAS u32x4*)(qs + n16 * 64 + 8 * c4), qf1 = *(const LAS u32x4*)(qs + n16 * 64 + 32 + 8 * c4);
                u32x4 bq[8];
#pragma unroll
                for (int ks = 0; ks < 8; ++ks) { const bool on = (n16 >> 2) == (ks >> 1); const u32x4 qv = (ks & 1) ? qf1 : qf0; bq[ks] = (u32x4){on ? qv.x : 0u, on ? qv.y : 0u, on ? qv.z : 0u, on ? qv.w : 0u}; }
#pragma unroll 2
                for (int t = 0; t < 16; ++t) {
                    const int r = is[16 * t + n16];
                    const float* kp = ((r & 0x40000000) ? knew + (size_t)(r & 0xffff) * 256 : kc + (size_t)r * 256) + 8 * c4;
                    f32x4 acc = {0.f, 0.f, 0.f, 0.f};
#pragma unroll
                    for (int ks = 0; ks < 8; ++ks) { const f32x4 x0 = *(const f32x4*)(kp + 32 * ks), x1 = *(const f32x4*)(kp + 32 * ks + 4);
                        const u32x4 ka = {pk_bf16(x0[0], x0[1]), pk_bf16(x0[2], x0[3]), pk_bf16(x1[0], x1[1]), pk_bf16(x1[2], x1[3])};
                        acc = __builtin_amdgcn_mfma_f32_16x16x32_bf16(__builtin_bit_cast(bf16x8, ka), __builtin_bit_cast(bf16x8, bq[ks]), acc, 0, 0, 0); }
                    ATT_EMIT(t, acc);
                }
            } else {
                const LAS unsigned char* q8 = (const LAS unsigned char*)qs;
                long bq[8];
                { const bool on = (n16 >> 2) == c4;
#pragma unroll
                  for (int h2 = 0; h2 < 4; ++h2) { const u32x4 qv = *(const LAS u32x4*)(q8 + n16 * 64 + 16 * h2);
                      const u32x2 z0 = {on ? qv.x : 0u, on ? qv.y : 0u}, z1 = {on ? qv.z : 0u, on ? qv.w : 0u}; bq[2 * h2] = __builtin_bit_cast(long, z0); bq[2 * h2 + 1] = __builtin_bit_cast(long, z1); } }
                const unsigned char* K8 = WSP(unsigned char, WS_K8);
#pragma unroll
                for (int th = 0; th < 2; ++th) {
                    if (th) asm volatile("" ::: "memory");
                    u32x4 ka[8][4];
#pragma unroll
                    for (int t8 = 0; t8 < 8; ++t8) {
                        const int r = is[16 * (8 * th + t8) + n16];
                        const unsigned char* kp = K8 + (size_t)r * 256 + 64 * c4;
#pragma unroll
                        for (int h2 = 0; h2 < 4; ++h2) ka[t8][h2] = *(const u32x4*)(kp + 16 * h2);
                    }
                    __builtin_amdgcn_sched_barrier(0);
#pragma unroll
                    for (int t8 = 0; t8 < 8; ++t8) {
                        f32x4 acc = {0.f, 0.f, 0.f, 0.f};
#pragma unroll
                        for (int h2 = 0; h2 < 4; ++h2) { const u32x2 lo = {ka[t8][h2].x, ka[t8][h2].y}, hi = {ka[t8][h2].z, ka[t8][h2].w};
                            acc = __builtin_amdgcn_mfma_f32_16x16x32_fp8_fp8(__builtin_bit_cast(long, lo), bq[2 * h2], acc, 0, 0, 0);
                            acc = __builtin_amdgcn_mfma_f32_16x16x32_fp8_fp8(__builtin_bit_cast(long, hi), bq[2 * h2 + 1], acc, 0, 0, 0); }
                        ATT_EMIT(8 * th + t8, acc * 0.125f);
                    }
                }
            }
#undef ATT_EMIT
            mx = fmaxf(mx, __shfl_xor(mx, 16)); mx = fmaxf(mx, __shfl_xor(mx, 32));
            float sm = 0.f;
            u32x2 lw_[16];
#pragma unroll
            for (int t = 0; t < 16; ++t) lw_[t] = *(const LAS u32x2*)(ps + n16 * 256 + 16 * t + 4 * c4);
#pragma unroll
            for (int t = 0; t < 16; ++t) {
                const u32x2 w = lw_[t];
                const float e0 = __expf(bflo(w.x) - mx), e1 = __expf(bfhi(w.x) - mx), e2 = __expf(bflo(w.y) - mx), e3 = __expf(bfhi(w.y) - mx);
                sm += (e0 + e1) + (e2 + e3);
                u32x2 o_; o_.x = pk_bf16(e0, e1); o_.y = pk_bf16(e2, e3); *(LAS u32x2*)(ps + n16 * 256 + 16 * t + 4 * c4) = o_;
            }
            sm += __shfl_xor(sm, 16); sm += __shfl_xor(sm, 32);
            if (c4 == 0) invs[n16] = 1.0f / sm;
        }
        wave_lds_fence();
        if (!SAMPLE) {
            const unsigned char* V8 = WSP(unsigned char, WS_V8);
            const int rs = c4, kvh = n16 >> 2, nst = n > 64 ? 64 : n;
            f32x4 oa[4][4];
#pragma unroll
            for (int g = 0; g < 4; ++g)
#pragma unroll
                for (int q = 0; q < 4; ++q) oa[g][q] = (f32x4){0.f, 0.f, 0.f, 0.f};
            u32x4 vr[8], vn[8];
#pragma unroll
            for (int i = 0; i < 8; ++i) vn[i] = *(const u32x4*)(V8 + (size_t)is[64 * rs + i] * 256 + 16 * n16);
            for (int m0 = 0; m0 < nst; m0 += 8) {
#pragma unroll
                for (int i = 0; i < 8; ++i) vr[i] = vn[i];
                if (m0 + 8 < nst) {
#pragma unroll
                    for (int i = 0; i < 8; ++i) vn[i] = *(const u32x4*)(V8 + (size_t)is[64 * rs + m0 + 8 + i] * 256 + 16 * n16);
                }
                __builtin_amdgcn_sched_barrier(0);
#pragma unroll
                for (int h4 = 0; h4 < 2; ++h4) {
                    u32x2 pg[4];
#pragma unroll
                    for (int g = 0; g < 4; ++g) pg[g] = *(const LAS u32x2*)(ps + (kvh * 4 + g) * 256 + 64 * rs + m0 + 4 * h4);
#pragma unroll
                    for (int i = 0; i < 4; ++i) {
                        const u32x4 v_ = vr[4 * h4 + i];
                        const f32x4 v0 = fp8x4_f32(v_.x), v1 = fp8x4_f32(v_.y), v2 = fp8x4_f32(v_.z), v3 = fp8x4_f32(v_.w);
#pragma unroll
                        for (int g = 0; g < 4; ++g) { const unsigned pw = (i < 2) ? pg[g].x : pg[g].y; const float pf = (i & 1) ? bfhi(pw) : bflo(pw);
                            oa[g][0] += pf * v0; oa[g][1] += pf * v1; oa[g][2] += pf * v2; oa[g][3] += pf * v3; }
                    }
                }
            }
#pragma unroll
            for (int g = 0; g < 4; ++g)
#pragma unroll
                for (int q = 0; q < 4; ++q)
#pragma unroll
                    for (int e_ = 0; e_ < 4; ++e_) { float x = oa[g][q][e_]; x += __shfl_xor(x, 16); x += __shfl_xor(x, 32); oa[g][q][e_] = x; }
            if (rs == 0) {
                const f32x4 iv = *(const LAS f32x4*)(invs + 4 * kvh);
#pragma unroll
                for (int g = 0; g < 4; ++g) { bf16_t* op = O + (size_t)row * D + (kvh * 4 + g) * 64 + 16 * (n16 & 3);
                    u32x4 w0, w1; const float sc_ = iv[g];
                    w0.x = pk_bf16(oa[g][0][0] * sc_, oa[g][0][1] * sc_); w0.y = pk_bf16(oa[g][0][2] * sc_, oa[g][0][3] * sc_); w0.z = pk_bf16(oa[g][1][0] * sc_, oa[g][1][1] * sc_); w0.w = pk_bf16(oa[g][1][2] * sc_, oa[g][1][3] * sc_);
                    w1.x = pk_bf16(oa[g][2][0] * sc_, oa[g][2][1] * sc_); w1.y = pk_bf16(oa[g][2][2] * sc_, oa[g][2][3] * sc_); w1.z = pk_bf16(oa[g][3][0] * sc_, oa[g][3][1] * sc_); w1.w = pk_bf16(oa[g][3][2] * sc_, oa[g][3][3] * sc_);
                    *(u32x4*)op = w0; *(u32x4*)(op + 8) = w1; }
            }
        } else {
        f32x4 o0 = {0.f, 0.f, 0.f, 0.f}, o1 = o0, o2 = o0, o3 = o0;
        constexpr int GV = SAMPLE ? 16 : 32;
        const int ng = (n + GV - 1) / GV;
        unsigned vb[SAMPLE ? 1 : GV], vbn[SAMPLE ? 1 : GV]; f32x4 vf[SAMPLE ? GV : 1];
        const unsigned char* V8 = WSP(unsigned char, WS_V8);
        if (!SAMPLE) {
#pragma unroll
            for (int i = 0; i < GV; ++i) vbn[i] = *(const unsigned*)(V8 + (size_t)is[i] * 256 + 4 * lane);
        }
#pragma unroll 1
        for (int g = 0; g < ng; ++g) {
            if (!SAMPLE) {
#pragma unroll
                for (int i = 0; i < GV; ++i) vb[i] = vbn[i];
                if (g + 1 < ng) {
#pragma unroll
                    for (int i = 0; i < GV; ++i) vbn[i] = *(const unsigned*)(V8 + (size_t)is[GV * (g + 1) + i] * 256 + 4 * lane);
                }
                __builtin_amdgcn_sched_barrier(0);
            } else {
#pragma unroll
                for (int i = 0; i < GV; ++i) { const int r = is[GV * g + i]; vf[i] = *(const f32x4*)(((r & 0x40000000) ? vnew + (size_t)(r & 0xffff) * 256 : vc + (size_t)r * 256) + 4 * lane); }
            }
#pragma unroll
            for (int i4 = 0; i4 < GV / 4; ++i4) {
                const u32x2 p0 = *(const LAS u32x2*)(ps + (c4 * 4 + 0) * 256 + GV * g + 4 * i4), p1 = *(const LAS u32x2*)(ps + (c4 * 4 + 1) * 256 + GV * g + 4 * i4),
                            p2 = *(const LAS u32x2*)(ps + (c4 * 4 + 2) * 256 + GV * g + 4 * i4), p3 = *(const LAS u32x2*)(ps + (c4 * 4 + 3) * 256 + GV * g + 4 * i4);
                f32x4 v0, v1, v2, v3;
                if (!SAMPLE) { v0 = fp8x4_f32(vb[4 * i4]); v1 = fp8x4_f32(vb[4 * i4 + 1]); v2 = fp8x4_f32(vb[4 * i4 + 2]); v3 = fp8x4_f32(vb[4 * i4 + 3]); }
                else { v0 = vf[4 * i4]; v1 = vf[4 * i4 + 1]; v2 = vf[4 * i4 + 2]; v3 = vf[4 * i4 + 3]; }
                o0 += bflo(p0.x) * v0 + bfhi(p0.x) * v1 + bflo(p0.y) * v2 + bfhi(p0.y) * v3;
                o1 += bflo(p1.x) * v0 + bfhi(p1.x) * v1 + bflo(p1.y) * v2 + bfhi(p1.y) * v3;
                o2 += bflo(p2.x) * v0 + bfhi(p2.x) * v1 + bflo(p2.y) * v2 + bfhi(p2.y) * v3;
                o3 += bflo(p3.x) * v0 + bfhi(p3.x) * v1 + bflo(p3.y) * v2 + bfhi(p3.y) * v3;
            }
        }
        { const f32x4 iv = *(const LAS f32x4*)(invs + 4 * c4); bf16_t* op = O + (size_t)row * D + c4 * 256 + 4 * n16; st_bf4(op, o0 * iv[0]); st_bf4(op + 64, o1 * iv[1]); st_bf4(op + 128, o2 * iv[2]); st_bf4(op + 192, o3 * iv[3]); }
        }
    }
}

__global__ void __launch_bounds__(512, 2) mega(P p_unused) {
    extern __shared__ __attribute__((aligned(16))) unsigned char lds_raw[];
    LAS unsigned char* lds = (LAS unsigned char*)lds_raw;
    volatile LAS unsigned* misc = (volatile LAS unsigned*)(lds + LDS_MISC);
    if (TID() < 4) misc[TID()] = 0u;
    __syncthreads();
    KP p = kargs();
    const bool multi = (p->ph_hi - p->ph_lo) > 1;
    XcdBarrier bar; bar.bar = WSP(unsigned, WS_BAR); bar.x = 0; bar.st = misc;
    if (multi) bar = xcd_barrier_post(WSP(unsigned, WS_BAR), misc);
    int ph = 0;
    const int lo = p->ph_lo, hi = p->ph_hi;
#ifndef REPMASK
#define REPMASK 0ull
#endif
#define PH_BEGIN if (ph >= lo && ph < hi) { KP p = kargs(); const int nrep_ = ((REPMASK >> ph) & 1ull) ? 3 : 1; for (int rep_ = 0; rep_ < nrep_; ++rep_) {
#define PH_END   if (ph + 1 < hi || rep_ + 1 < nrep_) xcd_barrier(bar); } } ++ph;

    PH_BEGIN phase_ada(p, lds); phase_weights(p, lds); PH_END

    for (int layer = 0; layer < 4; ++layer) {
        const int j = layer >> 1;
        if ((layer & 1) == 0) {
            PH_BEGIN phase_prep<true>(p, layer, 0, j, layer == 0); PH_END
            PH_BEGIN {
                FRwkvIn f{WSP(bf16_t, WS_RB), WSP(bf16_t, WS_KB), WSP(bf16_t, WS_VB), WSP(bf16_t, WS_TW), WSP(bf16_t, WS_TA), WSP(bf16_t, WS_TV), WSP(bf16_t, WS_TG)};
                pg8::Gemm g{WSP(bf16_t, WS_XR), WSP(bf16_t, WS_WRW_T) + (size_t)j * 4096 * D, NP, j == 0 ? 3840 : 4096, D, j == 0 ? 2 : 1, XR_STRIDE};
                pg8::StaticOrder S; S.init(NP, g.N, (int)gridDim.x, BID());
                pg8::EpiAdapt<FRwkvIn, true> E{f};
                pg8::gemm_phase(lds, g, S, E);
                wgemm_ks<true>(lds, WSP(bf16_t, WS_XR), D, XR_STRIDE, NP, NS, WSP(bf16_t, WS_WRW_T) + (size_t)j * 4096 * D, D, 4096, f);
            } PH_END
            PH_BEGIN {
                FStoreF32 fw{WSP(float, WS_WP), D, D}, fa{WSP(float, WS_AP), D, D}, fv{WSP(float, WS_VP), D, D}, fg{WSP(float, WS_GG), D, D};
                wgemm_w(WSP(bf16_t, WS_TW), 64, NP, NS, WSP(bf16_t, WS_W2T) + (size_t)j * D * 64, 64, D, fw);
                wgemm_w(WSP(bf16_t, WS_TA), 64, NP, NS, WSP(bf16_t, WS_A2T) + (size_t)j * D * 64, 64, D, fa);
                if (j == 1) wgemm_w(WSP(bf16_t, WS_TV), 32, NP, NS, WSP(bf16_t, WS_V2T), 32, D, fv);
                wgemm_w(WSP(bf16_t, WS_TG), 160, NP, NS, WSP(bf16_t, WS_G2T) + (size_t)j * D * 160, 160, D, fg);
                phase_chunk(p, j, lds);
            } PH_END
            PH_BEGIN phase_carry(p, j, lds); PH_END
            PH_BEGIN phase_post2(p, j, lds); PH_END
        } else {
            PH_BEGIN phase_prep<false>(p, layer, 0, j); PH_END
            PH_BEGIN {
                FStoreBf16 f{WSP(bf16_t, WS_PR), PINP, PINP};
                pg8::Gemm g{WSP(bf16_t, WS_XR), WSP(bf16_t, WS_WIN_T) + (size_t)j * PINP * D, NP, PINP, D, 0, 0};
                pg8::StaticOrder S; S.init(NP, PINP, (int)gridDim.x, BID());
                pg8::EpiAdapt<FStoreBf16, true> E{f};
                pg8::gemm_phase(lds, g, S, E);
                FStoreBf16 fs{WSP(bf16_t, WS_PR), PINP, PIN};
                wgemm_ks<false>(lds, WSP(bf16_t, WS_XR), D, 0, NP, NS, WSP(bf16_t, WS_WIN_T) + (size_t)j * PINP * D, D, PINP, fs);
            } PH_END
            PH_BEGIN phase_dsapost(p, j); PH_END
            PH_BEGIN phase_idx2<false>(p, j); phase_idx2<true>(p, j); PH_END
            PH_BEGIN phase_topk_prompt(p); phase_topk_sample(p, lds); PH_END
            PH_BEGIN phase_attn<true>(p, j, lds); phase_attn<false>(p, j, lds); PH_END
        }
        PH_BEGIN {
            FResid f{p->out, WSP(float, WS_MODS) + (size_t)layer * 36 * 6144 + 2 * D, layer == 0 ? p->x_prompt : nullptr, layer == 0 ? p->x_sample : nullptr};
            const bf16_t* Wt = ((layer & 1) == 0 ? WSP(bf16_t, WS_WO_T) : WSP(bf16_t, WS_WAO_T)) + (size_t)j * D * D;
            pg8::Gemm g{WSP(bf16_t, WS_YG), Wt, NP, D, D, 0, 0};
            pg8::StaticOrder S; S.init(NP, D, (int)gridDim.x, BID());
            pg8::EpiAdapt<FResid, false> E{f};
            pg8::gemm_phase(lds, g, S, E);
            wgemm_ks<false>(lds, WSP(bf16_t, WS_YG), D, 0, NP, NS, Wt, D, D, f);
        } PH_END
        PH_BEGIN phase_prep<false>(p, layer, 1, j); PH_END
        PH_BEGIN {
            FRelu2 f{WSP(bf16_t, WS_U)};
            pg8::Gemm g{WSP(bf16_t, WS_XR), WSP(bf16_t, WS_WUP_T) + (size_t)layer * DFF * D, NP, DFF, D, 0, 0};
            pg8::StaticOrder S; S.init(NP, DFF, (int)gridDim.x, BID());
            pg8::EpiAdapt<FRelu2, true> E{f};
            pg8::gemm_phase(lds, g, S, E);
            wgemm_ks<false>(lds, WSP(bf16_t, WS_XR), D, 0, NP, NS, WSP(bf16_t, WS_WUP_T) + (size_t)layer * DFF * D, D, DFF, f);
        } PH_END
        PH_BEGIN {
            FResid f{p->out, WSP(float, WS_MODS) + (size_t)layer * 36 * 6144 + 5 * D, nullptr, nullptr};
            pg8::Gemm g{WSP(bf16_t, WS_U), WSP(bf16_t, WS_WDN_T) + (size_t)layer * DFF * D, NP, D, DFF, 0, 0};
            pg8::StaticOrder S; S.init(NP, D, (int)gridDim.x, BID());
            pg8::EpiAdapt<FResid, false> E{f};
            pg8::gemm_phase(lds, g, S, E);
            wgemm_ks<false>(lds, WSP(bf16_t, WS_U), DFF, 0, NP, NS, WSP(bf16_t, WS_WDN_T) + (size_t)layer * DFF * D, DFF, D, f);
        } PH_END
    }
#undef PH_BEGIN
#undef PH_END
}

static int count_phases() { int n = 1; for (int layer = 0; layer < 4; ++layer) { n += ((layer & 1) == 0) ? 5 : 6; n += 4; } return n; }

extern "C" void kernel_launch(void* const* d_in, const int* in_sizes, int n_in, void* d_out, int out_size, void* d_ws, size_t ws_size, hipStream_t stream) {
    static int grid = 0;
    if (grid == 0) {
        if (n_in != 39 || out_size != (int)O_END || ws_size < WS_END) { fprintf(stderr, "kernel_launch: unexpected shapes n_in %d out %d ws %zu (need %zu)\n", n_in, out_size, ws_size, (size_t)WS_END); grid = -1; return; }
        int dev = 0, cus = 0, per_cu = 0;
        if (hipGetDevice(&dev) != hipSuccess || hipDeviceGetAttribute(&cus, hipDeviceAttributeMultiprocessorCount, dev) != hipSuccess) { grid = -1; return; }
        if (hipFuncSetAttribute((const void*)mega, hipFuncAttributeMaxDynamicSharedMemorySize, LDS_BYTES) != hipSuccess) { fprintf(stderr, "kernel_launch: hipFuncSetAttribute failed\n"); grid = -1; return; }
        if (hipOccupancyMaxActiveBlocksPerMultiprocessor(&per_cu, (const void*)mega, 512, LDS_BYTES) != hipSuccess || per_cu < 1) fprintf(stderr, "kernel_launch: occupancy query says %d\n", per_cu);
        (void)hipGetLastError();
        grid = cus;
    }
    if (grid < 0) return;
    (void)hipMemsetAsync((char*)d_ws + WS_BAR, 0, 65536, stream);
    P p{};
    memcpy((void*)&p, (const void*)d_in, 39 * sizeof(void*));
    p.out = (float*)d_out; p.ws = (unsigned char*)d_ws;
#ifndef STOP_PH
#define STOP_PH 1000
#endif
    const int nph = count_phases() < STOP_PH ? count_phases() : STOP_PH;
#ifndef ONE_LAUNCH
    for (int ph = 0; ph < nph; ++ph) { p.ph_lo = ph; p.ph_hi = ph + 1; hipLaunchKernelGGL(mega, dim3(grid), dim3(512), LDS_BYTES, stream, p); }
#else
    p.ph_lo = 0; p.ph_hi = nph; hipLaunchKernelGGL(mega, dim3(grid), dim3(512), LDS_BYTES, stream, p);
#endif
}
```

```cpp
#define ONE_LAUNCH 1
#include <hip/hip_runtime.h>
#include <cstdio>
#include <cstdint>
#include <cstring>

#define LAS __attribute__((address_space(3)))
typedef unsigned short bf16_t;
typedef short bf16x8 __attribute__((ext_vector_type(8)));
typedef float f32x4 __attribute__((ext_vector_type(4)));
typedef float f32x2 __attribute__((ext_vector_type(2)));
typedef unsigned u32x4 __attribute__((ext_vector_type(4)));
typedef unsigned u32x2 __attribute__((ext_vector_type(2)));

constexpr int D = 1024, NP = 16384, NS = 256, NT = NP + NS, SEQL = 4096, PAST = 8192, NSEQ = 36, DFF = 4096;
constexpr int PIN = 2120, PINP = 2304;
constexpr int TOPK = 256, SCS_LD = 8320;
constexpr size_t O_YP = 0, O_YS = 16777216, O_KP = 17039360, O_VP = 25427968, O_IKP = 33816576, O_WKVP = 35913728, O_SHP = 36438016,
                 O_KS = 36446208, O_VS = 36577280, O_IKS = 36708352, O_WKVS = 36741120, O_SHS = 40935424, O_END = 41000960;
constexpr size_t al256(size_t x) { return (x + 255) & ~(size_t)255; }
constexpr size_t WS_BAR = 0;
constexpr size_t WS_MODS = 65536;
constexpr size_t WS_WUP_T = al256(WS_MODS + (size_t)4 * NSEQ * 6144 * 4);
constexpr size_t WS_WDN_T = WS_WUP_T + (size_t)4 * DFF * D * 2;
constexpr size_t WS_WRW_T = WS_WDN_T + (size_t)4 * DFF * D * 2;
constexpr size_t WS_WO_T = WS_WRW_T + (size_t)2 * 4096 * D * 2;
constexpr size_t WS_WIN_T = WS_WO_T + (size_t)2 * D * D * 2;
constexpr size_t WS_WAO_T = WS_WIN_T + (size_t)2 * PINP * D * 2;
constexpr size_t WS_W2T = WS_WAO_T + (size_t)2 * D * D * 2;
constexpr size_t WS_A2T = WS_W2T + (size_t)2 * D * 64 * 2;
constexpr size_t WS_V2T = WS_A2T + (size_t)2 * D * 64 * 2;
constexpr size_t WS_G2T = WS_V2T + (size_t)D * 32 * 2;
constexpr size_t WS_XR = WS_G2T + (size_t)2 * D * 160 * 2;
constexpr size_t XR_STRIDE = (size_t)NT * D;
constexpr size_t WS_RB = WS_XR + 6 * XR_STRIDE * 2;
constexpr size_t WS_KB = WS_RB + XR_STRIDE * 2;
constexpr size_t WS_VB = WS_KB + XR_STRIDE * 2;
constexpr size_t WS_TW = WS_VB + XR_STRIDE * 2;
constexpr size_t WS_TA = WS_TW + (size_t)NT * 64 * 2;
constexpr size_t WS_TV = WS_TA + (size_t)NT * 64 * 2;
constexpr size_t WS_TG = WS_TV + (size_t)NT * 32 * 2;
constexpr size_t WS_WP = al256(WS_TG + (size_t)NT * 160 * 2);
constexpr size_t F32A = (size_t)NT * D * 4;
constexpr size_t WS_AP = WS_WP + F32A, WS_VP = WS_AP + F32A, WS_GG = WS_VP + F32A, WS_VFIRST = WS_GG + F32A;
constexpr size_t WS_DEC = WS_VFIRST + F32A, WS_KM = WS_DEC + F32A, WS_VM = WS_KM + F32A, WS_AV = WS_VM + F32A, WS_BV = WS_AV + F32A, WS_Y = WS_BV + F32A;
constexpr size_t WS_YG = WS_Y + F32A;
constexpr size_t WS_U = WS_YG + XR_STRIDE * 2;
constexpr size_t WS_PR = WS_U + (size_t)NT * DFF * 2;
constexpr size_t WS_Q = WS_PR + (size_t)NT * PINP * 4;
constexpr size_t WS_QI = WS_Q + F32A;
constexpr size_t WS_WI = WS_QI + (size_t)NT * 512 * 4;
constexpr size_t WS_SC = al256(WS_WI + (size_t)NT * 8 * 4);
constexpr size_t WS_SCS = WS_SC + (size_t)4 * 4096 * 4096 * 4;
constexpr size_t WS_SEL = al256(WS_SCS + (size_t)NS * SCS_LD * 4);
constexpr size_t WS_CNT = WS_SEL + (size_t)NT * 256 * 4;
constexpr size_t WS_KBF = al256(WS_CNT + (size_t)NT * 4);
constexpr size_t WS_VBF = WS_KBF + (size_t)NT * 256 * 2;
constexpr size_t WS_QIB = WS_VBF + (size_t)NT * 256 * 2;
constexpr size_t WS_KIB = WS_QIB + (size_t)NT * 512 * 2;
constexpr size_t WS_K8 = al256(WS_KIB + (size_t)NT * 64 * 2);
constexpr size_t WS_V8 = WS_K8 + (size_t)NT * 256;
constexpr size_t WS_END = al256(WS_V8 + (size_t)NT * 256);

constexpr int LCH = 64, NCH = SEQL / LCH;
constexpr size_t WS_PCH = WS_SC, WS_CCH = WS_PCH + (size_t)64 * NCH * 4096 * 4, WS_SST = WS_CCH + (size_t)64 * NCH * 4096 * 4;
static_assert(WS_SST + (size_t)64 * NCH * 4096 * 4 <= WS_SCS, "scan buffers must fit the aliased region");
constexpr int LDS_BYTES = 147456;
constexpr int LDS_MISC = 131072;

typedef __bf16 bf16x2_t __attribute__((ext_vector_type(2)));
__device__ __forceinline__ unsigned pk_bf16(float lo, float hi) { const f32x2 v = {lo, hi}; const bf16x2_t b = __builtin_convertvector(v, bf16x2_t); return __builtin_bit_cast(unsigned, b); }
__device__ __forceinline__ unsigned pk_fp8x4(f32x4 v) { int w = 0; w = __builtin_amdgcn_cvt_pk_fp8_f32(v[0], v[1], w, false); w = __builtin_amdgcn_cvt_pk_fp8_f32(v[2], v[3], w, true); return (unsigned)w; }
__device__ __forceinline__ f32x4 fp8x4_f32(unsigned w) { return (f32x4){__builtin_amdgcn_cvt_f32_fp8((int)w, 0), __builtin_amdgcn_cvt_f32_fp8((int)w, 1), __builtin_amdgcn_cvt_f32_fp8((int)w, 2), __builtin_amdgcn_cvt_f32_fp8((int)w, 3)}; }
__device__ __forceinline__ float bf2f(unsigned short x) { return __uint_as_float((unsigned)x << 16); }
__device__ __forceinline__ float bflo(unsigned x) { return __uint_as_float(x << 16); }
__device__ __forceinline__ float bfhi(unsigned x) { return __uint_as_float(x & 0xffff0000u); }
__device__ __forceinline__ f32x4 ld_bf4(const bf16_t* p) { const u32x2 v = *(const u32x2*)p; return (f32x4){bflo(v.x), bfhi(v.x), bflo(v.y), bfhi(v.y)}; }
__device__ __forceinline__ void st_bf4(bf16_t* p, f32x4 v) { u32x2 w; w.x = pk_bf16(v[0], v[1]); w.y = pk_bf16(v[2], v[3]); *(u32x2*)p = w; }
template <int CTRL> __device__ __forceinline__ float dppf(float v) { return __int_as_float(__builtin_amdgcn_update_dpp(0, __float_as_int(v), CTRL, 0xf, 0xf, false)); }
template <int CTRL> __device__ __forceinline__ int dppi(int v) { return __builtin_amdgcn_update_dpp(0, v, CTRL, 0xf, 0xf, false); }
__device__ __forceinline__ float g16_sum(float v) { v += dppf<0xB1>(v); v += dppf<0x4E>(v); v += dppf<0x141>(v); v += dppf<0x140>(v); return v; }
__device__ __forceinline__ float g16_max(float v) { v = fmaxf(v, dppf<0xB1>(v)); v = fmaxf(v, dppf<0x4E>(v)); v = fmaxf(v, dppf<0x141>(v)); v = fmaxf(v, dppf<0x140>(v)); return v; }
__device__ __forceinline__ int g16_sum_i(int v) { v += dppi<0xB1>(v); v += dppi<0x4E>(v); v += dppi<0x141>(v); v += dppi<0x140>(v); return v; }
__device__ __forceinline__ int g16_min_i(int v) { v = min(v, dppi<0xB1>(v)); v = min(v, dppi<0x4E>(v)); v = min(v, dppi<0x141>(v)); v = min(v, dppi<0x140>(v)); return v; }
__device__ __forceinline__ float rlf(float v, int k) { return __int_as_float(__builtin_amdgcn_readlane(__float_as_int(v), k)); }
__device__ __forceinline__ float wave_sum(float v) { v = g16_sum(v); return (rlf(v, 0) + rlf(v, 16)) + (rlf(v, 32) + rlf(v, 48)); }
__device__ __forceinline__ float wave_max(float v) { v = g16_max(v); return fmaxf(fmaxf(rlf(v, 0), rlf(v, 16)), fmaxf(rlf(v, 32), rlf(v, 48))); }
__device__ __forceinline__ int wave_sum_i(int v) { v = g16_sum_i(v); return (__builtin_amdgcn_readlane(v, 0) + __builtin_amdgcn_readlane(v, 16)) + (__builtin_amdgcn_readlane(v, 32) + __builtin_amdgcn_readlane(v, 48)); }
__device__ __forceinline__ int wave_min_i(int v) { v = g16_min_i(v); return min(min(__builtin_amdgcn_readlane(v, 0), __builtin_amdgcn_readlane(v, 16)), min(__builtin_amdgcn_readlane(v, 32), __builtin_amdgcn_readlane(v, 48))); }
__device__ __forceinline__ float sigmoidf_(float x) { return 1.0f / (1.0f + expf(-x)); }
__device__ __forceinline__ float fsig(float x) { return __builtin_amdgcn_rcpf(1.0f + __expf(-x)); }
__device__ __forceinline__ float ftanh(float x) { return 2.0f * fsig(2.0f * x) - 1.0f; }
__device__ __forceinline__ int row_seq(int row) { return row < NP ? (row >> 12) : 4 + ((row - NP) >> 3); }
__device__ __forceinline__ int row_pos(int row) { return row < NP ? (row & 4095) : PAST + ((row - NP) & 7); }
__device__ __forceinline__ int TID() { int t = threadIdx.x; asm volatile("" : "+v"(t)); return t; }
__device__ __forceinline__ int BID() { int b = blockIdx.x; asm volatile("" : "+s"(b)); return b; }
__device__ __forceinline__ void wave_lds_fence() { __builtin_amdgcn_fence(__ATOMIC_RELEASE, "wavefront"); __builtin_amdgcn_wave_barrier(); __builtin_amdgcn_fence(__ATOMIC_ACQUIRE, "wavefront"); }

#define XB_TMO      128
#define XB_XCNT(j)  (256  + 64 * (j))
#define XB_XSUB(j)  (1280 + 64 * (j))
#define XB_XGEN(j)  (2304 + 64 * (j))
#define XB_TOP      3328
#define XB_TOPGEN   3392
#define XCD_BAR_WORDS 3456
#define XB_SPIN_CAP (1u << 22)
__device__ __forceinline__ unsigned xb_ld(unsigned* p)              { return __hip_atomic_load(p, __ATOMIC_RELAXED, __HIP_MEMORY_SCOPE_AGENT); }
__device__ __forceinline__ unsigned xb_add(unsigned* p, unsigned v) { return __hip_atomic_fetch_add(p, v, __ATOMIC_RELAXED, __HIP_MEMORY_SCOPE_AGENT); }
__device__ __forceinline__ unsigned xb_xcc_id() { return (unsigned)__builtin_amdgcn_s_getreg((3 << 11) | 20) & 0xFu; }
#define XB_SPIN(cond, bar) do { unsigned _sp = 0; while (cond) { __builtin_amdgcn_s_sleep(1); \
    if ((++_sp & 255u) == 0u) { if (xb_ld(&(bar)[XB_TMO])) break; if (_sp > XB_SPIN_CAP) { atomicAdd(&(bar)[XB_TMO], 1u); break; } } } } while (0)
struct XcdBarrier { unsigned* bar; unsigned x; volatile LAS unsigned* st; };
__device__ __forceinline__ XcdBarrier xcd_barrier_post(unsigned* bar, volatile LAS unsigned* st) {
    XcdBarrier b; b.bar = bar; b.x = xb_xcc_id(); b.st = st;
    if (threadIdx.x == 0) (void)xb_add(&bar[XB_XCNT(b.x)], 1u);
    return b;
}
__device__ __forceinline__ void xcd_barrier_complete(unsigned* bar, unsigned x, unsigned& nloc, unsigned& nx) {
    const unsigned G = gridDim.x * gridDim.y * gridDim.z;
    unsigned sum, cnt, mine, sp = 0u;
    for (;;) {
        sum = 0u; cnt = 0u; mine = 0u;
#pragma unroll
        for (unsigned j = 0; j < 16; ++j) { const unsigned c = xb_ld(&bar[XB_XCNT(j)]); sum += c; cnt += (c > 0u) ? 1u : 0u; mine = (j == x) ? c : mine; }
        if (sum == G) break;
        __builtin_amdgcn_s_sleep(1);
        if ((++sp & 255u) == 0u) { if (xb_ld(&bar[XB_TMO])) break; if (sp > XB_SPIN_CAP) { atomicAdd(&bar[XB_TMO], 1u); break; } }
    }
    nloc = mine > 0u ? mine : 1u; nx = cnt > 0u ? cnt : 1u;
}
__device__ __forceinline__ void xcd_barrier(const XcdBarrier& b) {
    asm volatile("s_waitcnt vmcnt(0)" ::: "memory");
    __syncthreads();
    if (threadIdx.x == 0) {
        unsigned* bar = b.bar;
        __builtin_amdgcn_s_waitcnt(0);
        unsigned nloc = b.st[0], nx = b.st[1];
        if (nloc == 0u) { xcd_barrier_complete(bar, b.x, nloc, nx); b.st[0] = nloc; b.st[1] = nx; }
        const unsigned old = xb_add(&bar[XB_XSUB(b.x)], 1u);
        const unsigned gen = old / nloc;
        if (old + 1u == (gen + 1u) * nloc) {
            __builtin_amdgcn_fence(__ATOMIC_RELEASE, "agent");
            asm volatile("s_waitcnt vmcnt(0)" ::: "memory");
            const unsigned og = xb_add(&bar[XB_TOP], 1u);
            const unsigned tg = og / nx;
            if (og + 1u == (tg + 1u) * nx) xb_add(&bar[XB_TOPGEN], 1u);
            else XB_SPIN(xb_ld(&bar[XB_TOPGEN]) == tg, bar);
            __builtin_amdgcn_fence(__ATOMIC_ACQUIRE, "agent");
            xb_add(&bar[XB_XGEN(b.x)], 1u);
            asm volatile("s_waitcnt vmcnt(0)" ::: "memory");
        } else {
            XB_SPIN(xb_ld(&bar[XB_XGEN(b.x)]) == gen, bar);
            __builtin_amdgcn_fence(__ATOMIC_ACQUIRE, "agent");
            asm volatile("s_waitcnt vmcnt(0)" ::: "memory");
        }
    }
    __syncthreads();
}

struct P {
    const float *x_prompt, *x_sample, *cache_k, *cache_v, *cache_ik, *state_wkv, *state_shift; const int* page_table;
    const float *c_prompt, *c_sample, *norm_g, *w_ada, *b_ada, *w_up, *w_down, *rw_mix, *rw_w_rkv, *rw_w_o, *rw_w0, *rw_w1, *rw_w2, *rw_a0, *rw_a1, *rw_a2,
                *rw_v0, *rw_v1, *rw_v2, *rw_g1, *rw_g2, *rw_k_k, *rw_k_a, *rw_r_k, *rw_lnx_w, *rw_lnx_b, *att_w_in, *att_w_o, *att_q_norm, *att_k_norm, *idx_k_norm;
    float* out; unsigned char* ws; int ph_lo, ph_hi;
};
typedef const P __attribute__((address_space(4)))* KP;
#define WSP(T, off) ((T*)(p->ws + (off)))
__device__ __forceinline__ KP kargs() { KP k = (KP)__builtin_amdgcn_kernarg_segment_ptr(); asm volatile("" : "+s"(k)); return k; }

namespace pg8 {
constexpr int BM = 256, BK = 64, HALF = 128, HTB = HALF * BK * 2, STAGE_BYTES = 8 * HTB, NXCD = 8, WGM = 8;
__device__ __forceinline__ int lds_byte(int r, int c) { const int st = (r >> 4) * 2 + (c >> 5), rr = r & 15, cc = c & 31, ob = rr * 64 + cc * 2; return st * 1024 + (ob ^ (((ob >> 9) & 1) << 5)); }
__device__ __forceinline__ void stage_rc(int b, int& R, int& C) { const int st = b / 1024, sb = b % 1024, swz = sb ^ (((sb >> 9) & 1) << 5); R = (st >> 1) * 16 + swz / 64; C = (st & 1) * 32 + (swz % 64) / 2; }
__device__ __forceinline__ int perm32(int rho) { const int n = rho >> 4, i = rho & 15; return 8 * (i >> 2) + 4 * n + (i & 3); }
struct Unit { int pm, pn; };
struct Gemm { const bf16_t* A; const bf16_t* Bt; int M, N, K, mode; size_t agrp; };
__device__ __forceinline__ int phys_pn(const Gemm& g, int pn) { return (g.mode == 2 && pn >= 12) ? pn + 1 : pn; }
__device__ __forceinline__ const char* a_ptr(const Gemm& g, const Unit& u, size_t tstep) {
    int grp = 0; if (g.mode) grp = u.pn < 12 ? (u.pn >> 2) : (u.pn == 12 ? 2 : u.pn - 10);
    return (const char*)g.A + (size_t)grp * g.agrp * 2 + (size_t)u.pm * tstep; }
struct StaticOrder {
    int nM, nN, nwg, G, c;
    __device__ void init(int M, int N, int G_, int c_) { nM = M / BM; nN = N / BM; nwg = nM * nN; G = G_; c = c_; }
    __device__ bool next(int i, Unit& u) const {
        const long L = (long)i * G + c; if (L >= nwg) return false;
        int wgid = (int)L; { const int q = nwg / NXCD, r = nwg % NXCD, xcd = wgid % NXCD, off = wgid / NXCD; wgid = (xcd < r ? xcd * (q + 1) : r * (q + 1) + (xcd - r) * q) + off; }
        const int nig = WGM * nN, gid = wgid / nig, fm = gid * WGM, gsz = (nM - fm) < WGM ? (nM - fm) : WGM;
        u.pm = fm + ((wgid % nig) % gsz); u.pn = (wgid % nig) / gsz; return true;
    }
};
template <class F, bool PERM_> struct EpiAdapt {
    static constexpr bool PERM = PERM_;
    F f;
    __device__ __forceinline__ void operator()(const f32x4 (&acc)[2][2][4][2], const Unit& u, int wr, int wc, int fr, int fq) const {
        const int row0 = u.pm * BM + wr * 64 + fr, col0 = u.pn * BM + wc * 32 + (PERM ? 8 * fq : 4 * fq);
#pragma unroll
        for (int ai = 0; ai < 2; ++ai)
#pragma unroll
            for (int m = 0; m < 4; ++m)
#pragma unroll
                for (int bj = 0; bj < 2; ++bj) {
                    if constexpr (PERM) f.vec8(row0 + ai * HALF + m * 16, col0 + bj * HALF, acc[ai][bj][m][0], acc[ai][bj][m][1]);
                    else {
#pragma unroll
                        for (int n = 0; n < 2; ++n) f.vec4(row0 + ai * HALF + m * 16, col0 + bj * HALF + 16 * n, acc[ai][bj][m][n]);
                    }
                }
    }
};

template <class Epi>
__device__ __forceinline__ void gemm_phase(LAS unsigned char* lds, const Gemm g, const StaticOrder& S, const Epi& E) {
    const int tid = TID(), wid = __builtin_amdgcn_readfirstlane(tid >> 6), lane = tid & 63, wr = wid >> 2, wc = wid & 3, fr = lane & 15, fq = lane >> 4;
    const int K = g.K, nt = K / BK;
    unsigned voffA[2], voffB[2];
#pragma unroll
    for (int i = 0; i < 2; ++i) { int R, C; stage_rc(tid * 16 + i * 8192, R, C); const int Rb = Epi::PERM ? ((R & ~31) + perm32(R & 31)) : R;
        voffA[i] = (unsigned)(R * K + C) * 2u; voffB[i] = (unsigned)(Rb * K + C) * 2u; }
    const size_t kstep = (size_t)(BK * 2);
    const size_t hstep = (size_t)HALF * K * 2;
    const size_t tstep = 2 * hstep;
    const unsigned ldsw = (unsigned)wid * 1024u;
    const int aoff = lds_byte(wr * 64 + fr, fq * 8), boff = lds_byte(wc * 32 + fr, fq * 8);
#define PG8_SA(b, h) (((b) * 2 + (h)) * HTB)
#define PG8_SB(b, h) ((4 + (b) * 2 + (h)) * HTB)
#define PG8_STAGE(bufoff, gbase, voff) do { _Pragma("unroll") for (int _i = 0; _i < 2; ++_i) \
        __builtin_amdgcn_global_load_lds((const unsigned*)((const char*)(gbase) + (voff)[_i]), (LAS unsigned*)(lds + (bufoff) + ldsw + _i * 8192), 16, 0, 0); } while (0)
#define PG8_LDA(dst, b, h) do { _Pragma("unroll") for (int m = 0; m < 4; ++m) _Pragma("unroll") for (int k = 0; k < 2; ++k) dst[m][k] = *(const LAS bf16x8*)(lds + PG8_SA(b, h) + aoff + m * 2048 + k * 1024); } while (0)
#define PG8_LDB(dst, b, h) do { _Pragma("unroll") for (int n = 0; n < 2; ++n) _Pragma("unroll") for (int k = 0; k < 2; ++k) dst[n][k] = *(const LAS bf16x8*)(lds + PG8_SB(b, h) + boff + n * 2048 + k * 1024); } while (0)
#define PG8_MMA(ai, bj, At, Bt) do { __builtin_amdgcn_s_setprio(1); _Pragma("unroll") for (int m = 0; m < 4; ++m) _Pragma("unroll") for (int n = 0; n < 2; ++n) _Pragma("unroll") for (int k = 0; k < 2; ++k) \
        acc[ai][bj][m][n] = __builtin_amdgcn_mfma_f32_16x16x32_bf16(Bt[n][k], At[m][k], acc[ai][bj][m][n], 0, 0, 0); __builtin_amdgcn_s_setprio(0); } while (0)
#define PG8_WAIT_V(n) asm volatile("s_waitcnt vmcnt(" #n ")" ::: "memory")
#define PG8_WAIT_L(n) asm volatile("s_waitcnt lgkmcnt(" #n ")" ::: "memory")
#define PG8_BAR __builtin_amdgcn_s_barrier()
#define PG8_SCHED __builtin_amdgcn_sched_barrier(0)
    Unit cur, nxt; int ui = 0;
    if (!S.next(0, cur)) return;
    cur.pn = phys_pn(g, cur.pn);
    f32x4 acc[2][2][4][2];
#pragma unroll
    for (int a = 0; a < 2; ++a)
#pragma unroll
        for (int b = 0; b < 2; ++b)
#pragma unroll
            for (int m = 0; m < 4; ++m)
#pragma unroll
                for (int n = 0; n < 2; ++n) acc[a][b][m][n] = (f32x4){0.f, 0.f, 0.f, 0.f};
    bf16x8 At[4][2], B0[2][2], B1[2][2];
    const char* cA = a_ptr(g, cur, tstep); const char* cB = (const char*)g.Bt + (size_t)cur.pn * tstep;
    PG8_STAGE(PG8_SB(0, 0), cB, voffB); PG8_STAGE(PG8_SA(0, 0), cA, voffA); PG8_STAGE(PG8_SB(0, 1), cB + hstep, voffB); PG8_STAGE(PG8_SA(0, 1), cA + hstep, voffA);
    if (wr == 1) PG8_BAR;
    PG8_WAIT_V(4); PG8_BAR;
    PG8_STAGE(PG8_SB(1, 0), cB + kstep, voffB); PG8_STAGE(PG8_SA(1, 0), cA + kstep, voffA); PG8_STAGE(PG8_SB(1, 1), cB + hstep + kstep, voffB);
    PG8_WAIT_V(6); PG8_BAR;
    for (;;) {
        const bool has_next = S.next(ui + 1, nxt);
        if (has_next) nxt.pn = phys_pn(g, nxt.pn);
        const char* nA = has_next ? a_ptr(g, nxt, tstep) : cA; const char* nB = has_next ? (const char*)g.Bt + (size_t)nxt.pn * tstep : cB;
        for (int t = 0; t < nt; t += 2) {
            const bool last = (t == nt - 2);
            const char* a1 = cA + (size_t)(t + 1) * kstep;
            const char* a2 = last ? nA : cA + (size_t)(t + 2) * kstep; const char* b2 = last ? nB : cB + (size_t)(t + 2) * kstep;
            const char* a3 = a2 + kstep; const char* b3 = b2 + kstep;
            PG8_LDB(B0, 0, 0); PG8_SCHED; PG8_LDA(At, 0, 0); PG8_STAGE(PG8_SA(1, 1), a1 + hstep, voffA);
            PG8_WAIT_L(8); PG8_BAR; PG8_WAIT_L(0); PG8_MMA(0, 0, At, B0); PG8_BAR; PG8_SCHED;
            PG8_LDB(B1, 0, 1); PG8_STAGE(PG8_SB(0, 0), b2, voffB);
            PG8_BAR; PG8_WAIT_L(0); PG8_MMA(0, 1, At, B1); PG8_BAR;
            PG8_LDA(At, 0, 1); PG8_STAGE(PG8_SA(0, 0), a2, voffA);
            PG8_BAR; PG8_WAIT_L(0); PG8_MMA(1, 0, At, B0); PG8_BAR; PG8_SCHED;
            PG8_STAGE(PG8_SB(0, 1), b2 + hstep, voffB);
            PG8_WAIT_V(6); PG8_BAR; PG8_MMA(1, 1, At, B1); PG8_BAR;
            PG8_LDB(B0, 1, 0); PG8_SCHED; PG8_LDA(At, 1, 0); PG8_STAGE(PG8_SA(0, 1), a2 + hstep, voffA);
            PG8_WAIT_L(8); PG8_BAR; PG8_WAIT_L(0); PG8_MMA(0, 0, At, B0); PG8_BAR; PG8_SCHED;
            PG8_LDB(B1, 1, 1); PG8_STAGE(PG8_SB(1, 0), b3, voffB);
            PG8_BAR; PG8_WAIT_L(0); PG8_MMA(0, 1, At, B1); PG8_BAR;
            PG8_LDA(At, 1, 1); PG8_STAGE(PG8_SA(1, 0), a3, voffA);
            PG8_BAR; PG8_WAIT_L(0); PG8_MMA(1, 0, At, B0); PG8_BAR; PG8_SCHED;
            PG8_STAGE(PG8_SB(1, 1), b3 + hstep, voffB);
            PG8_WAIT_V(6); PG8_BAR; PG8_MMA(1, 1, At, B1); PG8_BAR;
        }
        E(acc, cur, wr, wc, fr, fq);
        if (!has_next) break;
#pragma unroll
        for (int a = 0; a < 2; ++a)
#pragma unroll
            for (int b = 0; b < 2; ++b)
#pragma unroll
                for (int m = 0; m < 4; ++m)
#pragma unroll
                    for (int n = 0; n < 2; ++n) acc[a][b][m][n] = (f32x4){0.f, 0.f, 0.f, 0.f};
        cur = nxt; cA = nA; cB = nB; ++ui;
    }
    PG8_WAIT_V(0);
    if (wr == 0) PG8_BAR;
    PG8_BAR;
#undef PG8_SA
#undef PG8_SB
#undef PG8_STAGE
#undef PG8_LDA
#undef PG8_LDB
#undef PG8_MMA
#undef PG8_WAIT_V
#undef PG8_WAIT_L
#undef PG8_BAR
#undef PG8_SCHED
}
}

template <class F>
__device__ __forceinline__ void sgemm_bf(LAS unsigned char* lds, const bf16_t* A, int lda, int row0, int M, const float* W, int ldw, int N, int K, int coloff, const F& f) {
    LAS float* As = (LAS float*)lds;
    LAS float* Ws = (LAS float*)(lds + 32 * 68 * 4);
    const int tid = TID(), ty = tid >> 4, tx = tid & 15;
    const int ntn = (N + 63) / 64, ntiles = (M / 64) * ntn;
    for (int tile = BID(); tile < ntiles; tile += gridDim.x) {
        const int tm = tile / ntn, tn = tile % ntn, r0 = row0 + tm * 64, n0 = tn * 64;
        f32x4 c0 = {0.f, 0.f, 0.f, 0.f}, c1 = {0.f, 0.f, 0.f, 0.f};
        for (int k0 = 0; k0 < K; k0 += 32) {
            __syncthreads();
            { const int r = tid >> 3, q = tid & 7; const f32x4 a = ld_bf4(A + (size_t)(r0 + r) * lda + k0 + 4 * q);
              As[(4 * q + 0) * 68 + r] = a[0]; As[(4 * q + 1) * 68 + r] = a[1]; As[(4 * q + 2) * 68 + r] = a[2]; As[(4 * q + 3) * 68 + r] = a[3]; }
            { const int kr = tid >> 4, c = tid & 15; f32x4 w = {0.f, 0.f, 0.f, 0.f}; if (n0 + 4 * c < N) w = *(const f32x4*)(W + (size_t)(k0 + kr) * ldw + n0 + 4 * c);
              *(LAS f32x4*)(Ws + kr * 68 + 4 * c) = w; }
            __syncthreads();
#pragma unroll 8
            for (int kk = 0; kk < 32; ++kk) {
                const f32x2 a = *(const LAS f32x2*)(As + kk * 68 + 2 * ty); const f32x4 b = *(const LAS f32x4*)(Ws + kk * 68 + 4 * tx);
                c0 += a.x * b; c1 += a.y * b;
            }
        }
        if (n0 + 4 * tx < N) { f.vec4(r0 + 2 * ty, n0 + 4 * tx + coloff, c0); f.vec4(r0 + 2 * ty + 1, n0 + 4 * tx + coloff, c1); }
    }
    __syncthreads();
}

typedef float f32x16 __attribute__((ext_vector_type(16)));
__device__ __forceinline__ int rw_group(int n0) { const int t = n0 >> 8; return t < 12 ? (t >> 2) : (t == 12 ? 2 : t - 10); }
template <bool RWGRP, class F>
__device__ __forceinline__ void wgemm_ks(LAS unsigned char* lds, const bf16_t* A, int lda, size_t agrp, int row0, int M, const bf16_t* Bt, int K, int N, const F& f) {
    const int tid = TID(), wave = tid >> 6, lane = tid & 63, lr = lane & 31, lh = lane >> 5;
    LAS float* red = (LAS float*)lds;
    const int ntn = N / 64, nitems = (M / 32) * ntn, kw = K / 8, steps = kw / 16;
    for (int item = BID(); item < nitems; item += gridDim.x) {
        const int tm = item / ntn, tn = item % ntn, r0 = row0 + tm * 32, n0 = tn * 64;
        const bf16_t* Ab = A + (RWGRP ? (size_t)rw_group(n0) * agrp : 0) + (size_t)(r0 + lr) * lda + wave * kw + lh * 8;
        const bf16_t* B0 = Bt + (size_t)(n0 + lr) * K + wave * kw + lh * 8; const bf16_t* B1 = B0 + (size_t)32 * K;
        f32x16 acc0, acc1;
#pragma unroll
        for (int r = 0; r < 16; ++r) { acc0[r] = 0.f; acc1[r] = 0.f; }
#pragma unroll 8
        for (int st = 0; st < steps; ++st) {
            const bf16x8 a = *(const bf16x8*)(Ab + 16 * st), b0 = *(const bf16x8*)(B0 + 16 * st), b1 = *(const bf16x8*)(B1 + 16 * st);
            acc0 = __builtin_amdgcn_mfma_f32_32x32x16_bf16(b0, a, acc0, 0, 0, 0);
            acc1 = __builtin_amdgcn_mfma_f32_32x32x16_bf16(b1, a, acc1, 0, 0, 0);
        }
        __syncthreads();
#pragma unroll
        for (int r = 0; r < 16; ++r) { red[((wave * 2 + 0) * 16 + r) * 64 + lane] = acc0[r]; red[((wave * 2 + 1) * 16 + r) * 64 + lane] = acc1[r]; }
        __syncthreads();
        { const int t = tid >> 8, r4 = (tid >> 6) & 3, l2 = tid & 63; f32x4 v = {0.f, 0.f, 0.f, 0.f};
#pragma unroll
          for (int w = 0; w < 8; ++w)
#pragma unroll
              for (int e = 0; e < 4; ++e) v[e] += red[((w * 2 + t) * 16 + 4 * r4 + e) * 64 + l2];
          f.vec4(r0 + (l2 & 31), n0 + 32 * t + 8 * r4 + 4 * (l2 >> 5), v); }
    }
    __syncthreads();
}
template <class F>
__device__ __forceinline__ void wgemm_w(const bf16_t* A, int lda, int row0, int M, const bf16_t* Bt, int K, int N, const F& f) {
    const int lane = TID() & 63, lr = lane & 31, lh = lane >> 5, gw = BID() * 8 + (TID() >> 6), nw = gridDim.x * 8;
    const int ntn = N / 64, nitems = (M / 32) * ntn, steps = K / 16;
    for (int item = gw; item < nitems; item += nw) {
        const int tm = item / ntn, tn = item % ntn, r0 = row0 + tm * 32, n0 = tn * 64;
        const bf16_t* Ab = A + (size_t)(r0 + lr) * lda + lh * 8;
        const bf16_t* B0 = Bt + (size_t)(n0 + lr) * K + lh * 8; const bf16_t* B1 = B0 + (size_t)32 * K;
        f32x16 acc0, acc1;
#pragma unroll
        for (int r = 0; r < 16; ++r) { acc0[r] = 0.f; acc1[r] = 0.f; }
        for (int st = 0; st < steps; ++st) {
            const bf16x8 a = *(const bf16x8*)(Ab + 16 * st), b0 = *(const bf16x8*)(B0 + 16 * st), b1 = *(const bf16x8*)(B1 + 16 * st);
            acc0 = __builtin_amdgcn_mfma_f32_32x32x16_bf16(b0, a, acc0, 0, 0, 0);
            acc1 = __builtin_amdgcn_mfma_f32_32x32x16_bf16(b1, a, acc1, 0, 0, 0);
        }
#pragma unroll
        for (int r4 = 0; r4 < 4; ++r4) {
            f.vec4(r0 + lr, n0 + 8 * r4 + 4 * lh, (f32x4){acc0[4 * r4], acc0[4 * r4 + 1], acc0[4 * r4 + 2], acc0[4 * r4 + 3]});
            f.vec4(r0 + lr, n0 + 32 + 8 * r4 + 4 * lh, (f32x4){acc1[4 * r4], acc1[4 * r4 + 1], acc1[4 * r4 + 2], acc1[4 * r4 + 3]});
        }
    }
}

struct FRwkvIn {
    bf16_t *rb, *kb, *vb, *tw, *ta, *tv, *tg;
    __device__ __forceinline__ void vec8(int row, int col, f32x4 a, f32x4 b) const {
        if (col < 3072) { u32x4 w; w.x = pk_bf16(a[0], a[1]); w.y = pk_bf16(a[2], a[3]); w.z = pk_bf16(b[0], b[1]); w.w = pk_bf16(b[2], b[3]);
            *(u32x4*)(rb + (size_t)(col >> 10) * XR_STRIDE + (size_t)row * D + (col & 1023)) = w; }
        else { vec4(row, col, a); vec4(row, col + 4, b); } }
    __device__ __forceinline__ void vec4(int row, int col, f32x4 v) const {
        if (col < 3072) { st_bf4(rb + (size_t)(col >> 10) * XR_STRIDE + (size_t)row * D + (col & 1023), v); }
        else if (col < 3328) { const int c = col - 3072; if (c < 32) st_bf4(tv + (size_t)row * 32 + c, v); }
        else if (col < 3584) { const int c = col - 3328; if (c < 64) { f32x4 t = {ftanh(v[0]), ftanh(v[1]), ftanh(v[2]), ftanh(v[3])}; st_bf4(tw + (size_t)row * 64 + c, t); } }
        else if (col < 3840) { const int c = col - 3584; if (c < 64) st_bf4(ta + (size_t)row * 64 + c, v); }
        else { const int c = col - 3840; if (c < 160) { f32x4 t = {fsig(v[0]), fsig(v[1]), fsig(v[2]), fsig(v[3])}; st_bf4(tg + (size_t)row * 160 + c, t); } }
    }
};
struct FStoreF32 { float* C; int ldc; int ncols; __device__ __forceinline__ void vec4(int row, int col, f32x4 v) const { if (col < ncols) *(f32x4*)(C + (size_t)row * ldc + col) = v; } };
struct FStoreBf16 { bf16_t* C; int ldc; int ncols;
    __device__ __forceinline__ void vec4(int row, int col, f32x4 v) const { if (col < ncols) st_bf4(C + (size_t)row * ldc + col, v); }
    __device__ __forceinline__ void vec8(int row, int col, f32x4 a, f32x4 b) const { if (col < ncols) { u32x4 w; w.x = pk_bf16(a[0], a[1]); w.y = pk_bf16(a[2], a[3]); w.z = pk_bf16(b[0], b[1]); w.w = pk_bf16(b[2], b[3]); *(u32x4*)(C + (size_t)row * ldc + col) = w; } } };
struct FResid {
    float* X; const float* gate;
    const float* xin_p; const float* xin_s;
    __device__ __forceinline__ void vec4(int row, int col, f32x4 v) const {
        const f32x4 g = *(const f32x4*)(gate + (size_t)row_seq(row) * 6144 + col); float* xp = X + (size_t)row * D + col;
        const float* ip = xin_p ? (row < NP ? xin_p + (size_t)row * D + col : xin_s + (size_t)(row - NP) * D + col) : xp;
        const f32x4 x = *(const f32x4*)ip; *(f32x4*)xp = x + g * v; }
};
struct FRelu2 { bf16_t* U;
    __device__ __forceinline__ void vec8(int row, int col, f32x4 a, f32x4 b) const {
        f32x4 s, t; for (int e = 0; e < 4; ++e) { const float x = fmaxf(a[e], 0.f), y = fmaxf(b[e], 0.f); s[e] = x * x; t[e] = y * y; }
        u32x4 w; w.x = pk_bf16(s[0], s[1]); w.y = pk_bf16(s[2], s[3]); w.z = pk_bf16(t[0], t[1]); w.w = pk_bf16(t[2], t[3]); *(u32x4*)(U + (size_t)row * DFF + col) = w; }
    __device__ __forceinline__ void vec4(int row, int col, f32x4 v) const {
        f32x4 t; for (int e = 0; e < 4; ++e) { const float r = fmaxf(v[e], 0.f); t[e] = r * r; } st_bf4(U + (size_t)row * DFF + col, t); } };

__device__ __forceinline__ void phase_copy_x(KP p) {
    const size_t n4p = (size_t)NP * D / 4, n4 = (size_t)NT * D / 4;
    for (size_t i = (size_t)BID() * 512 + TID(); i < n4; i += (size_t)gridDim.x * 512)
        ((f32x4*)p->out)[i] = i < n4p ? ((const f32x4*)p->x_prompt)[i] : ((const f32x4*)p->x_sample)[i - n4p];
}

struct TJob { const float* src; bf16_t* dst; int K, N, drow0; };
__device__ __forceinline__ TJob tjob(KP p, int i) {
    TJob t; t.drow0 = 0;
    if (i < 4) { t.src = p->w_up + (size_t)i * D * DFF; t.dst = WSP(bf16_t, WS_WUP_T) + (size_t)i * DFF * D; t.K = D; t.N = DFF; return t; }
    if (i < 8) { const int l = i - 4; t.src = p->w_down + (size_t)l * DFF * D; t.dst = WSP(bf16_t, WS_WDN_T) + (size_t)l * DFF * D; t.K = DFF; t.N = D; return t; }
    i -= 8; const int j = i / 14, k = i % 14; bf16_t* wrw = WSP(bf16_t, WS_WRW_T) + (size_t)j * 4096 * D;
    t.K = D; t.N = D;
    switch (k) {
        case 0: case 1: case 2: t.src = p->rw_w_rkv + ((size_t)j * 3 + k) * D * D; t.dst = wrw; t.drow0 = k * 1024; break;
        case 3: t.src = p->rw_v1; t.dst = wrw; t.drow0 = 3072; t.N = j == 1 ? 32 : 0; break;
        case 4: t.src = p->rw_w1 + (size_t)j * D * 64; t.dst = wrw; t.drow0 = 3328; t.N = 64; break;
        case 5: t.src = p->rw_a1 + (size_t)j * D * 64; t.dst = wrw; t.drow0 = 3584; t.N = 64; break;
        case 6: t.src = p->rw_g1 + (size_t)j * D * 160; t.dst = wrw; t.drow0 = 3840; t.N = 160; break;
        case 7: t.src = p->rw_w_o + (size_t)j * D * D; t.dst = WSP(bf16_t, WS_WO_T) + (size_t)j * D * D; break;
        case 8: t.src = p->rw_w2 + (size_t)j * 64 * D; t.dst = WSP(bf16_t, WS_W2T) + (size_t)j * D * 64; t.K = 64; break;
        case 9: t.src = p->rw_a2 + (size_t)j * 64 * D; t.dst = WSP(bf16_t, WS_A2T) + (size_t)j * D * 64; t.K = 64; break;
        case 10: t.src = p->rw_g2 + (size_t)j * 160 * D; t.dst = WSP(bf16_t, WS_G2T) + (size_t)j * D * 160; t.K = 160; break;
        case 11: t.src = p->rw_v2; t.dst = WSP(bf16_t, WS_V2T); t.K = 32; t.N = j == 1 ? D : 0; break;
        case 12: t.src = p->att_w_in + (size_t)j * D * PIN; t.dst = WSP(bf16_t, WS_WIN_T) + (size_t)j * PINP * D; t.N = PIN; break;
        default: t.src = p->att_w_o + (size_t)j * D * D; t.dst = WSP(bf16_t, WS_WAO_T) + (size_t)j * D * D; break;
    }
    return t;
}
__device__ __forceinline__ int tjob_tiles(const TJob& t) { return ((t.K + 63) / 64) * ((t.N + 63) / 64); }
__device__ __forceinline__ void phase_weights(KP p, LAS unsigned char* lds) {
    LAS float* T = (LAS float*)lds;
    const int tid = TID();
    int total = 0;
    for (int i = 0; i < 36; ++i) total += tjob_tiles(tjob(p, i));
    const int ngrp = (total + 3) / 4;
    for (int g = BID(); g < ngrp; g += gridDim.x) {
        __syncthreads();
        TJob tj[4]; int k0[4], n0[4];
        { int i = 0, start = 0, cnt = tjob_tiles(tjob(p, 0));
#pragma unroll
          for (int u = 0; u < 4; ++u) { const int gt = 4 * g + u;
              while (i < 35 && gt >= start + cnt) { start += cnt; ++i; cnt = tjob_tiles(tjob(p, i)); }
              tj[u] = tjob(p, i); const int lt = gt - start, nkt = (tj[u].K + 63) / 64;
              if (gt >= total || lt >= cnt) { tj[u] = tjob(p, 0); k0[u] = 1 << 20; n0[u] = 1 << 20; } else { k0[u] = (lt % nkt) * 64; n0[u] = (lt / nkt) * 64; } }
        }
        f32x4 v[4][2];
        const int kk = tid >> 4, n4 = (tid & 15) * 4;
#pragma unroll
        for (int u = 0; u < 4; ++u)
#pragma unroll
            for (int hh = 0; hh < 2; ++hh) { const int k = k0[u] + kk + 32 * hh, n = n0[u] + n4; const bool ok = k < tj[u].K && n < tj[u].N;
                const f32x4 t_ = *(const f32x4*)(tj[u].src + (size_t)min(k, tj[u].K - 1) * tj[u].N + min(n, tj[u].N - 4));
                v[u][hh] = ok ? t_ : (f32x4){0.f, 0.f, 0.f, 0.f}; }
#pragma unroll
        for (int u = 0; u < 4; ++u)
#pragma unroll
            for (int hh = 0; hh < 2; ++hh)
#pragma unroll
                for (int e = 0; e < 4; ++e) T[(u * 64 + kk + 32 * hh) * 65 + n4 + e] = v[u][hh][e];
        __syncthreads();
        const int nn = tid >> 3, k8 = (tid & 7) * 8;
#pragma unroll
        for (int u = 0; u < 4; ++u) {
            if (n0[u] + nn < tj[u].N && k0[u] + k8 < tj[u].K) {
                u32x4 w;
                w.x = pk_bf16(T[(u * 64 + k8 + 0) * 65 + nn], T[(u * 64 + k8 + 1) * 65 + nn]); w.y = pk_bf16(T[(u * 64 + k8 + 2) * 65 + nn], T[(u * 64 + k8 + 3) * 65 + nn]);
                w.z = pk_bf16(T[(u * 64 + k8 + 4) * 65 + nn], T[(u * 64 + k8 + 5) * 65 + nn]); w.w = pk_bf16(T[(u * 64 + k8 + 6) * 65 + nn], T[(u * 64 + k8 + 7) * 65 + nn]);
                *(u32x4*)(tj[u].dst + (size_t)(tj[u].drow0 + n0[u] + nn) * tj[u].K + k0[u] + k8) = w;
            }
        }
    }
    __syncthreads();
}

__device__ __forceinline__ void phase_ada(KP p, LAS unsigned char* lds) {
    float* mods = WSP(float, WS_MODS);
    LAS float* sil = (LAS float*)lds;
    LAS float* red = (LAS float*)(lds + 36864);
    const int tid = TID(), c = tid & 127, ds = tid >> 7;
    for (int item = BID(); item < 192; item += gridDim.x) {
        const int l = item / 48, col = (item % 48) * 128 + c;
        float acc[36];
#pragma unroll
        for (int s = 0; s < 36; ++s) acc[s] = 0.f;
        for (int cc = 0; cc < 4; ++cc) {
            __syncthreads();
            for (int e = tid; e < 4 * 64 * 36; e += 512) { const int s = e % 36, dd = (e / 36) % 64, sl = e / (36 * 64), d = 256 * sl + 64 * cc + dd;
                const float cv = s < 4 ? p->c_prompt[s * D + d] : p->c_sample[(s - 4) * D + d]; sil[e] = cv / (1.0f + expf(-cv)); }
            __syncthreads();
            const float* wp = p->w_ada + ((size_t)l * D + 256 * ds + 64 * cc) * 6144 + col;
            for (int dd = 0; dd < 64; ++dd) {
                const float w = wp[(size_t)dd * 6144];
                const LAS float* sp = sil + (ds * 64 + dd) * 36;
#pragma unroll
                for (int s = 0; s < 36; ++s) acc[s] += sp[s] * w;
            }
        }
        __syncthreads();
#pragma unroll
        for (int s = 0; s < 36; ++s) red[(ds * 128 + c) * 36 + s] = acc[s];
        __syncthreads();
        for (int k = 0; k < 9; ++k) { const int s = 9 * ds + k;
            const float v = red[(0 * 128 + c) * 36 + s] + red[(1 * 128 + c) * 36 + s] + red[(2 * 128 + c) * 36 + s] + red[(3 * 128 + c) * 36 + s];
            mods[((size_t)l * 36 + s) * 6144 + col] = v + p->b_ada[l * 6144 + col]; }
    }
    __syncthreads();
}

template <bool MIX>
__device__ __forceinline__ void phase_prep(KP p, int layer, int which, int j, bool first = false) {
    const float* X = p->out;
    const float* mods = WSP(float, WS_MODS) + (size_t)layer * 36 * 6144;
    const float* g = p->norm_g + (layer * 2 + which) * D;
    bf16_t* XR = WSP(bf16_t, WS_XR);
    const int lane = TID() & 63, gw = BID() * 8 + (TID() >> 6), nw = gridDim.x * 8;
    for (int run = gw; run < NT / 8; run += nw) {
        const int row0 = run * 8, seq = row_seq(row0);
        const float* sh = mods + (size_t)seq * 6144 + (which ? 3 : 0) * D; const float* sc = sh + D;
        f32x4 gv[4], scv[4], shv[4], hp[4];
#pragma unroll
        for (int i = 0; i < 4; ++i) { const int col = 512 * (i >> 1) + 8 * lane + 4 * (i & 1); gv[i] = *(const f32x4*)(g + col); scv[i] = *(const f32x4*)(sc + col) + 1.0f; shv[i] = *(const f32x4*)(sh + col); hp[i] = (f32x4){0.f, 0.f, 0.f, 0.f}; }
        int rstart = 0;
        if (MIX) {
            if (row0 >= NP) {
#pragma unroll
                for (int i = 0; i < 4; ++i) hp[i] = *(const f32x4*)(p->state_shift + ((size_t)j * 32 + (seq - 4)) * D + 512 * (i >> 1) + 8 * lane + 4 * (i & 1));
            } else if ((row0 & 4095) != 0) rstart = -1;
        }
        for (int r = rstart; r < 8; ++r) {
            const int row = row0 + r;
            f32x4 x[4]; float ss = 0.f;
            const float* xr = first ? (row < NP ? p->x_prompt + (size_t)row * D : p->x_sample + (size_t)(row - NP) * D) : X + (size_t)row * D;
#pragma unroll
            for (int i = 0; i < 4; ++i) { x[i] = *(const f32x4*)(xr + 512 * (i >> 1) + 8 * lane + 4 * (i & 1)); ss += x[i][0] * x[i][0] + x[i][1] * x[i][1] + x[i][2] * x[i][2] + x[i][3] * x[i][3]; }
            ss = wave_sum(ss);
            const float rstd = rsqrtf(ss * (1.0f / 1024.0f) + 1e-6f);
            f32x4 h[4];
#pragma unroll
            for (int i = 0; i < 4; ++i) h[i] = x[i] * rstd * gv[i] * scv[i] + shv[i];
            if (MIX) {
                if (r >= 0) {
#pragma unroll
                    for (int n = 0; n < 6; ++n) {
                        const int mi = n == 0 ? 0 : (n == 1 ? 2 : (n == 2 ? 3 : (n == 3 ? 1 : n)));
                        const float* mx = p->rw_mix + ((size_t)j * 6 + mi) * D;
#pragma unroll
                        for (int i2 = 0; i2 < 2; ++i2) { const int col = 512 * i2 + 8 * lane; const f32x4 m0 = *(const f32x4*)(mx + col), m1 = *(const f32x4*)(mx + col + 4);
                            const f32x4 a = h[2 * i2] + (hp[2 * i2] - h[2 * i2]) * m0, b2 = h[2 * i2 + 1] + (hp[2 * i2 + 1] - h[2 * i2 + 1]) * m1;
                            u32x4 w; w.x = pk_bf16(a[0], a[1]); w.y = pk_bf16(a[2], a[3]); w.z = pk_bf16(b2[0], b2[1]); w.w = pk_bf16(b2[2], b2[3]);
                            *(u32x4*)(XR + (size_t)n * XR_STRIDE + (size_t)row * D + col) = w; }
                    }
                    const bool lastp = row < NP && (row & 4095) == 4095, lasts = row >= NP && ((row - NP) & 7) == 7;
                    if (lastp || lasts) {
                        float* so = lastp ? p->out + O_SHP + ((size_t)j * 4 + seq) * D : p->out + O_SHS + ((size_t)j * 32 + (seq - 4)) * D;
#pragma unroll
                        for (int i = 0; i < 4; ++i) *(f32x4*)(so + 512 * (i >> 1) + 8 * lane + 4 * (i & 1)) = h[i];
                    }
                }
#pragma unroll
                for (int i = 0; i < 4; ++i) hp[i] = h[i];
            } else {
#pragma unroll
                for (int i2 = 0; i2 < 2; ++i2) { const f32x4 a = h[2 * i2], b2 = h[2 * i2 + 1]; u32x4 w; w.x = pk_bf16(a[0], a[1]); w.y = pk_bf16(a[2], a[3]); w.z = pk_bf16(b2[0], b2[1]); w.w = pk_bf16(b2[2], b2[3]);
                    *(u32x4*)(XR + (size_t)row * D + 512 * i2 + 8 * lane) = w; }
            }
        }
    }
}

__device__ __forceinline__ void phase_scanprep(KP p, int j) {
    const bf16_t *KB = WSP(bf16_t, WS_KB), *VB = WSP(bf16_t, WS_VB);
    const float *WPp = WSP(float, WS_WP), *APp = WSP(float, WS_AP), *VPp = WSP(float, WS_VP);
    float *VF = WSP(float, WS_VFIRST), *DEC = WSP(float, WS_DEC), *KM = WSP(float, WS_KM), *VM = WSP(float, WS_VM), *AV = WSP(float, WS_AV), *BV = WSP(float, WS_BV);
    const int lane = TID() & 63, gw = BID() * 8 + (TID() >> 6), nw = gridDim.x * 8;
    for (int row = gw; row < NT; row += nw) {
#pragma unroll
        for (int i = 0; i < 4; ++i) {
            const int col = 256 * i + 4 * lane; const size_t o = (size_t)row * D + col;
            const f32x4 k = ld_bf4(KB + o), v = ld_bf4(VB + o), wp = *(const f32x4*)(WPp + o), ap = *(const f32x4*)(APp + o);
            const f32x4 w0 = *(const f32x4*)(p->rw_w0 + j * D + col), a0 = *(const f32x4*)(p->rw_a0 + j * D + col), kkw = *(const f32x4*)(p->rw_k_k + j * D + col), kaw = *(const f32x4*)(p->rw_k_a + j * D + col);
            f32x4 dec, a, vm, kk, km;
#pragma unroll
            for (int e = 0; e < 4; ++e) {
                const float wpre = w0[e] + wp[e], z = -wpre, sp = fmaxf(z, 0.f) + log1pf(expf(-fabsf(z)));
                dec[e] = expf(-expf(-sp - 0.5f));
                a[e] = sigmoidf_(a0[e] + ap[e]);
                kk[e] = k[e] * kkw[e];
                km[e] = k[e] * (1.0f + (a[e] - 1.0f) * kaw[e]);
            }
            if (j == 0) { vm = v; *(f32x4*)(VF + o) = v; }
            else { const f32x4 vf = *(const f32x4*)(VF + o), vp = *(const f32x4*)(VPp + o), v0 = *(const f32x4*)(p->rw_v0 + (j - 1) * D + col);
#pragma unroll
                for (int e = 0; e < 4; ++e) vm[e] = v[e] + (vf[e] - v[e]) * sigmoidf_(v0[e] + vp[e]); }
            float ss = kk[0] * kk[0] + kk[1] * kk[1] + kk[2] * kk[2] + kk[3] * kk[3];
            ss = g16_sum(ss);
            const float inv = rsqrtf(fmaxf(ss, 1e-24f));
            kk = kk * inv;
            *(f32x4*)(DEC + o) = dec; *(f32x4*)(KM + o) = km; *(f32x4*)(VM + o) = vm; *(f32x4*)(AV + o) = -kk; *(f32x4*)(BV + o) = kk * a;
        }
    }
}

__device__ __forceinline__ float rl(float v, int k) { return __int_as_float(__builtin_amdgcn_readlane(__float_as_int(v), k)); }
__device__ __forceinline__ void scan_run(KP p, size_t row_base, int nsteps, int colbase, float (&S)[64]) {
    const float *DEC = WSP(float, WS_DEC), *KM = WSP(float, WS_KM), *VM = WSP(float, WS_VM), *AV = WSP(float, WS_AV), *BV = WSP(float, WS_BV);
    const bf16_t* RB = WSP(bf16_t, WS_RB); float* Y = WSP(float, WS_Y);
    const int lane = TID() & 63;
    size_t o = row_base * D + colbase + lane;
    float w = DEC[o], kx = KM[o], v = VM[o], a = AV[o], b = BV[o], r = bf2f(RB[o]);
    for (int t = 0; t < nsteps; ++t) {
        const size_t on = (t + 1 < nsteps) ? o + D : o;
        const float wn = DEC[on], kn = KM[on], vn = VM[on], an = AV[on], bn = BV[on], rn = bf2f(RB[on]);
        float sa = 0.f;
#pragma unroll
        for (int k = 0; k < 64; ++k) sa += S[k] * rl(a, k);
#pragma unroll
        for (int k = 0; k < 64; ++k) S[k] = S[k] * rl(w, k) + sa * rl(b, k) + v * rl(kx, k);
        float y = 0.f;
#pragma unroll
        for (int k = 0; k < 64; ++k) y += S[k] * rl(r, k);
        Y[o] = y;
        o = on; w = wn; kx = kn; v = vn; a = an; b = bn; r = rn;
    }
}
__device__ __forceinline__ void phase_scanA(KP p) {
    const float *DEC = WSP(float, WS_DEC), *KM = WSP(float, WS_KM), *VM = WSP(float, WS_VM), *AV = WSP(float, WS_AV), *BV = WSP(float, WS_BV);
    float *PCH = WSP(float, WS_PCH), *CCH = WSP(float, WS_CCH);
    const int lane = TID() & 63, gw = BID() * 8 + (TID() >> 6), nw = gridDim.x * 8;
    for (int it = gw; it < 64 * NCH; it += nw) {
        const int sh = it / NCH, c = it % NCH, b = sh >> 4, h = sh & 15;
        float SP[64], SC[64];
#pragma unroll
        for (int k = 0; k < 64; ++k) { SP[k] = (k == lane) ? 1.f : 0.f; SC[k] = 0.f; }
        size_t o = ((size_t)b * 4096 + (size_t)c * LCH) * D + h * 64 + lane;
        float w = DEC[o], kx = KM[o], v = VM[o], a = AV[o], bb = BV[o];
        for (int t = 0; t < LCH; ++t) {
            const size_t on = (t + 1 < LCH) ? o + D : o;
            const float wn = DEC[on], kn = KM[on], vn = VM[on], an = AV[on], bn = BV[on];
            float saP = 0.f, saC = 0.f;
#pragma unroll
            for (int k = 0; k < 64; ++k) { const float ak = rl(a, k); saP += SP[k] * ak; saC += SC[k] * ak; }
#pragma unroll
            for (int k = 0; k < 64; ++k) { const float wk = rl(w, k), bk = rl(bb, k); SP[k] = SP[k] * wk + saP * bk; SC[k] = SC[k] * wk + saC * bk + v * rl(kx, k); }
            o = on; w = wn; kx = kn; v = vn; a = an; bb = bn;
        }
        float* po = PCH + ((size_t)it * 64 + lane) * 64; float* co = CCH + ((size_t)it * 64 + lane) * 64;
#pragma unroll
        for (int k = 0; k < 64; k += 4) { *(f32x4*)(po + k) = (f32x4){SP[k], SP[k + 1], SP[k + 2], SP[k + 3]}; *(f32x4*)(co + k) = (f32x4){SC[k], SC[k + 1], SC[k + 2], SC[k + 3]}; }
    }
}
__device__ __forceinline__ void phase_scanB(KP p, int j, LAS unsigned char* lds) {
    const int tid = TID(), lane = tid & 63, wave = tid >> 6;
    if (BID() < 32) {
        const float *PCH = WSP(float, WS_PCH), *CCH = WSP(float, WS_CCH); float* SST = WSP(float, WS_SST);
        const int sh = BID() * 2 + (wave >> 2), q = wave & 3, row0 = 32 * (q >> 1), col0 = 32 * (q & 1), b = sh >> 4, h = sh & 15;
        LAS float* Sl = (LAS float*)lds + (wave >> 2) * (2 * 64 * 65);
        const int lr = lane & 31, lh = lane >> 5;
        f32x16 acc;
#pragma unroll
        for (int r = 0; r < 16; ++r) acc[r] = 0.f;
        for (int c = 0; c <= NCH; ++c) {
            LAS float* Sw = Sl + (c & 1) * (64 * 65);
            float* go = c < NCH ? SST + ((size_t)sh * NCH + c) * 4096 : p->out + O_WKVP + (((size_t)j * 4 + b) * 16 + h) * 4096;
#pragma unroll
            for (int r = 0; r < 16; ++r) { const int row = row0 + (r & 3) + 8 * (r >> 2) + 4 * lh; Sw[row * 65 + col0 + lr] = acc[r]; go[row * 64 + col0 + lr] = acc[r]; }
            if (c == NCH) break;
            const float* Pc = PCH + ((size_t)sh * NCH + c) * 4096; const float* Cc = CCH + ((size_t)sh * NCH + c) * 4096;
            float bv[32];
#pragma unroll
            for (int kk = 0; kk < 32; ++kk) bv[kk] = Pc[(2 * kk + lh) * 64 + col0 + lr];
#pragma unroll
            for (int r = 0; r < 16; ++r) acc[r] = Cc[(row0 + (r & 3) + 8 * (r >> 2) + 4 * lh) * 64 + col0 + lr];
            __syncthreads();
#pragma unroll
            for (int kk = 0; kk < 32; ++kk) acc = __builtin_amdgcn_mfma_f32_32x32x2f32(Sw[(row0 + lr) * 65 + 2 * kk + lh], bv[kk], acc, 0, 0, 0);
        }
    } else {
        for (int it = (BID() - 32) * 8 + wave; it < 512; it += (gridDim.x - 32) * 8) {
            const int b = it >> 4, h = it & 15;
            const float* s0 = p->state_wkv + (((size_t)j * 32 + b) * 16 + h) * 4096 + lane * 64;
            float S[64];
#pragma unroll
            for (int k = 0; k < 64; k += 4) { const f32x4 t = *(const f32x4*)(s0 + k); S[k] = t[0]; S[k + 1] = t[1]; S[k + 2] = t[2]; S[k + 3] = t[3]; }
            scan_run(p, (size_t)NP + b * 8, 8, h * 64, S);
            float* o = p->out + O_WKVS + (((size_t)j * 32 + b) * 16 + h) * 4096 + lane * 64;
#pragma unroll
            for (int k = 0; k < 64; k += 4) *(f32x4*)(o + k) = (f32x4){S[k], S[k + 1], S[k + 2], S[k + 3]};
        }
    }
    __syncthreads();
}
__device__ __forceinline__ void phase_scanC(KP p) {
    const float* SST = WSP(float, WS_SST);
    const int lane = TID() & 63, gw = BID() * 8 + (TID() >> 6), nw = gridDim.x * 8;
    for (int it = gw; it < 64 * NCH; it += nw) {
        const int sh = it / NCH, c = it % NCH, b = sh >> 4, h = sh & 15;
        const float* s0 = SST + ((size_t)it * 64 + lane) * 64;
        float S[64];
#pragma unroll
        for (int k = 0; k < 64; k += 4) { const f32x4 t = *(const f32x4*)(s0 + k); S[k] = t[0]; S[k + 1] = t[1]; S[k + 2] = t[2]; S[k + 3] = t[3]; }
        scan_run(p, (size_t)b * 4096 + (size_t)c * LCH, LCH, h * 64, S);
    }
}


constexpr int CST = 72;
constexpr int CMAT = 64 * CST * 2;
constexpr int CH_F32 = 11 * CMAT, CH_PART = CH_F32 + 64 * 68 * 4, CH_GL = CH_PART + 64 * 4 * 4;
__device__ __forceinline__ bf16x8 cfrag(const LAS bf16_t* M, int row, int ks, int c4) { return *(const LAS bf16x8*)(M + row * CST + 32 * ks + 8 * c4); }
__device__ __forceinline__ f32x4 cmm(const LAS bf16_t* A, int arow, const LAS bf16_t* B, int brow, int c4, f32x4 acc) {
    acc = __builtin_amdgcn_mfma_f32_16x16x32_bf16(cfrag(A, arow, 0, c4), cfrag(B, brow, 0, c4), acc, 0, 0, 0);
    return __builtin_amdgcn_mfma_f32_16x16x32_bf16(cfrag(A, arow, 1, c4), cfrag(B, brow, 1, c4), acc, 0, 0, 0); }
__device__ __forceinline__ unsigned short f2bf(float x) { return (unsigned short)(pk_bf16(x, 0.f) & 0xffffu); }
__device__ __forceinline__ void st_t4(LAS bf16_t* Mt, int d, int t0, f32x4 v) { u32x2 w; w.x = pk_bf16(v[0], v[1]); w.y = pk_bf16(v[2], v[3]); *(LAS u32x2*)(Mt + d * CST + t0) = w; }

__device__ __forceinline__ void phase_chunk(KP p, int j, LAS unsigned char* lds) {
    LAS bf16_t* Mx = (LAS bf16_t*)lds;
#define CM(i) (Mx + (i) * (64 * CST))
    LAS float* F32 = (LAS float*)(lds + CH_F32);
    asm volatile("" : "+v"(F32));
    LAS float* part = (LAS float*)(lds + CH_PART);
    LAS float* gLs = (LAS float*)(lds + CH_GL);
    const bf16_t *RB = WSP(bf16_t, WS_RB), *KB = WSP(bf16_t, WS_KB), *VB = WSP(bf16_t, WS_VB), *TW = WSP(bf16_t, WS_TW), *TA_ = WSP(bf16_t, WS_TA), *TV = WSP(bf16_t, WS_TV);
    const bf16_t *W2T = WSP(bf16_t, WS_W2T) + (size_t)j * D * 64, *A2T = WSP(bf16_t, WS_A2T) + (size_t)j * D * 64, *V2T = WSP(bf16_t, WS_V2T);
    float* VF = WSP(float, WS_VFIRST); float *PCH = WSP(float, WS_PCH), *CCH = WSP(float, WS_CCH), *Y0 = WSP(float, WS_Y), *BON = WSP(float, WS_AV);
    bf16_t *GM = WSP(bf16_t, WS_DEC), *VM2 = WSP(bf16_t, WS_KM);
#define CH_BAR() do { asm volatile("s_waitcnt lgkmcnt(0)" ::: "memory"); __builtin_amdgcn_s_barrier(); asm volatile("" ::: "memory"); } while (0)
    bf16x8 f_aw[2], f_aa[2], f_av; unsigned short e_k[2][4], e_v[2][4], e_r[2][4];
    f_av = (bf16x8){0, 0, 0, 0, 0, 0, 0, 0};
#define CH_PREFETCH(itx) do { const int tid_ = TID(), lane_ = tid_ & 63, w_ = tid_ >> 6, n_ = lane_ & 15, c4_ = lane_ >> 4, tr_ = w_ >> 1, tcb_ = 2 * (w_ & 1); \
        const int sh_ = (itx) / NCH, c_ = (itx) % NCH, R0_ = (sh_ >> 4) * 4096 + c_ * LCH, hc_ = (sh_ & 15) * 64; const int ar_ = 16 * tr_ + n_; \
        _Pragma("unroll") for (int ks = 0; ks < 2; ++ks) { f_aw[ks] = *(const bf16x8*)(TW + (size_t)R0_ * 64 + ar_ * 64 + 32 * ks + 8 * c4_); f_aa[ks] = *(const bf16x8*)(TA_ + (size_t)R0_ * 64 + ar_ * 64 + 32 * ks + 8 * c4_); } \
        if (j == 1) f_av = *(const bf16x8*)(TV + (size_t)R0_ * 32 + ar_ * 32 + 8 * c4_); \
        _Pragma("unroll") for (int ti = 0; ti < 2; ++ti) _Pragma("unroll") for (int r = 0; r < 4; ++r) { const size_t o_ = (size_t)R0_ * D + hc_ + (16 * tr_ + 4 * c4_ + r) * D + 16 * (tcb_ + ti) + n_; \
            e_k[ti][r] = KB[o_]; e_v[ti][r] = VB[o_]; e_r[ti][r] = RB[o_]; } } while (0)
    if (BID() < 64 * NCH) CH_PREFETCH(BID());
    for (int it = BID(); it < 64 * NCH; it += gridDim.x) {
        const int tid = TID(), lane = tid & 63, w = tid >> 6, n = lane & 15, c4 = lane >> 4, tr = w >> 1, tcb = 2 * (w & 1);
        const int sh = it / NCH, c = it % NCH, b = sh >> 4, h = sh & 15, R0 = b * 4096 + c * LCH, hc = h * 64;
        const bf16_t *KBb = KB + (size_t)R0 * D + hc, *VBb = VB + (size_t)R0 * D + hc, *RBb = RB + (size_t)R0 * D + hc;
        float* VFb = VF + (size_t)R0 * D + hc; bf16_t* VM2b = VM2 + (size_t)R0 * D + hc; bf16_t* GMb = GM + (size_t)R0 * D + hc; bf16_t* Y0b = (bf16_t*)Y0 + (size_t)R0 * D + hc;
        float* PCb = PCH + (size_t)it * 4096; float* CCb = CCH + (size_t)it * 4096; float* BONb = BON + (size_t)R0 * 16 + h;
        const bf16_t *TWb = TW + (size_t)R0 * 64, *TAb = TA_ + (size_t)R0 * 64, *TVb = TV + (size_t)R0 * 32, *W2b = W2T + (size_t)hc * 64, *A2b = A2T + (size_t)hc * 64, *V2b = V2T + (size_t)hc * 32;
        const float *w0b = p->rw_w0 + j * D + hc, *a0b = p->rw_a0 + j * D + hc, *kkb = p->rw_k_k + j * D + hc, *kab = p->rw_k_a + j * D + hc, *rkb = p->rw_r_k + j * D + hc, *v0b = p->rw_v0 + (j ? (j - 1) : 0) * D + hc;
        f32x4 wp[2], ap[2], vp[2];
#pragma unroll
        for (int ti = 0; ti < 2; ++ti) { wp[ti] = (f32x4){0.f, 0.f, 0.f, 0.f}; ap[ti] = wp[ti]; vp[ti] = wp[ti]; }
        {   const int ar = 16 * tr + n;
#pragma unroll
            for (int ks = 0; ks < 2; ++ks) {
                const bf16x8 aw = f_aw[ks], aa = f_aa[ks];
#pragma unroll
                for (int ti = 0; ti < 2; ++ti) { const int br = 16 * (tcb + ti) + n;
                    wp[ti] = __builtin_amdgcn_mfma_f32_16x16x32_bf16(aw, *(const bf16x8*)(W2b + br * 64 + 32 * ks + 8 * c4), wp[ti], 0, 0, 0);
                    ap[ti] = __builtin_amdgcn_mfma_f32_16x16x32_bf16(aa, *(const bf16x8*)(A2b + br * 64 + 32 * ks + 8 * c4), ap[ti], 0, 0, 0); }
            }
            if (j == 1) { const bf16x8 av = f_av;
#pragma unroll
                for (int ti = 0; ti < 2; ++ti) vp[ti] = __builtin_amdgcn_mfma_f32_16x16x32_bf16(av, *(const bf16x8*)(V2b + (16 * (tcb + ti) + n) * 32 + 8 * c4), vp[ti], 0, 0, 0); }
        }
        f32x4 lw[2], asg[2], kkv[2], kpr[2], vpr[2], rr[2];
        float ssq[4] = {0.f, 0.f, 0.f, 0.f}, bon[4] = {0.f, 0.f, 0.f, 0.f};
        float vf8[2][4];
#pragma unroll
        for (int ti = 0; ti < 2; ++ti)
#pragma unroll
            for (int r = 0; r < 4; ++r) vf8[ti][r] = 0.f;
        if (j == 1) {
#pragma unroll
            for (int ti = 0; ti < 2; ++ti)
#pragma unroll
                for (int r = 0; r < 4; ++r) vf8[ti][r] = VFb[(16 * tr + 4 * c4 + r) * D + 16 * (tcb + ti) + n];
        }
#pragma unroll
        for (int ti = 0; ti < 2; ++ti) {
            const int d = 16 * (tcb + ti) + n;
            const float w0 = w0b[d], a0 = a0b[d], kkw = kkb[d], kaw = kab[d], rkw = rkb[d];
            const float v0 = j ? v0b[d] : 0.f;
#pragma unroll
            for (int r = 0; r < 4; ++r) {
                const int o = (16 * tr + 4 * c4 + r) * D + d;
                const float kx = bf2f(e_k[ti][r]), vx = bf2f(e_v[ti][r]), rx = bf2f(e_r[ti][r]);
                const float z = -(w0 + wp[ti][r]), sp = fmaxf(z, 0.f) + __logf(1.0f + __expf(-fabsf(z)));
                lw[ti][r] = -__expf(-sp - 0.5f);
                const float a = fsig(a0 + ap[ti][r]);
                asg[ti][r] = a;
                float vv = vx;
                if (j == 0) VFb[o] = vx; else { const float vf = vf8[ti][r]; vv = vx + (vf - vx) * fsig(v0 + vp[ti][r]); }
                vpr[ti][r] = vv; rr[ti][r] = rx;
                const float kk = kx * kkw; kkv[ti][r] = kk; ssq[r] += kk * kk;
                const float kp = kx * (1.0f + (a - 1.0f) * kaw); kpr[ti][r] = kp; bon[r] += rx * kp * rkw;
                F32[(16 * tr + 4 * c4 + r) * 68 + d] = lw[ti][r];
                VM2b[o] = f2bf(vv);
            }
        }
#pragma unroll
        for (int r = 0; r < 4; ++r) { ssq[r] = g16_sum(ssq[r]); bon[r] = g16_sum(bon[r]); }
        if (n == 0) {
#pragma unroll
            for (int r = 0; r < 4; ++r) { const int t = 16 * tr + 4 * c4 + r; part[(t * 2 + (w & 1)) * 2 + 0] = ssq[r]; part[(t * 2 + (w & 1)) * 2 + 1] = bon[r]; }
        }
        if (it + (int)gridDim.x < 64 * NCH) CH_PREFETCH(it + (int)gridDim.x);
        CH_BAR();
        f32x4 cs[2];
#pragma unroll
        for (int ti = 0; ti < 2; ++ti) {
            f32x4 acc = {0.f, 0.f, 0.f, 0.f};
            for (int q = 0; q < 4 * (tr + 1); ++q) {
                const float av = (4 * q + c4 <= 16 * tr + n) ? 1.0f : 0.0f;
                acc = __builtin_amdgcn_mfma_f32_16x16x4f32(av, F32[(4 * q + c4) * 68 + 16 * (tcb + ti) + n], acc, 0, 0, 0);
            }
            cs[ti] = acc;
        }
        float inv[4];
#pragma unroll
        for (int r = 0; r < 4; ++r) { const int t = 16 * tr + 4 * c4 + r; inv[r] = rsqrtf(fmaxf(part[(t * 2 + 0) * 2] + part[(t * 2 + 1) * 2], 1e-24f));
            if (n == 0 && (w & 1) == 0) BONb[t * 16] = part[(t * 2 + 0) * 2 + 1] + part[(t * 2 + 1) * 2 + 1]; }
        f32x4 rt[2];
#pragma unroll
        for (int ti = 0; ti < 2; ++ti) {
            const int d = 16 * (tcb + ti) + n, t0 = 16 * tr + 4 * c4;
            f32x4 at, bt, kt;
#pragma unroll
            for (int r = 0; r < 4; ++r) {
                const float g = __expf(cs[ti][r]), gi = __expf(-cs[ti][r]), gm = __expf(cs[ti][r] - lw[ti][r]);
                const float kk = kkv[ti][r] * inv[r];
                at[r] = -kk * gm; bt[r] = kk * asg[ti][r] * gi; kt[r] = kpr[ti][r] * gi; rt[ti][r] = rr[ti][r] * g;
                CM(0)[(t0 + r) * CST + d] = f2bf(at[r]); CM(1)[(t0 + r) * CST + d] = f2bf(bt[r]); CM(2)[(t0 + r) * CST + d] = f2bf(kt[r]); CM(3)[(t0 + r) * CST + d] = f2bf(rt[ti][r]);
                if (t0 + r == 63) gLs[d] = g;
            }
            st_t4(CM(4), d, t0, at); st_t4(CM(5), d, t0, bt); st_t4(CM(6), d, t0, kt); st_t4(CM(7), d, t0, vpr[ti]);
        }
        CH_BAR();
#pragma unroll
        for (int ti = 0; ti < 2; ++ti) {
            const int tc = tcb + ti, s = 16 * tc + n, t0 = 16 * tr + 4 * c4;
            if (tc <= tr) {
                { f32x4 m = {0.f, 0.f, 0.f, 0.f}; m = cmm(CM(0), 16 * tr + n, CM(1), 16 * tc + n, c4, m);
#pragma unroll
                  for (int r = 0; r < 4; ++r) F32[(t0 + r) * 68 + s] = (s < t0 + r) ? m[r] : 0.f; }
                asm volatile("" ::: "memory");
                { f32x4 m = {0.f, 0.f, 0.f, 0.f}; m = cmm(CM(0), 16 * tr + n, CM(2), 16 * tc + n, c4, m);
#pragma unroll
                  for (int r = 0; r < 4; ++r) CM(8)[(t0 + r) * CST + s] = f2bf((s < t0 + r) ? m[r] : 0.f); }
                asm volatile("" ::: "memory");
                { f32x4 m = {0.f, 0.f, 0.f, 0.f}; m = cmm(CM(3), 16 * tr + n, CM(1), 16 * tc + n, c4, m);
#pragma unroll
                  for (int r = 0; r < 4; ++r) CM(9)[(t0 + r) * CST + s] = f2bf((s <= t0 + r) ? m[r] : 0.f); }
                asm volatile("" ::: "memory");
                { f32x4 m = {0.f, 0.f, 0.f, 0.f}; m = cmm(CM(3), 16 * tr + n, CM(2), 16 * tc + n, c4, m);
#pragma unroll
                  for (int r = 0; r < 4; ++r) CM(10)[(t0 + r) * CST + s] = f2bf((s <= t0 + r) ? m[r] : 0.f); }
                asm volatile("" ::: "memory");
            } else {
#pragma unroll
                for (int r = 0; r < 4; ++r) { F32[(t0 + r) * 68 + s] = 0.f; CM(8)[(t0 + r) * CST + s] = 0; CM(9)[(t0 + r) * CST + s] = 0; CM(10)[(t0 + r) * CST + s] = 0; }
            }
        }
        CH_BAR();
        { const int e0 = tid * 8;
#pragma unroll
          for (int e = 0; e < 8; ++e) { const int t = (e0 + e) >> 6, s_ = (e0 + e) & 63; CM(2)[t * CST + s_] = f2bf(F32[t * 68 + s_]); }
          unsigned z_ = 0u; asm volatile("" : "+v"(z_));
          *(LAS u32x4*)(CM(0) + (e0 >> 6) * CST + (e0 & 63)) = (u32x4){z_, z_, z_, z_}; }
        CH_BAR();
        if (w < 4) {
            const int cw = 16 * w;
            LAS float* scr = (LAS float*)CM(1) + w * (16 * 17);
#pragma unroll 1
            for (int I = 0; I < 4; ++I) {
                f32x4 rh = {0.f, 0.f, 0.f, 0.f};
                if (I > 0) { rh = __builtin_amdgcn_mfma_f32_16x16x32_bf16(cfrag(CM(2), 16 * I + n, 0, c4), cfrag(CM(0), cw + n, 0, c4), rh, 0, 0, 0);
                    if (I > 2) rh = __builtin_amdgcn_mfma_f32_16x16x32_bf16(cfrag(CM(2), 16 * I + n, 1, c4), cfrag(CM(0), cw + n, 1, c4), rh, 0, 0, 0); }
#pragma unroll
                for (int r = 0; r < 4; ++r) scr[(4 * c4 + r) * 17 + n] = rh[r] + ((16 * I + 4 * c4 + r) == (cw + n) ? 1.f : 0.f);
                wave_lds_fence();
                float x[16];
#pragma unroll
                for (int i = 0; i < 16; ++i) x[i] = scr[i * 17 + n];
                f32x4 mc[4], mn[4];
                mc[0] = *(const LAS f32x4*)(F32 + (16 * I + 1) * 68 + 16 * I);
#pragma unroll
                for (int i = 1; i < 16; ++i) {
                    if (i + 1 < 16) {
#pragma unroll
                        for (int j4 = 0; j4 < (i + 4) / 4; ++j4) mn[j4] = *(const LAS f32x4*)(F32 + (16 * I + i + 1) * 68 + 16 * I + 4 * j4);
                    }
                    float a0 = 0.f, a1 = 0.f;
#pragma unroll
                    for (int j4 = 0; j4 < (i + 3) / 4; ++j4) {
                        if (4 * j4 + 0 < i) a0 += mc[j4][0] * x[4 * j4 + 0];
                        if (4 * j4 + 1 < i) a1 += mc[j4][1] * x[4 * j4 + 1];
                        if (4 * j4 + 2 < i) a0 += mc[j4][2] * x[4 * j4 + 2];
                        if (4 * j4 + 3 < i) a1 += mc[j4][3] * x[4 * j4 + 3];
                    }
                    x[i] += a0 + a1;
#pragma unroll
                    for (int j4 = 0; j4 < 4; ++j4) mc[j4] = mn[j4];
                    asm volatile("" ::: "memory");
                }
                if (c4 == 0) {
#pragma unroll
                    for (int i = 0; i < 16; ++i) CM(3)[(16 * I + i) * CST + cw + n] = f2bf(x[i]);
                    u32x4 t0, t1;
                    t0.x = pk_bf16(x[0], x[1]); t0.y = pk_bf16(x[2], x[3]); t0.z = pk_bf16(x[4], x[5]); t0.w = pk_bf16(x[6], x[7]);
                    t1.x = pk_bf16(x[8], x[9]); t1.y = pk_bf16(x[10], x[11]); t1.z = pk_bf16(x[12], x[13]); t1.w = pk_bf16(x[14], x[15]);
                    *(LAS u32x4*)(CM(0) + (cw + n) * CST + 16 * I) = t0; *(LAS u32x4*)(CM(0) + (cw + n) * CST + 16 * I + 8) = t1;
                }
                wave_lds_fence();
            }
        }
        CH_BAR();
#pragma unroll
        for (int ti = 0; ti < 2; ++ti) {
            const int d = 16 * (tcb + ti) + n;
            { f32x4 x1 = {0.f, 0.f, 0.f, 0.f}; x1 = cmm(CM(8), 16 * tr + n, CM(7), 16 * (tcb + ti) + n, c4, x1); st_t4(CM(0), d, 16 * tr + 4 * c4, x1); }
            asm volatile("" ::: "memory");
            { f32x4 ta = {0.f, 0.f, 0.f, 0.f}; ta = cmm(CM(3), 16 * tr + n, CM(4), 16 * (tcb + ti) + n, c4, ta); st_t4(CM(1), d, 16 * tr + 4 * c4, ta); }
            asm volatile("" ::: "memory");
        }
        CH_BAR();
#pragma unroll
        for (int ti = 0; ti < 2; ++ti) {
            f32x4 uv = {0.f, 0.f, 0.f, 0.f};
            uv = cmm(CM(3), 16 * tr + n, CM(0), 16 * (tcb + ti) + n, c4, uv);
            st_t4(CM(2), 16 * (tcb + ti) + n, 16 * tr + 4 * c4, uv);
        }
        CH_BAR();
#pragma unroll
        for (int ti = 0; ti < 2; ++ti) {
            const int cc = 16 * (tcb + ti) + n, r0 = 16 * tr + 4 * c4;
            const float gl = gLs[cc];
            { f32x4 pm = {0.f, 0.f, 0.f, 0.f}; pm = cmm(CM(1), 16 * tr + n, CM(5), cc, c4, pm);
#pragma unroll
              for (int r = 0; r < 4; ++r) PCb[(r0 + r) * 64 + cc] = (pm[r] + ((r0 + r) == cc ? 1.f : 0.f)) * gl; }
            asm volatile("" ::: "memory");
            { f32x4 cm_ = {0.f, 0.f, 0.f, 0.f}; cm_ = cmm(CM(2), 16 * tr + n, CM(5), cc, c4, cm_); cm_ = cmm(CM(7), 16 * tr + n, CM(6), cc, c4, cm_);
#pragma unroll
              for (int r = 0; r < 4; ++r) CCb[(r0 + r) * 64 + cc] = cm_[r] * gl; }
            asm volatile("" ::: "memory");
            { f32x4 gg = {0.f, 0.f, 0.f, 0.f}; gg = cmm(CM(9), 16 * tr + n, CM(1), cc, c4, gg);
#pragma unroll
              for (int r = 0; r < 4; ++r) GMb[(r0 + r) * D + cc] = f2bf(gg[r] + rt[ti][r]); }
            asm volatile("" ::: "memory");
            { f32x4 y0 = {0.f, 0.f, 0.f, 0.f}; y0 = cmm(CM(9), 16 * tr + n, CM(2), cc, c4, y0); y0 = cmm(CM(10), 16 * tr + n, CM(7), cc, c4, y0);
#pragma unroll
              for (int r = 0; r < 4; ++r) Y0b[(r0 + r) * D + cc] = f2bf(y0[r]); }
            asm volatile("" ::: "memory");
        }
        CH_BAR();
    }
#undef CM
#undef CH_PREFETCH
#undef CH_BAR
}

__device__ __forceinline__ void phase_sample_mixer_w(KP p, int j, int first, int stride) {
    const int tid = TID(), lane = tid & 63;
    {
        const bf16_t *RB = WSP(bf16_t, WS_RB), *KB = WSP(bf16_t, WS_KB), *VB = WSP(bf16_t, WS_VB); bf16_t* YG = WSP(bf16_t, WS_YG);
        const float *WPp = WSP(float, WS_WP), *APp = WSP(float, WS_AP), *VPp = WSP(float, WS_VP), *GG = WSP(float, WS_GG); float* VF = WSP(float, WS_VFIRST);
        for (int it = first; it < 512; it += stride) {
            const int b = it >> 4, h = it & 15, col = h * 64 + lane;
            const float* s0 = p->state_wkv + (((size_t)j * 32 + b) * 16 + h) * 4096 + lane * 64;
            float S[64];
#pragma unroll
            for (int k = 0; k < 64; k += 4) { const f32x4 t = *(const f32x4*)(s0 + k); S[k] = t[0]; S[k + 1] = t[1]; S[k + 2] = t[2]; S[k + 3] = t[3]; }
            const float w0 = p->rw_w0[j * D + col], a0 = p->rw_a0[j * D + col], kkw = p->rw_k_k[j * D + col], kaw = p->rw_k_a[j * D + col], rkw = p->rw_r_k[j * D + col];
            const float v0 = j ? p->rw_v0[(j - 1) * D + col] : 0.f, lnw = p->rw_lnx_w[j * D + col], lnb = p->rw_lnx_b[j * D + col];
            for (int t = 0; t < 8; ++t) {
                const size_t o = (size_t)(NP + b * 8 + t) * D + col;
                const float kx = bf2f(KB[o]), vx = bf2f(VB[o]), r = bf2f(RB[o]);
                const float z = -(w0 + WPp[o]), sp = fmaxf(z, 0.f) + log1pf(expf(-fabsf(z)));
                const float wd = expf(-expf(-sp - 0.5f)), asg = sigmoidf_(a0 + APp[o]);
                float v = vx;
                if (j == 0) VF[o] = vx; else { const float vf = VF[o]; v = vx + (vf - vx) * sigmoidf_(v0 + VPp[o]); }
                float kk = kx * kkw; const float ss = wave_sum(kk * kk); kk *= rsqrtf(fmaxf(ss, 1e-24f));
                const float kp = kx * (1.0f + (asg - 1.0f) * kaw), a = -kk, bq = kk * asg;
                float sa = 0.f;
#pragma unroll
                for (int k = 0; k < 64; ++k) sa += S[k] * rl(a, k);
#pragma unroll
                for (int k = 0; k < 64; ++k) S[k] = S[k] * rl(wd, k) + sa * rl(bq, k) + v * rl(kp, k);
                float y = 0.f;
#pragma unroll
                for (int k = 0; k < 64; ++k) y += S[k] * rl(r, k);
                const float mu = wave_sum(y) * (1.0f / 64.0f), dy = y - mu, var = wave_sum(dy * dy) * (1.0f / 64.0f);
                const float bonus = wave_sum(r * kp * rkw);
                YG[o] = f2bf((dy * rsqrtf(var + 64e-5f) * lnw + lnb + bonus * v) * GG[o]);
            }
            float* so = p->out + O_WKVS + (((size_t)j * 32 + b) * 16 + h) * 4096 + lane * 64;
#pragma unroll
            for (int k = 0; k < 64; k += 4) *(f32x4*)(so + k) = (f32x4){S[k], S[k + 1], S[k + 2], S[k + 3]};
        }
    }
}
__device__ __forceinline__ void phase_carry(KP p, int j, LAS unsigned char* lds) {
    const float *PCH = WSP(float, WS_PCH), *CCH = WSP(float, WS_CCH); float* SST = WSP(float, WS_SST);
    LAS float* Sl = (LAS float*)lds;
    LAS unsigned* cflag = (LAS unsigned*)(lds + 9216);
    if (TID() == 0) *cflag = 0u;
    __syncthreads();
    unsigned arrivals = 0u;
    if ((TID() >> 6) >= 4) { phase_sample_mixer_w(p, j, BID() * 4 + ((TID() >> 6) - 4), (int)gridDim.x * 4); }
    else
    for (int it = BID(); it < 256; it += gridDim.x) {
        const int wave = TID() >> 6, sh = it >> 2, row0 = 16 * (it & 3), col0 = 16 * (wave & 3), b = sh >> 4, h = sh & 15;
        const bool act = true;
        f32x4 acc = {0.f, 0.f, 0.f, 0.f}, c0, c1, c2;
        float b0[16], b1[16], b2[16];
#define CARRY_LOAD(BX, CX, cc_) do { const int l_ = TID() & 63, ln = l_ & 15, lq = l_ >> 4; \
            const float* Pc = PCH + ((size_t)sh * NCH + (cc_)) * 4096; const float* Cc = CCH + ((size_t)sh * NCH + (cc_)) * 4096; \
            _Pragma("unroll") for (int q = 0; q < 16; ++q) BX[q] = Pc[(4 * q + lq) * 64 + col0 + ln]; \
            _Pragma("unroll") for (int r = 0; r < 4; ++r) CX[r] = Cc[(row0 + 4 * lq + r) * 64 + col0 + ln]; } while (0)
#define CARRY_STEP(BX, CX, BL, CL, c_) do { const int l_ = TID() & 63, ln = l_ & 15, lq = l_ >> 4; \
            LAS float* Sw = Sl + ((c_) & 1) * (16 * 68); bf16_t* go = (bf16_t*)SST + ((size_t)sh * NCH + (c_)) * 4096; \
            if (act) { _Pragma("unroll") for (int r = 0; r < 4; ++r) Sw[(4 * lq + r) * 68 + col0 + ln] = acc[r]; } \
            const f32x4 sc = acc; acc = CX; \
            asm volatile("s_waitcnt lgkmcnt(0)" ::: "memory"); arrivals += 4u; \
            if ((TID() & 63) == 0) __hip_atomic_fetch_add(cflag, 1u, __ATOMIC_RELAXED, __HIP_MEMORY_SCOPE_WORKGROUP); \
            { unsigned sp_ = 0; while (__builtin_amdgcn_readfirstlane(__hip_atomic_load(cflag, __ATOMIC_RELAXED, __HIP_MEMORY_SCOPE_WORKGROUP)) < arrivals && ++sp_ < (1u << 22)) __builtin_amdgcn_s_sleep(0); } \
            asm volatile("" ::: "memory"); \
            if (act) { \
                _Pragma("unroll") for (int r = 0; r < 4; ++r) go[(row0 + 4 * lq + r) * 64 + col0 + ln] = f2bf(sc[r]); \
                if ((c_) + 2 < NCH) CARRY_LOAD(BL, CL, (c_) + 2); \
                float av[16]; _Pragma("unroll") for (int q = 0; q < 16; ++q) av[q] = Sw[ln * 68 + 4 * q + lq]; \
                asm volatile("s_waitcnt lgkmcnt(0)" ::: "memory"); \
                _Pragma("unroll") for (int q = 0; q < 16; ++q) acc = __builtin_amdgcn_mfma_f32_16x16x4f32(av[q], BX[q], acc, 0, 0, 0); } } while (0)
        if (act) { CARRY_LOAD(b0, c0, 0); CARRY_LOAD(b1, c1, 1); }
        for (int c = 0; c < NCH; c += 3) {
            CARRY_STEP(b0, c0, b2, c2, c);
            if (c + 1 < NCH) CARRY_STEP(b1, c1, b0, c0, c + 1);
            if (c + 2 < NCH) CARRY_STEP(b2, c2, b1, c1, c + 2);
        }
        if (act) { const int l_ = TID() & 63, ln = l_ & 15, lq = l_ >> 4; float* go = p->out + O_WKVP + (((size_t)j * 4 + b) * 16 + h) * 4096;
#pragma unroll
            for (int r = 0; r < 4; ++r) go[(row0 + 4 * lq + r) * 64 + col0 + ln] = acc[r]; }
#undef CARRY_LOAD
#undef CARRY_STEP
    }
    __syncthreads();
}
__device__ __forceinline__ void phase_sample_mixer(KP p, int j) {
    const int tid = TID(), lane = tid & 63, wave = tid >> 6;
    {
        const bf16_t *RB = WSP(bf16_t, WS_RB), *KB = WSP(bf16_t, WS_KB), *VB = WSP(bf16_t, WS_VB); bf16_t* YG = WSP(bf16_t, WS_YG);
        const float *WPp = WSP(float, WS_WP), *APp = WSP(float, WS_AP), *VPp = WSP(float, WS_VP), *GG = WSP(float, WS_GG); float* VF = WSP(float, WS_VFIRST);
        for (int it = BID() * 8 + wave; it < 512; it += gridDim.x * 8) {
            const int b = it >> 4, h = it & 15, col = h * 64 + lane;
            const float* s0 = p->state_wkv + (((size_t)j * 32 + b) * 16 + h) * 4096 + lane * 64;
            float S[64];
#pragma unroll
            for (int k = 0; k < 64; k += 4) { const f32x4 t = *(const f32x4*)(s0 + k); S[k] = t[0]; S[k + 1] = t[1]; S[k + 2] = t[2]; S[k + 3] = t[3]; }
            const float w0 = p->rw_w0[j * D + col], a0 = p->rw_a0[j * D + col], kkw = p->rw_k_k[j * D + col], kaw = p->rw_k_a[j * D + col], rkw = p->rw_r_k[j * D + col];
            const float v0 = j ? p->rw_v0[(j - 1) * D + col] : 0.f, lnw = p->rw_lnx_w[j * D + col], lnb = p->rw_lnx_b[j * D + col];
            for (int t = 0; t < 8; ++t) {
                const size_t o = (size_t)(NP + b * 8 + t) * D + col;
                const float kx = bf2f(KB[o]), vx = bf2f(VB[o]), r = bf2f(RB[o]);
                const float z = -(w0 + WPp[o]), sp = fmaxf(z, 0.f) + log1pf(expf(-fabsf(z)));
                const float wd = expf(-expf(-sp - 0.5f)), asg = sigmoidf_(a0 + APp[o]);
                float v = vx;
                if (j == 0) VF[o] = vx; else { const float vf = VF[o]; v = vx + (vf - vx) * sigmoidf_(v0 + VPp[o]); }
                float kk = kx * kkw; const float ss = wave_sum(kk * kk); kk *= rsqrtf(fmaxf(ss, 1e-24f));
                const float kp = kx * (1.0f + (asg - 1.0f) * kaw), a = -kk, bq = kk * asg;
                float sa = 0.f;
#pragma unroll
                for (int k = 0; k < 64; ++k) sa += S[k] * rl(a, k);
#pragma unroll
                for (int k = 0; k < 64; ++k) S[k] = S[k] * rl(wd, k) + sa * rl(bq, k) + v * rl(kp, k);
                float y = 0.f;
#pragma unroll
                for (int k = 0; k < 64; ++k) y += S[k] * rl(r, k);
                const float mu = wave_sum(y) * (1.0f / 64.0f), dy = y - mu, var = wave_sum(dy * dy) * (1.0f / 64.0f);
                const float bonus = wave_sum(r * kp * rkw);
                YG[o] = f2bf((dy * rsqrtf(var + 64e-5f) * lnw + lnb + bonus * v) * GG[o]);
            }
            float* so = p->out + O_WKVS + (((size_t)j * 32 + b) * 16 + h) * 4096 + lane * 64;
#pragma unroll
            for (int k = 0; k < 64; k += 4) *(f32x4*)(so + k) = (f32x4){S[k], S[k + 1], S[k + 2], S[k + 3]};
        }
    }
}
__device__ __forceinline__ void phase_post2(KP p, int j, LAS unsigned char* lds) {
    LAS float* part = (LAS float*)lds;
    const bf16_t *GM = WSP(bf16_t, WS_DEC), *VM2 = WSP(bf16_t, WS_KM), *TG = WSP(bf16_t, WS_TG), *G2T = WSP(bf16_t, WS_G2T) + (size_t)j * D * 160;
    const float *Y0 = WSP(float, WS_Y), *BON = WSP(float, WS_AV), *SST = WSP(float, WS_SST); bf16_t* YG = WSP(bf16_t, WS_YG);
    for (int it = BID(); it < 64 * NCH; it += gridDim.x) {
        const int tid = TID(), lane = tid & 63, w = tid >> 6, n = lane & 15, c4 = lane >> 4, tr = w >> 1, tcb = 2 * (w & 1);
        const int sh = it / NCH, c = it % NCH, b = sh >> 4, h = sh & 15, R0 = b * 4096 + c * LCH, hc = h * 64;
        f32x4 y[2], g[2];
        const size_t ar = (size_t)(R0 + 16 * tr + n);
#pragma unroll
        for (int ti = 0; ti < 2; ++ti) {
            const int dv = 16 * (tcb + ti) + n;
            f32x4 acc = {0.f, 0.f, 0.f, 0.f}, gacc = acc;
#pragma unroll
            for (int ks = 0; ks < 2; ++ks) {
                const bf16x8 af = *(const bf16x8*)(GM + ar * D + hc + 32 * ks + 8 * c4);
                const bf16x8 bw = *(const bf16x8*)((const bf16_t*)SST + ((size_t)it * 64 + dv) * 64 + 32 * ks + 8 * c4);
                acc = __builtin_amdgcn_mfma_f32_16x16x32_bf16(af, bw, acc, 0, 0, 0);
            }
#pragma unroll
            for (int ks = 0; ks < 5; ++ks)
                gacc = __builtin_amdgcn_mfma_f32_16x16x32_bf16(*(const bf16x8*)(TG + ar * 160 + 32 * ks + 8 * c4), *(const bf16x8*)(G2T + (size_t)(hc + dv) * 160 + 32 * ks + 8 * c4), gacc, 0, 0, 0);
#pragma unroll
            for (int r = 0; r < 4; ++r) acc[r] += bf2f(((const bf16_t*)Y0)[(size_t)(R0 + 16 * tr + 4 * c4 + r) * D + hc + dv]);
            y[ti] = acc; g[ti] = gacc;
        }
        float bonus4[4]; unsigned short vm4[2][4]; float lnw2[2], lnb2[2];
#pragma unroll
        for (int r = 0; r < 4; ++r) bonus4[r] = BON[(size_t)(R0 + 16 * tr + 4 * c4 + r) * 16 + h];
#pragma unroll
        for (int ti = 0; ti < 2; ++ti) { const int col = hc + 16 * (tcb + ti) + n; lnw2[ti] = p->rw_lnx_w[j * D + col]; lnb2[ti] = p->rw_lnx_b[j * D + col];
#pragma unroll
            for (int r = 0; r < 4; ++r) vm4[ti][r] = VM2[(size_t)(R0 + 16 * tr + 4 * c4 + r) * D + col]; }
        float s1[4], s2[4];
#pragma unroll
        for (int r = 0; r < 4; ++r) { s1[r] = g16_sum(y[0][r] + y[1][r]); s2[r] = g16_sum(y[0][r] * y[0][r] + y[1][r] * y[1][r]); }
        asm volatile("s_waitcnt lgkmcnt(0)" ::: "memory"); __builtin_amdgcn_s_barrier(); asm volatile("" ::: "memory");
        if (n == 0) {
#pragma unroll
            for (int r = 0; r < 4; ++r) { const int t = 16 * tr + 4 * c4 + r; part[(t * 2 + (w & 1)) * 2 + 0] = s1[r]; part[(t * 2 + (w & 1)) * 2 + 1] = s2[r]; }
        }
        asm volatile("s_waitcnt lgkmcnt(0)" ::: "memory"); __builtin_amdgcn_s_barrier(); asm volatile("" ::: "memory");
#pragma unroll
        for (int r = 0; r < 4; ++r) {
            const int t = 16 * tr + 4 * c4 + r;
            const float mu = (part[(t * 2 + 0) * 2] + part[(t * 2 + 1) * 2]) * (1.0f / 64.0f), ex2 = (part[(t * 2 + 0) * 2 + 1] + part[(t * 2 + 1) * 2 + 1]) * (1.0f / 64.0f);
            const float rs = rsqrtf(fmaxf(ex2 - mu * mu, 0.f) + 64e-5f), bonus = bonus4[r];
#pragma unroll
            for (int ti = 0; ti < 2; ++ti) {
                const int col = hc + 16 * (tcb + ti) + n; const size_t o = (size_t)(R0 + t) * D + col;
                YG[o] = f2bf(((y[ti][r] - mu) * rs * lnw2[ti] + lnb2[ti] + bonus * bf2f(vm4[ti][r])) * g[ti][r]);
            }
        }
    }
    __syncthreads();
}

__device__ __forceinline__ void phase_post(KP p, int j) {
    const float *Y = WSP(float, WS_Y), *KM = WSP(float, WS_KM), *VM = WSP(float, WS_VM), *GG = WSP(float, WS_GG);
    const bf16_t* RB = WSP(bf16_t, WS_RB); bf16_t* YG = WSP(bf16_t, WS_YG);
    const int lane = TID() & 63, gw = BID() * 8 + (TID() >> 6), nw = gridDim.x * 8;
    for (int row = gw; row < NT; row += nw) {
#pragma unroll
        for (int i = 0; i < 4; ++i) {
            const int col = 256 * i + 4 * lane; const size_t o = (size_t)row * D + col;
            const f32x4 y = *(const f32x4*)(Y + o), r = ld_bf4(RB + o), km = *(const f32x4*)(KM + o), vm = *(const f32x4*)(VM + o), gg = *(const f32x4*)(GG + o);
            const f32x4 lw = *(const f32x4*)(p->rw_lnx_w + j * D + col), lb = *(const f32x4*)(p->rw_lnx_b + j * D + col), rk = *(const f32x4*)(p->rw_r_k + j * D + col);
            const float mu = g16_sum(y[0] + y[1] + y[2] + y[3]) * (1.0f / 64.0f);
            const f32x4 d = y - mu;
            const float var = g16_sum(d[0] * d[0] + d[1] * d[1] + d[2] * d[2] + d[3] * d[3]) * (1.0f / 64.0f);
            const float rs = rsqrtf(var + 64e-5f);
            const float bon = g16_sum(r[0] * km[0] * rk[0] + r[1] * km[1] * rk[1] + r[2] * km[2] * rk[2] + r[3] * km[3] * rk[3]);
            st_bf4(YG + o, (d * rs * lw + lb + bon * vm) * gg);
        }
    }
}

__constant__ double kRopeInv[8] = {1.0, 0.19392274474868576, 0.03760603093086393, 0.007292664737217109, 0.001414213562373095, 0.0002742481756762073, 5.318295896944988e-05, 1.031338537721246e-05};
__device__ __forceinline__ void phase_dsapost(KP p, int j) {
    const bf16_t* PR = WSP(bf16_t, WS_PR); float *Q = WSP(float, WS_Q), *QI = WSP(float, WS_QI), *WI = WSP(float, WS_WI);
    const int lane = TID() & 63, l16 = lane & 15, gw = BID() * 8 + (TID() >> 6), nw = gridDim.x * 8;
    const f32x4 qn = *(const f32x4*)(p->att_q_norm + j * 64 + 4 * l16), kn = *(const f32x4*)(p->att_k_norm + j * 64 + 4 * l16), in = *(const f32x4*)(p->idx_k_norm + j * 64 + 4 * l16);
    for (int row = gw; row < NT; row += nw) {
        const int pos = row_pos(row);
        const bf16_t* pr = PR + (size_t)row * PINP;
        f32x4 cs = {1.f, 1.f, 1.f, 1.f}, sn = {0.f, 0.f, 0.f, 0.f};
        if (l16 < 4) {
#pragma unroll
            for (int e = 0; e < 4; ++e) { double ang = (double)pos * kRopeInv[4 * (l16 & 1) + e]; ang -= floor(ang * 0.15915494309189535) * 6.283185307179586; const float af = (float)ang; cs[e] = cosf(af); sn[e] = sinf(af); }
        }
        const float sgn = (l16 < 2) ? -1.0f : 1.0f;
#define ROPE4(v) do { f32x4 _o; _o[0] = __shfl_xor((v)[0], 2); _o[1] = __shfl_xor((v)[1], 2); _o[2] = __shfl_xor((v)[2], 2); _o[3] = __shfl_xor((v)[3], 2); if (l16 < 4) (v) = (v) * cs + sgn * (_o * sn); } while (0)
#define HNORM4(v, w) do { const float _ss = g16_sum((v)[0] * (v)[0] + (v)[1] * (v)[1] + (v)[2] * (v)[2] + (v)[3] * (v)[3]); (v) = (v) * rsqrtf(_ss * (1.0f / 64.0f) + 1e-6f) * (w); } while (0)
#pragma unroll
        for (int i = 0; i < 4; ++i) { f32x4 v = ld_bf4(pr + 256 * i + 4 * lane); HNORM4(v, qn); ROPE4(v); st_bf4((bf16_t*)Q + (size_t)row * D + 256 * i + 4 * lane, v); }
        { f32x4 v = ld_bf4(pr + 1024 + 4 * lane); HNORM4(v, kn); ROPE4(v);
          float* ko = row < NP ? p->out + O_KP + ((size_t)j * NP + row) * 256 : p->out + O_KS + ((size_t)j * NS + (row - NP)) * 256; *(f32x4*)(ko + 4 * lane) = v; *(unsigned*)(WSP(unsigned char, WS_K8) + (size_t)row * 256 + 4 * lane) = pk_fp8x4(v); }
        { const f32x4 v = ld_bf4(pr + 1280 + 4 * lane);
          float* vo = row < NP ? p->out + O_VP + ((size_t)j * NP + row) * 256 : p->out + O_VS + ((size_t)j * NS + (row - NP)) * 256; *(f32x4*)(vo + 4 * lane) = v; *(unsigned*)(WSP(unsigned char, WS_V8) + (size_t)row * 256 + 4 * lane) = pk_fp8x4(v); }
#pragma unroll
        for (int i = 0; i < 2; ++i) { f32x4 v = ld_bf4(pr + 1536 + 256 * i + 4 * lane); ROPE4(v); st_bf4(WSP(bf16_t, WS_QIB) + (size_t)row * 512 + 256 * i + 4 * lane, v); }
        { f32x4 v = ld_bf4(pr + 2048 + 4 * l16); HNORM4(v, in); ROPE4(v);
          float* io = row < NP ? p->out + O_IKP + ((size_t)j * NP + row) * 64 : p->out + O_IKS + ((size_t)j * NS + (row - NP)) * 64; if (lane < 16) { *(f32x4*)(io + 4 * lane) = v; st_bf4(WSP(bf16_t, WS_KIB) + (size_t)row * 64 + 4 * lane, v); } }
        if (lane < 2) { const f32x4 v = ld_bf4(pr + 2112 + 4 * lane); *(f32x4*)(WI + (size_t)row * 8 + 4 * lane) = v * 0.35355339059327373f; }
#undef ROPE4
#undef HNORM4
    }
}

template <bool SAMPLE>
__device__ __forceinline__ void phase_idx(KP p, int j, LAS unsigned char* lds) {
    LAS float* Qs = (LAS float*)lds;
    LAS float* Ks = (LAS float*)(lds + 32768);
    const float *QI = WSP(float, WS_QI), *WI = WSP(float, WS_WI);
    const int tid = TID(), q = tid >> 5, kx = tid & 31;
    const int nitems = SAMPLE ? 32 * 65 : 1024;
    for (int it = BID(); it < nitems; it += gridDim.x) {
        int b, t0, rowbase, nkt, kt0 = 0;
        if (SAMPLE) { b = it / 65; kt0 = it % 65; t0 = 0; rowbase = NP + b * 8; nkt = kt0 + 1; }
        else { const int k4 = it >> 8, w = it & 255, i = (k4 & 1) ? (k4 * 256 + 255 - w) : (k4 * 256 + w); b = i & 3; t0 = (i >> 2) * 16; rowbase = b * 4096 + t0; nkt = (t0 + 15) / 128 + 1; }
        const int nq = SAMPLE ? 8 : 16;
        __syncthreads();
#pragma unroll
        for (int n = 0; n < 16; ++n) { const int e = tid + 512 * n, qq = e >> 9, c = e & 511, h = c >> 6, d = c & 63;
            Qs[(d * 16 + qq) * 8 + h] = qq < nq ? QI[(size_t)(rowbase + qq) * 512 + c] : 0.f; }
        float wi[8];
#pragma unroll
        for (int h = 0; h < 8; ++h) wi[h] = q < nq ? WI[(size_t)(rowbase + q) * 8 + h] : 0.f;
        for (int kt = kt0; kt < nkt; ++kt) {
            __syncthreads();
#pragma unroll
            for (int n = 0; n < 16; ++n) { const int e = tid + 512 * n, key = e >> 6, d = e & 63, s = kt * 128 + key; float v = 0.f;
                if (SAMPLE) {
                    if (s < PAST) { const int pg = p->page_table[b * 64 + (s >> 7)]; v = p->cache_ik[(((size_t)j * 2560 + pg) * 128 + (s & 127)) * 64 + d]; }
                    else if (s < PAST + 8) v = p->out[O_IKS + ((size_t)j * NS + b * 8 + (s - PAST)) * 64 + d];
                } else v = p->out[O_IKP + ((size_t)j * NP + b * 4096 + s) * 64 + d];
                Ks[d * 132 + key] = v; }
            __syncthreads();
            f32x4 acc[8];
#pragma unroll
            for (int h = 0; h < 8; ++h) acc[h] = (f32x4){0.f, 0.f, 0.f, 0.f};
#pragma unroll 4
            for (int d = 0; d < 64; ++d) {
                const f32x4 qa = *(const LAS f32x4*)(Qs + (d * 16 + q) * 8), qb = *(const LAS f32x4*)(Qs + (d * 16 + q) * 8 + 4), kv = *(const LAS f32x4*)(Ks + d * 132 + 4 * kx);
                acc[0] += qa[0] * kv; acc[1] += qa[1] * kv; acc[2] += qa[2] * kv; acc[3] += qa[3] * kv;
                acc[4] += qb[0] * kv; acc[5] += qb[1] * kv; acc[6] += qb[2] * kv; acc[7] += qb[3] * kv;
            }
            f32x4 sc = {0.f, 0.f, 0.f, 0.f};
#pragma unroll
            for (int h = 0; h < 8; ++h)
#pragma unroll
                for (int e = 0; e < 4; ++e) sc[e] += fmaxf(acc[h][e] * 0.125f, 0.f) * wi[h];
            if (q < nq) {
                if (SAMPLE) *(f32x4*)(WSP(float, WS_SCS) + (size_t)(b * 8 + q) * SCS_LD + kt * 128 + 4 * kx) = sc;
                else *(f32x4*)(WSP(float, WS_SC) + ((size_t)b * 4096 + t0 + q) * 4096 + kt * 128 + 4 * kx) = sc;
            }
        }
    }
    __syncthreads();
}

template <bool SAMPLE>
__device__ __forceinline__ void phase_idx2(KP p, int j) {
    const bf16_t *QIB = WSP(bf16_t, WS_QIB), *KIB = WSP(bf16_t, WS_KIB); const float* WI = WSP(float, WS_WI);
    const int lane = TID() & 63, lr = lane & 31, lh = lane >> 5, gw = BID() * 8 + (TID() >> 6), nw = gridDim.x * 8;
    const int nitems = SAMPLE ? 32 * 65 : 4096;
    for (int it = gw; it < nitems; it += nw) {
        int b, rowbase, tile0, ntile;
        if (SAMPLE) { b = it / 65; rowbase = NP + b * 8; tile0 = (it % 65) * 4; ntile = min(4, 257 - tile0); }
        else { const int sub = it >= 2048, w_ = it & 2047; b = w_ & 3; const int wb = w_ >> 2, kk = sub ? 511 - wb : wb, nt = (kk * 8 + 7) / 32 + 1;
            rowbase = b * 4096 + kk * 8; tile0 = sub ? (nt >> 1) : 0; ntile = sub ? nt - (nt >> 1) : (nt >> 1); }
        if (ntile <= 0) continue;
        bf16x8 af[2][4]; float w[2][2][8];
        { const int hd = (lr & 3) + 4 * ((lr >> 3) & 1), jq = 2 * ((lr >> 2) & 1) + (lr >> 4);
#pragma unroll
          for (int st = 0; st < 2; ++st)
#pragma unroll
              for (int ks = 0; ks < 4; ++ks) af[st][ks] = *(const bf16x8*)(QIB + (size_t)(rowbase + 4 * st + jq) * 512 + hd * 64 + 16 * ks + 8 * lh);
#pragma unroll
          for (int st = 0; st < 2; ++st)
#pragma unroll
              for (int q = 0; q < 2; ++q) { const f32x4 w0 = *(const f32x4*)(WI + (size_t)(rowbase + 4 * st + 2 * lh + q) * 8), w1 = *(const f32x4*)(WI + (size_t)(rowbase + 4 * st + 2 * lh + q) * 8 + 4);
#pragma unroll
                  for (int e = 0; e < 4; ++e) { w[st][q][e] = w0[e] * 0.125f; w[st][q][4 + e] = w1[e] * 0.125f; } } }
#define IDX_LOADB(BF, tl_) do { const int s_ = (tile0 + (tl_)) * 32 + lr; \
            if (!SAMPLE) { _Pragma("unroll") for (int ks = 0; ks < 4; ++ks) BF[ks] = *(const bf16x8*)(KIB + ((size_t)b * 4096 + s_) * 64 + 16 * ks + 8 * lh); } \
            else { const float* kp = p->out + O_IKS + ((size_t)j * NS + b * 8) * 64; \
                if (s_ < PAST) kp = p->cache_ik + (((size_t)j * 2560 + p->page_table[b * 64 + (s_ >> 7)]) * 128 + (s_ & 127)) * 64; else kp += (size_t)min(s_ - PAST, 7) * 64; \
                _Pragma("unroll") for (int ks = 0; ks < 4; ++ks) { const f32x4 x0 = *(const f32x4*)(kp + 16 * ks + 8 * lh), x1 = *(const f32x4*)(kp + 16 * ks + 8 * lh + 4); \
                    const u32x4 wv = {pk_bf16(x0[0], x0[1]), pk_bf16(x0[2], x0[3]), pk_bf16(x1[0], x1[1]), pk_bf16(x1[2], x1[3])}; BF[ks] = __builtin_bit_cast(bf16x8, wv); } } } while (0)
        bf16x8 bnx[4];
        IDX_LOADB(bnx, 0);
        for (int tl = 0; tl < ntile; ++tl) {
            const int s = (tile0 + tl) * 32 + lr;
            bf16x8 bfr[4];
#pragma unroll
            for (int ks = 0; ks < 4; ++ks) bfr[ks] = bnx[ks];
            if (tl + 1 < ntile) IDX_LOADB(bnx, tl + 1);
            __builtin_amdgcn_sched_barrier(0);
#pragma unroll
            for (int st = 0; st < 2; ++st) {
                f32x16 acc;
#pragma unroll
                for (int r = 0; r < 16; ++r) acc[r] = 0.f;
#pragma unroll
                for (int ks = 0; ks < 4; ++ks) acc = __builtin_amdgcn_mfma_f32_32x32x16_bf16(af[st][ks], bfr[ks], acc, 0, 0, 0);
#pragma unroll
                for (int q = 0; q < 2; ++q) {
                    float sc = 0.f;
#pragma unroll
                    for (int hh = 0; hh < 2; ++hh)
#pragma unroll
                        for (int hl = 0; hl < 4; ++hl) sc += fmaxf(acc[4 * (2 * q + hh) + hl], 0.f) * w[st][q][hl + 4 * hh];
                    if (SAMPLE) WSP(float, WS_SCS)[(size_t)(b * 8 + 4 * st + 2 * lh + q) * SCS_LD + s] = sc;
                    else WSP(float, WS_SC)[((size_t)rowbase + 4 * st + 2 * lh + q) * 4096 + s] = sc;
                }
            }
        }
    }
#undef IDX_LOADB
}

__device__ __forceinline__ unsigned fkey(float f) { f = (f == 0.f) ? 0.f : f; const unsigned u = __float_as_uint(f); return (u & 0x80000000u) ? ~u : (u | 0x80000000u); }
__device__ __forceinline__ void phase_topk_prompt(KP p) {
    const float* SC = WSP(float, WS_SC); int* SEL = WSP(int, WS_SEL); int* CNT = WSP(int, WS_CNT);
    const int lane = TID() & 63, gw = BID() * 8 + (TID() >> 6), nw = gridDim.x * 8;
    for (int qi = gw; qi < NP; qi += nw) {
        const int b = qi & 3, tt = qi >> 2, t = (tt & 1) ? 4095 - (tt >> 1) : (tt >> 1), row = b * 4096 + t, n = t + 1;
        int* sel = SEL + (size_t)row * 256;
        if (n <= TOPK) { for (int s = lane; s < n; s += 64) sel[s] = s; if (lane == 0) CNT[row] = n; continue; }
        const float* base = SC + (size_t)row * 4096;
        unsigned u[64];
#pragma unroll
        for (int m = 0; m < 64; ++m) u[m] = __float_as_uint(base[lane + 64 * m]);
#pragma unroll
        for (int m = 0; m < 64; ++m) { const unsigned k_ = fkey(__uint_as_float(u[m])); u[m] = (lane + 64 * m < n) ? k_ : 0u; }
        unsigned tau = 0u;
#pragma unroll 1
        for (int bit = 31; bit >= 0; --bit) {
            const unsigned cand = tau | (1u << bit); int c = 0;
#pragma unroll
            for (int m = 0; m < 64; ++m) c += (u[m] >= cand) ? 1 : 0;
            c = wave_sum_i(c);
            if (c >= TOPK) tau = cand;
            if (c == TOPK) break;
        }
        int cg = 0, ct = 0; unsigned tlo = 0u, thi = 0u;
#pragma unroll
        for (int m = 31; m >= 0; --m) { cg += (u[m] > tau) ? 1 : 0; const unsigned tie = (u[m] == tau) ? 1u : 0u; ct += (int)tie; tlo = (tlo << 1) | tie; }
#pragma unroll
        for (int m = 63; m >= 32; --m) { cg += (u[m] > tau) ? 1 : 0; const unsigned tie = (u[m] == tau) ? 1u : 0u; ct += (int)tie; thi = (thi << 1) | tie; }
        unsigned long long tmask = ((unsigned long long)thi << 32) | tlo;
        const int totg = wave_sum_i(cg), tott = wave_sum_i(ct);
        const int need = TOPK - totg;
        unsigned long long smask = 0ull;
        if (tott == need) smask = tmask;
        else {
#pragma unroll 1
            for (int it = 0; it < need; ++it) {
                const int m0 = tmask ? (int)__builtin_ctzll(tmask) : 64;
                const int cand = tmask ? (lane + 64 * m0) : 0x7fffffff, best = wave_min_i(cand);
                if (cand == best && tmask) { smask |= (1ull << m0); tmask &= ~(1ull << m0); }
            }
        }
        const int mine = cg + __popcll(smask);
        int incl = mine;
#pragma unroll
        for (int d = 1; d < 64; d <<= 1) { const int o = __shfl_up(incl, d); if (lane >= d) incl += o; }
        int off = incl - mine;
#pragma unroll
        for (int m = 0; m < 64; ++m) { if ((u[m] > tau) || ((smask >> m) & 1ull)) { sel[off] = lane + 64 * m; ++off; } }
        if (lane == 0) CNT[row] = TOPK;
    }
}
__device__ __forceinline__ void phase_topk_sample(KP p, LAS unsigned char* lds) {
    LAS unsigned* ckey = (LAS unsigned*)lds;
    LAS int* cidx = (LAS int*)(lds + 8192);
    const float* SCS = WSP(float, WS_SCS); int* SEL = WSP(int, WS_SEL); int* CNT = WSP(int, WS_CNT);
    for (int qq = BID(); qq < NS; qq += gridDim.x) {
        const int tid = TID(), lane = tid & 63, wave = tid >> 6;
        const int n = PAST + 1 + (qq & 7), row = NP + qq, s0 = 1088 * wave;
        const float* base = SCS + (size_t)qq * SCS_LD;
        unsigned u[17];
#pragma unroll
        for (int m = 0; m < 17; ++m) { const int s = s0 + lane + 64 * m; u[m] = __float_as_uint(base[s < SCS_LD ? s : 0]); }
#pragma unroll
        for (int m = 0; m < 17; ++m) { const unsigned k_ = fkey(__uint_as_float(u[m])); u[m] = (s0 + lane + 64 * m < n) ? k_ : 0u; }
        __syncthreads();
        {
            int nvalid = 0;
#pragma unroll
            for (int m = 0; m < 17; ++m) nvalid += (u[m] != 0u) ? 1 : 0;
            nvalid = wave_sum_i(nvalid);
            unsigned tau = 0u; int need = 0; unsigned tmask = 0u, smask = 0u;
            if (nvalid > TOPK) {
#pragma unroll 1
                for (int bit = 31; bit >= 0; --bit) {
                    const unsigned cand = tau | (1u << bit); int c = 0;
#pragma unroll
                    for (int m = 0; m < 17; ++m) c += (u[m] >= cand) ? 1 : 0;
                    c = wave_sum_i(c);
                    if (c >= TOPK) tau = cand;
                    if (c == TOPK) break;
                }
                int cg = 0, ct = 0;
#pragma unroll
                for (int m = 0; m < 17; ++m) { cg += (u[m] > tau) ? 1 : 0; const bool tie = (u[m] == tau); ct += tie ? 1 : 0; tmask |= tie ? (1u << m) : 0u; }
                cg = wave_sum_i(cg); ct = wave_sum_i(ct);
                need = TOPK - cg;
                if (ct == need) smask = tmask;
                else {
#pragma unroll 1
                    for (int it = 0; it < need; ++it) {
                        const int m0 = tmask ? (int)__builtin_ctz(tmask) : 32;
                        const int cand = tmask ? (lane + 64 * m0) : 0x7fffffff, best = wave_min_i(cand);
                        if (cand == best && tmask) { smask |= (1u << m0); tmask &= ~(1u << m0); }
                    }
                }
            } else { tau = 0u; smask = 0u; }
            int mine = 0;
#pragma unroll
            for (int m = 0; m < 17; ++m) mine += ((u[m] > tau) || ((smask >> m) & 1u)) ? 1 : 0;
            int incl = mine;
#pragma unroll
            for (int d = 1; d < 64; d <<= 1) { const int o = __shfl_up(incl, d); if (lane >= d) incl += o; }
            int off = incl - mine;
            const int total = __builtin_amdgcn_readlane(incl, 63);
#pragma unroll
            for (int m = 0; m < 17; ++m) { if ((u[m] > tau) || ((smask >> m) & 1u)) { ckey[wave * 256 + off] = u[m]; cidx[wave * 256 + off] = s0 + lane + 64 * m; ++off; } }
            for (int e = total + lane; e < 256; e += 64) { ckey[wave * 256 + e] = 0u; cidx[wave * 256 + e] = 0x7fffffff; }
        }
        __syncthreads();
        if (wave == 0) {
            unsigned v[32]; int ix[32];
#pragma unroll
            for (int m = 0; m < 32; ++m) { v[m] = ckey[lane + 64 * m]; ix[m] = cidx[lane + 64 * m]; }
            unsigned tau = 0u;
#pragma unroll 1
            for (int bit = 31; bit >= 0; --bit) {
                const unsigned cand = tau | (1u << bit); int c = 0;
#pragma unroll
                for (int m = 0; m < 32; ++m) c += (v[m] >= cand) ? 1 : 0;
                c = wave_sum_i(c);
                if (c >= TOPK) tau = cand;
                if (c == TOPK) break;
            }
            int cg = 0, ct = 0; unsigned tmask = 0u, smask = 0u;
#pragma unroll
            for (int m = 31; m >= 0; --m) { cg += (v[m] > tau) ? 1 : 0; const unsigned tie = (v[m] == tau) ? 1u : 0u; ct += (int)tie; tmask = (tmask << 1) | tie; }
            cg = wave_sum_i(cg); ct = wave_sum_i(ct);
            const int need = TOPK - cg;
            if (ct == need) smask = tmask;
            else {
#pragma unroll 1
                for (int it = 0; it < need; ++it) {
                    int bi = 0x7fffffff, bm = 0;
#pragma unroll
                    for (int m = 0; m < 32; ++m) { const bool t_ = (tmask >> m) & 1u; if (t_ && ix[m] < bi) { bi = ix[m]; bm = m; } }
                    const int best = wave_min_i(bi);
                    if (bi == best && bi != 0x7fffffff) { smask |= (1u << bm); tmask &= ~(1u << bm); }
                }
            }
            int mine = 0;
#pragma unroll
            for (int m = 0; m < 32; ++m) mine += ((v[m] > tau) || ((smask >> m) & 1u)) ? 1 : 0;
            int incl = mine;
#pragma unroll
            for (int d = 1; d < 64; d <<= 1) { const int o = __shfl_up(incl, d); if (lane >= d) incl += o; }
            int off = incl - mine;
            int* sel = SEL + (size_t)row * 256;
#pragma unroll
            for (int m = 0; m < 32; ++m) { if ((v[m] > tau) || ((smask >> m) & 1u)) { if (off < TOPK) sel[off] = ix[m]; ++off; } }
            if (lane == 0) CNT[row] = TOPK;
        }
    }
    __syncthreads();
}

template <bool SAMPLE>
__device__ __forceinline__ void phase_attn(KP p, int j, LAS unsigned char* lds) {
    const int tid = TID(), lane = tid & 63, wave = tid >> 6, n16 = lane & 15, c4 = lane >> 4;
    LAS bf16_t* ps = (LAS bf16_t*)(lds + wave * 16384);
    LAS int* is = (LAS int*)(lds + wave * 16384 + 8192);
    LAS bf16_t* qs = (LAS bf16_t*)(lds + wave * 16384 + 9216);
    LAS float* invs = (LAS float*)(lds + wave * 16384 + 11264);
    const float* Q = WSP(float, WS_Q); const int* SEL = WSP(int, WS_SEL); const int* CNT = WSP(int, WS_CNT); bf16_t* O = WSP(bf16_t, WS_YG);
    const bf16_t *KBF = WSP(bf16_t, WS_KBF), *VBF = WSP(bf16_t, WS_VBF);
    const float* kc = p->cache_k + (size_t)j * 2560 * 128 * 256; const float* vc = p->cache_v + (size_t)j * 2560 * 128 * 256;
    const float* knew = p->out + O_KS + (size_t)j * NS * 256; const float* vnew = p->out + O_VS + (size_t)j * NS * 256;
    const int gw = BID() * 8 + wave, nw = gridDim.x * 8, nq = SAMPLE ? NS : NP;
    unsigned* qctr = WSP(unsigned, WS_BAR + 40960) + (size_t)j * 256;
    int qb = 0, qnext = 0, qsub = 2, qcur = 0;
    if (!SAMPLE) { unsigned v_ = 0u; if (lane == 0) v_ = __hip_atomic_fetch_add(qctr + 16 * ((BID() + qb) & 3), 2u, __ATOMIC_RELAXED, __HIP_MEMORY_SCOPE_AGENT); qnext = (int)__builtin_amdgcn_readfirstlane(v_); }
    for (int qi = gw; SAMPLE ? (qi < nq) : true; qi += nw) {
        int row;
        if (SAMPLE) row = NP + qi;
        else {
            if (qsub == 2) {
                for (;;) {
                    qcur = qnext; qsub = 0;
                    if (qcur < 4096 || qb == 3) break;
                    ++qb; unsigned v_ = 0u; if (lane == 0) v_ = __hip_atomic_fetch_add(qctr + 16 * ((BID() + qb) & 3), 2u, __ATOMIC_RELAXED, __HIP_MEMORY_SCOPE_AGENT); qnext = (int)__builtin_amdgcn_readfirstlane(v_);
                }
                if (qcur >= 4096) break;
                { unsigned v_ = 0u; if (lane == 0) v_ = __hip_atomic_fetch_add(qctr + 16 * ((BID() + qb) & 3), 2u, __ATOMIC_RELAXED, __HIP_MEMORY_SCOPE_AGENT); qnext = (int)__builtin_amdgcn_readfirstlane(v_); }
            }
            row = ((BID() + qb) & 3) * 4096 + (4095 - (qcur + qsub)); ++qsub;
        }
        const int n = CNT[row];
        wave_lds_fence();
#pragma unroll
        for (int c = 0; c < 4; ++c) { const int slot = lane + 64 * c;
            int s = SEL[(size_t)row * 256 + slot]; const bool ok = slot < n;
            int r;
            if (SAMPLE) { const int bb = (row - NP) >> 3; s = ok ? s : 0; const int sp = min(max(s, 0), PAST - 1); const int pg = p->page_table[bb * 64 + (sp >> 7)];
                r = (s < PAST) ? pg * 128 + (s & 127) : (0x40000000 | (bb * 8 + min(s - PAST, 7))); }
            else r = (row & ~4095) + (ok ? s : 0);
            is[slot] = r; }
#pragma unroll
        for (int i = 0; i < 4; ++i) { const f32x4 q4 = ld_bf4((const bf16_t*)Q + (size_t)row * D + 256 * i + 4 * lane);
            if (SAMPLE) { const f32x4 q8 = q4 * 0.125f; u32x2 w; w.x = pk_bf16(q8[0], q8[1]); w.y = pk_bf16(q8[2], q8[3]); *(LAS u32x2*)(qs + 256 * i + 4 * lane) = w; }
            else *(LAS unsigned*)((LAS unsigned char*)qs + 256 * i + 4 * lane) = pk_fp8x4(q4); }
        wave_lds_fence();
        {
            float mx = -__builtin_huge_valf();
#define ATT_EMIT(t_, acc_) do { f32x4 l_ = (acc_); _Pragma("unroll") for (int r = 0; r < 4; ++r) { if (16 * (t_) + 4 * c4 + r >= n) l_[r] = -__builtin_huge_valf(); mx = fmaxf(mx, l_[r]); } \
                u32x2 w_; w_.x = pk_bf16(l_[0], l_[1]); w_.y = pk_bf16(l_[2], l_[3]); *(LAS u32x2*)(ps + n16 * 256 + 16 * (t_) + 4 * c4) = w_; } while (0)
            if (SAMPLE) {
                const u32x4 qf0 = *(const LAS u32x4*)(qs + n16 * 64 + 8 * c4), qf1 = *(const LAS u32x4*)(qs + n16 * 64 + 32 + 8 * c4);
                u32x4 bq[8];
#pragma unroll
                for (int ks = 0; ks < 8; ++ks) { const bool on = (n16 >> 2) == (ks >> 1); const u32x4 qv = (ks & 1) ? qf1 : qf0; bq[ks] = (u32x4){on ? qv.x : 0u, on ? qv.y : 0u, on ? qv.z : 0u, on ? qv.w : 0u}; }
#pragma unroll 2
                for (int t = 0; t < 16; ++t) {
                    const int r = is[16 * t + n16];
                    const float* kp = ((r & 0x40000000) ? knew + (size_t)(r & 0xffff) * 256 : kc + (size_t)r * 256) + 8 * c4;
                    f32x4 acc = {0.f, 0.f, 0.f, 0.f};
#pragma unroll
                    for (int ks = 0; ks < 8; ++ks) { const f32x4 x0 = *(const f32x4*)(kp + 32 * ks), x1 = *(const f32x4*)(kp + 32 * ks + 4);
                        const u32x4 ka = {pk_bf16(x0[0], x0[1]), pk_bf16(x0[2], x0[3]), pk_bf16(x1[0], x1[1]), pk_bf16(x1[2], x1[3])};
                        acc = __builtin_amdgcn_mfma_f32_16x16x32_bf16(__builtin_bit_cast(bf16x8, ka), __builtin_bit_cast(bf16x8, bq[ks]), acc, 0, 0, 0); }
                    ATT_EMIT(t, acc);
                }
            } else {
                const LAS unsigned char* q8 = (const LAS unsigned char*)qs;
                long bq[8];
                { const bool on = (n16 >> 2) == c4;
#pragma unroll
                  for (int h2 = 0; h2 < 4; ++h2) { const u32x4 qv = *(const LAS u32x4*)(q8 + n16 * 64 + 16 * h2);
                      const u32x2 z0 = {on ? qv.x : 0u, on ? qv.y : 0u}, z1 = {on ? qv.z : 0u, on ? qv.w : 0u}; bq[2 * h2] = __builtin_bit_cast(long, z0); bq[2 * h2 + 1] = __builtin_bit_cast(long, z1); } }
                const unsigned char* K8 = WSP(unsigned char, WS_K8);
#pragma unroll
                for (int th = 0; th < 2; ++th) {
                    if (th) asm volatile("" ::: "memory");
                    u32x4 ka[8][4];
#pragma unroll
                    for (int t8 = 0; t8 < 8; ++t8) {
                        const int r = is[16 * (8 * th + t8) + n16];
                        const unsigned char* kp = K8 + (size_t)r * 256 + 64 * c4;
#pragma unroll
                        for (int h2 = 0; h2 < 4; ++h2) ka[t8][h2] = *(const u32x4*)(kp + 16 * h2);
                    }
                    __builtin_amdgcn_sched_barrier(0);
#pragma unroll
                    for (int t8 = 0; t8 < 8; ++t8) {
                        f32x4 acc = {0.f, 0.f, 0.f, 0.f};
#pragma unroll
                        for (int h2 = 0; h2 < 4; ++h2) { const u32x2 lo = {ka[t8][h2].x, ka[t8][h2].y}, hi = {ka[t8][h2].z, ka[t8][h2].w};
                            acc = __builtin_amdgcn_mfma_f32_16x16x32_fp8_fp8(__builtin_bit_cast(long, lo), bq[2 * h2], acc, 0, 0, 0);
                            acc = __builtin_amdgcn_mfma_f32_16x16x32_fp8_fp8(__builtin_bit_cast(long, hi), bq[2 * h2 + 1], acc, 0, 0, 0); }
                        ATT_EMIT(8 * th + t8, acc * 0.125f);
                    }
                }
            }
#undef ATT_EMIT
            mx = fmaxf(mx, __shfl_xor(mx, 16)); mx = fmaxf(mx, __shfl_xor(mx, 32));
            float sm = 0.f;
            u32x2 lw_[16];
#pragma unroll
            for (int t = 0; t < 16; ++t) lw_[t] = *(const LAS u32x2*)(ps + n16 * 256 + 16 * t + 4 * c4);
#pragma unroll
            for (int t = 0; t < 16; ++t) {
                const u32x2 w = lw_[t];
                const float e0 = __expf(bflo(w.x) - mx), e1 = __expf(bfhi(w.x) - mx), e2 = __expf(bflo(w.y) - mx), e3 = __expf(bfhi(w.y) - mx);
                sm += (e0 + e1) + (e2 + e3);
                u32x2 o_; o_.x = pk_bf16(e0, e1); o_.y = pk_bf16(e2, e3); *(LAS u32x2*)(ps + n16 * 256 + 16 * t + 4 * c4) = o_;
            }
            sm += __shfl_xor(sm, 16); sm += __shfl_xor(sm, 32);
            if (c4 == 0) invs[n16] = 1.0f / sm;
        }
        wave_lds_fence();
        if (!SAMPLE) {
            const unsigned char* V8 = WSP(unsigned char, WS_V8);
            const int rs = c4, kvh = n16 >> 2, nst = n > 64 ? 64 : n;
            f32x4 oa[4][4];
#pragma unroll
            for (int g = 0; g < 4; ++g)
#pragma unroll
                for (int q = 0; q < 4; ++q) oa[g][q] = (f32x4){0.f, 0.f, 0.f, 0.f};
            u32x4 vr[8], vn[8];
#pragma unroll
            for (int i = 0; i < 8; ++i) vn[i] = *(const u32x4*)(V8 + (size_t)is[64 * rs + i] * 256 + 16 * n16);
            for (int m0 = 0; m0 < nst; m0 += 8) {
#pragma unroll
                for (int i = 0; i < 8; ++i) vr[i] = vn[i];
                if (m0 + 8 < nst) {
#pragma unroll
                    for (int i = 0; i < 8; ++i) vn[i] = *(const u32x4*)(V8 + (size_t)is[64 * rs + m0 + 8 + i] * 256 + 16 * n16);
                }
                __builtin_amdgcn_sched_barrier(0);
#pragma unroll
                for (int h4 = 0; h4 < 2; ++h4) {
                    u32x2 pg[4];
#pragma unroll
                    for (int g = 0; g < 4; ++g) pg[g] = *(const LAS u32x2*)(ps + (kvh * 4 + g) * 256 + 64 * rs + m0 + 4 * h4);
#pragma unroll
                    for (int i = 0; i < 4; ++i) {
                        const u32x4 v_ = vr[4 * h4 + i];
                        const f32x4 v0 = fp8x4_f32(v_.x), v1 = fp8x4_f32(v_.y), v2 = fp8x4_f32(v_.z), v3 = fp8x4_f32(v_.w);
#pragma unroll
                        for (int g = 0; g < 4; ++g) { const unsigned pw = (i < 2) ? pg[g].x : pg[g].y; const float pf = (i & 1) ? bfhi(pw) : bflo(pw);
                            oa[g][0] += pf * v0; oa[g][1] += pf * v1; oa[g][2] += pf * v2; oa[g][3] += pf * v3; }
                    }
                }
            }
#pragma unroll
            for (int g = 0; g < 4; ++g)
#pragma unroll
                for (int q = 0; q < 4; ++q)
#pragma unroll
                    for (int e_ = 0; e_ < 4; ++e_) { float x = oa[g][q][e_]; x += __shfl_xor(x, 16); x += __shfl_xor(x, 32); oa[g][q][e_] = x; }
            if (rs == 0) {
                const f32x4 iv = *(const LAS f32x4*)(invs + 4 * kvh);
#pragma unroll
                for (int g = 0; g < 4; ++g) { bf16_t* op = O + (size_t)row * D + (kvh * 4 + g) * 64 + 16 * (n16 & 3);
                    u32x4 w0, w1; const float sc_ = iv[g];
                    w0.x = pk_bf16(oa[g][0][0] * sc_, oa[g][0][1] * sc_); w0.y = pk_bf16(oa[g][0][2] * sc_, oa[g][0][3] * sc_); w0.z = pk_bf16(oa[g][1][0] * sc_, oa[g][1][1] * sc_); w0.w = pk_bf16(oa[g][1][2] * sc_, oa[g][1][3] * sc_);
                    w1.x = pk_bf16(oa[g][2][0] * sc_, oa[g][2][1] * sc_); w1.y = pk_bf16(oa[g][2][2] * sc_, oa[g][2][3] * sc_); w1.z = pk_bf16(oa[g][3][0] * sc_, oa[g][3][1] * sc_); w1.w = pk_bf16(oa[g][3][2] * sc_, oa[g][3][3] * sc_);
                    *(u32x4*)op = w0; *(u32x4*)(op + 8) = w1; }
            }
        } else {
        f32x4 o0 = {0.f, 0.f, 0.f, 0.f}, o1 = o0, o2 = o0, o3 = o0;
        constexpr int GV = SAMPLE ? 16 : 32;
        const int ng = (n + GV - 1) / GV;
        unsigned vb[SAMPLE ? 1 : GV], vbn[SAMPLE ? 1 : GV]; f32x4 vf[SAMPLE ? GV : 1];
        const unsigned char* V8 = WSP(unsigned char, WS_V8);
        if (!SAMPLE) {
#pragma unroll
            for (int i = 0; i < GV; ++i) vbn[i] = *(const unsigned*)(V8 + (size_t)is[i] * 256 + 4 * lane);
        }
#pragma unroll 1
        for (int g = 0; g < ng; ++g) {
            if (!SAMPLE) {
#pragma unroll
                for (int i = 0; i < GV; ++i) vb[i] = vbn[i];
                if (g + 1 < ng) {
#pragma unroll
                    for (int i = 0; i < GV; ++i) vbn[i] = *(const unsigned*)(V8 + (size_t)is[GV * (g + 1) + i] * 256 + 4 * lane);
                }
                __builtin_amdgcn_sched_barrier(0);
            } else {
#pragma unroll
                for (int i = 0; i < GV; ++i) { const int r = is[GV * g + i]; vf[i] = *(const f32x4*)(((r & 0x40000000) ? vnew + (size_t)(r & 0xffff) * 256 : vc + (size_t)r * 256) + 4 * lane); }
            }
#pragma unroll
            for (int i4 = 0; i4 < GV / 4; ++i4) {
                const u32x2 p0 = *(const LAS u32x2*)(ps + (c4 * 4 + 0) * 256 + GV * g + 4 * i4), p1 = *(const LAS u32x2*)(ps + (c4 * 4 + 1) * 256 + GV * g + 4 * i4),
                            p2 = *(const LAS u32x2*)(ps + (c4 * 4 + 2) * 256 + GV * g + 4 * i4), p3 = *(const LAS u32x2*)(ps + (c4 * 4 + 3) * 256 + GV * g + 4 * i4);
                f32x4 v0, v1, v2, v3;
                if (!SAMPLE) { v0 = fp8x4_f32(vb[4 * i4]); v1 = fp8x4_f32(vb[4 * i4 + 1]); v2 = fp8x4_f32(vb[4 * i4 + 2]); v3 = fp8x4_f32(vb[4 * i4 + 3]); }
                else { v0 = vf[4 * i4]; v1 = vf[4 * i4 + 1]; v2 = vf[4 * i4 + 2]; v3 = vf[4 * i4 + 3]; }
                o0 += bflo(p0.x) * v0 + bfhi(p0.x) * v1 + bflo(p0.y) * v2 + bfhi(p0.y) * v3;
                o1 += bflo(p1.x) * v0 + bfhi(p1.x) * v1 + bflo(p1.y) * v2 + bfhi(p1.y) * v3;
                o2 += bflo(p2.x) * v0 + bfhi(p2.x) * v1 + bflo(p2.y) * v2 + bfhi(p2.y) * v3;
                o3 += bflo(p3.x) * v0 + bfhi(p3.x) * v1 + bflo(p3.y) * v2 + bfhi(p3.y) * v3;
            }
        }
        { const f32x4 iv = *(const LAS f32x4*)(invs + 4 * c4); bf16_t* op = O + (size_t)row * D + c4 * 256 + 4 * n16; st_bf4(op, o0 * iv[0]); st_bf4(op + 64, o1 * iv[1]); st_bf4(op + 128, o2 * iv[2]); st_bf4(op + 192, o3 * iv[3]); }
        }
    }
}

__global__ void __launch_bounds__(512, 2) mega(P p_unused) {
    extern __shared__ __attribute__((aligned(16))) unsigned char lds_raw[];
    LAS unsigned char* lds = (LAS unsigned char*)lds_raw;
    volatile LAS unsigned* misc = (volatile LAS unsigned*)(lds + LDS_MISC);
    if (TID() < 4) misc[TID()] = 0u;
    __syncthreads();
    KP p = kargs();
    const bool multi = (p->ph_hi - p->ph_lo) > 1;
    XcdBarrier bar; bar.bar = WSP(unsigned, WS_BAR); bar.x = 0; bar.st = misc;
    if (multi) bar = xcd_barrier_post(WSP(unsigned, WS_BAR), misc);
    int ph = 0;
    const int lo = p->ph_lo, hi = p->ph_hi;
#ifndef REPMASK
#define REPMASK 0ull
#endif
#define PH_BEGIN if (ph >= lo && ph < hi) { KP p = kargs(); const int nrep_ = ((REPMASK >> ph) & 1ull) ? 3 : 1; for (int rep_ = 0; rep_ < nrep_; ++rep_) {
#define PH_END   if (ph + 1 < hi || rep_ + 1 < nrep_) xcd_barrier(bar); } } ++ph;

    PH_BEGIN phase_ada(p, lds); phase_weights(p, lds); PH_END

    for (int layer = 0; layer < 4; ++layer) {
        const int j = layer >> 1;
        if ((layer & 1) == 0) {
            PH_BEGIN phase_prep<true>(p, layer, 0, j, layer == 0); PH_END
            PH_BEGIN {
                FRwkvIn f{WSP(bf16_t, WS_RB), WSP(bf16_t, WS_KB), WSP(bf16_t, WS_VB), WSP(bf16_t, WS_TW), WSP(bf16_t, WS_TA), WSP(bf16_t, WS_TV), WSP(bf16_t, WS_TG)};
                pg8::Gemm g{WSP(bf16_t, WS_XR), WSP(bf16_t, WS_WRW_T) + (size_t)j * 4096 * D, NP, j == 0 ? 3840 : 4096, D, j == 0 ? 2 : 1, XR_STRIDE};
                pg8::StaticOrder S; S.init(NP, g.N, (int)gridDim.x, BID());
                pg8::EpiAdapt<FRwkvIn, true> E{f};
                pg8::gemm_phase(lds, g, S, E);
                wgemm_ks<true>(lds, WSP(bf16_t, WS_XR), D, XR_STRIDE, NP, NS, WSP(bf16_t, WS_WRW_T) + (size_t)j * 4096 * D, D, 4096, f);
            } PH_END
            PH_BEGIN {
                FStoreF32 fw{WSP(float, WS_WP), D, D}, fa{WSP(float, WS_AP), D, D}, fv{WSP(float, WS_VP), D, D}, fg{WSP(float, WS_GG), D, D};
                wgemm_w(WSP(bf16_t, WS_TW), 64, NP, NS, WSP(bf16_t, WS_W2T) + (size_t)j * D * 64, 64, D, fw);
                wgemm_w(WSP(bf16_t, WS_TA), 64, NP, NS, WSP(bf16_t, WS_A2T) + (size_t)j * D * 64, 64, D, fa);
                if (j == 1) wgemm_w(WSP(bf16_t, WS_TV), 32, NP, NS, WSP(bf16_t, WS_V2T), 32, D, fv);
                wgemm_w(WSP(bf16_t, WS_TG), 160, NP, NS, WSP(bf16_t, WS_G2T) + (size_t)j * D * 160, 160, D, fg);
                phase_chunk(p, j, lds);
            } PH_END
            PH_BEGIN phase_carry(p, j, lds); PH_END
            PH_BEGIN phase_post2(p, j, lds); PH_END
        } else {
            PH_BEGIN phase_prep<false>(p, layer, 0, j); PH_END
            PH_BEGIN {
                FStoreBf16 f{WSP(bf16_t, WS_PR), PINP, PINP};
                pg8::Gemm g{WSP(bf16_t, WS_XR), WSP(bf16_t, WS_WIN_T) + (size_t)j * PINP * D, NP, PINP, D, 0, 0};
                pg8::StaticOrder S; S.init(NP, PINP, (int)gridDim.x, BID());
                pg8::EpiAdapt<FStoreBf16, true> E{f};
                pg8::gemm_phase(lds, g, S, E);
                FStoreBf16 fs{WSP(bf16_t, WS_PR), PINP, PIN};
                wgemm_ks<false>(lds, WSP(bf16_t, WS_XR), D, 0, NP, NS, WSP(bf16_t, WS_WIN_T) + (size_t)j * PINP * D, D, PINP, fs);
            } PH_END
            PH_BEGIN phase_dsapost(p, j); PH_END
            PH_BEGIN phase_idx2<false>(p, j); phase_idx2<true>(p, j); PH_END
            PH_BEGIN phase_topk_prompt(p); phase_topk_sample(p, lds); PH_END
            PH_BEGIN phase_attn<true>(p, j, lds); phase_attn<false>(p, j, lds); PH_END
        }
        PH_BEGIN {
            FResid f{p->out, WSP(float, WS_MODS) + (size_t)layer * 36 * 6144 + 2 * D, layer == 0 ? p->x_prompt : nullptr, layer == 0 ? p->x_sample : nullptr};
            const bf16_t* Wt = ((layer & 1) == 0 ? WSP(bf16_t, WS_WO_T) : WSP(bf16_t, WS_WAO_T)) + (size_t)j * D * D;
            pg8::Gemm g{WSP(bf16_t, WS_YG), Wt, NP, D, D, 0, 0};
            pg8::StaticOrder S; S.init(NP, D, (int)gridDim.x, BID());
            pg8::EpiAdapt<FResid, false> E{f};
            pg8::gemm_phase(lds, g, S, E);
            wgemm_ks<false>(lds, WSP(bf16_t, WS_YG), D, 0, NP, NS, Wt, D, D, f);
        } PH_END
        PH_BEGIN phase_prep<false>(p, layer, 1, j); PH_END
        PH_BEGIN {
            FRelu2 f{WSP(bf16_t, WS_U)};
            pg8::Gemm g{WSP(bf16_t, WS_XR), WSP(bf16_t, WS_WUP_T) + (size_t)layer * DFF * D, NP, DFF, D, 0, 0};
            pg8::StaticOrder S; S.init(NP, DFF, (int)gridDim.x, BID());
            pg8::EpiAdapt<FRelu2, true> E{f};
            pg8::gemm_phase(lds, g, S, E);
            wgemm_ks<false>(lds, WSP(bf16_t, WS_XR), D, 0, NP, NS, WSP(bf16_t, WS_WUP_T) + (size_t)layer * DFF * D, D, DFF, f);
        } PH_END
        PH_BEGIN {
            FResid f{p->out, WSP(float, WS_MODS) + (size_t)layer * 36 * 6144 + 5 * D, nullptr, nullptr};
            pg8::Gemm g{WSP(bf16_t, WS_U), WSP(bf16_t, WS_WDN_T) + (size_t)layer * DFF * D, NP, D, DFF, 0, 0};
            pg8::StaticOrder S; S.init(NP, D, (int)gridDim.x, BID());
            pg8::EpiAdapt<FResid, false> E{f};
            pg8::gemm_phase(lds, g, S, E);
            wgemm_ks<false>(lds, WSP(bf16_t, WS_U), DFF, 0, NP, NS, WSP(bf16_t, WS_WDN_T) + (size_t)layer * DFF * D, DFF, D, f);
        } PH_END
    }
#undef PH_BEGIN
#undef PH_END
}

static int count_phases() { int n = 1; for (int layer = 0; layer < 4; ++layer) { n += ((layer & 1) == 0) ? 5 : 6; n += 4; } return n; }

extern "C" void kernel_launch(void* const* d_in, const int* in_sizes, int n_in, void* d_out, int out_size, void* d_ws, size_t ws_size, hipStream_t stream) {
    static int grid = 0;
    if (grid == 0) {
        if (n_in != 39 || out_size != (int)O_END || ws_size < WS_END) { fprintf(stderr, "kernel_launch: unexpected shapes n_in %d out %d ws %zu (need %zu)\n", n_in, out_size, ws_size, (size_t)WS_END); grid = -1; return; }
        int dev = 0, cus = 0, per_cu = 0;
        if (hipGetDevice(&dev) != hipSuccess || hipDeviceGetAttribute(&cus, hipDeviceAttributeMultiprocessorCount, dev) != hipSuccess) { grid = -1; return; }
        if (hipFuncSetAttribute((const void*)mega, hipFuncAttributeMaxDynamicSharedMemorySize, LDS_BYTES) != hipSuccess) { fprintf(stderr, "kernel_launch: hipFuncSetAttribute failed\n"); grid = -1; return; }
        if (hipOccupancyMaxActiveBlocksPerMultiprocessor(&per_cu, (const void*)mega, 512, LDS_BYTES) != hipSuccess || per_cu < 1) fprintf(stderr, "kernel_launch: occupancy query says %d\n", per_cu);
        (void)hipGetLastError();
        grid = cus;
    }
    if (grid < 0) return;
    (void)hipMemsetAsync((char*)d_ws + WS_BAR, 0, 65536, stream);
    P p{};
    memcpy((void*)&p, (const void*)d_in, 39 * sizeof(void*));
    p.out = (float*)d_out; p.ws = (unsigned char*)d_ws;
#ifndef STOP_PH
#define STOP_PH 1000
#endif
    const int nph = count_phases() < STOP_PH ? count_phases() : STOP_PH;
#ifndef ONE_LAUNCH
    for (int ph = 0; ph < nph; ++ph) { p.ph_lo = ph; p.ph_hi = ph + 1; hipLaunchKernelGGL(mega, dim3(grid), dim3(512), LDS_BYTES, stream, p); }
#else
    p.ph_lo = 0; p.ph_hi = nph; hipLaunchKernelGGL(mega, dim3(grid), dim3(512), LDS_BYTES, stream, p);
#endif
}
```

```cpp
#define ONE_LAUNCH 1
#include <hip/hip_runtime.h>
#include <cstdio>
#include <cstdint>
#include <cstring>

#define LAS __attribute__((address_space(3)))
typedef unsigned short bf16_t;
typedef short bf16x8 __attribute__((ext_vector_type(8)));
typedef float f32x4 __attribute__((ext_vector_type(4)));
typedef float f32x2 __attribute__((ext_vector_type(2)));
typedef unsigned u32x4 __attribute__((ext_vector_type(4)));
typedef unsigned u32x2 __attribute__((ext_vector_type(2)));

constexpr int D = 1024, NP = 16384, NS = 256, NT = NP + NS, SEQL = 4096, PAST = 8192, NSEQ = 36, DFF = 4096;
constexpr int PIN = 2120, PINP = 2304;
constexpr int TOPK = 256, SCS_LD = 8320;
constexpr size_t O_YP = 0, O_YS = 16777216, O_KP = 17039360, O_VP = 25427968, O_IKP = 33816576, O_WKVP = 35913728, O_SHP = 36438016,
                 O_KS = 36446208, O_VS = 36577280, O_IKS = 36708352, O_WKVS = 36741120, O_SHS = 40935424, O_END = 41000960;
constexpr size_t al256(size_t x) { return (x + 255) & ~(size_t)255; }
constexpr size_t WS_BAR = 0;
constexpr size_t WS_MODS = 65536;
constexpr size_t WS_WUP_T = al256(WS_MODS + (size_t)4 * NSEQ * 6144 * 4);
constexpr size_t WS_WDN_T = WS_WUP_T + (size_t)4 * DFF * D * 2;
constexpr size_t WS_WRW_T = WS_WDN_T + (size_t)4 * DFF * D * 2;
constexpr size_t WS_WO_T = WS_WRW_T + (size_t)2 * 4096 * D * 2;
constexpr size_t WS_WIN_T = WS_WO_T + (size_t)2 * D * D * 2;
constexpr size_t WS_WAO_T = WS_WIN_T + (size_t)2 * PINP * D * 2;
constexpr size_t WS_W2T = WS_WAO_T + (size_t)2 * D * D * 2;
constexpr size_t WS_A2T = WS_W2T + (size_t)2 * D * 64 * 2;
constexpr size_t WS_V2T = WS_A2T + (size_t)2 * D * 64 * 2;
constexpr size_t WS_G2T = WS_V2T + (size_t)D * 32 * 2;
constexpr size_t WS_XR = WS_G2T + (size_t)2 * D * 160 * 2;
constexpr size_t XR_STRIDE = (size_t)NT * D;
constexpr size_t WS_RB = WS_XR + 6 * XR_STRIDE * 2;
constexpr size_t WS_KB = WS_RB + XR_STRIDE * 2;
constexpr size_t WS_VB = WS_KB + XR_STRIDE * 2;
constexpr size_t WS_TW = WS_VB + XR_STRIDE * 2;
constexpr size_t WS_TA = WS_TW + (size_t)NT * 64 * 2;
constexpr size_t WS_TV = WS_TA + (size_t)NT * 64 * 2;
constexpr size_t WS_TG = WS_TV + (size_t)NT * 32 * 2;
constexpr size_t WS_WP = al256(WS_TG + (size_t)NT * 160 * 2);
constexpr size_t F32A = (size_t)NT * D * 4;
constexpr size_t WS_AP = WS_WP + F32A, WS_VP = WS_AP + F32A, WS_GG = WS_VP + F32A, WS_VFIRST = WS_GG + F32A;
constexpr size_t WS_DEC = WS_VFIRST + F32A, WS_KM = WS_DEC + F32A, WS_VM = WS_KM + F32A, WS_AV = WS_VM + F32A, WS_BV = WS_AV + F32A, WS_Y = WS_BV + F32A;
constexpr size_t WS_YG = WS_Y + F32A;
constexpr size_t WS_U = WS_YG + XR_STRIDE * 2;
constexpr size_t WS_PR = WS_U + (size_t)NT * DFF * 2;
constexpr size_t WS_Q = WS_PR + (size_t)NT * PINP * 4;
constexpr size_t WS_QI = WS_Q + F32A;
constexpr size_t WS_WI = WS_QI + (size_t)NT * 512 * 4;
constexpr size_t WS_SC = al256(WS_WI + (size_t)NT * 8 * 4);
constexpr size_t WS_SCS = WS_SC + (size_t)4 * 4096 * 4096 * 4;
constexpr size_t WS_SEL = al256(WS_SCS + (size_t)NS * SCS_LD * 4);
constexpr size_t WS_CNT = WS_SEL + (size_t)NT * 256 * 4;
constexpr size_t WS_KBF = al256(WS_CNT + (size_t)NT * 4);
constexpr size_t WS_VBF = WS_KBF + (size_t)NT * 256 * 2;
constexpr size_t WS_QIB = WS_VBF + (size_t)NT * 256 * 2;
constexpr size_t WS_KIB = WS_QIB + (size_t)NT * 512 * 2;
constexpr size_t WS_K8 = al256(WS_KIB + (size_t)NT * 64 * 2);
constexpr size_t WS_V8 = WS_K8 + (size_t)NT * 256;
constexpr size_t WS_END = al256(WS_V8 + (size_t)NT * 256);

constexpr int LCH = 64, NCH = SEQL / LCH;
constexpr size_t WS_PCH = WS_SC, WS_CCH = WS_PCH + (size_t)64 * NCH * 4096 * 4, WS_SST = WS_CCH + (size_t)64 * NCH * 4096 * 4;
static_assert(WS_SST + (size_t)64 * NCH * 4096 * 4 <= WS_SCS, "scan buffers must fit the aliased region");
constexpr int LDS_BYTES = 147456;
constexpr int LDS_MISC = 131072;

typedef __bf16 bf16x2_t __attribute__((ext_vector_type(2)));
__device__ __forceinline__ unsigned pk_bf16(float lo, float hi) { const f32x2 v = {lo, hi}; const bf16x2_t b = __builtin_convertvector(v, bf16x2_t); return __builtin_bit_cast(unsigned, b); }
__device__ __forceinline__ unsigned pk_fp8x4(f32x4 v) { int w = 0; w = __builtin_amdgcn_cvt_pk_fp8_f32(v[0], v[1], w, false); w = __builtin_amdgcn_cvt_pk_fp8_f32(v[2], v[3], w, true); return (unsigned)w; }
__device__ __forceinline__ f32x4 fp8x4_f32(unsigned w) { return (f32x4){__builtin_amdgcn_cvt_f32_fp8((int)w, 0), __builtin_amdgcn_cvt_f32_fp8((int)w, 1), __builtin_amdgcn_cvt_f32_fp8((int)w, 2), __builtin_amdgcn_cvt_f32_fp8((int)w, 3)}; }
__device__ __forceinline__ float bf2f(unsigned short x) { return __uint_as_float((unsigned)x << 16); }
__device__ __forceinline__ float bflo(unsigned x) { return __uint_as_float(x << 16); }
__device__ __forceinline__ float bfhi(unsigned x) { return __uint_as_float(x & 0xffff0000u); }
__device__ __forceinline__ f32x4 ld_bf4(const bf16_t* p) { const u32x2 v = *(const u32x2*)p; return (f32x4){bflo(v.x), bfhi(v.x), bflo(v.y), bfhi(v.y)}; }
__device__ __forceinline__ void st_bf4(bf16_t* p, f32x4 v) { u32x2 w; w.x = pk_bf16(v[0], v[1]); w.y = pk_bf16(v[2], v[3]); *(u32x2*)p = w; }
template <int CTRL> __device__ __forceinline__ float dppf(float v) { return __int_as_float(__builtin_amdgcn_update_dpp(0, __float_as_int(v), CTRL, 0xf, 0xf, false)); }
template <int CTRL> __device__ __forceinline__ int dppi(int v) { return __builtin_amdgcn_update_dpp(0, v, CTRL, 0xf, 0xf, false); }
__device__ __forceinline__ float g16_sum(float v) { v += dppf<0xB1>(v); v += dppf<0x4E>(v); v += dppf<0x141>(v); v += dppf<0x140>(v); return v; }
__device__ __forceinline__ float g16_max(float v) { v = fmaxf(v, dppf<0xB1>(v)); v = fmaxf(v, dppf<0x4E>(v)); v = fmaxf(v, dppf<0x141>(v)); v = fmaxf(v, dppf<0x140>(v)); return v; }
__device__ __forceinline__ int g16_sum_i(int v) { v += dppi<0xB1>(v); v += dppi<0x4E>(v); v += dppi<0x141>(v); v += dppi<0x140>(v); return v; }
__device__ __forceinline__ int g16_min_i(int v) { v = min(v, dppi<0xB1>(v)); v = min(v, dppi<0x4E>(v)); v = min(v, dppi<0x141>(v)); v = min(v, dppi<0x140>(v)); return v; }
__device__ __forceinline__ float rlf(float v, int k) { return __int_as_float(__builtin_amdgcn_readlane(__float_as_int(v), k)); }
__device__ __forceinline__ float wave_sum(float v) { v = g16_sum(v); return (rlf(v, 0) + rlf(v, 16)) + (rlf(v, 32) + rlf(v, 48)); }
__device__ __forceinline__ float wave_max(float v) { v = g16_max(v); return fmaxf(fmaxf(rlf(v, 0), rlf(v, 16)), fmaxf(rlf(v, 32), rlf(v, 48))); }
__device__ __forceinline__ int wave_sum_i(int v) { v = g16_sum_i(v); return (__builtin_amdgcn_readlane(v, 0) + __builtin_amdgcn_readlane(v, 16)) + (__builtin_amdgcn_readlane(v, 32) + __builtin_amdgcn_readlane(v, 48)); }
__device__ __forceinline__ int wave_min_i(int v) { v = g16_min_i(v); return min(min(__builtin_amdgcn_readlane(v, 0), __builtin_amdgcn_readlane(v, 16)), min(__builtin_amdgcn_readlane(v, 32), __builtin_amdgcn_readlane(v, 48))); }
__device__ __forceinline__ float sigmoidf_(float x) { return 1.0f / (1.0f + expf(-x)); }
__device__ __forceinline__ float fsig(float x) { return __builtin_amdgcn_rcpf(1.0f + __expf(-x)); }
__device__ __forceinline__ float ftanh(float x) { return 2.0f * fsig(2.0f * x) - 1.0f; }
__device__ __forceinline__ int row_seq(int row) { return row < NP ? (row >> 12) : 4 + ((row - NP) >> 3); }
__device__ __forceinline__ int row_pos(int row) { return row < NP ? (row & 4095) : PAST + ((row - NP) & 7); }
__device__ __forceinline__ int TID() { int t = threadIdx.x; asm volatile("" : "+v"(t)); return t; }
__device__ __forceinline__ int BID() { int b = blockIdx.x; asm volatile("" : "+s"(b)); return b; }
__device__ __forceinline__ void wave_lds_fence() { __builtin_amdgcn_fence(__ATOMIC_RELEASE, "wavefront"); __builtin_amdgcn_wave_barrier(); __builtin_amdgcn_fence(__ATOMIC_ACQUIRE, "wavefront"); }

#define XB_TMO      128
#define XB_XCNT(j)  (256  + 64 * (j))
#define XB_XSUB(j)  (1280 + 64 * (j))
#define XB_XGEN(j)  (2304 + 64 * (j))
#define XB_TOP      3328
#define XB_TOPGEN   3392
#define XCD_BAR_WORDS 3456
#define XB_SPIN_CAP (1u << 22)
__device__ __forceinline__ unsigned xb_ld(unsigned* p)              { return __hip_atomic_load(p, __ATOMIC_RELAXED, __HIP_MEMORY_SCOPE_AGENT); }
__device__ __forceinline__ unsigned xb_add(unsigned* p, unsigned v) { return __hip_atomic_fetch_add(p, v, __ATOMIC_RELAXED, __HIP_MEMORY_SCOPE_AGENT); }
__device__ __forceinline__ unsigned xb_xcc_id() { return (unsigned)__builtin_amdgcn_s_getreg((3 << 11) | 20) & 0xFu; }
#define XB_SPIN(cond, bar) do { unsigned _sp = 0; while (cond) { __builtin_amdgcn_s_sleep(1); \
    if ((++_sp & 255u) == 0u) { if (xb_ld(&(bar)[XB_TMO])) break; if (_sp > XB_SPIN_CAP) { atomicAdd(&(bar)[XB_TMO], 1u); break; } } } } while (0)
struct XcdBarrier { unsigned* bar; unsigned x; volatile LAS unsigned* st; };
__device__ __forceinline__ XcdBarrier xcd_barrier_post(unsigned* bar, volatile LAS unsigned* st) {
    XcdBarrier b; b.bar = bar; b.x = xb_xcc_id(); b.st = st;
    if (threadIdx.x == 0) (void)xb_add(&bar[XB_XCNT(b.x)], 1u);
    return b;
}
__device__ __forceinline__ void xcd_barrier_complete(unsigned* bar, unsigned x, unsigned& nloc, unsigned& nx) {
    const unsigned G = gridDim.x * gridDim.y * gridDim.z;
    unsigned sum, cnt, mine, sp = 0u;
    for (;;) {
        sum = 0u; cnt = 0u; mine = 0u;
#pragma unroll
        for (unsigned j = 0; j < 16; ++j) { const unsigned c = xb_ld(&bar[XB_XCNT(j)]); sum += c; cnt += (c > 0u) ? 1u : 0u; mine = (j == x) ? c : mine; }
        if (sum == G) break;
        __builtin_amdgcn_s_sleep(1);
        if ((++sp & 255u) == 0u) { if (xb_ld(&bar[XB_TMO])) break; if (sp > XB_SPIN_CAP) { atomicAdd(&bar[XB_TMO], 1u); break; } }
    }
    nloc = mine > 0u ? mine : 1u; nx = cnt > 0u ? cnt : 1u;
}
__device__ __forceinline__ void xcd_barrier(const XcdBarrier& b) {
    asm volatile("s_waitcnt vmcnt(0)" ::: "memory");
    __syncthreads();
    if (threadIdx.x == 0) {
        unsigned* bar = b.bar;
        __builtin_amdgcn_s_waitcnt(0);
        unsigned nloc = b.st[0], nx = b.st[1];
        if (nloc == 0u) { xcd_barrier_complete(bar, b.x, nloc, nx); b.st[0] = nloc; b.st[1] = nx; }
        const unsigned old = xb_add(&bar[XB_XSUB(b.x)], 1u);
        const unsigned gen = old / nloc;
        if (old + 1u == (gen + 1u) * nloc) {
            __builtin_amdgcn_fence(__ATOMIC_RELEASE, "agent");
            asm volatile("s_waitcnt vmcnt(0)" ::: "memory");
            const unsigned og = xb_add(&bar[XB_TOP], 1u);
            const unsigned tg = og / nx;
            if (og + 1u == (tg + 1u) * nx) xb_add(&bar[XB_TOPGEN], 1u);
            else XB_SPIN(xb_ld(&bar[XB_TOPGEN]) == tg, bar);
            __builtin_amdgcn_fence(__ATOMIC_ACQUIRE, "agent");
            xb_add(&bar[XB_XGEN(b.x)], 1u);
            asm volatile("s_waitcnt vmcnt(0)" ::: "memory");
        } else {
            XB_SPIN(xb_ld(&bar[XB_XGEN(b.x)]) == gen, bar);
            __builtin_amdgcn_fence(__ATOMIC_ACQUIRE, "agent");
            asm volatile("s_waitcnt vmcnt(0)" ::: "memory");
        }
    }
    __syncthreads();
}

struct P {
    const float *x_prompt, *x_sample, *cache_k, *cache_v, *cache_ik, *state_wkv, *state_shift; const int* page_table;
    const float *c_prompt, *c_sample, *norm_g, *w_ada, *b_ada, *w_up, *w_down, *rw_mix, *rw_w_rkv, *rw_w_o, *rw_w0, *rw_w1, *rw_w2, *rw_a0, *rw_a1, *rw_a2,
                *rw_v0, *rw_v1, *rw_v2, *rw_g1, *rw_g2, *rw_k_k, *rw_k_a, *rw_r_k, *rw_lnx_w, *rw_lnx_b, *att_w_in, *att_w_o, *att_q_norm, *att_k_norm, *idx_k_norm;
    float* out; unsigned char* ws; int ph_lo, ph_hi;
};
typedef const P __attribute__((address_space(4)))* KP;
#define WSP(T, off) ((T*)(p->ws + (off)))
__device__ __forceinline__ KP kargs() { KP k = (KP)__builtin_amdgcn_kernarg_segment_ptr(); asm volatile("" : "+s"(k)); return k; }

namespace pg8 {
constexpr int BM = 256, BK = 64, HALF = 128, HTB = HALF * BK * 2, STAGE_BYTES = 8 * HTB, NXCD = 8, WGM = 8;
__device__ __forceinline__ int lds_byte(int r, int c) { const int st = (r >> 4) * 2 + (c >> 5), rr = r & 15, cc = c & 31, ob = rr * 64 + cc * 2; return st * 1024 + (ob ^ (((ob >> 9) & 1) << 5)); }
__device__ __forceinline__ void stage_rc(int b, int& R, int& C) { const int st = b / 1024, sb = b % 1024, swz = sb ^ (((sb >> 9) & 1) << 5); R = (st >> 1) * 16 + swz / 64; C = (st & 1) * 32 + (swz % 64) / 2; }
__device__ __forceinline__ int perm32(int rho) { const int n = rho >> 4, i = rho & 15; return 8 * (i >> 2) + 4 * n + (i & 3); }
struct Unit { int pm, pn; };
struct Gemm { const bf16_t* A; const bf16_t* Bt; int M, N, K, mode; size_t agrp; };
__device__ __forceinline__ int phys_pn(const Gemm& g, int pn) { return (g.mode == 2 && pn >= 12) ? pn + 1 : pn; }
__device__ __forceinline__ const char* a_ptr(const Gemm& g, const Unit& u, size_t tstep) {
    int grp = 0; if (g.mode) grp = u.pn < 12 ? (u.pn >> 2) : (u.pn == 12 ? 2 : u.pn - 10);
    return (const char*)g.A + (size_t)grp * g.agrp * 2 + (size_t)u.pm * tstep; }
struct StaticOrder {
    int nM, nN, nwg, G, c;
    __device__ void init(int M, int N, int G_, int c_) { nM = M / BM; nN = N / BM; nwg = nM * nN; G = G_; c = c_; }
    __device__ bool next(int i, Unit& u) const {
        const long L = (long)i * G + c; if (L >= nwg) return false;
        int wgid = (int)L; { const int q = nwg / NXCD, r = nwg % NXCD, xcd = wgid % NXCD, off = wgid / NXCD; wgid = (xcd < r ? xcd * (q + 1) : r * (q + 1) + (xcd - r) * q) + off; }
        const int nig = WGM * nN, gid = wgid / nig, fm = gid * WGM, gsz = (nM - fm) < WGM ? (nM - fm) : WGM;
        u.pm = fm + ((wgid % nig) % gsz); u.pn = (wgid % nig) / gsz; return true;
    }
};
template <class F, bool PERM_> struct EpiAdapt {
    static constexpr bool PERM = PERM_;
    F f;
    __device__ __forceinline__ void operator()(const f32x4 (&acc)[2][2][4][2], const Unit& u, int wr, int wc, int fr, int fq) const {
        const int row0 = u.pm * BM + wr * 64 + fr, col0 = u.pn * BM + wc * 32 + (PERM ? 8 * fq : 4 * fq);
#pragma unroll
        for (int ai = 0; ai < 2; ++ai)
#pragma unroll
            for (int m = 0; m < 4; ++m)
#pragma unroll
                for (int bj = 0; bj < 2; ++bj) {
                    if constexpr (PERM) f.vec8(row0 + ai * HALF + m * 16, col0 + bj * HALF, acc[ai][bj][m][0], acc[ai][bj][m][1]);
                    else {
#pragma unroll
                        for (int n = 0; n < 2; ++n) f.vec4(row0 + ai * HALF + m * 16, col0 + bj * HALF + 16 * n, acc[ai][bj][m][n]);
                    }
                }
    }
};

template <class Epi>
__device__ __forceinline__ void gemm_phase(LAS unsigned char* lds, const Gemm g, const StaticOrder& S, const Epi& E) {
    const int tid = TID(), wid = __builtin_amdgcn_readfirstlane(tid >> 6), lane = tid & 63, wr = wid >> 2, wc = wid & 3, fr = lane & 15, fq = lane >> 4;
    const int K = g.K, nt = K / BK;
    unsigned voffA[2], voffB[2];
#pragma unroll
    for (int i = 0; i < 2; ++i) { int R, C; stage_rc(tid * 16 + i * 8192, R, C); const int Rb = Epi::PERM ? ((R & ~31) + perm32(R & 31)) : R;
        voffA[i] = (unsigned)(R * K + C) * 2u; voffB[i] = (unsigned)(Rb * K + C) * 2u; }
    const size_t kstep = (size_t)(BK * 2);
    const size_t hstep = (size_t)HALF * K * 2;
    const size_t tstep = 2 * hstep;
    const unsigned ldsw = (unsigned)wid * 1024u;
    const int aoff = lds_byte(wr * 64 + fr, fq * 8), boff = lds_byte(wc * 32 + fr, fq * 8);
#define PG8_SA(b, h) (((b) * 2 + (h)) * HTB)
#define PG8_SB(b, h) ((4 + (b) * 2 + (h)) * HTB)
#define PG8_STAGE(bufoff, gbase, voff) do { _Pragma("unroll") for (int _i = 0; _i < 2; ++_i) \
        __builtin_amdgcn_global_load_lds((const unsigned*)((const char*)(gbase) + (voff)[_i]), (LAS unsigned*)(lds + (bufoff) + ldsw + _i * 8192), 16, 0, 0); } while (0)
#define PG8_LDA(dst, b, h) do { _Pragma("unroll") for (int m = 0; m < 4; ++m) _Pragma("unroll") for (int k = 0; k < 2; ++k) dst[m][k] = *(const LAS bf16x8*)(lds + PG8_SA(b, h) + aoff + m * 2048 + k * 1024); } while (0)
#define PG8_LDB(dst, b, h) do { _Pragma("unroll") for (int n = 0; n < 2; ++n) _Pragma("unroll") for (int k = 0; k < 2; ++k) dst[n][k] = *(const LAS bf16x8*)(lds + PG8_SB(b, h) + boff + n * 2048 + k * 1024); } while (0)
#define PG8_MMA(ai, bj, At, Bt) do { __builtin_amdgcn_s_setprio(1); _Pragma("unroll") for (int m = 0; m < 4; ++m) _Pragma("unroll") for (int n = 0; n < 2; ++n) _Pragma("unroll") for (int k = 0; k < 2; ++k) \
        acc[ai][bj][m][n] = __builtin_amdgcn_mfma_f32_16x16x32_bf16(Bt[n][k], At[m][k], acc[ai][bj][m][n], 0, 0, 0); __builtin_amdgcn_s_setprio(0); } while (0)
#define PG8_WAIT_V(n) asm volatile("s_waitcnt vmcnt(" #n ")" ::: "memory")
#define PG8_WAIT_L(n) asm volatile("s_waitcnt lgkmcnt(" #n ")" ::: "memory")
#define PG8_BAR __builtin_amdgcn_s_barrier()
#define PG8_SCHED __builtin_amdgcn_sched_barrier(0)
    Unit cur, nxt; int ui = 0;
    if (!S.next(0, cur)) return;
    cur.pn = phys_pn(g, cur.pn);
    f32x4 acc[2][2][4][2];
#pragma unroll
    for (int a = 0; a < 2; ++a)
#pragma unroll
        for (int b = 0; b < 2; ++b)
#pragma unroll
            for (int m = 0; m < 4; ++m)
#pragma unroll
                for (int n = 0; n < 2; ++n) acc[a][b][m][n] = (f32x4){0.f, 0.f, 0.f, 0.f};
    bf16x8 At[4][2], B0[2][2], B1[2][2];
    const char* cA = a_ptr(g, cur, tstep); const char* cB = (const char*)g.Bt + (size_t)cur.pn * tstep;
    PG8_STAGE(PG8_SB(0, 0), cB, voffB); PG8_STAGE(PG8_SA(0, 0), cA, voffA); PG8_STAGE(PG8_SB(0, 1), cB + hstep, voffB); PG8_STAGE(PG8_SA(0, 1), cA + hstep, voffA);
    if (wr == 1) PG8_BAR;
    PG8_WAIT_V(4); PG8_BAR;
    PG8_STAGE(PG8_SB(1, 0), cB + kstep, voffB); PG8_STAGE(PG8_SA(1, 0), cA + kstep, voffA); PG8_STAGE(PG8_SB(1, 1), cB + hstep + kstep, voffB);
    PG8_WAIT_V(6); PG8_BAR;
    for (;;) {
        const bool has_next = S.next(ui + 1, nxt);
        if (has_next) nxt.pn = phys_pn(g, nxt.pn);
        const char* nA = has_next ? a_ptr(g, nxt, tstep) : cA; const char* nB = has_next ? (const char*)g.Bt + (size_t)nxt.pn * tstep : cB;
        for (int t = 0; t < nt; t += 2) {
            const bool last = (t == nt - 2);
            const char* a1 = cA + (size_t)(t + 1) * kstep;
            const char* a2 = last ? nA : cA + (size_t)(t + 2) * kstep; const char* b2 = last ? nB : cB + (size_t)(t + 2) * kstep;
            const char* a3 = a2 + kstep; const char* b3 = b2 + kstep;
            PG8_LDB(B0, 0, 0); PG8_SCHED; PG8_LDA(At, 0, 0); PG8_STAGE(PG8_SA(1, 1), a1 + hstep, voffA);
            PG8_WAIT_L(8); PG8_BAR; PG8_WAIT_L(0); PG8_MMA(0, 0, At, B0); PG8_BAR; PG8_SCHED;
            PG8_LDB(B1, 0, 1); PG8_STAGE(PG8_SB(0, 0), b2, voffB);
            PG8_BAR; PG8_WAIT_L(0); PG8_MMA(0, 1, At, B1); PG8_BAR;
            PG8_LDA(At, 0, 1); PG8_STAGE(PG8_SA(0, 0), a2, voffA);
            PG8_BAR; PG8_WAIT_L(0); PG8_MMA(1, 0, At, B0); PG8_BAR; PG8_SCHED;
            PG8_STAGE(PG8_SB(0, 1), b2 + hstep, voffB);
            PG8_WAIT_V(6); PG8_BAR; PG8_MMA(1, 1, At, B1); PG8_BAR;
            PG8_LDB(B0, 1, 0); PG8_SCHED; PG8_LDA(At, 1, 0); PG8_STAGE(PG8_SA(0, 1), a2 + hstep, voffA);
            PG8_WAIT_L(8); PG8_BAR; PG8_WAIT_L(0); PG8_MMA(0, 0, At, B0); PG8_BAR; PG8_SCHED;
            PG8_LDB(B1, 1, 1); PG8_STAGE(PG8_SB(1, 0), b3, voffB);
            PG8_BAR; PG8_WAIT_L(0); PG8_MMA(0, 1, At, B1); PG8_BAR;
            PG8_LDA(At, 1, 1); PG8_STAGE(PG8_SA(1, 0), a3, voffA);
            PG8_BAR; PG8_WAIT_L(0); PG8_MMA(1, 0, At, B0); PG8_BAR; PG8_SCHED;
            PG8_STAGE(PG8_SB(1, 1), b3 + hstep, voffB);
            PG8_WAIT_V(6); PG8_BAR; PG8_MMA(1, 1, At, B1); PG8_BAR;
        }
        E(acc, cur, wr, wc, fr, fq);
        if (!has_next) break;
#pragma unroll
        for (int a = 0; a < 2; ++a)
#pragma unroll
            for (int b = 0; b < 2; ++b)
#pragma unroll
                for (int m = 0; m < 4; ++m)
#pragma unroll
                    for (int n = 0; n < 2; ++n) acc[a][b][m][n] = (f32x4){0.f, 0.f, 0.f, 0.f};
        cur = nxt; cA = nA; cB = nB; ++ui;
    }
    PG8_WAIT_V(0);
    if (wr == 0) PG8_BAR;
    PG8_BAR;
#undef PG8_SA
#undef PG8_SB
#undef PG8_STAGE
#undef PG8_LDA
#undef PG8_LDB
#undef PG8_MMA
#undef PG8_WAIT_V
#undef PG8_WAIT_L
#undef PG8_BAR
#undef PG8_SCHED
}
}

template <class F>
__device__ __forceinline__ void sgemm_bf(LAS unsigned char* lds, const bf16_t* A, int lda, int row0, int M, const float* W, int ldw, int N, int K, int coloff, const F& f) {
    LAS float* As = (LAS float*)lds;
    LAS float* Ws = (LAS float*)(lds + 32 * 68 * 4);
    const int tid = TID(), ty = tid >> 4, tx = tid & 15;
    const int ntn = (N + 63) / 64, ntiles = (M / 64) * ntn;
    for (int tile = BID(); tile < ntiles; tile += gridDim.x) {
        const int tm = tile / ntn, tn = tile % ntn, r0 = row0 + tm * 64, n0 = tn * 64;
        f32x4 c0 = {0.f, 0.f, 0.f, 0.f}, c1 = {0.f, 0.f, 0.f, 0.f};
        for (int k0 = 0; k0 < K; k0 += 32) {
            __syncthreads();
            { const int r = tid >> 3, q = tid & 7; const f32x4 a = ld_bf4(A + (size_t)(r0 + r) * lda + k0 + 4 * q);
              As[(4 * q + 0) * 68 + r] = a[0]; As[(4 * q + 1) * 68 + r] = a[1]; As[(4 * q + 2) * 68 + r] = a[2]; As[(4 * q + 3) * 68 + r] = a[3]; }
            { const int kr = tid >> 4, c = tid & 15; f32x4 w = {0.f, 0.f, 0.f, 0.f}; if (n0 + 4 * c < N) w = *(const f32x4*)(W + (size_t)(k0 + kr) * ldw + n0 + 4 * c);
              *(LAS f32x4*)(Ws + kr * 68 + 4 * c) = w; }
            __syncthreads();
#pragma unroll 8
            for (int kk = 0; kk < 32; ++kk) {
                const f32x2 a = *(const LAS f32x2*)(As + kk * 68 + 2 * ty); const f32x4 b = *(const LAS f32x4*)(Ws + kk * 68 + 4 * tx);
                c0 += a.x * b; c1 += a.y * b;
            }
        }
        if (n0 + 4 * tx < N) { f.vec4(r0 + 2 * ty, n0 + 4 * tx + coloff, c0); f.vec4(r0 + 2 * ty + 1, n0 + 4 * tx + coloff, c1); }
    }
    __syncthreads();
}

typedef float f32x16 __attribute__((ext_vector_type(16)));
__device__ __forceinline__ int rw_group(int n0) { const int t = n0 >> 8; return t < 12 ? (t >> 2) : (t == 12 ? 2 : t - 10); }
template <bool RWGRP, class F>
__device__ __forceinline__ void wgemm_ks(LAS unsigned char* lds, const bf16_t* A, int lda, size_t agrp, int row0, int M, const bf16_t* Bt, int K, int N, const F& f) {
    const int tid = TID(), wave = tid >> 6, lane = tid & 63, lr = lane & 31, lh = lane >> 5;
    LAS float* red = (LAS float*)lds;
    const int ntn = N / 64, nitems = (M / 32) * ntn, kw = K / 8, steps = kw / 16;
    for (int item = BID(); item < nitems; item += gridDim.x) {
        const int tm = item / ntn, tn = item % ntn, r0 = row0 + tm * 32, n0 = tn * 64;
        const bf16_t* Ab = A + (RWGRP ? (size_t)rw_group(n0) * agrp : 0) + (size_t)(r0 + lr) * lda + wave * kw + lh * 8;
        const bf16_t* B0 = Bt + (size_t)(n0 + lr) * K + wave * kw + lh * 8; const bf16_t* B1 = B0 + (size_t)32 * K;
        f32x16 acc0, acc1;
#pragma unroll
        for (int r = 0; r < 16; ++r) { acc0[r] = 0.f; acc1[r] = 0.f; }
#pragma unroll 8
        for (int st = 0; st < steps; ++st) {
            const bf16x8 a = *(const bf16x8*)(Ab + 16 * st), b0 = *(const bf16x8*)(B0 + 16 * st), b1 = *(const bf16x8*)(B1 + 16 * st);
            acc0 = __builtin_amdgcn_mfma_f32_32x32x16_bf16(b0, a, acc0, 0, 0, 0);
            acc1 = __builtin_amdgcn_mfma_f32_32x32x16_bf16(b1, a, acc1, 0, 0, 0);
        }
        __syncthreads();
#pragma unroll
        for (int r = 0; r < 16; ++r) { red[((wave * 2 + 0) * 16 + r) * 64 + lane] = acc0[r]; red[((wave * 2 + 1) * 16 + r) * 64 + lane] = acc1[r]; }
        __syncthreads();
        { const int t = tid >> 8, r4 = (tid >> 6) & 3, l2 = tid & 63; f32x4 v = {0.f, 0.f, 0.f, 0.f};
#pragma unroll
          for (int w = 0; w < 8; ++w)
#pragma unroll
              for (int e = 0; e < 4; ++e) v[e] += red[((w * 2 + t) * 16 + 4 * r4 + e) * 64 + l2];
          f.vec4(r0 + (l2 & 31), n0 + 32 * t + 8 * r4 + 4 * (l2 >> 5), v); }
    }
    __syncthreads();
}
template <class F>
__device__ __forceinline__ void wgemm_w(const bf16_t* A, int lda, int row0, int M, const bf16_t* Bt, int K, int N, const F& f) {
    const int lane = TID() & 63, lr = lane & 31, lh = lane >> 5, gw = BID() * 8 + (TID() >> 6), nw = gridDim.x * 8;
    const int ntn = N / 64, nitems = (M / 32) * ntn, steps = K / 16;
    for (int item = gw; item < nitems; item += nw) {
        const int tm = item / ntn, tn = item % ntn, r0 = row0 + tm * 32, n0 = tn * 64;
        const bf16_t* Ab = A + (size_t)(r0 + lr) * lda + lh * 8;
        const bf16_t* B0 = Bt + (size_t)(n0 + lr) * K + lh * 8; const bf16_t* B1 = B0 + (size_t)32 * K;
        f32x16 acc0, acc1;
#pragma unroll
        for (int r = 0; r < 16; ++r) { acc0[r] = 0.f; acc1[r] = 0.f; }
        for (int st = 0; st < steps; ++st) {
            const bf16x8 a = *(const bf16x8*)(Ab + 16 * st), b0 = *(const bf16x8*)(B0 + 16 * st), b1 = *(const bf16x8*)(B1 + 16 * st);
            acc0 = __builtin_amdgcn_mfma_f32_32x32x16_bf16(b0, a, acc0, 0, 0, 0);
            acc1 = __builtin_amdgcn_mfma_f32_32x32x16_bf16(b1, a, acc1, 0, 0, 0);
        }
#pragma unroll
        for (int r4 = 0; r4 < 4; ++r4) {
            f.vec4(r0 + lr, n0 + 8 * r4 + 4 * lh, (f32x4){acc0[4 * r4], acc0[4 * r4 + 1], acc0[4 * r4 + 2], acc0[4 * r4 + 3]});
            f.vec4(r0 + lr, n0 + 32 + 8 * r4 + 4 * lh, (f32x4){acc1[4 * r4], acc1[4 * r4 + 1], acc1[4 * r4 + 2], acc1[4 * r4 + 3]});
        }
    }
}

struct FRwkvIn {
    bf16_t *rb, *kb, *vb, *tw, *ta, *tv, *tg;
    __device__ __forceinline__ void vec8(int row, int col, f32x4 a, f32x4 b) const {
        if (col < 3072) { u32x4 w; w.x = pk_bf16(a[0], a[1]); w.y = pk_bf16(a[2], a[3]); w.z = pk_bf16(b[0], b[1]); w.w = pk_bf16(b[2], b[3]);
            *(u32x4*)(rb + (size_t)(col >> 10) * XR_STRIDE + (size_t)row * D + (col & 1023)) = w; }
        else { vec4(row, col, a); vec4(row, col + 4, b); } }
    __device__ __forceinline__ void vec4(int row, int col, f32x4 v) const {
        if (col < 3072) { st_bf4(rb + (size_t)(col >> 10) * XR_STRIDE + (size_t)row * D + (col & 1023), v); }
        else if (col < 3328) { const int c = col - 3072; if (c < 32) st_bf4(tv + (size_t)row * 32 + c, v); }
        else if (col < 3584) { const int c = col - 3328; if (c < 64) { f32x4 t = {ftanh(v[0]), ftanh(v[1]), ftanh(v[2]), ftanh(v[3])}; st_bf4(tw + (size_t)row * 64 + c, t); } }
        else if (col < 3840) { const int c = col - 3584; if (c < 64) st_bf4(ta + (size_t)row * 64 + c, v); }
        else { const int c = col - 3840; if (c < 160) { f32x4 t = {fsig(v[0]), fsig(v[1]), fsig(v[2]), fsig(v[3])}; st_bf4(tg + (size_t)row * 160 + c, t); } }
    }
};
struct FStoreF32 { float* C; int ldc; int ncols; __device__ __forceinline__ void vec4(int row, int col, f32x4 v) const { if (col < ncols) *(f32x4*)(C + (size_t)row * ldc + col) = v; } };
struct FStoreBf16 { bf16_t* C; int ldc; int ncols;
    __device__ __forceinline__ void vec4(int row, int col, f32x4 v) const { if (col < ncols) st_bf4(C + (size_t)row * ldc + col, v); }
    __device__ __forceinline__ void vec8(int row, int col, f32x4 a, f32x4 b) const { if (col < ncols) { u32x4 w; w.x = pk_bf16(a[0], a[1]); w.y = pk_bf16(a[2], a[3]); w.z = pk_bf16(b[0], b[1]); w.w = pk_bf16(b[2], b[3]); *(u32x4*)(C + (size_t)row * ldc + col) = w; } } };
struct FResid {
    float* X; const float* gate;
    const float* xin_p; const float* xin_s;
    __device__ __forceinline__ void vec4(int row, int col, f32x4 v) const {
        const f32x4 g = *(const f32x4*)(gate + (size_t)row_seq(row) * 6144 + col); float* xp = X + (size_t)row * D + col;
        const float* ip = xin_p ? (row < NP ? xin_p + (size_t)row * D + col : xin_s + (size_t)(row - NP) * D + col) : xp;
        const f32x4 x = *(const f32x4*)ip; *(f32x4*)xp = x + g * v; }
};
struct FRelu2 { bf16_t* U;
    __device__ __forceinline__ void vec8(int row, int col, f32x4 a, f32x4 b) const {
        f32x4 s, t; for (int e = 0; e < 4; ++e) { const float x = fmaxf(a[e], 0.f), y = fmaxf(b[e], 0.f); s[e] = x * x; t[e] = y * y; }
        u32x4 w; w.x = pk_bf16(s[0], s[1]); w.y = pk_bf16(s[2], s[3]); w.z = pk_bf16(t[0], t[1]); w.w = pk_bf16(t[2], t[3]); *(u32x4*)(U + (size_t)row * DFF + col) = w; }
    __device__ __forceinline__ void vec4(int row, int col, f32x4 v) const {
        f32x4 t; for (int e = 0; e < 4; ++e) { const float r = fmaxf(v[e], 0.f); t[e] = r * r; } st_bf4(U + (size_t)row * DFF + col, t); } };

__device__ __forceinline__ void phase_copy_x(KP p) {
    const size_t n4p = (size_t)NP * D / 4, n4 = (size_t)NT * D / 4;
    for (size_t i = (size_t)BID() * 512 + TID(); i < n4; i += (size_t)gridDim.x * 512)
        ((f32x4*)p->out)[i] = i < n4p ? ((const f32x4*)p->x_prompt)[i] : ((const f32x4*)p->x_sample)[i - n4p];
}

struct TJob { const float* src; bf16_t* dst; int K, N, drow0; };
__device__ __forceinline__ TJob tjob(KP p, int i) {
    TJob t; t.drow0 = 0;
    if (i < 4) { t.src = p->w_up + (size_t)i * D * DFF; t.dst = WSP(bf16_t, WS_WUP_T) + (size_t)i * DFF * D; t.K = D; t.N = DFF; return t; }
    if (i < 8) { const int l = i - 4; t.src = p->w_down + (size_t)l * DFF * D; t.dst = WSP(bf16_t, WS_WDN_T) + (size_t)l * DFF * D; t.K = DFF; t.N = D; return t; }
    i -= 8; const int j = i / 14, k = i % 14; bf16_t* wrw = WSP(bf16_t, WS_WRW_T) + (size_t)j * 4096 * D;
    t.K = D; t.N = D;
    switch (k) {
        case 0: case 1: case 2: t.src = p->rw_w_rkv + ((size_t)j * 3 + k) * D * D; t.dst = wrw; t.drow0 = k * 1024; break;
        case 3: t.src = p->rw_v1; t.dst = wrw; t.drow0 = 3072; t.N = j == 1 ? 32 : 0; break;
        case 4: t.src = p->rw_w1 + (size_t)j * D * 64; t.dst = wrw; t.drow0 = 3328; t.N = 64; break;
        case 5: t.src = p->rw_a1 + (size_t)j * D * 64; t.dst = wrw; t.drow0 = 3584; t.N = 64; break;
        case 6: t.src = p->rw_g1 + (size_t)j * D * 160; t.dst = wrw; t.drow0 = 3840; t.N = 160; break;
        case 7: t.src = p->rw_w_o + (size_t)j * D * D; t.dst = WSP(bf16_t, WS_WO_T) + (size_t)j * D * D; break;
        case 8: t.src = p->rw_w2 + (size_t)j * 64 * D; t.dst = WSP(bf16_t, WS_W2T) + (size_t)j * D * 64; t.K = 64; break;
        case 9: t.src = p->rw_a2 + (size_t)j * 64 * D; t.dst = WSP(bf16_t, WS_A2T) + (size_t)j * D * 64; t.K = 64; break;
        case 10: t.src = p->rw_g2 + (size_t)j * 160 * D; t.dst = WSP(bf16_t, WS_G2T) + (size_t)j * D * 160; t.K = 160; break;
        case 11: t.src = p->rw_v2; t.dst = WSP(bf16_t, WS_V2T); t.K = 32; t.N = j == 1 ? D : 0; break;
        case 12: t.src = p->att_w_in + (size_t)j * D * PIN; t.dst = WSP(bf16_t, WS_WIN_T) + (size_t)j * PINP * D; t.N = PIN; break;
        default: t.src = p->att_w_o + (size_t)j * D * D; t.dst = WSP(bf16_t, WS_WAO_T) + (size_t)j * D * D; break;
    }
    return t;
}
__device__ __forceinline__ int tjob_tiles(const TJob& t) { return ((t.K + 63) / 64) * ((t.N + 63) / 64); }
__device__ __forceinline__ void phase_weights(KP p, LAS unsigned char* lds) {
    LAS float* T = (LAS float*)lds;
    int total = 0;
    for (int i = 0; i < 36; ++i) total += tjob_tiles(tjob(p, i));
    const int ngrp = (total + 3) / 4;
    f32x4 v[4][2];
    bf16_t* dstn[4]; int Kn[4], nlim[4], klim[4];
#define WT_ISSUE(G_) do { const int tid_ = TID(), kk_ = tid_ >> 4, n4_ = (tid_ & 15) * 4; \
        int i_ = 0, start_ = 0, cnt_ = tjob_tiles(tjob(p, 0)); \
        _Pragma("unroll") for (int u = 0; u < 4; ++u) { const int gt_ = 4 * (G_) + u; \
            while (i_ < 35 && gt_ >= start_ + cnt_) { start_ += cnt_; ++i_; cnt_ = tjob_tiles(tjob(p, i_)); } \
            const TJob tj_ = tjob(p, i_); const int lt_ = gt_ - start_, nkt_ = (tj_.K + 63) / 64; \
            const bool dead_ = gt_ >= total || lt_ >= cnt_; const int k0_ = dead_ ? 0 : (lt_ % nkt_) * 64, n0_ = dead_ ? 0 : (lt_ / nkt_) * 64; \
            dstn[u] = tj_.dst + (size_t)(tj_.drow0 + n0_) * tj_.K + k0_; Kn[u] = tj_.K; nlim[u] = dead_ ? 0 : tj_.N - n0_; klim[u] = dead_ ? 0 : tj_.K - k0_; \
            _Pragma("unroll") for (int hh = 0; hh < 2; ++hh) { const int k_ = k0_ + kk_ + 32 * hh, n_ = n0_ + n4_; \
                v[u][hh] = *(const f32x4*)(tj_.src + (size_t)min(k_, tj_.K - 1) * tj_.N + min(n_, tj_.N - 4)); } } } while (0)
    if (BID() < ngrp) WT_ISSUE(BID());
    for (int g = BID(); g < ngrp; g += gridDim.x) {
        const int tid = TID(), kk = tid >> 4, n4 = (tid & 15) * 4;
#pragma unroll
        for (int u = 0; u < 4; ++u)
#pragma unroll
            for (int hh = 0; hh < 2; ++hh)
#pragma unroll
                for (int e = 0; e < 4; ++e) T[(u * 64 + kk + 32 * hh) * 65 + n4 + e] = v[u][hh][e];
        bf16_t* dstc[4]; int Kc[4], nl[4], kl[4];
#pragma unroll
        for (int u = 0; u < 4; ++u) { dstc[u] = dstn[u]; Kc[u] = Kn[u]; nl[u] = nlim[u]; kl[u] = klim[u]; }
        if (g + (int)gridDim.x < ngrp) WT_ISSUE(g + (int)gridDim.x);
        asm volatile("s_waitcnt lgkmcnt(0)" ::: "memory"); __builtin_amdgcn_s_barrier(); asm volatile("" ::: "memory");
        const int nn = tid >> 3, k8 = (tid & 7) * 8;
#pragma unroll
        for (int u = 0; u < 4; ++u) {
            if (nn < nl[u] && k8 < kl[u]) {
                u32x4 w;
                w.x = pk_bf16(T[(u * 64 + k8 + 0) * 65 + nn], T[(u * 64 + k8 + 1) * 65 + nn]); w.y = pk_bf16(T[(u * 64 + k8 + 2) * 65 + nn], T[(u * 64 + k8 + 3) * 65 + nn]);
                w.z = pk_bf16(T[(u * 64 + k8 + 4) * 65 + nn], T[(u * 64 + k8 + 5) * 65 + nn]); w.w = pk_bf16(T[(u * 64 + k8 + 6) * 65 + nn], T[(u * 64 + k8 + 7) * 65 + nn]);
                *(u32x4*)(dstc[u] + (size_t)nn * Kc[u] + k8) = w;
            }
        }
        asm volatile("s_waitcnt lgkmcnt(0)" ::: "memory"); __builtin_amdgcn_s_barrier(); asm volatile("" ::: "memory");
    }
#undef WT_ISSUE
    __syncthreads();
}

__device__ __forceinline__ void phase_ada(KP p, LAS unsigned char* lds) {
    float* mods = WSP(float, WS_MODS);
    LAS float* red = (LAS float*)lds;
    const int tid = TID(), lane = tid & 63, w = tid >> 6, ln = lane & 15, lq = lane >> 4;
    float af[3][32];
#pragma unroll
    for (int m = 0; m < 3; ++m) {
        const int s = 16 * m + ln; const bool ok = s < 36;
        const float* cp = s < 4 ? p->c_prompt + (size_t)s * D : p->c_sample + (size_t)((ok ? s : 35) - 4) * D;
#pragma unroll
        for (int i = 0; i < 32; ++i) { const float cv = cp[128 * w + 4 * i + lq]; af[m][i] = ok ? cv * __builtin_amdgcn_rcpf(1.0f + __expf(-cv)) : 0.f; }
    }
    f32x2 wv[32];
#define ADA_LOAD(B_) do { const int l_ = (B_) / 192, cb_ = ((B_) % 192) * 32; const float* wp_ = p->w_ada + ((size_t)l_ * D + 128 * w + lq) * 6144 + cb_ + 2 * ln; \
        _Pragma("unroll") for (int i = 0; i < 32; ++i) wv[i] = *(const f32x2*)(wp_ + (size_t)(4 * i) * 6144); } while (0)
    if (BID() < 768) ADA_LOAD(BID());
    for (int B = BID(); B < 768; B += gridDim.x) {
        const int l = B / 192, cb = (B % 192) * 32;
        f32x4 acc[3][2];
#pragma unroll
        for (int m = 0; m < 3; ++m) { acc[m][0] = (f32x4){0.f, 0.f, 0.f, 0.f}; acc[m][1] = acc[m][0]; }
#pragma unroll
        for (int i = 0; i < 32; ++i)
#pragma unroll
            for (int m = 0; m < 3; ++m) {
                acc[m][0] = __builtin_amdgcn_mfma_f32_16x16x4f32(af[m][i], wv[i][0], acc[m][0], 0, 0, 0);
                acc[m][1] = __builtin_amdgcn_mfma_f32_16x16x4f32(af[m][i], wv[i][1], acc[m][1], 0, 0, 0);
            }
        if (B + (int)gridDim.x < 768) ADA_LOAD(B + (int)gridDim.x);
#pragma unroll
        for (int m = 0; m < 3; ++m)
#pragma unroll
            for (int r = 0; r < 4; ++r) { const int s = 16 * m + 4 * lq + r;
                if (s < 36) *(LAS f32x2*)(red + (w * 36 + s) * 32 + 2 * ln) = (f32x2){acc[m][0][r], acc[m][1][r]}; }
        asm volatile("s_waitcnt lgkmcnt(0)" ::: "memory"); __builtin_amdgcn_s_barrier(); asm volatile("" ::: "memory");
        for (int o = tid; o < 36 * 32; o += 512) { const int s = o >> 5, cc = o & 31;
            float v = 0.f;
#pragma unroll
            for (int ww = 0; ww < 8; ++ww) v += red[(ww * 36 + s) * 32 + cc];
            mods[((size_t)l * 36 + s) * 6144 + cb + cc] = v + p->b_ada[l * 6144 + cb + cc]; }
        asm volatile("s_waitcnt lgkmcnt(0)" ::: "memory"); __builtin_amdgcn_s_barrier(); asm volatile("" ::: "memory");
    }
#undef ADA_LOAD
    __syncthreads();
}

template <bool MIX>
__device__ __forceinline__ void phase_prep(KP p, int layer, int which, int j, bool first = false) {
    const float* X = p->out;
    const float* mods = WSP(float, WS_MODS) + (size_t)layer * 36 * 6144;
    const float* g = p->norm_g + (layer * 2 + which) * D;
    bf16_t* XR = WSP(bf16_t, WS_XR);
    const int lane = TID() & 63, gw = BID() * 8 + (TID() >> 6), nw = gridDim.x * 8;
    for (int run = gw; run < NT / 8; run += nw) {
        const int row0 = run * 8, seq = row_seq(row0);
        const float* sh = mods + (size_t)seq * 6144 + (which ? 3 : 0) * D; const float* sc = sh + D;
        f32x4 gv[4], scv[4], shv[4], hp[4];
#pragma unroll
        for (int i = 0; i < 4; ++i) { const int col = 512 * (i >> 1) + 8 * lane + 4 * (i & 1); gv[i] = *(const f32x4*)(g + col); scv[i] = *(const f32x4*)(sc + col) + 1.0f; shv[i] = *(const f32x4*)(sh + col); hp[i] = (f32x4){0.f, 0.f, 0.f, 0.f}; }
        int rstart = 0;
        if (MIX) {
            if (row0 >= NP) {
#pragma unroll
                for (int i = 0; i < 4; ++i) hp[i] = *(const f32x4*)(p->state_shift + ((size_t)j * 32 + (seq - 4)) * D + 512 * (i >> 1) + 8 * lane + 4 * (i & 1));
            } else if ((row0 & 4095) != 0) rstart = -1;
        }
        for (int r = rstart; r < 8; ++r) {
            const int row = row0 + r;
            f32x4 x[4]; float ss = 0.f;
            const float* xr = first ? (row < NP ? p->x_prompt + (size_t)row * D : p->x_sample + (size_t)(row - NP) * D) : X + (size_t)row * D;
#pragma unroll
            for (int i = 0; i < 4; ++i) { x[i] = *(const f32x4*)(xr + 512 * (i >> 1) + 8 * lane + 4 * (i & 1)); ss += x[i][0] * x[i][0] + x[i][1] * x[i][1] + x[i][2] * x[i][2] + x[i][3] * x[i][3]; }
            ss = wave_sum(ss);
            const float rstd = rsqrtf(ss * (1.0f / 1024.0f) + 1e-6f);
            f32x4 h[4];
#pragma unroll
            for (int i = 0; i < 4; ++i) h[i] = x[i] * rstd * gv[i] * scv[i] + shv[i];
            if (MIX) {
                if (r >= 0) {
#pragma unroll
                    for (int n = 0; n < 6; ++n) {
                        const int mi = n == 0 ? 0 : (n == 1 ? 2 : (n == 2 ? 3 : (n == 3 ? 1 : n)));
                        const float* mx = p->rw_mix + ((size_t)j * 6 + mi) * D;
#pragma unroll
                        for (int i2 = 0; i2 < 2; ++i2) { const int col = 512 * i2 + 8 * lane; const f32x4 m0 = *(const f32x4*)(mx + col), m1 = *(const f32x4*)(mx + col + 4);
                            const f32x4 a = h[2 * i2] + (hp[2 * i2] - h[2 * i2]) * m0, b2 = h[2 * i2 + 1] + (hp[2 * i2 + 1] - h[2 * i2 + 1]) * m1;
                            u32x4 w; w.x = pk_bf16(a[0], a[1]); w.y = pk_bf16(a[2], a[3]); w.z = pk_bf16(b2[0], b2[1]); w.w = pk_bf16(b2[2], b2[3]);
                            *(u32x4*)(XR + (size_t)n * XR_STRIDE + (size_t)row * D + col) = w; }
                    }
                    const bool lastp = row < NP && (row & 4095) == 4095, lasts = row >= NP && ((row - NP) & 7) == 7;
                    if (lastp || lasts) {
                        float* so = lastp ? p->out + O_SHP + ((size_t)j * 4 + seq) * D : p->out + O_SHS + ((size_t)j * 32 + (seq - 4)) * D;
#pragma unroll
                        for (int i = 0; i < 4; ++i) *(f32x4*)(so + 512 * (i >> 1) + 8 * lane + 4 * (i & 1)) = h[i];
                    }
                }
#pragma unroll
                for (int i = 0; i < 4; ++i) hp[i] = h[i];
            } else {
#pragma unroll
                for (int i2 = 0; i2 < 2; ++i2) { const f32x4 a = h[2 * i2], b2 = h[2 * i2 + 1]; u32x4 w; w.x = pk_bf16(a[0], a[1]); w.y = pk_bf16(a[2], a[3]); w.z = pk_bf16(b2[0], b2[1]); w.w = pk_bf16(b2[2], b2[3]);
                    *(u32x4*)(XR + (size_t)row * D + 512 * i2 + 8 * lane) = w; }
            }
        }
    }
}

__device__ __forceinline__ void phase_scanprep(KP p, int j) {
    const bf16_t *KB = WSP(bf16_t, WS_KB), *VB = WSP(bf16_t, WS_VB);
    const float *WPp = WSP(float, WS_WP), *APp = WSP(float, WS_AP), *VPp = WSP(float, WS_VP);
    float *VF = WSP(float, WS_VFIRST), *DEC = WSP(float, WS_DEC), *KM = WSP(float, WS_KM), *VM = WSP(float, WS_VM), *AV = WSP(float, WS_AV), *BV = WSP(float, WS_BV);
    const int lane = TID() & 63, gw = BID() * 8 + (TID() >> 6), nw = gridDim.x * 8;
    for (int row = gw; row < NT; row += nw) {
#pragma unroll
        for (int i = 0; i < 4; ++i) {
            const int col = 256 * i + 4 * lane; const size_t o = (size_t)row * D + col;
            const f32x4 k = ld_bf4(KB + o), v = ld_bf4(VB + o), wp = *(const f32x4*)(WPp + o), ap = *(const f32x4*)(APp + o);
            const f32x4 w0 = *(const f32x4*)(p->rw_w0 + j * D + col), a0 = *(const f32x4*)(p->rw_a0 + j * D + col), kkw = *(const f32x4*)(p->rw_k_k + j * D + col), kaw = *(const f32x4*)(p->rw_k_a + j * D + col);
            f32x4 dec, a, vm, kk, km;
#pragma unroll
            for (int e = 0; e < 4; ++e) {
                const float wpre = w0[e] + wp[e], z = -wpre, sp = fmaxf(z, 0.f) + log1pf(expf(-fabsf(z)));
                dec[e] = expf(-expf(-sp - 0.5f));
                a[e] = sigmoidf_(a0[e] + ap[e]);
                kk[e] = k[e] * kkw[e];
                km[e] = k[e] * (1.0f + (a[e] - 1.0f) * kaw[e]);
            }
            if (j == 0) { vm = v; *(f32x4*)(VF + o) = v; }
            else { const f32x4 vf = *(const f32x4*)(VF + o), vp = *(const f32x4*)(VPp + o), v0 = *(const f32x4*)(p->rw_v0 + (j - 1) * D + col);
#pragma unroll
                for (int e = 0; e < 4; ++e) vm[e] = v[e] + (vf[e] - v[e]) * sigmoidf_(v0[e] + vp[e]); }
            float ss = kk[0] * kk[0] + kk[1] * kk[1] + kk[2] * kk[2] + kk[3] * kk[3];
            ss = g16_sum(ss);
            const float inv = rsqrtf(fmaxf(ss, 1e-24f));
            kk = kk * inv;
            *(f32x4*)(DEC + o) = dec; *(f32x4*)(KM + o) = km; *(f32x4*)(VM + o) = vm; *(f32x4*)(AV + o) = -kk; *(f32x4*)(BV + o) = kk * a;
        }
    }
}

__device__ __forceinline__ float rl(float v, int k) { return __int_as_float(__builtin_amdgcn_readlane(__float_as_int(v), k)); }
__device__ __forceinline__ void scan_run(KP p, size_t row_base, int nsteps, int colbase, float (&S)[64]) {
    const float *DEC = WSP(float, WS_DEC), *KM = WSP(float, WS_KM), *VM = WSP(float, WS_VM), *AV = WSP(float, WS_AV), *BV = WSP(float, WS_BV);
    const bf16_t* RB = WSP(bf16_t, WS_RB); float* Y = WSP(float, WS_Y);
    const int lane = TID() & 63;
    size_t o = row_base * D + colbase + lane;
    float w = DEC[o], kx = KM[o], v = VM[o], a = AV[o], b = BV[o], r = bf2f(RB[o]);
    for (int t = 0; t < nsteps; ++t) {
        const size_t on = (t + 1 < nsteps) ? o + D : o;
        const float wn = DEC[on], kn = KM[on], vn = VM[on], an = AV[on], bn = BV[on], rn = bf2f(RB[on]);
        float sa = 0.f;
#pragma unroll
        for (int k = 0; k < 64; ++k) sa += S[k] * rl(a, k);
#pragma unroll
        for (int k = 0; k < 64; ++k) S[k] = S[k] * rl(w, k) + sa * rl(b, k) + v * rl(kx, k);
        float y = 0.f;
#pragma unroll
        for (int k = 0; k < 64; ++k) y += S[k] * rl(r, k);
        Y[o] = y;
        o = on; w = wn; kx = kn; v = vn; a = an; b = bn; r = rn;
    }
}
__device__ __forceinline__ void phase_scanA(KP p) {
    const float *DEC = WSP(float, WS_DEC), *KM = WSP(float, WS_KM), *VM = WSP(float, WS_VM), *AV = WSP(float, WS_AV), *BV = WSP(float, WS_BV);
    float *PCH = WSP(float, WS_PCH), *CCH = WSP(float, WS_CCH);
    const int lane = TID() & 63, gw = BID() * 8 + (TID() >> 6), nw = gridDim.x * 8;
    for (int it = gw; it < 64 * NCH; it += nw) {
        const int sh = it / NCH, c = it % NCH, b = sh >> 4, h = sh & 15;
        float SP[64], SC[64];
#pragma unroll
        for (int k = 0; k < 64; ++k) { SP[k] = (k == lane) ? 1.f : 0.f; SC[k] = 0.f; }
        size_t o = ((size_t)b * 4096 + (size_t)c * LCH) * D + h * 64 + lane;
        float w = DEC[o], kx = KM[o], v = VM[o], a = AV[o], bb = BV[o];
        for (int t = 0; t < LCH; ++t) {
            const size_t on = (t + 1 < LCH) ? o + D : o;
            const float wn = DEC[on], kn = KM[on], vn = VM[on], an = AV[on], bn = BV[on];
            float saP = 0.f, saC = 0.f;
#pragma unroll
            for (int k = 0; k < 64; ++k) { const float ak = rl(a, k); saP += SP[k] * ak; saC += SC[k] * ak; }
#pragma unroll
            for (int k = 0; k < 64; ++k) { const float wk = rl(w, k), bk = rl(bb, k); SP[k] = SP[k] * wk + saP * bk; SC[k] = SC[k] * wk + saC * bk + v * rl(kx, k); }
            o = on; w = wn; kx = kn; v = vn; a = an; bb = bn;
        }
        float* po = PCH + ((size_t)it * 64 + lane) * 64; float* co = CCH + ((size_t)it * 64 + lane) * 64;
#pragma unroll
        for (int k = 0; k < 64; k += 4) { *(f32x4*)(po + k) = (f32x4){SP[k], SP[k + 1], SP[k + 2], SP[k + 3]}; *(f32x4*)(co + k) = (f32x4){SC[k], SC[k + 1], SC[k + 2], SC[k + 3]}; }
    }
}
__device__ __forceinline__ void phase_scanB(KP p, int j, LAS unsigned char* lds) {
    const int tid = TID(), lane = tid & 63, wave = tid >> 6;
    if (BID() < 32) {
        const float *PCH = WSP(float, WS_PCH), *CCH = WSP(float, WS_CCH); float* SST = WSP(float, WS_SST);
        const int sh = BID() * 2 + (wave >> 2), q = wave & 3, row0 = 32 * (q >> 1), col0 = 32 * (q & 1), b = sh >> 4, h = sh & 15;
        LAS float* Sl = (LAS float*)lds + (wave >> 2) * (2 * 64 * 65);
        const int lr = lane & 31, lh = lane >> 5;
        f32x16 acc;
#pragma unroll
        for (int r = 0; r < 16; ++r) acc[r] = 0.f;
        for (int c = 0; c <= NCH; ++c) {
            LAS float* Sw = Sl + (c & 1) * (64 * 65);
            float* go = c < NCH ? SST + ((size_t)sh * NCH + c) * 4096 : p->out + O_WKVP + (((size_t)j * 4 + b) * 16 + h) * 4096;
#pragma unroll
            for (int r = 0; r < 16; ++r) { const int row = row0 + (r & 3) + 8 * (r >> 2) + 4 * lh; Sw[row * 65 + col0 + lr] = acc[r]; go[row * 64 + col0 + lr] = acc[r]; }
            if (c == NCH) break;
            const float* Pc = PCH + ((size_t)sh * NCH + c) * 4096; const float* Cc = CCH + ((size_t)sh * NCH + c) * 4096;
            float bv[32];
#pragma unroll
            for (int kk = 0; kk < 32; ++kk) bv[kk] = Pc[(2 * kk + lh) * 64 + col0 + lr];
#pragma unroll
            for (int r = 0; r < 16; ++r) acc[r] = Cc[(row0 + (r & 3) + 8 * (r >> 2) + 4 * lh) * 64 + col0 + lr];
            __syncthreads();
#pragma unroll
            for (int kk = 0; kk < 32; ++kk) acc = __builtin_amdgcn_mfma_f32_32x32x2f32(Sw[(row0 + lr) * 65 + 2 * kk + lh], bv[kk], acc, 0, 0, 0);
        }
    } else {
        for (int it = (BID() - 32) * 8 + wave; it < 512; it += (gridDim.x - 32) * 8) {
            const int b = it >> 4, h = it & 15;
            const float* s0 = p->state_wkv + (((size_t)j * 32 + b) * 16 + h) * 4096 + lane * 64;
            float S[64];
#pragma unroll
            for (int k = 0; k < 64; k += 4) { const f32x4 t = *(const f32x4*)(s0 + k); S[k] = t[0]; S[k + 1] = t[1]; S[k + 2] = t[2]; S[k + 3] = t[3]; }
            scan_run(p, (size_t)NP + b * 8, 8, h * 64, S);
            float* o = p->out + O_WKVS + (((size_t)j * 32 + b) * 16 + h) * 4096 + lane * 64;
#pragma unroll
            for (int k = 0; k < 64; k += 4) *(f32x4*)(o + k) = (f32x4){S[k], S[k + 1], S[k + 2], S[k + 3]};
        }
    }
    __syncthreads();
}
__device__ __forceinline__ void phase_scanC(KP p) {
    const float* SST = WSP(float, WS_SST);
    const int lane = TID() & 63, gw = BID() * 8 + (TID() >> 6), nw = gridDim.x * 8;
    for (int it = gw; it < 64 * NCH; it += nw) {
        const int sh = it / NCH, c = it % NCH, b = sh >> 4, h = sh & 15;
        const float* s0 = SST + ((size_t)it * 64 + lane) * 64;
        float S[64];
#pragma unroll
        for (int k = 0; k < 64; k += 4) { const f32x4 t = *(const f32x4*)(s0 + k); S[k] = t[0]; S[k + 1] = t[1]; S[k + 2] = t[2]; S[k + 3] = t[3]; }
        scan_run(p, (size_t)b * 4096 + (size_t)c * LCH, LCH, h * 64, S);
    }
}


constexpr int CST = 72;
constexpr int CMAT = 64 * CST * 2;
constexpr int CH_F32 = 11 * CMAT, CH_PART = CH_F32 + 64 * 68 * 4, CH_GL = CH_PART + 64 * 4 * 4;
__device__ __forceinline__ bf16x8 cfrag(const LAS bf16_t* M, int row, int ks, int c4) { return *(const LAS bf16x8*)(M + row * CST + 32 * ks + 8 * c4); }
__device__ __forceinline__ f32x4 cmm(const LAS bf16_t* A, int arow, const LAS bf16_t* B, int brow, int c4, f32x4 acc) {
    acc = __builtin_amdgcn_mfma_f32_16x16x32_bf16(cfrag(A, arow, 0, c4), cfrag(B, brow, 0, c4), acc, 0, 0, 0);
    return __builtin_amdgcn_mfma_f32_16x16x32_bf16(cfrag(A, arow, 1, c4), cfrag(B, brow, 1, c4), acc, 0, 0, 0); }
__device__ __forceinline__ unsigned short f2bf(float x) { return (unsigned short)(pk_bf16(x, 0.f) & 0xffffu); }
__device__ __forceinline__ void st_t4(LAS bf16_t* Mt, int d, int t0, f32x4 v) { u32x2 w; w.x = pk_bf16(v[0], v[1]); w.y = pk_bf16(v[2], v[3]); *(LAS u32x2*)(Mt + d * CST + t0) = w; }

__device__ __forceinline__ void phase_chunk(KP p, int j, LAS unsigned char* lds) {
    LAS bf16_t* Mx = (LAS bf16_t*)lds;
#define CM(i) (Mx + (i) * (64 * CST))
    LAS float* F32 = (LAS float*)(lds + CH_F32);
    asm volatile("" : "+v"(F32));
    LAS float* part = (LAS float*)(lds + CH_PART);
    LAS float* gLs = (LAS float*)(lds + CH_GL);
    const bf16_t *RB = WSP(bf16_t, WS_RB), *KB = WSP(bf16_t, WS_KB), *VB = WSP(bf16_t, WS_VB), *TW = WSP(bf16_t, WS_TW), *TA_ = WSP(bf16_t, WS_TA), *TV = WSP(bf16_t, WS_TV);
    const bf16_t *W2T = WSP(bf16_t, WS_W2T) + (size_t)j * D * 64, *A2T = WSP(bf16_t, WS_A2T) + (size_t)j * D * 64, *V2T = WSP(bf16_t, WS_V2T);
    float* VF = WSP(float, WS_VFIRST); float *PCH = WSP(float, WS_PCH), *CCH = WSP(float, WS_CCH), *Y0 = WSP(float, WS_Y), *BON = WSP(float, WS_AV);
    bf16_t *GM = WSP(bf16_t, WS_DEC), *VM2 = WSP(bf16_t, WS_KM);
#define CH_BAR() do { asm volatile("s_waitcnt lgkmcnt(0)" ::: "memory"); __builtin_amdgcn_s_barrier(); asm volatile("" ::: "memory"); } while (0)
    bf16x8 f_aw[2], f_aa[2], f_av; unsigned short e_k[2][4], e_v[2][4], e_r[2][4];
    f_av = (bf16x8){0, 0, 0, 0, 0, 0, 0, 0};
#define CH_PREFETCH(itx) do { const int tid_ = TID(), lane_ = tid_ & 63, w_ = tid_ >> 6, n_ = lane_ & 15, c4_ = lane_ >> 4, tr_ = w_ >> 1, tcb_ = 2 * (w_ & 1); \
        const int sh_ = (itx) / NCH, c_ = (itx) % NCH, R0_ = (sh_ >> 4) * 4096 + c_ * LCH, hc_ = (sh_ & 15) * 64; const int ar_ = 16 * tr_ + n_; \
        _Pragma("unroll") for (int ks = 0; ks < 2; ++ks) { f_aw[ks] = *(const bf16x8*)(TW + (size_t)R0_ * 64 + ar_ * 64 + 32 * ks + 8 * c4_); f_aa[ks] = *(const bf16x8*)(TA_ + (size_t)R0_ * 64 + ar_ * 64 + 32 * ks + 8 * c4_); } \
        if (j == 1) f_av = *(const bf16x8*)(TV + (size_t)R0_ * 32 + ar_ * 32 + 8 * c4_); \
        _Pragma("unroll") for (int ti = 0; ti < 2; ++ti) _Pragma("unroll") for (int r = 0; r < 4; ++r) { const size_t o_ = (size_t)R0_ * D + hc_ + (16 * tr_ + 4 * c4_ + r) * D + 16 * (tcb_ + ti) + n_; \
            e_k[ti][r] = KB[o_]; e_v[ti][r] = VB[o_]; e_r[ti][r] = RB[o_]; } } while (0)
    if (BID() < 64 * NCH) CH_PREFETCH(BID());
    for (int it = BID(); it < 64 * NCH; it += gridDim.x) {
        const int tid = TID(), lane = tid & 63, w = tid >> 6, n = lane & 15, c4 = lane >> 4, tr = w >> 1, tcb = 2 * (w & 1);
        const int sh = it / NCH, c = it % NCH, b = sh >> 4, h = sh & 15, R0 = b * 4096 + c * LCH, hc = h * 64;
        const bf16_t *KBb = KB + (size_t)R0 * D + hc, *VBb = VB + (size_t)R0 * D + hc, *RBb = RB + (size_t)R0 * D + hc;
        float* VFb = VF + (size_t)R0 * D + hc; bf16_t* VM2b = VM2 + (size_t)R0 * D + hc; bf16_t* GMb = GM + (size_t)R0 * D + hc; bf16_t* Y0b = (bf16_t*)Y0 + (size_t)R0 * D + hc;
        float* PCb = PCH + (size_t)it * 4096; float* CCb = CCH + (size_t)it * 4096; float* BONb = BON + (size_t)R0 * 16 + h;
        const bf16_t *TWb = TW + (size_t)R0 * 64, *TAb = TA_ + (size_t)R0 * 64, *TVb = TV + (size_t)R0 * 32, *W2b = W2T + (size_t)hc * 64, *A2b = A2T + (size_t)hc * 64, *V2b = V2T + (size_t)hc * 32;
        const float *w0b = p->rw_w0 + j * D + hc, *a0b = p->rw_a0 + j * D + hc, *kkb = p->rw_k_k + j * D + hc, *kab = p->rw_k_a + j * D + hc, *rkb = p->rw_r_k + j * D + hc, *v0b = p->rw_v0 + (j ? (j - 1) : 0) * D + hc;
        f32x4 wp[2], ap[2], vp[2];
#pragma unroll
        for (int ti = 0; ti < 2; ++ti) { wp[ti] = (f32x4){0.f, 0.f, 0.f, 0.f}; ap[ti] = wp[ti]; vp[ti] = wp[ti]; }
        {   const int ar = 16 * tr + n;
#pragma unroll
            for (int ks = 0; ks < 2; ++ks) {
                const bf16x8 aw = f_aw[ks], aa = f_aa[ks];
#pragma unroll
                for (int ti = 0; ti < 2; ++ti) { const int br = 16 * (tcb + ti) + n;
                    wp[ti] = __builtin_amdgcn_mfma_f32_16x16x32_bf16(aw, *(const bf16x8*)(W2b + br * 64 + 32 * ks + 8 * c4), wp[ti], 0, 0, 0);
                    ap[ti] = __builtin_amdgcn_mfma_f32_16x16x32_bf16(aa, *(const bf16x8*)(A2b + br * 64 + 32 * ks + 8 * c4), ap[ti], 0, 0, 0); }
            }
            if (j == 1) { const bf16x8 av = f_av;
#pragma unroll
                for (int ti = 0; ti < 2; ++ti) vp[ti] = __builtin_amdgcn_mfma_f32_16x16x32_bf16(av, *(const bf16x8*)(V2b + (16 * (tcb + ti) + n) * 32 + 8 * c4), vp[ti], 0, 0, 0); }
        }
        f32x4 lw[2], asg[2], kkv[2], kpr[2], vpr[2], rr[2];
        float ssq[4] = {0.f, 0.f, 0.f, 0.f}, bon[4] = {0.f, 0.f, 0.f, 0.f};
        float vf8[2][4];
#pragma unroll
        for (int ti = 0; ti < 2; ++ti)
#pragma unroll
            for (int r = 0; r < 4; ++r) vf8[ti][r] = 0.f;
        if (j == 1) {
#pragma unroll
            for (int ti = 0; ti < 2; ++ti)
#pragma unroll
                for (int r = 0; r < 4; ++r) vf8[ti][r] = VFb[(16 * tr + 4 * c4 + r) * D + 16 * (tcb + ti) + n];
        }
#pragma unroll
        for (int ti = 0; ti < 2; ++ti) {
            const int d = 16 * (tcb + ti) + n;
            const float w0 = w0b[d], a0 = a0b[d], kkw = kkb[d], kaw = kab[d], rkw = rkb[d];
            const float v0 = j ? v0b[d] : 0.f;
#pragma unroll
            for (int r = 0; r < 4; ++r) {
                const int o = (16 * tr + 4 * c4 + r) * D + d;
                const float kx = bf2f(e_k[ti][r]), vx = bf2f(e_v[ti][r]), rx = bf2f(e_r[ti][r]);
                const float z = -(w0 + wp[ti][r]), sp = fmaxf(z, 0.f) + __logf(1.0f + __expf(-fabsf(z)));
                lw[ti][r] = -__expf(-sp - 0.5f);
                const float a = fsig(a0 + ap[ti][r]);
                asg[ti][r] = a;
                float vv = vx;
                if (j == 0) VFb[o] = vx; else { const float vf = vf8[ti][r]; vv = vx + (vf - vx) * fsig(v0 + vp[ti][r]); }
                vpr[ti][r] = vv; rr[ti][r] = rx;
                const float kk = kx * kkw; kkv[ti][r] = kk; ssq[r] += kk * kk;
                const float kp = kx * (1.0f + (a - 1.0f) * kaw); kpr[ti][r] = kp; bon[r] += rx * kp * rkw;
                F32[(16 * tr + 4 * c4 + r) * 68 + d] = lw[ti][r];
                VM2b[o] = f2bf(vv);
            }
        }
#pragma unroll
        for (int r = 0; r < 4; ++r) { ssq[r] = g16_sum(ssq[r]); bon[r] = g16_sum(bon[r]); }
        if (n == 0) {
#pragma unroll
            for (int r = 0; r < 4; ++r) { const int t = 16 * tr + 4 * c4 + r; part[(t * 2 + (w & 1)) * 2 + 0] = ssq[r]; part[(t * 2 + (w & 1)) * 2 + 1] = bon[r]; }
        }
        if (it + (int)gridDim.x < 64 * NCH) CH_PREFETCH(it + (int)gridDim.x);
        CH_BAR();
        f32x4 cs[2];
#pragma unroll
        for (int ti = 0; ti < 2; ++ti) {
            f32x4 acc = {0.f, 0.f, 0.f, 0.f};
            for (int q = 0; q < 4 * (tr + 1); ++q) {
                const float av = (4 * q + c4 <= 16 * tr + n) ? 1.0f : 0.0f;
                acc = __builtin_amdgcn_mfma_f32_16x16x4f32(av, F32[(4 * q + c4) * 68 + 16 * (tcb + ti) + n], acc, 0, 0, 0);
            }
            cs[ti] = acc;
        }
        float inv[4];
#pragma unroll
        for (int r = 0; r < 4; ++r) { const int t = 16 * tr + 4 * c4 + r; inv[r] = rsqrtf(fmaxf(part[(t * 2 + 0) * 2] + part[(t * 2 + 1) * 2], 1e-24f));
            if (n == 0 && (w & 1) == 0) BONb[t * 16] = part[(t * 2 + 0) * 2 + 1] + part[(t * 2 + 1) * 2 + 1]; }
        f32x4 rt[2];
#pragma unroll
        for (int ti = 0; ti < 2; ++ti) {
            const int d = 16 * (tcb + ti) + n, t0 = 16 * tr + 4 * c4;
            f32x4 at, bt, kt;
#pragma unroll
            for (int r = 0; r < 4; ++r) {
                const float g = __expf(cs[ti][r]), gi = __expf(-cs[ti][r]), gm = __expf(cs[ti][r] - lw[ti][r]);
                const float kk = kkv[ti][r] * inv[r];
                at[r] = -kk * gm; bt[r] = kk * asg[ti][r] * gi; kt[r] = kpr[ti][r] * gi; rt[ti][r] = rr[ti][r] * g;
                CM(0)[(t0 + r) * CST + d] = f2bf(at[r]); CM(1)[(t0 + r) * CST + d] = f2bf(bt[r]); CM(2)[(t0 + r) * CST + d] = f2bf(kt[r]); CM(3)[(t0 + r) * CST + d] = f2bf(rt[ti][r]);
                if (t0 + r == 63) gLs[d] = g;
            }
            st_t4(CM(4), d, t0, at); st_t4(CM(5), d, t0, bt); st_t4(CM(6), d, t0, kt); st_t4(CM(7), d, t0, vpr[ti]);
        }
        CH_BAR();
#pragma unroll
        for (int ti = 0; ti < 2; ++ti) {
            const int tc = tcb + ti, s = 16 * tc + n, t0 = 16 * tr + 4 * c4;
            if (tc <= tr) {
                { f32x4 m = {0.f, 0.f, 0.f, 0.f}; m = cmm(CM(0), 16 * tr + n, CM(1), 16 * tc + n, c4, m);
#pragma unroll
                  for (int r = 0; r < 4; ++r) F32[(t0 + r) * 68 + s] = (s < t0 + r) ? m[r] : 0.f; }
                asm volatile("" ::: "memory");
                { f32x4 m = {0.f, 0.f, 0.f, 0.f}; m = cmm(CM(0), 16 * tr + n, CM(2), 16 * tc + n, c4, m);
#pragma unroll
                  for (int r = 0; r < 4; ++r) CM(8)[(t0 + r) * CST + s] = f2bf((s < t0 + r) ? m[r] : 0.f); }
                asm volatile("" ::: "memory");
                { f32x4 m = {0.f, 0.f, 0.f, 0.f}; m = cmm(CM(3), 16 * tr + n, CM(1), 16 * tc + n, c4, m);
#pragma unroll
                  for (int r = 0; r < 4; ++r) CM(9)[(t0 + r) * CST + s] = f2bf((s <= t0 + r) ? m[r] : 0.f); }
                asm volatile("" ::: "memory");
                { f32x4 m = {0.f, 0.f, 0.f, 0.f}; m = cmm(CM(3), 16 * tr + n, CM(2), 16 * tc + n, c4, m);
#pragma unroll
                  for (int r = 0; r < 4; ++r) CM(10)[(t0 + r) * CST + s] = f2bf((s <= t0 + r) ? m[r] : 0.f); }
                asm volatile("" ::: "memory");
            } else {
#pragma unroll
                for (int r = 0; r < 4; ++r) { F32[(t0 + r) * 68 + s] = 0.f; CM(8)[(t0 + r) * CST + s] = 0; CM(9)[(t0 + r) * CST + s] = 0; CM(10)[(t0 + r) * CST + s] = 0; }
            }
        }
        CH_BAR();
        { const int e0 = tid * 8;
#pragma unroll
          for (int e = 0; e < 8; ++e) { const int t = (e0 + e) >> 6, s_ = (e0 + e) & 63; CM(2)[t * CST + s_] = f2bf(F32[t * 68 + s_]); }
          unsigned z_ = 0u; asm volatile("" : "+v"(z_));
          *(LAS u32x4*)(CM(0) + (e0 >> 6) * CST + (e0 & 63)) = (u32x4){z_, z_, z_, z_}; }
        CH_BAR();
        if (w < 4) {
            const int cw = 16 * w;
            LAS float* scr = (LAS float*)CM(1) + w * (16 * 17);
#pragma unroll 1
            for (int I = 0; I < 4; ++I) {
                f32x4 rh = {0.f, 0.f, 0.f, 0.f};
                if (I > 0) { rh = __builtin_amdgcn_mfma_f32_16x16x32_bf16(cfrag(CM(2), 16 * I + n, 0, c4), cfrag(CM(0), cw + n, 0, c4), rh, 0, 0, 0);
                    if (I > 2) rh = __builtin_amdgcn_mfma_f32_16x16x32_bf16(cfrag(CM(2), 16 * I + n, 1, c4), cfrag(CM(0), cw + n, 1, c4), rh, 0, 0, 0); }
#pragma unroll
                for (int r = 0; r < 4; ++r) scr[(4 * c4 + r) * 17 + n] = rh[r] + ((16 * I + 4 * c4 + r) == (cw + n) ? 1.f : 0.f);
                wave_lds_fence();
                float x[16];
#pragma unroll
                for (int i = 0; i < 16; ++i) x[i] = scr[i * 17 + n];
                f32x4 mc[4], mn[4];
                mc[0] = *(const LAS f32x4*)(F32 + (16 * I + 1) * 68 + 16 * I);
#pragma unroll
                for (int i = 1; i < 16; ++i) {
                    if (i + 1 < 16) {
#pragma unroll
                        for (int j4 = 0; j4 < (i + 4) / 4; ++j4) mn[j4] = *(const LAS f32x4*)(F32 + (16 * I + i + 1) * 68 + 16 * I + 4 * j4);
                    }
                    float a0 = 0.f, a1 = 0.f;
#pragma unroll
                    for (int j4 = 0; j4 < (i + 3) / 4; ++j4) {
                        if (4 * j4 + 0 < i) a0 += mc[j4][0] * x[4 * j4 + 0];
                        if (4 * j4 + 1 < i) a1 += mc[j4][1] * x[4 * j4 + 1];
                        if (4 * j4 + 2 < i) a0 += mc[j4][2] * x[4 * j4 + 2];
                        if (4 * j4 + 3 < i) a1 += mc[j4][3] * x[4 * j4 + 3];
                    }
                    x[i] += a0 + a1;
#pragma unroll
                    for (int j4 = 0; j4 < 4; ++j4) mc[j4] = mn[j4];
                    asm volatile("" ::: "memory");
                }
                if (c4 == 0) {
#pragma unroll
                    for (int i = 0; i < 16; ++i) CM(3)[(16 * I + i) * CST + cw + n] = f2bf(x[i]);
                    u32x4 t0, t1;
                    t0.x = pk_bf16(x[0], x[1]); t0.y = pk_bf16(x[2], x[3]); t0.z = pk_bf16(x[4], x[5]); t0.w = pk_bf16(x[6], x[7]);
                    t1.x = pk_bf16(x[8], x[9]); t1.y = pk_bf16(x[10], x[11]); t1.z = pk_bf16(x[12], x[13]); t1.w = pk_bf16(x[14], x[15]);
                    *(LAS u32x4*)(CM(0) + (cw + n) * CST + 16 * I) = t0; *(LAS u32x4*)(CM(0) + (cw + n) * CST + 16 * I + 8) = t1;
                }
                wave_lds_fence();
            }
        }
        CH_BAR();
#pragma unroll
        for (int ti = 0; ti < 2; ++ti) {
            const int d = 16 * (tcb + ti) + n;
            { f32x4 x1 = {0.f, 0.f, 0.f, 0.f}; x1 = cmm(CM(8), 16 * tr + n, CM(7), 16 * (tcb + ti) + n, c4, x1); st_t4(CM(0), d, 16 * tr + 4 * c4, x1); }
            asm volatile("" ::: "memory");
            { f32x4 ta = {0.f, 0.f, 0.f, 0.f}; ta = cmm(CM(3), 16 * tr + n, CM(4), 16 * (tcb + ti) + n, c4, ta); st_t4(CM(1), d, 16 * tr + 4 * c4, ta); }
            asm volatile("" ::: "memory");
        }
        CH_BAR();
#pragma unroll
        for (int ti = 0; ti < 2; ++ti) {
            f32x4 uv = {0.f, 0.f, 0.f, 0.f};
            uv = cmm(CM(3), 16 * tr + n, CM(0), 16 * (tcb + ti) + n, c4, uv);
            st_t4(CM(2), 16 * (tcb + ti) + n, 16 * tr + 4 * c4, uv);
        }
        CH_BAR();
#pragma unroll
        for (int ti = 0; ti < 2; ++ti) {
            const int cc = 16 * (tcb + ti) + n, r0 = 16 * tr + 4 * c4;
            const float gl = gLs[cc];
            { f32x4 pm = {0.f, 0.f, 0.f, 0.f}; pm = cmm(CM(1), 16 * tr + n, CM(5), cc, c4, pm);
#pragma unroll
              for (int r = 0; r < 4; ++r) PCb[(r0 + r) * 64 + cc] = (pm[r] + ((r0 + r) == cc ? 1.f : 0.f)) * gl; }
            asm volatile("" ::: "memory");
            { f32x4 cm_ = {0.f, 0.f, 0.f, 0.f}; cm_ = cmm(CM(2), 16 * tr + n, CM(5), cc, c4, cm_); cm_ = cmm(CM(7), 16 * tr + n, CM(6), cc, c4, cm_);
#pragma unroll
              for (int r = 0; r < 4; ++r) CCb[(r0 + r) * 64 + cc] = cm_[r] * gl; }
            asm volatile("" ::: "memory");
            { f32x4 gg = {0.f, 0.f, 0.f, 0.f}; gg = cmm(CM(9), 16 * tr + n, CM(1), cc, c4, gg);
#pragma unroll
              for (int r = 0; r < 4; ++r) GMb[(r0 + r) * D + cc] = f2bf(gg[r] + rt[ti][r]); }
            asm volatile("" ::: "memory");
            { f32x4 y0 = {0.f, 0.f, 0.f, 0.f}; y0 = cmm(CM(9), 16 * tr + n, CM(2), cc, c4, y0); y0 = cmm(CM(10), 16 * tr + n, CM(7), cc, c4, y0);
#pragma unroll
              for (int r = 0; r < 4; ++r) Y0b[(r0 + r) * D + cc] = f2bf(y0[r]); }
            asm volatile("" ::: "memory");
        }
        CH_BAR();
    }
#undef CM
#undef CH_PREFETCH
#undef CH_BAR
}

__device__ __forceinline__ void phase_sample_mixer_w(KP p, int j, int first, int stride) {
    const int tid = TID(), lane = tid & 63;
    {
        const bf16_t *RB = WSP(bf16_t, WS_RB), *KB = WSP(bf16_t, WS_KB), *VB = WSP(bf16_t, WS_VB); bf16_t* YG = WSP(bf16_t, WS_YG);
        const float *WPp = WSP(float, WS_WP), *APp = WSP(float, WS_AP), *VPp = WSP(float, WS_VP), *GG = WSP(float, WS_GG); float* VF = WSP(float, WS_VFIRST);
        for (int it = first; it < 512; it += stride) {
            const int b = it >> 4, h = it & 15, col = h * 64 + lane;
            const float* s0 = p->state_wkv + (((size_t)j * 32 + b) * 16 + h) * 4096 + lane * 64;
            float S[64];
#pragma unroll
            for (int k = 0; k < 64; k += 4) { const f32x4 t = *(const f32x4*)(s0 + k); S[k] = t[0]; S[k + 1] = t[1]; S[k + 2] = t[2]; S[k + 3] = t[3]; }
            const float w0 = p->rw_w0[j * D + col], a0 = p->rw_a0[j * D + col], kkw = p->rw_k_k[j * D + col], kaw = p->rw_k_a[j * D + col], rkw = p->rw_r_k[j * D + col];
            const float v0 = j ? p->rw_v0[(j - 1) * D + col] : 0.f, lnw = p->rw_lnx_w[j * D + col], lnb = p->rw_lnx_b[j * D + col];
            for (int t = 0; t < 8; ++t) {
                const size_t o = (size_t)(NP + b * 8 + t) * D + col;
                const float kx = bf2f(KB[o]), vx = bf2f(VB[o]), r = bf2f(RB[o]);
                const float z = -(w0 + WPp[o]), sp = fmaxf(z, 0.f) + log1pf(expf(-fabsf(z)));
                const float wd = expf(-expf(-sp - 0.5f)), asg = sigmoidf_(a0 + APp[o]);
                float v = vx;
                if (j == 0) VF[o] = vx; else { const float vf = VF[o]; v = vx + (vf - vx) * sigmoidf_(v0 + VPp[o]); }
                float kk = kx * kkw; const float ss = wave_sum(kk * kk); kk *= rsqrtf(fmaxf(ss, 1e-24f));
                const float kp = kx * (1.0f + (asg - 1.0f) * kaw), a = -kk, bq = kk * asg;
                float sa = 0.f;
#pragma unroll
                for (int k = 0; k < 64; ++k) sa += S[k] * rl(a, k);
#pragma unroll
                for (int k = 0; k < 64; ++k) S[k] = S[k] * rl(wd, k) + sa * rl(bq, k) + v * rl(kp, k);
                float y = 0.f;
#pragma unroll
                for (int k = 0; k < 64; ++k) y += S[k] * rl(r, k);
                const float mu = wave_sum(y) * (1.0f / 64.0f), dy = y - mu, var = wave_sum(dy * dy) * (1.0f / 64.0f);
                const float bonus = wave_sum(r * kp * rkw);
                YG[o] = f2bf((dy * rsqrtf(var + 64e-5f) * lnw + lnb + bonus * v) * GG[o]);
            }
            float* so = p->out + O_WKVS + (((size_t)j * 32 + b) * 16 + h) * 4096 + lane * 64;
#pragma unroll
            for (int k = 0; k < 64; k += 4) *(f32x4*)(so + k) = (f32x4){S[k], S[k + 1], S[k + 2], S[k + 3]};
        }
    }
}
__device__ __forceinline__ void phase_carry(KP p, int j, LAS unsigned char* lds) {
    const float *PCH = WSP(float, WS_PCH), *CCH = WSP(float, WS_CCH); float* SST = WSP(float, WS_SST);
    LAS float* Sl = (LAS float*)lds;
    LAS unsigned* cflag = (LAS unsigned*)(lds + 9216);
    if (TID() == 0) *cflag = 0u;
    __syncthreads();
    unsigned arrivals = 0u;
    if ((TID() >> 6) >= 4) { phase_sample_mixer_w(p, j, BID() * 4 + ((TID() >> 6) - 4), (int)gridDim.x * 4); }
    else
    for (int it = BID(); it < 256; it += gridDim.x) {
        const int wave = TID() >> 6, sh = it >> 2, row0 = 16 * (it & 3), col0 = 16 * (wave & 3), b = sh >> 4, h = sh & 15;
        const bool act = true;
        f32x4 acc = {0.f, 0.f, 0.f, 0.f}, c0, c1, c2;
        float b0[16], b1[16], b2[16];
#define CARRY_LOAD(BX, CX, cc_) do { const int l_ = TID() & 63, ln = l_ & 15, lq = l_ >> 4; \
            const float* Pc = PCH + ((size_t)sh * NCH + (cc_)) * 4096; const float* Cc = CCH + ((size_t)sh * NCH + (cc_)) * 4096; \
            _Pragma("unroll") for (int q = 0; q < 16; ++q) BX[q] = Pc[(4 * q + lq) * 64 + col0 + ln]; \
            _Pragma("unroll") for (int r = 0; r < 4; ++r) CX[r] = Cc[(row0 + 4 * lq + r) * 64 + col0 + ln]; } while (0)
#define CARRY_STEP(BX, CX, BL, CL, c_) do { const int l_ = TID() & 63, ln = l_ & 15, lq = l_ >> 4; \
            LAS float* Sw = Sl + ((c_) & 1) * (16 * 68); bf16_t* go = (bf16_t*)SST + ((size_t)sh * NCH + (c_)) * 4096; \
            if (act) { _Pragma("unroll") for (int r = 0; r < 4; ++r) Sw[(4 * lq + r) * 68 + col0 + ln] = acc[r]; } \
            const f32x4 sc = acc; acc = CX; \
            asm volatile("s_waitcnt lgkmcnt(0)" ::: "memory"); arrivals += 4u; \
            if ((TID() & 63) == 0) __hip_atomic_fetch_add(cflag, 1u, __ATOMIC_RELAXED, __HIP_MEMORY_SCOPE_WORKGROUP); \
            { unsigned sp_ = 0; while (__builtin_amdgcn_readfirstlane(__hip_atomic_load(cflag, __ATOMIC_RELAXED, __HIP_MEMORY_SCOPE_WORKGROUP)) < arrivals && ++sp_ < (1u << 22)) __builtin_amdgcn_s_sleep(0); } \
            asm volatile("" ::: "memory"); \
            if (act) { \
                _Pragma("unroll") for (int r = 0; r < 4; ++r) go[(row0 + 4 * lq + r) * 64 + col0 + ln] = f2bf(sc[r]); \
                if ((c_) + 2 < NCH) CARRY_LOAD(BL, CL, (c_) + 2); \
                float av[16]; _Pragma("unroll") for (int q = 0; q < 16; ++q) av[q] = Sw[ln * 68 + 4 * q + lq]; \
                asm volatile("s_waitcnt lgkmcnt(0)" ::: "memory"); \
                _Pragma("unroll") for (int q = 0; q < 16; ++q) acc = __builtin_amdgcn_mfma_f32_16x16x4f32(av[q], BX[q], acc, 0, 0, 0); } } while (0)
        if (act) { CARRY_LOAD(b0, c0, 0); CARRY_LOAD(b1, c1, 1); }
        for (int c = 0; c < NCH; c += 3) {
            CARRY_STEP(b0, c0, b2, c2, c);
            if (c + 1 < NCH) CARRY_STEP(b1, c1, b0, c0, c + 1);
            if (c + 2 < NCH) CARRY_STEP(b2, c2, b1, c1, c + 2);
        }
        if (act) { const int l_ = TID() & 63, ln = l_ & 15, lq = l_ >> 4; float* go = p->out + O_WKVP + (((size_t)j * 4 + b) * 16 + h) * 4096;
#pragma unroll
            for (int r = 0; r < 4; ++r) go[(row0 + 4 * lq + r) * 64 + col0 + ln] = acc[r]; }
#undef CARRY_LOAD
#undef CARRY_STEP
    }
    __syncthreads();
}
__device__ __forceinline__ void phase_sample_mixer(KP p, int j) {
    const int tid = TID(), lane = tid & 63, wave = tid >> 6;
    {
        const bf16_t *RB = WSP(bf16_t, WS_RB), *KB = WSP(bf16_t, WS_KB), *VB = WSP(bf16_t, WS_VB); bf16_t* YG = WSP(bf16_t, WS_YG);
        const float *WPp = WSP(float, WS_WP), *APp = WSP(float, WS_AP), *VPp = WSP(float, WS_VP), *GG = WSP(float, WS_GG); float* VF = WSP(float, WS_VFIRST);
        for (int it = BID() * 8 + wave; it < 512; it += gridDim.x * 8) {
            const int b = it >> 4, h = it & 15, col = h * 64 + lane;
            const float* s0 = p->state_wkv + (((size_t)j * 32 + b) * 16 + h) * 4096 + lane * 64;
            float S[64];
#pragma unroll
            for (int k = 0; k < 64; k += 4) { const f32x4 t = *(const f32x4*)(s0 + k); S[k] = t[0]; S[k + 1] = t[1]; S[k + 2] = t[2]; S[k + 3] = t[3]; }
            const float w0 = p->rw_w0[j * D + col], a0 = p->rw_a0[j * D + col], kkw = p->rw_k_k[j * D + col], kaw = p->rw_k_a[j * D + col], rkw = p->rw_r_k[j * D + col];
            const float v0 = j ? p->rw_v0[(j - 1) * D + col] : 0.f, lnw = p->rw_lnx_w[j * D + col], lnb = p->rw_lnx_b[j * D + col];
            for (int t = 0; t < 8; ++t) {
                const size_t o = (size_t)(NP + b * 8 + t) * D + col;
                const float kx = bf2f(KB[o]), vx = bf2f(VB[o]), r = bf2f(RB[o]);
                const float z = -(w0 + WPp[o]), sp = fmaxf(z, 0.f) + log1pf(expf(-fabsf(z)));
                const float wd = expf(-expf(-sp - 0.5f)), asg = sigmoidf_(a0 + APp[o]);
                float v = vx;
                if (j == 0) VF[o] = vx; else { const float vf = VF[o]; v = vx + (vf - vx) * sigmoidf_(v0 + VPp[o]); }
                float kk = kx * kkw; const float ss = wave_sum(kk * kk); kk *= rsqrtf(fmaxf(ss, 1e-24f));
                const float kp = kx * (1.0f + (asg - 1.0f) * kaw), a = -kk, bq = kk * asg;
                float sa = 0.f;
#pragma unroll
                for (int k = 0; k < 64; ++k) sa += S[k] * rl(a, k);
#pragma unroll
                for (int k = 0; k < 64; ++k) S[k] = S[k] * rl(wd, k) + sa * rl(bq, k) + v * rl(kp, k);
                float y = 0.f;
#pragma unroll
                for (int k = 0; k < 64; ++k) y += S[k] * rl(r, k);
                const float mu = wave_sum(y) * (1.0f / 64.0f), dy = y - mu, var = wave_sum(dy * dy) * (1.0f / 64.0f);
                const float bonus = wave_sum(r * kp * rkw);
                YG[o] = f2bf((dy * rsqrtf(var + 64e-5f) * lnw + lnb + bonus * v) * GG[o]);
            }
            float* so = p->out + O_WKVS + (((size_t)j * 32 + b) * 16 + h) * 4096 + lane * 64;
#pragma unroll
            for (int k = 0; k < 64; k += 4) *(f32x4*)(so + k) = (f32x4){S[k], S[k + 1], S[k + 2], S[k + 3]};
        }
    }
}
__device__ __forceinline__ void phase_post2(KP p, int j, LAS unsigned char* lds) {
    LAS float* part = (LAS float*)lds;
    const bf16_t *GM = WSP(bf16_t, WS_DEC), *VM2 = WSP(bf16_t, WS_KM), *TG = WSP(bf16_t, WS_TG), *G2T = WSP(bf16_t, WS_G2T) + (size_t)j * D * 160;
    const float *Y0 = WSP(float, WS_Y), *BON = WSP(float, WS_AV), *SST = WSP(float, WS_SST); bf16_t* YG = WSP(bf16_t, WS_YG);
    for (int it = BID(); it < 64 * NCH; it += gridDim.x) {
        const int tid = TID(), lane = tid & 63, w = tid >> 6, n = lane & 15, c4 = lane >> 4, tr = w >> 1, tcb = 2 * (w & 1);
        const int sh = it / NCH, c = it % NCH, b = sh >> 4, h = sh & 15, R0 = b * 4096 + c * LCH, hc = h * 64;
        f32x4 y[2], g[2];
        const size_t ar = (size_t)(R0 + 16 * tr + n);
#pragma unroll
        for (int ti = 0; ti < 2; ++ti) {
            const int dv = 16 * (tcb + ti) + n;
            f32x4 acc = {0.f, 0.f, 0.f, 0.f}, gacc = acc;
#pragma unroll
            for (int ks = 0; ks < 2; ++ks) {
                const bf16x8 af = *(const bf16x8*)(GM + ar * D + hc + 32 * ks + 8 * c4);
                const bf16x8 bw = *(const bf16x8*)((const bf16_t*)SST + ((size_t)it * 64 + dv) * 64 + 32 * ks + 8 * c4);
                acc = __builtin_amdgcn_mfma_f32_16x16x32_bf16(af, bw, acc, 0, 0, 0);
            }
#pragma unroll
            for (int ks = 0; ks < 5; ++ks)
                gacc = __builtin_amdgcn_mfma_f32_16x16x32_bf16(*(const bf16x8*)(TG + ar * 160 + 32 * ks + 8 * c4), *(const bf16x8*)(G2T + (size_t)(hc + dv) * 160 + 32 * ks + 8 * c4), gacc, 0, 0, 0);
#pragma unroll
            for (int r = 0; r < 4; ++r) acc[r] += bf2f(((const bf16_t*)Y0)[(size_t)(R0 + 16 * tr + 4 * c4 + r) * D + hc + dv]);
            y[ti] = acc; g[ti] = gacc;
        }
        float bonus4[4]; unsigned short vm4[2][4]; float lnw2[2], lnb2[2];
#pragma unroll
        for (int r = 0; r < 4; ++r) bonus4[r] = BON[(size_t)(R0 + 16 * tr + 4 * c4 + r) * 16 + h];
#pragma unroll
        for (int ti = 0; ti < 2; ++ti) { const int col = hc + 16 * (tcb + ti) + n; lnw2[ti] = p->rw_lnx_w[j * D + col]; lnb2[ti] = p->rw_lnx_b[j * D + col];
#pragma unroll
            for (int r = 0; r < 4; ++r) vm4[ti][r] = VM2[(size_t)(R0 + 16 * tr + 4 * c4 + r) * D + col]; }
        float s1[4], s2[4];
#pragma unroll
        for (int r = 0; r < 4; ++r) { s1[r] = g16_sum(y[0][r] + y[1][r]); s2[r] = g16_sum(y[0][r] * y[0][r] + y[1][r] * y[1][r]); }
        asm volatile("s_waitcnt lgkmcnt(0)" ::: "memory"); __builtin_amdgcn_s_barrier(); asm volatile("" ::: "memory");
        if (n == 0) {
#pragma unroll
            for (int r = 0; r < 4; ++r) { const int t = 16 * tr + 4 * c4 + r; part[(t * 2 + (w & 1)) * 2 + 0] = s1[r]; part[(t * 2 + (w & 1)) * 2 + 1] = s2[r]; }
        }
        asm volatile("s_waitcnt lgkmcnt(0)" ::: "memory"); __builtin_amdgcn_s_barrier(); asm volatile("" ::: "memory");
#pragma unroll
        for (int r = 0; r < 4; ++r) {
            const int t = 16 * tr + 4 * c4 + r;
            const float mu = (part[(t * 2 + 0) * 2] + part[(t * 2 + 1) * 2]) * (1.0f / 64.0f), ex2 = (part[(t * 2 + 0) * 2 + 1] + part[(t * 2 + 1) * 2 + 1]) * (1.0f / 64.0f);
            const float rs = rsqrtf(fmaxf(ex2 - mu * mu, 0.f) + 64e-5f), bonus = bonus4[r];
#pragma unroll
            for (int ti = 0; ti < 2; ++ti) {
                const int col = hc + 16 * (tcb + ti) + n; const size_t o = (size_t)(R0 + t) * D + col;
                YG[o] = f2bf(((y[ti][r] - mu) * rs * lnw2[ti] + lnb2[ti] + bonus * bf2f(vm4[ti][r])) * g[ti][r]);
            }
        }
    }
    __syncthreads();
}

__device__ __forceinline__ void phase_post(KP p, int j) {
    const float *Y = WSP(float, WS_Y), *KM = WSP(float, WS_KM), *VM = WSP(float, WS_VM), *GG = WSP(float, WS_GG);
    const bf16_t* RB = WSP(bf16_t, WS_RB); bf16_t* YG = WSP(bf16_t, WS_YG);
    const int lane = TID() & 63, gw = BID() * 8 + (TID() >> 6), nw = gridDim.x * 8;
    for (int row = gw; row < NT; row += nw) {
#pragma unroll
        for (int i = 0; i < 4; ++i) {
            const int col = 256 * i + 4 * lane; const size_t o = (size_t)row * D + col;
            const f32x4 y = *(const f32x4*)(Y + o), r = ld_bf4(RB + o), km = *(const f32x4*)(KM + o), vm = *(const f32x4*)(VM + o), gg = *(const f32x4*)(GG + o);
            const f32x4 lw = *(const f32x4*)(p->rw_lnx_w + j * D + col), lb = *(const f32x4*)(p->rw_lnx_b + j * D + col), rk = *(const f32x4*)(p->rw_r_k + j * D + col);
            const float mu = g16_sum(y[0] + y[1] + y[2] + y[3]) * (1.0f / 64.0f);
            const f32x4 d = y - mu;
            const float var = g16_sum(d[0] * d[0] + d[1] * d[1] + d[2] * d[2] + d[3] * d[3]) * (1.0f / 64.0f);
            const float rs = rsqrtf(var + 64e-5f);
            const float bon = g16_sum(r[0] * km[0] * rk[0] + r[1] * km[1] * rk[1] + r[2] * km[2] * rk[2] + r[3] * km[3] * rk[3]);
            st_bf4(YG + o, (d * rs * lw + lb + bon * vm) * gg);
        }
    }
}

__constant__ double kRopeInv[8] = {1.0, 0.19392274474868576, 0.03760603093086393, 0.007292664737217109, 0.001414213562373095, 0.0002742481756762073, 5.318295896944988e-05, 1.031338537721246e-05};
__device__ __forceinline__ void phase_dsapost(KP p, int j) {
    const bf16_t* PR = WSP(bf16_t, WS_PR); float *Q = WSP(float, WS_Q), *QI = WSP(float, WS_QI), *WI = WSP(float, WS_WI);
    const int lane = TID() & 63, l16 = lane & 15, gw = BID() * 8 + (TID() >> 6), nw = gridDim.x * 8;
    const f32x4 qn = *(const f32x4*)(p->att_q_norm + j * 64 + 4 * l16), kn = *(const f32x4*)(p->att_k_norm + j * 64 + 4 * l16), in = *(const f32x4*)(p->idx_k_norm + j * 64 + 4 * l16);
    for (int row = gw; row < NT; row += nw) {
        const int pos = row_pos(row);
        const bf16_t* pr = PR + (size_t)row * PINP;
        f32x4 cs = {1.f, 1.f, 1.f, 1.f}, sn = {0.f, 0.f, 0.f, 0.f};
        if (l16 < 4) {
#pragma unroll
            for (int e = 0; e < 4; ++e) { double ang = (double)pos * kRopeInv[4 * (l16 & 1) + e]; ang -= floor(ang * 0.15915494309189535) * 6.283185307179586; const float af = (float)ang; cs[e] = cosf(af); sn[e] = sinf(af); }
        }
        const float sgn = (l16 < 2) ? -1.0f : 1.0f;
#define ROPE4(v) do { f32x4 _o; _o[0] = __shfl_xor((v)[0], 2); _o[1] = __shfl_xor((v)[1], 2); _o[2] = __shfl_xor((v)[2], 2); _o[3] = __shfl_xor((v)[3], 2); if (l16 < 4) (v) = (v) * cs + sgn * (_o * sn); } while (0)
#define HNORM4(v, w) do { const float _ss = g16_sum((v)[0] * (v)[0] + (v)[1] * (v)[1] + (v)[2] * (v)[2] + (v)[3] * (v)[3]); (v) = (v) * rsqrtf(_ss * (1.0f / 64.0f) + 1e-6f) * (w); } while (0)
#pragma unroll
        for (int i = 0; i < 4; ++i) { f32x4 v = ld_bf4(pr + 256 * i + 4 * lane); HNORM4(v, qn); ROPE4(v); st_bf4((bf16_t*)Q + (size_t)row * D + 256 * i + 4 * lane, v); }
        { f32x4 v = ld_bf4(pr + 1024 + 4 * lane); HNORM4(v, kn); ROPE4(v);
          float* ko = row < NP ? p->out + O_KP + ((size_t)j * NP + row) * 256 : p->out + O_KS + ((size_t)j * NS + (row - NP)) * 256; *(f32x4*)(ko + 4 * lane) = v; *(unsigned*)(WSP(unsigned char, WS_K8) + (size_t)row * 256 + 4 * lane) = pk_fp8x4(v); }
        { const f32x4 v = ld_bf4(pr + 1280 + 4 * lane);
          float* vo = row < NP ? p->out + O_VP + ((size_t)j * NP + row) * 256 : p->out + O_VS + ((size_t)j * NS + (row - NP)) * 256; *(f32x4*)(vo + 4 * lane) = v; *(unsigned*)(WSP(unsigned char, WS_V8) + (size_t)row * 256 + 4 * lane) = pk_fp8x4(v); }
#pragma unroll
        for (int i = 0; i < 2; ++i) { f32x4 v = ld_bf4(pr + 1536 + 256 * i + 4 * lane); ROPE4(v); st_bf4(WSP(bf16_t, WS_QIB) + (size_t)row * 512 + 256 * i + 4 * lane, v); }
        { f32x4 v = ld_bf4(pr + 2048 + 4 * l16); HNORM4(v, in); ROPE4(v);
          float* io = row < NP ? p->out + O_IKP + ((size_t)j * NP + row) * 64 : p->out + O_IKS + ((size_t)j * NS + (row - NP)) * 64; if (lane < 16) { *(f32x4*)(io + 4 * lane) = v; st_bf4(WSP(bf16_t, WS_KIB) + (size_t)row * 64 + 4 * lane, v); } }
        if (lane < 2) { const f32x4 v = ld_bf4(pr + 2112 + 4 * lane); *(f32x4*)(WI + (size_t)row * 8 + 4 * lane) = v * 0.35355339059327373f; }
#undef ROPE4
#undef HNORM4
    }
}

template <bool SAMPLE>
__device__ __forceinline__ void phase_idx(KP p, int j, LAS unsigned char* lds) {
    LAS float* Qs = (LAS float*)lds;
    LAS float* Ks = (LAS float*)(lds + 32768);
    const float *QI = WSP(float, WS_QI), *WI = WSP(float, WS_WI);
    const int tid = TID(), q = tid >> 5, kx = tid & 31;
    const int nitems = SAMPLE ? 32 * 65 : 1024;
    for (int it = BID(); it < nitems; it += gridDim.x) {
        int b, t0, rowbase, nkt, kt0 = 0;
        if (SAMPLE) { b = it / 65; kt0 = it % 65; t0 = 0; rowbase = NP + b * 8; nkt = kt0 + 1; }
        else { const int k4 = it >> 8, w = it & 255, i = (k4 & 1) ? (k4 * 256 + 255 - w) : (k4 * 256 + w); b = i & 3; t0 = (i >> 2) * 16; rowbase = b * 4096 + t0; nkt = (t0 + 15) / 128 + 1; }
        const int nq = SAMPLE ? 8 : 16;
        __syncthreads();
#pragma unroll
        for (int n = 0; n < 16; ++n) { const int e = tid + 512 * n, qq = e >> 9, c = e & 511, h = c >> 6, d = c & 63;
            Qs[(d * 16 + qq) * 8 + h] = qq < nq ? QI[(size_t)(rowbase + qq) * 512 + c] : 0.f; }
        float wi[8];
#pragma unroll
        for (int h = 0; h < 8; ++h) wi[h] = q < nq ? WI[(size_t)(rowbase + q) * 8 + h] : 0.f;
        for (int kt = kt0; kt < nkt; ++kt) {
            __syncthreads();
#pragma unroll
            for (int n = 0; n < 16; ++n) { const int e = tid + 512 * n, key = e >> 6, d = e & 63, s = kt * 128 + key; float v = 0.f;
                if (SAMPLE) {
                    if (s < PAST) { const int pg = p->page_table[b * 64 + (s >> 7)]; v = p->cache_ik[(((size_t)j * 2560 + pg) * 128 + (s & 127)) * 64 + d]; }
                    else if (s < PAST + 8) v = p->out[O_IKS + ((size_t)j * NS + b * 8 + (s - PAST)) * 64 + d];
                } else v = p->out[O_IKP + ((size_t)j * NP + b * 4096 + s) * 64 + d];
                Ks[d * 132 + key] = v; }
            __syncthreads();
            f32x4 acc[8];
#pragma unroll
            for (int h = 0; h < 8; ++h) acc[h] = (f32x4){0.f, 0.f, 0.f, 0.f};
#pragma unroll 4
            for (int d = 0; d < 64; ++d) {
                const f32x4 qa = *(const LAS f32x4*)(Qs + (d * 16 + q) * 8), qb = *(const LAS f32x4*)(Qs + (d * 16 + q) * 8 + 4), kv = *(const LAS f32x4*)(Ks + d * 132 + 4 * kx);
                acc[0] += qa[0] * kv; acc[1] += qa[1] * kv; acc[2] += qa[2] * kv; acc[3] += qa[3] * kv;
                acc[4] += qb[0] * kv; acc[5] += qb[1] * kv; acc[6] += qb[2] * kv; acc[7] += qb[3] * kv;
            }
            f32x4 sc = {0.f, 0.f, 0.f, 0.f};
#pragma unroll
            for (int h = 0; h < 8; ++h)
#pragma unroll
                for (int e = 0; e < 4; ++e) sc[e] += fmaxf(acc[h][e] * 0.125f, 0.f) * wi[h];
            if (q < nq) {
                if (SAMPLE) *(f32x4*)(WSP(float, WS_SCS) + (size_t)(b * 8 + q) * SCS_LD + kt * 128 + 4 * kx) = sc;
                else *(f32x4*)(WSP(float, WS_SC) + ((size_t)b * 4096 + t0 + q) * 4096 + kt * 128 + 4 * kx) = sc;
            }
        }
    }
    __syncthreads();
}

template <bool SAMPLE>
__device__ __forceinline__ void phase_idx2(KP p, int j) {
    const bf16_t *QIB = WSP(bf16_t, WS_QIB), *KIB = WSP(bf16_t, WS_KIB); const float* WI = WSP(float, WS_WI);
    const int lane = TID() & 63, lr = lane & 31, lh = lane >> 5, gw = BID() * 8 + (TID() >> 6), nw = gridDim.x * 8;
    const int nitems = SAMPLE ? 32 * 65 : 4096;
    for (int it = gw; it < nitems; it += nw) {
        int b, rowbase, tile0, ntile;
        if (SAMPLE) { b = it / 65; rowbase = NP + b * 8; tile0 = (it % 65) * 4; ntile = min(4, 257 - tile0); }
        else { const int sub = it >= 2048, w_ = it & 2047; b = w_ & 3; const int wb = w_ >> 2, kk = sub ? 511 - wb : wb, nt = (kk * 8 + 7) / 32 + 1;
            rowbase = b * 4096 + kk * 8; tile0 = sub ? (nt >> 1) : 0; ntile = sub ? nt - (nt >> 1) : (nt >> 1); }
        if (ntile <= 0) continue;
        bf16x8 af[2][4]; float w[2][2][8];
        { const int hd = (lr & 3) + 4 * ((lr >> 3) & 1), jq = 2 * ((lr >> 2) & 1) + (lr >> 4);
#pragma unroll
          for (int st = 0; st < 2; ++st)
#pragma unroll
              for (int ks = 0; ks < 4; ++ks) af[st][ks] = *(const bf16x8*)(QIB + (size_t)(rowbase + 4 * st + jq) * 512 + hd * 64 + 16 * ks + 8 * lh);
#pragma unroll
          for (int st = 0; st < 2; ++st)
#pragma unroll
              for (int q = 0; q < 2; ++q) { const f32x4 w0 = *(const f32x4*)(WI + (size_t)(rowbase + 4 * st + 2 * lh + q) * 8), w1 = *(const f32x4*)(WI + (size_t)(rowbase + 4 * st + 2 * lh + q) * 8 + 4);
#pragma unroll
                  for (int e = 0; e < 4; ++e) { w[st][q][e] = w0[e] * 0.125f; w[st][q][4 + e] = w1[e] * 0.125f; } } }
#define IDX_LOADB(BF, tl_) do { const int s_ = (tile0 + (tl_)) * 32 + lr; \
            if (!SAMPLE) { _Pragma("unroll") for (int ks = 0; ks < 4; ++ks) BF[ks] = *(const bf16x8*)(KIB + ((size_t)b * 4096 + s_) * 64 + 16 * ks + 8 * lh); } \
            else { const float* kp = p->out + O_IKS + ((size_t)j * NS + b * 8) * 64; \
                if (s_ < PAST) kp = p->cache_ik + (((size_t)j * 2560 + p->page_table[b * 64 + (s_ >> 7)]) * 128 + (s_ & 127)) * 64; else kp += (size_t)min(s_ - PAST, 7) * 64; \
                _Pragma("unroll") for (int ks = 0; ks < 4; ++ks) { const f32x4 x0 = *(const f32x4*)(kp + 16 * ks + 8 * lh), x1 = *(const f32x4*)(kp + 16 * ks + 8 * lh + 4); \
                    const u32x4 wv = {pk_bf16(x0[0], x0[1]), pk_bf16(x0[2], x0[3]), pk_bf16(x1[0], x1[1]), pk_bf16(x1[2], x1[3])}; BF[ks] = __builtin_bit_cast(bf16x8, wv); } } } while (0)
        bf16x8 bnx[4];
        IDX_LOADB(bnx, 0);
        for (int tl = 0; tl < ntile; ++tl) {
            const int s = (tile0 + tl) * 32 + lr;
            bf16x8 bfr[4];
#pragma unroll
            for (int ks = 0; ks < 4; ++ks) bfr[ks] = bnx[ks];
            if (tl + 1 < ntile) IDX_LOADB(bnx, tl + 1);
            __builtin_amdgcn_sched_barrier(0);
#pragma unroll
            for (int st = 0; st < 2; ++st) {
                f32x16 acc;
#pragma unroll
                for (int r = 0; r < 16; ++r) acc[r] = 0.f;
#pragma unroll
                for (int ks = 0; ks < 4; ++ks) acc = __builtin_amdgcn_mfma_f32_32x32x16_bf16(af[st][ks], bfr[ks], acc, 0, 0, 0);
#pragma unroll
                for (int q = 0; q < 2; ++q) {
                    float sc = 0.f;
#pragma unroll
                    for (int hh = 0; hh < 2; ++hh)
#pragma unroll
                        for (int hl = 0; hl < 4; ++hl) sc += fmaxf(acc[4 * (2 * q + hh) + hl], 0.f) * w[st][q][hl + 4 * hh];
                    if (SAMPLE) WSP(float, WS_SCS)[(size_t)(b * 8 + 4 * st + 2 * lh + q) * SCS_LD + s] = sc;
                    else WSP(float, WS_SC)[((size_t)rowbase + 4 * st + 2 * lh + q) * 4096 + s] = sc;
                }
            }
        }
    }
#undef IDX_LOADB
}

__device__ __forceinline__ unsigned fkey(float f) { f = (f == 0.f) ? 0.f : f; const unsigned u = __float_as_uint(f); return (u & 0x80000000u) ? ~u : (u | 0x80000000u); }
__device__ __forceinline__ void phase_topk_prompt(KP p) {
    const float* SC = WSP(float, WS_SC); int* SEL = WSP(int, WS_SEL); int* CNT = WSP(int, WS_CNT);
    const int lane = TID() & 63, gw = BID() * 8 + (TID() >> 6), nw = gridDim.x * 8;
    for (int qi = gw; qi < NP; qi += nw) {
        const int b = qi & 3, tt = qi >> 2, t = (tt & 1) ? 4095 - (tt >> 1) : (tt >> 1), row = b * 4096 + t, n = t + 1;
        int* sel = SEL + (size_t)row * 256;
        if (n <= TOPK) { for (int s = lane; s < n; s += 64) sel[s] = s; if (lane == 0) CNT[row] = n; continue; }
        const float* base = SC + (size_t)row * 4096;
        unsigned u[64];
#pragma unroll
        for (int m = 0; m < 64; ++m) u[m] = __float_as_uint(base[lane + 64 * m]);
#pragma unroll
        for (int m = 0; m < 64; ++m) { const unsigned k_ = fkey(__uint_as_float(u[m])); u[m] = (lane + 64 * m < n) ? k_ : 0u; }
        unsigned tau = 0u;
#pragma unroll 1
        for (int bit = 31; bit >= 0; --bit) {
            const unsigned cand = tau | (1u << bit); int c = 0;
#pragma unroll
            for (int m = 0; m < 64; ++m) c += (u[m] >= cand) ? 1 : 0;
            c = wave_sum_i(c);
            if (c >= TOPK) tau = cand;
            if (c == TOPK) break;
        }
        int cg = 0, ct = 0; unsigned tlo = 0u, thi = 0u;
#pragma unroll
        for (int m = 31; m >= 0; --m) { cg += (u[m] > tau) ? 1 : 0; const unsigned tie = (u[m] == tau) ? 1u : 0u; ct += (int)tie; tlo = (tlo << 1) | tie; }
#pragma unroll
        for (int m = 63; m >= 32; --m) { cg += (u[m] > tau) ? 1 : 0; const unsigned tie = (u[m] == tau) ? 1u : 0u; ct += (int)tie; thi = (thi << 1) | tie; }
        unsigned long long tmask = ((unsigned long long)thi << 32) | tlo;
        const int totg = wave_sum_i(cg), tott = wave_sum_i(ct);
        const int need = TOPK - totg;
        unsigned long long smask = 0ull;
        if (tott == need) smask = tmask;
        else {
#pragma unroll 1
            for (int it = 0; it < need; ++it) {
                const int m0 = tmask ? (int)__builtin_ctzll(tmask) : 64;
                const int cand = tmask ? (lane + 64 * m0) : 0x7fffffff, best = wave_min_i(cand);
                if (cand == best && tmask) { smask |= (1ull << m0); tmask &= ~(1ull << m0); }
            }
        }
        const int mine = cg + __popcll(smask);
        int incl = mine;
#pragma unroll
        for (int d = 1; d < 64; d <<= 1) { const int o = __shfl_up(incl, d); if (lane >= d) incl += o; }
        int off = incl - mine;
#pragma unroll
        for (int m = 0; m < 64; ++m) { if ((u[m] > tau) || ((smask >> m) & 1ull)) { sel[off] = lane + 64 * m; ++off; } }
        if (lane == 0) CNT[row] = TOPK;
    }
}
__device__ __forceinline__ void phase_topk_sample(KP p, LAS unsigned char* lds) {
    LAS unsigned* ckey = (LAS unsigned*)lds;
    LAS int* cidx = (LAS int*)(lds + 8192);
    const float* SCS = WSP(float, WS_SCS); int* SEL = WSP(int, WS_SEL); int* CNT = WSP(int, WS_CNT);
    for (int qq = BID(); qq < NS; qq += gridDim.x) {
        const int tid = TID(), lane = tid & 63, wave = tid >> 6;
        const int n = PAST + 1 + (qq & 7), row = NP + qq, s0 = 1088 * wave;
        const float* base = SCS + (size_t)qq * SCS_LD;
        unsigned u[17];
#pragma unroll
        for (int m = 0; m < 17; ++m) { const int s = s0 + lane + 64 * m; u[m] = __float_as_uint(base[s < SCS_LD ? s : 0]); }
#pragma unroll
        for (int m = 0; m < 17; ++m) { const unsigned k_ = fkey(__uint_as_float(u[m])); u[m] = (s0 + lane + 64 * m < n) ? k_ : 0u; }
        __syncthreads();
        {
            int nvalid = 0;
#pragma unroll
            for (int m = 0; m < 17; ++m) nvalid += (u[m] != 0u) ? 1 : 0;
            nvalid = wave_sum_i(nvalid);
            unsigned tau = 0u; int need = 0; unsigned tmask = 0u, smask = 0u;
            if (nvalid > TOPK) {
#pragma unroll 1
                for (int bit = 31; bit >= 0; --bit) {
                    const unsigned cand = tau | (1u << bit); int c = 0;
#pragma unroll
                    for (int m = 0; m < 17; ++m) c += (u[m] >= cand) ? 1 : 0;
                    c = wave_sum_i(c);
                    if (c >= TOPK) tau = cand;
                    if (c == TOPK) break;
                }
                int cg = 0, ct = 0;
#pragma unroll
                for (int m = 0; m < 17; ++m) { cg += (u[m] > tau) ? 1 : 0; const bool tie = (u[m] == tau); ct += tie ? 1 : 0; tmask |= tie ? (1u << m) : 0u; }
                cg = wave_sum_i(cg); ct = wave_sum_i(ct);
                need = TOPK - cg;
                if (ct == need) smask = tmask;
                else {
#pragma unroll 1
                    for (int it = 0; it < need; ++it) {
                        const int m0 = tmask ? (int)__builtin_ctz(tmask) : 32;
                        const int cand = tmask ? (lane + 64 * m0) : 0x7fffffff, best = wave_min_i(cand);
                        if (cand == best && tmask) { smask |= (1u << m0); tmask &= ~(1u << m0); }
                    }
                }
            } else { tau = 0u; smask = 0u; }
            int mine = 0;
#pragma unroll
            for (int m = 0; m < 17; ++m) mine += ((u[m] > tau) || ((smask >> m) & 1u)) ? 1 : 0;
            int incl = mine;
#pragma unroll
            for (int d = 1; d < 64; d <<= 1) { const int o = __shfl_up(incl, d); if (lane >= d) incl += o; }
            int off = incl - mine;
            const int total = __builtin_amdgcn_readlane(incl, 63);
#pragma unroll
            for (int m = 0; m < 17; ++m) { if ((u[m] > tau) || ((smask >> m) & 1u)) { ckey[wave * 256 + off] = u[m]; cidx[wave * 256 + off] = s0 + lane + 64 * m; ++off; } }
            for (int e = total + lane; e < 256; e += 64) { ckey[wave * 256 + e] = 0u; cidx[wave * 256 + e] = 0x7fffffff; }
        }
        __syncthreads();
        if (wave == 0) {
            unsigned v[32]; int ix[32];
#pragma unroll
            for (int m = 0; m < 32; ++m) { v[m] = ckey[lane + 64 * m]; ix[m] = cidx[lane + 64 * m]; }
            unsigned tau = 0u;
#pragma unroll 1
            for (int bit = 31; bit >= 0; --bit) {
                const unsigned cand = tau | (1u << bit); int c = 0;
#pragma unroll
                for (int m = 0; m < 32; ++m) c += (v[m] >= cand) ? 1 : 0;
                c = wave_sum_i(c);
                if (c >= TOPK) tau = cand;
                if (c == TOPK) break;
            }
            int cg = 0, ct = 0; unsigned tmask = 0u, smask = 0u;
#pragma unroll
            for (int m = 31; m >= 0; --m) { cg += (v[m] > tau) ? 1 : 0; const unsigned tie = (v[m] == tau) ? 1u : 0u; ct += (int)tie; tmask = (tmask << 1) | tie; }
            cg = wave_sum_i(cg); ct = wave_sum_i(ct);
            const int need = TOPK - cg;
            if (ct == need) smask = tmask;
            else {
#pragma unroll 1
                for (int it = 0; it < need; ++it) {
                    int bi = 0x7fffffff, bm = 0;
#pragma unroll
                    for (int m = 0; m < 32; ++m) { const bool t_ = (tmask >> m) & 1u; if (t_ && ix[m] < bi) { bi = ix[m]; bm = m; } }
                    const int best = wave_min_i(bi);
                    if (bi == best && bi != 0x7fffffff) { smask |= (1u << bm); tmask &= ~(1u << bm); }
                }
            }
            int mine = 0;
#pragma unroll
            for (int m = 0; m < 32; ++m) mine += ((v[m] > tau) || ((smask >> m) & 1u)) ? 1 : 0;
            int incl = mine;
#pragma unroll
            for (int d = 1; d < 64; d <<= 1) { const int o = __shfl_up(incl, d); if (lane >= d) incl += o; }
            int off = incl - mine;
            int* sel = SEL + (size_t)row * 256;
#pragma unroll
            for (int m = 0; m < 32; ++m) { if ((v[m] > tau) || ((smask >> m) & 1u)) { if (off < TOPK) sel[off] = ix[m]; ++off; } }
            if (lane == 0) CNT[row] = TOPK;
        }
    }
    __syncthreads();
}

template <bool SAMPLE>
__device__ __forceinline__ void phase_attn(KP p, int j, LAS unsigned char* lds) {
    const int tid = TID(), lane = tid & 63, wave = tid >> 6, n16 = lane & 15, c4 = lane >> 4;
    LAS bf16_t* ps = (LAS bf16_t*)(lds + wave * 16384);
    LAS int* is = (LAS int*)(lds + wave * 16384 + 8192);
    LAS bf16_t* qs = (LAS bf16_t*)(lds + wave * 16384 + 9216);
    LAS float* invs = (LAS float*)(lds + wave * 16384 + 11264);
    const float* Q = WSP(float, WS_Q); const int* SEL = WSP(int, WS_SEL); const int* CNT = WSP(int, WS_CNT); bf16_t* O = WSP(bf16_t, WS_YG);
    const bf16_t *KBF = WSP(bf16_t, WS_KBF), *VBF = WSP(bf16_t, WS_VBF);
    const float* kc = p->cache_k + (size_t)j * 2560 * 128 * 256; const float* vc = p->cache_v + (size_t)j * 2560 * 128 * 256;
    const float* knew = p->out + O_KS + (size_t)j * NS * 256; const float* vnew = p->out + O_VS + (size_t)j * NS * 256;
    const int gw = BID() * 8 + wave, nw = gridDim.x * 8, nq = SAMPLE ? NS : NP;
    unsigned* qctr = WSP(unsigned, WS_BAR + 40960) + (size_t)j * 256;
    int qb = 0, qnext = 0, qsub = 2, qcur = 0;
    if (!SAMPLE) { unsigned v_ = 0u; if (lane == 0) v_ = __hip_atomic_fetch_add(qctr + 16 * ((BID() + qb) & 3), 2u, __ATOMIC_RELAXED, __HIP_MEMORY_SCOPE_AGENT); qnext = (int)__builtin_amdgcn_readfirstlane(v_); }
    for (int qi = gw; SAMPLE ? (qi < nq) : true; qi += nw) {
        int row;
        if (SAMPLE) row = NP + qi;
        else {
            if (qsub == 2) {
                for (;;) {
                    qcur = qnext; qsub = 0;
                    if (qcur < 4096 || qb == 3) break;
                    ++qb; unsigned v_ = 0u; if (lane == 0) v_ = __hip_atomic_fetch_add(qctr + 16 * ((BID() + qb) & 3), 2u, __ATOMIC_RELAXED, __HIP_MEMORY_SCOPE_AGENT); qnext = (int)__builtin_amdgcn_readfirstlane(v_);
                }
                if (qcur >= 4096) break;
                { unsigned v_ = 0u; if (lane == 0) v_ = __hip_atomic_fetch_add(qctr + 16 * ((BID() + qb) & 3), 2u, __ATOMIC_RELAXED, __HIP_MEMORY_SCOPE_AGENT); qnext = (int)__builtin_amdgcn_readfirstlane(v_); }
            }
            row = ((BID() + qb) & 3) * 4096 + (4095 - (qcur + qsub)); ++qsub;
        }
        const int n = CNT[row];
        wave_lds_fence();
#pragma unroll
        for (int c = 0; c < 4; ++c) { const int slot = lane + 64 * c;
            int s = SEL[(size_t)row * 256 + slot]; const bool ok = slot < n;
            int r;
            if (SAMPLE) { const int bb = (row - NP) >> 3; s = ok ? s : 0; const int sp = min(max(s, 0), PAST - 1); const int pg = p->page_table[bb * 64 + (sp >> 7)];
                r = (s < PAST) ? pg * 128 + (s & 127) : (0x40000000 | (bb * 8 + min(s - PAST, 7))); }
            else r = (row & ~4095) + (ok ? s : 0);
            is[slot] = r; }
#pragma unroll
        for (int i = 0; i < 4; ++i) { const f32x4 q4 = ld_bf4((const bf16_t*)Q + (size_t)row * D + 256 * i + 4 * lane);
            if (SAMPLE) { const f32x4 q8 = q4 * 0.125f; u32x2 w; w.x = pk_bf16(q8[0], q8[1]); w.y = pk_bf16(q8[2], q8[3]); *(LAS u32x2*)(qs + 256 * i + 4 * lane) = w; }
            else *(LAS unsigned*)((LAS unsigned char*)qs + 256 * i + 4 * lane) = pk_fp8x4(q4); }
        wave_lds_fence();
        {
            float mx = -__builtin_huge_valf();
#define ATT_EMIT(t_, acc_) do { f32x4 l_ = (acc_); _Pragma("unroll") for (int r = 0; r < 4; ++r) { if (16 * (t_) + 4 * c4 + r >= n) l_[r] = -__builtin_huge_valf(); mx = fmaxf(mx, l_[r]); } \
                u32x2 w_; w_.x = pk_bf16(l_[0], l_[1]); w_.y = pk_bf16(l_[2], l_[3]); *(LAS u32x2*)(ps + n16 * 256 + 16 * (t_) + 4 * c4) = w_; } while (0)
            if (SAMPLE) {
                const u32x4 qf0 = *(const LAS u32x4*)(qs + n16 * 64 + 8 * c4), qf1 = *(const LAS u32x4*)(qs + n16 * 64 + 32 + 8 * c4);
                u32x4 bq[8];
#pragma unroll
                for (int ks = 0; ks < 8; ++ks) { const bool on = (n16 >> 2) == (ks >> 1); const u32x4 qv = (ks & 1) ? qf1 : qf0; bq[ks] = (u32x4){on ? qv.x : 0u, on ? qv.y : 0u, on ? qv.z : 0u, on ? qv.w : 0u}; }
#pragma unroll 2
                for (int t = 0; t < 16; ++t) {
                    const int r = is[16 * t + n16];
                    const float* kp = ((r & 0x40000000) ? knew + (size_t)(r & 0xffff) * 256 : kc + (size_t)r * 256) + 8 * c4;
                    f32x4 acc = {0.f, 0.f, 0.f, 0.f};
#pragma unroll
                    for (int ks = 0; ks < 8; ++ks) { const f32x4 x0 = *(const f32x4*)(kp + 32 * ks), x1 = *(const f32x4*)(kp + 32 * ks + 4);
                        const u32x4 ka = {pk_bf16(x0[0], x0[1]), pk_bf16(x0[2], x0[3]), pk_bf16(x1[0], x1[1]), pk_bf16(x1[2], x1[3])};
                        acc = __builtin_amdgcn_mfma_f32_16x16x32_bf16(__builtin_bit_cast(bf16x8, ka), __builtin_bit_cast(bf16x8, bq[ks]), acc, 0, 0, 0); }
                    ATT_EMIT(t, acc);
                }
            } else {
                const LAS unsigned char* q8 = (const LAS unsigned char*)qs;
                long bq[8];
                { const bool on = (n16 >> 2) == c4;
#pragma unroll
                  for (int h2 = 0; h2 < 4; ++h2) { const u32x4 qv = *(const LAS u32x4*)(q8 + n16 * 64 + 16 * h2);
                      const u32x2 z0 = {on ? qv.x : 0u, on ? qv.y : 0u}, z1 = {on ? qv.z : 0u, on ? qv.w : 0u}; bq[2 * h2] = __builtin_bit_cast(long, z0); bq[2 * h2 + 1] = __builtin_bit_cast(long, z1); } }
                const unsigned char* K8 = WSP(unsigned char, WS_K8);
#pragma unroll
                for (int th = 0; th < 2; ++th) {
                    if (th) asm volatile("" ::: "memory");
                    u32x4 ka[8][4];
#pragma unroll
                    for (int t8 = 0; t8 < 8; ++t8) {
                        const int r = is[16 * (8 * th + t8) + n16];
                        const unsigned char* kp = K8 + (size_t)r * 256 + 64 * c4;
#pragma unroll
                        for (int h2 = 0; h2 < 4; ++h2) ka[t8][h2] = *(const u32x4*)(kp + 16 * h2);
                    }
                    __builtin_amdgcn_sched_barrier(0);
#pragma unroll
                    for (int t8 = 0; t8 < 8; ++t8) {
                        f32x4 acc = {0.f, 0.f, 0.f, 0.f};
#pragma unroll
                        for (int h2 = 0; h2 < 4; ++h2) { const u32x2 lo = {ka[t8][h2].x, ka[t8][h2].y}, hi = {ka[t8][h2].z, ka[t8][h2].w};
                            acc = __builtin_amdgcn_mfma_f32_16x16x32_fp8_fp8(__builtin_bit_cast(long, lo), bq[2 * h2], acc, 0, 0, 0);
                            acc = __builtin_amdgcn_mfma_f32_16x16x32_fp8_fp8(__builtin_bit_cast(long, hi), bq[2 * h2 + 1], acc, 0, 0, 0); }
                        ATT_EMIT(8 * th + t8, acc * 0.125f);
                    }
                }
            }
#undef ATT_EMIT
            mx = fmaxf(mx, __shfl_xor(mx, 16)); mx = fmaxf(mx, __shfl_xor(mx, 32));
            float sm = 0.f;
            u32x2 lw_[16];
#pragma unroll
            for (int t = 0; t < 16; ++t) lw_[t] = *(const LAS u32x2*)(ps + n16 * 256 + 16 * t + 4 * c4);
#pragma unroll
            for (int t = 0; t < 16; ++t) {
                const u32x2 w = lw_[t];
                const float e0 = __expf(bflo(w.x) - mx), e1 = __expf(bfhi(w.x) - mx), e2 = __expf(bflo(w.y) - mx), e3 = __expf(bfhi(w.y) - mx);
                sm += (e0 + e1) + (e2 + e3);
                u32x2 o_; o_.x = pk_bf16(e0, e1); o_.y = pk_bf16(e2, e3); *(LAS u32x2*)(ps + n16 * 256 + 16 * t + 4 * c4) = o_;
            }
            sm += __shfl_xor(sm, 16); sm += __shfl_xor(sm, 32);
            if (c4 == 0) invs[n16] = 1.0f / sm;
        }
        wave_lds_fence();
        if (!SAMPLE) {
            const unsigned char* V8 = WSP(unsigned char, WS_V8);
            const int rs = c4, kvh = n16 >> 2, nst = n > 64 ? 64 : n;
            f32x4 oa[4][4];
#pragma unroll
            for (int g = 0; g < 4; ++g)
#pragma unroll
                for (int q = 0; q < 4; ++q) oa[g][q] = (f32x4){0.f, 0.f, 0.f, 0.f};
            u32x4 vr[8], vn[8];
#pragma unroll
            for (int i = 0; i < 8; ++i) vn[i] = *(const u32x4*)(V8 + (size_t)is[64 * rs + i] * 256 + 16 * n16);
            for (int m0 = 0; m0 < nst; m0 += 8) {
#pragma unroll
                for (int i = 0; i < 8; ++i) vr[i] = vn[i];
                if (m0 + 8 < nst) {
#pragma unroll
                    for (int i = 0; i < 8; ++i) vn[i] = *(const u32x4*)(V8 + (size_t)is[64 * rs + m0 + 8 + i] * 256 + 16 * n16);
                }
                __builtin_amdgcn_sched_barrier(0);
#pragma unroll
                for (int h4 = 0; h4 < 2; ++h4) {
                    u32x2 pg[4];
#pragma unroll
                    for (int g = 0; g < 4; ++g) pg[g] = *(const LAS u32x2*)(ps + (kvh * 4 + g) * 256 + 64 * rs + m0 + 4 * h4);
#pragma unroll
                    for (int i = 0; i < 4; ++i) {
                        const u32x4 v_ = vr[4 * h4 + i];
                        const f32x4 v0 = fp8x4_f32(v_.x), v1 = fp8x4_f32(v_.y), v2 = fp8x4_f32(v_.z), v3 = fp8x4_f32(v_.w);
#pragma unroll
                        for (int g = 0; g < 4; ++g) { const unsigned pw = (i < 2) ? pg[g].x : pg[g].y; const float pf = (i & 1) ? bfhi(pw) : bflo(pw);
                            oa[g][0] += pf * v0; oa[g][1] += pf * v1; oa[g][2] += pf * v2; oa[g][3] += pf * v3; }
                    }
                }
            }
#pragma unroll
            for (int g = 0; g < 4; ++g)
#pragma unroll
                for (int q = 0; q < 4; ++q)
#pragma unroll
                    for (int e_ = 0; e_ < 4; ++e_) { float x = oa[g][q][e_]; x += __shfl_xor(x, 16); x += __shfl_xor(x, 32); oa[g][q][e_] = x; }
            if (rs == 0) {
                const f32x4 iv = *(const LAS f32x4*)(invs + 4 * kvh);
#pragma unroll
                for (int g = 0; g < 4; ++g) { bf16_t* op = O + (size_t)row * D + (kvh * 4 + g) * 64 + 16 * (n16 & 3);
                    u32x4 w0, w1; const float sc_ = iv[g];
                    w0.x = pk_bf16(oa[g][0][0] * sc_, oa[g][0][1] * sc_); w0.y = pk_bf16(oa[g][0][2] * sc_, oa[g][0][3] * sc_); w0.z = pk_bf16(oa[g][1][0] * sc_, oa[g][1][1] * sc_); w0.w = pk_bf16(oa[g][1][2] * sc_, oa[g][1][3] * sc_);
                    w1.x = pk_bf16(oa[g][2][0] * sc_, oa[g][2][1] * sc_); w1.y = pk_bf16(oa[g][2][2] * sc_, oa[g][2][3] * sc_); w1.z = pk_bf16(oa[g][3][0] * sc_, oa[g][3][1] * sc_); w1.w = pk_bf16(oa[g][3][2] * sc_, oa[g][3][3] * sc_);
                    *(u32x4*)op = w0; *(u32x4*)(op + 8) = w1; }
            }
        } else {
        f32x4 o0 = {0.f, 0.f, 0.f, 0.f}, o1 = o0, o2 = o0, o3 = o0;
        constexpr int GV = SAMPLE ? 16 : 32;
        const int ng = (n + GV - 1) / GV;
        unsigned vb[SAMPLE ? 1 : GV], vbn[SAMPLE ? 1 : GV]; f32x4 vf[SAMPLE ? GV : 1];
        const unsigned char* V8 = WSP(unsigned char, WS_V8);
        if (!SAMPLE) {
#pragma unroll
            for (int i = 0; i < GV; ++i) vbn[i] = *(const unsigned*)(V8 + (size_t)is[i] * 256 + 4 * lane);
        }
#pragma unroll 1
        for (int g = 0; g < ng; ++g) {
            if (!SAMPLE) {
#pragma unroll
                for (int i = 0; i < GV; ++i) vb[i] = vbn[i];
                if (g + 1 < ng) {
#pragma unroll
                    for (int i = 0; i < GV; ++i) vbn[i] = *(const unsigned*)(V8 + (size_t)is[GV * (g + 1) + i] * 256 + 4 * lane);
                }
                __builtin_amdgcn_sched_barrier(0);
            } else {
#pragma unroll
                for (int i = 0; i < GV; ++i) { const int r = is[GV * g + i]; vf[i] = *(const f32x4*)(((r & 0x40000000) ? vnew + (size_t)(r & 0xffff) * 256 : vc + (size_t)r * 256) + 4 * lane); }
            }
#pragma unroll
            for (int i4 = 0; i4 < GV / 4; ++i4) {
                const u32x2 p0 = *(const LAS u32x2*)(ps + (c4 * 4 + 0) * 256 + GV * g + 4 * i4), p1 = *(const LAS u32x2*)(ps + (c4 * 4 + 1) * 256 + GV * g + 4 * i4),
                            p2 = *(const LAS u32x2*)(ps + (c4 * 4 + 2) * 256 + GV * g + 4 * i4), p3 = *(const LAS u32x2*)(ps + (c4 * 4 + 3) * 256 + GV * g + 4 * i4);
                f32x4 v0, v1, v2, v3;
                if (!SAMPLE) { v0 = fp8x4_f32(vb[4 * i4]); v1 = fp8x4_f32(vb[4 * i4 + 1]); v2 = fp8x4_f32(vb[4 * i4 + 2]); v3 = fp8x4_f32(vb[4 * i4 + 3]); }
                else { v0 = vf[4 * i4]; v1 = vf[4 * i4 + 1]; v2 = vf[4 * i4 + 2]; v3 = vf[4 * i4 + 3]; }
                o0 += bflo(p0.x) * v0 + bfhi(p0.x) * v1 + bflo(p0.y) * v2 + bfhi(p0.y) * v3;
                o1 += bflo(p1.x) * v0 + bfhi(p1.x) * v1 + bflo(p1.y) * v2 + bfhi(p1.y) * v3;
                o2 += bflo(p2.x) * v0 + bfhi(p2.x) * v1 + bflo(p2.y) * v2 + bfhi(p2.y) * v3;
                o3 += bflo(p3.x) * v0 + bfhi(p3.x) * v1 + bflo(p3.y) * v2 + bfhi(p3.y) * v3;
            }
        }
        { const f32x4 iv = *(const LAS f32x4*)(invs + 4 * c4); bf16_t* op = O + (size_t)row * D + c4 * 256 + 4 * n16; st_bf4(op, o0 * iv[0]); st_bf4(op + 64, o1 * iv[1]); st_bf4(op + 128, o2 * iv[2]); st_bf4(op + 192, o3 * iv[3]); }
        }
    }
}

__global__ void __launch_bounds__(512, 2) mega(P p_unused) {
    extern __shared__ __attribute__((aligned(16))) unsigned char lds_raw[];
    LAS unsigned char* lds = (LAS unsigned char*)lds_raw;
    volatile LAS unsigned* misc = (volatile LAS unsigned*)(lds + LDS_MISC);
    if (TID() < 4) misc[TID()] = 0u;
    __syncthreads();
    KP p = kargs();
    const bool multi = (p->ph_hi - p->ph_lo) > 1;
    XcdBarrier bar; bar.bar = WSP(unsigned, WS_BAR); bar.x = 0; bar.st = misc;
    if (multi) bar = xcd_barrier_post(WSP(unsigned, WS_BAR), misc);
    int ph = 0;
    const int lo = p->ph_lo, hi = p->ph_hi;
#ifndef REPMASK
#define REPMASK 0ull
#endif
#define PH_BEGIN if (ph >= lo && ph < hi) { KP p = kargs(); const int nrep_ = ((REPMASK >> ph) & 1ull) ? 3 : 1; for (int rep_ = 0; rep_ < nrep_; ++rep_) {
#define PH_END   if (ph + 1 < hi || rep_ + 1 < nrep_) xcd_barrier(bar); } } ++ph;

    PH_BEGIN phase_ada(p, lds); phase_weights(p, lds); PH_END

    for (int layer = 0; layer < 4; ++layer) {
        const int j = layer >> 1;
        if ((layer & 1) == 0) {
            PH_BEGIN phase_prep<true>(p, layer, 0, j, layer == 0); PH_END
            PH_BEGIN {
                FRwkvIn f{WSP(bf16_t, WS_RB), WSP(bf16_t, WS_KB), WSP(bf16_t, WS_VB), WSP(bf16_t, WS_TW), WSP(bf16_t, WS_TA), WSP(bf16_t, WS_TV), WSP(bf16_t, WS_TG)};
                pg8::Gemm g{WSP(bf16_t, WS_XR), WSP(bf16_t, WS_WRW_T) + (size_t)j * 4096 * D, NP, j == 0 ? 3840 : 4096, D, j == 0 ? 2 : 1, XR_STRIDE};
                pg8::StaticOrder S; S.init(NP, g.N, (int)gridDim.x, BID());
                pg8::EpiAdapt<FRwkvIn, true> E{f};
                pg8::gemm_phase(lds, g, S, E);
                wgemm_ks<true>(lds, WSP(bf16_t, WS_XR), D, XR_STRIDE, NP, NS, WSP(bf16_t, WS_WRW_T) + (size_t)j * 4096 * D, D, 4096, f);
            } PH_END
            PH_BEGIN {
                FStoreF32 fw{WSP(float, WS_WP), D, D}, fa{WSP(float, WS_AP), D, D}, fv{WSP(float, WS_VP), D, D}, fg{WSP(float, WS_GG), D, D};
                wgemm_w(WSP(bf16_t, WS_TW), 64, NP, NS, WSP(bf16_t, WS_W2T) + (size_t)j * D * 64, 64, D, fw);
                wgemm_w(WSP(bf16_t, WS_TA), 64, NP, NS, WSP(bf16_t, WS_A2T) + (size_t)j * D * 64, 64, D, fa);
                if (j == 1) wgemm_w(WSP(bf16_t, WS_TV), 32, NP, NS, WSP(bf16_t, WS_V2T), 32, D, fv);
                wgemm_w(WSP(bf16_t, WS_TG), 160, NP, NS, WSP(bf16_t, WS_G2T) + (size_t)j * D * 160, 160, D, fg);
                phase_chunk(p, j, lds);
            } PH_END
            PH_BEGIN phase_carry(p, j, lds); PH_END
            PH_BEGIN phase_post2(p, j, lds); PH_END
        } else {
            PH_BEGIN phase_prep<false>(p, layer, 0, j); PH_END
            PH_BEGIN {
                FStoreBf16 f{WSP(bf16_t, WS_PR), PINP, PINP};
                pg8::Gemm g{WSP(bf16_t, WS_XR), WSP(bf16_t, WS_WIN_T) + (size_t)j * PINP * D, NP, PINP, D, 0, 0};
                pg8::StaticOrder S; S.init(NP, PINP, (int)gridDim.x, BID());
                pg8::EpiAdapt<FStoreBf16, true> E{f};
                pg8::gemm_phase(lds, g, S, E);
                FStoreBf16 fs{WSP(bf16_t, WS_PR), PINP, PIN};
                wgemm_ks<false>(lds, WSP(bf16_t, WS_XR), D, 0, NP, NS, WSP(bf16_t, WS_WIN_T) + (size_t)j * PINP * D, D, PINP, fs);
            } PH_END
            PH_BEGIN phase_dsapost(p, j); PH_END
            PH_BEGIN phase_idx2<false>(p, j); phase_idx2<true>(p, j); PH_END
            PH_BEGIN phase_topk_prompt(p); phase_topk_sample(p, lds); PH_END
            PH_BEGIN phase_attn<true>(p, j, lds); phase_attn<false>(p, j, lds); PH_END
        }
        PH_BEGIN {
            FResid f{p->out, WSP(float, WS_MODS) + (size_t)layer * 36 * 6144 + 2 * D, layer == 0 ? p->x_prompt : nullptr, layer == 0 ? p->x_sample : nullptr};
            const bf16_t* Wt = ((layer & 1) == 0 ? WSP(bf16_t, WS_WO_T) : WSP(bf16_t, WS_WAO_T)) + (size_t)j * D * D;
            pg8::Gemm g{WSP(bf16_t, WS_YG), Wt, NP, D, D, 0, 0};
            pg8::StaticOrder S; S.init(NP, D, (int)gridDim.x, BID());
            pg8::EpiAdapt<FResid, false> E{f};
            pg8::gemm_phase(lds, g, S, E);
            wgemm_ks<false>(lds, WSP(bf16_t, WS_YG), D, 0, NP, NS, Wt, D, D, f);
        } PH_END
        PH_BEGIN phase_prep<false>(p, layer, 1, j); PH_END
        PH_BEGIN {
            FRelu2 f{WSP(bf16_t, WS_U)};
            pg8::Gemm g{WSP(bf16_t, WS_XR), WSP(bf16_t, WS_WUP_T) + (size_t)layer * DFF * D, NP, DFF, D, 0, 0};
            pg8::StaticOrder S; S.init(NP, DFF, (int)gridDim.x, BID());
            pg8::EpiAdapt<FRelu2, true> E{f};
            pg8::gemm_phase(lds, g, S, E);
            wgemm_ks<false>(lds, WSP(bf16_t, WS_XR), D, 0, NP, NS, WSP(bf16_t, WS_WUP_T) + (size_t)layer * DFF * D, D, DFF, f);
        } PH_END
        PH_BEGIN {
            FResid f{p->out, WSP(float, WS_MODS) + (size_t)layer * 36 * 6144 + 5 * D, nullptr, nullptr};
            pg8::Gemm g{WSP(bf16_t, WS_U), WSP(bf16_t, WS_WDN_T) + (size_t)layer * DFF * D, NP, D, DFF, 0, 0};
            pg8::StaticOrder S; S.init(NP, D, (int)gridDim.x, BID());
            pg8::EpiAdapt<FResid, false> E{f};
            pg8::gemm_phase(lds, g, S, E);
            wgemm_ks<false>(lds, WSP(bf16_t, WS_U), DFF, 0, NP, NS, WSP(bf16_t, WS_WDN_T) + (size_t)layer * DFF * D, DFF, D, f);
        } PH_END
    }
#undef PH_BEGIN
#undef PH_END
}

static int count_phases() { int n = 1; for (int layer = 0; layer < 4; ++layer) { n += ((layer & 1) == 0) ? 5 : 6; n += 4; } return n; }

extern "C" void kernel_launch(void* const* d_in, const int* in_sizes, int n_in, void* d_out, int out_size, void* d_ws, size_t ws_size, hipStream_t stream) {
    static int grid = 0;
    if (grid == 0) {
        if (n_in != 39 || out_size != (int)O_END || ws_size < WS_END) { fprintf(stderr, "kernel_launch: unexpected shapes n_in %d out %d ws %zu (need %zu)\n", n_in, out_size, ws_size, (size_t)WS_END); grid = -1; return; }
        int dev = 0, cus = 0, per_cu = 0;
        if (hipGetDevice(&dev) != hipSuccess || hipDeviceGetAttribute(&cus, hipDeviceAttributeMultiprocessorCount, dev) != hipSuccess) { grid = -1; return; }
        if (hipFuncSetAttribute((const void*)mega, hipFuncAttributeMaxDynamicSharedMemorySize, LDS_BYTES) != hipSuccess) { fprintf(stderr, "kernel_launch: hipFuncSetAttribute failed\n"); grid = -1; return; }
        if (hipOccupancyMaxActiveBlocksPerMultiprocessor(&per_cu, (const void*)mega, 512, LDS_BYTES) != hipSuccess || per_cu < 1) fprintf(stderr, "kernel_launch: occupancy query says %d\n", per_cu);
        (void)hipGetLastError();
        grid = cus;
    }
    if (grid < 0) return;
    (void)hipMemsetAsync((char*)d_ws + WS_BAR, 0, 65536, stream);
    P p{};
    memcpy((void*)&p, (const void*)d_in, 39 * sizeof(void*));
    p.out = (float*)d_out; p.ws = (unsigned char*)d_ws;
#ifndef STOP_PH
#define STOP_PH 1000
#endif
    const int nph = count_phases() < STOP_PH ? count_phases() : STOP_PH;
#ifndef ONE_LAUNCH
    for (int ph = 0; ph < nph; ++ph) { p.ph_lo = ph; p.ph_hi = ph + 1; hipLaunchKernelGGL(mega, dim3(grid), dim3(512), LDS_BYTES, stream, p); }
#else
    p.ph_lo = 0; p.ph_hi = nph; hipLaunchKernelGGL(mega, dim3(grid), dim3(512), LDS_BYTES, stream, p);
#endif
}
```

```cpp
#define ONE_LAUNCH 1
#include <hip/hip_runtime.h>
#include <cstdio>
#include <cstdint>
#include <cstring>

#define LAS __attribute__((address_space(3)))
typedef unsigned short bf16_t;
typedef short bf16x8 __attribute__((ext_vector_type(8)));
typedef float f32x4 __attribute__((ext_vector_type(4)));
typedef float f32x2 __attribute__((ext_vector_type(2)));
typedef unsigned u32x4 __attribute__((ext_vector_type(4)));
typedef unsigned u32x2 __attribute__((ext_vector_type(2)));

constexpr int D = 1024, NP = 16384, NS = 256, NT = NP + NS, SEQL = 4096, PAST = 8192, NSEQ = 36, DFF = 4096;
constexpr int PIN = 2120, PINP = 2304;
constexpr int TOPK = 256, SCS_LD = 8320;
constexpr size_t O_YP = 0, O_YS = 16777216, O_KP = 17039360, O_VP = 25427968, O_IKP = 33816576, O_WKVP = 35913728, O_SHP = 36438016,
                 O_KS = 36446208, O_VS = 36577280, O_IKS = 36708352, O_WKVS = 36741120, O_SHS = 40935424, O_END = 41000960;
constexpr size_t al256(size_t x) { return (x + 255) & ~(size_t)255; }
constexpr size_t WS_BAR = 0;
constexpr size_t WS_MODS = 65536;
constexpr size_t WS_WUP_T = al256(WS_MODS + (size_t)4 * NSEQ * 6144 * 4);
constexpr size_t WS_WDN_T = WS_WUP_T + (size_t)4 * DFF * D * 2;
constexpr size_t WS_WRW_T = WS_WDN_T + (size_t)4 * DFF * D * 2;
constexpr size_t WS_WO_T = WS_WRW_T + (size_t)2 * 4096 * D * 2;
constexpr size_t WS_WIN_T = WS_WO_T + (size_t)2 * D * D * 2;
constexpr size_t WS_WAO_T = WS_WIN_T + (size_t)2 * PINP * D * 2;
constexpr size_t WS_W2T = WS_WAO_T + (size_t)2 * D * D * 2;
constexpr size_t WS_A2T = WS_W2T + (size_t)2 * D * 64 * 2;
constexpr size_t WS_V2T = WS_A2T + (size_t)2 * D * 64 * 2;
constexpr size_t WS_G2T = WS_V2T + (size_t)D * 32 * 2;
constexpr size_t WS_XR = WS_G2T + (size_t)2 * D * 160 * 2;
constexpr size_t XR_STRIDE = (size_t)NT * D;
constexpr size_t WS_RB = WS_XR + 6 * XR_STRIDE * 2;
constexpr size_t WS_KB = WS_RB + XR_STRIDE * 2;
constexpr size_t WS_VB = WS_KB + XR_STRIDE * 2;
constexpr size_t WS_TW = WS_VB + XR_STRIDE * 2;
constexpr size_t WS_TA = WS_TW + (size_t)NT * 64 * 2;
constexpr size_t WS_TV = WS_TA + (size_t)NT * 64 * 2;
constexpr size_t WS_TG = WS_TV + (size_t)NT * 32 * 2;
constexpr size_t WS_WP = al256(WS_TG + (size_t)NT * 160 * 2);
constexpr size_t F32A = (size_t)NT * D * 4;
constexpr size_t WS_AP = WS_WP + F32A, WS_VP = WS_AP + F32A, WS_GG = WS_VP + F32A, WS_VFIRST = WS_GG + F32A;
constexpr size_t WS_DEC = WS_VFIRST + F32A, WS_KM = WS_DEC + F32A, WS_VM = WS_KM + F32A, WS_AV = WS_VM + F32A, WS_BV = WS_AV + F32A, WS_Y = WS_BV + F32A;
constexpr size_t WS_YG = WS_Y + F32A;
constexpr size_t WS_U = WS_YG + XR_STRIDE * 2;
constexpr size_t WS_PR = WS_U + (size_t)NT * DFF * 2;
constexpr size_t WS_Q = WS_PR + (size_t)NT * PINP * 4;
constexpr size_t WS_QI = WS_Q + F32A;
constexpr size_t WS_WI = WS_QI + (size_t)NT * 512 * 4;
constexpr size_t WS_SC = al256(WS_WI + (size_t)NT * 8 * 4);
constexpr size_t WS_SCS = WS_SC + (size_t)4 * 4096 * 4096 * 4;
constexpr size_t WS_SEL = al256(WS_SCS + (size_t)NS * SCS_LD * 4);
constexpr size_t WS_CNT = WS_SEL + (size_t)NT * 256 * 4;
constexpr size_t WS_KBF = al256(WS_CNT + (size_t)NT * 4);
constexpr size_t WS_VBF = WS_KBF + (size_t)NT * 256 * 2;
constexpr size_t WS_QIB = WS_VBF + (size_t)NT * 256 * 2;
constexpr size_t WS_KIB = WS_QIB + (size_t)NT * 512 * 2;
constexpr size_t WS_K8 = al256(WS_KIB + (size_t)NT * 64 * 2);
constexpr size_t WS_V8 = WS_K8 + (size_t)NT * 256;
constexpr size_t WS_END = al256(WS_V8 + (size_t)NT * 256);

constexpr int LCH = 64, NCH = SEQL / LCH;
constexpr size_t WS_PCH = WS_SC, WS_CCH = WS_PCH + (size_t)64 * NCH * 4096 * 4, WS_SST = WS_CCH + (size_t)64 * NCH * 4096 * 4;
static_assert(WS_SST + (size_t)64 * NCH * 4096 * 4 <= WS_SCS, "scan buffers must fit the aliased region");
constexpr int LDS_BYTES = 147456;
constexpr int LDS_MISC = 131072;

typedef __bf16 bf16x2_t __attribute__((ext_vector_type(2)));
__device__ __forceinline__ unsigned pk_bf16(float lo, float hi) { const f32x2 v = {lo, hi}; const bf16x2_t b = __builtin_convertvector(v, bf16x2_t); return __builtin_bit_cast(unsigned, b); }
__device__ __forceinline__ unsigned pk_fp8x4(f32x4 v) { int w = 0; w = __builtin_amdgcn_cvt_pk_fp8_f32(v[0], v[1], w, false); w = __builtin_amdgcn_cvt_pk_fp8_f32(v[2], v[3], w, true); return (unsigned)w; }
__device__ __forceinline__ f32x4 fp8x4_f32(unsigned w) { return (f32x4){__builtin_amdgcn_cvt_f32_fp8((int)w, 0), __builtin_amdgcn_cvt_f32_fp8((int)w, 1), __builtin_amdgcn_cvt_f32_fp8((int)w, 2), __builtin_amdgcn_cvt_f32_fp8((int)w, 3)}; }
__device__ __forceinline__ float bf2f(unsigned short x) { return __uint_as_float((unsigned)x << 16); }
__device__ __forceinline__ float bflo(unsigned x) { return __uint_as_float(x << 16); }
__device__ __forceinline__ float bfhi(unsigned x) { return __uint_as_float(x & 0xffff0000u); }
__device__ __forceinline__ f32x4 ld_bf4(const bf16_t* p) { const u32x2 v = *(const u32x2*)p; return (f32x4){bflo(v.x), bfhi(v.x), bflo(v.y), bfhi(v.y)}; }
__device__ __forceinline__ void st_bf4(bf16_t* p, f32x4 v) { u32x2 w; w.x = pk_bf16(v[0], v[1]); w.y = pk_bf16(v[2], v[3]); *(u32x2*)p = w; }
template <int CTRL> __device__ __forceinline__ float dppf(float v) { return __int_as_float(__builtin_amdgcn_update_dpp(0, __float_as_int(v), CTRL, 0xf, 0xf, false)); }
template <int CTRL> __device__ __forceinline__ int dppi(int v) { return __builtin_amdgcn_update_dpp(0, v, CTRL, 0xf, 0xf, false); }
__device__ __forceinline__ float g16_sum(float v) { v += dppf<0xB1>(v); v += dppf<0x4E>(v); v += dppf<0x141>(v); v += dppf<0x140>(v); return v; }
__device__ __forceinline__ float g16_max(float v) { v = fmaxf(v, dppf<0xB1>(v)); v = fmaxf(v, dppf<0x4E>(v)); v = fmaxf(v, dppf<0x141>(v)); v = fmaxf(v, dppf<0x140>(v)); return v; }
__device__ __forceinline__ int g16_sum_i(int v) { v += dppi<0xB1>(v); v += dppi<0x4E>(v); v += dppi<0x141>(v); v += dppi<0x140>(v); return v; }
__device__ __forceinline__ int g16_min_i(int v) { v = min(v, dppi<0xB1>(v)); v = min(v, dppi<0x4E>(v)); v = min(v, dppi<0x141>(v)); v = min(v, dppi<0x140>(v)); return v; }
__device__ __forceinline__ float rlf(float v, int k) { return __int_as_float(__builtin_amdgcn_readlane(__float_as_int(v), k)); }
__device__ __forceinline__ float wave_sum(float v) { v = g16_sum(v); return (rlf(v, 0) + rlf(v, 16)) + (rlf(v, 32) + rlf(v, 48)); }
__device__ __forceinline__ float wave_max(float v) { v = g16_max(v); return fmaxf(fmaxf(rlf(v, 0), rlf(v, 16)), fmaxf(rlf(v, 32), rlf(v, 48))); }
__device__ __forceinline__ int wave_sum_i(int v) { v = g16_sum_i(v); return (__builtin_amdgcn_readlane(v, 0) + __builtin_amdgcn_readlane(v, 16)) + (__builtin_amdgcn_readlane(v, 32) + __builtin_amdgcn_readlane(v, 48)); }
__device__ __forceinline__ int wave_min_i(int v) { v = g16_min_i(v); return min(min(__builtin_amdgcn_readlane(v, 0), __builtin_amdgcn_readlane(v, 16)), min(__builtin_amdgcn_readlane(v, 32), __builtin_amdgcn_readlane(v, 48))); }
__device__ __forceinline__ float sigmoidf_(float x) { return 1.0f / (1.0f + expf(-x)); }
__device__ __forceinline__ float fsig(float x) { return __builtin_amdgcn_rcpf(1.0f + __expf(-x)); }
__device__ __forceinline__ float ftanh(float x) { return 2.0f * fsig(2.0f * x) - 1.0f; }
__device__ __forceinline__ int row_seq(int row) { return row < NP ? (row >> 12) : 4 + ((row - NP) >> 3); }
__device__ __forceinline__ int row_pos(int row) { return row < NP ? (row & 4095) : PAST + ((row - NP) & 7); }
__device__ __forceinline__ int TID() { int t = threadIdx.x; asm volatile("" : "+v"(t)); return t; }
__device__ __forceinline__ int BID() { int b = blockIdx.x; asm volatile("" : "+s"(b)); return b; }
__device__ __forceinline__ void wave_lds_fence() { __builtin_amdgcn_fence(__ATOMIC_RELEASE, "wavefront"); __builtin_amdgcn_wave_barrier(); __builtin_amdgcn_fence(__ATOMIC_ACQUIRE, "wavefront"); }

#define XB_TMO      128
#define XB_XCNT(j)  (256  + 64 * (j))
#define XB_XSUB(j)  (1280 + 64 * (j))
#define XB_XGEN(j)  (2304 + 64 * (j))
#define XB_TOP      3328
#define XB_TOPGEN   3392
#define XCD_BAR_WORDS 3456
#define XB_SPIN_CAP (1u << 22)
__device__ __forceinline__ unsigned xb_ld(unsigned* p)              { return __hip_atomic_load(p, __ATOMIC_RELAXED, __HIP_MEMORY_SCOPE_AGENT); }
__device__ __forceinline__ unsigned xb_add(unsigned* p, unsigned v) { return __hip_atomic_fetch_add(p, v, __ATOMIC_RELAXED, __HIP_MEMORY_SCOPE_AGENT); }
__device__ __forceinline__ unsigned xb_xcc_id() { return (unsigned)__builtin_amdgcn_s_getreg((3 << 11) | 20) & 0xFu; }
#define XB_SPIN(cond, bar) do { unsigned _sp = 0; while (cond) { __builtin_amdgcn_s_sleep(1); \
    if ((++_sp & 255u) == 0u) { if (xb_ld(&(bar)[XB_TMO])) break; if (_sp > XB_SPIN_CAP) { atomicAdd(&(bar)[XB_TMO], 1u); break; } } } } while (0)
struct XcdBarrier { unsigned* bar; unsigned x; volatile LAS unsigned* st; };
__device__ __forceinline__ XcdBarrier xcd_barrier_post(unsigned* bar, volatile LAS unsigned* st) {
    XcdBarrier b; b.bar = bar; b.x = xb_xcc_id(); b.st = st;
    if (threadIdx.x == 0) (void)xb_add(&bar[XB_XCNT(b.x)], 1u);
    return b;
}
__device__ __forceinline__ void xcd_barrier_complete(unsigned* bar, unsigned x, unsigned& nloc, unsigned& nx) {
    const unsigned G = gridDim.x * gridDim.y * gridDim.z;
    unsigned sum, cnt, mine, sp = 0u;
    for (;;) {
        sum = 0u; cnt = 0u; mine = 0u;
#pragma unroll
        for (unsigned j = 0; j < 16; ++j) { const unsigned c = xb_ld(&bar[XB_XCNT(j)]); sum += c; cnt += (c > 0u) ? 1u : 0u; mine = (j == x) ? c : mine; }
        if (sum == G) break;
        __builtin_amdgcn_s_sleep(1);
        if ((++sp & 255u) == 0u) { if (xb_ld(&bar[XB_TMO])) break; if (sp > XB_SPIN_CAP) { atomicAdd(&bar[XB_TMO], 1u); break; } }
    }
    nloc = mine > 0u ? mine : 1u; nx = cnt > 0u ? cnt : 1u;
}
__device__ __forceinline__ void xcd_barrier(const XcdBarrier& b) {
    asm volatile("s_waitcnt vmcnt(0)" ::: "memory");
    __syncthreads();
    if (threadIdx.x == 0) {
        unsigned* bar = b.bar;
        __builtin_amdgcn_s_waitcnt(0);
        unsigned nloc = b.st[0], nx = b.st[1];
        if (nloc == 0u) { xcd_barrier_complete(bar, b.x, nloc, nx); b.st[0] = nloc; b.st[1] = nx; }
        const unsigned old = xb_add(&bar[XB_XSUB(b.x)], 1u);
        const unsigned gen = old / nloc;
        if (old + 1u == (gen + 1u) * nloc) {
            __builtin_amdgcn_fence(__ATOMIC_RELEASE, "agent");
            asm volatile("s_waitcnt vmcnt(0)" ::: "memory");
            const unsigned og = xb_add(&bar[XB_TOP], 1u);
            const unsigned tg = og / nx;
            if (og + 1u == (tg + 1u) * nx) xb_add(&bar[XB_TOPGEN], 1u);
            else XB_SPIN(xb_ld(&bar[XB_TOPGEN]) == tg, bar);
            __builtin_amdgcn_fence(__ATOMIC_ACQUIRE, "agent");
            xb_add(&bar[XB_XGEN(b.x)], 1u);
            asm volatile("s_waitcnt vmcnt(0)" ::: "memory");
        } else {
            XB_SPIN(xb_ld(&bar[XB_XGEN(b.x)]) == gen, bar);
            __builtin_amdgcn_fence(__ATOMIC_ACQUIRE, "agent");
            asm volatile("s_waitcnt vmcnt(0)" ::: "memory");
        }
    }
    __syncthreads();
}

struct P {
    const float *x_prompt, *x_sample, *cache_k, *cache_v, *cache_ik, *state_wkv, *state_shift; const int* page_table;
    const float *c_prompt, *c_sample, *norm_g, *w_ada, *b_ada, *w_up, *w_down, *rw_mix, *rw_w_rkv, *rw_w_o, *rw_w0, *rw_w1, *rw_w2, *rw_a0, *rw_a1, *rw_a2,
                *rw_v0, *rw_v1, *rw_v2, *rw_g1, *rw_g2, *rw_k_k, *rw_k_a, *rw_r_k, *rw_lnx_w, *rw_lnx_b, *att_w_in, *att_w_o, *att_q_norm, *att_k_norm, *idx_k_norm;
    float* out; unsigned char* ws; int ph_lo, ph_hi;
};
typedef const P __attribute__((address_space(4)))* KP;
#define WSP(T, off) ((T*)(p->ws + (off)))
__device__ __forceinline__ KP kargs() { KP k = (KP)__builtin_amdgcn_kernarg_segment_ptr(); asm volatile("" : "+s"(k)); return k; }

namespace pg8 {
constexpr int BM = 256, BK = 64, HALF = 128, HTB = HALF * BK * 2, STAGE_BYTES = 8 * HTB, NXCD = 8, WGM = 8;
__device__ __forceinline__ int lds_byte(int r, int c) { const int st = (r >> 4) * 2 + (c >> 5), rr = r & 15, cc = c & 31, ob = rr * 64 + cc * 2; return st * 1024 + (ob ^ (((ob >> 9) & 1) << 5)); }
__device__ __forceinline__ void stage_rc(int b, int& R, int& C) { const int st = b / 1024, sb = b % 1024, swz = sb ^ (((sb >> 9) & 1) << 5); R = (st >> 1) * 16 + swz / 64; C = (st & 1) * 32 + (swz % 64) / 2; }
__device__ __forceinline__ int perm32(int rho) { const int n = rho >> 4, i = rho & 15; return 8 * (i >> 2) + 4 * n + (i & 3); }
struct Unit { int pm, pn; };
struct Gemm { const bf16_t* A; const bf16_t* Bt; int M, N, K, mode; size_t agrp; };
__device__ __forceinline__ int phys_pn(const Gemm& g, int pn) { return (g.mode == 2 && pn >= 12) ? pn + 1 : pn; }
__device__ __forceinline__ const char* a_ptr(const Gemm& g, const Unit& u, size_t tstep) {
    int grp = 0; if (g.mode) grp = u.pn < 12 ? (u.pn >> 2) : (u.pn == 12 ? 2 : u.pn - 10);
    return (const char*)g.A + (size_t)grp * g.agrp * 2 + (size_t)u.pm * tstep; }
struct StaticOrder {
    int nM, nN, nwg, G, c;
    __device__ void init(int M, int N, int G_, int c_) { nM = M / BM; nN = N / BM; nwg = nM * nN; G = G_; c = c_; }
    __device__ bool next(int i, Unit& u) const {
        const long L = (long)i * G + c; if (L >= nwg) return false;
        int wgid = (int)L; { const int q = nwg / NXCD, r = nwg % NXCD, xcd = wgid % NXCD, off = wgid / NXCD; wgid = (xcd < r ? xcd * (q + 1) : r * (q + 1) + (xcd - r) * q) + off; }
        const int nig = WGM * nN, gid = wgid / nig, fm = gid * WGM, gsz = (nM - fm) < WGM ? (nM - fm) : WGM;
        u.pm = fm + ((wgid % nig) % gsz); u.pn = (wgid % nig) / gsz; return true;
    }
};
template <class F, bool PERM_> struct EpiAdapt {
    static constexpr bool PERM = PERM_;
    F f;
    __device__ __forceinline__ void operator()(const f32x4 (&acc)[2][2][4][2], const Unit& u, int wr, int wc, int fr, int fq) const {
        const int row0 = u.pm * BM + wr * 64 + fr, col0 = u.pn * BM + wc * 32 + (PERM ? 8 * fq : 4 * fq);
#pragma unroll
        for (int ai = 0; ai < 2; ++ai)
#pragma unroll
            for (int m = 0; m < 4; ++m)
#pragma unroll
                for (int bj = 0; bj < 2; ++bj) {
                    if constexpr (PERM) f.vec8(row0 + ai * HALF + m * 16, col0 + bj * HALF, acc[ai][bj][m][0], acc[ai][bj][m][1]);
                    else {
#pragma unroll
                        for (int n = 0; n < 2; ++n) f.vec4(row0 + ai * HALF + m * 16, col0 + bj * HALF + 16 * n, acc[ai][bj][m][n]);
                    }
                }
    }
};

template <class Epi>
__device__ __forceinline__ void gemm_phase(LAS unsigned char* lds, const Gemm g, const StaticOrder& S, const Epi& E) {
    const int tid = TID(), wid = __builtin_amdgcn_readfirstlane(tid >> 6), lane = tid & 63, wr = wid >> 2, wc = wid & 3, fr = lane & 15, fq = lane >> 4;
    const int K = g.K, nt = K / BK;
    unsigned voffA[2], voffB[2];
#pragma unroll
    for (int i = 0; i < 2; ++i) { int R, C; stage_rc(tid * 16 + i * 8192, R, C); const int Rb = Epi::PERM ? ((R & ~31) + perm32(R & 31)) : R;
        voffA[i] = (unsigned)(R * K + C) * 2u; voffB[i] = (unsigned)(Rb * K + C) * 2u; }
    const size_t kstep = (size_t)(BK * 2);
    const size_t hstep = (size_t)HALF * K * 2;
    const size_t tstep = 2 * hstep;
    const unsigned ldsw = (unsigned)wid * 1024u;
    const int aoff = lds_byte(wr * 64 + fr, fq * 8), boff = lds_byte(wc * 32 + fr, fq * 8);
#define PG8_SA(b, h) (((b) * 2 + (h)) * HTB)
#define PG8_SB(b, h) ((4 + (b) * 2 + (h)) * HTB)
#define PG8_STAGE(bufoff, gbase, voff) do { _Pragma("unroll") for (int _i = 0; _i < 2; ++_i) \
        __builtin_amdgcn_global_load_lds((const unsigned*)((const char*)(gbase) + (voff)[_i]), (LAS unsigned*)(lds + (bufoff) + ldsw + _i * 8192), 16, 0, 0); } while (0)
#define PG8_LDA(dst, b, h) do { _Pragma("unroll") for (int m = 0; m < 4; ++m) _Pragma("unroll") for (int k = 0; k < 2; ++k) dst[m][k] = *(const LAS bf16x8*)(lds + PG8_SA(b, h) + aoff + m * 2048 + k * 1024); } while (0)
#define PG8_LDB(dst, b, h) do { _Pragma("unroll") for (int n = 0; n < 2; ++n) _Pragma("unroll") for (int k = 0; k < 2; ++k) dst[n][k] = *(const LAS bf16x8*)(lds + PG8_SB(b, h) + boff + n * 2048 + k * 1024); } while (0)
#define PG8_MMA(ai, bj, At, Bt) do { __builtin_amdgcn_s_setprio(1); _Pragma("unroll") for (int m = 0; m < 4; ++m) _Pragma("unroll") for (int n = 0; n < 2; ++n) _Pragma("unroll") for (int k = 0; k < 2; ++k) \
        acc[ai][bj][m][n] = __builtin_amdgcn_mfma_f32_16x16x32_bf16(Bt[n][k], At[m][k], acc[ai][bj][m][n], 0, 0, 0); __builtin_amdgcn_s_setprio(0); } while (0)
#define PG8_WAIT_V(n) asm volatile("s_waitcnt vmcnt(" #n ")" ::: "memory")
#define PG8_WAIT_L(n) asm volatile("s_waitcnt lgkmcnt(" #n ")" ::: "memory")
#define PG8_BAR __builtin_amdgcn_s_barrier()
#define PG8_SCHED __builtin_amdgcn_sched_barrier(0)
    Unit cur, nxt; int ui = 0;
    if (!S.next(0, cur)) return;
    cur.pn = phys_pn(g, cur.pn);
    f32x4 acc[2][2][4][2];
#pragma unroll
    for (int a = 0; a < 2; ++a)
#pragma unroll
        for (int b = 0; b < 2; ++b)
#pragma unroll
            for (int m = 0; m < 4; ++m)
#pragma unroll
                for (int n = 0; n < 2; ++n) acc[a][b][m][n] = (f32x4){0.f, 0.f, 0.f, 0.f};
    bf16x8 At[4][2], B0[2][2], B1[2][2];
    const char* cA = a_ptr(g, cur, tstep); const char* cB = (const char*)g.Bt + (size_t)cur.pn * tstep;
    PG8_STAGE(PG8_SB(0, 0), cB, voffB); PG8_STAGE(PG8_SA(0, 0), cA, voffA); PG8_STAGE(PG8_SB(0, 1), cB + hstep, voffB); PG8_STAGE(PG8_SA(0, 1), cA + hstep, voffA);
    if (wr == 1) PG8_BAR;
    PG8_WAIT_V(4); PG8_BAR;
    PG8_STAGE(PG8_SB(1, 0), cB + kstep, voffB); PG8_STAGE(PG8_SA(1, 0), cA + kstep, voffA); PG8_STAGE(PG8_SB(1, 1), cB + hstep + kstep, voffB);
    PG8_WAIT_V(6); PG8_BAR;
    for (;;) {
        const bool has_next = S.next(ui + 1, nxt);
        if (has_next) nxt.pn = phys_pn(g, nxt.pn);
        const char* nA = has_next ? a_ptr(g, nxt, tstep) : cA; const char* nB = has_next ? (const char*)g.Bt + (size_t)nxt.pn * tstep : cB;
        for (int t = 0; t < nt; t += 2) {
            const bool last = (t == nt - 2);
            const char* a1 = cA + (size_t)(t + 1) * kstep;
            const char* a2 = last ? nA : cA + (size_t)(t + 2) * kstep; const char* b2 = last ? nB : cB + (size_t)(t + 2) * kstep;
            const char* a3 = a2 + kstep; const char* b3 = b2 + kstep;
            PG8_LDB(B0, 0, 0); PG8_SCHED; PG8_LDA(At, 0, 0); PG8_STAGE(PG8_SA(1, 1), a1 + hstep, voffA);
            PG8_WAIT_L(8); PG8_BAR; PG8_WAIT_L(0); PG8_MMA(0, 0, At, B0); PG8_BAR; PG8_SCHED;
            PG8_LDB(B1, 0, 1); PG8_STAGE(PG8_SB(0, 0), b2, voffB);
            PG8_BAR; PG8_WAIT_L(0); PG8_MMA(0, 1, At, B1); PG8_BAR;
            PG8_LDA(At, 0, 1); PG8_STAGE(PG8_SA(0, 0), a2, voffA);
            PG8_BAR; PG8_WAIT_L(0); PG8_MMA(1, 0, At, B0); PG8_BAR; PG8_SCHED;
            PG8_STAGE(PG8_SB(0, 1), b2 + hstep, voffB);
            PG8_WAIT_V(6); PG8_BAR; PG8_MMA(1, 1, At, B1); PG8_BAR;
            PG8_LDB(B0, 1, 0); PG8_SCHED; PG8_LDA(At, 1, 0); PG8_STAGE(PG8_SA(0, 1), a2 + hstep, voffA);
            PG8_WAIT_L(8); PG8_BAR; PG8_WAIT_L(0); PG8_MMA(0, 0, At, B0); PG8_BAR; PG8_SCHED;
            PG8_LDB(B1, 1, 1); PG8_STAGE(PG8_SB(1, 0), b3, voffB);
            PG8_BAR; PG8_WAIT_L(0); PG8_MMA(0, 1, At, B1); PG8_BAR;
            PG8_LDA(At, 1, 1); PG8_STAGE(PG8_SA(1, 0), a3, voffA);
            PG8_BAR; PG8_WAIT_L(0); PG8_MMA(1, 0, At, B0); PG8_BAR; PG8_SCHED;
            PG8_STAGE(PG8_SB(1, 1), b3 + hstep, voffB);
            PG8_WAIT_V(6); PG8_BAR; PG8_MMA(1, 1, At, B1); PG8_BAR;
        }
        E(acc, cur, wr, wc, fr, fq);
        if (!has_next) break;
#pragma unroll
        for (int a = 0; a < 2; ++a)
#pragma unroll
            for (int b = 0; b < 2; ++b)
#pragma unroll
                for (int m = 0; m < 4; ++m)
#pragma unroll
                    for (int n = 0; n < 2; ++n) acc[a][b][m][n] = (f32x4){0.f, 0.f, 0.f, 0.f};
        cur = nxt; cA = nA; cB = nB; ++ui;
    }
    PG8_WAIT_V(0);
    if (wr == 0) PG8_BAR;
    PG8_BAR;
#undef PG8_SA
#undef PG8_SB
#undef PG8_STAGE
#undef PG8_LDA
#undef PG8_LDB
#undef PG8_MMA
#undef PG8_WAIT_V
#undef PG8_WAIT_L
#undef PG8_BAR
#undef PG8_SCHED
}
}

template <class F>
__device__ __forceinline__ void sgemm_bf(LAS unsigned char* lds, const bf16_t* A, int lda, int row0, int M, const float* W, int ldw, int N, int K, int coloff, const F& f) {
    LAS float* As = (LAS float*)lds;
    LAS float* Ws = (LAS float*)(lds + 32 * 68 * 4);
    const int tid = TID(), ty = tid >> 4, tx = tid & 15;
    const int ntn = (N + 63) / 64, ntiles = (M / 64) * ntn;
    for (int tile = BID(); tile < ntiles; tile += gridDim.x) {
        const int tm = tile / ntn, tn = tile % ntn, r0 = row0 + tm * 64, n0 = tn * 64;
        f32x4 c0 = {0.f, 0.f, 0.f, 0.f}, c1 = {0.f, 0.f, 0.f, 0.f};
        for (int k0 = 0; k0 < K; k0 += 32) {
            __syncthreads();
            { const int r = tid >> 3, q = tid & 7; const f32x4 a = ld_bf4(A + (size_t)(r0 + r) * lda + k0 + 4 * q);
              As[(4 * q + 0) * 68 + r] = a[0]; As[(4 * q + 1) * 68 + r] = a[1]; As[(4 * q + 2) * 68 + r] = a[2]; As[(4 * q + 3) * 68 + r] = a[3]; }
            { const int kr = tid >> 4, c = tid & 15; f32x4 w = {0.f, 0.f, 0.f, 0.f}; if (n0 + 4 * c < N) w = *(const f32x4*)(W + (size_t)(k0 + kr) * ldw + n0 + 4 * c);
              *(LAS f32x4*)(Ws + kr * 68 + 4 * c) = w; }
            __syncthreads();
#pragma unroll 8
            for (int kk = 0; kk < 32; ++kk) {
                const f32x2 a = *(const LAS f32x2*)(As + kk * 68 + 2 * ty); const f32x4 b = *(const LAS f32x4*)(Ws + kk * 68 + 4 * tx);
                c0 += a.x * b; c1 += a.y * b;
            }
        }
        if (n0 + 4 * tx < N) { f.vec4(r0 + 2 * ty, n0 + 4 * tx + coloff, c0); f.vec4(r0 + 2 * ty + 1, n0 + 4 * tx + coloff, c1); }
    }
    __syncthreads();
}

typedef float f32x16 __attribute__((ext_vector_type(16)));
__device__ __forceinline__ int rw_group(int n0) { const int t = n0 >> 8; return t < 12 ? (t >> 2) : (t == 12 ? 2 : t - 10); }
template <bool RWGRP, class F>
__device__ __forceinline__ void wgemm_ks(LAS unsigned char* lds, const bf16_t* A, int lda, size_t agrp, int row0, int M, const bf16_t* Bt, int K, int N, const F& f, int wg0 = 0) {
    const int tid = TID(), wave = tid >> 6, lane = tid & 63, lr = lane & 31, lh = lane >> 5;
    LAS float* red = (LAS float*)lds;
    const int ntn = N / 64, nitems = (M / 32) * ntn, kw = K / 8, steps = kw / 16;
    const int vb_ = BID() - wg0, nwg_ = (int)gridDim.x - wg0;
    for (int item = vb_ < 0 ? nitems : vb_; item < nitems; item += nwg_) {
        const int tm = item / ntn, tn = item % ntn, r0 = row0 + tm * 32, n0 = tn * 64;
        const bf16_t* Ab = A + (RWGRP ? (size_t)rw_group(n0) * agrp : 0) + (size_t)(r0 + lr) * lda + wave * kw + lh * 8;
        const bf16_t* B0 = Bt + (size_t)(n0 + lr) * K + wave * kw + lh * 8; const bf16_t* B1 = B0 + (size_t)32 * K;
        f32x16 acc0, acc1;
#pragma unroll
        for (int r = 0; r < 16; ++r) { acc0[r] = 0.f; acc1[r] = 0.f; }
#pragma unroll 8
        for (int st = 0; st < steps; ++st) {
            const bf16x8 a = *(const bf16x8*)(Ab + 16 * st), b0 = *(const bf16x8*)(B0 + 16 * st), b1 = *(const bf16x8*)(B1 + 16 * st);
            acc0 = __builtin_amdgcn_mfma_f32_32x32x16_bf16(b0, a, acc0, 0, 0, 0);
            acc1 = __builtin_amdgcn_mfma_f32_32x32x16_bf16(b1, a, acc1, 0, 0, 0);
        }
        __syncthreads();
#pragma unroll
        for (int r = 0; r < 16; ++r) { red[((wave * 2 + 0) * 16 + r) * 64 + lane] = acc0[r]; red[((wave * 2 + 1) * 16 + r) * 64 + lane] = acc1[r]; }
        __syncthreads();
        { const int t = tid >> 8, r4 = (tid >> 6) & 3, l2 = tid & 63; f32x4 v = {0.f, 0.f, 0.f, 0.f};
#pragma unroll
          for (int w = 0; w < 8; ++w)
#pragma unroll
              for (int e = 0; e < 4; ++e) v[e] += red[((w * 2 + t) * 16 + 4 * r4 + e) * 64 + l2];
          f.vec4(r0 + (l2 & 31), n0 + 32 * t + 8 * r4 + 4 * (l2 >> 5), v); }
    }
    __syncthreads();
}
template <class F>
__device__ __forceinline__ void wgemm_w(const bf16_t* A, int lda, int row0, int M, const bf16_t* Bt, int K, int N, const F& f) {
    const int lane = TID() & 63, lr = lane & 31, lh = lane >> 5, gw = BID() * 8 + (TID() >> 6), nw = gridDim.x * 8;
    const int ntn = N / 64, nitems = (M / 32) * ntn, steps = K / 16;
    for (int item = gw; item < nitems; item += nw) {
        const int tm = item / ntn, tn = item % ntn, r0 = row0 + tm * 32, n0 = tn * 64;
        const bf16_t* Ab = A + (size_t)(r0 + lr) * lda + lh * 8;
        const bf16_t* B0 = Bt + (size_t)(n0 + lr) * K + lh * 8; const bf16_t* B1 = B0 + (size_t)32 * K;
        f32x16 acc0, acc1;
#pragma unroll
        for (int r = 0; r < 16; ++r) { acc0[r] = 0.f; acc1[r] = 0.f; }
        for (int st = 0; st < steps; ++st) {
            const bf16x8 a = *(const bf16x8*)(Ab + 16 * st), b0 = *(const bf16x8*)(B0 + 16 * st), b1 = *(const bf16x8*)(B1 + 16 * st);
            acc0 = __builtin_amdgcn_mfma_f32_32x32x16_bf16(b0, a, acc0, 0, 0, 0);
            acc1 = __builtin_amdgcn_mfma_f32_32x32x16_bf16(b1, a, acc1, 0, 0, 0);
        }
#pragma unroll
        for (int r4 = 0; r4 < 4; ++r4) {
            f.vec4(r0 + lr, n0 + 8 * r4 + 4 * lh, (f32x4){acc0[4 * r4], acc0[4 * r4 + 1], acc0[4 * r4 + 2], acc0[4 * r4 + 3]});
            f.vec4(r0 + lr, n0 + 32 + 8 * r4 + 4 * lh, (f32x4){acc1[4 * r4], acc1[4 * r4 + 1], acc1[4 * r4 + 2], acc1[4 * r4 + 3]});
        }
    }
}

struct FRwkvIn {
    bf16_t *rb, *kb, *vb, *tw, *ta, *tv, *tg;
    __device__ __forceinline__ void vec8(int row, int col, f32x4 a, f32x4 b) const {
        if (col < 3072) { u32x4 w; w.x = pk_bf16(a[0], a[1]); w.y = pk_bf16(a[2], a[3]); w.z = pk_bf16(b[0], b[1]); w.w = pk_bf16(b[2], b[3]);
            *(u32x4*)(rb + (size_t)(col >> 10) * XR_STRIDE + (size_t)row * D + (col & 1023)) = w; }
        else { vec4(row, col, a); vec4(row, col + 4, b); } }
    __device__ __forceinline__ void vec4(int row, int col, f32x4 v) const {
        if (col < 3072) { st_bf4(rb + (size_t)(col >> 10) * XR_STRIDE + (size_t)row * D + (col & 1023), v); }
        else if (col < 3328) { const int c = col - 3072; if (c < 32) st_bf4(tv + (size_t)row * 32 + c, v); }
        else if (col < 3584) { const int c = col - 3328; if (c < 64) { f32x4 t = {ftanh(v[0]), ftanh(v[1]), ftanh(v[2]), ftanh(v[3])}; st_bf4(tw + (size_t)row * 64 + c, t); } }
        else if (col < 3840) { const int c = col - 3584; if (c < 64) st_bf4(ta + (size_t)row * 64 + c, v); }
        else { const int c = col - 3840; if (c < 160) { f32x4 t = {fsig(v[0]), fsig(v[1]), fsig(v[2]), fsig(v[3])}; st_bf4(tg + (size_t)row * 160 + c, t); } }
    }
};
struct FStoreF32 { float* C; int ldc; int ncols; __device__ __forceinline__ void vec4(int row, int col, f32x4 v) const { if (col < ncols) *(f32x4*)(C + (size_t)row * ldc + col) = v; } };
struct FStoreBf16 { bf16_t* C; int ldc; int ncols;
    __device__ __forceinline__ void vec4(int row, int col, f32x4 v) const { if (col < ncols) st_bf4(C + (size_t)row * ldc + col, v); }
    __device__ __forceinline__ void vec8(int row, int col, f32x4 a, f32x4 b) const { if (col < ncols) { u32x4 w; w.x = pk_bf16(a[0], a[1]); w.y = pk_bf16(a[2], a[3]); w.z = pk_bf16(b[0], b[1]); w.w = pk_bf16(b[2], b[3]); *(u32x4*)(C + (size_t)row * ldc + col) = w; } } };
struct FResid {
    float* X; const float* gate;
    const float* xin_p; const float* xin_s;
    __device__ __forceinline__ void vec4(int row, int col, f32x4 v) const {
        const f32x4 g = *(const f32x4*)(gate + (size_t)row_seq(row) * 6144 + col); float* xp = X + (size_t)row * D + col;
        const float* ip = xin_p ? (row < NP ? xin_p + (size_t)row * D + col : xin_s + (size_t)(row - NP) * D + col) : xp;
        const f32x4 x = *(const f32x4*)ip; *(f32x4*)xp = x + g * v; }
};
struct FRelu2 { bf16_t* U;
    __device__ __forceinline__ void vec8(int row, int col, f32x4 a, f32x4 b) const {
        f32x4 s, t; for (int e = 0; e < 4; ++e) { const float x = fmaxf(a[e], 0.f), y = fmaxf(b[e], 0.f); s[e] = x * x; t[e] = y * y; }
        u32x4 w; w.x = pk_bf16(s[0], s[1]); w.y = pk_bf16(s[2], s[3]); w.z = pk_bf16(t[0], t[1]); w.w = pk_bf16(t[2], t[3]); *(u32x4*)(U + (size_t)row * DFF + col) = w; }
    __device__ __forceinline__ void vec4(int row, int col, f32x4 v) const {
        f32x4 t; for (int e = 0; e < 4; ++e) { const float r = fmaxf(v[e], 0.f); t[e] = r * r; } st_bf4(U + (size_t)row * DFF + col, t); } };

__device__ __forceinline__ void phase_copy_x(KP p) {
    const size_t n4p = (size_t)NP * D / 4, n4 = (size_t)NT * D / 4;
    for (size_t i = (size_t)BID() * 512 + TID(); i < n4; i += (size_t)gridDim.x * 512)
        ((f32x4*)p->out)[i] = i < n4p ? ((const f32x4*)p->x_prompt)[i] : ((const f32x4*)p->x_sample)[i - n4p];
}

struct TJob { const float* src; bf16_t* dst; int K, N, drow0; };
__device__ __forceinline__ TJob tjob(KP p, int i) {
    TJob t; t.drow0 = 0;
    if (i < 4) { t.src = p->w_up + (size_t)i * D * DFF; t.dst = WSP(bf16_t, WS_WUP_T) + (size_t)i * DFF * D; t.K = D; t.N = DFF; return t; }
    if (i < 8) { const int l = i - 4; t.src = p->w_down + (size_t)l * DFF * D; t.dst = WSP(bf16_t, WS_WDN_T) + (size_t)l * DFF * D; t.K = DFF; t.N = D; return t; }
    i -= 8; const int j = i / 14, k = i % 14; bf16_t* wrw = WSP(bf16_t, WS_WRW_T) + (size_t)j * 4096 * D;
    t.K = D; t.N = D;
    switch (k) {
        case 0: case 1: case 2: t.src = p->rw_w_rkv + ((size_t)j * 3 + k) * D * D; t.dst = wrw; t.drow0 = k * 1024; break;
        case 3: t.src = p->rw_v1; t.dst = wrw; t.drow0 = 3072; t.N = j == 1 ? 32 : 0; break;
        case 4: t.src = p->rw_w1 + (size_t)j * D * 64; t.dst = wrw; t.drow0 = 3328; t.N = 64; break;
        case 5: t.src = p->rw_a1 + (size_t)j * D * 64; t.dst = wrw; t.drow0 = 3584; t.N = 64; break;
        case 6: t.src = p->rw_g1 + (size_t)j * D * 160; t.dst = wrw; t.drow0 = 3840; t.N = 160; break;
        case 7: t.src = p->rw_w_o + (size_t)j * D * D; t.dst = WSP(bf16_t, WS_WO_T) + (size_t)j * D * D; break;
        case 8: t.src = p->rw_w2 + (size_t)j * 64 * D; t.dst = WSP(bf16_t, WS_W2T) + (size_t)j * D * 64; t.K = 64; break;
        case 9: t.src = p->rw_a2 + (size_t)j * 64 * D; t.dst = WSP(bf16_t, WS_A2T) + (size_t)j * D * 64; t.K = 64; break;
        case 10: t.src = p->rw_g2 + (size_t)j * 160 * D; t.dst = WSP(bf16_t, WS_G2T) + (size_t)j * D * 160; t.K = 160; break;
        case 11: t.src = p->rw_v2; t.dst = WSP(bf16_t, WS_V2T); t.K = 32; t.N = j == 1 ? D : 0; break;
        case 12: t.src = p->att_w_in + (size_t)j * D * PIN; t.dst = WSP(bf16_t, WS_WIN_T) + (size_t)j * PINP * D; t.N = PIN; break;
        default: t.src = p->att_w_o + (size_t)j * D * D; t.dst = WSP(bf16_t, WS_WAO_T) + (size_t)j * D * D; break;
    }
    return t;
}
__device__ __forceinline__ int tjob_tiles(const TJob& t) { return ((t.K + 63) / 64) * ((t.N + 63) / 64); }
__device__ __forceinline__ void phase_weights(KP p, LAS unsigned char* lds) {
    LAS float* T = (LAS float*)lds;
    int total = 0;
    for (int i = 0; i < 36; ++i) total += tjob_tiles(tjob(p, i));
    const int ngrp = (total + 3) / 4;
    f32x4 v[4][2];
    bf16_t* dstn[4]; int Kn[4], nlim[4], klim[4];
#define WT_ISSUE(G_) do { const int tid_ = TID(), kk_ = tid_ >> 4, n4_ = (tid_ & 15) * 4; \
        int i_ = 0, start_ = 0, cnt_ = tjob_tiles(tjob(p, 0)); \
        _Pragma("unroll") for (int u = 0; u < 4; ++u) { const int gt_ = 4 * (G_) + u; \
            while (i_ < 35 && gt_ >= start_ + cnt_) { start_ += cnt_; ++i_; cnt_ = tjob_tiles(tjob(p, i_)); } \
            const TJob tj_ = tjob(p, i_); const int lt_ = gt_ - start_, nkt_ = (tj_.K + 63) / 64; \
            const bool dead_ = gt_ >= total || lt_ >= cnt_; const int k0_ = dead_ ? 0 : (lt_ % nkt_) * 64, n0_ = dead_ ? 0 : (lt_ / nkt_) * 64; \
            dstn[u] = tj_.dst + (size_t)(tj_.drow0 + n0_) * tj_.K + k0_; Kn[u] = tj_.K; nlim[u] = dead_ ? 0 : tj_.N - n0_; klim[u] = dead_ ? 0 : tj_.K - k0_; \
            _Pragma("unroll") for (int hh = 0; hh < 2; ++hh) { const int k_ = k0_ + kk_ + 32 * hh, n_ = n0_ + n4_; \
                v[u][hh] = *(const f32x4*)(tj_.src + (size_t)min(k_, tj_.K - 1) * tj_.N + min(n_, tj_.N - 4)); } } } while (0)
    if (BID() < ngrp) WT_ISSUE(BID());
    for (int g = BID(); g < ngrp; g += gridDim.x) {
        const int tid = TID(), kk = tid >> 4, n4 = (tid & 15) * 4;
#pragma unroll
        for (int u = 0; u < 4; ++u)
#pragma unroll
            for (int hh = 0; hh < 2; ++hh)
#pragma unroll
                for (int e = 0; e < 4; ++e) T[(u * 64 + kk + 32 * hh) * 65 + n4 + e] = v[u][hh][e];
        bf16_t* dstc[4]; int Kc[4], nl[4], kl[4];
#pragma unroll
        for (int u = 0; u < 4; ++u) { dstc[u] = dstn[u]; Kc[u] = Kn[u]; nl[u] = nlim[u]; kl[u] = klim[u]; }
        if (g + (int)gridDim.x < ngrp) WT_ISSUE(g + (int)gridDim.x);
        asm volatile("s_waitcnt lgkmcnt(0)" ::: "memory"); __builtin_amdgcn_s_barrier(); asm volatile("" ::: "memory");
        const int nn = tid >> 3, k8 = (tid & 7) * 8;
#pragma unroll
        for (int u = 0; u < 4; ++u) {
            if (nn < nl[u] && k8 < kl[u]) {
                u32x4 w;
                w.x = pk_bf16(T[(u * 64 + k8 + 0) * 65 + nn], T[(u * 64 + k8 + 1) * 65 + nn]); w.y = pk_bf16(T[(u * 64 + k8 + 2) * 65 + nn], T[(u * 64 + k8 + 3) * 65 + nn]);
                w.z = pk_bf16(T[(u * 64 + k8 + 4) * 65 + nn], T[(u * 64 + k8 + 5) * 65 + nn]); w.w = pk_bf16(T[(u * 64 + k8 + 6) * 65 + nn], T[(u * 64 + k8 + 7) * 65 + nn]);
                *(u32x4*)(dstc[u] + (size_t)nn * Kc[u] + k8) = w;
            }
        }
        asm volatile("s_waitcnt lgkmcnt(0)" ::: "memory"); __builtin_amdgcn_s_barrier(); asm volatile("" ::: "memory");
    }
#undef WT_ISSUE
    __syncthreads();
}

__device__ __forceinline__ void phase_ada(KP p, LAS unsigned char* lds) {
    float* mods = WSP(float, WS_MODS);
    LAS float* red = (LAS float*)lds;
    const int tid = TID(), lane = tid & 63, w = tid >> 6, ln = lane & 15, lq = lane >> 4;
    float af[3][32];
#pragma unroll
    for (int m = 0; m < 3; ++m) {
        const int s = 16 * m + ln; const bool ok = s < 36;
        const float* cp = s < 4 ? p->c_prompt + (size_t)s * D : p->c_sample + (size_t)((ok ? s : 35) - 4) * D;
#pragma unroll
        for (int i = 0; i < 32; ++i) { const float cv = cp[128 * w + 4 * i + lq]; af[m][i] = ok ? cv * __builtin_amdgcn_rcpf(1.0f + __expf(-cv)) : 0.f; }
    }
    f32x2 wv[32];
#define ADA_LOAD(B_) do { const int l_ = (B_) / 192, cb_ = ((B_) % 192) * 32; const float* wp_ = p->w_ada + ((size_t)l_ * D + 128 * w + lq) * 6144 + cb_ + 2 * ln; \
        _Pragma("unroll") for (int i = 0; i < 32; ++i) wv[i] = *(const f32x2*)(wp_ + (size_t)(4 * i) * 6144); } while (0)
    if (BID() < 768) ADA_LOAD(BID());
    for (int B = BID(); B < 768; B += gridDim.x) {
        const int l = B / 192, cb = (B % 192) * 32;
        f32x4 acc[3][2];
#pragma unroll
        for (int m = 0; m < 3; ++m) { acc[m][0] = (f32x4){0.f, 0.f, 0.f, 0.f}; acc[m][1] = acc[m][0]; }
#pragma unroll
        for (int i = 0; i < 32; ++i)
#pragma unroll
            for (int m = 0; m < 3; ++m) {
                acc[m][0] = __builtin_amdgcn_mfma_f32_16x16x4f32(af[m][i], wv[i][0], acc[m][0], 0, 0, 0);
                acc[m][1] = __builtin_amdgcn_mfma_f32_16x16x4f32(af[m][i], wv[i][1], acc[m][1], 0, 0, 0);
            }
        if (B + (int)gridDim.x < 768) ADA_LOAD(B + (int)gridDim.x);
#pragma unroll
        for (int m = 0; m < 3; ++m)
#pragma unroll
            for (int r = 0; r < 4; ++r) { const int s = 16 * m + 4 * lq + r;
                if (s < 36) *(LAS f32x2*)(red + (w * 36 + s) * 32 + 2 * ln) = (f32x2){acc[m][0][r], acc[m][1][r]}; }
        asm volatile("s_waitcnt lgkmcnt(0)" ::: "memory"); __builtin_amdgcn_s_barrier(); asm volatile("" ::: "memory");
        for (int o = tid; o < 36 * 32; o += 512) { const int s = o >> 5, cc = o & 31;
            float v = 0.f;
#pragma unroll
            for (int ww = 0; ww < 8; ++ww) v += red[(ww * 36 + s) * 32 + cc];
            mods[((size_t)l * 36 + s) * 6144 + cb + cc] = v + p->b_ada[l * 6144 + cb + cc]; }
        asm volatile("s_waitcnt lgkmcnt(0)" ::: "memory"); __builtin_amdgcn_s_barrier(); asm volatile("" ::: "memory");
    }
#undef ADA_LOAD
    __syncthreads();
}

template <bool MIX>
__device__ __forceinline__ void phase_prep(KP p, int layer, int which, int j, bool first = false) {
    const float* X = p->out;
    const float* mods = WSP(float, WS_MODS) + (size_t)layer * 36 * 6144;
    const float* g = p->norm_g + (layer * 2 + which) * D;
    bf16_t* XR = WSP(bf16_t, WS_XR);
    const int lane = TID() & 63, gw = BID() * 8 + (TID() >> 6), nw = gridDim.x * 8;
    for (int run = gw; run < NT / 8; run += nw) {
        const int row0 = run * 8, seq = row_seq(row0);
        const float* sh = mods + (size_t)seq * 6144 + (which ? 3 : 0) * D; const float* sc = sh + D;
        f32x4 gv[4], scv[4], shv[4], hp[4];
#pragma unroll
        for (int i = 0; i < 4; ++i) { const int col = 512 * (i >> 1) + 8 * lane + 4 * (i & 1); gv[i] = *(const f32x4*)(g + col); scv[i] = *(const f32x4*)(sc + col) + 1.0f; shv[i] = *(const f32x4*)(sh + col); hp[i] = (f32x4){0.f, 0.f, 0.f, 0.f}; }
        int rstart = 0;
        if (MIX) {
            if (row0 >= NP) {
#pragma unroll
                for (int i = 0; i < 4; ++i) hp[i] = *(const f32x4*)(p->state_shift + ((size_t)j * 32 + (seq - 4)) * D + 512 * (i >> 1) + 8 * lane + 4 * (i & 1));
            } else if ((row0 & 4095) != 0) rstart = -1;
        }
        for (int r = rstart; r < 8; ++r) {
            const int row = row0 + r;
            f32x4 x[4]; float ss = 0.f;
            const float* xr = first ? (row < NP ? p->x_prompt + (size_t)row * D : p->x_sample + (size_t)(row - NP) * D) : X + (size_t)row * D;
#pragma unroll
            for (int i = 0; i < 4; ++i) { x[i] = *(const f32x4*)(xr + 512 * (i >> 1) + 8 * lane + 4 * (i & 1)); ss += x[i][0] * x[i][0] + x[i][1] * x[i][1] + x[i][2] * x[i][2] + x[i][3] * x[i][3]; }
            ss = wave_sum(ss);
            const float rstd = rsqrtf(ss * (1.0f / 1024.0f) + 1e-6f);
            f32x4 h[4];
#pragma unroll
            for (int i = 0; i < 4; ++i) h[i] = x[i] * rstd * gv[i] * scv[i] + shv[i];
            if (MIX) {
                if (r >= 0) {
#pragma unroll
                    for (int n = 0; n < 6; ++n) {
                        const int mi = n == 0 ? 0 : (n == 1 ? 2 : (n == 2 ? 3 : (n == 3 ? 1 : n)));
                        const float* mx = p->rw_mix + ((size_t)j * 6 + mi) * D;
#pragma unroll
                        for (int i2 = 0; i2 < 2; ++i2) { const int col = 512 * i2 + 8 * lane; const f32x4 m0 = *(const f32x4*)(mx + col), m1 = *(const f32x4*)(mx + col + 4);
                            const f32x4 a = h[2 * i2] + (hp[2 * i2] - h[2 * i2]) * m0, b2 = h[2 * i2 + 1] + (hp[2 * i2 + 1] - h[2 * i2 + 1]) * m1;
                            u32x4 w; w.x = pk_bf16(a[0], a[1]); w.y = pk_bf16(a[2], a[3]); w.z = pk_bf16(b2[0], b2[1]); w.w = pk_bf16(b2[2], b2[3]);
                            *(u32x4*)(XR + (size_t)n * XR_STRIDE + (size_t)row * D + col) = w; }
                    }
                    const bool lastp = row < NP && (row & 4095) == 4095, lasts = row >= NP && ((row - NP) & 7) == 7;
                    if (lastp || lasts) {
                        float* so = lastp ? p->out + O_SHP + ((size_t)j * 4 + seq) * D : p->out + O_SHS + ((size_t)j * 32 + (seq - 4)) * D;
#pragma unroll
                        for (int i = 0; i < 4; ++i) *(f32x4*)(so + 512 * (i >> 1) + 8 * lane + 4 * (i & 1)) = h[i];
                    }
                }
#pragma unroll
                for (int i = 0; i < 4; ++i) hp[i] = h[i];
            } else {
#pragma unroll
                for (int i2 = 0; i2 < 2; ++i2) { const f32x4 a = h[2 * i2], b2 = h[2 * i2 + 1]; u32x4 w; w.x = pk_bf16(a[0], a[1]); w.y = pk_bf16(a[2], a[3]); w.z = pk_bf16(b2[0], b2[1]); w.w = pk_bf16(b2[2], b2[3]);
                    *(u32x4*)(XR + (size_t)row * D + 512 * i2 + 8 * lane) = w; }
            }
        }
    }
}

__device__ __forceinline__ void phase_scanprep(KP p, int j) {
    const bf16_t *KB = WSP(bf16_t, WS_KB), *VB = WSP(bf16_t, WS_VB);
    const float *WPp = WSP(float, WS_WP), *APp = WSP(float, WS_AP), *VPp = WSP(float, WS_VP);
    float *VF = WSP(float, WS_VFIRST), *DEC = WSP(float, WS_DEC), *KM = WSP(float, WS_KM), *VM = WSP(float, WS_VM), *AV = WSP(float, WS_AV), *BV = WSP(float, WS_BV);
    const int lane = TID() & 63, gw = BID() * 8 + (TID() >> 6), nw = gridDim.x * 8;
    for (int row = gw; row < NT; row += nw) {
#pragma unroll
        for (int i = 0; i < 4; ++i) {
            const int col = 256 * i + 4 * lane; const size_t o = (size_t)row * D + col;
            const f32x4 k = ld_bf4(KB + o), v = ld_bf4(VB + o), wp = *(const f32x4*)(WPp + o), ap = *(const f32x4*)(APp + o);
            const f32x4 w0 = *(const f32x4*)(p->rw_w0 + j * D + col), a0 = *(const f32x4*)(p->rw_a0 + j * D + col), kkw = *(const f32x4*)(p->rw_k_k + j * D + col), kaw = *(const f32x4*)(p->rw_k_a + j * D + col);
            f32x4 dec, a, vm, kk, km;
#pragma unroll
            for (int e = 0; e < 4; ++e) {
                const float wpre = w0[e] + wp[e], z = -wpre, sp = fmaxf(z, 0.f) + log1pf(expf(-fabsf(z)));
                dec[e] = expf(-expf(-sp - 0.5f));
                a[e] = sigmoidf_(a0[e] + ap[e]);
                kk[e] = k[e] * kkw[e];
                km[e] = k[e] * (1.0f + (a[e] - 1.0f) * kaw[e]);
            }
            if (j == 0) { vm = v; *(f32x4*)(VF + o) = v; }
            else { const f32x4 vf = *(const f32x4*)(VF + o), vp = *(const f32x4*)(VPp + o), v0 = *(const f32x4*)(p->rw_v0 + (j - 1) * D + col);
#pragma unroll
                for (int e = 0; e < 4; ++e) vm[e] = v[e] + (vf[e] - v[e]) * sigmoidf_(v0[e] + vp[e]); }
            float ss = kk[0] * kk[0] + kk[1] * kk[1] + kk[2] * kk[2] + kk[3] * kk[3];
            ss = g16_sum(ss);
            const float inv = rsqrtf(fmaxf(ss, 1e-24f));
            kk = kk * inv;
            *(f32x4*)(DEC + o) = dec; *(f32x4*)(KM + o) = km; *(f32x4*)(VM + o) = vm; *(f32x4*)(AV + o) = -kk; *(f32x4*)(BV + o) = kk * a;
        }
    }
}

__device__ __forceinline__ float rl(float v, int k) { return __int_as_float(__builtin_amdgcn_readlane(__float_as_int(v), k)); }
__device__ __forceinline__ void scan_run(KP p, size_t row_base, int nsteps, int colbase, float (&S)[64]) {
    const float *DEC = WSP(float, WS_DEC), *KM = WSP(float, WS_KM), *VM = WSP(float, WS_VM), *AV = WSP(float, WS_AV), *BV = WSP(float, WS_BV);
    const bf16_t* RB = WSP(bf16_t, WS_RB); float* Y = WSP(float, WS_Y);
    const int lane = TID() & 63;
    size_t o = row_base * D + colbase + lane;
    float w = DEC[o], kx = KM[o], v = VM[o], a = AV[o], b = BV[o], r = bf2f(RB[o]);
    for (int t = 0; t < nsteps; ++t) {
        const size_t on = (t + 1 < nsteps) ? o + D : o;
        const float wn = DEC[on], kn = KM[on], vn = VM[on], an = AV[on], bn = BV[on], rn = bf2f(RB[on]);
        float sa = 0.f;
#pragma unroll
        for (int k = 0; k < 64; ++k) sa += S[k] * rl(a, k);
#pragma unroll
        for (int k = 0; k < 64; ++k) S[k] = S[k] * rl(w, k) + sa * rl(b, k) + v * rl(kx, k);
        float y = 0.f;
#pragma unroll
        for (int k = 0; k < 64; ++k) y += S[k] * rl(r, k);
        Y[o] = y;
        o = on; w = wn; kx = kn; v = vn; a = an; b = bn; r = rn;
    }
}
__device__ __forceinline__ void phase_scanA(KP p) {
    const float *DEC = WSP(float, WS_DEC), *KM = WSP(float, WS_KM), *VM = WSP(float, WS_VM), *AV = WSP(float, WS_AV), *BV = WSP(float, WS_BV);
    float *PCH = WSP(float, WS_PCH), *CCH = WSP(float, WS_CCH);
    const int lane = TID() & 63, gw = BID() * 8 + (TID() >> 6), nw = gridDim.x * 8;
    for (int it = gw; it < 64 * NCH; it += nw) {
        const int sh = it / NCH, c = it % NCH, b = sh >> 4, h = sh & 15;
        float SP[64], SC[64];
#pragma unroll
        for (int k = 0; k < 64; ++k) { SP[k] = (k == lane) ? 1.f : 0.f; SC[k] = 0.f; }
        size_t o = ((size_t)b * 4096 + (size_t)c * LCH) * D + h * 64 + lane;
        float w = DEC[o], kx = KM[o], v = VM[o], a = AV[o], bb = BV[o];
        for (int t = 0; t < LCH; ++t) {
            const size_t on = (t + 1 < LCH) ? o + D : o;
            const float wn = DEC[on], kn = KM[on], vn = VM[on], an = AV[on], bn = BV[on];
            float saP = 0.f, saC = 0.f;
#pragma unroll
            for (int k = 0; k < 64; ++k) { const float ak = rl(a, k); saP += SP[k] * ak; saC += SC[k] * ak; }
#pragma unroll
            for (int k = 0; k < 64; ++k) { const float wk = rl(w, k), bk = rl(bb, k); SP[k] = SP[k] * wk + saP * bk; SC[k] = SC[k] * wk + saC * bk + v * rl(kx, k); }
            o = on; w = wn; kx = kn; v = vn; a = an; bb = bn;
        }
        float* po = PCH + ((size_t)it * 64 + lane) * 64; float* co = CCH + ((size_t)it * 64 + lane) * 64;
#pragma unroll
        for (int k = 0; k < 64; k += 4) { *(f32x4*)(po + k) = (f32x4){SP[k], SP[k + 1], SP[k + 2], SP[k + 3]}; *(f32x4*)(co + k) = (f32x4){SC[k], SC[k + 1], SC[k + 2], SC[k + 3]}; }
    }
}
__device__ __forceinline__ void phase_scanB(KP p, int j, LAS unsigned char* lds) {
    const int tid = TID(), lane = tid & 63, wave = tid >> 6;
    if (BID() < 32) {
        const float *PCH = WSP(float, WS_PCH), *CCH = WSP(float, WS_CCH); float* SST = WSP(float, WS_SST);
        const int sh = BID() * 2 + (wave >> 2), q = wave & 3, row0 = 32 * (q >> 1), col0 = 32 * (q & 1), b = sh >> 4, h = sh & 15;
        LAS float* Sl = (LAS float*)lds + (wave >> 2) * (2 * 64 * 65);
        const int lr = lane & 31, lh = lane >> 5;
        f32x16 acc;
#pragma unroll
        for (int r = 0; r < 16; ++r) acc[r] = 0.f;
        for (int c = 0; c <= NCH; ++c) {
            LAS float* Sw = Sl + (c & 1) * (64 * 65);
            float* go = c < NCH ? SST + ((size_t)sh * NCH + c) * 4096 : p->out + O_WKVP + (((size_t)j * 4 + b) * 16 + h) * 4096;
#pragma unroll
            for (int r = 0; r < 16; ++r) { const int row = row0 + (r & 3) + 8 * (r >> 2) + 4 * lh; Sw[row * 65 + col0 + lr] = acc[r]; go[row * 64 + col0 + lr] = acc[r]; }
            if (c == NCH) break;
            const float* Pc = PCH + ((size_t)sh * NCH + c) * 4096; const float* Cc = CCH + ((size_t)sh * NCH + c) * 4096;
            float bv[32];
#pragma unroll
            for (int kk = 0; kk < 32; ++kk) bv[kk] = Pc[(2 * kk + lh) * 64 + col0 + lr];
#pragma unroll
            for (int r = 0; r < 16; ++r) acc[r] = Cc[(row0 + (r & 3) + 8 * (r >> 2) + 4 * lh) * 64 + col0 + lr];
            __syncthreads();
#pragma unroll
            for (int kk = 0; kk < 32; ++kk) acc = __builtin_amdgcn_mfma_f32_32x32x2f32(Sw[(row0 + lr) * 65 + 2 * kk + lh], bv[kk], acc, 0, 0, 0);
        }
    } else {
        for (int it = (BID() - 32) * 8 + wave; it < 512; it += (gridDim.x - 32) * 8) {
            const int b = it >> 4, h = it & 15;
            const float* s0 = p->state_wkv + (((size_t)j * 32 + b) * 16 + h) * 4096 + lane * 64;
            float S[64];
#pragma unroll
            for (int k = 0; k < 64; k += 4) { const f32x4 t = *(const f32x4*)(s0 + k); S[k] = t[0]; S[k + 1] = t[1]; S[k + 2] = t[2]; S[k + 3] = t[3]; }
            scan_run(p, (size_t)NP + b * 8, 8, h * 64, S);
            float* o = p->out + O_WKVS + (((size_t)j * 32 + b) * 16 + h) * 4096 + lane * 64;
#pragma unroll
            for (int k = 0; k < 64; k += 4) *(f32x4*)(o + k) = (f32x4){S[k], S[k + 1], S[k + 2], S[k + 3]};
        }
    }
    __syncthreads();
}
__device__ __forceinline__ void phase_scanC(KP p) {
    const float* SST = WSP(float, WS_SST);
    const int lane = TID() & 63, gw = BID() * 8 + (TID() >> 6), nw = gridDim.x * 8;
    for (int it = gw; it < 64 * NCH; it += nw) {
        const int sh = it / NCH, c = it % NCH, b = sh >> 4, h = sh & 15;
        const float* s0 = SST + ((size_t)it * 64 + lane) * 64;
        float S[64];
#pragma unroll
        for (int k = 0; k < 64; k += 4) { const f32x4 t = *(const f32x4*)(s0 + k); S[k] = t[0]; S[k + 1] = t[1]; S[k + 2] = t[2]; S[k + 3] = t[3]; }
        scan_run(p, (size_t)b * 4096 + (size_t)c * LCH, LCH, h * 64, S);
    }
}


constexpr int CST = 72;
constexpr int CMAT = 64 * CST * 2;
constexpr int CH_F32 = 11 * CMAT, CH_PART = CH_F32 + 64 * 68 * 4, CH_GL = CH_PART + 64 * 4 * 4;
__device__ __forceinline__ bf16x8 cfrag(const LAS bf16_t* M, int row, int ks, int c4) { return *(const LAS bf16x8*)(M + row * CST + 32 * ks + 8 * c4); }
__device__ __forceinline__ f32x4 cmm(const LAS bf16_t* A, int arow, const LAS bf16_t* B, int brow, int c4, f32x4 acc) {
    acc = __builtin_amdgcn_mfma_f32_16x16x32_bf16(cfrag(A, arow, 0, c4), cfrag(B, brow, 0, c4), acc, 0, 0, 0);
    return __builtin_amdgcn_mfma_f32_16x16x32_bf16(cfrag(A, arow, 1, c4), cfrag(B, brow, 1, c4), acc, 0, 0, 0); }
__device__ __forceinline__ unsigned short f2bf(float x) { return (unsigned short)(pk_bf16(x, 0.f) & 0xffffu); }
__device__ __forceinline__ void st_t4(LAS bf16_t* Mt, int d, int t0, f32x4 v) { u32x2 w; w.x = pk_bf16(v[0], v[1]); w.y = pk_bf16(v[2], v[3]); *(LAS u32x2*)(Mt + d * CST + t0) = w; }

__device__ __forceinline__ void phase_chunk(KP p, int j, LAS unsigned char* lds) {
    LAS bf16_t* Mx = (LAS bf16_t*)lds;
#define CM(i) (Mx + (i) * (64 * CST))
    LAS float* F32 = (LAS float*)(lds + CH_F32);
    asm volatile("" : "+v"(F32));
    LAS float* part = (LAS float*)(lds + CH_PART);
    LAS float* gLs = (LAS float*)(lds + CH_GL);
    const bf16_t *RB = WSP(bf16_t, WS_RB), *KB = WSP(bf16_t, WS_KB), *VB = WSP(bf16_t, WS_VB), *TW = WSP(bf16_t, WS_TW), *TA_ = WSP(bf16_t, WS_TA), *TV = WSP(bf16_t, WS_TV);
    const bf16_t *W2T = WSP(bf16_t, WS_W2T) + (size_t)j * D * 64, *A2T = WSP(bf16_t, WS_A2T) + (size_t)j * D * 64, *V2T = WSP(bf16_t, WS_V2T);
    float* VF = WSP(float, WS_VFIRST); float *PCH = WSP(float, WS_PCH), *CCH = WSP(float, WS_CCH), *Y0 = WSP(float, WS_Y), *BON = WSP(float, WS_AV);
    bf16_t *GM = WSP(bf16_t, WS_DEC), *VM2 = WSP(bf16_t, WS_KM);
#define CH_BAR() do { asm volatile("s_waitcnt lgkmcnt(0)" ::: "memory"); __builtin_amdgcn_s_barrier(); asm volatile("" ::: "memory"); } while (0)
    bf16x8 f_aw[2], f_aa[2], f_av; unsigned short e_k[2][4], e_v[2][4], e_r[2][4];
    f_av = (bf16x8){0, 0, 0, 0, 0, 0, 0, 0};
#define CH_PREFETCH(itx) do { const int tid_ = TID(), lane_ = tid_ & 63, w_ = tid_ >> 6, n_ = lane_ & 15, c4_ = lane_ >> 4, tr_ = w_ >> 1, tcb_ = 2 * (w_ & 1); \
        const int sh_ = (itx) / NCH, c_ = (itx) % NCH, R0_ = (sh_ >> 4) * 4096 + c_ * LCH, hc_ = (sh_ & 15) * 64; const int ar_ = 16 * tr_ + n_; \
        _Pragma("unroll") for (int ks = 0; ks < 2; ++ks) { f_aw[ks] = *(const bf16x8*)(TW + (size_t)R0_ * 64 + ar_ * 64 + 32 * ks + 8 * c4_); f_aa[ks] = *(const bf16x8*)(TA_ + (size_t)R0_ * 64 + ar_ * 64 + 32 * ks + 8 * c4_); } \
        if (j == 1) f_av = *(const bf16x8*)(TV + (size_t)R0_ * 32 + ar_ * 32 + 8 * c4_); \
        _Pragma("unroll") for (int ti = 0; ti < 2; ++ti) _Pragma("unroll") for (int r = 0; r < 4; ++r) { const size_t o_ = (size_t)R0_ * D + hc_ + (16 * tr_ + 4 * c4_ + r) * D + 16 * (tcb_ + ti) + n_; \
            e_k[ti][r] = KB[o_]; e_v[ti][r] = VB[o_]; e_r[ti][r] = RB[o_]; } } while (0)
#define CH_MAP(q_) (((((q_) >> 4) & 3) * 16 + ((q_) & 15)) * NCH + ((q_) >> 6))
    if (BID() < 64 * NCH) CH_PREFETCH(CH_MAP(BID()));
    for (int q = BID(); q < 64 * NCH; q += gridDim.x) {
        const int it = CH_MAP(q);
        const int tid = TID(), lane = tid & 63, w = tid >> 6, n = lane & 15, c4 = lane >> 4, tr = w >> 1, tcb = 2 * (w & 1);
        const int sh = it / NCH, c = it % NCH, b = sh >> 4, h = sh & 15, R0 = b * 4096 + c * LCH, hc = h * 64;
        const bf16_t *KBb = KB + (size_t)R0 * D + hc, *VBb = VB + (size_t)R0 * D + hc, *RBb = RB + (size_t)R0 * D + hc;
        bf16_t* VFb = (bf16_t*)VF + (size_t)R0 * D + hc; bf16_t* VM2b = VM2 + (size_t)R0 * D + hc; bf16_t* GMb = GM + (size_t)R0 * D + hc; bf16_t* Y0b = (bf16_t*)Y0 + (size_t)R0 * D + hc;
        float* PCb = PCH + (size_t)it * 4096; float* CCb = CCH + (size_t)it * 4096; float* BONb = BON + (size_t)R0 * 16 + h;
        const bf16_t *TWb = TW + (size_t)R0 * 64, *TAb = TA_ + (size_t)R0 * 64, *TVb = TV + (size_t)R0 * 32, *W2b = W2T + (size_t)hc * 64, *A2b = A2T + (size_t)hc * 64, *V2b = V2T + (size_t)hc * 32;
        const float *w0b = p->rw_w0 + j * D + hc, *a0b = p->rw_a0 + j * D + hc, *kkb = p->rw_k_k + j * D + hc, *kab = p->rw_k_a + j * D + hc, *rkb = p->rw_r_k + j * D + hc, *v0b = p->rw_v0 + (j ? (j - 1) : 0) * D + hc;
        f32x4 wp[2], ap[2], vp[2];
#pragma unroll
        for (int ti = 0; ti < 2; ++ti) { wp[ti] = (f32x4){0.f, 0.f, 0.f, 0.f}; ap[ti] = wp[ti]; vp[ti] = wp[ti]; }
        {   const int ar = 16 * tr + n;
#pragma unroll
            for (int ks = 0; ks < 2; ++ks) {
                const bf16x8 aw = f_aw[ks], aa = f_aa[ks];
#pragma unroll
                for (int ti = 0; ti < 2; ++ti) { const int br = 16 * (tcb + ti) + n;
                    wp[ti] = __builtin_amdgcn_mfma_f32_16x16x32_bf16(aw, *(const bf16x8*)(W2b + br * 64 + 32 * ks + 8 * c4), wp[ti], 0, 0, 0);
                    ap[ti] = __builtin_amdgcn_mfma_f32_16x16x32_bf16(aa, *(const bf16x8*)(A2b + br * 64 + 32 * ks + 8 * c4), ap[ti], 0, 0, 0); }
            }
            if (j == 1) { const bf16x8 av = f_av;
#pragma unroll
                for (int ti = 0; ti < 2; ++ti) vp[ti] = __builtin_amdgcn_mfma_f32_16x16x32_bf16(av, *(const bf16x8*)(V2b + (16 * (tcb + ti) + n) * 32 + 8 * c4), vp[ti], 0, 0, 0); }
        }
        f32x4 lw[2], asg[2], kkv[2], kpr[2], vpr[2], rr[2];
        float ssq[4] = {0.f, 0.f, 0.f, 0.f}, bon[4] = {0.f, 0.f, 0.f, 0.f};
        float vf8[2][4];
#pragma unroll
        for (int ti = 0; ti < 2; ++ti)
#pragma unroll
            for (int r = 0; r < 4; ++r) vf8[ti][r] = 0.f;
        if (j == 1) {
#pragma unroll
            for (int ti = 0; ti < 2; ++ti)
#pragma unroll
                for (int r = 0; r < 4; ++r) vf8[ti][r] = bf2f(VFb[(16 * tr + 4 * c4 + r) * D + 16 * (tcb + ti) + n]);
        }
#pragma unroll
        for (int ti = 0; ti < 2; ++ti) {
            const int d = 16 * (tcb + ti) + n;
            const float w0 = w0b[d], a0 = a0b[d], kkw = kkb[d], kaw = kab[d], rkw = rkb[d];
            const float v0 = j ? v0b[d] : 0.f;
#pragma unroll
            for (int r = 0; r < 4; ++r) {
                const int o = (16 * tr + 4 * c4 + r) * D + d;
                const float kx = bf2f(e_k[ti][r]), vx = bf2f(e_v[ti][r]), rx = bf2f(e_r[ti][r]);
                const float z = -(w0 + wp[ti][r]), sp = fmaxf(z, 0.f) + __logf(1.0f + __expf(-fabsf(z)));
                lw[ti][r] = -__expf(-sp - 0.5f);
                const float a = fsig(a0 + ap[ti][r]);
                asg[ti][r] = a;
                float vv = vx;
                if (j == 0) VFb[o] = e_v[ti][r]; else { const float vf = vf8[ti][r]; vv = vx + (vf - vx) * fsig(v0 + vp[ti][r]); }
                vpr[ti][r] = vv; rr[ti][r] = rx;
                const float kk = kx * kkw; kkv[ti][r] = kk; ssq[r] += kk * kk;
                const float kp = kx * (1.0f + (a - 1.0f) * kaw); kpr[ti][r] = kp; bon[r] += rx * kp * rkw;
                F32[(16 * tr + 4 * c4 + r) * 68 + d] = lw[ti][r];
                VM2b[o] = f2bf(vv);
            }
        }
#pragma unroll
        for (int r = 0; r < 4; ++r) { ssq[r] = g16_sum(ssq[r]); bon[r] = g16_sum(bon[r]); }
        if (n == 0) {
#pragma unroll
            for (int r = 0; r < 4; ++r) { const int t = 16 * tr + 4 * c4 + r; part[(t * 2 + (w & 1)) * 2 + 0] = ssq[r]; part[(t * 2 + (w & 1)) * 2 + 1] = bon[r]; }
        }
        if (q + (int)gridDim.x < 64 * NCH) CH_PREFETCH(CH_MAP(q + (int)gridDim.x));
        CH_BAR();
        f32x4 cs[2];
#pragma unroll
        for (int ti = 0; ti < 2; ++ti) {
            f32x4 acc = {0.f, 0.f, 0.f, 0.f};
            for (int q = 0; q < 4 * (tr + 1); ++q) {
                const float av = (4 * q + c4 <= 16 * tr + n) ? 1.0f : 0.0f;
                acc = __builtin_amdgcn_mfma_f32_16x16x4f32(av, F32[(4 * q + c4) * 68 + 16 * (tcb + ti) + n], acc, 0, 0, 0);
            }
            cs[ti] = acc;
        }
        float inv[4];
#pragma unroll
        for (int r = 0; r < 4; ++r) { const int t = 16 * tr + 4 * c4 + r; inv[r] = rsqrtf(fmaxf(part[(t * 2 + 0) * 2] + part[(t * 2 + 1) * 2], 1e-24f));
            if (n == 0 && (w & 1) == 0) BONb[t * 16] = part[(t * 2 + 0) * 2 + 1] + part[(t * 2 + 1) * 2 + 1]; }
        f32x4 rt[2];
#pragma unroll
        for (int ti = 0; ti < 2; ++ti) {
            const int d = 16 * (tcb + ti) + n, t0 = 16 * tr + 4 * c4;
            f32x4 at, bt, kt;
#pragma unroll
            for (int r = 0; r < 4; ++r) {
                const float g = __expf(cs[ti][r]), gi = __expf(-cs[ti][r]), gm = __expf(cs[ti][r] - lw[ti][r]);
                const float kk = kkv[ti][r] * inv[r];
                at[r] = -kk * gm; bt[r] = kk * asg[ti][r] * gi; kt[r] = kpr[ti][r] * gi; rt[ti][r] = rr[ti][r] * g;
                CM(0)[(t0 + r) * CST + d] = f2bf(at[r]); CM(1)[(t0 + r) * CST + d] = f2bf(bt[r]); CM(2)[(t0 + r) * CST + d] = f2bf(kt[r]); CM(3)[(t0 + r) * CST + d] = f2bf(rt[ti][r]);
                if (t0 + r == 63) gLs[d] = g;
            }
            st_t4(CM(4), d, t0, at); st_t4(CM(5), d, t0, bt); st_t4(CM(6), d, t0, kt); st_t4(CM(7), d, t0, vpr[ti]);
        }
        CH_BAR();
#pragma unroll
        for (int ti = 0; ti < 2; ++ti) {
            const int tc = tcb + ti, s = 16 * tc + n, t0 = 16 * tr + 4 * c4;
            if (tc <= tr) {
                { f32x4 m = {0.f, 0.f, 0.f, 0.f}; m = cmm(CM(0), 16 * tr + n, CM(1), 16 * tc + n, c4, m);
#pragma unroll
                  for (int r = 0; r < 4; ++r) F32[(t0 + r) * 68 + s] = (s < t0 + r) ? m[r] : 0.f; }
                asm volatile("" ::: "memory");
                { f32x4 m = {0.f, 0.f, 0.f, 0.f}; m = cmm(CM(0), 16 * tr + n, CM(2), 16 * tc + n, c4, m);
#pragma unroll
                  for (int r = 0; r < 4; ++r) CM(8)[(t0 + r) * CST + s] = f2bf((s < t0 + r) ? m[r] : 0.f); }
                asm volatile("" ::: "memory");
                { f32x4 m = {0.f, 0.f, 0.f, 0.f}; m = cmm(CM(3), 16 * tr + n, CM(1), 16 * tc + n, c4, m);
#pragma unroll
                  for (int r = 0; r < 4; ++r) CM(9)[(t0 + r) * CST + s] = f2bf((s <= t0 + r) ? m[r] : 0.f); }
                asm volatile("" ::: "memory");
                { f32x4 m = {0.f, 0.f, 0.f, 0.f}; m = cmm(CM(3), 16 * tr + n, CM(2), 16 * tc + n, c4, m);
#pragma unroll
                  for (int r = 0; r < 4; ++r) CM(10)[(t0 + r) * CST + s] = f2bf((s <= t0 + r) ? m[r] : 0.f); }
                asm volatile("" ::: "memory");
            } else {
#pragma unroll
                for (int r = 0; r < 4; ++r) { F32[(t0 + r) * 68 + s] = 0.f; CM(8)[(t0 + r) * CST + s] = 0; CM(9)[(t0 + r) * CST + s] = 0; CM(10)[(t0 + r) * CST + s] = 0; }
            }
        }
        CH_BAR();
        { const int e0 = tid * 8;
#pragma unroll
          for (int e = 0; e < 8; ++e) { const int t = (e0 + e) >> 6, s_ = (e0 + e) & 63; CM(2)[t * CST + s_] = f2bf(F32[t * 68 + s_]); }
          unsigned z_ = 0u; asm volatile("" : "+v"(z_));
          *(LAS u32x4*)(CM(0) + (e0 >> 6) * CST + (e0 & 63)) = (u32x4){z_, z_, z_, z_}; }
        CH_BAR();
        if (w < 4) {
            const int cw = 16 * w;
            LAS float* scr = (LAS float*)CM(1) + w * (16 * 17);
#pragma unroll 1
            for (int I = 0; I < 4; ++I) {
                f32x4 rh = {0.f, 0.f, 0.f, 0.f};
                if (I > 0) { rh = __builtin_amdgcn_mfma_f32_16x16x32_bf16(cfrag(CM(2), 16 * I + n, 0, c4), cfrag(CM(0), cw + n, 0, c4), rh, 0, 0, 0);
                    if (I > 2) rh = __builtin_amdgcn_mfma_f32_16x16x32_bf16(cfrag(CM(2), 16 * I + n, 1, c4), cfrag(CM(0), cw + n, 1, c4), rh, 0, 0, 0); }
#pragma unroll
                for (int r = 0; r < 4; ++r) scr[(4 * c4 + r) * 17 + n] = rh[r] + ((16 * I + 4 * c4 + r) == (cw + n) ? 1.f : 0.f);
                wave_lds_fence();
                float x[16];
#pragma unroll
                for (int i = 0; i < 16; ++i) x[i] = scr[i * 17 + n];
                f32x4 mc[4], mn[4];
                mc[0] = *(const LAS f32x4*)(F32 + (16 * I + 1) * 68 + 16 * I);
#pragma unroll
                for (int i = 1; i < 16; ++i) {
                    if (i + 1 < 16) {
#pragma unroll
                        for (int j4 = 0; j4 < (i + 4) / 4; ++j4) mn[j4] = *(const LAS f32x4*)(F32 + (16 * I + i + 1) * 68 + 16 * I + 4 * j4);
                    }
                    float a0 = 0.f, a1 = 0.f;
#pragma unroll
                    for (int j4 = 0; j4 < (i + 3) / 4; ++j4) {
                        if (4 * j4 + 0 < i) a0 += mc[j4][0] * x[4 * j4 + 0];
                        if (4 * j4 + 1 < i) a1 += mc[j4][1] * x[4 * j4 + 1];
                        if (4 * j4 + 2 < i) a0 += mc[j4][2] * x[4 * j4 + 2];
                        if (4 * j4 + 3 < i) a1 += mc[j4][3] * x[4 * j4 + 3];
                    }
                    x[i] += a0 + a1;
#pragma unroll
                    for (int j4 = 0; j4 < 4; ++j4) mc[j4] = mn[j4];
                    asm volatile("" ::: "memory");
                }
                if (c4 == 0) {
#pragma unroll
                    for (int i = 0; i < 16; ++i) CM(3)[(16 * I + i) * CST + cw + n] = f2bf(x[i]);
                    u32x4 t0, t1;
                    t0.x = pk_bf16(x[0], x[1]); t0.y = pk_bf16(x[2], x[3]); t0.z = pk_bf16(x[4], x[5]); t0.w = pk_bf16(x[6], x[7]);
                    t1.x = pk_bf16(x[8], x[9]); t1.y = pk_bf16(x[10], x[11]); t1.z = pk_bf16(x[12], x[13]); t1.w = pk_bf16(x[14], x[15]);
                    *(LAS u32x4*)(CM(0) + (cw + n) * CST + 16 * I) = t0; *(LAS u32x4*)(CM(0) + (cw + n) * CST + 16 * I + 8) = t1;
                }
                wave_lds_fence();
            }
        }
        CH_BAR();
#pragma unroll
        for (int ti = 0; ti < 2; ++ti) {
            const int d = 16 * (tcb + ti) + n;
            { f32x4 x1 = {0.f, 0.f, 0.f, 0.f}; x1 = cmm(CM(8), 16 * tr + n, CM(7), 16 * (tcb + ti) + n, c4, x1); st_t4(CM(0), d, 16 * tr + 4 * c4, x1); }
            asm volatile("" ::: "memory");
            { f32x4 ta = {0.f, 0.f, 0.f, 0.f}; ta = cmm(CM(3), 16 * tr + n, CM(4), 16 * (tcb + ti) + n, c4, ta); st_t4(CM(1), d, 16 * tr + 4 * c4, ta); }
            asm volatile("" ::: "memory");
        }
        CH_BAR();
#pragma unroll
        for (int ti = 0; ti < 2; ++ti) {
            f32x4 uv = {0.f, 0.f, 0.f, 0.f};
            uv = cmm(CM(3), 16 * tr + n, CM(0), 16 * (tcb + ti) + n, c4, uv);
            st_t4(CM(2), 16 * (tcb + ti) + n, 16 * tr + 4 * c4, uv);
        }
        CH_BAR();
#pragma unroll
        for (int ti = 0; ti < 2; ++ti) {
            const int cc = 16 * (tcb + ti) + n, r0 = 16 * tr + 4 * c4;
            const float gl = gLs[cc];
            { f32x4 pm = {0.f, 0.f, 0.f, 0.f}; pm = cmm(CM(1), 16 * tr + n, CM(5), cc, c4, pm);
#pragma unroll
              for (int r = 0; r < 4; ++r) PCb[(r0 + r) * 64 + cc] = (pm[r] + ((r0 + r) == cc ? 1.f : 0.f)) * gl; }
            asm volatile("" ::: "memory");
            { f32x4 cm_ = {0.f, 0.f, 0.f, 0.f}; cm_ = cmm(CM(2), 16 * tr + n, CM(5), cc, c4, cm_); cm_ = cmm(CM(7), 16 * tr + n, CM(6), cc, c4, cm_);
#pragma unroll
              for (int r = 0; r < 4; ++r) CCb[(r0 + r) * 64 + cc] = cm_[r] * gl; }
            asm volatile("" ::: "memory");
            { f32x4 gg = {0.f, 0.f, 0.f, 0.f}; gg = cmm(CM(9), 16 * tr + n, CM(1), cc, c4, gg);
#pragma unroll
              for (int r = 0; r < 4; ++r) GMb[(r0 + r) * D + cc] = f2bf(gg[r] + rt[ti][r]); }
            asm volatile("" ::: "memory");
            { f32x4 y0 = {0.f, 0.f, 0.f, 0.f}; y0 = cmm(CM(9), 16 * tr + n, CM(2), cc, c4, y0); y0 = cmm(CM(10), 16 * tr + n, CM(7), cc, c4, y0);
#pragma unroll
              for (int r = 0; r < 4; ++r) Y0b[(r0 + r) * D + cc] = f2bf(y0[r]); }
            asm volatile("" ::: "memory");
        }
        CH_BAR();
    }
#undef CM
#undef CH_PREFETCH
#undef CH_BAR
}

__device__ __forceinline__ void phase_sample_mixer_w(KP p, int j, int first, int stride) {
    const int tid = TID(), lane = tid & 63;
    {
        const bf16_t *RB = WSP(bf16_t, WS_RB), *KB = WSP(bf16_t, WS_KB), *VB = WSP(bf16_t, WS_VB); bf16_t* YG = WSP(bf16_t, WS_YG);
        const float *WPp = WSP(float, WS_WP), *APp = WSP(float, WS_AP), *VPp = WSP(float, WS_VP), *GG = WSP(float, WS_GG); float* VF = WSP(float, WS_VFIRST);
        for (int it = first; it < 512; it += stride) {
            const int b = it >> 4, h = it & 15, col = h * 64 + lane;
            const float* s0 = p->state_wkv + (((size_t)j * 32 + b) * 16 + h) * 4096 + lane * 64;
            float S[64];
#pragma unroll
            for (int k = 0; k < 64; k += 4) { const f32x4 t = *(const f32x4*)(s0 + k); S[k] = t[0]; S[k + 1] = t[1]; S[k + 2] = t[2]; S[k + 3] = t[3]; }
            const float w0 = p->rw_w0[j * D + col], a0 = p->rw_a0[j * D + col], kkw = p->rw_k_k[j * D + col], kaw = p->rw_k_a[j * D + col], rkw = p->rw_r_k[j * D + col];
            const float v0 = j ? p->rw_v0[(j - 1) * D + col] : 0.f, lnw = p->rw_lnx_w[j * D + col], lnb = p->rw_lnx_b[j * D + col];
            for (int t = 0; t < 8; ++t) {
                const size_t o = (size_t)(NP + b * 8 + t) * D + col;
                const float kx = bf2f(KB[o]), vx = bf2f(VB[o]), r = bf2f(RB[o]);
                const float z = -(w0 + WPp[o]), sp = fmaxf(z, 0.f) + log1pf(expf(-fabsf(z)));
                const float wd = expf(-expf(-sp - 0.5f)), asg = sigmoidf_(a0 + APp[o]);
                float v = vx;
                if (j == 0) VF[o] = vx; else { const float vf = VF[o]; v = vx + (vf - vx) * sigmoidf_(v0 + VPp[o]); }
                float kk = kx * kkw; const float ss = wave_sum(kk * kk); kk *= rsqrtf(fmaxf(ss, 1e-24f));
                const float kp = kx * (1.0f + (asg - 1.0f) * kaw), a = -kk, bq = kk * asg;
                float sa = 0.f;
#pragma unroll
                for (int k = 0; k < 64; ++k) sa += S[k] * rl(a, k);
#pragma unroll
                for (int k = 0; k < 64; ++k) S[k] = S[k] * rl(wd, k) + sa * rl(bq, k) + v * rl(kp, k);
                float y = 0.f;
#pragma unroll
                for (int k = 0; k < 64; ++k) y += S[k] * rl(r, k);
                const float mu = wave_sum(y) * (1.0f / 64.0f), dy = y - mu, var = wave_sum(dy * dy) * (1.0f / 64.0f);
                const float bonus = wave_sum(r * kp * rkw);
                YG[o] = f2bf((dy * rsqrtf(var + 64e-5f) * lnw + lnb + bonus * v) * GG[o]);
            }
            float* so = p->out + O_WKVS + (((size_t)j * 32 + b) * 16 + h) * 4096 + lane * 64;
#pragma unroll
            for (int k = 0; k < 64; k += 4) *(f32x4*)(so + k) = (f32x4){S[k], S[k + 1], S[k + 2], S[k + 3]};
        }
    }
}
__device__ __forceinline__ void phase_carry(KP p, int j, LAS unsigned char* lds) {
    const float *PCH = WSP(float, WS_PCH), *CCH = WSP(float, WS_CCH); float* SST = WSP(float, WS_SST);
    LAS float* Sl = (LAS float*)lds;
    LAS unsigned* cflag = (LAS unsigned*)(lds + 9216);
    if (TID() == 0) *cflag = 0u;
    __syncthreads();
    unsigned arrivals = 0u;
    if ((TID() >> 6) >= 4) { phase_sample_mixer_w(p, j, BID() * 4 + ((TID() >> 6) - 4), (int)gridDim.x * 4); }
    else
    for (int it = BID(); it < 256; it += gridDim.x) {
        const int wave = TID() >> 6, sh = it >> 2, row0 = 16 * (it & 3), col0 = 16 * (wave & 3), b = sh >> 4, h = sh & 15;
        const bool act = true;
        f32x4 acc = {0.f, 0.f, 0.f, 0.f}, c0, c1, c2;
        float b0[16], b1[16], b2[16];
#define CARRY_LOAD(BX, CX, cc_) do { const int l_ = TID() & 63, ln = l_ & 15, lq = l_ >> 4; \
            const float* Pc = PCH + ((size_t)sh * NCH + (cc_)) * 4096; const float* Cc = CCH + ((size_t)sh * NCH + (cc_)) * 4096; \
            _Pragma("unroll") for (int q = 0; q < 16; ++q) BX[q] = Pc[(4 * q + lq) * 64 + col0 + ln]; \
            _Pragma("unroll") for (int r = 0; r < 4; ++r) CX[r] = Cc[(row0 + 4 * lq + r) * 64 + col0 + ln]; } while (0)
#define CARRY_STEP(BX, CX, BL, CL, c_) do { const int l_ = TID() & 63, ln = l_ & 15, lq = l_ >> 4; \
            LAS float* Sw = Sl + ((c_) & 1) * (16 * 68); bf16_t* go = (bf16_t*)SST + ((size_t)sh * NCH + (c_)) * 4096; \
            if (act) { _Pragma("unroll") for (int r = 0; r < 4; ++r) Sw[(4 * lq + r) * 68 + col0 + ln] = acc[r]; } \
            const f32x4 sc = acc; acc = CX; \
            asm volatile("s_waitcnt lgkmcnt(0)" ::: "memory"); arrivals += 4u; \
            if ((TID() & 63) == 0) __hip_atomic_fetch_add(cflag, 1u, __ATOMIC_RELAXED, __HIP_MEMORY_SCOPE_WORKGROUP); \
            { unsigned sp_ = 0; while (__builtin_amdgcn_readfirstlane(__hip_atomic_load(cflag, __ATOMIC_RELAXED, __HIP_MEMORY_SCOPE_WORKGROUP)) < arrivals && ++sp_ < (1u << 22)) __builtin_amdgcn_s_sleep(0); } \
            asm volatile("" ::: "memory"); \
            if (act) { \
                _Pragma("unroll") for (int r = 0; r < 4; ++r) go[(row0 + 4 * lq + r) * 64 + col0 + ln] = f2bf(sc[r]); \
                if ((c_) + 2 < NCH) CARRY_LOAD(BL, CL, (c_) + 2); \
                float av[16]; _Pragma("unroll") for (int q = 0; q < 16; ++q) av[q] = Sw[ln * 68 + 4 * q + lq]; \
                asm volatile("s_waitcnt lgkmcnt(0)" ::: "memory"); \
                _Pragma("unroll") for (int q = 0; q < 16; ++q) acc = __builtin_amdgcn_mfma_f32_16x16x4f32(av[q], BX[q], acc, 0, 0, 0); } } while (0)
        if (act) { CARRY_LOAD(b0, c0, 0); CARRY_LOAD(b1, c1, 1); }
        for (int c = 0; c < NCH; c += 3) {
            CARRY_STEP(b0, c0, b2, c2, c);
            if (c + 1 < NCH) CARRY_STEP(b1, c1, b0, c0, c + 1);
            if (c + 2 < NCH) CARRY_STEP(b2, c2, b1, c1, c + 2);
        }
        if (act) { const int l_ = TID() & 63, ln = l_ & 15, lq = l_ >> 4; float* go = p->out + O_WKVP + (((size_t)j * 4 + b) * 16 + h) * 4096;
#pragma unroll
            for (int r = 0; r < 4; ++r) go[(row0 + 4 * lq + r) * 64 + col0 + ln] = acc[r]; }
#undef CARRY_LOAD
#undef CARRY_STEP
    }
    __syncthreads();
}
__device__ __forceinline__ void phase_sample_mixer(KP p, int j) {
    const int tid = TID(), lane = tid & 63, wave = tid >> 6;
    {
        const bf16_t *RB = WSP(bf16_t, WS_RB), *KB = WSP(bf16_t, WS_KB), *VB = WSP(bf16_t, WS_VB); bf16_t* YG = WSP(bf16_t, WS_YG);
        const float *WPp = WSP(float, WS_WP), *APp = WSP(float, WS_AP), *VPp = WSP(float, WS_VP), *GG = WSP(float, WS_GG); float* VF = WSP(float, WS_VFIRST);
        for (int it = BID() * 8 + wave; it < 512; it += gridDim.x * 8) {
            const int b = it >> 4, h = it & 15, col = h * 64 + lane;
            const float* s0 = p->state_wkv + (((size_t)j * 32 + b) * 16 + h) * 4096 + lane * 64;
            float S[64];
#pragma unroll
            for (int k = 0; k < 64; k += 4) { const f32x4 t = *(const f32x4*)(s0 + k); S[k] = t[0]; S[k + 1] = t[1]; S[k + 2] = t[2]; S[k + 3] = t[3]; }
            const float w0 = p->rw_w0[j * D + col], a0 = p->rw_a0[j * D + col], kkw = p->rw_k_k[j * D + col], kaw = p->rw_k_a[j * D + col], rkw = p->rw_r_k[j * D + col];
            const float v0 = j ? p->rw_v0[(j - 1) * D + col] : 0.f, lnw = p->rw_lnx_w[j * D + col], lnb = p->rw_lnx_b[j * D + col];
            for (int t = 0; t < 8; ++t) {
                const size_t o = (size_t)(NP + b * 8 + t) * D + col;
                const float kx = bf2f(KB[o]), vx = bf2f(VB[o]), r = bf2f(RB[o]);
                const float z = -(w0 + WPp[o]), sp = fmaxf(z, 0.f) + log1pf(expf(-fabsf(z)));
                const float wd = expf(-expf(-sp - 0.5f)), asg = sigmoidf_(a0 + APp[o]);
                float v = vx;
                if (j == 0) VF[o] = vx; else { const float vf = VF[o]; v = vx + (vf - vx) * sigmoidf_(v0 + VPp[o]); }
                float kk = kx * kkw; const float ss = wave_sum(kk * kk); kk *= rsqrtf(fmaxf(ss, 1e-24f));
                const float kp = kx * (1.0f + (asg - 1.0f) * kaw), a = -kk, bq = kk * asg;
                float sa = 0.f;
#pragma unroll
                for (int k = 0; k < 64; ++k) sa += S[k] * rl(a, k);
#pragma unroll
                for (int k = 0; k < 64; ++k) S[k] = S[k] * rl(wd, k) + sa * rl(bq, k) + v * rl(kp, k);
                float y = 0.f;
#pragma unroll
                for (int k = 0; k < 64; ++k) y += S[k] * rl(r, k);
                const float mu = wave_sum(y) * (1.0f / 64.0f), dy = y - mu, var = wave_sum(dy * dy) * (1.0f / 64.0f);
                const float bonus = wave_sum(r * kp * rkw);
                YG[o] = f2bf((dy * rsqrtf(var + 64e-5f) * lnw + lnb + bonus * v) * GG[o]);
            }
            float* so = p->out + O_WKVS + (((size_t)j * 32 + b) * 16 + h) * 4096 + lane * 64;
#pragma unroll
            for (int k = 0; k < 64; k += 4) *(f32x4*)(so + k) = (f32x4){S[k], S[k + 1], S[k + 2], S[k + 3]};
        }
    }
}
__device__ __forceinline__ void phase_post2(KP p, int j, LAS unsigned char* lds) {
    LAS float* part = (LAS float*)lds;
    const bf16_t *GM = WSP(bf16_t, WS_DEC), *VM2 = WSP(bf16_t, WS_KM), *TG = WSP(bf16_t, WS_TG), *G2T = WSP(bf16_t, WS_G2T) + (size_t)j * D * 160;
    const float *Y0 = WSP(float, WS_Y), *BON = WSP(float, WS_AV), *SST = WSP(float, WS_SST); bf16_t* YG = WSP(bf16_t, WS_YG);
    for (int it = BID(); it < 64 * NCH; it += gridDim.x) {
        const int tid = TID(), lane = tid & 63, w = tid >> 6, n = lane & 15, c4 = lane >> 4, tr = w >> 1, tcb = 2 * (w & 1);
        const int sh = it / NCH, c = it % NCH, b = sh >> 4, h = sh & 15, R0 = b * 4096 + c * LCH, hc = h * 64;
        f32x4 y[2], g[2];
        const size_t ar = (size_t)(R0 + 16 * tr + n);
#pragma unroll
        for (int ti = 0; ti < 2; ++ti) {
            const int dv = 16 * (tcb + ti) + n;
            f32x4 acc = {0.f, 0.f, 0.f, 0.f}, gacc = acc;
#pragma unroll
            for (int ks = 0; ks < 2; ++ks) {
                const bf16x8 af = *(const bf16x8*)(GM + ar * D + hc + 32 * ks + 8 * c4);
                const bf16x8 bw = *(const bf16x8*)((const bf16_t*)SST + ((size_t)it * 64 + dv) * 64 + 32 * ks + 8 * c4);
                acc = __builtin_amdgcn_mfma_f32_16x16x32_bf16(af, bw, acc, 0, 0, 0);
            }
#pragma unroll
            for (int ks = 0; ks < 5; ++ks)
                gacc = __builtin_amdgcn_mfma_f32_16x16x32_bf16(*(const bf16x8*)(TG + ar * 160 + 32 * ks + 8 * c4), *(const bf16x8*)(G2T + (size_t)(hc + dv) * 160 + 32 * ks + 8 * c4), gacc, 0, 0, 0);
#pragma unroll
            for (int r = 0; r < 4; ++r) acc[r] += bf2f(((const bf16_t*)Y0)[(size_t)(R0 + 16 * tr + 4 * c4 + r) * D + hc + dv]);
            y[ti] = acc; g[ti] = gacc;
        }
        float bonus4[4]; unsigned short vm4[2][4]; float lnw2[2], lnb2[2];
#pragma unroll
        for (int r = 0; r < 4; ++r) bonus4[r] = BON[(size_t)(R0 + 16 * tr + 4 * c4 + r) * 16 + h];
#pragma unroll
        for (int ti = 0; ti < 2; ++ti) { const int col = hc + 16 * (tcb + ti) + n; lnw2[ti] = p->rw_lnx_w[j * D + col]; lnb2[ti] = p->rw_lnx_b[j * D + col];
#pragma unroll
            for (int r = 0; r < 4; ++r) vm4[ti][r] = VM2[(size_t)(R0 + 16 * tr + 4 * c4 + r) * D + col]; }
        float s1[4], s2[4];
#pragma unroll
        for (int r = 0; r < 4; ++r) { s1[r] = g16_sum(y[0][r] + y[1][r]); s2[r] = g16_sum(y[0][r] * y[0][r] + y[1][r] * y[1][r]); }
        asm volatile("s_waitcnt lgkmcnt(0)" ::: "memory"); __builtin_amdgcn_s_barrier(); asm volatile("" ::: "memory");
        if (n == 0) {
#pragma unroll
            for (int r = 0; r < 4; ++r) { const int t = 16 * tr + 4 * c4 + r; part[(t * 2 + (w & 1)) * 2 + 0] = s1[r]; part[(t * 2 + (w & 1)) * 2 + 1] = s2[r]; }
        }
        asm volatile("s_waitcnt lgkmcnt(0)" ::: "memory"); __builtin_amdgcn_s_barrier(); asm volatile("" ::: "memory");
#pragma unroll
        for (int r = 0; r < 4; ++r) {
            const int t = 16 * tr + 4 * c4 + r;
            const float mu = (part[(t * 2 + 0) * 2] + part[(t * 2 + 1) * 2]) * (1.0f / 64.0f), ex2 = (part[(t * 2 + 0) * 2 + 1] + part[(t * 2 + 1) * 2 + 1]) * (1.0f / 64.0f);
            const float rs = rsqrtf(fmaxf(ex2 - mu * mu, 0.f) + 64e-5f), bonus = bonus4[r];
#pragma unroll
            for (int ti = 0; ti < 2; ++ti) {
                const int col = hc + 16 * (tcb + ti) + n; const size_t o = (size_t)(R0 + t) * D + col;
                YG[o] = f2bf(((y[ti][r] - mu) * rs * lnw2[ti] + lnb2[ti] + bonus * bf2f(vm4[ti][r])) * g[ti][r]);
            }
        }
    }
    __syncthreads();
}

__device__ __forceinline__ void phase_post(KP p, int j) {
    const float *Y = WSP(float, WS_Y), *KM = WSP(float, WS_KM), *VM = WSP(float, WS_VM), *GG = WSP(float, WS_GG);
    const bf16_t* RB = WSP(bf16_t, WS_RB); bf16_t* YG = WSP(bf16_t, WS_YG);
    const int lane = TID() & 63, gw = BID() * 8 + (TID() >> 6), nw = gridDim.x * 8;
    for (int row = gw; row < NT; row += nw) {
#pragma unroll
        for (int i = 0; i < 4; ++i) {
            const int col = 256 * i + 4 * lane; const size_t o = (size_t)row * D + col;
            const f32x4 y = *(const f32x4*)(Y + o), r = ld_bf4(RB + o), km = *(const f32x4*)(KM + o), vm = *(const f32x4*)(VM + o), gg = *(const f32x4*)(GG + o);
            const f32x4 lw = *(const f32x4*)(p->rw_lnx_w + j * D + col), lb = *(const f32x4*)(p->rw_lnx_b + j * D + col), rk = *(const f32x4*)(p->rw_r_k + j * D + col);
            const float mu = g16_sum(y[0] + y[1] + y[2] + y[3]) * (1.0f / 64.0f);
            const f32x4 d = y - mu;
            const float var = g16_sum(d[0] * d[0] + d[1] * d[1] + d[2] * d[2] + d[3] * d[3]) * (1.0f / 64.0f);
            const float rs = rsqrtf(var + 64e-5f);
            const float bon = g16_sum(r[0] * km[0] * rk[0] + r[1] * km[1] * rk[1] + r[2] * km[2] * rk[2] + r[3] * km[3] * rk[3]);
            st_bf4(YG + o, (d * rs * lw + lb + bon * vm) * gg);
        }
    }
}

__constant__ double kRopeInv[8] = {1.0, 0.19392274474868576, 0.03760603093086393, 0.007292664737217109, 0.001414213562373095, 0.0002742481756762073, 5.318295896944988e-05, 1.031338537721246e-05};
__device__ __forceinline__ void phase_dsapost(KP p, int j) {
    const bf16_t* PR = WSP(bf16_t, WS_PR); float *Q = WSP(float, WS_Q), *QI = WSP(float, WS_QI), *WI = WSP(float, WS_WI);
    const int lane = TID() & 63, l16 = lane & 15, gw = BID() * 8 + (TID() >> 6), nw = gridDim.x * 8;
    const f32x4 qn = *(const f32x4*)(p->att_q_norm + j * 64 + 4 * l16), kn = *(const f32x4*)(p->att_k_norm + j * 64 + 4 * l16), in = *(const f32x4*)(p->idx_k_norm + j * 64 + 4 * l16);
    for (int row = gw; row < NT; row += nw) {
        const int pos = row_pos(row);
        const bf16_t* pr = PR + (size_t)row * PINP;
        f32x4 cs = {1.f, 1.f, 1.f, 1.f}, sn = {0.f, 0.f, 0.f, 0.f};
        if (l16 < 4) {
#pragma unroll
            for (int e = 0; e < 4; ++e) { double ang = (double)pos * kRopeInv[4 * (l16 & 1) + e]; ang -= floor(ang * 0.15915494309189535) * 6.283185307179586; const float af = (float)ang; cs[e] = cosf(af); sn[e] = sinf(af); }
        }
        const float sgn = (l16 < 2) ? -1.0f : 1.0f;
#define ROPE4(v) do { f32x4 _o; _o[0] = __shfl_xor((v)[0], 2); _o[1] = __shfl_xor((v)[1], 2); _o[2] = __shfl_xor((v)[2], 2); _o[3] = __shfl_xor((v)[3], 2); if (l16 < 4) (v) = (v) * cs + sgn * (_o * sn); } while (0)
#define HNORM4(v, w) do { const float _ss = g16_sum((v)[0] * (v)[0] + (v)[1] * (v)[1] + (v)[2] * (v)[2] + (v)[3] * (v)[3]); (v) = (v) * rsqrtf(_ss * (1.0f / 64.0f) + 1e-6f) * (w); } while (0)
#pragma unroll
        for (int i = 0; i < 4; ++i) { f32x4 v = ld_bf4(pr + 256 * i + 4 * lane); HNORM4(v, qn); ROPE4(v); st_bf4((bf16_t*)Q + (size_t)row * D + 256 * i + 4 * lane, v); }
        { f32x4 v = ld_bf4(pr + 1024 + 4 * lane); HNORM4(v, kn); ROPE4(v);
          float* ko = row < NP ? p->out + O_KP + ((size_t)j * NP + row) * 256 : p->out + O_KS + ((size_t)j * NS + (row - NP)) * 256; *(f32x4*)(ko + 4 * lane) = v; *(unsigned*)(WSP(unsigned char, WS_K8) + (size_t)row * 256 + 4 * lane) = pk_fp8x4(v); }
        { const f32x4 v = ld_bf4(pr + 1280 + 4 * lane);
          float* vo = row < NP ? p->out + O_VP + ((size_t)j * NP + row) * 256 : p->out + O_VS + ((size_t)j * NS + (row - NP)) * 256; *(f32x4*)(vo + 4 * lane) = v; *(unsigned*)(WSP(unsigned char, WS_V8) + (size_t)row * 256 + 4 * lane) = pk_fp8x4(v); }
#pragma unroll
        for (int i = 0; i < 2; ++i) { f32x4 v = ld_bf4(pr + 1536 + 256 * i + 4 * lane); ROPE4(v); st_bf4(WSP(bf16_t, WS_QIB) + (size_t)row * 512 + 256 * i + 4 * lane, v); }
        { f32x4 v = ld_bf4(pr + 2048 + 4 * l16); HNORM4(v, in); ROPE4(v);
          float* io = row < NP ? p->out + O_IKP + ((size_t)j * NP + row) * 64 : p->out + O_IKS + ((size_t)j * NS + (row - NP)) * 64; if (lane < 16) { *(f32x4*)(io + 4 * lane) = v; st_bf4(WSP(bf16_t, WS_KIB) + (size_t)row * 64 + 4 * lane, v); } }
        if (lane < 2) { const f32x4 v = ld_bf4(pr + 2112 + 4 * lane); *(f32x4*)(WI + (size_t)row * 8 + 4 * lane) = v * 0.35355339059327373f; }
#undef ROPE4
#undef HNORM4
    }
}

template <bool SAMPLE>
__device__ __forceinline__ void phase_idx(KP p, int j, LAS unsigned char* lds) {
    LAS float* Qs = (LAS float*)lds;
    LAS float* Ks = (LAS float*)(lds + 32768);
    const float *QI = WSP(float, WS_QI), *WI = WSP(float, WS_WI);
    const int tid = TID(), q = tid >> 5, kx = tid & 31;
    const int nitems = SAMPLE ? 32 * 65 : 1024;
    for (int it = BID(); it < nitems; it += gridDim.x) {
        int b, t0, rowbase, nkt, kt0 = 0;
        if (SAMPLE) { b = it / 65; kt0 = it % 65; t0 = 0; rowbase = NP + b * 8; nkt = kt0 + 1; }
        else { const int k4 = it >> 8, w = it & 255, i = (k4 & 1) ? (k4 * 256 + 255 - w) : (k4 * 256 + w); b = i & 3; t0 = (i >> 2) * 16; rowbase = b * 4096 + t0; nkt = (t0 + 15) / 128 + 1; }
        const int nq = SAMPLE ? 8 : 16;
        __syncthreads();
#pragma unroll
        for (int n = 0; n < 16; ++n) { const int e = tid + 512 * n, qq = e >> 9, c = e & 511, h = c >> 6, d = c & 63;
            Qs[(d * 16 + qq) * 8 + h] = qq < nq ? QI[(size_t)(rowbase + qq) * 512 + c] : 0.f; }
        float wi[8];
#pragma unroll
        for (int h = 0; h < 8; ++h) wi[h] = q < nq ? WI[(size_t)(rowbase + q) * 8 + h] : 0.f;
        for (int kt = kt0; kt < nkt; ++kt) {
            __syncthreads();
#pragma unroll
            for (int n = 0; n < 16; ++n) { const int e = tid + 512 * n, key = e >> 6, d = e & 63, s = kt * 128 + key; float v = 0.f;
                if (SAMPLE) {
                    if (s < PAST) { const int pg = p->page_table[b * 64 + (s >> 7)]; v = p->cache_ik[(((size_t)j * 2560 + pg) * 128 + (s & 127)) * 64 + d]; }
                    else if (s < PAST + 8) v = p->out[O_IKS + ((size_t)j * NS + b * 8 + (s - PAST)) * 64 + d];
                } else v = p->out[O_IKP + ((size_t)j * NP + b * 4096 + s) * 64 + d];
                Ks[d * 132 + key] = v; }
            __syncthreads();
            f32x4 acc[8];
#pragma unroll
            for (int h = 0; h < 8; ++h) acc[h] = (f32x4){0.f, 0.f, 0.f, 0.f};
#pragma unroll 4
            for (int d = 0; d < 64; ++d) {
                const f32x4 qa = *(const LAS f32x4*)(Qs + (d * 16 + q) * 8), qb = *(const LAS f32x4*)(Qs + (d * 16 + q) * 8 + 4), kv = *(const LAS f32x4*)(Ks + d * 132 + 4 * kx);
                acc[0] += qa[0] * kv; acc[1] += qa[1] * kv; acc[2] += qa[2] * kv; acc[3] += qa[3] * kv;
                acc[4] += qb[0] * kv; acc[5] += qb[1] * kv; acc[6] += qb[2] * kv; acc[7] += qb[3] * kv;
            }
            f32x4 sc = {0.f, 0.f, 0.f, 0.f};
#pragma unroll
            for (int h = 0; h < 8; ++h)
#pragma unroll
                for (int e = 0; e < 4; ++e) sc[e] += fmaxf(acc[h][e] * 0.125f, 0.f) * wi[h];
            if (q < nq) {
                if (SAMPLE) *(f32x4*)(WSP(float, WS_SCS) + (size_t)(b * 8 + q) * SCS_LD + kt * 128 + 4 * kx) = sc;
                else *(f32x4*)(WSP(float, WS_SC) + ((size_t)b * 4096 + t0 + q) * 4096 + kt * 128 + 4 * kx) = sc;
            }
        }
    }
    __syncthreads();
}

template <bool SAMPLE>
__device__ __forceinline__ void phase_idx2(KP p, int j) {
    const bf16_t *QIB = WSP(bf16_t, WS_QIB), *KIB = WSP(bf16_t, WS_KIB); const float* WI = WSP(float, WS_WI);
    const int lane = TID() & 63, lr = lane & 31, lh = lane >> 5, gw = BID() * 8 + (TID() >> 6), nw = gridDim.x * 8;
    const int nitems = SAMPLE ? 32 * 65 : 4096;
    for (int it = gw; it < nitems; it += nw) {
        int b, rowbase, tile0, ntile;
        if (SAMPLE) { b = it / 65; rowbase = NP + b * 8; tile0 = (it % 65) * 4; ntile = min(4, 257 - tile0); }
        else { const int sub = it >= 2048, w_ = it & 2047; b = w_ & 3; const int wb = w_ >> 2, kk = sub ? 511 - wb : wb, nt = (kk * 8 + 7) / 32 + 1;
            rowbase = b * 4096 + kk * 8; tile0 = sub ? (nt >> 1) : 0; ntile = sub ? nt - (nt >> 1) : (nt >> 1); }
        if (ntile <= 0) continue;
        bf16x8 af[2][4]; float w[2][2][8];
        { const int hd = (lr & 3) + 4 * ((lr >> 3) & 1), jq = 2 * ((lr >> 2) & 1) + (lr >> 4);
#pragma unroll
          for (int st = 0; st < 2; ++st)
#pragma unroll
              for (int ks = 0; ks < 4; ++ks) af[st][ks] = *(const bf16x8*)(QIB + (size_t)(rowbase + 4 * st + jq) * 512 + hd * 64 + 16 * ks + 8 * lh);
#pragma unroll
          for (int st = 0; st < 2; ++st)
#pragma unroll
              for (int q = 0; q < 2; ++q) { const f32x4 w0 = *(const f32x4*)(WI + (size_t)(rowbase + 4 * st + 2 * lh + q) * 8), w1 = *(const f32x4*)(WI + (size_t)(rowbase + 4 * st + 2 * lh + q) * 8 + 4);
#pragma unroll
                  for (int e = 0; e < 4; ++e) { w[st][q][e] = w0[e] * 0.125f; w[st][q][4 + e] = w1[e] * 0.125f; } } }
#define IDX_LOADB(BF, tl_) do { const int s_ = (tile0 + (tl_)) * 32 + lr; \
            if (!SAMPLE) { _Pragma("unroll") for (int ks = 0; ks < 4; ++ks) BF[ks] = *(const bf16x8*)(KIB + ((size_t)b * 4096 + s_) * 64 + 16 * ks + 8 * lh); } \
            else { const float* kp = p->out + O_IKS + ((size_t)j * NS + b * 8) * 64; \
                if (s_ < PAST) kp = p->cache_ik + (((size_t)j * 2560 + p->page_table[b * 64 + (s_ >> 7)]) * 128 + (s_ & 127)) * 64; else kp += (size_t)min(s_ - PAST, 7) * 64; \
                _Pragma("unroll") for (int ks = 0; ks < 4; ++ks) { const f32x4 x0 = *(const f32x4*)(kp + 16 * ks + 8 * lh), x1 = *(const f32x4*)(kp + 16 * ks + 8 * lh + 4); \
                    const u32x4 wv = {pk_bf16(x0[0], x0[1]), pk_bf16(x0[2], x0[3]), pk_bf16(x1[0], x1[1]), pk_bf16(x1[2], x1[3])}; BF[ks] = __builtin_bit_cast(bf16x8, wv); } } } while (0)
        bf16x8 bnx[4];
        IDX_LOADB(bnx, 0);
        for (int tl = 0; tl < ntile; ++tl) {
            const int s = (tile0 + tl) * 32 + lr;
            bf16x8 bfr[4];
#pragma unroll
            for (int ks = 0; ks < 4; ++ks) bfr[ks] = bnx[ks];
            if (tl + 1 < ntile) IDX_LOADB(bnx, tl + 1);
            __builtin_amdgcn_sched_barrier(0);
#pragma unroll
            for (int st = 0; st < 2; ++st) {
                f32x16 acc;
#pragma unroll
                for (int r = 0; r < 16; ++r) acc[r] = 0.f;
#pragma unroll
                for (int ks = 0; ks < 4; ++ks) acc = __builtin_amdgcn_mfma_f32_32x32x16_bf16(af[st][ks], bfr[ks], acc, 0, 0, 0);
#pragma unroll
                for (int q = 0; q < 2; ++q) {
                    float sc = 0.f;
#pragma unroll
                    for (int hh = 0; hh < 2; ++hh)
#pragma unroll
                        for (int hl = 0; hl < 4; ++hl) sc += fmaxf(acc[4 * (2 * q + hh) + hl], 0.f) * w[st][q][hl + 4 * hh];
                    if (SAMPLE) WSP(float, WS_SCS)[(size_t)(b * 8 + 4 * st + 2 * lh + q) * SCS_LD + s] = sc;
                    else WSP(float, WS_SC)[((size_t)rowbase + 4 * st + 2 * lh + q) * 4096 + s] = sc;
                }
            }
        }
    }
#undef IDX_LOADB
}

__device__ __forceinline__ unsigned fkey(float f) { f = (f == 0.f) ? 0.f : f; const unsigned u = __float_as_uint(f); return (u & 0x80000000u) ? ~u : (u | 0x80000000u); }
__device__ __forceinline__ void phase_topk_prompt(KP p) {
    const float* SC = WSP(float, WS_SC); int* SEL = WSP(int, WS_SEL); int* CNT = WSP(int, WS_CNT);
    const int lane = TID() & 63, gw = BID() * 8 + (TID() >> 6), nw = gridDim.x * 8;
    for (int qi = gw; qi < NP; qi += nw) {
        const int b = qi & 3, tt = qi >> 2, t = (tt & 1) ? 4095 - (tt >> 1) : (tt >> 1), row = b * 4096 + t, n = t + 1;
        int* sel = SEL + (size_t)row * 256;
        if (n <= TOPK) { for (int s = lane; s < n; s += 64) sel[s] = s; if (lane == 0) CNT[row] = n; continue; }
        const float* base = SC + (size_t)row * 4096;
        unsigned u[64];
#pragma unroll
        for (int m = 0; m < 64; ++m) u[m] = __float_as_uint(base[lane + 64 * m]);
#pragma unroll
        for (int m = 0; m < 64; ++m) { const unsigned k_ = fkey(__uint_as_float(u[m])); u[m] = (lane + 64 * m < n) ? k_ : 0u; }
        unsigned tau = 0u;
#pragma unroll 1
        for (int bit = 31; bit >= 0; --bit) {
            const unsigned cand = tau | (1u << bit); int c = 0;
#pragma unroll
            for (int m = 0; m < 64; ++m) c += (u[m] >= cand) ? 1 : 0;
            c = wave_sum_i(c);
            if (c >= TOPK) tau = cand;
            if (c == TOPK) break;
        }
        int cg = 0, ct = 0; unsigned tlo = 0u, thi = 0u;
#pragma unroll
        for (int m = 31; m >= 0; --m) { cg += (u[m] > tau) ? 1 : 0; const unsigned tie = (u[m] == tau) ? 1u : 0u; ct += (int)tie; tlo = (tlo << 1) | tie; }
#pragma unroll
        for (int m = 63; m >= 32; --m) { cg += (u[m] > tau) ? 1 : 0; const unsigned tie = (u[m] == tau) ? 1u : 0u; ct += (int)tie; thi = (thi << 1) | tie; }
        unsigned long long tmask = ((unsigned long long)thi << 32) | tlo;
        const int totg = wave_sum_i(cg), tott = wave_sum_i(ct);
        const int need = TOPK - totg;
        unsigned long long smask = 0ull;
        if (tott == need) smask = tmask;
        else {
#pragma unroll 1
            for (int it = 0; it < need; ++it) {
                const int m0 = tmask ? (int)__builtin_ctzll(tmask) : 64;
                const int cand = tmask ? (lane + 64 * m0) : 0x7fffffff, best = wave_min_i(cand);
                if (cand == best && tmask) { smask |= (1ull << m0); tmask &= ~(1ull << m0); }
            }
        }
        const int mine = cg + __popcll(smask);
        int incl = mine;
#pragma unroll
        for (int d = 1; d < 64; d <<= 1) { const int o = __shfl_up(incl, d); if (lane >= d) incl += o; }
        int off = incl - mine;
#pragma unroll
        for (int m = 0; m < 64; ++m) { if ((u[m] > tau) || ((smask >> m) & 1ull)) { sel[off] = lane + 64 * m; ++off; } }
        if (lane == 0) CNT[row] = TOPK;
    }
}
__device__ __forceinline__ void phase_topk_sample(KP p, LAS unsigned char* lds) {
    LAS unsigned* ckey = (LAS unsigned*)lds;
    LAS int* cidx = (LAS int*)(lds + 8192);
    const float* SCS = WSP(float, WS_SCS); int* SEL = WSP(int, WS_SEL); int* CNT = WSP(int, WS_CNT);
    for (int qq = BID(); qq < NS; qq += gridDim.x) {
        const int tid = TID(), lane = tid & 63, wave = tid >> 6;
        const int n = PAST + 1 + (qq & 7), row = NP + qq, s0 = 1088 * wave;
        const float* base = SCS + (size_t)qq * SCS_LD;
        unsigned u[17];
#pragma unroll
        for (int m = 0; m < 17; ++m) { const int s = s0 + lane + 64 * m; u[m] = __float_as_uint(base[s < SCS_LD ? s : 0]); }
#pragma unroll
        for (int m = 0; m < 17; ++m) { const unsigned k_ = fkey(__uint_as_float(u[m])); u[m] = (s0 + lane + 64 * m < n) ? k_ : 0u; }
        __syncthreads();
        {
            int nvalid = 0;
#pragma unroll
            for (int m = 0; m < 17; ++m) nvalid += (u[m] != 0u) ? 1 : 0;
            nvalid = wave_sum_i(nvalid);
            unsigned tau = 0u; int need = 0; unsigned tmask = 0u, smask = 0u;
            if (nvalid > TOPK) {
#pragma unroll 1
                for (int bit = 31; bit >= 0; --bit) {
                    const unsigned cand = tau | (1u << bit); int c = 0;
#pragma unroll
                    for (int m = 0; m < 17; ++m) c += (u[m] >= cand) ? 1 : 0;
                    c = wave_sum_i(c);
                    if (c >= TOPK) tau = cand;
                    if (c == TOPK) break;
                }
                int cg = 0, ct = 0;
#pragma unroll
                for (int m = 0; m < 17; ++m) { cg += (u[m] > tau) ? 1 : 0; const bool tie = (u[m] == tau); ct += tie ? 1 : 0; tmask |= tie ? (1u << m) : 0u; }
                cg = wave_sum_i(cg); ct = wave_sum_i(ct);
                need = TOPK - cg;
                if (ct == need) smask = tmask;
                else {
#pragma unroll 1
                    for (int it = 0; it < need; ++it) {
                        const int m0 = tmask ? (int)__builtin_ctz(tmask) : 32;
                        const int cand = tmask ? (lane + 64 * m0) : 0x7fffffff, best = wave_min_i(cand);
                        if (cand == best && tmask) { smask |= (1u << m0); tmask &= ~(1u << m0); }
                    }
                }
            } else { tau = 0u; smask = 0u; }
            int mine = 0;
#pragma unroll
            for (int m = 0; m < 17; ++m) mine += ((u[m] > tau) || ((smask >> m) & 1u)) ? 1 : 0;
            int incl = mine;
#pragma unroll
            for (int d = 1; d < 64; d <<= 1) { const int o = __shfl_up(incl, d); if (lane >= d) incl += o; }
            int off = incl - mine;
            const int total = __builtin_amdgcn_readlane(incl, 63);
#pragma unroll
            for (int m = 0; m < 17; ++m) { if ((u[m] > tau) || ((smask >> m) & 1u)) { ckey[wave * 256 + off] = u[m]; cidx[wave * 256 + off] = s0 + lane + 64 * m; ++off; } }
            for (int e = total + lane; e < 256; e += 64) { ckey[wave * 256 + e] = 0u; cidx[wave * 256 + e] = 0x7fffffff; }
        }
        __syncthreads();
        if (wave == 0) {
            unsigned v[32]; int ix[32];
#pragma unroll
            for (int m = 0; m < 32; ++m) { v[m] = ckey[lane + 64 * m]; ix[m] = cidx[lane + 64 * m]; }
            unsigned tau = 0u;
#pragma unroll 1
            for (int bit = 31; bit >= 0; --bit) {
                const unsigned cand = tau | (1u << bit); int c = 0;
#pragma unroll
                for (int m = 0; m < 32; ++m) c += (v[m] >= cand) ? 1 : 0;
                c = wave_sum_i(c);
                if (c >= TOPK) tau = cand;
                if (c == TOPK) break;
            }
            int cg = 0, ct = 0; unsigned tmask = 0u, smask = 0u;
#pragma unroll
            for (int m = 31; m >= 0; --m) { cg += (v[m] > tau) ? 1 : 0; const unsigned tie = (v[m] == tau) ? 1u : 0u; ct += (int)tie; tmask = (tmask << 1) | tie; }
            cg = wave_sum_i(cg); ct = wave_sum_i(ct);
            const int need = TOPK - cg;
            if (ct == need) smask = tmask;
            else {
#pragma unroll 1
                for (int it = 0; it < need; ++it) {
                    int bi = 0x7fffffff, bm = 0;
#pragma unroll
                    for (int m = 0; m < 32; ++m) { const bool t_ = (tmask >> m) & 1u; if (t_ && ix[m] < bi) { bi = ix[m]; bm = m; } }
                    const int best = wave_min_i(bi);
                    if (bi == best && bi != 0x7fffffff) { smask |= (1u << bm); tmask &= ~(1u << bm); }
                }
            }
            int mine = 0;
#pragma unroll
            for (int m = 0; m < 32; ++m) mine += ((v[m] > tau) || ((smask >> m) & 1u)) ? 1 : 0;
            int incl = mine;
#pragma unroll
            for (int d = 1; d < 64; d <<= 1) { const int o = __shfl_up(incl, d); if (lane >= d) incl += o; }
            int off = incl - mine;
            int* sel = SEL + (size_t)row * 256;
#pragma unroll
            for (int m = 0; m < 32; ++m) { if ((v[m] > tau) || ((smask >> m) & 1u)) { if (off < TOPK) sel[off] = ix[m]; ++off; } }
            if (lane == 0) CNT[row] = TOPK;
        }
    }
    __syncthreads();
}

template <bool SAMPLE>
__device__ __forceinline__ void phase_attn(KP p, int j, LAS unsigned char* lds) {
    const int tid = TID(), lane = tid & 63, wave = tid >> 6, n16 = lane & 15, c4 = lane >> 4;
    LAS bf16_t* ps = (LAS bf16_t*)(lds + wave * 16384);
    LAS int* is = (LAS int*)(lds + wave * 16384 + 8192);
    LAS bf16_t* qs = (LAS bf16_t*)(lds + wave * 16384 + 9216);
    LAS float* invs = (LAS float*)(lds + wave * 16384 + 11264);
    const float* Q = WSP(float, WS_Q); const int* SEL = WSP(int, WS_SEL); const int* CNT = WSP(int, WS_CNT); bf16_t* O = WSP(bf16_t, WS_YG);
    const bf16_t *KBF = WSP(bf16_t, WS_KBF), *VBF = WSP(bf16_t, WS_VBF);
    const float* kc = p->cache_k + (size_t)j * 2560 * 128 * 256; const float* vc = p->cache_v + (size_t)j * 2560 * 128 * 256;
    const float* knew = p->out + O_KS + (size_t)j * NS * 256; const float* vnew = p->out + O_VS + (size_t)j * NS * 256;
    const int gw = BID() * 8 + wave, nw = gridDim.x * 8, nq = SAMPLE ? NS : NP;
    unsigned* qctr = WSP(unsigned, WS_BAR + 40960) + (size_t)j * 256;
    int qb = 0, qnext = 0, qsub = 2, qcur = 0;
    if (!SAMPLE) { unsigned v_ = 0u; if (lane == 0) v_ = __hip_atomic_fetch_add(qctr + 16 * ((BID() + qb) & 3), 2u, __ATOMIC_RELAXED, __HIP_MEMORY_SCOPE_AGENT); qnext = (int)__builtin_amdgcn_readfirstlane(v_); }
    for (int qi = gw; SAMPLE ? (qi < nq) : true; qi += nw) {
        int row;
        if (SAMPLE) row = NP + qi;
        else {
            if (qsub == 2) {
                for (;;) {
                    qcur = qnext; qsub = 0;
                    if (qcur < 4096 || qb == 3) break;
                    ++qb; unsigned v_ = 0u; if (lane == 0) v_ = __hip_atomic_fetch_add(qctr + 16 * ((BID() + qb) & 3), 2u, __ATOMIC_RELAXED, __HIP_MEMORY_SCOPE_AGENT); qnext = (int)__builtin_amdgcn_readfirstlane(v_);
                }
                if (qcur >= 4096) break;
                { unsigned v_ = 0u; if (lane == 0) v_ = __hip_atomic_fetch_add(qctr + 16 * ((BID() + qb) & 3), 2u, __ATOMIC_RELAXED, __HIP_MEMORY_SCOPE_AGENT); qnext = (int)__builtin_amdgcn_readfirstlane(v_); }
            }
            row = ((BID() + qb) & 3) * 4096 + (4095 - (qcur + qsub)); ++qsub;
        }
        const int n = CNT[row];
        wave_lds_fence();
#pragma unroll
        for (int c = 0; c < 4; ++c) { const int slot = lane + 64 * c;
            int s = SEL[(size_t)row * 256 + slot]; const bool ok = slot < n;
            int r;
            if (SAMPLE) { const int bb = (row - NP) >> 3; s = ok ? s : 0; const int sp = min(max(s, 0), PAST - 1); const int pg = p->page_table[bb * 64 + (sp >> 7)];
                r = (s < PAST) ? pg * 128 + (s & 127) : (0x40000000 | (bb * 8 + min(s - PAST, 7))); }
            else r = (row & ~4095) + (ok ? s : 0);
            is[slot] = r; }
#pragma unroll
        for (int i = 0; i < 4; ++i) { const f32x4 q4 = ld_bf4((const bf16_t*)Q + (size_t)row * D + 256 * i + 4 * lane);
            if (SAMPLE) { const f32x4 q8 = q4 * 0.125f; u32x2 w; w.x = pk_bf16(q8[0], q8[1]); w.y = pk_bf16(q8[2], q8[3]); *(LAS u32x2*)(qs + 256 * i + 4 * lane) = w; }
            else *(LAS unsigned*)((LAS unsigned char*)qs + 256 * i + 4 * lane) = pk_fp8x4(q4); }
        wave_lds_fence();
        {
            float mx = -__builtin_huge_valf();
#define ATT_EMIT(t_, acc_) do { f32x4 l_ = (acc_); _Pragma("unroll") for (int r = 0; r < 4; ++r) { if (16 * (t_) + 4 * c4 + r >= n) l_[r] = -__builtin_huge_valf(); mx = fmaxf(mx, l_[r]); } \
                u32x2 w_; w_.x = pk_bf16(l_[0], l_[1]); w_.y = pk_bf16(l_[2], l_[3]); *(LAS u32x2*)(ps + n16 * 256 + 16 * (t_) + 4 * c4) = w_; } while (0)
            if (SAMPLE) {
                const u32x4 qf0 = *(const LAS u32x4*)(qs + n16 * 64 + 8 * c4), qf1 = *(const LAS u32x4*)(qs + n16 * 64 + 32 + 8 * c4);
                u32x4 bq[8];
#pragma unroll
                for (int ks = 0; ks < 8; ++ks) { const bool on = (n16 >> 2) == (ks >> 1); const u32x4 qv = (ks & 1) ? qf1 : qf0; bq[ks] = (u32x4){on ? qv.x : 0u, on ? qv.y : 0u, on ? qv.z : 0u, on ? qv.w : 0u}; }
#pragma unroll 2
                for (int t = 0; t < 16; ++t) {
                    const int r = is[16 * t + n16];
                    const float* kp = ((r & 0x40000000) ? knew + (size_t)(r & 0xffff) * 256 : kc + (size_t)r * 256) + 8 * c4;
                    f32x4 acc = {0.f, 0.f, 0.f, 0.f};
#pragma unroll
                    for (int ks = 0; ks < 8; ++ks) { const f32x4 x0 = *(const f32x4*)(kp + 32 * ks), x1 = *(const f32x4*)(kp + 32 * ks + 4);
                        const u32x4 ka = {pk_bf16(x0[0], x0[1]), pk_bf16(x0[2], x0[3]), pk_bf16(x1[0], x1[1]), pk_bf16(x1[2], x1[3])};
                        acc = __builtin_amdgcn_mfma_f32_16x16x32_bf16(__builtin_bit_cast(bf16x8, ka), __builtin_bit_cast(bf16x8, bq[ks]), acc, 0, 0, 0); }
                    ATT_EMIT(t, acc);
                }
            } else {
                const LAS unsigned char* q8 = (const LAS unsigned char*)qs;
                long bq[8];
                { const bool on = (n16 >> 2) == c4;
#pragma unroll
                  for (int h2 = 0; h2 < 4; ++h2) { const u32x4 qv = *(const LAS u32x4*)(q8 + n16 * 64 + 16 * h2);
                      const u32x2 z0 = {on ? qv.x : 0u, on ? qv.y : 0u}, z1 = {on ? qv.z : 0u, on ? qv.w : 0u}; bq[2 * h2] = __builtin_bit_cast(long, z0); bq[2 * h2 + 1] = __builtin_bit_cast(long, z1); } }
                const unsigned char* K8 = WSP(unsigned char, WS_K8);
#pragma unroll
                for (int th = 0; th < 2; ++th) {
                    if (th) asm volatile("" ::: "memory");
                    u32x4 ka[8][4];
#pragma unroll
                    for (int t8 = 0; t8 < 8; ++t8) {
                        const int r = is[16 * (8 * th + t8) + n16];
                        const unsigned char* kp = K8 + (size_t)r * 256 + 64 * c4;
#pragma unroll
                        for (int h2 = 0; h2 < 4; ++h2) ka[t8][h2] = *(const u32x4*)(kp + 16 * h2);
                    }
                    __builtin_amdgcn_sched_barrier(0);
#pragma unroll
                    for (int t8 = 0; t8 < 8; ++t8) {
                        f32x4 acc = {0.f, 0.f, 0.f, 0.f};
#pragma unroll
                        for (int h2 = 0; h2 < 4; ++h2) { const u32x2 lo = {ka[t8][h2].x, ka[t8][h2].y}, hi = {ka[t8][h2].z, ka[t8][h2].w};
                            acc = __builtin_amdgcn_mfma_f32_16x16x32_fp8_fp8(__builtin_bit_cast(long, lo), bq[2 * h2], acc, 0, 0, 0);
                            acc = __builtin_amdgcn_mfma_f32_16x16x32_fp8_fp8(__builtin_bit_cast(long, hi), bq[2 * h2 + 1], acc, 0, 0, 0); }
                        ATT_EMIT(8 * th + t8, acc * 0.125f);
                    }
                }
            }
#undef ATT_EMIT
            mx = fmaxf(mx, __shfl_xor(mx, 16)); mx = fmaxf(mx, __shfl_xor(mx, 32));
            float sm = 0.f;
            u32x2 lw_[16];
#pragma unroll
            for (int t = 0; t < 16; ++t) lw_[t] = *(const LAS u32x2*)(ps + n16 * 256 + 16 * t + 4 * c4);
#pragma unroll
            for (int t = 0; t < 16; ++t) {
                const u32x2 w = lw_[t];
                const float e0 = __expf(bflo(w.x) - mx), e1 = __expf(bfhi(w.x) - mx), e2 = __expf(bflo(w.y) - mx), e3 = __expf(bfhi(w.y) - mx);
                sm += (e0 + e1) + (e2 + e3);
                u32x2 o_; o_.x = pk_bf16(e0, e1); o_.y = pk_bf16(e2, e3); *(LAS u32x2*)(ps + n16 * 256 + 16 * t + 4 * c4) = o_;
            }
            sm += __shfl_xor(sm, 16); sm += __shfl_xor(sm, 32);
            if (c4 == 0) invs[n16] = 1.0f / sm;
        }
        wave_lds_fence();
        if (!SAMPLE) {
            const unsigned char* V8 = WSP(unsigned char, WS_V8);
            const int rs = c4, kvh = n16 >> 2, nst = n > 64 ? 64 : n;
            f32x4 oa[4][4];
#pragma unroll
            for (int g = 0; g < 4; ++g)
#pragma unroll
                for (int q = 0; q < 4; ++q) oa[g][q] = (f32x4){0.f, 0.f, 0.f, 0.f};
            u32x4 vr[8], vn[8];
#pragma unroll
            for (int i = 0; i < 8; ++i) vn[i] = *(const u32x4*)(V8 + (size_t)is[64 * rs + i] * 256 + 16 * n16);
            for (int m0 = 0; m0 < nst; m0 += 8) {
#pragma unroll
                for (int i = 0; i < 8; ++i) vr[i] = vn[i];
                if (m0 + 8 < nst) {
#pragma unroll
                    for (int i = 0; i < 8; ++i) vn[i] = *(const u32x4*)(V8 + (size_t)is[64 * rs + m0 + 8 + i] * 256 + 16 * n16);
                }
                __builtin_amdgcn_sched_barrier(0);
#pragma unroll
                for (int h4 = 0; h4 < 2; ++h4) {
                    u32x2 pg[4];
#pragma unroll
                    for (int g = 0; g < 4; ++g) pg[g] = *(const LAS u32x2*)(ps + (kvh * 4 + g) * 256 + 64 * rs + m0 + 4 * h4);
#pragma unroll
                    for (int i = 0; i < 4; ++i) {
                        const u32x4 v_ = vr[4 * h4 + i];
                        const f32x4 v0 = fp8x4_f32(v_.x), v1 = fp8x4_f32(v_.y), v2 = fp8x4_f32(v_.z), v3 = fp8x4_f32(v_.w);
#pragma unroll
                        for (int g = 0; g < 4; ++g) { const unsigned pw = (i < 2) ? pg[g].x : pg[g].y; const float pf = (i & 1) ? bfhi(pw) : bflo(pw);
                            oa[g][0] += pf * v0; oa[g][1] += pf * v1; oa[g][2] += pf * v2; oa[g][3] += pf * v3; }
                    }
                }
            }
#pragma unroll
            for (int g = 0; g < 4; ++g)
#pragma unroll
                for (int q = 0; q < 4; ++q)
#pragma unroll
                    for (int e_ = 0; e_ < 4; ++e_) { float x = oa[g][q][e_]; x += __shfl_xor(x, 16); x += __shfl_xor(x, 32); oa[g][q][e_] = x; }
            if (rs == 0) {
                const f32x4 iv = *(const LAS f32x4*)(invs + 4 * kvh);
#pragma unroll
                for (int g = 0; g < 4; ++g) { bf16_t* op = O + (size_t)row * D + (kvh * 4 + g) * 64 + 16 * (n16 & 3);
                    u32x4 w0, w1; const float sc_ = iv[g];
                    w0.x = pk_bf16(oa[g][0][0] * sc_, oa[g][0][1] * sc_); w0.y = pk_bf16(oa[g][0][2] * sc_, oa[g][0][3] * sc_); w0.z = pk_bf16(oa[g][1][0] * sc_, oa[g][1][1] * sc_); w0.w = pk_bf16(oa[g][1][2] * sc_, oa[g][1][3] * sc_);
                    w1.x = pk_bf16(oa[g][2][0] * sc_, oa[g][2][1] * sc_); w1.y = pk_bf16(oa[g][2][2] * sc_, oa[g][2][3] * sc_); w1.z = pk_bf16(oa[g][3][0] * sc_, oa[g][3][1] * sc_); w1.w = pk_bf16(oa[g][3][2] * sc_, oa[g][3][3] * sc_);
                    *(u32x4*)op = w0; *(u32x4*)(op + 8) = w1; }
            }
        } else {
        f32x4 o0 = {0.f, 0.f, 0.f, 0.f}, o1 = o0, o2 = o0, o3 = o0;
        constexpr int GV = SAMPLE ? 16 : 32;
        const int ng = (n + GV - 1) / GV;
        unsigned vb[SAMPLE ? 1 : GV], vbn[SAMPLE ? 1 : GV]; f32x4 vf[SAMPLE ? GV : 1];
        const unsigned char* V8 = WSP(unsigned char, WS_V8);
        if (!SAMPLE) {
#pragma unroll
            for (int i = 0; i < GV; ++i) vbn[i] = *(const unsigned*)(V8 + (size_t)is[i] * 256 + 4 * lane);
        }
#pragma unroll 1
        for (int g = 0; g < ng; ++g) {
            if (!SAMPLE) {
#pragma unroll
                for (int i = 0; i < GV; ++i) vb[i] = vbn[i];
                if (g + 1 < ng) {
#pragma unroll
                    for (int i = 0; i < GV; ++i) vbn[i] = *(const unsigned*)(V8 + (size_t)is[GV * (g + 1) + i] * 256 + 4 * lane);
                }
                __builtin_amdgcn_sched_barrier(0);
            } else {
#pragma unroll
                for (int i = 0; i < GV; ++i) { const int r = is[GV * g + i]; vf[i] = *(const f32x4*)(((r & 0x40000000) ? vnew + (size_t)(r & 0xffff) * 256 : vc + (size_t)r * 256) + 4 * lane); }
            }
#pragma unroll
            for (int i4 = 0; i4 < GV / 4; ++i4) {
                const u32x2 p0 = *(const LAS u32x2*)(ps + (c4 * 4 + 0) * 256 + GV * g + 4 * i4), p1 = *(const LAS u32x2*)(ps + (c4 * 4 + 1) * 256 + GV * g + 4 * i4),
                            p2 = *(const LAS u32x2*)(ps + (c4 * 4 + 2) * 256 + GV * g + 4 * i4), p3 = *(const LAS u32x2*)(ps + (c4 * 4 + 3) * 256 + GV * g + 4 * i4);
                f32x4 v0, v1, v2, v3;
                if (!SAMPLE) { v0 = fp8x4_f32(vb[4 * i4]); v1 = fp8x4_f32(vb[4 * i4 + 1]); v2 = fp8x4_f32(vb[4 * i4 + 2]); v3 = fp8x4_f32(vb[4 * i4 + 3]); }
                else { v0 = vf[4 * i4]; v1 = vf[4 * i4 + 1]; v2 = vf[4 * i4 + 2]; v3 = vf[4 * i4 + 3]; }
                o0 += bflo(p0.x) * v0 + bfhi(p0.x) * v1 + bflo(p0.y) * v2 + bfhi(p0.y) * v3;
                o1 += bflo(p1.x) * v0 + bfhi(p1.x) * v1 + bflo(p1.y) * v2 + bfhi(p1.y) * v3;
                o2 += bflo(p2.x) * v0 + bfhi(p2.x) * v1 + bflo(p2.y) * v2 + bfhi(p2.y) * v3;
                o3 += bflo(p3.x) * v0 + bfhi(p3.x) * v1 + bflo(p3.y) * v2 + bfhi(p3.y) * v3;
            }
        }
        { const f32x4 iv = *(const LAS f32x4*)(invs + 4 * c4); bf16_t* op = O + (size_t)row * D + c4 * 256 + 4 * n16; st_bf4(op, o0 * iv[0]); st_bf4(op + 64, o1 * iv[1]); st_bf4(op + 128, o2 * iv[2]); st_bf4(op + 192, o3 * iv[3]); }
        }
    }
}

__global__ void __launch_bounds__(512, 2) mega(P p_unused) {
    extern __shared__ __attribute__((aligned(16))) unsigned char lds_raw[];
    LAS unsigned char* lds = (LAS unsigned char*)lds_raw;
    volatile LAS unsigned* misc = (volatile LAS unsigned*)(lds + LDS_MISC);
    if (TID() < 4) misc[TID()] = 0u;
    __syncthreads();
    KP p = kargs();
    const bool multi = (p->ph_hi - p->ph_lo) > 1;
    XcdBarrier bar; bar.bar = WSP(unsigned, WS_BAR); bar.x = 0; bar.st = misc;
    if (multi) bar = xcd_barrier_post(WSP(unsigned, WS_BAR), misc);
    int ph = 0;
    const int lo = p->ph_lo, hi = p->ph_hi;
#ifndef REPMASK
#define REPMASK 0ull
#endif
#define PH_BEGIN if (ph >= lo && ph < hi) { KP p = kargs(); const int nrep_ = ((REPMASK >> ph) & 1ull) ? 3 : 1; for (int rep_ = 0; rep_ < nrep_; ++rep_) {
#define PH_END   if (ph + 1 < hi || rep_ + 1 < nrep_) xcd_barrier(bar); } } ++ph;

    PH_BEGIN phase_ada(p, lds); phase_weights(p, lds); PH_END

    for (int layer = 0; layer < 4; ++layer) {
        const int j = layer >> 1;
        if ((layer & 1) == 0) {
            PH_BEGIN phase_prep<true>(p, layer, 0, j, layer == 0); PH_END
            PH_BEGIN {
                FRwkvIn f{WSP(bf16_t, WS_RB), WSP(bf16_t, WS_KB), WSP(bf16_t, WS_VB), WSP(bf16_t, WS_TW), WSP(bf16_t, WS_TA), WSP(bf16_t, WS_TV), WSP(bf16_t, WS_TG)};
                pg8::Gemm g{WSP(bf16_t, WS_XR), WSP(bf16_t, WS_WRW_T) + (size_t)j * 4096 * D, NP, j == 0 ? 3840 : 4096, D, j == 0 ? 2 : 1, XR_STRIDE};
                pg8::StaticOrder S; S.init(NP, g.N, (int)gridDim.x, BID());
                pg8::EpiAdapt<FRwkvIn, true> E{f};
                pg8::gemm_phase(lds, g, S, E);
                wgemm_ks<true>(lds, WSP(bf16_t, WS_XR), D, XR_STRIDE, NP, NS, WSP(bf16_t, WS_WRW_T) + (size_t)j * 4096 * D, D, 4096, f, ((NP / 256) * (g.N / 256)) % (int)gridDim.x);
            } PH_END
            PH_BEGIN {
                FStoreF32 fw{WSP(float, WS_WP), D, D}, fa{WSP(float, WS_AP), D, D}, fv{WSP(float, WS_VP), D, D}, fg{WSP(float, WS_GG), D, D};
                wgemm_w(WSP(bf16_t, WS_TW), 64, NP, NS, WSP(bf16_t, WS_W2T) + (size_t)j * D * 64, 64, D, fw);
                wgemm_w(WSP(bf16_t, WS_TA), 64, NP, NS, WSP(bf16_t, WS_A2T) + (size_t)j * D * 64, 64, D, fa);
                if (j == 1) wgemm_w(WSP(bf16_t, WS_TV), 32, NP, NS, WSP(bf16_t, WS_V2T), 32, D, fv);
                wgemm_w(WSP(bf16_t, WS_TG), 160, NP, NS, WSP(bf16_t, WS_G2T) + (size_t)j * D * 160, 160, D, fg);
                phase_chunk(p, j, lds);
            } PH_END
            PH_BEGIN phase_carry(p, j, lds); PH_END
            PH_BEGIN phase_post2(p, j, lds); PH_END
        } else {
            PH_BEGIN phase_prep<false>(p, layer, 0, j); PH_END
            PH_BEGIN {
                FStoreBf16 f{WSP(bf16_t, WS_PR), PINP, PINP};
                pg8::Gemm g{WSP(bf16_t, WS_XR), WSP(bf16_t, WS_WIN_T) + (size_t)j * PINP * D, NP, PINP, D, 0, 0};
                pg8::StaticOrder S; S.init(NP, PINP, (int)gridDim.x, BID());
                pg8::EpiAdapt<FStoreBf16, true> E{f};
                pg8::gemm_phase(lds, g, S, E);
                FStoreBf16 fs{WSP(bf16_t, WS_PR), PINP, PIN};
                wgemm_ks<false>(lds, WSP(bf16_t, WS_XR), D, 0, NP, NS, WSP(bf16_t, WS_WIN_T) + (size_t)j * PINP * D, D, PINP, fs, ((NP / 256) * (PINP / 256)) % (int)gridDim.x);
            } PH_END
            PH_BEGIN phase_dsapost(p, j); PH_END
            PH_BEGIN phase_idx2<false>(p, j); phase_idx2<true>(p, j); PH_END
            PH_BEGIN phase_topk_prompt(p); phase_topk_sample(p, lds); PH_END
            PH_BEGIN phase_attn<true>(p, j, lds); phase_attn<false>(p, j, lds); PH_END
        }
        PH_BEGIN {
            FResid f{p->out, WSP(float, WS_MODS) + (size_t)layer * 36 * 6144 + 2 * D, layer == 0 ? p->x_prompt : nullptr, layer == 0 ? p->x_sample : nullptr};
            const bf16_t* Wt = ((layer & 1) == 0 ? WSP(bf16_t, WS_WO_T) : WSP(bf16_t, WS_WAO_T)) + (size_t)j * D * D;
            pg8::Gemm g{WSP(bf16_t, WS_YG), Wt, NP, D, D, 0, 0};
            pg8::StaticOrder S; S.init(NP, D, (int)gridDim.x, BID());
            pg8::EpiAdapt<FResid, false> E{f};
            pg8::gemm_phase(lds, g, S, E);
            wgemm_ks<false>(lds, WSP(bf16_t, WS_YG), D, 0, NP, NS, Wt, D, D, f);
        } PH_END
        PH_BEGIN phase_prep<false>(p, layer, 1, j); PH_END
        PH_BEGIN {
            FRelu2 f{WSP(bf16_t, WS_U)};
            pg8::Gemm g{WSP(bf16_t, WS_XR), WSP(bf16_t, WS_WUP_T) + (size_t)layer * DFF * D, NP, DFF, D, 0, 0};
            pg8::StaticOrder S; S.init(NP, DFF, (int)gridDim.x, BID());
            pg8::EpiAdapt<FRelu2, true> E{f};
            pg8::gemm_phase(lds, g, S, E);
            wgemm_ks<false>(lds, WSP(bf16_t, WS_XR), D, 0, NP, NS, WSP(bf16_t, WS_WUP_T) + (size_t)layer * DFF * D, D, DFF, f);
        } PH_END
        PH_BEGIN {
            FResid f{p->out, WSP(float, WS_MODS) + (size_t)layer * 36 * 6144 + 5 * D, nullptr, nullptr};
            pg8::Gemm g{WSP(bf16_t, WS_U), WSP(bf16_t, WS_WDN_T) + (size_t)layer * DFF * D, NP, D, DFF, 0, 0};
            pg8::StaticOrder S; S.init(NP, D, (int)gridDim.x, BID());
            pg8::EpiAdapt<FResid, false> E{f};
            pg8::gemm_phase(lds, g, S, E);
            wgemm_ks<false>(lds, WSP(bf16_t, WS_U), DFF, 0, NP, NS, WSP(bf16_t, WS_WDN_T) + (size_t)layer * DFF * D, DFF, D, f);
        } PH_END
    }
#undef PH_BEGIN
#undef PH_END
}

static int count_phases() { int n = 1; for (int layer = 0; layer < 4; ++layer) { n += ((layer & 1) == 0) ? 5 : 6; n += 4; } return n; }

extern "C" void kernel_launch(void* const* d_in, const int* in_sizes, int n_in, void* d_out, int out_size, void* d_ws, size_t ws_size, hipStream_t stream) {
    static int grid = 0;
    if (grid == 0) {
        if (n_in != 39 || out_size != (int)O_END || ws_size < WS_END) { fprintf(stderr, "kernel_launch: unexpected shapes n_in %d out %d ws %zu (need %zu)\n", n_in, out_size, ws_size, (size_t)WS_END); grid = -1; return; }
        int dev = 0, cus = 0, per_cu = 0;
        if (hipGetDevice(&dev) != hipSuccess || hipDeviceGetAttribute(&cus, hipDeviceAttributeMultiprocessorCount, dev) != hipSuccess) { grid = -1; return; }
        if (hipFuncSetAttribute((const void*)mega, hipFuncAttributeMaxDynamicSharedMemorySize, LDS_BYTES) != hipSuccess) { fprintf(stderr, "kernel_launch: hipFuncSetAttribute failed\n"); grid = -1; return; }
        if (hipOccupancyMaxActiveBlocksPerMultiprocessor(&per_cu, (const void*)mega, 512, LDS_BYTES) != hipSuccess || per_cu < 1) fprintf(stderr, "kernel_launch: occupancy query says %d\n", per_cu);
        (void)hipGetLastError();
        grid = cus;
    }
    if (grid < 0) return;
    (void)hipMemsetAsync((char*)d_ws + WS_BAR, 0, 65536, stream);
    P p{};
    memcpy((void*)&p, (const void*)d_in, 39 * sizeof(void*));
    p.out = (float*)d_out; p.ws = (unsigned char*)d_ws;
#ifndef STOP_PH
#define STOP_PH 1000
#endif
    const int nph = count_phases() < STOP_PH ? count_phases() : STOP_PH;
#ifndef ONE_LAUNCH
    for (int ph = 0; ph < nph; ++ph) { p.ph_lo = ph; p.ph_hi = ph + 1; hipLaunchKernelGGL(mega, dim3(grid), dim3(512), LDS_BYTES, stream, p); }
#else
    p.ph_lo = 0; p.ph_hi = nph; hipLaunchKernelGGL(mega, dim3(grid), dim3(512), LDS_BYTES, stream, p);
#endif
}
```

```cpp
#define ONE_LAUNCH 1
#include <hip/hip_runtime.h>
#include <cstdio>
#include <cstdint>
#include <cstring>

#define LAS __attribute__((address_space(3)))
typedef unsigned short bf16_t;
typedef short bf16x8 __attribute__((ext_vector_type(8)));
typedef float f32x4 __attribute__((ext_vector_type(4)));
typedef float f32x2 __attribute__((ext_vector_type(2)));
typedef unsigned u32x4 __attribute__((ext_vector_type(4)));
typedef unsigned u32x2 __attribute__((ext_vector_type(2)));

constexpr int D = 1024, NP = 16384, NS = 256, NT = NP + NS, SEQL = 4096, PAST = 8192, NSEQ = 36, DFF = 4096;
constexpr int PIN = 2120, PINP = 2304;
constexpr int TOPK = 256, SCS_LD = 8320;
constexpr size_t O_YP = 0, O_YS = 16777216, O_KP = 17039360, O_VP = 25427968, O_IKP = 33816576, O_WKVP = 35913728, O_SHP = 36438016,
                 O_KS = 36446208, O_VS = 36577280, O_IKS = 36708352, O_WKVS = 36741120, O_SHS = 40935424, O_END = 41000960;
constexpr size_t al256(size_t x) { return (x + 255) & ~(size_t)255; }
constexpr size_t WS_BAR = 0;
constexpr size_t WS_MODS = 65536;
constexpr size_t WS_WUP_T = al256(WS_MODS + (size_t)4 * NSEQ * 6144 * 4);
constexpr size_t WS_WDN_T = WS_WUP_T + (size_t)4 * DFF * D * 2;
constexpr size_t WS_WRW_T = WS_WDN_T + (size_t)4 * DFF * D * 2;
constexpr size_t WS_WO_T = WS_WRW_T + (size_t)2 * 4096 * D * 2;
constexpr size_t WS_WIN_T = WS_WO_T + (size_t)2 * D * D * 2;
constexpr size_t WS_WAO_T = WS_WIN_T + (size_t)2 * PINP * D * 2;
constexpr size_t WS_W2T = WS_WAO_T + (size_t)2 * D * D * 2;
constexpr size_t WS_A2T = WS_W2T + (size_t)2 * D * 64 * 2;
constexpr size_t WS_V2T = WS_A2T + (size_t)2 * D * 64 * 2;
constexpr size_t WS_G2T = WS_V2T + (size_t)D * 32 * 2;
constexpr size_t WS_XR = WS_G2T + (size_t)2 * D * 160 * 2;
constexpr size_t XR_STRIDE = (size_t)NT * D;
constexpr size_t WS_RB = WS_XR + 6 * XR_STRIDE * 2;
constexpr size_t WS_KB = WS_RB + XR_STRIDE * 2;
constexpr size_t WS_VB = WS_KB + XR_STRIDE * 2;
constexpr size_t WS_TW = WS_VB + XR_STRIDE * 2;
constexpr size_t WS_TA = WS_TW + (size_t)NT * 64 * 2;
constexpr size_t WS_TV = WS_TA + (size_t)NT * 64 * 2;
constexpr size_t WS_TG = WS_TV + (size_t)NT * 32 * 2;
constexpr size_t WS_WP = al256(WS_TG + (size_t)NT * 160 * 2);
constexpr size_t F32A = (size_t)NT * D * 4;
constexpr size_t WS_AP = WS_WP + F32A, WS_VP = WS_AP + F32A, WS_GG = WS_VP + F32A, WS_VFIRST = WS_GG + F32A;
constexpr size_t WS_DEC = WS_VFIRST + F32A, WS_KM = WS_DEC + F32A, WS_VM = WS_KM + F32A, WS_AV = WS_VM + F32A, WS_BV = WS_AV + F32A, WS_Y = WS_BV + F32A;
constexpr size_t WS_YG = WS_Y + F32A;
constexpr size_t WS_U = WS_YG + XR_STRIDE * 2;
constexpr size_t WS_PR = WS_U + (size_t)NT * DFF * 2;
constexpr size_t WS_Q = WS_PR + (size_t)NT * PINP * 4;
constexpr size_t WS_QI = WS_Q + F32A;
constexpr size_t WS_WI = WS_QI + (size_t)NT * 512 * 4;
constexpr size_t WS_SC = al256(WS_WI + (size_t)NT * 8 * 4);
constexpr size_t WS_SCS = WS_SC + (size_t)4 * 4096 * 4096 * 4;
constexpr size_t WS_SEL = al256(WS_SCS + (size_t)NS * SCS_LD * 4);
constexpr size_t WS_CNT = WS_SEL + (size_t)NT * 256 * 4;
constexpr size_t WS_KBF = al256(WS_CNT + (size_t)NT * 4);
constexpr size_t WS_VBF = WS_KBF + (size_t)NT * 256 * 2;
constexpr size_t WS_QIB = WS_VBF + (size_t)NT * 256 * 2;
constexpr size_t WS_KIB = WS_QIB + (size_t)NT * 512 * 2;
constexpr size_t WS_K8 = al256(WS_KIB + (size_t)NT * 64 * 2);
constexpr size_t WS_V8 = WS_K8 + (size_t)NT * 256;
constexpr size_t WS_END = al256(WS_V8 + (size_t)NT * 256);
constexpr size_t WS_ROPE = WS_KBF;

constexpr int LCH = 64, NCH = SEQL / LCH;
constexpr size_t WS_PCH = WS_SC, WS_CCH = WS_PCH + (size_t)64 * NCH * 4096 * 4, WS_SST = WS_CCH + (size_t)64 * NCH * 4096 * 4;
static_assert(WS_SST + (size_t)64 * NCH * 4096 * 4 <= WS_SCS, "scan buffers must fit the aliased region");
constexpr int LDS_BYTES = 147456;
constexpr int LDS_MISC = 131072;

typedef __bf16 bf16x2_t __attribute__((ext_vector_type(2)));
__device__ __forceinline__ unsigned pk_bf16(float lo, float hi) { const f32x2 v = {lo, hi}; const bf16x2_t b = __builtin_convertvector(v, bf16x2_t); return __builtin_bit_cast(unsigned, b); }
__device__ __forceinline__ unsigned pk_fp8x4(f32x4 v) { int w = 0; w = __builtin_amdgcn_cvt_pk_fp8_f32(v[0], v[1], w, false); w = __builtin_amdgcn_cvt_pk_fp8_f32(v[2], v[3], w, true); return (unsigned)w; }
__device__ __forceinline__ f32x4 fp8x4_f32(unsigned w) { return (f32x4){__builtin_amdgcn_cvt_f32_fp8((int)w, 0), __builtin_amdgcn_cvt_f32_fp8((int)w, 1), __builtin_amdgcn_cvt_f32_fp8((int)w, 2), __builtin_amdgcn_cvt_f32_fp8((int)w, 3)}; }
__device__ __forceinline__ float bf2f(unsigned short x) { return __uint_as_float((unsigned)x << 16); }
__device__ __forceinline__ float bflo(unsigned x) { return __uint_as_float(x << 16); }
__device__ __forceinline__ float bfhi(unsigned x) { return __uint_as_float(x & 0xffff0000u); }
__device__ __forceinline__ f32x4 ld_bf4(const bf16_t* p) { const u32x2 v = *(const u32x2*)p; return (f32x4){bflo(v.x), bfhi(v.x), bflo(v.y), bfhi(v.y)}; }
__device__ __forceinline__ void st_bf4(bf16_t* p, f32x4 v) { u32x2 w; w.x = pk_bf16(v[0], v[1]); w.y = pk_bf16(v[2], v[3]); *(u32x2*)p = w; }
template <int CTRL> __device__ __forceinline__ float dppf(float v) { return __int_as_float(__builtin_amdgcn_update_dpp(0, __float_as_int(v), CTRL, 0xf, 0xf, false)); }
template <int CTRL> __device__ __forceinline__ int dppi(int v) { return __builtin_amdgcn_update_dpp(0, v, CTRL, 0xf, 0xf, false); }
__device__ __forceinline__ float g16_sum(float v) { v += dppf<0xB1>(v); v += dppf<0x4E>(v); v += dppf<0x141>(v); v += dppf<0x140>(v); return v; }
__device__ __forceinline__ float g16_max(float v) { v = fmaxf(v, dppf<0xB1>(v)); v = fmaxf(v, dppf<0x4E>(v)); v = fmaxf(v, dppf<0x141>(v)); v = fmaxf(v, dppf<0x140>(v)); return v; }
__device__ __forceinline__ int g16_sum_i(int v) { v += dppi<0xB1>(v); v += dppi<0x4E>(v); v += dppi<0x141>(v); v += dppi<0x140>(v); return v; }
__device__ __forceinline__ int g16_min_i(int v) { v = min(v, dppi<0xB1>(v)); v = min(v, dppi<0x4E>(v)); v = min(v, dppi<0x141>(v)); v = min(v, dppi<0x140>(v)); return v; }
__device__ __forceinline__ float rlf(float v, int k) { return __int_as_float(__builtin_amdgcn_readlane(__float_as_int(v), k)); }
__device__ __forceinline__ float wave_sum(float v) { v = g16_sum(v); return (rlf(v, 0) + rlf(v, 16)) + (rlf(v, 32) + rlf(v, 48)); }
__device__ __forceinline__ float wave_max(float v) { v = g16_max(v); return fmaxf(fmaxf(rlf(v, 0), rlf(v, 16)), fmaxf(rlf(v, 32), rlf(v, 48))); }
__device__ __forceinline__ int wave_sum_i(int v) { v = g16_sum_i(v); return (__builtin_amdgcn_readlane(v, 0) + __builtin_amdgcn_readlane(v, 16)) + (__builtin_amdgcn_readlane(v, 32) + __builtin_amdgcn_readlane(v, 48)); }
__device__ __forceinline__ int wave_min_i(int v) { v = g16_min_i(v); return min(min(__builtin_amdgcn_readlane(v, 0), __builtin_amdgcn_readlane(v, 16)), min(__builtin_amdgcn_readlane(v, 32), __builtin_amdgcn_readlane(v, 48))); }
__device__ __forceinline__ float sigmoidf_(float x) { return 1.0f / (1.0f + expf(-x)); }
__device__ __forceinline__ float fsig(float x) { return __builtin_amdgcn_rcpf(1.0f + __expf(-x)); }
__device__ __forceinline__ float ftanh(float x) { return 2.0f * fsig(2.0f * x) - 1.0f; }
__device__ __forceinline__ int row_seq(int row) { return row < NP ? (row >> 12) : 4 + ((row - NP) >> 3); }
__device__ __forceinline__ int row_pos(int row) { return row < NP ? (row & 4095) : PAST + ((row - NP) & 7); }
__device__ __forceinline__ int TID() { int t = threadIdx.x; asm volatile("" : "+v"(t)); return t; }
__device__ __forceinline__ int BID() { int b = blockIdx.x; asm volatile("" : "+s"(b)); return b; }
__device__ __forceinline__ void wave_lds_fence() { __builtin_amdgcn_fence(__ATOMIC_RELEASE, "wavefront"); __builtin_amdgcn_wave_barrier(); __builtin_amdgcn_fence(__ATOMIC_ACQUIRE, "wavefront"); }

#define XB_TMO      128
#define XB_XCNT(j)  (256  + 64 * (j))
#define XB_XSUB(j)  (1280 + 64 * (j))
#define XB_XGEN(j)  (2304 + 64 * (j))
#define XB_TOP      3328
#define XB_TOPGEN   3392
#define XCD_BAR_WORDS 3456
#define XB_SPIN_CAP (1u << 22)
__device__ __forceinline__ unsigned xb_ld(unsigned* p)              { return __hip_atomic_load(p, __ATOMIC_RELAXED, __HIP_MEMORY_SCOPE_AGENT); }
__device__ __forceinline__ unsigned xb_add(unsigned* p, unsigned v) { return __hip_atomic_fetch_add(p, v, __ATOMIC_RELAXED, __HIP_MEMORY_SCOPE_AGENT); }
__device__ __forceinline__ unsigned xb_xcc_id() { return (unsigned)__builtin_amdgcn_s_getreg((3 << 11) | 20) & 0xFu; }
#define XB_SPIN(cond, bar) do { unsigned _sp = 0; while (cond) { __builtin_amdgcn_s_sleep(1); \
    if ((++_sp & 255u) == 0u) { if (xb_ld(&(bar)[XB_TMO])) break; if (_sp > XB_SPIN_CAP) { atomicAdd(&(bar)[XB_TMO], 1u); break; } } } } while (0)
struct XcdBarrier { unsigned* bar; unsigned x; volatile LAS unsigned* st; };
__device__ __forceinline__ XcdBarrier xcd_barrier_post(unsigned* bar, volatile LAS unsigned* st) {
    XcdBarrier b; b.bar = bar; b.x = xb_xcc_id(); b.st = st;
    if (threadIdx.x == 0) (void)xb_add(&bar[XB_XCNT(b.x)], 1u);
    return b;
}
__device__ __forceinline__ void xcd_barrier_complete(unsigned* bar, unsigned x, unsigned& nloc, unsigned& nx) {
    const unsigned G = gridDim.x * gridDim.y * gridDim.z;
    unsigned sum, cnt, mine, sp = 0u;
    for (;;) {
        sum = 0u; cnt = 0u; mine = 0u;
#pragma unroll
        for (unsigned j = 0; j < 16; ++j) { const unsigned c = xb_ld(&bar[XB_XCNT(j)]); sum += c; cnt += (c > 0u) ? 1u : 0u; mine = (j == x) ? c : mine; }
        if (sum == G) break;
        __builtin_amdgcn_s_sleep(1);
        if ((++sp & 255u) == 0u) { if (xb_ld(&bar[XB_TMO])) break; if (sp > XB_SPIN_CAP) { atomicAdd(&bar[XB_TMO], 1u); break; } }
    }
    nloc = mine > 0u ? mine : 1u; nx = cnt > 0u ? cnt : 1u;
}
__device__ __forceinline__ void xcd_barrier(const XcdBarrier& b) {
    asm volatile("s_waitcnt vmcnt(0)" ::: "memory");
    __syncthreads();
    if (threadIdx.x == 0) {
        unsigned* bar = b.bar;
        __builtin_amdgcn_s_waitcnt(0);
        unsigned nloc = b.st[0], nx = b.st[1];
        if (nloc == 0u) { xcd_barrier_complete(bar, b.x, nloc, nx); b.st[0] = nloc; b.st[1] = nx; }
        const unsigned old = xb_add(&bar[XB_XSUB(b.x)], 1u);
        const unsigned gen = old / nloc;
        if (old + 1u == (gen + 1u) * nloc) {
            __builtin_amdgcn_fence(__ATOMIC_RELEASE, "agent");
            asm volatile("s_waitcnt vmcnt(0)" ::: "memory");
            const unsigned og = xb_add(&bar[XB_TOP], 1u);
            const unsigned tg = og / nx;
            if (og + 1u == (tg + 1u) * nx) xb_add(&bar[XB_TOPGEN], 1u);
            else XB_SPIN(xb_ld(&bar[XB_TOPGEN]) == tg, bar);
            __builtin_amdgcn_fence(__ATOMIC_ACQUIRE, "agent");
            xb_add(&bar[XB_XGEN(b.x)], 1u);
            asm volatile("s_waitcnt vmcnt(0)" ::: "memory");
        } else {
            XB_SPIN(xb_ld(&bar[XB_XGEN(b.x)]) == gen, bar);
            __builtin_amdgcn_fence(__ATOMIC_ACQUIRE, "agent");
            asm volatile("s_waitcnt vmcnt(0)" ::: "memory");
        }
    }
    __syncthreads();
}

struct P {
    const float *x_prompt, *x_sample, *cache_k, *cache_v, *cache_ik, *state_wkv, *state_shift; const int* page_table;
    const float *c_prompt, *c_sample, *norm_g, *w_ada, *b_ada, *w_up, *w_down, *rw_mix, *rw_w_rkv, *rw_w_o, *rw_w0, *rw_w1, *rw_w2, *rw_a0, *rw_a1, *rw_a2,
                *rw_v0, *rw_v1, *rw_v2, *rw_g1, *rw_g2, *rw_k_k, *rw_k_a, *rw_r_k, *rw_lnx_w, *rw_lnx_b, *att_w_in, *att_w_o, *att_q_norm, *att_k_norm, *idx_k_norm;
    float* out; unsigned char* ws; int ph_lo, ph_hi;
};
typedef const P __attribute__((address_space(4)))* KP;
#define WSP(T, off) ((T*)(p->ws + (off)))
__device__ __forceinline__ KP kargs() { KP k = (KP)__builtin_amdgcn_kernarg_segment_ptr(); asm volatile("" : "+s"(k)); return k; }

namespace pg8 {
constexpr int BM = 256, BK = 64, HALF = 128, HTB = HALF * BK * 2, STAGE_BYTES = 8 * HTB, NXCD = 8, WGM = 8;
__device__ __forceinline__ int lds_byte(int r, int c) { const int st = (r >> 4) * 2 + (c >> 5), rr = r & 15, cc = c & 31, ob = rr * 64 + cc * 2; return st * 1024 + (ob ^ (((ob >> 9) & 1) << 5)); }
__device__ __forceinline__ void stage_rc(int b, int& R, int& C) { const int st = b / 1024, sb = b % 1024, swz = sb ^ (((sb >> 9) & 1) << 5); R = (st >> 1) * 16 + swz / 64; C = (st & 1) * 32 + (swz % 64) / 2; }
__device__ __forceinline__ int perm32(int rho) { const int n = rho >> 4, i = rho & 15; return 8 * (i >> 2) + 4 * n + (i & 3); }
struct Unit { int pm, pn; };
struct Gemm { const bf16_t* A; const bf16_t* Bt; int M, N, K, mode; size_t agrp; };
__device__ __forceinline__ int phys_pn(const Gemm& g, int pn) { return (g.mode == 2 && pn >= 12) ? pn + 1 : pn; }
__device__ __forceinline__ const char* a_ptr(const Gemm& g, const Unit& u, size_t tstep) {
    int grp = 0; if (g.mode) grp = u.pn < 12 ? (u.pn >> 2) : (u.pn == 12 ? 2 : u.pn - 10);
    return (const char*)g.A + (size_t)grp * g.agrp * 2 + (size_t)u.pm * tstep; }
struct StaticOrder {
    int nM, nN, nwg, G, c;
    __device__ void init(int M, int N, int G_, int c_) { nM = M / BM; nN = N / BM; nwg = nM * nN; G = G_; c = c_; }
    __device__ bool next(int i, Unit& u) const {
        const long L = (long)i * G + c; if (L >= nwg) return false;
        int wgid = (int)L; { const int q = nwg / NXCD, r = nwg % NXCD, xcd = wgid % NXCD, off = wgid / NXCD; wgid = (xcd < r ? xcd * (q + 1) : r * (q + 1) + (xcd - r) * q) + off; }
        const int nig = WGM * nN, gid = wgid / nig, fm = gid * WGM, gsz = (nM - fm) < WGM ? (nM - fm) : WGM;
        u.pm = fm + ((wgid % nig) % gsz); u.pn = (wgid % nig) / gsz; return true;
    }
};
template <class F, bool PERM_> struct EpiAdapt {
    static constexpr bool PERM = PERM_;
    F f;
    __device__ __forceinline__ void operator()(const f32x4 (&acc)[2][2][4][2], const Unit& u, int wr, int wc, int fr, int fq) const {
        const int row0 = u.pm * BM + wr * 64 + fr, col0 = u.pn * BM + wc * 32 + (PERM ? 8 * fq : 4 * fq);
#pragma unroll
        for (int ai = 0; ai < 2; ++ai)
#pragma unroll
            for (int m = 0; m < 4; ++m)
#pragma unroll
                for (int bj = 0; bj < 2; ++bj) {
                    if constexpr (PERM) f.vec8(row0 + ai * HALF + m * 16, col0 + bj * HALF, acc[ai][bj][m][0], acc[ai][bj][m][1]);
                    else {
#pragma unroll
                        for (int n = 0; n < 2; ++n) f.vec4(row0 + ai * HALF + m * 16, col0 + bj * HALF + 16 * n, acc[ai][bj][m][n]);
                    }
                }
    }
};

template <class Epi>
__device__ __forceinline__ void gemm_phase(LAS unsigned char* lds, const Gemm g, const StaticOrder& S, const Epi& E) {
    const int tid = TID(), wid = __builtin_amdgcn_readfirstlane(tid >> 6), lane = tid & 63, wr = wid >> 2, wc = wid & 3, fr = lane & 15, fq = lane >> 4;
    const int K = g.K, nt = K / BK;
    unsigned voffA[2], voffB[2];
#pragma unroll
    for (int i = 0; i < 2; ++i) { int R, C; stage_rc(tid * 16 + i * 8192, R, C); const int Rb = Epi::PERM ? ((R & ~31) + perm32(R & 31)) : R;
        voffA[i] = (unsigned)(R * K + C) * 2u; voffB[i] = (unsigned)(Rb * K + C) * 2u; }
    const size_t kstep = (size_t)(BK * 2);
    const size_t hstep = (size_t)HALF * K * 2;
    const size_t tstep = 2 * hstep;
    const unsigned ldsw = (unsigned)wid * 1024u;
    const int aoff = lds_byte(wr * 64 + fr, fq * 8), boff = lds_byte(wc * 32 + fr, fq * 8);
#define PG8_SA(b, h) (((b) * 2 + (h)) * HTB)
#define PG8_SB(b, h) ((4 + (b) * 2 + (h)) * HTB)
#define PG8_STAGE(bufoff, gbase, voff) do { _Pragma("unroll") for (int _i = 0; _i < 2; ++_i) \
        __builtin_amdgcn_global_load_lds((const unsigned*)((const char*)(gbase) + (voff)[_i]), (LAS unsigned*)(lds + (bufoff) + ldsw + _i * 8192), 16, 0, 0); } while (0)
#define PG8_LDA(dst, b, h) do { _Pragma("unroll") for (int m = 0; m < 4; ++m) _Pragma("unroll") for (int k = 0; k < 2; ++k) dst[m][k] = *(const LAS bf16x8*)(lds + PG8_SA(b, h) + aoff + m * 2048 + k * 1024); } while (0)
#define PG8_LDB(dst, b, h) do { _Pragma("unroll") for (int n = 0; n < 2; ++n) _Pragma("unroll") for (int k = 0; k < 2; ++k) dst[n][k] = *(const LAS bf16x8*)(lds + PG8_SB(b, h) + boff + n * 2048 + k * 1024); } while (0)
#define PG8_MMA(ai, bj, At, Bt) do { __builtin_amdgcn_s_setprio(1); _Pragma("unroll") for (int m = 0; m < 4; ++m) _Pragma("unroll") for (int n = 0; n < 2; ++n) _Pragma("unroll") for (int k = 0; k < 2; ++k) \
        acc[ai][bj][m][n] = __builtin_amdgcn_mfma_f32_16x16x32_bf16(Bt[n][k], At[m][k], acc[ai][bj][m][n], 0, 0, 0); __builtin_amdgcn_s_setprio(0); } while (0)
#define PG8_WAIT_V(n) asm volatile("s_waitcnt vmcnt(" #n ")" ::: "memory")
#define PG8_WAIT_L(n) asm volatile("s_waitcnt lgkmcnt(" #n ")" ::: "memory")
#define PG8_BAR __builtin_amdgcn_s_barrier()
#define PG8_SCHED __builtin_amdgcn_sched_barrier(0)
    Unit cur, nxt; int ui = 0;
    if (!S.next(0, cur)) return;
    cur.pn = phys_pn(g, cur.pn);
    f32x4 acc[2][2][4][2];
#pragma unroll
    for (int a = 0; a < 2; ++a)
#pragma unroll
        for (int b = 0; b < 2; ++b)
#pragma unroll
            for (int m = 0; m < 4; ++m)
#pragma unroll
                for (int n = 0; n < 2; ++n) acc[a][b][m][n] = (f32x4){0.f, 0.f, 0.f, 0.f};
    bf16x8 At[4][2], B0[2][2], B1[2][2];
    const char* cA = a_ptr(g, cur, tstep); const char* cB = (const char*)g.Bt + (size_t)cur.pn * tstep;
    PG8_STAGE(PG8_SB(0, 0), cB, voffB); PG8_STAGE(PG8_SA(0, 0), cA, voffA); PG8_STAGE(PG8_SB(0, 1), cB + hstep, voffB); PG8_STAGE(PG8_SA(0, 1), cA + hstep, voffA);
    if (wr == 1) PG8_BAR;
    PG8_WAIT_V(4); PG8_BAR;
    PG8_STAGE(PG8_SB(1, 0), cB + kstep, voffB); PG8_STAGE(PG8_SA(1, 0), cA + kstep, voffA); PG8_STAGE(PG8_SB(1, 1), cB + hstep + kstep, voffB);
    PG8_WAIT_V(6); PG8_BAR;
    for (;;) {
        const bool has_next = S.next(ui + 1, nxt);
        if (has_next) nxt.pn = phys_pn(g, nxt.pn);
        const char* nA = has_next ? a_ptr(g, nxt, tstep) : cA; const char* nB = has_next ? (const char*)g.Bt + (size_t)nxt.pn * tstep : cB;
        for (int t = 0; t < nt; t += 2) {
            const bool last = (t == nt - 2);
            const char* a1 = cA + (size_t)(t + 1) * kstep;
            const char* a2 = last ? nA : cA + (size_t)(t + 2) * kstep; const char* b2 = last ? nB : cB + (size_t)(t + 2) * kstep;
            const char* a3 = a2 + kstep; const char* b3 = b2 + kstep;
            PG8_LDB(B0, 0, 0); PG8_SCHED; PG8_LDA(At, 0, 0); PG8_STAGE(PG8_SA(1, 1), a1 + hstep, voffA);
            PG8_WAIT_L(8); PG8_BAR; PG8_WAIT_L(0); PG8_MMA(0, 0, At, B0); PG8_BAR; PG8_SCHED;
            PG8_LDB(B1, 0, 1); PG8_STAGE(PG8_SB(0, 0), b2, voffB);
            PG8_BAR; PG8_WAIT_L(0); PG8_MMA(0, 1, At, B1); PG8_BAR;
            PG8_LDA(At, 0, 1); PG8_STAGE(PG8_SA(0, 0), a2, voffA);
            PG8_BAR; PG8_WAIT_L(0); PG8_MMA(1, 0, At, B0); PG8_BAR; PG8_SCHED;
            PG8_STAGE(PG8_SB(0, 1), b2 + hstep, voffB);
            PG8_WAIT_V(6); PG8_BAR; PG8_MMA(1, 1, At, B1); PG8_BAR;
            PG8_LDB(B0, 1, 0); PG8_SCHED; PG8_LDA(At, 1, 0); PG8_STAGE(PG8_SA(0, 1), a2 + hstep, voffA);
            PG8_WAIT_L(8); PG8_BAR; PG8_WAIT_L(0); PG8_MMA(0, 0, At, B0); PG8_BAR; PG8_SCHED;
            PG8_LDB(B1, 1, 1); PG8_STAGE(PG8_SB(1, 0), b3, voffB);
            PG8_BAR; PG8_WAIT_L(0); PG8_MMA(0, 1, At, B1); PG8_BAR;
            PG8_LDA(At, 1, 1); PG8_STAGE(PG8_SA(1, 0), a3, voffA);
            PG8_BAR; PG8_WAIT_L(0); PG8_MMA(1, 0, At, B0); PG8_BAR; PG8_SCHED;
            PG8_STAGE(PG8_SB(1, 1), b3 + hstep, voffB);
            PG8_WAIT_V(6); PG8_BAR; PG8_MMA(1, 1, At, B1); PG8_BAR;
        }
        E(acc, cur, wr, wc, fr, fq);
        if (!has_next) break;
#pragma unroll
        for (int a = 0; a < 2; ++a)
#pragma unroll
            for (int b = 0; b < 2; ++b)
#pragma unroll
                for (int m = 0; m < 4; ++m)
#pragma unroll
                    for (int n = 0; n < 2; ++n) acc[a][b][m][n] = (f32x4){0.f, 0.f, 0.f, 0.f};
        cur = nxt; cA = nA; cB = nB; ++ui;
    }
    PG8_WAIT_V(0);
    if (wr == 0) PG8_BAR;
    PG8_BAR;
#undef PG8_SA
#undef PG8_SB
#undef PG8_STAGE
#undef PG8_LDA
#undef PG8_LDB
#undef PG8_MMA
#undef PG8_WAIT_V
#undef PG8_WAIT_L
#undef PG8_BAR
#undef PG8_SCHED
}
}

template <class F>
__device__ __forceinline__ void sgemm_bf(LAS unsigned char* lds, const bf16_t* A, int lda, int row0, int M, const float* W, int ldw, int N, int K, int coloff, const F& f) {
    LAS float* As = (LAS float*)lds;
    LAS float* Ws = (LAS float*)(lds + 32 * 68 * 4);
    const int tid = TID(), ty = tid >> 4, tx = tid & 15;
    const int ntn = (N + 63) / 64, ntiles = (M / 64) * ntn;
    for (int tile = BID(); tile < ntiles; tile += gridDim.x) {
        const int tm = tile / ntn, tn = tile % ntn, r0 = row0 + tm * 64, n0 = tn * 64;
        f32x4 c0 = {0.f, 0.f, 0.f, 0.f}, c1 = {0.f, 0.f, 0.f, 0.f};
        for (int k0 = 0; k0 < K; k0 += 32) {
            __syncthreads();
            { const int r = tid >> 3, q = tid & 7; const f32x4 a = ld_bf4(A + (size_t)(r0 + r) * lda + k0 + 4 * q);
              As[(4 * q + 0) * 68 + r] = a[0]; As[(4 * q + 1) * 68 + r] = a[1]; As[(4 * q + 2) * 68 + r] = a[2]; As[(4 * q + 3) * 68 + r] = a[3]; }
            { const int kr = tid >> 4, c = tid & 15; f32x4 w = {0.f, 0.f, 0.f, 0.f}; if (n0 + 4 * c < N) w = *(const f32x4*)(W + (size_t)(k0 + kr) * ldw + n0 + 4 * c);
              *(LAS f32x4*)(Ws + kr * 68 + 4 * c) = w; }
            __syncthreads();
#pragma unroll 8
            for (int kk = 0; kk < 32; ++kk) {
                const f32x2 a = *(const LAS f32x2*)(As + kk * 68 + 2 * ty); const f32x4 b = *(const LAS f32x4*)(Ws + kk * 68 + 4 * tx);
                c0 += a.x * b; c1 += a.y * b;
            }
        }
        if (n0 + 4 * tx < N) { f.vec4(r0 + 2 * ty, n0 + 4 * tx + coloff, c0); f.vec4(r0 + 2 * ty + 1, n0 + 4 * tx + coloff, c1); }
    }
    __syncthreads();
}

typedef float f32x16 __attribute__((ext_vector_type(16)));
__device__ __forceinline__ int rw_group(int n0) { const int t = n0 >> 8; return t < 12 ? (t >> 2) : (t == 12 ? 2 : t - 10); }
template <bool RWGRP, class F>
__device__ __forceinline__ void wgemm_ks(LAS unsigned char* lds, const bf16_t* A, int lda, size_t agrp, int row0, int M, const bf16_t* Bt, int K, int N, const F& f, int wg0 = 0) {
    const int tid = TID(), wave = tid >> 6, lane = tid & 63, lr = lane & 31, lh = lane >> 5;
    LAS float* red = (LAS float*)lds;
    const int ntn = N / 64, nitems = (M / 32) * ntn, kw = K / 8, steps = kw / 16;
    const int vb_ = BID() - wg0, nwg_ = (int)gridDim.x - wg0;
    for (int item = vb_ < 0 ? nitems : vb_; item < nitems; item += nwg_) {
        const int tm = item / ntn, tn = item % ntn, r0 = row0 + tm * 32, n0 = tn * 64;
        const bf16_t* Ab = A + (RWGRP ? (size_t)rw_group(n0) * agrp : 0) + (size_t)(r0 + lr) * lda + wave * kw + lh * 8;
        const bf16_t* B0 = Bt + (size_t)(n0 + lr) * K + wave * kw + lh * 8; const bf16_t* B1 = B0 + (size_t)32 * K;
        f32x16 acc0, acc1;
#pragma unroll
        for (int r = 0; r < 16; ++r) { acc0[r] = 0.f; acc1[r] = 0.f; }
#pragma unroll 8
        for (int st = 0; st < steps; ++st) {
            const bf16x8 a = *(const bf16x8*)(Ab + 16 * st), b0 = *(const bf16x8*)(B0 + 16 * st), b1 = *(const bf16x8*)(B1 + 16 * st);
            acc0 = __builtin_amdgcn_mfma_f32_32x32x16_bf16(b0, a, acc0, 0, 0, 0);
            acc1 = __builtin_amdgcn_mfma_f32_32x32x16_bf16(b1, a, acc1, 0, 0, 0);
        }
        __syncthreads();
#pragma unroll
        for (int r = 0; r < 16; ++r) { red[((wave * 2 + 0) * 16 + r) * 64 + lane] = acc0[r]; red[((wave * 2 + 1) * 16 + r) * 64 + lane] = acc1[r]; }
        __syncthreads();
        { const int t = tid >> 8, r4 = (tid >> 6) & 3, l2 = tid & 63; f32x4 v = {0.f, 0.f, 0.f, 0.f};
#pragma unroll
          for (int w = 0; w < 8; ++w)
#pragma unroll
              for (int e = 0; e < 4; ++e) v[e] += red[((w * 2 + t) * 16 + 4 * r4 + e) * 64 + l2];
          f.vec4(r0 + (l2 & 31), n0 + 32 * t + 8 * r4 + 4 * (l2 >> 5), v); }
    }
    __syncthreads();
}
template <class F>
__device__ __forceinline__ void wgemm_w(const bf16_t* A, int lda, int row0, int M, const bf16_t* Bt, int K, int N, const F& f) {
    const int lane = TID() & 63, lr = lane & 31, lh = lane >> 5, gw = BID() * 8 + (TID() >> 6), nw = gridDim.x * 8;
    const int ntn = N / 64, nitems = (M / 32) * ntn, steps = K / 16;
    for (int item = gw; item < nitems; item += nw) {
        const int tm = item / ntn, tn = item % ntn, r0 = row0 + tm * 32, n0 = tn * 64;
        const bf16_t* Ab = A + (size_t)(r0 + lr) * lda + lh * 8;
        const bf16_t* B0 = Bt + (size_t)(n0 + lr) * K + lh * 8; const bf16_t* B1 = B0 + (size_t)32 * K;
        f32x16 acc0, acc1;
#pragma unroll
        for (int r = 0; r < 16; ++r) { acc0[r] = 0.f; acc1[r] = 0.f; }
        for (int st = 0; st < steps; ++st) {
            const bf16x8 a = *(const bf16x8*)(Ab + 16 * st), b0 = *(const bf16x8*)(B0 + 16 * st), b1 = *(const bf16x8*)(B1 + 16 * st);
            acc0 = __builtin_amdgcn_mfma_f32_32x32x16_bf16(b0, a, acc0, 0, 0, 0);
            acc1 = __builtin_amdgcn_mfma_f32_32x32x16_bf16(b1, a, acc1, 0, 0, 0);
        }
#pragma unroll
        for (int r4 = 0; r4 < 4; ++r4) {
            f.vec4(r0 + lr, n0 + 8 * r4 + 4 * lh, (f32x4){acc0[4 * r4], acc0[4 * r4 + 1], acc0[4 * r4 + 2], acc0[4 * r4 + 3]});
            f.vec4(r0 + lr, n0 + 32 + 8 * r4 + 4 * lh, (f32x4){acc1[4 * r4], acc1[4 * r4 + 1], acc1[4 * r4 + 2], acc1[4 * r4 + 3]});
        }
    }
}

struct FRwkvIn {
    bf16_t *rb, *kb, *vb, *tw, *ta, *tv, *tg;
    __device__ __forceinline__ void vec8(int row, int col, f32x4 a, f32x4 b) const {
        if (col < 3072) { u32x4 w; w.x = pk_bf16(a[0], a[1]); w.y = pk_bf16(a[2], a[3]); w.z = pk_bf16(b[0], b[1]); w.w = pk_bf16(b[2], b[3]);
            *(u32x4*)(rb + (size_t)(col >> 10) * XR_STRIDE + (size_t)row * D + (col & 1023)) = w; }
        else { vec4(row, col, a); vec4(row, col + 4, b); } }
    __device__ __forceinline__ void vec4(int row, int col, f32x4 v) const {
        if (col < 3072) { st_bf4(rb + (size_t)(col >> 10) * XR_STRIDE + (size_t)row * D + (col & 1023), v); }
        else if (col < 3328) { const int c = col - 3072; if (c < 32) st_bf4(tv + (size_t)row * 32 + c, v); }
        else if (col < 3584) { const int c = col - 3328; if (c < 64) { f32x4 t = {ftanh(v[0]), ftanh(v[1]), ftanh(v[2]), ftanh(v[3])}; st_bf4(tw + (size_t)row * 64 + c, t); } }
        else if (col < 3840) { const int c = col - 3584; if (c < 64) st_bf4(ta + (size_t)row * 64 + c, v); }
        else { const int c = col - 3840; if (c < 160) { f32x4 t = {fsig(v[0]), fsig(v[1]), fsig(v[2]), fsig(v[3])}; st_bf4(tg + (size_t)row * 160 + c, t); } }
    }
};
struct FStoreF32 { float* C; int ldc; int ncols; __device__ __forceinline__ void vec4(int row, int col, f32x4 v) const { if (col < ncols) *(f32x4*)(C + (size_t)row * ldc + col) = v; } };
struct FStoreBf16 { bf16_t* C; int ldc; int ncols;
    __device__ __forceinline__ void vec4(int row, int col, f32x4 v) const { if (col < ncols) st_bf4(C + (size_t)row * ldc + col, v); }
    __device__ __forceinline__ void vec8(int row, int col, f32x4 a, f32x4 b) const { if (col < ncols) { u32x4 w; w.x = pk_bf16(a[0], a[1]); w.y = pk_bf16(a[2], a[3]); w.z = pk_bf16(b[0], b[1]); w.w = pk_bf16(b[2], b[3]); *(u32x4*)(C + (size_t)row * ldc + col) = w; } } };
struct FResid {
    float* X; const float* gate;
    const float* xin_p; const float* xin_s;
    __device__ __forceinline__ void vec4(int row, int col, f32x4 v) const {
        const f32x4 g = *(const f32x4*)(gate + (size_t)row_seq(row) * 6144 + col); float* xp = X + (size_t)row * D + col;
        const float* ip = xin_p ? (row < NP ? xin_p + (size_t)row * D + col : xin_s + (size_t)(row - NP) * D + col) : xp;
        const f32x4 x = *(const f32x4*)ip; *(f32x4*)xp = x + g * v; }
};
struct FRelu2 { bf16_t* U;
    __device__ __forceinline__ void vec8(int row, int col, f32x4 a, f32x4 b) const {
        f32x4 s, t; for (int e = 0; e < 4; ++e) { const float x = fmaxf(a[e], 0.f), y = fmaxf(b[e], 0.f); s[e] = x * x; t[e] = y * y; }
        u32x4 w; w.x = pk_bf16(s[0], s[1]); w.y = pk_bf16(s[2], s[3]); w.z = pk_bf16(t[0], t[1]); w.w = pk_bf16(t[2], t[3]); *(u32x4*)(U + (size_t)row * DFF + col) = w; }
    __device__ __forceinline__ void vec4(int row, int col, f32x4 v) const {
        f32x4 t; for (int e = 0; e < 4; ++e) { const float r = fmaxf(v[e], 0.f); t[e] = r * r; } st_bf4(U + (size_t)row * DFF + col, t); } };

__device__ __forceinline__ void phase_copy_x(KP p) {
    const size_t n4p = (size_t)NP * D / 4, n4 = (size_t)NT * D / 4;
    for (size_t i = (size_t)BID() * 512 + TID(); i < n4; i += (size_t)gridDim.x * 512)
        ((f32x4*)p->out)[i] = i < n4p ? ((const f32x4*)p->x_prompt)[i] : ((const f32x4*)p->x_sample)[i - n4p];
}

struct TJob { const float* src; bf16_t* dst; int K, N, drow0; };
__device__ __forceinline__ TJob tjob(KP p, int i) {
    TJob t; t.drow0 = 0;
    if (i < 4) { t.src = p->w_up + (size_t)i * D * DFF; t.dst = WSP(bf16_t, WS_WUP_T) + (size_t)i * DFF * D; t.K = D; t.N = DFF; return t; }
    if (i < 8) { const int l = i - 4; t.src = p->w_down + (size_t)l * DFF * D; t.dst = WSP(bf16_t, WS_WDN_T) + (size_t)l * DFF * D; t.K = DFF; t.N = D; return t; }
    i -= 8; const int j = i / 14, k = i % 14; bf16_t* wrw = WSP(bf16_t, WS_WRW_T) + (size_t)j * 4096 * D;
    t.K = D; t.N = D;
    switch (k) {
        case 0: case 1: case 2: t.src = p->rw_w_rkv + ((size_t)j * 3 + k) * D * D; t.dst = wrw; t.drow0 = k * 1024; break;
        case 3: t.src = p->rw_v1; t.dst = wrw; t.drow0 = 3072; t.N = j == 1 ? 32 : 0; break;
        case 4: t.src = p->rw_w1 + (size_t)j * D * 64; t.dst = wrw; t.drow0 = 3328; t.N = 64; break;
        case 5: t.src = p->rw_a1 + (size_t)j * D * 64; t.dst = wrw; t.drow0 = 3584; t.N = 64; break;
        case 6: t.src = p->rw_g1 + (size_t)j * D * 160; t.dst = wrw; t.drow0 = 3840; t.N = 160; break;
        case 7: t.src = p->rw_w_o + (size_t)j * D * D; t.dst = WSP(bf16_t, WS_WO_T) + (size_t)j * D * D; break;
        case 8: t.src = p->rw_w2 + (size_t)j * 64 * D; t.dst = WSP(bf16_t, WS_W2T) + (size_t)j * D * 64; t.K = 64; break;
        case 9: t.src = p->rw_a2 + (size_t)j * 64 * D; t.dst = WSP(bf16_t, WS_A2T) + (size_t)j * D * 64; t.K = 64; break;
        case 10: t.src = p->rw_g2 + (size_t)j * 160 * D; t.dst = WSP(bf16_t, WS_G2T) + (size_t)j * D * 160; t.K = 160; break;
        case 11: t.src = p->rw_v2; t.dst = WSP(bf16_t, WS_V2T); t.K = 32; t.N = j == 1 ? D : 0; break;
        case 12: t.src = p->att_w_in + (size_t)j * D * PIN; t.dst = WSP(bf16_t, WS_WIN_T) + (size_t)j * PINP * D; t.N = PIN; break;
        default: t.src = p->att_w_o + (size_t)j * D * D; t.dst = WSP(bf16_t, WS_WAO_T) + (size_t)j * D * D; break;
    }
    return t;
}
__device__ __forceinline__ int tjob_tiles(const TJob& t) { return ((t.K + 63) / 64) * ((t.N + 63) / 64); }
__device__ __forceinline__ void phase_weights(KP p, LAS unsigned char* lds) {
    LAS float* T = (LAS float*)lds;
    int total = 0;
    for (int i = 0; i < 36; ++i) total += tjob_tiles(tjob(p, i));
    const int ngrp = (total + 3) / 4;
    f32x4 v[4][2];
    bf16_t* dstn[4]; int Kn[4], nlim[4], klim[4];
#define WT_ISSUE(G_) do { const int tid_ = TID(), kk_ = tid_ >> 4, n4_ = (tid_ & 15) * 4; \
        int i_ = 0, start_ = 0, cnt_ = tjob_tiles(tjob(p, 0)); \
        _Pragma("unroll") for (int u = 0; u < 4; ++u) { const int gt_ = 4 * (G_) + u; \
            while (i_ < 35 && gt_ >= start_ + cnt_) { start_ += cnt_; ++i_; cnt_ = tjob_tiles(tjob(p, i_)); } \
            const TJob tj_ = tjob(p, i_); const int lt_ = gt_ - start_, nkt_ = (tj_.K + 63) / 64; \
            const bool dead_ = gt_ >= total || lt_ >= cnt_; const int k0_ = dead_ ? 0 : (lt_ % nkt_) * 64, n0_ = dead_ ? 0 : (lt_ / nkt_) * 64; \
            dstn[u] = tj_.dst + (size_t)(tj_.drow0 + n0_) * tj_.K + k0_; Kn[u] = tj_.K; nlim[u] = dead_ ? 0 : tj_.N - n0_; klim[u] = dead_ ? 0 : tj_.K - k0_; \
            _Pragma("unroll") for (int hh = 0; hh < 2; ++hh) { const int k_ = k0_ + kk_ + 32 * hh, n_ = n0_ + n4_; \
                v[u][hh] = *(const f32x4*)(tj_.src + (size_t)min(k_, tj_.K - 1) * tj_.N + min(n_, tj_.N - 4)); } } } while (0)
    if (BID() < ngrp) WT_ISSUE(BID());
    for (int g = BID(); g < ngrp; g += gridDim.x) {
        const int tid = TID(), kk = tid >> 4, n4 = (tid & 15) * 4;
#pragma unroll
        for (int u = 0; u < 4; ++u)
#pragma unroll
            for (int hh = 0; hh < 2; ++hh)
#pragma unroll
                for (int e = 0; e < 4; ++e) T[(u * 64 + kk + 32 * hh) * 65 + n4 + e] = v[u][hh][e];
        bf16_t* dstc[4]; int Kc[4], nl[4], kl[4];
#pragma unroll
        for (int u = 0; u < 4; ++u) { dstc[u] = dstn[u]; Kc[u] = Kn[u]; nl[u] = nlim[u]; kl[u] = klim[u]; }
        if (g + (int)gridDim.x < ngrp) WT_ISSUE(g + (int)gridDim.x);
        asm volatile("s_waitcnt lgkmcnt(0)" ::: "memory"); __builtin_amdgcn_s_barrier(); asm volatile("" ::: "memory");
        const int nn = tid >> 3, k8 = (tid & 7) * 8;
#pragma unroll
        for (int u = 0; u < 4; ++u) {
            if (nn < nl[u] && k8 < kl[u]) {
                u32x4 w;
                w.x = pk_bf16(T[(u * 64 + k8 + 0) * 65 + nn], T[(u * 64 + k8 + 1) * 65 + nn]); w.y = pk_bf16(T[(u * 64 + k8 + 2) * 65 + nn], T[(u * 64 + k8 + 3) * 65 + nn]);
                w.z = pk_bf16(T[(u * 64 + k8 + 4) * 65 + nn], T[(u * 64 + k8 + 5) * 65 + nn]); w.w = pk_bf16(T[(u * 64 + k8 + 6) * 65 + nn], T[(u * 64 + k8 + 7) * 65 + nn]);
                *(u32x4*)(dstc[u] + (size_t)nn * Kc[u] + k8) = w;
            }
        }
        asm volatile("s_waitcnt lgkmcnt(0)" ::: "memory"); __builtin_amdgcn_s_barrier(); asm volatile("" ::: "memory");
    }
#undef WT_ISSUE
    __syncthreads();
}

__device__ __forceinline__ void phase_ada(KP p, LAS unsigned char* lds) {
    float* mods = WSP(float, WS_MODS);
    LAS float* red = (LAS float*)lds;
    const int tid = TID(), lane = tid & 63, w = tid >> 6, ln = lane & 15, lq = lane >> 4;
    float af[3][32];
#pragma unroll
    for (int m = 0; m < 3; ++m) {
        const int s = 16 * m + ln; const bool ok = s < 36;
        const float* cp = s < 4 ? p->c_prompt + (size_t)s * D : p->c_sample + (size_t)((ok ? s : 35) - 4) * D;
#pragma unroll
        for (int i = 0; i < 32; ++i) { const float cv = cp[128 * w + 4 * i + lq]; af[m][i] = ok ? cv * __builtin_amdgcn_rcpf(1.0f + __expf(-cv)) : 0.f; }
    }
    f32x2 wv[32];
#define ADA_LOAD(B_) do { const int l_ = (B_) / 192, cb_ = ((B_) % 192) * 32; const float* wp_ = p->w_ada + ((size_t)l_ * D + 128 * w + lq) * 6144 + cb_ + 2 * ln; \
        _Pragma("unroll") for (int i = 0; i < 32; ++i) wv[i] = *(const f32x2*)(wp_ + (size_t)(4 * i) * 6144); } while (0)
    if (BID() < 768) ADA_LOAD(BID());
    for (int B = BID(); B < 768; B += gridDim.x) {
        const int l = B / 192, cb = (B % 192) * 32;
        f32x4 acc[3][2];
#pragma unroll
        for (int m = 0; m < 3; ++m) { acc[m][0] = (f32x4){0.f, 0.f, 0.f, 0.f}; acc[m][1] = acc[m][0]; }
#pragma unroll
        for (int i = 0; i < 32; ++i)
#pragma unroll
            for (int m = 0; m < 3; ++m) {
                acc[m][0] = __builtin_amdgcn_mfma_f32_16x16x4f32(af[m][i], wv[i][0], acc[m][0], 0, 0, 0);
                acc[m][1] = __builtin_amdgcn_mfma_f32_16x16x4f32(af[m][i], wv[i][1], acc[m][1], 0, 0, 0);
            }
        if (B + (int)gridDim.x < 768) ADA_LOAD(B + (int)gridDim.x);
#pragma unroll
        for (int m = 0; m < 3; ++m)
#pragma unroll
            for (int r = 0; r < 4; ++r) { const int s = 16 * m + 4 * lq + r;
                if (s < 36) *(LAS f32x2*)(red + (w * 36 + s) * 32 + 2 * ln) = (f32x2){acc[m][0][r], acc[m][1][r]}; }
        asm volatile("s_waitcnt lgkmcnt(0)" ::: "memory"); __builtin_amdgcn_s_barrier(); asm volatile("" ::: "memory");
        for (int o = tid; o < 36 * 32; o += 512) { const int s = o >> 5, cc = o & 31;
            float v = 0.f;
#pragma unroll
            for (int ww = 0; ww < 8; ++ww) v += red[(ww * 36 + s) * 32 + cc];
            mods[((size_t)l * 36 + s) * 6144 + cb + cc] = v + p->b_ada[l * 6144 + cb + cc]; }
        asm volatile("s_waitcnt lgkmcnt(0)" ::: "memory"); __builtin_amdgcn_s_barrier(); asm volatile("" ::: "memory");
    }
#undef ADA_LOAD
    __syncthreads();
}

template <bool MIX>
__device__ __forceinline__ void phase_prep(KP p, int layer, int which, int j, bool first = false) {
    const float* X = p->out;
    const float* mods = WSP(float, WS_MODS) + (size_t)layer * 36 * 6144;
    const float* g = p->norm_g + (layer * 2 + which) * D;
    bf16_t* XR = WSP(bf16_t, WS_XR);
    const int lane = TID() & 63, gw = BID() * 8 + (TID() >> 6), nw = gridDim.x * 8;
    for (int run = gw; run < NT / 8; run += nw) {
        const int row0 = run * 8, seq = row_seq(row0);
        const float* sh = mods + (size_t)seq * 6144 + (which ? 3 : 0) * D; const float* sc = sh + D;
        f32x4 gv[4], scv[4], shv[4], hp[4];
#pragma unroll
        for (int i = 0; i < 4; ++i) { const int col = 512 * (i >> 1) + 8 * lane + 4 * (i & 1); gv[i] = *(const f32x4*)(g + col); scv[i] = *(const f32x4*)(sc + col) + 1.0f; shv[i] = *(const f32x4*)(sh + col); hp[i] = (f32x4){0.f, 0.f, 0.f, 0.f}; }
        int rstart = 0;
        if (MIX) {
            if (row0 >= NP) {
#pragma unroll
                for (int i = 0; i < 4; ++i) hp[i] = *(const f32x4*)(p->state_shift + ((size_t)j * 32 + (seq - 4)) * D + 512 * (i >> 1) + 8 * lane + 4 * (i & 1));
            } else if ((row0 & 4095) != 0) rstart = -1;
        }
        for (int r = rstart; r < 8; ++r) {
            const int row = row0 + r;
            f32x4 x[4]; float ss = 0.f;
            const float* xr = first ? (row < NP ? p->x_prompt + (size_t)row * D : p->x_sample + (size_t)(row - NP) * D) : X + (size_t)row * D;
#pragma unroll
            for (int i = 0; i < 4; ++i) { x[i] = *(const f32x4*)(xr + 512 * (i >> 1) + 8 * lane + 4 * (i & 1)); ss += x[i][0] * x[i][0] + x[i][1] * x[i][1] + x[i][2] * x[i][2] + x[i][3] * x[i][3]; }
            ss = wave_sum(ss);
            const float rstd = rsqrtf(ss * (1.0f / 1024.0f) + 1e-6f);
            f32x4 h[4];
#pragma unroll
            for (int i = 0; i < 4; ++i) h[i] = x[i] * rstd * gv[i] * scv[i] + shv[i];
            if (MIX) {
                if (r >= 0) {
#pragma unroll
                    for (int n = 0; n < 6; ++n) {
                        const int mi = n == 0 ? 0 : (n == 1 ? 2 : (n == 2 ? 3 : (n == 3 ? 1 : n)));
                        const float* mx = p->rw_mix + ((size_t)j * 6 + mi) * D;
#pragma unroll
                        for (int i2 = 0; i2 < 2; ++i2) { const int col = 512 * i2 + 8 * lane; const f32x4 m0 = *(const f32x4*)(mx + col), m1 = *(const f32x4*)(mx + col + 4);
                            const f32x4 a = h[2 * i2] + (hp[2 * i2] - h[2 * i2]) * m0, b2 = h[2 * i2 + 1] + (hp[2 * i2 + 1] - h[2 * i2 + 1]) * m1;
                            u32x4 w; w.x = pk_bf16(a[0], a[1]); w.y = pk_bf16(a[2], a[3]); w.z = pk_bf16(b2[0], b2[1]); w.w = pk_bf16(b2[2], b2[3]);
                            *(u32x4*)(XR + (size_t)n * XR_STRIDE + (size_t)row * D + col) = w; }
                    }
                    const bool lastp = row < NP && (row & 4095) == 4095, lasts = row >= NP && ((row - NP) & 7) == 7;
                    if (lastp || lasts) {
                        float* so = lastp ? p->out + O_SHP + ((size_t)j * 4 + seq) * D : p->out + O_SHS + ((size_t)j * 32 + (seq - 4)) * D;
#pragma unroll
                        for (int i = 0; i < 4; ++i) *(f32x4*)(so + 512 * (i >> 1) + 8 * lane + 4 * (i & 1)) = h[i];
                    }
                }
#pragma unroll
                for (int i = 0; i < 4; ++i) hp[i] = h[i];
            } else {
#pragma unroll
                for (int i2 = 0; i2 < 2; ++i2) { const f32x4 a = h[2 * i2], b2 = h[2 * i2 + 1]; u32x4 w; w.x = pk_bf16(a[0], a[1]); w.y = pk_bf16(a[2], a[3]); w.z = pk_bf16(b2[0], b2[1]); w.w = pk_bf16(b2[2], b2[3]);
                    *(u32x4*)(XR + (size_t)row * D + 512 * i2 + 8 * lane) = w; }
            }
        }
    }
}

__device__ __forceinline__ void phase_scanprep(KP p, int j) {
    const bf16_t *KB = WSP(bf16_t, WS_KB), *VB = WSP(bf16_t, WS_VB);
    const float *WPp = WSP(float, WS_WP), *APp = WSP(float, WS_AP), *VPp = WSP(float, WS_VP);
    float *VF = WSP(float, WS_VFIRST), *DEC = WSP(float, WS_DEC), *KM = WSP(float, WS_KM), *VM = WSP(float, WS_VM), *AV = WSP(float, WS_AV), *BV = WSP(float, WS_BV);
    const int lane = TID() & 63, gw = BID() * 8 + (TID() >> 6), nw = gridDim.x * 8;
    for (int row = gw; row < NT; row += nw) {
#pragma unroll
        for (int i = 0; i < 4; ++i) {
            const int col = 256 * i + 4 * lane; const size_t o = (size_t)row * D + col;
            const f32x4 k = ld_bf4(KB + o), v = ld_bf4(VB + o), wp = *(const f32x4*)(WPp + o), ap = *(const f32x4*)(APp + o);
            const f32x4 w0 = *(const f32x4*)(p->rw_w0 + j * D + col), a0 = *(const f32x4*)(p->rw_a0 + j * D + col), kkw = *(const f32x4*)(p->rw_k_k + j * D + col), kaw = *(const f32x4*)(p->rw_k_a + j * D + col);
            f32x4 dec, a, vm, kk, km;
#pragma unroll
            for (int e = 0; e < 4; ++e) {
                const float wpre = w0[e] + wp[e], z = -wpre, sp = fmaxf(z, 0.f) + log1pf(expf(-fabsf(z)));
                dec[e] = expf(-expf(-sp - 0.5f));
                a[e] = sigmoidf_(a0[e] + ap[e]);
                kk[e] = k[e] * kkw[e];
                km[e] = k[e] * (1.0f + (a[e] - 1.0f) * kaw[e]);
            }
            if (j == 0) { vm = v; *(f32x4*)(VF + o) = v; }
            else { const f32x4 vf = *(const f32x4*)(VF + o), vp = *(const f32x4*)(VPp + o), v0 = *(const f32x4*)(p->rw_v0 + (j - 1) * D + col);
#pragma unroll
                for (int e = 0; e < 4; ++e) vm[e] = v[e] + (vf[e] - v[e]) * sigmoidf_(v0[e] + vp[e]); }
            float ss = kk[0] * kk[0] + kk[1] * kk[1] + kk[2] * kk[2] + kk[3] * kk[3];
            ss = g16_sum(ss);
            const float inv = rsqrtf(fmaxf(ss, 1e-24f));
            kk = kk * inv;
            *(f32x4*)(DEC + o) = dec; *(f32x4*)(KM + o) = km; *(f32x4*)(VM + o) = vm; *(f32x4*)(AV + o) = -kk; *(f32x4*)(BV + o) = kk * a;
        }
    }
}

__device__ __forceinline__ float rl(float v, int k) { return __int_as_float(__builtin_amdgcn_readlane(__float_as_int(v), k)); }
__device__ __forceinline__ void scan_run(KP p, size_t row_base, int nsteps, int colbase, float (&S)[64]) {
    const float *DEC = WSP(float, WS_DEC), *KM = WSP(float, WS_KM), *VM = WSP(float, WS_VM), *AV = WSP(float, WS_AV), *BV = WSP(float, WS_BV);
    const bf16_t* RB = WSP(bf16_t, WS_RB); float* Y = WSP(float, WS_Y);
    const int lane = TID() & 63;
    size_t o = row_base * D + colbase + lane;
    float w = DEC[o], kx = KM[o], v = VM[o], a = AV[o], b = BV[o], r = bf2f(RB[o]);
    for (int t = 0; t < nsteps; ++t) {
        const size_t on = (t + 1 < nsteps) ? o + D : o;
        const float wn = DEC[on], kn = KM[on], vn = VM[on], an = AV[on], bn = BV[on], rn = bf2f(RB[on]);
        float sa = 0.f;
#pragma unroll
        for (int k = 0; k < 64; ++k) sa += S[k] * rl(a, k);
#pragma unroll
        for (int k = 0; k < 64; ++k) S[k] = S[k] * rl(w, k) + sa * rl(b, k) + v * rl(kx, k);
        float y = 0.f;
#pragma unroll
        for (int k = 0; k < 64; ++k) y += S[k] * rl(r, k);
        Y[o] = y;
        o = on; w = wn; kx = kn; v = vn; a = an; b = bn; r = rn;
    }
}
__device__ __forceinline__ void phase_scanA(KP p) {
    const float *DEC = WSP(float, WS_DEC), *KM = WSP(float, WS_KM), *VM = WSP(float, WS_VM), *AV = WSP(float, WS_AV), *BV = WSP(float, WS_BV);
    float *PCH = WSP(float, WS_PCH), *CCH = WSP(float, WS_CCH);
    const int lane = TID() & 63, gw = BID() * 8 + (TID() >> 6), nw = gridDim.x * 8;
    for (int it = gw; it < 64 * NCH; it += nw) {
        const int sh = it / NCH, c = it % NCH, b = sh >> 4, h = sh & 15;
        float SP[64], SC[64];
#pragma unroll
        for (int k = 0; k < 64; ++k) { SP[k] = (k == lane) ? 1.f : 0.f; SC[k] = 0.f; }
        size_t o = ((size_t)b * 4096 + (size_t)c * LCH) * D + h * 64 + lane;
        float w = DEC[o], kx = KM[o], v = VM[o], a = AV[o], bb = BV[o];
        for (int t = 0; t < LCH; ++t) {
            const size_t on = (t + 1 < LCH) ? o + D : o;
            const float wn = DEC[on], kn = KM[on], vn = VM[on], an = AV[on], bn = BV[on];
            float saP = 0.f, saC = 0.f;
#pragma unroll
            for (int k = 0; k < 64; ++k) { const float ak = rl(a, k); saP += SP[k] * ak; saC += SC[k] * ak; }
#pragma unroll
            for (int k = 0; k < 64; ++k) { const float wk = rl(w, k), bk = rl(bb, k); SP[k] = SP[k] * wk + saP * bk; SC[k] = SC[k] * wk + saC * bk + v * rl(kx, k); }
            o = on; w = wn; kx = kn; v = vn; a = an; bb = bn;
        }
        float* po = PCH + ((size_t)it * 64 + lane) * 64; float* co = CCH + ((size_t)it * 64 + lane) * 64;
#pragma unroll
        for (int k = 0; k < 64; k += 4) { *(f32x4*)(po + k) = (f32x4){SP[k], SP[k + 1], SP[k + 2], SP[k + 3]}; *(f32x4*)(co + k) = (f32x4){SC[k], SC[k + 1], SC[k + 2], SC[k + 3]}; }
    }
}
__device__ __forceinline__ void phase_scanB(KP p, int j, LAS unsigned char* lds) {
    const int tid = TID(), lane = tid & 63, wave = tid >> 6;
    if (BID() < 32) {
        const float *PCH = WSP(float, WS_PCH), *CCH = WSP(float, WS_CCH); float* SST = WSP(float, WS_SST);
        const int sh = BID() * 2 + (wave >> 2), q = wave & 3, row0 = 32 * (q >> 1), col0 = 32 * (q & 1), b = sh >> 4, h = sh & 15;
        LAS float* Sl = (LAS float*)lds + (wave >> 2) * (2 * 64 * 65);
        const int lr = lane & 31, lh = lane >> 5;
        f32x16 acc;
#pragma unroll
        for (int r = 0; r < 16; ++r) acc[r] = 0.f;
        for (int c = 0; c <= NCH; ++c) {
            LAS float* Sw = Sl + (c & 1) * (64 * 65);
            float* go = c < NCH ? SST + ((size_t)sh * NCH + c) * 4096 : p->out + O_WKVP + (((size_t)j * 4 + b) * 16 + h) * 4096;
#pragma unroll
            for (int r = 0; r < 16; ++r) { const int row = row0 + (r & 3) + 8 * (r >> 2) + 4 * lh; Sw[row * 65 + col0 + lr] = acc[r]; go[row * 64 + col0 + lr] = acc[r]; }
            if (c == NCH) break;
            const float* Pc = PCH + ((size_t)sh * NCH + c) * 4096; const float* Cc = CCH + ((size_t)sh * NCH + c) * 4096;
            float bv[32];
#pragma unroll
            for (int kk = 0; kk < 32; ++kk) bv[kk] = Pc[(2 * kk + lh) * 64 + col0 + lr];
#pragma unroll
            for (int r = 0; r < 16; ++r) acc[r] = Cc[(row0 + (r & 3) + 8 * (r >> 2) + 4 * lh) * 64 + col0 + lr];
            __syncthreads();
#pragma unroll
            for (int kk = 0; kk < 32; ++kk) acc = __builtin_amdgcn_mfma_f32_32x32x2f32(Sw[(row0 + lr) * 65 + 2 * kk + lh], bv[kk], acc, 0, 0, 0);
        }
    } else {
        for (int it = (BID() - 32) * 8 + wave; it < 512; it += (gridDim.x - 32) * 8) {
            const int b = it >> 4, h = it & 15;
            const float* s0 = p->state_wkv + (((size_t)j * 32 + b) * 16 + h) * 4096 + lane * 64;
            float S[64];
#pragma unroll
            for (int k = 0; k < 64; k += 4) { const f32x4 t = *(const f32x4*)(s0 + k); S[k] = t[0]; S[k + 1] = t[1]; S[k + 2] = t[2]; S[k + 3] = t[3]; }
            scan_run(p, (size_t)NP + b * 8, 8, h * 64, S);
            float* o = p->out + O_WKVS + (((size_t)j * 32 + b) * 16 + h) * 4096 + lane * 64;
#pragma unroll
            for (int k = 0; k < 64; k += 4) *(f32x4*)(o + k) = (f32x4){S[k], S[k + 1], S[k + 2], S[k + 3]};
        }
    }
    __syncthreads();
}
__device__ __forceinline__ void phase_scanC(KP p) {
    const float* SST = WSP(float, WS_SST);
    const int lane = TID() & 63, gw = BID() * 8 + (TID() >> 6), nw = gridDim.x * 8;
    for (int it = gw; it < 64 * NCH; it += nw) {
        const int sh = it / NCH, c = it % NCH, b = sh >> 4, h = sh & 15;
        const float* s0 = SST + ((size_t)it * 64 + lane) * 64;
        float S[64];
#pragma unroll
        for (int k = 0; k < 64; k += 4) { const f32x4 t = *(const f32x4*)(s0 + k); S[k] = t[0]; S[k + 1] = t[1]; S[k + 2] = t[2]; S[k + 3] = t[3]; }
        scan_run(p, (size_t)b * 4096 + (size_t)c * LCH, LCH, h * 64, S);
    }
}


constexpr int CST = 72;
constexpr int CMAT = 64 * CST * 2;
constexpr int CH_F32 = 11 * CMAT, CH_PART = CH_F32 + 64 * 68 * 4, CH_GL = CH_PART + 64 * 4 * 4;
__device__ __forceinline__ bf16x8 cfrag(const LAS bf16_t* M, int row, int ks, int c4) { return *(const LAS bf16x8*)(M + row * CST + 32 * ks + 8 * c4); }
__device__ __forceinline__ f32x4 cmm(const LAS bf16_t* A, int arow, const LAS bf16_t* B, int brow, int c4, f32x4 acc) {
    acc = __builtin_amdgcn_mfma_f32_16x16x32_bf16(cfrag(A, arow, 0, c4), cfrag(B, brow, 0, c4), acc, 0, 0, 0);
    return __builtin_amdgcn_mfma_f32_16x16x32_bf16(cfrag(A, arow, 1, c4), cfrag(B, brow, 1, c4), acc, 0, 0, 0); }
__device__ __forceinline__ unsigned short f2bf(float x) { return (unsigned short)(pk_bf16(x, 0.f) & 0xffffu); }
__device__ __forceinline__ void st_t4(LAS bf16_t* Mt, int d, int t0, f32x4 v) { u32x2 w; w.x = pk_bf16(v[0], v[1]); w.y = pk_bf16(v[2], v[3]); *(LAS u32x2*)(Mt + d * CST + t0) = w; }

__device__ __forceinline__ void phase_chunk(KP p, int j, LAS unsigned char* lds) {
    LAS bf16_t* Mx = (LAS bf16_t*)lds;
#define CM(i) (Mx + (i) * (64 * CST))
    LAS float* F32 = (LAS float*)(lds + CH_F32);
    asm volatile("" : "+v"(F32));
    LAS float* part = (LAS float*)(lds + CH_PART);
    LAS float* gLs = (LAS float*)(lds + CH_GL);
    const bf16_t *RB = WSP(bf16_t, WS_RB), *KB = WSP(bf16_t, WS_KB), *VB = WSP(bf16_t, WS_VB), *TW = WSP(bf16_t, WS_TW), *TA_ = WSP(bf16_t, WS_TA), *TV = WSP(bf16_t, WS_TV);
    const bf16_t *W2T = WSP(bf16_t, WS_W2T) + (size_t)j * D * 64, *A2T = WSP(bf16_t, WS_A2T) + (size_t)j * D * 64, *V2T = WSP(bf16_t, WS_V2T);
    float* VF = WSP(float, WS_VFIRST); float *PCH = WSP(float, WS_PCH), *CCH = WSP(float, WS_CCH), *Y0 = WSP(float, WS_Y), *BON = WSP(float, WS_AV);
    bf16_t *GM = WSP(bf16_t, WS_DEC), *VM2 = WSP(bf16_t, WS_KM);
#define CH_BAR() do { asm volatile("s_waitcnt lgkmcnt(0)" ::: "memory"); __builtin_amdgcn_s_barrier(); asm volatile("" ::: "memory"); } while (0)
    bf16x8 f_aw[2], f_aa[2], f_av; unsigned short e_k[2][4], e_v[2][4], e_r[2][4];
    f_av = (bf16x8){0, 0, 0, 0, 0, 0, 0, 0};
#define CH_PREFETCH(itx) do { const int tid_ = TID(), lane_ = tid_ & 63, w_ = tid_ >> 6, n_ = lane_ & 15, c4_ = lane_ >> 4, tr_ = w_ >> 1, tcb_ = 2 * (w_ & 1); \
        const int sh_ = (itx) / NCH, c_ = (itx) % NCH, R0_ = (sh_ >> 4) * 4096 + c_ * LCH, hc_ = (sh_ & 15) * 64; const int ar_ = 16 * tr_ + n_; \
        _Pragma("unroll") for (int ks = 0; ks < 2; ++ks) { f_aw[ks] = *(const bf16x8*)(TW + (size_t)R0_ * 64 + ar_ * 64 + 32 * ks + 8 * c4_); f_aa[ks] = *(const bf16x8*)(TA_ + (size_t)R0_ * 64 + ar_ * 64 + 32 * ks + 8 * c4_); } \
        if (j == 1) f_av = *(const bf16x8*)(TV + (size_t)R0_ * 32 + ar_ * 32 + 8 * c4_); \
        _Pragma("unroll") for (int ti = 0; ti < 2; ++ti) _Pragma("unroll") for (int r = 0; r < 4; ++r) { const size_t o_ = (size_t)R0_ * D + hc_ + (16 * tr_ + 4 * c4_ + r) * D + 16 * (tcb_ + ti) + n_; \
            e_k[ti][r] = KB[o_]; e_v[ti][r] = VB[o_]; e_r[ti][r] = RB[o_]; } } while (0)
#define CH_MAP(q_) (((((q_) >> 4) & 3) * 16 + ((q_) & 15)) * NCH + ((q_) >> 6))
    if (BID() < 64 * NCH) CH_PREFETCH(CH_MAP(BID()));
    for (int q = BID(); q < 64 * NCH; q += gridDim.x) {
        const int it = CH_MAP(q);
        const int tid = TID(), lane = tid & 63, w = tid >> 6, n = lane & 15, c4 = lane >> 4, tr = w >> 1, tcb = 2 * (w & 1);
        const int sh = it / NCH, c = it % NCH, b = sh >> 4, h = sh & 15, R0 = b * 4096 + c * LCH, hc = h * 64;
        const bf16_t *KBb = KB + (size_t)R0 * D + hc, *VBb = VB + (size_t)R0 * D + hc, *RBb = RB + (size_t)R0 * D + hc;
        bf16_t* VFb = (bf16_t*)VF + (size_t)R0 * D + hc; bf16_t* VM2b = VM2 + (size_t)R0 * D + hc; bf16_t* GMb = GM + (size_t)R0 * D + hc; bf16_t* Y0b = (bf16_t*)Y0 + (size_t)R0 * D + hc;
        float* PCb = PCH + (size_t)it * 4096; float* CCb = CCH + (size_t)it * 4096; float* BONb = BON + (size_t)R0 * 16 + h;
        const bf16_t *TWb = TW + (size_t)R0 * 64, *TAb = TA_ + (size_t)R0 * 64, *TVb = TV + (size_t)R0 * 32, *W2b = W2T + (size_t)hc * 64, *A2b = A2T + (size_t)hc * 64, *V2b = V2T + (size_t)hc * 32;
        const float *w0b = p->rw_w0 + j * D + hc, *a0b = p->rw_a0 + j * D + hc, *kkb = p->rw_k_k + j * D + hc, *kab = p->rw_k_a + j * D + hc, *rkb = p->rw_r_k + j * D + hc, *v0b = p->rw_v0 + (j ? (j - 1) : 0) * D + hc;
        f32x4 wp[2], ap[2], vp[2];
#pragma unroll
        for (int ti = 0; ti < 2; ++ti) { wp[ti] = (f32x4){0.f, 0.f, 0.f, 0.f}; ap[ti] = wp[ti]; vp[ti] = wp[ti]; }
        {   const int ar = 16 * tr + n;
#pragma unroll
            for (int ks = 0; ks < 2; ++ks) {
                const bf16x8 aw = f_aw[ks], aa = f_aa[ks];
#pragma unroll
                for (int ti = 0; ti < 2; ++ti) { const int br = 16 * (tcb + ti) + n;
                    wp[ti] = __builtin_amdgcn_mfma_f32_16x16x32_bf16(aw, *(const bf16x8*)(W2b + br * 64 + 32 * ks + 8 * c4), wp[ti], 0, 0, 0);
                    ap[ti] = __builtin_amdgcn_mfma_f32_16x16x32_bf16(aa, *(const bf16x8*)(A2b + br * 64 + 32 * ks + 8 * c4), ap[ti], 0, 0, 0); }
            }
            if (j == 1) { const bf16x8 av = f_av;
#pragma unroll
                for (int ti = 0; ti < 2; ++ti) vp[ti] = __builtin_amdgcn_mfma_f32_16x16x32_bf16(av, *(const bf16x8*)(V2b + (16 * (tcb + ti) + n) * 32 + 8 * c4), vp[ti], 0, 0, 0); }
        }
        f32x4 lw[2], asg[2], kkv[2], kpr[2], vpr[2], rr[2];
        float ssq[4] = {0.f, 0.f, 0.f, 0.f}, bon[4] = {0.f, 0.f, 0.f, 0.f};
        float vf8[2][4];
#pragma unroll
        for (int ti = 0; ti < 2; ++ti)
#pragma unroll
            for (int r = 0; r < 4; ++r) vf8[ti][r] = 0.f;
        if (j == 1) {
#pragma unroll
            for (int ti = 0; ti < 2; ++ti)
#pragma unroll
                for (int r = 0; r < 4; ++r) vf8[ti][r] = bf2f(VFb[(16 * tr + 4 * c4 + r) * D + 16 * (tcb + ti) + n]);
        }
#pragma unroll
        for (int ti = 0; ti < 2; ++ti) {
            const int d = 16 * (tcb + ti) + n;
            const float w0 = w0b[d], a0 = a0b[d], kkw = kkb[d], kaw = kab[d], rkw = rkb[d];
            const float v0 = j ? v0b[d] : 0.f;
#pragma unroll
            for (int r = 0; r < 4; ++r) {
                const int o = (16 * tr + 4 * c4 + r) * D + d;
                const float kx = bf2f(e_k[ti][r]), vx = bf2f(e_v[ti][r]), rx = bf2f(e_r[ti][r]);
                const float z = -(w0 + wp[ti][r]), sp = fmaxf(z, 0.f) + __logf(1.0f + __expf(-fabsf(z)));
                lw[ti][r] = -__expf(-sp - 0.5f);
                const float a = fsig(a0 + ap[ti][r]);
                asg[ti][r] = a;
                float vv = vx;
                if (j == 0) VFb[o] = e_v[ti][r]; else { const float vf = vf8[ti][r]; vv = vx + (vf - vx) * fsig(v0 + vp[ti][r]); }
                vpr[ti][r] = vv; rr[ti][r] = rx;
                const float kk = kx * kkw; kkv[ti][r] = kk; ssq[r] += kk * kk;
                const float kp = kx * (1.0f + (a - 1.0f) * kaw); kpr[ti][r] = kp; bon[r] += rx * kp * rkw;
                F32[(16 * tr + 4 * c4 + r) * 68 + d] = lw[ti][r];
                VM2b[o] = f2bf(vv);
            }
        }
#pragma unroll
        for (int r = 0; r < 4; ++r) { ssq[r] = g16_sum(ssq[r]); bon[r] = g16_sum(bon[r]); }
        if (n == 0) {
#pragma unroll
            for (int r = 0; r < 4; ++r) { const int t = 16 * tr + 4 * c4 + r; part[(t * 2 + (w & 1)) * 2 + 0] = ssq[r]; part[(t * 2 + (w & 1)) * 2 + 1] = bon[r]; }
        }
        if (q + (int)gridDim.x < 64 * NCH) CH_PREFETCH(CH_MAP(q + (int)gridDim.x));
        CH_BAR();
        f32x4 cs[2];
#pragma unroll
        for (int ti = 0; ti < 2; ++ti) {
            f32x4 acc = {0.f, 0.f, 0.f, 0.f};
            for (int q = 0; q < 4 * (tr + 1); ++q) {
                const float av = (4 * q + c4 <= 16 * tr + n) ? 1.0f : 0.0f;
                acc = __builtin_amdgcn_mfma_f32_16x16x4f32(av, F32[(4 * q + c4) * 68 + 16 * (tcb + ti) + n], acc, 0, 0, 0);
            }
            cs[ti] = acc;
        }
        float inv[4];
#pragma unroll
        for (int r = 0; r < 4; ++r) { const int t = 16 * tr + 4 * c4 + r; inv[r] = rsqrtf(fmaxf(part[(t * 2 + 0) * 2] + part[(t * 2 + 1) * 2], 1e-24f));
            if (n == 0 && (w & 1) == 0) BONb[t * 16] = part[(t * 2 + 0) * 2 + 1] + part[(t * 2 + 1) * 2 + 1]; }
        f32x4 rt[2];
#pragma unroll
        for (int ti = 0; ti < 2; ++ti) {
            const int d = 16 * (tcb + ti) + n, t0 = 16 * tr + 4 * c4;
            f32x4 at, bt, kt;
#pragma unroll
            for (int r = 0; r < 4; ++r) {
                const float g = __expf(cs[ti][r]), gi = __expf(-cs[ti][r]), gm = __expf(cs[ti][r] - lw[ti][r]);
                const float kk = kkv[ti][r] * inv[r];
                at[r] = -kk * gm; bt[r] = kk * asg[ti][r] * gi; kt[r] = kpr[ti][r] * gi; rt[ti][r] = rr[ti][r] * g;
                CM(0)[(t0 + r) * CST + d] = f2bf(at[r]); CM(1)[(t0 + r) * CST + d] = f2bf(bt[r]); CM(2)[(t0 + r) * CST + d] = f2bf(kt[r]); CM(3)[(t0 + r) * CST + d] = f2bf(rt[ti][r]);
                if (t0 + r == 63) gLs[d] = g;
            }
            st_t4(CM(4), d, t0, at); st_t4(CM(5), d, t0, bt); st_t4(CM(6), d, t0, kt); st_t4(CM(7), d, t0, vpr[ti]);
        }
        CH_BAR();
#pragma unroll
        for (int ti = 0; ti < 2; ++ti) {
            const int tc = tcb + ti, s = 16 * tc + n, t0 = 16 * tr + 4 * c4;
            if (tc <= tr) {
                { f32x4 m = {0.f, 0.f, 0.f, 0.f}; m = cmm(CM(0), 16 * tr + n, CM(1), 16 * tc + n, c4, m);
#pragma unroll
                  for (int r = 0; r < 4; ++r) F32[(t0 + r) * 68 + s] = (s < t0 + r) ? m[r] : 0.f; }
                asm volatile("" ::: "memory");
                { f32x4 m = {0.f, 0.f, 0.f, 0.f}; m = cmm(CM(0), 16 * tr + n, CM(2), 16 * tc + n, c4, m);
#pragma unroll
                  for (int r = 0; r < 4; ++r) CM(8)[(t0 + r) * CST + s] = f2bf((s < t0 + r) ? m[r] : 0.f); }
                asm volatile("" ::: "memory");
                { f32x4 m = {0.f, 0.f, 0.f, 0.f}; m = cmm(CM(3), 16 * tr + n, CM(1), 16 * tc + n, c4, m);
#pragma unroll
                  for (int r = 0; r < 4; ++r) CM(9)[(t0 + r) * CST + s] = f2bf((s <= t0 + r) ? m[r] : 0.f); }
                asm volatile("" ::: "memory");
                { f32x4 m = {0.f, 0.f, 0.f, 0.f}; m = cmm(CM(3), 16 * tr + n, CM(2), 16 * tc + n, c4, m);
#pragma unroll
                  for (int r = 0; r < 4; ++r) CM(10)[(t0 + r) * CST + s] = f2bf((s <= t0 + r) ? m[r] : 0.f); }
                asm volatile("" ::: "memory");
            } else {
#pragma unroll
                for (int r = 0; r < 4; ++r) { F32[(t0 + r) * 68 + s] = 0.f; CM(8)[(t0 + r) * CST + s] = 0; CM(9)[(t0 + r) * CST + s] = 0; CM(10)[(t0 + r) * CST + s] = 0; }
            }
        }
        CH_BAR();
        { const int e0 = tid * 8;
#pragma unroll
          for (int e = 0; e < 8; ++e) { const int t = (e0 + e) >> 6, s_ = (e0 + e) & 63; CM(2)[t * CST + s_] = f2bf(F32[t * 68 + s_]); }
          unsigned z_ = 0u; asm volatile("" : "+v"(z_));
          *(LAS u32x4*)(CM(0) + (e0 >> 6) * CST + (e0 & 63)) = (u32x4){z_, z_, z_, z_}; }
        CH_BAR();
        if (w < 4) {
            const int cw = 16 * w;
            LAS float* scr = (LAS float*)CM(1) + w * (16 * 17);
#pragma unroll 1
            for (int I = 0; I < 4; ++I) {
                f32x4 rh = {0.f, 0.f, 0.f, 0.f};
                if (I > 0) { rh = __builtin_amdgcn_mfma_f32_16x16x32_bf16(cfrag(CM(2), 16 * I + n, 0, c4), cfrag(CM(0), cw + n, 0, c4), rh, 0, 0, 0);
                    if (I > 2) rh = __builtin_amdgcn_mfma_f32_16x16x32_bf16(cfrag(CM(2), 16 * I + n, 1, c4), cfrag(CM(0), cw + n, 1, c4), rh, 0, 0, 0); }
#pragma unroll
                for (int r = 0; r < 4; ++r) scr[(4 * c4 + r) * 17 + n] = rh[r] + ((16 * I + 4 * c4 + r) == (cw + n) ? 1.f : 0.f);
                wave_lds_fence();
                float x[16];
#pragma unroll
                for (int i = 0; i < 16; ++i) x[i] = scr[i * 17 + n];
                f32x4 mc[4], mn[4];
                mc[0] = *(const LAS f32x4*)(F32 + (16 * I + 1) * 68 + 16 * I);
#pragma unroll
                for (int i = 1; i < 16; ++i) {
                    if (i + 1 < 16) {
#pragma unroll
                        for (int j4 = 0; j4 < (i + 4) / 4; ++j4) mn[j4] = *(const LAS f32x4*)(F32 + (16 * I + i + 1) * 68 + 16 * I + 4 * j4);
                    }
                    float a0 = 0.f, a1 = 0.f;
#pragma unroll
                    for (int j4 = 0; j4 < (i + 3) / 4; ++j4) {
                        if (4 * j4 + 0 < i) a0 += mc[j4][0] * x[4 * j4 + 0];
                        if (4 * j4 + 1 < i) a1 += mc[j4][1] * x[4 * j4 + 1];
                        if (4 * j4 + 2 < i) a0 += mc[j4][2] * x[4 * j4 + 2];
                        if (4 * j4 + 3 < i) a1 += mc[j4][3] * x[4 * j4 + 3];
                    }
                    x[i] += a0 + a1;
#pragma unroll
                    for (int j4 = 0; j4 < 4; ++j4) mc[j4] = mn[j4];
                    asm volatile("" ::: "memory");
                }
                if (c4 == 0) {
#pragma unroll
                    for (int i = 0; i < 16; ++i) CM(3)[(16 * I + i) * CST + cw + n] = f2bf(x[i]);
                    u32x4 t0, t1;
                    t0.x = pk_bf16(x[0], x[1]); t0.y = pk_bf16(x[2], x[3]); t0.z = pk_bf16(x[4], x[5]); t0.w = pk_bf16(x[6], x[7]);
                    t1.x = pk_bf16(x[8], x[9]); t1.y = pk_bf16(x[10], x[11]); t1.z = pk_bf16(x[12], x[13]); t1.w = pk_bf16(x[14], x[15]);
                    *(LAS u32x4*)(CM(0) + (cw + n) * CST + 16 * I) = t0; *(LAS u32x4*)(CM(0) + (cw + n) * CST + 16 * I + 8) = t1;
                }
                wave_lds_fence();
            }
        }
        CH_BAR();
#pragma unroll
        for (int ti = 0; ti < 2; ++ti) {
            const int d = 16 * (tcb + ti) + n;
            { f32x4 x1 = {0.f, 0.f, 0.f, 0.f}; x1 = cmm(CM(8), 16 * tr + n, CM(7), 16 * (tcb + ti) + n, c4, x1); st_t4(CM(0), d, 16 * tr + 4 * c4, x1); }
            asm volatile("" ::: "memory");
            { f32x4 ta = {0.f, 0.f, 0.f, 0.f}; ta = cmm(CM(3), 16 * tr + n, CM(4), 16 * (tcb + ti) + n, c4, ta); st_t4(CM(1), d, 16 * tr + 4 * c4, ta); }
            asm volatile("" ::: "memory");
        }
        CH_BAR();
#pragma unroll
        for (int ti = 0; ti < 2; ++ti) {
            f32x4 uv = {0.f, 0.f, 0.f, 0.f};
            uv = cmm(CM(3), 16 * tr + n, CM(0), 16 * (tcb + ti) + n, c4, uv);
            st_t4(CM(2), 16 * (tcb + ti) + n, 16 * tr + 4 * c4, uv);
        }
        CH_BAR();
#pragma unroll
        for (int ti = 0; ti < 2; ++ti) {
            const int cc = 16 * (tcb + ti) + n, r0 = 16 * tr + 4 * c4;
            const float gl = gLs[cc];
            { f32x4 pm = {0.f, 0.f, 0.f, 0.f}; pm = cmm(CM(1), 16 * tr + n, CM(5), cc, c4, pm);
#pragma unroll
              for (int r = 0; r < 4; ++r) PCb[(r0 + r) * 64 + cc] = (pm[r] + ((r0 + r) == cc ? 1.f : 0.f)) * gl; }
            asm volatile("" ::: "memory");
            { f32x4 cm_ = {0.f, 0.f, 0.f, 0.f}; cm_ = cmm(CM(2), 16 * tr + n, CM(5), cc, c4, cm_); cm_ = cmm(CM(7), 16 * tr + n, CM(6), cc, c4, cm_);
#pragma unroll
              for (int r = 0; r < 4; ++r) CCb[(r0 + r) * 64 + cc] = cm_[r] * gl; }
            asm volatile("" ::: "memory");
            { f32x4 gg = {0.f, 0.f, 0.f, 0.f}; gg = cmm(CM(9), 16 * tr + n, CM(1), cc, c4, gg);
#pragma unroll
              for (int r = 0; r < 4; ++r) GMb[(r0 + r) * D + cc] = f2bf(gg[r] + rt[ti][r]); }
            asm volatile("" ::: "memory");
            { f32x4 y0 = {0.f, 0.f, 0.f, 0.f}; y0 = cmm(CM(9), 16 * tr + n, CM(2), cc, c4, y0); y0 = cmm(CM(10), 16 * tr + n, CM(7), cc, c4, y0);
#pragma unroll
              for (int r = 0; r < 4; ++r) Y0b[(r0 + r) * D + cc] = f2bf(y0[r]); }
            asm volatile("" ::: "memory");
        }
        CH_BAR();
    }
#undef CM
#undef CH_PREFETCH
#undef CH_BAR
}

__device__ __forceinline__ void phase_sample_mixer_w(KP p, int j, int first, int stride) {
    const int tid = TID(), lane = tid & 63;
    {
        const bf16_t *RB = WSP(bf16_t, WS_RB), *KB = WSP(bf16_t, WS_KB), *VB = WSP(bf16_t, WS_VB); bf16_t* YG = WSP(bf16_t, WS_YG);
        const float *WPp = WSP(float, WS_WP), *APp = WSP(float, WS_AP), *VPp = WSP(float, WS_VP), *GG = WSP(float, WS_GG); float* VF = WSP(float, WS_VFIRST);
        for (int it = first; it < 512; it += stride) {
            const int b = it >> 4, h = it & 15, col = h * 64 + lane;
            const float* s0 = p->state_wkv + (((size_t)j * 32 + b) * 16 + h) * 4096 + lane * 64;
            float S[64];
#pragma unroll
            for (int k = 0; k < 64; k += 4) { const f32x4 t = *(const f32x4*)(s0 + k); S[k] = t[0]; S[k + 1] = t[1]; S[k + 2] = t[2]; S[k + 3] = t[3]; }
            const float w0 = p->rw_w0[j * D + col], a0 = p->rw_a0[j * D + col], kkw = p->rw_k_k[j * D + col], kaw = p->rw_k_a[j * D + col], rkw = p->rw_r_k[j * D + col];
            const float v0 = j ? p->rw_v0[(j - 1) * D + col] : 0.f, lnw = p->rw_lnx_w[j * D + col], lnb = p->rw_lnx_b[j * D + col];
            for (int t = 0; t < 8; ++t) {
                const size_t o = (size_t)(NP + b * 8 + t) * D + col;
                const float kx = bf2f(KB[o]), vx = bf2f(VB[o]), r = bf2f(RB[o]);
                const float z = -(w0 + WPp[o]), sp = fmaxf(z, 0.f) + log1pf(expf(-fabsf(z)));
                const float wd = expf(-expf(-sp - 0.5f)), asg = sigmoidf_(a0 + APp[o]);
                float v = vx;
                if (j == 0) VF[o] = vx; else { const float vf = VF[o]; v = vx + (vf - vx) * sigmoidf_(v0 + VPp[o]); }
                float kk = kx * kkw; const float ss = wave_sum(kk * kk); kk *= rsqrtf(fmaxf(ss, 1e-24f));
                const float kp = kx * (1.0f + (asg - 1.0f) * kaw), a = -kk, bq = kk * asg;
                float sa = 0.f;
#pragma unroll
                for (int k = 0; k < 64; ++k) sa += S[k] * rl(a, k);
#pragma unroll
                for (int k = 0; k < 64; ++k) S[k] = S[k] * rl(wd, k) + sa * rl(bq, k) + v * rl(kp, k);
                float y = 0.f;
#pragma unroll
                for (int k = 0; k < 64; ++k) y += S[k] * rl(r, k);
                const float mu = wave_sum(y) * (1.0f / 64.0f), dy = y - mu, var = wave_sum(dy * dy) * (1.0f / 64.0f);
                const float bonus = wave_sum(r * kp * rkw);
                YG[o] = f2bf((dy * rsqrtf(var + 64e-5f) * lnw + lnb + bonus * v) * GG[o]);
            }
            float* so = p->out + O_WKVS + (((size_t)j * 32 + b) * 16 + h) * 4096 + lane * 64;
#pragma unroll
            for (int k = 0; k < 64; k += 4) *(f32x4*)(so + k) = (f32x4){S[k], S[k + 1], S[k + 2], S[k + 3]};
        }
    }
}
__device__ __forceinline__ void phase_carry(KP p, int j, LAS unsigned char* lds) {
    const float *PCH = WSP(float, WS_PCH), *CCH = WSP(float, WS_CCH); float* SST = WSP(float, WS_SST);
    LAS float* Sl = (LAS float*)lds;
    LAS unsigned* cflag = (LAS unsigned*)(lds + 9216);
    if (TID() == 0) *cflag = 0u;
    __syncthreads();
    unsigned arrivals = 0u;
    if ((TID() >> 6) >= 4) { phase_sample_mixer_w(p, j, BID() * 4 + ((TID() >> 6) - 4), (int)gridDim.x * 4); }
    else
    for (int it = BID(); it < 256; it += gridDim.x) {
        const int wave = TID() >> 6, sh = it >> 2, row0 = 16 * (it & 3), col0 = 16 * (wave & 3), b = sh >> 4, h = sh & 15;
        const bool act = true;
        f32x4 acc = {0.f, 0.f, 0.f, 0.f}, c0, c1, c2;
        float b0[16], b1[16], b2[16];
#define CARRY_LOAD(BX, CX, cc_) do { const int l_ = TID() & 63, ln = l_ & 15, lq = l_ >> 4; \
            const float* Pc = PCH + ((size_t)sh * NCH + (cc_)) * 4096; const float* Cc = CCH + ((size_t)sh * NCH + (cc_)) * 4096; \
            _Pragma("unroll") for (int q = 0; q < 16; ++q) BX[q] = Pc[(4 * q + lq) * 64 + col0 + ln]; \
            _Pragma("unroll") for (int r = 0; r < 4; ++r) CX[r] = Cc[(row0 + 4 * lq + r) * 64 + col0 + ln]; } while (0)
#define CARRY_STEP(BX, CX, BL, CL, c_) do { const int l_ = TID() & 63, ln = l_ & 15, lq = l_ >> 4; \
            LAS float* Sw = Sl + ((c_) & 1) * (16 * 68); bf16_t* go = (bf16_t*)SST + ((size_t)sh * NCH + (c_)) * 4096; \
            if (act) { _Pragma("unroll") for (int r = 0; r < 4; ++r) Sw[(4 * lq + r) * 68 + col0 + ln] = acc[r]; } \
            const f32x4 sc = acc; acc = CX; \
            asm volatile("s_waitcnt lgkmcnt(0)" ::: "memory"); arrivals += 4u; \
            if ((TID() & 63) == 0) __hip_atomic_fetch_add(cflag, 1u, __ATOMIC_RELAXED, __HIP_MEMORY_SCOPE_WORKGROUP); \
            { unsigned sp_ = 0; while (__builtin_amdgcn_readfirstlane(__hip_atomic_load(cflag, __ATOMIC_RELAXED, __HIP_MEMORY_SCOPE_WORKGROUP)) < arrivals && ++sp_ < (1u << 22)) __builtin_amdgcn_s_sleep(0); } \
            asm volatile("" ::: "memory"); \
            if (act) { \
                _Pragma("unroll") for (int r = 0; r < 4; ++r) go[(row0 + 4 * lq + r) * 64 + col0 + ln] = f2bf(sc[r]); \
                if ((c_) + 2 < NCH) CARRY_LOAD(BL, CL, (c_) + 2); \
                float av[16]; _Pragma("unroll") for (int q = 0; q < 16; ++q) av[q] = Sw[ln * 68 + 4 * q + lq]; \
                asm volatile("s_waitcnt lgkmcnt(0)" ::: "memory"); \
                _Pragma("unroll") for (int q = 0; q < 16; ++q) acc = __builtin_amdgcn_mfma_f32_16x16x4f32(av[q], BX[q], acc, 0, 0, 0); } } while (0)
        if (act) { CARRY_LOAD(b0, c0, 0); CARRY_LOAD(b1, c1, 1); }
        for (int c = 0; c < NCH; c += 3) {
            CARRY_STEP(b0, c0, b2, c2, c);
            if (c + 1 < NCH) CARRY_STEP(b1, c1, b0, c0, c + 1);
            if (c + 2 < NCH) CARRY_STEP(b2, c2, b1, c1, c + 2);
        }
        if (act) { const int l_ = TID() & 63, ln = l_ & 15, lq = l_ >> 4; float* go = p->out + O_WKVP + (((size_t)j * 4 + b) * 16 + h) * 4096;
#pragma unroll
            for (int r = 0; r < 4; ++r) go[(row0 + 4 * lq + r) * 64 + col0 + ln] = acc[r]; }
#undef CARRY_LOAD
#undef CARRY_STEP
    }
    __syncthreads();
}
__device__ __forceinline__ void phase_sample_mixer(KP p, int j) {
    const int tid = TID(), lane = tid & 63, wave = tid >> 6;
    {
        const bf16_t *RB = WSP(bf16_t, WS_RB), *KB = WSP(bf16_t, WS_KB), *VB = WSP(bf16_t, WS_VB); bf16_t* YG = WSP(bf16_t, WS_YG);
        const float *WPp = WSP(float, WS_WP), *APp = WSP(float, WS_AP), *VPp = WSP(float, WS_VP), *GG = WSP(float, WS_GG); float* VF = WSP(float, WS_VFIRST);
        for (int it = BID() * 8 + wave; it < 512; it += gridDim.x * 8) {
            const int b = it >> 4, h = it & 15, col = h * 64 + lane;
            const float* s0 = p->state_wkv + (((size_t)j * 32 + b) * 16 + h) * 4096 + lane * 64;
            float S[64];
#pragma unroll
            for (int k = 0; k < 64; k += 4) { const f32x4 t = *(const f32x4*)(s0 + k); S[k] = t[0]; S[k + 1] = t[1]; S[k + 2] = t[2]; S[k + 3] = t[3]; }
            const float w0 = p->rw_w0[j * D + col], a0 = p->rw_a0[j * D + col], kkw = p->rw_k_k[j * D + col], kaw = p->rw_k_a[j * D + col], rkw = p->rw_r_k[j * D + col];
            const float v0 = j ? p->rw_v0[(j - 1) * D + col] : 0.f, lnw = p->rw_lnx_w[j * D + col], lnb = p->rw_lnx_b[j * D + col];
            for (int t = 0; t < 8; ++t) {
                const size_t o = (size_t)(NP + b * 8 + t) * D + col;
                const float kx = bf2f(KB[o]), vx = bf2f(VB[o]), r = bf2f(RB[o]);
                const float z = -(w0 + WPp[o]), sp = fmaxf(z, 0.f) + log1pf(expf(-fabsf(z)));
                const float wd = expf(-expf(-sp - 0.5f)), asg = sigmoidf_(a0 + APp[o]);
                float v = vx;
                if (j == 0) VF[o] = vx; else { const float vf = VF[o]; v = vx + (vf - vx) * sigmoidf_(v0 + VPp[o]); }
                float kk = kx * kkw; const float ss = wave_sum(kk * kk); kk *= rsqrtf(fmaxf(ss, 1e-24f));
                const float kp = kx * (1.0f + (asg - 1.0f) * kaw), a = -kk, bq = kk * asg;
                float sa = 0.f;
#pragma unroll
                for (int k = 0; k < 64; ++k) sa += S[k] * rl(a, k);
#pragma unroll
                for (int k = 0; k < 64; ++k) S[k] = S[k] * rl(wd, k) + sa * rl(bq, k) + v * rl(kp, k);
                float y = 0.f;
#pragma unroll
                for (int k = 0; k < 64; ++k) y += S[k] * rl(r, k);
                const float mu = wave_sum(y) * (1.0f / 64.0f), dy = y - mu, var = wave_sum(dy * dy) * (1.0f / 64.0f);
                const float bonus = wave_sum(r * kp * rkw);
                YG[o] = f2bf((dy * rsqrtf(var + 64e-5f) * lnw + lnb + bonus * v) * GG[o]);
            }
            float* so = p->out + O_WKVS + (((size_t)j * 32 + b) * 16 + h) * 4096 + lane * 64;
#pragma unroll
            for (int k = 0; k < 64; k += 4) *(f32x4*)(so + k) = (f32x4){S[k], S[k + 1], S[k + 2], S[k + 3]};
        }
    }
}
__device__ __forceinline__ void phase_post2(KP p, int j, LAS unsigned char* lds) {
    LAS float* part = (LAS float*)lds;
    const bf16_t *GM = WSP(bf16_t, WS_DEC), *VM2 = WSP(bf16_t, WS_KM), *TG = WSP(bf16_t, WS_TG), *G2T = WSP(bf16_t, WS_G2T) + (size_t)j * D * 160;
    const float *Y0 = WSP(float, WS_Y), *BON = WSP(float, WS_AV), *SST = WSP(float, WS_SST); bf16_t* YG = WSP(bf16_t, WS_YG);
    for (int it = BID(); it < 64 * NCH; it += gridDim.x) {
        const int tid = TID(), lane = tid & 63, w = tid >> 6, n = lane & 15, c4 = lane >> 4, tr = w >> 1, tcb = 2 * (w & 1);
        const int sh = it / NCH, c = it % NCH, b = sh >> 4, h = sh & 15, R0 = b * 4096 + c * LCH, hc = h * 64;
        f32x4 y[2], g[2];
        const size_t ar = (size_t)(R0 + 16 * tr + n);
#pragma unroll
        for (int ti = 0; ti < 2; ++ti) {
            const int dv = 16 * (tcb + ti) + n;
            f32x4 acc = {0.f, 0.f, 0.f, 0.f}, gacc = acc;
#pragma unroll
            for (int ks = 0; ks < 2; ++ks) {
                const bf16x8 af = *(const bf16x8*)(GM + ar * D + hc + 32 * ks + 8 * c4);
                const bf16x8 bw = *(const bf16x8*)((const bf16_t*)SST + ((size_t)it * 64 + dv) * 64 + 32 * ks + 8 * c4);
                acc = __builtin_amdgcn_mfma_f32_16x16x32_bf16(af, bw, acc, 0, 0, 0);
            }
#pragma unroll
            for (int ks = 0; ks < 5; ++ks)
                gacc = __builtin_amdgcn_mfma_f32_16x16x32_bf16(*(const bf16x8*)(TG + ar * 160 + 32 * ks + 8 * c4), *(const bf16x8*)(G2T + (size_t)(hc + dv) * 160 + 32 * ks + 8 * c4), gacc, 0, 0, 0);
#pragma unroll
            for (int r = 0; r < 4; ++r) acc[r] += bf2f(((const bf16_t*)Y0)[(size_t)(R0 + 16 * tr + 4 * c4 + r) * D + hc + dv]);
            y[ti] = acc; g[ti] = gacc;
        }
        float bonus4[4]; unsigned short vm4[2][4]; float lnw2[2], lnb2[2];
#pragma unroll
        for (int r = 0; r < 4; ++r) bonus4[r] = BON[(size_t)(R0 + 16 * tr + 4 * c4 + r) * 16 + h];
#pragma unroll
        for (int ti = 0; ti < 2; ++ti) { const int col = hc + 16 * (tcb + ti) + n; lnw2[ti] = p->rw_lnx_w[j * D + col]; lnb2[ti] = p->rw_lnx_b[j * D + col];
#pragma unroll
            for (int r = 0; r < 4; ++r) vm4[ti][r] = VM2[(size_t)(R0 + 16 * tr + 4 * c4 + r) * D + col]; }
        float s1[4], s2[4];
#pragma unroll
        for (int r = 0; r < 4; ++r) { s1[r] = g16_sum(y[0][r] + y[1][r]); s2[r] = g16_sum(y[0][r] * y[0][r] + y[1][r] * y[1][r]); }
        asm volatile("s_waitcnt lgkmcnt(0)" ::: "memory"); __builtin_amdgcn_s_barrier(); asm volatile("" ::: "memory");
        if (n == 0) {
#pragma unroll
            for (int r = 0; r < 4; ++r) { const int t = 16 * tr + 4 * c4 + r; part[(t * 2 + (w & 1)) * 2 + 0] = s1[r]; part[(t * 2 + (w & 1)) * 2 + 1] = s2[r]; }
        }
        asm volatile("s_waitcnt lgkmcnt(0)" ::: "memory"); __builtin_amdgcn_s_barrier(); asm volatile("" ::: "memory");
#pragma unroll
        for (int r = 0; r < 4; ++r) {
            const int t = 16 * tr + 4 * c4 + r;
            const float mu = (part[(t * 2 + 0) * 2] + part[(t * 2 + 1) * 2]) * (1.0f / 64.0f), ex2 = (part[(t * 2 + 0) * 2 + 1] + part[(t * 2 + 1) * 2 + 1]) * (1.0f / 64.0f);
            const float rs = rsqrtf(fmaxf(ex2 - mu * mu, 0.f) + 64e-5f), bonus = bonus4[r];
#pragma unroll
            for (int ti = 0; ti < 2; ++ti) {
                const int col = hc + 16 * (tcb + ti) + n; const size_t o = (size_t)(R0 + t) * D + col;
                YG[o] = f2bf(((y[ti][r] - mu) * rs * lnw2[ti] + lnb2[ti] + bonus * bf2f(vm4[ti][r])) * g[ti][r]);
            }
        }
    }
    __syncthreads();
}

__device__ __forceinline__ void phase_post(KP p, int j) {
    const float *Y = WSP(float, WS_Y), *KM = WSP(float, WS_KM), *VM = WSP(float, WS_VM), *GG = WSP(float, WS_GG);
    const bf16_t* RB = WSP(bf16_t, WS_RB); bf16_t* YG = WSP(bf16_t, WS_YG);
    const int lane = TID() & 63, gw = BID() * 8 + (TID() >> 6), nw = gridDim.x * 8;
    for (int row = gw; row < NT; row += nw) {
#pragma unroll
        for (int i = 0; i < 4; ++i) {
            const int col = 256 * i + 4 * lane; const size_t o = (size_t)row * D + col;
            const f32x4 y = *(const f32x4*)(Y + o), r = ld_bf4(RB + o), km = *(const f32x4*)(KM + o), vm = *(const f32x4*)(VM + o), gg = *(const f32x4*)(GG + o);
            const f32x4 lw = *(const f32x4*)(p->rw_lnx_w + j * D + col), lb = *(const f32x4*)(p->rw_lnx_b + j * D + col), rk = *(const f32x4*)(p->rw_r_k + j * D + col);
            const float mu = g16_sum(y[0] + y[1] + y[2] + y[3]) * (1.0f / 64.0f);
            const f32x4 d = y - mu;
            const float var = g16_sum(d[0] * d[0] + d[1] * d[1] + d[2] * d[2] + d[3] * d[3]) * (1.0f / 64.0f);
            const float rs = rsqrtf(var + 64e-5f);
            const float bon = g16_sum(r[0] * km[0] * rk[0] + r[1] * km[1] * rk[1] + r[2] * km[2] * rk[2] + r[3] * km[3] * rk[3]);
            st_bf4(YG + o, (d * rs * lw + lb + bon * vm) * gg);
        }
    }
}

__constant__ double kRopeInv[8] = {1.0, 0.19392274474868576, 0.03760603093086393, 0.007292664737217109, 0.001414213562373095, 0.0002742481756762073, 5.318295896944988e-05, 1.031338537721246e-05};
__device__ __forceinline__ void phase_rope_table(KP p) {
    float* TB = WSP(float, WS_ROPE);
    for (int e = ((int)gridDim.x - 1 - BID()) * 512 + TID(); e < 4104 * 8; e += gridDim.x * 512) {
        const int pi = e >> 3, f = e & 7, pos = pi < 4096 ? pi : PAST + (pi - 4096);
        double ang = (double)pos * kRopeInv[f]; ang -= floor(ang * 0.15915494309189535) * 6.283185307179586; const float af = (float)ang;
        TB[pi * 16 + f] = cosf(af); TB[pi * 16 + 8 + f] = sinf(af);
    }
}
__device__ __forceinline__ void phase_dsapost(KP p, int j) {
    const bf16_t* PR = WSP(bf16_t, WS_PR); float *Q = WSP(float, WS_Q), *QI = WSP(float, WS_QI), *WI = WSP(float, WS_WI);
    const int lane = TID() & 63, l16 = lane & 15, gw = BID() * 8 + (TID() >> 6), nw = gridDim.x * 8;
    const f32x4 qn = *(const f32x4*)(p->att_q_norm + j * 64 + 4 * l16), kn = *(const f32x4*)(p->att_k_norm + j * 64 + 4 * l16), in = *(const f32x4*)(p->idx_k_norm + j * 64 + 4 * l16);
    for (int row = gw; row < NT; row += nw) {
        const int pos = row_pos(row);
        const bf16_t* pr = PR + (size_t)row * PINP;
        const float* tb = WSP(float, WS_ROPE) + (row < NP ? (row & 4095) : 4096 + ((row - NP) & 7)) * 16 + 4 * (l16 & 1);
        const f32x4 cs = *(const f32x4*)tb, sn = *(const f32x4*)(tb + 8);
        const float sgn = (l16 < 2) ? -1.0f : 1.0f;
#define ROPE4(v) do { f32x4 _o; _o[0] = __shfl_xor((v)[0], 2); _o[1] = __shfl_xor((v)[1], 2); _o[2] = __shfl_xor((v)[2], 2); _o[3] = __shfl_xor((v)[3], 2); if (l16 < 4) (v) = (v) * cs + sgn * (_o * sn); } while (0)
#define HNORM4(v, w) do { const float _ss = g16_sum((v)[0] * (v)[0] + (v)[1] * (v)[1] + (v)[2] * (v)[2] + (v)[3] * (v)[3]); (v) = (v) * rsqrtf(_ss * (1.0f / 64.0f) + 1e-6f) * (w); } while (0)
#pragma unroll
        for (int i = 0; i < 4; ++i) { f32x4 v = ld_bf4(pr + 256 * i + 4 * lane); HNORM4(v, qn); ROPE4(v); st_bf4((bf16_t*)Q + (size_t)row * D + 256 * i + 4 * lane, v); }
        { f32x4 v = ld_bf4(pr + 1024 + 4 * lane); HNORM4(v, kn); ROPE4(v);
          float* ko = row < NP ? p->out + O_KP + ((size_t)j * NP + row) * 256 : p->out + O_KS + ((size_t)j * NS + (row - NP)) * 256; *(f32x4*)(ko + 4 * lane) = v; *(unsigned*)(WSP(unsigned char, WS_K8) + (size_t)row * 256 + 4 * lane) = pk_fp8x4(v); }
        { const f32x4 v = ld_bf4(pr + 1280 + 4 * lane);
          float* vo = row < NP ? p->out + O_VP + ((size_t)j * NP + row) * 256 : p->out + O_VS + ((size_t)j * NS + (row - NP)) * 256; *(f32x4*)(vo + 4 * lane) = v; *(unsigned*)(WSP(unsigned char, WS_V8) + (size_t)row * 256 + 4 * lane) = pk_fp8x4(v); }
#pragma unroll
        for (int i = 0; i < 2; ++i) { f32x4 v = ld_bf4(pr + 1536 + 256 * i + 4 * lane); ROPE4(v); st_bf4(WSP(bf16_t, WS_QIB) + (size_t)row * 512 + 256 * i + 4 * lane, v); }
        { f32x4 v = ld_bf4(pr + 2048 + 4 * l16); HNORM4(v, in); ROPE4(v);
          float* io = row < NP ? p->out + O_IKP + ((size_t)j * NP + row) * 64 : p->out + O_IKS + ((size_t)j * NS + (row - NP)) * 64; if (lane < 16) { *(f32x4*)(io + 4 * lane) = v; st_bf4(WSP(bf16_t, WS_KIB) + (size_t)row * 64 + 4 * lane, v); } }
        if (lane < 2) { const f32x4 v = ld_bf4(pr + 2112 + 4 * lane); *(f32x4*)(WI + (size_t)row * 8 + 4 * lane) = v * 0.35355339059327373f; }
#undef ROPE4
#undef HNORM4
    }
}

template <bool SAMPLE>
__device__ __forceinline__ void phase_idx(KP p, int j, LAS unsigned char* lds) {
    LAS float* Qs = (LAS float*)lds;
    LAS float* Ks = (LAS float*)(lds + 32768);
    const float *QI = WSP(float, WS_QI), *WI = WSP(float, WS_WI);
    const int tid = TID(), q = tid >> 5, kx = tid & 31;
    const int nitems = SAMPLE ? 32 * 65 : 1024;
    for (int it = BID(); it < nitems; it += gridDim.x) {
        int b, t0, rowbase, nkt, kt0 = 0;
        if (SAMPLE) { b = it / 65; kt0 = it % 65; t0 = 0; rowbase = NP + b * 8; nkt = kt0 + 1; }
        else { const int k4 = it >> 8, w = it & 255, i = (k4 & 1) ? (k4 * 256 + 255 - w) : (k4 * 256 + w); b = i & 3; t0 = (i >> 2) * 16; rowbase = b * 4096 + t0; nkt = (t0 + 15) / 128 + 1; }
        const int nq = SAMPLE ? 8 : 16;
        __syncthreads();
#pragma unroll
        for (int n = 0; n < 16; ++n) { const int e = tid + 512 * n, qq = e >> 9, c = e & 511, h = c >> 6, d = c & 63;
            Qs[(d * 16 + qq) * 8 + h] = qq < nq ? QI[(size_t)(rowbase + qq) * 512 + c] : 0.f; }
        float wi[8];
#pragma unroll
        for (int h = 0; h < 8; ++h) wi[h] = q < nq ? WI[(size_t)(rowbase + q) * 8 + h] : 0.f;
        for (int kt = kt0; kt < nkt; ++kt) {
            __syncthreads();
#pragma unroll
            for (int n = 0; n < 16; ++n) { const int e = tid + 512 * n, key = e >> 6, d = e & 63, s = kt * 128 + key; float v = 0.f;
                if (SAMPLE) {
                    if (s < PAST) { const int pg = p->page_table[b * 64 + (s >> 7)]; v = p->cache_ik[(((size_t)j * 2560 + pg) * 128 + (s & 127)) * 64 + d]; }
                    else if (s < PAST + 8) v = p->out[O_IKS + ((size_t)j * NS + b * 8 + (s - PAST)) * 64 + d];
                } else v = p->out[O_IKP + ((size_t)j * NP + b * 4096 + s) * 64 + d];
                Ks[d * 132 + key] = v; }
            __syncthreads();
            f32x4 acc[8];
#pragma unroll
            for (int h = 0; h < 8; ++h) acc[h] = (f32x4){0.f, 0.f, 0.f, 0.f};
#pragma unroll 4
            for (int d = 0; d < 64; ++d) {
                const f32x4 qa = *(const LAS f32x4*)(Qs + (d * 16 + q) * 8), qb = *(const LAS f32x4*)(Qs + (d * 16 + q) * 8 + 4), kv = *(const LAS f32x4*)(Ks + d * 132 + 4 * kx);
                acc[0] += qa[0] * kv; acc[1] += qa[1] * kv; acc[2] += qa[2] * kv; acc[3] += qa[3] * kv;
                acc[4] += qb[0] * kv; acc[5] += qb[1] * kv; acc[6] += qb[2] * kv; acc[7] += qb[3] * kv;
            }
            f32x4 sc = {0.f, 0.f, 0.f, 0.f};
#pragma unroll
            for (int h = 0; h < 8; ++h)
#pragma unroll
                for (int e = 0; e < 4; ++e) sc[e] += fmaxf(acc[h][e] * 0.125f, 0.f) * wi[h];
            if (q < nq) {
                if (SAMPLE) *(f32x4*)(WSP(float, WS_SCS) + (size_t)(b * 8 + q) * SCS_LD + kt * 128 + 4 * kx) = sc;
                else *(f32x4*)(WSP(float, WS_SC) + ((size_t)b * 4096 + t0 + q) * 4096 + kt * 128 + 4 * kx) = sc;
            }
        }
    }
    __syncthreads();
}

template <bool SAMPLE>
__device__ __forceinline__ void phase_idx2(KP p, int j) {
    const bf16_t *QIB = WSP(bf16_t, WS_QIB), *KIB = WSP(bf16_t, WS_KIB); const float* WI = WSP(float, WS_WI);
    const int lane = TID() & 63, lr = lane & 31, lh = lane >> 5, gw = BID() * 8 + (TID() >> 6), nw = gridDim.x * 8;
    const int nitems = SAMPLE ? 32 * 65 : 4096;
    for (int it = gw; it < nitems; it += nw) {
        int b, rowbase, tile0, ntile;
        if (SAMPLE) { b = it / 65; rowbase = NP + b * 8; tile0 = (it % 65) * 4; ntile = min(4, 257 - tile0); }
        else { const int sub = it >= 2048, w_ = it & 2047; b = w_ & 3; const int wb = w_ >> 2, kk = sub ? 511 - wb : wb, nt = (kk * 8 + 7) / 32 + 1;
            rowbase = b * 4096 + kk * 8; tile0 = sub ? (nt >> 1) : 0; ntile = sub ? nt - (nt >> 1) : (nt >> 1); }
        if (ntile <= 0) continue;
        bf16x8 af[2][4]; float w[2][2][8];
        { const int hd = (lr & 3) + 4 * ((lr >> 3) & 1), jq = 2 * ((lr >> 2) & 1) + (lr >> 4);
#pragma unroll
          for (int st = 0; st < 2; ++st)
#pragma unroll
              for (int ks = 0; ks < 4; ++ks) af[st][ks] = *(const bf16x8*)(QIB + (size_t)(rowbase + 4 * st + jq) * 512 + hd * 64 + 16 * ks + 8 * lh);
#pragma unroll
          for (int st = 0; st < 2; ++st)
#pragma unroll
              for (int q = 0; q < 2; ++q) { const f32x4 w0 = *(const f32x4*)(WI + (size_t)(rowbase + 4 * st + 2 * lh + q) * 8), w1 = *(const f32x4*)(WI + (size_t)(rowbase + 4 * st + 2 * lh + q) * 8 + 4);
#pragma unroll
                  for (int e = 0; e < 4; ++e) { w[st][q][e] = w0[e] * 0.125f; w[st][q][4 + e] = w1[e] * 0.125f; } } }
#define IDX_LOADB(BF, tl_) do { const int s_ = (tile0 + (tl_)) * 32 + lr; \
            if (!SAMPLE) { _Pragma("unroll") for (int ks = 0; ks < 4; ++ks) BF[ks] = *(const bf16x8*)(KIB + ((size_t)b * 4096 + s_) * 64 + 16 * ks + 8 * lh); } \
            else { const float* kp = p->out + O_IKS + ((size_t)j * NS + b * 8) * 64; \
                if (s_ < PAST) kp = p->cache_ik + (((size_t)j * 2560 + p->page_table[b * 64 + (s_ >> 7)]) * 128 + (s_ & 127)) * 64; else kp += (size_t)min(s_ - PAST, 7) * 64; \
                _Pragma("unroll") for (int ks = 0; ks < 4; ++ks) { const f32x4 x0 = *(const f32x4*)(kp + 16 * ks + 8 * lh), x1 = *(const f32x4*)(kp + 16 * ks + 8 * lh + 4); \
                    const u32x4 wv = {pk_bf16(x0[0], x0[1]), pk_bf16(x0[2], x0[3]), pk_bf16(x1[0], x1[1]), pk_bf16(x1[2], x1[3])}; BF[ks] = __builtin_bit_cast(bf16x8, wv); } } } while (0)
        bf16x8 bnx[4];
        IDX_LOADB(bnx, 0);
        for (int tl = 0; tl < ntile; ++tl) {
            const int s = (tile0 + tl) * 32 + lr;
            bf16x8 bfr[4];
#pragma unroll
            for (int ks = 0; ks < 4; ++ks) bfr[ks] = bnx[ks];
            if (tl + 1 < ntile) IDX_LOADB(bnx, tl + 1);
            __builtin_amdgcn_sched_barrier(0);
#pragma unroll
            for (int st = 0; st < 2; ++st) {
                f32x16 acc;
#pragma unroll
                for (int r = 0; r < 16; ++r) acc[r] = 0.f;
#pragma unroll
                for (int ks = 0; ks < 4; ++ks) acc = __builtin_amdgcn_mfma_f32_32x32x16_bf16(af[st][ks], bfr[ks], acc, 0, 0, 0);
#pragma unroll
                for (int q = 0; q < 2; ++q) {
                    float sc = 0.f;
#pragma unroll
                    for (int hh = 0; hh < 2; ++hh)
#pragma unroll
                        for (int hl = 0; hl < 4; ++hl) sc += fmaxf(acc[4 * (2 * q + hh) + hl], 0.f) * w[st][q][hl + 4 * hh];
                    if (SAMPLE) WSP(float, WS_SCS)[(size_t)(b * 8 + 4 * st + 2 * lh + q) * SCS_LD + s] = sc;
                    else WSP(float, WS_SC)[((size_t)rowbase + 4 * st + 2 * lh + q) * 4096 + s] = sc;
                }
            }
        }
    }
#undef IDX_LOADB
}

__device__ __forceinline__ unsigned fkey(float f) { f = (f == 0.f) ? 0.f : f; const unsigned u = __float_as_uint(f); return (u & 0x80000000u) ? ~u : (u | 0x80000000u); }
__device__ __forceinline__ void phase_topk_prompt(KP p) {
    const float* SC = WSP(float, WS_SC); int* SEL = WSP(int, WS_SEL); int* CNT = WSP(int, WS_CNT);
    const int lane = TID() & 63, gw = BID() * 8 + (TID() >> 6), nw = gridDim.x * 8;
    for (int qi = gw; qi < NP; qi += nw) {
        const int b = qi & 3, tt = qi >> 2, t = (tt & 1) ? 4095 - (tt >> 1) : (tt >> 1), row = b * 4096 + t, n = t + 1;
        int* sel = SEL + (size_t)row * 256;
        if (n <= TOPK) { for (int s = lane; s < n; s += 64) sel[s] = s; if (lane == 0) CNT[row] = n; continue; }
        const float* base = SC + (size_t)row * 4096;
        const int nb = __builtin_amdgcn_readfirstlane((n + 1023) >> 10);
        unsigned u[64];
#pragma unroll
        for (int kb = 0; kb < 4; ++kb) {
            if (kb < nb) {
#pragma unroll
                for (int m = 16 * kb; m < 16 * kb + 16; ++m) u[m] = __float_as_uint(base[lane + 64 * m]);
            } else {
#pragma unroll
                for (int m = 16 * kb; m < 16 * kb + 16; ++m) u[m] = 0u;
            }
        }
#pragma unroll
        for (int m = 0; m < 64; ++m) { const unsigned k_ = fkey(__uint_as_float(u[m])); u[m] = (lane + 64 * m < n) ? k_ : 0u; }
        unsigned tau = 0u;
#pragma unroll 1
        for (int bit = 31; bit >= 0; --bit) {
            const unsigned cand = tau | (1u << bit); int c = 0;
#pragma unroll
            for (int m = 0; m < 16; ++m) c += (u[m] >= cand) ? 1 : 0;
            if (nb > 1) {
#pragma unroll
                for (int m = 16; m < 32; ++m) c += (u[m] >= cand) ? 1 : 0;
                if (nb > 2) {
#pragma unroll
                    for (int m = 32; m < 48; ++m) c += (u[m] >= cand) ? 1 : 0;
                    if (nb > 3) {
#pragma unroll
                        for (int m = 48; m < 64; ++m) c += (u[m] >= cand) ? 1 : 0;
                    }
                }
            }
            c = wave_sum_i(c);
            if (c >= TOPK) tau = cand;
            if (c == TOPK) break;
        }
        int cg = 0, ct = 0; unsigned tlo = 0u, thi = 0u;
#pragma unroll
        for (int m = 31; m >= 0; --m) { cg += (u[m] > tau) ? 1 : 0; const unsigned tie = (u[m] == tau) ? 1u : 0u; ct += (int)tie; tlo = (tlo << 1) | tie; }
#pragma unroll
        for (int m = 63; m >= 32; --m) { cg += (u[m] > tau) ? 1 : 0; const unsigned tie = (u[m] == tau) ? 1u : 0u; ct += (int)tie; thi = (thi << 1) | tie; }
        unsigned long long tmask = ((unsigned long long)thi << 32) | tlo;
        const int totg = wave_sum_i(cg), tott = wave_sum_i(ct);
        const int need = TOPK - totg;
        unsigned long long smask = 0ull;
        if (tott == need) smask = tmask;
        else {
#pragma unroll 1
            for (int it = 0; it < need; ++it) {
                const int m0 = tmask ? (int)__builtin_ctzll(tmask) : 64;
                const int cand = tmask ? (lane + 64 * m0) : 0x7fffffff, best = wave_min_i(cand);
                if (cand == best && tmask) { smask |= (1ull << m0); tmask &= ~(1ull << m0); }
            }
        }
        const int mine = cg + __popcll(smask);
        int incl = mine;
#pragma unroll
        for (int d = 1; d < 64; d <<= 1) { const int o = __shfl_up(incl, d); if (lane >= d) incl += o; }
        int off = incl - mine;
#pragma unroll
        for (int m = 0; m < 64; ++m) { if ((u[m] > tau) || ((smask >> m) & 1ull)) { sel[off] = lane + 64 * m; ++off; } }
        if (lane == 0) CNT[row] = TOPK;
    }
}
__device__ __forceinline__ void phase_topk_sample(KP p, LAS unsigned char* lds) {
    LAS unsigned* ckey = (LAS unsigned*)lds;
    LAS int* cidx = (LAS int*)(lds + 8192);
    const float* SCS = WSP(float, WS_SCS); int* SEL = WSP(int, WS_SEL); int* CNT = WSP(int, WS_CNT);
    for (int qq = BID(); qq < NS; qq += gridDim.x) {
        const int tid = TID(), lane = tid & 63, wave = tid >> 6;
        const int n = PAST + 1 + (qq & 7), row = NP + qq, s0 = 1088 * wave;
        const float* base = SCS + (size_t)qq * SCS_LD;
        unsigned u[17];
#pragma unroll
        for (int m = 0; m < 17; ++m) { const int s = s0 + lane + 64 * m; u[m] = __float_as_uint(base[s < SCS_LD ? s : 0]); }
#pragma unroll
        for (int m = 0; m < 17; ++m) { const unsigned k_ = fkey(__uint_as_float(u[m])); u[m] = (s0 + lane + 64 * m < n) ? k_ : 0u; }
        __syncthreads();
        {
            int nvalid = 0;
#pragma unroll
            for (int m = 0; m < 17; ++m) nvalid += (u[m] != 0u) ? 1 : 0;
            nvalid = wave_sum_i(nvalid);
            unsigned tau = 0u; int need = 0; unsigned tmask = 0u, smask = 0u;
            if (nvalid > TOPK) {
#pragma unroll 1
                for (int bit = 31; bit >= 0; --bit) {
                    const unsigned cand = tau | (1u << bit); int c = 0;
#pragma unroll
                    for (int m = 0; m < 17; ++m) c += (u[m] >= cand) ? 1 : 0;
                    c = wave_sum_i(c);
                    if (c >= TOPK) tau = cand;
                    if (c == TOPK) break;
                }
                int cg = 0, ct = 0;
#pragma unroll
                for (int m = 0; m < 17; ++m) { cg += (u[m] > tau) ? 1 : 0; const bool tie = (u[m] == tau); ct += tie ? 1 : 0; tmask |= tie ? (1u << m) : 0u; }
                cg = wave_sum_i(cg); ct = wave_sum_i(ct);
                need = TOPK - cg;
                if (ct == need) smask = tmask;
                else {
#pragma unroll 1
                    for (int it = 0; it < need; ++it) {
                        const int m0 = tmask ? (int)__builtin_ctz(tmask) : 32;
                        const int cand = tmask ? (lane + 64 * m0) : 0x7fffffff, best = wave_min_i(cand);
                        if (cand == best && tmask) { smask |= (1u << m0); tmask &= ~(1u << m0); }
                    }
                }
            } else { tau = 0u; smask = 0u; }
            int mine = 0;
#pragma unroll
            for (int m = 0; m < 17; ++m) mine += ((u[m] > tau) || ((smask >> m) & 1u)) ? 1 : 0;
            int incl = mine;
#pragma unroll
            for (int d = 1; d < 64; d <<= 1) { const int o = __shfl_up(incl, d); if (lane >= d) incl += o; }
            int off = incl - mine;
            const int total = __builtin_amdgcn_readlane(incl, 63);
#pragma unroll
            for (int m = 0; m < 17; ++m) { if ((u[m] > tau) || ((smask >> m) & 1u)) { ckey[wave * 256 + off] = u[m]; cidx[wave * 256 + off] = s0 + lane + 64 * m; ++off; } }
            for (int e = total + lane; e < 256; e += 64) { ckey[wave * 256 + e] = 0u; cidx[wave * 256 + e] = 0x7fffffff; }
        }
        __syncthreads();
        if (wave == 0) {
            unsigned v[32]; int ix[32];
#pragma unroll
            for (int m = 0; m < 32; ++m) { v[m] = ckey[lane + 64 * m]; ix[m] = cidx[lane + 64 * m]; }
            unsigned tau = 0u;
#pragma unroll 1
            for (int bit = 31; bit >= 0; --bit) {
                const unsigned cand = tau | (1u << bit); int c = 0;
#pragma unroll
                for (int m = 0; m < 32; ++m) c += (v[m] >= cand) ? 1 : 0;
                c = wave_sum_i(c);
                if (c >= TOPK) tau = cand;
                if (c == TOPK) break;
            }
            int cg = 0, ct = 0; unsigned tmask = 0u, smask = 0u;
#pragma unroll
            for (int m = 31; m >= 0; --m) { cg += (v[m] > tau) ? 1 : 0; const unsigned tie = (v[m] == tau) ? 1u : 0u; ct += (int)tie; tmask = (tmask << 1) | tie; }
            cg = wave_sum_i(cg); ct = wave_sum_i(ct);
            const int need = TOPK - cg;
            if (ct == need) smask = tmask;
            else {
#pragma unroll 1
                for (int it = 0; it < need; ++it) {
                    int bi = 0x7fffffff, bm = 0;
#pragma unroll
                    for (int m = 0; m < 32; ++m) { const bool t_ = (tmask >> m) & 1u; if (t_ && ix[m] < bi) { bi = ix[m]; bm = m; } }
                    const int best = wave_min_i(bi);
                    if (bi == best && bi != 0x7fffffff) { smask |= (1u << bm); tmask &= ~(1u << bm); }
                }
            }
            int mine = 0;
#pragma unroll
            for (int m = 0; m < 32; ++m) mine += ((v[m] > tau) || ((smask >> m) & 1u)) ? 1 : 0;
            int incl = mine;
#pragma unroll
            for (int d = 1; d < 64; d <<= 1) { const int o = __shfl_up(incl, d); if (lane >= d) incl += o; }
            int off = incl - mine;
            int* sel = SEL + (size_t)row * 256;
#pragma unroll
            for (int m = 0; m < 32; ++m) { if ((v[m] > tau) || ((smask >> m) & 1u)) { if (off < TOPK) sel[off] = ix[m]; ++off; } }
            if (lane == 0) CNT[row] = TOPK;
        }
    }
    __syncthreads();
}

template <bool SAMPLE>
__device__ __forceinline__ void phase_attn(KP p, int j, LAS unsigned char* lds) {
    const int tid = TID(), lane = tid & 63, wave = tid >> 6, n16 = lane & 15, c4 = lane >> 4;
    LAS bf16_t* ps = (LAS bf16_t*)(lds + wave * 16384);
    LAS int* is = (LAS int*)(lds + wave * 16384 + 8192);
    LAS bf16_t* qs = (LAS bf16_t*)(lds + wave * 16384 + 9216);
    LAS float* invs = (LAS float*)(lds + wave * 16384 + 11264);
    const float* Q = WSP(float, WS_Q); const int* SEL = WSP(int, WS_SEL); const int* CNT = WSP(int, WS_CNT); bf16_t* O = WSP(bf16_t, WS_YG);
    const bf16_t *KBF = WSP(bf16_t, WS_KBF), *VBF = WSP(bf16_t, WS_VBF);
    const float* kc = p->cache_k + (size_t)j * 2560 * 128 * 256; const float* vc = p->cache_v + (size_t)j * 2560 * 128 * 256;
    const float* knew = p->out + O_KS + (size_t)j * NS * 256; const float* vnew = p->out + O_VS + (size_t)j * NS * 256;
    const int gw = BID() * 8 + wave, nw = gridDim.x * 8, nq = SAMPLE ? NS : NP;
    unsigned* qctr = WSP(unsigned, WS_BAR + 40960) + (size_t)j * 256;
    int qb = 0, qnext = 0, qsub = 2, qcur = 0;
    if (!SAMPLE) { unsigned v_ = 0u; if (lane == 0) v_ = __hip_atomic_fetch_add(qctr + 16 * ((BID() + qb) & 3), 2u, __ATOMIC_RELAXED, __HIP_MEMORY_SCOPE_AGENT); qnext = (int)__builtin_amdgcn_readfirstlane(v_); }
    for (int qi = gw; SAMPLE ? (qi < nq) : true; qi += nw) {
        int row;
        if (SAMPLE) row = NP + qi;
        else {
            if (qsub == 2) {
                for (;;) {
                    qcur = qnext; qsub = 0;
                    if (qcur < 4096 || qb == 3) break;
                    ++qb; unsigned v_ = 0u; if (lane == 0) v_ = __hip_atomic_fetch_add(qctr + 16 * ((BID() + qb) & 3), 2u, __ATOMIC_RELAXED, __HIP_MEMORY_SCOPE_AGENT); qnext = (int)__builtin_amdgcn_readfirstlane(v_);
                }
                if (qcur >= 4096) break;
                { unsigned v_ = 0u; if (lane == 0) v_ = __hip_atomic_fetch_add(qctr + 16 * ((BID() + qb) & 3), 2u, __ATOMIC_RELAXED, __HIP_MEMORY_SCOPE_AGENT); qnext = (int)__builtin_amdgcn_readfirstlane(v_); }
            }
            row = ((BID() + qb) & 3) * 4096 + (4095 - (qcur + qsub)); ++qsub;
        }
        const int n = CNT[row];
        wave_lds_fence();
#pragma unroll
        for (int c = 0; c < 4; ++c) { const int slot = lane + 64 * c;
            int s = SEL[(size_t)row * 256 + slot]; const bool ok = slot < n;
            int r;
            if (SAMPLE) { const int bb = (row - NP) >> 3; s = ok ? s : 0; const int sp = min(max(s, 0), PAST - 1); const int pg = p->page_table[bb * 64 + (sp >> 7)];
                r = (s < PAST) ? pg * 128 + (s & 127) : (0x40000000 | (bb * 8 + min(s - PAST, 7))); }
            else r = (row & ~4095) + (ok ? s : 0);
            is[slot] = r; }
#pragma unroll
        for (int i = 0; i < 4; ++i) { const f32x4 q4 = ld_bf4((const bf16_t*)Q + (size_t)row * D + 256 * i + 4 * lane);
            if (SAMPLE) { const f32x4 q8 = q4 * 0.125f; u32x2 w; w.x = pk_bf16(q8[0], q8[1]); w.y = pk_bf16(q8[2], q8[3]); *(LAS u32x2*)(qs + 256 * i + 4 * lane) = w; }
            else *(LAS unsigned*)((LAS unsigned char*)qs + 256 * i + 4 * lane) = pk_fp8x4(q4); }
        wave_lds_fence();
        {
            float mx = -__builtin_huge_valf();
#define ATT_EMIT(t_, acc_) do { f32x4 l_ = (acc_); _Pragma("unroll") for (int r = 0; r < 4; ++r) { if (16 * (t_) + 4 * c4 + r >= n) l_[r] = -__builtin_huge_valf(); mx = fmaxf(mx, l_[r]); } \
                u32x2 w_; w_.x = pk_bf16(l_[0], l_[1]); w_.y = pk_bf16(l_[2], l_[3]); *(LAS u32x2*)(ps + n16 * 256 + 16 * (t_) + 4 * c4) = w_; } while (0)
            if (SAMPLE) {
                const u32x4 qf0 = *(const LAS u32x4*)(qs + n16 * 64 + 8 * c4), qf1 = *(const LAS u32x4*)(qs + n16 * 64 + 32 + 8 * c4);
                u32x4 bq[8];
#pragma unroll
                for (int ks = 0; ks < 8; ++ks) { const bool on = (n16 >> 2) == (ks >> 1); const u32x4 qv = (ks & 1) ? qf1 : qf0; bq[ks] = (u32x4){on ? qv.x : 0u, on ? qv.y : 0u, on ? qv.z : 0u, on ? qv.w : 0u}; }
#pragma unroll 2
                for (int t = 0; t < 16; ++t) {
                    const int r = is[16 * t + n16];
                    const float* kp = ((r & 0x40000000) ? knew + (size_t)(r & 0xffff) * 256 : kc + (size_t)r * 256) + 8 * c4;
                    f32x4 acc = {0.f, 0.f, 0.f, 0.f};
#pragma unroll
                    for (int ks = 0; ks < 8; ++ks) { const f32x4 x0 = *(const f32x4*)(kp + 32 * ks), x1 = *(const f32x4*)(kp + 32 * ks + 4);
                        const u32x4 ka = {pk_bf16(x0[0], x0[1]), pk_bf16(x0[2], x0[3]), pk_bf16(x1[0], x1[1]), pk_bf16(x1[2], x1[3])};
                        acc = __builtin_amdgcn_mfma_f32_16x16x32_bf16(__builtin_bit_cast(bf16x8, ka), __builtin_bit_cast(bf16x8, bq[ks]), acc, 0, 0, 0); }
                    ATT_EMIT(t, acc);
                }
            } else {
                const LAS unsigned char* q8 = (const LAS unsigned char*)qs;
                long bq[8];
                { const bool on = (n16 >> 2) == c4;
#pragma unroll
                  for (int h2 = 0; h2 < 4; ++h2) { const u32x4 qv = *(const LAS u32x4*)(q8 + n16 * 64 + 16 * h2);
                      const u32x2 z0 = {on ? qv.x : 0u, on ? qv.y : 0u}, z1 = {on ? qv.z : 0u, on ? qv.w : 0u}; bq[2 * h2] = __builtin_bit_cast(long, z0); bq[2 * h2 + 1] = __builtin_bit_cast(long, z1); } }
                const unsigned char* K8 = WSP(unsigned char, WS_K8);
#pragma unroll
                for (int th = 0; th < 2; ++th) {
                    if (th) asm volatile("" ::: "memory");
                    u32x4 ka[8][4];
#pragma unroll
                    for (int t8 = 0; t8 < 8; ++t8) {
                        const int r = is[16 * (8 * th + t8) + n16];
                        const unsigned char* kp = K8 + (size_t)r * 256 + 64 * c4;
#pragma unroll
                        for (int h2 = 0; h2 < 4; ++h2) ka[t8][h2] = *(const u32x4*)(kp + 16 * h2);
                    }
                    __builtin_amdgcn_sched_barrier(0);
#pragma unroll
                    for (int t8 = 0; t8 < 8; ++t8) {
                        f32x4 acc = {0.f, 0.f, 0.f, 0.f};
#pragma unroll
                        for (int h2 = 0; h2 < 4; ++h2) { const u32x2 lo = {ka[t8][h2].x, ka[t8][h2].y}, hi = {ka[t8][h2].z, ka[t8][h2].w};
                            acc = __builtin_amdgcn_mfma_f32_16x16x32_fp8_fp8(__builtin_bit_cast(long, lo), bq[2 * h2], acc, 0, 0, 0);
                            acc = __builtin_amdgcn_mfma_f32_16x16x32_fp8_fp8(__builtin_bit_cast(long, hi), bq[2 * h2 + 1], acc, 0, 0, 0); }
                        ATT_EMIT(8 * th + t8, acc * 0.125f);
                    }
                }
            }
#undef ATT_EMIT
            mx = fmaxf(mx, __shfl_xor(mx, 16)); mx = fmaxf(mx, __shfl_xor(mx, 32));
            float sm = 0.f;
            u32x2 lw_[16];
#pragma unroll
            for (int t = 0; t < 16; ++t) lw_[t] = *(const LAS u32x2*)(ps + n16 * 256 + 16 * t + 4 * c4);
#pragma unroll
            for (int t = 0; t < 16; ++t) {
                const u32x2 w = lw_[t];
                const float e0 = __expf(bflo(w.x) - mx), e1 = __expf(bfhi(w.x) - mx), e2 = __expf(bflo(w.y) - mx), e3 = __expf(bfhi(w.y) - mx);
                sm += (e0 + e1) + (e2 + e3);
                u32x2 o_; o_.x = pk_bf16(e0, e1); o_.y = pk_bf16(e2, e3); *(LAS u32x2*)(ps + n16 * 256 + 16 * t + 4 * c4) = o_;
            }
            sm += __shfl_xor(sm, 16); sm += __shfl_xor(sm, 32);
            if (c4 == 0) invs[n16] = 1.0f / sm;
        }
        wave_lds_fence();
        if (!SAMPLE) {
            const unsigned char* V8 = WSP(unsigned char, WS_V8);
            const int rs = c4, kvh = n16 >> 2, nst = n > 64 ? 64 : n;
            f32x4 oa[4][4];
#pragma unroll
            for (int g = 0; g < 4; ++g)
#pragma unroll
                for (int q = 0; q < 4; ++q) oa[g][q] = (f32x4){0.f, 0.f, 0.f, 0.f};
            u32x4 vr[8], vn[8];
#pragma unroll
            for (int i = 0; i < 8; ++i) vn[i] = *(const u32x4*)(V8 + (size_t)is[64 * rs + i] * 256 + 16 * n16);
            for (int m0 = 0; m0 < nst; m0 += 8) {
#pragma unroll
                for (int i = 0; i < 8; ++i) vr[i] = vn[i];
                if (m0 + 8 < nst) {
#pragma unroll
                    for (int i = 0; i < 8; ++i) vn[i] = *(const u32x4*)(V8 + (size_t)is[64 * rs + m0 + 8 + i] * 256 + 16 * n16);
                }
                __builtin_amdgcn_sched_barrier(0);
#pragma unroll
                for (int h4 = 0; h4 < 2; ++h4) {
                    u32x2 pg[4];
#pragma unroll
                    for (int g = 0; g < 4; ++g) pg[g] = *(const LAS u32x2*)(ps + (kvh * 4 + g) * 256 + 64 * rs + m0 + 4 * h4);
#pragma unroll
                    for (int i = 0; i < 4; ++i) {
                        const u32x4 v_ = vr[4 * h4 + i];
                        const f32x4 v0 = fp8x4_f32(v_.x), v1 = fp8x4_f32(v_.y), v2 = fp8x4_f32(v_.z), v3 = fp8x4_f32(v_.w);
#pragma unroll
                        for (int g = 0; g < 4; ++g) { const unsigned pw = (i < 2) ? pg[g].x : pg[g].y; const float pf = (i & 1) ? bfhi(pw) : bflo(pw);
                            oa[g][0] += pf * v0; oa[g][1] += pf * v1; oa[g][2] += pf * v2; oa[g][3] += pf * v3; }
                    }
                }
            }
#pragma unroll
            for (int g = 0; g < 4; ++g)
#pragma unroll
                for (int q = 0; q < 4; ++q)
#pragma unroll
                    for (int e_ = 0; e_ < 4; ++e_) { float x = oa[g][q][e_]; x += __shfl_xor(x, 16); x += __shfl_xor(x, 32); oa[g][q][e_] = x; }
            if (rs == 0) {
                const f32x4 iv = *(const LAS f32x4*)(invs + 4 * kvh);
#pragma unroll
                for (int g = 0; g < 4; ++g) { bf16_t* op = O + (size_t)row * D + (kvh * 4 + g) * 64 + 16 * (n16 & 3);
                    u32x4 w0, w1; const float sc_ = iv[g];
                    w0.x = pk_bf16(oa[g][0][0] * sc_, oa[g][0][1] * sc_); w0.y = pk_bf16(oa[g][0][2] * sc_, oa[g][0][3] * sc_); w0.z = pk_bf16(oa[g][1][0] * sc_, oa[g][1][1] * sc_); w0.w = pk_bf16(oa[g][1][2] * sc_, oa[g][1][3] * sc_);
                    w1.x = pk_bf16(oa[g][2][0] * sc_, oa[g][2][1] * sc_); w1.y = pk_bf16(oa[g][2][2] * sc_, oa[g][2][3] * sc_); w1.z = pk_bf16(oa[g][3][0] * sc_, oa[g][3][1] * sc_); w1.w = pk_bf16(oa[g][3][2] * sc_, oa[g][3][3] * sc_);
                    *(u32x4*)op = w0; *(u32x4*)(op + 8) = w1; }
            }
        } else {
        f32x4 o0 = {0.f, 0.f, 0.f, 0.f}, o1 = o0, o2 = o0, o3 = o0;
        constexpr int GV = SAMPLE ? 16 : 32;
        const int ng = (n + GV - 1) / GV;
        unsigned vb[SAMPLE ? 1 : GV], vbn[SAMPLE ? 1 : GV]; f32x4 vf[SAMPLE ? GV : 1];
        const unsigned char* V8 = WSP(unsigned char, WS_V8);
        if (!SAMPLE) {
#pragma unroll
            for (int i = 0; i < GV; ++i) vbn[i] = *(const unsigned*)(V8 + (size_t)is[i] * 256 + 4 * lane);
        }
#pragma unroll 1
        for (int g = 0; g < ng; ++g) {
            if (!SAMPLE) {
#pragma unroll
                for (int i = 0; i < GV; ++i) vb[i] = vbn[i];
                if (g + 1 < ng) {
#pragma unroll
                    for (int i = 0; i < GV; ++i) vbn[i] = *(const unsigned*)(V8 + (size_t)is[GV * (g + 1) + i] * 256 + 4 * lane);
                }
                __builtin_amdgcn_sched_barrier(0);
            } else {
#pragma unroll
                for (int i = 0; i < GV; ++i) { const int r = is[GV * g + i]; vf[i] = *(const f32x4*)(((r & 0x40000000) ? vnew + (size_t)(r & 0xffff) * 256 : vc + (size_t)r * 256) + 4 * lane); }
            }
#pragma unroll
            for (int i4 = 0; i4 < GV / 4; ++i4) {
                const u32x2 p0 = *(const LAS u32x2*)(ps + (c4 * 4 + 0) * 256 + GV * g + 4 * i4), p1 = *(const LAS u32x2*)(ps + (c4 * 4 + 1) * 256 + GV * g + 4 * i4),
                            p2 = *(const LAS u32x2*)(ps + (c4 * 4 + 2) * 256 + GV * g + 4 * i4), p3 = *(const LAS u32x2*)(ps + (c4 * 4 + 3) * 256 + GV * g + 4 * i4);
                f32x4 v0, v1, v2, v3;
                if (!SAMPLE) { v0 = fp8x4_f32(vb[4 * i4]); v1 = fp8x4_f32(vb[4 * i4 + 1]); v2 = fp8x4_f32(vb[4 * i4 + 2]); v3 = fp8x4_f32(vb[4 * i4 + 3]); }
                else { v0 = vf[4 * i4]; v1 = vf[4 * i4 + 1]; v2 = vf[4 * i4 + 2]; v3 = vf[4 * i4 + 3]; }
                o0 += bflo(p0.x) * v0 + bfhi(p0.x) * v1 + bflo(p0.y) * v2 + bfhi(p0.y) * v3;
                o1 += bflo(p1.x) * v0 + bfhi(p1.x) * v1 + bflo(p1.y) * v2 + bfhi(p1.y) * v3;
                o2 += bflo(p2.x) * v0 + bfhi(p2.x) * v1 + bflo(p2.y) * v2 + bfhi(p2.y) * v3;
                o3 += bflo(p3.x) * v0 + bfhi(p3.x) * v1 + bflo(p3.y) * v2 + bfhi(p3.y) * v3;
            }
        }
        { const f32x4 iv = *(const LAS f32x4*)(invs + 4 * c4); bf16_t* op = O + (size_t)row * D + c4 * 256 + 4 * n16; st_bf4(op, o0 * iv[0]); st_bf4(op + 64, o1 * iv[1]); st_bf4(op + 128, o2 * iv[2]); st_bf4(op + 192, o3 * iv[3]); }
        }
    }
}

__global__ void __launch_bounds__(512, 2) mega(P p_unused) {
    extern __shared__ __attribute__((aligned(16))) unsigned char lds_raw[];
    LAS unsigned char* lds = (LAS unsigned char*)lds_raw;
    volatile LAS unsigned* misc = (volatile LAS unsigned*)(lds + LDS_MISC);
    if (TID() < 4) misc[TID()] = 0u;
    __syncthreads();
    KP p = kargs();
    const bool multi = (p->ph_hi - p->ph_lo) > 1;
    XcdBarrier bar; bar.bar = WSP(unsigned, WS_BAR); bar.x = 0; bar.st = misc;
    if (multi) bar = xcd_barrier_post(WSP(unsigned, WS_BAR), misc);
    int ph = 0;
    const int lo = p->ph_lo, hi = p->ph_hi;
#ifndef REPMASK
#define REPMASK 0ull
#endif
#define PH_BEGIN if (ph >= lo && ph < hi) { KP p = kargs(); const int nrep_ = ((REPMASK >> ph) & 1ull) ? 3 : 1; for (int rep_ = 0; rep_ < nrep_; ++rep_) {
#define PH_END   if (ph + 1 < hi || rep_ + 1 < nrep_) xcd_barrier(bar); } } ++ph;

    PH_BEGIN phase_ada(p, lds); phase_weights(p, lds); phase_rope_table(p); PH_END

    for (int layer = 0; layer < 4; ++layer) {
        const int j = layer >> 1;
        if ((layer & 1) == 0) {
            PH_BEGIN phase_prep<true>(p, layer, 0, j, layer == 0); PH_END
            PH_BEGIN {
                FRwkvIn f{WSP(bf16_t, WS_RB), WSP(bf16_t, WS_KB), WSP(bf16_t, WS_VB), WSP(bf16_t, WS_TW), WSP(bf16_t, WS_TA), WSP(bf16_t, WS_TV), WSP(bf16_t, WS_TG)};
                pg8::Gemm g{WSP(bf16_t, WS_XR), WSP(bf16_t, WS_WRW_T) + (size_t)j * 4096 * D, NP, j == 0 ? 3840 : 4096, D, j == 0 ? 2 : 1, XR_STRIDE};
                pg8::StaticOrder S; S.init(NP, g.N, (int)gridDim.x, BID());
                pg8::EpiAdapt<FRwkvIn, true> E{f};
                pg8::gemm_phase(lds, g, S, E);
                wgemm_ks<true>(lds, WSP(bf16_t, WS_XR), D, XR_STRIDE, NP, NS, WSP(bf16_t, WS_WRW_T) + (size_t)j * 4096 * D, D, 4096, f, ((NP / 256) * (g.N / 256)) % (int)gridDim.x);
            } PH_END
            PH_BEGIN {
                FStoreF32 fw{WSP(float, WS_WP), D, D}, fa{WSP(float, WS_AP), D, D}, fv{WSP(float, WS_VP), D, D}, fg{WSP(float, WS_GG), D, D};
                wgemm_w(WSP(bf16_t, WS_TW), 64, NP, NS, WSP(bf16_t, WS_W2T) + (size_t)j * D * 64, 64, D, fw);
                wgemm_w(WSP(bf16_t, WS_TA), 64, NP, NS, WSP(bf16_t, WS_A2T) + (size_t)j * D * 64, 64, D, fa);
                if (j == 1) wgemm_w(WSP(bf16_t, WS_TV), 32, NP, NS, WSP(bf16_t, WS_V2T), 32, D, fv);
                wgemm_w(WSP(bf16_t, WS_TG), 160, NP, NS, WSP(bf16_t, WS_G2T) + (size_t)j * D * 160, 160, D, fg);
                phase_chunk(p, j, lds);
            } PH_END
            PH_BEGIN phase_carry(p, j, lds); PH_END
            PH_BEGIN phase_post2(p, j, lds); PH_END
        } else {
            PH_BEGIN phase_prep<false>(p, layer, 0, j); PH_END
            PH_BEGIN {
                FStoreBf16 f{WSP(bf16_t, WS_PR), PINP, PINP};
                pg8::Gemm g{WSP(bf16_t, WS_XR), WSP(bf16_t, WS_WIN_T) + (size_t)j * PINP * D, NP, PINP, D, 0, 0};
                pg8::StaticOrder S; S.init(NP, PINP, (int)gridDim.x, BID());
                pg8::EpiAdapt<FStoreBf16, true> E{f};
                pg8::gemm_phase(lds, g, S, E);
                FStoreBf16 fs{WSP(bf16_t, WS_PR), PINP, PIN};
                wgemm_ks<false>(lds, WSP(bf16_t, WS_XR), D, 0, NP, NS, WSP(bf16_t, WS_WIN_T) + (size_t)j * PINP * D, D, PINP, fs, ((NP / 256) * (PINP / 256)) % (int)gridDim.x);
            } PH_END
            PH_BEGIN phase_dsapost(p, j); PH_END
            PH_BEGIN phase_idx2<false>(p, j); phase_idx2<true>(p, j); PH_END
            PH_BEGIN phase_topk_prompt(p); phase_topk_sample(p, lds); PH_END
            PH_BEGIN phase_attn<true>(p, j, lds); phase_attn<false>(p, j, lds); PH_END
        }
        PH_BEGIN {
            FResid f{p->out, WSP(float, WS_MODS) + (size_t)layer * 36 * 6144 + 2 * D, layer == 0 ? p->x_prompt : nullptr, layer == 0 ? p->x_sample : nullptr};
            const bf16_t* Wt = ((layer & 1) == 0 ? WSP(bf16_t, WS_WO_T) : WSP(bf16_t, WS_WAO_T)) + (size_t)j * D * D;
            pg8::Gemm g{WSP(bf16_t, WS_YG), Wt, NP, D, D, 0, 0};
            pg8::StaticOrder S; S.init(NP, D, (int)gridDim.x, BID());
            pg8::EpiAdapt<FResid, false> E{f};
            pg8::gemm_phase(lds, g, S, E);
            wgemm_ks<false>(lds, WSP(bf16_t, WS_YG), D, 0, NP, NS, Wt, D, D, f);
        } PH_END
        PH_BEGIN phase_prep<false>(p, layer, 1, j); PH_END
        PH_BEGIN {
            FRelu2 f{WSP(bf16_t, WS_U)};
            pg8::Gemm g{WSP(bf16_t, WS_XR), WSP(bf16_t, WS_WUP_T) + (size_t)layer * DFF * D, NP, DFF, D, 0, 0};
            pg8::StaticOrder S; S.init(NP, DFF, (int)gridDim.x, BID());
            pg8::EpiAdapt<FRelu2, true> E{f};
            pg8::gemm_phase(lds, g, S, E);
            wgemm_ks<false>(lds, WSP(bf16_t, WS_XR), D, 0, NP, NS, WSP(bf16_t, WS_WUP_T) + (size_t)layer * DFF * D, D, DFF, f);
        } PH_END
        PH_BEGIN {
            FResid f{p->out, WSP(float, WS_MODS) + (size_t)layer * 36 * 6144 + 5 * D, nullptr, nullptr};
            pg8::Gemm g{WSP(bf16_t, WS_U), WSP(bf16_t, WS_WDN_T) + (size_t)layer * DFF * D, NP, D, DFF, 0, 0};
            pg8::StaticOrder S; S.init(NP, D, (int)gridDim.x, BID());
            pg8::EpiAdapt<FResid, false> E{f};
            pg8::gemm_phase(lds, g, S, E);
            wgemm_ks<false>(lds, WSP(bf16_t, WS_U), DFF, 0, NP, NS, WSP(bf16_t, WS_WDN_T) + (size_t)layer * DFF * D, DFF, D, f);
        } PH_END
    }
#undef PH_BEGIN
#undef PH_END
}

static int count_phases() { int n = 1; for (int layer = 0; layer < 4; ++layer) { n += ((layer & 1) == 0) ? 5 : 6; n += 4; } return n; }

extern "C" void kernel_launch(void* const* d_in, const int* in_sizes, int n_in, void* d_out, int out_size, void* d_ws, size_t ws_size, hipStream_t stream) {
    static int grid = 0;
    if (grid == 0) {
        if (n_in != 39 || out_size != (int)O_END || ws_size < WS_END) { fprintf(stderr, "kernel_launch: unexpected shapes n_in %d out %d ws %zu (need %zu)\n", n_in, out_size, ws_size, (size_t)WS_END); grid = -1; return; }
        int dev = 0, cus = 0, per_cu = 0;
        if (hipGetDevice(&dev) != hipSuccess || hipDeviceGetAttribute(&cus, hipDeviceAttributeMultiprocessorCount, dev) != hipSuccess) { grid = -1; return; }
        if (hipFuncSetAttribute((const void*)mega, hipFuncAttributeMaxDynamicSharedMemorySize, LDS_BYTES) != hipSuccess) { fprintf(stderr, "kernel_launch: hipFuncSetAttribute failed\n"); grid = -1; return; }
        if (hipOccupancyMaxActiveBlocksPerMultiprocessor(&per_cu, (const void*)mega, 512, LDS_BYTES) != hipSuccess || per_cu < 1) fprintf(stderr, "kernel_launch: occupancy query says %d\n", per_cu);
        (void)hipGetLastError();
        grid = cus;
    }
    if (grid < 0) return;
    (void)hipMemsetAsync((char*)d_ws + WS_BAR, 0, 65536, stream);
    P p{};
    memcpy((void*)&p, (const void*)d_in, 39 * sizeof(void*));
    p.out = (float*)d_out; p.ws = (unsigned char*)d_ws;
#ifndef STOP_PH
#define STOP_PH 1000
#endif
    const int nph = count_phases() < STOP_PH ? count_phases() : STOP_PH;
#ifndef ONE_LAUNCH
    for (int ph = 0; ph < nph; ++ph) { p.ph_lo = ph; p.ph_hi = ph + 1; hipLaunchKernelGGL(mega, dim3(grid), dim3(512), LDS_BYTES, stream, p); }
#else
    p.ph_lo = 0; p.ph_hi = nph; hipLaunchKernelGGL(mega, dim3(grid), dim3(512), LDS_BYTES, stream, p);
#endif
}
```

```cpp
#define ONE_LAUNCH 1
#include <hip/hip_runtime.h>
#include <cstdio>
#include <cstdint>
#include <cstring>

#define LAS __attribute__((address_space(3)))
typedef unsigned short bf16_t;
typedef short bf16x8 __attribute__((ext_vector_type(8)));
typedef float f32x4 __attribute__((ext_vector_type(4)));
typedef float f32x2 __attribute__((ext_vector_type(2)));
typedef unsigned u32x4 __attribute__((ext_vector_type(4)));
typedef unsigned u32x2 __attribute__((ext_vector_type(2)));

constexpr int D = 1024, NP = 16384, NS = 256, NT = NP + NS, SEQL = 4096, PAST = 8192, NSEQ = 36, DFF = 4096;
constexpr int PIN = 2120, PINP = 2304;
constexpr int TOPK = 256, SCS_LD = 8320;
constexpr size_t O_YP = 0, O_YS = 16777216, O_KP = 17039360, O_VP = 25427968, O_IKP = 33816576, O_WKVP = 35913728, O_SHP = 36438016,
                 O_KS = 36446208, O_VS = 36577280, O_IKS = 36708352, O_WKVS = 36741120, O_SHS = 40935424, O_END = 41000960;
constexpr size_t al256(size_t x) { return (x + 255) & ~(size_t)255; }
constexpr size_t WS_BAR = 0;
constexpr size_t WS_MODS = 65536;
constexpr size_t WS_WUP_T = al256(WS_MODS + (size_t)4 * NSEQ * 6144 * 4);
constexpr size_t WS_WDN_T = WS_WUP_T + (size_t)4 * DFF * D * 2;
constexpr size_t WS_WRW_T = WS_WDN_T + (size_t)4 * DFF * D * 2;
constexpr size_t WS_WO_T = WS_WRW_T + (size_t)2 * 4096 * D * 2;
constexpr size_t WS_WIN_T = WS_WO_T + (size_t)2 * D * D * 2;
constexpr size_t WS_WAO_T = WS_WIN_T + (size_t)2 * PINP * D * 2;
constexpr size_t WS_W2T = WS_WAO_T + (size_t)2 * D * D * 2;
constexpr size_t WS_A2T = WS_W2T + (size_t)2 * D * 64 * 2;
constexpr size_t WS_V2T = WS_A2T + (size_t)2 * D * 64 * 2;
constexpr size_t WS_G2T = WS_V2T + (size_t)D * 32 * 2;
constexpr size_t WS_XR = WS_G2T + (size_t)2 * D * 160 * 2;
constexpr size_t XR_STRIDE = (size_t)NT * D;
constexpr size_t WS_RB = WS_XR + 6 * XR_STRIDE * 2;
constexpr size_t WS_KB = WS_RB + XR_STRIDE * 2;
constexpr size_t WS_VB = WS_KB + XR_STRIDE * 2;
constexpr size_t WS_TW = WS_VB + XR_STRIDE * 2;
constexpr size_t WS_TA = WS_TW + (size_t)NT * 64 * 2;
constexpr size_t WS_TV = WS_TA + (size_t)NT * 64 * 2;
constexpr size_t WS_TG = WS_TV + (size_t)NT * 32 * 2;
constexpr size_t WS_WP = al256(WS_TG + (size_t)NT * 160 * 2);
constexpr size_t F32A = (size_t)NT * D * 4;
constexpr size_t WS_AP = WS_WP + F32A, WS_VP = WS_AP + F32A, WS_GG = WS_VP + F32A, WS_VFIRST = WS_GG + F32A;
constexpr size_t WS_DEC = WS_VFIRST + F32A, WS_KM = WS_DEC + F32A, WS_VM = WS_KM + F32A, WS_AV = WS_VM + F32A, WS_BV = WS_AV + F32A, WS_Y = WS_BV + F32A;
constexpr size_t WS_YG = WS_Y + F32A;
constexpr size_t WS_U = WS_YG + XR_STRIDE * 2;
constexpr size_t WS_PR = WS_U + (size_t)NT * DFF * 2;
constexpr size_t WS_Q = WS_PR + (size_t)NT * PINP * 4;
constexpr size_t WS_QI = WS_Q + F32A;
constexpr size_t WS_WI = WS_QI + (size_t)NT * 512 * 4;
constexpr size_t WS_SC = al256(WS_WI + (size_t)NT * 8 * 4);
constexpr size_t WS_SCS = WS_SC + (size_t)4 * 4096 * 4096 * 4;
constexpr size_t WS_SEL = al256(WS_SCS + (size_t)NS * SCS_LD * 4);
constexpr size_t WS_CNT = WS_SEL + (size_t)NT * 256 * 4;
constexpr size_t WS_KBF = al256(WS_CNT + (size_t)NT * 4);
constexpr size_t WS_VBF = WS_KBF + (size_t)NT * 256 * 2;
constexpr size_t WS_QIB = WS_VBF + (size_t)NT * 256 * 2;
constexpr size_t WS_KIB = WS_QIB + (size_t)NT * 512 * 2;
constexpr size_t WS_K8 = al256(WS_KIB + (size_t)NT * 64 * 2);
constexpr size_t WS_V8 = WS_K8 + (size_t)NT * 256;
constexpr size_t WS_END = al256(WS_V8 + (size_t)NT * 256);
constexpr size_t WS_ROPE = WS_KBF;

constexpr int LCH = 64, NCH = SEQL / LCH;
constexpr size_t WS_PCH = WS_SC, WS_CCH = WS_PCH + (size_t)64 * NCH * 4096 * 4, WS_SST = WS_CCH + (size_t)64 * NCH * 4096 * 4;
static_assert(WS_SST + (size_t)64 * NCH * 4096 * 4 <= WS_SCS, "scan buffers must fit the aliased region");
constexpr int LDS_BYTES = 147456;
constexpr int LDS_MISC = 131072;

typedef __bf16 bf16x2_t __attribute__((ext_vector_type(2)));
__device__ __forceinline__ unsigned pk_bf16(float lo, float hi) { const f32x2 v = {lo, hi}; const bf16x2_t b = __builtin_convertvector(v, bf16x2_t); return __builtin_bit_cast(unsigned, b); }
__device__ __forceinline__ unsigned pk_fp8x4(f32x4 v) { int w = 0; w = __builtin_amdgcn_cvt_pk_fp8_f32(v[0], v[1], w, false); w = __builtin_amdgcn_cvt_pk_fp8_f32(v[2], v[3], w, true); return (unsigned)w; }
__device__ __forceinline__ f32x4 fp8x4_f32(unsigned w) { return (f32x4){__builtin_amdgcn_cvt_f32_fp8((int)w, 0), __builtin_amdgcn_cvt_f32_fp8((int)w, 1), __builtin_amdgcn_cvt_f32_fp8((int)w, 2), __builtin_amdgcn_cvt_f32_fp8((int)w, 3)}; }
__device__ __forceinline__ float bf2f(unsigned short x) { return __uint_as_float((unsigned)x << 16); }
__device__ __forceinline__ float bflo(unsigned x) { return __uint_as_float(x << 16); }
__device__ __forceinline__ float bfhi(unsigned x) { return __uint_as_float(x & 0xffff0000u); }
__device__ __forceinline__ f32x4 ld_bf4(const bf16_t* p) { const u32x2 v = *(const u32x2*)p; return (f32x4){bflo(v.x), bfhi(v.x), bflo(v.y), bfhi(v.y)}; }
__device__ __forceinline__ void st_bf4(bf16_t* p, f32x4 v) { u32x2 w; w.x = pk_bf16(v[0], v[1]); w.y = pk_bf16(v[2], v[3]); *(u32x2*)p = w; }
template <int CTRL> __device__ __forceinline__ float dppf(float v) { return __int_as_float(__builtin_amdgcn_update_dpp(0, __float_as_int(v), CTRL, 0xf, 0xf, false)); }
template <int CTRL> __device__ __forceinline__ int dppi(int v) { return __builtin_amdgcn_update_dpp(0, v, CTRL, 0xf, 0xf, false); }
__device__ __forceinline__ float g16_sum(float v) { v += dppf<0xB1>(v); v += dppf<0x4E>(v); v += dppf<0x141>(v); v += dppf<0x140>(v); return v; }
__device__ __forceinline__ float g16_max(float v) { v = fmaxf(v, dppf<0xB1>(v)); v = fmaxf(v, dppf<0x4E>(v)); v = fmaxf(v, dppf<0x141>(v)); v = fmaxf(v, dppf<0x140>(v)); return v; }
__device__ __forceinline__ int g16_sum_i(int v) { v += dppi<0xB1>(v); v += dppi<0x4E>(v); v += dppi<0x141>(v); v += dppi<0x140>(v); return v; }
__device__ __forceinline__ int g16_min_i(int v) { v = min(v, dppi<0xB1>(v)); v = min(v, dppi<0x4E>(v)); v = min(v, dppi<0x141>(v)); v = min(v, dppi<0x140>(v)); return v; }
__device__ __forceinline__ float rlf(float v, int k) { return __int_as_float(__builtin_amdgcn_readlane(__float_as_int(v), k)); }
__device__ __forceinline__ float wave_sum(float v) { v = g16_sum(v); return (rlf(v, 0) + rlf(v, 16)) + (rlf(v, 32) + rlf(v, 48)); }
__device__ __forceinline__ float wave_max(float v) { v = g16_max(v); return fmaxf(fmaxf(rlf(v, 0), rlf(v, 16)), fmaxf(rlf(v, 32), rlf(v, 48))); }
__device__ __forceinline__ int wave_sum_i(int v) { v = g16_sum_i(v); return (__builtin_amdgcn_readlane(v, 0) + __builtin_amdgcn_readlane(v, 16)) + (__builtin_amdgcn_readlane(v, 32) + __builtin_amdgcn_readlane(v, 48)); }
__device__ __forceinline__ int wave_min_i(int v) { v = g16_min_i(v); return min(min(__builtin_amdgcn_readlane(v, 0), __builtin_amdgcn_readlane(v, 16)), min(__builtin_amdgcn_readlane(v, 32), __builtin_amdgcn_readlane(v, 48))); }
__device__ __forceinline__ float sigmoidf_(float x) { return 1.0f / (1.0f + expf(-x)); }
__device__ __forceinline__ float fsig(float x) { return __builtin_amdgcn_rcpf(1.0f + __expf(-x)); }
__device__ __forceinline__ float ftanh(float x) { return 2.0f * fsig(2.0f * x) - 1.0f; }
__device__ __forceinline__ int row_seq(int row) { return row < NP ? (row >> 12) : 4 + ((row - NP) >> 3); }
__device__ __forceinline__ int row_pos(int row) { return row < NP ? (row & 4095) : PAST + ((row - NP) & 7); }
__device__ __forceinline__ int TID() { int t = threadIdx.x; asm volatile("" : "+v"(t)); return t; }
__device__ __forceinline__ int BID() { int b = blockIdx.x; asm volatile("" : "+s"(b)); return b; }
__device__ __forceinline__ void wave_lds_fence() { __builtin_amdgcn_fence(__ATOMIC_RELEASE, "wavefront"); __builtin_amdgcn_wave_barrier(); __builtin_amdgcn_fence(__ATOMIC_ACQUIRE, "wavefront"); }

#define XB_TMO      128
#define XB_XCNT(j)  (256  + 64 * (j))
#define XB_XSUB(j)  (1280 + 64 * (j))
#define XB_XGEN(j)  (2304 + 64 * (j))
#define XB_TOP      3328
#define XB_TOPGEN   3392
#define XCD_BAR_WORDS 3456
#define XB_SPIN_CAP (1u << 22)
__device__ __forceinline__ unsigned xb_ld(unsigned* p)              { return __hip_atomic_load(p, __ATOMIC_RELAXED, __HIP_MEMORY_SCOPE_AGENT); }
__device__ __forceinline__ unsigned xb_add(unsigned* p, unsigned v) { return __hip_atomic_fetch_add(p, v, __ATOMIC_RELAXED, __HIP_MEMORY_SCOPE_AGENT); }
__device__ __forceinline__ unsigned xb_xcc_id() { return (unsigned)__builtin_amdgcn_s_getreg((3 << 11) | 20) & 0xFu; }
#define XB_SPIN(cond, bar) do { unsigned _sp = 0; while (cond) { __builtin_amdgcn_s_sleep(1); \
    if ((++_sp & 255u) == 0u) { if (xb_ld(&(bar)[XB_TMO])) break; if (_sp > XB_SPIN_CAP) { atomicAdd(&(bar)[XB_TMO], 1u); break; } } } } while (0)
struct XcdBarrier { unsigned* bar; unsigned x; volatile LAS unsigned* st; };
__device__ __forceinline__ XcdBarrier xcd_barrier_post(unsigned* bar, volatile LAS unsigned* st) {
    XcdBarrier b; b.bar = bar; b.x = xb_xcc_id(); b.st = st;
    if (threadIdx.x == 0) (void)xb_add(&bar[XB_XCNT(b.x)], 1u);
    return b;
}
__device__ __forceinline__ void xcd_barrier_complete(unsigned* bar, unsigned x, unsigned& nloc, unsigned& nx) {
    const unsigned G = gridDim.x * gridDim.y * gridDim.z;
    unsigned sum, cnt, mine, sp = 0u;
    for (;;) {
        sum = 0u; cnt = 0u; mine = 0u;
#pragma unroll
        for (unsigned j = 0; j < 16; ++j) { const unsigned c = xb_ld(&bar[XB_XCNT(j)]); sum += c; cnt += (c > 0u) ? 1u : 0u; mine = (j == x) ? c : mine; }
        if (sum == G) break;
        __builtin_amdgcn_s_sleep(1);
        if ((++sp & 255u) == 0u) { if (xb_ld(&bar[XB_TMO])) break; if (sp > XB_SPIN_CAP) { atomicAdd(&bar[XB_TMO], 1u); break; } }
    }
    nloc = mine > 0u ? mine : 1u; nx = cnt > 0u ? cnt : 1u;
}
__device__ __forceinline__ void xcd_barrier(const XcdBarrier& b) {
    asm volatile("s_waitcnt vmcnt(0)" ::: "memory");
    __syncthreads();
    if (threadIdx.x == 0) {
        unsigned* bar = b.bar;
        __builtin_amdgcn_s_waitcnt(0);
        unsigned nloc = b.st[0], nx = b.st[1];
        if (nloc == 0u) { xcd_barrier_complete(bar, b.x, nloc, nx); b.st[0] = nloc; b.st[1] = nx; }
        const unsigned old = xb_add(&bar[XB_XSUB(b.x)], 1u);
        const unsigned gen = old / nloc;
        if (old + 1u == (gen + 1u) * nloc) {
            __builtin_amdgcn_fence(__ATOMIC_RELEASE, "agent");
            asm volatile("s_waitcnt vmcnt(0)" ::: "memory");
            const unsigned og = xb_add(&bar[XB_TOP], 1u);
            const unsigned tg = og / nx;
            if (og + 1u == (tg + 1u) * nx) xb_add(&bar[XB_TOPGEN], 1u);
            else XB_SPIN(xb_ld(&bar[XB_TOPGEN]) == tg, bar);
            __builtin_amdgcn_fence(__ATOMIC_ACQUIRE, "agent");
            xb_add(&bar[XB_XGEN(b.x)], 1u);
            asm volatile("s_waitcnt vmcnt(0)" ::: "memory");
        } else {
            XB_SPIN(xb_ld(&bar[XB_XGEN(b.x)]) == gen, bar);
            __builtin_amdgcn_fence(__ATOMIC_ACQUIRE, "agent");
            asm volatile("s_waitcnt vmcnt(0)" ::: "memory");
        }
    }
    __syncthreads();
}

struct P {
    const float *x_prompt, *x_sample, *cache_k, *cache_v, *cache_ik, *state_wkv, *state_shift; const int* page_table;
    const float *c_prompt, *c_sample, *norm_g, *w_ada, *b_ada, *w_up, *w_down, *rw_mix, *rw_w_rkv, *rw_w_o, *rw_w0, *rw_w1, *rw_w2, *rw_a0, *rw_a1, *rw_a2,
                *rw_v0, *rw_v1, *rw_v2, *rw_g1, *rw_g2, *rw_k_k, *rw_k_a, *rw_r_k, *rw_lnx_w, *rw_lnx_b, *att_w_in, *att_w_o, *att_q_norm, *att_k_norm, *idx_k_norm;
    float* out; unsigned char* ws; int ph_lo, ph_hi;
};
typedef const P __attribute__((address_space(4)))* KP;
#define WSP(T, off) ((T*)(p->ws + (off)))
__device__ __forceinline__ KP kargs() { KP k = (KP)__builtin_amdgcn_kernarg_segment_ptr(); asm volatile("" : "+s"(k)); return k; }

namespace pg8 {
constexpr int BM = 256, BK = 64, HALF = 128, HTB = HALF * BK * 2, STAGE_BYTES = 8 * HTB, NXCD = 8, WGM = 8;
__device__ __forceinline__ int lds_byte(int r, int c) { const int st = (r >> 4) * 2 + (c >> 5), rr = r & 15, cc = c & 31, ob = rr * 64 + cc * 2; return st * 1024 + (ob ^ (((ob >> 9) & 1) << 5)); }
__device__ __forceinline__ void stage_rc(int b, int& R, int& C) { const int st = b / 1024, sb = b % 1024, swz = sb ^ (((sb >> 9) & 1) << 5); R = (st >> 1) * 16 + swz / 64; C = (st & 1) * 32 + (swz % 64) / 2; }
__device__ __forceinline__ int perm32(int rho) { const int n = rho >> 4, i = rho & 15; return 8 * (i >> 2) + 4 * n + (i & 3); }
struct Unit { int pm, pn; };
struct Gemm { const bf16_t* A; const bf16_t* Bt; int M, N, K, mode; size_t agrp; };
__device__ __forceinline__ int phys_pn(const Gemm& g, int pn) { return (g.mode == 2 && pn >= 12) ? pn + 1 : pn; }
__device__ __forceinline__ const char* a_ptr(const Gemm& g, const Unit& u, size_t tstep) {
    int grp = 0; if (g.mode) grp = u.pn < 12 ? (u.pn >> 2) : (u.pn == 12 ? 2 : u.pn - 10);
    return (const char*)g.A + (size_t)grp * g.agrp * 2 + (size_t)u.pm * tstep; }
struct StaticOrder {
    int nM, nN, nwg, G, c;
    __device__ void init(int M, int N, int G_, int c_) { nM = M / BM; nN = N / BM; nwg = nM * nN; G = G_; c = c_; }
    __device__ bool next(int i, Unit& u) const {
        const long L = (long)i * G + c; if (L >= nwg) return false;
        int wgid = (int)L; { const int q = nwg / NXCD, r = nwg % NXCD, xcd = wgid % NXCD, off = wgid / NXCD; wgid = (xcd < r ? xcd * (q + 1) : r * (q + 1) + (xcd - r) * q) + off; }
        const int nig = WGM * nN, gid = wgid / nig, fm = gid * WGM, gsz = (nM - fm) < WGM ? (nM - fm) : WGM;
        u.pm = fm + ((wgid % nig) % gsz); u.pn = (wgid % nig) / gsz; return true;
    }
};
template <class F, bool PERM_> struct EpiAdapt {
    static constexpr bool PERM = PERM_;
    F f;
    __device__ __forceinline__ void operator()(const f32x4 (&acc)[2][2][4][2], const Unit& u, int wr, int wc, int fr, int fq) const {
        const int row0 = u.pm * BM + wr * 64 + fr, col0 = u.pn * BM + wc * 32 + (PERM ? 8 * fq : 4 * fq);
#pragma unroll
        for (int ai = 0; ai < 2; ++ai)
#pragma unroll
            for (int m = 0; m < 4; ++m)
#pragma unroll
                for (int bj = 0; bj < 2; ++bj) {
                    if constexpr (PERM) f.vec8(row0 + ai * HALF + m * 16, col0 + bj * HALF, acc[ai][bj][m][0], acc[ai][bj][m][1]);
                    else {
#pragma unroll
                        for (int n = 0; n < 2; ++n) f.vec4(row0 + ai * HALF + m * 16, col0 + bj * HALF + 16 * n, acc[ai][bj][m][n]);
                    }
                }
    }
};

template <class Epi>
__device__ __forceinline__ void gemm_phase(LAS unsigned char* lds, const Gemm g, const StaticOrder& S, const Epi& E) {
    const int tid = TID(), wid = __builtin_amdgcn_readfirstlane(tid >> 6), lane = tid & 63, wr = wid >> 2, wc = wid & 3, fr = lane & 15, fq = lane >> 4;
    const int K = g.K, nt = K / BK;
    unsigned voffA[2], voffB[2];
#pragma unroll
    for (int i = 0; i < 2; ++i) { int R, C; stage_rc(tid * 16 + i * 8192, R, C); const int Rb = Epi::PERM ? ((R & ~31) + perm32(R & 31)) : R;
        voffA[i] = (unsigned)(R * K + C) * 2u; voffB[i] = (unsigned)(Rb * K + C) * 2u; }
    const size_t kstep = (size_t)(BK * 2);
    const size_t hstep = (size_t)HALF * K * 2;
    const size_t tstep = 2 * hstep;
    const unsigned ldsw = (unsigned)wid * 1024u;
    const int aoff = lds_byte(wr * 64 + fr, fq * 8), boff = lds_byte(wc * 32 + fr, fq * 8);
#define PG8_SA(b, h) (((b) * 2 + (h)) * HTB)
#define PG8_SB(b, h) ((4 + (b) * 2 + (h)) * HTB)
#define PG8_STAGE(bufoff, gbase, voff) do { _Pragma("unroll") for (int _i = 0; _i < 2; ++_i) \
        __builtin_amdgcn_global_load_lds((const unsigned*)((const char*)(gbase) + (voff)[_i]), (LAS unsigned*)(lds + (bufoff) + ldsw + _i * 8192), 16, 0, 0); } while (0)
#define PG8_LDA(dst, b, h) do { _Pragma("unroll") for (int m = 0; m < 4; ++m) _Pragma("unroll") for (int k = 0; k < 2; ++k) dst[m][k] = *(const LAS bf16x8*)(lds + PG8_SA(b, h) + aoff + m * 2048 + k * 1024); } while (0)
#define PG8_LDB(dst, b, h) do { _Pragma("unroll") for (int n = 0; n < 2; ++n) _Pragma("unroll") for (int k = 0; k < 2; ++k) dst[n][k] = *(const LAS bf16x8*)(lds + PG8_SB(b, h) + boff + n * 2048 + k * 1024); } while (0)
#define PG8_MMA(ai, bj, At, Bt) do { __builtin_amdgcn_s_setprio(1); _Pragma("unroll") for (int m = 0; m < 4; ++m) _Pragma("unroll") for (int n = 0; n < 2; ++n) _Pragma("unroll") for (int k = 0; k < 2; ++k) \
        acc[ai][bj][m][n] = __builtin_amdgcn_mfma_f32_16x16x32_bf16(Bt[n][k], At[m][k], acc[ai][bj][m][n], 0, 0, 0); __builtin_amdgcn_s_setprio(0); } while (0)
#define PG8_WAIT_V(n) asm volatile("s_waitcnt vmcnt(" #n ")" ::: "memory")
#define PG8_WAIT_L(n) asm volatile("s_waitcnt lgkmcnt(" #n ")" ::: "memory")
#define PG8_BAR __builtin_amdgcn_s_barrier()
#define PG8_SCHED __builtin_amdgcn_sched_barrier(0)
    Unit cur, nxt; int ui = 0;
    if (!S.next(0, cur)) return;
    cur.pn = phys_pn(g, cur.pn);
    f32x4 acc[2][2][4][2];
#pragma unroll
    for (int a = 0; a < 2; ++a)
#pragma unroll
        for (int b = 0; b < 2; ++b)
#pragma unroll
            for (int m = 0; m < 4; ++m)
#pragma unroll
                for (int n = 0; n < 2; ++n) acc[a][b][m][n] = (f32x4){0.f, 0.f, 0.f, 0.f};
    bf16x8 At[4][2], B0[2][2], B1[2][2];
    const char* cA = a_ptr(g, cur, tstep); const char* cB = (const char*)g.Bt + (size_t)cur.pn * tstep;
    PG8_STAGE(PG8_SB(0, 0), cB, voffB); PG8_STAGE(PG8_SA(0, 0), cA, voffA); PG8_STAGE(PG8_SB(0, 1), cB + hstep, voffB); PG8_STAGE(PG8_SA(0, 1), cA + hstep, voffA);
    if (wr == 1) PG8_BAR;
    PG8_WAIT_V(4); PG8_BAR;
    PG8_STAGE(PG8_SB(1, 0), cB + kstep, voffB); PG8_STAGE(PG8_SA(1, 0), cA + kstep, voffA); PG8_STAGE(PG8_SB(1, 1), cB + hstep + kstep, voffB);
    PG8_WAIT_V(6); PG8_BAR;
    for (;;) {
        const bool has_next = S.next(ui + 1, nxt);
        if (has_next) nxt.pn = phys_pn(g, nxt.pn);
        const char* nA = has_next ? a_ptr(g, nxt, tstep) : cA; const char* nB = has_next ? (const char*)g.Bt + (size_t)nxt.pn * tstep : cB;
        for (int t = 0; t < nt; t += 2) {
            const bool last = (t == nt - 2);
            const char* a1 = cA + (size_t)(t + 1) * kstep;
            const char* a2 = last ? nA : cA + (size_t)(t + 2) * kstep; const char* b2 = last ? nB : cB + (size_t)(t + 2) * kstep;
            const char* a3 = a2 + kstep; const char* b3 = b2 + kstep;
            PG8_LDB(B0, 0, 0); PG8_SCHED; PG8_LDA(At, 0, 0); PG8_STAGE(PG8_SA(1, 1), a1 + hstep, voffA);
            PG8_WAIT_L(8); PG8_BAR; PG8_WAIT_L(0); PG8_MMA(0, 0, At, B0); PG8_BAR; PG8_SCHED;
            PG8_LDB(B1, 0, 1); PG8_STAGE(PG8_SB(0, 0), b2, voffB);
            PG8_BAR; PG8_WAIT_L(0); PG8_MMA(0, 1, At, B1); PG8_BAR;
            PG8_LDA(At, 0, 1); PG8_STAGE(PG8_SA(0, 0), a2, voffA);
            PG8_BAR; PG8_WAIT_L(0); PG8_MMA(1, 0, At, B0); PG8_BAR; PG8_SCHED;
            PG8_STAGE(PG8_SB(0, 1), b2 + hstep, voffB);
            PG8_WAIT_V(6); PG8_BAR; PG8_MMA(1, 1, At, B1); PG8_BAR;
            PG8_LDB(B0, 1, 0); PG8_SCHED; PG8_LDA(At, 1, 0); PG8_STAGE(PG8_SA(0, 1), a2 + hstep, voffA);
            PG8_WAIT_L(8); PG8_BAR; PG8_WAIT_L(0); PG8_MMA(0, 0, At, B0); PG8_BAR; PG8_SCHED;
            PG8_LDB(B1, 1, 1); PG8_STAGE(PG8_SB(1, 0), b3, voffB);
            PG8_BAR; PG8_WAIT_L(0); PG8_MMA(0, 1, At, B1); PG8_BAR;
            PG8_LDA(At, 1, 1); PG8_STAGE(PG8_SA(1, 0), a3, voffA);
            PG8_BAR; PG8_WAIT_L(0); PG8_MMA(1, 0, At, B0); PG8_BAR; PG8_SCHED;
            PG8_STAGE(PG8_SB(1, 1), b3 + hstep, voffB);
            PG8_WAIT_V(6); PG8_BAR; PG8_MMA(1, 1, At, B1); PG8_BAR;
        }
        E(acc, cur, wr, wc, fr, fq);
        if (!has_next) break;
#pragma unroll
        for (int a = 0; a < 2; ++a)
#pragma unroll
            for (int b = 0; b < 2; ++b)
#pragma unroll
                for (int m = 0; m < 4; ++m)
#pragma unroll
                    for (int n = 0; n < 2; ++n) acc[a][b][m][n] = (f32x4){0.f, 0.f, 0.f, 0.f};
        cur = nxt; cA = nA; cB = nB; ++ui;
    }
    PG8_WAIT_V(0);
    if (wr == 0) PG8_BAR;
    PG8_BAR;
#undef PG8_SA
#undef PG8_SB
#undef PG8_STAGE
#undef PG8_LDA
#undef PG8_LDB
#undef PG8_MMA
#undef PG8_WAIT_V
#undef PG8_WAIT_L
#undef PG8_BAR
#undef PG8_SCHED
}
}

template <class F>
__device__ __forceinline__ void sgemm_bf(LAS unsigned char* lds, const bf16_t* A, int lda, int row0, int M, const float* W, int ldw, int N, int K, int coloff, const F& f) {
    LAS float* As = (LAS float*)lds;
    LAS float* Ws = (LAS float*)(lds + 32 * 68 * 4);
    const int tid = TID(), ty = tid >> 4, tx = tid & 15;
    const int ntn = (N + 63) / 64, ntiles = (M / 64) * ntn;
    for (int tile = BID(); tile < ntiles; tile += gridDim.x) {
        const int tm = tile / ntn, tn = tile % ntn, r0 = row0 + tm * 64, n0 = tn * 64;
        f32x4 c0 = {0.f, 0.f, 0.f, 0.f}, c1 = {0.f, 0.f, 0.f, 0.f};
        for (int k0 = 0; k0 < K; k0 += 32) {
            __syncthreads();
            { const int r = tid >> 3, q = tid & 7; const f32x4 a = ld_bf4(A + (size_t)(r0 + r) * lda + k0 + 4 * q);
              As[(4 * q + 0) * 68 + r] = a[0]; As[(4 * q + 1) * 68 + r] = a[1]; As[(4 * q + 2) * 68 + r] = a[2]; As[(4 * q + 3) * 68 + r] = a[3]; }
            { const int kr = tid >> 4, c = tid & 15; f32x4 w = {0.f, 0.f, 0.f, 0.f}; if (n0 + 4 * c < N) w = *(const f32x4*)(W + (size_t)(k0 + kr) * ldw + n0 + 4 * c);
              *(LAS f32x4*)(Ws + kr * 68 + 4 * c) = w; }
            __syncthreads();
#pragma unroll 8
            for (int kk = 0; kk < 32; ++kk) {
                const f32x2 a = *(const LAS f32x2*)(As + kk * 68 + 2 * ty); const f32x4 b = *(const LAS f32x4*)(Ws + kk * 68 + 4 * tx);
                c0 += a.x * b; c1 += a.y * b;
            }
        }
        if (n0 + 4 * tx < N) { f.vec4(r0 + 2 * ty, n0 + 4 * tx + coloff, c0); f.vec4(r0 + 2 * ty + 1, n0 + 4 * tx + coloff, c1); }
    }
    __syncthreads();
}

typedef float f32x16 __attribute__((ext_vector_type(16)));
__device__ __forceinline__ int rw_group(int n0) { const int t = n0 >> 8; return t < 12 ? (t >> 2) : (t == 12 ? 2 : t - 10); }
template <bool RWGRP, class F>
__device__ __forceinline__ void wgemm_ks(LAS unsigned char* lds, const bf16_t* A, int lda, size_t agrp, int row0, int M, const bf16_t* Bt, int K, int N, const F& f, int wg0 = 0) {
    const int tid = TID(), wave = tid >> 6, lane = tid & 63, lr = lane & 31, lh = lane >> 5;
    LAS float* red = (LAS float*)lds;
    const int ntn = N / 64, nitems = (M / 32) * ntn, kw = K / 8, steps = kw / 16;
    const int vb_ = BID() - wg0, nwg_ = (int)gridDim.x - wg0;
    for (int item = vb_ < 0 ? nitems : vb_; item < nitems; item += nwg_) {
        const int tm = item / ntn, tn = item % ntn, r0 = row0 + tm * 32, n0 = tn * 64;
        const bf16_t* Ab = A + (RWGRP ? (size_t)rw_group(n0) * agrp : 0) + (size_t)(r0 + lr) * lda + wave * kw + lh * 8;
        const bf16_t* B0 = Bt + (size_t)(n0 + lr) * K + wave * kw + lh * 8; const bf16_t* B1 = B0 + (size_t)32 * K;
        f32x16 acc0, acc1;
#pragma unroll
        for (int r = 0; r < 16; ++r) { acc0[r] = 0.f; acc1[r] = 0.f; }
#pragma unroll 8
        for (int st = 0; st < steps; ++st) {
            const bf16x8 a = *(const bf16x8*)(Ab + 16 * st), b0 = *(const bf16x8*)(B0 + 16 * st), b1 = *(const bf16x8*)(B1 + 16 * st);
            acc0 = __builtin_amdgcn_mfma_f32_32x32x16_bf16(b0, a, acc0, 0, 0, 0);
            acc1 = __builtin_amdgcn_mfma_f32_32x32x16_bf16(b1, a, acc1, 0, 0, 0);
        }
        __syncthreads();
#pragma unroll
        for (int r = 0; r < 16; ++r) { red[((wave * 2 + 0) * 16 + r) * 64 + lane] = acc0[r]; red[((wave * 2 + 1) * 16 + r) * 64 + lane] = acc1[r]; }
        __syncthreads();
        { const int t = tid >> 8, r4 = (tid >> 6) & 3, l2 = tid & 63; f32x4 v = {0.f, 0.f, 0.f, 0.f};
#pragma unroll
          for (int w = 0; w < 8; ++w)
#pragma unroll
              for (int e = 0; e < 4; ++e) v[e] += red[((w * 2 + t) * 16 + 4 * r4 + e) * 64 + l2];
          f.vec4(r0 + (l2 & 31), n0 + 32 * t + 8 * r4 + 4 * (l2 >> 5), v); }
    }
    __syncthreads();
}
template <class F>
__device__ __forceinline__ void wgemm_w(const bf16_t* A, int lda, int row0, int M, const bf16_t* Bt, int K, int N, const F& f) {
    const int lane = TID() & 63, lr = lane & 31, lh = lane >> 5, gw = BID() * 8 + (TID() >> 6), nw = gridDim.x * 8;
    const int ntn = N / 64, nitems = (M / 32) * ntn, steps = K / 16;
    for (int item = gw; item < nitems; item += nw) {
        const int tm = item / ntn, tn = item % ntn, r0 = row0 + tm * 32, n0 = tn * 64;
        const bf16_t* Ab = A + (size_t)(r0 + lr) * lda + lh * 8;
        const bf16_t* B0 = Bt + (size_t)(n0 + lr) * K + lh * 8; const bf16_t* B1 = B0 + (size_t)32 * K;
        f32x16 acc0, acc1;
#pragma unroll
        for (int r = 0; r < 16; ++r) { acc0[r] = 0.f; acc1[r] = 0.f; }
        for (int st = 0; st < steps; ++st) {
            const bf16x8 a = *(const bf16x8*)(Ab + 16 * st), b0 = *(const bf16x8*)(B0 + 16 * st), b1 = *(const bf16x8*)(B1 + 16 * st);
            acc0 = __builtin_amdgcn_mfma_f32_32x32x16_bf16(b0, a, acc0, 0, 0, 0);
            acc1 = __builtin_amdgcn_mfma_f32_32x32x16_bf16(b1, a, acc1, 0, 0, 0);
        }
#pragma unroll
        for (int r4 = 0; r4 < 4; ++r4) {
            f.vec4(r0 + lr, n0 + 8 * r4 + 4 * lh, (f32x4){acc0[4 * r4], acc0[4 * r4 + 1], acc0[4 * r4 + 2], acc0[4 * r4 + 3]});
            f.vec4(r0 + lr, n0 + 32 + 8 * r4 + 4 * lh, (f32x4){acc1[4 * r4], acc1[4 * r4 + 1], acc1[4 * r4 + 2], acc1[4 * r4 + 3]});
        }
    }
}

struct FRwkvIn {
    bf16_t *rb, *kb, *vb, *tw, *ta, *tv, *tg;
    __device__ __forceinline__ void vec8(int row, int col, f32x4 a, f32x4 b) const {
        if (col < 3072) { u32x4 w; w.x = pk_bf16(a[0], a[1]); w.y = pk_bf16(a[2], a[3]); w.z = pk_bf16(b[0], b[1]); w.w = pk_bf16(b[2], b[3]);
            *(u32x4*)(rb + (size_t)(col >> 10) * XR_STRIDE + (size_t)row * D + (col & 1023)) = w; }
        else { vec4(row, col, a); vec4(row, col + 4, b); } }
    __device__ __forceinline__ void vec4(int row, int col, f32x4 v) const {
        if (col < 3072) { st_bf4(rb + (size_t)(col >> 10) * XR_STRIDE + (size_t)row * D + (col & 1023), v); }
        else if (col < 3328) { const int c = col - 3072; if (c < 32) st_bf4(tv + (size_t)row * 32 + c, v); }
        else if (col < 3584) { const int c = col - 3328; if (c < 64) { f32x4 t = {ftanh(v[0]), ftanh(v[1]), ftanh(v[2]), ftanh(v[3])}; st_bf4(tw + (size_t)row * 64 + c, t); } }
        else if (col < 3840) { const int c = col - 3584; if (c < 64) st_bf4(ta + (size_t)row * 64 + c, v); }
        else { const int c = col - 3840; if (c < 160) { f32x4 t = {fsig(v[0]), fsig(v[1]), fsig(v[2]), fsig(v[3])}; st_bf4(tg + (size_t)row * 160 + c, t); } }
    }
};
struct FStoreF32 { float* C; int ldc; int ncols; __device__ __forceinline__ void vec4(int row, int col, f32x4 v) const { if (col < ncols) *(f32x4*)(C + (size_t)row * ldc + col) = v; } };
struct FStoreBf16 { bf16_t* C; int ldc; int ncols;
    __device__ __forceinline__ void vec4(int row, int col, f32x4 v) const { if (col < ncols) st_bf4(C + (size_t)row * ldc + col, v); }
    __device__ __forceinline__ void vec8(int row, int col, f32x4 a, f32x4 b) const { if (col < ncols) { u32x4 w; w.x = pk_bf16(a[0], a[1]); w.y = pk_bf16(a[2], a[3]); w.z = pk_bf16(b[0], b[1]); w.w = pk_bf16(b[2], b[3]); *(u32x4*)(C + (size_t)row * ldc + col) = w; } } };
struct FResid {
    float* X; const float* gate;
    const float* xin_p; const float* xin_s;
    __device__ __forceinline__ void vec4(int row, int col, f32x4 v) const {
        const f32x4 g = *(const f32x4*)(gate + (size_t)row_seq(row) * 6144 + col); float* xp = X + (size_t)row * D + col;
        const float* ip = xin_p ? (row < NP ? xin_p + (size_t)row * D + col : xin_s + (size_t)(row - NP) * D + col) : xp;
        const f32x4 x = *(const f32x4*)ip; *(f32x4*)xp = x + g * v; }
};
struct FRelu2 { bf16_t* U;
    __device__ __forceinline__ void vec8(int row, int col, f32x4 a, f32x4 b) const {
        f32x4 s, t; for (int e = 0; e < 4; ++e) { const float x = fmaxf(a[e], 0.f), y = fmaxf(b[e], 0.f); s[e] = x * x; t[e] = y * y; }
        u32x4 w; w.x = pk_bf16(s[0], s[1]); w.y = pk_bf16(s[2], s[3]); w.z = pk_bf16(t[0], t[1]); w.w = pk_bf16(t[2], t[3]); *(u32x4*)(U + (size_t)row * DFF + col) = w; }
    __device__ __forceinline__ void vec4(int row, int col, f32x4 v) const {
        f32x4 t; for (int e = 0; e < 4; ++e) { const float r = fmaxf(v[e], 0.f); t[e] = r * r; } st_bf4(U + (size_t)row * DFF + col, t); } };

__device__ __forceinline__ void phase_copy_x(KP p) {
    const size_t n4p = (size_t)NP * D / 4, n4 = (size_t)NT * D / 4;
    for (size_t i = (size_t)BID() * 512 + TID(); i < n4; i += (size_t)gridDim.x * 512)
        ((f32x4*)p->out)[i] = i < n4p ? ((const f32x4*)p->x_prompt)[i] : ((const f32x4*)p->x_sample)[i - n4p];
}

struct TJob { const float* src; bf16_t* dst; int K, N, drow0; };
__device__ __forceinline__ TJob tjob(KP p, int i) {
    TJob t; t.drow0 = 0;
    if (i < 4) { t.src = p->w_up + (size_t)i * D * DFF; t.dst = WSP(bf16_t, WS_WUP_T) + (size_t)i * DFF * D; t.K = D; t.N = DFF; return t; }
    if (i < 8) { const int l = i - 4; t.src = p->w_down + (size_t)l * DFF * D; t.dst = WSP(bf16_t, WS_WDN_T) + (size_t)l * DFF * D; t.K = DFF; t.N = D; return t; }
    i -= 8; const int j = i / 14, k = i % 14; bf16_t* wrw = WSP(bf16_t, WS_WRW_T) + (size_t)j * 4096 * D;
    t.K = D; t.N = D;
    switch (k) {
        case 0: case 1: case 2: t.src = p->rw_w_rkv + ((size_t)j * 3 + k) * D * D; t.dst = wrw; t.drow0 = k * 1024; break;
        case 3: t.src = p->rw_v1; t.dst = wrw; t.drow0 = 3072; t.N = j == 1 ? 32 : 0; break;
        case 4: t.src = p->rw_w1 + (size_t)j * D * 64; t.dst = wrw; t.drow0 = 3328; t.N = 64; break;
        case 5: t.src = p->rw_a1 + (size_t)j * D * 64; t.dst = wrw; t.drow0 = 3584; t.N = 64; break;
        case 6: t.src = p->rw_g1 + (size_t)j * D * 160; t.dst = wrw; t.drow0 = 3840; t.N = 160; break;
        case 7: t.src = p->rw_w_o + (size_t)j * D * D; t.dst = WSP(bf16_t, WS_WO_T) + (size_t)j * D * D; break;
        case 8: t.src = p->rw_w2 + (size_t)j * 64 * D; t.dst = WSP(bf16_t, WS_W2T) + (size_t)j * D * 64; t.K = 64; break;
        case 9: t.src = p->rw_a2 + (size_t)j * 64 * D; t.dst = WSP(bf16_t, WS_A2T) + (size_t)j * D * 64; t.K = 64; break;
        case 10: t.src = p->rw_g2 + (size_t)j * 160 * D; t.dst = WSP(bf16_t, WS_G2T) + (size_t)j * D * 160; t.K = 160; break;
        case 11: t.src = p->rw_v2; t.dst = WSP(bf16_t, WS_V2T); t.K = 32; t.N = j == 1 ? D : 0; break;
        case 12: t.src = p->att_w_in + (size_t)j * D * PIN; t.dst = WSP(bf16_t, WS_WIN_T) + (size_t)j * PINP * D; t.N = PIN; break;
        default: t.src = p->att_w_o + (size_t)j * D * D; t.dst = WSP(bf16_t, WS_WAO_T) + (size_t)j * D * D; break;
    }
    return t;
}
__device__ __forceinline__ int tjob_tiles(const TJob& t) { return ((t.K + 63) / 64) * ((t.N + 63) / 64); }
__device__ __forceinline__ void phase_weights(KP p, LAS unsigned char* lds) {
    LAS float* T = (LAS float*)lds;
    int total = 0;
    for (int i = 0; i < 36; ++i) total += tjob_tiles(tjob(p, i));
    const int ngrp = (total + 3) / 4;
    f32x4 v[4][2];
    bf16_t* dstn[4]; int Kn[4], nlim[4], klim[4];
#define WT_ISSUE(G_) do { const int tid_ = TID(), kk_ = tid_ >> 4, n4_ = (tid_ & 15) * 4; \
        int i_ = 0, start_ = 0, cnt_ = tjob_tiles(tjob(p, 0)); \
        _Pragma("unroll") for (int u = 0; u < 4; ++u) { const int gt_ = 4 * (G_) + u; \
            while (i_ < 35 && gt_ >= start_ + cnt_) { start_ += cnt_; ++i_; cnt_ = tjob_tiles(tjob(p, i_)); } \
            const TJob tj_ = tjob(p, i_); const int lt_ = gt_ - start_, nkt_ = (tj_.K + 63) / 64; \
            const bool dead_ = gt_ >= total || lt_ >= cnt_; const int k0_ = dead_ ? 0 : (lt_ % nkt_) * 64, n0_ = dead_ ? 0 : (lt_ / nkt_) * 64; \
            dstn[u] = tj_.dst + (size_t)(tj_.drow0 + n0_) * tj_.K + k0_; Kn[u] = tj_.K; nlim[u] = dead_ ? 0 : tj_.N - n0_; klim[u] = dead_ ? 0 : tj_.K - k0_; \
            _Pragma("unroll") for (int hh = 0; hh < 2; ++hh) { const int k_ = k0_ + kk_ + 32 * hh, n_ = n0_ + n4_; \
                v[u][hh] = *(const f32x4*)(tj_.src + (size_t)min(k_, tj_.K - 1) * tj_.N + min(n_, tj_.N - 4)); } } } while (0)
    if (BID() < ngrp) WT_ISSUE(BID());
    for (int g = BID(); g < ngrp; g += gridDim.x) {
        const int tid = TID(), kk = tid >> 4, n4 = (tid & 15) * 4;
#pragma unroll
        for (int u = 0; u < 4; ++u)
#pragma unroll
            for (int hh = 0; hh < 2; ++hh)
#pragma unroll
                for (int e = 0; e < 4; ++e) T[(u * 64 + kk + 32 * hh) * 65 + n4 + e] = v[u][hh][e];
        bf16_t* dstc[4]; int Kc[4], nl[4], kl[4];
#pragma unroll
        for (int u = 0; u < 4; ++u) { dstc[u] = dstn[u]; Kc[u] = Kn[u]; nl[u] = nlim[u]; kl[u] = klim[u]; }
        if (g + (int)gridDim.x < ngrp) WT_ISSUE(g + (int)gridDim.x);
        asm volatile("s_waitcnt lgkmcnt(0)" ::: "memory"); __builtin_amdgcn_s_barrier(); asm volatile("" ::: "memory");
        const int nn = tid >> 3, k8 = (tid & 7) * 8;
#pragma unroll
        for (int u = 0; u < 4; ++u) {
            if (nn < nl[u] && k8 < kl[u]) {
                u32x4 w;
                w.x = pk_bf16(T[(u * 64 + k8 + 0) * 65 + nn], T[(u * 64 + k8 + 1) * 65 + nn]); w.y = pk_bf16(T[(u * 64 + k8 + 2) * 65 + nn], T[(u * 64 + k8 + 3) * 65 + nn]);
                w.z = pk_bf16(T[(u * 64 + k8 + 4) * 65 + nn], T[(u * 64 + k8 + 5) * 65 + nn]); w.w = pk_bf16(T[(u * 64 + k8 + 6) * 65 + nn], T[(u * 64 + k8 + 7) * 65 + nn]);
                *(u32x4*)(dstc[u] + (size_t)nn * Kc[u] + k8) = w;
            }
        }
        asm volatile("s_waitcnt lgkmcnt(0)" ::: "memory"); __builtin_amdgcn_s_barrier(); asm volatile("" ::: "memory");
    }
#undef WT_ISSUE
    __syncthreads();
}

__device__ __forceinline__ void phase_ada(KP p, LAS unsigned char* lds) {
    float* mods = WSP(float, WS_MODS);
    LAS float* red = (LAS float*)lds;
    const int tid = TID(), lane = tid & 63, w = tid >> 6, ln = lane & 15, lq = lane >> 4;
    float af[3][32];
#pragma unroll
    for (int m = 0; m < 3; ++m) {
        const int s = 16 * m + ln; const bool ok = s < 36;
        const float* cp = s < 4 ? p->c_prompt + (size_t)s * D : p->c_sample + (size_t)((ok ? s : 35) - 4) * D;
#pragma unroll
        for (int i = 0; i < 32; ++i) { const float cv = cp[128 * w + 4 * i + lq]; af[m][i] = ok ? cv * __builtin_amdgcn_rcpf(1.0f + __expf(-cv)) : 0.f; }
    }
    f32x2 wv[32];
#define ADA_LOAD(B_) do { const int l_ = (B_) / 192, cb_ = ((B_) % 192) * 32; const float* wp_ = p->w_ada + ((size_t)l_ * D + 128 * w + lq) * 6144 + cb_ + 2 * ln; \
        _Pragma("unroll") for (int i = 0; i < 32; ++i) wv[i] = *(const f32x2*)(wp_ + (size_t)(4 * i) * 6144); } while (0)
    if (BID() < 768) ADA_LOAD(BID());
    for (int B = BID(); B < 768; B += gridDim.x) {
        const int l = B / 192, cb = (B % 192) * 32;
        f32x4 acc[3][2];
#pragma unroll
        for (int m = 0; m < 3; ++m) { acc[m][0] = (f32x4){0.f, 0.f, 0.f, 0.f}; acc[m][1] = acc[m][0]; }
#pragma unroll
        for (int i = 0; i < 32; ++i)
#pragma unroll
            for (int m = 0; m < 3; ++m) {
                acc[m][0] = __builtin_amdgcn_mfma_f32_16x16x4f32(af[m][i], wv[i][0], acc[m][0], 0, 0, 0);
                acc[m][1] = __builtin_amdgcn_mfma_f32_16x16x4f32(af[m][i], wv[i][1], acc[m][1], 0, 0, 0);
            }
        if (B + (int)gridDim.x < 768) ADA_LOAD(B + (int)gridDim.x);
#pragma unroll
        for (int m = 0; m < 3; ++m)
#pragma unroll
            for (int r = 0; r < 4; ++r) { const int s = 16 * m + 4 * lq + r;
                if (s < 36) *(LAS f32x2*)(red + (w * 36 + s) * 32 + 2 * ln) = (f32x2){acc[m][0][r], acc[m][1][r]}; }
        asm volatile("s_waitcnt lgkmcnt(0)" ::: "memory"); __builtin_amdgcn_s_barrier(); asm volatile("" ::: "memory");
        for (int o = tid; o < 36 * 32; o += 512) { const int s = o >> 5, cc = o & 31;
            float v = 0.f;
#pragma unroll
            for (int ww = 0; ww < 8; ++ww) v += red[(ww * 36 + s) * 32 + cc];
            mods[((size_t)l * 36 + s) * 6144 + cb + cc] = v + p->b_ada[l * 6144 + cb + cc]; }
        asm volatile("s_waitcnt lgkmcnt(0)" ::: "memory"); __builtin_amdgcn_s_barrier(); asm volatile("" ::: "memory");
    }
#undef ADA_LOAD
    __syncthreads();
}

template <bool MIX>
__device__ __forceinline__ void phase_prep(KP p, int layer, int which, int j, bool first = false) {
    const float* X = p->out;
    const float* mods = WSP(float, WS_MODS) + (size_t)layer * 36 * 6144;
    const float* g = p->norm_g + (layer * 2 + which) * D;
    bf16_t* XR = WSP(bf16_t, WS_XR);
    const int lane = TID() & 63, gw = BID() * 8 + (TID() >> 6), nw = gridDim.x * 8;
    for (int run = gw; run < NP / 8 + NS; run += nw) {
        const int row0 = run < NP / 8 ? run * 8 : NP + (run - NP / 8), nrows = run < NP / 8 ? 8 : 1, seq = row_seq(row0);
        const float* sh = mods + (size_t)seq * 6144 + (which ? 3 : 0) * D; const float* sc = sh + D;
        f32x4 gv[4], scv[4], shv[4], hp[4];
#pragma unroll
        for (int i = 0; i < 4; ++i) { const int col = 512 * (i >> 1) + 8 * lane + 4 * (i & 1); gv[i] = *(const f32x4*)(g + col); scv[i] = *(const f32x4*)(sc + col) + 1.0f; shv[i] = *(const f32x4*)(sh + col); hp[i] = (f32x4){0.f, 0.f, 0.f, 0.f}; }
        int rstart = 0;
        if (MIX) {
            if (row0 >= NP && ((row0 - NP) & 7) == 0) {
#pragma unroll
                for (int i = 0; i < 4; ++i) hp[i] = *(const f32x4*)(p->state_shift + ((size_t)j * 32 + (seq - 4)) * D + 512 * (i >> 1) + 8 * lane + 4 * (i & 1));
            } else if (row0 >= NP || (row0 & 4095) != 0) rstart = -1;
        }
        for (int r = rstart; r < nrows; ++r) {
            const int row = row0 + r;
            f32x4 x[4]; float ss = 0.f;
            const float* xr = first ? (row < NP ? p->x_prompt + (size_t)row * D : p->x_sample + (size_t)(row - NP) * D) : X + (size_t)row * D;
#pragma unroll
            for (int i = 0; i < 4; ++i) { x[i] = *(const f32x4*)(xr + 512 * (i >> 1) + 8 * lane + 4 * (i & 1)); ss += x[i][0] * x[i][0] + x[i][1] * x[i][1] + x[i][2] * x[i][2] + x[i][3] * x[i][3]; }
            ss = wave_sum(ss);
            const float rstd = rsqrtf(ss * (1.0f / 1024.0f) + 1e-6f);
            f32x4 h[4];
#pragma unroll
            for (int i = 0; i < 4; ++i) h[i] = x[i] * rstd * gv[i] * scv[i] + shv[i];
            if (MIX) {
                if (r >= 0) {
#pragma unroll
                    for (int n = 0; n < 6; ++n) {
                        const int mi = n == 0 ? 0 : (n == 1 ? 2 : (n == 2 ? 3 : (n == 3 ? 1 : n)));
                        const float* mx = p->rw_mix + ((size_t)j * 6 + mi) * D;
#pragma unroll
                        for (int i2 = 0; i2 < 2; ++i2) { const int col = 512 * i2 + 8 * lane; const f32x4 m0 = *(const f32x4*)(mx + col), m1 = *(const f32x4*)(mx + col + 4);
                            const f32x4 a = h[2 * i2] + (hp[2 * i2] - h[2 * i2]) * m0, b2 = h[2 * i2 + 1] + (hp[2 * i2 + 1] - h[2 * i2 + 1]) * m1;
                            u32x4 w; w.x = pk_bf16(a[0], a[1]); w.y = pk_bf16(a[2], a[3]); w.z = pk_bf16(b2[0], b2[1]); w.w = pk_bf16(b2[2], b2[3]);
                            *(u32x4*)(XR + (size_t)n * XR_STRIDE + (size_t)row * D + col) = w; }
                    }
                    const bool lastp = row < NP && (row & 4095) == 4095, lasts = row >= NP && ((row - NP) & 7) == 7;
                    if (lastp || lasts) {
                        float* so = lastp ? p->out + O_SHP + ((size_t)j * 4 + seq) * D : p->out + O_SHS + ((size_t)j * 32 + (seq - 4)) * D;
#pragma unroll
                        for (int i = 0; i < 4; ++i) *(f32x4*)(so + 512 * (i >> 1) + 8 * lane + 4 * (i & 1)) = h[i];
                    }
                }
#pragma unroll
                for (int i = 0; i < 4; ++i) hp[i] = h[i];
            } else {
#pragma unroll
                for (int i2 = 0; i2 < 2; ++i2) { const f32x4 a = h[2 * i2], b2 = h[2 * i2 + 1]; u32x4 w; w.x = pk_bf16(a[0], a[1]); w.y = pk_bf16(a[2], a[3]); w.z = pk_bf16(b2[0], b2[1]); w.w = pk_bf16(b2[2], b2[3]);
                    *(u32x4*)(XR + (size_t)row * D + 512 * i2 + 8 * lane) = w; }
            }
        }
    }
}

__device__ __forceinline__ void phase_scanprep(KP p, int j) {
    const bf16_t *KB = WSP(bf16_t, WS_KB), *VB = WSP(bf16_t, WS_VB);
    const float *WPp = WSP(float, WS_WP), *APp = WSP(float, WS_AP), *VPp = WSP(float, WS_VP);
    float *VF = WSP(float, WS_VFIRST), *DEC = WSP(float, WS_DEC), *KM = WSP(float, WS_KM), *VM = WSP(float, WS_VM), *AV = WSP(float, WS_AV), *BV = WSP(float, WS_BV);
    const int lane = TID() & 63, gw = BID() * 8 + (TID() >> 6), nw = gridDim.x * 8;
    for (int row = gw; row < NT; row += nw) {
#pragma unroll
        for (int i = 0; i < 4; ++i) {
            const int col = 256 * i + 4 * lane; const size_t o = (size_t)row * D + col;
            const f32x4 k = ld_bf4(KB + o), v = ld_bf4(VB + o), wp = *(const f32x4*)(WPp + o), ap = *(const f32x4*)(APp + o);
            const f32x4 w0 = *(const f32x4*)(p->rw_w0 + j * D + col), a0 = *(const f32x4*)(p->rw_a0 + j * D + col), kkw = *(const f32x4*)(p->rw_k_k + j * D + col), kaw = *(const f32x4*)(p->rw_k_a + j * D + col);
            f32x4 dec, a, vm, kk, km;
#pragma unroll
            for (int e = 0; e < 4; ++e) {
                const float wpre = w0[e] + wp[e], z = -wpre, sp = fmaxf(z, 0.f) + log1pf(expf(-fabsf(z)));
                dec[e] = expf(-expf(-sp - 0.5f));
                a[e] = sigmoidf_(a0[e] + ap[e]);
                kk[e] = k[e] * kkw[e];
                km[e] = k[e] * (1.0f + (a[e] - 1.0f) * kaw[e]);
            }
            if (j == 0) { vm = v; *(f32x4*)(VF + o) = v; }
            else { const f32x4 vf = *(const f32x4*)(VF + o), vp = *(const f32x4*)(VPp + o), v0 = *(const f32x4*)(p->rw_v0 + (j - 1) * D + col);
#pragma unroll
                for (int e = 0; e < 4; ++e) vm[e] = v[e] + (vf[e] - v[e]) * sigmoidf_(v0[e] + vp[e]); }
            float ss = kk[0] * kk[0] + kk[1] * kk[1] + kk[2] * kk[2] + kk[3] * kk[3];
            ss = g16_sum(ss);
            const float inv = rsqrtf(fmaxf(ss, 1e-24f));
            kk = kk * inv;
            *(f32x4*)(DEC + o) = dec; *(f32x4*)(KM + o) = km; *(f32x4*)(VM + o) = vm; *(f32x4*)(AV + o) = -kk; *(f32x4*)(BV + o) = kk * a;
        }
    }
}

__device__ __forceinline__ float rl(float v, int k) { return __int_as_float(__builtin_amdgcn_readlane(__float_as_int(v), k)); }
__device__ __forceinline__ void scan_run(KP p, size_t row_base, int nsteps, int colbase, float (&S)[64]) {
    const float *DEC = WSP(float, WS_DEC), *KM = WSP(float, WS_KM), *VM = WSP(float, WS_VM), *AV = WSP(float, WS_AV), *BV = WSP(float, WS_BV);
    const bf16_t* RB = WSP(bf16_t, WS_RB); float* Y = WSP(float, WS_Y);
    const int lane = TID() & 63;
    size_t o = row_base * D + colbase + lane;
    float w = DEC[o], kx = KM[o], v = VM[o], a = AV[o], b = BV[o], r = bf2f(RB[o]);
    for (int t = 0; t < nsteps; ++t) {
        const size_t on = (t + 1 < nsteps) ? o + D : o;
        const float wn = DEC[on], kn = KM[on], vn = VM[on], an = AV[on], bn = BV[on], rn = bf2f(RB[on]);
        float sa = 0.f;
#pragma unroll
        for (int k = 0; k < 64; ++k) sa += S[k] * rl(a, k);
#pragma unroll
        for (int k = 0; k < 64; ++k) S[k] = S[k] * rl(w, k) + sa * rl(b, k) + v * rl(kx, k);
        float y = 0.f;
#pragma unroll
        for (int k = 0; k < 64; ++k) y += S[k] * rl(r, k);
        Y[o] = y;
        o = on; w = wn; kx = kn; v = vn; a = an; b = bn; r = rn;
    }
}
__device__ __forceinline__ void phase_scanA(KP p) {
    const float *DEC = WSP(float, WS_DEC), *KM = WSP(float, WS_KM), *VM = WSP(float, WS_VM), *AV = WSP(float, WS_AV), *BV = WSP(float, WS_BV);
    float *PCH = WSP(float, WS_PCH), *CCH = WSP(float, WS_CCH);
    const int lane = TID() & 63, gw = BID() * 8 + (TID() >> 6), nw = gridDim.x * 8;
    for (int it = gw; it < 64 * NCH; it += nw) {
        const int sh = it / NCH, c = it % NCH, b = sh >> 4, h = sh & 15;
        float SP[64], SC[64];
#pragma unroll
        for (int k = 0; k < 64; ++k) { SP[k] = (k == lane) ? 1.f : 0.f; SC[k] = 0.f; }
        size_t o = ((size_t)b * 4096 + (size_t)c * LCH) * D + h * 64 + lane;
        float w = DEC[o], kx = KM[o], v = VM[o], a = AV[o], bb = BV[o];
        for (int t = 0; t < LCH; ++t) {
            const size_t on = (t + 1 < LCH) ? o + D : o;
            const float wn = DEC[on], kn = KM[on], vn = VM[on], an = AV[on], bn = BV[on];
            float saP = 0.f, saC = 0.f;
#pragma unroll
            for (int k = 0; k < 64; ++k) { const float ak = rl(a, k); saP += SP[k] * ak; saC += SC[k] * ak; }
#pragma unroll
            for (int k = 0; k < 64; ++k) { const float wk = rl(w, k), bk = rl(bb, k); SP[k] = SP[k] * wk + saP * bk; SC[k] = SC[k] * wk + saC * bk + v * rl(kx, k); }
            o = on; w = wn; kx = kn; v = vn; a = an; bb = bn;
        }
        float* po = PCH + ((size_t)it * 64 + lane) * 64; float* co = CCH + ((size_t)it * 64 + lane) * 64;
#pragma unroll
        for (int k = 0; k < 64; k += 4) { *(f32x4*)(po + k) = (f32x4){SP[k], SP[k + 1], SP[k + 2], SP[k + 3]}; *(f32x4*)(co + k) = (f32x4){SC[k], SC[k + 1], SC[k + 2], SC[k + 3]}; }
    }
}
__device__ __forceinline__ void phase_scanB(KP p, int j, LAS unsigned char* lds) {
    const int tid = TID(), lane = tid & 63, wave = tid >> 6;
    if (BID() < 32) {
        const float *PCH = WSP(float, WS_PCH), *CCH = WSP(float, WS_CCH); float* SST = WSP(float, WS_SST);
        const int sh = BID() * 2 + (wave >> 2), q = wave & 3, row0 = 32 * (q >> 1), col0 = 32 * (q & 1), b = sh >> 4, h = sh & 15;
        LAS float* Sl = (LAS float*)lds + (wave >> 2) * (2 * 64 * 65);
        const int lr = lane & 31, lh = lane >> 5;
        f32x16 acc;
#pragma unroll
        for (int r = 0; r < 16; ++r) acc[r] = 0.f;
        for (int c = 0; c <= NCH; ++c) {
            LAS float* Sw = Sl + (c & 1) * (64 * 65);
            float* go = c < NCH ? SST + ((size_t)sh * NCH + c) * 4096 : p->out + O_WKVP + (((size_t)j * 4 + b) * 16 + h) * 4096;
#pragma unroll
            for (int r = 0; r < 16; ++r) { const int row = row0 + (r & 3) + 8 * (r >> 2) + 4 * lh; Sw[row * 65 + col0 + lr] = acc[r]; go[row * 64 + col0 + lr] = acc[r]; }
            if (c == NCH) break;
            const float* Pc = PCH + ((size_t)sh * NCH + c) * 4096; const float* Cc = CCH + ((size_t)sh * NCH + c) * 4096;
            float bv[32];
#pragma unroll
            for (int kk = 0; kk < 32; ++kk) bv[kk] = Pc[(2 * kk + lh) * 64 + col0 + lr];
#pragma unroll
            for (int r = 0; r < 16; ++r) acc[r] = Cc[(row0 + (r & 3) + 8 * (r >> 2) + 4 * lh) * 64 + col0 + lr];
            __syncthreads();
#pragma unroll
            for (int kk = 0; kk < 32; ++kk) acc = __builtin_amdgcn_mfma_f32_32x32x2f32(Sw[(row0 + lr) * 65 + 2 * kk + lh], bv[kk], acc, 0, 0, 0);
        }
    } else {
        for (int it = (BID() - 32) * 8 + wave; it < 512; it += (gridDim.x - 32) * 8) {
            const int b = it >> 4, h = it & 15;
            const float* s0 = p->state_wkv + (((size_t)j * 32 + b) * 16 + h) * 4096 + lane * 64;
            float S[64];
#pragma unroll
            for (int k = 0; k < 64; k += 4) { const f32x4 t = *(const f32x4*)(s0 + k); S[k] = t[0]; S[k + 1] = t[1]; S[k + 2] = t[2]; S[k + 3] = t[3]; }
            scan_run(p, (size_t)NP + b * 8, 8, h * 64, S);
            float* o = p->out + O_WKVS + (((size_t)j * 32 + b) * 16 + h) * 4096 + lane * 64;
#pragma unroll
            for (int k = 0; k < 64; k += 4) *(f32x4*)(o + k) = (f32x4){S[k], S[k + 1], S[k + 2], S[k + 3]};
        }
    }
    __syncthreads();
}
__device__ __forceinline__ void phase_scanC(KP p) {
    const float* SST = WSP(float, WS_SST);
    const int lane = TID() & 63, gw = BID() * 8 + (TID() >> 6), nw = gridDim.x * 8;
    for (int it = gw; it < 64 * NCH; it += nw) {
        const int sh = it / NCH, c = it % NCH, b = sh >> 4, h = sh & 15;
        const float* s0 = SST + ((size_t)it * 64 + lane) * 64;
        float S[64];
#pragma unroll
        for (int k = 0; k < 64; k += 4) { const f32x4 t = *(const f32x4*)(s0 + k); S[k] = t[0]; S[k + 1] = t[1]; S[k + 2] = t[2]; S[k + 3] = t[3]; }
        scan_run(p, (size_t)b * 4096 + (size_t)c * LCH, LCH, h * 64, S);
    }
}


constexpr int CST = 72;
constexpr int CMAT = 64 * CST * 2;
constexpr int CH_F32 = 11 * CMAT, CH_PART = CH_F32 + 64 * 68 * 4, CH_GL = CH_PART + 64 * 4 * 4;
__device__ __forceinline__ bf16x8 cfrag(const LAS bf16_t* M, int row, int ks, int c4) { return *(const LAS bf16x8*)(M + row * CST + 32 * ks + 8 * c4); }
__device__ __forceinline__ f32x4 cmm(const LAS bf16_t* A, int arow, const LAS bf16_t* B, int brow, int c4, f32x4 acc) {
    acc = __builtin_amdgcn_mfma_f32_16x16x32_bf16(cfrag(A, arow, 0, c4), cfrag(B, brow, 0, c4), acc, 0, 0, 0);
    return __builtin_amdgcn_mfma_f32_16x16x32_bf16(cfrag(A, arow, 1, c4), cfrag(B, brow, 1, c4), acc, 0, 0, 0); }
__device__ __forceinline__ unsigned short f2bf(float x) { return (unsigned short)(pk_bf16(x, 0.f) & 0xffffu); }
__device__ __forceinline__ void st_t4(LAS bf16_t* Mt, int d, int t0, f32x4 v) { u32x2 w; w.x = pk_bf16(v[0], v[1]); w.y = pk_bf16(v[2], v[3]); *(LAS u32x2*)(Mt + d * CST + t0) = w; }

__device__ __forceinline__ void phase_chunk(KP p, int j, LAS unsigned char* lds) {
    LAS bf16_t* Mx = (LAS bf16_t*)lds;
#define CM(i) (Mx + (i) * (64 * CST))
    LAS float* F32 = (LAS float*)(lds + CH_F32);
    asm volatile("" : "+v"(F32));
    LAS float* part = (LAS float*)(lds + CH_PART);
    LAS float* gLs = (LAS float*)(lds + CH_GL);
    const bf16_t *RB = WSP(bf16_t, WS_RB), *KB = WSP(bf16_t, WS_KB), *VB = WSP(bf16_t, WS_VB), *TW = WSP(bf16_t, WS_TW), *TA_ = WSP(bf16_t, WS_TA), *TV = WSP(bf16_t, WS_TV);
    const bf16_t *W2T = WSP(bf16_t, WS_W2T) + (size_t)j * D * 64, *A2T = WSP(bf16_t, WS_A2T) + (size_t)j * D * 64, *V2T = WSP(bf16_t, WS_V2T);
    float* VF = WSP(float, WS_VFIRST); float *PCH = WSP(float, WS_PCH), *CCH = WSP(float, WS_CCH), *Y0 = WSP(float, WS_Y), *BON = WSP(float, WS_AV);
    bf16_t *GM = WSP(bf16_t, WS_DEC), *VM2 = WSP(bf16_t, WS_KM);
#define CH_BAR() do { asm volatile("s_waitcnt lgkmcnt(0)" ::: "memory"); __builtin_amdgcn_s_barrier(); asm volatile("" ::: "memory"); } while (0)
    bf16x8 f_aw[2], f_aa[2], f_av; unsigned short e_k[2][4], e_v[2][4], e_r[2][4];
    f_av = (bf16x8){0, 0, 0, 0, 0, 0, 0, 0};
#define CH_PREFETCH(itx) do { const int tid_ = TID(), lane_ = tid_ & 63, w_ = tid_ >> 6, n_ = lane_ & 15, c4_ = lane_ >> 4, tr_ = w_ >> 1, tcb_ = 2 * (w_ & 1); \
        const int sh_ = (itx) / NCH, c_ = (itx) % NCH, R0_ = (sh_ >> 4) * 4096 + c_ * LCH, hc_ = (sh_ & 15) * 64; const int ar_ = 16 * tr_ + n_; \
        _Pragma("unroll") for (int ks = 0; ks < 2; ++ks) { f_aw[ks] = *(const bf16x8*)(TW + (size_t)R0_ * 64 + ar_ * 64 + 32 * ks + 8 * c4_); f_aa[ks] = *(const bf16x8*)(TA_ + (size_t)R0_ * 64 + ar_ * 64 + 32 * ks + 8 * c4_); } \
        if (j == 1) f_av = *(const bf16x8*)(TV + (size_t)R0_ * 32 + ar_ * 32 + 8 * c4_); \
        _Pragma("unroll") for (int ti = 0; ti < 2; ++ti) _Pragma("unroll") for (int r = 0; r < 4; ++r) { const size_t o_ = (size_t)R0_ * D + hc_ + (16 * tr_ + 4 * c4_ + r) * D + 16 * (tcb_ + ti) + n_; \
            e_k[ti][r] = KB[o_]; e_v[ti][r] = VB[o_]; e_r[ti][r] = RB[o_]; } } while (0)
#define CH_MAP(q_) (((((q_) >> 4) & 3) * 16 + ((q_) & 15)) * NCH + ((q_) >> 6))
    if (BID() < 64 * NCH) CH_PREFETCH(CH_MAP(BID()));
    for (int q = BID(); q < 64 * NCH; q += gridDim.x) {
        const int it = CH_MAP(q);
        const int tid = TID(), lane = tid & 63, w = tid >> 6, n = lane & 15, c4 = lane >> 4, tr = w >> 1, tcb = 2 * (w & 1);
        const int sh = it / NCH, c = it % NCH, b = sh >> 4, h = sh & 15, R0 = b * 4096 + c * LCH, hc = h * 64;
        const bf16_t *KBb = KB + (size_t)R0 * D + hc, *VBb = VB + (size_t)R0 * D + hc, *RBb = RB + (size_t)R0 * D + hc;
        bf16_t* VFb = (bf16_t*)VF + (size_t)R0 * D + hc; bf16_t* VM2b = VM2 + (size_t)R0 * D + hc; bf16_t* GMb = GM + (size_t)R0 * D + hc; bf16_t* Y0b = (bf16_t*)Y0 + (size_t)R0 * D + hc;
        float* PCb = PCH + (size_t)it * 4096; float* CCb = CCH + (size_t)it * 4096; float* BONb = BON + (size_t)R0 * 16 + h;
        const bf16_t *TWb = TW + (size_t)R0 * 64, *TAb = TA_ + (size_t)R0 * 64, *TVb = TV + (size_t)R0 * 32, *W2b = W2T + (size_t)hc * 64, *A2b = A2T + (size_t)hc * 64, *V2b = V2T + (size_t)hc * 32;
        const float *w0b = p->rw_w0 + j * D + hc, *a0b = p->rw_a0 + j * D + hc, *kkb = p->rw_k_k + j * D + hc, *kab = p->rw_k_a + j * D + hc, *rkb = p->rw_r_k + j * D + hc, *v0b = p->rw_v0 + (j ? (j - 1) : 0) * D + hc;
        f32x4 wp[2], ap[2], vp[2];
#pragma unroll
        for (int ti = 0; ti < 2; ++ti) { wp[ti] = (f32x4){0.f, 0.f, 0.f, 0.f}; ap[ti] = wp[ti]; vp[ti] = wp[ti]; }
        {   const int ar = 16 * tr + n;
#pragma unroll
            for (int ks = 0; ks < 2; ++ks) {
                const bf16x8 aw = f_aw[ks], aa = f_aa[ks];
#pragma unroll
                for (int ti = 0; ti < 2; ++ti) { const int br = 16 * (tcb + ti) + n;
                    wp[ti] = __builtin_amdgcn_mfma_f32_16x16x32_bf16(aw, *(const bf16x8*)(W2b + br * 64 + 32 * ks + 8 * c4), wp[ti], 0, 0, 0);
                    ap[ti] = __builtin_amdgcn_mfma_f32_16x16x32_bf16(aa, *(const bf16x8*)(A2b + br * 64 + 32 * ks + 8 * c4), ap[ti], 0, 0, 0); }
            }
            if (j == 1) { const bf16x8 av = f_av;
#pragma unroll
                for (int ti = 0; ti < 2; ++ti) vp[ti] = __builtin_amdgcn_mfma_f32_16x16x32_bf16(av, *(const bf16x8*)(V2b + (16 * (tcb + ti) + n) * 32 + 8 * c4), vp[ti], 0, 0, 0); }
        }
        f32x4 lw[2], asg[2], kkv[2], kpr[2], vpr[2], rr[2];
        float ssq[4] = {0.f, 0.f, 0.f, 0.f}, bon[4] = {0.f, 0.f, 0.f, 0.f};
        float vf8[2][4];
#pragma unroll
        for (int ti = 0; ti < 2; ++ti)
#pragma unroll
            for (int r = 0; r < 4; ++r) vf8[ti][r] = 0.f;
        if (j == 1) {
#pragma unroll
            for (int ti = 0; ti < 2; ++ti)
#pragma unroll
                for (int r = 0; r < 4; ++r) vf8[ti][r] = bf2f(VFb[(16 * tr + 4 * c4 + r) * D + 16 * (tcb + ti) + n]);
        }
#pragma unroll
        for (int ti = 0; ti < 2; ++ti) {
            const int d = 16 * (tcb + ti) + n;
            const float w0 = w0b[d], a0 = a0b[d], kkw = kkb[d], kaw = kab[d], rkw = rkb[d];
            const float v0 = j ? v0b[d] : 0.f;
#pragma unroll
            for (int r = 0; r < 4; ++r) {
                const int o = (16 * tr + 4 * c4 + r) * D + d;
                const float kx = bf2f(e_k[ti][r]), vx = bf2f(e_v[ti][r]), rx = bf2f(e_r[ti][r]);
                const float z = -(w0 + wp[ti][r]), sp = fmaxf(z, 0.f) + __logf(1.0f + __expf(-fabsf(z)));
                lw[ti][r] = -__expf(-sp - 0.5f);
                const float a = fsig(a0 + ap[ti][r]);
                asg[ti][r] = a;
                float vv = vx;
                if (j == 0) VFb[o] = e_v[ti][r]; else { const float vf = vf8[ti][r]; vv = vx + (vf - vx) * fsig(v0 + vp[ti][r]); }
                vpr[ti][r] = vv; rr[ti][r] = rx;
                const float kk = kx * kkw; kkv[ti][r] = kk; ssq[r] += kk * kk;
                const float kp = kx * (1.0f + (a - 1.0f) * kaw); kpr[ti][r] = kp; bon[r] += rx * kp * rkw;
                F32[(16 * tr + 4 * c4 + r) * 68 + d] = lw[ti][r];
                VM2b[o] = f2bf(vv);
            }
        }
#pragma unroll
        for (int r = 0; r < 4; ++r) { ssq[r] = g16_sum(ssq[r]); bon[r] = g16_sum(bon[r]); }
        if (n == 0) {
#pragma unroll
            for (int r = 0; r < 4; ++r) { const int t = 16 * tr + 4 * c4 + r; part[(t * 2 + (w & 1)) * 2 + 0] = ssq[r]; part[(t * 2 + (w & 1)) * 2 + 1] = bon[r]; }
        }
        if (q + (int)gridDim.x < 64 * NCH) CH_PREFETCH(CH_MAP(q + (int)gridDim.x));
        CH_BAR();
        f32x4 cs[2];
#pragma unroll
        for (int ti = 0; ti < 2; ++ti) {
            f32x4 acc = {0.f, 0.f, 0.f, 0.f};
            for (int q = 0; q < 4 * (tr + 1); ++q) {
                const float av = (4 * q + c4 <= 16 * tr + n) ? 1.0f : 0.0f;
                acc = __builtin_amdgcn_mfma_f32_16x16x4f32(av, F32[(4 * q + c4) * 68 + 16 * (tcb + ti) + n], acc, 0, 0, 0);
            }
            cs[ti] = acc;
        }
        float inv[4];
#pragma unroll
        for (int r = 0; r < 4; ++r) { const int t = 16 * tr + 4 * c4 + r; inv[r] = rsqrtf(fmaxf(part[(t * 2 + 0) * 2] + part[(t * 2 + 1) * 2], 1e-24f));
            if (n == 0 && (w & 1) == 0) BONb[t * 16] = part[(t * 2 + 0) * 2 + 1] + part[(t * 2 + 1) * 2 + 1]; }
        f32x4 rt[2];
#pragma unroll
        for (int ti = 0; ti < 2; ++ti) {
            const int d = 16 * (tcb + ti) + n, t0 = 16 * tr + 4 * c4;
            f32x4 at, bt, kt;
#pragma unroll
            for (int r = 0; r < 4; ++r) {
                const float g = __expf(cs[ti][r]), gi = __expf(-cs[ti][r]), gm = __expf(cs[ti][r] - lw[ti][r]);
                const float kk = kkv[ti][r] * inv[r];
                at[r] = -kk * gm; bt[r] = kk * asg[ti][r] * gi; kt[r] = kpr[ti][r] * gi; rt[ti][r] = rr[ti][r] * g;
                CM(0)[(t0 + r) * CST + d] = f2bf(at[r]); CM(1)[(t0 + r) * CST + d] = f2bf(bt[r]); CM(2)[(t0 + r) * CST + d] = f2bf(kt[r]); CM(3)[(t0 + r) * CST + d] = f2bf(rt[ti][r]);
                if (t0 + r == 63) gLs[d] = g;
            }
            st_t4(CM(4), d, t0, at); st_t4(CM(5), d, t0, bt); st_t4(CM(6), d, t0, kt); st_t4(CM(7), d, t0, vpr[ti]);
        }
        CH_BAR();
#pragma unroll
        for (int ti = 0; ti < 2; ++ti) {
            const int tc = tcb + ti, s = 16 * tc + n, t0 = 16 * tr + 4 * c4;
            if (tc <= tr) {
                { f32x4 m = {0.f, 0.f, 0.f, 0.f}; m = cmm(CM(0), 16 * tr + n, CM(1), 16 * tc + n, c4, m);
#pragma unroll
                  for (int r = 0; r < 4; ++r) F32[(t0 + r) * 68 + s] = (s < t0 + r) ? m[r] : 0.f; }
                asm volatile("" ::: "memory");
                { f32x4 m = {0.f, 0.f, 0.f, 0.f}; m = cmm(CM(0), 16 * tr + n, CM(2), 16 * tc + n, c4, m);
#pragma unroll
                  for (int r = 0; r < 4; ++r) CM(8)[(t0 + r) * CST + s] = f2bf((s < t0 + r) ? m[r] : 0.f); }
                asm volatile("" ::: "memory");
                { f32x4 m = {0.f, 0.f, 0.f, 0.f}; m = cmm(CM(3), 16 * tr + n, CM(1), 16 * tc + n, c4, m);
#pragma unroll
                  for (int r = 0; r < 4; ++r) CM(9)[(t0 + r) * CST + s] = f2bf((s <= t0 + r) ? m[r] : 0.f); }
                asm volatile("" ::: "memory");
                { f32x4 m = {0.f, 0.f, 0.f, 0.f}; m = cmm(CM(3), 16 * tr + n, CM(2), 16 * tc + n, c4, m);
#pragma unroll
                  for (int r = 0; r < 4; ++r) CM(10)[(t0 + r) * CST + s] = f2bf((s <= t0 + r) ? m[r] : 0.f); }
                asm volatile("" ::: "memory");
            } else {
#pragma unroll
                for (int r = 0; r < 4; ++r) { F32[(t0 + r) * 68 + s] = 0.f; CM(8)[(t0 + r) * CST + s] = 0; CM(9)[(t0 + r) * CST + s] = 0; CM(10)[(t0 + r) * CST + s] = 0; }
            }
        }
        CH_BAR();
        { const int e0 = tid * 8;
#pragma unroll
          for (int e = 0; e < 8; ++e) { const int t = (e0 + e) >> 6, s_ = (e0 + e) & 63; CM(2)[t * CST + s_] = f2bf(F32[t * 68 + s_]); }
          unsigned z_ = 0u; asm volatile("" : "+v"(z_));
          *(LAS u32x4*)(CM(0) + (e0 >> 6) * CST + (e0 & 63)) = (u32x4){z_, z_, z_, z_}; }
        CH_BAR();
        if (w < 4) {
            const int cw = 16 * w;
            LAS float* scr = (LAS float*)CM(1) + w * (16 * 17);
#pragma unroll 1
            for (int I = 0; I < 4; ++I) {
                f32x4 rh = {0.f, 0.f, 0.f, 0.f};
                if (I > 0) { rh = __builtin_amdgcn_mfma_f32_16x16x32_bf16(cfrag(CM(2), 16 * I + n, 0, c4), cfrag(CM(0), cw + n, 0, c4), rh, 0, 0, 0);
                    if (I > 2) rh = __builtin_amdgcn_mfma_f32_16x16x32_bf16(cfrag(CM(2), 16 * I + n, 1, c4), cfrag(CM(0), cw + n, 1, c4), rh, 0, 0, 0); }
#pragma unroll
                for (int r = 0; r < 4; ++r) scr[(4 * c4 + r) * 17 + n] = rh[r] + ((16 * I + 4 * c4 + r) == (cw + n) ? 1.f : 0.f);
                wave_lds_fence();
                float x[16];
#pragma unroll
                for (int i = 0; i < 16; ++i) x[i] = scr[i * 17 + n];
                f32x4 mc[4], mn[4];
                mc[0] = *(const LAS f32x4*)(F32 + (16 * I + 1) * 68 + 16 * I);
#pragma unroll
                for (int i = 1; i < 16; ++i) {
                    if (i + 1 < 16) {
#pragma unroll
                        for (int j4 = 0; j4 < (i + 4) / 4; ++j4) mn[j4] = *(const LAS f32x4*)(F32 + (16 * I + i + 1) * 68 + 16 * I + 4 * j4);
                    }
                    float a0 = 0.f, a1 = 0.f;
#pragma unroll
                    for (int j4 = 0; j4 < (i + 3) / 4; ++j4) {
                        if (4 * j4 + 0 < i) a0 += mc[j4][0] * x[4 * j4 + 0];
                        if (4 * j4 + 1 < i) a1 += mc[j4][1] * x[4 * j4 + 1];
                        if (4 * j4 + 2 < i) a0 += mc[j4][2] * x[4 * j4 + 2];
                        if (4 * j4 + 3 < i) a1 += mc[j4][3] * x[4 * j4 + 3];
                    }
                    x[i] += a0 + a1;
#pragma unroll
                    for (int j4 = 0; j4 < 4; ++j4) mc[j4] = mn[j4];
                    asm volatile("" ::: "memory");
                }
                if (c4 == 0) {
#pragma unroll
                    for (int i = 0; i < 16; ++i) CM(3)[(16 * I + i) * CST + cw + n] = f2bf(x[i]);
                    u32x4 t0, t1;
                    t0.x = pk_bf16(x[0], x[1]); t0.y = pk_bf16(x[2], x[3]); t0.z = pk_bf16(x[4], x[5]); t0.w = pk_bf16(x[6], x[7]);
                    t1.x = pk_bf16(x[8], x[9]); t1.y = pk_bf16(x[10], x[11]); t1.z = pk_bf16(x[12], x[13]); t1.w = pk_bf16(x[14], x[15]);
                    *(LAS u32x4*)(CM(0) + (cw + n) * CST + 16 * I) = t0; *(LAS u32x4*)(CM(0) + (cw + n) * CST + 16 * I + 8) = t1;
                }
                wave_lds_fence();
            }
        }
        CH_BAR();
#pragma unroll
        for (int ti = 0; ti < 2; ++ti) {
            const int d = 16 * (tcb + ti) + n;
            { f32x4 x1 = {0.f, 0.f, 0.f, 0.f}; x1 = cmm(CM(8), 16 * tr + n, CM(7), 16 * (tcb + ti) + n, c4, x1); st_t4(CM(0), d, 16 * tr + 4 * c4, x1); }
            asm volatile("" ::: "memory");
            { f32x4 ta = {0.f, 0.f, 0.f, 0.f}; ta = cmm(CM(3), 16 * tr + n, CM(4), 16 * (tcb + ti) + n, c4, ta); st_t4(CM(1), d, 16 * tr + 4 * c4, ta); }
            asm volatile("" ::: "memory");
        }
        CH_BAR();
#pragma unroll
        for (int ti = 0; ti < 2; ++ti) {
            f32x4 uv = {0.f, 0.f, 0.f, 0.f};
            uv = cmm(CM(3), 16 * tr + n, CM(0), 16 * (tcb + ti) + n, c4, uv);
            st_t4(CM(2), 16 * (tcb + ti) + n, 16 * tr + 4 * c4, uv);
        }
        CH_BAR();
#pragma unroll
        for (int ti = 0; ti < 2; ++ti) {
            const int cc = 16 * (tcb + ti) + n, r0 = 16 * tr + 4 * c4;
            const float gl = gLs[cc];
            { f32x4 pm = {0.f, 0.f, 0.f, 0.f}; pm = cmm(CM(1), 16 * tr + n, CM(5), cc, c4, pm);
#pragma unroll
              for (int r = 0; r < 4; ++r) PCb[(r0 + r) * 64 + cc] = (pm[r] + ((r0 + r) == cc ? 1.f : 0.f)) * gl; }
            asm volatile("" ::: "memory");
            { f32x4 cm_ = {0.f, 0.f, 0.f, 0.f}; cm_ = cmm(CM(2), 16 * tr + n, CM(5), cc, c4, cm_); cm_ = cmm(CM(7), 16 * tr + n, CM(6), cc, c4, cm_);
#pragma unroll
              for (int r = 0; r < 4; ++r) CCb[(r0 + r) * 64 + cc] = cm_[r] * gl; }
            asm volatile("" ::: "memory");
            { f32x4 gg = {0.f, 0.f, 0.f, 0.f}; gg = cmm(CM(9), 16 * tr + n, CM(1), cc, c4, gg);
#pragma unroll
              for (int r = 0; r < 4; ++r) GMb[(r0 + r) * D + cc] = f2bf(gg[r] + rt[ti][r]); }
            asm volatile("" ::: "memory");
            { f32x4 y0 = {0.f, 0.f, 0.f, 0.f}; y0 = cmm(CM(9), 16 * tr + n, CM(2), cc, c4, y0); y0 = cmm(CM(10), 16 * tr + n, CM(7), cc, c4, y0);
#pragma unroll
              for (int r = 0; r < 4; ++r) Y0b[(r0 + r) * D + cc] = f2bf(y0[r]); }
            asm volatile("" ::: "memory");
        }
        CH_BAR();
    }
#undef CM
#undef CH_PREFETCH
#undef CH_BAR
}

__device__ __forceinline__ void phase_sample_mixer_w(KP p, int j, int first, int stride) {
    const int tid = TID(), lane = tid & 63;
    {
        const bf16_t *RB = WSP(bf16_t, WS_RB), *KB = WSP(bf16_t, WS_KB), *VB = WSP(bf16_t, WS_VB); bf16_t* YG = WSP(bf16_t, WS_YG);
        const float *WPp = WSP(float, WS_WP), *APp = WSP(float, WS_AP), *VPp = WSP(float, WS_VP), *GG = WSP(float, WS_GG); float* VF = WSP(float, WS_VFIRST);
        for (int it = first; it < 512; it += stride) {
            const int b = it >> 4, h = it & 15, col = h * 64 + lane;
            const float* s0 = p->state_wkv + (((size_t)j * 32 + b) * 16 + h) * 4096 + lane * 64;
            float S[64];
#pragma unroll
            for (int k = 0; k < 64; k += 4) { const f32x4 t = *(const f32x4*)(s0 + k); S[k] = t[0]; S[k + 1] = t[1]; S[k + 2] = t[2]; S[k + 3] = t[3]; }
            const float w0 = p->rw_w0[j * D + col], a0 = p->rw_a0[j * D + col], kkw = p->rw_k_k[j * D + col], kaw = p->rw_k_a[j * D + col], rkw = p->rw_r_k[j * D + col];
            const float v0 = j ? p->rw_v0[(j - 1) * D + col] : 0.f, lnw = p->rw_lnx_w[j * D + col], lnb = p->rw_lnx_b[j * D + col];
            for (int t = 0; t < 8; ++t) {
                const size_t o = (size_t)(NP + b * 8 + t) * D + col;
                const float kx = bf2f(KB[o]), vx = bf2f(VB[o]), r = bf2f(RB[o]);
                const float z = -(w0 + WPp[o]), sp = fmaxf(z, 0.f) + log1pf(expf(-fabsf(z)));
                const float wd = expf(-expf(-sp - 0.5f)), asg = sigmoidf_(a0 + APp[o]);
                float v = vx;
                if (j == 0) VF[o] = vx; else { const float vf = VF[o]; v = vx + (vf - vx) * sigmoidf_(v0 + VPp[o]); }
                float kk = kx * kkw; const float ss = wave_sum(kk * kk); kk *= rsqrtf(fmaxf(ss, 1e-24f));
                const float kp = kx * (1.0f + (asg - 1.0f) * kaw), a = -kk, bq = kk * asg;
                float sa = 0.f;
#pragma unroll
                for (int k = 0; k < 64; ++k) sa += S[k] * rl(a, k);
#pragma unroll
                for (int k = 0; k < 64; ++k) S[k] = S[k] * rl(wd, k) + sa * rl(bq, k) + v * rl(kp, k);
                float y = 0.f;
#pragma unroll
                for (int k = 0; k < 64; ++k) y += S[k] * rl(r, k);
                const float mu = wave_sum(y) * (1.0f / 64.0f), dy = y - mu, var = wave_sum(dy * dy) * (1.0f / 64.0f);
                const float bonus = wave_sum(r * kp * rkw);
                YG[o] = f2bf((dy * rsqrtf(var + 64e-5f) * lnw + lnb + bonus * v) * GG[o]);
            }
            float* so = p->out + O_WKVS + (((size_t)j * 32 + b) * 16 + h) * 4096 + lane * 64;
#pragma unroll
            for (int k = 0; k < 64; k += 4) *(f32x4*)(so + k) = (f32x4){S[k], S[k + 1], S[k + 2], S[k + 3]};
        }
    }
}
__device__ __forceinline__ void phase_carry(KP p, int j, LAS unsigned char* lds) {
    const float *PCH = WSP(float, WS_PCH), *CCH = WSP(float, WS_CCH); float* SST = WSP(float, WS_SST);
    LAS float* Sl = (LAS float*)lds;
    LAS unsigned* cflag = (LAS unsigned*)(lds + 9216);
    if (TID() == 0) *cflag = 0u;
    __syncthreads();
    unsigned arrivals = 0u;
    if ((TID() >> 6) >= 4) { phase_sample_mixer_w(p, j, BID() * 4 + ((TID() >> 6) - 4), (int)gridDim.x * 4); }
    else
    for (int it = BID(); it < 256; it += gridDim.x) {
        const int wave = TID() >> 6, sh = it >> 2, row0 = 16 * (it & 3), col0 = 16 * (wave & 3), b = sh >> 4, h = sh & 15;
        const bool act = true;
        f32x4 acc = {0.f, 0.f, 0.f, 0.f}, c0, c1, c2;
        float b0[16], b1[16], b2[16];
#define CARRY_LOAD(BX, CX, cc_) do { const int l_ = TID() & 63, ln = l_ & 15, lq = l_ >> 4; \
            const float* Pc = PCH + ((size_t)sh * NCH + (cc_)) * 4096; const float* Cc = CCH + ((size_t)sh * NCH + (cc_)) * 4096; \
            _Pragma("unroll") for (int q = 0; q < 16; ++q) BX[q] = Pc[(4 * q + lq) * 64 + col0 + ln]; \
            _Pragma("unroll") for (int r = 0; r < 4; ++r) CX[r] = Cc[(row0 + 4 * lq + r) * 64 + col0 + ln]; } while (0)
#define CARRY_STEP(BX, CX, BL, CL, c_) do { const int l_ = TID() & 63, ln = l_ & 15, lq = l_ >> 4; \
            LAS float* Sw = Sl + ((c_) & 1) * (16 * 68); bf16_t* go = (bf16_t*)SST + ((size_t)sh * NCH + (c_)) * 4096; \
            if (act) { _Pragma("unroll") for (int r = 0; r < 4; ++r) Sw[(4 * lq + r) * 68 + col0 + ln] = acc[r]; } \
            const f32x4 sc = acc; acc = CX; \
            asm volatile("s_waitcnt lgkmcnt(0)" ::: "memory"); arrivals += 4u; \
            if ((TID() & 63) == 0) __hip_atomic_fetch_add(cflag, 1u, __ATOMIC_RELAXED, __HIP_MEMORY_SCOPE_WORKGROUP); \
            { unsigned sp_ = 0; while (__builtin_amdgcn_readfirstlane(__hip_atomic_load(cflag, __ATOMIC_RELAXED, __HIP_MEMORY_SCOPE_WORKGROUP)) < arrivals && ++sp_ < (1u << 22)) __builtin_amdgcn_s_sleep(0); } \
            asm volatile("" ::: "memory"); \
            if (act) { \
                _Pragma("unroll") for (int r = 0; r < 4; ++r) go[(row0 + 4 * lq + r) * 64 + col0 + ln] = f2bf(sc[r]); \
                if ((c_) + 2 < NCH) CARRY_LOAD(BL, CL, (c_) + 2); \
                float av[16]; _Pragma("unroll") for (int q = 0; q < 16; ++q) av[q] = Sw[ln * 68 + 4 * q + lq]; \
                asm volatile("s_waitcnt lgkmcnt(0)" ::: "memory"); \
                _Pragma("unroll") for (int q = 0; q < 16; ++q) acc = __builtin_amdgcn_mfma_f32_16x16x4f32(av[q], BX[q], acc, 0, 0, 0); } } while (0)
        if (act) { CARRY_LOAD(b0, c0, 0); CARRY_LOAD(b1, c1, 1); }
        for (int c = 0; c < NCH; c += 3) {
            CARRY_STEP(b0, c0, b2, c2, c);
            if (c + 1 < NCH) CARRY_STEP(b1, c1, b0, c0, c + 1);
            if (c + 2 < NCH) CARRY_STEP(b2, c2, b1, c1, c + 2);
        }
        if (act) { const int l_ = TID() & 63, ln = l_ & 15, lq = l_ >> 4; float* go = p->out + O_WKVP + (((size_t)j * 4 + b) * 16 + h) * 4096;
#pragma unroll
            for (int r = 0; r < 4; ++r) go[(row0 + 4 * lq + r) * 64 + col0 + ln] = acc[r]; }
#undef CARRY_LOAD
#undef CARRY_STEP
    }
    __syncthreads();
}
__device__ __forceinline__ void phase_sample_mixer(KP p, int j) {
    const int tid = TID(), lane = tid & 63, wave = tid >> 6;
    {
        const bf16_t *RB = WSP(bf16_t, WS_RB), *KB = WSP(bf16_t, WS_KB), *VB = WSP(bf16_t, WS_VB); bf16_t* YG = WSP(bf16_t, WS_YG);
        const float *WPp = WSP(float, WS_WP), *APp = WSP(float, WS_AP), *VPp = WSP(float, WS_VP), *GG = WSP(float, WS_GG); float* VF = WSP(float, WS_VFIRST);
        for (int it = BID() * 8 + wave; it < 512; it += gridDim.x * 8) {
            const int b = it >> 4, h = it & 15, col = h * 64 + lane;
            const float* s0 = p->state_wkv + (((size_t)j * 32 + b) * 16 + h) * 4096 + lane * 64;
            float S[64];
#pragma unroll
            for (int k = 0; k < 64; k += 4) { const f32x4 t = *(const f32x4*)(s0 + k); S[k] = t[0]; S[k + 1] = t[1]; S[k + 2] = t[2]; S[k + 3] = t[3]; }
            const float w0 = p->rw_w0[j * D + col], a0 = p->rw_a0[j * D + col], kkw = p->rw_k_k[j * D + col], kaw = p->rw_k_a[j * D + col], rkw = p->rw_r_k[j * D + col];
            const float v0 = j ? p->rw_v0[(j - 1) * D + col] : 0.f, lnw = p->rw_lnx_w[j * D + col], lnb = p->rw_lnx_b[j * D + col];
            for (int t = 0; t < 8; ++t) {
                const size_t o = (size_t)(NP + b * 8 + t) * D + col;
                const float kx = bf2f(KB[o]), vx = bf2f(VB[o]), r = bf2f(RB[o]);
                const float z = -(w0 + WPp[o]), sp = fmaxf(z, 0.f) + log1pf(expf(-fabsf(z)));
                const float wd = expf(-expf(-sp - 0.5f)), asg = sigmoidf_(a0 + APp[o]);
                float v = vx;
                if (j == 0) VF[o] = vx; else { const float vf = VF[o]; v = vx + (vf - vx) * sigmoidf_(v0 + VPp[o]); }
                float kk = kx * kkw; const float ss = wave_sum(kk * kk); kk *= rsqrtf(fmaxf(ss, 1e-24f));
                const float kp = kx * (1.0f + (asg - 1.0f) * kaw), a = -kk, bq = kk * asg;
                float sa = 0.f;
#pragma unroll
                for (int k = 0; k < 64; ++k) sa += S[k] * rl(a, k);
#pragma unroll
                for (int k = 0; k < 64; ++k) S[k] = S[k] * rl(wd, k) + sa * rl(bq, k) + v * rl(kp, k);
                float y = 0.f;
#pragma unroll
                for (int k = 0; k < 64; ++k) y += S[k] * rl(r, k);
                const float mu = wave_sum(y) * (1.0f / 64.0f), dy = y - mu, var = wave_sum(dy * dy) * (1.0f / 64.0f);
                const float bonus = wave_sum(r * kp * rkw);
                YG[o] = f2bf((dy * rsqrtf(var + 64e-5f) * lnw + lnb + bonus * v) * GG[o]);
            }
            float* so = p->out + O_WKVS + (((size_t)j * 32 + b) * 16 + h) * 4096 + lane * 64;
#pragma unroll
            for (int k = 0; k < 64; k += 4) *(f32x4*)(so + k) = (f32x4){S[k], S[k + 1], S[k + 2], S[k + 3]};
        }
    }
}
__device__ __forceinline__ void phase_post2(KP p, int j, LAS unsigned char* lds) {
    LAS float* part = (LAS float*)lds;
    const bf16_t *GM = WSP(bf16_t, WS_DEC), *VM2 = WSP(bf16_t, WS_KM), *TG = WSP(bf16_t, WS_TG), *G2T = WSP(bf16_t, WS_G2T) + (size_t)j * D * 160;
    const float *Y0 = WSP(float, WS_Y), *BON = WSP(float, WS_AV), *SST = WSP(float, WS_SST); bf16_t* YG = WSP(bf16_t, WS_YG);
    for (int it = BID(); it < 64 * NCH; it += gridDim.x) {
        const int tid = TID(), lane = tid & 63, w = tid >> 6, n = lane & 15, c4 = lane >> 4, tr = w >> 1, tcb = 2 * (w & 1);
        const int sh = it / NCH, c = it % NCH, b = sh >> 4, h = sh & 15, R0 = b * 4096 + c * LCH, hc = h * 64;
        f32x4 y[2], g[2];
        const size_t ar = (size_t)(R0 + 16 * tr + n);
#pragma unroll
        for (int ti = 0; ti < 2; ++ti) {
            const int dv = 16 * (tcb + ti) + n;
            f32x4 acc = {0.f, 0.f, 0.f, 0.f}, gacc = acc;
#pragma unroll
            for (int ks = 0; ks < 2; ++ks) {
                const bf16x8 af = *(const bf16x8*)(GM + ar * D + hc + 32 * ks + 8 * c4);
                const bf16x8 bw = *(const bf16x8*)((const bf16_t*)SST + ((size_t)it * 64 + dv) * 64 + 32 * ks + 8 * c4);
                acc = __builtin_amdgcn_mfma_f32_16x16x32_bf16(af, bw, acc, 0, 0, 0);
            }
#pragma unroll
            for (int ks = 0; ks < 5; ++ks)
                gacc = __builtin_amdgcn_mfma_f32_16x16x32_bf16(*(const bf16x8*)(TG + ar * 160 + 32 * ks + 8 * c4), *(const bf16x8*)(G2T + (size_t)(hc + dv) * 160 + 32 * ks + 8 * c4), gacc, 0, 0, 0);
#pragma unroll
            for (int r = 0; r < 4; ++r) acc[r] += bf2f(((const bf16_t*)Y0)[(size_t)(R0 + 16 * tr + 4 * c4 + r) * D + hc + dv]);
            y[ti] = acc; g[ti] = gacc;
        }
        float bonus4[4]; unsigned short vm4[2][4]; float lnw2[2], lnb2[2];
#pragma unroll
        for (int r = 0; r < 4; ++r) bonus4[r] = BON[(size_t)(R0 + 16 * tr + 4 * c4 + r) * 16 + h];
#pragma unroll
        for (int ti = 0; ti < 2; ++ti) { const int col = hc + 16 * (tcb + ti) + n; lnw2[ti] = p->rw_lnx_w[j * D + col]; lnb2[ti] = p->rw_lnx_b[j * D + col];
#pragma unroll
            for (int r = 0; r < 4; ++r) vm4[ti][r] = VM2[(size_t)(R0 + 16 * tr + 4 * c4 + r) * D + col]; }
        float s1[4], s2[4];
#pragma unroll
        for (int r = 0; r < 4; ++r) { s1[r] = g16_sum(y[0][r] + y[1][r]); s2[r] = g16_sum(y[0][r] * y[0][r] + y[1][r] * y[1][r]); }
        asm volatile("s_waitcnt lgkmcnt(0)" ::: "memory"); __builtin_amdgcn_s_barrier(); asm volatile("" ::: "memory");
        if (n == 0) {
#pragma unroll
            for (int r = 0; r < 4; ++r) { const int t = 16 * tr + 4 * c4 + r; part[(t * 2 + (w & 1)) * 2 + 0] = s1[r]; part[(t * 2 + (w & 1)) * 2 + 1] = s2[r]; }
        }
        asm volatile("s_waitcnt lgkmcnt(0)" ::: "memory"); __builtin_amdgcn_s_barrier(); asm volatile("" ::: "memory");
#pragma unroll
        for (int r = 0; r < 4; ++r) {
            const int t = 16 * tr + 4 * c4 + r;
            const float mu = (part[(t * 2 + 0) * 2] + part[(t * 2 + 1) * 2]) * (1.0f / 64.0f), ex2 = (part[(t * 2 + 0) * 2 + 1] + part[(t * 2 + 1) * 2 + 1]) * (1.0f / 64.0f);
            const float rs = rsqrtf(fmaxf(ex2 - mu * mu, 0.f) + 64e-5f), bonus = bonus4[r];
#pragma unroll
            for (int ti = 0; ti < 2; ++ti) {
                const int col = hc + 16 * (tcb + ti) + n; const size_t o = (size_t)(R0 + t) * D + col;
                YG[o] = f2bf(((y[ti][r] - mu) * rs * lnw2[ti] + lnb2[ti] + bonus * bf2f(vm4[ti][r])) * g[ti][r]);
            }
        }
    }
    __syncthreads();
}

__device__ __forceinline__ void phase_post(KP p, int j) {
    const float *Y = WSP(float, WS_Y), *KM = WSP(float, WS_KM), *VM = WSP(float, WS_VM), *GG = WSP(float, WS_GG);
    const bf16_t* RB = WSP(bf16_t, WS_RB); bf16_t* YG = WSP(bf16_t, WS_YG);
    const int lane = TID() & 63, gw = BID() * 8 + (TID() >> 6), nw = gridDim.x * 8;
    for (int row = gw; row < NT; row += nw) {
#pragma unroll
        for (int i = 0; i < 4; ++i) {
            const int col = 256 * i + 4 * lane; const size_t o = (size_t)row * D + col;
            const f32x4 y = *(const f32x4*)(Y + o), r = ld_bf4(RB + o), km = *(const f32x4*)(KM + o), vm = *(const f32x4*)(VM + o), gg = *(const f32x4*)(GG + o);
            const f32x4 lw = *(const f32x4*)(p->rw_lnx_w + j * D + col), lb = *(const f32x4*)(p->rw_lnx_b + j * D + col), rk = *(const f32x4*)(p->rw_r_k + j * D + col);
            const float mu = g16_sum(y[0] + y[1] + y[2] + y[3]) * (1.0f / 64.0f);
            const f32x4 d = y - mu;
            const float var = g16_sum(d[0] * d[0] + d[1] * d[1] + d[2] * d[2] + d[3] * d[3]) * (1.0f / 64.0f);
            const float rs = rsqrtf(var + 64e-5f);
            const float bon = g16_sum(r[0] * km[0] * rk[0] + r[1] * km[1] * rk[1] + r[2] * km[2] * rk[2] + r[3] * km[3] * rk[3]);
            st_bf4(YG + o, (d * rs * lw + lb + bon * vm) * gg);
        }
    }
}

__constant__ double kRopeInv[8] = {1.0, 0.19392274474868576, 0.03760603093086393, 0.007292664737217109, 0.001414213562373095, 0.0002742481756762073, 5.318295896944988e-05, 1.031338537721246e-05};
__device__ __forceinline__ void phase_rope_table(KP p) {
    float* TB = WSP(float, WS_ROPE);
    for (int e = ((int)gridDim.x - 1 - BID()) * 512 + TID(); e < 4104 * 8; e += gridDim.x * 512) {
        const int pi = e >> 3, f = e & 7, pos = pi < 4096 ? pi : PAST + (pi - 4096);
        double ang = (double)pos * kRopeInv[f]; ang -= floor(ang * 0.15915494309189535) * 6.283185307179586; const float af = (float)ang;
        TB[pi * 16 + f] = cosf(af); TB[pi * 16 + 8 + f] = sinf(af);
    }
}
__device__ __forceinline__ void phase_dsapost(KP p, int j) {
    const bf16_t* PR = WSP(bf16_t, WS_PR); float *Q = WSP(float, WS_Q), *QI = WSP(float, WS_QI), *WI = WSP(float, WS_WI);
    const int lane = TID() & 63, l16 = lane & 15, gw = BID() * 8 + (TID() >> 6), nw = gridDim.x * 8;
    const f32x4 qn = *(const f32x4*)(p->att_q_norm + j * 64 + 4 * l16), kn = *(const f32x4*)(p->att_k_norm + j * 64 + 4 * l16), in = *(const f32x4*)(p->idx_k_norm + j * 64 + 4 * l16);
    for (int row = gw; row < NT; row += nw) {
        const int pos = row_pos(row);
        const bf16_t* pr = PR + (size_t)row * PINP;
        const float* tb = WSP(float, WS_ROPE) + (row < NP ? (row & 4095) : 4096 + ((row - NP) & 7)) * 16 + 4 * (l16 & 1);
        const f32x4 cs = *(const f32x4*)tb, sn = *(const f32x4*)(tb + 8);
        const float sgn = (l16 < 2) ? -1.0f : 1.0f;
#define ROPE4(v) do { f32x4 _o; _o[0] = __shfl_xor((v)[0], 2); _o[1] = __shfl_xor((v)[1], 2); _o[2] = __shfl_xor((v)[2], 2); _o[3] = __shfl_xor((v)[3], 2); if (l16 < 4) (v) = (v) * cs + sgn * (_o * sn); } while (0)
#define HNORM4(v, w) do { const float _ss = g16_sum((v)[0] * (v)[0] + (v)[1] * (v)[1] + (v)[2] * (v)[2] + (v)[3] * (v)[3]); (v) = (v) * rsqrtf(_ss * (1.0f / 64.0f) + 1e-6f) * (w); } while (0)
#pragma unroll
        for (int i = 0; i < 4; ++i) { f32x4 v = ld_bf4(pr + 256 * i + 4 * lane); HNORM4(v, qn); ROPE4(v); st_bf4((bf16_t*)Q + (size_t)row * D + 256 * i + 4 * lane, v); }
        { f32x4 v = ld_bf4(pr + 1024 + 4 * lane); HNORM4(v, kn); ROPE4(v);
          float* ko = row < NP ? p->out + O_KP + ((size_t)j * NP + row) * 256 : p->out + O_KS + ((size_t)j * NS + (row - NP)) * 256; *(f32x4*)(ko + 4 * lane) = v; *(unsigned*)(WSP(unsigned char, WS_K8) + (size_t)row * 256 + 4 * lane) = pk_fp8x4(v); }
        { const f32x4 v = ld_bf4(pr + 1280 + 4 * lane);
          float* vo = row < NP ? p->out + O_VP + ((size_t)j * NP + row) * 256 : p->out + O_VS + ((size_t)j * NS + (row - NP)) * 256; *(f32x4*)(vo + 4 * lane) = v; *(unsigned*)(WSP(unsigned char, WS_V8) + (size_t)row * 256 + 4 * lane) = pk_fp8x4(v); }
#pragma unroll
        for (int i = 0; i < 2; ++i) { f32x4 v = ld_bf4(pr + 1536 + 256 * i + 4 * lane); ROPE4(v); st_bf4(WSP(bf16_t, WS_QIB) + (size_t)row * 512 + 256 * i + 4 * lane, v); }
        { f32x4 v = ld_bf4(pr + 2048 + 4 * l16); HNORM4(v, in); ROPE4(v);
          float* io = row < NP ? p->out + O_IKP + ((size_t)j * NP + row) * 64 : p->out + O_IKS + ((size_t)j * NS + (row - NP)) * 64; if (lane < 16) { *(f32x4*)(io + 4 * lane) = v; st_bf4(WSP(bf16_t, WS_KIB) + (size_t)row * 64 + 4 * lane, v); } }
        if (lane < 2) { const f32x4 v = ld_bf4(pr + 2112 + 4 * lane); *(f32x4*)(WI + (size_t)row * 8 + 4 * lane) = v * 0.35355339059327373f; }
#undef ROPE4
#undef HNORM4
    }
}

template <bool SAMPLE>
__device__ __forceinline__ void phase_idx(KP p, int j, LAS unsigned char* lds) {
    LAS float* Qs = (LAS float*)lds;
    LAS float* Ks = (LAS float*)(lds + 32768);
    const float *QI = WSP(float, WS_QI), *WI = WSP(float, WS_WI);
    const int tid = TID(), q = tid >> 5, kx = tid & 31;
    const int nitems = SAMPLE ? 32 * 65 : 1024;
    for (int it = BID(); it < nitems; it += gridDim.x) {
        int b, t0, rowbase, nkt, kt0 = 0;
        if (SAMPLE) { b = it / 65; kt0 = it % 65; t0 = 0; rowbase = NP + b * 8; nkt = kt0 + 1; }
        else { const int k4 = it >> 8, w = it & 255, i = (k4 & 1) ? (k4 * 256 + 255 - w) : (k4 * 256 + w); b = i & 3; t0 = (i >> 2) * 16; rowbase = b * 4096 + t0; nkt = (t0 + 15) / 128 + 1; }
        const int nq = SAMPLE ? 8 : 16;
        __syncthreads();
#pragma unroll
        for (int n = 0; n < 16; ++n) { const int e = tid + 512 * n, qq = e >> 9, c = e & 511, h = c >> 6, d = c & 63;
            Qs[(d * 16 + qq) * 8 + h] = qq < nq ? QI[(size_t)(rowbase + qq) * 512 + c] : 0.f; }
        float wi[8];
#pragma unroll
        for (int h = 0; h < 8; ++h) wi[h] = q < nq ? WI[(size_t)(rowbase + q) * 8 + h] : 0.f;
        for (int kt = kt0; kt < nkt; ++kt) {
            __syncthreads();
#pragma unroll
            for (int n = 0; n < 16; ++n) { const int e = tid + 512 * n, key = e >> 6, d = e & 63, s = kt * 128 + key; float v = 0.f;
                if (SAMPLE) {
                    if (s < PAST) { const int pg = p->page_table[b * 64 + (s >> 7)]; v = p->cache_ik[(((size_t)j * 2560 + pg) * 128 + (s & 127)) * 64 + d]; }
                    else if (s < PAST + 8) v = p->out[O_IKS + ((size_t)j * NS + b * 8 + (s - PAST)) * 64 + d];
                } else v = p->out[O_IKP + ((size_t)j * NP + b * 4096 + s) * 64 + d];
                Ks[d * 132 + key] = v; }
            __syncthreads();
            f32x4 acc[8];
#pragma unroll
            for (int h = 0; h < 8; ++h) acc[h] = (f32x4){0.f, 0.f, 0.f, 0.f};
#pragma unroll 4
            for (int d = 0; d < 64; ++d) {
                const f32x4 qa = *(const LAS f32x4*)(Qs + (d * 16 + q) * 8), qb = *(const LAS f32x4*)(Qs + (d * 16 + q) * 8 + 4), kv = *(const LAS f32x4*)(Ks + d * 132 + 4 * kx);
                acc[0] += qa[0] * kv; acc[1] += qa[1] * kv; acc[2] += qa[2] * kv; acc[3] += qa[3] * kv;
                acc[4] += qb[0] * kv; acc[5] += qb[1] * kv; acc[6] += qb[2] * kv; acc[7] += qb[3] * kv;
            }
            f32x4 sc = {0.f, 0.f, 0.f, 0.f};
#pragma unroll
            for (int h = 0; h < 8; ++h)
#pragma unroll
                for (int e = 0; e < 4; ++e) sc[e] += fmaxf(acc[h][e] * 0.125f, 0.f) * wi[h];
            if (q < nq) {
                if (SAMPLE) *(f32x4*)(WSP(float, WS_SCS) + (size_t)(b * 8 + q) * SCS_LD + kt * 128 + 4 * kx) = sc;
                else *(f32x4*)(WSP(float, WS_SC) + ((size_t)b * 4096 + t0 + q) * 4096 + kt * 128 + 4 * kx) = sc;
            }
        }
    }
    __syncthreads();
}

template <bool SAMPLE>
__device__ __forceinline__ void phase_idx2(KP p, int j) {
    const bf16_t *QIB = WSP(bf16_t, WS_QIB), *KIB = WSP(bf16_t, WS_KIB); const float* WI = WSP(float, WS_WI);
    const int lane = TID() & 63, lr = lane & 31, lh = lane >> 5, gw = BID() * 8 + (TID() >> 6), nw = gridDim.x * 8;
    const int nitems = SAMPLE ? 32 * 65 : 4096;
    for (int it = gw; it < nitems; it += nw) {
        int b, rowbase, tile0, ntile;
        if (SAMPLE) { b = it / 65; rowbase = NP + b * 8; tile0 = (it % 65) * 4; ntile = min(4, 257 - tile0); }
        else { const int sub = it >= 2048, w_ = it & 2047; b = w_ & 3; const int wb = w_ >> 2, kk = sub ? 511 - wb : wb, nt = (kk * 8 + 7) / 32 + 1;
            rowbase = b * 4096 + kk * 8; tile0 = sub ? (nt >> 1) : 0; ntile = sub ? nt - (nt >> 1) : (nt >> 1); }
        if (ntile <= 0) continue;
        bf16x8 af[2][4]; float w[2][2][8];
        { const int hd = (lr & 3) + 4 * ((lr >> 3) & 1), jq = 2 * ((lr >> 2) & 1) + (lr >> 4);
#pragma unroll
          for (int st = 0; st < 2; ++st)
#pragma unroll
              for (int ks = 0; ks < 4; ++ks) af[st][ks] = *(const bf16x8*)(QIB + (size_t)(rowbase + 4 * st + jq) * 512 + hd * 64 + 16 * ks + 8 * lh);
#pragma unroll
          for (int st = 0; st < 2; ++st)
#pragma unroll
              for (int q = 0; q < 2; ++q) { const f32x4 w0 = *(const f32x4*)(WI + (size_t)(rowbase + 4 * st + 2 * lh + q) * 8), w1 = *(const f32x4*)(WI + (size_t)(rowbase + 4 * st + 2 * lh + q) * 8 + 4);
#pragma unroll
                  for (int e = 0; e < 4; ++e) { w[st][q][e] = w0[e] * 0.125f; w[st][q][4 + e] = w1[e] * 0.125f; } } }
#define IDX_LOADB(BF, tl_) do { const int s_ = (tile0 + (tl_)) * 32 + lr; \
            if (!SAMPLE) { _Pragma("unroll") for (int ks = 0; ks < 4; ++ks) BF[ks] = *(const bf16x8*)(KIB + ((size_t)b * 4096 + s_) * 64 + 16 * ks + 8 * lh); } \
            else { const float* kp = p->out + O_IKS + ((size_t)j * NS + b * 8) * 64; \
                if (s_ < PAST) kp = p->cache_ik + (((size_t)j * 2560 + p->page_table[b * 64 + (s_ >> 7)]) * 128 + (s_ & 127)) * 64; else kp += (size_t)min(s_ - PAST, 7) * 64; \
                _Pragma("unroll") for (int ks = 0; ks < 4; ++ks) { const f32x4 x0 = *(const f32x4*)(kp + 16 * ks + 8 * lh), x1 = *(const f32x4*)(kp + 16 * ks + 8 * lh + 4); \
                    const u32x4 wv = {pk_bf16(x0[0], x0[1]), pk_bf16(x0[2], x0[3]), pk_bf16(x1[0], x1[1]), pk_bf16(x1[2], x1[3])}; BF[ks] = __builtin_bit_cast(bf16x8, wv); } } } while (0)
        bf16x8 bnx[4];
        IDX_LOADB(bnx, 0);
        for (int tl = 0; tl < ntile; ++tl) {
            const int s = (tile0 + tl) * 32 + lr;
            bf16x8 bfr[4];
#pragma unroll
            for (int ks = 0; ks < 4; ++ks) bfr[ks] = bnx[ks];
            if (tl + 1 < ntile) IDX_LOADB(bnx, tl + 1);
            __builtin_amdgcn_sched_barrier(0);
#pragma unroll
            for (int st = 0; st < 2; ++st) {
                f32x16 acc;
#pragma unroll
                for (int r = 0; r < 16; ++r) acc[r] = 0.f;
#pragma unroll
                for (int ks = 0; ks < 4; ++ks) acc = __builtin_amdgcn_mfma_f32_32x32x16_bf16(af[st][ks], bfr[ks], acc, 0, 0, 0);
#pragma unroll
                for (int q = 0; q < 2; ++q) {
                    float sc = 0.f;
#pragma unroll
                    for (int hh = 0; hh < 2; ++hh)
#pragma unroll
                        for (int hl = 0; hl < 4; ++hl) sc += fmaxf(acc[4 * (2 * q + hh) + hl], 0.f) * w[st][q][hl + 4 * hh];
                    if (SAMPLE) WSP(float, WS_SCS)[(size_t)(b * 8 + 4 * st + 2 * lh + q) * SCS_LD + s] = sc;
                    else WSP(float, WS_SC)[((size_t)rowbase + 4 * st + 2 * lh + q) * 4096 + s] = sc;
                }
            }
        }
    }
#undef IDX_LOADB
}

__device__ __forceinline__ unsigned fkey(float f) { f = (f == 0.f) ? 0.f : f; const unsigned u = __float_as_uint(f); return (u & 0x80000000u) ? ~u : (u | 0x80000000u); }
__device__ __forceinline__ void phase_topk_prompt(KP p) {
    const float* SC = WSP(float, WS_SC); int* SEL = WSP(int, WS_SEL); int* CNT = WSP(int, WS_CNT);
    const int lane = TID() & 63, gw = BID() * 8 + (TID() >> 6), nw = gridDim.x * 8;
    for (int qi = gw; qi < NP; qi += nw) {
        const int b = qi & 3, tt = qi >> 2, t = (tt & 1) ? 4095 - (tt >> 1) : (tt >> 1), row = b * 4096 + t, n = t + 1;
        int* sel = SEL + (size_t)row * 256;
        if (n <= TOPK) { for (int s = lane; s < n; s += 64) sel[s] = s; if (lane == 0) CNT[row] = n; continue; }
        const float* base = SC + (size_t)row * 4096;
        const int nb = __builtin_amdgcn_readfirstlane((n + 1023) >> 10);
        unsigned u[64];
#pragma unroll
        for (int kb = 0; kb < 4; ++kb) {
            if (kb < nb) {
#pragma unroll
                for (int m = 16 * kb; m < 16 * kb + 16; ++m) u[m] = __float_as_uint(base[lane + 64 * m]);
            } else {
#pragma unroll
                for (int m = 16 * kb; m < 16 * kb + 16; ++m) u[m] = 0u;
            }
        }
#pragma unroll
        for (int m = 0; m < 64; ++m) { const unsigned k_ = fkey(__uint_as_float(u[m])); u[m] = (lane + 64 * m < n) ? k_ : 0u; }
        unsigned tau = 0u;
#pragma unroll 1
        for (int bit = 31; bit >= 0; --bit) {
            const unsigned cand = tau | (1u << bit); int c = 0;
#pragma unroll
            for (int m = 0; m < 16; ++m) c += (u[m] >= cand) ? 1 : 0;
            if (nb > 1) {
#pragma unroll
                for (int m = 16; m < 32; ++m) c += (u[m] >= cand) ? 1 : 0;
                if (nb > 2) {
#pragma unroll
                    for (int m = 32; m < 48; ++m) c += (u[m] >= cand) ? 1 : 0;
                    if (nb > 3) {
#pragma unroll
                        for (int m = 48; m < 64; ++m) c += (u[m] >= cand) ? 1 : 0;
                    }
                }
            }
            c = wave_sum_i(c);
            if (c >= TOPK) tau = cand;
            if (c == TOPK) break;
        }
        int cg = 0, ct = 0; unsigned tlo = 0u, thi = 0u;
#pragma unroll
        for (int m = 31; m >= 0; --m) { cg += (u[m] > tau) ? 1 : 0; const unsigned tie = (u[m] == tau) ? 1u : 0u; ct += (int)tie; tlo = (tlo << 1) | tie; }
#pragma unroll
        for (int m = 63; m >= 32; --m) { cg += (u[m] > tau) ? 1 : 0; const unsigned tie = (u[m] == tau) ? 1u : 0u; ct += (int)tie; thi = (thi << 1) | tie; }
        unsigned long long tmask = ((unsigned long long)thi << 32) | tlo;
        const int totg = wave_sum_i(cg), tott = wave_sum_i(ct);
        const int need = TOPK - totg;
        unsigned long long smask = 0ull;
        if (tott == need) smask = tmask;
        else {
#pragma unroll 1
            for (int it = 0; it < need; ++it) {
                const int m0 = tmask ? (int)__builtin_ctzll(tmask) : 64;
                const int cand = tmask ? (lane + 64 * m0) : 0x7fffffff, best = wave_min_i(cand);
                if (cand == best && tmask) { smask |= (1ull << m0); tmask &= ~(1ull << m0); }
            }
        }
        const int mine = cg + __popcll(smask);
        int incl = mine;
#pragma unroll
        for (int d = 1; d < 64; d <<= 1) { const int o = __shfl_up(incl, d); if (lane >= d) incl += o; }
        int off = incl - mine;
#pragma unroll
        for (int m = 0; m < 64; ++m) { if ((u[m] > tau) || ((smask >> m) & 1ull)) { sel[off] = lane + 64 * m; ++off; } }
        if (lane == 0) CNT[row] = TOPK;
    }
}
__device__ __forceinline__ void phase_topk_sample(KP p, LAS unsigned char* lds) {
    LAS unsigned* ckey = (LAS unsigned*)lds;
    LAS int* cidx = (LAS int*)(lds + 8192);
    const float* SCS = WSP(float, WS_SCS); int* SEL = WSP(int, WS_SEL); int* CNT = WSP(int, WS_CNT);
    for (int qq = BID(); qq < NS; qq += gridDim.x) {
        const int tid = TID(), lane = tid & 63, wave = tid >> 6;
        const int n = PAST + 1 + (qq & 7), row = NP + qq, s0 = 1088 * wave;
        const float* base = SCS + (size_t)qq * SCS_LD;
        unsigned u[17];
#pragma unroll
        for (int m = 0; m < 17; ++m) { const int s = s0 + lane + 64 * m; u[m] = __float_as_uint(base[s < SCS_LD ? s : 0]); }
#pragma unroll
        for (int m = 0; m < 17; ++m) { const unsigned k_ = fkey(__uint_as_float(u[m])); u[m] = (s0 + lane + 64 * m < n) ? k_ : 0u; }
        __syncthreads();
        {
            int nvalid = 0;
#pragma unroll
            for (int m = 0; m < 17; ++m) nvalid += (u[m] != 0u) ? 1 : 0;
            nvalid = wave_sum_i(nvalid);
            unsigned tau = 0u; int need = 0; unsigned tmask = 0u, smask = 0u;
            if (nvalid > TOPK) {
#pragma unroll 1
                for (int bit = 31; bit >= 0; --bit) {
                    const unsigned cand = tau | (1u << bit); int c = 0;
#pragma unroll
                    for (int m = 0; m < 17; ++m) c += (u[m] >= cand) ? 1 : 0;
                    c = wave_sum_i(c);
                    if (c >= TOPK) tau = cand;
                    if (c == TOPK) break;
                }
                int cg = 0, ct = 0;
#pragma unroll
                for (int m = 0; m < 17; ++m) { cg += (u[m] > tau) ? 1 : 0; const bool tie = (u[m] == tau); ct += tie ? 1 : 0; tmask |= tie ? (1u << m) : 0u; }
                cg = wave_sum_i(cg); ct = wave_sum_i(ct);
                need = TOPK - cg;
                if (ct == need) smask = tmask;
                else {
#pragma unroll 1
                    for (int it = 0; it < need; ++it) {
                        const int m0 = tmask ? (int)__builtin_ctz(tmask) : 32;
                        const int cand = tmask ? (lane + 64 * m0) : 0x7fffffff, best = wave_min_i(cand);
                        if (cand == best && tmask) { smask |= (1u << m0); tmask &= ~(1u << m0); }
                    }
                }
            } else { tau = 0u; smask = 0u; }
            int mine = 0;
#pragma unroll
            for (int m = 0; m < 17; ++m) mine += ((u[m] > tau) || ((smask >> m) & 1u)) ? 1 : 0;
            int incl = mine;
#pragma unroll
            for (int d = 1; d < 64; d <<= 1) { const int o = __shfl_up(incl, d); if (lane >= d) incl += o; }
            int off = incl - mine;
            const int total = __builtin_amdgcn_readlane(incl, 63);
#pragma unroll
            for (int m = 0; m < 17; ++m) { if ((u[m] > tau) || ((smask >> m) & 1u)) { ckey[wave * 256 + off] = u[m]; cidx[wave * 256 + off] = s0 + lane + 64 * m; ++off; } }
            for (int e = total + lane; e < 256; e += 64) { ckey[wave * 256 + e] = 0u; cidx[wave * 256 + e] = 0x7fffffff; }
        }
        __syncthreads();
        if (wave == 0) {
            unsigned v[32]; int ix[32];
#pragma unroll
            for (int m = 0; m < 32; ++m) { v[m] = ckey[lane + 64 * m]; ix[m] = cidx[lane + 64 * m]; }
            unsigned tau = 0u;
#pragma unroll 1
            for (int bit = 31; bit >= 0; --bit) {
                const unsigned cand = tau | (1u << bit); int c = 0;
#pragma unroll
                for (int m = 0; m < 32; ++m) c += (v[m] >= cand) ? 1 : 0;
                c = wave_sum_i(c);
                if (c >= TOPK) tau = cand;
                if (c == TOPK) break;
            }
            int cg = 0, ct = 0; unsigned tmask = 0u, smask = 0u;
#pragma unroll
            for (int m = 31; m >= 0; --m) { cg += (v[m] > tau) ? 1 : 0; const unsigned tie = (v[m] == tau) ? 1u : 0u; ct += (int)tie; tmask = (tmask << 1) | tie; }
            cg = wave_sum_i(cg); ct = wave_sum_i(ct);
            const int need = TOPK - cg;
            if (ct == need) smask = tmask;
            else {
#pragma unroll 1
                for (int it = 0; it < need; ++it) {
                    int bi = 0x7fffffff, bm = 0;
#pragma unroll
                    for (int m = 0; m < 32; ++m) { const bool t_ = (tmask >> m) & 1u; if (t_ && ix[m] < bi) { bi = ix[m]; bm = m; } }
                    const int best = wave_min_i(bi);
                    if (bi == best && bi != 0x7fffffff) { smask |= (1u << bm); tmask &= ~(1u << bm); }
                }
            }
            int mine = 0;
#pragma unroll
            for (int m = 0; m < 32; ++m) mine += ((v[m] > tau) || ((smask >> m) & 1u)) ? 1 : 0;
            int incl = mine;
#pragma unroll
            for (int d = 1; d < 64; d <<= 1) { const int o = __shfl_up(incl, d); if (lane >= d) incl += o; }
            int off = incl - mine;
            int* sel = SEL + (size_t)row * 256;
#pragma unroll
            for (int m = 0; m < 32; ++m) { if ((v[m] > tau) || ((smask >> m) & 1u)) { if (off < TOPK) sel[off] = ix[m]; ++off; } }
            if (lane == 0) CNT[row] = TOPK;
        }
    }
    __syncthreads();
}

template <bool SAMPLE>
__device__ __forceinline__ void phase_attn(KP p, int j, LAS unsigned char* lds) {
    const int tid = TID(), lane = tid & 63, wave = tid >> 6, n16 = lane & 15, c4 = lane >> 4;
    LAS bf16_t* ps = (LAS bf16_t*)(lds + wave * 16384);
    LAS int* is = (LAS int*)(lds + wave * 16384 + 8192);
    LAS bf16_t* qs = (LAS bf16_t*)(lds + wave * 16384 + 9216);
    LAS float* invs = (LAS float*)(lds + wave * 16384 + 11264);
    const float* Q = WSP(float, WS_Q); const int* SEL = WSP(int, WS_SEL); const int* CNT = WSP(int, WS_CNT); bf16_t* O = WSP(bf16_t, WS_YG);
    const bf16_t *KBF = WSP(bf16_t, WS_KBF), *VBF = WSP(bf16_t, WS_VBF);
    const float* kc = p->cache_k + (size_t)j * 2560 * 128 * 256; const float* vc = p->cache_v + (size_t)j * 2560 * 128 * 256;
    const float* knew = p->out + O_KS + (size_t)j * NS * 256; const float* vnew = p->out + O_VS + (size_t)j * NS * 256;
    const int gw = BID() * 8 + wave, nw = gridDim.x * 8, nq = SAMPLE ? NS : NP;
    unsigned* qctr = WSP(unsigned, WS_BAR + 40960) + (size_t)j * 256;
    int qb = 0, qnext = 0, qsub = 2, qcur = 0;
    if (!SAMPLE) { unsigned v_ = 0u; if (lane == 0) v_ = __hip_atomic_fetch_add(qctr + 16 * ((BID() + qb) & 3), 2u, __ATOMIC_RELAXED, __HIP_MEMORY_SCOPE_AGENT); qnext = (int)__builtin_amdgcn_readfirstlane(v_); }
    for (int qi = gw; SAMPLE ? (qi < nq) : true; qi += nw) {
        int row;
        if (SAMPLE) row = NP + qi;
        else {
            if (qsub == 2) {
                for (;;) {
                    qcur = qnext; qsub = 0;
                    if (qcur < 4096 || qb == 3) break;
                    ++qb; unsigned v_ = 0u; if (lane == 0) v_ = __hip_atomic_fetch_add(qctr + 16 * ((BID() + qb) & 3), 2u, __ATOMIC_RELAXED, __HIP_MEMORY_SCOPE_AGENT); qnext = (int)__builtin_amdgcn_readfirstlane(v_);
                }
                if (qcur >= 4096) break;
                { unsigned v_ = 0u; if (lane == 0) v_ = __hip_atomic_fetch_add(qctr + 16 * ((BID() + qb) & 3), 2u, __ATOMIC_RELAXED, __HIP_MEMORY_SCOPE_AGENT); qnext = (int)__builtin_amdgcn_readfirstlane(v_); }
            }
            row = ((BID() + qb) & 3) * 4096 + (4095 - (qcur + qsub)); ++qsub;
        }
        const int n = CNT[row];
        wave_lds_fence();
#pragma unroll
        for (int c = 0; c < 4; ++c) { const int slot = lane + 64 * c;
            int s = SEL[(size_t)row * 256 + slot]; const bool ok = slot < n;
            int r;
            if (SAMPLE) { const int bb = (row - NP) >> 3; s = ok ? s : 0; const int sp = min(max(s, 0), PAST - 1); const int pg = p->page_table[bb * 64 + (sp >> 7)];
                r = (s < PAST) ? pg * 128 + (s & 127) : (0x40000000 | (bb * 8 + min(s - PAST, 7))); }
            else r = (row & ~4095) + (ok ? s : 0);
            is[slot] = r; }
#pragma unroll
        for (int i = 0; i < 4; ++i) { const f32x4 q4 = ld_bf4((const bf16_t*)Q + (size_t)row * D + 256 * i + 4 * lane);
            if (SAMPLE) { const f32x4 q8 = q4 * 0.125f; u32x2 w; w.x = pk_bf16(q8[0], q8[1]); w.y = pk_bf16(q8[2], q8[3]); *(LAS u32x2*)(qs + 256 * i + 4 * lane) = w; }
            else *(LAS unsigned*)((LAS unsigned char*)qs + 256 * i + 4 * lane) = pk_fp8x4(q4); }
        wave_lds_fence();
        {
            float mx = -__builtin_huge_valf();
#define ATT_EMIT(t_, acc_) do { f32x4 l_ = (acc_); _Pragma("unroll") for (int r = 0; r < 4; ++r) { if (16 * (t_) + 4 * c4 + r >= n) l_[r] = -__builtin_huge_valf(); mx = fmaxf(mx, l_[r]); } \
                u32x2 w_; w_.x = pk_bf16(l_[0], l_[1]); w_.y = pk_bf16(l_[2], l_[3]); *(LAS u32x2*)(ps + n16 * 256 + 16 * (t_) + 4 * c4) = w_; } while (0)
            if (SAMPLE) {
                const u32x4 qf0 = *(const LAS u32x4*)(qs + n16 * 64 + 8 * c4), qf1 = *(const LAS u32x4*)(qs + n16 * 64 + 32 + 8 * c4);
                u32x4 bq[8];
#pragma unroll
                for (int ks = 0; ks < 8; ++ks) { const bool on = (n16 >> 2) == (ks >> 1); const u32x4 qv = (ks & 1) ? qf1 : qf0; bq[ks] = (u32x4){on ? qv.x : 0u, on ? qv.y : 0u, on ? qv.z : 0u, on ? qv.w : 0u}; }
#pragma unroll 2
                for (int t = 0; t < 16; ++t) {
                    const int r = is[16 * t + n16];
                    const float* kp = ((r & 0x40000000) ? knew + (size_t)(r & 0xffff) * 256 : kc + (size_t)r * 256) + 8 * c4;
                    f32x4 acc = {0.f, 0.f, 0.f, 0.f};
#pragma unroll
                    for (int ks = 0; ks < 8; ++ks) { const f32x4 x0 = *(const f32x4*)(kp + 32 * ks), x1 = *(const f32x4*)(kp + 32 * ks + 4);
                        const u32x4 ka = {pk_bf16(x0[0], x0[1]), pk_bf16(x0[2], x0[3]), pk_bf16(x1[0], x1[1]), pk_bf16(x1[2], x1[3])};
                        acc = __builtin_amdgcn_mfma_f32_16x16x32_bf16(__builtin_bit_cast(bf16x8, ka), __builtin_bit_cast(bf16x8, bq[ks]), acc, 0, 0, 0); }
                    ATT_EMIT(t, acc);
                }
            } else {
                const LAS unsigned char* q8 = (const LAS unsigned char*)qs;
                long bq[8];
                { const bool on = (n16 >> 2) == c4;
#pragma unroll
                  for (int h2 = 0; h2 < 4; ++h2) { const u32x4 qv = *(const LAS u32x4*)(q8 + n16 * 64 + 16 * h2);
                      const u32x2 z0 = {on ? qv.x : 0u, on ? qv.y : 0u}, z1 = {on ? qv.z : 0u, on ? qv.w : 0u}; bq[2 * h2] = __builtin_bit_cast(long, z0); bq[2 * h2 + 1] = __builtin_bit_cast(long, z1); } }
                const unsigned char* K8 = WSP(unsigned char, WS_K8);
#pragma unroll
                for (int th = 0; th < 2; ++th) {
                    if (th) asm volatile("" ::: "memory");
                    u32x4 ka[8][4];
#pragma unroll
                    for (int t8 = 0; t8 < 8; ++t8) {
                        const int r = is[16 * (8 * th + t8) + n16];
                        const unsigned char* kp = K8 + (size_t)r * 256 + 64 * c4;
#pragma unroll
                        for (int h2 = 0; h2 < 4; ++h2) ka[t8][h2] = *(const u32x4*)(kp + 16 * h2);
                    }
                    __builtin_amdgcn_sched_barrier(0);
#pragma unroll
                    for (int t8 = 0; t8 < 8; ++t8) {
                        f32x4 acc = {0.f, 0.f, 0.f, 0.f};
#pragma unroll
                        for (int h2 = 0; h2 < 4; ++h2) { const u32x2 lo = {ka[t8][h2].x, ka[t8][h2].y}, hi = {ka[t8][h2].z, ka[t8][h2].w};
                            acc = __builtin_amdgcn_mfma_f32_16x16x32_fp8_fp8(__builtin_bit_cast(long, lo), bq[2 * h2], acc, 0, 0, 0);
                            acc = __builtin_amdgcn_mfma_f32_16x16x32_fp8_fp8(__builtin_bit_cast(long, hi), bq[2 * h2 + 1], acc, 0, 0, 0); }
                        ATT_EMIT(8 * th + t8, acc * 0.125f);
                    }
                }
            }
#undef ATT_EMIT
            mx = fmaxf(mx, __shfl_xor(mx, 16)); mx = fmaxf(mx, __shfl_xor(mx, 32));
            float sm = 0.f;
            u32x2 lw_[16];
#pragma unroll
            for (int t = 0; t < 16; ++t) lw_[t] = *(const LAS u32x2*)(ps + n16 * 256 + 16 * t + 4 * c4);
#pragma unroll
            for (int t = 0; t < 16; ++t) {
                const u32x2 w = lw_[t];
                const float e0 = __expf(bflo(w.x) - mx), e1 = __expf(bfhi(w.x) - mx), e2 = __expf(bflo(w.y) - mx), e3 = __expf(bfhi(w.y) - mx);
                sm += (e0 + e1) + (e2 + e3);
                u32x2 o_; o_.x = pk_bf16(e0, e1); o_.y = pk_bf16(e2, e3); *(LAS u32x2*)(ps + n16 * 256 + 16 * t + 4 * c4) = o_;
            }
            sm += __shfl_xor(sm, 16); sm += __shfl_xor(sm, 32);
            if (c4 == 0) invs[n16] = 1.0f / sm;
        }
        wave_lds_fence();
        if (!SAMPLE) {
            const unsigned char* V8 = WSP(unsigned char, WS_V8);
            const int rs = c4, kvh = n16 >> 2, nst = n > 64 ? 64 : n;
            f32x4 oa[4][4];
#pragma unroll
            for (int g = 0; g < 4; ++g)
#pragma unroll
                for (int q = 0; q < 4; ++q) oa[g][q] = (f32x4){0.f, 0.f, 0.f, 0.f};
            u32x4 vr[8], vn[8];
#pragma unroll
            for (int i = 0; i < 8; ++i) vn[i] = *(const u32x4*)(V8 + (size_t)is[64 * rs + i] * 256 + 16 * n16);
            for (int m0 = 0; m0 < nst; m0 += 8) {
#pragma unroll
                for (int i = 0; i < 8; ++i) vr[i] = vn[i];
                if (m0 + 8 < nst) {
#pragma unroll
                    for (int i = 0; i < 8; ++i) vn[i] = *(const u32x4*)(V8 + (size_t)is[64 * rs + m0 + 8 + i] * 256 + 16 * n16);
                }
                __builtin_amdgcn_sched_barrier(0);
#pragma unroll
                for (int h4 = 0; h4 < 2; ++h4) {
                    u32x2 pg[4];
#pragma unroll
                    for (int g = 0; g < 4; ++g) pg[g] = *(const LAS u32x2*)(ps + (kvh * 4 + g) * 256 + 64 * rs + m0 + 4 * h4);
#pragma unroll
                    for (int i = 0; i < 4; ++i) {
                        const u32x4 v_ = vr[4 * h4 + i];
                        const f32x4 v0 = fp8x4_f32(v_.x), v1 = fp8x4_f32(v_.y), v2 = fp8x4_f32(v_.z), v3 = fp8x4_f32(v_.w);
#pragma unroll
                        for (int g = 0; g < 4; ++g) { const unsigned pw = (i < 2) ? pg[g].x : pg[g].y; const float pf = (i & 1) ? bfhi(pw) : bflo(pw);
                            oa[g][0] += pf * v0; oa[g][1] += pf * v1; oa[g][2] += pf * v2; oa[g][3] += pf * v3; }
                    }
                }
            }
#pragma unroll
            for (int g = 0; g < 4; ++g)
#pragma unroll
                for (int q = 0; q < 4; ++q)
#pragma unroll
                    for (int e_ = 0; e_ < 4; ++e_) { float x = oa[g][q][e_]; x += __shfl_xor(x, 16); x += __shfl_xor(x, 32); oa[g][q][e_] = x; }
            if (rs == 0) {
                const f32x4 iv = *(const LAS f32x4*)(invs + 4 * kvh);
#pragma unroll
                for (int g = 0; g < 4; ++g) { bf16_t* op = O + (size_t)row * D + (kvh * 4 + g) * 64 + 16 * (n16 & 3);
                    u32x4 w0, w1; const float sc_ = iv[g];
                    w0.x = pk_bf16(oa[g][0][0] * sc_, oa[g][0][1] * sc_); w0.y = pk_bf16(oa[g][0][2] * sc_, oa[g][0][3] * sc_); w0.z = pk_bf16(oa[g][1][0] * sc_, oa[g][1][1] * sc_); w0.w = pk_bf16(oa[g][1][2] * sc_, oa[g][1][3] * sc_);
                    w1.x = pk_bf16(oa[g][2][0] * sc_, oa[g][2][1] * sc_); w1.y = pk_bf16(oa[g][2][2] * sc_, oa[g][2][3] * sc_); w1.z = pk_bf16(oa[g][3][0] * sc_, oa[g][3][1] * sc_); w1.w = pk_bf16(oa[g][3][2] * sc_, oa[g][3][3] * sc_);
                    *(u32x4*)op = w0; *(u32x4*)(op + 8) = w1; }
            }
        } else {
        f32x4 o0 = {0.f, 0.f, 0.f, 0.f}, o1 = o0, o2 = o0, o3 = o0;
        constexpr int GV = SAMPLE ? 16 : 32;
        const int ng = (n + GV - 1) / GV;
        unsigned vb[SAMPLE ? 1 : GV], vbn[SAMPLE ? 1 : GV]; f32x4 vf[SAMPLE ? GV : 1];
        const unsigned char* V8 = WSP(unsigned char, WS_V8);
        if (!SAMPLE) {
#pragma unroll
            for (int i = 0; i < GV; ++i) vbn[i] = *(const unsigned*)(V8 + (size_t)is[i] * 256 + 4 * lane);
        }
#pragma unroll 1
        for (int g = 0; g < ng; ++g) {
            if (!SAMPLE) {
#pragma unroll
                for (int i = 0; i < GV; ++i) vb[i] = vbn[i];
                if (g + 1 < ng) {
#pragma unroll
                    for (int i = 0; i < GV; ++i) vbn[i] = *(const unsigned*)(V8 + (size_t)is[GV * (g + 1) + i] * 256 + 4 * lane);
                }
                __builtin_amdgcn_sched_barrier(0);
            } else {
#pragma unroll
                for (int i = 0; i < GV; ++i) { const int r = is[GV * g + i]; vf[i] = *(const f32x4*)(((r & 0x40000000) ? vnew + (size_t)(r & 0xffff) * 256 : vc + (size_t)r * 256) + 4 * lane); }
            }
#pragma unroll
            for (int i4 = 0; i4 < GV / 4; ++i4) {
                const u32x2 p0 = *(const LAS u32x2*)(ps + (c4 * 4 + 0) * 256 + GV * g + 4 * i4), p1 = *(const LAS u32x2*)(ps + (c4 * 4 + 1) * 256 + GV * g + 4 * i4),
                            p2 = *(const LAS u32x2*)(ps + (c4 * 4 + 2) * 256 + GV * g + 4 * i4), p3 = *(const LAS u32x2*)(ps + (c4 * 4 + 3) * 256 + GV * g + 4 * i4);
                f32x4 v0, v1, v2, v3;
                if (!SAMPLE) { v0 = fp8x4_f32(vb[4 * i4]); v1 = fp8x4_f32(vb[4 * i4 + 1]); v2 = fp8x4_f32(vb[4 * i4 + 2]); v3 = fp8x4_f32(vb[4 * i4 + 3]); }
                else { v0 = vf[4 * i4]; v1 = vf[4 * i4 + 1]; v2 = vf[4 * i4 + 2]; v3 = vf[4 * i4 + 3]; }
                o0 += bflo(p0.x) * v0 + bfhi(p0.x) * v1 + bflo(p0.y) * v2 + bfhi(p0.y) * v3;
                o1 += bflo(p1.x) * v0 + bfhi(p1.x) * v1 + bflo(p1.y) * v2 + bfhi(p1.y) * v3;
                o2 += bflo(p2.x) * v0 + bfhi(p2.x) * v1 + bflo(p2.y) * v2 + bfhi(p2.y) * v3;
                o3 += bflo(p3.x) * v0 + bfhi(p3.x) * v1 + bflo(p3.y) * v2 + bfhi(p3.y) * v3;
            }
        }
        { const f32x4 iv = *(const LAS f32x4*)(invs + 4 * c4); bf16_t* op = O + (size_t)row * D + c4 * 256 + 4 * n16; st_bf4(op, o0 * iv[0]); st_bf4(op + 64, o1 * iv[1]); st_bf4(op + 128, o2 * iv[2]); st_bf4(op + 192, o3 * iv[3]); }
        }
    }
}

__global__ void __launch_bounds__(512, 2) mega(P p_unused) {
    extern __shared__ __attribute__((aligned(16))) unsigned char lds_raw[];
    LAS unsigned char* lds = (LAS unsigned char*)lds_raw;
    volatile LAS unsigned* misc = (volatile LAS unsigned*)(lds + LDS_MISC);
    if (TID() < 4) misc[TID()] = 0u;
    __syncthreads();
    KP p = kargs();
    const bool multi = (p->ph_hi - p->ph_lo) > 1;
    XcdBarrier bar; bar.bar = WSP(unsigned, WS_BAR); bar.x = 0; bar.st = misc;
    if (multi) bar = xcd_barrier_post(WSP(unsigned, WS_BAR), misc);
    int ph = 0;
    const int lo = p->ph_lo, hi = p->ph_hi;
#ifndef REPMASK
#define REPMASK 0ull
#endif
#define PH_BEGIN if (ph >= lo && ph < hi) { KP p = kargs(); const int nrep_ = ((REPMASK >> ph) & 1ull) ? 3 : 1; for (int rep_ = 0; rep_ < nrep_; ++rep_) {
#define PH_END   if (ph + 1 < hi || rep_ + 1 < nrep_) xcd_barrier(bar); } } ++ph;

    PH_BEGIN phase_ada(p, lds); phase_weights(p, lds); phase_rope_table(p); PH_END

    for (int layer = 0; layer < 4; ++layer) {
        const int j = layer >> 1;
        if ((layer & 1) == 0) {
            PH_BEGIN phase_prep<true>(p, layer, 0, j, layer == 0); PH_END
            PH_BEGIN {
                FRwkvIn f{WSP(bf16_t, WS_RB), WSP(bf16_t, WS_KB), WSP(bf16_t, WS_VB), WSP(bf16_t, WS_TW), WSP(bf16_t, WS_TA), WSP(bf16_t, WS_TV), WSP(bf16_t, WS_TG)};
                pg8::Gemm g{WSP(bf16_t, WS_XR), WSP(bf16_t, WS_WRW_T) + (size_t)j * 4096 * D, NP, j == 0 ? 3840 : 4096, D, j == 0 ? 2 : 1, XR_STRIDE};
                pg8::StaticOrder S; S.init(NP, g.N, (int)gridDim.x, BID());
                pg8::EpiAdapt<FRwkvIn, true> E{f};
                pg8::gemm_phase(lds, g, S, E);
                wgemm_ks<true>(lds, WSP(bf16_t, WS_XR), D, XR_STRIDE, NP, NS, WSP(bf16_t, WS_WRW_T) + (size_t)j * 4096 * D, D, 4096, f, ((NP / 256) * (g.N / 256)) % (int)gridDim.x);
            } PH_END
            PH_BEGIN {
                FStoreF32 fw{WSP(float, WS_WP), D, D}, fa{WSP(float, WS_AP), D, D}, fv{WSP(float, WS_VP), D, D}, fg{WSP(float, WS_GG), D, D};
                wgemm_w(WSP(bf16_t, WS_TW), 64, NP, NS, WSP(bf16_t, WS_W2T) + (size_t)j * D * 64, 64, D, fw);
                wgemm_w(WSP(bf16_t, WS_TA), 64, NP, NS, WSP(bf16_t, WS_A2T) + (size_t)j * D * 64, 64, D, fa);
                if (j == 1) wgemm_w(WSP(bf16_t, WS_TV), 32, NP, NS, WSP(bf16_t, WS_V2T), 32, D, fv);
                wgemm_w(WSP(bf16_t, WS_TG), 160, NP, NS, WSP(bf16_t, WS_G2T) + (size_t)j * D * 160, 160, D, fg);
                phase_chunk(p, j, lds);
            } PH_END
            PH_BEGIN phase_carry(p, j, lds); PH_END
            PH_BEGIN phase_post2(p, j, lds); PH_END
        } else {
            PH_BEGIN phase_prep<false>(p, layer, 0, j); PH_END
            PH_BEGIN {
                FStoreBf16 f{WSP(bf16_t, WS_PR), PINP, PINP};
                pg8::Gemm g{WSP(bf16_t, WS_XR), WSP(bf16_t, WS_WIN_T) + (size_t)j * PINP * D, NP, PINP, D, 0, 0};
                pg8::StaticOrder S; S.init(NP, PINP, (int)gridDim.x, BID());
                pg8::EpiAdapt<FStoreBf16, true> E{f};
                pg8::gemm_phase(lds, g, S, E);
                FStoreBf16 fs{WSP(bf16_t, WS_PR), PINP, PIN};
                wgemm_ks<false>(lds, WSP(bf16_t, WS_XR), D, 0, NP, NS, WSP(bf16_t, WS_WIN_T) + (size_t)j * PINP * D, D, PINP, fs, ((NP / 256) * (PINP / 256)) % (int)gridDim.x);
            } PH_END
            PH_BEGIN phase_dsapost(p, j); PH_END
            PH_BEGIN phase_idx2<false>(p, j); phase_idx2<true>(p, j); PH_END
            PH_BEGIN phase_topk_prompt(p); phase_topk_sample(p, lds); PH_END
            PH_BEGIN phase_attn<true>(p, j, lds); phase_attn<false>(p, j, lds); PH_END
        }
        PH_BEGIN {
            FResid f{p->out, WSP(float, WS_MODS) + (size_t)layer * 36 * 6144 + 2 * D, layer == 0 ? p->x_prompt : nullptr, layer == 0 ? p->x_sample : nullptr};
            const bf16_t* Wt = ((layer & 1) == 0 ? WSP(bf16_t, WS_WO_T) : WSP(bf16_t, WS_WAO_T)) + (size_t)j * D * D;
            pg8::Gemm g{WSP(bf16_t, WS_YG), Wt, NP, D, D, 0, 0};
            pg8::StaticOrder S; S.init(NP, D, (int)gridDim.x, BID());
            pg8::EpiAdapt<FResid, false> E{f};
            pg8::gemm_phase(lds, g, S, E);
            wgemm_ks<false>(lds, WSP(bf16_t, WS_YG), D, 0, NP, NS, Wt, D, D, f);
        } PH_END
        PH_BEGIN phase_prep<false>(p, layer, 1, j); PH_END
        PH_BEGIN {
            FRelu2 f{WSP(bf16_t, WS_U)};
            pg8::Gemm g{WSP(bf16_t, WS_XR), WSP(bf16_t, WS_WUP_T) + (size_t)layer * DFF * D, NP, DFF, D, 0, 0};
            pg8::StaticOrder S; S.init(NP, DFF, (int)gridDim.x, BID());
            pg8::EpiAdapt<FRelu2, true> E{f};
            pg8::gemm_phase(lds, g, S, E);
            wgemm_ks<false>(lds, WSP(bf16_t, WS_XR), D, 0, NP, NS, WSP(bf16_t, WS_WUP_T) + (size_t)layer * DFF * D, D, DFF, f);
        } PH_END
        PH_BEGIN {
            FResid f{p->out, WSP(float, WS_MODS) + (size_t)layer * 36 * 6144 + 5 * D, nullptr, nullptr};
            pg8::Gemm g{WSP(bf16_t, WS_U), WSP(bf16_t, WS_WDN_T) + (size_t)layer * DFF * D, NP, D, DFF, 0, 0};
            pg8::StaticOrder S; S.init(NP, D, (int)gridDim.x, BID());
            pg8::EpiAdapt<FResid, false> E{f};
            pg8::gemm_phase(lds, g, S, E);
            wgemm_ks<false>(lds, WSP(bf16_t, WS_U), DFF, 0, NP, NS, WSP(bf16_t, WS_WDN_T) + (size_t)layer * DFF * D, DFF, D, f);
        } PH_END
    }
#undef PH_BEGIN
#undef PH_END
}

static int count_phases() { int n = 1; for (int layer = 0; layer < 4; ++layer) { n += ((layer & 1) == 0) ? 5 : 6; n += 4; } return n; }

extern "C" void kernel_launch(void* const* d_in, const int* in_sizes, int n_in, void* d_out, int out_size, void* d_ws, size_t ws_size, hipStream_t stream) {
    static int grid = 0;
    if (grid == 0) {
        if (n_in != 39 || out_size != (int)O_END || ws_size < WS_END) { fprintf(stderr, "kernel_launch: unexpected shapes n_in %d out %d ws %zu (need %zu)\n", n_in, out_size, ws_size, (size_t)WS_END); grid = -1; return; }
        int dev = 0, cus = 0, per_cu = 0;
        if (hipGetDevice(&dev) != hipSuccess || hipDeviceGetAttribute(&cus, hipDeviceAttributeMultiprocessorCount, dev) != hipSuccess) { grid = -1; return; }
        if (hipFuncSetAttribute((const void*)mega, hipFuncAttributeMaxDynamicSharedMemorySize, LDS_BYTES) != hipSuccess) { fprintf(stderr, "kernel_launch: hipFuncSetAttribute failed\n"); grid = -1; return; }
        if (hipOccupancyMaxActiveBlocksPerMultiprocessor(&per_cu, (const void*)mega, 512, LDS_BYTES) != hipSuccess || per_cu < 1) fprintf(stderr, "kernel_launch: occupancy query says %d\n", per_cu);
        (void)hipGetLastError();
        grid = cus;
    }
    if (grid < 0) return;
    (void)hipMemsetAsync((char*)d_ws + WS_BAR, 0, 65536, stream);
    P p{};
    memcpy((void*)&p, (const void*)d_in, 39 * sizeof(void*));
    p.out = (float*)d_out; p.ws = (unsigned char*)d_ws;
#ifndef STOP_PH
#define STOP_PH 1000
#endif
    const int nph = count_phases() < STOP_PH ? count_phases() : STOP_PH;
#ifndef ONE_LAUNCH
    for (int ph = 0; ph < nph; ++ph) { p.ph_lo = ph; p.ph_hi = ph + 1; hipLaunchKernelGGL(mega, dim3(grid), dim3(512), LDS_BYTES, stream, p); }
#else
    p.ph_lo = 0; p.ph_hi = nph; hipLaunchKernelGGL(mega, dim3(grid), dim3(512), LDS_BYTES, stream, p);
#endif
}
```

```cpp
#define ONE_LAUNCH 1
#include <hip/hip_runtime.h>
#include <cstdio>
#include <cstdint>
#include <cstring>

#define LAS __attribute__((address_space(3)))
typedef unsigned short bf16_t;
typedef short bf16x8 __attribute__((ext_vector_type(8)));
typedef float f32x4 __attribute__((ext_vector_type(4)));
typedef float f32x2 __attribute__((ext_vector_type(2)));
typedef unsigned u32x4 __attribute__((ext_vector_type(4)));
typedef unsigned u32x2 __attribute__((ext_vector_type(2)));

constexpr int D = 1024, NP = 16384, NS = 256, NT = NP + NS, SEQL = 4096, PAST = 8192, NSEQ = 36, DFF = 4096;
constexpr int PIN = 2120, PINP = 2304;
constexpr int TOPK = 256, SCS_LD = 8320;
constexpr size_t O_YP = 0, O_YS = 16777216, O_KP = 17039360, O_VP = 25427968, O_IKP = 33816576, O_WKVP = 35913728, O_SHP = 36438016,
                 O_KS = 36446208, O_VS = 36577280, O_IKS = 36708352, O_WKVS = 36741120, O_SHS = 40935424, O_END = 41000960;
constexpr size_t al256(size_t x) { return (x + 255) & ~(size_t)255; }
constexpr size_t WS_BAR = 0;
constexpr size_t WS_MODS = 65536;
constexpr size_t WS_WUP_T = al256(WS_MODS + (size_t)4 * NSEQ * 6144 * 4);
constexpr size_t WS_WDN_T = WS_WUP_T + (size_t)4 * DFF * D * 2;
constexpr size_t WS_WRW_T = WS_WDN_T + (size_t)4 * DFF * D * 2;
constexpr size_t WS_WO_T = WS_WRW_T + (size_t)2 * 4096 * D * 2;
constexpr size_t WS_WIN_T = WS_WO_T + (size_t)2 * D * D * 2;
constexpr size_t WS_WAO_T = WS_WIN_T + (size_t)2 * PINP * D * 2;
constexpr size_t WS_W2T = WS_WAO_T + (size_t)2 * D * D * 2;
constexpr size_t WS_A2T = WS_W2T + (size_t)2 * D * 64 * 2;
constexpr size_t WS_V2T = WS_A2T + (size_t)2 * D * 64 * 2;
constexpr size_t WS_G2T = WS_V2T + (size_t)D * 32 * 2;
constexpr size_t WS_XR = WS_G2T + (size_t)2 * D * 160 * 2;
constexpr size_t XR_STRIDE = (size_t)NT * D;
constexpr size_t WS_RB = WS_XR + 6 * XR_STRIDE * 2;
constexpr size_t WS_KB = WS_RB + XR_STRIDE * 2;
constexpr size_t WS_VB = WS_KB + XR_STRIDE * 2;
constexpr size_t WS_TW = WS_VB + XR_STRIDE * 2;
constexpr size_t WS_TA = WS_TW + (size_t)NT * 64 * 2;
constexpr size_t WS_TV = WS_TA + (size_t)NT * 64 * 2;
constexpr size_t WS_TG = WS_TV + (size_t)NT * 32 * 2;
constexpr size_t WS_WP = al256(WS_TG + (size_t)NT * 160 * 2);
constexpr size_t F32A = (size_t)NT * D * 4;
constexpr size_t WS_AP = WS_WP + F32A, WS_VP = WS_AP + F32A, WS_GG = WS_VP + F32A, WS_VFIRST = WS_GG + F32A;
constexpr size_t WS_DEC = WS_VFIRST + F32A, WS_KM = WS_DEC + F32A, WS_VM = WS_KM + F32A, WS_AV = WS_VM + F32A, WS_BV = WS_AV + F32A, WS_Y = WS_BV + F32A;
constexpr size_t WS_YG = WS_Y + F32A;
constexpr size_t WS_U = WS_YG + XR_STRIDE * 2;
constexpr size_t WS_PR = WS_U + (size_t)NT * DFF * 2;
constexpr size_t WS_Q = WS_PR + (size_t)NT * PINP * 4;
constexpr size_t WS_QI = WS_Q + F32A;
constexpr size_t WS_WI = WS_QI + (size_t)NT * 512 * 4;
constexpr size_t WS_SC = al256(WS_WI + (size_t)NT * 8 * 4);
constexpr size_t WS_SCS = WS_SC + (size_t)4 * 4096 * 4096 * 4;
constexpr size_t WS_SEL = al256(WS_SCS + (size_t)NS * SCS_LD * 4);
constexpr size_t WS_CNT = WS_SEL + (size_t)NT * 256 * 4;
constexpr size_t WS_KBF = al256(WS_CNT + (size_t)NT * 4);
constexpr size_t WS_VBF = WS_KBF + (size_t)NT * 256 * 2;
constexpr size_t WS_QIB = WS_VBF + (size_t)NT * 256 * 2;
constexpr size_t WS_KIB = WS_QIB + (size_t)NT * 512 * 2;
constexpr size_t WS_K8 = al256(WS_KIB + (size_t)NT * 64 * 2);
constexpr size_t WS_V8 = WS_K8 + (size_t)NT * 256;
constexpr size_t WS_END = al256(WS_V8 + (size_t)NT * 256);
constexpr size_t WS_ROPE = WS_KBF;

constexpr int LCH = 64, NCH = SEQL / LCH;
constexpr size_t WS_PCH = WS_SC, WS_CCH = WS_PCH + (size_t)64 * NCH * 4096 * 4, WS_SST = WS_CCH + (size_t)64 * NCH * 4096 * 4;
static_assert(WS_SST + (size_t)64 * NCH * 4096 * 4 <= WS_SCS, "scan buffers must fit the aliased region");
constexpr int LDS_BYTES = 147456;
constexpr int LDS_MISC = 131072;

typedef __bf16 bf16x2_t __attribute__((ext_vector_type(2)));
__device__ __forceinline__ unsigned pk_bf16(float lo, float hi) { const f32x2 v = {lo, hi}; const bf16x2_t b = __builtin_convertvector(v, bf16x2_t); return __builtin_bit_cast(unsigned, b); }
__device__ __forceinline__ unsigned pk_fp8x4(f32x4 v) { int w = 0; w = __builtin_amdgcn_cvt_pk_fp8_f32(v[0], v[1], w, false); w = __builtin_amdgcn_cvt_pk_fp8_f32(v[2], v[3], w, true); return (unsigned)w; }
__device__ __forceinline__ f32x4 fp8x4_f32(unsigned w) { return (f32x4){__builtin_amdgcn_cvt_f32_fp8((int)w, 0), __builtin_amdgcn_cvt_f32_fp8((int)w, 1), __builtin_amdgcn_cvt_f32_fp8((int)w, 2), __builtin_amdgcn_cvt_f32_fp8((int)w, 3)}; }
__device__ __forceinline__ float bf2f(unsigned short x) { return __uint_as_float((unsigned)x << 16); }
__device__ __forceinline__ float bflo(unsigned x) { return __uint_as_float(x << 16); }
__device__ __forceinline__ float bfhi(unsigned x) { return __uint_as_float(x & 0xffff0000u); }
__device__ __forceinline__ f32x4 ld_bf4(const bf16_t* p) { const u32x2 v = *(const u32x2*)p; return (f32x4){bflo(v.x), bfhi(v.x), bflo(v.y), bfhi(v.y)}; }
__device__ __forceinline__ void st_bf4(bf16_t* p, f32x4 v) { u32x2 w; w.x = pk_bf16(v[0], v[1]); w.y = pk_bf16(v[2], v[3]); *(u32x2*)p = w; }
template <int CTRL> __device__ __forceinline__ float dppf(float v) { return __int_as_float(__builtin_amdgcn_update_dpp(0, __float_as_int(v), CTRL, 0xf, 0xf, false)); }
template <int CTRL> __device__ __forceinline__ int dppi(int v) { return __builtin_amdgcn_update_dpp(0, v, CTRL, 0xf, 0xf, false); }
__device__ __forceinline__ float g16_sum(float v) { v += dppf<0xB1>(v); v += dppf<0x4E>(v); v += dppf<0x141>(v); v += dppf<0x140>(v); return v; }
__device__ __forceinline__ float g16_max(float v) { v = fmaxf(v, dppf<0xB1>(v)); v = fmaxf(v, dppf<0x4E>(v)); v = fmaxf(v, dppf<0x141>(v)); v = fmaxf(v, dppf<0x140>(v)); return v; }
__device__ __forceinline__ int g16_sum_i(int v) { v += dppi<0xB1>(v); v += dppi<0x4E>(v); v += dppi<0x141>(v); v += dppi<0x140>(v); return v; }
__device__ __forceinline__ int g16_min_i(int v) { v = min(v, dppi<0xB1>(v)); v = min(v, dppi<0x4E>(v)); v = min(v, dppi<0x141>(v)); v = min(v, dppi<0x140>(v)); return v; }
__device__ __forceinline__ float rlf(float v, int k) { return __int_as_float(__builtin_amdgcn_readlane(__float_as_int(v), k)); }
__device__ __forceinline__ float wave_sum(float v) { v = g16_sum(v); return (rlf(v, 0) + rlf(v, 16)) + (rlf(v, 32) + rlf(v, 48)); }
__device__ __forceinline__ float wave_max(float v) { v = g16_max(v); return fmaxf(fmaxf(rlf(v, 0), rlf(v, 16)), fmaxf(rlf(v, 32), rlf(v, 48))); }
__device__ __forceinline__ int wave_sum_i(int v) { v = g16_sum_i(v); return (__builtin_amdgcn_readlane(v, 0) + __builtin_amdgcn_readlane(v, 16)) + (__builtin_amdgcn_readlane(v, 32) + __builtin_amdgcn_readlane(v, 48)); }
__device__ __forceinline__ int wave_min_i(int v) { v = g16_min_i(v); return min(min(__builtin_amdgcn_readlane(v, 0), __builtin_amdgcn_readlane(v, 16)), min(__builtin_amdgcn_readlane(v, 32), __builtin_amdgcn_readlane(v, 48))); }
__device__ __forceinline__ float sigmoidf_(float x) { return 1.0f / (1.0f + expf(-x)); }
__device__ __forceinline__ float fsig(float x) { return __builtin_amdgcn_rcpf(1.0f + __expf(-x)); }
__device__ __forceinline__ float ftanh(float x) { return 2.0f * fsig(2.0f * x) - 1.0f; }
__device__ __forceinline__ int row_seq(int row) { return row < NP ? (row >> 12) : 4 + ((row - NP) >> 3); }
__device__ __forceinline__ int row_pos(int row) { return row < NP ? (row & 4095) : PAST + ((row - NP) & 7); }
__device__ __forceinline__ int TID() { int t = threadIdx.x; asm volatile("" : "+v"(t)); return t; }
__device__ __forceinline__ int BID() { int b = blockIdx.x; asm volatile("" : "+s"(b)); return b; }
__device__ __forceinline__ void wave_lds_fence() { __builtin_amdgcn_fence(__ATOMIC_RELEASE, "wavefront"); __builtin_amdgcn_wave_barrier(); __builtin_amdgcn_fence(__ATOMIC_ACQUIRE, "wavefront"); }

#define XB_TMO      128
#define XB_XCNT(j)  (256  + 64 * (j))
#define XB_XSUB(j)  (1280 + 64 * (j))
#define XB_XGEN(j)  (2304 + 64 * (j))
#define XB_TOP      3328
#define XB_TOPGEN   3392
#define XCD_BAR_WORDS 3456
#define XB_SPIN_CAP (1u << 22)
__device__ __forceinline__ unsigned xb_ld(unsigned* p)              { return __hip_atomic_load(p, __ATOMIC_RELAXED, __HIP_MEMORY_SCOPE_AGENT); }
__device__ __forceinline__ unsigned xb_add(unsigned* p, unsigned v) { return __hip_atomic_fetch_add(p, v, __ATOMIC_RELAXED, __HIP_MEMORY_SCOPE_AGENT); }
__device__ __forceinline__ unsigned xb_xcc_id() { return (unsigned)__builtin_amdgcn_s_getreg((3 << 11) | 20) & 0xFu; }
#define XB_SPIN(cond, bar) do { unsigned _sp = 0; while (cond) { __builtin_amdgcn_s_sleep(1); \
    if ((++_sp & 255u) == 0u) { if (xb_ld(&(bar)[XB_TMO])) break; if (_sp > XB_SPIN_CAP) { atomicAdd(&(bar)[XB_TMO], 1u); break; } } } } while (0)
struct XcdBarrier { unsigned* bar; unsigned x; volatile LAS unsigned* st; };
__device__ __forceinline__ XcdBarrier xcd_barrier_post(unsigned* bar, volatile LAS unsigned* st) {
    XcdBarrier b; b.bar = bar; b.x = xb_xcc_id(); b.st = st;
    if (threadIdx.x == 0) (void)xb_add(&bar[XB_XCNT(b.x)], 1u);
    return b;
}
__device__ __forceinline__ void xcd_barrier_complete(unsigned* bar, unsigned x, unsigned& nloc, unsigned& nx) {
    const unsigned G = gridDim.x * gridDim.y * gridDim.z;
    unsigned sum, cnt, mine, sp = 0u;
    for (;;) {
        sum = 0u; cnt = 0u; mine = 0u;
#pragma unroll
        for (unsigned j = 0; j < 16; ++j) { const unsigned c = xb_ld(&bar[XB_XCNT(j)]); sum += c; cnt += (c > 0u) ? 1u : 0u; mine = (j == x) ? c : mine; }
        if (sum == G) break;
        __builtin_amdgcn_s_sleep(1);
        if ((++sp & 255u) == 0u) { if (xb_ld(&bar[XB_TMO])) break; if (sp > XB_SPIN_CAP) { atomicAdd(&bar[XB_TMO], 1u); break; } }
    }
    nloc = mine > 0u ? mine : 1u; nx = cnt > 0u ? cnt : 1u;
}
__device__ __forceinline__ void xcd_barrier(const XcdBarrier& b) {
    asm volatile("s_waitcnt vmcnt(0)" ::: "memory");
    __syncthreads();
    if (threadIdx.x == 0) {
        unsigned* bar = b.bar;
        __builtin_amdgcn_s_waitcnt(0);
        unsigned nloc = b.st[0], nx = b.st[1];
        if (nloc == 0u) { xcd_barrier_complete(bar, b.x, nloc, nx); b.st[0] = nloc; b.st[1] = nx; }
        const unsigned old = xb_add(&bar[XB_XSUB(b.x)], 1u);
        const unsigned gen = old / nloc;
        if (old + 1u == (gen + 1u) * nloc) {
            __builtin_amdgcn_fence(__ATOMIC_RELEASE, "agent");
            asm volatile("s_waitcnt vmcnt(0)" ::: "memory");
            const unsigned og = xb_add(&bar[XB_TOP], 1u);
            const unsigned tg = og / nx;
            if (og + 1u == (tg + 1u) * nx) xb_add(&bar[XB_TOPGEN], 1u);
            else XB_SPIN(xb_ld(&bar[XB_TOPGEN]) == tg, bar);
            __builtin_amdgcn_fence(__ATOMIC_ACQUIRE, "agent");
            xb_add(&bar[XB_XGEN(b.x)], 1u);
            asm volatile("s_waitcnt vmcnt(0)" ::: "memory");
        } else {
            XB_SPIN(xb_ld(&bar[XB_XGEN(b.x)]) == gen, bar);
            __builtin_amdgcn_fence(__ATOMIC_ACQUIRE, "agent");
            asm volatile("s_waitcnt vmcnt(0)" ::: "memory");
        }
    }
    __syncthreads();
}

struct P {
    const float *x_prompt, *x_sample, *cache_k, *cache_v, *cache_ik, *state_wkv, *state_shift; const int* page_table;
    const float *c_prompt, *c_sample, *norm_g, *w_ada, *b_ada, *w_up, *w_down, *rw_mix, *rw_w_rkv, *rw_w_o, *rw_w0, *rw_w1, *rw_w2, *rw_a0, *rw_a1, *rw_a2,
                *rw_v0, *rw_v1, *rw_v2, *rw_g1, *rw_g2, *rw_k_k, *rw_k_a, *rw_r_k, *rw_lnx_w, *rw_lnx_b, *att_w_in, *att_w_o, *att_q_norm, *att_k_norm, *idx_k_norm;
    float* out; unsigned char* ws; int ph_lo, ph_hi;
};
typedef const P __attribute__((address_space(4)))* KP;
#define WSP(T, off) ((T*)(p->ws + (off)))
__device__ __forceinline__ KP kargs() { KP k = (KP)__builtin_amdgcn_kernarg_segment_ptr(); asm volatile("" : "+s"(k)); return k; }

namespace pg8 {
constexpr int BM = 256, BK = 64, HALF = 128, HTB = HALF * BK * 2, STAGE_BYTES = 8 * HTB, NXCD = 8, WGM = 8;
__device__ __forceinline__ int lds_byte(int r, int c) { const int st = (r >> 4) * 2 + (c >> 5), rr = r & 15, cc = c & 31, ob = rr * 64 + cc * 2; return st * 1024 + (ob ^ (((ob >> 9) & 1) << 5)); }
__device__ __forceinline__ void stage_rc(int b, int& R, int& C) { const int st = b / 1024, sb = b % 1024, swz = sb ^ (((sb >> 9) & 1) << 5); R = (st >> 1) * 16 + swz / 64; C = (st & 1) * 32 + (swz % 64) / 2; }
__device__ __forceinline__ int perm32(int rho) { const int n = rho >> 4, i = rho & 15; return 8 * (i >> 2) + 4 * n + (i & 3); }
struct Unit { int pm, pn; };
struct Gemm { const bf16_t* A; const bf16_t* Bt; int M, N, K, mode; size_t agrp; };
__device__ __forceinline__ int phys_pn(const Gemm& g, int pn) { return (g.mode == 2 && pn >= 12) ? pn + 1 : pn; }
__device__ __forceinline__ const char* a_ptr(const Gemm& g, const Unit& u, size_t tstep) {
    int grp = 0; if (g.mode) grp = u.pn < 12 ? (u.pn >> 2) : (u.pn == 12 ? 2 : u.pn - 10);
    return (const char*)g.A + (size_t)grp * g.agrp * 2 + (size_t)u.pm * tstep; }
struct StaticOrder {
    int nM, nN, nwg, G, c;
    __device__ void init(int M, int N, int G_, int c_) { nM = M / BM; nN = N / BM; nwg = nM * nN; G = G_; c = c_; }
    __device__ bool next(int i, Unit& u) const {
        const long L = (long)i * G + c; if (L >= nwg) return false;
        int wgid = (int)L; { const int q = nwg / NXCD, r = nwg % NXCD, xcd = wgid % NXCD, off = wgid / NXCD; wgid = (xcd < r ? xcd * (q + 1) : r * (q + 1) + (xcd - r) * q) + off; }
        const int nig = WGM * nN, gid = wgid / nig, fm = gid * WGM, gsz = (nM - fm) < WGM ? (nM - fm) : WGM;
        u.pm = fm + ((wgid % nig) % gsz); u.pn = (wgid % nig) / gsz; return true;
    }
};
template <class F, bool PERM_> struct EpiAdapt {
    static constexpr bool PERM = PERM_;
    F f;
    __device__ __forceinline__ void operator()(const f32x4 (&acc)[2][2][4][2], const Unit& u, int wr, int wc, int fr, int fq) const {
        const int row0 = u.pm * BM + wr * 64 + fr, col0 = u.pn * BM + wc * 32 + (PERM ? 8 * fq : 4 * fq);
#pragma unroll
        for (int ai = 0; ai < 2; ++ai)
#pragma unroll
            for (int m = 0; m < 4; ++m)
#pragma unroll
                for (int bj = 0; bj < 2; ++bj) {
                    if constexpr (PERM) f.vec8(row0 + ai * HALF + m * 16, col0 + bj * HALF, acc[ai][bj][m][0], acc[ai][bj][m][1]);
                    else {
#pragma unroll
                        for (int n = 0; n < 2; ++n) f.vec4(row0 + ai * HALF + m * 16, col0 + bj * HALF + 16 * n, acc[ai][bj][m][n]);
                    }
                }
    }
};

template <class Epi>
__device__ __forceinline__ void gemm_phase(LAS unsigned char* lds, const Gemm g, const StaticOrder& S, const Epi& E) {
    const int tid = TID(), wid = __builtin_amdgcn_readfirstlane(tid >> 6), lane = tid & 63, wr = wid >> 2, wc = wid & 3, fr = lane & 15, fq = lane >> 4;
    const int K = g.K, nt = K / BK;
    unsigned voffA[2], voffB[2];
#pragma unroll
    for (int i = 0; i < 2; ++i) { int R, C; stage_rc(tid * 16 + i * 8192, R, C); const int Rb = Epi::PERM ? ((R & ~31) + perm32(R & 31)) : R;
        voffA[i] = (unsigned)(R * K + C) * 2u; voffB[i] = (unsigned)(Rb * K + C) * 2u; }
    const size_t kstep = (size_t)(BK * 2);
    const size_t hstep = (size_t)HALF * K * 2;
    const size_t tstep = 2 * hstep;
    const unsigned ldsw = (unsigned)wid * 1024u;
    const int aoff = lds_byte(wr * 64 + fr, fq * 8), boff = lds_byte(wc * 32 + fr, fq * 8);
#define PG8_SA(b, h) (((b) * 2 + (h)) * HTB)
#define PG8_SB(b, h) ((4 + (b) * 2 + (h)) * HTB)
#define PG8_STAGE(bufoff, gbase, voff) do { _Pragma("unroll") for (int _i = 0; _i < 2; ++_i) \
        __builtin_amdgcn_global_load_lds((const unsigned*)((const char*)(gbase) + (voff)[_i]), (LAS unsigned*)(lds + (bufoff) + ldsw + _i * 8192), 16, 0, 0); } while (0)
#define PG8_LDA(dst, b, h) do { _Pragma("unroll") for (int m = 0; m < 4; ++m) _Pragma("unroll") for (int k = 0; k < 2; ++k) dst[m][k] = *(const LAS bf16x8*)(lds + PG8_SA(b, h) + aoff + m * 2048 + k * 1024); } while (0)
#define PG8_LDB(dst, b, h) do { _Pragma("unroll") for (int n = 0; n < 2; ++n) _Pragma("unroll") for (int k = 0; k < 2; ++k) dst[n][k] = *(const LAS bf16x8*)(lds + PG8_SB(b, h) + boff + n * 2048 + k * 1024); } while (0)
#define PG8_MMA(ai, bj, At, Bt) do { __builtin_amdgcn_s_setprio(1); _Pragma("unroll") for (int m = 0; m < 4; ++m) _Pragma("unroll") for (int n = 0; n < 2; ++n) _Pragma("unroll") for (int k = 0; k < 2; ++k) \
        acc[ai][bj][m][n] = __builtin_amdgcn_mfma_f32_16x16x32_bf16(Bt[n][k], At[m][k], acc[ai][bj][m][n], 0, 0, 0); __builtin_amdgcn_s_setprio(0); } while (0)
#define PG8_WAIT_V(n) asm volatile("s_waitcnt vmcnt(" #n ")" ::: "memory")
#define PG8_WAIT_L(n) asm volatile("s_waitcnt lgkmcnt(" #n ")" ::: "memory")
#define PG8_BAR __builtin_amdgcn_s_barrier()
#define PG8_SCHED __builtin_amdgcn_sched_barrier(0)
    Unit cur, nxt; int ui = 0;
    if (!S.next(0, cur)) return;
    cur.pn = phys_pn(g, cur.pn);
    f32x4 acc[2][2][4][2];
#pragma unroll
    for (int a = 0; a < 2; ++a)
#pragma unroll
        for (int b = 0; b < 2; ++b)
#pragma unroll
            for (int m = 0; m < 4; ++m)
#pragma unroll
                for (int n = 0; n < 2; ++n) acc[a][b][m][n] = (f32x4){0.f, 0.f, 0.f, 0.f};
    bf16x8 At[4][2], B0[2][2], B1[2][2];
    const char* cA = a_ptr(g, cur, tstep); const char* cB = (const char*)g.Bt + (size_t)cur.pn * tstep;
    PG8_STAGE(PG8_SB(0, 0), cB, voffB); PG8_STAGE(PG8_SA(0, 0), cA, voffA); PG8_STAGE(PG8_SB(0, 1), cB + hstep, voffB); PG8_STAGE(PG8_SA(0, 1), cA + hstep, voffA);
    if (wr == 1) PG8_BAR;
    PG8_WAIT_V(4); PG8_BAR;
    PG8_STAGE(PG8_SB(1, 0), cB + kstep, voffB); PG8_STAGE(PG8_SA(1, 0), cA + kstep, voffA); PG8_STAGE(PG8_SB(1, 1), cB + hstep + kstep, voffB);
    PG8_WAIT_V(6); PG8_BAR;
    for (;;) {
        const bool has_next = S.next(ui + 1, nxt);
        if (has_next) nxt.pn = phys_pn(g, nxt.pn);
        const char* nA = has_next ? a_ptr(g, nxt, tstep) : cA; const char* nB = has_next ? (const char*)g.Bt + (size_t)nxt.pn * tstep : cB;
        for (int t = 0; t < nt; t += 2) {
            const bool last = (t == nt - 2);
            const char* a1 = cA + (size_t)(t + 1) * kstep;
            const char* a2 = last ? nA : cA + (size_t)(t + 2) * kstep; const char* b2 = last ? nB : cB + (size_t)(t + 2) * kstep;
            const char* a3 = a2 + kstep; const char* b3 = b2 + kstep;
            PG8_LDB(B0, 0, 0); PG8_SCHED; PG8_LDA(At, 0, 0); PG8_STAGE(PG8_SA(1, 1), a1 + hstep, voffA);
            PG8_WAIT_L(8); PG8_BAR; PG8_WAIT_L(0); PG8_MMA(0, 0, At, B0); PG8_BAR; PG8_SCHED;
            PG8_LDB(B1, 0, 1); PG8_STAGE(PG8_SB(0, 0), b2, voffB);
            PG8_BAR; PG8_WAIT_L(0); PG8_MMA(0, 1, At, B1); PG8_BAR;
            PG8_LDA(At, 0, 1); PG8_STAGE(PG8_SA(0, 0), a2, voffA);
            PG8_BAR; PG8_WAIT_L(0); PG8_MMA(1, 0, At, B0); PG8_BAR; PG8_SCHED;
            PG8_STAGE(PG8_SB(0, 1), b2 + hstep, voffB);
            PG8_WAIT_V(6); PG8_BAR; PG8_MMA(1, 1, At, B1); PG8_BAR;
            PG8_LDB(B0, 1, 0); PG8_SCHED; PG8_LDA(At, 1, 0); PG8_STAGE(PG8_SA(0, 1), a2 + hstep, voffA);
            PG8_WAIT_L(8); PG8_BAR; PG8_WAIT_L(0); PG8_MMA(0, 0, At, B0); PG8_BAR; PG8_SCHED;
            PG8_LDB(B1, 1, 1); PG8_STAGE(PG8_SB(1, 0), b3, voffB);
            PG8_BAR; PG8_WAIT_L(0); PG8_MMA(0, 1, At, B1); PG8_BAR;
            PG8_LDA(At, 1, 1); PG8_STAGE(PG8_SA(1, 0), a3, voffA);
            PG8_BAR; PG8_WAIT_L(0); PG8_MMA(1, 0, At, B0); PG8_BAR; PG8_SCHED;
            PG8_STAGE(PG8_SB(1, 1), b3 + hstep, voffB);
            PG8_WAIT_V(6); PG8_BAR; PG8_MMA(1, 1, At, B1); PG8_BAR;
        }
        E(acc, cur, wr, wc, fr, fq);
        if (!has_next) break;
#pragma unroll
        for (int a = 0; a < 2; ++a)
#pragma unroll
            for (int b = 0; b < 2; ++b)
#pragma unroll
                for (int m = 0; m < 4; ++m)
#pragma unroll
                    for (int n = 0; n < 2; ++n) acc[a][b][m][n] = (f32x4){0.f, 0.f, 0.f, 0.f};
        cur = nxt; cA = nA; cB = nB; ++ui;
    }
    PG8_WAIT_V(0);
    if (wr == 0) PG8_BAR;
    PG8_BAR;
#undef PG8_SA
#undef PG8_SB
#undef PG8_STAGE
#undef PG8_LDA
#undef PG8_LDB
#undef PG8_MMA
#undef PG8_WAIT_V
#undef PG8_WAIT_L
#undef PG8_BAR
#undef PG8_SCHED
}
}

template <class F>
__device__ __forceinline__ void sgemm_bf(LAS unsigned char* lds, const bf16_t* A, int lda, int row0, int M, const float* W, int ldw, int N, int K, int coloff, const F& f) {
    LAS float* As = (LAS float*)lds;
    LAS float* Ws = (LAS float*)(lds + 32 * 68 * 4);
    const int tid = TID(), ty = tid >> 4, tx = tid & 15;
    const int ntn = (N + 63) / 64, ntiles = (M / 64) * ntn;
    for (int tile = BID(); tile < ntiles; tile += gridDim.x) {
        const int tm = tile / ntn, tn = tile % ntn, r0 = row0 + tm * 64, n0 = tn * 64;
        f32x4 c0 = {0.f, 0.f, 0.f, 0.f}, c1 = {0.f, 0.f, 0.f, 0.f};
        for (int k0 = 0; k0 < K; k0 += 32) {
            __syncthreads();
            { const int r = tid >> 3, q = tid & 7; const f32x4 a = ld_bf4(A + (size_t)(r0 + r) * lda + k0 + 4 * q);
              As[(4 * q + 0) * 68 + r] = a[0]; As[(4 * q + 1) * 68 + r] = a[1]; As[(4 * q + 2) * 68 + r] = a[2]; As[(4 * q + 3) * 68 + r] = a[3]; }
            { const int kr = tid >> 4, c = tid & 15; f32x4 w = {0.f, 0.f, 0.f, 0.f}; if (n0 + 4 * c < N) w = *(const f32x4*)(W + (size_t)(k0 + kr) * ldw + n0 + 4 * c);
              *(LAS f32x4*)(Ws + kr * 68 + 4 * c) = w; }
            __syncthreads();
#pragma unroll 8
            for (int kk = 0; kk < 32; ++kk) {
                const f32x2 a = *(const LAS f32x2*)(As + kk * 68 + 2 * ty); const f32x4 b = *(const LAS f32x4*)(Ws + kk * 68 + 4 * tx);
                c0 += a.x * b; c1 += a.y * b;
            }
        }
        if (n0 + 4 * tx < N) { f.vec4(r0 + 2 * ty, n0 + 4 * tx + coloff, c0); f.vec4(r0 + 2 * ty + 1, n0 + 4 * tx + coloff, c1); }
    }
    __syncthreads();
}

typedef float f32x16 __attribute__((ext_vector_type(16)));
__device__ __forceinline__ int rw_group(int n0) { const int t = n0 >> 8; return t < 12 ? (t >> 2) : (t == 12 ? 2 : t - 10); }
template <bool RWGRP, class F>
__device__ __forceinline__ void wgemm_ks(LAS unsigned char* lds, const bf16_t* A, int lda, size_t agrp, int row0, int M, const bf16_t* Bt, int K, int N, const F& f, int wg0 = 0) {
    const int tid = TID(), wave = tid >> 6, lane = tid & 63, lr = lane & 31, lh = lane >> 5;
    LAS float* red = (LAS float*)lds;
    const int ntn = N / 64, nitems = (M / 32) * ntn, kw = K / 8, steps = kw / 16;
    const int vb_ = BID() - wg0, nwg_ = (int)gridDim.x - wg0;
    for (int item = vb_ < 0 ? nitems : vb_; item < nitems; item += nwg_) {
        const int tm = item / ntn, tn = item % ntn, r0 = row0 + tm * 32, n0 = tn * 64;
        const bf16_t* Ab = A + (RWGRP ? (size_t)rw_group(n0) * agrp : 0) + (size_t)(r0 + lr) * lda + wave * kw + lh * 8;
        const bf16_t* B0 = Bt + (size_t)(n0 + lr) * K + wave * kw + lh * 8; const bf16_t* B1 = B0 + (size_t)32 * K;
        f32x16 acc0, acc1;
#pragma unroll
        for (int r = 0; r < 16; ++r) { acc0[r] = 0.f; acc1[r] = 0.f; }
#pragma unroll 8
        for (int st = 0; st < steps; ++st) {
            const bf16x8 a = *(const bf16x8*)(Ab + 16 * st), b0 = *(const bf16x8*)(B0 + 16 * st), b1 = *(const bf16x8*)(B1 + 16 * st);
            acc0 = __builtin_amdgcn_mfma_f32_32x32x16_bf16(b0, a, acc0, 0, 0, 0);
            acc1 = __builtin_amdgcn_mfma_f32_32x32x16_bf16(b1, a, acc1, 0, 0, 0);
        }
        __syncthreads();
#pragma unroll
        for (int r = 0; r < 16; ++r) { red[((wave * 2 + 0) * 16 + r) * 64 + lane] = acc0[r]; red[((wave * 2 + 1) * 16 + r) * 64 + lane] = acc1[r]; }
        __syncthreads();
        { const int t = tid >> 8, r4 = (tid >> 6) & 3, l2 = tid & 63; f32x4 v = {0.f, 0.f, 0.f, 0.f};
#pragma unroll
          for (int w = 0; w < 8; ++w)
#pragma unroll
              for (int e = 0; e < 4; ++e) v[e] += red[((w * 2 + t) * 16 + 4 * r4 + e) * 64 + l2];
          f.vec4(r0 + (l2 & 31), n0 + 32 * t + 8 * r4 + 4 * (l2 >> 5), v); }
    }
    __syncthreads();
}
template <class F>
__device__ __forceinline__ void wgemm_w(const bf16_t* A, int lda, int row0, int M, const bf16_t* Bt, int K, int N, const F& f) {
    const int lane = TID() & 63, lr = lane & 31, lh = lane >> 5, gw = BID() * 8 + (TID() >> 6), nw = gridDim.x * 8;
    const int ntn = N / 64, nitems = (M / 32) * ntn, steps = K / 16;
    for (int item = gw; item < nitems; item += nw) {
        const int tm = item / ntn, tn = item % ntn, r0 = row0 + tm * 32, n0 = tn * 64;
        const bf16_t* Ab = A + (size_t)(r0 + lr) * lda + lh * 8;
        const bf16_t* B0 = Bt + (size_t)(n0 + lr) * K + lh * 8; const bf16_t* B1 = B0 + (size_t)32 * K;
        f32x16 acc0, acc1;
#pragma unroll
        for (int r = 0; r < 16; ++r) { acc0[r] = 0.f; acc1[r] = 0.f; }
        for (int st = 0; st < steps; ++st) {
            const bf16x8 a = *(const bf16x8*)(Ab + 16 * st), b0 = *(const bf16x8*)(B0 + 16 * st), b1 = *(const bf16x8*)(B1 + 16 * st);
            acc0 = __builtin_amdgcn_mfma_f32_32x32x16_bf16(b0, a, acc0, 0, 0, 0);
            acc1 = __builtin_amdgcn_mfma_f32_32x32x16_bf16(b1, a, acc1, 0, 0, 0);
        }
#pragma unroll
        for (int r4 = 0; r4 < 4; ++r4) {
            f.vec4(r0 + lr, n0 + 8 * r4 + 4 * lh, (f32x4){acc0[4 * r4], acc0[4 * r4 + 1], acc0[4 * r4 + 2], acc0[4 * r4 + 3]});
            f.vec4(r0 + lr, n0 + 32 + 8 * r4 + 4 * lh, (f32x4){acc1[4 * r4], acc1[4 * r4 + 1], acc1[4 * r4 + 2], acc1[4 * r4 + 3]});
        }
    }
}

struct FRwkvIn {
    bf16_t *rb, *kb, *vb, *tw, *ta, *tv, *tg;
    __device__ __forceinline__ void vec8(int row, int col, f32x4 a, f32x4 b) const {
        if (col < 3072) { u32x4 w; w.x = pk_bf16(a[0], a[1]); w.y = pk_bf16(a[2], a[3]); w.z = pk_bf16(b[0], b[1]); w.w = pk_bf16(b[2], b[3]);
            *(u32x4*)(rb + (size_t)(col >> 10) * XR_STRIDE + (size_t)row * D + (col & 1023)) = w; }
        else { vec4(row, col, a); vec4(row, col + 4, b); } }
    __device__ __forceinline__ void vec4(int row, int col, f32x4 v) const {
        if (col < 3072) { st_bf4(rb + (size_t)(col >> 10) * XR_STRIDE + (size_t)row * D + (col & 1023), v); }
        else if (col < 3328) { const int c = col - 3072; if (c < 32) st_bf4(tv + (size_t)row * 32 + c, v); }
        else if (col < 3584) { const int c = col - 3328; if (c < 64) { f32x4 t = {ftanh(v[0]), ftanh(v[1]), ftanh(v[2]), ftanh(v[3])}; st_bf4(tw + (size_t)row * 64 + c, t); } }
        else if (col < 3840) { const int c = col - 3584; if (c < 64) st_bf4(ta + (size_t)row * 64 + c, v); }
        else { const int c = col - 3840; if (c < 160) { f32x4 t = {fsig(v[0]), fsig(v[1]), fsig(v[2]), fsig(v[3])}; st_bf4(tg + (size_t)row * 160 + c, t); } }
    }
};
struct FStoreF32 { float* C; int ldc; int ncols; __device__ __forceinline__ void vec4(int row, int col, f32x4 v) const { if (col < ncols) *(f32x4*)(C + (size_t)row * ldc + col) = v; } };
struct FStoreBf16 { bf16_t* C; int ldc; int ncols;
    __device__ __forceinline__ void vec4(int row, int col, f32x4 v) const { if (col < ncols) st_bf4(C + (size_t)row * ldc + col, v); }
    __device__ __forceinline__ void vec8(int row, int col, f32x4 a, f32x4 b) const { if (col < ncols) { u32x4 w; w.x = pk_bf16(a[0], a[1]); w.y = pk_bf16(a[2], a[3]); w.z = pk_bf16(b[0], b[1]); w.w = pk_bf16(b[2], b[3]); *(u32x4*)(C + (size_t)row * ldc + col) = w; } } };
struct FResid {
    float* X; const float* gate;
    const float* xin_p; const float* xin_s;
    __device__ __forceinline__ void vec4(int row, int col, f32x4 v) const {
        const f32x4 g = *(const f32x4*)(gate + (size_t)row_seq(row) * 6144 + col); float* xp = X + (size_t)row * D + col;
        const float* ip = xin_p ? (row < NP ? xin_p + (size_t)row * D + col : xin_s + (size_t)(row - NP) * D + col) : xp;
        const f32x4 x = *(const f32x4*)ip; *(f32x4*)xp = x + g * v; }
};
struct FRelu2 { bf16_t* U;
    __device__ __forceinline__ void vec8(int row, int col, f32x4 a, f32x4 b) const {
        f32x4 s, t; for (int e = 0; e < 4; ++e) { const float x = fmaxf(a[e], 0.f), y = fmaxf(b[e], 0.f); s[e] = x * x; t[e] = y * y; }
        u32x4 w; w.x = pk_bf16(s[0], s[1]); w.y = pk_bf16(s[2], s[3]); w.z = pk_bf16(t[0], t[1]); w.w = pk_bf16(t[2], t[3]); *(u32x4*)(U + (size_t)row * DFF + col) = w; }
    __device__ __forceinline__ void vec4(int row, int col, f32x4 v) const {
        f32x4 t; for (int e = 0; e < 4; ++e) { const float r = fmaxf(v[e], 0.f); t[e] = r * r; } st_bf4(U + (size_t)row * DFF + col, t); } };

__device__ __forceinline__ void phase_copy_x(KP p) {
    const size_t n4p = (size_t)NP * D / 4, n4 = (size_t)NT * D / 4;
    for (size_t i = (size_t)BID() * 512 + TID(); i < n4; i += (size_t)gridDim.x * 512)
        ((f32x4*)p->out)[i] = i < n4p ? ((const f32x4*)p->x_prompt)[i] : ((const f32x4*)p->x_sample)[i - n4p];
}

struct TJob { const float* src; bf16_t* dst; int K, N, drow0; };
__device__ __forceinline__ TJob tjob(KP p, int i) {
    TJob t; t.drow0 = 0;
    if (i < 4) { t.src = p->w_up + (size_t)i * D * DFF; t.dst = WSP(bf16_t, WS_WUP_T) + (size_t)i * DFF * D; t.K = D; t.N = DFF; return t; }
    if (i < 8) { const int l = i - 4; t.src = p->w_down + (size_t)l * DFF * D; t.dst = WSP(bf16_t, WS_WDN_T) + (size_t)l * DFF * D; t.K = DFF; t.N = D; return t; }
    i -= 8; const int j = i / 14, k = i % 14; bf16_t* wrw = WSP(bf16_t, WS_WRW_T) + (size_t)j * 4096 * D;
    t.K = D; t.N = D;
    switch (k) {
        case 0: case 1: case 2: t.src = p->rw_w_rkv + ((size_t)j * 3 + k) * D * D; t.dst = wrw; t.drow0 = k * 1024; break;
        case 3: t.src = p->rw_v1; t.dst = wrw; t.drow0 = 3072; t.N = j == 1 ? 32 : 0; break;
        case 4: t.src = p->rw_w1 + (size_t)j * D * 64; t.dst = wrw; t.drow0 = 3328; t.N = 64; break;
        case 5: t.src = p->rw_a1 + (size_t)j * D * 64; t.dst = wrw; t.drow0 = 3584; t.N = 64; break;
        case 6: t.src = p->rw_g1 + (size_t)j * D * 160; t.dst = wrw; t.drow0 = 3840; t.N = 160; break;
        case 7: t.src = p->rw_w_o + (size_t)j * D * D; t.dst = WSP(bf16_t, WS_WO_T) + (size_t)j * D * D; break;
        case 8: t.src = p->rw_w2 + (size_t)j * 64 * D; t.dst = WSP(bf16_t, WS_W2T) + (size_t)j * D * 64; t.K = 64; break;
        case 9: t.src = p->rw_a2 + (size_t)j * 64 * D; t.dst = WSP(bf16_t, WS_A2T) + (size_t)j * D * 64; t.K = 64; break;
        case 10: t.src = p->rw_g2 + (size_t)j * 160 * D; t.dst = WSP(bf16_t, WS_G2T) + (size_t)j * D * 160; t.K = 160; break;
        case 11: t.src = p->rw_v2; t.dst = WSP(bf16_t, WS_V2T); t.K = 32; t.N = j == 1 ? D : 0; break;
        case 12: t.src = p->att_w_in + (size_t)j * D * PIN; t.dst = WSP(bf16_t, WS_WIN_T) + (size_t)j * PINP * D; t.N = PIN; break;
        default: t.src = p->att_w_o + (size_t)j * D * D; t.dst = WSP(bf16_t, WS_WAO_T) + (size_t)j * D * D; break;
    }
    return t;
}
__device__ __forceinline__ int tjob_tiles(const TJob& t) { return ((t.K + 63) / 64) * ((t.N + 63) / 64); }
__device__ __forceinline__ void phase_weights(KP p, LAS unsigned char* lds) {
    LAS float* T = (LAS float*)lds;
    int total = 0;
    for (int i = 0; i < 36; ++i) total += tjob_tiles(tjob(p, i));
    const int ngrp = (total + 3) / 4;
    f32x4 v[4][2];
    bf16_t* dstn[4]; int Kn[4], nlim[4], klim[4];
#define WT_ISSUE(G_) do { const int tid_ = TID(), kk_ = tid_ >> 4, n4_ = (tid_ & 15) * 4; \
        int i_ = 0, start_ = 0, cnt_ = tjob_tiles(tjob(p, 0)); \
        _Pragma("unroll") for (int u = 0; u < 4; ++u) { const int gt_ = 4 * (G_) + u; \
            while (i_ < 35 && gt_ >= start_ + cnt_) { start_ += cnt_; ++i_; cnt_ = tjob_tiles(tjob(p, i_)); } \
            const TJob tj_ = tjob(p, i_); const int lt_ = gt_ - start_, nkt_ = (tj_.K + 63) / 64; \
            const bool dead_ = gt_ >= total || lt_ >= cnt_; const int k0_ = dead_ ? 0 : (lt_ % nkt_) * 64, n0_ = dead_ ? 0 : (lt_ / nkt_) * 64; \
            dstn[u] = tj_.dst + (size_t)(tj_.drow0 + n0_) * tj_.K + k0_; Kn[u] = tj_.K; nlim[u] = dead_ ? 0 : tj_.N - n0_; klim[u] = dead_ ? 0 : tj_.K - k0_; \
            _Pragma("unroll") for (int hh = 0; hh < 2; ++hh) { const int k_ = k0_ + kk_ + 32 * hh, n_ = n0_ + n4_; \
                v[u][hh] = *(const f32x4*)(tj_.src + (size_t)min(k_, tj_.K - 1) * tj_.N + min(n_, tj_.N - 4)); } } } while (0)
    if (BID() < ngrp) WT_ISSUE(BID());
    for (int g = BID(); g < ngrp; g += gridDim.x) {
        const int tid = TID(), kk = tid >> 4, n4 = (tid & 15) * 4;
#pragma unroll
        for (int u = 0; u < 4; ++u)
#pragma unroll
            for (int hh = 0; hh < 2; ++hh)
#pragma unroll
                for (int e = 0; e < 4; ++e) T[(u * 64 + kk + 32 * hh) * 65 + n4 + e] = v[u][hh][e];
        bf16_t* dstc[4]; int Kc[4], nl[4], kl[4];
#pragma unroll
        for (int u = 0; u < 4; ++u) { dstc[u] = dstn[u]; Kc[u] = Kn[u]; nl[u] = nlim[u]; kl[u] = klim[u]; }
        if (g + (int)gridDim.x < ngrp) WT_ISSUE(g + (int)gridDim.x);
        asm volatile("s_waitcnt lgkmcnt(0)" ::: "memory"); __builtin_amdgcn_s_barrier(); asm volatile("" ::: "memory");
        const int nn = tid >> 3, k8 = (tid & 7) * 8;
#pragma unroll
        for (int u = 0; u < 4; ++u) {
            if (nn < nl[u] && k8 < kl[u]) {
                u32x4 w;
                w.x = pk_bf16(T[(u * 64 + k8 + 0) * 65 + nn], T[(u * 64 + k8 + 1) * 65 + nn]); w.y = pk_bf16(T[(u * 64 + k8 + 2) * 65 + nn], T[(u * 64 + k8 + 3) * 65 + nn]);
                w.z = pk_bf16(T[(u * 64 + k8 + 4) * 65 + nn], T[(u * 64 + k8 + 5) * 65 + nn]); w.w = pk_bf16(T[(u * 64 + k8 + 6) * 65 + nn], T[(u * 64 + k8 + 7) * 65 + nn]);
                *(u32x4*)(dstc[u] + (size_t)nn * Kc[u] + k8) = w;
            }
        }
        asm volatile("s_waitcnt lgkmcnt(0)" ::: "memory"); __builtin_amdgcn_s_barrier(); asm volatile("" ::: "memory");
    }
#undef WT_ISSUE
    __syncthreads();
}

__device__ __forceinline__ void phase_ada(KP p, LAS unsigned char* lds) {
    float* mods = WSP(float, WS_MODS);
    LAS float* red = (LAS float*)lds;
    const int tid = TID(), lane = tid & 63, w = tid >> 6, ln = lane & 15, lq = lane >> 4;
    float af[3][32];
#pragma unroll
    for (int m = 0; m < 3; ++m) {
        const int s = 16 * m + ln; const bool ok = s < 36;
        const float* cp = s < 4 ? p->c_prompt + (size_t)s * D : p->c_sample + (size_t)((ok ? s : 35) - 4) * D;
#pragma unroll
        for (int i = 0; i < 32; ++i) { const float cv = cp[128 * w + 4 * i + lq]; af[m][i] = ok ? cv * __builtin_amdgcn_rcpf(1.0f + __expf(-cv)) : 0.f; }
    }
    f32x2 wv[32];
#define ADA_LOAD(B_) do { const int l_ = (B_) / 192, cb_ = ((B_) % 192) * 32; const float* wp_ = p->w_ada + ((size_t)l_ * D + 128 * w + lq) * 6144 + cb_ + 2 * ln; \
        _Pragma("unroll") for (int i = 0; i < 32; ++i) wv[i] = *(const f32x2*)(wp_ + (size_t)(4 * i) * 6144); } while (0)
    if (BID() < 768) ADA_LOAD(BID());
    for (int B = BID(); B < 768; B += gridDim.x) {
        const int l = B / 192, cb = (B % 192) * 32;
        f32x4 acc[3][2];
#pragma unroll
        for (int m = 0; m < 3; ++m) { acc[m][0] = (f32x4){0.f, 0.f, 0.f, 0.f}; acc[m][1] = acc[m][0]; }
#pragma unroll
        for (int i = 0; i < 32; ++i)
#pragma unroll
            for (int m = 0; m < 3; ++m) {
                acc[m][0] = __builtin_amdgcn_mfma_f32_16x16x4f32(af[m][i], wv[i][0], acc[m][0], 0, 0, 0);
                acc[m][1] = __builtin_amdgcn_mfma_f32_16x16x4f32(af[m][i], wv[i][1], acc[m][1], 0, 0, 0);
            }
        if (B + (int)gridDim.x < 768) ADA_LOAD(B + (int)gridDim.x);
#pragma unroll
        for (int m = 0; m < 3; ++m)
#pragma unroll
            for (int r = 0; r < 4; ++r) { const int s = 16 * m + 4 * lq + r;
                if (s < 36) *(LAS f32x2*)(red + (w * 36 + s) * 32 + 2 * ln) = (f32x2){acc[m][0][r], acc[m][1][r]}; }
        asm volatile("s_waitcnt lgkmcnt(0)" ::: "memory"); __builtin_amdgcn_s_barrier(); asm volatile("" ::: "memory");
        for (int o = tid; o < 36 * 32; o += 512) { const int s = o >> 5, cc = o & 31;
            float v = 0.f;
#pragma unroll
            for (int ww = 0; ww < 8; ++ww) v += red[(ww * 36 + s) * 32 + cc];
            mods[((size_t)l * 36 + s) * 6144 + cb + cc] = v + p->b_ada[l * 6144 + cb + cc]; }
        asm volatile("s_waitcnt lgkmcnt(0)" ::: "memory"); __builtin_amdgcn_s_barrier(); asm volatile("" ::: "memory");
    }
#undef ADA_LOAD
    __syncthreads();
}

template <bool MIX>
__device__ __forceinline__ void phase_prep(KP p, int layer, int which, int j, bool first = false) {
    const float* X = p->out;
    const float* mods = WSP(float, WS_MODS) + (size_t)layer * 36 * 6144;
    const float* g = p->norm_g + (layer * 2 + which) * D;
    bf16_t* XR = WSP(bf16_t, WS_XR);
    const int lane = TID() & 63, gw = BID() * 8 + (TID() >> 6), nw = gridDim.x * 8;
    for (int run = gw; run < NP / 8 + NS; run += nw) {
        const int row0 = run < NP / 8 ? run * 8 : NP + (run - NP / 8), nrows = run < NP / 8 ? 8 : 1, seq = row_seq(row0);
        const float* sh = mods + (size_t)seq * 6144 + (which ? 3 : 0) * D; const float* sc = sh + D;
        f32x4 gv[4], scv[4], shv[4], hp[4];
#pragma unroll
        for (int i = 0; i < 4; ++i) { const int col = 512 * (i >> 1) + 8 * lane + 4 * (i & 1); gv[i] = *(const f32x4*)(g + col); scv[i] = *(const f32x4*)(sc + col) + 1.0f; shv[i] = *(const f32x4*)(sh + col); hp[i] = (f32x4){0.f, 0.f, 0.f, 0.f}; }
        int rstart = 0;
        if (MIX) {
            if (row0 >= NP && ((row0 - NP) & 7) == 0) {
#pragma unroll
                for (int i = 0; i < 4; ++i) hp[i] = *(const f32x4*)(p->state_shift + ((size_t)j * 32 + (seq - 4)) * D + 512 * (i >> 1) + 8 * lane + 4 * (i & 1));
            } else if (row0 >= NP || (row0 & 4095) != 0) rstart = -1;
        }
        f32x4 xn[4];
#define PREP_LOAD(ROW_) do { const int row_ = (ROW_); const float* xr_ = first ? (row_ < NP ? p->x_prompt + (size_t)row_ * D : p->x_sample + (size_t)(row_ - NP) * D) : X + (size_t)row_ * D; \
            _Pragma("unroll") for (int i = 0; i < 4; ++i) xn[i] = *(const f32x4*)(xr_ + 512 * (i >> 1) + 8 * lane + 4 * (i & 1)); } while (0)
        PREP_LOAD(row0 + rstart);
        for (int r = rstart; r < nrows; ++r) {
            const int row = row0 + r;
            f32x4 x[4]; float ss = 0.f;
#pragma unroll
            for (int i = 0; i < 4; ++i) x[i] = xn[i];
            if (r + 1 < nrows) PREP_LOAD(row + 1);
#pragma unroll
            for (int i = 0; i < 4; ++i) ss += x[i][0] * x[i][0] + x[i][1] * x[i][1] + x[i][2] * x[i][2] + x[i][3] * x[i][3];
            ss = wave_sum(ss);
            const float rstd = rsqrtf(ss * (1.0f / 1024.0f) + 1e-6f);
            f32x4 h[4];
#pragma unroll
            for (int i = 0; i < 4; ++i) h[i] = x[i] * rstd * gv[i] * scv[i] + shv[i];
            if (MIX) {
                if (r >= 0) {
#pragma unroll
                    for (int n = 0; n < 6; ++n) {
                        const int mi = n == 0 ? 0 : (n == 1 ? 2 : (n == 2 ? 3 : (n == 3 ? 1 : n)));
                        const float* mx = p->rw_mix + ((size_t)j * 6 + mi) * D;
#pragma unroll
                        for (int i2 = 0; i2 < 2; ++i2) { const int col = 512 * i2 + 8 * lane; const f32x4 m0 = *(const f32x4*)(mx + col), m1 = *(const f32x4*)(mx + col + 4);
                            const f32x4 a = h[2 * i2] + (hp[2 * i2] - h[2 * i2]) * m0, b2 = h[2 * i2 + 1] + (hp[2 * i2 + 1] - h[2 * i2 + 1]) * m1;
                            u32x4 w; w.x = pk_bf16(a[0], a[1]); w.y = pk_bf16(a[2], a[3]); w.z = pk_bf16(b2[0], b2[1]); w.w = pk_bf16(b2[2], b2[3]);
                            *(u32x4*)(XR + (size_t)n * XR_STRIDE + (size_t)row * D + col) = w; }
                    }
                    const bool lastp = row < NP && (row & 4095) == 4095, lasts = row >= NP && ((row - NP) & 7) == 7;
                    if (lastp || lasts) {
                        float* so = lastp ? p->out + O_SHP + ((size_t)j * 4 + seq) * D : p->out + O_SHS + ((size_t)j * 32 + (seq - 4)) * D;
#pragma unroll
                        for (int i = 0; i < 4; ++i) *(f32x4*)(so + 512 * (i >> 1) + 8 * lane + 4 * (i & 1)) = h[i];
                    }
                }
#pragma unroll
                for (int i = 0; i < 4; ++i) hp[i] = h[i];
            } else {
#pragma unroll
                for (int i2 = 0; i2 < 2; ++i2) { const f32x4 a = h[2 * i2], b2 = h[2 * i2 + 1]; u32x4 w; w.x = pk_bf16(a[0], a[1]); w.y = pk_bf16(a[2], a[3]); w.z = pk_bf16(b2[0], b2[1]); w.w = pk_bf16(b2[2], b2[3]);
                    *(u32x4*)(XR + (size_t)row * D + 512 * i2 + 8 * lane) = w; }
            }
        }
    }
}

#undef PREP_LOAD
__device__ __forceinline__ void phase_scanprep(KP p, int j) {
    const bf16_t *KB = WSP(bf16_t, WS_KB), *VB = WSP(bf16_t, WS_VB);
    const float *WPp = WSP(float, WS_WP), *APp = WSP(float, WS_AP), *VPp = WSP(float, WS_VP);
    float *VF = WSP(float, WS_VFIRST), *DEC = WSP(float, WS_DEC), *KM = WSP(float, WS_KM), *VM = WSP(float, WS_VM), *AV = WSP(float, WS_AV), *BV = WSP(float, WS_BV);
    const int lane = TID() & 63, gw = BID() * 8 + (TID() >> 6), nw = gridDim.x * 8;
    for (int row = gw; row < NT; row += nw) {
#pragma unroll
        for (int i = 0; i < 4; ++i) {
            const int col = 256 * i + 4 * lane; const size_t o = (size_t)row * D + col;
            const f32x4 k = ld_bf4(KB + o), v = ld_bf4(VB + o), wp = *(const f32x4*)(WPp + o), ap = *(const f32x4*)(APp + o);
            const f32x4 w0 = *(const f32x4*)(p->rw_w0 + j * D + col), a0 = *(const f32x4*)(p->rw_a0 + j * D + col), kkw = *(const f32x4*)(p->rw_k_k + j * D + col), kaw = *(const f32x4*)(p->rw_k_a + j * D + col);
            f32x4 dec, a, vm, kk, km;
#pragma unroll
            for (int e = 0; e < 4; ++e) {
                const float wpre = w0[e] + wp[e], z = -wpre, sp = fmaxf(z, 0.f) + log1pf(expf(-fabsf(z)));
                dec[e] = expf(-expf(-sp - 0.5f));
                a[e] = sigmoidf_(a0[e] + ap[e]);
                kk[e] = k[e] * kkw[e];
                km[e] = k[e] * (1.0f + (a[e] - 1.0f) * kaw[e]);
            }
            if (j == 0) { vm = v; *(f32x4*)(VF + o) = v; }
            else { const f32x4 vf = *(const f32x4*)(VF + o), vp = *(const f32x4*)(VPp + o), v0 = *(const f32x4*)(p->rw_v0 + (j - 1) * D + col);
#pragma unroll
                for (int e = 0; e < 4; ++e) vm[e] = v[e] + (vf[e] - v[e]) * sigmoidf_(v0[e] + vp[e]); }
            float ss = kk[0] * kk[0] + kk[1] * kk[1] + kk[2] * kk[2] + kk[3] * kk[3];
            ss = g16_sum(ss);
            const float inv = rsqrtf(fmaxf(ss, 1e-24f));
            kk = kk * inv;
            *(f32x4*)(DEC + o) = dec; *(f32x4*)(KM + o) = km; *(f32x4*)(VM + o) = vm; *(f32x4*)(AV + o) = -kk; *(f32x4*)(BV + o) = kk * a;
        }
    }
}

__device__ __forceinline__ float rl(float v, int k) { return __int_as_float(__builtin_amdgcn_readlane(__float_as_int(v), k)); }
__device__ __forceinline__ void scan_run(KP p, size_t row_base, int nsteps, int colbase, float (&S)[64]) {
    const float *DEC = WSP(float, WS_DEC), *KM = WSP(float, WS_KM), *VM = WSP(float, WS_VM), *AV = WSP(float, WS_AV), *BV = WSP(float, WS_BV);
    const bf16_t* RB = WSP(bf16_t, WS_RB); float* Y = WSP(float, WS_Y);
    const int lane = TID() & 63;
    size_t o = row_base * D + colbase + lane;
    float w = DEC[o], kx = KM[o], v = VM[o], a = AV[o], b = BV[o], r = bf2f(RB[o]);
    for (int t = 0; t < nsteps; ++t) {
        const size_t on = (t + 1 < nsteps) ? o + D : o;
        const float wn = DEC[on], kn = KM[on], vn = VM[on], an = AV[on], bn = BV[on], rn = bf2f(RB[on]);
        float sa = 0.f;
#pragma unroll
        for (int k = 0; k < 64; ++k) sa += S[k] * rl(a, k);
#pragma unroll
        for (int k = 0; k < 64; ++k) S[k] = S[k] * rl(w, k) + sa * rl(b, k) + v * rl(kx, k);
        float y = 0.f;
#pragma unroll
        for (int k = 0; k < 64; ++k) y += S[k] * rl(r, k);
        Y[o] = y;
        o = on; w = wn; kx = kn; v = vn; a = an; b = bn; r = rn;
    }
}
__device__ __forceinline__ void phase_scanA(KP p) {
    const float *DEC = WSP(float, WS_DEC), *KM = WSP(float, WS_KM), *VM = WSP(float, WS_VM), *AV = WSP(float, WS_AV), *BV = WSP(float, WS_BV);
    float *PCH = WSP(float, WS_PCH), *CCH = WSP(float, WS_CCH);
    const int lane = TID() & 63, gw = BID() * 8 + (TID() >> 6), nw = gridDim.x * 8;
    for (int it = gw; it < 64 * NCH; it += nw) {
        const int sh = it / NCH, c = it % NCH, b = sh >> 4, h = sh & 15;
        float SP[64], SC[64];
#pragma unroll
        for (int k = 0; k < 64; ++k) { SP[k] = (k == lane) ? 1.f : 0.f; SC[k] = 0.f; }
        size_t o = ((size_t)b * 4096 + (size_t)c * LCH) * D + h * 64 + lane;
        float w = DEC[o], kx = KM[o], v = VM[o], a = AV[o], bb = BV[o];
        for (int t = 0; t < LCH; ++t) {
            const size_t on = (t + 1 < LCH) ? o + D : o;
            const float wn = DEC[on], kn = KM[on], vn = VM[on], an = AV[on], bn = BV[on];
            float saP = 0.f, saC = 0.f;
#pragma unroll
            for (int k = 0; k < 64; ++k) { const float ak = rl(a, k); saP += SP[k] * ak; saC += SC[k] * ak; }
#pragma unroll
            for (int k = 0; k < 64; ++k) { const float wk = rl(w, k), bk = rl(bb, k); SP[k] = SP[k] * wk + saP * bk; SC[k] = SC[k] * wk + saC * bk + v * rl(kx, k); }
            o = on; w = wn; kx = kn; v = vn; a = an; bb = bn;
        }
        float* po = PCH + ((size_t)it * 64 + lane) * 64; float* co = CCH + ((size_t)it * 64 + lane) * 64;
#pragma unroll
        for (int k = 0; k < 64; k += 4) { *(f32x4*)(po + k) = (f32x4){SP[k], SP[k + 1], SP[k + 2], SP[k + 3]}; *(f32x4*)(co + k) = (f32x4){SC[k], SC[k + 1], SC[k + 2], SC[k + 3]}; }
    }
}
__device__ __forceinline__ void phase_scanB(KP p, int j, LAS unsigned char* lds) {
    const int tid = TID(), lane = tid & 63, wave = tid >> 6;
    if (BID() < 32) {
        const float *PCH = WSP(float, WS_PCH), *CCH = WSP(float, WS_CCH); float* SST = WSP(float, WS_SST);
        const int sh = BID() * 2 + (wave >> 2), q = wave & 3, row0 = 32 * (q >> 1), col0 = 32 * (q & 1), b = sh >> 4, h = sh & 15;
        LAS float* Sl = (LAS float*)lds + (wave >> 2) * (2 * 64 * 65);
        const int lr = lane & 31, lh = lane >> 5;
        f32x16 acc;
#pragma unroll
        for (int r = 0; r < 16; ++r) acc[r] = 0.f;
        for (int c = 0; c <= NCH; ++c) {
            LAS float* Sw = Sl + (c & 1) * (64 * 65);
            float* go = c < NCH ? SST + ((size_t)sh * NCH + c) * 4096 : p->out + O_WKVP + (((size_t)j * 4 + b) * 16 + h) * 4096;
#pragma unroll
            for (int r = 0; r < 16; ++r) { const int row = row0 + (r & 3) + 8 * (r >> 2) + 4 * lh; Sw[row * 65 + col0 + lr] = acc[r]; go[row * 64 + col0 + lr] = acc[r]; }
            if (c == NCH) break;
            const float* Pc = PCH + ((size_t)sh * NCH + c) * 4096; const float* Cc = CCH + ((size_t)sh * NCH + c) * 4096;
            float bv[32];
#pragma unroll
            for (int kk = 0; kk < 32; ++kk) bv[kk] = Pc[(2 * kk + lh) * 64 + col0 + lr];
#pragma unroll
            for (int r = 0; r < 16; ++r) acc[r] = Cc[(row0 + (r & 3) + 8 * (r >> 2) + 4 * lh) * 64 + col0 + lr];
            __syncthreads();
#pragma unroll
            for (int kk = 0; kk < 32; ++kk) acc = __builtin_amdgcn_mfma_f32_32x32x2f32(Sw[(row0 + lr) * 65 + 2 * kk + lh], bv[kk], acc, 0, 0, 0);
        }
    } else {
        for (int it = (BID() - 32) * 8 + wave; it < 512; it += (gridDim.x - 32) * 8) {
            const int b = it >> 4, h = it & 15;
            const float* s0 = p->state_wkv + (((size_t)j * 32 + b) * 16 + h) * 4096 + lane * 64;
            float S[64];
#pragma unroll
            for (int k = 0; k < 64; k += 4) { const f32x4 t = *(const f32x4*)(s0 + k); S[k] = t[0]; S[k + 1] = t[1]; S[k + 2] = t[2]; S[k + 3] = t[3]; }
            scan_run(p, (size_t)NP + b * 8, 8, h * 64, S);
            float* o = p->out + O_WKVS + (((size_t)j * 32 + b) * 16 + h) * 4096 + lane * 64;
#pragma unroll
            for (int k = 0; k < 64; k += 4) *(f32x4*)(o + k) = (f32x4){S[k], S[k + 1], S[k + 2], S[k + 3]};
        }
    }
    __syncthreads();
}
__device__ __forceinline__ void phase_scanC(KP p) {
    const float* SST = WSP(float, WS_SST);
    const int lane = TID() & 63, gw = BID() * 8 + (TID() >> 6), nw = gridDim.x * 8;
    for (int it = gw; it < 64 * NCH; it += nw) {
        const int sh = it / NCH, c = it % NCH, b = sh >> 4, h = sh & 15;
        const float* s0 = SST + ((size_t)it * 64 + lane) * 64;
        float S[64];
#pragma unroll
        for (int k = 0; k < 64; k += 4) { const f32x4 t = *(const f32x4*)(s0 + k); S[k] = t[0]; S[k + 1] = t[1]; S[k + 2] = t[2]; S[k + 3] = t[3]; }
        scan_run(p, (size_t)b * 4096 + (size_t)c * LCH, LCH, h * 64, S);
    }
}


constexpr int CST = 72;
constexpr int CMAT = 64 * CST * 2;
constexpr int CH_F32 = 11 * CMAT, CH_PART = CH_F32 + 64 * 68 * 4, CH_GL = CH_PART + 64 * 4 * 4;
__device__ __forceinline__ bf16x8 cfrag(const LAS bf16_t* M, int row, int ks, int c4) { return *(const LAS bf16x8*)(M + row * CST + 32 * ks + 8 * c4); }
__device__ __forceinline__ f32x4 cmm(const LAS bf16_t* A, int arow, const LAS bf16_t* B, int brow, int c4, f32x4 acc) {
    acc = __builtin_amdgcn_mfma_f32_16x16x32_bf16(cfrag(A, arow, 0, c4), cfrag(B, brow, 0, c4), acc, 0, 0, 0);
    return __builtin_amdgcn_mfma_f32_16x16x32_bf16(cfrag(A, arow, 1, c4), cfrag(B, brow, 1, c4), acc, 0, 0, 0); }
__device__ __forceinline__ unsigned short f2bf(float x) { return (unsigned short)(pk_bf16(x, 0.f) & 0xffffu); }
__device__ __forceinline__ void st_t4(LAS bf16_t* Mt, int d, int t0, f32x4 v) { u32x2 w; w.x = pk_bf16(v[0], v[1]); w.y = pk_bf16(v[2], v[3]); *(LAS u32x2*)(Mt + d * CST + t0) = w; }

__device__ __forceinline__ void phase_chunk(KP p, int j, LAS unsigned char* lds) {
    LAS bf16_t* Mx = (LAS bf16_t*)lds;
#define CM(i) (Mx + (i) * (64 * CST))
    LAS float* F32 = (LAS float*)(lds + CH_F32);
    asm volatile("" : "+v"(F32));
    LAS float* part = (LAS float*)(lds + CH_PART);
    LAS float* gLs = (LAS float*)(lds + CH_GL);
    const bf16_t *RB = WSP(bf16_t, WS_RB), *KB = WSP(bf16_t, WS_KB), *VB = WSP(bf16_t, WS_VB), *TW = WSP(bf16_t, WS_TW), *TA_ = WSP(bf16_t, WS_TA), *TV = WSP(bf16_t, WS_TV);
    const bf16_t *W2T = WSP(bf16_t, WS_W2T) + (size_t)j * D * 64, *A2T = WSP(bf16_t, WS_A2T) + (size_t)j * D * 64, *V2T = WSP(bf16_t, WS_V2T);
    float* VF = WSP(float, WS_VFIRST); float *PCH = WSP(float, WS_PCH), *CCH = WSP(float, WS_CCH), *Y0 = WSP(float, WS_Y), *BON = WSP(float, WS_AV);
    bf16_t *GM = WSP(bf16_t, WS_DEC), *VM2 = WSP(bf16_t, WS_KM);
#define CH_BAR() do { asm volatile("s_waitcnt lgkmcnt(0)" ::: "memory"); __builtin_amdgcn_s_barrier(); asm volatile("" ::: "memory"); } while (0)
    bf16x8 f_aw[2], f_aa[2], f_av; unsigned short e_k[2][4], e_v[2][4], e_r[2][4];
    f_av = (bf16x8){0, 0, 0, 0, 0, 0, 0, 0};
#define CH_PREFETCH(itx) do { const int tid_ = TID(), lane_ = tid_ & 63, w_ = tid_ >> 6, n_ = lane_ & 15, c4_ = lane_ >> 4, tr_ = w_ >> 1, tcb_ = 2 * (w_ & 1); \
        const int sh_ = (itx) / NCH, c_ = (itx) % NCH, R0_ = (sh_ >> 4) * 4096 + c_ * LCH, hc_ = (sh_ & 15) * 64; const int ar_ = 16 * tr_ + n_; \
        _Pragma("unroll") for (int ks = 0; ks < 2; ++ks) { f_aw[ks] = *(const bf16x8*)(TW + (size_t)R0_ * 64 + ar_ * 64 + 32 * ks + 8 * c4_); f_aa[ks] = *(const bf16x8*)(TA_ + (size_t)R0_ * 64 + ar_ * 64 + 32 * ks + 8 * c4_); } \
        if (j == 1) f_av = *(const bf16x8*)(TV + (size_t)R0_ * 32 + ar_ * 32 + 8 * c4_); \
        _Pragma("unroll") for (int ti = 0; ti < 2; ++ti) _Pragma("unroll") for (int r = 0; r < 4; ++r) { const size_t o_ = (size_t)R0_ * D + hc_ + (16 * tr_ + 4 * c4_ + r) * D + 16 * (tcb_ + ti) + n_; \
            e_k[ti][r] = KB[o_]; e_v[ti][r] = VB[o_]; e_r[ti][r] = RB[o_]; } } while (0)
#define CH_MAP(q_) (((((q_) >> 4) & 3) * 16 + ((q_) & 15)) * NCH + ((q_) >> 6))
    if (BID() < 64 * NCH) CH_PREFETCH(CH_MAP(BID()));
    for (int q = BID(); q < 64 * NCH; q += gridDim.x) {
        const int it = CH_MAP(q);
        const int tid = TID(), lane = tid & 63, w = tid >> 6, n = lane & 15, c4 = lane >> 4, tr = w >> 1, tcb = 2 * (w & 1);
        const int sh = it / NCH, c = it % NCH, b = sh >> 4, h = sh & 15, R0 = b * 4096 + c * LCH, hc = h * 64;
        const bf16_t *KBb = KB + (size_t)R0 * D + hc, *VBb = VB + (size_t)R0 * D + hc, *RBb = RB + (size_t)R0 * D + hc;
        bf16_t* VFb = (bf16_t*)VF + (size_t)R0 * D + hc; bf16_t* VM2b = VM2 + (size_t)R0 * D + hc; bf16_t* GMb = GM + (size_t)R0 * D + hc; bf16_t* Y0b = (bf16_t*)Y0 + (size_t)R0 * D + hc;
        float* PCb = PCH + (size_t)it * 4096; float* CCb = CCH + (size_t)it * 4096; float* BONb = BON + (size_t)R0 * 16 + h;
        const bf16_t *TWb = TW + (size_t)R0 * 64, *TAb = TA_ + (size_t)R0 * 64, *TVb = TV + (size_t)R0 * 32, *W2b = W2T + (size_t)hc * 64, *A2b = A2T + (size_t)hc * 64, *V2b = V2T + (size_t)hc * 32;
        const float *w0b = p->rw_w0 + j * D + hc, *a0b = p->rw_a0 + j * D + hc, *kkb = p->rw_k_k + j * D + hc, *kab = p->rw_k_a + j * D + hc, *rkb = p->rw_r_k + j * D + hc, *v0b = p->rw_v0 + (j ? (j - 1) : 0) * D + hc;
        f32x4 wp[2], ap[2], vp[2];
#pragma unroll
        for (int ti = 0; ti < 2; ++ti) { wp[ti] = (f32x4){0.f, 0.f, 0.f, 0.f}; ap[ti] = wp[ti]; vp[ti] = wp[ti]; }
        {   const int ar = 16 * tr + n;
#pragma unroll
            for (int ks = 0; ks < 2; ++ks) {
                const bf16x8 aw = f_aw[ks], aa = f_aa[ks];
#pragma unroll
                for (int ti = 0; ti < 2; ++ti) { const int br = 16 * (tcb + ti) + n;
                    wp[ti] = __builtin_amdgcn_mfma_f32_16x16x32_bf16(aw, *(const bf16x8*)(W2b + br * 64 + 32 * ks + 8 * c4), wp[ti], 0, 0, 0);
                    ap[ti] = __builtin_amdgcn_mfma_f32_16x16x32_bf16(aa, *(const bf16x8*)(A2b + br * 64 + 32 * ks + 8 * c4), ap[ti], 0, 0, 0); }
            }
            if (j == 1) { const bf16x8 av = f_av;
#pragma unroll
                for (int ti = 0; ti < 2; ++ti) vp[ti] = __builtin_amdgcn_mfma_f32_16x16x32_bf16(av, *(const bf16x8*)(V2b + (16 * (tcb + ti) + n) * 32 + 8 * c4), vp[ti], 0, 0, 0); }
        }
        f32x4 lw[2], asg[2], kkv[2], kpr[2], vpr[2], rr[2];
        float ssq[4] = {0.f, 0.f, 0.f, 0.f}, bon[4] = {0.f, 0.f, 0.f, 0.f};
        float vf8[2][4];
#pragma unroll
        for (int ti = 0; ti < 2; ++ti)
#pragma unroll
            for (int r = 0; r < 4; ++r) vf8[ti][r] = 0.f;
        if (j == 1) {
#pragma unroll
            for (int ti = 0; ti < 2; ++ti)
#pragma unroll
                for (int r = 0; r < 4; ++r) vf8[ti][r] = bf2f(VFb[(16 * tr + 4 * c4 + r) * D + 16 * (tcb + ti) + n]);
        }
#pragma unroll
        for (int ti = 0; ti < 2; ++ti) {
            const int d = 16 * (tcb + ti) + n;
            const float w0 = w0b[d], a0 = a0b[d], kkw = kkb[d], kaw = kab[d], rkw = rkb[d];
            const float v0 = j ? v0b[d] : 0.f;
#pragma unroll
            for (int r = 0; r < 4; ++r) {
                const int o = (16 * tr + 4 * c4 + r) * D + d;
                const float kx = bf2f(e_k[ti][r]), vx = bf2f(e_v[ti][r]), rx = bf2f(e_r[ti][r]);
                const float z = -(w0 + wp[ti][r]), sp = fmaxf(z, 0.f) + __logf(1.0f + __expf(-fabsf(z)));
                lw[ti][r] = -__expf(-sp - 0.5f);
                const float a = fsig(a0 + ap[ti][r]);
                asg[ti][r] = a;
                float vv = vx;
                if (j == 0) VFb[o] = e_v[ti][r]; else { const float vf = vf8[ti][r]; vv = vx + (vf - vx) * fsig(v0 + vp[ti][r]); }
                vpr[ti][r] = vv; rr[ti][r] = rx;
                const float kk = kx * kkw; kkv[ti][r] = kk; ssq[r] += kk * kk;
                const float kp = kx * (1.0f + (a - 1.0f) * kaw); kpr[ti][r] = kp; bon[r] += rx * kp * rkw;
                F32[(16 * tr + 4 * c4 + r) * 68 + d] = lw[ti][r];
                VM2b[o] = f2bf(vv);
            }
        }
#pragma unroll
        for (int r = 0; r < 4; ++r) { ssq[r] = g16_sum(ssq[r]); bon[r] = g16_sum(bon[r]); }
        if (n == 0) {
#pragma unroll
            for (int r = 0; r < 4; ++r) { const int t = 16 * tr + 4 * c4 + r; part[(t * 2 + (w & 1)) * 2 + 0] = ssq[r]; part[(t * 2 + (w & 1)) * 2 + 1] = bon[r]; }
        }
        if (q + (int)gridDim.x < 64 * NCH) CH_PREFETCH(CH_MAP(q + (int)gridDim.x));
        CH_BAR();
        f32x4 cs[2];
#pragma unroll
        for (int ti = 0; ti < 2; ++ti) {
            f32x4 acc = {0.f, 0.f, 0.f, 0.f};
            for (int q = 0; q < 4 * (tr + 1); ++q) {
                const float av = (4 * q + c4 <= 16 * tr + n) ? 1.0f : 0.0f;
                acc = __builtin_amdgcn_mfma_f32_16x16x4f32(av, F32[(4 * q + c4) * 68 + 16 * (tcb + ti) + n], acc, 0, 0, 0);
            }
            cs[ti] = acc;
        }
        float inv[4];
#pragma unroll
        for (int r = 0; r < 4; ++r) { const int t = 16 * tr + 4 * c4 + r; inv[r] = rsqrtf(fmaxf(part[(t * 2 + 0) * 2] + part[(t * 2 + 1) * 2], 1e-24f));
            if (n == 0 && (w & 1) == 0) BONb[t * 16] = part[(t * 2 + 0) * 2 + 1] + part[(t * 2 + 1) * 2 + 1]; }
        f32x4 rt[2];
#pragma unroll
        for (int ti = 0; ti < 2; ++ti) {
            const int d = 16 * (tcb + ti) + n, t0 = 16 * tr + 4 * c4;
            f32x4 at, bt, kt;
#pragma unroll
            for (int r = 0; r < 4; ++r) {
                const float g = __expf(cs[ti][r]), gi = __expf(-cs[ti][r]), gm = __expf(cs[ti][r] - lw[ti][r]);
                const float kk = kkv[ti][r] * inv[r];
                at[r] = -kk * gm; bt[r] = kk * asg[ti][r] * gi; kt[r] = kpr[ti][r] * gi; rt[ti][r] = rr[ti][r] * g;
                CM(0)[(t0 + r) * CST + d] = f2bf(at[r]); CM(1)[(t0 + r) * CST + d] = f2bf(bt[r]); CM(2)[(t0 + r) * CST + d] = f2bf(kt[r]); CM(3)[(t0 + r) * CST + d] = f2bf(rt[ti][r]);
                if (t0 + r == 63) gLs[d] = g;
            }
            st_t4(CM(4), d, t0, at); st_t4(CM(5), d, t0, bt); st_t4(CM(6), d, t0, kt); st_t4(CM(7), d, t0, vpr[ti]);
        }
        CH_BAR();
#pragma unroll
        for (int ti = 0; ti < 2; ++ti) {
            const int tc = tcb + ti, s = 16 * tc + n, t0 = 16 * tr + 4 * c4;
            if (tc <= tr) {
                { f32x4 m = {0.f, 0.f, 0.f, 0.f}; m = cmm(CM(0), 16 * tr + n, CM(1), 16 * tc + n, c4, m);
#pragma unroll
                  for (int r = 0; r < 4; ++r) F32[(t0 + r) * 68 + s] = (s < t0 + r) ? m[r] : 0.f; }
                asm volatile("" ::: "memory");
                { f32x4 m = {0.f, 0.f, 0.f, 0.f}; m = cmm(CM(0), 16 * tr + n, CM(2), 16 * tc + n, c4, m);
#pragma unroll
                  for (int r = 0; r < 4; ++r) CM(8)[(t0 + r) * CST + s] = f2bf((s < t0 + r) ? m[r] : 0.f); }
                asm volatile("" ::: "memory");
                { f32x4 m = {0.f, 0.f, 0.f, 0.f}; m = cmm(CM(3), 16 * tr + n, CM(1), 16 * tc + n, c4, m);
#pragma unroll
                  for (int r = 0; r < 4; ++r) CM(9)[(t0 + r) * CST + s] = f2bf((s <= t0 + r) ? m[r] : 0.f); }
                asm volatile("" ::: "memory");
                { f32x4 m = {0.f, 0.f, 0.f, 0.f}; m = cmm(CM(3), 16 * tr + n, CM(2), 16 * tc + n, c4, m);
#pragma unroll
                  for (int r = 0; r < 4; ++r) CM(10)[(t0 + r) * CST + s] = f2bf((s <= t0 + r) ? m[r] : 0.f); }
                asm volatile("" ::: "memory");
            } else {
#pragma unroll
                for (int r = 0; r < 4; ++r) { F32[(t0 + r) * 68 + s] = 0.f; CM(8)[(t0 + r) * CST + s] = 0; CM(9)[(t0 + r) * CST + s] = 0; CM(10)[(t0 + r) * CST + s] = 0; }
            }
        }
        CH_BAR();
        { const int e0 = tid * 8;
#pragma unroll
          for (int e = 0; e < 8; ++e) { const int t = (e0 + e) >> 6, s_ = (e0 + e) & 63; CM(2)[t * CST + s_] = f2bf(F32[t * 68 + s_]); }
          unsigned z_ = 0u; asm volatile("" : "+v"(z_));
          *(LAS u32x4*)(CM(0) + (e0 >> 6) * CST + (e0 & 63)) = (u32x4){z_, z_, z_, z_}; }
        CH_BAR();
        if (w < 4) {
            const int cw = 16 * w;
            LAS float* scr = (LAS float*)CM(1) + w * (16 * 17);
#pragma unroll 1
            for (int I = 0; I < 4; ++I) {
                f32x4 rh = {0.f, 0.f, 0.f, 0.f};
                if (I > 0) { rh = __builtin_amdgcn_mfma_f32_16x16x32_bf16(cfrag(CM(2), 16 * I + n, 0, c4), cfrag(CM(0), cw + n, 0, c4), rh, 0, 0, 0);
                    if (I > 2) rh = __builtin_amdgcn_mfma_f32_16x16x32_bf16(cfrag(CM(2), 16 * I + n, 1, c4), cfrag(CM(0), cw + n, 1, c4), rh, 0, 0, 0); }
#pragma unroll
                for (int r = 0; r < 4; ++r) scr[(4 * c4 + r) * 17 + n] = rh[r] + ((16 * I + 4 * c4 + r) == (cw + n) ? 1.f : 0.f);
                wave_lds_fence();
                float x[16];
#pragma unroll
                for (int i = 0; i < 16; ++i) x[i] = scr[i * 17 + n];
                f32x4 mc[4], mn[4];
                mc[0] = *(const LAS f32x4*)(F32 + (16 * I + 1) * 68 + 16 * I);
#pragma unroll
                for (int i = 1; i < 16; ++i) {
                    if (i + 1 < 16) {
#pragma unroll
                        for (int j4 = 0; j4 < (i + 4) / 4; ++j4) mn[j4] = *(const LAS f32x4*)(F32 + (16 * I + i + 1) * 68 + 16 * I + 4 * j4);
                    }
                    float a0 = 0.f, a1 = 0.f;
#pragma unroll
                    for (int j4 = 0; j4 < (i + 3) / 4; ++j4) {
                        if (4 * j4 + 0 < i) a0 += mc[j4][0] * x[4 * j4 + 0];
                        if (4 * j4 + 1 < i) a1 += mc[j4][1] * x[4 * j4 + 1];
                        if (4 * j4 + 2 < i) a0 += mc[j4][2] * x[4 * j4 + 2];
                        if (4 * j4 + 3 < i) a1 += mc[j4][3] * x[4 * j4 + 3];
                    }
                    x[i] += a0 + a1;
#pragma unroll
                    for (int j4 = 0; j4 < 4; ++j4) mc[j4] = mn[j4];
                    asm volatile("" ::: "memory");
                }
                if (c4 == 0) {
#pragma unroll
                    for (int i = 0; i < 16; ++i) CM(3)[(16 * I + i) * CST + cw + n] = f2bf(x[i]);
                    u32x4 t0, t1;
                    t0.x = pk_bf16(x[0], x[1]); t0.y = pk_bf16(x[2], x[3]); t0.z = pk_bf16(x[4], x[5]); t0.w = pk_bf16(x[6], x[7]);
                    t1.x = pk_bf16(x[8], x[9]); t1.y = pk_bf16(x[10], x[11]); t1.z = pk_bf16(x[12], x[13]); t1.w = pk_bf16(x[14], x[15]);
                    *(LAS u32x4*)(CM(0) + (cw + n) * CST + 16 * I) = t0; *(LAS u32x4*)(CM(0) + (cw + n) * CST + 16 * I + 8) = t1;
                }
                wave_lds_fence();
            }
        }
        CH_BAR();
#pragma unroll
        for (int ti = 0; ti < 2; ++ti) {
            const int d = 16 * (tcb + ti) + n;
            { f32x4 x1 = {0.f, 0.f, 0.f, 0.f}; x1 = cmm(CM(8), 16 * tr + n, CM(7), 16 * (tcb + ti) + n, c4, x1); st_t4(CM(0), d, 16 * tr + 4 * c4, x1); }
            asm volatile("" ::: "memory");
            { f32x4 ta = {0.f, 0.f, 0.f, 0.f}; ta = cmm(CM(3), 16 * tr + n, CM(4), 16 * (tcb + ti) + n, c4, ta); st_t4(CM(1), d, 16 * tr + 4 * c4, ta); }
            asm volatile("" ::: "memory");
        }
        CH_BAR();
#pragma unroll
        for (int ti = 0; ti < 2; ++ti) {
            f32x4 uv = {0.f, 0.f, 0.f, 0.f};
            uv = cmm(CM(3), 16 * tr + n, CM(0), 16 * (tcb + ti) + n, c4, uv);
            st_t4(CM(2), 16 * (tcb + ti) + n, 16 * tr + 4 * c4, uv);
        }
        CH_BAR();
#pragma unroll
        for (int ti = 0; ti < 2; ++ti) {
            const int cc = 16 * (tcb + ti) + n, r0 = 16 * tr + 4 * c4;
            const float gl = gLs[cc];
            { f32x4 pm = {0.f, 0.f, 0.f, 0.f}; pm = cmm(CM(1), 16 * tr + n, CM(5), cc, c4, pm);
#pragma unroll
              for (int r = 0; r < 4; ++r) PCb[(r0 + r) * 64 + cc] = (pm[r] + ((r0 + r) == cc ? 1.f : 0.f)) * gl; }
            asm volatile("" ::: "memory");
            { f32x4 cm_ = {0.f, 0.f, 0.f, 0.f}; cm_ = cmm(CM(2), 16 * tr + n, CM(5), cc, c4, cm_); cm_ = cmm(CM(7), 16 * tr + n, CM(6), cc, c4, cm_);
#pragma unroll
              for (int r = 0; r < 4; ++r) CCb[(r0 + r) * 64 + cc] = cm_[r] * gl; }
            asm volatile("" ::: "memory");
            { f32x4 gg = {0.f, 0.f, 0.f, 0.f}; gg = cmm(CM(9), 16 * tr + n, CM(1), cc, c4, gg);
#pragma unroll
              for (int r = 0; r < 4; ++r) GMb[(r0 + r) * D + cc] = f2bf(gg[r] + rt[ti][r]); }
            asm volatile("" ::: "memory");
            { f32x4 y0 = {0.f, 0.f, 0.f, 0.f}; y0 = cmm(CM(9), 16 * tr + n, CM(2), cc, c4, y0); y0 = cmm(CM(10), 16 * tr + n, CM(7), cc, c4, y0);
#pragma unroll
              for (int r = 0; r < 4; ++r) Y0b[(r0 + r) * D + cc] = f2bf(y0[r]); }
            asm volatile("" ::: "memory");
        }
        CH_BAR();
    }
#undef CM
#undef CH_PREFETCH
#undef CH_BAR
}

__device__ __forceinline__ void phase_sample_mixer_w(KP p, int j, int first, int stride) {
    const int tid = TID(), lane = tid & 63;
    {
        const bf16_t *RB = WSP(bf16_t, WS_RB), *KB = WSP(bf16_t, WS_KB), *VB = WSP(bf16_t, WS_VB); bf16_t* YG = WSP(bf16_t, WS_YG);
        const float *WPp = WSP(float, WS_WP), *APp = WSP(float, WS_AP), *VPp = WSP(float, WS_VP), *GG = WSP(float, WS_GG); float* VF = WSP(float, WS_VFIRST);
        for (int it = first; it < 512; it += stride) {
            const int b = it >> 4, h = it & 15, col = h * 64 + lane;
            const float* s0 = p->state_wkv + (((size_t)j * 32 + b) * 16 + h) * 4096 + lane * 64;
            float S[64];
#pragma unroll
            for (int k = 0; k < 64; k += 4) { const f32x4 t = *(const f32x4*)(s0 + k); S[k] = t[0]; S[k + 1] = t[1]; S[k + 2] = t[2]; S[k + 3] = t[3]; }
            const float w0 = p->rw_w0[j * D + col], a0 = p->rw_a0[j * D + col], kkw = p->rw_k_k[j * D + col], kaw = p->rw_k_a[j * D + col], rkw = p->rw_r_k[j * D + col];
            const float v0 = j ? p->rw_v0[(j - 1) * D + col] : 0.f, lnw = p->rw_lnx_w[j * D + col], lnb = p->rw_lnx_b[j * D + col];
            for (int t = 0; t < 8; ++t) {
                const size_t o = (size_t)(NP + b * 8 + t) * D + col;
                const float kx = bf2f(KB[o]), vx = bf2f(VB[o]), r = bf2f(RB[o]);
                const float z = -(w0 + WPp[o]), sp = fmaxf(z, 0.f) + log1pf(expf(-fabsf(z)));
                const float wd = expf(-expf(-sp - 0.5f)), asg = sigmoidf_(a0 + APp[o]);
                float v = vx;
                if (j == 0) VF[o] = vx; else { const float vf = VF[o]; v = vx + (vf - vx) * sigmoidf_(v0 + VPp[o]); }
                float kk = kx * kkw; const float ss = wave_sum(kk * kk); kk *= rsqrtf(fmaxf(ss, 1e-24f));
                const float kp = kx * (1.0f + (asg - 1.0f) * kaw), a = -kk, bq = kk * asg;
                float sa = 0.f;
#pragma unroll
                for (int k = 0; k < 64; ++k) sa += S[k] * rl(a, k);
#pragma unroll
                for (int k = 0; k < 64; ++k) S[k] = S[k] * rl(wd, k) + sa * rl(bq, k) + v * rl(kp, k);
                float y = 0.f;
#pragma unroll
                for (int k = 0; k < 64; ++k) y += S[k] * rl(r, k);
                const float mu = wave_sum(y) * (1.0f / 64.0f), dy = y - mu, var = wave_sum(dy * dy) * (1.0f / 64.0f);
                const float bonus = wave_sum(r * kp * rkw);
                YG[o] = f2bf((dy * rsqrtf(var + 64e-5f) * lnw + lnb + bonus * v) * GG[o]);
            }
            float* so = p->out + O_WKVS + (((size_t)j * 32 + b) * 16 + h) * 4096 + lane * 64;
#pragma unroll
            for (int k = 0; k < 64; k += 4) *(f32x4*)(so + k) = (f32x4){S[k], S[k + 1], S[k + 2], S[k + 3]};
        }
    }
}
__device__ __forceinline__ void phase_carry(KP p, int j, LAS unsigned char* lds) {
    const float *PCH = WSP(float, WS_PCH), *CCH = WSP(float, WS_CCH); float* SST = WSP(float, WS_SST);
    LAS float* Sl = (LAS float*)lds;
    LAS unsigned* cflag = (LAS unsigned*)(lds + 9216);
    if (TID() == 0) *cflag = 0u;
    __syncthreads();
    unsigned arrivals = 0u;
    if ((TID() >> 6) >= 4) { phase_sample_mixer_w(p, j, BID() * 4 + ((TID() >> 6) - 4), (int)gridDim.x * 4); }
    else
    for (int it = BID(); it < 256; it += gridDim.x) {
        const int wave = TID() >> 6, sh = it >> 2, row0 = 16 * (it & 3), col0 = 16 * (wave & 3), b = sh >> 4, h = sh & 15;
        const bool act = true;
        f32x4 acc = {0.f, 0.f, 0.f, 0.f}, c0, c1, c2;
        float b0[16], b1[16], b2[16];
#define CARRY_LOAD(BX, CX, cc_) do { const int l_ = TID() & 63, ln = l_ & 15, lq = l_ >> 4; \
            const float* Pc = PCH + ((size_t)sh * NCH + (cc_)) * 4096; const float* Cc = CCH + ((size_t)sh * NCH + (cc_)) * 4096; \
            _Pragma("unroll") for (int q = 0; q < 16; ++q) BX[q] = Pc[(4 * q + lq) * 64 + col0 + ln]; \
            _Pragma("unroll") for (int r = 0; r < 4; ++r) CX[r] = Cc[(row0 + 4 * lq + r) * 64 + col0 + ln]; } while (0)
#define CARRY_STEP(BX, CX, BL, CL, c_) do { const int l_ = TID() & 63, ln = l_ & 15, lq = l_ >> 4; \
            LAS float* Sw = Sl + ((c_) & 1) * (16 * 68); bf16_t* go = (bf16_t*)SST + ((size_t)sh * NCH + (c_)) * 4096; \
            if (act) { _Pragma("unroll") for (int r = 0; r < 4; ++r) Sw[(4 * lq + r) * 68 + col0 + ln] = acc[r]; } \
            const f32x4 sc = acc; acc = CX; \
            asm volatile("s_waitcnt lgkmcnt(0)" ::: "memory"); arrivals += 4u; \
            if ((TID() & 63) == 0) __hip_atomic_fetch_add(cflag, 1u, __ATOMIC_RELAXED, __HIP_MEMORY_SCOPE_WORKGROUP); \
            { unsigned sp_ = 0; while (__builtin_amdgcn_readfirstlane(__hip_atomic_load(cflag, __ATOMIC_RELAXED, __HIP_MEMORY_SCOPE_WORKGROUP)) < arrivals && ++sp_ < (1u << 22)) __builtin_amdgcn_s_sleep(0); } \
            asm volatile("" ::: "memory"); \
            if (act) { \
                _Pragma("unroll") for (int r = 0; r < 4; ++r) go[(row0 + 4 * lq + r) * 64 + col0 + ln] = f2bf(sc[r]); \
                if ((c_) + 2 < NCH) CARRY_LOAD(BL, CL, (c_) + 2); \
                float av[16]; _Pragma("unroll") for (int q = 0; q < 16; ++q) av[q] = Sw[ln * 68 + 4 * q + lq]; \
                asm volatile("s_waitcnt lgkmcnt(0)" ::: "memory"); \
                _Pragma("unroll") for (int q = 0; q < 16; ++q) acc = __builtin_amdgcn_mfma_f32_16x16x4f32(av[q], BX[q], acc, 0, 0, 0); } } while (0)
        if (act) { CARRY_LOAD(b0, c0, 0); CARRY_LOAD(b1, c1, 1); }
        for (int c = 0; c < NCH; c += 3) {
            CARRY_STEP(b0, c0, b2, c2, c);
            if (c + 1 < NCH) CARRY_STEP(b1, c1, b0, c0, c + 1);
            if (c + 2 < NCH) CARRY_STEP(b2, c2, b1, c1, c + 2);
        }
        if (act) { const int l_ = TID() & 63, ln = l_ & 15, lq = l_ >> 4; float* go = p->out + O_WKVP + (((size_t)j * 4 + b) * 16 + h) * 4096;
#pragma unroll
            for (int r = 0; r < 4; ++r) go[(row0 + 4 * lq + r) * 64 + col0 + ln] = acc[r]; }
#undef CARRY_LOAD
#undef CARRY_STEP
    }
    __syncthreads();
}
__device__ __forceinline__ void phase_sample_mixer(KP p, int j) {
    const int tid = TID(), lane = tid & 63, wave = tid >> 6;
    {
        const bf16_t *RB = WSP(bf16_t, WS_RB), *KB = WSP(bf16_t, WS_KB), *VB = WSP(bf16_t, WS_VB); bf16_t* YG = WSP(bf16_t, WS_YG);
        const float *WPp = WSP(float, WS_WP), *APp = WSP(float, WS_AP), *VPp = WSP(float, WS_VP), *GG = WSP(float, WS_GG); float* VF = WSP(float, WS_VFIRST);
        for (int it = BID() * 8 + wave; it < 512; it += gridDim.x * 8) {
            const int b = it >> 4, h = it & 15, col = h * 64 + lane;
            const float* s0 = p->state_wkv + (((size_t)j * 32 + b) * 16 + h) * 4096 + lane * 64;
            float S[64];
#pragma unroll
            for (int k = 0; k < 64; k += 4) { const f32x4 t = *(const f32x4*)(s0 + k); S[k] = t[0]; S[k + 1] = t[1]; S[k + 2] = t[2]; S[k + 3] = t[3]; }
            const float w0 = p->rw_w0[j * D + col], a0 = p->rw_a0[j * D + col], kkw = p->rw_k_k[j * D + col], kaw = p->rw_k_a[j * D + col], rkw = p->rw_r_k[j * D + col];
            const float v0 = j ? p->rw_v0[(j - 1) * D + col] : 0.f, lnw = p->rw_lnx_w[j * D + col], lnb = p->rw_lnx_b[j * D + col];
            for (int t = 0; t < 8; ++t) {
                const size_t o = (size_t)(NP + b * 8 + t) * D + col;
                const float kx = bf2f(KB[o]), vx = bf2f(VB[o]), r = bf2f(RB[o]);
                const float z = -(w0 + WPp[o]), sp = fmaxf(z, 0.f) + log1pf(expf(-fabsf(z)));
                const float wd = expf(-expf(-sp - 0.5f)), asg = sigmoidf_(a0 + APp[o]);
                float v = vx;
                if (j == 0) VF[o] = vx; else { const float vf = VF[o]; v = vx + (vf - vx) * sigmoidf_(v0 + VPp[o]); }
                float kk = kx * kkw; const float ss = wave_sum(kk * kk); kk *= rsqrtf(fmaxf(ss, 1e-24f));
                const float kp = kx * (1.0f + (asg - 1.0f) * kaw), a = -kk, bq = kk * asg;
                float sa = 0.f;
#pragma unroll
                for (int k = 0; k < 64; ++k) sa += S[k] * rl(a, k);
#pragma unroll
                for (int k = 0; k < 64; ++k) S[k] = S[k] * rl(wd, k) + sa * rl(bq, k) + v * rl(kp, k);
                float y = 0.f;
#pragma unroll
                for (int k = 0; k < 64; ++k) y += S[k] * rl(r, k);
                const float mu = wave_sum(y) * (1.0f / 64.0f), dy = y - mu, var = wave_sum(dy * dy) * (1.0f / 64.0f);
                const float bonus = wave_sum(r * kp * rkw);
                YG[o] = f2bf((dy * rsqrtf(var + 64e-5f) * lnw + lnb + bonus * v) * GG[o]);
            }
            float* so = p->out + O_WKVS + (((size_t)j * 32 + b) * 16 + h) * 4096 + lane * 64;
#pragma unroll
            for (int k = 0; k < 64; k += 4) *(f32x4*)(so + k) = (f32x4){S[k], S[k + 1], S[k + 2], S[k + 3]};
        }
    }
}
__device__ __forceinline__ void phase_post2(KP p, int j, LAS unsigned char* lds) {
    LAS float* part = (LAS float*)lds;
    const bf16_t *GM = WSP(bf16_t, WS_DEC), *VM2 = WSP(bf16_t, WS_KM), *TG = WSP(bf16_t, WS_TG), *G2T = WSP(bf16_t, WS_G2T) + (size_t)j * D * 160;
    const float *Y0 = WSP(float, WS_Y), *BON = WSP(float, WS_AV), *SST = WSP(float, WS_SST); bf16_t* YG = WSP(bf16_t, WS_YG);
    for (int it = BID(); it < 64 * NCH; it += gridDim.x) {
        const int tid = TID(), lane = tid & 63, w = tid >> 6, n = lane & 15, c4 = lane >> 4, tr = w >> 1, tcb = 2 * (w & 1);
        const int sh = it / NCH, c = it % NCH, b = sh >> 4, h = sh & 15, R0 = b * 4096 + c * LCH, hc = h * 64;
        f32x4 y[2], g[2];
        const size_t ar = (size_t)(R0 + 16 * tr + n);
#pragma unroll
        for (int ti = 0; ti < 2; ++ti) {
            const int dv = 16 * (tcb + ti) + n;
            f32x4 acc = {0.f, 0.f, 0.f, 0.f}, gacc = acc;
#pragma unroll
            for (int ks = 0; ks < 2; ++ks) {
                const bf16x8 af = *(const bf16x8*)(GM + ar * D + hc + 32 * ks + 8 * c4);
                const bf16x8 bw = *(const bf16x8*)((const bf16_t*)SST + ((size_t)it * 64 + dv) * 64 + 32 * ks + 8 * c4);
                acc = __builtin_amdgcn_mfma_f32_16x16x32_bf16(af, bw, acc, 0, 0, 0);
            }
#pragma unroll
            for (int ks = 0; ks < 5; ++ks)
                gacc = __builtin_amdgcn_mfma_f32_16x16x32_bf16(*(const bf16x8*)(TG + ar * 160 + 32 * ks + 8 * c4), *(const bf16x8*)(G2T + (size_t)(hc + dv) * 160 + 32 * ks + 8 * c4), gacc, 0, 0, 0);
#pragma unroll
            for (int r = 0; r < 4; ++r) acc[r] += bf2f(((const bf16_t*)Y0)[(size_t)(R0 + 16 * tr + 4 * c4 + r) * D + hc + dv]);
            y[ti] = acc; g[ti] = gacc;
        }
        float bonus4[4]; unsigned short vm4[2][4]; float lnw2[2], lnb2[2];
#pragma unroll
        for (int r = 0; r < 4; ++r) bonus4[r] = BON[(size_t)(R0 + 16 * tr + 4 * c4 + r) * 16 + h];
#pragma unroll
        for (int ti = 0; ti < 2; ++ti) { const int col = hc + 16 * (tcb + ti) + n; lnw2[ti] = p->rw_lnx_w[j * D + col]; lnb2[ti] = p->rw_lnx_b[j * D + col];
#pragma unroll
            for (int r = 0; r < 4; ++r) vm4[ti][r] = VM2[(size_t)(R0 + 16 * tr + 4 * c4 + r) * D + col]; }
        float s1[4], s2[4];
#pragma unroll
        for (int r = 0; r < 4; ++r) { s1[r] = g16_sum(y[0][r] + y[1][r]); s2[r] = g16_sum(y[0][r] * y[0][r] + y[1][r] * y[1][r]); }
        asm volatile("s_waitcnt lgkmcnt(0)" ::: "memory"); __builtin_amdgcn_s_barrier(); asm volatile("" ::: "memory");
        if (n == 0) {
#pragma unroll
            for (int r = 0; r < 4; ++r) { const int t = 16 * tr + 4 * c4 + r; part[(t * 2 + (w & 1)) * 2 + 0] = s1[r]; part[(t * 2 + (w & 1)) * 2 + 1] = s2[r]; }
        }
        asm volatile("s_waitcnt lgkmcnt(0)" ::: "memory"); __builtin_amdgcn_s_barrier(); asm volatile("" ::: "memory");
#pragma unroll
        for (int r = 0; r < 4; ++r) {
            const int t = 16 * tr + 4 * c4 + r;
            const float mu = (part[(t * 2 + 0) * 2] + part[(t * 2 + 1) * 2]) * (1.0f / 64.0f), ex2 = (part[(t * 2 + 0) * 2 + 1] + part[(t * 2 + 1) * 2 + 1]) * (1.0f / 64.0f);
            const float rs = rsqrtf(fmaxf(ex2 - mu * mu, 0.f) + 64e-5f), bonus = bonus4[r];
#pragma unroll
            for (int ti = 0; ti < 2; ++ti) {
                const int col = hc + 16 * (tcb + ti) + n; const size_t o = (size_t)(R0 + t) * D + col;
                YG[o] = f2bf(((y[ti][r] - mu) * rs * lnw2[ti] + lnb2[ti] + bonus * bf2f(vm4[ti][r])) * g[ti][r]);
            }
        }
    }
    __syncthreads();
}

__device__ __forceinline__ void phase_post(KP p, int j) {
    const float *Y = WSP(float, WS_Y), *KM = WSP(float, WS_KM), *VM = WSP(float, WS_VM), *GG = WSP(float, WS_GG);
    const bf16_t* RB = WSP(bf16_t, WS_RB); bf16_t* YG = WSP(bf16_t, WS_YG);
    const int lane = TID() & 63, gw = BID() * 8 + (TID() >> 6), nw = gridDim.x * 8;
    for (int row = gw; row < NT; row += nw) {
#pragma unroll
        for (int i = 0; i < 4; ++i) {
            const int col = 256 * i + 4 * lane; const size_t o = (size_t)row * D + col;
            const f32x4 y = *(const f32x4*)(Y + o), r = ld_bf4(RB + o), km = *(const f32x4*)(KM + o), vm = *(const f32x4*)(VM + o), gg = *(const f32x4*)(GG + o);
            const f32x4 lw = *(const f32x4*)(p->rw_lnx_w + j * D + col), lb = *(const f32x4*)(p->rw_lnx_b + j * D + col), rk = *(const f32x4*)(p->rw_r_k + j * D + col);
            const float mu = g16_sum(y[0] + y[1] + y[2] + y[3]) * (1.0f / 64.0f);
            const f32x4 d = y - mu;
            const float var = g16_sum(d[0] * d[0] + d[1] * d[1] + d[2] * d[2] + d[3] * d[3]) * (1.0f / 64.0f);
            const float rs = rsqrtf(var + 64e-5f);
            const float bon = g16_sum(r[0] * km[0] * rk[0] + r[1] * km[1] * rk[1] + r[2] * km[2] * rk[2] + r[3] * km[3] * rk[3]);
            st_bf4(YG + o, (d * rs * lw + lb + bon * vm) * gg);
        }
    }
}

__constant__ double kRopeInv[8] = {1.0, 0.19392274474868576, 0.03760603093086393, 0.007292664737217109, 0.001414213562373095, 0.0002742481756762073, 5.318295896944988e-05, 1.031338537721246e-05};
__device__ __forceinline__ void phase_rope_table(KP p) {
    float* TB = WSP(float, WS_ROPE);
    for (int e = ((int)gridDim.x - 1 - BID()) * 512 + TID(); e < 4104 * 8; e += gridDim.x * 512) {
        const int pi = e >> 3, f = e & 7, pos = pi < 4096 ? pi : PAST + (pi - 4096);
        double ang = (double)pos * kRopeInv[f]; ang -= floor(ang * 0.15915494309189535) * 6.283185307179586; const float af = (float)ang;
        TB[pi * 16 + f] = cosf(af); TB[pi * 16 + 8 + f] = sinf(af);
    }
}
__device__ __forceinline__ void phase_dsapost(KP p, int j) {
    const bf16_t* PR = WSP(bf16_t, WS_PR); float *Q = WSP(float, WS_Q), *QI = WSP(float, WS_QI), *WI = WSP(float, WS_WI);
    const int lane = TID() & 63, l16 = lane & 15, gw = BID() * 8 + (TID() >> 6), nw = gridDim.x * 8;
    const f32x4 qn = *(const f32x4*)(p->att_q_norm + j * 64 + 4 * l16), kn = *(const f32x4*)(p->att_k_norm + j * 64 + 4 * l16), in = *(const f32x4*)(p->idx_k_norm + j * 64 + 4 * l16);
    for (int row = gw; row < NT; row += nw) {
        const int pos = row_pos(row);
        const bf16_t* pr = PR + (size_t)row * PINP;
        const float* tb = WSP(float, WS_ROPE) + (row < NP ? (row & 4095) : 4096 + ((row - NP) & 7)) * 16 + 4 * (l16 & 1);
        const f32x4 cs = *(const f32x4*)tb, sn = *(const f32x4*)(tb + 8);
        const float sgn = (l16 < 2) ? -1.0f : 1.0f;
#define ROPE4(v) do { f32x4 _o; _o[0] = __shfl_xor((v)[0], 2); _o[1] = __shfl_xor((v)[1], 2); _o[2] = __shfl_xor((v)[2], 2); _o[3] = __shfl_xor((v)[3], 2); if (l16 < 4) (v) = (v) * cs + sgn * (_o * sn); } while (0)
#define HNORM4(v, w) do { const float _ss = g16_sum((v)[0] * (v)[0] + (v)[1] * (v)[1] + (v)[2] * (v)[2] + (v)[3] * (v)[3]); (v) = (v) * rsqrtf(_ss * (1.0f / 64.0f) + 1e-6f) * (w); } while (0)
#pragma unroll
        for (int i = 0; i < 4; ++i) { f32x4 v = ld_bf4(pr + 256 * i + 4 * lane); HNORM4(v, qn); ROPE4(v); st_bf4((bf16_t*)Q + (size_t)row * D + 256 * i + 4 * lane, v); }
        { f32x4 v = ld_bf4(pr + 1024 + 4 * lane); HNORM4(v, kn); ROPE4(v);
          float* ko = row < NP ? p->out + O_KP + ((size_t)j * NP + row) * 256 : p->out + O_KS + ((size_t)j * NS + (row - NP)) * 256; *(f32x4*)(ko + 4 * lane) = v; *(unsigned*)(WSP(unsigned char, WS_K8) + (size_t)row * 256 + 4 * lane) = pk_fp8x4(v); }
        { const f32x4 v = ld_bf4(pr + 1280 + 4 * lane);
          float* vo = row < NP ? p->out + O_VP + ((size_t)j * NP + row) * 256 : p->out + O_VS + ((size_t)j * NS + (row - NP)) * 256; *(f32x4*)(vo + 4 * lane) = v; *(unsigned*)(WSP(unsigned char, WS_V8) + (size_t)row * 256 + 4 * lane) = pk_fp8x4(v); }
#pragma unroll
        for (int i = 0; i < 2; ++i) { f32x4 v = ld_bf4(pr + 1536 + 256 * i + 4 * lane); ROPE4(v); st_bf4(WSP(bf16_t, WS_QIB) + (size_t)row * 512 + 256 * i + 4 * lane, v); }
        { f32x4 v = ld_bf4(pr + 2048 + 4 * l16); HNORM4(v, in); ROPE4(v);
          float* io = row < NP ? p->out + O_IKP + ((size_t)j * NP + row) * 64 : p->out + O_IKS + ((size_t)j * NS + (row - NP)) * 64; if (lane < 16) { *(f32x4*)(io + 4 * lane) = v; st_bf4(WSP(bf16_t, WS_KIB) + (size_t)row * 64 + 4 * lane, v); } }
        if (lane < 2) { const f32x4 v = ld_bf4(pr + 2112 + 4 * lane); *(f32x4*)(WI + (size_t)row * 8 + 4 * lane) = v * 0.35355339059327373f; }
#undef ROPE4
#undef HNORM4
    }
}

template <bool SAMPLE>
__device__ __forceinline__ void phase_idx(KP p, int j, LAS unsigned char* lds) {
    LAS float* Qs = (LAS float*)lds;
    LAS float* Ks = (LAS float*)(lds + 32768);
    const float *QI = WSP(float, WS_QI), *WI = WSP(float, WS_WI);
    const int tid = TID(), q = tid >> 5, kx = tid & 31;
    const int nitems = SAMPLE ? 32 * 65 : 1024;
    for (int it = BID(); it < nitems; it += gridDim.x) {
        int b, t0, rowbase, nkt, kt0 = 0;
        if (SAMPLE) { b = it / 65; kt0 = it % 65; t0 = 0; rowbase = NP + b * 8; nkt = kt0 + 1; }
        else { const int k4 = it >> 8, w = it & 255, i = (k4 & 1) ? (k4 * 256 + 255 - w) : (k4 * 256 + w); b = i & 3; t0 = (i >> 2) * 16; rowbase = b * 4096 + t0; nkt = (t0 + 15) / 128 + 1; }
        const int nq = SAMPLE ? 8 : 16;
        __syncthreads();
#pragma unroll
        for (int n = 0; n < 16; ++n) { const int e = tid + 512 * n, qq = e >> 9, c = e & 511, h = c >> 6, d = c & 63;
            Qs[(d * 16 + qq) * 8 + h] = qq < nq ? QI[(size_t)(rowbase + qq) * 512 + c] : 0.f; }
        float wi[8];
#pragma unroll
        for (int h = 0; h < 8; ++h) wi[h] = q < nq ? WI[(size_t)(rowbase + q) * 8 + h] : 0.f;
        for (int kt = kt0; kt < nkt; ++kt) {
            __syncthreads();
#pragma unroll
            for (int n = 0; n < 16; ++n) { const int e = tid + 512 * n, key = e >> 6, d = e & 63, s = kt * 128 + key; float v = 0.f;
                if (SAMPLE) {
                    if (s < PAST) { const int pg = p->page_table[b * 64 + (s >> 7)]; v = p->cache_ik[(((size_t)j * 2560 + pg) * 128 + (s & 127)) * 64 + d]; }
                    else if (s < PAST + 8) v = p->out[O_IKS + ((size_t)j * NS + b * 8 + (s - PAST)) * 64 + d];
                } else v = p->out[O_IKP + ((size_t)j * NP + b * 4096 + s) * 64 + d];
                Ks[d * 132 + key] = v; }
            __syncthreads();
            f32x4 acc[8];
#pragma unroll
            for (int h = 0; h < 8; ++h) acc[h] = (f32x4){0.f, 0.f, 0.f, 0.f};
#pragma unroll 4
            for (int d = 0; d < 64; ++d) {
                const f32x4 qa = *(const LAS f32x4*)(Qs + (d * 16 + q) * 8), qb = *(const LAS f32x4*)(Qs + (d * 16 + q) * 8 + 4), kv = *(const LAS f32x4*)(Ks + d * 132 + 4 * kx);
                acc[0] += qa[0] * kv; acc[1] += qa[1] * kv; acc[2] += qa[2] * kv; acc[3] += qa[3] * kv;
                acc[4] += qb[0] * kv; acc[5] += qb[1] * kv; acc[6] += qb[2] * kv; acc[7] += qb[3] * kv;
            }
            f32x4 sc = {0.f, 0.f, 0.f, 0.f};
#pragma unroll
            for (int h = 0; h < 8; ++h)
#pragma unroll
                for (int e = 0; e < 4; ++e) sc[e] += fmaxf(acc[h][e] * 0.125f, 0.f) * wi[h];
            if (q < nq) {
                if (SAMPLE) *(f32x4*)(WSP(float, WS_SCS) + (size_t)(b * 8 + q) * SCS_LD + kt * 128 + 4 * kx) = sc;
                else *(f32x4*)(WSP(float, WS_SC) + ((size_t)b * 4096 + t0 + q) * 4096 + kt * 128 + 4 * kx) = sc;
            }
        }
    }
    __syncthreads();
}

template <bool SAMPLE>
__device__ __forceinline__ void phase_idx2(KP p, int j) {
    const bf16_t *QIB = WSP(bf16_t, WS_QIB), *KIB = WSP(bf16_t, WS_KIB); const float* WI = WSP(float, WS_WI);
    const int lane = TID() & 63, lr = lane & 31, lh = lane >> 5, gw = BID() * 8 + (TID() >> 6), nw = gridDim.x * 8;
    const int nitems = SAMPLE ? 32 * 65 : 4096;
    for (int it = gw; it < nitems; it += nw) {
        int b, rowbase, tile0, ntile;
        if (SAMPLE) { b = it / 65; rowbase = NP + b * 8; tile0 = (it % 65) * 4; ntile = min(4, 257 - tile0); }
        else { const int sub = it >= 2048, w_ = it & 2047; b = w_ & 3; const int wb = w_ >> 2, kk = sub ? 511 - wb : wb, nt = (kk * 8 + 7) / 32 + 1;
            rowbase = b * 4096 + kk * 8; tile0 = sub ? (nt >> 1) : 0; ntile = sub ? nt - (nt >> 1) : (nt >> 1); }
        if (ntile <= 0) continue;
        bf16x8 af[2][4]; float w[2][2][8];
        { const int hd = (lr & 3) + 4 * ((lr >> 3) & 1), jq = 2 * ((lr >> 2) & 1) + (lr >> 4);
#pragma unroll
          for (int st = 0; st < 2; ++st)
#pragma unroll
              for (int ks = 0; ks < 4; ++ks) af[st][ks] = *(const bf16x8*)(QIB + (size_t)(rowbase + 4 * st + jq) * 512 + hd * 64 + 16 * ks + 8 * lh);
#pragma unroll
          for (int st = 0; st < 2; ++st)
#pragma unroll
              for (int q = 0; q < 2; ++q) { const f32x4 w0 = *(const f32x4*)(WI + (size_t)(rowbase + 4 * st + 2 * lh + q) * 8), w1 = *(const f32x4*)(WI + (size_t)(rowbase + 4 * st + 2 * lh + q) * 8 + 4);
#pragma unroll
                  for (int e = 0; e < 4; ++e) { w[st][q][e] = w0[e] * 0.125f; w[st][q][4 + e] = w1[e] * 0.125f; } } }
#define IDX_LOADB(BF, tl_) do { const int s_ = (tile0 + (tl_)) * 32 + lr; \
            if (!SAMPLE) { _Pragma("unroll") for (int ks = 0; ks < 4; ++ks) BF[ks] = *(const bf16x8*)(KIB + ((size_t)b * 4096 + s_) * 64 + 16 * ks + 8 * lh); } \
            else { const float* kp = p->out + O_IKS + ((size_t)j * NS + b * 8) * 64; \
                if (s_ < PAST) kp = p->cache_ik + (((size_t)j * 2560 + p->page_table[b * 64 + (s_ >> 7)]) * 128 + (s_ & 127)) * 64; else kp += (size_t)min(s_ - PAST, 7) * 64; \
                _Pragma("unroll") for (int ks = 0; ks < 4; ++ks) { const f32x4 x0 = *(const f32x4*)(kp + 16 * ks + 8 * lh), x1 = *(const f32x4*)(kp + 16 * ks + 8 * lh + 4); \
                    const u32x4 wv = {pk_bf16(x0[0], x0[1]), pk_bf16(x0[2], x0[3]), pk_bf16(x1[0], x1[1]), pk_bf16(x1[2], x1[3])}; BF[ks] = __builtin_bit_cast(bf16x8, wv); } } } while (0)
        bf16x8 bnx[4];
        IDX_LOADB(bnx, 0);
        for (int tl = 0; tl < ntile; ++tl) {
            const int s = (tile0 + tl) * 32 + lr;
            bf16x8 bfr[4];
#pragma unroll
            for (int ks = 0; ks < 4; ++ks) bfr[ks] = bnx[ks];
            if (tl + 1 < ntile) IDX_LOADB(bnx, tl + 1);
            __builtin_amdgcn_sched_barrier(0);
#pragma unroll
            for (int st = 0; st < 2; ++st) {
                f32x16 acc;
#pragma unroll
                for (int r = 0; r < 16; ++r) acc[r] = 0.f;
#pragma unroll
                for (int ks = 0; ks < 4; ++ks) acc = __builtin_amdgcn_mfma_f32_32x32x16_bf16(af[st][ks], bfr[ks], acc, 0, 0, 0);
#pragma unroll
                for (int q = 0; q < 2; ++q) {
                    float sc = 0.f;
#pragma unroll
                    for (int hh = 0; hh < 2; ++hh)
#pragma unroll
                        for (int hl = 0; hl < 4; ++hl) sc += fmaxf(acc[4 * (2 * q + hh) + hl], 0.f) * w[st][q][hl + 4 * hh];
                    if (SAMPLE) WSP(float, WS_SCS)[(size_t)(b * 8 + 4 * st + 2 * lh + q) * SCS_LD + s] = sc;
                    else WSP(float, WS_SC)[((size_t)rowbase + 4 * st + 2 * lh + q) * 4096 + s] = sc;
                }
            }
        }
    }
#undef IDX_LOADB
}

__device__ __forceinline__ unsigned fkey(float f) { f = (f == 0.f) ? 0.f : f; const unsigned u = __float_as_uint(f); return (u & 0x80000000u) ? ~u : (u | 0x80000000u); }
__device__ __forceinline__ void phase_topk_prompt(KP p) {
    const float* SC = WSP(float, WS_SC); int* SEL = WSP(int, WS_SEL); int* CNT = WSP(int, WS_CNT);
    const int lane = TID() & 63, gw = BID() * 8 + (TID() >> 6), nw = gridDim.x * 8;
    for (int qi = gw; qi < NP; qi += nw) {
        const int b = qi & 3, tt = qi >> 2, t = (tt & 1) ? 4095 - (tt >> 1) : (tt >> 1), row = b * 4096 + t, n = t + 1;
        int* sel = SEL + (size_t)row * 256;
        if (n <= TOPK) { for (int s = lane; s < n; s += 64) sel[s] = s; if (lane == 0) CNT[row] = n; continue; }
        const float* base = SC + (size_t)row * 4096;
        const int nb = __builtin_amdgcn_readfirstlane((n + 1023) >> 10);
        unsigned u[64];
#pragma unroll
        for (int kb = 0; kb < 4; ++kb) {
            if (kb < nb) {
#pragma unroll
                for (int m = 16 * kb; m < 16 * kb + 16; ++m) u[m] = __float_as_uint(base[lane + 64 * m]);
            } else {
#pragma unroll
                for (int m = 16 * kb; m < 16 * kb + 16; ++m) u[m] = 0u;
            }
        }
#pragma unroll
        for (int m = 0; m < 64; ++m) { const unsigned k_ = fkey(__uint_as_float(u[m])); u[m] = (lane + 64 * m < n) ? k_ : 0u; }
        unsigned tau = 0u;
#pragma unroll 1
        for (int bit = 31; bit >= 0; --bit) {
            const unsigned cand = tau | (1u << bit); int c = 0;
#pragma unroll
            for (int m = 0; m < 16; ++m) c += (u[m] >= cand) ? 1 : 0;
            if (nb > 1) {
#pragma unroll
                for (int m = 16; m < 32; ++m) c += (u[m] >= cand) ? 1 : 0;
                if (nb > 2) {
#pragma unroll
                    for (int m = 32; m < 48; ++m) c += (u[m] >= cand) ? 1 : 0;
                    if (nb > 3) {
#pragma unroll
                        for (int m = 48; m < 64; ++m) c += (u[m] >= cand) ? 1 : 0;
                    }
                }
            }
            c = wave_sum_i(c);
            if (c >= TOPK) tau = cand;
            if (c == TOPK) break;
        }
        int cg = 0, ct = 0; unsigned tlo = 0u, thi = 0u;
#pragma unroll
        for (int m = 31; m >= 0; --m) { cg += (u[m] > tau) ? 1 : 0; const unsigned tie = (u[m] == tau) ? 1u : 0u; ct += (int)tie; tlo = (tlo << 1) | tie; }
#pragma unroll
        for (int m = 63; m >= 32; --m) { cg += (u[m] > tau) ? 1 : 0; const unsigned tie = (u[m] == tau) ? 1u : 0u; ct += (int)tie; thi = (thi << 1) | tie; }
        unsigned long long tmask = ((unsigned long long)thi << 32) | tlo;
        const int totg = wave_sum_i(cg), tott = wave_sum_i(ct);
        const int need = TOPK - totg;
        unsigned long long smask = 0ull;
        if (tott == need) smask = tmask;
        else {
#pragma unroll 1
            for (int it = 0; it < need; ++it) {
                const int m0 = tmask ? (int)__builtin_ctzll(tmask) : 64;
                const int cand = tmask ? (lane + 64 * m0) : 0x7fffffff, best = wave_min_i(cand);
                if (cand == best && tmask) { smask |= (1ull << m0); tmask &= ~(1ull << m0); }
            }
        }
        const int mine = cg + __popcll(smask);
        int incl = mine;
#pragma unroll
        for (int d = 1; d < 64; d <<= 1) { const int o = __shfl_up(incl, d); if (lane >= d) incl += o; }
        int off = incl - mine;
#pragma unroll
        for (int m = 0; m < 64; ++m) { if ((u[m] > tau) || ((smask >> m) & 1ull)) { sel[off] = lane + 64 * m; ++off; } }
        if (lane == 0) CNT[row] = TOPK;
    }
}
__device__ __forceinline__ void phase_topk_sample(KP p, LAS unsigned char* lds) {
    LAS unsigned* ckey = (LAS unsigned*)lds;
    LAS int* cidx = (LAS int*)(lds + 8192);
    const float* SCS = WSP(float, WS_SCS); int* SEL = WSP(int, WS_SEL); int* CNT = WSP(int, WS_CNT);
    for (int qq = BID(); qq < NS; qq += gridDim.x) {
        const int tid = TID(), lane = tid & 63, wave = tid >> 6;
        const int n = PAST + 1 + (qq & 7), row = NP + qq, s0 = 1088 * wave;
        const float* base = SCS + (size_t)qq * SCS_LD;
        unsigned u[17];
#pragma unroll
        for (int m = 0; m < 17; ++m) { const int s = s0 + lane + 64 * m; u[m] = __float_as_uint(base[s < SCS_LD ? s : 0]); }
#pragma unroll
        for (int m = 0; m < 17; ++m) { const unsigned k_ = fkey(__uint_as_float(u[m])); u[m] = (s0 + lane + 64 * m < n) ? k_ : 0u; }
        __syncthreads();
        {
            int nvalid = 0;
#pragma unroll
            for (int m = 0; m < 17; ++m) nvalid += (u[m] != 0u) ? 1 : 0;
            nvalid = wave_sum_i(nvalid);
            unsigned tau = 0u; int need = 0; unsigned tmask = 0u, smask = 0u;
            if (nvalid > TOPK) {
#pragma unroll 1
                for (int bit = 31; bit >= 0; --bit) {
                    const unsigned cand = tau | (1u << bit); int c = 0;
#pragma unroll
                    for (int m = 0; m < 17; ++m) c += (u[m] >= cand) ? 1 : 0;
                    c = wave_sum_i(c);
                    if (c >= TOPK) tau = cand;
                    if (c == TOPK) break;
                }
                int cg = 0, ct = 0;
#pragma unroll
                for (int m = 0; m < 17; ++m) { cg += (u[m] > tau) ? 1 : 0; const bool tie = (u[m] == tau); ct += tie ? 1 : 0; tmask |= tie ? (1u << m) : 0u; }
                cg = wave_sum_i(cg); ct = wave_sum_i(ct);
                need = TOPK - cg;
                if (ct == need) smask = tmask;
                else {
#pragma unroll 1
                    for (int it = 0; it < need; ++it) {
                        const int m0 = tmask ? (int)__builtin_ctz(tmask) : 32;
                        const int cand = tmask ? (lane + 64 * m0) : 0x7fffffff, best = wave_min_i(cand);
                        if (cand == best && tmask) { smask |= (1u << m0); tmask &= ~(1u << m0); }
                    }
                }
            } else { tau = 0u; smask = 0u; }
            int mine = 0;
#pragma unroll
            for (int m = 0; m < 17; ++m) mine += ((u[m] > tau) || ((smask >> m) & 1u)) ? 1 : 0;
            int incl = mine;
#pragma unroll
            for (int d = 1; d < 64; d <<= 1) { const int o = __shfl_up(incl, d); if (lane >= d) incl += o; }
            int off = incl - mine;
            const int total = __builtin_amdgcn_readlane(incl, 63);
#pragma unroll
            for (int m = 0; m < 17; ++m) { if ((u[m] > tau) || ((smask >> m) & 1u)) { ckey[wave * 256 + off] = u[m]; cidx[wave * 256 + off] = s0 + lane + 64 * m; ++off; } }
            for (int e = total + lane; e < 256; e += 64) { ckey[wave * 256 + e] = 0u; cidx[wave * 256 + e] = 0x7fffffff; }
        }
        __syncthreads();
        if (wave == 0) {
            unsigned v[32]; int ix[32];
#pragma unroll
            for (int m = 0; m < 32; ++m) { v[m] = ckey[lane + 64 * m]; ix[m] = cidx[lane + 64 * m]; }
            unsigned tau = 0u;
#pragma unroll 1
            for (int bit = 31; bit >= 0; --bit) {
                const unsigned cand = tau | (1u << bit); int c = 0;
#pragma unroll
                for (int m = 0; m < 32; ++m) c += (v[m] >= cand) ? 1 : 0;
                c = wave_sum_i(c);
                if (c >= TOPK) tau = cand;
                if (c == TOPK) break;
            }
            int cg = 0, ct = 0; unsigned tmask = 0u, smask = 0u;
#pragma unroll
            for (int m = 31; m >= 0; --m) { cg += (v[m] > tau) ? 1 : 0; const unsigned tie = (v[m] == tau) ? 1u : 0u; ct += (int)tie; tmask = (tmask << 1) | tie; }
            cg = wave_sum_i(cg); ct = wave_sum_i(ct);
            const int need = TOPK - cg;
            if (ct == need) smask = tmask;
            else {
#pragma unroll 1
                for (int it = 0; it < need; ++it) {
                    int bi = 0x7fffffff, bm = 0;
#pragma unroll
                    for (int m = 0; m < 32; ++m) { const bool t_ = (tmask >> m) & 1u; if (t_ && ix[m] < bi) { bi = ix[m]; bm = m; } }
                    const int best = wave_min_i(bi);
                    if (bi == best && bi != 0x7fffffff) { smask |= (1u << bm); tmask &= ~(1u << bm); }
                }
            }
            int mine = 0;
#pragma unroll
            for (int m = 0; m < 32; ++m) mine += ((v[m] > tau) || ((smask >> m) & 1u)) ? 1 : 0;
            int incl = mine;
#pragma unroll
            for (int d = 1; d < 64; d <<= 1) { const int o = __shfl_up(incl, d); if (lane >= d) incl += o; }
            int off = incl - mine;
            int* sel = SEL + (size_t)row * 256;
#pragma unroll
            for (int m = 0; m < 32; ++m) { if ((v[m] > tau) || ((smask >> m) & 1u)) { if (off < TOPK) sel[off] = ix[m]; ++off; } }
            if (lane == 0) CNT[row] = TOPK;
        }
    }
    __syncthreads();
}

template <bool SAMPLE>
__device__ __forceinline__ void phase_attn(KP p, int j, LAS unsigned char* lds) {
    const int tid = TID(), lane = tid & 63, wave = tid >> 6, n16 = lane & 15, c4 = lane >> 4;
    LAS bf16_t* ps = (LAS bf16_t*)(lds + wave * 16384);
    LAS int* is = (LAS int*)(lds + wave * 16384 + 8192);
    LAS bf16_t* qs = (LAS bf16_t*)(lds + wave * 16384 + 9216);
    LAS float* invs = (LAS float*)(lds + wave * 16384 + 11264);
    const float* Q = WSP(float, WS_Q); const int* SEL = WSP(int, WS_SEL); const int* CNT = WSP(int, WS_CNT); bf16_t* O = WSP(bf16_t, WS_YG);
    const bf16_t *KBF = WSP(bf16_t, WS_KBF), *VBF = WSP(bf16_t, WS_VBF);
    const float* kc = p->cache_k + (size_t)j * 2560 * 128 * 256; const float* vc = p->cache_v + (size_t)j * 2560 * 128 * 256;
    const float* knew = p->out + O_KS + (size_t)j * NS * 256; const float* vnew = p->out + O_VS + (size_t)j * NS * 256;
    const int gw = BID() * 8 + wave, nw = gridDim.x * 8, nq = SAMPLE ? NS : NP;
    unsigned* qctr = WSP(unsigned, WS_BAR + 40960) + (size_t)j * 256;
    int qb = 0, qnext = 0, qsub = 2, qcur = 0;
    if (!SAMPLE) { unsigned v_ = 0u; if (lane == 0) v_ = __hip_atomic_fetch_add(qctr + 16 * ((BID() + qb) & 3), 2u, __ATOMIC_RELAXED, __HIP_MEMORY_SCOPE_AGENT); qnext = (int)__builtin_amdgcn_readfirstlane(v_); }
    for (int qi = gw; SAMPLE ? (qi < nq) : true; qi += nw) {
        int row;
        if (SAMPLE) row = NP + qi;
        else {
            if (qsub == 2) {
                for (;;) {
                    qcur = qnext; qsub = 0;
                    if (qcur < 4096 || qb == 3) break;
                    ++qb; unsigned v_ = 0u; if (lane == 0) v_ = __hip_atomic_fetch_add(qctr + 16 * ((BID() + qb) & 3), 2u, __ATOMIC_RELAXED, __HIP_MEMORY_SCOPE_AGENT); qnext = (int)__builtin_amdgcn_readfirstlane(v_);
                }
                if (qcur >= 4096) break;
                { unsigned v_ = 0u; if (lane == 0) v_ = __hip_atomic_fetch_add(qctr + 16 * ((BID() + qb) & 3), 2u, __ATOMIC_RELAXED, __HIP_MEMORY_SCOPE_AGENT); qnext = (int)__builtin_amdgcn_readfirstlane(v_); }
            }
            row = ((BID() + qb) & 3) * 4096 + (4095 - (qcur + qsub)); ++qsub;
        }
        const int n = CNT[row];
        wave_lds_fence();
#pragma unroll
        for (int c = 0; c < 4; ++c) { const int slot = lane + 64 * c;
            int s = SEL[(size_t)row * 256 + slot]; const bool ok = slot < n;
            int r;
            if (SAMPLE) { const int bb = (row - NP) >> 3; s = ok ? s : 0; const int sp = min(max(s, 0), PAST - 1); const int pg = p->page_table[bb * 64 + (sp >> 7)];
                r = (s < PAST) ? pg * 128 + (s & 127) : (0x40000000 | (bb * 8 + min(s - PAST, 7))); }
            else r = (row & ~4095) + (ok ? s : 0);
            is[slot] = r; }
#pragma unroll
        for (int i = 0; i < 4; ++i) { const f32x4 q4 = ld_bf4((const bf16_t*)Q + (size_t)row * D + 256 * i + 4 * lane);
            if (SAMPLE) { const f32x4 q8 = q4 * 0.125f; u32x2 w; w.x = pk_bf16(q8[0], q8[1]); w.y = pk_bf16(q8[2], q8[3]); *(LAS u32x2*)(qs + 256 * i + 4 * lane) = w; }
            else *(LAS unsigned*)((LAS unsigned char*)qs + 256 * i + 4 * lane) = pk_fp8x4(q4); }
        wave_lds_fence();
        {
            float mx = -__builtin_huge_valf();
#define ATT_EMIT(t_, acc_) do { f32x4 l_ = (acc_); _Pragma("unroll") for (int r = 0; r < 4; ++r) { if (16 * (t_) + 4 * c4 + r >= n) l_[r] = -__builtin_huge_valf(); mx = fmaxf(mx, l_[r]); } \
                u32x2 w_; w_.x = pk_bf16(l_[0], l_[1]); w_.y = pk_bf16(l_[2], l_[3]); *(LAS u32x2*)(ps + n16 * 256 + 16 * (t_) + 4 * c4) = w_; } while (0)
            if (SAMPLE) {
                const u32x4 qf0 = *(const LAS u32x4*)(qs + n16 * 64 + 8 * c4), qf1 = *(const LAS u32x4*)(qs + n16 * 64 + 32 + 8 * c4);
                u32x4 bq[8];
#pragma unroll
                for (int ks = 0; ks < 8; ++ks) { const bool on = (n16 >> 2) == (ks >> 1); const u32x4 qv = (ks & 1) ? qf1 : qf0; bq[ks] = (u32x4){on ? qv.x : 0u, on ? qv.y : 0u, on ? qv.z : 0u, on ? qv.w : 0u}; }
#pragma unroll 2
                for (int t = 0; t < 16; ++t) {
                    const int r = is[16 * t + n16];
                    const float* kp = ((r & 0x40000000) ? knew + (size_t)(r & 0xffff) * 256 : kc + (size_t)r * 256) + 8 * c4;
                    f32x4 acc = {0.f, 0.f, 0.f, 0.f};
#pragma unroll
                    for (int ks = 0; ks < 8; ++ks) { const f32x4 x0 = *(const f32x4*)(kp + 32 * ks), x1 = *(const f32x4*)(kp + 32 * ks + 4);
                        const u32x4 ka = {pk_bf16(x0[0], x0[1]), pk_bf16(x0[2], x0[3]), pk_bf16(x1[0], x1[1]), pk_bf16(x1[2], x1[3])};
                        acc = __builtin_amdgcn_mfma_f32_16x16x32_bf16(__builtin_bit_cast(bf16x8, ka), __builtin_bit_cast(bf16x8, bq[ks]), acc, 0, 0, 0); }
                    ATT_EMIT(t, acc);
                }
            } else {
                const LAS unsigned char* q8 = (const LAS unsigned char*)qs;
                long bq[8];
                { const bool on = (n16 >> 2) == c4;
#pragma unroll
                  for (int h2 = 0; h2 < 4; ++h2) { const u32x4 qv = *(const LAS u32x4*)(q8 + n16 * 64 + 16 * h2);
                      const u32x2 z0 = {on ? qv.x : 0u, on ? qv.y : 0u}, z1 = {on ? qv.z : 0u, on ? qv.w : 0u}; bq[2 * h2] = __builtin_bit_cast(long, z0); bq[2 * h2 + 1] = __builtin_bit_cast(long, z1); } }
                const unsigned char* K8 = WSP(unsigned char, WS_K8);
#pragma unroll
                for (int th = 0; th < 2; ++th) {
                    if (th) asm volatile("" ::: "memory");
                    u32x4 ka[8][4];
#pragma unroll
                    for (int t8 = 0; t8 < 8; ++t8) {
                        const int r = is[16 * (8 * th + t8) + n16];
                        const unsigned char* kp = K8 + (size_t)r * 256 + 64 * c4;
#pragma unroll
                        for (int h2 = 0; h2 < 4; ++h2) ka[t8][h2] = *(const u32x4*)(kp + 16 * h2);
                    }
                    __builtin_amdgcn_sched_barrier(0);
#pragma unroll
                    for (int t8 = 0; t8 < 8; ++t8) {
                        f32x4 acc = {0.f, 0.f, 0.f, 0.f};
#pragma unroll
                        for (int h2 = 0; h2 < 4; ++h2) { const u32x2 lo = {ka[t8][h2].x, ka[t8][h2].y}, hi = {ka[t8][h2].z, ka[t8][h2].w};
                            acc = __builtin_amdgcn_mfma_f32_16x16x32_fp8_fp8(__builtin_bit_cast(long, lo), bq[2 * h2], acc, 0, 0, 0);
                            acc = __builtin_amdgcn_mfma_f32_16x16x32_fp8_fp8(__builtin_bit_cast(long, hi), bq[2 * h2 + 1], acc, 0, 0, 0); }
                        ATT_EMIT(8 * th + t8, acc * 0.125f);
                    }
                }
            }
#undef ATT_EMIT
            mx = fmaxf(mx, __shfl_xor(mx, 16)); mx = fmaxf(mx, __shfl_xor(mx, 32));
            float sm = 0.f;
            u32x2 lw_[16];
#pragma unroll
            for (int t = 0; t < 16; ++t) lw_[t] = *(const LAS u32x2*)(ps + n16 * 256 + 16 * t + 4 * c4);
#pragma unroll
            for (int t = 0; t < 16; ++t) {
                const u32x2 w = lw_[t];
                const float e0 = __expf(bflo(w.x) - mx), e1 = __expf(bfhi(w.x) - mx), e2 = __expf(bflo(w.y) - mx), e3 = __expf(bfhi(w.y) - mx);
                sm += (e0 + e1) + (e2 + e3);
                u32x2 o_; o_.x = pk_bf16(e0, e1); o_.y = pk_bf16(e2, e3); *(LAS u32x2*)(ps + n16 * 256 + 16 * t + 4 * c4) = o_;
            }
            sm += __shfl_xor(sm, 16); sm += __shfl_xor(sm, 32);
            if (c4 == 0) invs[n16] = 1.0f / sm;
        }
        wave_lds_fence();
        if (!SAMPLE) {
            const unsigned char* V8 = WSP(unsigned char, WS_V8);
            const int rs = c4, kvh = n16 >> 2, nst = n > 64 ? 64 : n;
            f32x4 oa[4][4];
#pragma unroll
            for (int g = 0; g < 4; ++g)
#pragma unroll
                for (int q = 0; q < 4; ++q) oa[g][q] = (f32x4){0.f, 0.f, 0.f, 0.f};
            u32x4 vr[8], vn[8];
#pragma unroll
            for (int i = 0; i < 8; ++i) vn[i] = *(const u32x4*)(V8 + (size_t)is[64 * rs + i] * 256 + 16 * n16);
            for (int m0 = 0; m0 < nst; m0 += 8) {
#pragma unroll
                for (int i = 0; i < 8; ++i) vr[i] = vn[i];
                if (m0 + 8 < nst) {
#pragma unroll
                    for (int i = 0; i < 8; ++i) vn[i] = *(const u32x4*)(V8 + (size_t)is[64 * rs + m0 + 8 + i] * 256 + 16 * n16);
                }
                __builtin_amdgcn_sched_barrier(0);
#pragma unroll
                for (int h4 = 0; h4 < 2; ++h4) {
                    u32x2 pg[4];
#pragma unroll
                    for (int g = 0; g < 4; ++g) pg[g] = *(const LAS u32x2*)(ps + (kvh * 4 + g) * 256 + 64 * rs + m0 + 4 * h4);
#pragma unroll
                    for (int i = 0; i < 4; ++i) {
                        const u32x4 v_ = vr[4 * h4 + i];
                        const f32x4 v0 = fp8x4_f32(v_.x), v1 = fp8x4_f32(v_.y), v2 = fp8x4_f32(v_.z), v3 = fp8x4_f32(v_.w);
#pragma unroll
                        for (int g = 0; g < 4; ++g) { const unsigned pw = (i < 2) ? pg[g].x : pg[g].y; const float pf = (i & 1) ? bfhi(pw) : bflo(pw);
                            oa[g][0] += pf * v0; oa[g][1] += pf * v1; oa[g][2] += pf * v2; oa[g][3] += pf * v3; }
                    }
                }
            }
#pragma unroll
            for (int g = 0; g < 4; ++g)
#pragma unroll
                for (int q = 0; q < 4; ++q)
#pragma unroll
                    for (int e_ = 0; e_ < 4; ++e_) { float x = oa[g][q][e_]; x += __shfl_xor(x, 16); x += __shfl_xor(x, 32); oa[g][q][e_] = x; }
            if (rs == 0) {
                const f32x4 iv = *(const LAS f32x4*)(invs + 4 * kvh);
#pragma unroll
                for (int g = 0; g < 4; ++g) { bf16_t* op = O + (size_t)row * D + (kvh * 4 + g) * 64 + 16 * (n16 & 3);
                    u32x4 w0, w1; const float sc_ = iv[g];
                    w0.x = pk_bf16(oa[g][0][0] * sc_, oa[g][0][1] * sc_); w0.y = pk_bf16(oa[g][0][2] * sc_, oa[g][0][3] * sc_); w0.z = pk_bf16(oa[g][1][0] * sc_, oa[g][1][1] * sc_); w0.w = pk_bf16(oa[g][1][2] * sc_, oa[g][1][3] * sc_);
                    w1.x = pk_bf16(oa[g][2][0] * sc_, oa[g][2][1] * sc_); w1.y = pk_bf16(oa[g][2][2] * sc_, oa[g][2][3] * sc_); w1.z = pk_bf16(oa[g][3][0] * sc_, oa[g][3][1] * sc_); w1.w = pk_bf16(oa[g][3][2] * sc_, oa[g][3][3] * sc_);
                    *(u32x4*)op = w0; *(u32x4*)(op + 8) = w1; }
            }
        } else {
        f32x4 o0 = {0.f, 0.f, 0.f, 0.f}, o1 = o0, o2 = o0, o3 = o0;
        constexpr int GV = SAMPLE ? 16 : 32;
        const int ng = (n + GV - 1) / GV;
        unsigned vb[SAMPLE ? 1 : GV], vbn[SAMPLE ? 1 : GV]; f32x4 vf[SAMPLE ? GV : 1];
        const unsigned char* V8 = WSP(unsigned char, WS_V8);
        if (!SAMPLE) {
#pragma unroll
            for (int i = 0; i < GV; ++i) vbn[i] = *(const unsigned*)(V8 + (size_t)is[i] * 256 + 4 * lane);
        }
#pragma unroll 1
        for (int g = 0; g < ng; ++g) {
            if (!SAMPLE) {
#pragma unroll
                for (int i = 0; i < GV; ++i) vb[i] = vbn[i];
                if (g + 1 < ng) {
#pragma unroll
                    for (int i = 0; i < GV; ++i) vbn[i] = *(const unsigned*)(V8 + (size_t)is[GV * (g + 1) + i] * 256 + 4 * lane);
                }
                __builtin_amdgcn_sched_barrier(0);
            } else {
#pragma unroll
                for (int i = 0; i < GV; ++i) { const int r = is[GV * g + i]; vf[i] = *(const f32x4*)(((r & 0x40000000) ? vnew + (size_t)(r & 0xffff) * 256 : vc + (size_t)r * 256) + 4 * lane); }
            }
#pragma unroll
            for (int i4 = 0; i4 < GV / 4; ++i4) {
                const u32x2 p0 = *(const LAS u32x2*)(ps + (c4 * 4 + 0) * 256 + GV * g + 4 * i4), p1 = *(const LAS u32x2*)(ps + (c4 * 4 + 1) * 256 + GV * g + 4 * i4),
                            p2 = *(const LAS u32x2*)(ps + (c4 * 4 + 2) * 256 + GV * g + 4 * i4), p3 = *(const LAS u32x2*)(ps + (c4 * 4 + 3) * 256 + GV * g + 4 * i4);
                f32x4 v0, v1, v2, v3;
                if (!SAMPLE) { v0 = fp8x4_f32(vb[4 * i4]); v1 = fp8x4_f32(vb[4 * i4 + 1]); v2 = fp8x4_f32(vb[4 * i4 + 2]); v3 = fp8x4_f32(vb[4 * i4 + 3]); }
                else { v0 = vf[4 * i4]; v1 = vf[4 * i4 + 1]; v2 = vf[4 * i4 + 2]; v3 = vf[4 * i4 + 3]; }
                o0 += bflo(p0.x) * v0 + bfhi(p0.x) * v1 + bflo(p0.y) * v2 + bfhi(p0.y) * v3;
                o1 += bflo(p1.x) * v0 + bfhi(p1.x) * v1 + bflo(p1.y) * v2 + bfhi(p1.y) * v3;
                o2 += bflo(p2.x) * v0 + bfhi(p2.x) * v1 + bflo(p2.y) * v2 + bfhi(p2.y) * v3;
                o3 += bflo(p3.x) * v0 + bfhi(p3.x) * v1 + bflo(p3.y) * v2 + bfhi(p3.y) * v3;
            }
        }
        { const f32x4 iv = *(const LAS f32x4*)(invs + 4 * c4); bf16_t* op = O + (size_t)row * D + c4 * 256 + 4 * n16; st_bf4(op, o0 * iv[0]); st_bf4(op + 64, o1 * iv[1]); st_bf4(op + 128, o2 * iv[2]); st_bf4(op + 192, o3 * iv[3]); }
        }
    }
}

__global__ void __launch_bounds__(512, 2) mega(P p_unused) {
    extern __shared__ __attribute__((aligned(16))) unsigned char lds_raw[];
    LAS unsigned char* lds = (LAS unsigned char*)lds_raw;
    volatile LAS unsigned* misc = (volatile LAS unsigned*)(lds + LDS_MISC);
    if (TID() < 4) misc[TID()] = 0u;
    __syncthreads();
    KP p = kargs();
    const bool multi = (p->ph_hi - p->ph_lo) > 1;
    XcdBarrier bar; bar.bar = WSP(unsigned, WS_BAR); bar.x = 0; bar.st = misc;
    if (multi) bar = xcd_barrier_post(WSP(unsigned, WS_BAR), misc);
    int ph = 0;
    const int lo = p->ph_lo, hi = p->ph_hi;
#ifndef REPMASK
#define REPMASK 0ull
#endif
#define PH_BEGIN if (ph >= lo && ph < hi) { KP p = kargs(); const int nrep_ = ((REPMASK >> ph) & 1ull) ? 3 : 1; for (int rep_ = 0; rep_ < nrep_; ++rep_) {
#define PH_END   if (ph + 1 < hi || rep_ + 1 < nrep_) xcd_barrier(bar); } } ++ph;

    PH_BEGIN phase_ada(p, lds); phase_weights(p, lds); phase_rope_table(p); PH_END

    for (int layer = 0; layer < 4; ++layer) {
        const int j = layer >> 1;
        if ((layer & 1) == 0) {
            PH_BEGIN phase_prep<true>(p, layer, 0, j, layer == 0); PH_END
            PH_BEGIN {
                FRwkvIn f{WSP(bf16_t, WS_RB), WSP(bf16_t, WS_KB), WSP(bf16_t, WS_VB), WSP(bf16_t, WS_TW), WSP(bf16_t, WS_TA), WSP(bf16_t, WS_TV), WSP(bf16_t, WS_TG)};
                pg8::Gemm g{WSP(bf16_t, WS_XR), WSP(bf16_t, WS_WRW_T) + (size_t)j * 4096 * D, NP, j == 0 ? 3840 : 4096, D, j == 0 ? 2 : 1, XR_STRIDE};
                pg8::StaticOrder S; S.init(NP, g.N, (int)gridDim.x, BID());
                pg8::EpiAdapt<FRwkvIn, true> E{f};
                pg8::gemm_phase(lds, g, S, E);
                wgemm_ks<true>(lds, WSP(bf16_t, WS_XR), D, XR_STRIDE, NP, NS, WSP(bf16_t, WS_WRW_T) + (size_t)j * 4096 * D, D, 4096, f, ((NP / 256) * (g.N / 256)) % (int)gridDim.x);
            } PH_END
            PH_BEGIN {
                FStoreF32 fw{WSP(float, WS_WP), D, D}, fa{WSP(float, WS_AP), D, D}, fv{WSP(float, WS_VP), D, D}, fg{WSP(float, WS_GG), D, D};
                wgemm_w(WSP(bf16_t, WS_TW), 64, NP, NS, WSP(bf16_t, WS_W2T) + (size_t)j * D * 64, 64, D, fw);
                wgemm_w(WSP(bf16_t, WS_TA), 64, NP, NS, WSP(bf16_t, WS_A2T) + (size_t)j * D * 64, 64, D, fa);
                if (j == 1) wgemm_w(WSP(bf16_t, WS_TV), 32, NP, NS, WSP(bf16_t, WS_V2T), 32, D, fv);
                wgemm_w(WSP(bf16_t, WS_TG), 160, NP, NS, WSP(bf16_t, WS_G2T) + (size_t)j * D * 160, 160, D, fg);
                phase_chunk(p, j, lds);
            } PH_END
            PH_BEGIN phase_carry(p, j, lds); PH_END
            PH_BEGIN phase_post2(p, j, lds); PH_END
        } else {
            PH_BEGIN phase_prep<false>(p, layer, 0, j); PH_END
            PH_BEGIN {
                FStoreBf16 f{WSP(bf16_t, WS_PR), PINP, PINP};
                pg8::Gemm g{WSP(bf16_t, WS_XR), WSP(bf16_t, WS_WIN_T) + (size_t)j * PINP * D, NP, PINP, D, 0, 0};
                pg8::StaticOrder S; S.init(NP, PINP, (int)gridDim.x, BID());
                pg8::EpiAdapt<FStoreBf16, true> E{f};
                pg8::gemm_phase(lds, g, S, E);
                FStoreBf16 fs{WSP(bf16_t, WS_PR), PINP, PIN};
                wgemm_ks<false>(lds, WSP(bf16_t, WS_XR), D, 0, NP, NS, WSP(bf16_t, WS_WIN_T) + (size_t)j * PINP * D, D, PINP, fs, ((NP / 256) * (PINP / 256)) % (int)gridDim.x);
            } PH_END
            PH_BEGIN phase_dsapost(p, j); PH_END
            PH_BEGIN phase_idx2<false>(p, j); phase_idx2<true>(p, j); PH_END
            PH_BEGIN phase_topk_prompt(p); phase_topk_sample(p, lds); PH_END
            PH_BEGIN phase_attn<true>(p, j, lds); phase_attn<false>(p, j, lds); PH_END
        }
        PH_BEGIN {
            FResid f{p->out, WSP(float, WS_MODS) + (size_t)layer * 36 * 6144 + 2 * D, layer == 0 ? p->x_prompt : nullptr, layer == 0 ? p->x_sample : nullptr};
            const bf16_t* Wt = ((layer & 1) == 0 ? WSP(bf16_t, WS_WO_T) : WSP(bf16_t, WS_WAO_T)) + (size_t)j * D * D;
            pg8::Gemm g{WSP(bf16_t, WS_YG), Wt, NP, D, D, 0, 0};
            pg8::StaticOrder S; S.init(NP, D, (int)gridDim.x, BID());
            pg8::EpiAdapt<FResid, false> E{f};
            pg8::gemm_phase(lds, g, S, E);
            wgemm_ks<false>(lds, WSP(bf16_t, WS_YG), D, 0, NP, NS, Wt, D, D, f);
        } PH_END
        PH_BEGIN phase_prep<false>(p, layer, 1, j); PH_END
        PH_BEGIN {
            FRelu2 f{WSP(bf16_t, WS_U)};
            pg8::Gemm g{WSP(bf16_t, WS_XR), WSP(bf16_t, WS_WUP_T) + (size_t)layer * DFF * D, NP, DFF, D, 0, 0};
            pg8::StaticOrder S; S.init(NP, DFF, (int)gridDim.x, BID());
            pg8::EpiAdapt<FRelu2, true> E{f};
            pg8::gemm_phase(lds, g, S, E);
            wgemm_ks<false>(lds, WSP(bf16_t, WS_XR), D, 0, NP, NS, WSP(bf16_t, WS_WUP_T) + (size_t)layer * DFF * D, D, DFF, f);
        } PH_END
        PH_BEGIN {
            FResid f{p->out, WSP(float, WS_MODS) + (size_t)layer * 36 * 6144 + 5 * D, nullptr, nullptr};
            pg8::Gemm g{WSP(bf16_t, WS_U), WSP(bf16_t, WS_WDN_T) + (size_t)layer * DFF * D, NP, D, DFF, 0, 0};
            pg8::StaticOrder S; S.init(NP, D, (int)gridDim.x, BID());
            pg8::EpiAdapt<FResid, false> E{f};
            pg8::gemm_phase(lds, g, S, E);
            wgemm_ks<false>(lds, WSP(bf16_t, WS_U), DFF, 0, NP, NS, WSP(bf16_t, WS_WDN_T) + (size_t)layer * DFF * D, DFF, D, f);
        } PH_END
    }
#undef PH_BEGIN
#undef PH_END
}

static int count_phases() { int n = 1; for (int layer = 0; layer < 4; ++layer) { n += ((layer & 1) == 0) ? 5 : 6; n += 4; } return n; }

extern "C" void kernel_launch(void* const* d_in, const int* in_sizes, int n_in, void* d_out, int out_size, void* d_ws, size_t ws_size, hipStream_t stream) {
    static int grid = 0;
    if (grid == 0) {
        if (n_in != 39 || out_size != (int)O_END || ws_size < WS_END) { fprintf(stderr, "kernel_launch: unexpected shapes n_in %d out %d ws %zu (need %zu)\n", n_in, out_size, ws_size, (size_t)WS_END); grid = -1; return; }
        int dev = 0, cus = 0, per_cu = 0;
        if (hipGetDevice(&dev) != hipSuccess || hipDeviceGetAttribute(&cus, hipDeviceAttributeMultiprocessorCount, dev) != hipSuccess) { grid = -1; return; }
        if (hipFuncSetAttribute((const void*)mega, hipFuncAttributeMaxDynamicSharedMemorySize, LDS_BYTES) != hipSuccess) { fprintf(stderr, "kernel_launch: hipFuncSetAttribute failed\n"); grid = -1; return; }
        if (hipOccupancyMaxActiveBlocksPerMultiprocessor(&per_cu, (const void*)mega, 512, LDS_BYTES) != hipSuccess || per_cu < 1) fprintf(stderr, "kernel_launch: occupancy query says %d\n", per_cu);
        (void)hipGetLastError();
        grid = cus;
    }
    if (grid < 0) return;
    (void)hipMemsetAsync((char*)d_ws + WS_BAR, 0, 65536, stream);
    P p{};
    memcpy((void*)&p, (const void*)d_in, 39 * sizeof(void*));
    p.out = (float*)d_out; p.ws = (unsigned char*)d_ws;
#ifndef STOP_PH
#define STOP_PH 1000
#endif
    const int nph = count_phases() < STOP_PH ? count_phases() : STOP_PH;
#ifndef ONE_LAUNCH
    for (int ph = 0; ph < nph; ++ph) { p.ph_lo = ph; p.ph_hi = ph + 1; hipLaunchKernelGGL(mega, dim3(grid), dim3(512), LDS_BYTES, stream, p); }
#else
    p.ph_lo = 0; p.ph_hi = nph; hipLaunchKernelGGL(mega, dim3(grid), dim3(512), LDS_BYTES, stream, p);
#endif
}
```

```cpp
#define ONE_LAUNCH 1
#include <hip/hip_runtime.h>
#include <cstdio>
#include <cstdint>
#include <cstring>

#define LAS __attribute__((address_space(3)))
typedef unsigned short bf16_t;
typedef short bf16x8 __attribute__((ext_vector_type(8)));
typedef float f32x4 __attribute__((ext_vector_type(4)));
typedef float f32x2 __attribute__((ext_vector_type(2)));
typedef unsigned u32x4 __attribute__((ext_vector_type(4)));
typedef unsigned u32x2 __attribute__((ext_vector_type(2)));

constexpr int D = 1024, NP = 16384, NS = 256, NT = NP + NS, SEQL = 4096, PAST = 8192, NSEQ = 36, DFF = 4096;
constexpr int PIN = 2120, PINP = 2304;
constexpr int TOPK = 256, SCS_LD = 8320;
constexpr size_t O_YP = 0, O_YS = 16777216, O_KP = 17039360, O_VP = 25427968, O_IKP = 33816576, O_WKVP = 35913728, O_SHP = 36438016,
                 O_KS = 36446208, O_VS = 36577280, O_IKS = 36708352, O_WKVS = 36741120, O_SHS = 40935424, O_END = 41000960;
constexpr size_t al256(size_t x) { return (x + 255) & ~(size_t)255; }
constexpr size_t WS_BAR = 0;
constexpr size_t WS_MODS = 65536;
constexpr size_t WS_WUP_T = al256(WS_MODS + (size_t)4 * NSEQ * 6144 * 4);
constexpr size_t WS_WDN_T = WS_WUP_T + (size_t)4 * DFF * D * 2;
constexpr size_t WS_WRW_T = WS_WDN_T + (size_t)4 * DFF * D * 2;
constexpr size_t WS_WO_T = WS_WRW_T + (size_t)2 * 4096 * D * 2;
constexpr size_t WS_WIN_T = WS_WO_T + (size_t)2 * D * D * 2;
constexpr size_t WS_WAO_T = WS_WIN_T + (size_t)2 * PINP * D * 2;
constexpr size_t WS_W2T = WS_WAO_T + (size_t)2 * D * D * 2;
constexpr size_t WS_A2T = WS_W2T + (size_t)2 * D * 64 * 2;
constexpr size_t WS_V2T = WS_A2T + (size_t)2 * D * 64 * 2;
constexpr size_t WS_G2T = WS_V2T + (size_t)D * 32 * 2;
constexpr size_t WS_XR = WS_G2T + (size_t)2 * D * 160 * 2;
constexpr size_t XR_STRIDE = (size_t)NT * D;
constexpr size_t WS_RB = WS_XR + 6 * XR_STRIDE * 2;
constexpr size_t WS_KB = WS_RB + XR_STRIDE * 2;
constexpr size_t WS_VB = WS_KB + XR_STRIDE * 2;
constexpr size_t WS_TW = WS_VB + XR_STRIDE * 2;
constexpr size_t WS_TA = WS_TW + (size_t)NT * 64 * 2;
constexpr size_t WS_TV = WS_TA + (size_t)NT * 64 * 2;
constexpr size_t WS_TG = WS_TV + (size_t)NT * 32 * 2;
constexpr size_t WS_WP = al256(WS_TG + (size_t)NT * 160 * 2);
constexpr size_t F32A = (size_t)NT * D * 4;
constexpr size_t WS_AP = WS_WP + F32A, WS_VP = WS_AP + F32A, WS_GG = WS_VP + F32A, WS_VFIRST = WS_GG + F32A;
constexpr size_t WS_DEC = WS_VFIRST + F32A, WS_KM = WS_DEC + F32A, WS_VM = WS_KM + F32A, WS_AV = WS_VM + F32A, WS_BV = WS_AV + F32A, WS_Y = WS_BV + F32A;
constexpr size_t WS_YG = WS_Y + F32A;
constexpr size_t WS_U = WS_YG + XR_STRIDE * 2;
constexpr size_t WS_PR = WS_U + (size_t)NT * DFF * 2;
constexpr size_t WS_Q = WS_PR + (size_t)NT * PINP * 4;
constexpr size_t WS_QI = WS_Q + F32A;
constexpr size_t WS_WI = WS_QI + (size_t)NT * 512 * 4;
constexpr size_t WS_SC = al256(WS_WI + (size_t)NT * 8 * 4);
constexpr size_t WS_SCS = WS_SC + (size_t)4 * 4096 * 4096 * 4;
constexpr size_t WS_SEL = al256(WS_SCS + (size_t)NS * SCS_LD * 4);
constexpr size_t WS_CNT = WS_SEL + (size_t)NT * 256 * 4;
constexpr size_t WS_KBF = al256(WS_CNT + (size_t)NT * 4);
constexpr size_t WS_VBF = WS_KBF + (size_t)NT * 256 * 2;
constexpr size_t WS_QIB = WS_VBF + (size_t)NT * 256 * 2;
constexpr size_t WS_KIB = WS_QIB + (size_t)NT * 512 * 2;
constexpr size_t WS_K8 = al256(WS_KIB + (size_t)NT * 64 * 2);
constexpr size_t WS_V8 = WS_K8 + (size_t)NT * 256;
constexpr size_t WS_END = al256(WS_V8 + (size_t)NT * 256);
constexpr size_t WS_ROPE = WS_KBF;

constexpr int LCH = 64, NCH = SEQL / LCH;
constexpr size_t WS_PCH = WS_SC, WS_CCH = WS_PCH + (size_t)64 * NCH * 4096 * 4, WS_SST = WS_CCH + (size_t)64 * NCH * 4096 * 4;
static_assert(WS_SST + (size_t)64 * NCH * 4096 * 4 <= WS_SCS, "scan buffers must fit the aliased region");
constexpr int LDS_BYTES = 147456;
constexpr int LDS_MISC = 131072;

typedef __bf16 bf16x2_t __attribute__((ext_vector_type(2)));
__device__ __forceinline__ unsigned pk_bf16(float lo, float hi) { const f32x2 v = {lo, hi}; const bf16x2_t b = __builtin_convertvector(v, bf16x2_t); return __builtin_bit_cast(unsigned, b); }
__device__ __forceinline__ unsigned pk_fp8x4(f32x4 v) { int w = 0; w = __builtin_amdgcn_cvt_pk_fp8_f32(v[0], v[1], w, false); w = __builtin_amdgcn_cvt_pk_fp8_f32(v[2], v[3], w, true); return (unsigned)w; }
__device__ __forceinline__ f32x4 fp8x4_f32(unsigned w) { return (f32x4){__builtin_amdgcn_cvt_f32_fp8((int)w, 0), __builtin_amdgcn_cvt_f32_fp8((int)w, 1), __builtin_amdgcn_cvt_f32_fp8((int)w, 2), __builtin_amdgcn_cvt_f32_fp8((int)w, 3)}; }
__device__ __forceinline__ float bf2f(unsigned short x) { return __uint_as_float((unsigned)x << 16); }
__device__ __forceinline__ float bflo(unsigned x) { return __uint_as_float(x << 16); }
__device__ __forceinline__ float bfhi(unsigned x) { return __uint_as_float(x & 0xffff0000u); }
__device__ __forceinline__ f32x4 ld_bf4(const bf16_t* p) { const u32x2 v = *(const u32x2*)p; return (f32x4){bflo(v.x), bfhi(v.x), bflo(v.y), bfhi(v.y)}; }
__device__ __forceinline__ void st_bf4(bf16_t* p, f32x4 v) { u32x2 w; w.x = pk_bf16(v[0], v[1]); w.y = pk_bf16(v[2], v[3]); *(u32x2*)p = w; }
template <int CTRL> __device__ __forceinline__ float dppf(float v) { return __int_as_float(__builtin_amdgcn_update_dpp(0, __float_as_int(v), CTRL, 0xf, 0xf, false)); }
template <int CTRL> __device__ __forceinline__ int dppi(int v) { return __builtin_amdgcn_update_dpp(0, v, CTRL, 0xf, 0xf, false); }
__device__ __forceinline__ float g16_sum(float v) { v += dppf<0xB1>(v); v += dppf<0x4E>(v); v += dppf<0x141>(v); v += dppf<0x140>(v); return v; }
__device__ __forceinline__ float g16_max(float v) { v = fmaxf(v, dppf<0xB1>(v)); v = fmaxf(v, dppf<0x4E>(v)); v = fmaxf(v, dppf<0x141>(v)); v = fmaxf(v, dppf<0x140>(v)); return v; }
__device__ __forceinline__ int g16_sum_i(int v) { v += dppi<0xB1>(v); v += dppi<0x4E>(v); v += dppi<0x141>(v); v += dppi<0x140>(v); return v; }
__device__ __forceinline__ int g16_min_i(int v) { v = min(v, dppi<0xB1>(v)); v = min(v, dppi<0x4E>(v)); v = min(v, dppi<0x141>(v)); v = min(v, dppi<0x140>(v)); return v; }
__device__ __forceinline__ float rlf(float v, int k) { return __int_as_float(__builtin_amdgcn_readlane(__float_as_int(v), k)); }
__device__ __forceinline__ float wave_sum(float v) { v = g16_sum(v); return (rlf(v, 0) + rlf(v, 16)) + (rlf(v, 32) + rlf(v, 48)); }
__device__ __forceinline__ float wave_max(float v) { v = g16_max(v); return fmaxf(fmaxf(rlf(v, 0), rlf(v, 16)), fmaxf(rlf(v, 32), rlf(v, 48))); }
__device__ __forceinline__ int wave_sum_i(int v) { v = g16_sum_i(v); return (__builtin_amdgcn_readlane(v, 0) + __builtin_amdgcn_readlane(v, 16)) + (__builtin_amdgcn_readlane(v, 32) + __builtin_amdgcn_readlane(v, 48)); }
__device__ __forceinline__ int wave_min_i(int v) { v = g16_min_i(v); return min(min(__builtin_amdgcn_readlane(v, 0), __builtin_amdgcn_readlane(v, 16)), min(__builtin_amdgcn_readlane(v, 32), __builtin_amdgcn_readlane(v, 48))); }
__device__ __forceinline__ float sigmoidf_(float x) { return 1.0f / (1.0f + expf(-x)); }
__device__ __forceinline__ float fsig(float x) { return __builtin_amdgcn_rcpf(1.0f + __expf(-x)); }
__device__ __forceinline__ float ftanh(float x) { return 2.0f * fsig(2.0f * x) - 1.0f; }
__device__ __forceinline__ int row_seq(int row) { return row < NP ? (row >> 12) : 4 + ((row - NP) >> 3); }
__device__ __forceinline__ int row_pos(int row) { return row < NP ? (row & 4095) : PAST + ((row - NP) & 7); }
__device__ __forceinline__ int TID() { int t = threadIdx.x; asm volatile("" : "+v"(t)); return t; }
__device__ __forceinline__ int BID() { int b = blockIdx.x; asm volatile("" : "+s"(b)); return b; }
__device__ __forceinline__ void wave_lds_fence() { __builtin_amdgcn_fence(__ATOMIC_RELEASE, "wavefront"); __builtin_amdgcn_wave_barrier(); __builtin_amdgcn_fence(__ATOMIC_ACQUIRE, "wavefront"); }

#define XB_TMO      128
#define XB_XCNT(j)  (256  + 64 * (j))
#define XB_XSUB(j)  (1280 + 64 * (j))
#define XB_XGEN(j)  (2304 + 64 * (j))
#define XB_TOP      3328
#define XB_TOPGEN   3392
#define XCD_BAR_WORDS 3456
#define XB_SPIN_CAP (1u << 22)
__device__ __forceinline__ unsigned xb_ld(unsigned* p)              { return __hip_atomic_load(p, __ATOMIC_RELAXED, __HIP_MEMORY_SCOPE_AGENT); }
__device__ __forceinline__ unsigned xb_add(unsigned* p, unsigned v) { return __hip_atomic_fetch_add(p, v, __ATOMIC_RELAXED, __HIP_MEMORY_SCOPE_AGENT); }
__device__ __forceinline__ unsigned xb_xcc_id() { return (unsigned)__builtin_amdgcn_s_getreg((3 << 11) | 20) & 0xFu; }
#define XB_SPIN(cond, bar) do { unsigned _sp = 0; while (cond) { __builtin_amdgcn_s_sleep(1); \
    if ((++_sp & 255u) == 0u) { if (xb_ld(&(bar)[XB_TMO])) break; if (_sp > XB_SPIN_CAP) { atomicAdd(&(bar)[XB_TMO], 1u); break; } } } } while (0)
struct XcdBarrier { unsigned* bar; unsigned x; volatile LAS unsigned* st; };
__device__ __forceinline__ XcdBarrier xcd_barrier_post(unsigned* bar, volatile LAS unsigned* st) {
    XcdBarrier b; b.bar = bar; b.x = xb_xcc_id(); b.st = st;
    if (threadIdx.x == 0) (void)xb_add(&bar[XB_XCNT(b.x)], 1u);
    return b;
}
__device__ __forceinline__ void xcd_barrier_complete(unsigned* bar, unsigned x, unsigned& nloc, unsigned& nx) {
    const unsigned G = gridDim.x * gridDim.y * gridDim.z;
    unsigned sum, cnt, mine, sp = 0u;
    for (;;) {
        sum = 0u; cnt = 0u; mine = 0u;
#pragma unroll
        for (unsigned j = 0; j < 16; ++j) { const unsigned c = xb_ld(&bar[XB_XCNT(j)]); sum += c; cnt += (c > 0u) ? 1u : 0u; mine = (j == x) ? c : mine; }
        if (sum == G) break;
        __builtin_amdgcn_s_sleep(1);
        if ((++sp & 255u) == 0u) { if (xb_ld(&bar[XB_TMO])) break; if (sp > XB_SPIN_CAP) { atomicAdd(&bar[XB_TMO], 1u); break; } }
    }
    nloc = mine > 0u ? mine : 1u; nx = cnt > 0u ? cnt : 1u;
}
__device__ __forceinline__ void xcd_barrier(const XcdBarrier& b) {
    asm volatile("s_waitcnt vmcnt(0)" ::: "memory");
    __syncthreads();
    if (threadIdx.x == 0) {
        unsigned* bar = b.bar;
        __builtin_amdgcn_s_waitcnt(0);
        unsigned nloc = b.st[0], nx = b.st[1];
        if (nloc == 0u) { xcd_barrier_complete(bar, b.x, nloc, nx); b.st[0] = nloc; b.st[1] = nx; }
        const unsigned old = xb_add(&bar[XB_XSUB(b.x)], 1u);
        const unsigned gen = old / nloc;
        if (old + 1u == (gen + 1u) * nloc) {
            __builtin_amdgcn_fence(__ATOMIC_RELEASE, "agent");
            asm volatile("s_waitcnt vmcnt(0)" ::: "memory");
            const unsigned og = xb_add(&bar[XB_TOP], 1u);
            const unsigned tg = og / nx;
            if (og + 1u == (tg + 1u) * nx) xb_add(&bar[XB_TOPGEN], 1u);
            else XB_SPIN(xb_ld(&bar[XB_TOPGEN]) == tg, bar);
            __builtin_amdgcn_fence(__ATOMIC_ACQUIRE, "agent");
            xb_add(&bar[XB_XGEN(b.x)], 1u);
            asm volatile("s_waitcnt vmcnt(0)" ::: "memory");
        } else {
            XB_SPIN(xb_ld(&bar[XB_XGEN(b.x)]) == gen, bar);
            __builtin_amdgcn_fence(__ATOMIC_ACQUIRE, "agent");
            asm volatile("s_waitcnt vmcnt(0)" ::: "memory");
        }
    }
    __syncthreads();
}

struct P {
    const float *x_prompt, *x_sample, *cache_k, *cache_v, *cache_ik, *state_wkv, *state_shift; const int* page_table;
    const float *c_prompt, *c_sample, *norm_g, *w_ada, *b_ada, *w_up, *w_down, *rw_mix, *rw_w_rkv, *rw_w_o, *rw_w0, *rw_w1, *rw_w2, *rw_a0, *rw_a1, *rw_a2,
                *rw_v0, *rw_v1, *rw_v2, *rw_g1, *rw_g2, *rw_k_k, *rw_k_a, *rw_r_k, *rw_lnx_w, *rw_lnx_b, *att_w_in, *att_w_o, *att_q_norm, *att_k_norm, *idx_k_norm;
    float* out; unsigned char* ws; int ph_lo, ph_hi;
};
typedef const P __attribute__((address_space(4)))* KP;
#define WSP(T, off) ((T*)(p->ws + (off)))
__device__ __forceinline__ KP kargs() { KP k = (KP)__builtin_amdgcn_kernarg_segment_ptr(); asm volatile("" : "+s"(k)); return k; }

namespace pg8 {
constexpr int BM = 256, BK = 64, HALF = 128, HTB = HALF * BK * 2, STAGE_BYTES = 8 * HTB, NXCD = 8, WGM = 8;
__device__ __forceinline__ int lds_byte(int r, int c) { const int st = (r >> 4) * 2 + (c >> 5), rr = r & 15, cc = c & 31, ob = rr * 64 + cc * 2; return st * 1024 + (ob ^ (((ob >> 9) & 1) << 5)); }
__device__ __forceinline__ void stage_rc(int b, int& R, int& C) { const int st = b / 1024, sb = b % 1024, swz = sb ^ (((sb >> 9) & 1) << 5); R = (st >> 1) * 16 + swz / 64; C = (st & 1) * 32 + (swz % 64) / 2; }
__device__ __forceinline__ int perm32(int rho) { const int n = rho >> 4, i = rho & 15; return 8 * (i >> 2) + 4 * n + (i & 3); }
struct Unit { int pm, pn; };
struct Gemm { const bf16_t* A; const bf16_t* Bt; int M, N, K, mode; size_t agrp; };
__device__ __forceinline__ int phys_pn(const Gemm& g, int pn) { return (g.mode == 2 && pn >= 12) ? pn + 1 : pn; }
__device__ __forceinline__ const char* a_ptr(const Gemm& g, const Unit& u, size_t tstep) {
    int grp = 0; if (g.mode) grp = u.pn < 12 ? (u.pn >> 2) : (u.pn == 12 ? 2 : u.pn - 10);
    return (const char*)g.A + (size_t)grp * g.agrp * 2 + (size_t)u.pm * tstep; }
struct StaticOrder {
    int nM, nN, nwg, G, c;
    __device__ void init(int M, int N, int G_, int c_) { nM = M / BM; nN = N / BM; nwg = nM * nN; G = G_; c = c_; }
    __device__ bool next(int i, Unit& u) const {
        const long L = (long)i * G + c; if (L >= nwg) return false;
        int wgid = (int)L; { const int q = nwg / NXCD, r = nwg % NXCD, xcd = wgid % NXCD, off = wgid / NXCD; wgid = (xcd < r ? xcd * (q + 1) : r * (q + 1) + (xcd - r) * q) + off; }
        const int nig = WGM * nN, gid = wgid / nig, fm = gid * WGM, gsz = (nM - fm) < WGM ? (nM - fm) : WGM;
        u.pm = fm + ((wgid % nig) % gsz); u.pn = (wgid % nig) / gsz; return true;
    }
};
template <class F, bool PERM_> struct EpiAdapt {
    static constexpr bool PERM = PERM_;
    F f;
    __device__ __forceinline__ void operator()(const f32x4 (&acc)[2][2][4][2], const Unit& u, int wr, int wc, int fr, int fq) const {
        const int row0 = u.pm * BM + wr * 64 + fr, col0 = u.pn * BM + wc * 32 + (PERM ? 8 * fq : 4 * fq);
#pragma unroll
        for (int ai = 0; ai < 2; ++ai)
#pragma unroll
            for (int m = 0; m < 4; ++m)
#pragma unroll
                for (int bj = 0; bj < 2; ++bj) {
                    if constexpr (PERM) f.vec8(row0 + ai * HALF + m * 16, col0 + bj * HALF, acc[ai][bj][m][0], acc[ai][bj][m][1]);
                    else {
#pragma unroll
                        for (int n = 0; n < 2; ++n) f.vec4(row0 + ai * HALF + m * 16, col0 + bj * HALF + 16 * n, acc[ai][bj][m][n]);
                    }
                }
    }
};

template <class Epi>
__device__ __forceinline__ void gemm_phase(LAS unsigned char* lds, const Gemm g, const StaticOrder& S, const Epi& E) {
    const int tid = TID(), wid = __builtin_amdgcn_readfirstlane(tid >> 6), lane = tid & 63, wr = wid >> 2, wc = wid & 3, fr = lane & 15, fq = lane >> 4;
    const int K = g.K, nt = K / BK;
    unsigned voffA[2], voffB[2];
#pragma unroll
    for (int i = 0; i < 2; ++i) { int R, C; stage_rc(tid * 16 + i * 8192, R, C); const int Rb = Epi::PERM ? ((R & ~31) + perm32(R & 31)) : R;
        voffA[i] = (unsigned)(R * K + C) * 2u; voffB[i] = (unsigned)(Rb * K + C) * 2u; }
    const size_t kstep = (size_t)(BK * 2);
    const size_t hstep = (size_t)HALF * K * 2;
    const size_t tstep = 2 * hstep;
    const unsigned ldsw = (unsigned)wid * 1024u;
    const int aoff = lds_byte(wr * 64 + fr, fq * 8), boff = lds_byte(wc * 32 + fr, fq * 8);
#define PG8_SA(b, h) (((b) * 2 + (h)) * HTB)
#define PG8_SB(b, h) ((4 + (b) * 2 + (h)) * HTB)
#define PG8_STAGE(bufoff, gbase, voff) do { _Pragma("unroll") for (int _i = 0; _i < 2; ++_i) \
        __builtin_amdgcn_global_load_lds((const unsigned*)((const char*)(gbase) + (voff)[_i]), (LAS unsigned*)(lds + (bufoff) + ldsw + _i * 8192), 16, 0, 0); } while (0)
#define PG8_LDA(dst, b, h) do { _Pragma("unroll") for (int m = 0; m < 4; ++m) _Pragma("unroll") for (int k = 0; k < 2; ++k) dst[m][k] = *(const LAS bf16x8*)(lds + PG8_SA(b, h) + aoff + m * 2048 + k * 1024); } while (0)
#define PG8_LDB(dst, b, h) do { _Pragma("unroll") for (int n = 0; n < 2; ++n) _Pragma("unroll") for (int k = 0; k < 2; ++k) dst[n][k] = *(const LAS bf16x8*)(lds + PG8_SB(b, h) + boff + n * 2048 + k * 1024); } while (0)
#define PG8_MMA(ai, bj, At, Bt) do { __builtin_amdgcn_s_setprio(1); _Pragma("unroll") for (int m = 0; m < 4; ++m) _Pragma("unroll") for (int n = 0; n < 2; ++n) _Pragma("unroll") for (int k = 0; k < 2; ++k) \
        acc[ai][bj][m][n] = __builtin_amdgcn_mfma_f32_16x16x32_bf16(Bt[n][k], At[m][k], acc[ai][bj][m][n], 0, 0, 0); __builtin_amdgcn_s_setprio(0); } while (0)
#define PG8_WAIT_V(n) asm volatile("s_waitcnt vmcnt(" #n ")" ::: "memory")
#define PG8_WAIT_L(n) asm volatile("s_waitcnt lgkmcnt(" #n ")" ::: "memory")
#define PG8_BAR __builtin_amdgcn_s_barrier()
#define PG8_SCHED __builtin_amdgcn_sched_barrier(0)
    Unit cur, nxt; int ui = 0;
    if (!S.next(0, cur)) return;
    cur.pn = phys_pn(g, cur.pn);
    f32x4 acc[2][2][4][2];
#pragma unroll
    for (int a = 0; a < 2; ++a)
#pragma unroll
        for (int b = 0; b < 2; ++b)
#pragma unroll
            for (int m = 0; m < 4; ++m)
#pragma unroll
                for (int n = 0; n < 2; ++n) acc[a][b][m][n] = (f32x4){0.f, 0.f, 0.f, 0.f};
    bf16x8 At[4][2], B0[2][2], B1[2][2];
    const char* cA = a_ptr(g, cur, tstep); const char* cB = (const char*)g.Bt + (size_t)cur.pn * tstep;
    PG8_STAGE(PG8_SB(0, 0), cB, voffB); PG8_STAGE(PG8_SA(0, 0), cA, voffA); PG8_STAGE(PG8_SB(0, 1), cB + hstep, voffB); PG8_STAGE(PG8_SA(0, 1), cA + hstep, voffA);
    if (wr == 1) PG8_BAR;
    PG8_WAIT_V(4); PG8_BAR;
    PG8_STAGE(PG8_SB(1, 0), cB + kstep, voffB); PG8_STAGE(PG8_SA(1, 0), cA + kstep, voffA); PG8_STAGE(PG8_SB(1, 1), cB + hstep + kstep, voffB);
    PG8_WAIT_V(6); PG8_BAR;
    for (;;) {
        const bool has_next = S.next(ui + 1, nxt);
        if (has_next) nxt.pn = phys_pn(g, nxt.pn);
        const char* nA = has_next ? a_ptr(g, nxt, tstep) : cA; const char* nB = has_next ? (const char*)g.Bt + (size_t)nxt.pn * tstep : cB;
        for (int t = 0; t < nt; t += 2) {
            const bool last = (t == nt - 2);
            const char* a1 = cA + (size_t)(t + 1) * kstep;
            const char* a2 = last ? nA : cA + (size_t)(t + 2) * kstep; const char* b2 = last ? nB : cB + (size_t)(t + 2) * kstep;
            const char* a3 = a2 + kstep; const char* b3 = b2 + kstep;
            PG8_LDB(B0, 0, 0); PG8_SCHED; PG8_LDA(At, 0, 0); PG8_STAGE(PG8_SA(1, 1), a1 + hstep, voffA);
            PG8_WAIT_L(8); PG8_BAR; PG8_WAIT_L(0); PG8_MMA(0, 0, At, B0); PG8_BAR; PG8_SCHED;
            PG8_LDB(B1, 0, 1); PG8_STAGE(PG8_SB(0, 0), b2, voffB);
            PG8_BAR; PG8_WAIT_L(0); PG8_MMA(0, 1, At, B1); PG8_BAR;
            PG8_LDA(At, 0, 1); PG8_STAGE(PG8_SA(0, 0), a2, voffA);
            PG8_BAR; PG8_WAIT_L(0); PG8_MMA(1, 0, At, B0); PG8_BAR; PG8_SCHED;
            PG8_STAGE(PG8_SB(0, 1), b2 + hstep, voffB);
            PG8_WAIT_V(6); PG8_BAR; PG8_MMA(1, 1, At, B1); PG8_BAR;
            PG8_LDB(B0, 1, 0); PG8_SCHED; PG8_LDA(At, 1, 0); PG8_STAGE(PG8_SA(0, 1), a2 + hstep, voffA);
            PG8_WAIT_L(8); PG8_BAR; PG8_WAIT_L(0); PG8_MMA(0, 0, At, B0); PG8_BAR; PG8_SCHED;
            PG8_LDB(B1, 1, 1); PG8_STAGE(PG8_SB(1, 0), b3, voffB);
            PG8_BAR; PG8_WAIT_L(0); PG8_MMA(0, 1, At, B1); PG8_BAR;
            PG8_LDA(At, 1, 1); PG8_STAGE(PG8_SA(1, 0), a3, voffA);
            PG8_BAR; PG8_WAIT_L(0); PG8_MMA(1, 0, At, B0); PG8_BAR; PG8_SCHED;
            PG8_STAGE(PG8_SB(1, 1), b3 + hstep, voffB);
            PG8_WAIT_V(6); PG8_BAR; PG8_MMA(1, 1, At, B1); PG8_BAR;
        }
        E(acc, cur, wr, wc, fr, fq);
        if (!has_next) break;
#pragma unroll
        for (int a = 0; a < 2; ++a)
#pragma unroll
            for (int b = 0; b < 2; ++b)
#pragma unroll
                for (int m = 0; m < 4; ++m)
#pragma unroll
                    for (int n = 0; n < 2; ++n) acc[a][b][m][n] = (f32x4){0.f, 0.f, 0.f, 0.f};
        cur = nxt; cA = nA; cB = nB; ++ui;
    }
    PG8_WAIT_V(0);
    if (wr == 0) PG8_BAR;
    PG8_BAR;
#undef PG8_SA
#undef PG8_SB
#undef PG8_STAGE
#undef PG8_LDA
#undef PG8_LDB
#undef PG8_MMA
#undef PG8_WAIT_V
#undef PG8_WAIT_L
#undef PG8_BAR
#undef PG8_SCHED
}
}

template <class F>
__device__ __forceinline__ void sgemm_bf(LAS unsigned char* lds, const bf16_t* A, int lda, int row0, int M, const float* W, int ldw, int N, int K, int coloff, const F& f) {
    LAS float* As = (LAS float*)lds;
    LAS float* Ws = (LAS float*)(lds + 32 * 68 * 4);
    const int tid = TID(), ty = tid >> 4, tx = tid & 15;
    const int ntn = (N + 63) / 64, ntiles = (M / 64) * ntn;
    for (int tile = BID(); tile < ntiles; tile += gridDim.x) {
        const int tm = tile / ntn, tn = tile % ntn, r0 = row0 + tm * 64, n0 = tn * 64;
        f32x4 c0 = {0.f, 0.f, 0.f, 0.f}, c1 = {0.f, 0.f, 0.f, 0.f};
        for (int k0 = 0; k0 < K; k0 += 32) {
            __syncthreads();
            { const int r = tid >> 3, q = tid & 7; const f32x4 a = ld_bf4(A + (size_t)(r0 + r) * lda + k0 + 4 * q);
              As[(4 * q + 0) * 68 + r] = a[0]; As[(4 * q + 1) * 68 + r] = a[1]; As[(4 * q + 2) * 68 + r] = a[2]; As[(4 * q + 3) * 68 + r] = a[3]; }
            { const int kr = tid >> 4, c = tid & 15; f32x4 w = {0.f, 0.f, 0.f, 0.f}; if (n0 + 4 * c < N) w = *(const f32x4*)(W + (size_t)(k0 + kr) * ldw + n0 + 4 * c);
              *(LAS f32x4*)(Ws + kr * 68 + 4 * c) = w; }
            __syncthreads();
#pragma unroll 8
            for (int kk = 0; kk < 32; ++kk) {
                const f32x2 a = *(const LAS f32x2*)(As + kk * 68 + 2 * ty); const f32x4 b = *(const LAS f32x4*)(Ws + kk * 68 + 4 * tx);
                c0 += a.x * b; c1 += a.y * b;
            }
        }
        if (n0 + 4 * tx < N) { f.vec4(r0 + 2 * ty, n0 + 4 * tx + coloff, c0); f.vec4(r0 + 2 * ty + 1, n0 + 4 * tx + coloff, c1); }
    }
    __syncthreads();
}

typedef float f32x16 __attribute__((ext_vector_type(16)));
__device__ __forceinline__ int rw_group(int n0) { const int t = n0 >> 8; return t < 12 ? (t >> 2) : (t == 12 ? 2 : t - 10); }
template <bool RWGRP, class F>
__device__ __forceinline__ void wgemm_ks(LAS unsigned char* lds, const bf16_t* A, int lda, size_t agrp, int row0, int M, const bf16_t* Bt, int K, int N, const F& f, int wg0 = 0) {
    const int tid = TID(), wave = tid >> 6, lane = tid & 63, lr = lane & 31, lh = lane >> 5;
    LAS float* red = (LAS float*)lds;
    const int ntn = N / 64, nitems = (M / 32) * ntn, kw = K / 8, steps = kw / 16;
    const int vb_ = BID() - wg0, nwg_ = (int)gridDim.x - wg0;
    for (int item = vb_ < 0 ? nitems : vb_; item < nitems; item += nwg_) {
        const int tm = item / ntn, tn = item % ntn, r0 = row0 + tm * 32, n0 = tn * 64;
        const bf16_t* Ab = A + (RWGRP ? (size_t)rw_group(n0) * agrp : 0) + (size_t)(r0 + lr) * lda + wave * kw + lh * 8;
        const bf16_t* B0 = Bt + (size_t)(n0 + lr) * K + wave * kw + lh * 8; const bf16_t* B1 = B0 + (size_t)32 * K;
        f32x16 acc0, acc1;
#pragma unroll
        for (int r = 0; r < 16; ++r) { acc0[r] = 0.f; acc1[r] = 0.f; }
#pragma unroll 8
        for (int st = 0; st < steps; ++st) {
            const bf16x8 a = *(const bf16x8*)(Ab + 16 * st), b0 = *(const bf16x8*)(B0 + 16 * st), b1 = *(const bf16x8*)(B1 + 16 * st);
            acc0 = __builtin_amdgcn_mfma_f32_32x32x16_bf16(b0, a, acc0, 0, 0, 0);
            acc1 = __builtin_amdgcn_mfma_f32_32x32x16_bf16(b1, a, acc1, 0, 0, 0);
        }
        __syncthreads();
#pragma unroll
        for (int r = 0; r < 16; ++r) { red[((wave * 2 + 0) * 16 + r) * 64 + lane] = acc0[r]; red[((wave * 2 + 1) * 16 + r) * 64 + lane] = acc1[r]; }
        __syncthreads();
        { const int t = tid >> 8, r4 = (tid >> 6) & 3, l2 = tid & 63; f32x4 v = {0.f, 0.f, 0.f, 0.f};
#pragma unroll
          for (int w = 0; w < 8; ++w)
#pragma unroll
              for (int e = 0; e < 4; ++e) v[e] += red[((w * 2 + t) * 16 + 4 * r4 + e) * 64 + l2];
          f.vec4(r0 + (l2 & 31), n0 + 32 * t + 8 * r4 + 4 * (l2 >> 5), v); }
    }
    __syncthreads();
}
template <class F>
__device__ __forceinline__ void wgemm_w(const bf16_t* A, int lda, int row0, int M, const bf16_t* Bt, int K, int N, const F& f) {
    const int lane = TID() & 63, lr = lane & 31, lh = lane >> 5, gw = BID() * 8 + (TID() >> 6), nw = gridDim.x * 8;
    const int ntn = N / 64, nitems = (M / 32) * ntn, steps = K / 16;
    for (int item = gw; item < nitems; item += nw) {
        const int tm = item / ntn, tn = item % ntn, r0 = row0 + tm * 32, n0 = tn * 64;
        const bf16_t* Ab = A + (size_t)(r0 + lr) * lda + lh * 8;
        const bf16_t* B0 = Bt + (size_t)(n0 + lr) * K + lh * 8; const bf16_t* B1 = B0 + (size_t)32 * K;
        f32x16 acc0, acc1;
#pragma unroll
        for (int r = 0; r < 16; ++r) { acc0[r] = 0.f; acc1[r] = 0.f; }
        for (int st = 0; st < steps; ++st) {
            const bf16x8 a = *(const bf16x8*)(Ab + 16 * st), b0 = *(const bf16x8*)(B0 + 16 * st), b1 = *(const bf16x8*)(B1 + 16 * st);
            acc0 = __builtin_amdgcn_mfma_f32_32x32x16_bf16(b0, a, acc0, 0, 0, 0);
            acc1 = __builtin_amdgcn_mfma_f32_32x32x16_bf16(b1, a, acc1, 0, 0, 0);
        }
#pragma unroll
        for (int r4 = 0; r4 < 4; ++r4) {
            f.vec4(r0 + lr, n0 + 8 * r4 + 4 * lh, (f32x4){acc0[4 * r4], acc0[4 * r4 + 1], acc0[4 * r4 + 2], acc0[4 * r4 + 3]});
            f.vec4(r0 + lr, n0 + 32 + 8 * r4 + 4 * lh, (f32x4){acc1[4 * r4], acc1[4 * r4 + 1], acc1[4 * r4 + 2], acc1[4 * r4 + 3]});
        }
    }
}

struct FRwkvIn {
    bf16_t *rb, *kb, *vb, *tw, *ta, *tv, *tg;
    __device__ __forceinline__ void vec8(int row, int col, f32x4 a, f32x4 b) const {
        if (col < 3072) { u32x4 w; w.x = pk_bf16(a[0], a[1]); w.y = pk_bf16(a[2], a[3]); w.z = pk_bf16(b[0], b[1]); w.w = pk_bf16(b[2], b[3]);
            *(u32x4*)(rb + (size_t)(col >> 10) * XR_STRIDE + (size_t)row * D + (col & 1023)) = w; }
        else { vec4(row, col, a); vec4(row, col + 4, b); } }
    __device__ __forceinline__ void vec4(int row, int col, f32x4 v) const {
        if (col < 3072) { st_bf4(rb + (size_t)(col >> 10) * XR_STRIDE + (size_t)row * D + (col & 1023), v); }
        else if (col < 3328) { const int c = col - 3072; if (c < 32) st_bf4(tv + (size_t)row * 32 + c, v); }
        else if (col < 3584) { const int c = col - 3328; if (c < 64) { f32x4 t = {ftanh(v[0]), ftanh(v[1]), ftanh(v[2]), ftanh(v[3])}; st_bf4(tw + (size_t)row * 64 + c, t); } }
        else if (col < 3840) { const int c = col - 3584; if (c < 64) st_bf4(ta + (size_t)row * 64 + c, v); }
        else { const int c = col - 3840; if (c < 160) { f32x4 t = {fsig(v[0]), fsig(v[1]), fsig(v[2]), fsig(v[3])}; st_bf4(tg + (size_t)row * 160 + c, t); } }
    }
};
struct FStoreF32 { float* C; int ldc; int ncols; __device__ __forceinline__ void vec4(int row, int col, f32x4 v) const { if (col < ncols) *(f32x4*)(C + (size_t)row * ldc + col) = v; } };
struct FStoreBf16 { bf16_t* C; int ldc; int ncols;
    __device__ __forceinline__ void vec4(int row, int col, f32x4 v) const { if (col < ncols) st_bf4(C + (size_t)row * ldc + col, v); }
    __device__ __forceinline__ void vec8(int row, int col, f32x4 a, f32x4 b) const { if (col < ncols) { u32x4 w; w.x = pk_bf16(a[0], a[1]); w.y = pk_bf16(a[2], a[3]); w.z = pk_bf16(b[0], b[1]); w.w = pk_bf16(b[2], b[3]); *(u32x4*)(C + (size_t)row * ldc + col) = w; } } };
struct FResid {
    float* X; const float* gate;
    const float* xin_p; const float* xin_s;
    __device__ __forceinline__ void vec4(int row, int col, f32x4 v) const {
        const f32x4 g = *(const f32x4*)(gate + (size_t)row_seq(row) * 6144 + col); float* xp = X + (size_t)row * D + col;
        const float* ip = xin_p ? (row < NP ? xin_p + (size_t)row * D + col : xin_s + (size_t)(row - NP) * D + col) : xp;
        const f32x4 x = *(const f32x4*)ip; *(f32x4*)xp = x + g * v; }
};
struct FRelu2 { bf16_t* U;
    __device__ __forceinline__ void vec8(int row, int col, f32x4 a, f32x4 b) const {
        f32x4 s, t; for (int e = 0; e < 4; ++e) { const float x = fmaxf(a[e], 0.f), y = fmaxf(b[e], 0.f); s[e] = x * x; t[e] = y * y; }
        u32x4 w; w.x = pk_bf16(s[0], s[1]); w.y = pk_bf16(s[2], s[3]); w.z = pk_bf16(t[0], t[1]); w.w = pk_bf16(t[2], t[3]); *(u32x4*)(U + (size_t)row * DFF + col) = w; }
    __device__ __forceinline__ void vec4(int row, int col, f32x4 v) const {
        f32x4 t; for (int e = 0; e < 4; ++e) { const float r = fmaxf(v[e], 0.f); t[e] = r * r; } st_bf4(U + (size_t)row * DFF + col, t); } };

__device__ __forceinline__ void phase_copy_x(KP p) {
    const size_t n4p = (size_t)NP * D / 4, n4 = (size_t)NT * D / 4;
    for (size_t i = (size_t)BID() * 512 + TID(); i < n4; i += (size_t)gridDim.x * 512)
        ((f32x4*)p->out)[i] = i < n4p ? ((const f32x4*)p->x_prompt)[i] : ((const f32x4*)p->x_sample)[i - n4p];
}

struct TJob { const float* src; bf16_t* dst; int K, N, drow0; };
__device__ __forceinline__ TJob tjob(KP p, int i) {
    TJob t; t.drow0 = 0;
    if (i < 4) { t.src = p->w_up + (size_t)i * D * DFF; t.dst = WSP(bf16_t, WS_WUP_T) + (size_t)i * DFF * D; t.K = D; t.N = DFF; return t; }
    if (i < 8) { const int l = i - 4; t.src = p->w_down + (size_t)l * DFF * D; t.dst = WSP(bf16_t, WS_WDN_T) + (size_t)l * DFF * D; t.K = DFF; t.N = D; return t; }
    i -= 8; const int j = i / 14, k = i % 14; bf16_t* wrw = WSP(bf16_t, WS_WRW_T) + (size_t)j * 4096 * D;
    t.K = D; t.N = D;
    switch (k) {
        case 0: case 1: case 2: t.src = p->rw_w_rkv + ((size_t)j * 3 + k) * D * D; t.dst = wrw; t.drow0 = k * 1024; break;
        case 3: t.src = p->rw_v1; t.dst = wrw; t.drow0 = 3072; t.N = j == 1 ? 32 : 0; break;
        case 4: t.src = p->rw_w1 + (size_t)j * D * 64; t.dst = wrw; t.drow0 = 3328; t.N = 64; break;
        case 5: t.src = p->rw_a1 + (size_t)j * D * 64; t.dst = wrw; t.drow0 = 3584; t.N = 64; break;
        case 6: t.src = p->rw_g1 + (size_t)j * D * 160; t.dst = wrw; t.drow0 = 3840; t.N = 160; break;
        case 7: t.src = p->rw_w_o + (size_t)j * D * D; t.dst = WSP(bf16_t, WS_WO_T) + (size_t)j * D * D; break;
        case 8: t.src = p->rw_w2 + (size_t)j * 64 * D; t.dst = WSP(bf16_t, WS_W2T) + (size_t)j * D * 64; t.K = 64; break;
        case 9: t.src = p->rw_a2 + (size_t)j * 64 * D; t.dst = WSP(bf16_t, WS_A2T) + (size_t)j * D * 64; t.K = 64; break;
        case 10: t.src = p->rw_g2 + (size_t)j * 160 * D; t.dst = WSP(bf16_t, WS_G2T) + (size_t)j * D * 160; t.K = 160; break;
        case 11: t.src = p->rw_v2; t.dst = WSP(bf16_t, WS_V2T); t.K = 32; t.N = j == 1 ? D : 0; break;
        case 12: t.src = p->att_w_in + (size_t)j * D * PIN; t.dst = WSP(bf16_t, WS_WIN_T) + (size_t)j * PINP * D; t.N = PIN; break;
        default: t.src = p->att_w_o + (size_t)j * D * D; t.dst = WSP(bf16_t, WS_WAO_T) + (size_t)j * D * D; break;
    }
    return t;
}
__device__ __forceinline__ int tjob_tiles(const TJob& t) { return ((t.K + 63) / 64) * ((t.N + 63) / 64); }
__device__ __forceinline__ void phase_weights(KP p, LAS unsigned char* lds) {
    LAS float* T = (LAS float*)lds;
    int total = 0;
    for (int i = 0; i < 36; ++i) total += tjob_tiles(tjob(p, i));
    const int ngrp = (total + 3) / 4;
    f32x4 v[4][2];
    bf16_t* dstn[4]; int Kn[4], nlim[4], klim[4];
#define WT_ISSUE(G_) do { const int tid_ = TID(), kk_ = tid_ >> 4, n4_ = (tid_ & 15) * 4; \
        int i_ = 0, start_ = 0, cnt_ = tjob_tiles(tjob(p, 0)); \
        _Pragma("unroll") for (int u = 0; u < 4; ++u) { const int gt_ = 4 * (G_) + u; \
            while (i_ < 35 && gt_ >= start_ + cnt_) { start_ += cnt_; ++i_; cnt_ = tjob_tiles(tjob(p, i_)); } \
            const TJob tj_ = tjob(p, i_); const int lt_ = gt_ - start_, nkt_ = (tj_.K + 63) / 64; \
            const bool dead_ = gt_ >= total || lt_ >= cnt_; const int k0_ = dead_ ? 0 : (lt_ % nkt_) * 64, n0_ = dead_ ? 0 : (lt_ / nkt_) * 64; \
            dstn[u] = tj_.dst + (size_t)(tj_.drow0 + n0_) * tj_.K + k0_; Kn[u] = tj_.K; nlim[u] = dead_ ? 0 : tj_.N - n0_; klim[u] = dead_ ? 0 : tj_.K - k0_; \
            _Pragma("unroll") for (int hh = 0; hh < 2; ++hh) { const int k_ = k0_ + kk_ + 32 * hh, n_ = n0_ + n4_; \
                v[u][hh] = *(const f32x4*)(tj_.src + (size_t)min(k_, tj_.K - 1) * tj_.N + min(n_, tj_.N - 4)); } } } while (0)
    if (BID() < ngrp) WT_ISSUE(BID());
    for (int g = BID(); g < ngrp; g += gridDim.x) {
        const int tid = TID(), kk = tid >> 4, n4 = (tid & 15) * 4;
#pragma unroll
        for (int u = 0; u < 4; ++u)
#pragma unroll
            for (int hh = 0; hh < 2; ++hh)
#pragma unroll
                for (int e = 0; e < 4; ++e) T[(u * 64 + kk + 32 * hh) * 65 + n4 + e] = v[u][hh][e];
        bf16_t* dstc[4]; int Kc[4], nl[4], kl[4];
#pragma unroll
        for (int u = 0; u < 4; ++u) { dstc[u] = dstn[u]; Kc[u] = Kn[u]; nl[u] = nlim[u]; kl[u] = klim[u]; }
        if (g + (int)gridDim.x < ngrp) WT_ISSUE(g + (int)gridDim.x);
        asm volatile("s_waitcnt lgkmcnt(0)" ::: "memory"); __builtin_amdgcn_s_barrier(); asm volatile("" ::: "memory");
        const int nn = tid >> 3, k8 = (tid & 7) * 8;
#pragma unroll
        for (int u = 0; u < 4; ++u) {
            if (nn < nl[u] && k8 < kl[u]) {
                u32x4 w;
                w.x = pk_bf16(T[(u * 64 + k8 + 0) * 65 + nn], T[(u * 64 + k8 + 1) * 65 + nn]); w.y = pk_bf16(T[(u * 64 + k8 + 2) * 65 + nn], T[(u * 64 + k8 + 3) * 65 + nn]);
                w.z = pk_bf16(T[(u * 64 + k8 + 4) * 65 + nn], T[(u * 64 + k8 + 5) * 65 + nn]); w.w = pk_bf16(T[(u * 64 + k8 + 6) * 65 + nn], T[(u * 64 + k8 + 7) * 65 + nn]);
                *(u32x4*)(dstc[u] + (size_t)nn * Kc[u] + k8) = w;
            }
        }
        asm volatile("s_waitcnt lgkmcnt(0)" ::: "memory"); __builtin_amdgcn_s_barrier(); asm volatile("" ::: "memory");
    }
#undef WT_ISSUE
    __syncthreads();
}

__device__ __forceinline__ void phase_ada(KP p, LAS unsigned char* lds) {
    float* mods = WSP(float, WS_MODS);
    LAS float* red = (LAS float*)lds;
    const int tid = TID(), lane = tid & 63, w = tid >> 6, ln = lane & 15, lq = lane >> 4;
    float af[3][32];
#pragma unroll
    for (int m = 0; m < 3; ++m) {
        const int s = 16 * m + ln; const bool ok = s < 36;
        const float* cp = s < 4 ? p->c_prompt + (size_t)s * D : p->c_sample + (size_t)((ok ? s : 35) - 4) * D;
#pragma unroll
        for (int i = 0; i < 32; ++i) { const float cv = cp[128 * w + 4 * i + lq]; af[m][i] = ok ? cv * __builtin_amdgcn_rcpf(1.0f + __expf(-cv)) : 0.f; }
    }
    f32x2 wv[32];
#define ADA_LOAD(B_) do { const int l_ = (B_) / 192, cb_ = ((B_) % 192) * 32; const float* wp_ = p->w_ada + ((size_t)l_ * D + 128 * w + lq) * 6144 + cb_ + 2 * ln; \
        _Pragma("unroll") for (int i = 0; i < 32; ++i) wv[i] = *(const f32x2*)(wp_ + (size_t)(4 * i) * 6144); } while (0)
    if (BID() < 768) ADA_LOAD(BID());
    for (int B = BID(); B < 768; B += gridDim.x) {
        const int l = B / 192, cb = (B % 192) * 32;
        f32x4 acc[3][2];
#pragma unroll
        for (int m = 0; m < 3; ++m) { acc[m][0] = (f32x4){0.f, 0.f, 0.f, 0.f}; acc[m][1] = acc[m][0]; }
#pragma unroll
        for (int i = 0; i < 32; ++i)
#pragma unroll
            for (int m = 0; m < 3; ++m) {
                acc[m][0] = __builtin_amdgcn_mfma_f32_16x16x4f32(af[m][i], wv[i][0], acc[m][0], 0, 0, 0);
                acc[m][1] = __builtin_amdgcn_mfma_f32_16x16x4f32(af[m][i], wv[i][1], acc[m][1], 0, 0, 0);
            }
        if (B + (int)gridDim.x < 768) ADA_LOAD(B + (int)gridDim.x);
#pragma unroll
        for (int m = 0; m < 3; ++m)
#pragma unroll
            for (int r = 0; r < 4; ++r) { const int s = 16 * m + 4 * lq + r;
                if (s < 36) *(LAS f32x2*)(red + (w * 36 + s) * 32 + 2 * ln) = (f32x2){acc[m][0][r], acc[m][1][r]}; }
        asm volatile("s_waitcnt lgkmcnt(0)" ::: "memory"); __builtin_amdgcn_s_barrier(); asm volatile("" ::: "memory");
        for (int o = tid; o < 36 * 32; o += 512) { const int s = o >> 5, cc = o & 31;
            float v = 0.f;
#pragma unroll
            for (int ww = 0; ww < 8; ++ww) v += red[(ww * 36 + s) * 32 + cc];
            mods[((size_t)l * 36 + s) * 6144 + cb + cc] = v + p->b_ada[l * 6144 + cb + cc]; }
        asm volatile("s_waitcnt lgkmcnt(0)" ::: "memory"); __builtin_amdgcn_s_barrier(); asm volatile("" ::: "memory");
    }
#undef ADA_LOAD
    __syncthreads();
}

template <bool MIX>
__device__ __forceinline__ void phase_prep(KP p, int layer, int which, int j, bool first = false) {
    const float* X = p->out;
    const float* mods = WSP(float, WS_MODS) + (size_t)layer * 36 * 6144;
    const float* g = p->norm_g + (layer * 2 + which) * D;
    bf16_t* XR = WSP(bf16_t, WS_XR);
    const int lane = TID() & 63, gw = BID() * 8 + (TID() >> 6), nw = gridDim.x * 8;
    for (int run = gw; run < NP / 8 + NS; run += nw) {
        const int row0 = run < NP / 8 ? run * 8 : NP + (run - NP / 8), nrows = run < NP / 8 ? 8 : 1, seq = row_seq(row0);
        const float* sh = mods + (size_t)seq * 6144 + (which ? 3 : 0) * D; const float* sc = sh + D;
        f32x4 gv[4], scv[4], shv[4], hp[4];
#pragma unroll
        for (int i = 0; i < 4; ++i) { const int col = 512 * (i >> 1) + 8 * lane + 4 * (i & 1); gv[i] = *(const f32x4*)(g + col); scv[i] = *(const f32x4*)(sc + col) + 1.0f; shv[i] = *(const f32x4*)(sh + col); hp[i] = (f32x4){0.f, 0.f, 0.f, 0.f}; }
        int rstart = 0;
        if (MIX) {
            if (row0 >= NP && ((row0 - NP) & 7) == 0) {
#pragma unroll
                for (int i = 0; i < 4; ++i) hp[i] = *(const f32x4*)(p->state_shift + ((size_t)j * 32 + (seq - 4)) * D + 512 * (i >> 1) + 8 * lane + 4 * (i & 1));
            } else if (row0 >= NP || (row0 & 4095) != 0) rstart = -1;
        }
        f32x4 xn[4];
#define PREP_LOAD(ROW_) do { const int row_ = (ROW_); const float* xr_ = first ? (row_ < NP ? p->x_prompt + (size_t)row_ * D : p->x_sample + (size_t)(row_ - NP) * D) : X + (size_t)row_ * D; \
            _Pragma("unroll") for (int i = 0; i < 4; ++i) xn[i] = *(const f32x4*)(xr_ + 512 * (i >> 1) + 8 * lane + 4 * (i & 1)); } while (0)
        PREP_LOAD(row0 + rstart);
        for (int r = rstart; r < nrows; ++r) {
            const int row = row0 + r;
            f32x4 x[4]; float ss = 0.f;
#pragma unroll
            for (int i = 0; i < 4; ++i) x[i] = xn[i];
            if (r + 1 < nrows) PREP_LOAD(row + 1);
#pragma unroll
            for (int i = 0; i < 4; ++i) ss += x[i][0] * x[i][0] + x[i][1] * x[i][1] + x[i][2] * x[i][2] + x[i][3] * x[i][3];
            ss = wave_sum(ss);
            const float rstd = rsqrtf(ss * (1.0f / 1024.0f) + 1e-6f);
            f32x4 h[4];
#pragma unroll
            for (int i = 0; i < 4; ++i) h[i] = x[i] * rstd * gv[i] * scv[i] + shv[i];
            if (MIX) {
                if (r >= 0) {
#pragma unroll
                    for (int n = 0; n < 6; ++n) {
                        const int mi = n == 0 ? 0 : (n == 1 ? 2 : (n == 2 ? 3 : (n == 3 ? 1 : n)));
                        const float* mx = p->rw_mix + ((size_t)j * 6 + mi) * D;
#pragma unroll
                        for (int i2 = 0; i2 < 2; ++i2) { const int col = 512 * i2 + 8 * lane; const f32x4 m0 = *(const f32x4*)(mx + col), m1 = *(const f32x4*)(mx + col + 4);
                            const f32x4 a = h[2 * i2] + (hp[2 * i2] - h[2 * i2]) * m0, b2 = h[2 * i2 + 1] + (hp[2 * i2 + 1] - h[2 * i2 + 1]) * m1;
                            u32x4 w; w.x = pk_bf16(a[0], a[1]); w.y = pk_bf16(a[2], a[3]); w.z = pk_bf16(b2[0], b2[1]); w.w = pk_bf16(b2[2], b2[3]);
                            *(u32x4*)(XR + (size_t)n * XR_STRIDE + (size_t)row * D + col) = w; }
                    }
                    const bool lastp = row < NP && (row & 4095) == 4095, lasts = row >= NP && ((row - NP) & 7) == 7;
                    if (lastp || lasts) {
                        float* so = lastp ? p->out + O_SHP + ((size_t)j * 4 + seq) * D : p->out + O_SHS + ((size_t)j * 32 + (seq - 4)) * D;
#pragma unroll
                        for (int i = 0; i < 4; ++i) *(f32x4*)(so + 512 * (i >> 1) + 8 * lane + 4 * (i & 1)) = h[i];
                    }
                }
#pragma unroll
                for (int i = 0; i < 4; ++i) hp[i] = h[i];
            } else {
#pragma unroll
                for (int i2 = 0; i2 < 2; ++i2) { const f32x4 a = h[2 * i2], b2 = h[2 * i2 + 1]; u32x4 w; w.x = pk_bf16(a[0], a[1]); w.y = pk_bf16(a[2], a[3]); w.z = pk_bf16(b2[0], b2[1]); w.w = pk_bf16(b2[2], b2[3]);
                    *(u32x4*)(XR + (size_t)row * D + 512 * i2 + 8 * lane) = w; }
            }
        }
    }
}

#undef PREP_LOAD
__device__ __forceinline__ void phase_scanprep(KP p, int j) {
    const bf16_t *KB = WSP(bf16_t, WS_KB), *VB = WSP(bf16_t, WS_VB);
    const float *WPp = WSP(float, WS_WP), *APp = WSP(float, WS_AP), *VPp = WSP(float, WS_VP);
    float *VF = WSP(float, WS_VFIRST), *DEC = WSP(float, WS_DEC), *KM = WSP(float, WS_KM), *VM = WSP(float, WS_VM), *AV = WSP(float, WS_AV), *BV = WSP(float, WS_BV);
    const int lane = TID() & 63, gw = BID() * 8 + (TID() >> 6), nw = gridDim.x * 8;
    for (int row = gw; row < NT; row += nw) {
#pragma unroll
        for (int i = 0; i < 4; ++i) {
            const int col = 256 * i + 4 * lane; const size_t o = (size_t)row * D + col;
            const f32x4 k = ld_bf4(KB + o), v = ld_bf4(VB + o), wp = *(const f32x4*)(WPp + o), ap = *(const f32x4*)(APp + o);
            const f32x4 w0 = *(const f32x4*)(p->rw_w0 + j * D + col), a0 = *(const f32x4*)(p->rw_a0 + j * D + col), kkw = *(const f32x4*)(p->rw_k_k + j * D + col), kaw = *(const f32x4*)(p->rw_k_a + j * D + col);
            f32x4 dec, a, vm, kk, km;
#pragma unroll
            for (int e = 0; e < 4; ++e) {
                const float wpre = w0[e] + wp[e], z = -wpre, sp = fmaxf(z, 0.f) + log1pf(expf(-fabsf(z)));
                dec[e] = expf(-expf(-sp - 0.5f));
                a[e] = sigmoidf_(a0[e] + ap[e]);
                kk[e] = k[e] * kkw[e];
                km[e] = k[e] * (1.0f + (a[e] - 1.0f) * kaw[e]);
            }
            if (j == 0) { vm = v; *(f32x4*)(VF + o) = v; }
            else { const f32x4 vf = *(const f32x4*)(VF + o), vp = *(const f32x4*)(VPp + o), v0 = *(const f32x4*)(p->rw_v0 + (j - 1) * D + col);
#pragma unroll
                for (int e = 0; e < 4; ++e) vm[e] = v[e] + (vf[e] - v[e]) * sigmoidf_(v0[e] + vp[e]); }
            float ss = kk[0] * kk[0] + kk[1] * kk[1] + kk[2] * kk[2] + kk[3] * kk[3];
            ss = g16_sum(ss);
            const float inv = rsqrtf(fmaxf(ss, 1e-24f));
            kk = kk * inv;
            *(f32x4*)(DEC + o) = dec; *(f32x4*)(KM + o) = km; *(f32x4*)(VM + o) = vm; *(f32x4*)(AV + o) = -kk; *(f32x4*)(BV + o) = kk * a;
        }
    }
}

__device__ __forceinline__ float rl(float v, int k) { return __int_as_float(__builtin_amdgcn_readlane(__float_as_int(v), k)); }
__device__ __forceinline__ void scan_run(KP p, size_t row_base, int nsteps, int colbase, float (&S)[64]) {
    const float *DEC = WSP(float, WS_DEC), *KM = WSP(float, WS_KM), *VM = WSP(float, WS_VM), *AV = WSP(float, WS_AV), *BV = WSP(float, WS_BV);
    const bf16_t* RB = WSP(bf16_t, WS_RB); float* Y = WSP(float, WS_Y);
    const int lane = TID() & 63;
    size_t o = row_base * D + colbase + lane;
    float w = DEC[o], kx = KM[o], v = VM[o], a = AV[o], b = BV[o], r = bf2f(RB[o]);
    for (int t = 0; t < nsteps; ++t) {
        const size_t on = (t + 1 < nsteps) ? o + D : o;
        const float wn = DEC[on], kn = KM[on], vn = VM[on], an = AV[on], bn = BV[on], rn = bf2f(RB[on]);
        float sa = 0.f;
#pragma unroll
        for (int k = 0; k < 64; ++k) sa += S[k] * rl(a, k);
#pragma unroll
        for (int k = 0; k < 64; ++k) S[k] = S[k] * rl(w, k) + sa * rl(b, k) + v * rl(kx, k);
        float y = 0.f;
#pragma unroll
        for (int k = 0; k < 64; ++k) y += S[k] * rl(r, k);
        Y[o] = y;
        o = on; w = wn; kx = kn; v = vn; a = an; b = bn; r = rn;
    }
}
__device__ __forceinline__ void phase_scanA(KP p) {
    const float *DEC = WSP(float, WS_DEC), *KM = WSP(float, WS_KM), *VM = WSP(float, WS_VM), *AV = WSP(float, WS_AV), *BV = WSP(float, WS_BV);
    float *PCH = WSP(float, WS_PCH), *CCH = WSP(float, WS_CCH);
    const int lane = TID() & 63, gw = BID() * 8 + (TID() >> 6), nw = gridDim.x * 8;
    for (int it = gw; it < 64 * NCH; it += nw) {
        const int sh = it / NCH, c = it % NCH, b = sh >> 4, h = sh & 15;
        float SP[64], SC[64];
#pragma unroll
        for (int k = 0; k < 64; ++k) { SP[k] = (k == lane) ? 1.f : 0.f; SC[k] = 0.f; }
        size_t o = ((size_t)b * 4096 + (size_t)c * LCH) * D + h * 64 + lane;
        float w = DEC[o], kx = KM[o], v = VM[o], a = AV[o], bb = BV[o];
        for (int t = 0; t < LCH; ++t) {
            const size_t on = (t + 1 < LCH) ? o + D : o;
            const float wn = DEC[on], kn = KM[on], vn = VM[on], an = AV[on], bn = BV[on];
            float saP = 0.f, saC = 0.f;
#pragma unroll
            for (int k = 0; k < 64; ++k) { const float ak = rl(a, k); saP += SP[k] * ak; saC += SC[k] * ak; }
#pragma unroll
            for (int k = 0; k < 64; ++k) { const float wk = rl(w, k), bk = rl(bb, k); SP[k] = SP[k] * wk + saP * bk; SC[k] = SC[k] * wk + saC * bk + v * rl(kx, k); }
            o = on; w = wn; kx = kn; v = vn; a = an; bb = bn;
        }
        float* po = PCH + ((size_t)it * 64 + lane) * 64; float* co = CCH + ((size_t)it * 64 + lane) * 64;
#pragma unroll
        for (int k = 0; k < 64; k += 4) { *(f32x4*)(po + k) = (f32x4){SP[k], SP[k + 1], SP[k + 2], SP[k + 3]}; *(f32x4*)(co + k) = (f32x4){SC[k], SC[k + 1], SC[k + 2], SC[k + 3]}; }
    }
}
__device__ __forceinline__ void phase_scanB(KP p, int j, LAS unsigned char* lds) {
    const int tid = TID(), lane = tid & 63, wave = tid >> 6;
    if (BID() < 32) {
        const float *PCH = WSP(float, WS_PCH), *CCH = WSP(float, WS_CCH); float* SST = WSP(float, WS_SST);
        const int sh = BID() * 2 + (wave >> 2), q = wave & 3, row0 = 32 * (q >> 1), col0 = 32 * (q & 1), b = sh >> 4, h = sh & 15;
        LAS float* Sl = (LAS float*)lds + (wave >> 2) * (2 * 64 * 65);
        const int lr = lane & 31, lh = lane >> 5;
        f32x16 acc;
#pragma unroll
        for (int r = 0; r < 16; ++r) acc[r] = 0.f;
        for (int c = 0; c <= NCH; ++c) {
            LAS float* Sw = Sl + (c & 1) * (64 * 65);
            float* go = c < NCH ? SST + ((size_t)sh * NCH + c) * 4096 : p->out + O_WKVP + (((size_t)j * 4 + b) * 16 + h) * 4096;
#pragma unroll
            for (int r = 0; r < 16; ++r) { const int row = row0 + (r & 3) + 8 * (r >> 2) + 4 * lh; Sw[row * 65 + col0 + lr] = acc[r]; go[row * 64 + col0 + lr] = acc[r]; }
            if (c == NCH) break;
            const float* Pc = PCH + ((size_t)sh * NCH + c) * 4096; const float* Cc = CCH + ((size_t)sh * NCH + c) * 4096;
            float bv[32];
#pragma unroll
            for (int kk = 0; kk < 32; ++kk) bv[kk] = Pc[(2 * kk + lh) * 64 + col0 + lr];
#pragma unroll
            for (int r = 0; r < 16; ++r) acc[r] = Cc[(row0 + (r & 3) + 8 * (r >> 2) + 4 * lh) * 64 + col0 + lr];
            __syncthreads();
#pragma unroll
            for (int kk = 0; kk < 32; ++kk) acc = __builtin_amdgcn_mfma_f32_32x32x2f32(Sw[(row0 + lr) * 65 + 2 * kk + lh], bv[kk], acc, 0, 0, 0);
        }
    } else {
        for (int it = (BID() - 32) * 8 + wave; it < 512; it += (gridDim.x - 32) * 8) {
            const int b = it >> 4, h = it & 15;
            const float* s0 = p->state_wkv + (((size_t)j * 32 + b) * 16 + h) * 4096 + lane * 64;
            float S[64];
#pragma unroll
            for (int k = 0; k < 64; k += 4) { const f32x4 t = *(const f32x4*)(s0 + k); S[k] = t[0]; S[k + 1] = t[1]; S[k + 2] = t[2]; S[k + 3] = t[3]; }
            scan_run(p, (size_t)NP + b * 8, 8, h * 64, S);
            float* o = p->out + O_WKVS + (((size_t)j * 32 + b) * 16 + h) * 4096 + lane * 64;
#pragma unroll
            for (int k = 0; k < 64; k += 4) *(f32x4*)(o + k) = (f32x4){S[k], S[k + 1], S[k + 2], S[k + 3]};
        }
    }
    __syncthreads();
}
__device__ __forceinline__ void phase_scanC(KP p) {
    const float* SST = WSP(float, WS_SST);
    const int lane = TID() & 63, gw = BID() * 8 + (TID() >> 6), nw = gridDim.x * 8;
    for (int it = gw; it < 64 * NCH; it += nw) {
        const int sh = it / NCH, c = it % NCH, b = sh >> 4, h = sh & 15;
        const float* s0 = SST + ((size_t)it * 64 + lane) * 64;
        float S[64];
#pragma unroll
        for (int k = 0; k < 64; k += 4) { const f32x4 t = *(const f32x4*)(s0 + k); S[k] = t[0]; S[k + 1] = t[1]; S[k + 2] = t[2]; S[k + 3] = t[3]; }
        scan_run(p, (size_t)b * 4096 + (size_t)c * LCH, LCH, h * 64, S);
    }
}


constexpr int CST = 72;
constexpr int CMAT = 64 * CST * 2;
constexpr int CH_F32 = 11 * CMAT, CH_PART = CH_F32 + 64 * 68 * 4, CH_GL = CH_PART + 64 * 4 * 4;
__device__ __forceinline__ bf16x8 cfrag(const LAS bf16_t* M, int row, int ks, int c4) { return *(const LAS bf16x8*)(M + row * CST + 32 * ks + 8 * c4); }
__device__ __forceinline__ f32x4 cmm(const LAS bf16_t* A, int arow, const LAS bf16_t* B, int brow, int c4, f32x4 acc) {
    acc = __builtin_amdgcn_mfma_f32_16x16x32_bf16(cfrag(A, arow, 0, c4), cfrag(B, brow, 0, c4), acc, 0, 0, 0);
    return __builtin_amdgcn_mfma_f32_16x16x32_bf16(cfrag(A, arow, 1, c4), cfrag(B, brow, 1, c4), acc, 0, 0, 0); }
__device__ __forceinline__ unsigned short f2bf(float x) { return (unsigned short)(pk_bf16(x, 0.f) & 0xffffu); }
__device__ __forceinline__ void st_t4(LAS bf16_t* Mt, int d, int t0, f32x4 v) { u32x2 w; w.x = pk_bf16(v[0], v[1]); w.y = pk_bf16(v[2], v[3]); *(LAS u32x2*)(Mt + d * CST + t0) = w; }

__device__ __forceinline__ void phase_chunk(KP p, int j, LAS unsigned char* lds) {
    LAS bf16_t* Mx = (LAS bf16_t*)lds;
#define CM(i) (Mx + (i) * (64 * CST))
    LAS float* F32 = (LAS float*)(lds + CH_F32);
    asm volatile("" : "+v"(F32));
    LAS float* part = (LAS float*)(lds + CH_PART);
    LAS float* gLs = (LAS float*)(lds + CH_GL);
    const bf16_t *RB = WSP(bf16_t, WS_RB), *KB = WSP(bf16_t, WS_KB), *VB = WSP(bf16_t, WS_VB), *TW = WSP(bf16_t, WS_TW), *TA_ = WSP(bf16_t, WS_TA), *TV = WSP(bf16_t, WS_TV);
    const bf16_t *W2T = WSP(bf16_t, WS_W2T) + (size_t)j * D * 64, *A2T = WSP(bf16_t, WS_A2T) + (size_t)j * D * 64, *V2T = WSP(bf16_t, WS_V2T);
    float* VF = WSP(float, WS_VFIRST); float *PCH = WSP(float, WS_PCH), *CCH = WSP(float, WS_CCH), *Y0 = WSP(float, WS_Y), *BON = WSP(float, WS_AV);
    bf16_t *GM = WSP(bf16_t, WS_DEC), *VM2 = WSP(bf16_t, WS_KM);
#define CH_BAR() do { asm volatile("s_waitcnt lgkmcnt(0)" ::: "memory"); __builtin_amdgcn_s_barrier(); asm volatile("" ::: "memory"); } while (0)
    bf16x8 f_aw[2], f_aa[2], f_av; unsigned short e_k[2][4], e_v[2][4], e_r[2][4];
    f_av = (bf16x8){0, 0, 0, 0, 0, 0, 0, 0};
#define CH_PREFETCH(itx) do { const int tid_ = TID(), lane_ = tid_ & 63, w_ = tid_ >> 6, n_ = lane_ & 15, c4_ = lane_ >> 4, tr_ = w_ >> 1, tcb_ = 2 * (w_ & 1); \
        const int sh_ = (itx) / NCH, c_ = (itx) % NCH, R0_ = (sh_ >> 4) * 4096 + c_ * LCH, hc_ = (sh_ & 15) * 64; const int ar_ = 16 * tr_ + n_; \
        _Pragma("unroll") for (int ks = 0; ks < 2; ++ks) { f_aw[ks] = *(const bf16x8*)(TW + (size_t)R0_ * 64 + ar_ * 64 + 32 * ks + 8 * c4_); f_aa[ks] = *(const bf16x8*)(TA_ + (size_t)R0_ * 64 + ar_ * 64 + 32 * ks + 8 * c4_); } \
        if (j == 1) f_av = *(const bf16x8*)(TV + (size_t)R0_ * 32 + ar_ * 32 + 8 * c4_); \
        _Pragma("unroll") for (int ti = 0; ti < 2; ++ti) _Pragma("unroll") for (int r = 0; r < 4; ++r) { const size_t o_ = (size_t)R0_ * D + hc_ + (16 * tr_ + 4 * c4_ + r) * D + 16 * (tcb_ + ti) + n_; \
            e_k[ti][r] = KB[o_]; e_v[ti][r] = VB[o_]; e_r[ti][r] = RB[o_]; } } while (0)
#define CH_MAP(q_) (((((q_) >> 4) & 3) * 16 + ((q_) & 15)) * NCH + ((q_) >> 6))
    if (BID() < 64 * NCH) CH_PREFETCH(CH_MAP(BID()));
    for (int q = BID(); q < 64 * NCH; q += gridDim.x) {
        const int it = CH_MAP(q);
        const int tid = TID(), lane = tid & 63, w = tid >> 6, n = lane & 15, c4 = lane >> 4, tr = w >> 1, tcb = 2 * (w & 1);
        const int sh = it / NCH, c = it % NCH, b = sh >> 4, h = sh & 15, R0 = b * 4096 + c * LCH, hc = h * 64;
        const bf16_t *KBb = KB + (size_t)R0 * D + hc, *VBb = VB + (size_t)R0 * D + hc, *RBb = RB + (size_t)R0 * D + hc;
        bf16_t* VFb = (bf16_t*)VF + (size_t)R0 * D + hc; bf16_t* VM2b = VM2 + (size_t)R0 * D + hc; bf16_t* GMb = GM + (size_t)R0 * D + hc; bf16_t* Y0b = (bf16_t*)Y0 + (size_t)R0 * D + hc;
        float* PCb = PCH + (size_t)it * 4096; float* CCb = CCH + (size_t)it * 4096; float* BONb = BON + (size_t)R0 * 16 + h;
        const bf16_t *TWb = TW + (size_t)R0 * 64, *TAb = TA_ + (size_t)R0 * 64, *TVb = TV + (size_t)R0 * 32, *W2b = W2T + (size_t)hc * 64, *A2b = A2T + (size_t)hc * 64, *V2b = V2T + (size_t)hc * 32;
        const float *w0b = p->rw_w0 + j * D + hc, *a0b = p->rw_a0 + j * D + hc, *kkb = p->rw_k_k + j * D + hc, *kab = p->rw_k_a + j * D + hc, *rkb = p->rw_r_k + j * D + hc, *v0b = p->rw_v0 + (j ? (j - 1) : 0) * D + hc;
        f32x4 wp[2], ap[2], vp[2];
#pragma unroll
        for (int ti = 0; ti < 2; ++ti) { wp[ti] = (f32x4){0.f, 0.f, 0.f, 0.f}; ap[ti] = wp[ti]; vp[ti] = wp[ti]; }
        {   const int ar = 16 * tr + n;
#pragma unroll
            for (int ks = 0; ks < 2; ++ks) {
                const bf16x8 aw = f_aw[ks], aa = f_aa[ks];
#pragma unroll
                for (int ti = 0; ti < 2; ++ti) { const int br = 16 * (tcb + ti) + n;
                    wp[ti] = __builtin_amdgcn_mfma_f32_16x16x32_bf16(aw, *(const bf16x8*)(W2b + br * 64 + 32 * ks + 8 * c4), wp[ti], 0, 0, 0);
                    ap[ti] = __builtin_amdgcn_mfma_f32_16x16x32_bf16(aa, *(const bf16x8*)(A2b + br * 64 + 32 * ks + 8 * c4), ap[ti], 0, 0, 0); }
            }
            if (j == 1) { const bf16x8 av = f_av;
#pragma unroll
                for (int ti = 0; ti < 2; ++ti) vp[ti] = __builtin_amdgcn_mfma_f32_16x16x32_bf16(av, *(const bf16x8*)(V2b + (16 * (tcb + ti) + n) * 32 + 8 * c4), vp[ti], 0, 0, 0); }
        }
        f32x4 lw[2], asg[2], kkv[2], kpr[2], vpr[2], rr[2];
        float ssq[4] = {0.f, 0.f, 0.f, 0.f}, bon[4] = {0.f, 0.f, 0.f, 0.f};
        float vf8[2][4];
#pragma unroll
        for (int ti = 0; ti < 2; ++ti)
#pragma unroll
            for (int r = 0; r < 4; ++r) vf8[ti][r] = 0.f;
        if (j == 1) {
#pragma unroll
            for (int ti = 0; ti < 2; ++ti)
#pragma unroll
                for (int r = 0; r < 4; ++r) vf8[ti][r] = bf2f(VFb[(16 * tr + 4 * c4 + r) * D + 16 * (tcb + ti) + n]);
        }
#pragma unroll
        for (int ti = 0; ti < 2; ++ti) {
            const int d = 16 * (tcb + ti) + n;
            const float w0 = w0b[d], a0 = a0b[d], kkw = kkb[d], kaw = kab[d], rkw = rkb[d];
            const float v0 = j ? v0b[d] : 0.f;
#pragma unroll
            for (int r = 0; r < 4; ++r) {
                const int o = (16 * tr + 4 * c4 + r) * D + d;
                const float kx = bf2f(e_k[ti][r]), vx = bf2f(e_v[ti][r]), rx = bf2f(e_r[ti][r]);
                const float z = -(w0 + wp[ti][r]), sp = fmaxf(z, 0.f) + __logf(1.0f + __expf(-fabsf(z)));
                lw[ti][r] = -__expf(-sp - 0.5f);
                const float a = fsig(a0 + ap[ti][r]);
                asg[ti][r] = a;
                float vv = vx;
                if (j == 0) VFb[o] = e_v[ti][r]; else { const float vf = vf8[ti][r]; vv = vx + (vf - vx) * fsig(v0 + vp[ti][r]); }
                vpr[ti][r] = vv; rr[ti][r] = rx;
                const float kk = kx * kkw; kkv[ti][r] = kk; ssq[r] += kk * kk;
                const float kp = kx * (1.0f + (a - 1.0f) * kaw); kpr[ti][r] = kp; bon[r] += rx * kp * rkw;
                F32[(16 * tr + 4 * c4 + r) * 68 + d] = lw[ti][r];
                VM2b[o] = f2bf(vv);
            }
        }
#pragma unroll
        for (int r = 0; r < 4; ++r) { ssq[r] = g16_sum(ssq[r]); bon[r] = g16_sum(bon[r]); }
        if (n == 0) {
#pragma unroll
            for (int r = 0; r < 4; ++r) { const int t = 16 * tr + 4 * c4 + r; part[(t * 2 + (w & 1)) * 2 + 0] = ssq[r]; part[(t * 2 + (w & 1)) * 2 + 1] = bon[r]; }
        }
        if (q + (int)gridDim.x < 64 * NCH) CH_PREFETCH(CH_MAP(q + (int)gridDim.x));
        CH_BAR();
        f32x4 cs[2];
#pragma unroll
        for (int ti = 0; ti < 2; ++ti) {
            f32x4 acc = {0.f, 0.f, 0.f, 0.f};
            for (int q = 0; q < 4 * (tr + 1); ++q) {
                const float av = (4 * q + c4 <= 16 * tr + n) ? 1.0f : 0.0f;
                acc = __builtin_amdgcn_mfma_f32_16x16x4f32(av, F32[(4 * q + c4) * 68 + 16 * (tcb + ti) + n], acc, 0, 0, 0);
            }
            cs[ti] = acc;
        }
        float inv[4];
#pragma unroll
        for (int r = 0; r < 4; ++r) { const int t = 16 * tr + 4 * c4 + r; inv[r] = rsqrtf(fmaxf(part[(t * 2 + 0) * 2] + part[(t * 2 + 1) * 2], 1e-24f));
            if (n == 0 && (w & 1) == 0) BONb[t * 16] = part[(t * 2 + 0) * 2 + 1] + part[(t * 2 + 1) * 2 + 1]; }
        f32x4 rt[2];
#pragma unroll
        for (int ti = 0; ti < 2; ++ti) {
            const int d = 16 * (tcb + ti) + n, t0 = 16 * tr + 4 * c4;
            f32x4 at, bt, kt;
#pragma unroll
            for (int r = 0; r < 4; ++r) {
                const float g = __expf(cs[ti][r]), gi = __expf(-cs[ti][r]), gm = __expf(cs[ti][r] - lw[ti][r]);
                const float kk = kkv[ti][r] * inv[r];
                at[r] = -kk * gm; bt[r] = kk * asg[ti][r] * gi; kt[r] = kpr[ti][r] * gi; rt[ti][r] = rr[ti][r] * g;
                CM(0)[(t0 + r) * CST + d] = f2bf(at[r]); CM(1)[(t0 + r) * CST + d] = f2bf(bt[r]); CM(2)[(t0 + r) * CST + d] = f2bf(kt[r]); CM(3)[(t0 + r) * CST + d] = f2bf(rt[ti][r]);
                if (t0 + r == 63) gLs[d] = g;
            }
            st_t4(CM(4), d, t0, at); st_t4(CM(5), d, t0, bt); st_t4(CM(6), d, t0, kt); st_t4(CM(7), d, t0, vpr[ti]);
        }
        CH_BAR();
#pragma unroll
        for (int ti = 0; ti < 2; ++ti) {
            const int tc = tcb + ti, s = 16 * tc + n, t0 = 16 * tr + 4 * c4;
            if (tc <= tr) {
                { f32x4 m = {0.f, 0.f, 0.f, 0.f}; m = cmm(CM(0), 16 * tr + n, CM(1), 16 * tc + n, c4, m);
#pragma unroll
                  for (int r = 0; r < 4; ++r) F32[(t0 + r) * 68 + s] = (s < t0 + r) ? m[r] : 0.f; }
                asm volatile("" ::: "memory");
                { f32x4 m = {0.f, 0.f, 0.f, 0.f}; m = cmm(CM(0), 16 * tr + n, CM(2), 16 * tc + n, c4, m);
#pragma unroll
                  for (int r = 0; r < 4; ++r) CM(8)[(t0 + r) * CST + s] = f2bf((s < t0 + r) ? m[r] : 0.f); }
                asm volatile("" ::: "memory");
                { f32x4 m = {0.f, 0.f, 0.f, 0.f}; m = cmm(CM(3), 16 * tr + n, CM(1), 16 * tc + n, c4, m);
#pragma unroll
                  for (int r = 0; r < 4; ++r) CM(9)[(t0 + r) * CST + s] = f2bf((s <= t0 + r) ? m[r] : 0.f); }
                asm volatile("" ::: "memory");
                { f32x4 m = {0.f, 0.f, 0.f, 0.f}; m = cmm(CM(3), 16 * tr + n, CM(2), 16 * tc + n, c4, m);
#pragma unroll
                  for (int r = 0; r < 4; ++r) CM(10)[(t0 + r) * CST + s] = f2bf((s <= t0 + r) ? m[r] : 0.f); }
                asm volatile("" ::: "memory");
            } else {
#pragma unroll
                for (int r = 0; r < 4; ++r) { F32[(t0 + r) * 68 + s] = 0.f; CM(8)[(t0 + r) * CST + s] = 0; CM(9)[(t0 + r) * CST + s] = 0; CM(10)[(t0 + r) * CST + s] = 0; }
            }
        }
        CH_BAR();
        { const int e0 = tid * 8;
#pragma unroll
          for (int e = 0; e < 8; ++e) { const int t = (e0 + e) >> 6, s_ = (e0 + e) & 63; CM(2)[t * CST + s_] = f2bf(F32[t * 68 + s_]); }
          unsigned z_ = 0u; asm volatile("" : "+v"(z_));
          *(LAS u32x4*)(CM(0) + (e0 >> 6) * CST + (e0 & 63)) = (u32x4){z_, z_, z_, z_}; }
        CH_BAR();
        if (w < 4) {
            const int cw = 16 * w;
            LAS float* scr = (LAS float*)CM(1) + w * (16 * 17);
#pragma unroll 1
            for (int I = 0; I < 4; ++I) {
                f32x4 rh = {0.f, 0.f, 0.f, 0.f};
                if (I > 0) { rh = __builtin_amdgcn_mfma_f32_16x16x32_bf16(cfrag(CM(2), 16 * I + n, 0, c4), cfrag(CM(0), cw + n, 0, c4), rh, 0, 0, 0);
                    if (I > 2) rh = __builtin_amdgcn_mfma_f32_16x16x32_bf16(cfrag(CM(2), 16 * I + n, 1, c4), cfrag(CM(0), cw + n, 1, c4), rh, 0, 0, 0); }
#pragma unroll
                for (int r = 0; r < 4; ++r) scr[(4 * c4 + r) * 17 + n] = rh[r] + ((16 * I + 4 * c4 + r) == (cw + n) ? 1.f : 0.f);
                wave_lds_fence();
                float x[16];
#pragma unroll
                for (int i = 0; i < 16; ++i) x[i] = scr[i * 17 + n];
                f32x4 mc[4], mn[4];
                mc[0] = *(const LAS f32x4*)(F32 + (16 * I + 1) * 68 + 16 * I);
#pragma unroll
                for (int i = 1; i < 16; ++i) {
                    if (i + 1 < 16) {
#pragma unroll
                        for (int j4 = 0; j4 < (i + 4) / 4; ++j4) mn[j4] = *(const LAS f32x4*)(F32 + (16 * I + i + 1) * 68 + 16 * I + 4 * j4);
                    }
                    float a0 = 0.f, a1 = 0.f;
#pragma unroll
                    for (int j4 = 0; j4 < (i + 3) / 4; ++j4) {
                        if (4 * j4 + 0 < i) a0 += mc[j4][0] * x[4 * j4 + 0];
                        if (4 * j4 + 1 < i) a1 += mc[j4][1] * x[4 * j4 + 1];
                        if (4 * j4 + 2 < i) a0 += mc[j4][2] * x[4 * j4 + 2];
                        if (4 * j4 + 3 < i) a1 += mc[j4][3] * x[4 * j4 + 3];
                    }
                    x[i] += a0 + a1;
#pragma unroll
                    for (int j4 = 0; j4 < 4; ++j4) mc[j4] = mn[j4];
                    asm volatile("" ::: "memory");
                }
                if (c4 == 0) {
#pragma unroll
                    for (int i = 0; i < 16; ++i) CM(3)[(16 * I + i) * CST + cw + n] = f2bf(x[i]);
                    u32x4 t0, t1;
                    t0.x = pk_bf16(x[0], x[1]); t0.y = pk_bf16(x[2], x[3]); t0.z = pk_bf16(x[4], x[5]); t0.w = pk_bf16(x[6], x[7]);
                    t1.x = pk_bf16(x[8], x[9]); t1.y = pk_bf16(x[10], x[11]); t1.z = pk_bf16(x[12], x[13]); t1.w = pk_bf16(x[14], x[15]);
                    *(LAS u32x4*)(CM(0) + (cw + n) * CST + 16 * I) = t0; *(LAS u32x4*)(CM(0) + (cw + n) * CST + 16 * I + 8) = t1;
                }
                wave_lds_fence();
            }
        }
        CH_BAR();
#pragma unroll
        for (int ti = 0; ti < 2; ++ti) {
            const int d = 16 * (tcb + ti) + n;
            { f32x4 x1 = {0.f, 0.f, 0.f, 0.f}; x1 = cmm(CM(8), 16 * tr + n, CM(7), 16 * (tcb + ti) + n, c4, x1); st_t4(CM(0), d, 16 * tr + 4 * c4, x1); }
            asm volatile("" ::: "memory");
            { f32x4 ta = {0.f, 0.f, 0.f, 0.f}; ta = cmm(CM(3), 16 * tr + n, CM(4), 16 * (tcb + ti) + n, c4, ta); st_t4(CM(1), d, 16 * tr + 4 * c4, ta); }
            asm volatile("" ::: "memory");
        }
        CH_BAR();
#pragma unroll
        for (int ti = 0; ti < 2; ++ti) {
            f32x4 uv = {0.f, 0.f, 0.f, 0.f};
            uv = cmm(CM(3), 16 * tr + n, CM(0), 16 * (tcb + ti) + n, c4, uv);
            st_t4(CM(2), 16 * (tcb + ti) + n, 16 * tr + 4 * c4, uv);
        }
        CH_BAR();
#pragma unroll
        for (int ti = 0; ti < 2; ++ti) {
            const int cc = 16 * (tcb + ti) + n, r0 = 16 * tr + 4 * c4;
            const float gl = gLs[cc];
            { f32x4 pm = {0.f, 0.f, 0.f, 0.f}; pm = cmm(CM(1), 16 * tr + n, CM(5), cc, c4, pm);
#pragma unroll
              for (int r = 0; r < 4; ++r) PCb[(r0 + r) * 64 + cc] = (pm[r] + ((r0 + r) == cc ? 1.f : 0.f)) * gl; }
            asm volatile("" ::: "memory");
            { f32x4 cm_ = {0.f, 0.f, 0.f, 0.f}; cm_ = cmm(CM(2), 16 * tr + n, CM(5), cc, c4, cm_); cm_ = cmm(CM(7), 16 * tr + n, CM(6), cc, c4, cm_);
#pragma unroll
              for (int r = 0; r < 4; ++r) CCb[(r0 + r) * 64 + cc] = cm_[r] * gl; }
            asm volatile("" ::: "memory");
            { f32x4 gg = {0.f, 0.f, 0.f, 0.f}; gg = cmm(CM(9), 16 * tr + n, CM(1), cc, c4, gg);
#pragma unroll
              for (int r = 0; r < 4; ++r) GMb[(r0 + r) * D + cc] = f2bf(gg[r] + rt[ti][r]); }
            asm volatile("" ::: "memory");
            { f32x4 y0 = {0.f, 0.f, 0.f, 0.f}; y0 = cmm(CM(9), 16 * tr + n, CM(2), cc, c4, y0); y0 = cmm(CM(10), 16 * tr + n, CM(7), cc, c4, y0);
#pragma unroll
              for (int r = 0; r < 4; ++r) Y0b[(r0 + r) * D + cc] = f2bf(y0[r]); }
            asm volatile("" ::: "memory");
        }
        CH_BAR();
    }
#undef CM
#undef CH_PREFETCH
#undef CH_BAR
}

__device__ __forceinline__ void phase_sample_mixer_w(KP p, int j, int first, int stride) {
    const int tid = TID(), lane = tid & 63;
    {
        const bf16_t *RB = WSP(bf16_t, WS_RB), *KB = WSP(bf16_t, WS_KB), *VB = WSP(bf16_t, WS_VB); bf16_t* YG = WSP(bf16_t, WS_YG);
        const float *WPp = WSP(float, WS_WP), *APp = WSP(float, WS_AP), *VPp = WSP(float, WS_VP), *GG = WSP(float, WS_GG); float* VF = WSP(float, WS_VFIRST);
        for (int it = first; it < 512; it += stride) {
            const int b = it >> 4, h = it & 15, col = h * 64 + lane;
            const float* s0 = p->state_wkv + (((size_t)j * 32 + b) * 16 + h) * 4096 + lane * 64;
            float S[64];
#pragma unroll
            for (int k = 0; k < 64; k += 4) { const f32x4 t = *(const f32x4*)(s0 + k); S[k] = t[0]; S[k + 1] = t[1]; S[k + 2] = t[2]; S[k + 3] = t[3]; }
            const float w0 = p->rw_w0[j * D + col], a0 = p->rw_a0[j * D + col], kkw = p->rw_k_k[j * D + col], kaw = p->rw_k_a[j * D + col], rkw = p->rw_r_k[j * D + col];
            const float v0 = j ? p->rw_v0[(j - 1) * D + col] : 0.f, lnw = p->rw_lnx_w[j * D + col], lnb = p->rw_lnx_b[j * D + col];
            for (int t = 0; t < 8; ++t) {
                const size_t o = (size_t)(NP + b * 8 + t) * D + col;
                const float kx = bf2f(KB[o]), vx = bf2f(VB[o]), r = bf2f(RB[o]);
                const float z = -(w0 + WPp[o]), sp = fmaxf(z, 0.f) + log1pf(expf(-fabsf(z)));
                const float wd = expf(-expf(-sp - 0.5f)), asg = sigmoidf_(a0 + APp[o]);
                float v = vx;
                if (j == 0) VF[o] = vx; else { const float vf = VF[o]; v = vx + (vf - vx) * sigmoidf_(v0 + VPp[o]); }
                float kk = kx * kkw; const float ss = wave_sum(kk * kk); kk *= rsqrtf(fmaxf(ss, 1e-24f));
                const float kp = kx * (1.0f + (asg - 1.0f) * kaw), a = -kk, bq = kk * asg;
                float sa = 0.f;
#pragma unroll
                for (int k = 0; k < 64; ++k) sa += S[k] * rl(a, k);
#pragma unroll
                for (int k = 0; k < 64; ++k) S[k] = S[k] * rl(wd, k) + sa * rl(bq, k) + v * rl(kp, k);
                float y = 0.f;
#pragma unroll
                for (int k = 0; k < 64; ++k) y += S[k] * rl(r, k);
                const float mu = wave_sum(y) * (1.0f / 64.0f), dy = y - mu, var = wave_sum(dy * dy) * (1.0f / 64.0f);
                const float bonus = wave_sum(r * kp * rkw);
                YG[o] = f2bf((dy * rsqrtf(var + 64e-5f) * lnw + lnb + bonus * v) * GG[o]);
            }
            float* so = p->out + O_WKVS + (((size_t)j * 32 + b) * 16 + h) * 4096 + lane * 64;
#pragma unroll
            for (int k = 0; k < 64; k += 4) *(f32x4*)(so + k) = (f32x4){S[k], S[k + 1], S[k + 2], S[k + 3]};
        }
    }
}
__device__ __forceinline__ void phase_carry(KP p, int j, LAS unsigned char* lds) {
    const float *PCH = WSP(float, WS_PCH), *CCH = WSP(float, WS_CCH); float* SST = WSP(float, WS_SST);
    LAS float* Sl = (LAS float*)lds;
    LAS unsigned* cflag = (LAS unsigned*)(lds + 9216);
    if (TID() == 0) *cflag = 0u;
    __syncthreads();
    unsigned arrivals = 0u;
    if ((TID() >> 6) >= 4) { phase_sample_mixer_w(p, j, BID() * 4 + ((TID() >> 6) - 4), (int)gridDim.x * 4); }
    else
    for (int it = BID(); it < 256; it += gridDim.x) {
        const int wave = TID() >> 6, sh = it >> 2, row0 = 16 * (it & 3), col0 = 16 * (wave & 3), b = sh >> 4, h = sh & 15;
        const bool act = true;
        f32x4 acc = {0.f, 0.f, 0.f, 0.f}, c0, c1, c2;
        float b0[16], b1[16], b2[16];
#define CARRY_LOAD(BX, CX, cc_) do { const int l_ = TID() & 63, ln = l_ & 15, lq = l_ >> 4; \
            const float* Pc = PCH + ((size_t)sh * NCH + (cc_)) * 4096; const float* Cc = CCH + ((size_t)sh * NCH + (cc_)) * 4096; \
            _Pragma("unroll") for (int q = 0; q < 16; ++q) BX[q] = Pc[(4 * q + lq) * 64 + col0 + ln]; \
            _Pragma("unroll") for (int r = 0; r < 4; ++r) CX[r] = Cc[(row0 + 4 * lq + r) * 64 + col0 + ln]; } while (0)
#define CARRY_STEP(BX, CX, BL, CL, c_) do { const int l_ = TID() & 63, ln = l_ & 15, lq = l_ >> 4; \
            LAS float* Sw = Sl + ((c_) & 1) * (16 * 68); bf16_t* go = (bf16_t*)SST + ((size_t)sh * NCH + (c_)) * 4096; \
            if (act) { _Pragma("unroll") for (int r = 0; r < 4; ++r) Sw[(4 * lq + r) * 68 + col0 + ln] = acc[r]; } \
            const f32x4 sc = acc; acc = CX; \
            asm volatile("s_waitcnt lgkmcnt(0)" ::: "memory"); arrivals += 4u; \
            if ((TID() & 63) == 0) __hip_atomic_fetch_add(cflag, 1u, __ATOMIC_RELAXED, __HIP_MEMORY_SCOPE_WORKGROUP); \
            { unsigned sp_ = 0; while (__builtin_amdgcn_readfirstlane(__hip_atomic_load(cflag, __ATOMIC_RELAXED, __HIP_MEMORY_SCOPE_WORKGROUP)) < arrivals && ++sp_ < (1u << 22)) __builtin_amdgcn_s_sleep(0); } \
            asm volatile("" ::: "memory"); \
            if (act) { \
                _Pragma("unroll") for (int r = 0; r < 4; ++r) go[(row0 + 4 * lq + r) * 64 + col0 + ln] = f2bf(sc[r]); \
                if ((c_) + 2 < NCH) CARRY_LOAD(BL, CL, (c_) + 2); \
                float av[16]; _Pragma("unroll") for (int q = 0; q < 16; ++q) av[q] = Sw[ln * 68 + 4 * q + lq]; \
                asm volatile("s_waitcnt lgkmcnt(0)" ::: "memory"); \
                _Pragma("unroll") for (int q = 0; q < 16; ++q) acc = __builtin_amdgcn_mfma_f32_16x16x4f32(av[q], BX[q], acc, 0, 0, 0); } } while (0)
        if (act) { CARRY_LOAD(b0, c0, 0); CARRY_LOAD(b1, c1, 1); }
        for (int c = 0; c < NCH; c += 3) {
            CARRY_STEP(b0, c0, b2, c2, c);
            if (c + 1 < NCH) CARRY_STEP(b1, c1, b0, c0, c + 1);
            if (c + 2 < NCH) CARRY_STEP(b2, c2, b1, c1, c + 2);
        }
        if (act) { const int l_ = TID() & 63, ln = l_ & 15, lq = l_ >> 4; float* go = p->out + O_WKVP + (((size_t)j * 4 + b) * 16 + h) * 4096;
#pragma unroll
            for (int r = 0; r < 4; ++r) go[(row0 + 4 * lq + r) * 64 + col0 + ln] = acc[r]; }
#undef CARRY_LOAD
#undef CARRY_STEP
    }
    __syncthreads();
}
__device__ __forceinline__ void phase_sample_mixer(KP p, int j) {
    const int tid = TID(), lane = tid & 63, wave = tid >> 6;
    {
        const bf16_t *RB = WSP(bf16_t, WS_RB), *KB = WSP(bf16_t, WS_KB), *VB = WSP(bf16_t, WS_VB); bf16_t* YG = WSP(bf16_t, WS_YG);
        const float *WPp = WSP(float, WS_WP), *APp = WSP(float, WS_AP), *VPp = WSP(float, WS_VP), *GG = WSP(float, WS_GG); float* VF = WSP(float, WS_VFIRST);
        for (int it = BID() * 8 + wave; it < 512; it += gridDim.x * 8) {
            const int b = it >> 4, h = it & 15, col = h * 64 + lane;
            const float* s0 = p->state_wkv + (((size_t)j * 32 + b) * 16 + h) * 4096 + lane * 64;
            float S[64];
#pragma unroll
            for (int k = 0; k < 64; k += 4) { const f32x4 t = *(const f32x4*)(s0 + k); S[k] = t[0]; S[k + 1] = t[1]; S[k + 2] = t[2]; S[k + 3] = t[3]; }
            const float w0 = p->rw_w0[j * D + col], a0 = p->rw_a0[j * D + col], kkw = p->rw_k_k[j * D + col], kaw = p->rw_k_a[j * D + col], rkw = p->rw_r_k[j * D + col];
            const float v0 = j ? p->rw_v0[(j - 1) * D + col] : 0.f, lnw = p->rw_lnx_w[j * D + col], lnb = p->rw_lnx_b[j * D + col];
            for (int t = 0; t < 8; ++t) {
                const size_t o = (size_t)(NP + b * 8 + t) * D + col;
                const float kx = bf2f(KB[o]), vx = bf2f(VB[o]), r = bf2f(RB[o]);
                const float z = -(w0 + WPp[o]), sp = fmaxf(z, 0.f) + log1pf(expf(-fabsf(z)));
                const float wd = expf(-expf(-sp - 0.5f)), asg = sigmoidf_(a0 + APp[o]);
                float v = vx;
                if (j == 0) VF[o] = vx; else { const float vf = VF[o]; v = vx + (vf - vx) * sigmoidf_(v0 + VPp[o]); }
                float kk = kx * kkw; const float ss = wave_sum(kk * kk); kk *= rsqrtf(fmaxf(ss, 1e-24f));
                const float kp = kx * (1.0f + (asg - 1.0f) * kaw), a = -kk, bq = kk * asg;
                float sa = 0.f;
#pragma unroll
                for (int k = 0; k < 64; ++k) sa += S[k] * rl(a, k);
#pragma unroll
                for (int k = 0; k < 64; ++k) S[k] = S[k] * rl(wd, k) + sa * rl(bq, k) + v * rl(kp, k);
                float y = 0.f;
#pragma unroll
                for (int k = 0; k < 64; ++k) y += S[k] * rl(r, k);
                const float mu = wave_sum(y) * (1.0f / 64.0f), dy = y - mu, var = wave_sum(dy * dy) * (1.0f / 64.0f);
                const float bonus = wave_sum(r * kp * rkw);
                YG[o] = f2bf((dy * rsqrtf(var + 64e-5f) * lnw + lnb + bonus * v) * GG[o]);
            }
            float* so = p->out + O_WKVS + (((size_t)j * 32 + b) * 16 + h) * 4096 + lane * 64;
#pragma unroll
            for (int k = 0; k < 64; k += 4) *(f32x4*)(so + k) = (f32x4){S[k], S[k + 1], S[k + 2], S[k + 3]};
        }
    }
}
__device__ __forceinline__ void phase_post2(KP p, int j, LAS unsigned char* lds) {
    LAS float* part = (LAS float*)lds;
    const bf16_t *GM = WSP(bf16_t, WS_DEC), *VM2 = WSP(bf16_t, WS_KM), *TG = WSP(bf16_t, WS_TG), *G2T = WSP(bf16_t, WS_G2T) + (size_t)j * D * 160;
    const float *Y0 = WSP(float, WS_Y), *BON = WSP(float, WS_AV), *SST = WSP(float, WS_SST); bf16_t* YG = WSP(bf16_t, WS_YG);
    for (int it = BID(); it < 64 * NCH; it += gridDim.x) {
        const int tid = TID(), lane = tid & 63, w = tid >> 6, n = lane & 15, c4 = lane >> 4, tr = w >> 1, tcb = 2 * (w & 1);
        const int sh = it / NCH, c = it % NCH, b = sh >> 4, h = sh & 15, R0 = b * 4096 + c * LCH, hc = h * 64;
        f32x4 y[2], g[2];
        const size_t ar = (size_t)(R0 + 16 * tr + n);
#pragma unroll
        for (int ti = 0; ti < 2; ++ti) {
            const int dv = 16 * (tcb + ti) + n;
            f32x4 acc = {0.f, 0.f, 0.f, 0.f}, gacc = acc;
#pragma unroll
            for (int ks = 0; ks < 2; ++ks) {
                const bf16x8 af = *(const bf16x8*)(GM + ar * D + hc + 32 * ks + 8 * c4);
                const bf16x8 bw = *(const bf16x8*)((const bf16_t*)SST + ((size_t)it * 64 + dv) * 64 + 32 * ks + 8 * c4);
                acc = __builtin_amdgcn_mfma_f32_16x16x32_bf16(af, bw, acc, 0, 0, 0);
            }
#pragma unroll
            for (int ks = 0; ks < 5; ++ks)
                gacc = __builtin_amdgcn_mfma_f32_16x16x32_bf16(*(const bf16x8*)(TG + ar * 160 + 32 * ks + 8 * c4), *(const bf16x8*)(G2T + (size_t)(hc + dv) * 160 + 32 * ks + 8 * c4), gacc, 0, 0, 0);
#pragma unroll
            for (int r = 0; r < 4; ++r) acc[r] += bf2f(((const bf16_t*)Y0)[(size_t)(R0 + 16 * tr + 4 * c4 + r) * D + hc + dv]);
            y[ti] = acc; g[ti] = gacc;
        }
        float bonus4[4]; unsigned short vm4[2][4]; float lnw2[2], lnb2[2];
#pragma unroll
        for (int r = 0; r < 4; ++r) bonus4[r] = BON[(size_t)(R0 + 16 * tr + 4 * c4 + r) * 16 + h];
#pragma unroll
        for (int ti = 0; ti < 2; ++ti) { const int col = hc + 16 * (tcb + ti) + n; lnw2[ti] = p->rw_lnx_w[j * D + col]; lnb2[ti] = p->rw_lnx_b[j * D + col];
#pragma unroll
            for (int r = 0; r < 4; ++r) vm4[ti][r] = VM2[(size_t)(R0 + 16 * tr + 4 * c4 + r) * D + col]; }
        float s1[4], s2[4];
#pragma unroll
        for (int r = 0; r < 4; ++r) { s1[r] = g16_sum(y[0][r] + y[1][r]); s2[r] = g16_sum(y[0][r] * y[0][r] + y[1][r] * y[1][r]); }
        asm volatile("s_waitcnt lgkmcnt(0)" ::: "memory"); __builtin_amdgcn_s_barrier(); asm volatile("" ::: "memory");
        if (n == 0) {
#pragma unroll
            for (int r = 0; r < 4; ++r) { const int t = 16 * tr + 4 * c4 + r; part[(t * 2 + (w & 1)) * 2 + 0] = s1[r]; part[(t * 2 + (w & 1)) * 2 + 1] = s2[r]; }
        }
        asm volatile("s_waitcnt lgkmcnt(0)" ::: "memory"); __builtin_amdgcn_s_barrier(); asm volatile("" ::: "memory");
#pragma unroll
        for (int r = 0; r < 4; ++r) {
            const int t = 16 * tr + 4 * c4 + r;
            const float mu = (part[(t * 2 + 0) * 2] + part[(t * 2 + 1) * 2]) * (1.0f / 64.0f), ex2 = (part[(t * 2 + 0) * 2 + 1] + part[(t * 2 + 1) * 2 + 1]) * (1.0f / 64.0f);
            const float rs = rsqrtf(fmaxf(ex2 - mu * mu, 0.f) + 64e-5f), bonus = bonus4[r];
#pragma unroll
            for (int ti = 0; ti < 2; ++ti) {
                const int col = hc + 16 * (tcb + ti) + n; const size_t o = (size_t)(R0 + t) * D + col;
                YG[o] = f2bf(((y[ti][r] - mu) * rs * lnw2[ti] + lnb2[ti] + bonus * bf2f(vm4[ti][r])) * g[ti][r]);
            }
        }
    }
    __syncthreads();
}

__device__ __forceinline__ void phase_post(KP p, int j) {
    const float *Y = WSP(float, WS_Y), *KM = WSP(float, WS_KM), *VM = WSP(float, WS_VM), *GG = WSP(float, WS_GG);
    const bf16_t* RB = WSP(bf16_t, WS_RB); bf16_t* YG = WSP(bf16_t, WS_YG);
    const int lane = TID() & 63, gw = BID() * 8 + (TID() >> 6), nw = gridDim.x * 8;
    for (int row = gw; row < NT; row += nw) {
#pragma unroll
        for (int i = 0; i < 4; ++i) {
            const int col = 256 * i + 4 * lane; const size_t o = (size_t)row * D + col;
            const f32x4 y = *(const f32x4*)(Y + o), r = ld_bf4(RB + o), km = *(const f32x4*)(KM + o), vm = *(const f32x4*)(VM + o), gg = *(const f32x4*)(GG + o);
            const f32x4 lw = *(const f32x4*)(p->rw_lnx_w + j * D + col), lb = *(const f32x4*)(p->rw_lnx_b + j * D + col), rk = *(const f32x4*)(p->rw_r_k + j * D + col);
            const float mu = g16_sum(y[0] + y[1] + y[2] + y[3]) * (1.0f / 64.0f);
            const f32x4 d = y - mu;
            const float var = g16_sum(d[0] * d[0] + d[1] * d[1] + d[2] * d[2] + d[3] * d[3]) * (1.0f / 64.0f);
            const float rs = rsqrtf(var + 64e-5f);
            const float bon = g16_sum(r[0] * km[0] * rk[0] + r[1] * km[1] * rk[1] + r[2] * km[2] * rk[2] + r[3] * km[3] * rk[3]);
            st_bf4(YG + o, (d * rs * lw + lb + bon * vm) * gg);
        }
    }
}

__constant__ double kRopeInv[8] = {1.0, 0.19392274474868576, 0.03760603093086393, 0.007292664737217109, 0.001414213562373095, 0.0002742481756762073, 5.318295896944988e-05, 1.031338537721246e-05};
__device__ __forceinline__ void phase_rope_table(KP p) {
    float* TB = WSP(float, WS_ROPE);
    for (int e = ((int)gridDim.x - 1 - BID()) * 512 + TID(); e < 4104 * 8; e += gridDim.x * 512) {
        const int pi = e >> 3, f = e & 7, pos = pi < 4096 ? pi : PAST + (pi - 4096);
        double ang = (double)pos * kRopeInv[f]; ang -= floor(ang * 0.15915494309189535) * 6.283185307179586; const float af = (float)ang;
        TB[pi * 16 + f] = cosf(af); TB[pi * 16 + 8 + f] = sinf(af);
    }
}
__device__ __forceinline__ void phase_dsapost(KP p, int j) {
    const bf16_t* PR = WSP(bf16_t, WS_PR); float *Q = WSP(float, WS_Q), *QI = WSP(float, WS_QI), *WI = WSP(float, WS_WI);
    const int lane = TID() & 63, l16 = lane & 15, gw = BID() * 8 + (TID() >> 6), nw = gridDim.x * 8;
    const f32x4 qn = *(const f32x4*)(p->att_q_norm + j * 64 + 4 * l16), kn = *(const f32x4*)(p->att_k_norm + j * 64 + 4 * l16), in = *(const f32x4*)(p->idx_k_norm + j * 64 + 4 * l16);
    u32x2 rw[10]; f32x4 csn, snn;
#define DP_LOAD(ROW_) do { const int row_ = (ROW_); const bf16_t* pr_ = PR + (size_t)row_ * PINP; \
        _Pragma("unroll") for (int i = 0; i < 8; ++i) rw[i] = *(const u32x2*)(pr_ + 256 * i + 4 * lane); \
        rw[8] = *(const u32x2*)(pr_ + 2048 + 4 * l16); rw[9] = *(const u32x2*)(pr_ + 2112 + 4 * (lane & 1)); \
        const float* tb_ = WSP(float, WS_ROPE) + (row_ < NP ? (row_ & 4095) : 4096 + ((row_ - NP) & 7)) * 16 + 4 * (l16 & 1); csn = *(const f32x4*)tb_; snn = *(const f32x4*)(tb_ + 8); } while (0)
#define BF4(w_) ((f32x4){bflo((w_).x), bfhi((w_).x), bflo((w_).y), bfhi((w_).y)})
    if (gw < NT) DP_LOAD(gw);
    for (int row = gw; row < NT; row += nw) {
        u32x2 rc[10];
#pragma unroll
        for (int i = 0; i < 10; ++i) rc[i] = rw[i];
        const f32x4 cs = csn, sn = snn;
        if (row + nw < NT) DP_LOAD(row + nw);
        const float sgn = (l16 < 2) ? -1.0f : 1.0f;
#define ROPE4(v) do { f32x4 _o; _o[0] = __shfl_xor((v)[0], 2); _o[1] = __shfl_xor((v)[1], 2); _o[2] = __shfl_xor((v)[2], 2); _o[3] = __shfl_xor((v)[3], 2); if (l16 < 4) (v) = (v) * cs + sgn * (_o * sn); } while (0)
#define HNORM4(v, w) do { const float _ss = g16_sum((v)[0] * (v)[0] + (v)[1] * (v)[1] + (v)[2] * (v)[2] + (v)[3] * (v)[3]); (v) = (v) * rsqrtf(_ss * (1.0f / 64.0f) + 1e-6f) * (w); } while (0)
#pragma unroll
        for (int i = 0; i < 4; ++i) { f32x4 v = BF4(rc[i]); HNORM4(v, qn); ROPE4(v); st_bf4((bf16_t*)Q + (size_t)row * D + 256 * i + 4 * lane, v); }
        { f32x4 v = BF4(rc[4]); HNORM4(v, kn); ROPE4(v);
          float* ko = row < NP ? p->out + O_KP + ((size_t)j * NP + row) * 256 : p->out + O_KS + ((size_t)j * NS + (row - NP)) * 256; *(f32x4*)(ko + 4 * lane) = v; *(unsigned*)(WSP(unsigned char, WS_K8) + (size_t)row * 256 + 4 * lane) = pk_fp8x4(v); }
        { const f32x4 v = BF4(rc[5]);
          float* vo = row < NP ? p->out + O_VP + ((size_t)j * NP + row) * 256 : p->out + O_VS + ((size_t)j * NS + (row - NP)) * 256; *(f32x4*)(vo + 4 * lane) = v; *(unsigned*)(WSP(unsigned char, WS_V8) + (size_t)row * 256 + 4 * lane) = pk_fp8x4(v); }
#pragma unroll
        for (int i = 0; i < 2; ++i) { f32x4 v = BF4(rc[6 + i]); ROPE4(v); st_bf4(WSP(bf16_t, WS_QIB) + (size_t)row * 512 + 256 * i + 4 * lane, v); }
        { f32x4 v = BF4(rc[8]); HNORM4(v, in); ROPE4(v);
          float* io = row < NP ? p->out + O_IKP + ((size_t)j * NP + row) * 64 : p->out + O_IKS + ((size_t)j * NS + (row - NP)) * 64; if (lane < 16) { *(f32x4*)(io + 4 * lane) = v; st_bf4(WSP(bf16_t, WS_KIB) + (size_t)row * 64 + 4 * lane, v); } }
        if (lane < 2) { const f32x4 v = BF4(rc[9]); *(f32x4*)(WI + (size_t)row * 8 + 4 * lane) = v * 0.35355339059327373f; }
#undef ROPE4
#undef HNORM4
    }
#undef DP_LOAD
#undef BF4
}

template <bool SAMPLE>
__device__ __forceinline__ void phase_idx(KP p, int j, LAS unsigned char* lds) {
    LAS float* Qs = (LAS float*)lds;
    LAS float* Ks = (LAS float*)(lds + 32768);
    const float *QI = WSP(float, WS_QI), *WI = WSP(float, WS_WI);
    const int tid = TID(), q = tid >> 5, kx = tid & 31;
    const int nitems = SAMPLE ? 32 * 65 : 1024;
    for (int it = BID(); it < nitems; it += gridDim.x) {
        int b, t0, rowbase, nkt, kt0 = 0;
        if (SAMPLE) { b = it / 65; kt0 = it % 65; t0 = 0; rowbase = NP + b * 8; nkt = kt0 + 1; }
        else { const int k4 = it >> 8, w = it & 255, i = (k4 & 1) ? (k4 * 256 + 255 - w) : (k4 * 256 + w); b = i & 3; t0 = (i >> 2) * 16; rowbase = b * 4096 + t0; nkt = (t0 + 15) / 128 + 1; }
        const int nq = SAMPLE ? 8 : 16;
        __syncthreads();
#pragma unroll
        for (int n = 0; n < 16; ++n) { const int e = tid + 512 * n, qq = e >> 9, c = e & 511, h = c >> 6, d = c & 63;
            Qs[(d * 16 + qq) * 8 + h] = qq < nq ? QI[(size_t)(rowbase + qq) * 512 + c] : 0.f; }
        float wi[8];
#pragma unroll
        for (int h = 0; h < 8; ++h) wi[h] = q < nq ? WI[(size_t)(rowbase + q) * 8 + h] : 0.f;
        for (int kt = kt0; kt < nkt; ++kt) {
            __syncthreads();
#pragma unroll
            for (int n = 0; n < 16; ++n) { const int e = tid + 512 * n, key = e >> 6, d = e & 63, s = kt * 128 + key; float v = 0.f;
                if (SAMPLE) {
                    if (s < PAST) { const int pg = p->page_table[b * 64 + (s >> 7)]; v = p->cache_ik[(((size_t)j * 2560 + pg) * 128 + (s & 127)) * 64 + d]; }
                    else if (s < PAST + 8) v = p->out[O_IKS + ((size_t)j * NS + b * 8 + (s - PAST)) * 64 + d];
                } else v = p->out[O_IKP + ((size_t)j * NP + b * 4096 + s) * 64 + d];
                Ks[d * 132 + key] = v; }
            __syncthreads();
            f32x4 acc[8];
#pragma unroll
            for (int h = 0; h < 8; ++h) acc[h] = (f32x4){0.f, 0.f, 0.f, 0.f};
#pragma unroll 4
            for (int d = 0; d < 64; ++d) {
                const f32x4 qa = *(const LAS f32x4*)(Qs + (d * 16 + q) * 8), qb = *(const LAS f32x4*)(Qs + (d * 16 + q) * 8 + 4), kv = *(const LAS f32x4*)(Ks + d * 132 + 4 * kx);
                acc[0] += qa[0] * kv; acc[1] += qa[1] * kv; acc[2] += qa[2] * kv; acc[3] += qa[3] * kv;
                acc[4] += qb[0] * kv; acc[5] += qb[1] * kv; acc[6] += qb[2] * kv; acc[7] += qb[3] * kv;
            }
            f32x4 sc = {0.f, 0.f, 0.f, 0.f};
#pragma unroll
            for (int h = 0; h < 8; ++h)
#pragma unroll
                for (int e = 0; e < 4; ++e) sc[e] += fmaxf(acc[h][e] * 0.125f, 0.f) * wi[h];
            if (q < nq) {
                if (SAMPLE) *(f32x4*)(WSP(float, WS_SCS) + (size_t)(b * 8 + q) * SCS_LD + kt * 128 + 4 * kx) = sc;
                else *(f32x4*)(WSP(float, WS_SC) + ((size_t)b * 4096 + t0 + q) * 4096 + kt * 128 + 4 * kx) = sc;
            }
        }
    }
    __syncthreads();
}

template <bool SAMPLE>
__device__ __forceinline__ void phase_idx2(KP p, int j) {
    const bf16_t *QIB = WSP(bf16_t, WS_QIB), *KIB = WSP(bf16_t, WS_KIB); const float* WI = WSP(float, WS_WI);
    const int lane = TID() & 63, lr = lane & 31, lh = lane >> 5, gw = BID() * 8 + (TID() >> 6), nw = gridDim.x * 8;
    const int nitems = SAMPLE ? 32 * 65 : 4096;
    for (int it = gw; it < nitems; it += nw) {
        int b, rowbase, tile0, ntile;
        if (SAMPLE) { b = it / 65; rowbase = NP + b * 8; tile0 = (it % 65) * 4; ntile = min(4, 257 - tile0); }
        else { const int sub = it >= 2048, w_ = it & 2047; b = w_ & 3; const int wb = w_ >> 2, kk = sub ? 511 - wb : wb, nt = (kk * 8 + 7) / 32 + 1;
            rowbase = b * 4096 + kk * 8; tile0 = sub ? (nt >> 1) : 0; ntile = sub ? nt - (nt >> 1) : (nt >> 1); }
        if (ntile <= 0) continue;
        bf16x8 af[2][4]; float w[2][2][8];
        { const int hd = (lr & 3) + 4 * ((lr >> 3) & 1), jq = 2 * ((lr >> 2) & 1) + (lr >> 4);
#pragma unroll
          for (int st = 0; st < 2; ++st)
#pragma unroll
              for (int ks = 0; ks < 4; ++ks) af[st][ks] = *(const bf16x8*)(QIB + (size_t)(rowbase + 4 * st + jq) * 512 + hd * 64 + 16 * ks + 8 * lh);
#pragma unroll
          for (int st = 0; st < 2; ++st)
#pragma unroll
              for (int q = 0; q < 2; ++q) { const f32x4 w0 = *(const f32x4*)(WI + (size_t)(rowbase + 4 * st + 2 * lh + q) * 8), w1 = *(const f32x4*)(WI + (size_t)(rowbase + 4 * st + 2 * lh + q) * 8 + 4);
#pragma unroll
                  for (int e = 0; e < 4; ++e) { w[st][q][e] = w0[e] * 0.125f; w[st][q][4 + e] = w1[e] * 0.125f; } } }
#define IDX_LOADB(BF, tl_) do { const int s_ = (tile0 + (tl_)) * 32 + lr; \
            if (!SAMPLE) { _Pragma("unroll") for (int ks = 0; ks < 4; ++ks) BF[ks] = *(const bf16x8*)(KIB + ((size_t)b * 4096 + s_) * 64 + 16 * ks + 8 * lh); } \
            else { const float* kp = p->out + O_IKS + ((size_t)j * NS + b * 8) * 64; \
                if (s_ < PAST) kp = p->cache_ik + (((size_t)j * 2560 + p->page_table[b * 64 + (s_ >> 7)]) * 128 + (s_ & 127)) * 64; else kp += (size_t)min(s_ - PAST, 7) * 64; \
                _Pragma("unroll") for (int ks = 0; ks < 4; ++ks) { const f32x4 x0 = *(const f32x4*)(kp + 16 * ks + 8 * lh), x1 = *(const f32x4*)(kp + 16 * ks + 8 * lh + 4); \
                    const u32x4 wv = {pk_bf16(x0[0], x0[1]), pk_bf16(x0[2], x0[3]), pk_bf16(x1[0], x1[1]), pk_bf16(x1[2], x1[3])}; BF[ks] = __builtin_bit_cast(bf16x8, wv); } } } while (0)
        bf16x8 bnx[4];
        IDX_LOADB(bnx, 0);
        for (int tl = 0; tl < ntile; ++tl) {
            const int s = (tile0 + tl) * 32 + lr;
            bf16x8 bfr[4];
#pragma unroll
            for (int ks = 0; ks < 4; ++ks) bfr[ks] = bnx[ks];
            if (tl + 1 < ntile) IDX_LOADB(bnx, tl + 1);
            __builtin_amdgcn_sched_barrier(0);
#pragma unroll
            for (int st = 0; st < 2; ++st) {
                f32x16 acc;
#pragma unroll
                for (int r = 0; r < 16; ++r) acc[r] = 0.f;
#pragma unroll
                for (int ks = 0; ks < 4; ++ks) acc = __builtin_amdgcn_mfma_f32_32x32x16_bf16(af[st][ks], bfr[ks], acc, 0, 0, 0);
#pragma unroll
                for (int q = 0; q < 2; ++q) {
                    float sc = 0.f;
#pragma unroll
                    for (int hh = 0; hh < 2; ++hh)
#pragma unroll
                        for (int hl = 0; hl < 4; ++hl) sc += fmaxf(acc[4 * (2 * q + hh) + hl], 0.f) * w[st][q][hl + 4 * hh];
                    if (SAMPLE) WSP(float, WS_SCS)[(size_t)(b * 8 + 4 * st + 2 * lh + q) * SCS_LD + s] = sc;
                    else WSP(float, WS_SC)[((size_t)rowbase + 4 * st + 2 * lh + q) * 4096 + s] = sc;
                }
            }
        }
    }
#undef IDX_LOADB
}

__device__ __forceinline__ unsigned fkey(float f) { f = (f == 0.f) ? 0.f : f; const unsigned u = __float_as_uint(f); return (u & 0x80000000u) ? ~u : (u | 0x80000000u); }
__device__ __forceinline__ void phase_topk_prompt(KP p) {
    const float* SC = WSP(float, WS_SC); int* SEL = WSP(int, WS_SEL); int* CNT = WSP(int, WS_CNT);
    const int lane = TID() & 63, gw = BID() * 8 + (TID() >> 6), nw = gridDim.x * 8;
    for (int qi = gw; qi < NP; qi += nw) {
        const int b = qi & 3, tt = qi >> 2, t = (tt & 1) ? 4095 - (tt >> 1) : (tt >> 1), row = b * 4096 + t, n = t + 1;
        int* sel = SEL + (size_t)row * 256;
        if (n <= TOPK) { for (int s = lane; s < n; s += 64) sel[s] = s; if (lane == 0) CNT[row] = n; continue; }
        const float* base = SC + (size_t)row * 4096;
        const int nb = __builtin_amdgcn_readfirstlane((n + 1023) >> 10);
        unsigned u[64];
#pragma unroll
        for (int kb = 0; kb < 4; ++kb) {
            if (kb < nb) {
#pragma unroll
                for (int m = 16 * kb; m < 16 * kb + 16; ++m) u[m] = __float_as_uint(base[lane + 64 * m]);
            } else {
#pragma unroll
                for (int m = 16 * kb; m < 16 * kb + 16; ++m) u[m] = 0u;
            }
        }
#pragma unroll
        for (int m = 0; m < 64; ++m) { const unsigned k_ = fkey(__uint_as_float(u[m])); u[m] = (lane + 64 * m < n) ? k_ : 0u; }
        unsigned tau = 0u;
#pragma unroll 1
        for (int bit = 31; bit >= 0; --bit) {
            const unsigned cand = tau | (1u << bit); int c = 0;
#pragma unroll
            for (int m = 0; m < 16; ++m) c += (u[m] >= cand) ? 1 : 0;
            if (nb > 1) {
#pragma unroll
                for (int m = 16; m < 32; ++m) c += (u[m] >= cand) ? 1 : 0;
                if (nb > 2) {
#pragma unroll
                    for (int m = 32; m < 48; ++m) c += (u[m] >= cand) ? 1 : 0;
                    if (nb > 3) {
#pragma unroll
                        for (int m = 48; m < 64; ++m) c += (u[m] >= cand) ? 1 : 0;
                    }
                }
            }
            c = wave_sum_i(c);
            if (c >= TOPK) tau = cand;
            if (c == TOPK) break;
        }
        int cg = 0, ct = 0; unsigned tlo = 0u, thi = 0u;
#pragma unroll
        for (int m = 31; m >= 0; --m) { cg += (u[m] > tau) ? 1 : 0; const unsigned tie = (u[m] == tau) ? 1u : 0u; ct += (int)tie; tlo = (tlo << 1) | tie; }
#pragma unroll
        for (int m = 63; m >= 32; --m) { cg += (u[m] > tau) ? 1 : 0; const unsigned tie = (u[m] == tau) ? 1u : 0u; ct += (int)tie; thi = (thi << 1) | tie; }
        unsigned long long tmask = ((unsigned long long)thi << 32) | tlo;
        const int totg = wave_sum_i(cg), tott = wave_sum_i(ct);
        const int need = TOPK - totg;
        unsigned long long smask = 0ull;
        if (tott == need) smask = tmask;
        else {
#pragma unroll 1
            for (int it = 0; it < need; ++it) {
                const int m0 = tmask ? (int)__builtin_ctzll(tmask) : 64;
                const int cand = tmask ? (lane + 64 * m0) : 0x7fffffff, best = wave_min_i(cand);
                if (cand == best && tmask) { smask |= (1ull << m0); tmask &= ~(1ull << m0); }
            }
        }
        const int mine = cg + __popcll(smask);
        int incl = mine;
#pragma unroll
        for (int d = 1; d < 64; d <<= 1) { const int o = __shfl_up(incl, d); if (lane >= d) incl += o; }
        int off = incl - mine;
#pragma unroll
        for (int m = 0; m < 64; ++m) { if ((u[m] > tau) || ((smask >> m) & 1ull)) { sel[off] = lane + 64 * m; ++off; } }
        if (lane == 0) CNT[row] = TOPK;
    }
}
__device__ __forceinline__ void phase_topk_sample(KP p, LAS unsigned char* lds) {
    LAS unsigned* ckey = (LAS unsigned*)lds;
    LAS int* cidx = (LAS int*)(lds + 8192);
    const float* SCS = WSP(float, WS_SCS); int* SEL = WSP(int, WS_SEL); int* CNT = WSP(int, WS_CNT);
    for (int qq = BID(); qq < NS; qq += gridDim.x) {
        const int tid = TID(), lane = tid & 63, wave = tid >> 6;
        const int n = PAST + 1 + (qq & 7), row = NP + qq, s0 = 1088 * wave;
        const float* base = SCS + (size_t)qq * SCS_LD;
        unsigned u[17];
#pragma unroll
        for (int m = 0; m < 17; ++m) { const int s = s0 + lane + 64 * m; u[m] = __float_as_uint(base[s < SCS_LD ? s : 0]); }
#pragma unroll
        for (int m = 0; m < 17; ++m) { const unsigned k_ = fkey(__uint_as_float(u[m])); u[m] = (s0 + lane + 64 * m < n) ? k_ : 0u; }
        __syncthreads();
        {
            int nvalid = 0;
#pragma unroll
            for (int m = 0; m < 17; ++m) nvalid += (u[m] != 0u) ? 1 : 0;
            nvalid = wave_sum_i(nvalid);
            unsigned tau = 0u; int need = 0; unsigned tmask = 0u, smask = 0u;
            if (nvalid > TOPK) {
#pragma unroll 1
                for (int bit = 31; bit >= 0; --bit) {
                    const unsigned cand = tau | (1u << bit); int c = 0;
#pragma unroll
                    for (int m = 0; m < 17; ++m) c += (u[m] >= cand) ? 1 : 0;
                    c = wave_sum_i(c);
                    if (c >= TOPK) tau = cand;
                    if (c == TOPK) break;
                }
                int cg = 0, ct = 0;
#pragma unroll
                for (int m = 0; m < 17; ++m) { cg += (u[m] > tau) ? 1 : 0; const bool tie = (u[m] == tau); ct += tie ? 1 : 0; tmask |= tie ? (1u << m) : 0u; }
                cg = wave_sum_i(cg); ct = wave_sum_i(ct);
                need = TOPK - cg;
                if (ct == need) smask = tmask;
                else {
#pragma unroll 1
                    for (int it = 0; it < need; ++it) {
                        const int m0 = tmask ? (int)__builtin_ctz(tmask) : 32;
                        const int cand = tmask ? (lane + 64 * m0) : 0x7fffffff, best = wave_min_i(cand);
                        if (cand == best && tmask) { smask |= (1u << m0); tmask &= ~(1u << m0); }
                    }
                }
            } else { tau = 0u; smask = 0u; }
            int mine = 0;
#pragma unroll
            for (int m = 0; m < 17; ++m) mine += ((u[m] > tau) || ((smask >> m) & 1u)) ? 1 : 0;
            int incl = mine;
#pragma unroll
            for (int d = 1; d < 64; d <<= 1) { const int o = __shfl_up(incl, d); if (lane >= d) incl += o; }
            int off = incl - mine;
            const int total = __builtin_amdgcn_readlane(incl, 63);
#pragma unroll
            for (int m = 0; m < 17; ++m) { if ((u[m] > tau) || ((smask >> m) & 1u)) { ckey[wave * 256 + off] = u[m]; cidx[wave * 256 + off] = s0 + lane + 64 * m; ++off; } }
            for (int e = total + lane; e < 256; e += 64) { ckey[wave * 256 + e] = 0u; cidx[wave * 256 + e] = 0x7fffffff; }
        }
        __syncthreads();
        if (wave == 0) {
            unsigned v[32]; int ix[32];
#pragma unroll
            for (int m = 0; m < 32; ++m) { v[m] = ckey[lane + 64 * m]; ix[m] = cidx[lane + 64 * m]; }
            unsigned tau = 0u;
#pragma unroll 1
            for (int bit = 31; bit >= 0; --bit) {
                const unsigned cand = tau | (1u << bit); int c = 0;
#pragma unroll
                for (int m = 0; m < 32; ++m) c += (v[m] >= cand) ? 1 : 0;
                c = wave_sum_i(c);
                if (c >= TOPK) tau = cand;
                if (c == TOPK) break;
            }
            int cg = 0, ct = 0; unsigned tmask = 0u, smask = 0u;
#pragma unroll
            for (int m = 31; m >= 0; --m) { cg += (v[m] > tau) ? 1 : 0; const unsigned tie = (v[m] == tau) ? 1u : 0u; ct += (int)tie; tmask = (tmask << 1) | tie; }
            cg = wave_sum_i(cg); ct = wave_sum_i(ct);
            const int need = TOPK - cg;
            if (ct == need) smask = tmask;
            else {
#pragma unroll 1
                for (int it = 0; it < need; ++it) {
                    int bi = 0x7fffffff, bm = 0;
#pragma unroll
                    for (int m = 0; m < 32; ++m) { const bool t_ = (tmask >> m) & 1u; if (t_ && ix[m] < bi) { bi = ix[m]; bm = m; } }
                    const int best = wave_min_i(bi);
                    if (bi == best && bi != 0x7fffffff) { smask |= (1u << bm); tmask &= ~(1u << bm); }
                }
            }
            int mine = 0;
#pragma unroll
            for (int m = 0; m < 32; ++m) mine += ((v[m] > tau) || ((smask >> m) & 1u)) ? 1 : 0;
            int incl = mine;
#pragma unroll
            for (int d = 1; d < 64; d <<= 1) { const int o = __shfl_up(incl, d); if (lane >= d) incl += o; }
            int off = incl - mine;
            int* sel = SEL + (size_t)row * 256;
#pragma unroll
            for (int m = 0; m < 32; ++m) { if ((v[m] > tau) || ((smask >> m) & 1u)) { if (off < TOPK) sel[off] = ix[m]; ++off; } }
            if (lane == 0) CNT[row] = TOPK;
        }
    }
    __syncthreads();
}

template <bool SAMPLE>
__device__ __forceinline__ void phase_attn(KP p, int j, LAS unsigned char* lds) {
    const int tid = TID(), lane = tid & 63, wave = tid >> 6, n16 = lane & 15, c4 = lane >> 4;
    LAS bf16_t* ps = (LAS bf16_t*)(lds + wave * 16384);
    LAS int* is = (LAS int*)(lds + wave * 16384 + 8192);
    LAS bf16_t* qs = (LAS bf16_t*)(lds + wave * 16384 + 9216);
    LAS float* invs = (LAS float*)(lds + wave * 16384 + 11264);
    const float* Q = WSP(float, WS_Q); const int* SEL = WSP(int, WS_SEL); const int* CNT = WSP(int, WS_CNT); bf16_t* O = WSP(bf16_t, WS_YG);
    const bf16_t *KBF = WSP(bf16_t, WS_KBF), *VBF = WSP(bf16_t, WS_VBF);
    const float* kc = p->cache_k + (size_t)j * 2560 * 128 * 256; const float* vc = p->cache_v + (size_t)j * 2560 * 128 * 256;
    const float* knew = p->out + O_KS + (size_t)j * NS * 256; const float* vnew = p->out + O_VS + (size_t)j * NS * 256;
    const int gw = BID() * 8 + wave, nw = gridDim.x * 8, nq = SAMPLE ? NS : NP;
    unsigned* qctr = WSP(unsigned, WS_BAR + 40960) + (size_t)j * 256;
    int qb = 0, qnext = 0, qsub = 2, qcur = 0;
    if (!SAMPLE) { unsigned v_ = 0u; if (lane == 0) v_ = __hip_atomic_fetch_add(qctr + 16 * ((BID() + qb) & 3), 2u, __ATOMIC_RELAXED, __HIP_MEMORY_SCOPE_AGENT); qnext = (int)__builtin_amdgcn_readfirstlane(v_); }
    for (int qi = gw; SAMPLE ? (qi < nq) : true; qi += nw) {
        int row;
        if (SAMPLE) row = NP + qi;
        else {
            if (qsub == 2) {
                for (;;) {
                    qcur = qnext; qsub = 0;
                    if (qcur < 4096 || qb == 3) break;
                    ++qb; unsigned v_ = 0u; if (lane == 0) v_ = __hip_atomic_fetch_add(qctr + 16 * ((BID() + qb) & 3), 2u, __ATOMIC_RELAXED, __HIP_MEMORY_SCOPE_AGENT); qnext = (int)__builtin_amdgcn_readfirstlane(v_);
                }
                if (qcur >= 4096) break;
                { unsigned v_ = 0u; if (lane == 0) v_ = __hip_atomic_fetch_add(qctr + 16 * ((BID() + qb) & 3), 2u, __ATOMIC_RELAXED, __HIP_MEMORY_SCOPE_AGENT); qnext = (int)__builtin_amdgcn_readfirstlane(v_); }
            }
            row = ((BID() + qb) & 3) * 4096 + (4095 - (qcur + qsub)); ++qsub;
        }
        const int n = CNT[row];
        wave_lds_fence();
#pragma unroll
        for (int c = 0; c < 4; ++c) { const int slot = lane + 64 * c;
            int s = SEL[(size_t)row * 256 + slot]; const bool ok = slot < n;
            int r;
            if (SAMPLE) { const int bb = (row - NP) >> 3; s = ok ? s : 0; const int sp = min(max(s, 0), PAST - 1); const int pg = p->page_table[bb * 64 + (sp >> 7)];
                r = (s < PAST) ? pg * 128 + (s & 127) : (0x40000000 | (bb * 8 + min(s - PAST, 7))); }
            else r = (row & ~4095) + (ok ? s : 0);
            is[slot] = r; }
#pragma unroll
        for (int i = 0; i < 4; ++i) { const f32x4 q4 = ld_bf4((const bf16_t*)Q + (size_t)row * D + 256 * i + 4 * lane);
            if (SAMPLE) { const f32x4 q8 = q4 * 0.125f; u32x2 w; w.x = pk_bf16(q8[0], q8[1]); w.y = pk_bf16(q8[2], q8[3]); *(LAS u32x2*)(qs + 256 * i + 4 * lane) = w; }
            else *(LAS unsigned*)((LAS unsigned char*)qs + 256 * i + 4 * lane) = pk_fp8x4(q4); }
        wave_lds_fence();
        {
            float mx = -__builtin_huge_valf();
#define ATT_EMIT(t_, acc_) do { f32x4 l_ = (acc_); _Pragma("unroll") for (int r = 0; r < 4; ++r) { if (16 * (t_) + 4 * c4 + r >= n) l_[r] = -__builtin_huge_valf(); mx = fmaxf(mx, l_[r]); } \
                u32x2 w_; w_.x = pk_bf16(l_[0], l_[1]); w_.y = pk_bf16(l_[2], l_[3]); *(LAS u32x2*)(ps + n16 * 256 + 16 * (t_) + 4 * c4) = w_; } while (0)
            if (SAMPLE) {
                const u32x4 qf0 = *(const LAS u32x4*)(qs + n16 * 64 + 8 * c4), qf1 = *(const LAS u32x4*)(qs + n16 * 64 + 32 + 8 * c4);
                u32x4 bq[8];
#pragma unroll
                for (int ks = 0; ks < 8; ++ks) { const bool on = (n16 >> 2) == (ks >> 1); const u32x4 qv = (ks & 1) ? qf1 : qf0; bq[ks] = (u32x4){on ? qv.x : 0u, on ? qv.y : 0u, on ? qv.z : 0u, on ? qv.w : 0u}; }
#pragma unroll 2
                for (int t = 0; t < 16; ++t) {
                    const int r = is[16 * t + n16];
                    const float* kp = ((r & 0x40000000) ? knew + (size_t)(r & 0xffff) * 256 : kc + (size_t)r * 256) + 8 * c4;
                    f32x4 acc = {0.f, 0.f, 0.f, 0.f};
#pragma unroll
                    for (int ks = 0; ks < 8; ++ks) { const f32x4 x0 = *(const f32x4*)(kp + 32 * ks), x1 = *(const f32x4*)(kp + 32 * ks + 4);
                        const u32x4 ka = {pk_bf16(x0[0], x0[1]), pk_bf16(x0[2], x0[3]), pk_bf16(x1[0], x1[1]), pk_bf16(x1[2], x1[3])};
                        acc = __builtin_amdgcn_mfma_f32_16x16x32_bf16(__builtin_bit_cast(bf16x8, ka), __builtin_bit_cast(bf16x8, bq[ks]), acc, 0, 0, 0); }
                    ATT_EMIT(t, acc);
                }
            } else {
                const LAS unsigned char* q8 = (const LAS unsigned char*)qs;
                long bq[8];
                { const bool on = (n16 >> 2) == c4;
#pragma unroll
                  for (int h2 = 0; h2 < 4; ++h2) { const u32x4 qv = *(const LAS u32x4*)(q8 + n16 * 64 + 16 * h2);
                      const u32x2 z0 = {on ? qv.x : 0u, on ? qv.y : 0u}, z1 = {on ? qv.z : 0u, on ? qv.w : 0u}; bq[2 * h2] = __builtin_bit_cast(long, z0); bq[2 * h2 + 1] = __builtin_bit_cast(long, z1); } }
                const unsigned char* K8 = WSP(unsigned char, WS_K8);
#pragma unroll
                for (int th = 0; th < 2; ++th) {
                    if (th) asm volatile("" ::: "memory");
                    u32x4 ka[8][4];
#pragma unroll
                    for (int t8 = 0; t8 < 8; ++t8) {
                        const int r = is[16 * (8 * th + t8) + n16];
                        const unsigned char* kp = K8 + (size_t)r * 256 + 64 * c4;
#pragma unroll
                        for (int h2 = 0; h2 < 4; ++h2) ka[t8][h2] = *(const u32x4*)(kp + 16 * h2);
                    }
                    __builtin_amdgcn_sched_barrier(0);
#pragma unroll
                    for (int t8 = 0; t8 < 8; ++t8) {
                        f32x4 acc = {0.f, 0.f, 0.f, 0.f};
#pragma unroll
                        for (int h2 = 0; h2 < 4; ++h2) { const u32x2 lo = {ka[t8][h2].x, ka[t8][h2].y}, hi = {ka[t8][h2].z, ka[t8][h2].w};
                            acc = __builtin_amdgcn_mfma_f32_16x16x32_fp8_fp8(__builtin_bit_cast(long, lo), bq[2 * h2], acc, 0, 0, 0);
                            acc = __builtin_amdgcn_mfma_f32_16x16x32_fp8_fp8(__builtin_bit_cast(long, hi), bq[2 * h2 + 1], acc, 0, 0, 0); }
                        ATT_EMIT(8 * th + t8, acc * 0.125f);
                    }
                }
            }
#undef ATT_EMIT
            mx = fmaxf(mx, __shfl_xor(mx, 16)); mx = fmaxf(mx, __shfl_xor(mx, 32));
            float sm = 0.f;
            u32x2 lw_[16];
#pragma unroll
            for (int t = 0; t < 16; ++t) lw_[t] = *(const LAS u32x2*)(ps + n16 * 256 + 16 * t + 4 * c4);
#pragma unroll
            for (int t = 0; t < 16; ++t) {
                const u32x2 w = lw_[t];
                const float e0 = __expf(bflo(w.x) - mx), e1 = __expf(bfhi(w.x) - mx), e2 = __expf(bflo(w.y) - mx), e3 = __expf(bfhi(w.y) - mx);
                sm += (e0 + e1) + (e2 + e3);
                u32x2 o_; o_.x = pk_bf16(e0, e1); o_.y = pk_bf16(e2, e3); *(LAS u32x2*)(ps + n16 * 256 + 16 * t + 4 * c4) = o_;
            }
            sm += __shfl_xor(sm, 16); sm += __shfl_xor(sm, 32);
            if (c4 == 0) invs[n16] = 1.0f / sm;
        }
        wave_lds_fence();
        if (!SAMPLE) {
            const unsigned char* V8 = WSP(unsigned char, WS_V8);
            const int rs = c4, kvh = n16 >> 2, nst = n > 64 ? 64 : n;
            f32x4 oa[4][4];
#pragma unroll
            for (int g = 0; g < 4; ++g)
#pragma unroll
                for (int q = 0; q < 4; ++q) oa[g][q] = (f32x4){0.f, 0.f, 0.f, 0.f};
            u32x4 vr[8], vn[8];
#pragma unroll
            for (int i = 0; i < 8; ++i) vn[i] = *(const u32x4*)(V8 + (size_t)is[64 * rs + i] * 256 + 16 * n16);
            for (int m0 = 0; m0 < nst; m0 += 8) {
#pragma unroll
                for (int i = 0; i < 8; ++i) vr[i] = vn[i];
                if (m0 + 8 < nst) {
#pragma unroll
                    for (int i = 0; i < 8; ++i) vn[i] = *(const u32x4*)(V8 + (size_t)is[64 * rs + m0 + 8 + i] * 256 + 16 * n16);
                }
                __builtin_amdgcn_sched_barrier(0);
#pragma unroll
                for (int h4 = 0; h4 < 2; ++h4) {
                    u32x2 pg[4];
#pragma unroll
                    for (int g = 0; g < 4; ++g) pg[g] = *(const LAS u32x2*)(ps + (kvh * 4 + g) * 256 + 64 * rs + m0 + 4 * h4);
#pragma unroll
                    for (int i = 0; i < 4; ++i) {
                        const u32x4 v_ = vr[4 * h4 + i];
                        const f32x4 v0 = fp8x4_f32(v_.x), v1 = fp8x4_f32(v_.y), v2 = fp8x4_f32(v_.z), v3 = fp8x4_f32(v_.w);
#pragma unroll
                        for (int g = 0; g < 4; ++g) { const unsigned pw = (i < 2) ? pg[g].x : pg[g].y; const float pf = (i & 1) ? bfhi(pw) : bflo(pw);
                            oa[g][0] += pf * v0; oa[g][1] += pf * v1; oa[g][2] += pf * v2; oa[g][3] += pf * v3; }
                    }
                }
            }
#pragma unroll
            for (int g = 0; g < 4; ++g)
#pragma unroll
                for (int q = 0; q < 4; ++q)
#pragma unroll
                    for (int e_ = 0; e_ < 4; ++e_) { float x = oa[g][q][e_]; x += __shfl_xor(x, 16); x += __shfl_xor(x, 32); oa[g][q][e_] = x; }
            if (rs == 0) {
                const f32x4 iv = *(const LAS f32x4*)(invs + 4 * kvh);
#pragma unroll
                for (int g = 0; g < 4; ++g) { bf16_t* op = O + (size_t)row * D + (kvh * 4 + g) * 64 + 16 * (n16 & 3);
                    u32x4 w0, w1; const float sc_ = iv[g];
                    w0.x = pk_bf16(oa[g][0][0] * sc_, oa[g][0][1] * sc_); w0.y = pk_bf16(oa[g][0][2] * sc_, oa[g][0][3] * sc_); w0.z = pk_bf16(oa[g][1][0] * sc_, oa[g][1][1] * sc_); w0.w = pk_bf16(oa[g][1][2] * sc_, oa[g][1][3] * sc_);
                    w1.x = pk_bf16(oa[g][2][0] * sc_, oa[g][2][1] * sc_); w1.y = pk_bf16(oa[g][2][2] * sc_, oa[g][2][3] * sc_); w1.z = pk_bf16(oa[g][3][0] * sc_, oa[g][3][1] * sc_); w1.w = pk_bf16(oa[g][3][2] * sc_, oa[g][3][3] * sc_);
                    *(u32x4*)op = w0; *(u32x4*)(op + 8) = w1; }
            }
        } else {
        f32x4 o0 = {0.f, 0.f, 0.f, 0.f}, o1 = o0, o2 = o0, o3 = o0;
        constexpr int GV = SAMPLE ? 16 : 32;
        const int ng = (n + GV - 1) / GV;
        unsigned vb[SAMPLE ? 1 : GV], vbn[SAMPLE ? 1 : GV]; f32x4 vf[SAMPLE ? GV : 1];
        const unsigned char* V8 = WSP(unsigned char, WS_V8);
        if (!SAMPLE) {
#pragma unroll
            for (int i = 0; i < GV; ++i) vbn[i] = *(const unsigned*)(V8 + (size_t)is[i] * 256 + 4 * lane);
        }
#pragma unroll 1
        for (int g = 0; g < ng; ++g) {
            if (!SAMPLE) {
#pragma unroll
                for (int i = 0; i < GV; ++i) vb[i] = vbn[i];
                if (g + 1 < ng) {
#pragma unroll
                    for (int i = 0; i < GV; ++i) vbn[i] = *(const unsigned*)(V8 + (size_t)is[GV * (g + 1) + i] * 256 + 4 * lane);
                }
                __builtin_amdgcn_sched_barrier(0);
            } else {
#pragma unroll
                for (int i = 0; i < GV; ++i) { const int r = is[GV * g + i]; vf[i] = *(const f32x4*)(((r & 0x40000000) ? vnew + (size_t)(r & 0xffff) * 256 : vc + (size_t)r * 256) + 4 * lane); }
            }
#pragma unroll
            for (int i4 = 0; i4 < GV / 4; ++i4) {
                const u32x2 p0 = *(const LAS u32x2*)(ps + (c4 * 4 + 0) * 256 + GV * g + 4 * i4), p1 = *(const LAS u32x2*)(ps + (c4 * 4 + 1) * 256 + GV * g + 4 * i4),
                            p2 = *(const LAS u32x2*)(ps + (c4 * 4 + 2) * 256 + GV * g + 4 * i4), p3 = *(const LAS u32x2*)(ps + (c4 * 4 + 3) * 256 + GV * g + 4 * i4);
                f32x4 v0, v1, v2, v3;
                if (!SAMPLE) { v0 = fp8x4_f32(vb[4 * i4]); v1 = fp8x4_f32(vb[4 * i4 + 1]); v2 = fp8x4_f32(vb[4 * i4 + 2]); v3 = fp8x4_f32(vb[4 * i4 + 3]); }
                else { v0 = vf[4 * i4]; v1 = vf[4 * i4 + 1]; v2 = vf[4 * i4 + 2]; v3 = vf[4 * i4 + 3]; }
                o0 += bflo(p0.x) * v0 + bfhi(p0.x) * v1 + bflo(p0.y) * v2 + bfhi(p0.y) * v3;
                o1 += bflo(p1.x) * v0 + bfhi(p1.x) * v1 + bflo(p1.y) * v2 + bfhi(p1.y) * v3;
                o2 += bflo(p2.x) * v0 + bfhi(p2.x) * v1 + bflo(p2.y) * v2 + bfhi(p2.y) * v3;
                o3 += bflo(p3.x) * v0 + bfhi(p3.x) * v1 + bflo(p3.y) * v2 + bfhi(p3.y) * v3;
            }
        }
        { const f32x4 iv = *(const LAS f32x4*)(invs + 4 * c4); bf16_t* op = O + (size_t)row * D + c4 * 256 + 4 * n16; st_bf4(op, o0 * iv[0]); st_bf4(op + 64, o1 * iv[1]); st_bf4(op + 128, o2 * iv[2]); st_bf4(op + 192, o3 * iv[3]); }
        }
    }
}

__global__ void __launch_bounds__(512, 2) mega(P p_unused) {
    extern __shared__ __attribute__((aligned(16))) unsigned char lds_raw[];
    LAS unsigned char* lds = (LAS unsigned char*)lds_raw;
    volatile LAS unsigned* misc = (volatile LAS unsigned*)(lds + LDS_MISC);
    if (TID() < 4) misc[TID()] = 0u;
    __syncthreads();
    KP p = kargs();
    const bool multi = (p->ph_hi - p->ph_lo) > 1;
    XcdBarrier bar; bar.bar = WSP(unsigned, WS_BAR); bar.x = 0; bar.st = misc;
    if (multi) bar = xcd_barrier_post(WSP(unsigned, WS_BAR), misc);
    int ph = 0;
    const int lo = p->ph_lo, hi = p->ph_hi;
#ifndef REPMASK
#define REPMASK 0ull
#endif
#define PH_BEGIN if (ph >= lo && ph < hi) { KP p = kargs(); const int nrep_ = ((REPMASK >> ph) & 1ull) ? 3 : 1; for (int rep_ = 0; rep_ < nrep_; ++rep_) {
#define PH_END   if (ph + 1 < hi || rep_ + 1 < nrep_) xcd_barrier(bar); } } ++ph;

    PH_BEGIN phase_ada(p, lds); phase_weights(p, lds); phase_rope_table(p); PH_END

    for (int layer = 0; layer < 4; ++layer) {
        const int j = layer >> 1;
        if ((layer & 1) == 0) {
            PH_BEGIN phase_prep<true>(p, layer, 0, j, layer == 0); PH_END
            PH_BEGIN {
                FRwkvIn f{WSP(bf16_t, WS_RB), WSP(bf16_t, WS_KB), WSP(bf16_t, WS_VB), WSP(bf16_t, WS_TW), WSP(bf16_t, WS_TA), WSP(bf16_t, WS_TV), WSP(bf16_t, WS_TG)};
                pg8::Gemm g{WSP(bf16_t, WS_XR), WSP(bf16_t, WS_WRW_T) + (size_t)j * 4096 * D, NP, j == 0 ? 3840 : 4096, D, j == 0 ? 2 : 1, XR_STRIDE};
                pg8::StaticOrder S; S.init(NP, g.N, (int)gridDim.x, BID());
                pg8::EpiAdapt<FRwkvIn, true> E{f};
                pg8::gemm_phase(lds, g, S, E);
                wgemm_ks<true>(lds, WSP(bf16_t, WS_XR), D, XR_STRIDE, NP, NS, WSP(bf16_t, WS_WRW_T) + (size_t)j * 4096 * D, D, 4096, f, ((NP / 256) * (g.N / 256)) % (int)gridDim.x);
            } PH_END
            PH_BEGIN {
                FStoreF32 fw{WSP(float, WS_WP), D, D}, fa{WSP(float, WS_AP), D, D}, fv{WSP(float, WS_VP), D, D}, fg{WSP(float, WS_GG), D, D};
                wgemm_w(WSP(bf16_t, WS_TW), 64, NP, NS, WSP(bf16_t, WS_W2T) + (size_t)j * D * 64, 64, D, fw);
                wgemm_w(WSP(bf16_t, WS_TA), 64, NP, NS, WSP(bf16_t, WS_A2T) + (size_t)j * D * 64, 64, D, fa);
                if (j == 1) wgemm_w(WSP(bf16_t, WS_TV), 32, NP, NS, WSP(bf16_t, WS_V2T), 32, D, fv);
                wgemm_w(WSP(bf16_t, WS_TG), 160, NP, NS, WSP(bf16_t, WS_G2T) + (size_t)j * D * 160, 160, D, fg);
                phase_chunk(p, j, lds);
            } PH_END
            PH_BEGIN phase_carry(p, j, lds); PH_END
            PH_BEGIN phase_post2(p, j, lds); PH_END
        } else {
            PH_BEGIN phase_prep<false>(p, layer, 0, j); PH_END
            PH_BEGIN {
                FStoreBf16 f{WSP(bf16_t, WS_PR), PINP, PINP};
                pg8::Gemm g{WSP(bf16_t, WS_XR), WSP(bf16_t, WS_WIN_T) + (size_t)j * PINP * D, NP, PINP, D, 0, 0};
                pg8::StaticOrder S; S.init(NP, PINP, (int)gridDim.x, BID());
                pg8::EpiAdapt<FStoreBf16, true> E{f};
                pg8::gemm_phase(lds, g, S, E);
                FStoreBf16 fs{WSP(bf16_t, WS_PR), PINP, PIN};
                wgemm_ks<false>(lds, WSP(bf16_t, WS_XR), D, 0, NP, NS, WSP(bf16_t, WS_WIN_T) + (size_t)j * PINP * D, D, PINP, fs, ((NP / 256) * (PINP / 256)) % (int)gridDim.x);
            } PH_END
            PH_BEGIN phase_dsapost(p, j); PH_END
            PH_BEGIN phase_idx2<false>(p, j); phase_idx2<true>(p, j); PH_END
            PH_BEGIN phase_topk_prompt(p); phase_topk_sample(p, lds); PH_END
            PH_BEGIN phase_attn<true>(p, j, lds); phase_attn<false>(p, j, lds); PH_END
        }
        PH_BEGIN {
            FResid f{p->out, WSP(float, WS_MODS) + (size_t)layer * 36 * 6144 + 2 * D, layer == 0 ? p->x_prompt : nullptr, layer == 0 ? p->x_sample : nullptr};
            const bf16_t* Wt = ((layer & 1) == 0 ? WSP(bf16_t, WS_WO_T) : WSP(bf16_t, WS_WAO_T)) + (size_t)j * D * D;
            pg8::Gemm g{WSP(bf16_t, WS_YG), Wt, NP, D, D, 0, 0};
            pg8::StaticOrder S; S.init(NP, D, (int)gridDim.x, BID());
            pg8::EpiAdapt<FResid, false> E{f};
            pg8::gemm_phase(lds, g, S, E);
            wgemm_ks<false>(lds, WSP(bf16_t, WS_YG), D, 0, NP, NS, Wt, D, D, f);
        } PH_END
        PH_BEGIN phase_prep<false>(p, layer, 1, j); PH_END
        PH_BEGIN {
            FRelu2 f{WSP(bf16_t, WS_U)};
            pg8::Gemm g{WSP(bf16_t, WS_XR), WSP(bf16_t, WS_WUP_T) + (size_t)layer * DFF * D, NP, DFF, D, 0, 0};
            pg8::StaticOrder S; S.init(NP, DFF, (int)gridDim.x, BID());
            pg8::EpiAdapt<FRelu2, true> E{f};
            pg8::gemm_phase(lds, g, S, E);
            wgemm_ks<false>(lds, WSP(bf16_t, WS_XR), D, 0, NP, NS, WSP(bf16_t, WS_WUP_T) + (size_t)layer * DFF * D, D, DFF, f);
        } PH_END
        PH_BEGIN {
            FResid f{p->out, WSP(float, WS_MODS) + (size_t)layer * 36 * 6144 + 5 * D, nullptr, nullptr};
            pg8::Gemm g{WSP(bf16_t, WS_U), WSP(bf16_t, WS_WDN_T) + (size_t)layer * DFF * D, NP, D, DFF, 0, 0};
            pg8::StaticOrder S; S.init(NP, D, (int)gridDim.x, BID());
            pg8::EpiAdapt<FResid, false> E{f};
            pg8::gemm_phase(lds, g, S, E);
            wgemm_ks<false>(lds, WSP(bf16_t, WS_U), DFF, 0, NP, NS, WSP(bf16_t, WS_WDN_T) + (size_t)layer * DFF * D, DFF, D, f);
        } PH_END
    }
#undef PH_BEGIN
#undef PH_END
}

static int count_phases() { int n = 1; for (int layer = 0; layer < 4; ++layer) { n += ((layer & 1) == 0) ? 5 : 6; n += 4; } return n; }

extern "C" void kernel_launch(void* const* d_in, const int* in_sizes, int n_in, void* d_out, int out_size, void* d_ws, size_t ws_size, hipStream_t stream) {
    static int grid = 0;
    if (grid == 0) {
        if (n_in != 39 || out_size != (int)O_END || ws_size < WS_END) { fprintf(stderr, "kernel_launch: unexpected shapes n_in %d out %d ws %zu (need %zu)\n", n_in, out_size, ws_size, (size_t)WS_END); grid = -1; return; }
        int dev = 0, cus = 0, per_cu = 0;
        if (hipGetDevice(&dev) != hipSuccess || hipDeviceGetAttribute(&cus, hipDeviceAttributeMultiprocessorCount, dev) != hipSuccess) { grid = -1; return; }
        if (hipFuncSetAttribute((const void*)mega, hipFuncAttributeMaxDynamicSharedMemorySize, LDS_BYTES) != hipSuccess) { fprintf(stderr, "kernel_launch: hipFuncSetAttribute failed\n"); grid = -1; return; }
        if (hipOccupancyMaxActiveBlocksPerMultiprocessor(&per_cu, (const void*)mega, 512, LDS_BYTES) != hipSuccess || per_cu < 1) fprintf(stderr, "kernel_launch: occupancy query says %d\n", per_cu);
        (void)hipGetLastError();
        grid = cus;
    }
    if (grid < 0) return;
    (void)hipMemsetAsync((char*)d_ws + WS_BAR, 0, 65536, stream);
    P p{};
    memcpy((void*)&p, (const void*)d_in, 39 * sizeof(void*));
    p.out = (float*)d_out; p.ws = (unsigned char*)d_ws;
#ifndef STOP_PH
#define STOP_PH 1000
#endif
    const int nph = count_phases() < STOP_PH ? count_phases() : STOP_PH;
#ifndef ONE_LAUNCH
    for (int ph = 0; ph < nph; ++ph) { p.ph_lo = ph; p.ph_hi = ph + 1; hipLaunchKernelGGL(mega, dim3(grid), dim3(512), LDS_BYTES, stream, p); }
#else
    p.ph_lo = 0; p.ph_hi = nph; hipLaunchKernelGGL(mega, dim3(grid), dim3(512), LDS_BYTES, stream, p);
#endif
}
```

```cpp
#define ONE_LAUNCH 1
#include <hip/hip_runtime.h>
#include <cstdio>
#include <cstdint>
#include <cstring>

#define LAS __attribute__((address_space(3)))
typedef unsigned short bf16_t;
typedef short bf16x8 __attribute__((ext_vector_type(8)));
typedef float f32x4 __attribute__((ext_vector_type(4)));
typedef float f32x2 __attribute__((ext_vector_type(2)));
typedef unsigned u32x4 __attribute__((ext_vector_type(4)));
typedef unsigned u32x2 __attribute__((ext_vector_type(2)));

constexpr int D = 1024, NP = 16384, NS = 256, NT = NP + NS, SEQL = 4096, PAST = 8192, NSEQ = 36, DFF = 4096;
constexpr int PIN = 2120, PINP = 2304;
constexpr int TOPK = 256, SCS_LD = 8320;
constexpr size_t O_YP = 0, O_YS = 16777216, O_KP = 17039360, O_VP = 25427968, O_IKP = 33816576, O_WKVP = 35913728, O_SHP = 36438016,
                 O_KS = 36446208, O_VS = 36577280, O_IKS = 36708352, O_WKVS = 36741120, O_SHS = 40935424, O_END = 41000960;
constexpr size_t al256(size_t x) { return (x + 255) & ~(size_t)255; }
constexpr size_t WS_BAR = 0;
constexpr size_t WS_MODS = 65536;
constexpr size_t WS_WUP_T = al256(WS_MODS + (size_t)4 * NSEQ * 6144 * 4);
constexpr size_t WS_WDN_T = WS_WUP_T + (size_t)4 * DFF * D * 2;
constexpr size_t WS_WRW_T = WS_WDN_T + (size_t)4 * DFF * D * 2;
constexpr size_t WS_WO_T = WS_WRW_T + (size_t)2 * 4096 * D * 2;
constexpr size_t WS_WIN_T = WS_WO_T + (size_t)2 * D * D * 2;
constexpr size_t WS_WAO_T = WS_WIN_T + (size_t)2 * PINP * D * 2;
constexpr size_t WS_W2T = WS_WAO_T + (size_t)2 * D * D * 2;
constexpr size_t WS_A2T = WS_W2T + (size_t)2 * D * 64 * 2;
constexpr size_t WS_V2T = WS_A2T + (size_t)2 * D * 64 * 2;
constexpr size_t WS_G2T = WS_V2T + (size_t)D * 32 * 2;
constexpr size_t WS_XR = WS_G2T + (size_t)2 * D * 160 * 2;
constexpr size_t XR_STRIDE = (size_t)NT * D;
constexpr size_t WS_RB = WS_XR + 6 * XR_STRIDE * 2;
constexpr size_t WS_KB = WS_RB + XR_STRIDE * 2;
constexpr size_t WS_VB = WS_KB + XR_STRIDE * 2;
constexpr size_t WS_TW = WS_VB + XR_STRIDE * 2;
constexpr size_t WS_TA = WS_TW + (size_t)NT * 64 * 2;
constexpr size_t WS_TV = WS_TA + (size_t)NT * 64 * 2;
constexpr size_t WS_TG = WS_TV + (size_t)NT * 32 * 2;
constexpr size_t WS_WP = al256(WS_TG + (size_t)NT * 160 * 2);
constexpr size_t F32A = (size_t)NT * D * 4;
constexpr size_t WS_AP = WS_WP + F32A, WS_VP = WS_AP + F32A, WS_GG = WS_VP + F32A, WS_VFIRST = WS_GG + F32A;
constexpr size_t WS_DEC = WS_VFIRST + F32A, WS_KM = WS_DEC + F32A, WS_VM = WS_KM + F32A, WS_AV = WS_VM + F32A, WS_BV = WS_AV + F32A, WS_Y = WS_BV + F32A;
constexpr size_t WS_YG = WS_Y + F32A;
constexpr size_t WS_U = WS_YG + XR_STRIDE * 2;
constexpr size_t WS_PR = WS_U + (size_t)NT * DFF * 2;
constexpr size_t WS_Q = WS_PR + (size_t)NT * PINP * 4;
constexpr size_t WS_QI = WS_Q + F32A;
constexpr size_t WS_WI = WS_QI + (size_t)NT * 512 * 4;
constexpr size_t WS_SC = al256(WS_WI + (size_t)NT * 8 * 4);
constexpr size_t WS_SCS = WS_SC + (size_t)4 * 4096 * 4096 * 4;
constexpr size_t WS_SEL = al256(WS_SCS + (size_t)NS * SCS_LD * 4);
constexpr size_t WS_CNT = WS_SEL + (size_t)NT * 256 * 4;
constexpr size_t WS_KBF = al256(WS_CNT + (size_t)NT * 4);
constexpr size_t WS_VBF = WS_KBF + (size_t)NT * 256 * 2;
constexpr size_t WS_QIB = WS_VBF + (size_t)NT * 256 * 2;
constexpr size_t WS_KIB = WS_QIB + (size_t)NT * 512 * 2;
constexpr size_t WS_K8 = al256(WS_KIB + (size_t)NT * 64 * 2);
constexpr size_t WS_V8 = WS_K8 + (size_t)NT * 256;
constexpr size_t WS_END = al256(WS_V8 + (size_t)NT * 256);
constexpr size_t WS_ROPE = WS_KBF;

constexpr int LCH = 64, NCH = SEQL / LCH;
constexpr size_t WS_PCH = WS_SC, WS_CCH = WS_PCH + (size_t)64 * NCH * 4096 * 4, WS_SST = WS_CCH + (size_t)64 * NCH * 4096 * 4;
static_assert(WS_SST + (size_t)64 * NCH * 4096 * 4 <= WS_SCS, "scan buffers must fit the aliased region");
constexpr int LDS_BYTES = 147456;
constexpr int LDS_MISC = 131072;

typedef __bf16 bf16x2_t __attribute__((ext_vector_type(2)));
__device__ __forceinline__ unsigned pk_bf16(float lo, float hi) { const f32x2 v = {lo, hi}; const bf16x2_t b = __builtin_convertvector(v, bf16x2_t); return __builtin_bit_cast(unsigned, b); }
__device__ __forceinline__ unsigned pk_fp8x4(f32x4 v) { int w = 0; w = __builtin_amdgcn_cvt_pk_fp8_f32(v[0], v[1], w, false); w = __builtin_amdgcn_cvt_pk_fp8_f32(v[2], v[3], w, true); return (unsigned)w; }
__device__ __forceinline__ f32x4 fp8x4_f32(unsigned w) { return (f32x4){__builtin_amdgcn_cvt_f32_fp8((int)w, 0), __builtin_amdgcn_cvt_f32_fp8((int)w, 1), __builtin_amdgcn_cvt_f32_fp8((int)w, 2), __builtin_amdgcn_cvt_f32_fp8((int)w, 3)}; }
__device__ __forceinline__ float bf2f(unsigned short x) { return __uint_as_float((unsigned)x << 16); }
__device__ __forceinline__ float bflo(unsigned x) { return __uint_as_float(x << 16); }
__device__ __forceinline__ float bfhi(unsigned x) { return __uint_as_float(x & 0xffff0000u); }
__device__ __forceinline__ f32x4 ld_bf4(const bf16_t* p) { const u32x2 v = *(const u32x2*)p; return (f32x4){bflo(v.x), bfhi(v.x), bflo(v.y), bfhi(v.y)}; }
__device__ __forceinline__ void st_bf4(bf16_t* p, f32x4 v) { u32x2 w; w.x = pk_bf16(v[0], v[1]); w.y = pk_bf16(v[2], v[3]); *(u32x2*)p = w; }
template <int CTRL> __device__ __forceinline__ float dppf(float v) { return __int_as_float(__builtin_amdgcn_update_dpp(0, __float_as_int(v), CTRL, 0xf, 0xf, false)); }
template <int CTRL> __device__ __forceinline__ int dppi(int v) { return __builtin_amdgcn_update_dpp(0, v, CTRL, 0xf, 0xf, false); }
__device__ __forceinline__ float g16_sum(float v) { v += dppf<0xB1>(v); v += dppf<0x4E>(v); v += dppf<0x141>(v); v += dppf<0x140>(v); return v; }
__device__ __forceinline__ float g16_max(float v) { v = fmaxf(v, dppf<0xB1>(v)); v = fmaxf(v, dppf<0x4E>(v)); v = fmaxf(v, dppf<0x141>(v)); v = fmaxf(v, dppf<0x140>(v)); return v; }
__device__ __forceinline__ int g16_sum_i(int v) { v += dppi<0xB1>(v); v += dppi<0x4E>(v); v += dppi<0x141>(v); v += dppi<0x140>(v); return v; }
__device__ __forceinline__ int g16_min_i(int v) { v = min(v, dppi<0xB1>(v)); v = min(v, dppi<0x4E>(v)); v = min(v, dppi<0x141>(v)); v = min(v, dppi<0x140>(v)); return v; }
__device__ __forceinline__ float rlf(float v, int k) { return __int_as_float(__builtin_amdgcn_readlane(__float_as_int(v), k)); }
__device__ __forceinline__ float wave_sum(float v) { v = g16_sum(v); return (rlf(v, 0) + rlf(v, 16)) + (rlf(v, 32) + rlf(v, 48)); }
__device__ __forceinline__ float wave_max(float v) { v = g16_max(v); return fmaxf(fmaxf(rlf(v, 0), rlf(v, 16)), fmaxf(rlf(v, 32), rlf(v, 48))); }
__device__ __forceinline__ int wave_sum_i(int v) { v = g16_sum_i(v); return (__builtin_amdgcn_readlane(v, 0) + __builtin_amdgcn_readlane(v, 16)) + (__builtin_amdgcn_readlane(v, 32) + __builtin_amdgcn_readlane(v, 48)); }
__device__ __forceinline__ int wave_min_i(int v) { v = g16_min_i(v); return min(min(__builtin_amdgcn_readlane(v, 0), __builtin_amdgcn_readlane(v, 16)), min(__builtin_amdgcn_readlane(v, 32), __builtin_amdgcn_readlane(v, 48))); }
__device__ __forceinline__ float sigmoidf_(float x) { return 1.0f / (1.0f + expf(-x)); }
__device__ __forceinline__ float fsig(float x) { return __builtin_amdgcn_rcpf(1.0f + __expf(-x)); }
__device__ __forceinline__ float ftanh(float x) { return 2.0f * fsig(2.0f * x) - 1.0f; }
__device__ __forceinline__ int row_seq(int row) { return row < NP ? (row >> 12) : 4 + ((row - NP) >> 3); }
__device__ __forceinline__ int row_pos(int row) { return row < NP ? (row & 4095) : PAST + ((row - NP) & 7); }
__device__ __forceinline__ int TID() { int t = threadIdx.x; asm volatile("" : "+v"(t)); return t; }
__device__ __forceinline__ int BID() { int b = blockIdx.x; asm volatile("" : "+s"(b)); return b; }
__device__ __forceinline__ void wave_lds_fence() { __builtin_amdgcn_fence(__ATOMIC_RELEASE, "wavefront"); __builtin_amdgcn_wave_barrier(); __builtin_amdgcn_fence(__ATOMIC_ACQUIRE, "wavefront"); }

#define XB_TMO      128
#define XB_XCNT(j)  (256  + 64 * (j))
#define XB_XSUB(j)  (1280 + 64 * (j))
#define XB_XGEN(j)  (2304 + 64 * (j))
#define XB_TOP      3328
#define XB_TOPGEN   3392
#define XCD_BAR_WORDS 3456
#define XB_SPIN_CAP (1u << 22)
__device__ __forceinline__ unsigned xb_ld(unsigned* p)              { return __hip_atomic_load(p, __ATOMIC_RELAXED, __HIP_MEMORY_SCOPE_AGENT); }
__device__ __forceinline__ unsigned xb_add(unsigned* p, unsigned v) { return __hip_atomic_fetch_add(p, v, __ATOMIC_RELAXED, __HIP_MEMORY_SCOPE_AGENT); }
__device__ __forceinline__ unsigned xb_xcc_id() { return (unsigned)__builtin_amdgcn_s_getreg((3 << 11) | 20) & 0xFu; }
#define XB_SPIN(cond, bar) do { unsigned _sp = 0; while (cond) { __builtin_amdgcn_s_sleep(1); \
    if ((++_sp & 255u) == 0u) { if (xb_ld(&(bar)[XB_TMO])) break; if (_sp > XB_SPIN_CAP) { atomicAdd(&(bar)[XB_TMO], 1u); break; } } } } while (0)
struct XcdBarrier { unsigned* bar; unsigned x; volatile LAS unsigned* st; };
__device__ __forceinline__ XcdBarrier xcd_barrier_post(unsigned* bar, volatile LAS unsigned* st) {
    XcdBarrier b; b.bar = bar; b.x = xb_xcc_id(); b.st = st;
    if (threadIdx.x == 0) (void)xb_add(&bar[XB_XCNT(b.x)], 1u);
    return b;
}
__device__ __forceinline__ void xcd_barrier_complete(unsigned* bar, unsigned x, unsigned& nloc, unsigned& nx) {
    const unsigned G = gridDim.x * gridDim.y * gridDim.z;
    unsigned sum, cnt, mine, sp = 0u;
    for (;;) {
        sum = 0u; cnt = 0u; mine = 0u;
#pragma unroll
        for (unsigned j = 0; j < 16; ++j) { const unsigned c = xb_ld(&bar[XB_XCNT(j)]); sum += c; cnt += (c > 0u) ? 1u : 0u; mine = (j == x) ? c : mine; }
        if (sum == G) break;
        __builtin_amdgcn_s_sleep(1);
        if ((++sp & 255u) == 0u) { if (xb_ld(&bar[XB_TMO])) break; if (sp > XB_SPIN_CAP) { atomicAdd(&bar[XB_TMO], 1u); break; } }
    }
    nloc = mine > 0u ? mine : 1u; nx = cnt > 0u ? cnt : 1u;
}
__device__ __forceinline__ void xcd_barrier(const XcdBarrier& b) {
    asm volatile("s_waitcnt vmcnt(0)" ::: "memory");
    __syncthreads();
    if (threadIdx.x == 0) {
        unsigned* bar = b.bar;
        __builtin_amdgcn_s_waitcnt(0);
        unsigned nloc = b.st[0], nx = b.st[1];
        if (nloc == 0u) { xcd_barrier_complete(bar, b.x, nloc, nx); b.st[0] = nloc; b.st[1] = nx; }
        const unsigned old = xb_add(&bar[XB_XSUB(b.x)], 1u);
        const unsigned gen = old / nloc;
        if (old + 1u == (gen + 1u) * nloc) {
            __builtin_amdgcn_fence(__ATOMIC_RELEASE, "agent");
            asm volatile("s_waitcnt vmcnt(0)" ::: "memory");
            const unsigned og = xb_add(&bar[XB_TOP], 1u);
            const unsigned tg = og / nx;
            if (og + 1u == (tg + 1u) * nx) xb_add(&bar[XB_TOPGEN], 1u);
            else XB_SPIN(xb_ld(&bar[XB_TOPGEN]) == tg, bar);
            __builtin_amdgcn_fence(__ATOMIC_ACQUIRE, "agent");
            xb_add(&bar[XB_XGEN(b.x)], 1u);
            asm volatile("s_waitcnt vmcnt(0)" ::: "memory");
        } else {
            XB_SPIN(xb_ld(&bar[XB_XGEN(b.x)]) == gen, bar);
            __builtin_amdgcn_fence(__ATOMIC_ACQUIRE, "agent");
            asm volatile("s_waitcnt vmcnt(0)" ::: "memory");
        }
    }
    __syncthreads();
}

struct P {
    const float *x_prompt, *x_sample, *cache_k, *cache_v, *cache_ik, *state_wkv, *state_shift; const int* page_table;
    const float *c_prompt, *c_sample, *norm_g, *w_ada, *b_ada, *w_up, *w_down, *rw_mix, *rw_w_rkv, *rw_w_o, *rw_w0, *rw_w1, *rw_w2, *rw_a0, *rw_a1, *rw_a2,
                *rw_v0, *rw_v1, *rw_v2, *rw_g1, *rw_g2, *rw_k_k, *rw_k_a, *rw_r_k, *rw_lnx_w, *rw_lnx_b, *att_w_in, *att_w_o, *att_q_norm, *att_k_norm, *idx_k_norm;
    float* out; unsigned char* ws; int ph_lo, ph_hi;
};
typedef const P __attribute__((address_space(4)))* KP;
#define WSP(T, off) ((T*)(p->ws + (off)))
__device__ __forceinline__ KP kargs() { KP k = (KP)__builtin_amdgcn_kernarg_segment_ptr(); asm volatile("" : "+s"(k)); return k; }

namespace pg8 {
constexpr int BM = 256, BK = 64, HALF = 128, HTB = HALF * BK * 2, STAGE_BYTES = 8 * HTB, NXCD = 8, WGM = 8;
__device__ __forceinline__ int lds_byte(int r, int c) { const int st = (r >> 4) * 2 + (c >> 5), rr = r & 15, cc = c & 31, ob = rr * 64 + cc * 2; return st * 1024 + (ob ^ (((ob >> 9) & 1) << 5)); }
__device__ __forceinline__ void stage_rc(int b, int& R, int& C) { const int st = b / 1024, sb = b % 1024, swz = sb ^ (((sb >> 9) & 1) << 5); R = (st >> 1) * 16 + swz / 64; C = (st & 1) * 32 + (swz % 64) / 2; }
__device__ __forceinline__ int perm32(int rho) { const int n = rho >> 4, i = rho & 15; return 8 * (i >> 2) + 4 * n + (i & 3); }
struct Unit { int pm, pn; };
struct Gemm { const bf16_t* A; const bf16_t* Bt; int M, N, K, mode; size_t agrp; };
__device__ __forceinline__ int phys_pn(const Gemm& g, int pn) { return (g.mode == 2 && pn >= 12) ? pn + 1 : pn; }
__device__ __forceinline__ const char* a_ptr(const Gemm& g, const Unit& u, size_t tstep) {
    int grp = 0; if (g.mode) grp = u.pn < 12 ? (u.pn >> 2) : (u.pn == 12 ? 2 : u.pn - 10);
    return (const char*)g.A + (size_t)grp * g.agrp * 2 + (size_t)u.pm * tstep; }
struct StaticOrder {
    int nM, nN, nwg, G, c;
    __device__ void init(int M, int N, int G_, int c_) { nM = M / BM; nN = N / BM; nwg = nM * nN; G = G_; c = c_; }
    __device__ bool next(int i, Unit& u) const {
        const long L = (long)i * G + c; if (L >= nwg) return false;
        int wgid = (int)L; { const int q = nwg / NXCD, r = nwg % NXCD, xcd = wgid % NXCD, off = wgid / NXCD; wgid = (xcd < r ? xcd * (q + 1) : r * (q + 1) + (xcd - r) * q) + off; }
        const int nig = WGM * nN, gid = wgid / nig, fm = gid * WGM, gsz = (nM - fm) < WGM ? (nM - fm) : WGM;
        u.pm = fm + ((wgid % nig) % gsz); u.pn = (wgid % nig) / gsz; return true;
    }
};
template <class F, bool PERM_> struct EpiAdapt {
    static constexpr bool PERM = PERM_;
    F f;
    __device__ __forceinline__ void operator()(const f32x4 (&acc)[2][2][4][2], const Unit& u, int wr, int wc, int fr, int fq) const {
        const int row0 = u.pm * BM + wr * 64 + fr, col0 = u.pn * BM + wc * 32 + (PERM ? 8 * fq : 4 * fq);
#pragma unroll
        for (int ai = 0; ai < 2; ++ai)
#pragma unroll
            for (int m = 0; m < 4; ++m)
#pragma unroll
                for (int bj = 0; bj < 2; ++bj) {
                    if constexpr (PERM) f.vec8(row0 + ai * HALF + m * 16, col0 + bj * HALF, acc[ai][bj][m][0], acc[ai][bj][m][1]);
                    else {
#pragma unroll
                        for (int n = 0; n < 2; ++n) f.vec4(row0 + ai * HALF + m * 16, col0 + bj * HALF + 16 * n, acc[ai][bj][m][n]);
                    }
                }
    }
};

template <class Epi>
__device__ __forceinline__ void gemm_phase(LAS unsigned char* lds, const Gemm g, const StaticOrder& S, const Epi& E) {
    const int tid = TID(), wid = __builtin_amdgcn_readfirstlane(tid >> 6), lane = tid & 63, wr = wid >> 2, wc = wid & 3, fr = lane & 15, fq = lane >> 4;
    const int K = g.K, nt = K / BK;
    unsigned voffA[2], voffB[2];
#pragma unroll
    for (int i = 0; i < 2; ++i) { int R, C; stage_rc(tid * 16 + i * 8192, R, C); const int Rb = Epi::PERM ? ((R & ~31) + perm32(R & 31)) : R;
        voffA[i] = (unsigned)(R * K + C) * 2u; voffB[i] = (unsigned)(Rb * K + C) * 2u; }
    const size_t kstep = (size_t)(BK * 2);
    const size_t hstep = (size_t)HALF * K * 2;
    const size_t tstep = 2 * hstep;
    const unsigned ldsw = (unsigned)wid * 1024u;
    const int aoff = lds_byte(wr * 64 + fr, fq * 8), boff = lds_byte(wc * 32 + fr, fq * 8);
#define PG8_SA(b, h) (((b) * 2 + (h)) * HTB)
#define PG8_SB(b, h) ((4 + (b) * 2 + (h)) * HTB)
#define PG8_STAGE(bufoff, gbase, voff) do { _Pragma("unroll") for (int _i = 0; _i < 2; ++_i) \
        __builtin_amdgcn_global_load_lds((const unsigned*)((const char*)(gbase) + (voff)[_i]), (LAS unsigned*)(lds + (bufoff) + ldsw + _i * 8192), 16, 0, 0); } while (0)
#define PG8_LDA(dst, b, h) do { _Pragma("unroll") for (int m = 0; m < 4; ++m) _Pragma("unroll") for (int k = 0; k < 2; ++k) dst[m][k] = *(const LAS bf16x8*)(lds + PG8_SA(b, h) + aoff + m * 2048 + k * 1024); } while (0)
#define PG8_LDB(dst, b, h) do { _Pragma("unroll") for (int n = 0; n < 2; ++n) _Pragma("unroll") for (int k = 0; k < 2; ++k) dst[n][k] = *(const LAS bf16x8*)(lds + PG8_SB(b, h) + boff + n * 2048 + k * 1024); } while (0)
#define PG8_MMA(ai, bj, At, Bt) do { __builtin_amdgcn_s_setprio(1); _Pragma("unroll") for (int m = 0; m < 4; ++m) _Pragma("unroll") for (int n = 0; n < 2; ++n) _Pragma("unroll") for (int k = 0; k < 2; ++k) \
        acc[ai][bj][m][n] = __builtin_amdgcn_mfma_f32_16x16x32_bf16(Bt[n][k], At[m][k], acc[ai][bj][m][n], 0, 0, 0); __builtin_amdgcn_s_setprio(0); } while (0)
#define PG8_WAIT_V(n) asm volatile("s_waitcnt vmcnt(" #n ")" ::: "memory")
#define PG8_WAIT_L(n) asm volatile("s_waitcnt lgkmcnt(" #n ")" ::: "memory")
#define PG8_BAR __builtin_amdgcn_s_barrier()
#define PG8_SCHED __builtin_amdgcn_sched_barrier(0)
    Unit cur, nxt; int ui = 0;
    if (!S.next(0, cur)) return;
    cur.pn = phys_pn(g, cur.pn);
    f32x4 acc[2][2][4][2];
#pragma unroll
    for (int a = 0; a < 2; ++a)
#pragma unroll
        for (int b = 0; b < 2; ++b)
#pragma unroll
            for (int m = 0; m < 4; ++m)
#pragma unroll
                for (int n = 0; n < 2; ++n) acc[a][b][m][n] = (f32x4){0.f, 0.f, 0.f, 0.f};
    bf16x8 At[4][2], B0[2][2], B1[2][2];
    const char* cA = a_ptr(g, cur, tstep); const char* cB = (const char*)g.Bt + (size_t)cur.pn * tstep;
    PG8_STAGE(PG8_SB(0, 0), cB, voffB); PG8_STAGE(PG8_SA(0, 0), cA, voffA); PG8_STAGE(PG8_SB(0, 1), cB + hstep, voffB); PG8_STAGE(PG8_SA(0, 1), cA + hstep, voffA);
    if (wr == 1) PG8_BAR;
    PG8_WAIT_V(4); PG8_BAR;
    PG8_STAGE(PG8_SB(1, 0), cB + kstep, voffB); PG8_STAGE(PG8_SA(1, 0), cA + kstep, voffA); PG8_STAGE(PG8_SB(1, 1), cB + hstep + kstep, voffB);
    PG8_WAIT_V(6); PG8_BAR;
    for (;;) {
        const bool has_next = S.next(ui + 1, nxt);
        if (has_next) nxt.pn = phys_pn(g, nxt.pn);
        const char* nA = has_next ? a_ptr(g, nxt, tstep) : cA; const char* nB = has_next ? (const char*)g.Bt + (size_t)nxt.pn * tstep : cB;
        for (int t = 0; t < nt; t += 2) {
            const bool last = (t == nt - 2);
            const char* a1 = cA + (size_t)(t + 1) * kstep;
            const char* a2 = last ? nA : cA + (size_t)(t + 2) * kstep; const char* b2 = last ? nB : cB + (size_t)(t + 2) * kstep;
            const char* a3 = a2 + kstep; const char* b3 = b2 + kstep;
            PG8_LDB(B0, 0, 0); PG8_SCHED; PG8_LDA(At, 0, 0); PG8_STAGE(PG8_SA(1, 1), a1 + hstep, voffA);
            PG8_WAIT_L(8); PG8_BAR; PG8_WAIT_L(0); PG8_MMA(0, 0, At, B0); PG8_BAR; PG8_SCHED;
            PG8_LDB(B1, 0, 1); PG8_STAGE(PG8_SB(0, 0), b2, voffB);
            PG8_BAR; PG8_WAIT_L(0); PG8_MMA(0, 1, At, B1); PG8_BAR;
            PG8_LDA(At, 0, 1); PG8_STAGE(PG8_SA(0, 0), a2, voffA);
            PG8_BAR; PG8_WAIT_L(0); PG8_MMA(1, 0, At, B0); PG8_BAR; PG8_SCHED;
            PG8_STAGE(PG8_SB(0, 1), b2 + hstep, voffB);
            PG8_WAIT_V(6); PG8_BAR; PG8_MMA(1, 1, At, B1); PG8_BAR;
            PG8_LDB(B0, 1, 0); PG8_SCHED; PG8_LDA(At, 1, 0); PG8_STAGE(PG8_SA(0, 1), a2 + hstep, voffA);
            PG8_WAIT_L(8); PG8_BAR; PG8_WAIT_L(0); PG8_MMA(0, 0, At, B0); PG8_BAR; PG8_SCHED;
            PG8_LDB(B1, 1, 1); PG8_STAGE(PG8_SB(1, 0), b3, voffB);
            PG8_BAR; PG8_WAIT_L(0); PG8_MMA(0, 1, At, B1); PG8_BAR;
            PG8_LDA(At, 1, 1); PG8_STAGE(PG8_SA(1, 0), a3, voffA);
            PG8_BAR; PG8_WAIT_L(0); PG8_MMA(1, 0, At, B0); PG8_BAR; PG8_SCHED;
            PG8_STAGE(PG8_SB(1, 1), b3 + hstep, voffB);
            PG8_WAIT_V(6); PG8_BAR; PG8_MMA(1, 1, At, B1); PG8_BAR;
        }
        E(acc, cur, wr, wc, fr, fq);
        if (!has_next) break;
#pragma unroll
        for (int a = 0; a < 2; ++a)
#pragma unroll
            for (int b = 0; b < 2; ++b)
#pragma unroll
                for (int m = 0; m < 4; ++m)
#pragma unroll
                    for (int n = 0; n < 2; ++n) acc[a][b][m][n] = (f32x4){0.f, 0.f, 0.f, 0.f};
        cur = nxt; cA = nA; cB = nB; ++ui;
    }
    PG8_WAIT_V(0);
    if (wr == 0) PG8_BAR;
    PG8_BAR;
#undef PG8_SA
#undef PG8_SB
#undef PG8_STAGE
#undef PG8_LDA
#undef PG8_LDB
#undef PG8_MMA
#undef PG8_WAIT_V
#undef PG8_WAIT_L
#undef PG8_BAR
#undef PG8_SCHED
}
}

template <class F>
__device__ __forceinline__ void sgemm_bf(LAS unsigned char* lds, const bf16_t* A, int lda, int row0, int M, const float* W, int ldw, int N, int K, int coloff, const F& f) {
    LAS float* As = (LAS float*)lds;
    LAS float* Ws = (LAS float*)(lds + 32 * 68 * 4);
    const int tid = TID(), ty = tid >> 4, tx = tid & 15;
    const int ntn = (N + 63) / 64, ntiles = (M / 64) * ntn;
    for (int tile = BID(); tile < ntiles; tile += gridDim.x) {
        const int tm = tile / ntn, tn = tile % ntn, r0 = row0 + tm * 64, n0 = tn * 64;
        f32x4 c0 = {0.f, 0.f, 0.f, 0.f}, c1 = {0.f, 0.f, 0.f, 0.f};
        for (int k0 = 0; k0 < K; k0 += 32) {
            __syncthreads();
            { const int r = tid >> 3, q = tid & 7; const f32x4 a = ld_bf4(A + (size_t)(r0 + r) * lda + k0 + 4 * q);
              As[(4 * q + 0) * 68 + r] = a[0]; As[(4 * q + 1) * 68 + r] = a[1]; As[(4 * q + 2) * 68 + r] = a[2]; As[(4 * q + 3) * 68 + r] = a[3]; }
            { const int kr = tid >> 4, c = tid & 15; f32x4 w = {0.f, 0.f, 0.f, 0.f}; if (n0 + 4 * c < N) w = *(const f32x4*)(W + (size_t)(k0 + kr) * ldw + n0 + 4 * c);
              *(LAS f32x4*)(Ws + kr * 68 + 4 * c) = w; }
            __syncthreads();
#pragma unroll 8
            for (int kk = 0; kk < 32; ++kk) {
                const f32x2 a = *(const LAS f32x2*)(As + kk * 68 + 2 * ty); const f32x4 b = *(const LAS f32x4*)(Ws + kk * 68 + 4 * tx);
                c0 += a.x * b; c1 += a.y * b;
            }
        }
        if (n0 + 4 * tx < N) { f.vec4(r0 + 2 * ty, n0 + 4 * tx + coloff, c0); f.vec4(r0 + 2 * ty + 1, n0 + 4 * tx + coloff, c1); }
    }
    __syncthreads();
}

typedef float f32x16 __attribute__((ext_vector_type(16)));
__device__ __forceinline__ int rw_group(int n0) { const int t = n0 >> 8; return t < 12 ? (t >> 2) : (t == 12 ? 2 : t - 10); }
template <bool RWGRP, class F>
__device__ __forceinline__ void wgemm_ks(LAS unsigned char* lds, const bf16_t* A, int lda, size_t agrp, int row0, int M, const bf16_t* Bt, int K, int N, const F& f, int wg0 = 0) {
    const int tid = TID(), wave = tid >> 6, lane = tid & 63, lr = lane & 31, lh = lane >> 5;
    LAS float* red = (LAS float*)lds;
    const int ntn = N / 64, nitems = (M / 32) * ntn, kw = K / 8, steps = kw / 16;
    const int vb_ = BID() - wg0, nwg_ = (int)gridDim.x - wg0;
    for (int item = vb_ < 0 ? nitems : vb_; item < nitems; item += nwg_) {
        const int tm = item / ntn, tn = item % ntn, r0 = row0 + tm * 32, n0 = tn * 64;
        const bf16_t* Ab = A + (RWGRP ? (size_t)rw_group(n0) * agrp : 0) + (size_t)(r0 + lr) * lda + wave * kw + lh * 8;
        const bf16_t* B0 = Bt + (size_t)(n0 + lr) * K + wave * kw + lh * 8; const bf16_t* B1 = B0 + (size_t)32 * K;
        f32x16 acc0, acc1;
#pragma unroll
        for (int r = 0; r < 16; ++r) { acc0[r] = 0.f; acc1[r] = 0.f; }
#pragma unroll 8
        for (int st = 0; st < steps; ++st) {
            const bf16x8 a = *(const bf16x8*)(Ab + 16 * st), b0 = *(const bf16x8*)(B0 + 16 * st), b1 = *(const bf16x8*)(B1 + 16 * st);
            acc0 = __builtin_amdgcn_mfma_f32_32x32x16_bf16(b0, a, acc0, 0, 0, 0);
            acc1 = __builtin_amdgcn_mfma_f32_32x32x16_bf16(b1, a, acc1, 0, 0, 0);
        }
        __syncthreads();
#pragma unroll
        for (int r = 0; r < 16; ++r) { red[((wave * 2 + 0) * 16 + r) * 64 + lane] = acc0[r]; red[((wave * 2 + 1) * 16 + r) * 64 + lane] = acc1[r]; }
        __syncthreads();
        { const int t = tid >> 8, r4 = (tid >> 6) & 3, l2 = tid & 63; f32x4 v = {0.f, 0.f, 0.f, 0.f};
#pragma unroll
          for (int w = 0; w < 8; ++w)
#pragma unroll
              for (int e = 0; e < 4; ++e) v[e] += red[((w * 2 + t) * 16 + 4 * r4 + e) * 64 + l2];
          f.vec4(r0 + (l2 & 31), n0 + 32 * t + 8 * r4 + 4 * (l2 >> 5), v); }
    }
    __syncthreads();
}
template <class F>
__device__ __forceinline__ void wgemm_w(const bf16_t* A, int lda, int row0, int M, const bf16_t* Bt, int K, int N, const F& f) {
    const int lane = TID() & 63, lr = lane & 31, lh = lane >> 5, gw = BID() * 8 + (TID() >> 6), nw = gridDim.x * 8;
    const int ntn = N / 64, nitems = (M / 32) * ntn, steps = K / 16;
    for (int item = gw; item < nitems; item += nw) {
        const int tm = item / ntn, tn = item % ntn, r0 = row0 + tm * 32, n0 = tn * 64;
        const bf16_t* Ab = A + (size_t)(r0 + lr) * lda + lh * 8;
        const bf16_t* B0 = Bt + (size_t)(n0 + lr) * K + lh * 8; const bf16_t* B1 = B0 + (size_t)32 * K;
        f32x16 acc0, acc1;
#pragma unroll
        for (int r = 0; r < 16; ++r) { acc0[r] = 0.f; acc1[r] = 0.f; }
        for (int st = 0; st < steps; ++st) {
            const bf16x8 a = *(const bf16x8*)(Ab + 16 * st), b0 = *(const bf16x8*)(B0 + 16 * st), b1 = *(const bf16x8*)(B1 + 16 * st);
            acc0 = __builtin_amdgcn_mfma_f32_32x32x16_bf16(b0, a, acc0, 0, 0, 0);
            acc1 = __builtin_amdgcn_mfma_f32_32x32x16_bf16(b1, a, acc1, 0, 0, 0);
        }
#pragma unroll
        for (int r4 = 0; r4 < 4; ++r4) {
            f.vec4(r0 + lr, n0 + 8 * r4 + 4 * lh, (f32x4){acc0[4 * r4], acc0[4 * r4 + 1], acc0[4 * r4 + 2], acc0[4 * r4 + 3]});
            f.vec4(r0 + lr, n0 + 32 + 8 * r4 + 4 * lh, (f32x4){acc1[4 * r4], acc1[4 * r4 + 1], acc1[4 * r4 + 2], acc1[4 * r4 + 3]});
        }
    }
}

struct FRwkvIn {
    bf16_t *rb, *kb, *vb, *tw, *ta, *tv, *tg;
    __device__ __forceinline__ void vec8(int row, int col, f32x4 a, f32x4 b) const {
        if (col < 3072) { u32x4 w; w.x = pk_bf16(a[0], a[1]); w.y = pk_bf16(a[2], a[3]); w.z = pk_bf16(b[0], b[1]); w.w = pk_bf16(b[2], b[3]);
            *(u32x4*)(rb + (size_t)(col >> 10) * XR_STRIDE + (size_t)row * D + (col & 1023)) = w; }
        else { vec4(row, col, a); vec4(row, col + 4, b); } }
    __device__ __forceinline__ void vec4(int row, int col, f32x4 v) const {
        if (col < 3072) { st_bf4(rb + (size_t)(col >> 10) * XR_STRIDE + (size_t)row * D + (col & 1023), v); }
        else if (col < 3328) { const int c = col - 3072; if (c < 32) st_bf4(tv + (size_t)row * 32 + c, v); }
        else if (col < 3584) { const int c = col - 3328; if (c < 64) { f32x4 t = {ftanh(v[0]), ftanh(v[1]), ftanh(v[2]), ftanh(v[3])}; st_bf4(tw + (size_t)row * 64 + c, t); } }
        else if (col < 3840) { const int c = col - 3584; if (c < 64) st_bf4(ta + (size_t)row * 64 + c, v); }
        else { const int c = col - 3840; if (c < 160) { f32x4 t = {fsig(v[0]), fsig(v[1]), fsig(v[2]), fsig(v[3])}; st_bf4(tg + (size_t)row * 160 + c, t); } }
    }
};
struct FStoreF32 { float* C; int ldc; int ncols; __device__ __forceinline__ void vec4(int row, int col, f32x4 v) const { if (col < ncols) *(f32x4*)(C + (size_t)row * ldc + col) = v; } };
struct FStoreBf16 { bf16_t* C; int ldc; int ncols;
    __device__ __forceinline__ void vec4(int row, int col, f32x4 v) const { if (col < ncols) st_bf4(C + (size_t)row * ldc + col, v); }
    __device__ __forceinline__ void vec8(int row, int col, f32x4 a, f32x4 b) const { if (col < ncols) { u32x4 w; w.x = pk_bf16(a[0], a[1]); w.y = pk_bf16(a[2], a[3]); w.z = pk_bf16(b[0], b[1]); w.w = pk_bf16(b[2], b[3]); *(u32x4*)(C + (size_t)row * ldc + col) = w; } } };
struct FResid {
    float* X; const float* gate;
    const float* xin_p; const float* xin_s;
    __device__ __forceinline__ void vec4(int row, int col, f32x4 v) const {
        const f32x4 g = *(const f32x4*)(gate + (size_t)row_seq(row) * 6144 + col); float* xp = X + (size_t)row * D + col;
        const float* ip = xin_p ? (row < NP ? xin_p + (size_t)row * D + col : xin_s + (size_t)(row - NP) * D + col) : xp;
        const f32x4 x = *(const f32x4*)ip; *(f32x4*)xp = x + g * v; }
};
struct FRelu2 { bf16_t* U;
    __device__ __forceinline__ void vec8(int row, int col, f32x4 a, f32x4 b) const {
        f32x4 s, t; for (int e = 0; e < 4; ++e) { const float x = fmaxf(a[e], 0.f), y = fmaxf(b[e], 0.f); s[e] = x * x; t[e] = y * y; }
        u32x4 w; w.x = pk_bf16(s[0], s[1]); w.y = pk_bf16(s[2], s[3]); w.z = pk_bf16(t[0], t[1]); w.w = pk_bf16(t[2], t[3]); *(u32x4*)(U + (size_t)row * DFF + col) = w; }
    __device__ __forceinline__ void vec4(int row, int col, f32x4 v) const {
        f32x4 t; for (int e = 0; e < 4; ++e) { const float r = fmaxf(v[e], 0.f); t[e] = r * r; } st_bf4(U + (size_t)row * DFF + col, t); } };

__device__ __forceinline__ void phase_copy_x(KP p) {
    const size_t n4p = (size_t)NP * D / 4, n4 = (size_t)NT * D / 4;
    for (size_t i = (size_t)BID() * 512 + TID(); i < n4; i += (size_t)gridDim.x * 512)
        ((f32x4*)p->out)[i] = i < n4p ? ((const f32x4*)p->x_prompt)[i] : ((const f32x4*)p->x_sample)[i - n4p];
}

struct TJob { const float* src; bf16_t* dst; int K, N, drow0; };
__device__ __forceinline__ TJob tjob(KP p, int i) {
    TJob t; t.drow0 = 0;
    if (i < 4) { t.src = p->w_up + (size_t)i * D * DFF; t.dst = WSP(bf16_t, WS_WUP_T) + (size_t)i * DFF * D; t.K = D; t.N = DFF; return t; }
    if (i < 8) { const int l = i - 4; t.src = p->w_down + (size_t)l * DFF * D; t.dst = WSP(bf16_t, WS_WDN_T) + (size_t)l * DFF * D; t.K = DFF; t.N = D; return t; }
    i -= 8; const int j = i / 14, k = i % 14; bf16_t* wrw = WSP(bf16_t, WS_WRW_T) + (size_t)j * 4096 * D;
    t.K = D; t.N = D;
    switch (k) {
        case 0: case 1: case 2: t.src = p->rw_w_rkv + ((size_t)j * 3 + k) * D * D; t.dst = wrw; t.drow0 = k * 1024; break;
        case 3: t.src = p->rw_v1; t.dst = wrw; t.drow0 = 3072; t.N = j == 1 ? 32 : 0; break;
        case 4: t.src = p->rw_w1 + (size_t)j * D * 64; t.dst = wrw; t.drow0 = 3328; t.N = 64; break;
        case 5: t.src = p->rw_a1 + (size_t)j * D * 64; t.dst = wrw; t.drow0 = 3584; t.N = 64; break;
        case 6: t.src = p->rw_g1 + (size_t)j * D * 160; t.dst = wrw; t.drow0 = 3840; t.N = 160; break;
        case 7: t.src = p->rw_w_o + (size_t)j * D * D; t.dst = WSP(bf16_t, WS_WO_T) + (size_t)j * D * D; break;
        case 8: t.src = p->rw_w2 + (size_t)j * 64 * D; t.dst = WSP(bf16_t, WS_W2T) + (size_t)j * D * 64; t.K = 64; break;
        case 9: t.src = p->rw_a2 + (size_t)j * 64 * D; t.dst = WSP(bf16_t, WS_A2T) + (size_t)j * D * 64; t.K = 64; break;
        case 10: t.src = p->rw_g2 + (size_t)j * 160 * D; t.dst = WSP(bf16_t, WS_G2T) + (size_t)j * D * 160; t.K = 160; break;
        case 11: t.src = p->rw_v2; t.dst = WSP(bf16_t, WS_V2T); t.K = 32; t.N = j == 1 ? D : 0; break;
        case 12: t.src = p->att_w_in + (size_t)j * D * PIN; t.dst = WSP(bf16_t, WS_WIN_T) + (size_t)j * PINP * D; t.N = PIN; break;
        default: t.src = p->att_w_o + (size_t)j * D * D; t.dst = WSP(bf16_t, WS_WAO_T) + (size_t)j * D * D; break;
    }
    return t;
}
__device__ __forceinline__ int tjob_tiles(const TJob& t) { return ((t.K + 63) / 64) * ((t.N + 63) / 64); }
__device__ __forceinline__ void phase_weights(KP p, LAS unsigned char* lds) {
    LAS float* T = (LAS float*)lds;
    int total = 0;
    for (int i = 0; i < 36; ++i) total += tjob_tiles(tjob(p, i));
    const int ngrp = (total + 3) / 4;
    f32x4 v[4][2];
    bf16_t* dstn[4]; int Kn[4], nlim[4], klim[4];
#define WT_ISSUE(G_) do { const int tid_ = TID(), kk_ = tid_ >> 4, n4_ = (tid_ & 15) * 4; \
        int i_ = 0, start_ = 0, cnt_ = tjob_tiles(tjob(p, 0)); \
        _Pragma("unroll") for (int u = 0; u < 4; ++u) { const int gt_ = 4 * (G_) + u; \
            while (i_ < 35 && gt_ >= start_ + cnt_) { start_ += cnt_; ++i_; cnt_ = tjob_tiles(tjob(p, i_)); } \
            const TJob tj_ = tjob(p, i_); const int lt_ = gt_ - start_, nkt_ = (tj_.K + 63) / 64; \
            const bool dead_ = gt_ >= total || lt_ >= cnt_; const int k0_ = dead_ ? 0 : (lt_ % nkt_) * 64, n0_ = dead_ ? 0 : (lt_ / nkt_) * 64; \
            dstn[u] = tj_.dst + (size_t)(tj_.drow0 + n0_) * tj_.K + k0_; Kn[u] = tj_.K; nlim[u] = dead_ ? 0 : tj_.N - n0_; klim[u] = dead_ ? 0 : tj_.K - k0_; \
            _Pragma("unroll") for (int hh = 0; hh < 2; ++hh) { const int k_ = k0_ + kk_ + 32 * hh, n_ = n0_ + n4_; \
                v[u][hh] = *(const f32x4*)(tj_.src + (size_t)min(k_, tj_.K - 1) * tj_.N + min(n_, tj_.N - 4)); } } } while (0)
    if (BID() < ngrp) WT_ISSUE(BID());
    for (int g = BID(); g < ngrp; g += gridDim.x) {
        const int tid = TID(), kk = tid >> 4, n4 = (tid & 15) * 4;
#pragma unroll
        for (int u = 0; u < 4; ++u)
#pragma unroll
            for (int hh = 0; hh < 2; ++hh)
#pragma unroll
                for (int e = 0; e < 4; ++e) T[(u * 64 + kk + 32 * hh) * 65 + n4 + e] = v[u][hh][e];
        bf16_t* dstc[4]; int Kc[4], nl[4], kl[4];
#pragma unroll
        for (int u = 0; u < 4; ++u) { dstc[u] = dstn[u]; Kc[u] = Kn[u]; nl[u] = nlim[u]; kl[u] = klim[u]; }
        if (g + (int)gridDim.x < ngrp) WT_ISSUE(g + (int)gridDim.x);
        asm volatile("s_waitcnt lgkmcnt(0)" ::: "memory"); __builtin_amdgcn_s_barrier(); asm volatile("" ::: "memory");
        const int nn = tid >> 3, k8 = (tid & 7) * 8;
#pragma unroll
        for (int u = 0; u < 4; ++u) {
            if (nn < nl[u] && k8 < kl[u]) {
                u32x4 w;
                w.x = pk_bf16(T[(u * 64 + k8 + 0) * 65 + nn], T[(u * 64 + k8 + 1) * 65 + nn]); w.y = pk_bf16(T[(u * 64 + k8 + 2) * 65 + nn], T[(u * 64 + k8 + 3) * 65 + nn]);
                w.z = pk_bf16(T[(u * 64 + k8 + 4) * 65 + nn], T[(u * 64 + k8 + 5) * 65 + nn]); w.w = pk_bf16(T[(u * 64 + k8 + 6) * 65 + nn], T[(u * 64 + k8 + 7) * 65 + nn]);
                *(u32x4*)(dstc[u] + (size_t)nn * Kc[u] + k8) = w;
            }
        }
        asm volatile("s_waitcnt lgkmcnt(0)" ::: "memory"); __builtin_amdgcn_s_barrier(); asm volatile("" ::: "memory");
    }
#undef WT_ISSUE
    __syncthreads();
}

__device__ __forceinline__ void phase_ada(KP p, LAS unsigned char* lds) {
    float* mods = WSP(float, WS_MODS);
    LAS float* red = (LAS float*)lds;
    const int tid = TID(), lane = tid & 63, w = tid >> 6, ln = lane & 15, lq = lane >> 4;
    float af[3][32];
#pragma unroll
    for (int m = 0; m < 3; ++m) {
        const int s = 16 * m + ln; const bool ok = s < 36;
        const float* cp = s < 4 ? p->c_prompt + (size_t)s * D : p->c_sample + (size_t)((ok ? s : 35) - 4) * D;
#pragma unroll
        for (int i = 0; i < 32; ++i) { const float cv = cp[128 * w + 4 * i + lq]; af[m][i] = ok ? cv * __builtin_amdgcn_rcpf(1.0f + __expf(-cv)) : 0.f; }
    }
    f32x2 wv[32];
#define ADA_LOAD(B_) do { const int l_ = (B_) / 192, cb_ = ((B_) % 192) * 32; const float* wp_ = p->w_ada + ((size_t)l_ * D + 128 * w + lq) * 6144 + cb_ + 2 * ln; \
        _Pragma("unroll") for (int i = 0; i < 32; ++i) wv[i] = *(const f32x2*)(wp_ + (size_t)(4 * i) * 6144); } while (0)
    if (BID() < 768) ADA_LOAD(BID());
    for (int B = BID(); B < 768; B += gridDim.x) {
        const int l = B / 192, cb = (B % 192) * 32;
        f32x4 acc[3][2];
#pragma unroll
        for (int m = 0; m < 3; ++m) { acc[m][0] = (f32x4){0.f, 0.f, 0.f, 0.f}; acc[m][1] = acc[m][0]; }
#pragma unroll
        for (int i = 0; i < 32; ++i)
#pragma unroll
            for (int m = 0; m < 3; ++m) {
                acc[m][0] = __builtin_amdgcn_mfma_f32_16x16x4f32(af[m][i], wv[i][0], acc[m][0], 0, 0, 0);
                acc[m][1] = __builtin_amdgcn_mfma_f32_16x16x4f32(af[m][i], wv[i][1], acc[m][1], 0, 0, 0);
            }
        if (B + (int)gridDim.x < 768) ADA_LOAD(B + (int)gridDim.x);
#pragma unroll
        for (int m = 0; m < 3; ++m)
#pragma unroll
            for (int r = 0; r < 4; ++r) { const int s = 16 * m + 4 * lq + r;
                if (s < 36) *(LAS f32x2*)(red + (w * 36 + s) * 32 + 2 * ln) = (f32x2){acc[m][0][r], acc[m][1][r]}; }
        asm volatile("s_waitcnt lgkmcnt(0)" ::: "memory"); __builtin_amdgcn_s_barrier(); asm volatile("" ::: "memory");
        for (int o = tid; o < 36 * 32; o += 512) { const int s = o >> 5, cc = o & 31;
            float v = 0.f;
#pragma unroll
            for (int ww = 0; ww < 8; ++ww) v += red[(ww * 36 + s) * 32 + cc];
            mods[((size_t)l * 36 + s) * 6144 + cb + cc] = v + p->b_ada[l * 6144 + cb + cc]; }
        asm volatile("s_waitcnt lgkmcnt(0)" ::: "memory"); __builtin_amdgcn_s_barrier(); asm volatile("" ::: "memory");
    }
#undef ADA_LOAD
    __syncthreads();
}

template <bool MIX>
__device__ __forceinline__ void phase_prep(KP p, int layer, int which, int j, bool first = false) {
    const float* X = p->out;
    const float* mods = WSP(float, WS_MODS) + (size_t)layer * 36 * 6144;
    const float* g = p->norm_g + (layer * 2 + which) * D;
    bf16_t* XR = WSP(bf16_t, WS_XR);
    const int lane = TID() & 63, gw = BID() * 8 + (TID() >> 6), nw = gridDim.x * 8;
    for (int run = gw; run < NP / 8 + NS; run += nw) {
        const int row0 = run < NP / 8 ? run * 8 : NP + (run - NP / 8), nrows = run < NP / 8 ? 8 : 1, seq = row_seq(row0);
        const float* sh = mods + (size_t)seq * 6144 + (which ? 3 : 0) * D; const float* sc = sh + D;
        f32x4 gv[4], scv[4], shv[4], hp[4];
#pragma unroll
        for (int i = 0; i < 4; ++i) { const int col = 512 * (i >> 1) + 8 * lane + 4 * (i & 1); gv[i] = *(const f32x4*)(g + col); scv[i] = *(const f32x4*)(sc + col) + 1.0f; shv[i] = *(const f32x4*)(sh + col); hp[i] = (f32x4){0.f, 0.f, 0.f, 0.f}; }
        int rstart = 0;
        if (MIX) {
            if (row0 >= NP && ((row0 - NP) & 7) == 0) {
#pragma unroll
                for (int i = 0; i < 4; ++i) hp[i] = *(const f32x4*)(p->state_shift + ((size_t)j * 32 + (seq - 4)) * D + 512 * (i >> 1) + 8 * lane + 4 * (i & 1));
            } else if (row0 >= NP || (row0 & 4095) != 0) rstart = -1;
        }
        f32x4 xn[4];
#define PREP_LOAD(ROW_) do { const int row_ = (ROW_); const float* xr_ = first ? (row_ < NP ? p->x_prompt + (size_t)row_ * D : p->x_sample + (size_t)(row_ - NP) * D) : X + (size_t)row_ * D; \
            _Pragma("unroll") for (int i = 0; i < 4; ++i) xn[i] = *(const f32x4*)(xr_ + 512 * (i >> 1) + 8 * lane + 4 * (i & 1)); } while (0)
        PREP_LOAD(row0 + rstart);
        for (int r = rstart; r < nrows; ++r) {
            const int row = row0 + r;
            f32x4 x[4]; float ss = 0.f;
#pragma unroll
            for (int i = 0; i < 4; ++i) x[i] = xn[i];
            if (r + 1 < nrows) PREP_LOAD(row + 1);
#pragma unroll
            for (int i = 0; i < 4; ++i) ss += x[i][0] * x[i][0] + x[i][1] * x[i][1] + x[i][2] * x[i][2] + x[i][3] * x[i][3];
            ss = wave_sum(ss);
            const float rstd = rsqrtf(ss * (1.0f / 1024.0f) + 1e-6f);
            f32x4 h[4];
#pragma unroll
            for (int i = 0; i < 4; ++i) h[i] = x[i] * rstd * gv[i] * scv[i] + shv[i];
            if (MIX) {
                if (r >= 0) {
#pragma unroll
                    for (int n = 0; n < 6; ++n) {
                        const int mi = n == 0 ? 0 : (n == 1 ? 2 : (n == 2 ? 3 : (n == 3 ? 1 : n)));
                        const float* mx = p->rw_mix + ((size_t)j * 6 + mi) * D;
#pragma unroll
                        for (int i2 = 0; i2 < 2; ++i2) { const int col = 512 * i2 + 8 * lane; const f32x4 m0 = *(const f32x4*)(mx + col), m1 = *(const f32x4*)(mx + col + 4);
                            const f32x4 a = h[2 * i2] + (hp[2 * i2] - h[2 * i2]) * m0, b2 = h[2 * i2 + 1] + (hp[2 * i2 + 1] - h[2 * i2 + 1]) * m1;
                            u32x4 w; w.x = pk_bf16(a[0], a[1]); w.y = pk_bf16(a[2], a[3]); w.z = pk_bf16(b2[0], b2[1]); w.w = pk_bf16(b2[2], b2[3]);
                            *(u32x4*)(XR + (size_t)n * XR_STRIDE + (size_t)row * D + col) = w; }
                    }
                    const bool lastp = row < NP && (row & 4095) == 4095, lasts = row >= NP && ((row - NP) & 7) == 7;
                    if (lastp || lasts) {
                        float* so = lastp ? p->out + O_SHP + ((size_t)j * 4 + seq) * D : p->out + O_SHS + ((size_t)j * 32 + (seq - 4)) * D;
#pragma unroll
                        for (int i = 0; i < 4; ++i) *(f32x4*)(so + 512 * (i >> 1) + 8 * lane + 4 * (i & 1)) = h[i];
                    }
                }
#pragma unroll
                for (int i = 0; i < 4; ++i) hp[i] = h[i];
            } else {
#pragma unroll
                for (int i2 = 0; i2 < 2; ++i2) { const f32x4 a = h[2 * i2], b2 = h[2 * i2 + 1]; u32x4 w; w.x = pk_bf16(a[0], a[1]); w.y = pk_bf16(a[2], a[3]); w.z = pk_bf16(b2[0], b2[1]); w.w = pk_bf16(b2[2], b2[3]);
                    *(u32x4*)(XR + (size_t)row * D + 512 * i2 + 8 * lane) = w; }
            }
        }
    }
}

#undef PREP_LOAD
__device__ __forceinline__ void phase_scanprep(KP p, int j) {
    const bf16_t *KB = WSP(bf16_t, WS_KB), *VB = WSP(bf16_t, WS_VB);
    const float *WPp = WSP(float, WS_WP), *APp = WSP(float, WS_AP), *VPp = WSP(float, WS_VP);
    float *VF = WSP(float, WS_VFIRST), *DEC = WSP(float, WS_DEC), *KM = WSP(float, WS_KM), *VM = WSP(float, WS_VM), *AV = WSP(float, WS_AV), *BV = WSP(float, WS_BV);
    const int lane = TID() & 63, gw = BID() * 8 + (TID() >> 6), nw = gridDim.x * 8;
    for (int row = gw; row < NT; row += nw) {
#pragma unroll
        for (int i = 0; i < 4; ++i) {
            const int col = 256 * i + 4 * lane; const size_t o = (size_t)row * D + col;
            const f32x4 k = ld_bf4(KB + o), v = ld_bf4(VB + o), wp = *(const f32x4*)(WPp + o), ap = *(const f32x4*)(APp + o);
            const f32x4 w0 = *(const f32x4*)(p->rw_w0 + j * D + col), a0 = *(const f32x4*)(p->rw_a0 + j * D + col), kkw = *(const f32x4*)(p->rw_k_k + j * D + col), kaw = *(const f32x4*)(p->rw_k_a + j * D + col);
            f32x4 dec, a, vm, kk, km;
#pragma unroll
            for (int e = 0; e < 4; ++e) {
                const float wpre = w0[e] + wp[e], z = -wpre, sp = fmaxf(z, 0.f) + log1pf(expf(-fabsf(z)));
                dec[e] = expf(-expf(-sp - 0.5f));
                a[e] = sigmoidf_(a0[e] + ap[e]);
                kk[e] = k[e] * kkw[e];
                km[e] = k[e] * (1.0f + (a[e] - 1.0f) * kaw[e]);
            }
            if (j == 0) { vm = v; *(f32x4*)(VF + o) = v; }
            else { const f32x4 vf = *(const f32x4*)(VF + o), vp = *(const f32x4*)(VPp + o), v0 = *(const f32x4*)(p->rw_v0 + (j - 1) * D + col);
#pragma unroll
                for (int e = 0; e < 4; ++e) vm[e] = v[e] + (vf[e] - v[e]) * sigmoidf_(v0[e] + vp[e]); }
            float ss = kk[0] * kk[0] + kk[1] * kk[1] + kk[2] * kk[2] + kk[3] * kk[3];
            ss = g16_sum(ss);
            const float inv = rsqrtf(fmaxf(ss, 1e-24f));
            kk = kk * inv;
            *(f32x4*)(DEC + o) = dec; *(f32x4*)(KM + o) = km; *(f32x4*)(VM + o) = vm; *(f32x4*)(AV + o) = -kk; *(f32x4*)(BV + o) = kk * a;
        }
    }
}

__device__ __forceinline__ float rl(float v, int k) { return __int_as_float(__builtin_amdgcn_readlane(__float_as_int(v), k)); }
__device__ __forceinline__ void scan_run(KP p, size_t row_base, int nsteps, int colbase, float (&S)[64]) {
    const float *DEC = WSP(float, WS_DEC), *KM = WSP(float, WS_KM), *VM = WSP(float, WS_VM), *AV = WSP(float, WS_AV), *BV = WSP(float, WS_BV);
    const bf16_t* RB = WSP(bf16_t, WS_RB); float* Y = WSP(float, WS_Y);
    const int lane = TID() & 63;
    size_t o = row_base * D + colbase + lane;
    float w = DEC[o], kx = KM[o], v = VM[o], a = AV[o], b = BV[o], r = bf2f(RB[o]);
    for (int t = 0; t < nsteps; ++t) {
        const size_t on = (t + 1 < nsteps) ? o + D : o;
        const float wn = DEC[on], kn = KM[on], vn = VM[on], an = AV[on], bn = BV[on], rn = bf2f(RB[on]);
        float sa = 0.f;
#pragma unroll
        for (int k = 0; k < 64; ++k) sa += S[k] * rl(a, k);
#pragma unroll
        for (int k = 0; k < 64; ++k) S[k] = S[k] * rl(w, k) + sa * rl(b, k) + v * rl(kx, k);
        float y = 0.f;
#pragma unroll
        for (int k = 0; k < 64; ++k) y += S[k] * rl(r, k);
        Y[o] = y;
        o = on; w = wn; kx = kn; v = vn; a = an; b = bn; r = rn;
    }
}
__device__ __forceinline__ void phase_scanA(KP p) {
    const float *DEC = WSP(float, WS_DEC), *KM = WSP(float, WS_KM), *VM = WSP(float, WS_VM), *AV = WSP(float, WS_AV), *BV = WSP(float, WS_BV);
    float *PCH = WSP(float, WS_PCH), *CCH = WSP(float, WS_CCH);
    const int lane = TID() & 63, gw = BID() * 8 + (TID() >> 6), nw = gridDim.x * 8;
    for (int it = gw; it < 64 * NCH; it += nw) {
        const int sh = it / NCH, c = it % NCH, b = sh >> 4, h = sh & 15;
        float SP[64], SC[64];
#pragma unroll
        for (int k = 0; k < 64; ++k) { SP[k] = (k == lane) ? 1.f : 0.f; SC[k] = 0.f; }
        size_t o = ((size_t)b * 4096 + (size_t)c * LCH) * D + h * 64 + lane;
        float w = DEC[o], kx = KM[o], v = VM[o], a = AV[o], bb = BV[o];
        for (int t = 0; t < LCH; ++t) {
            const size_t on = (t + 1 < LCH) ? o + D : o;
            const float wn = DEC[on], kn = KM[on], vn = VM[on], an = AV[on], bn = BV[on];
            float saP = 0.f, saC = 0.f;
#pragma unroll
            for (int k = 0; k < 64; ++k) { const float ak = rl(a, k); saP += SP[k] * ak; saC += SC[k] * ak; }
#pragma unroll
            for (int k = 0; k < 64; ++k) { const float wk = rl(w, k), bk = rl(bb, k); SP[k] = SP[k] * wk + saP * bk; SC[k] = SC[k] * wk + saC * bk + v * rl(kx, k); }
            o = on; w = wn; kx = kn; v = vn; a = an; bb = bn;
        }
        float* po = PCH + ((size_t)it * 64 + lane) * 64; float* co = CCH + ((size_t)it * 64 + lane) * 64;
#pragma unroll
        for (int k = 0; k < 64; k += 4) { *(f32x4*)(po + k) = (f32x4){SP[k], SP[k + 1], SP[k + 2], SP[k + 3]}; *(f32x4*)(co + k) = (f32x4){SC[k], SC[k + 1], SC[k + 2], SC[k + 3]}; }
    }
}
__device__ __forceinline__ void phase_scanB(KP p, int j, LAS unsigned char* lds) {
    const int tid = TID(), lane = tid & 63, wave = tid >> 6;
    if (BID() < 32) {
        const float *PCH = WSP(float, WS_PCH), *CCH = WSP(float, WS_CCH); float* SST = WSP(float, WS_SST);
        const int sh = BID() * 2 + (wave >> 2), q = wave & 3, row0 = 32 * (q >> 1), col0 = 32 * (q & 1), b = sh >> 4, h = sh & 15;
        LAS float* Sl = (LAS float*)lds + (wave >> 2) * (2 * 64 * 65);
        const int lr = lane & 31, lh = lane >> 5;
        f32x16 acc;
#pragma unroll
        for (int r = 0; r < 16; ++r) acc[r] = 0.f;
        for (int c = 0; c <= NCH; ++c) {
            LAS float* Sw = Sl + (c & 1) * (64 * 65);
            float* go = c < NCH ? SST + ((size_t)sh * NCH + c) * 4096 : p->out + O_WKVP + (((size_t)j * 4 + b) * 16 + h) * 4096;
#pragma unroll
            for (int r = 0; r < 16; ++r) { const int row = row0 + (r & 3) + 8 * (r >> 2) + 4 * lh; Sw[row * 65 + col0 + lr] = acc[r]; go[row * 64 + col0 + lr] = acc[r]; }
            if (c == NCH) break;
            const float* Pc = PCH + ((size_t)sh * NCH + c) * 4096; const float* Cc = CCH + ((size_t)sh * NCH + c) * 4096;
            float bv[32];
#pragma unroll
            for (int kk = 0; kk < 32; ++kk) bv[kk] = Pc[(2 * kk + lh) * 64 + col0 + lr];
#pragma unroll
            for (int r = 0; r < 16; ++r) acc[r] = Cc[(row0 + (r & 3) + 8 * (r >> 2) + 4 * lh) * 64 + col0 + lr];
            __syncthreads();
#pragma unroll
            for (int kk = 0; kk < 32; ++kk) acc = __builtin_amdgcn_mfma_f32_32x32x2f32(Sw[(row0 + lr) * 65 + 2 * kk + lh], bv[kk], acc, 0, 0, 0);
        }
    } else {
        for (int it = (BID() - 32) * 8 + wave; it < 512; it += (gridDim.x - 32) * 8) {
            const int b = it >> 4, h = it & 15;
            const float* s0 = p->state_wkv + (((size_t)j * 32 + b) * 16 + h) * 4096 + lane * 64;
            float S[64];
#pragma unroll
            for (int k = 0; k < 64; k += 4) { const f32x4 t = *(const f32x4*)(s0 + k); S[k] = t[0]; S[k + 1] = t[1]; S[k + 2] = t[2]; S[k + 3] = t[3]; }
            scan_run(p, (size_t)NP + b * 8, 8, h * 64, S);
            float* o = p->out + O_WKVS + (((size_t)j * 32 + b) * 16 + h) * 4096 + lane * 64;
#pragma unroll
            for (int k = 0; k < 64; k += 4) *(f32x4*)(o + k) = (f32x4){S[k], S[k + 1], S[k + 2], S[k + 3]};
        }
    }
    __syncthreads();
}
__device__ __forceinline__ void phase_scanC(KP p) {
    const float* SST = WSP(float, WS_SST);
    const int lane = TID() & 63, gw = BID() * 8 + (TID() >> 6), nw = gridDim.x * 8;
    for (int it = gw; it < 64 * NCH; it += nw) {
        const int sh = it / NCH, c = it % NCH, b = sh >> 4, h = sh & 15;
        const float* s0 = SST + ((size_t)it * 64 + lane) * 64;
        float S[64];
#pragma unroll
        for (int k = 0; k < 64; k += 4) { const f32x4 t = *(const f32x4*)(s0 + k); S[k] = t[0]; S[k + 1] = t[1]; S[k + 2] = t[2]; S[k + 3] = t[3]; }
        scan_run(p, (size_t)b * 4096 + (size_t)c * LCH, LCH, h * 64, S);
    }
}


constexpr int CST = 72;
constexpr int CMAT = 64 * CST * 2;
constexpr int CH_F32 = 11 * CMAT, CH_PART = CH_F32 + 64 * 68 * 4, CH_GL = CH_PART + 64 * 4 * 4;
__device__ __forceinline__ bf16x8 cfrag(const LAS bf16_t* M, int row, int ks, int c4) { return *(const LAS bf16x8*)(M + row * CST + 32 * ks + 8 * c4); }
__device__ __forceinline__ f32x4 cmm(const LAS bf16_t* A, int arow, const LAS bf16_t* B, int brow, int c4, f32x4 acc) {
    acc = __builtin_amdgcn_mfma_f32_16x16x32_bf16(cfrag(A, arow, 0, c4), cfrag(B, brow, 0, c4), acc, 0, 0, 0);
    return __builtin_amdgcn_mfma_f32_16x16x32_bf16(cfrag(A, arow, 1, c4), cfrag(B, brow, 1, c4), acc, 0, 0, 0); }
__device__ __forceinline__ unsigned short f2bf(float x) { return (unsigned short)(pk_bf16(x, 0.f) & 0xffffu); }
__device__ __forceinline__ void st_t4(LAS bf16_t* Mt, int d, int t0, f32x4 v) { u32x2 w; w.x = pk_bf16(v[0], v[1]); w.y = pk_bf16(v[2], v[3]); *(LAS u32x2*)(Mt + d * CST + t0) = w; }

__device__ __forceinline__ void phase_chunk(KP p, int j, LAS unsigned char* lds) {
    LAS bf16_t* Mx = (LAS bf16_t*)lds;
#define CM(i) (Mx + (i) * (64 * CST))
    LAS float* F32 = (LAS float*)(lds + CH_F32);
    asm volatile("" : "+v"(F32));
    LAS float* part = (LAS float*)(lds + CH_PART);
    LAS float* gLs = (LAS float*)(lds + CH_GL);
    const bf16_t *RB = WSP(bf16_t, WS_RB), *KB = WSP(bf16_t, WS_KB), *VB = WSP(bf16_t, WS_VB), *TW = WSP(bf16_t, WS_TW), *TA_ = WSP(bf16_t, WS_TA), *TV = WSP(bf16_t, WS_TV);
    const bf16_t *W2T = WSP(bf16_t, WS_W2T) + (size_t)j * D * 64, *A2T = WSP(bf16_t, WS_A2T) + (size_t)j * D * 64, *V2T = WSP(bf16_t, WS_V2T);
    float* VF = WSP(float, WS_VFIRST); float *PCH = WSP(float, WS_PCH), *CCH = WSP(float, WS_CCH), *Y0 = WSP(float, WS_Y), *BON = WSP(float, WS_AV);
    bf16_t *GM = WSP(bf16_t, WS_DEC), *VM2 = WSP(bf16_t, WS_KM);
#define CH_BAR() do { asm volatile("s_waitcnt lgkmcnt(0)" ::: "memory"); __builtin_amdgcn_s_barrier(); asm volatile("" ::: "memory"); } while (0)
    bf16x8 f_aw[2], f_aa[2], f_av; unsigned short e_k[2][4], e_v[2][4], e_r[2][4];
    f_av = (bf16x8){0, 0, 0, 0, 0, 0, 0, 0};
#define CH_PREFETCH(itx) do { const int tid_ = TID(), lane_ = tid_ & 63, w_ = tid_ >> 6, n_ = lane_ & 15, c4_ = lane_ >> 4, tr_ = w_ >> 1, tcb_ = 2 * (w_ & 1); \
        const int sh_ = (itx) / NCH, c_ = (itx) % NCH, R0_ = (sh_ >> 4) * 4096 + c_ * LCH, hc_ = (sh_ & 15) * 64; const int ar_ = 16 * tr_ + n_; \
        _Pragma("unroll") for (int ks = 0; ks < 2; ++ks) { f_aw[ks] = *(const bf16x8*)(TW + (size_t)R0_ * 64 + ar_ * 64 + 32 * ks + 8 * c4_); f_aa[ks] = *(const bf16x8*)(TA_ + (size_t)R0_ * 64 + ar_ * 64 + 32 * ks + 8 * c4_); } \
        if (j == 1) f_av = *(const bf16x8*)(TV + (size_t)R0_ * 32 + ar_ * 32 + 8 * c4_); \
        _Pragma("unroll") for (int ti = 0; ti < 2; ++ti) _Pragma("unroll") for (int r = 0; r < 4; ++r) { const size_t o_ = (size_t)R0_ * D + hc_ + (16 * tr_ + 4 * c4_ + r) * D + 16 * (tcb_ + ti) + n_; \
            e_k[ti][r] = KB[o_]; e_v[ti][r] = VB[o_]; e_r[ti][r] = RB[o_]; } } while (0)
#define CH_MAP(q_) (((((q_) >> 4) & 3) * 16 + ((q_) & 15)) * NCH + ((q_) >> 6))
    if (BID() < 64 * NCH) CH_PREFETCH(CH_MAP(BID()));
    for (int q = BID(); q < 64 * NCH; q += gridDim.x) {
        const int it = CH_MAP(q);
        const int tid = TID(), lane = tid & 63, w = tid >> 6, n = lane & 15, c4 = lane >> 4, tr = w >> 1, tcb = 2 * (w & 1);
        const int sh = it / NCH, c = it % NCH, b = sh >> 4, h = sh & 15, R0 = b * 4096 + c * LCH, hc = h * 64;
        const bf16_t *KBb = KB + (size_t)R0 * D + hc, *VBb = VB + (size_t)R0 * D + hc, *RBb = RB + (size_t)R0 * D + hc;
        bf16_t* VFb = (bf16_t*)VF + (size_t)R0 * D + hc; bf16_t* VM2b = VM2 + (size_t)R0 * D + hc; bf16_t* GMb = GM + (size_t)R0 * D + hc; bf16_t* Y0b = (bf16_t*)Y0 + (size_t)R0 * D + hc;
        float* PCb = PCH + (size_t)it * 4096; float* CCb = CCH + (size_t)it * 4096; float* BONb = BON + (size_t)R0 * 16 + h;
        const bf16_t *TWb = TW + (size_t)R0 * 64, *TAb = TA_ + (size_t)R0 * 64, *TVb = TV + (size_t)R0 * 32, *W2b = W2T + (size_t)hc * 64, *A2b = A2T + (size_t)hc * 64, *V2b = V2T + (size_t)hc * 32;
        const float *w0b = p->rw_w0 + j * D + hc, *a0b = p->rw_a0 + j * D + hc, *kkb = p->rw_k_k + j * D + hc, *kab = p->rw_k_a + j * D + hc, *rkb = p->rw_r_k + j * D + hc, *v0b = p->rw_v0 + (j ? (j - 1) : 0) * D + hc;
        f32x4 wp[2], ap[2], vp[2];
#pragma unroll
        for (int ti = 0; ti < 2; ++ti) { wp[ti] = (f32x4){0.f, 0.f, 0.f, 0.f}; ap[ti] = wp[ti]; vp[ti] = wp[ti]; }
        {   const int ar = 16 * tr + n;
#pragma unroll
            for (int ks = 0; ks < 2; ++ks) {
                const bf16x8 aw = f_aw[ks], aa = f_aa[ks];
#pragma unroll
                for (int ti = 0; ti < 2; ++ti) { const int br = 16 * (tcb + ti) + n;
                    wp[ti] = __builtin_amdgcn_mfma_f32_16x16x32_bf16(aw, *(const bf16x8*)(W2b + br * 64 + 32 * ks + 8 * c4), wp[ti], 0, 0, 0);
                    ap[ti] = __builtin_amdgcn_mfma_f32_16x16x32_bf16(aa, *(const bf16x8*)(A2b + br * 64 + 32 * ks + 8 * c4), ap[ti], 0, 0, 0); }
            }
            if (j == 1) { const bf16x8 av = f_av;
#pragma unroll
                for (int ti = 0; ti < 2; ++ti) vp[ti] = __builtin_amdgcn_mfma_f32_16x16x32_bf16(av, *(const bf16x8*)(V2b + (16 * (tcb + ti) + n) * 32 + 8 * c4), vp[ti], 0, 0, 0); }
        }
        f32x4 lw[2], asg[2], kkv[2], kpr[2], vpr[2], rr[2];
        float ssq[4] = {0.f, 0.f, 0.f, 0.f}, bon[4] = {0.f, 0.f, 0.f, 0.f};
        float vf8[2][4];
#pragma unroll
        for (int ti = 0; ti < 2; ++ti)
#pragma unroll
            for (int r = 0; r < 4; ++r) vf8[ti][r] = 0.f;
        if (j == 1) {
#pragma unroll
            for (int ti = 0; ti < 2; ++ti)
#pragma unroll
                for (int r = 0; r < 4; ++r) vf8[ti][r] = bf2f(VFb[(16 * tr + 4 * c4 + r) * D + 16 * (tcb + ti) + n]);
        }
#pragma unroll
        for (int ti = 0; ti < 2; ++ti) {
            const int d = 16 * (tcb + ti) + n;
            const float w0 = w0b[d], a0 = a0b[d], kkw = kkb[d], kaw = kab[d], rkw = rkb[d];
            const float v0 = j ? v0b[d] : 0.f;
#pragma unroll
            for (int r = 0; r < 4; ++r) {
                const int o = (16 * tr + 4 * c4 + r) * D + d;
                const float kx = bf2f(e_k[ti][r]), vx = bf2f(e_v[ti][r]), rx = bf2f(e_r[ti][r]);
                const float z = -(w0 + wp[ti][r]), sp = fmaxf(z, 0.f) + __logf(1.0f + __expf(-fabsf(z)));
                lw[ti][r] = -__expf(-sp - 0.5f);
                const float a = fsig(a0 + ap[ti][r]);
                asg[ti][r] = a;
                float vv = vx;
                if (j == 0) VFb[o] = e_v[ti][r]; else { const float vf = vf8[ti][r]; vv = vx + (vf - vx) * fsig(v0 + vp[ti][r]); }
                vpr[ti][r] = vv; rr[ti][r] = rx;
                const float kk = kx * kkw; kkv[ti][r] = kk; ssq[r] += kk * kk;
                const float kp = kx * (1.0f + (a - 1.0f) * kaw); kpr[ti][r] = kp; bon[r] += rx * kp * rkw;
                F32[(16 * tr + 4 * c4 + r) * 68 + d] = lw[ti][r];
                VM2b[o] = f2bf(vv);
            }
        }
#pragma unroll
        for (int r = 0; r < 4; ++r) { ssq[r] = g16_sum(ssq[r]); bon[r] = g16_sum(bon[r]); }
        if (n == 0) {
#pragma unroll
            for (int r = 0; r < 4; ++r) { const int t = 16 * tr + 4 * c4 + r; part[(t * 2 + (w & 1)) * 2 + 0] = ssq[r]; part[(t * 2 + (w & 1)) * 2 + 1] = bon[r]; }
        }
        if (q + (int)gridDim.x < 64 * NCH) CH_PREFETCH(CH_MAP(q + (int)gridDim.x));
        CH_BAR();
        f32x4 cs[2];
#pragma unroll
        for (int ti = 0; ti < 2; ++ti) {
            f32x4 acc = {0.f, 0.f, 0.f, 0.f};
            for (int q = 0; q < 4 * (tr + 1); ++q) {
                const float av = (4 * q + c4 <= 16 * tr + n) ? 1.0f : 0.0f;
                acc = __builtin_amdgcn_mfma_f32_16x16x4f32(av, F32[(4 * q + c4) * 68 + 16 * (tcb + ti) + n], acc, 0, 0, 0);
            }
            cs[ti] = acc;
        }
        float inv[4];
#pragma unroll
        for (int r = 0; r < 4; ++r) { const int t = 16 * tr + 4 * c4 + r; inv[r] = rsqrtf(fmaxf(part[(t * 2 + 0) * 2] + part[(t * 2 + 1) * 2], 1e-24f));
            if (n == 0 && (w & 1) == 0) BONb[t * 16] = part[(t * 2 + 0) * 2 + 1] + part[(t * 2 + 1) * 2 + 1]; }
        f32x4 rt[2];
#pragma unroll
        for (int ti = 0; ti < 2; ++ti) {
            const int d = 16 * (tcb + ti) + n, t0 = 16 * tr + 4 * c4;
            f32x4 at, bt, kt;
#pragma unroll
            for (int r = 0; r < 4; ++r) {
                const float g = __expf(cs[ti][r]), gi = __expf(-cs[ti][r]), gm = __expf(cs[ti][r] - lw[ti][r]);
                const float kk = kkv[ti][r] * inv[r];
                at[r] = -kk * gm; bt[r] = kk * asg[ti][r] * gi; kt[r] = kpr[ti][r] * gi; rt[ti][r] = rr[ti][r] * g;
                CM(0)[(t0 + r) * CST + d] = f2bf(at[r]); CM(1)[(t0 + r) * CST + d] = f2bf(bt[r]); CM(2)[(t0 + r) * CST + d] = f2bf(kt[r]); CM(3)[(t0 + r) * CST + d] = f2bf(rt[ti][r]);
                if (t0 + r == 63) gLs[d] = g;
            }
            st_t4(CM(4), d, t0, at); st_t4(CM(5), d, t0, bt); st_t4(CM(6), d, t0, kt); st_t4(CM(7), d, t0, vpr[ti]);
        }
        CH_BAR();
#pragma unroll
        for (int ti = 0; ti < 2; ++ti) {
            const int tc = tcb + ti, s = 16 * tc + n, t0 = 16 * tr + 4 * c4;
            if (tc <= tr) {
                { f32x4 m = {0.f, 0.f, 0.f, 0.f}; m = cmm(CM(0), 16 * tr + n, CM(1), 16 * tc + n, c4, m);
#pragma unroll
                  for (int r = 0; r < 4; ++r) F32[(t0 + r) * 68 + s] = (s < t0 + r) ? m[r] : 0.f; }
                asm volatile("" ::: "memory");
                { f32x4 m = {0.f, 0.f, 0.f, 0.f}; m = cmm(CM(0), 16 * tr + n, CM(2), 16 * tc + n, c4, m);
#pragma unroll
                  for (int r = 0; r < 4; ++r) CM(8)[(t0 + r) * CST + s] = f2bf((s < t0 + r) ? m[r] : 0.f); }
                asm volatile("" ::: "memory");
                { f32x4 m = {0.f, 0.f, 0.f, 0.f}; m = cmm(CM(3), 16 * tr + n, CM(1), 16 * tc + n, c4, m);
#pragma unroll
                  for (int r = 0; r < 4; ++r) CM(9)[(t0 + r) * CST + s] = f2bf((s <= t0 + r) ? m[r] : 0.f); }
                asm volatile("" ::: "memory");
                { f32x4 m = {0.f, 0.f, 0.f, 0.f}; m = cmm(CM(3), 16 * tr + n, CM(2), 16 * tc + n, c4, m);
#pragma unroll
                  for (int r = 0; r < 4; ++r) CM(10)[(t0 + r) * CST + s] = f2bf((s <= t0 + r) ? m[r] : 0.f); }
                asm volatile("" ::: "memory");
            } else {
#pragma unroll
                for (int r = 0; r < 4; ++r) { F32[(t0 + r) * 68 + s] = 0.f; CM(8)[(t0 + r) * CST + s] = 0; CM(9)[(t0 + r) * CST + s] = 0; CM(10)[(t0 + r) * CST + s] = 0; }
            }
        }
        CH_BAR();
        { const int e0 = tid * 8;
#pragma unroll
          for (int e = 0; e < 8; ++e) { const int t = (e0 + e) >> 6, s_ = (e0 + e) & 63; CM(2)[t * CST + s_] = f2bf(F32[t * 68 + s_]); }
          unsigned z_ = 0u; asm volatile("" : "+v"(z_));
          *(LAS u32x4*)(CM(0) + (e0 >> 6) * CST + (e0 & 63)) = (u32x4){z_, z_, z_, z_}; }
        CH_BAR();
        if (w < 4) {
            const int cw = 16 * w;
            LAS float* scr = (LAS float*)CM(1) + w * (16 * 17);
#pragma unroll 1
            for (int I = 0; I < 4; ++I) {
                f32x4 rh = {0.f, 0.f, 0.f, 0.f};
                if (I > 0) { rh = __builtin_amdgcn_mfma_f32_16x16x32_bf16(cfrag(CM(2), 16 * I + n, 0, c4), cfrag(CM(0), cw + n, 0, c4), rh, 0, 0, 0);
                    if (I > 2) rh = __builtin_amdgcn_mfma_f32_16x16x32_bf16(cfrag(CM(2), 16 * I + n, 1, c4), cfrag(CM(0), cw + n, 1, c4), rh, 0, 0, 0); }
#pragma unroll
                for (int r = 0; r < 4; ++r) scr[(4 * c4 + r) * 17 + n] = rh[r] + ((16 * I + 4 * c4 + r) == (cw + n) ? 1.f : 0.f);
                wave_lds_fence();
                float x[16];
#pragma unroll
                for (int i = 0; i < 16; ++i) x[i] = scr[i * 17 + n];
                f32x4 mc[4], mn[4];
                mc[0] = *(const LAS f32x4*)(F32 + (16 * I + 1) * 68 + 16 * I);
#pragma unroll
                for (int i = 1; i < 16; ++i) {
                    if (i + 1 < 16) {
#pragma unroll
                        for (int j4 = 0; j4 < (i + 4) / 4; ++j4) mn[j4] = *(const LAS f32x4*)(F32 + (16 * I + i + 1) * 68 + 16 * I + 4 * j4);
                    }
                    float a0 = 0.f, a1 = 0.f;
#pragma unroll
                    for (int j4 = 0; j4 < (i + 3) / 4; ++j4) {
                        if (4 * j4 + 0 < i) a0 += mc[j4][0] * x[4 * j4 + 0];
                        if (4 * j4 + 1 < i) a1 += mc[j4][1] * x[4 * j4 + 1];
                        if (4 * j4 + 2 < i) a0 += mc[j4][2] * x[4 * j4 + 2];
                        if (4 * j4 + 3 < i) a1 += mc[j4][3] * x[4 * j4 + 3];
                    }
                    x[i] += a0 + a1;
#pragma unroll
                    for (int j4 = 0; j4 < 4; ++j4) mc[j4] = mn[j4];
                    asm volatile("" ::: "memory");
                }
                if (c4 == 0) {
#pragma unroll
                    for (int i = 0; i < 16; ++i) CM(3)[(16 * I + i) * CST + cw + n] = f2bf(x[i]);
                    u32x4 t0, t1;
                    t0.x = pk_bf16(x[0], x[1]); t0.y = pk_bf16(x[2], x[3]); t0.z = pk_bf16(x[4], x[5]); t0.w = pk_bf16(x[6], x[7]);
                    t1.x = pk_bf16(x[8], x[9]); t1.y = pk_bf16(x[10], x[11]); t1.z = pk_bf16(x[12], x[13]); t1.w = pk_bf16(x[14], x[15]);
                    *(LAS u32x4*)(CM(0) + (cw + n) * CST + 16 * I) = t0; *(LAS u32x4*)(CM(0) + (cw + n) * CST + 16 * I + 8) = t1;
                }
                wave_lds_fence();
            }
        }
        CH_BAR();
#pragma unroll
        for (int ti = 0; ti < 2; ++ti) {
            const int d = 16 * (tcb + ti) + n;
            { f32x4 x1 = {0.f, 0.f, 0.f, 0.f}; x1 = cmm(CM(8), 16 * tr + n, CM(7), 16 * (tcb + ti) + n, c4, x1); st_t4(CM(0), d, 16 * tr + 4 * c4, x1); }
            asm volatile("" ::: "memory");
            { f32x4 ta = {0.f, 0.f, 0.f, 0.f}; ta = cmm(CM(3), 16 * tr + n, CM(4), 16 * (tcb + ti) + n, c4, ta); st_t4(CM(1), d, 16 * tr + 4 * c4, ta); }
            asm volatile("" ::: "memory");
        }
        CH_BAR();
#pragma unroll
        for (int ti = 0; ti < 2; ++ti) {
            f32x4 uv = {0.f, 0.f, 0.f, 0.f};
            uv = cmm(CM(3), 16 * tr + n, CM(0), 16 * (tcb + ti) + n, c4, uv);
            st_t4(CM(2), 16 * (tcb + ti) + n, 16 * tr + 4 * c4, uv);
        }
        CH_BAR();
#pragma unroll
        for (int ti = 0; ti < 2; ++ti) {
            const int cc = 16 * (tcb + ti) + n, r0 = 16 * tr + 4 * c4;
            const float gl = gLs[cc];
            { f32x4 pm = {0.f, 0.f, 0.f, 0.f}; pm = cmm(CM(1), 16 * tr + n, CM(5), cc, c4, pm);
#pragma unroll
              for (int r = 0; r < 4; ++r) PCb[(r0 + r) * 64 + cc] = (pm[r] + ((r0 + r) == cc ? 1.f : 0.f)) * gl; }
            asm volatile("" ::: "memory");
            { f32x4 cm_ = {0.f, 0.f, 0.f, 0.f}; cm_ = cmm(CM(2), 16 * tr + n, CM(5), cc, c4, cm_); cm_ = cmm(CM(7), 16 * tr + n, CM(6), cc, c4, cm_);
#pragma unroll
              for (int r = 0; r < 4; ++r) CCb[(r0 + r) * 64 + cc] = cm_[r] * gl; }
            asm volatile("" ::: "memory");
            { f32x4 gg = {0.f, 0.f, 0.f, 0.f}; gg = cmm(CM(9), 16 * tr + n, CM(1), cc, c4, gg);
#pragma unroll
              for (int r = 0; r < 4; ++r) GMb[(r0 + r) * D + cc] = f2bf(gg[r] + rt[ti][r]); }
            asm volatile("" ::: "memory");
            { f32x4 y0 = {0.f, 0.f, 0.f, 0.f}; y0 = cmm(CM(9), 16 * tr + n, CM(2), cc, c4, y0); y0 = cmm(CM(10), 16 * tr + n, CM(7), cc, c4, y0);
#pragma unroll
              for (int r = 0; r < 4; ++r) Y0b[(r0 + r) * D + cc] = f2bf(y0[r]); }
            asm volatile("" ::: "memory");
        }
        CH_BAR();
    }
#undef CM
#undef CH_PREFETCH
#undef CH_BAR
}

__device__ __forceinline__ void phase_sample_mixer_w(KP p, int j, int first, int stride) {
    const int tid = TID(), lane = tid & 63;
    {
        const bf16_t *RB = WSP(bf16_t, WS_RB), *KB = WSP(bf16_t, WS_KB), *VB = WSP(bf16_t, WS_VB); bf16_t* YG = WSP(bf16_t, WS_YG);
        const float *WPp = WSP(float, WS_WP), *APp = WSP(float, WS_AP), *VPp = WSP(float, WS_VP), *GG = WSP(float, WS_GG); float* VF = WSP(float, WS_VFIRST);
        for (int it = first; it < 512; it += stride) {
            const int b = it >> 4, h = it & 15, col = h * 64 + lane;
            const float* s0 = p->state_wkv + (((size_t)j * 32 + b) * 16 + h) * 4096 + lane * 64;
            float S[64];
#pragma unroll
            for (int k = 0; k < 64; k += 4) { const f32x4 t = *(const f32x4*)(s0 + k); S[k] = t[0]; S[k + 1] = t[1]; S[k + 2] = t[2]; S[k + 3] = t[3]; }
            const float w0 = p->rw_w0[j * D + col], a0 = p->rw_a0[j * D + col], kkw = p->rw_k_k[j * D + col], kaw = p->rw_k_a[j * D + col], rkw = p->rw_r_k[j * D + col];
            const float v0 = j ? p->rw_v0[(j - 1) * D + col] : 0.f, lnw = p->rw_lnx_w[j * D + col], lnb = p->rw_lnx_b[j * D + col];
            for (int t = 0; t < 8; ++t) {
                const size_t o = (size_t)(NP + b * 8 + t) * D + col;
                const float kx = bf2f(KB[o]), vx = bf2f(VB[o]), r = bf2f(RB[o]);
                const float z = -(w0 + WPp[o]), sp = fmaxf(z, 0.f) + log1pf(expf(-fabsf(z)));
                const float wd = expf(-expf(-sp - 0.5f)), asg = sigmoidf_(a0 + APp[o]);
                float v = vx;
                if (j == 0) VF[o] = vx; else { const float vf = VF[o]; v = vx + (vf - vx) * sigmoidf_(v0 + VPp[o]); }
                float kk = kx * kkw; const float ss = wave_sum(kk * kk); kk *= rsqrtf(fmaxf(ss, 1e-24f));
                const float kp = kx * (1.0f + (asg - 1.0f) * kaw), a = -kk, bq = kk * asg;
                float sa = 0.f;
#pragma unroll
                for (int k = 0; k < 64; ++k) sa += S[k] * rl(a, k);
#pragma unroll
                for (int k = 0; k < 64; ++k) S[k] = S[k] * rl(wd, k) + sa * rl(bq, k) + v * rl(kp, k);
                float y = 0.f;
#pragma unroll
                for (int k = 0; k < 64; ++k) y += S[k] * rl(r, k);
                const float mu = wave_sum(y) * (1.0f / 64.0f), dy = y - mu, var = wave_sum(dy * dy) * (1.0f / 64.0f);
                const float bonus = wave_sum(r * kp * rkw);
                YG[o] = f2bf((dy * rsqrtf(var + 64e-5f) * lnw + lnb + bonus * v) * GG[o]);
            }
            float* so = p->out + O_WKVS + (((size_t)j * 32 + b) * 16 + h) * 4096 + lane * 64;
#pragma unroll
            for (int k = 0; k < 64; k += 4) *(f32x4*)(so + k) = (f32x4){S[k], S[k + 1], S[k + 2], S[k + 3]};
        }
    }
}
__device__ __forceinline__ void phase_carry(KP p, int j, LAS unsigned char* lds) {
    const float *PCH = WSP(float, WS_PCH), *CCH = WSP(float, WS_CCH); float* SST = WSP(float, WS_SST);
    LAS float* Sl = (LAS float*)lds;
    LAS unsigned* cflag = (LAS unsigned*)(lds + 9216);
    if (TID() == 0) *cflag = 0u;
    __syncthreads();
    unsigned arrivals = 0u;
    if ((TID() >> 6) >= 4) { phase_sample_mixer_w(p, j, BID() * 4 + ((TID() >> 6) - 4), (int)gridDim.x * 4); }
    else
    for (int it = BID(); it < 256; it += gridDim.x) {
        const int wave = TID() >> 6, sh = it >> 2, row0 = 16 * (it & 3), col0 = 16 * (wave & 3), b = sh >> 4, h = sh & 15;
        const bool act = true;
        f32x4 acc = {0.f, 0.f, 0.f, 0.f}, c0, c1, c2;
        float b0[16], b1[16], b2[16];
#define CARRY_LOAD(BX, CX, cc_) do { const int l_ = TID() & 63, ln = l_ & 15, lq = l_ >> 4; \
            const float* Pc = PCH + ((size_t)sh * NCH + (cc_)) * 4096; const float* Cc = CCH + ((size_t)sh * NCH + (cc_)) * 4096; \
            _Pragma("unroll") for (int q = 0; q < 16; ++q) BX[q] = Pc[(4 * q + lq) * 64 + col0 + ln]; \
            _Pragma("unroll") for (int r = 0; r < 4; ++r) CX[r] = Cc[(row0 + 4 * lq + r) * 64 + col0 + ln]; } while (0)
#define CARRY_STEP(BX, CX, BL, CL, c_) do { const int l_ = TID() & 63, ln = l_ & 15, lq = l_ >> 4; \
            LAS float* Sw = Sl + ((c_) & 1) * (16 * 68); bf16_t* go = (bf16_t*)SST + ((size_t)sh * NCH + (c_)) * 4096; \
            if (act) { _Pragma("unroll") for (int r = 0; r < 4; ++r) Sw[(4 * lq + r) * 68 + col0 + ln] = acc[r]; } \
            const f32x4 sc = acc; acc = CX; \
            asm volatile("s_waitcnt lgkmcnt(0)" ::: "memory"); arrivals += 4u; \
            if ((TID() & 63) == 0) __hip_atomic_fetch_add(cflag, 1u, __ATOMIC_RELAXED, __HIP_MEMORY_SCOPE_WORKGROUP); \
            { unsigned sp_ = 0; while (__builtin_amdgcn_readfirstlane(__hip_atomic_load(cflag, __ATOMIC_RELAXED, __HIP_MEMORY_SCOPE_WORKGROUP)) < arrivals && ++sp_ < (1u << 22)) __builtin_amdgcn_s_sleep(0); } \
            asm volatile("" ::: "memory"); \
            if (act) { \
                _Pragma("unroll") for (int r = 0; r < 4; ++r) go[(row0 + 4 * lq + r) * 64 + col0 + ln] = f2bf(sc[r]); \
                if ((c_) + 2 < NCH) CARRY_LOAD(BL, CL, (c_) + 2); \
                float av[16]; _Pragma("unroll") for (int q = 0; q < 16; ++q) av[q] = Sw[ln * 68 + 4 * q + lq]; \
                asm volatile("s_waitcnt lgkmcnt(0)" ::: "memory"); \
                _Pragma("unroll") for (int q = 0; q < 16; ++q) acc = __builtin_amdgcn_mfma_f32_16x16x4f32(av[q], BX[q], acc, 0, 0, 0); } } while (0)
        if (act) { CARRY_LOAD(b0, c0, 0); CARRY_LOAD(b1, c1, 1); }
        for (int c = 0; c < NCH; c += 3) {
            CARRY_STEP(b0, c0, b2, c2, c);
            if (c + 1 < NCH) CARRY_STEP(b1, c1, b0, c0, c + 1);
            if (c + 2 < NCH) CARRY_STEP(b2, c2, b1, c1, c + 2);
        }
        if (act) { const int l_ = TID() & 63, ln = l_ & 15, lq = l_ >> 4; float* go = p->out + O_WKVP + (((size_t)j * 4 + b) * 16 + h) * 4096;
#pragma unroll
            for (int r = 0; r < 4; ++r) go[(row0 + 4 * lq + r) * 64 + col0 + ln] = acc[r]; }
#undef CARRY_LOAD
#undef CARRY_STEP
    }
    __syncthreads();
}
__device__ __forceinline__ void phase_sample_mixer(KP p, int j) {
    const int tid = TID(), lane = tid & 63, wave = tid >> 6;
    {
        const bf16_t *RB = WSP(bf16_t, WS_RB), *KB = WSP(bf16_t, WS_KB), *VB = WSP(bf16_t, WS_VB); bf16_t* YG = WSP(bf16_t, WS_YG);
        const float *WPp = WSP(float, WS_WP), *APp = WSP(float, WS_AP), *VPp = WSP(float, WS_VP), *GG = WSP(float, WS_GG); float* VF = WSP(float, WS_VFIRST);
        for (int it = BID() * 8 + wave; it < 512; it += gridDim.x * 8) {
            const int b = it >> 4, h = it & 15, col = h * 64 + lane;
            const float* s0 = p->state_wkv + (((size_t)j * 32 + b) * 16 + h) * 4096 + lane * 64;
            float S[64];
#pragma unroll
            for (int k = 0; k < 64; k += 4) { const f32x4 t = *(const f32x4*)(s0 + k); S[k] = t[0]; S[k + 1] = t[1]; S[k + 2] = t[2]; S[k + 3] = t[3]; }
            const float w0 = p->rw_w0[j * D + col], a0 = p->rw_a0[j * D + col], kkw = p->rw_k_k[j * D + col], kaw = p->rw_k_a[j * D + col], rkw = p->rw_r_k[j * D + col];
            const float v0 = j ? p->rw_v0[(j - 1) * D + col] : 0.f, lnw = p->rw_lnx_w[j * D + col], lnb = p->rw_lnx_b[j * D + col];
            for (int t = 0; t < 8; ++t) {
                const size_t o = (size_t)(NP + b * 8 + t) * D + col;
                const float kx = bf2f(KB[o]), vx = bf2f(VB[o]), r = bf2f(RB[o]);
                const float z = -(w0 + WPp[o]), sp = fmaxf(z, 0.f) + log1pf(expf(-fabsf(z)));
                const float wd = expf(-expf(-sp - 0.5f)), asg = sigmoidf_(a0 + APp[o]);
                float v = vx;
                if (j == 0) VF[o] = vx; else { const float vf = VF[o]; v = vx + (vf - vx) * sigmoidf_(v0 + VPp[o]); }
                float kk = kx * kkw; const float ss = wave_sum(kk * kk); kk *= rsqrtf(fmaxf(ss, 1e-24f));
                const float kp = kx * (1.0f + (asg - 1.0f) * kaw), a = -kk, bq = kk * asg;
                float sa = 0.f;
#pragma unroll
                for (int k = 0; k < 64; ++k) sa += S[k] * rl(a, k);
#pragma unroll
                for (int k = 0; k < 64; ++k) S[k] = S[k] * rl(wd, k) + sa * rl(bq, k) + v * rl(kp, k);
                float y = 0.f;
#pragma unroll
                for (int k = 0; k < 64; ++k) y += S[k] * rl(r, k);
                const float mu = wave_sum(y) * (1.0f / 64.0f), dy = y - mu, var = wave_sum(dy * dy) * (1.0f / 64.0f);
                const float bonus = wave_sum(r * kp * rkw);
                YG[o] = f2bf((dy * rsqrtf(var + 64e-5f) * lnw + lnb + bonus * v) * GG[o]);
            }
            float* so = p->out + O_WKVS + (((size_t)j * 32 + b) * 16 + h) * 4096 + lane * 64;
#pragma unroll
            for (int k = 0; k < 64; k += 4) *(f32x4*)(so + k) = (f32x4){S[k], S[k + 1], S[k + 2], S[k + 3]};
        }
    }
}
__device__ __forceinline__ void phase_post2(KP p, int j, LAS unsigned char* lds) {
    LAS float* part = (LAS float*)lds;
    const bf16_t *GM = WSP(bf16_t, WS_DEC), *VM2 = WSP(bf16_t, WS_KM), *TG = WSP(bf16_t, WS_TG), *G2T = WSP(bf16_t, WS_G2T) + (size_t)j * D * 160;
    const float *Y0 = WSP(float, WS_Y), *BON = WSP(float, WS_AV), *SST = WSP(float, WS_SST); bf16_t* YG = WSP(bf16_t, WS_YG);
    bf16x8 n_af[2], n_bw[2][2], n_tg[5]; unsigned short n_y0[2][4];
#define P2_MAP(q_) (q_)
#define P2_LOAD(itx) do { const int tid_ = TID(), lane_ = tid_ & 63, w_ = tid_ >> 6, n_ = lane_ & 15, c4_ = lane_ >> 4, tr_ = w_ >> 1, tcb_ = 2 * (w_ & 1); \
        const int it_ = (itx), sh_ = it_ / NCH, c_ = it_ % NCH, R0_ = (sh_ >> 4) * 4096 + c_ * LCH, hc_ = (sh_ & 15) * 64; const size_t ar_ = (size_t)(R0_ + 16 * tr_ + n_); \
        _Pragma("unroll") for (int ks = 0; ks < 2; ++ks) n_af[ks] = *(const bf16x8*)(GM + ar_ * D + hc_ + 32 * ks + 8 * c4_); \
        _Pragma("unroll") for (int ti = 0; ti < 2; ++ti) _Pragma("unroll") for (int ks = 0; ks < 2; ++ks) \
            n_bw[ti][ks] = *(const bf16x8*)((const bf16_t*)SST + ((size_t)it_ * 64 + 16 * (tcb_ + ti) + n_) * 64 + 32 * ks + 8 * c4_); \
        _Pragma("unroll") for (int ks = 0; ks < 5; ++ks) n_tg[ks] = *(const bf16x8*)(TG + ar_ * 160 + 32 * ks + 8 * c4_); \
        _Pragma("unroll") for (int ti = 0; ti < 2; ++ti) _Pragma("unroll") for (int r = 0; r < 4; ++r) \
            n_y0[ti][r] = ((const bf16_t*)Y0)[(size_t)(R0_ + 16 * tr_ + 4 * c4_ + r) * D + hc_ + 16 * (tcb_ + ti) + n_]; } while (0)
    if (BID() < 64 * NCH) P2_LOAD(P2_MAP(BID()));
    for (int q = BID(); q < 64 * NCH; q += gridDim.x) {
        const int it = P2_MAP(q);
        const int tid = TID(), lane = tid & 63, w = tid >> 6, n = lane & 15, c4 = lane >> 4, tr = w >> 1, tcb = 2 * (w & 1);
        const int sh = it / NCH, c = it % NCH, b = sh >> 4, h = sh & 15, R0 = b * 4096 + c * LCH, hc = h * 64;
        f32x4 y[2], g[2];
        const size_t ar = (size_t)(R0 + 16 * tr + n);
        bf16x8 c_af[2], c_bw[2][2], c_tg[5]; unsigned short c_y0[2][4];
#pragma unroll
        for (int ks = 0; ks < 2; ++ks) { c_af[ks] = n_af[ks]; c_bw[0][ks] = n_bw[0][ks]; c_bw[1][ks] = n_bw[1][ks]; }
#pragma unroll
        for (int ks = 0; ks < 5; ++ks) c_tg[ks] = n_tg[ks];
#pragma unroll
        for (int ti = 0; ti < 2; ++ti)
#pragma unroll
            for (int r = 0; r < 4; ++r) c_y0[ti][r] = n_y0[ti][r];
        if (q + (int)gridDim.x < 64 * NCH) P2_LOAD(P2_MAP(q + (int)gridDim.x));
#pragma unroll
        for (int ti = 0; ti < 2; ++ti) {
            const int dv = 16 * (tcb + ti) + n;
            f32x4 acc = {0.f, 0.f, 0.f, 0.f}, gacc = acc;
#pragma unroll
            for (int ks = 0; ks < 2; ++ks) {
                acc = __builtin_amdgcn_mfma_f32_16x16x32_bf16(c_af[ks], c_bw[ti][ks], acc, 0, 0, 0);
            }
#pragma unroll
            for (int ks = 0; ks < 5; ++ks)
                gacc = __builtin_amdgcn_mfma_f32_16x16x32_bf16(c_tg[ks], *(const bf16x8*)(G2T + (size_t)(hc + dv) * 160 + 32 * ks + 8 * c4), gacc, 0, 0, 0);
#pragma unroll
            for (int r = 0; r < 4; ++r) acc[r] += bf2f(c_y0[ti][r]);
            y[ti] = acc; g[ti] = gacc;
        }
        float bonus4[4]; unsigned short vm4[2][4]; float lnw2[2], lnb2[2];
#pragma unroll
        for (int r = 0; r < 4; ++r) bonus4[r] = BON[(size_t)(R0 + 16 * tr + 4 * c4 + r) * 16 + h];
#pragma unroll
        for (int ti = 0; ti < 2; ++ti) { const int col = hc + 16 * (tcb + ti) + n; lnw2[ti] = p->rw_lnx_w[j * D + col]; lnb2[ti] = p->rw_lnx_b[j * D + col];
#pragma unroll
            for (int r = 0; r < 4; ++r) vm4[ti][r] = VM2[(size_t)(R0 + 16 * tr + 4 * c4 + r) * D + col]; }
        float s1[4], s2[4];
#pragma unroll
        for (int r = 0; r < 4; ++r) { s1[r] = g16_sum(y[0][r] + y[1][r]); s2[r] = g16_sum(y[0][r] * y[0][r] + y[1][r] * y[1][r]); }
        asm volatile("s_waitcnt lgkmcnt(0)" ::: "memory"); __builtin_amdgcn_s_barrier(); asm volatile("" ::: "memory");
        if (n == 0) {
#pragma unroll
            for (int r = 0; r < 4; ++r) { const int t = 16 * tr + 4 * c4 + r; part[(t * 2 + (w & 1)) * 2 + 0] = s1[r]; part[(t * 2 + (w & 1)) * 2 + 1] = s2[r]; }
        }
        asm volatile("s_waitcnt lgkmcnt(0)" ::: "memory"); __builtin_amdgcn_s_barrier(); asm volatile("" ::: "memory");
#pragma unroll
        for (int r = 0; r < 4; ++r) {
            const int t = 16 * tr + 4 * c4 + r;
            const float mu = (part[(t * 2 + 0) * 2] + part[(t * 2 + 1) * 2]) * (1.0f / 64.0f), ex2 = (part[(t * 2 + 0) * 2 + 1] + part[(t * 2 + 1) * 2 + 1]) * (1.0f / 64.0f);
            const float rs = rsqrtf(fmaxf(ex2 - mu * mu, 0.f) + 64e-5f), bonus = bonus4[r];
#pragma unroll
            for (int ti = 0; ti < 2; ++ti) {
                const int col = hc + 16 * (tcb + ti) + n; const size_t o = (size_t)(R0 + t) * D + col;
                YG[o] = f2bf(((y[ti][r] - mu) * rs * lnw2[ti] + lnb2[ti] + bonus * bf2f(vm4[ti][r])) * g[ti][r]);
            }
        }
    }
#undef P2_LOAD
#undef P2_MAP
    __syncthreads();
}

__device__ __forceinline__ void phase_post(KP p, int j) {
    const float *Y = WSP(float, WS_Y), *KM = WSP(float, WS_KM), *VM = WSP(float, WS_VM), *GG = WSP(float, WS_GG);
    const bf16_t* RB = WSP(bf16_t, WS_RB); bf16_t* YG = WSP(bf16_t, WS_YG);
    const int lane = TID() & 63, gw = BID() * 8 + (TID() >> 6), nw = gridDim.x * 8;
    for (int row = gw; row < NT; row += nw) {
#pragma unroll
        for (int i = 0; i < 4; ++i) {
            const int col = 256 * i + 4 * lane; const size_t o = (size_t)row * D + col;
            const f32x4 y = *(const f32x4*)(Y + o), r = ld_bf4(RB + o), km = *(const f32x4*)(KM + o), vm = *(const f32x4*)(VM + o), gg = *(const f32x4*)(GG + o);
            const f32x4 lw = *(const f32x4*)(p->rw_lnx_w + j * D + col), lb = *(const f32x4*)(p->rw_lnx_b + j * D + col), rk = *(const f32x4*)(p->rw_r_k + j * D + col);
            const float mu = g16_sum(y[0] + y[1] + y[2] + y[3]) * (1.0f / 64.0f);
            const f32x4 d = y - mu;
            const float var = g16_sum(d[0] * d[0] + d[1] * d[1] + d[2] * d[2] + d[3] * d[3]) * (1.0f / 64.0f);
            const float rs = rsqrtf(var + 64e-5f);
            const float bon = g16_sum(r[0] * km[0] * rk[0] + r[1] * km[1] * rk[1] + r[2] * km[2] * rk[2] + r[3] * km[3] * rk[3]);
            st_bf4(YG + o, (d * rs * lw + lb + bon * vm) * gg);
        }
    }
}

__constant__ double kRopeInv[8] = {1.0, 0.19392274474868576, 0.03760603093086393, 0.007292664737217109, 0.001414213562373095, 0.0002742481756762073, 5.318295896944988e-05, 1.031338537721246e-05};
__device__ __forceinline__ void phase_rope_table(KP p) {
    float* TB = WSP(float, WS_ROPE);
    for (int e = ((int)gridDim.x - 1 - BID()) * 512 + TID(); e < 4104 * 8; e += gridDim.x * 512) {
        const int pi = e >> 3, f = e & 7, pos = pi < 4096 ? pi : PAST + (pi - 4096);
        double ang = (double)pos * kRopeInv[f]; ang -= floor(ang * 0.15915494309189535) * 6.283185307179586; const float af = (float)ang;
        TB[pi * 16 + f] = cosf(af); TB[pi * 16 + 8 + f] = sinf(af);
    }
}
__device__ __forceinline__ void phase_dsapost(KP p, int j) {
    const bf16_t* PR = WSP(bf16_t, WS_PR); float *Q = WSP(float, WS_Q), *QI = WSP(float, WS_QI), *WI = WSP(float, WS_WI);
    const int lane = TID() & 63, l16 = lane & 15, gw = BID() * 8 + (TID() >> 6), nw = gridDim.x * 8;
    const f32x4 qn = *(const f32x4*)(p->att_q_norm + j * 64 + 4 * l16), kn = *(const f32x4*)(p->att_k_norm + j * 64 + 4 * l16), in = *(const f32x4*)(p->idx_k_norm + j * 64 + 4 * l16);
    u32x2 rw[10]; f32x4 csn, snn;
#define DP_LOAD(ROW_) do { const int row_ = (ROW_); const bf16_t* pr_ = PR + (size_t)row_ * PINP; \
        _Pragma("unroll") for (int i = 0; i < 8; ++i) rw[i] = *(const u32x2*)(pr_ + 256 * i + 4 * lane); \
        rw[8] = *(const u32x2*)(pr_ + 2048 + 4 * l16); rw[9] = *(const u32x2*)(pr_ + 2112 + 4 * (lane & 1)); \
        const float* tb_ = WSP(float, WS_ROPE) + (row_ < NP ? (row_ & 4095) : 4096 + ((row_ - NP) & 7)) * 16 + 4 * (l16 & 1); csn = *(const f32x4*)tb_; snn = *(const f32x4*)(tb_ + 8); } while (0)
#define BF4(w_) ((f32x4){bflo((w_).x), bfhi((w_).x), bflo((w_).y), bfhi((w_).y)})
    if (gw < NT) DP_LOAD(gw);
    for (int row = gw; row < NT; row += nw) {
        u32x2 rc[10];
#pragma unroll
        for (int i = 0; i < 10; ++i) rc[i] = rw[i];
        const f32x4 cs = csn, sn = snn;
        if (row + nw < NT) DP_LOAD(row + nw);
        const float sgn = (l16 < 2) ? -1.0f : 1.0f;
#define ROPE4(v) do { f32x4 _o; _o[0] = __shfl_xor((v)[0], 2); _o[1] = __shfl_xor((v)[1], 2); _o[2] = __shfl_xor((v)[2], 2); _o[3] = __shfl_xor((v)[3], 2); if (l16 < 4) (v) = (v) * cs + sgn * (_o * sn); } while (0)
#define HNORM4(v, w) do { const float _ss = g16_sum((v)[0] * (v)[0] + (v)[1] * (v)[1] + (v)[2] * (v)[2] + (v)[3] * (v)[3]); (v) = (v) * rsqrtf(_ss * (1.0f / 64.0f) + 1e-6f) * (w); } while (0)
#pragma unroll
        for (int i = 0; i < 4; ++i) { f32x4 v = BF4(rc[i]); HNORM4(v, qn); ROPE4(v); st_bf4((bf16_t*)Q + (size_t)row * D + 256 * i + 4 * lane, v); }
        { f32x4 v = BF4(rc[4]); HNORM4(v, kn); ROPE4(v);
          float* ko = row < NP ? p->out + O_KP + ((size_t)j * NP + row) * 256 : p->out + O_KS + ((size_t)j * NS + (row - NP)) * 256; *(f32x4*)(ko + 4 * lane) = v; *(unsigned*)(WSP(unsigned char, WS_K8) + (size_t)row * 256 + 4 * lane) = pk_fp8x4(v); }
        { const f32x4 v = BF4(rc[5]);
          float* vo = row < NP ? p->out + O_VP + ((size_t)j * NP + row) * 256 : p->out + O_VS + ((size_t)j * NS + (row - NP)) * 256; *(f32x4*)(vo + 4 * lane) = v; *(unsigned*)(WSP(unsigned char, WS_V8) + (size_t)row * 256 + 4 * lane) = pk_fp8x4(v); }
#pragma unroll
        for (int i = 0; i < 2; ++i) { f32x4 v = BF4(rc[6 + i]); ROPE4(v); st_bf4(WSP(bf16_t, WS_QIB) + (size_t)row * 512 + 256 * i + 4 * lane, v); }
        { f32x4 v = BF4(rc[8]); HNORM4(v, in); ROPE4(v);
          float* io = row < NP ? p->out + O_IKP + ((size_t)j * NP + row) * 64 : p->out + O_IKS + ((size_t)j * NS + (row - NP)) * 64; if (lane < 16) { *(f32x4*)(io + 4 * lane) = v; st_bf4(WSP(bf16_t, WS_KIB) + (size_t)row * 64 + 4 * lane, v); } }
        if (lane < 2) { const f32x4 v = BF4(rc[9]); *(f32x4*)(WI + (size_t)row * 8 + 4 * lane) = v * 0.35355339059327373f; }
#undef ROPE4
#undef HNORM4
    }
#undef DP_LOAD
#undef BF4
}

template <bool SAMPLE>
__device__ __forceinline__ void phase_idx(KP p, int j, LAS unsigned char* lds) {
    LAS float* Qs = (LAS float*)lds;
    LAS float* Ks = (LAS float*)(lds + 32768);
    const float *QI = WSP(float, WS_QI), *WI = WSP(float, WS_WI);
    const int tid = TID(), q = tid >> 5, kx = tid & 31;
    const int nitems = SAMPLE ? 32 * 65 : 1024;
    for (int it = BID(); it < nitems; it += gridDim.x) {
        int b, t0, rowbase, nkt, kt0 = 0;
        if (SAMPLE) { b = it / 65; kt0 = it % 65; t0 = 0; rowbase = NP + b * 8; nkt = kt0 + 1; }
        else { const int k4 = it >> 8, w = it & 255, i = (k4 & 1) ? (k4 * 256 + 255 - w) : (k4 * 256 + w); b = i & 3; t0 = (i >> 2) * 16; rowbase = b * 4096 + t0; nkt = (t0 + 15) / 128 + 1; }
        const int nq = SAMPLE ? 8 : 16;
        __syncthreads();
#pragma unroll
        for (int n = 0; n < 16; ++n) { const int e = tid + 512 * n, qq = e >> 9, c = e & 511, h = c >> 6, d = c & 63;
            Qs[(d * 16 + qq) * 8 + h] = qq < nq ? QI[(size_t)(rowbase + qq) * 512 + c] : 0.f; }
        float wi[8];
#pragma unroll
        for (int h = 0; h < 8; ++h) wi[h] = q < nq ? WI[(size_t)(rowbase + q) * 8 + h] : 0.f;
        for (int kt = kt0; kt < nkt; ++kt) {
            __syncthreads();
#pragma unroll
            for (int n = 0; n < 16; ++n) { const int e = tid + 512 * n, key = e >> 6, d = e & 63, s = kt * 128 + key; float v = 0.f;
                if (SAMPLE) {
                    if (s < PAST) { const int pg = p->page_table[b * 64 + (s >> 7)]; v = p->cache_ik[(((size_t)j * 2560 + pg) * 128 + (s & 127)) * 64 + d]; }
                    else if (s < PAST + 8) v = p->out[O_IKS + ((size_t)j * NS + b * 8 + (s - PAST)) * 64 + d];
                } else v = p->out[O_IKP + ((size_t)j * NP + b * 4096 + s) * 64 + d];
                Ks[d * 132 + key] = v; }
            __syncthreads();
            f32x4 acc[8];
#pragma unroll
            for (int h = 0; h < 8; ++h) acc[h] = (f32x4){0.f, 0.f, 0.f, 0.f};
#pragma unroll 4
            for (int d = 0; d < 64; ++d) {
                const f32x4 qa = *(const LAS f32x4*)(Qs + (d * 16 + q) * 8), qb = *(const LAS f32x4*)(Qs + (d * 16 + q) * 8 + 4), kv = *(const LAS f32x4*)(Ks + d * 132 + 4 * kx);
                acc[0] += qa[0] * kv; acc[1] += qa[1] * kv; acc[2] += qa[2] * kv; acc[3] += qa[3] * kv;
                acc[4] += qb[0] * kv; acc[5] += qb[1] * kv; acc[6] += qb[2] * kv; acc[7] += qb[3] * kv;
            }
            f32x4 sc = {0.f, 0.f, 0.f, 0.f};
#pragma unroll
            for (int h = 0; h < 8; ++h)
#pragma unroll
                for (int e = 0; e < 4; ++e) sc[e] += fmaxf(acc[h][e] * 0.125f, 0.f) * wi[h];
            if (q < nq) {
                if (SAMPLE) *(f32x4*)(WSP(float, WS_SCS) + (size_t)(b * 8 + q) * SCS_LD + kt * 128 + 4 * kx) = sc;
                else *(f32x4*)(WSP(float, WS_SC) + ((size_t)b * 4096 + t0 + q) * 4096 + kt * 128 + 4 * kx) = sc;
            }
        }
    }
    __syncthreads();
}

template <bool SAMPLE>
__device__ __forceinline__ void phase_idx2(KP p, int j) {
    const bf16_t *QIB = WSP(bf16_t, WS_QIB), *KIB = WSP(bf16_t, WS_KIB); const float* WI = WSP(float, WS_WI);
    const int lane = TID() & 63, lr = lane & 31, lh = lane >> 5, gw = BID() * 8 + (TID() >> 6), nw = gridDim.x * 8;
    const int nitems = SAMPLE ? 32 * 65 : 4096;
    for (int it = gw; it < nitems; it += nw) {
        int b, rowbase, tile0, ntile;
        if (SAMPLE) { b = it / 65; rowbase = NP + b * 8; tile0 = (it % 65) * 4; ntile = min(4, 257 - tile0); }
        else { const int sub = it >= 2048, w_ = it & 2047; b = w_ & 3; const int wb = w_ >> 2, kk = sub ? 511 - wb : wb, nt = (kk * 8 + 7) / 32 + 1;
            rowbase = b * 4096 + kk * 8; tile0 = sub ? (nt >> 1) : 0; ntile = sub ? nt - (nt >> 1) : (nt >> 1); }
        if (ntile <= 0) continue;
        bf16x8 af[2][4]; float w[2][2][8];
        { const int hd = (lr & 3) + 4 * ((lr >> 3) & 1), jq = 2 * ((lr >> 2) & 1) + (lr >> 4);
#pragma unroll
          for (int st = 0; st < 2; ++st)
#pragma unroll
              for (int ks = 0; ks < 4; ++ks) af[st][ks] = *(const bf16x8*)(QIB + (size_t)(rowbase + 4 * st + jq) * 512 + hd * 64 + 16 * ks + 8 * lh);
#pragma unroll
          for (int st = 0; st < 2; ++st)
#pragma unroll
              for (int q = 0; q < 2; ++q) { const f32x4 w0 = *(const f32x4*)(WI + (size_t)(rowbase + 4 * st + 2 * lh + q) * 8), w1 = *(const f32x4*)(WI + (size_t)(rowbase + 4 * st + 2 * lh + q) * 8 + 4);
#pragma unroll
                  for (int e = 0; e < 4; ++e) { w[st][q][e] = w0[e] * 0.125f; w[st][q][4 + e] = w1[e] * 0.125f; } } }
#define IDX_LOADB(BF, tl_) do { const int s_ = (tile0 + (tl_)) * 32 + lr; \
            if (!SAMPLE) { _Pragma("unroll") for (int ks = 0; ks < 4; ++ks) BF[ks] = *(const bf16x8*)(KIB + ((size_t)b * 4096 + s_) * 64 + 16 * ks + 8 * lh); } \
            else { const float* kp = p->out + O_IKS + ((size_t)j * NS + b * 8) * 64; \
                if (s_ < PAST) kp = p->cache_ik + (((size_t)j * 2560 + p->page_table[b * 64 + (s_ >> 7)]) * 128 + (s_ & 127)) * 64; else kp += (size_t)min(s_ - PAST, 7) * 64; \
                _Pragma("unroll") for (int ks = 0; ks < 4; ++ks) { const f32x4 x0 = *(const f32x4*)(kp + 16 * ks + 8 * lh), x1 = *(const f32x4*)(kp + 16 * ks + 8 * lh + 4); \
                    const u32x4 wv = {pk_bf16(x0[0], x0[1]), pk_bf16(x0[2], x0[3]), pk_bf16(x1[0], x1[1]), pk_bf16(x1[2], x1[3])}; BF[ks] = __builtin_bit_cast(bf16x8, wv); } } } while (0)
        bf16x8 bnx[4];
        IDX_LOADB(bnx, 0);
        for (int tl = 0; tl < ntile; ++tl) {
            const int s = (tile0 + tl) * 32 + lr;
            bf16x8 bfr[4];
#pragma unroll
            for (int ks = 0; ks < 4; ++ks) bfr[ks] = bnx[ks];
            if (tl + 1 < ntile) IDX_LOADB(bnx, tl + 1);
            __builtin_amdgcn_sched_barrier(0);
#pragma unroll
            for (int st = 0; st < 2; ++st) {
                f32x16 acc;
#pragma unroll
                for (int r = 0; r < 16; ++r) acc[r] = 0.f;
#pragma unroll
                for (int ks = 0; ks < 4; ++ks) acc = __builtin_amdgcn_mfma_f32_32x32x16_bf16(af[st][ks], bfr[ks], acc, 0, 0, 0);
#pragma unroll
                for (int q = 0; q < 2; ++q) {
                    float sc = 0.f;
#pragma unroll
                    for (int hh = 0; hh < 2; ++hh)
#pragma unroll
                        for (int hl = 0; hl < 4; ++hl) sc += fmaxf(acc[4 * (2 * q + hh) + hl], 0.f) * w[st][q][hl + 4 * hh];
                    if (SAMPLE) WSP(float, WS_SCS)[(size_t)(b * 8 + 4 * st + 2 * lh + q) * SCS_LD + s] = sc;
                    else WSP(float, WS_SC)[((size_t)rowbase + 4 * st + 2 * lh + q) * 4096 + s] = sc;
                }
            }
        }
    }
#undef IDX_LOADB
}

__device__ __forceinline__ unsigned fkey(float f) { f = (f == 0.f) ? 0.f : f; const unsigned u = __float_as_uint(f); return (u & 0x80000000u) ? ~u : (u | 0x80000000u); }
__device__ __forceinline__ void phase_topk_prompt(KP p) {
    const float* SC = WSP(float, WS_SC); int* SEL = WSP(int, WS_SEL); int* CNT = WSP(int, WS_CNT);
    const int lane = TID() & 63, gw = BID() * 8 + (TID() >> 6), nw = gridDim.x * 8;
    for (int qi = gw; qi < NP; qi += nw) {
        const int b = qi & 3, tt = qi >> 2, t = (tt & 1) ? 4095 - (tt >> 1) : (tt >> 1), row = b * 4096 + t, n = t + 1;
        int* sel = SEL + (size_t)row * 256;
        if (n <= TOPK) { for (int s = lane; s < n; s += 64) sel[s] = s; if (lane == 0) CNT[row] = n; continue; }
        const float* base = SC + (size_t)row * 4096;
        const int nb = __builtin_amdgcn_readfirstlane((n + 1023) >> 10);
        unsigned u[64];
#pragma unroll
        for (int kb = 0; kb < 4; ++kb) {
            if (kb < nb) {
#pragma unroll
                for (int m = 16 * kb; m < 16 * kb + 16; ++m) u[m] = __float_as_uint(base[lane + 64 * m]);
            } else {
#pragma unroll
                for (int m = 16 * kb; m < 16 * kb + 16; ++m) u[m] = 0u;
            }
        }
#pragma unroll
        for (int m = 0; m < 64; ++m) { const unsigned k_ = fkey(__uint_as_float(u[m])); u[m] = (lane + 64 * m < n) ? k_ : 0u; }
        unsigned tau = 0u;
#pragma unroll 1
        for (int bit = 31; bit >= 0; --bit) {
            const unsigned cand = tau | (1u << bit); int c = 0;
#pragma unroll
            for (int m = 0; m < 16; ++m) c += (u[m] >= cand) ? 1 : 0;
            if (nb > 1) {
#pragma unroll
                for (int m = 16; m < 32; ++m) c += (u[m] >= cand) ? 1 : 0;
                if (nb > 2) {
#pragma unroll
                    for (int m = 32; m < 48; ++m) c += (u[m] >= cand) ? 1 : 0;
                    if (nb > 3) {
#pragma unroll
                        for (int m = 48; m < 64; ++m) c += (u[m] >= cand) ? 1 : 0;
                    }
                }
            }
            c = wave_sum_i(c);
            if (c >= TOPK) tau = cand;
            if (c == TOPK) break;
        }
        int cg = 0, ct = 0; unsigned tlo = 0u, thi = 0u;
#pragma unroll
        for (int m = 31; m >= 0; --m) { cg += (u[m] > tau) ? 1 : 0; const unsigned tie = (u[m] == tau) ? 1u : 0u; ct += (int)tie; tlo = (tlo << 1) | tie; }
#pragma unroll
        for (int m = 63; m >= 32; --m) { cg += (u[m] > tau) ? 1 : 0; const unsigned tie = (u[m] == tau) ? 1u : 0u; ct += (int)tie; thi = (thi << 1) | tie; }
        unsigned long long tmask = ((unsigned long long)thi << 32) | tlo;
        const int totg = wave_sum_i(cg), tott = wave_sum_i(ct);
        const int need = TOPK - totg;
        unsigned long long smask = 0ull;
        if (tott == need) smask = tmask;
        else {
#pragma unroll 1
            for (int it = 0; it < need; ++it) {
                const int m0 = tmask ? (int)__builtin_ctzll(tmask) : 64;
                const int cand = tmask ? (lane + 64 * m0) : 0x7fffffff, best = wave_min_i(cand);
                if (cand == best && tmask) { smask |= (1ull << m0); tmask &= ~(1ull << m0); }
            }
        }
        const int mine = cg + __popcll(smask);
        int incl = mine;
#pragma unroll
        for (int d = 1; d < 64; d <<= 1) { const int o = __shfl_up(incl, d); if (lane >= d) incl += o; }
        int off = incl - mine;
#pragma unroll
        for (int m = 0; m < 64; ++m) { if ((u[m] > tau) || ((smask >> m) & 1ull)) { sel[off] = lane + 64 * m; ++off; } }
        if (lane == 0) CNT[row] = TOPK;
    }
}
__device__ __forceinline__ void phase_topk_sample(KP p, LAS unsigned char* lds) {
    LAS unsigned* ckey = (LAS unsigned*)lds;
    LAS int* cidx = (LAS int*)(lds + 8192);
    const float* SCS = WSP(float, WS_SCS); int* SEL = WSP(int, WS_SEL); int* CNT = WSP(int, WS_CNT);
    for (int qq = BID(); qq < NS; qq += gridDim.x) {
        const int tid = TID(), lane = tid & 63, wave = tid >> 6;
        const int n = PAST + 1 + (qq & 7), row = NP + qq, s0 = 1088 * wave;
        const float* base = SCS + (size_t)qq * SCS_LD;
        unsigned u[17];
#pragma unroll
        for (int m = 0; m < 17; ++m) { const int s = s0 + lane + 64 * m; u[m] = __float_as_uint(base[s < SCS_LD ? s : 0]); }
#pragma unroll
        for (int m = 0; m < 17; ++m) { const unsigned k_ = fkey(__uint_as_float(u[m])); u[m] = (s0 + lane + 64 * m < n) ? k_ : 0u; }
        __syncthreads();
        {
            int nvalid = 0;
#pragma unroll
            for (int m = 0; m < 17; ++m) nvalid += (u[m] != 0u) ? 1 : 0;
            nvalid = wave_sum_i(nvalid);
            unsigned tau = 0u; int need = 0; unsigned tmask = 0u, smask = 0u;
            if (nvalid > TOPK) {
#pragma unroll 1
                for (int bit = 31; bit >= 0; --bit) {
                    const unsigned cand = tau | (1u << bit); int c = 0;
#pragma unroll
                    for (int m = 0; m < 17; ++m) c += (u[m] >= cand) ? 1 : 0;
                    c = wave_sum_i(c);
                    if (c >= TOPK) tau = cand;
                    if (c == TOPK) break;
                }
                int cg = 0, ct = 0;
#pragma unroll
                for (int m = 0; m < 17; ++m) { cg += (u[m] > tau) ? 1 : 0; const bool tie = (u[m] == tau); ct += tie ? 1 : 0; tmask |= tie ? (1u << m) : 0u; }
                cg = wave_sum_i(cg); ct = wave_sum_i(ct);
                need = TOPK - cg;
                if (ct == need) smask = tmask;
                else {
#pragma unroll 1
                    for (int it = 0; it < need; ++it) {
                        const int m0 = tmask ? (int)__builtin_ctz(tmask) : 32;
                        const int cand = tmask ? (lane + 64 * m0) : 0x7fffffff, best = wave_min_i(cand);
                        if (cand == best && tmask) { smask |= (1u << m0); tmask &= ~(1u << m0); }
                    }
                }
            } else { tau = 0u; smask = 0u; }
            int mine = 0;
#pragma unroll
            for (int m = 0; m < 17; ++m) mine += ((u[m] > tau) || ((smask >> m) & 1u)) ? 1 : 0;
            int incl = mine;
#pragma unroll
            for (int d = 1; d < 64; d <<= 1) { const int o = __shfl_up(incl, d); if (lane >= d) incl += o; }
            int off = incl - mine;
            const int total = __builtin_amdgcn_readlane(incl, 63);
#pragma unroll
            for (int m = 0; m < 17; ++m) { if ((u[m] > tau) || ((smask >> m) & 1u)) { ckey[wave * 256 + off] = u[m]; cidx[wave * 256 + off] = s0 + lane + 64 * m; ++off; } }
            for (int e = total + lane; e < 256; e += 64) { ckey[wave * 256 + e] = 0u; cidx[wave * 256 + e] = 0x7fffffff; }
        }
        __syncthreads();
        if (wave == 0) {
            unsigned v[32]; int ix[32];
#pragma unroll
            for (int m = 0; m < 32; ++m) { v[m] = ckey[lane + 64 * m]; ix[m] = cidx[lane + 64 * m]; }
            unsigned tau = 0u;
#pragma unroll 1
            for (int bit = 31; bit >= 0; --bit) {
                const unsigned cand = tau | (1u << bit); int c = 0;
#pragma unroll
                for (int m = 0; m < 32; ++m) c += (v[m] >= cand) ? 1 : 0;
                c = wave_sum_i(c);
                if (c >= TOPK) tau = cand;
                if (c == TOPK) break;
            }
            int cg = 0, ct = 0; unsigned tmask = 0u, smask = 0u;
#pragma unroll
            for (int m = 31; m >= 0; --m) { cg += (v[m] > tau) ? 1 : 0; const unsigned tie = (v[m] == tau) ? 1u : 0u; ct += (int)tie; tmask = (tmask << 1) | tie; }
            cg = wave_sum_i(cg); ct = wave_sum_i(ct);
            const int need = TOPK - cg;
            if (ct == need) smask = tmask;
            else {
#pragma unroll 1
                for (int it = 0; it < need; ++it) {
                    int bi = 0x7fffffff, bm = 0;
#pragma unroll
                    for (int m = 0; m < 32; ++m) { const bool t_ = (tmask >> m) & 1u; if (t_ && ix[m] < bi) { bi = ix[m]; bm = m; } }
                    const int best = wave_min_i(bi);
                    if (bi == best && bi != 0x7fffffff) { smask |= (1u << bm); tmask &= ~(1u << bm); }
                }
            }
            int mine = 0;
#pragma unroll
            for (int m = 0; m < 32; ++m) mine += ((v[m] > tau) || ((smask >> m) & 1u)) ? 1 : 0;
            int incl = mine;
#pragma unroll
            for (int d = 1; d < 64; d <<= 1) { const int o = __shfl_up(incl, d); if (lane >= d) incl += o; }
            int off = incl - mine;
            int* sel = SEL + (size_t)row * 256;
#pragma unroll
            for (int m = 0; m < 32; ++m) { if ((v[m] > tau) || ((smask >> m) & 1u)) { if (off < TOPK) sel[off] = ix[m]; ++off; } }
            if (lane == 0) CNT[row] = TOPK;
        }
    }
    __syncthreads();
}

template <bool SAMPLE>
__device__ __forceinline__ void phase_attn(KP p, int j, LAS unsigned char* lds) {
    const int tid = TID(), lane = tid & 63, wave = tid >> 6, n16 = lane & 15, c4 = lane >> 4;
    LAS bf16_t* ps = (LAS bf16_t*)(lds + wave * 16384);
    LAS int* is = (LAS int*)(lds + wave * 16384 + 8192);
    LAS bf16_t* qs = (LAS bf16_t*)(lds + wave * 16384 + 9216);
    LAS float* invs = (LAS float*)(lds + wave * 16384 + 11264);
    const float* Q = WSP(float, WS_Q); const int* SEL = WSP(int, WS_SEL); const int* CNT = WSP(int, WS_CNT); bf16_t* O = WSP(bf16_t, WS_YG);
    const bf16_t *KBF = WSP(bf16_t, WS_KBF), *VBF = WSP(bf16_t, WS_VBF);
    const float* kc = p->cache_k + (size_t)j * 2560 * 128 * 256; const float* vc = p->cache_v + (size_t)j * 2560 * 128 * 256;
    const float* knew = p->out + O_KS + (size_t)j * NS * 256; const float* vnew = p->out + O_VS + (size_t)j * NS * 256;
    const int gw = BID() * 8 + wave, nw = gridDim.x * 8, nq = SAMPLE ? NS : NP;
    unsigned* qctr = WSP(unsigned, WS_BAR + 40960) + (size_t)j * 256;
    int qb = 0, qnext = 0, qsub = 2, qcur = 0;
    if (!SAMPLE) { unsigned v_ = 0u; if (lane == 0) v_ = __hip_atomic_fetch_add(qctr + 16 * ((BID() + qb) & 3), 2u, __ATOMIC_RELAXED, __HIP_MEMORY_SCOPE_AGENT); qnext = (int)__builtin_amdgcn_readfirstlane(v_); }
    for (int qi = gw; SAMPLE ? (qi < nq) : true; qi += nw) {
        int row;
        if (SAMPLE) row = NP + qi;
        else {
            if (qsub == 2) {
                for (;;) {
                    qcur = qnext; qsub = 0;
                    if (qcur < 4096 || qb == 3) break;
                    ++qb; unsigned v_ = 0u; if (lane == 0) v_ = __hip_atomic_fetch_add(qctr + 16 * ((BID() + qb) & 3), 2u, __ATOMIC_RELAXED, __HIP_MEMORY_SCOPE_AGENT); qnext = (int)__builtin_amdgcn_readfirstlane(v_);
                }
                if (qcur >= 4096) break;
                { unsigned v_ = 0u; if (lane == 0) v_ = __hip_atomic_fetch_add(qctr + 16 * ((BID() + qb) & 3), 2u, __ATOMIC_RELAXED, __HIP_MEMORY_SCOPE_AGENT); qnext = (int)__builtin_amdgcn_readfirstlane(v_); }
            }
            row = ((BID() + qb) & 3) * 4096 + (4095 - (qcur + qsub)); ++qsub;
        }
        const int n = CNT[row];
        wave_lds_fence();
#pragma unroll
        for (int c = 0; c < 4; ++c) { const int slot = lane + 64 * c;
            int s = SEL[(size_t)row * 256 + slot]; const bool ok = slot < n;
            int r;
            if (SAMPLE) { const int bb = (row - NP) >> 3; s = ok ? s : 0; const int sp = min(max(s, 0), PAST - 1); const int pg = p->page_table[bb * 64 + (sp >> 7)];
                r = (s < PAST) ? pg * 128 + (s & 127) : (0x40000000 | (bb * 8 + min(s - PAST, 7))); }
            else r = (row & ~4095) + (ok ? s : 0);
            is[slot] = r; }
#pragma unroll
        for (int i = 0; i < 4; ++i) { const f32x4 q4 = ld_bf4((const bf16_t*)Q + (size_t)row * D + 256 * i + 4 * lane);
            if (SAMPLE) { const f32x4 q8 = q4 * 0.125f; u32x2 w; w.x = pk_bf16(q8[0], q8[1]); w.y = pk_bf16(q8[2], q8[3]); *(LAS u32x2*)(qs + 256 * i + 4 * lane) = w; }
            else *(LAS unsigned*)((LAS unsigned char*)qs + 256 * i + 4 * lane) = pk_fp8x4(q4); }
        wave_lds_fence();
        {
            float mx = -__builtin_huge_valf();
#define ATT_EMIT(t_, acc_) do { f32x4 l_ = (acc_); _Pragma("unroll") for (int r = 0; r < 4; ++r) { if (16 * (t_) + 4 * c4 + r >= n) l_[r] = -__builtin_huge_valf(); mx = fmaxf(mx, l_[r]); } \
                u32x2 w_; w_.x = pk_bf16(l_[0], l_[1]); w_.y = pk_bf16(l_[2], l_[3]); *(LAS u32x2*)(ps + n16 * 256 + 16 * (t_) + 4 * c4) = w_; } while (0)
            if (SAMPLE) {
                const u32x4 qf0 = *(const LAS u32x4*)(qs + n16 * 64 + 8 * c4), qf1 = *(const LAS u32x4*)(qs + n16 * 64 + 32 + 8 * c4);
                u32x4 bq[8];
#pragma unroll
                for (int ks = 0; ks < 8; ++ks) { const bool on = (n16 >> 2) == (ks >> 1); const u32x4 qv = (ks & 1) ? qf1 : qf0; bq[ks] = (u32x4){on ? qv.x : 0u, on ? qv.y : 0u, on ? qv.z : 0u, on ? qv.w : 0u}; }
#pragma unroll 2
                for (int t = 0; t < 16; ++t) {
                    const int r = is[16 * t + n16];
                    const float* kp = ((r & 0x40000000) ? knew + (size_t)(r & 0xffff) * 256 : kc + (size_t)r * 256) + 8 * c4;
                    f32x4 acc = {0.f, 0.f, 0.f, 0.f};
#pragma unroll
                    for (int ks = 0; ks < 8; ++ks) { const f32x4 x0 = *(const f32x4*)(kp + 32 * ks), x1 = *(const f32x4*)(kp + 32 * ks + 4);
                        const u32x4 ka = {pk_bf16(x0[0], x0[1]), pk_bf16(x0[2], x0[3]), pk_bf16(x1[0], x1[1]), pk_bf16(x1[2], x1[3])};
                        acc = __builtin_amdgcn_mfma_f32_16x16x32_bf16(__builtin_bit_cast(bf16x8, ka), __builtin_bit_cast(bf16x8, bq[ks]), acc, 0, 0, 0); }
                    ATT_EMIT(t, acc);
                }
            } else {
                const LAS unsigned char* q8 = (const LAS unsigned char*)qs;
                long bq[8];
                { const bool on = (n16 >> 2) == c4;
#pragma unroll
                  for (int h2 = 0; h2 < 4; ++h2) { const u32x4 qv = *(const LAS u32x4*)(q8 + n16 * 64 + 16 * h2);
                      const u32x2 z0 = {on ? qv.x : 0u, on ? qv.y : 0u}, z1 = {on ? qv.z : 0u, on ? qv.w : 0u}; bq[2 * h2] = __builtin_bit_cast(long, z0); bq[2 * h2 + 1] = __builtin_bit_cast(long, z1); } }
                const unsigned char* K8 = WSP(unsigned char, WS_K8);
#pragma unroll
                for (int th = 0; th < 2; ++th) {
                    if (th) asm volatile("" ::: "memory");
                    u32x4 ka[8][4];
#pragma unroll
                    for (int t8 = 0; t8 < 8; ++t8) {
                        const int r = is[16 * (8 * th + t8) + n16];
                        const unsigned char* kp = K8 + (size_t)r * 256 + 64 * c4;
#pragma unroll
                        for (int h2 = 0; h2 < 4; ++h2) ka[t8][h2] = *(const u32x4*)(kp + 16 * h2);
                    }
                    __builtin_amdgcn_sched_barrier(0);
#pragma unroll
                    for (int t8 = 0; t8 < 8; ++t8) {
                        f32x4 acc = {0.f, 0.f, 0.f, 0.f};
#pragma unroll
                        for (int h2 = 0; h2 < 4; ++h2) { const u32x2 lo = {ka[t8][h2].x, ka[t8][h2].y}, hi = {ka[t8][h2].z, ka[t8][h2].w};
                            acc = __builtin_amdgcn_mfma_f32_16x16x32_fp8_fp8(__builtin_bit_cast(long, lo), bq[2 * h2], acc, 0, 0, 0);
                            acc = __builtin_amdgcn_mfma_f32_16x16x32_fp8_fp8(__builtin_bit_cast(long, hi), bq[2 * h2 + 1], acc, 0, 0, 0); }
                        ATT_EMIT(8 * th + t8, acc * 0.125f);
                    }
                }
            }
#undef ATT_EMIT
            mx = fmaxf(mx, __shfl_xor(mx, 16)); mx = fmaxf(mx, __shfl_xor(mx, 32));
            float sm = 0.f;
            u32x2 lw_[16];
#pragma unroll
            for (int t = 0; t < 16; ++t) lw_[t] = *(const LAS u32x2*)(ps + n16 * 256 + 16 * t + 4 * c4);
#pragma unroll
            for (int t = 0; t < 16; ++t) {
                const u32x2 w = lw_[t];
                const float e0 = __expf(bflo(w.x) - mx), e1 = __expf(bfhi(w.x) - mx), e2 = __expf(bflo(w.y) - mx), e3 = __expf(bfhi(w.y) - mx);
                sm += (e0 + e1) + (e2 + e3);
                u32x2 o_; o_.x = pk_bf16(e0, e1); o_.y = pk_bf16(e2, e3); *(LAS u32x2*)(ps + n16 * 256 + 16 * t + 4 * c4) = o_;
            }
            sm += __shfl_xor(sm, 16); sm += __shfl_xor(sm, 32);
            if (c4 == 0) invs[n16] = 1.0f / sm;
        }
        wave_lds_fence();
        if (!SAMPLE) {
            const unsigned char* V8 = WSP(unsigned char, WS_V8);
            const int rs = c4, kvh = n16 >> 2, nst = n > 64 ? 64 : n;
            f32x4 oa[4][4];
#pragma unroll
            for (int g = 0; g < 4; ++g)
#pragma unroll
                for (int q = 0; q < 4; ++q) oa[g][q] = (f32x4){0.f, 0.f, 0.f, 0.f};
            u32x4 vr[8], vn[8];
#pragma unroll
            for (int i = 0; i < 8; ++i) vn[i] = *(const u32x4*)(V8 + (size_t)is[64 * rs + i] * 256 + 16 * n16);
            for (int m0 = 0; m0 < nst; m0 += 8) {
#pragma unroll
                for (int i = 0; i < 8; ++i) vr[i] = vn[i];
                if (m0 + 8 < nst) {
#pragma unroll
                    for (int i = 0; i < 8; ++i) vn[i] = *(const u32x4*)(V8 + (size_t)is[64 * rs + m0 + 8 + i] * 256 + 16 * n16);
                }
                __builtin_amdgcn_sched_barrier(0);
#pragma unroll
                for (int h4 = 0; h4 < 2; ++h4) {
                    u32x2 pg[4];
#pragma unroll
                    for (int g = 0; g < 4; ++g) pg[g] = *(const LAS u32x2*)(ps + (kvh * 4 + g) * 256 + 64 * rs + m0 + 4 * h4);
#pragma unroll
                    for (int i = 0; i < 4; ++i) {
                        const u32x4 v_ = vr[4 * h4 + i];
                        const f32x4 v0 = fp8x4_f32(v_.x), v1 = fp8x4_f32(v_.y), v2 = fp8x4_f32(v_.z), v3 = fp8x4_f32(v_.w);
#pragma unroll
                        for (int g = 0; g < 4; ++g) { const unsigned pw = (i < 2) ? pg[g].x : pg[g].y; const float pf = (i & 1) ? bfhi(pw) : bflo(pw);
                            oa[g][0] += pf * v0; oa[g][1] += pf * v1; oa[g][2] += pf * v2; oa[g][3] += pf * v3; }
                    }
                }
            }
#pragma unroll
            for (int g = 0; g < 4; ++g)
#pragma unroll
                for (int q = 0; q < 4; ++q)
#pragma unroll
                    for (int e_ = 0; e_ < 4; ++e_) { float x = oa[g][q][e_]; x += __shfl_xor(x, 16); x += __shfl_xor(x, 32); oa[g][q][e_] = x; }
            if (rs == 0) {
                const f32x4 iv = *(const LAS f32x4*)(invs + 4 * kvh);
#pragma unroll
                for (int g = 0; g < 4; ++g) { bf16_t* op = O + (size_t)row * D + (kvh * 4 + g) * 64 + 16 * (n16 & 3);
                    u32x4 w0, w1; const float sc_ = iv[g];
                    w0.x = pk_bf16(oa[g][0][0] * sc_, oa[g][0][1] * sc_); w0.y = pk_bf16(oa[g][0][2] * sc_, oa[g][0][3] * sc_); w0.z = pk_bf16(oa[g][1][0] * sc_, oa[g][1][1] * sc_); w0.w = pk_bf16(oa[g][1][2] * sc_, oa[g][1][3] * sc_);
                    w1.x = pk_bf16(oa[g][2][0] * sc_, oa[g][2][1] * sc_); w1.y = pk_bf16(oa[g][2][2] * sc_, oa[g][2][3] * sc_); w1.z = pk_bf16(oa[g][3][0] * sc_, oa[g][3][1] * sc_); w1.w = pk_bf16(oa[g][3][2] * sc_, oa[g][3][3] * sc_);
                    *(u32x4*)op = w0; *(u32x4*)(op + 8) = w1; }
            }
        } else {
        f32x4 o0 = {0.f, 0.f, 0.f, 0.f}, o1 = o0, o2 = o0, o3 = o0;
        constexpr int GV = SAMPLE ? 16 : 32;
        const int ng = (n + GV - 1) / GV;
        unsigned vb[SAMPLE ? 1 : GV], vbn[SAMPLE ? 1 : GV]; f32x4 vf[SAMPLE ? GV : 1];
        const unsigned char* V8 = WSP(unsigned char, WS_V8);
        if (!SAMPLE) {
#pragma unroll
            for (int i = 0; i < GV; ++i) vbn[i] = *(const unsigned*)(V8 + (size_t)is[i] * 256 + 4 * lane);
        }
#pragma unroll 1
        for (int g = 0; g < ng; ++g) {
            if (!SAMPLE) {
#pragma unroll
                for (int i = 0; i < GV; ++i) vb[i] = vbn[i];
                if (g + 1 < ng) {
#pragma unroll
                    for (int i = 0; i < GV; ++i) vbn[i] = *(const unsigned*)(V8 + (size_t)is[GV * (g + 1) + i] * 256 + 4 * lane);
                }
                __builtin_amdgcn_sched_barrier(0);
            } else {
#pragma unroll
                for (int i = 0; i < GV; ++i) { const int r = is[GV * g + i]; vf[i] = *(const f32x4*)(((r & 0x40000000) ? vnew + (size_t)(r & 0xffff) * 256 : vc + (size_t)r * 256) + 4 * lane); }
            }
#pragma unroll
            for (int i4 = 0; i4 < GV / 4; ++i4) {
                const u32x2 p0 = *(const LAS u32x2*)(ps + (c4 * 4 + 0) * 256 + GV * g + 4 * i4), p1 = *(const LAS u32x2*)(ps + (c4 * 4 + 1) * 256 + GV * g + 4 * i4),
                            p2 = *(const LAS u32x2*)(ps + (c4 * 4 + 2) * 256 + GV * g + 4 * i4), p3 = *(const LAS u32x2*)(ps + (c4 * 4 + 3) * 256 + GV * g + 4 * i4);
                f32x4 v0, v1, v2, v3;
                if (!SAMPLE) { v0 = fp8x4_f32(vb[4 * i4]); v1 = fp8x4_f32(vb[4 * i4 + 1]); v2 = fp8x4_f32(vb[4 * i4 + 2]); v3 = fp8x4_f32(vb[4 * i4 + 3]); }
                else { v0 = vf[4 * i4]; v1 = vf[4 * i4 + 1]; v2 = vf[4 * i4 + 2]; v3 = vf[4 * i4 + 3]; }
                o0 += bflo(p0.x) * v0 + bfhi(p0.x) * v1 + bflo(p0.y) * v2 + bfhi(p0.y) * v3;
                o1 += bflo(p1.x) * v0 + bfhi(p1.x) * v1 + bflo(p1.y) * v2 + bfhi(p1.y) * v3;
                o2 += bflo(p2.x) * v0 + bfhi(p2.x) * v1 + bflo(p2.y) * v2 + bfhi(p2.y) * v3;
                o3 += bflo(p3.x) * v0 + bfhi(p3.x) * v1 + bflo(p3.y) * v2 + bfhi(p3.y) * v3;
            }
        }
        { const f32x4 iv = *(const LAS f32x4*)(invs + 4 * c4); bf16_t* op = O + (size_t)row * D + c4 * 256 + 4 * n16; st_bf4(op, o0 * iv[0]); st_bf4(op + 64, o1 * iv[1]); st_bf4(op + 128, o2 * iv[2]); st_bf4(op + 192, o3 * iv[3]); }
        }
    }
}

__global__ void __launch_bounds__(512, 2) mega(P p_unused) {
    extern __shared__ __attribute__((aligned(16))) unsigned char lds_raw[];
    LAS unsigned char* lds = (LAS unsigned char*)lds_raw;
    volatile LAS unsigned* misc = (volatile LAS unsigned*)(lds + LDS_MISC);
    if (TID() < 4) misc[TID()] = 0u;
    __syncthreads();
    KP p = kargs();
    const bool multi = (p->ph_hi - p->ph_lo) > 1;
    XcdBarrier bar; bar.bar = WSP(unsigned, WS_BAR); bar.x = 0; bar.st = misc;
    if (multi) bar = xcd_barrier_post(WSP(unsigned, WS_BAR), misc);
    int ph = 0;
    const int lo = p->ph_lo, hi = p->ph_hi;
#ifndef REPMASK
#define REPMASK 0ull
#endif
#define PH_BEGIN if (ph >= lo && ph < hi) { KP p = kargs(); const int nrep_ = ((REPMASK >> ph) & 1ull) ? 3 : 1; for (int rep_ = 0; rep_ < nrep_; ++rep_) {
#define PH_END   if (ph + 1 < hi || rep_ + 1 < nrep_) xcd_barrier(bar); } } ++ph;

    PH_BEGIN phase_ada(p, lds); phase_weights(p, lds); phase_rope_table(p); PH_END

    for (int layer = 0; layer < 4; ++layer) {
        const int j = layer >> 1;
        if ((layer & 1) == 0) {
            PH_BEGIN phase_prep<true>(p, layer, 0, j, layer == 0); PH_END
            PH_BEGIN {
                FRwkvIn f{WSP(bf16_t, WS_RB), WSP(bf16_t, WS_KB), WSP(bf16_t, WS_VB), WSP(bf16_t, WS_TW), WSP(bf16_t, WS_TA), WSP(bf16_t, WS_TV), WSP(bf16_t, WS_TG)};
                pg8::Gemm g{WSP(bf16_t, WS_XR), WSP(bf16_t, WS_WRW_T) + (size_t)j * 4096 * D, NP, j == 0 ? 3840 : 4096, D, j == 0 ? 2 : 1, XR_STRIDE};
                pg8::StaticOrder S; S.init(NP, g.N, (int)gridDim.x, BID());
                pg8::EpiAdapt<FRwkvIn, true> E{f};
                pg8::gemm_phase(lds, g, S, E);
                wgemm_ks<true>(lds, WSP(bf16_t, WS_XR), D, XR_STRIDE, NP, NS, WSP(bf16_t, WS_WRW_T) + (size_t)j * 4096 * D, D, 4096, f, ((NP / 256) * (g.N / 256)) % (int)gridDim.x);
            } PH_END
            PH_BEGIN {
                FStoreF32 fw{WSP(float, WS_WP), D, D}, fa{WSP(float, WS_AP), D, D}, fv{WSP(float, WS_VP), D, D}, fg{WSP(float, WS_GG), D, D};
                wgemm_w(WSP(bf16_t, WS_TW), 64, NP, NS, WSP(bf16_t, WS_W2T) + (size_t)j * D * 64, 64, D, fw);
                wgemm_w(WSP(bf16_t, WS_TA), 64, NP, NS, WSP(bf16_t, WS_A2T) + (size_t)j * D * 64, 64, D, fa);
                if (j == 1) wgemm_w(WSP(bf16_t, WS_TV), 32, NP, NS, WSP(bf16_t, WS_V2T), 32, D, fv);
                wgemm_w(WSP(bf16_t, WS_TG), 160, NP, NS, WSP(bf16_t, WS_G2T) + (size_t)j * D * 160, 160, D, fg);
                phase_chunk(p, j, lds);
            } PH_END
            PH_BEGIN phase_carry(p, j, lds); PH_END
            PH_BEGIN phase_post2(p, j, lds); PH_END
        } else {
            PH_BEGIN phase_prep<false>(p, layer, 0, j); PH_END
            PH_BEGIN {
                FStoreBf16 f{WSP(bf16_t, WS_PR), PINP, PINP};
                pg8::Gemm g{WSP(bf16_t, WS_XR), WSP(bf16_t, WS_WIN_T) + (size_t)j * PINP * D, NP, PINP, D, 0, 0};
                pg8::StaticOrder S; S.init(NP, PINP, (int)gridDim.x, BID());
                pg8::EpiAdapt<FStoreBf16, true> E{f};
                pg8::gemm_phase(lds, g, S, E);
                FStoreBf16 fs{WSP(bf16_t, WS_PR), PINP, PIN};
                wgemm_ks<false>(lds, WSP(bf16_t, WS_XR), D, 0, NP, NS, WSP(bf16_t, WS_WIN_T) + (size_t)j * PINP * D, D, PINP, fs, ((NP / 256) * (PINP / 256)) % (int)gridDim.x);
            } PH_END
            PH_BEGIN phase_dsapost(p, j); PH_END
            PH_BEGIN phase_idx2<false>(p, j); phase_idx2<true>(p, j); PH_END
            PH_BEGIN phase_topk_prompt(p); phase_topk_sample(p, lds); PH_END
            PH_BEGIN phase_attn<true>(p, j, lds); phase_attn<false>(p, j, lds); PH_END
        }
        PH_BEGIN {
            FResid f{p->out, WSP(float, WS_MODS) + (size_t)layer * 36 * 6144 + 2 * D, layer == 0 ? p->x_prompt : nullptr, layer == 0 ? p->x_sample : nullptr};
            const bf16_t* Wt = ((layer & 1) == 0 ? WSP(bf16_t, WS_WO_T) : WSP(bf16_t, WS_WAO_T)) + (size_t)j * D * D;
            pg8::Gemm g{WSP(bf16_t, WS_YG), Wt, NP, D, D, 0, 0};
            pg8::StaticOrder S; S.init(NP, D, (int)gridDim.x, BID());
            pg8::EpiAdapt<FResid, false> E{f};
            pg8::gemm_phase(lds, g, S, E);
            wgemm_ks<false>(lds, WSP(bf16_t, WS_YG), D, 0, NP, NS, Wt, D, D, f);
        } PH_END
        PH_BEGIN phase_prep<false>(p, layer, 1, j); PH_END
        PH_BEGIN {
            FRelu2 f{WSP(bf16_t, WS_U)};
            pg8::Gemm g{WSP(bf16_t, WS_XR), WSP(bf16_t, WS_WUP_T) + (size_t)layer * DFF * D, NP, DFF, D, 0, 0};
            pg8::StaticOrder S; S.init(NP, DFF, (int)gridDim.x, BID());
            pg8::EpiAdapt<FRelu2, true> E{f};
            pg8::gemm_phase(lds, g, S, E);
            wgemm_ks<false>(lds, WSP(bf16_t, WS_XR), D, 0, NP, NS, WSP(bf16_t, WS_WUP_T) + (size_t)layer * DFF * D, D, DFF, f);
        } PH_END
        PH_BEGIN {
            FResid f{p->out, WSP(float, WS_MODS) + (size_t)layer * 36 * 6144 + 5 * D, nullptr, nullptr};
            pg8::Gemm g{WSP(bf16_t, WS_U), WSP(bf16_t, WS_WDN_T) + (size_t)layer * DFF * D, NP, D, DFF, 0, 0};
            pg8::StaticOrder S; S.init(NP, D, (int)gridDim.x, BID());
            pg8::EpiAdapt<FResid, false> E{f};
            pg8::gemm_phase(lds, g, S, E);
            wgemm_ks<false>(lds, WSP(bf16_t, WS_U), DFF, 0, NP, NS, WSP(bf16_t, WS_WDN_T) + (size_t)layer * DFF * D, DFF, D, f);
        } PH_END
    }
#undef PH_BEGIN
#undef PH_END
}

static int count_phases() { int n = 1; for (int layer = 0; layer < 4; ++layer) { n += ((layer & 1) == 0) ? 5 : 6; n += 4; } return n; }

extern "C" void kernel_launch(void* const* d_in, const int* in_sizes, int n_in, void* d_out, int out_size, void* d_ws, size_t ws_size, hipStream_t stream) {
    static int grid = 0;
    if (grid == 0) {
        if (n_in != 39 || out_size != (int)O_END || ws_size < WS_END) { fprintf(stderr, "kernel_launch: unexpected shapes n_in %d out %d ws %zu (need %zu)\n", n_in, out_size, ws_size, (size_t)WS_END); grid = -1; return; }
        int dev = 0, cus = 0, per_cu = 0;
        if (hipGetDevice(&dev) != hipSuccess || hipDeviceGetAttribute(&cus, hipDeviceAttributeMultiprocessorCount, dev) != hipSuccess) { grid = -1; return; }
        if (hipFuncSetAttribute((const void*)mega, hipFuncAttributeMaxDynamicSharedMemorySize, LDS_BYTES) != hipSuccess) { fprintf(stderr, "kernel_launch: hipFuncSetAttribute failed\n"); grid = -1; return; }
        if (hipOccupancyMaxActiveBlocksPerMultiprocessor(&per_cu, (const void*)mega, 512, LDS_BYTES) != hipSuccess || per_cu < 1) fprintf(stderr, "kernel_launch: occupancy query says %d\n", per_cu);
        (void)hipGetLastError();
        grid = cus;
    }
    if (grid < 0) return;
    (void)hipMemsetAsync((char*)d_ws + WS_BAR, 0, 65536, stream);
    P p{};
    memcpy((void*)&p, (const void*)d_in, 39 * sizeof(void*));
    p.out = (float*)d_out; p.ws = (unsigned char*)d_ws;
#ifndef STOP_PH
#define STOP_PH 1000
#endif
    const int nph = count_phases() < STOP_PH ? count_phases() : STOP_PH;
#ifndef ONE_LAUNCH
    for (int ph = 0; ph < nph; ++ph) { p.ph_lo = ph; p.ph_hi = ph + 1; hipLaunchKernelGGL(mega, dim3(grid), dim3(512), LDS_BYTES, stream, p); }
#else
    p.ph_lo = 0; p.ph_hi = nph; hipLaunchKernelGGL(mega, dim3(grid), dim3(512), LDS_BYTES, stream, p);
#endif
}
```

```cpp
#define ONE_LAUNCH 1
#include <hip/hip_runtime.h>
#include <cstdio>
#include <cstdint>
#include <cstring>

#define LAS __attribute__((address_space(3)))
typedef unsigned short bf16_t;
typedef short bf16x8 __attribute__((ext_vector_type(8)));
typedef float f32x4 __attribute__((ext_vector_type(4)));
typedef float f32x2 __attribute__((ext_vector_type(2)));
typedef unsigned u32x4 __attribute__((ext_vector_type(4)));
typedef unsigned u32x2 __attribute__((ext_vector_type(2)));

constexpr int D = 1024, NP = 16384, NS = 256, NT = NP + NS, SEQL = 4096, PAST = 8192, NSEQ = 36, DFF = 4096;
constexpr int PIN = 2120, PINP = 2304;
constexpr int TOPK = 256, SCS_LD = 8320;
constexpr size_t O_YP = 0, O_YS = 16777216, O_KP = 17039360, O_VP = 25427968, O_IKP = 33816576, O_WKVP = 35913728, O_SHP = 36438016,
                 O_KS = 36446208, O_VS = 36577280, O_IKS = 36708352, O_WKVS = 36741120, O_SHS = 40935424, O_END = 41000960;
constexpr size_t al256(size_t x) { return (x + 255) & ~(size_t)255; }
constexpr size_t WS_BAR = 0;
constexpr size_t WS_MODS = 65536;
constexpr size_t WS_WUP_T = al256(WS_MODS + (size_t)4 * NSEQ * 6144 * 4);
constexpr size_t WS_WDN_T = WS_WUP_T + (size_t)4 * DFF * D * 2;
constexpr size_t WS_WRW_T = WS_WDN_T + (size_t)4 * DFF * D * 2;
constexpr size_t WS_WO_T = WS_WRW_T + (size_t)2 * 4096 * D * 2;
constexpr size_t WS_WIN_T = WS_WO_T + (size_t)2 * D * D * 2;
constexpr size_t WS_WAO_T = WS_WIN_T + (size_t)2 * PINP * D * 2;
constexpr size_t WS_W2T = WS_WAO_T + (size_t)2 * D * D * 2;
constexpr size_t WS_A2T = WS_W2T + (size_t)2 * D * 64 * 2;
constexpr size_t WS_V2T = WS_A2T + (size_t)2 * D * 64 * 2;
constexpr size_t WS_G2T = WS_V2T + (size_t)D * 32 * 2;
constexpr size_t WS_XR = WS_G2T + (size_t)2 * D * 160 * 2;
constexpr size_t XR_STRIDE = (size_t)NT * D;
constexpr size_t WS_RB = WS_XR + 6 * XR_STRIDE * 2;
constexpr size_t WS_KB = WS_RB + XR_STRIDE * 2;
constexpr size_t WS_VB = WS_KB + XR_STRIDE * 2;
constexpr size_t WS_TW = WS_VB + XR_STRIDE * 2;
constexpr size_t WS_TA = WS_TW + (size_t)NT * 64 * 2;
constexpr size_t WS_TV = WS_TA + (size_t)NT * 64 * 2;
constexpr size_t WS_TG = WS_TV + (size_t)NT * 32 * 2;
constexpr size_t WS_WP = al256(WS_TG + (size_t)NT * 160 * 2);
constexpr size_t F32A = (size_t)NT * D * 4;
constexpr size_t WS_AP = WS_WP + F32A, WS_VP = WS_AP + F32A, WS_GG = WS_VP + F32A, WS_VFIRST = WS_GG + F32A;
constexpr size_t WS_DEC = WS_VFIRST + F32A, WS_KM = WS_DEC + F32A, WS_VM = WS_KM + F32A, WS_AV = WS_VM + F32A, WS_BV = WS_AV + F32A, WS_Y = WS_BV + F32A;
constexpr size_t WS_YG = WS_Y + F32A;
constexpr size_t WS_U = WS_YG + XR_STRIDE * 2;
constexpr size_t WS_PR = WS_U + (size_t)NT * DFF * 2;
constexpr size_t WS_Q = WS_PR + (size_t)NT * PINP * 4;
constexpr size_t WS_QI = WS_Q + F32A;
constexpr size_t WS_WI = WS_QI + (size_t)NT * 512 * 4;
constexpr size_t WS_SC = al256(WS_WI + (size_t)NT * 8 * 4);
constexpr size_t WS_SCS = WS_SC + (size_t)4 * 4096 * 4096 * 4;
constexpr size_t WS_SEL = al256(WS_SCS + (size_t)NS * SCS_LD * 4);
constexpr size_t WS_CNT = WS_SEL + (size_t)NT * 256 * 4;
constexpr size_t WS_KBF = al256(WS_CNT + (size_t)NT * 4);
constexpr size_t WS_VBF = WS_KBF + (size_t)NT * 256 * 2;
constexpr size_t WS_QIB = WS_VBF + (size_t)NT * 256 * 2;
constexpr size_t WS_KIB = WS_QIB + (size_t)NT * 512 * 2;
constexpr size_t WS_K8 = al256(WS_KIB + (size_t)NT * 64 * 2);
constexpr size_t WS_V8 = WS_K8 + (size_t)NT * 256;
constexpr size_t WS_END = al256(WS_V8 + (size_t)NT * 256);
constexpr size_t WS_ROPE = WS_KBF;

constexpr int LCH = 64, NCH = SEQL / LCH;
constexpr size_t WS_PCH = WS_SC, WS_CCH = WS_PCH + (size_t)64 * NCH * 4096 * 4, WS_SST = WS_CCH + (size_t)64 * NCH * 4096 * 4;
static_assert(WS_SST + (size_t)64 * NCH * 4096 * 4 <= WS_SCS, "scan buffers must fit the aliased region");
constexpr int LDS_BYTES = 147456;
constexpr int LDS_MISC = 131072;

typedef __bf16 bf16x2_t __attribute__((ext_vector_type(2)));
__device__ __forceinline__ unsigned pk_bf16(float lo, float hi) { const f32x2 v = {lo, hi}; const bf16x2_t b = __builtin_convertvector(v, bf16x2_t); return __builtin_bit_cast(unsigned, b); }
__device__ __forceinline__ unsigned pk_fp8x4(f32x4 v) { int w = 0; w = __builtin_amdgcn_cvt_pk_fp8_f32(v[0], v[1], w, false); w = __builtin_amdgcn_cvt_pk_fp8_f32(v[2], v[3], w, true); return (unsigned)w; }
__device__ __forceinline__ f32x4 fp8x4_f32(unsigned w) { return (f32x4){__builtin_amdgcn_cvt_f32_fp8((int)w, 0), __builtin_amdgcn_cvt_f32_fp8((int)w, 1), __builtin_amdgcn_cvt_f32_fp8((int)w, 2), __builtin_amdgcn_cvt_f32_fp8((int)w, 3)}; }
__device__ __forceinline__ float bf2f(unsigned short x) { return __uint_as_float((unsigned)x << 16); }
__device__ __forceinline__ float bflo(unsigned x) { return __uint_as_float(x << 16); }
__device__ __forceinline__ float bfhi(unsigned x) { return __uint_as_float(x & 0xffff0000u); }
__device__ __forceinline__ f32x4 ld_bf4(const bf16_t* p) { const u32x2 v = *(const u32x2*)p; return (f32x4){bflo(v.x), bfhi(v.x), bflo(v.y), bfhi(v.y)}; }
__device__ __forceinline__ void st_bf4(bf16_t* p, f32x4 v) { u32x2 w; w.x = pk_bf16(v[0], v[1]); w.y = pk_bf16(v[2], v[3]); *(u32x2*)p = w; }
template <int CTRL> __device__ __forceinline__ float dppf(float v) { return __int_as_float(__builtin_amdgcn_update_dpp(0, __float_as_int(v), CTRL, 0xf, 0xf, false)); }
template <int CTRL> __device__ __forceinline__ int dppi(int v) { return __builtin_amdgcn_update_dpp(0, v, CTRL, 0xf, 0xf, false); }
__device__ __forceinline__ float g16_sum(float v) { v += dppf<0xB1>(v); v += dppf<0x4E>(v); v += dppf<0x141>(v); v += dppf<0x140>(v); return v; }
__device__ __forceinline__ float g16_max(float v) { v = fmaxf(v, dppf<0xB1>(v)); v = fmaxf(v, dppf<0x4E>(v)); v = fmaxf(v, dppf<0x141>(v)); v = fmaxf(v, dppf<0x140>(v)); return v; }
__device__ __forceinline__ int g16_sum_i(int v) { v += dppi<0xB1>(v); v += dppi<0x4E>(v); v += dppi<0x141>(v); v += dppi<0x140>(v); return v; }
__device__ __forceinline__ int g16_min_i(int v) { v = min(v, dppi<0xB1>(v)); v = min(v, dppi<0x4E>(v)); v = min(v, dppi<0x141>(v)); v = min(v, dppi<0x140>(v)); return v; }
__device__ __forceinline__ float rlf(float v, int k) { return __int_as_float(__builtin_amdgcn_readlane(__float_as_int(v), k)); }
__device__ __forceinline__ float wave_sum(float v) { v = g16_sum(v); return (rlf(v, 0) + rlf(v, 16)) + (rlf(v, 32) + rlf(v, 48)); }
__device__ __forceinline__ float wave_max(float v) { v = g16_max(v); return fmaxf(fmaxf(rlf(v, 0), rlf(v, 16)), fmaxf(rlf(v, 32), rlf(v, 48))); }
__device__ __forceinline__ int wave_sum_i(int v) { v = g16_sum_i(v); return (__builtin_amdgcn_readlane(v, 0) + __builtin_amdgcn_readlane(v, 16)) + (__builtin_amdgcn_readlane(v, 32) + __builtin_amdgcn_readlane(v, 48)); }
__device__ __forceinline__ int wave_min_i(int v) { v = g16_min_i(v); return min(min(__builtin_amdgcn_readlane(v, 0), __builtin_amdgcn_readlane(v, 16)), min(__builtin_amdgcn_readlane(v, 32), __builtin_amdgcn_readlane(v, 48))); }
__device__ __forceinline__ float sigmoidf_(float x) { return 1.0f / (1.0f + expf(-x)); }
__device__ __forceinline__ float fsig(float x) { return __builtin_amdgcn_rcpf(1.0f + __expf(-x)); }
__device__ __forceinline__ float ftanh(float x) { return 2.0f * fsig(2.0f * x) - 1.0f; }
__device__ __forceinline__ int row_seq(int row) { return row < NP ? (row >> 12) : 4 + ((row - NP) >> 3); }
__device__ __forceinline__ int row_pos(int row) { return row < NP ? (row & 4095) : PAST + ((row - NP) & 7); }
__device__ __forceinline__ int TID() { int t = threadIdx.x; asm volatile("" : "+v"(t)); return t; }
__device__ __forceinline__ int BID() { int b = blockIdx.x; asm volatile("" : "+s"(b)); return b; }
__device__ __forceinline__ void wave_lds_fence() { __builtin_amdgcn_fence(__ATOMIC_RELEASE, "wavefront"); __builtin_amdgcn_wave_barrier(); __builtin_amdgcn_fence(__ATOMIC_ACQUIRE, "wavefront"); }

#define XB_TMO      128
#define XB_XCNT(j)  (256  + 64 * (j))
#define XB_XSUB(j)  (1280 + 64 * (j))
#define XB_XGEN(j)  (2304 + 64 * (j))
#define XB_TOP      3328
#define XB_TOPGEN   3392
#define XCD_BAR_WORDS 3456
#define XB_SPIN_CAP (1u << 22)
__device__ __forceinline__ unsigned xb_ld(unsigned* p)              { return __hip_atomic_load(p, __ATOMIC_RELAXED, __HIP_MEMORY_SCOPE_AGENT); }
__device__ __forceinline__ unsigned xb_add(unsigned* p, unsigned v) { return __hip_atomic_fetch_add(p, v, __ATOMIC_RELAXED, __HIP_MEMORY_SCOPE_AGENT); }
__device__ __forceinline__ unsigned xb_xcc_id() { return (unsigned)__builtin_amdgcn_s_getreg((3 << 11) | 20) & 0xFu; }
#define XB_SPIN(cond, bar) do { unsigned _sp = 0; while (cond) { __builtin_amdgcn_s_sleep(1); \
    if ((++_sp & 255u) == 0u) { if (xb_ld(&(bar)[XB_TMO])) break; if (_sp > XB_SPIN_CAP) { atomicAdd(&(bar)[XB_TMO], 1u); break; } } } } while (0)
struct XcdBarrier { unsigned* bar; unsigned x; volatile LAS unsigned* st; };
__device__ __forceinline__ XcdBarrier xcd_barrier_post(unsigned* bar, volatile LAS unsigned* st) {
    XcdBarrier b; b.bar = bar; b.x = xb_xcc_id(); b.st = st;
    if (threadIdx.x == 0) (void)xb_add(&bar[XB_XCNT(b.x)], 1u);
    return b;
}
__device__ __forceinline__ void xcd_barrier_complete(unsigned* bar, unsigned x, unsigned& nloc, unsigned& nx) {
    const unsigned G = gridDim.x * gridDim.y * gridDim.z;
    unsigned sum, cnt, mine, sp = 0u;
    for (;;) {
        sum = 0u; cnt = 0u; mine = 0u;
#pragma unroll
        for (unsigned j = 0; j < 16; ++j) { const unsigned c = xb_ld(&bar[XB_XCNT(j)]); sum += c; cnt += (c > 0u) ? 1u : 0u; mine = (j == x) ? c : mine; }
        if (sum == G) break;
        __builtin_amdgcn_s_sleep(1);
        if ((++sp & 255u) == 0u) { if (xb_ld(&bar[XB_TMO])) break; if (sp > XB_SPIN_CAP) { atomicAdd(&bar[XB_TMO], 1u); break; } }
    }
    nloc = mine > 0u ? mine : 1u; nx = cnt > 0u ? cnt : 1u;
}
__device__ __forceinline__ void xcd_barrier(const XcdBarrier& b) {
    asm volatile("s_waitcnt vmcnt(0)" ::: "memory");
    __syncthreads();
    if (threadIdx.x == 0) {
        unsigned* bar = b.bar;
        __builtin_amdgcn_s_waitcnt(0);
        unsigned nloc = b.st[0], nx = b.st[1];
        if (nloc == 0u) { xcd_barrier_complete(bar, b.x, nloc, nx); b.st[0] = nloc; b.st[1] = nx; }
        const unsigned old = xb_add(&bar[XB_XSUB(b.x)], 1u);
        const unsigned gen = old / nloc;
        if (old + 1u == (gen + 1u) * nloc) {
            __builtin_amdgcn_fence(__ATOMIC_RELEASE, "agent");
            asm volatile("s_waitcnt vmcnt(0)" ::: "memory");
            const unsigned og = xb_add(&bar[XB_TOP], 1u);
            const unsigned tg = og / nx;
            if (og + 1u == (tg + 1u) * nx) xb_add(&bar[XB_TOPGEN], 1u);
            else XB_SPIN(xb_ld(&bar[XB_TOPGEN]) == tg, bar);
            __builtin_amdgcn_fence(__ATOMIC_ACQUIRE, "agent");
            xb_add(&bar[XB_XGEN(b.x)], 1u);
            asm volatile("s_waitcnt vmcnt(0)" ::: "memory");
        } else {
            XB_SPIN(xb_ld(&bar[XB_XGEN(b.x)]) == gen, bar);
            __builtin_amdgcn_fence(__ATOMIC_ACQUIRE, "agent");
            asm volatile("s_waitcnt vmcnt(0)" ::: "memory");
        }
    }
    __syncthreads();
}

struct P {
    const float *x_prompt, *x_sample, *cache_k, *cache_v, *cache_ik, *state_wkv, *state_shift; const int* page_table;
    const float *c_prompt, *c_sample, *norm_g, *w_ada, *b_ada, *w_up, *w_down, *rw_mix, *rw_w_rkv, *rw_w_o, *rw_w0, *rw_w1, *rw_w2, *rw_a0, *rw_a1, *rw_a2,
                *rw_v0, *rw_v1, *rw_v2, *rw_g1, *rw_g2, *rw_k_k, *rw_k_a, *rw_r_k, *rw_lnx_w, *rw_lnx_b, *att_w_in, *att_w_o, *att_q_norm, *att_k_norm, *idx_k_norm;
    float* out; unsigned char* ws; int ph_lo, ph_hi;
};
typedef const P __attribute__((address_space(4)))* KP;
#define WSP(T, off) ((T*)(p->ws + (off)))
__device__ __forceinline__ KP kargs() { KP k = (KP)__builtin_amdgcn_kernarg_segment_ptr(); asm volatile("" : "+s"(k)); return k; }

namespace pg8 {
constexpr int BM = 256, BK = 64, HALF = 128, HTB = HALF * BK * 2, STAGE_BYTES = 8 * HTB, NXCD = 8, WGM = 8;
__device__ __forceinline__ int lds_byte(int r, int c) { const int st = (r >> 4) * 2 + (c >> 5), rr = r & 15, cc = c & 31, ob = rr * 64 + cc * 2; return st * 1024 + (ob ^ (((ob >> 9) & 1) << 5)); }
__device__ __forceinline__ void stage_rc(int b, int& R, int& C) { const int st = b / 1024, sb = b % 1024, swz = sb ^ (((sb >> 9) & 1) << 5); R = (st >> 1) * 16 + swz / 64; C = (st & 1) * 32 + (swz % 64) / 2; }
__device__ __forceinline__ int perm32(int rho) { const int n = rho >> 4, i = rho & 15; return 8 * (i >> 2) + 4 * n + (i & 3); }
struct Unit { int pm, pn; };
struct Gemm { const bf16_t* A; const bf16_t* Bt; int M, N, K, mode; size_t agrp; };
__device__ __forceinline__ int phys_pn(const Gemm& g, int pn) { return (g.mode == 2 && pn >= 12) ? pn + 1 : pn; }
__device__ __forceinline__ const char* a_ptr(const Gemm& g, const Unit& u, size_t tstep) {
    int grp = 0; if (g.mode) grp = u.pn < 12 ? (u.pn >> 2) : (u.pn == 12 ? 2 : u.pn - 10);
    return (const char*)g.A + (size_t)grp * g.agrp * 2 + (size_t)u.pm * tstep; }
struct StaticOrder {
    int nM, nN, nwg, G, c;
    __device__ void init(int M, int N, int G_, int c_) { nM = M / BM; nN = N / BM; nwg = nM * nN; G = G_; c = c_; }
    __device__ bool next(int i, Unit& u) const {
        const long L = (long)i * G + c; if (L >= nwg) return false;
        int wgid = (int)L; { const int q = nwg / NXCD, r = nwg % NXCD, xcd = wgid % NXCD, off = wgid / NXCD; wgid = (xcd < r ? xcd * (q + 1) : r * (q + 1) + (xcd - r) * q) + off; }
        const int nig = WGM * nN, gid = wgid / nig, fm = gid * WGM, gsz = (nM - fm) < WGM ? (nM - fm) : WGM;
        u.pm = fm + ((wgid % nig) % gsz); u.pn = (wgid % nig) / gsz; return true;
    }
};
template <class F, bool PERM_> struct EpiAdapt {
    static constexpr bool PERM = PERM_;
    F f;
    __device__ __forceinline__ void operator()(const f32x4 (&acc)[2][2][4][2], const Unit& u, int wr, int wc, int fr, int fq) const {
        const int row0 = u.pm * BM + wr * 64 + fr, col0 = u.pn * BM + wc * 32 + (PERM ? 8 * fq : 4 * fq);
#pragma unroll
        for (int ai = 0; ai < 2; ++ai)
#pragma unroll
            for (int m = 0; m < 4; ++m)
#pragma unroll
                for (int bj = 0; bj < 2; ++bj) {
                    if constexpr (PERM) f.vec8(row0 + ai * HALF + m * 16, col0 + bj * HALF, acc[ai][bj][m][0], acc[ai][bj][m][1]);
                    else {
#pragma unroll
                        for (int n = 0; n < 2; ++n) f.vec4(row0 + ai * HALF + m * 16, col0 + bj * HALF + 16 * n, acc[ai][bj][m][n]);
                    }
                }
    }
};

template <class Epi>
__device__ __forceinline__ void gemm_phase(LAS unsigned char* lds, const Gemm g, const StaticOrder& S, const Epi& E) {
    const int tid = TID(), wid = __builtin_amdgcn_readfirstlane(tid >> 6), lane = tid & 63, wr = wid >> 2, wc = wid & 3, fr = lane & 15, fq = lane >> 4;
    const int K = g.K, nt = K / BK;
    unsigned voffA[2], voffB[2];
#pragma unroll
    for (int i = 0; i < 2; ++i) { int R, C; stage_rc(tid * 16 + i * 8192, R, C); const int Rb = Epi::PERM ? ((R & ~31) + perm32(R & 31)) : R;
        voffA[i] = (unsigned)(R * K + C) * 2u; voffB[i] = (unsigned)(Rb * K + C) * 2u; }
    const size_t kstep = (size_t)(BK * 2);
    const size_t hstep = (size_t)HALF * K * 2;
    const size_t tstep = 2 * hstep;
    const unsigned ldsw = (unsigned)wid * 1024u;
    const int aoff = lds_byte(wr * 64 + fr, fq * 8), boff = lds_byte(wc * 32 + fr, fq * 8);
#define PG8_SA(b, h) (((b) * 2 + (h)) * HTB)
#define PG8_SB(b, h) ((4 + (b) * 2 + (h)) * HTB)
#define PG8_STAGE(bufoff, gbase, voff) do { _Pragma("unroll") for (int _i = 0; _i < 2; ++_i) \
        __builtin_amdgcn_global_load_lds((const unsigned*)((const char*)(gbase) + (voff)[_i]), (LAS unsigned*)(lds + (bufoff) + ldsw + _i * 8192), 16, 0, 0); } while (0)
#define PG8_LDA(dst, b, h) do { _Pragma("unroll") for (int m = 0; m < 4; ++m) _Pragma("unroll") for (int k = 0; k < 2; ++k) dst[m][k] = *(const LAS bf16x8*)(lds + PG8_SA(b, h) + aoff + m * 2048 + k * 1024); } while (0)
#define PG8_LDB(dst, b, h) do { _Pragma("unroll") for (int n = 0; n < 2; ++n) _Pragma("unroll") for (int k = 0; k < 2; ++k) dst[n][k] = *(const LAS bf16x8*)(lds + PG8_SB(b, h) + boff + n * 2048 + k * 1024); } while (0)
#define PG8_MMA(ai, bj, At, Bt) do { __builtin_amdgcn_s_setprio(1); _Pragma("unroll") for (int m = 0; m < 4; ++m) _Pragma("unroll") for (int n = 0; n < 2; ++n) _Pragma("unroll") for (int k = 0; k < 2; ++k) \
        acc[ai][bj][m][n] = __builtin_amdgcn_mfma_f32_16x16x32_bf16(Bt[n][k], At[m][k], acc[ai][bj][m][n], 0, 0, 0); __builtin_amdgcn_s_setprio(0); } while (0)
#define PG8_WAIT_V(n) asm volatile("s_waitcnt vmcnt(" #n ")" ::: "memory")
#define PG8_WAIT_L(n) asm volatile("s_waitcnt lgkmcnt(" #n ")" ::: "memory")
#define PG8_BAR __builtin_amdgcn_s_barrier()
#define PG8_SCHED __builtin_amdgcn_sched_barrier(0)
    Unit cur, nxt; int ui = 0;
    if (!S.next(0, cur)) return;
    cur.pn = phys_pn(g, cur.pn);
    f32x4 acc[2][2][4][2];
#pragma unroll
    for (int a = 0; a < 2; ++a)
#pragma unroll
        for (int b = 0; b < 2; ++b)
#pragma unroll
            for (int m = 0; m < 4; ++m)
#pragma unroll
                for (int n = 0; n < 2; ++n) acc[a][b][m][n] = (f32x4){0.f, 0.f, 0.f, 0.f};
    bf16x8 At[4][2], B0[2][2], B1[2][2];
    const char* cA = a_ptr(g, cur, tstep); const char* cB = (const char*)g.Bt + (size_t)cur.pn * tstep;
    PG8_STAGE(PG8_SB(0, 0), cB, voffB); PG8_STAGE(PG8_SA(0, 0), cA, voffA); PG8_STAGE(PG8_SB(0, 1), cB + hstep, voffB); PG8_STAGE(PG8_SA(0, 1), cA + hstep, voffA);
    if (wr == 1) PG8_BAR;
    PG8_WAIT_V(4); PG8_BAR;
    PG8_STAGE(PG8_SB(1, 0), cB + kstep, voffB); PG8_STAGE(PG8_SA(1, 0), cA + kstep, voffA); PG8_STAGE(PG8_SB(1, 1), cB + hstep + kstep, voffB);
    PG8_WAIT_V(6); PG8_BAR;
    for (;;) {
        const bool has_next = S.next(ui + 1, nxt);
        if (has_next) nxt.pn = phys_pn(g, nxt.pn);
        const char* nA = has_next ? a_ptr(g, nxt, tstep) : cA; const char* nB = has_next ? (const char*)g.Bt + (size_t)nxt.pn * tstep : cB;
        for (int t = 0; t < nt; t += 2) {
            const bool last = (t == nt - 2);
            const char* a1 = cA + (size_t)(t + 1) * kstep;
            const char* a2 = last ? nA : cA + (size_t)(t + 2) * kstep; const char* b2 = last ? nB : cB + (size_t)(t + 2) * kstep;
            const char* a3 = a2 + kstep; const char* b3 = b2 + kstep;
            PG8_LDB(B0, 0, 0); PG8_SCHED; PG8_LDA(At, 0, 0); PG8_STAGE(PG8_SA(1, 1), a1 + hstep, voffA);
            PG8_WAIT_L(8); PG8_BAR; PG8_WAIT_L(0); PG8_MMA(0, 0, At, B0); PG8_BAR; PG8_SCHED;
            PG8_LDB(B1, 0, 1); PG8_STAGE(PG8_SB(0, 0), b2, voffB);
            PG8_BAR; PG8_WAIT_L(0); PG8_MMA(0, 1, At, B1); PG8_BAR;
            PG8_LDA(At, 0, 1); PG8_STAGE(PG8_SA(0, 0), a2, voffA);
            PG8_BAR; PG8_WAIT_L(0); PG8_MMA(1, 0, At, B0); PG8_BAR; PG8_SCHED;
            PG8_STAGE(PG8_SB(0, 1), b2 + hstep, voffB);
            PG8_WAIT_V(6); PG8_BAR; PG8_MMA(1, 1, At, B1); PG8_BAR;
            PG8_LDB(B0, 1, 0); PG8_SCHED; PG8_LDA(At, 1, 0); PG8_STAGE(PG8_SA(0, 1), a2 + hstep, voffA);
            PG8_WAIT_L(8); PG8_BAR; PG8_WAIT_L(0); PG8_MMA(0, 0, At, B0); PG8_BAR; PG8_SCHED;
            PG8_LDB(B1, 1, 1); PG8_STAGE(PG8_SB(1, 0), b3, voffB);
            PG8_BAR; PG8_WAIT_L(0); PG8_MMA(0, 1, At, B1); PG8_BAR;
            PG8_LDA(At, 1, 1); PG8_STAGE(PG8_SA(1, 0), a3, voffA);
            PG8_BAR; PG8_WAIT_L(0); PG8_MMA(1, 0, At, B0); PG8_BAR; PG8_SCHED;
            PG8_STAGE(PG8_SB(1, 1), b3 + hstep, voffB);
            PG8_WAIT_V(6); PG8_BAR; PG8_MMA(1, 1, At, B1); PG8_BAR;
        }
        E(acc, cur, wr, wc, fr, fq);
        if (!has_next) break;
#pragma unroll
        for (int a = 0; a < 2; ++a)
#pragma unroll
            for (int b = 0; b < 2; ++b)
#pragma unroll
                for (int m = 0; m < 4; ++m)
#pragma unroll
                    for (int n = 0; n < 2; ++n) acc[a][b][m][n] = (f32x4){0.f, 0.f, 0.f, 0.f};
        cur = nxt; cA = nA; cB = nB; ++ui;
    }
    PG8_WAIT_V(0);
    if (wr == 0) PG8_BAR;
    PG8_BAR;
#undef PG8_SA
#undef PG8_SB
#undef PG8_STAGE
#undef PG8_LDA
#undef PG8_LDB
#undef PG8_MMA
#undef PG8_WAIT_V
#undef PG8_WAIT_L
#undef PG8_BAR
#undef PG8_SCHED
}
}

template <class F>
__device__ __forceinline__ void sgemm_bf(LAS unsigned char* lds, const bf16_t* A, int lda, int row0, int M, const float* W, int ldw, int N, int K, int coloff, const F& f) {
    LAS float* As = (LAS float*)lds;
    LAS float* Ws = (LAS float*)(lds + 32 * 68 * 4);
    const int tid = TID(), ty = tid >> 4, tx = tid & 15;
    const int ntn = (N + 63) / 64, ntiles = (M / 64) * ntn;
    for (int tile = BID(); tile < ntiles; tile += gridDim.x) {
        const int tm = tile / ntn, tn = tile % ntn, r0 = row0 + tm * 64, n0 = tn * 64;
        f32x4 c0 = {0.f, 0.f, 0.f, 0.f}, c1 = {0.f, 0.f, 0.f, 0.f};
        for (int k0 = 0; k0 < K; k0 += 32) {
            __syncthreads();
            { const int r = tid >> 3, q = tid & 7; const f32x4 a = ld_bf4(A + (size_t)(r0 + r) * lda + k0 + 4 * q);
              As[(4 * q + 0) * 68 + r] = a[0]; As[(4 * q + 1) * 68 + r] = a[1]; As[(4 * q + 2) * 68 + r] = a[2]; As[(4 * q + 3) * 68 + r] = a[3]; }
            { const int kr = tid >> 4, c = tid & 15; f32x4 w = {0.f, 0.f, 0.f, 0.f}; if (n0 + 4 * c < N) w = *(const f32x4*)(W + (size_t)(k0 + kr) * ldw + n0 + 4 * c);
              *(LAS f32x4*)(Ws + kr * 68 + 4 * c) = w; }
            __syncthreads();
#pragma unroll 8
            for (int kk = 0; kk < 32; ++kk) {
                const f32x2 a = *(const LAS f32x2*)(As + kk * 68 + 2 * ty); const f32x4 b = *(const LAS f32x4*)(Ws + kk * 68 + 4 * tx);
                c0 += a.x * b; c1 += a.y * b;
            }
        }
        if (n0 + 4 * tx < N) { f.vec4(r0 + 2 * ty, n0 + 4 * tx + coloff, c0); f.vec4(r0 + 2 * ty + 1, n0 + 4 * tx + coloff, c1); }
    }
    __syncthreads();
}

typedef float f32x16 __attribute__((ext_vector_type(16)));
__device__ __forceinline__ int rw_group(int n0) { const int t = n0 >> 8; return t < 12 ? (t >> 2) : (t == 12 ? 2 : t - 10); }
template <bool RWGRP, class F>
__device__ __forceinline__ void wgemm_ks(LAS unsigned char* lds, const bf16_t* A, int lda, size_t agrp, int row0, int M, const bf16_t* Bt, int K, int N, const F& f, int wg0 = 0) {
    const int tid = TID(), wave = tid >> 6, lane = tid & 63, lr = lane & 31, lh = lane >> 5;
    LAS float* red = (LAS float*)lds;
    const int ntn = N / 64, nitems = (M / 32) * ntn, kw = K / 8, steps = kw / 16;
    const int vb_ = BID() - wg0, nwg_ = (int)gridDim.x - wg0;
    for (int item = vb_ < 0 ? nitems : vb_; item < nitems; item += nwg_) {
        const int tm = item / ntn, tn = item % ntn, r0 = row0 + tm * 32, n0 = tn * 64;
        const bf16_t* Ab = A + (RWGRP ? (size_t)rw_group(n0) * agrp : 0) + (size_t)(r0 + lr) * lda + wave * kw + lh * 8;
        const bf16_t* B0 = Bt + (size_t)(n0 + lr) * K + wave * kw + lh * 8; const bf16_t* B1 = B0 + (size_t)32 * K;
        f32x16 acc0, acc1;
#pragma unroll
        for (int r = 0; r < 16; ++r) { acc0[r] = 0.f; acc1[r] = 0.f; }
#pragma unroll 8
        for (int st = 0; st < steps; ++st) {
            const bf16x8 a = *(const bf16x8*)(Ab + 16 * st), b0 = *(const bf16x8*)(B0 + 16 * st), b1 = *(const bf16x8*)(B1 + 16 * st);
            acc0 = __builtin_amdgcn_mfma_f32_32x32x16_bf16(b0, a, acc0, 0, 0, 0);
            acc1 = __builtin_amdgcn_mfma_f32_32x32x16_bf16(b1, a, acc1, 0, 0, 0);
        }
        __syncthreads();
#pragma unroll
        for (int r = 0; r < 16; ++r) { red[((wave * 2 + 0) * 16 + r) * 64 + lane] = acc0[r]; red[((wave * 2 + 1) * 16 + r) * 64 + lane] = acc1[r]; }
        __syncthreads();
        { const int t = tid >> 8, r4 = (tid >> 6) & 3, l2 = tid & 63; f32x4 v = {0.f, 0.f, 0.f, 0.f};
#pragma unroll
          for (int w = 0; w < 8; ++w)
#pragma unroll
              for (int e = 0; e < 4; ++e) v[e] += red[((w * 2 + t) * 16 + 4 * r4 + e) * 64 + l2];
          f.vec4(r0 + (l2 & 31), n0 + 32 * t + 8 * r4 + 4 * (l2 >> 5), v); }
    }
    __syncthreads();
}
template <int K, class F>
__device__ __forceinline__ void wgemm_w(const bf16_t* A, int lda, int row0, int M, const bf16_t* Bt, int N, const F& f, int wsel) {
    const int lane = TID() & 63, lr = lane & 31, lh = lane >> 5;
    const int ntn = N / 64, nitems = (M / 32) * ntn; constexpr int steps = K / 16;
    if ((TID() >> 6) == wsel)
    for (int item = BID(); item < nitems; item += gridDim.x) {
        const int tm = item / ntn, tn = item % ntn, r0 = row0 + tm * 32, n0 = tn * 64;
        const bf16_t* Ab = A + (size_t)(r0 + lr) * lda + lh * 8;
        const bf16_t* B0 = Bt + (size_t)(n0 + lr) * K + lh * 8; const bf16_t* B1 = B0 + (size_t)32 * K;
        f32x16 acc0, acc1;
#pragma unroll
        for (int r = 0; r < 16; ++r) { acc0[r] = 0.f; acc1[r] = 0.f; }
#pragma unroll
        for (int st = 0; st < steps; ++st) {
            const bf16x8 a = *(const bf16x8*)(Ab + 16 * st), b0 = *(const bf16x8*)(B0 + 16 * st), b1 = *(const bf16x8*)(B1 + 16 * st);
            acc0 = __builtin_amdgcn_mfma_f32_32x32x16_bf16(b0, a, acc0, 0, 0, 0);
            acc1 = __builtin_amdgcn_mfma_f32_32x32x16_bf16(b1, a, acc1, 0, 0, 0);
        }
#pragma unroll
        for (int r4 = 0; r4 < 4; ++r4) {
            f.vec4(r0 + lr, n0 + 8 * r4 + 4 * lh, (f32x4){acc0[4 * r4], acc0[4 * r4 + 1], acc0[4 * r4 + 2], acc0[4 * r4 + 3]});
            f.vec4(r0 + lr, n0 + 32 + 8 * r4 + 4 * lh, (f32x4){acc1[4 * r4], acc1[4 * r4 + 1], acc1[4 * r4 + 2], acc1[4 * r4 + 3]});
        }
    }
}

struct FRwkvIn {
    bf16_t *rb, *kb, *vb, *tw, *ta, *tv, *tg;
    __device__ __forceinline__ void vec8(int row, int col, f32x4 a, f32x4 b) const {
        if (col < 3072) { u32x4 w; w.x = pk_bf16(a[0], a[1]); w.y = pk_bf16(a[2], a[3]); w.z = pk_bf16(b[0], b[1]); w.w = pk_bf16(b[2], b[3]);
            *(u32x4*)(rb + (size_t)(col >> 10) * XR_STRIDE + (size_t)row * D + (col & 1023)) = w; }
        else { vec4(row, col, a); vec4(row, col + 4, b); } }
    __device__ __forceinline__ void vec4(int row, int col, f32x4 v) const {
        if (col < 3072) { st_bf4(rb + (size_t)(col >> 10) * XR_STRIDE + (size_t)row * D + (col & 1023), v); }
        else if (col < 3328) { const int c = col - 3072; if (c < 32) st_bf4(tv + (size_t)row * 32 + c, v); }
        else if (col < 3584) { const int c = col - 3328; if (c < 64) { f32x4 t = {ftanh(v[0]), ftanh(v[1]), ftanh(v[2]), ftanh(v[3])}; st_bf4(tw + (size_t)row * 64 + c, t); } }
        else if (col < 3840) { const int c = col - 3584; if (c < 64) st_bf4(ta + (size_t)row * 64 + c, v); }
        else { const int c = col - 3840; if (c < 160) { f32x4 t = {fsig(v[0]), fsig(v[1]), fsig(v[2]), fsig(v[3])}; st_bf4(tg + (size_t)row * 160 + c, t); } }
    }
};
struct FStoreF32 { float* C; int ldc; int ncols; __device__ __forceinline__ void vec4(int row, int col, f32x4 v) const { if (col < ncols) *(f32x4*)(C + (size_t)row * ldc + col) = v; } };
struct FStoreBf16 { bf16_t* C; int ldc; int ncols;
    __device__ __forceinline__ void vec4(int row, int col, f32x4 v) const { if (col < ncols) st_bf4(C + (size_t)row * ldc + col, v); }
    __device__ __forceinline__ void vec8(int row, int col, f32x4 a, f32x4 b) const { if (col < ncols) { u32x4 w; w.x = pk_bf16(a[0], a[1]); w.y = pk_bf16(a[2], a[3]); w.z = pk_bf16(b[0], b[1]); w.w = pk_bf16(b[2], b[3]); *(u32x4*)(C + (size_t)row * ldc + col) = w; } } };
struct FResid {
    float* X; const float* gate;
    const float* xin_p; const float* xin_s;
    __device__ __forceinline__ void vec4(int row, int col, f32x4 v) const {
        const f32x4 g = *(const f32x4*)(gate + (size_t)row_seq(row) * 6144 + col); float* xp = X + (size_t)row * D + col;
        const float* ip = xin_p ? (row < NP ? xin_p + (size_t)row * D + col : xin_s + (size_t)(row - NP) * D + col) : xp;
        const f32x4 x = *(const f32x4*)ip; *(f32x4*)xp = x + g * v; }
};
struct FRelu2 { bf16_t* U;
    __device__ __forceinline__ void vec8(int row, int col, f32x4 a, f32x4 b) const {
        f32x4 s, t; for (int e = 0; e < 4; ++e) { const float x = fmaxf(a[e], 0.f), y = fmaxf(b[e], 0.f); s[e] = x * x; t[e] = y * y; }
        u32x4 w; w.x = pk_bf16(s[0], s[1]); w.y = pk_bf16(s[2], s[3]); w.z = pk_bf16(t[0], t[1]); w.w = pk_bf16(t[2], t[3]); *(u32x4*)(U + (size_t)row * DFF + col) = w; }
    __device__ __forceinline__ void vec4(int row, int col, f32x4 v) const {
        f32x4 t; for (int e = 0; e < 4; ++e) { const float r = fmaxf(v[e], 0.f); t[e] = r * r; } st_bf4(U + (size_t)row * DFF + col, t); } };

__device__ __forceinline__ void phase_copy_x(KP p) {
    const size_t n4p = (size_t)NP * D / 4, n4 = (size_t)NT * D / 4;
    for (size_t i = (size_t)BID() * 512 + TID(); i < n4; i += (size_t)gridDim.x * 512)
        ((f32x4*)p->out)[i] = i < n4p ? ((const f32x4*)p->x_prompt)[i] : ((const f32x4*)p->x_sample)[i - n4p];
}

struct TJob { const float* src; bf16_t* dst; int K, N, drow0; };
__device__ __forceinline__ TJob tjob(KP p, int i) {
    TJob t; t.drow0 = 0;
    if (i < 4) { t.src = p->w_up + (size_t)i * D * DFF; t.dst = WSP(bf16_t, WS_WUP_T) + (size_t)i * DFF * D; t.K = D; t.N = DFF; return t; }
    if (i < 8) { const int l = i - 4; t.src = p->w_down + (size_t)l * DFF * D; t.dst = WSP(bf16_t, WS_WDN_T) + (size_t)l * DFF * D; t.K = DFF; t.N = D; return t; }
    i -= 8; const int j = i / 14, k = i % 14; bf16_t* wrw = WSP(bf16_t, WS_WRW_T) + (size_t)j * 4096 * D;
    t.K = D; t.N = D;
    switch (k) {
        case 0: case 1: case 2: t.src = p->rw_w_rkv + ((size_t)j * 3 + k) * D * D; t.dst = wrw; t.drow0 = k * 1024; break;
        case 3: t.src = p->rw_v1; t.dst = wrw; t.drow0 = 3072; t.N = j == 1 ? 32 : 0; break;
        case 4: t.src = p->rw_w1 + (size_t)j * D * 64; t.dst = wrw; t.drow0 = 3328; t.N = 64; break;
        case 5: t.src = p->rw_a1 + (size_t)j * D * 64; t.dst = wrw; t.drow0 = 3584; t.N = 64; break;
        case 6: t.src = p->rw_g1 + (size_t)j * D * 160; t.dst = wrw; t.drow0 = 3840; t.N = 160; break;
        case 7: t.src = p->rw_w_o + (size_t)j * D * D; t.dst = WSP(bf16_t, WS_WO_T) + (size_t)j * D * D; break;
        case 8: t.src = p->rw_w2 + (size_t)j * 64 * D; t.dst = WSP(bf16_t, WS_W2T) + (size_t)j * D * 64; t.K = 64; break;
        case 9: t.src = p->rw_a2 + (size_t)j * 64 * D; t.dst = WSP(bf16_t, WS_A2T) + (size_t)j * D * 64; t.K = 64; break;
        case 10: t.src = p->rw_g2 + (size_t)j * 160 * D; t.dst = WSP(bf16_t, WS_G2T) + (size_t)j * D * 160; t.K = 160; break;
        case 11: t.src = p->rw_v2; t.dst = WSP(bf16_t, WS_V2T); t.K = 32; t.N = j == 1 ? D : 0; break;
        case 12: t.src = p->att_w_in + (size_t)j * D * PIN; t.dst = WSP(bf16_t, WS_WIN_T) + (size_t)j * PINP * D; t.N = PIN; break;
        default: t.src = p->att_w_o + (size_t)j * D * D; t.dst = WSP(bf16_t, WS_WAO_T) + (size_t)j * D * D; break;
    }
    return t;
}
__device__ __forceinline__ int tjob_tiles(const TJob& t) { return ((t.K + 63) / 64) * ((t.N + 63) / 64); }
__device__ __forceinline__ void phase_weights(KP p, LAS unsigned char* lds) {
    LAS float* T = (LAS float*)lds;
    int total = 0;
    for (int i = 0; i < 36; ++i) total += tjob_tiles(tjob(p, i));
    const int ngrp = (total + 3) / 4;
    f32x4 v[4][2];
    bf16_t* dstn[4]; int Kn[4], nlim[4], klim[4];
#define WT_ISSUE(G_) do { const int tid_ = TID(), kk_ = tid_ >> 4, n4_ = (tid_ & 15) * 4; \
        int i_ = 0, start_ = 0, cnt_ = tjob_tiles(tjob(p, 0)); \
        _Pragma("unroll") for (int u = 0; u < 4; ++u) { const int gt_ = 4 * (G_) + u; \
            while (i_ < 35 && gt_ >= start_ + cnt_) { start_ += cnt_; ++i_; cnt_ = tjob_tiles(tjob(p, i_)); } \
            const TJob tj_ = tjob(p, i_); const int lt_ = gt_ - start_, nkt_ = (tj_.K + 63) / 64; \
            const bool dead_ = gt_ >= total || lt_ >= cnt_; const int k0_ = dead_ ? 0 : (lt_ % nkt_) * 64, n0_ = dead_ ? 0 : (lt_ / nkt_) * 64; \
            dstn[u] = tj_.dst + (size_t)(tj_.drow0 + n0_) * tj_.K + k0_; Kn[u] = tj_.K; nlim[u] = dead_ ? 0 : tj_.N - n0_; klim[u] = dead_ ? 0 : tj_.K - k0_; \
            _Pragma("unroll") for (int hh = 0; hh < 2; ++hh) { const int k_ = k0_ + kk_ + 32 * hh, n_ = n0_ + n4_; \
                v[u][hh] = *(const f32x4*)(tj_.src + (size_t)min(k_, tj_.K - 1) * tj_.N + min(n_, tj_.N - 4)); } } } while (0)
    if (BID() < ngrp) WT_ISSUE(BID());
    for (int g = BID(); g < ngrp; g += gridDim.x) {
        const int tid = TID(), kk = tid >> 4, n4 = (tid & 15) * 4;
#pragma unroll
        for (int u = 0; u < 4; ++u)
#pragma unroll
            for (int hh = 0; hh < 2; ++hh)
#pragma unroll
                for (int e = 0; e < 4; ++e) T[(u * 64 + kk + 32 * hh) * 65 + n4 + e] = v[u][hh][e];
        bf16_t* dstc[4]; int Kc[4], nl[4], kl[4];
#pragma unroll
        for (int u = 0; u < 4; ++u) { dstc[u] = dstn[u]; Kc[u] = Kn[u]; nl[u] = nlim[u]; kl[u] = klim[u]; }
        if (g + (int)gridDim.x < ngrp) WT_ISSUE(g + (int)gridDim.x);
        asm volatile("s_waitcnt lgkmcnt(0)" ::: "memory"); __builtin_amdgcn_s_barrier(); asm volatile("" ::: "memory");
        const int nn = tid >> 3, k8 = (tid & 7) * 8;
#pragma unroll
        for (int u = 0; u < 4; ++u) {
            if (nn < nl[u] && k8 < kl[u]) {
                u32x4 w;
                w.x = pk_bf16(T[(u * 64 + k8 + 0) * 65 + nn], T[(u * 64 + k8 + 1) * 65 + nn]); w.y = pk_bf16(T[(u * 64 + k8 + 2) * 65 + nn], T[(u * 64 + k8 + 3) * 65 + nn]);
                w.z = pk_bf16(T[(u * 64 + k8 + 4) * 65 + nn], T[(u * 64 + k8 + 5) * 65 + nn]); w.w = pk_bf16(T[(u * 64 + k8 + 6) * 65 + nn], T[(u * 64 + k8 + 7) * 65 + nn]);
                *(u32x4*)(dstc[u] + (size_t)nn * Kc[u] + k8) = w;
            }
        }
        asm volatile("s_waitcnt lgkmcnt(0)" ::: "memory"); __builtin_amdgcn_s_barrier(); asm volatile("" ::: "memory");
    }
#undef WT_ISSUE
    __syncthreads();
}

__device__ __forceinline__ void phase_ada(KP p, LAS unsigned char* lds) {
    float* mods = WSP(float, WS_MODS);
    LAS float* red = (LAS float*)lds;
    const int tid = TID(), lane = tid & 63, w = tid >> 6, ln = lane & 15, lq = lane >> 4;
    float af[3][32];
#pragma unroll
    for (int m = 0; m < 3; ++m) {
        const int s = 16 * m + ln; const bool ok = s < 36;
        const float* cp = s < 4 ? p->c_prompt + (size_t)s * D : p->c_sample + (size_t)((ok ? s : 35) - 4) * D;
#pragma unroll
        for (int i = 0; i < 32; ++i) { const float cv = cp[128 * w + 4 * i + lq]; af[m][i] = ok ? cv * __builtin_amdgcn_rcpf(1.0f + __expf(-cv)) : 0.f; }
    }
    f32x2 wv[32];
#define ADA_LOAD(B_) do { const int l_ = (B_) / 192, cb_ = ((B_) % 192) * 32; const float* wp_ = p->w_ada + ((size_t)l_ * D + 128 * w + lq) * 6144 + cb_ + 2 * ln; \
        _Pragma("unroll") for (int i = 0; i < 32; ++i) wv[i] = *(const f32x2*)(wp_ + (size_t)(4 * i) * 6144); } while (0)
    if (BID() < 768) ADA_LOAD(BID());
    for (int B = BID(); B < 768; B += gridDim.x) {
        const int l = B / 192, cb = (B % 192) * 32;
        f32x4 acc[3][2];
#pragma unroll
        for (int m = 0; m < 3; ++m) { acc[m][0] = (f32x4){0.f, 0.f, 0.f, 0.f}; acc[m][1] = acc[m][0]; }
#pragma unroll
        for (int i = 0; i < 32; ++i)
#pragma unroll
            for (int m = 0; m < 3; ++m) {
                acc[m][0] = __builtin_amdgcn_mfma_f32_16x16x4f32(af[m][i], wv[i][0], acc[m][0], 0, 0, 0);
                acc[m][1] = __builtin_amdgcn_mfma_f32_16x16x4f32(af[m][i], wv[i][1], acc[m][1], 0, 0, 0);
            }
        if (B + (int)gridDim.x < 768) ADA_LOAD(B + (int)gridDim.x);
#pragma unroll
        for (int m = 0; m < 3; ++m)
#pragma unroll
            for (int r = 0; r < 4; ++r) { const int s = 16 * m + 4 * lq + r;
                if (s < 36) *(LAS f32x2*)(red + (w * 36 + s) * 32 + 2 * ln) = (f32x2){acc[m][0][r], acc[m][1][r]}; }
        asm volatile("s_waitcnt lgkmcnt(0)" ::: "memory"); __builtin_amdgcn_s_barrier(); asm volatile("" ::: "memory");
        for (int o = tid; o < 36 * 32; o += 512) { const int s = o >> 5, cc = o & 31;
            float v = 0.f;
#pragma unroll
            for (int ww = 0; ww < 8; ++ww) v += red[(ww * 36 + s) * 32 + cc];
            mods[((size_t)l * 36 + s) * 6144 + cb + cc] = v + p->b_ada[l * 6144 + cb + cc]; }
        asm volatile("s_waitcnt lgkmcnt(0)" ::: "memory"); __builtin_amdgcn_s_barrier(); asm volatile("" ::: "memory");
    }
#undef ADA_LOAD
    __syncthreads();
}

template <bool MIX>
__device__ __forceinline__ void phase_prep(KP p, int layer, int which, int j, bool first = false) {
    const float* X = p->out;
    const float* mods = WSP(float, WS_MODS) + (size_t)layer * 36 * 6144;
    const float* g = p->norm_g + (layer * 2 + which) * D;
    bf16_t* XR = WSP(bf16_t, WS_XR);
    const int lane = TID() & 63, gw = BID() * 8 + (TID() >> 6), nw = gridDim.x * 8;
    for (int run = gw; run < NP / 8 + NS; run += nw) {
        const int row0 = run < NP / 8 ? run * 8 : NP + (run - NP / 8), nrows = run < NP / 8 ? 8 : 1, seq = row_seq(row0);
        const float* sh = mods + (size_t)seq * 6144 + (which ? 3 : 0) * D; const float* sc = sh + D;
        f32x4 gv[4], scv[4], shv[4], hp[4];
#pragma unroll
        for (int i = 0; i < 4; ++i) { const int col = 512 * (i >> 1) + 8 * lane + 4 * (i & 1); gv[i] = *(const f32x4*)(g + col); scv[i] = *(const f32x4*)(sc + col) + 1.0f; shv[i] = *(const f32x4*)(sh + col); hp[i] = (f32x4){0.f, 0.f, 0.f, 0.f}; }
        int rstart = 0;
        if (MIX) {
            if (row0 >= NP && ((row0 - NP) & 7) == 0) {
#pragma unroll
                for (int i = 0; i < 4; ++i) hp[i] = *(const f32x4*)(p->state_shift + ((size_t)j * 32 + (seq - 4)) * D + 512 * (i >> 1) + 8 * lane + 4 * (i & 1));
            } else if (row0 >= NP || (row0 & 4095) != 0) rstart = -1;
        }
        f32x4 xn[4];
#define PREP_LOAD(ROW_) do { const int row_ = (ROW_); const float* xr_ = first ? (row_ < NP ? p->x_prompt + (size_t)row_ * D : p->x_sample + (size_t)(row_ - NP) * D) : X + (size_t)row_ * D; \
            _Pragma("unroll") for (int i = 0; i < 4; ++i) xn[i] = *(const f32x4*)(xr_ + 512 * (i >> 1) + 8 * lane + 4 * (i & 1)); } while (0)
        PREP_LOAD(row0 + rstart);
        for (int r = rstart; r < nrows; ++r) {
            const int row = row0 + r;
            f32x4 x[4]; float ss = 0.f;
#pragma unroll
            for (int i = 0; i < 4; ++i) x[i] = xn[i];
            if (r + 1 < nrows) PREP_LOAD(row + 1);
#pragma unroll
            for (int i = 0; i < 4; ++i) ss += x[i][0] * x[i][0] + x[i][1] * x[i][1] + x[i][2] * x[i][2] + x[i][3] * x[i][3];
            ss = wave_sum(ss);
            const float rstd = rsqrtf(ss * (1.0f / 1024.0f) + 1e-6f);
            f32x4 h[4];
#pragma unroll
            for (int i = 0; i < 4; ++i) h[i] = x[i] * rstd * gv[i] * scv[i] + shv[i];
            if (MIX) {
                if (r >= 0) {
#pragma unroll
                    for (int n = 0; n < 6; ++n) {
                        const int mi = n == 0 ? 0 : (n == 1 ? 2 : (n == 2 ? 3 : (n == 3 ? 1 : n)));
                        const float* mx = p->rw_mix + ((size_t)j * 6 + mi) * D;
#pragma unroll
                        for (int i2 = 0; i2 < 2; ++i2) { const int col = 512 * i2 + 8 * lane; const f32x4 m0 = *(const f32x4*)(mx + col), m1 = *(const f32x4*)(mx + col + 4);
                            const f32x4 a = h[2 * i2] + (hp[2 * i2] - h[2 * i2]) * m0, b2 = h[2 * i2 + 1] + (hp[2 * i2 + 1] - h[2 * i2 + 1]) * m1;
                            u32x4 w; w.x = pk_bf16(a[0], a[1]); w.y = pk_bf16(a[2], a[3]); w.z = pk_bf16(b2[0], b2[1]); w.w = pk_bf16(b2[2], b2[3]);
                            *(u32x4*)(XR + (size_t)n * XR_STRIDE + (size_t)row * D + col) = w; }
                    }
                    const bool lastp = row < NP && (row & 4095) == 4095, lasts = row >= NP && ((row - NP) & 7) == 7;
                    if (lastp || lasts) {
                        float* so = lastp ? p->out + O_SHP + ((size_t)j * 4 + seq) * D : p->out + O_SHS + ((size_t)j * 32 + (seq - 4)) * D;
#pragma unroll
                        for (int i = 0; i < 4; ++i) *(f32x4*)(so + 512 * (i >> 1) + 8 * lane + 4 * (i & 1)) = h[i];
                    }
                }
#pragma unroll
                for (int i = 0; i < 4; ++i) hp[i] = h[i];
            } else {
#pragma unroll
                for (int i2 = 0; i2 < 2; ++i2) { const f32x4 a = h[2 * i2], b2 = h[2 * i2 + 1]; u32x4 w; w.x = pk_bf16(a[0], a[1]); w.y = pk_bf16(a[2], a[3]); w.z = pk_bf16(b2[0], b2[1]); w.w = pk_bf16(b2[2], b2[3]);
                    *(u32x4*)(XR + (size_t)row * D + 512 * i2 + 8 * lane) = w; }
            }
        }
    }
}

#undef PREP_LOAD
__device__ __forceinline__ void phase_scanprep(KP p, int j) {
    const bf16_t *KB = WSP(bf16_t, WS_KB), *VB = WSP(bf16_t, WS_VB);
    const float *WPp = WSP(float, WS_WP), *APp = WSP(float, WS_AP), *VPp = WSP(float, WS_VP);
    float *VF = WSP(float, WS_VFIRST), *DEC = WSP(float, WS_DEC), *KM = WSP(float, WS_KM), *VM = WSP(float, WS_VM), *AV = WSP(float, WS_AV), *BV = WSP(float, WS_BV);
    const int lane = TID() & 63, gw = BID() * 8 + (TID() >> 6), nw = gridDim.x * 8;
    for (int row = gw; row < NT; row += nw) {
#pragma unroll
        for (int i = 0; i < 4; ++i) {
            const int col = 256 * i + 4 * lane; const size_t o = (size_t)row * D + col;
            const f32x4 k = ld_bf4(KB + o), v = ld_bf4(VB + o), wp = *(const f32x4*)(WPp + o), ap = *(const f32x4*)(APp + o);
            const f32x4 w0 = *(const f32x4*)(p->rw_w0 + j * D + col), a0 = *(const f32x4*)(p->rw_a0 + j * D + col), kkw = *(const f32x4*)(p->rw_k_k + j * D + col), kaw = *(const f32x4*)(p->rw_k_a + j * D + col);
            f32x4 dec, a, vm, kk, km;
#pragma unroll
            for (int e = 0; e < 4; ++e) {
                const float wpre = w0[e] + wp[e], z = -wpre, sp = fmaxf(z, 0.f) + log1pf(expf(-fabsf(z)));
                dec[e] = expf(-expf(-sp - 0.5f));
                a[e] = sigmoidf_(a0[e] + ap[e]);
                kk[e] = k[e] * kkw[e];
                km[e] = k[e] * (1.0f + (a[e] - 1.0f) * kaw[e]);
            }
            if (j == 0) { vm = v; *(f32x4*)(VF + o) = v; }
            else { const f32x4 vf = *(const f32x4*)(VF + o), vp = *(const f32x4*)(VPp + o), v0 = *(const f32x4*)(p->rw_v0 + (j - 1) * D + col);
#pragma unroll
                for (int e = 0; e < 4; ++e) vm[e] = v[e] + (vf[e] - v[e]) * sigmoidf_(v0[e] + vp[e]); }
            float ss = kk[0] * kk[0] + kk[1] * kk[1] + kk[2] * kk[2] + kk[3] * kk[3];
            ss = g16_sum(ss);
            const float inv = rsqrtf(fmaxf(ss, 1e-24f));
            kk = kk * inv;
            *(f32x4*)(DEC + o) = dec; *(f32x4*)(KM + o) = km; *(f32x4*)(VM + o) = vm; *(f32x4*)(AV + o) = -kk; *(f32x4*)(BV + o) = kk * a;
        }
    }
}

__device__ __forceinline__ float rl(float v, int k) { return __int_as_float(__builtin_amdgcn_readlane(__float_as_int(v), k)); }
__device__ __forceinline__ void scan_run(KP p, size_t row_base, int nsteps, int colbase, float (&S)[64]) {
    const float *DEC = WSP(float, WS_DEC), *KM = WSP(float, WS_KM), *VM = WSP(float, WS_VM), *AV = WSP(float, WS_AV), *BV = WSP(float, WS_BV);
    const bf16_t* RB = WSP(bf16_t, WS_RB); float* Y = WSP(float, WS_Y);
    const int lane = TID() & 63;
    size_t o = row_base * D + colbase + lane;
    float w = DEC[o], kx = KM[o], v = VM[o], a = AV[o], b = BV[o], r = bf2f(RB[o]);
    for (int t = 0; t < nsteps; ++t) {
        const size_t on = (t + 1 < nsteps) ? o + D : o;
        const float wn = DEC[on], kn = KM[on], vn = VM[on], an = AV[on], bn = BV[on], rn = bf2f(RB[on]);
        float sa = 0.f;
#pragma unroll
        for (int k = 0; k < 64; ++k) sa += S[k] * rl(a, k);
#pragma unroll
        for (int k = 0; k < 64; ++k) S[k] = S[k] * rl(w, k) + sa * rl(b, k) + v * rl(kx, k);
        float y = 0.f;
#pragma unroll
        for (int k = 0; k < 64; ++k) y += S[k] * rl(r, k);
        Y[o] = y;
        o = on; w = wn; kx = kn; v = vn; a = an; b = bn; r = rn;
    }
}
__device__ __forceinline__ void phase_scanA(KP p) {
    const float *DEC = WSP(float, WS_DEC), *KM = WSP(float, WS_KM), *VM = WSP(float, WS_VM), *AV = WSP(float, WS_AV), *BV = WSP(float, WS_BV);
    float *PCH = WSP(float, WS_PCH), *CCH = WSP(float, WS_CCH);
    const int lane = TID() & 63, gw = BID() * 8 + (TID() >> 6), nw = gridDim.x * 8;
    for (int it = gw; it < 64 * NCH; it += nw) {
        const int sh = it / NCH, c = it % NCH, b = sh >> 4, h = sh & 15;
        float SP[64], SC[64];
#pragma unroll
        for (int k = 0; k < 64; ++k) { SP[k] = (k == lane) ? 1.f : 0.f; SC[k] = 0.f; }
        size_t o = ((size_t)b * 4096 + (size_t)c * LCH) * D + h * 64 + lane;
        float w = DEC[o], kx = KM[o], v = VM[o], a = AV[o], bb = BV[o];
        for (int t = 0; t < LCH; ++t) {
            const size_t on = (t + 1 < LCH) ? o + D : o;
            const float wn = DEC[on], kn = KM[on], vn = VM[on], an = AV[on], bn = BV[on];
            float saP = 0.f, saC = 0.f;
#pragma unroll
            for (int k = 0; k < 64; ++k) { const float ak = rl(a, k); saP += SP[k] * ak; saC += SC[k] * ak; }
#pragma unroll
            for (int k = 0; k < 64; ++k) { const float wk = rl(w, k), bk = rl(bb, k); SP[k] = SP[k] * wk + saP * bk; SC[k] = SC[k] * wk + saC * bk + v * rl(kx, k); }
            o = on; w = wn; kx = kn; v = vn; a = an; bb = bn;
        }
        float* po = PCH + ((size_t)it * 64 + lane) * 64; float* co = CCH + ((size_t)it * 64 + lane) * 64;
#pragma unroll
        for (int k = 0; k < 64; k += 4) { *(f32x4*)(po + k) = (f32x4){SP[k], SP[k + 1], SP[k + 2], SP[k + 3]}; *(f32x4*)(co + k) = (f32x4){SC[k], SC[k + 1], SC[k + 2], SC[k + 3]}; }
    }
}
__device__ __forceinline__ void phase_scanB(KP p, int j, LAS unsigned char* lds) {
    const int tid = TID(), lane = tid & 63, wave = tid >> 6;
    if (BID() < 32) {
        const float *PCH = WSP(float, WS_PCH), *CCH = WSP(float, WS_CCH); float* SST = WSP(float, WS_SST);
        const int sh = BID() * 2 + (wave >> 2), q = wave & 3, row0 = 32 * (q >> 1), col0 = 32 * (q & 1), b = sh >> 4, h = sh & 15;
        LAS float* Sl = (LAS float*)lds + (wave >> 2) * (2 * 64 * 65);
        const int lr = lane & 31, lh = lane >> 5;
        f32x16 acc;
#pragma unroll
        for (int r = 0; r < 16; ++r) acc[r] = 0.f;
        for (int c = 0; c <= NCH; ++c) {
            LAS float* Sw = Sl + (c & 1) * (64 * 65);
            float* go = c < NCH ? SST + ((size_t)sh * NCH + c) * 4096 : p->out + O_WKVP + (((size_t)j * 4 + b) * 16 + h) * 4096;
#pragma unroll
            for (int r = 0; r < 16; ++r) { const int row = row0 + (r & 3) + 8 * (r >> 2) + 4 * lh; Sw[row * 65 + col0 + lr] = acc[r]; go[row * 64 + col0 + lr] = acc[r]; }
            if (c == NCH) break;
            const float* Pc = PCH + ((size_t)sh * NCH + c) * 4096; const float* Cc = CCH + ((size_t)sh * NCH + c) * 4096;
            float bv[32];
#pragma unroll
            for (int kk = 0; kk < 32; ++kk) bv[kk] = Pc[(2 * kk + lh) * 64 + col0 + lr];
#pragma unroll
            for (int r = 0; r < 16; ++r) acc[r] = Cc[(row0 + (r & 3) + 8 * (r >> 2) + 4 * lh) * 64 + col0 + lr];
            __syncthreads();
#pragma unroll
            for (int kk = 0; kk < 32; ++kk) acc = __builtin_amdgcn_mfma_f32_32x32x2f32(Sw[(row0 + lr) * 65 + 2 * kk + lh], bv[kk], acc, 0, 0, 0);
        }
    } else {
        for (int it = (BID() - 32) * 8 + wave; it < 512; it += (gridDim.x - 32) * 8) {
            const int b = it >> 4, h = it & 15;
            const float* s0 = p->state_wkv + (((size_t)j * 32 + b) * 16 + h) * 4096 + lane * 64;
            float S[64];
#pragma unroll
            for (int k = 0; k < 64; k += 4) { const f32x4 t = *(const f32x4*)(s0 + k); S[k] = t[0]; S[k + 1] = t[1]; S[k + 2] = t[2]; S[k + 3] = t[3]; }
            scan_run(p, (size_t)NP + b * 8, 8, h * 64, S);
            float* o = p->out + O_WKVS + (((size_t)j * 32 + b) * 16 + h) * 4096 + lane * 64;
#pragma unroll
            for (int k = 0; k < 64; k += 4) *(f32x4*)(o + k) = (f32x4){S[k], S[k + 1], S[k + 2], S[k + 3]};
        }
    }
    __syncthreads();
}
__device__ __forceinline__ void phase_scanC(KP p) {
    const float* SST = WSP(float, WS_SST);
    const int lane = TID() & 63, gw = BID() * 8 + (TID() >> 6), nw = gridDim.x * 8;
    for (int it = gw; it < 64 * NCH; it += nw) {
        const int sh = it / NCH, c = it % NCH, b = sh >> 4, h = sh & 15;
        const float* s0 = SST + ((size_t)it * 64 + lane) * 64;
        float S[64];
#pragma unroll
        for (int k = 0; k < 64; k += 4) { const f32x4 t = *(const f32x4*)(s0 + k); S[k] = t[0]; S[k + 1] = t[1]; S[k + 2] = t[2]; S[k + 3] = t[3]; }
        scan_run(p, (size_t)b * 4096 + (size_t)c * LCH, LCH, h * 64, S);
    }
}


constexpr int CST = 72;
constexpr int CMAT = 64 * CST * 2;
constexpr int CH_F32 = 11 * CMAT, CH_PART = CH_F32 + 64 * 68 * 4, CH_GL = CH_PART + 64 * 4 * 4;
__device__ __forceinline__ bf16x8 cfrag(const LAS bf16_t* M, int row, int ks, int c4) { return *(const LAS bf16x8*)(M + row * CST + 32 * ks + 8 * c4); }
__device__ __forceinline__ f32x4 cmm(const LAS bf16_t* A, int arow, const LAS bf16_t* B, int brow, int c4, f32x4 acc) {
    acc = __builtin_amdgcn_mfma_f32_16x16x32_bf16(cfrag(A, arow, 0, c4), cfrag(B, brow, 0, c4), acc, 0, 0, 0);
    return __builtin_amdgcn_mfma_f32_16x16x32_bf16(cfrag(A, arow, 1, c4), cfrag(B, brow, 1, c4), acc, 0, 0, 0); }
__device__ __forceinline__ unsigned short f2bf(float x) { return (unsigned short)(pk_bf16(x, 0.f) & 0xffffu); }
__device__ __forceinline__ void st_t4(LAS bf16_t* Mt, int d, int t0, f32x4 v) { u32x2 w; w.x = pk_bf16(v[0], v[1]); w.y = pk_bf16(v[2], v[3]); *(LAS u32x2*)(Mt + d * CST + t0) = w; }

__device__ __forceinline__ void phase_chunk(KP p, int j, LAS unsigned char* lds) {
    LAS bf16_t* Mx = (LAS bf16_t*)lds;
#define CM(i) (Mx + (i) * (64 * CST))
    LAS float* F32 = (LAS float*)(lds + CH_F32);
    asm volatile("" : "+v"(F32));
    LAS float* part = (LAS float*)(lds + CH_PART);
    LAS float* gLs = (LAS float*)(lds + CH_GL);
    const bf16_t *RB = WSP(bf16_t, WS_RB), *KB = WSP(bf16_t, WS_KB), *VB = WSP(bf16_t, WS_VB), *TW = WSP(bf16_t, WS_TW), *TA_ = WSP(bf16_t, WS_TA), *TV = WSP(bf16_t, WS_TV);
    const bf16_t *W2T = WSP(bf16_t, WS_W2T) + (size_t)j * D * 64, *A2T = WSP(bf16_t, WS_A2T) + (size_t)j * D * 64, *V2T = WSP(bf16_t, WS_V2T);
    float* VF = WSP(float, WS_VFIRST); float *PCH = WSP(float, WS_PCH), *CCH = WSP(float, WS_CCH), *Y0 = WSP(float, WS_Y), *BON = WSP(float, WS_AV);
    bf16_t *GM = WSP(bf16_t, WS_DEC), *VM2 = WSP(bf16_t, WS_KM);
#define CH_BAR() do { asm volatile("s_waitcnt lgkmcnt(0)" ::: "memory"); __builtin_amdgcn_s_barrier(); asm volatile("" ::: "memory"); } while (0)
    bf16x8 f_aw[2], f_aa[2], f_av; unsigned short e_k[2][4], e_v[2][4], e_r[2][4];
    f_av = (bf16x8){0, 0, 0, 0, 0, 0, 0, 0};
#define CH_PREFETCH(itx) do { const int tid_ = TID(), lane_ = tid_ & 63, w_ = tid_ >> 6, n_ = lane_ & 15, c4_ = lane_ >> 4, tr_ = w_ >> 1, tcb_ = 2 * (w_ & 1); \
        const int sh_ = (itx) / NCH, c_ = (itx) % NCH, R0_ = (sh_ >> 4) * 4096 + c_ * LCH, hc_ = (sh_ & 15) * 64; const int ar_ = 16 * tr_ + n_; \
        _Pragma("unroll") for (int ks = 0; ks < 2; ++ks) { f_aw[ks] = *(const bf16x8*)(TW + (size_t)R0_ * 64 + ar_ * 64 + 32 * ks + 8 * c4_); f_aa[ks] = *(const bf16x8*)(TA_ + (size_t)R0_ * 64 + ar_ * 64 + 32 * ks + 8 * c4_); } \
        if (j == 1) f_av = *(const bf16x8*)(TV + (size_t)R0_ * 32 + ar_ * 32 + 8 * c4_); \
        _Pragma("unroll") for (int ti = 0; ti < 2; ++ti) _Pragma("unroll") for (int r = 0; r < 4; ++r) { const size_t o_ = (size_t)R0_ * D + hc_ + (16 * tr_ + 4 * c4_ + r) * D + 16 * (tcb_ + ti) + n_; \
            e_k[ti][r] = KB[o_]; e_v[ti][r] = VB[o_]; e_r[ti][r] = RB[o_]; } } while (0)
#define CH_MAP(q_) (((((q_) >> 4) & 3) * 16 + ((q_) & 15)) * NCH + ((q_) >> 6))
    if (BID() < 64 * NCH) CH_PREFETCH(CH_MAP(BID()));
    for (int q = BID(); q < 64 * NCH; q += gridDim.x) {
        const int it = CH_MAP(q);
        const int tid = TID(), lane = tid & 63, w = tid >> 6, n = lane & 15, c4 = lane >> 4, tr = w >> 1, tcb = 2 * (w & 1);
        const int sh = it / NCH, c = it % NCH, b = sh >> 4, h = sh & 15, R0 = b * 4096 + c * LCH, hc = h * 64;
        const bf16_t *KBb = KB + (size_t)R0 * D + hc, *VBb = VB + (size_t)R0 * D + hc, *RBb = RB + (size_t)R0 * D + hc;
        bf16_t* VFb = (bf16_t*)VF + (size_t)R0 * D + hc; bf16_t* VM2b = VM2 + (size_t)R0 * D + hc; bf16_t* GMb = GM + (size_t)R0 * D + hc; bf16_t* Y0b = (bf16_t*)Y0 + (size_t)R0 * D + hc;
        float* PCb = PCH + (size_t)it * 4096; float* CCb = CCH + (size_t)it * 4096; float* BONb = BON + (size_t)R0 * 16 + h;
        const bf16_t *TWb = TW + (size_t)R0 * 64, *TAb = TA_ + (size_t)R0 * 64, *TVb = TV + (size_t)R0 * 32, *W2b = W2T + (size_t)hc * 64, *A2b = A2T + (size_t)hc * 64, *V2b = V2T + (size_t)hc * 32;
        const float *w0b = p->rw_w0 + j * D + hc, *a0b = p->rw_a0 + j * D + hc, *kkb = p->rw_k_k + j * D + hc, *kab = p->rw_k_a + j * D + hc, *rkb = p->rw_r_k + j * D + hc, *v0b = p->rw_v0 + (j ? (j - 1) : 0) * D + hc;
        f32x4 wp[2], ap[2], vp[2];
#pragma unroll
        for (int ti = 0; ti < 2; ++ti) { wp[ti] = (f32x4){0.f, 0.f, 0.f, 0.f}; ap[ti] = wp[ti]; vp[ti] = wp[ti]; }
        {   const int ar = 16 * tr + n;
#pragma unroll
            for (int ks = 0; ks < 2; ++ks) {
                const bf16x8 aw = f_aw[ks], aa = f_aa[ks];
#pragma unroll
                for (int ti = 0; ti < 2; ++ti) { const int br = 16 * (tcb + ti) + n;
                    wp[ti] = __builtin_amdgcn_mfma_f32_16x16x32_bf16(aw, *(const bf16x8*)(W2b + br * 64 + 32 * ks + 8 * c4), wp[ti], 0, 0, 0);
                    ap[ti] = __builtin_amdgcn_mfma_f32_16x16x32_bf16(aa, *(const bf16x8*)(A2b + br * 64 + 32 * ks + 8 * c4), ap[ti], 0, 0, 0); }
            }
            if (j == 1) { const bf16x8 av = f_av;
#pragma unroll
                for (int ti = 0; ti < 2; ++ti) vp[ti] = __builtin_amdgcn_mfma_f32_16x16x32_bf16(av, *(const bf16x8*)(V2b + (16 * (tcb + ti) + n) * 32 + 8 * c4), vp[ti], 0, 0, 0); }
        }
        f32x4 lw[2], asg[2], kkv[2], kpr[2], vpr[2], rr[2];
        float ssq[4] = {0.f, 0.f, 0.f, 0.f}, bon[4] = {0.f, 0.f, 0.f, 0.f};
        float vf8[2][4];
#pragma unroll
        for (int ti = 0; ti < 2; ++ti)
#pragma unroll
            for (int r = 0; r < 4; ++r) vf8[ti][r] = 0.f;
        if (j == 1) {
#pragma unroll
            for (int ti = 0; ti < 2; ++ti)
#pragma unroll
                for (int r = 0; r < 4; ++r) vf8[ti][r] = bf2f(VFb[(16 * tr + 4 * c4 + r) * D + 16 * (tcb + ti) + n]);
        }
#pragma unroll
        for (int ti = 0; ti < 2; ++ti) {
            const int d = 16 * (tcb + ti) + n;
            const float w0 = w0b[d], a0 = a0b[d], kkw = kkb[d], kaw = kab[d], rkw = rkb[d];
            const float v0 = j ? v0b[d] : 0.f;
#pragma unroll
            for (int r = 0; r < 4; ++r) {
                const int o = (16 * tr + 4 * c4 + r) * D + d;
                const float kx = bf2f(e_k[ti][r]), vx = bf2f(e_v[ti][r]), rx = bf2f(e_r[ti][r]);
                const float z = -(w0 + wp[ti][r]), sp = fmaxf(z, 0.f) + __logf(1.0f + __expf(-fabsf(z)));
                lw[ti][r] = -__expf(-sp - 0.5f);
                const float a = fsig(a0 + ap[ti][r]);
                asg[ti][r] = a;
                float vv = vx;
                if (j == 0) VFb[o] = e_v[ti][r]; else { const float vf = vf8[ti][r]; vv = vx + (vf - vx) * fsig(v0 + vp[ti][r]); }
                vpr[ti][r] = vv; rr[ti][r] = rx;
                const float kk = kx * kkw; kkv[ti][r] = kk; ssq[r] += kk * kk;
                const float kp = kx * (1.0f + (a - 1.0f) * kaw); kpr[ti][r] = kp; bon[r] += rx * kp * rkw;
                F32[(16 * tr + 4 * c4 + r) * 68 + d] = lw[ti][r];
                VM2b[o] = f2bf(vv);
            }
        }
#pragma unroll
        for (int r = 0; r < 4; ++r) { ssq[r] = g16_sum(ssq[r]); bon[r] = g16_sum(bon[r]); }
        if (n == 0) {
#pragma unroll
            for (int r = 0; r < 4; ++r) { const int t = 16 * tr + 4 * c4 + r; part[(t * 2 + (w & 1)) * 2 + 0] = ssq[r]; part[(t * 2 + (w & 1)) * 2 + 1] = bon[r]; }
        }
        if (q + (int)gridDim.x < 64 * NCH) CH_PREFETCH(CH_MAP(q + (int)gridDim.x));
        CH_BAR();
        f32x4 cs[2];
#pragma unroll
        for (int ti = 0; ti < 2; ++ti) {
            f32x4 acc = {0.f, 0.f, 0.f, 0.f};
            for (int q = 0; q < 4 * (tr + 1); ++q) {
                const float av = (4 * q + c4 <= 16 * tr + n) ? 1.0f : 0.0f;
                acc = __builtin_amdgcn_mfma_f32_16x16x4f32(av, F32[(4 * q + c4) * 68 + 16 * (tcb + ti) + n], acc, 0, 0, 0);
            }
            cs[ti] = acc;
        }
        float inv[4];
#pragma unroll
        for (int r = 0; r < 4; ++r) { const int t = 16 * tr + 4 * c4 + r; inv[r] = rsqrtf(fmaxf(part[(t * 2 + 0) * 2] + part[(t * 2 + 1) * 2], 1e-24f));
            if (n == 0 && (w & 1) == 0) BONb[t * 16] = part[(t * 2 + 0) * 2 + 1] + part[(t * 2 + 1) * 2 + 1]; }
        f32x4 rt[2];
#pragma unroll
        for (int ti = 0; ti < 2; ++ti) {
            const int d = 16 * (tcb + ti) + n, t0 = 16 * tr + 4 * c4;
            f32x4 at, bt, kt;
#pragma unroll
            for (int r = 0; r < 4; ++r) {
                const float g = __expf(cs[ti][r]), gi = __expf(-cs[ti][r]), gm = __expf(cs[ti][r] - lw[ti][r]);
                const float kk = kkv[ti][r] * inv[r];
                at[r] = -kk * gm; bt[r] = kk * asg[ti][r] * gi; kt[r] = kpr[ti][r] * gi; rt[ti][r] = rr[ti][r] * g;
                CM(0)[(t0 + r) * CST + d] = f2bf(at[r]); CM(1)[(t0 + r) * CST + d] = f2bf(bt[r]); CM(2)[(t0 + r) * CST + d] = f2bf(kt[r]); CM(3)[(t0 + r) * CST + d] = f2bf(rt[ti][r]);
                if (t0 + r == 63) gLs[d] = g;
            }
            st_t4(CM(4), d, t0, at); st_t4(CM(5), d, t0, bt); st_t4(CM(6), d, t0, kt); st_t4(CM(7), d, t0, vpr[ti]);
        }
        CH_BAR();
#pragma unroll
        for (int ti = 0; ti < 2; ++ti) {
            const int tc = tcb + ti, s = 16 * tc + n, t0 = 16 * tr + 4 * c4;
            if (tc <= tr) {
                { f32x4 m = {0.f, 0.f, 0.f, 0.f}; m = cmm(CM(0), 16 * tr + n, CM(1), 16 * tc + n, c4, m);
#pragma unroll
                  for (int r = 0; r < 4; ++r) F32[(t0 + r) * 68 + s] = (s < t0 + r) ? m[r] : 0.f; }
                asm volatile("" ::: "memory");
                { f32x4 m = {0.f, 0.f, 0.f, 0.f}; m = cmm(CM(0), 16 * tr + n, CM(2), 16 * tc + n, c4, m);
#pragma unroll
                  for (int r = 0; r < 4; ++r) CM(8)[(t0 + r) * CST + s] = f2bf((s < t0 + r) ? m[r] : 0.f); }
                asm volatile("" ::: "memory");
                { f32x4 m = {0.f, 0.f, 0.f, 0.f}; m = cmm(CM(3), 16 * tr + n, CM(1), 16 * tc + n, c4, m);
#pragma unroll
                  for (int r = 0; r < 4; ++r) CM(9)[(t0 + r) * CST + s] = f2bf((s <= t0 + r) ? m[r] : 0.f); }
                asm volatile("" ::: "memory");
                { f32x4 m = {0.f, 0.f, 0.f, 0.f}; m = cmm(CM(3), 16 * tr + n, CM(2), 16 * tc + n, c4, m);
#pragma unroll
                  for (int r = 0; r < 4; ++r) CM(10)[(t0 + r) * CST + s] = f2bf((s <= t0 + r) ? m[r] : 0.f); }
                asm volatile("" ::: "memory");
            } else {
#pragma unroll
                for (int r = 0; r < 4; ++r) { F32[(t0 + r) * 68 + s] = 0.f; CM(8)[(t0 + r) * CST + s] = 0; CM(9)[(t0 + r) * CST + s] = 0; CM(10)[(t0 + r) * CST + s] = 0; }
            }
        }
        CH_BAR();
        { const int e0 = tid * 8;
#pragma unroll
          for (int e = 0; e < 8; ++e) { const int t = (e0 + e) >> 6, s_ = (e0 + e) & 63; CM(2)[t * CST + s_] = f2bf(F32[t * 68 + s_]); }
          unsigned z_ = 0u; asm volatile("" : "+v"(z_));
          *(LAS u32x4*)(CM(0) + (e0 >> 6) * CST + (e0 & 63)) = (u32x4){z_, z_, z_, z_}; }
        CH_BAR();
        if (w < 4) {
            const int cw = 16 * w;
            LAS float* scr = (LAS float*)CM(1) + w * (16 * 17);
#pragma unroll 1
            for (int I = 0; I < 4; ++I) {
                f32x4 rh = {0.f, 0.f, 0.f, 0.f};
                if (I > 0) { rh = __builtin_amdgcn_mfma_f32_16x16x32_bf16(cfrag(CM(2), 16 * I + n, 0, c4), cfrag(CM(0), cw + n, 0, c4), rh, 0, 0, 0);
                    if (I > 2) rh = __builtin_amdgcn_mfma_f32_16x16x32_bf16(cfrag(CM(2), 16 * I + n, 1, c4), cfrag(CM(0), cw + n, 1, c4), rh, 0, 0, 0); }
#pragma unroll
                for (int r = 0; r < 4; ++r) scr[(4 * c4 + r) * 17 + n] = rh[r] + ((16 * I + 4 * c4 + r) == (cw + n) ? 1.f : 0.f);
                wave_lds_fence();
                float x[16];
#pragma unroll
                for (int i = 0; i < 16; ++i) x[i] = scr[i * 17 + n];
                f32x4 mc[4], mn[4];
                mc[0] = *(const LAS f32x4*)(F32 + (16 * I + 1) * 68 + 16 * I);
#pragma unroll
                for (int i = 1; i < 16; ++i) {
                    if (i + 1 < 16) {
#pragma unroll
                        for (int j4 = 0; j4 < (i + 4) / 4; ++j4) mn[j4] = *(const LAS f32x4*)(F32 + (16 * I + i + 1) * 68 + 16 * I + 4 * j4);
                    }
                    float a0 = 0.f, a1 = 0.f;
#pragma unroll
                    for (int j4 = 0; j4 < (i + 3) / 4; ++j4) {
                        if (4 * j4 + 0 < i) a0 += mc[j4][0] * x[4 * j4 + 0];
                        if (4 * j4 + 1 < i) a1 += mc[j4][1] * x[4 * j4 + 1];
                        if (4 * j4 + 2 < i) a0 += mc[j4][2] * x[4 * j4 + 2];
                        if (4 * j4 + 3 < i) a1 += mc[j4][3] * x[4 * j4 + 3];
                    }
                    x[i] += a0 + a1;
#pragma unroll
                    for (int j4 = 0; j4 < 4; ++j4) mc[j4] = mn[j4];
                    asm volatile("" ::: "memory");
                }
                if (c4 == 0) {
#pragma unroll
                    for (int i = 0; i < 16; ++i) CM(3)[(16 * I + i) * CST + cw + n] = f2bf(x[i]);
                    u32x4 t0, t1;
                    t0.x = pk_bf16(x[0], x[1]); t0.y = pk_bf16(x[2], x[3]); t0.z = pk_bf16(x[4], x[5]); t0.w = pk_bf16(x[6], x[7]);
                    t1.x = pk_bf16(x[8], x[9]); t1.y = pk_bf16(x[10], x[11]); t1.z = pk_bf16(x[12], x[13]); t1.w = pk_bf16(x[14], x[15]);
                    *(LAS u32x4*)(CM(0) + (cw + n) * CST + 16 * I) = t0; *(LAS u32x4*)(CM(0) + (cw + n) * CST + 16 * I + 8) = t1;
                }
                wave_lds_fence();
            }
        }
        CH_BAR();
#pragma unroll
        for (int ti = 0; ti < 2; ++ti) {
            const int d = 16 * (tcb + ti) + n;
            { f32x4 x1 = {0.f, 0.f, 0.f, 0.f}; x1 = cmm(CM(8), 16 * tr + n, CM(7), 16 * (tcb + ti) + n, c4, x1); st_t4(CM(0), d, 16 * tr + 4 * c4, x1); }
            asm volatile("" ::: "memory");
            { f32x4 ta = {0.f, 0.f, 0.f, 0.f}; ta = cmm(CM(3), 16 * tr + n, CM(4), 16 * (tcb + ti) + n, c4, ta); st_t4(CM(1), d, 16 * tr + 4 * c4, ta); }
            asm volatile("" ::: "memory");
        }
        CH_BAR();
#pragma unroll
        for (int ti = 0; ti < 2; ++ti) {
            f32x4 uv = {0.f, 0.f, 0.f, 0.f};
            uv = cmm(CM(3), 16 * tr + n, CM(0), 16 * (tcb + ti) + n, c4, uv);
            st_t4(CM(2), 16 * (tcb + ti) + n, 16 * tr + 4 * c4, uv);
        }
        CH_BAR();
#pragma unroll
        for (int ti = 0; ti < 2; ++ti) {
            const int cc = 16 * (tcb + ti) + n, r0 = 16 * tr + 4 * c4;
            const float gl = gLs[cc];
            { f32x4 pm = {0.f, 0.f, 0.f, 0.f}; pm = cmm(CM(1), 16 * tr + n, CM(5), cc, c4, pm);
#pragma unroll
              for (int r = 0; r < 4; ++r) PCb[(r0 + r) * 64 + cc] = (pm[r] + ((r0 + r) == cc ? 1.f : 0.f)) * gl; }
            asm volatile("" ::: "memory");
            { f32x4 cm_ = {0.f, 0.f, 0.f, 0.f}; cm_ = cmm(CM(2), 16 * tr + n, CM(5), cc, c4, cm_); cm_ = cmm(CM(7), 16 * tr + n, CM(6), cc, c4, cm_);
#pragma unroll
              for (int r = 0; r < 4; ++r) CCb[(r0 + r) * 64 + cc] = cm_[r] * gl; }
            asm volatile("" ::: "memory");
            { f32x4 gg = {0.f, 0.f, 0.f, 0.f}; gg = cmm(CM(9), 16 * tr + n, CM(1), cc, c4, gg);
#pragma unroll
              for (int r = 0; r < 4; ++r) GMb[(r0 + r) * D + cc] = f2bf(gg[r] + rt[ti][r]); }
            asm volatile("" ::: "memory");
            { f32x4 y0 = {0.f, 0.f, 0.f, 0.f}; y0 = cmm(CM(9), 16 * tr + n, CM(2), cc, c4, y0); y0 = cmm(CM(10), 16 * tr + n, CM(7), cc, c4, y0);
#pragma unroll
              for (int r = 0; r < 4; ++r) Y0b[(r0 + r) * D + cc] = f2bf(y0[r]); }
            asm volatile("" ::: "memory");
        }
        CH_BAR();
    }
#undef CM
#undef CH_PREFETCH
#undef CH_BAR
}

__device__ __forceinline__ void phase_sample_mixer_w(KP p, int j, int first, int stride) {
    const int tid = TID(), lane = tid & 63;
    {
        const bf16_t *RB = WSP(bf16_t, WS_RB), *KB = WSP(bf16_t, WS_KB), *VB = WSP(bf16_t, WS_VB); bf16_t* YG = WSP(bf16_t, WS_YG);
        const float *WPp = WSP(float, WS_WP), *APp = WSP(float, WS_AP), *VPp = WSP(float, WS_VP), *GG = WSP(float, WS_GG); float* VF = WSP(float, WS_VFIRST);
        for (int it = first; it < 512; it += stride) {
            const int b = it >> 4, h = it & 15, col = h * 64 + lane;
            const float* s0 = p->state_wkv + (((size_t)j * 32 + b) * 16 + h) * 4096 + lane * 64;
            float S[64];
#pragma unroll
            for (int k = 0; k < 64; k += 4) { const f32x4 t = *(const f32x4*)(s0 + k); S[k] = t[0]; S[k + 1] = t[1]; S[k + 2] = t[2]; S[k + 3] = t[3]; }
            const float w0 = p->rw_w0[j * D + col], a0 = p->rw_a0[j * D + col], kkw = p->rw_k_k[j * D + col], kaw = p->rw_k_a[j * D + col], rkw = p->rw_r_k[j * D + col];
            const float v0 = j ? p->rw_v0[(j - 1) * D + col] : 0.f, lnw = p->rw_lnx_w[j * D + col], lnb = p->rw_lnx_b[j * D + col];
            for (int t = 0; t < 8; ++t) {
                const size_t o = (size_t)(NP + b * 8 + t) * D + col;
                const float kx = bf2f(KB[o]), vx = bf2f(VB[o]), r = bf2f(RB[o]);
                const float z = -(w0 + WPp[o]), sp = fmaxf(z, 0.f) + log1pf(expf(-fabsf(z)));
                const float wd = expf(-expf(-sp - 0.5f)), asg = sigmoidf_(a0 + APp[o]);
                float v = vx;
                if (j == 0) VF[o] = vx; else { const float vf = VF[o]; v = vx + (vf - vx) * sigmoidf_(v0 + VPp[o]); }
                float kk = kx * kkw; const float ss = wave_sum(kk * kk); kk *= rsqrtf(fmaxf(ss, 1e-24f));
                const float kp = kx * (1.0f + (asg - 1.0f) * kaw), a = -kk, bq = kk * asg;
                float sa = 0.f;
#pragma unroll
                for (int k = 0; k < 64; ++k) sa += S[k] * rl(a, k);
#pragma unroll
                for (int k = 0; k < 64; ++k) S[k] = S[k] * rl(wd, k) + sa * rl(bq, k) + v * rl(kp, k);
                float y = 0.f;
#pragma unroll
                for (int k = 0; k < 64; ++k) y += S[k] * rl(r, k);
                const float mu = wave_sum(y) * (1.0f / 64.0f), dy = y - mu, var = wave_sum(dy * dy) * (1.0f / 64.0f);
                const float bonus = wave_sum(r * kp * rkw);
                YG[o] = f2bf((dy * rsqrtf(var + 64e-5f) * lnw + lnb + bonus * v) * GG[o]);
            }
            float* so = p->out + O_WKVS + (((size_t)j * 32 + b) * 16 + h) * 4096 + lane * 64;
#pragma unroll
            for (int k = 0; k < 64; k += 4) *(f32x4*)(so + k) = (f32x4){S[k], S[k + 1], S[k + 2], S[k + 3]};
        }
    }
}
__device__ __forceinline__ void phase_carry(KP p, int j, LAS unsigned char* lds) {
    const float *PCH = WSP(float, WS_PCH), *CCH = WSP(float, WS_CCH); float* SST = WSP(float, WS_SST);
    LAS float* Sl = (LAS float*)lds;
    LAS unsigned* cflag = (LAS unsigned*)(lds + 9216);
    if (TID() == 0) *cflag = 0u;
    __syncthreads();
    unsigned arrivals = 0u;
    if ((TID() >> 6) >= 4) { phase_sample_mixer_w(p, j, BID() * 4 + ((TID() >> 6) - 4), (int)gridDim.x * 4); }
    else
    for (int it0 = BID(); it0 < 256; it0 += gridDim.x) {
        const int it = gridDim.x == 256 ? ((((it0 & 7) * 8 + (it0 >> 5)) << 2) | ((it0 >> 3) & 3)) : it0;
        const int wave = TID() >> 6, sh = it >> 2, row0 = 16 * (it & 3), col0 = 16 * (wave & 3), b = sh >> 4, h = sh & 15;
        const bool act = true;
        f32x4 acc = {0.f, 0.f, 0.f, 0.f}, c0, c1, c2;
        float b0[16], b1[16], b2[16];
#define CARRY_LOAD(BX, CX, cc_) do { const int l_ = TID() & 63, ln = l_ & 15, lq = l_ >> 4; \
            const float* Pc = PCH + ((size_t)sh * NCH + (cc_)) * 4096; const float* Cc = CCH + ((size_t)sh * NCH + (cc_)) * 4096; \
            _Pragma("unroll") for (int q = 0; q < 16; ++q) BX[q] = Pc[(4 * q + lq) * 64 + col0 + ln]; \
            _Pragma("unroll") for (int r = 0; r < 4; ++r) CX[r] = Cc[(row0 + 4 * lq + r) * 64 + col0 + ln]; } while (0)
#define CARRY_STEP(BX, CX, BL, CL, c_) do { const int l_ = TID() & 63, ln = l_ & 15, lq = l_ >> 4; \
            LAS float* Sw = Sl + ((c_) & 1) * (16 * 68); bf16_t* go = (bf16_t*)SST + ((size_t)sh * NCH + (c_)) * 4096; \
            if (act) { _Pragma("unroll") for (int r = 0; r < 4; ++r) Sw[(4 * lq + r) * 68 + col0 + ln] = acc[r]; } \
            const f32x4 sc = acc; acc = CX; \
            asm volatile("s_waitcnt lgkmcnt(0)" ::: "memory"); arrivals += 4u; \
            if ((TID() & 63) == 0) __hip_atomic_fetch_add(cflag, 1u, __ATOMIC_RELAXED, __HIP_MEMORY_SCOPE_WORKGROUP); \
            { unsigned sp_ = 0; while (__builtin_amdgcn_readfirstlane(__hip_atomic_load(cflag, __ATOMIC_RELAXED, __HIP_MEMORY_SCOPE_WORKGROUP)) < arrivals && ++sp_ < (1u << 22)) __builtin_amdgcn_s_sleep(0); } \
            asm volatile("" ::: "memory"); \
            if (act) { \
                _Pragma("unroll") for (int r = 0; r < 4; ++r) go[(row0 + 4 * lq + r) * 64 + col0 + ln] = f2bf(sc[r]); \
                if ((c_) + 2 < NCH) CARRY_LOAD(BL, CL, (c_) + 2); \
                float av[16]; _Pragma("unroll") for (int q = 0; q < 16; ++q) av[q] = Sw[ln * 68 + 4 * q + lq]; \
                asm volatile("s_waitcnt lgkmcnt(0)" ::: "memory"); \
                _Pragma("unroll") for (int q = 0; q < 16; ++q) acc = __builtin_amdgcn_mfma_f32_16x16x4f32(av[q], BX[q], acc, 0, 0, 0); } } while (0)
        if (act) { CARRY_LOAD(b0, c0, 0); CARRY_LOAD(b1, c1, 1); }
        for (int c = 0; c < NCH; c += 3) {
            CARRY_STEP(b0, c0, b2, c2, c);
            if (c + 1 < NCH) CARRY_STEP(b1, c1, b0, c0, c + 1);
            if (c + 2 < NCH) CARRY_STEP(b2, c2, b1, c1, c + 2);
        }
        if (act) { const int l_ = TID() & 63, ln = l_ & 15, lq = l_ >> 4; float* go = p->out + O_WKVP + (((size_t)j * 4 + b) * 16 + h) * 4096;
#pragma unroll
            for (int r = 0; r < 4; ++r) go[(row0 + 4 * lq + r) * 64 + col0 + ln] = acc[r]; }
#undef CARRY_LOAD
#undef CARRY_STEP
    }
    __syncthreads();
}
__device__ __forceinline__ void phase_sample_mixer(KP p, int j) {
    const int tid = TID(), lane = tid & 63, wave = tid >> 6;
    {
        const bf16_t *RB = WSP(bf16_t, WS_RB), *KB = WSP(bf16_t, WS_KB), *VB = WSP(bf16_t, WS_VB); bf16_t* YG = WSP(bf16_t, WS_YG);
        const float *WPp = WSP(float, WS_WP), *APp = WSP(float, WS_AP), *VPp = WSP(float, WS_VP), *GG = WSP(float, WS_GG); float* VF = WSP(float, WS_VFIRST);
        for (int it = BID() * 8 + wave; it < 512; it += gridDim.x * 8) {
            const int b = it >> 4, h = it & 15, col = h * 64 + lane;
            const float* s0 = p->state_wkv + (((size_t)j * 32 + b) * 16 + h) * 4096 + lane * 64;
            float S[64];
#pragma unroll
            for (int k = 0; k < 64; k += 4) { const f32x4 t = *(const f32x4*)(s0 + k); S[k] = t[0]; S[k + 1] = t[1]; S[k + 2] = t[2]; S[k + 3] = t[3]; }
            const float w0 = p->rw_w0[j * D + col], a0 = p->rw_a0[j * D + col], kkw = p->rw_k_k[j * D + col], kaw = p->rw_k_a[j * D + col], rkw = p->rw_r_k[j * D + col];
            const float v0 = j ? p->rw_v0[(j - 1) * D + col] : 0.f, lnw = p->rw_lnx_w[j * D + col], lnb = p->rw_lnx_b[j * D + col];
            for (int t = 0; t < 8; ++t) {
                const size_t o = (size_t)(NP + b * 8 + t) * D + col;
                const float kx = bf2f(KB[o]), vx = bf2f(VB[o]), r = bf2f(RB[o]);
                const float z = -(w0 + WPp[o]), sp = fmaxf(z, 0.f) + log1pf(expf(-fabsf(z)));
                const float wd = expf(-expf(-sp - 0.5f)), asg = sigmoidf_(a0 + APp[o]);
                float v = vx;
                if (j == 0) VF[o] = vx; else { const float vf = VF[o]; v = vx + (vf - vx) * sigmoidf_(v0 + VPp[o]); }
                float kk = kx * kkw; const float ss = wave_sum(kk * kk); kk *= rsqrtf(fmaxf(ss, 1e-24f));
                const float kp = kx * (1.0f + (asg - 1.0f) * kaw), a = -kk, bq = kk * asg;
                float sa = 0.f;
#pragma unroll
                for (int k = 0; k < 64; ++k) sa += S[k] * rl(a, k);
#pragma unroll
                for (int k = 0; k < 64; ++k) S[k] = S[k] * rl(wd, k) + sa * rl(bq, k) + v * rl(kp, k);
                float y = 0.f;
#pragma unroll
                for (int k = 0; k < 64; ++k) y += S[k] * rl(r, k);
                const float mu = wave_sum(y) * (1.0f / 64.0f), dy = y - mu, var = wave_sum(dy * dy) * (1.0f / 64.0f);
                const float bonus = wave_sum(r * kp * rkw);
                YG[o] = f2bf((dy * rsqrtf(var + 64e-5f) * lnw + lnb + bonus * v) * GG[o]);
            }
            float* so = p->out + O_WKVS + (((size_t)j * 32 + b) * 16 + h) * 4096 + lane * 64;
#pragma unroll
            for (int k = 0; k < 64; k += 4) *(f32x4*)(so + k) = (f32x4){S[k], S[k + 1], S[k + 2], S[k + 3]};
        }
    }
}
__device__ __forceinline__ void phase_post2(KP p, int j, LAS unsigned char* lds) {
    LAS float* part = (LAS float*)lds;
    const bf16_t *GM = WSP(bf16_t, WS_DEC), *VM2 = WSP(bf16_t, WS_KM), *TG = WSP(bf16_t, WS_TG), *G2T = WSP(bf16_t, WS_G2T) + (size_t)j * D * 160;
    const float *Y0 = WSP(float, WS_Y), *BON = WSP(float, WS_AV), *SST = WSP(float, WS_SST); bf16_t* YG = WSP(bf16_t, WS_YG);
    bf16x8 n_af[2], n_bw[2][2], n_tg[5]; unsigned short n_y0[2][4];
#define P2_MAP(q_) (q_)
#define P2_LOAD(itx) do { const int tid_ = TID(), lane_ = tid_ & 63, w_ = tid_ >> 6, n_ = lane_ & 15, c4_ = lane_ >> 4, tr_ = w_ >> 1, tcb_ = 2 * (w_ & 1); \
        const int it_ = (itx), sh_ = it_ / NCH, c_ = it_ % NCH, R0_ = (sh_ >> 4) * 4096 + c_ * LCH, hc_ = (sh_ & 15) * 64; const size_t ar_ = (size_t)(R0_ + 16 * tr_ + n_); \
        _Pragma("unroll") for (int ks = 0; ks < 2; ++ks) n_af[ks] = *(const bf16x8*)(GM + ar_ * D + hc_ + 32 * ks + 8 * c4_); \
        _Pragma("unroll") for (int ti = 0; ti < 2; ++ti) _Pragma("unroll") for (int ks = 0; ks < 2; ++ks) \
            n_bw[ti][ks] = *(const bf16x8*)((const bf16_t*)SST + ((size_t)it_ * 64 + 16 * (tcb_ + ti) + n_) * 64 + 32 * ks + 8 * c4_); \
        _Pragma("unroll") for (int ks = 0; ks < 5; ++ks) n_tg[ks] = *(const bf16x8*)(TG + ar_ * 160 + 32 * ks + 8 * c4_); \
        _Pragma("unroll") for (int ti = 0; ti < 2; ++ti) _Pragma("unroll") for (int r = 0; r < 4; ++r) \
            n_y0[ti][r] = ((const bf16_t*)Y0)[(size_t)(R0_ + 16 * tr_ + 4 * c4_ + r) * D + hc_ + 16 * (tcb_ + ti) + n_]; } while (0)
    if (BID() < 64 * NCH) P2_LOAD(P2_MAP(BID()));
    for (int q = BID(); q < 64 * NCH; q += gridDim.x) {
        const int it = P2_MAP(q);
        const int tid = TID(), lane = tid & 63, w = tid >> 6, n = lane & 15, c4 = lane >> 4, tr = w >> 1, tcb = 2 * (w & 1);
        const int sh = it / NCH, c = it % NCH, b = sh >> 4, h = sh & 15, R0 = b * 4096 + c * LCH, hc = h * 64;
        f32x4 y[2], g[2];
        const size_t ar = (size_t)(R0 + 16 * tr + n);
        bf16x8 c_af[2], c_bw[2][2], c_tg[5]; unsigned short c_y0[2][4];
#pragma unroll
        for (int ks = 0; ks < 2; ++ks) { c_af[ks] = n_af[ks]; c_bw[0][ks] = n_bw[0][ks]; c_bw[1][ks] = n_bw[1][ks]; }
#pragma unroll
        for (int ks = 0; ks < 5; ++ks) c_tg[ks] = n_tg[ks];
#pragma unroll
        for (int ti = 0; ti < 2; ++ti)
#pragma unroll
            for (int r = 0; r < 4; ++r) c_y0[ti][r] = n_y0[ti][r];
        if (q + (int)gridDim.x < 64 * NCH) P2_LOAD(P2_MAP(q + (int)gridDim.x));
#pragma unroll
        for (int ti = 0; ti < 2; ++ti) {
            const int dv = 16 * (tcb + ti) + n;
            f32x4 acc = {0.f, 0.f, 0.f, 0.f}, gacc = acc;
#pragma unroll
            for (int ks = 0; ks < 2; ++ks) {
                acc = __builtin_amdgcn_mfma_f32_16x16x32_bf16(c_af[ks], c_bw[ti][ks], acc, 0, 0, 0);
            }
#pragma unroll
            for (int ks = 0; ks < 5; ++ks)
                gacc = __builtin_amdgcn_mfma_f32_16x16x32_bf16(c_tg[ks], *(const bf16x8*)(G2T + (size_t)(hc + dv) * 160 + 32 * ks + 8 * c4), gacc, 0, 0, 0);
#pragma unroll
            for (int r = 0; r < 4; ++r) acc[r] += bf2f(c_y0[ti][r]);
            y[ti] = acc; g[ti] = gacc;
        }
        float bonus4[4]; unsigned short vm4[2][4]; float lnw2[2], lnb2[2];
#pragma unroll
        for (int r = 0; r < 4; ++r) bonus4[r] = BON[(size_t)(R0 + 16 * tr + 4 * c4 + r) * 16 + h];
#pragma unroll
        for (int ti = 0; ti < 2; ++ti) { const int col = hc + 16 * (tcb + ti) + n; lnw2[ti] = p->rw_lnx_w[j * D + col]; lnb2[ti] = p->rw_lnx_b[j * D + col];
#pragma unroll
            for (int r = 0; r < 4; ++r) vm4[ti][r] = VM2[(size_t)(R0 + 16 * tr + 4 * c4 + r) * D + col]; }
        float s1[4], s2[4];
#pragma unroll
        for (int r = 0; r < 4; ++r) { s1[r] = g16_sum(y[0][r] + y[1][r]); s2[r] = g16_sum(y[0][r] * y[0][r] + y[1][r] * y[1][r]); }
        asm volatile("s_waitcnt lgkmcnt(0)" ::: "memory"); __builtin_amdgcn_s_barrier(); asm volatile("" ::: "memory");
        if (n == 0) {
#pragma unroll
            for (int r = 0; r < 4; ++r) { const int t = 16 * tr + 4 * c4 + r; part[(t * 2 + (w & 1)) * 2 + 0] = s1[r]; part[(t * 2 + (w & 1)) * 2 + 1] = s2[r]; }
        }
        asm volatile("s_waitcnt lgkmcnt(0)" ::: "memory"); __builtin_amdgcn_s_barrier(); asm volatile("" ::: "memory");
#pragma unroll
        for (int r = 0; r < 4; ++r) {
            const int t = 16 * tr + 4 * c4 + r;
            const float mu = (part[(t * 2 + 0) * 2] + part[(t * 2 + 1) * 2]) * (1.0f / 64.0f), ex2 = (part[(t * 2 + 0) * 2 + 1] + part[(t * 2 + 1) * 2 + 1]) * (1.0f / 64.0f);
            const float rs = rsqrtf(fmaxf(ex2 - mu * mu, 0.f) + 64e-5f), bonus = bonus4[r];
#pragma unroll
            for (int ti = 0; ti < 2; ++ti) {
                const int col = hc + 16 * (tcb + ti) + n; const size_t o = (size_t)(R0 + t) * D + col;
                YG[o] = f2bf(((y[ti][r] - mu) * rs * lnw2[ti] + lnb2[ti] + bonus * bf2f(vm4[ti][r])) * g[ti][r]);
            }
        }
    }
#undef P2_LOAD
#undef P2_MAP
    __syncthreads();
}

__device__ __forceinline__ void phase_post(KP p, int j) {
    const float *Y = WSP(float, WS_Y), *KM = WSP(float, WS_KM), *VM = WSP(float, WS_VM), *GG = WSP(float, WS_GG);
    const bf16_t* RB = WSP(bf16_t, WS_RB); bf16_t* YG = WSP(bf16_t, WS_YG);
    const int lane = TID() & 63, gw = BID() * 8 + (TID() >> 6), nw = gridDim.x * 8;
    for (int row = gw; row < NT; row += nw) {
#pragma unroll
        for (int i = 0; i < 4; ++i) {
            const int col = 256 * i + 4 * lane; const size_t o = (size_t)row * D + col;
            const f32x4 y = *(const f32x4*)(Y + o), r = ld_bf4(RB + o), km = *(const f32x4*)(KM + o), vm = *(const f32x4*)(VM + o), gg = *(const f32x4*)(GG + o);
            const f32x4 lw = *(const f32x4*)(p->rw_lnx_w + j * D + col), lb = *(const f32x4*)(p->rw_lnx_b + j * D + col), rk = *(const f32x4*)(p->rw_r_k + j * D + col);
            const float mu = g16_sum(y[0] + y[1] + y[2] + y[3]) * (1.0f / 64.0f);
            const f32x4 d = y - mu;
            const float var = g16_sum(d[0] * d[0] + d[1] * d[1] + d[2] * d[2] + d[3] * d[3]) * (1.0f / 64.0f);
            const float rs = rsqrtf(var + 64e-5f);
            const float bon = g16_sum(r[0] * km[0] * rk[0] + r[1] * km[1] * rk[1] + r[2] * km[2] * rk[2] + r[3] * km[3] * rk[3]);
            st_bf4(YG + o, (d * rs * lw + lb + bon * vm) * gg);
        }
    }
}

__constant__ double kRopeInv[8] = {1.0, 0.19392274474868576, 0.03760603093086393, 0.007292664737217109, 0.001414213562373095, 0.0002742481756762073, 5.318295896944988e-05, 1.031338537721246e-05};
__device__ __forceinline__ void phase_rope_table(KP p) {
    float* TB = WSP(float, WS_ROPE);
    for (int e = ((int)gridDim.x - 1 - BID()) * 512 + TID(); e < 4104 * 8; e += gridDim.x * 512) {
        const int pi = e >> 3, f = e & 7, pos = pi < 4096 ? pi : PAST + (pi - 4096);
        double ang = (double)pos * kRopeInv[f]; ang -= floor(ang * 0.15915494309189535) * 6.283185307179586; const float af = (float)ang;
        TB[pi * 16 + f] = cosf(af); TB[pi * 16 + 8 + f] = sinf(af);
    }
}
__device__ __forceinline__ void phase_dsapost(KP p, int j) {
    const bf16_t* PR = WSP(bf16_t, WS_PR); float *Q = WSP(float, WS_Q), *QI = WSP(float, WS_QI), *WI = WSP(float, WS_WI);
    const int lane = TID() & 63, l16 = lane & 15, gw = BID() * 8 + (TID() >> 6), nw = gridDim.x * 8;
    const f32x4 qn = *(const f32x4*)(p->att_q_norm + j * 64 + 4 * l16), kn = *(const f32x4*)(p->att_k_norm + j * 64 + 4 * l16), in = *(const f32x4*)(p->idx_k_norm + j * 64 + 4 * l16);
    u32x2 rw[10]; f32x4 csn, snn;
#define DP_LOAD(ROW_) do { const int row_ = (ROW_); const bf16_t* pr_ = PR + (size_t)row_ * PINP; \
        _Pragma("unroll") for (int i = 0; i < 8; ++i) rw[i] = *(const u32x2*)(pr_ + 256 * i + 4 * lane); \
        rw[8] = *(const u32x2*)(pr_ + 2048 + 4 * l16); rw[9] = *(const u32x2*)(pr_ + 2112 + 4 * (lane & 1)); \
        const float* tb_ = WSP(float, WS_ROPE) + (row_ < NP ? (row_ & 4095) : 4096 + ((row_ - NP) & 7)) * 16 + 4 * (l16 & 1); csn = *(const f32x4*)tb_; snn = *(const f32x4*)(tb_ + 8); } while (0)
#define BF4(w_) ((f32x4){bflo((w_).x), bfhi((w_).x), bflo((w_).y), bfhi((w_).y)})
    if (gw < NT) DP_LOAD(gw);
    for (int row = gw; row < NT; row += nw) {
        u32x2 rc[10];
#pragma unroll
        for (int i = 0; i < 10; ++i) rc[i] = rw[i];
        const f32x4 cs = csn, sn = snn;
        if (row + nw < NT) DP_LOAD(row + nw);
        const float sgn = (l16 < 2) ? -1.0f : 1.0f;
#define ROPE4(v) do { f32x4 _o; _o[0] = __shfl_xor((v)[0], 2); _o[1] = __shfl_xor((v)[1], 2); _o[2] = __shfl_xor((v)[2], 2); _o[3] = __shfl_xor((v)[3], 2); if (l16 < 4) (v) = (v) * cs + sgn * (_o * sn); } while (0)
#define HNORM4(v, w) do { const float _ss = g16_sum((v)[0] * (v)[0] + (v)[1] * (v)[1] + (v)[2] * (v)[2] + (v)[3] * (v)[3]); (v) = (v) * rsqrtf(_ss * (1.0f / 64.0f) + 1e-6f) * (w); } while (0)
#pragma unroll
        for (int i = 0; i < 4; ++i) { f32x4 v = BF4(rc[i]); HNORM4(v, qn); ROPE4(v); st_bf4((bf16_t*)Q + (size_t)row * D + 256 * i + 4 * lane, v); }
        { f32x4 v = BF4(rc[4]); HNORM4(v, kn); ROPE4(v);
          float* ko = row < NP ? p->out + O_KP + ((size_t)j * NP + row) * 256 : p->out + O_KS + ((size_t)j * NS + (row - NP)) * 256; *(f32x4*)(ko + 4 * lane) = v; *(unsigned*)(WSP(unsigned char, WS_K8) + (size_t)row * 256 + 4 * lane) = pk_fp8x4(v); }
        { const f32x4 v = BF4(rc[5]);
          float* vo = row < NP ? p->out + O_VP + ((size_t)j * NP + row) * 256 : p->out + O_VS + ((size_t)j * NS + (row - NP)) * 256; *(f32x4*)(vo + 4 * lane) = v; *(unsigned*)(WSP(unsigned char, WS_V8) + (size_t)row * 256 + 4 * lane) = pk_fp8x4(v); }
#pragma unroll
        for (int i = 0; i < 2; ++i) { f32x4 v = BF4(rc[6 + i]); ROPE4(v); st_bf4(WSP(bf16_t, WS_QIB) + (size_t)row * 512 + 256 * i + 4 * lane, v); }
        { f32x4 v = BF4(rc[8]); HNORM4(v, in); ROPE4(v);
          float* io = row < NP ? p->out + O_IKP + ((size_t)j * NP + row) * 64 : p->out + O_IKS + ((size_t)j * NS + (row - NP)) * 64; if (lane < 16) { *(f32x4*)(io + 4 * lane) = v; st_bf4(WSP(bf16_t, WS_KIB) + (size_t)row * 64 + 4 * lane, v); } }
        if (lane < 2) { const f32x4 v = BF4(rc[9]); *(f32x4*)(WI + (size_t)row * 8 + 4 * lane) = v * 0.35355339059327373f; }
#undef ROPE4
#undef HNORM4
    }
#undef DP_LOAD
#undef BF4
}

template <bool SAMPLE>
__device__ __forceinline__ void phase_idx(KP p, int j, LAS unsigned char* lds) {
    LAS float* Qs = (LAS float*)lds;
    LAS float* Ks = (LAS float*)(lds + 32768);
    const float *QI = WSP(float, WS_QI), *WI = WSP(float, WS_WI);
    const int tid = TID(), q = tid >> 5, kx = tid & 31;
    const int nitems = SAMPLE ? 32 * 65 : 1024;
    for (int it = BID(); it < nitems; it += gridDim.x) {
        int b, t0, rowbase, nkt, kt0 = 0;
        if (SAMPLE) { b = it / 65; kt0 = it % 65; t0 = 0; rowbase = NP + b * 8; nkt = kt0 + 1; }
        else { const int k4 = it >> 8, w = it & 255, i = (k4 & 1) ? (k4 * 256 + 255 - w) : (k4 * 256 + w); b = i & 3; t0 = (i >> 2) * 16; rowbase = b * 4096 + t0; nkt = (t0 + 15) / 128 + 1; }
        const int nq = SAMPLE ? 8 : 16;
        __syncthreads();
#pragma unroll
        for (int n = 0; n < 16; ++n) { const int e = tid + 512 * n, qq = e >> 9, c = e & 511, h = c >> 6, d = c & 63;
            Qs[(d * 16 + qq) * 8 + h] = qq < nq ? QI[(size_t)(rowbase + qq) * 512 + c] : 0.f; }
        float wi[8];
#pragma unroll
        for (int h = 0; h < 8; ++h) wi[h] = q < nq ? WI[(size_t)(rowbase + q) * 8 + h] : 0.f;
        for (int kt = kt0; kt < nkt; ++kt) {
            __syncthreads();
#pragma unroll
            for (int n = 0; n < 16; ++n) { const int e = tid + 512 * n, key = e >> 6, d = e & 63, s = kt * 128 + key; float v = 0.f;
                if (SAMPLE) {
                    if (s < PAST) { const int pg = p->page_table[b * 64 + (s >> 7)]; v = p->cache_ik[(((size_t)j * 2560 + pg) * 128 + (s & 127)) * 64 + d]; }
                    else if (s < PAST + 8) v = p->out[O_IKS + ((size_t)j * NS + b * 8 + (s - PAST)) * 64 + d];
                } else v = p->out[O_IKP + ((size_t)j * NP + b * 4096 + s) * 64 + d];
                Ks[d * 132 + key] = v; }
            __syncthreads();
            f32x4 acc[8];
#pragma unroll
            for (int h = 0; h < 8; ++h) acc[h] = (f32x4){0.f, 0.f, 0.f, 0.f};
#pragma unroll 4
            for (int d = 0; d < 64; ++d) {
                const f32x4 qa = *(const LAS f32x4*)(Qs + (d * 16 + q) * 8), qb = *(const LAS f32x4*)(Qs + (d * 16 + q) * 8 + 4), kv = *(const LAS f32x4*)(Ks + d * 132 + 4 * kx);
                acc[0] += qa[0] * kv; acc[1] += qa[1] * kv; acc[2] += qa[2] * kv; acc[3] += qa[3] * kv;
                acc[4] += qb[0] * kv; acc[5] += qb[1] * kv; acc[6] += qb[2] * kv; acc[7] += qb[3] * kv;
            }
            f32x4 sc = {0.f, 0.f, 0.f, 0.f};
#pragma unroll
            for (int h = 0; h < 8; ++h)
#pragma unroll
                for (int e = 0; e < 4; ++e) sc[e] += fmaxf(acc[h][e] * 0.125f, 0.f) * wi[h];
            if (q < nq) {
                if (SAMPLE) *(f32x4*)(WSP(float, WS_SCS) + (size_t)(b * 8 + q) * SCS_LD + kt * 128 + 4 * kx) = sc;
                else *(f32x4*)(WSP(float, WS_SC) + ((size_t)b * 4096 + t0 + q) * 4096 + kt * 128 + 4 * kx) = sc;
            }
        }
    }
    __syncthreads();
}

template <bool SAMPLE>
__device__ __forceinline__ void phase_idx2(KP p, int j) {
    const bf16_t *QIB = WSP(bf16_t, WS_QIB), *KIB = WSP(bf16_t, WS_KIB); const float* WI = WSP(float, WS_WI);
    const int lane = TID() & 63, lr = lane & 31, lh = lane >> 5, gw = BID() * 8 + (TID() >> 6), nw = gridDim.x * 8;
    const int nitems = SAMPLE ? 32 * 65 : 4096;
    for (int it = gw; it < nitems; it += nw) {
        int b, rowbase, tile0, ntile;
        if (SAMPLE) { b = it / 65; rowbase = NP + b * 8; tile0 = (it % 65) * 4; ntile = min(4, 257 - tile0); }
        else {
            const int sub = it >= 2048, w_ = it & 2047; b = w_ & 3; const int wb = (w_ >> 2) & 255, qh = w_ >> 10, g = sub ? 255 - wb : wb, sq = 2 * qh + sub, nt = (g * 16 + 15) / 32 + 1;
            rowbase = b * 4096 + g * 16; tile0 = (nt * sq) >> 2; ntile = ((nt * (sq + 1)) >> 2) - tile0; }
        if (ntile <= 0) continue;
        constexpr int NST = SAMPLE ? 2 : 4;
        bf16x8 af[NST][4]; float w[NST][2][8];
        { const int hd = (lr & 3) + 4 * ((lr >> 3) & 1), jq = 2 * ((lr >> 2) & 1) + (lr >> 4);
#pragma unroll
          for (int st = 0; st < NST; ++st)
#pragma unroll
              for (int ks = 0; ks < 4; ++ks) af[st][ks] = *(const bf16x8*)(QIB + (size_t)(rowbase + 4 * st + jq) * 512 + hd * 64 + 16 * ks + 8 * lh);
#pragma unroll
          for (int st = 0; st < NST; ++st)
#pragma unroll
              for (int q = 0; q < 2; ++q) { const f32x4 w0 = *(const f32x4*)(WI + (size_t)(rowbase + 4 * st + 2 * lh + q) * 8), w1 = *(const f32x4*)(WI + (size_t)(rowbase + 4 * st + 2 * lh + q) * 8 + 4);
#pragma unroll
                  for (int e = 0; e < 4; ++e) { w[st][q][e] = w0[e] * 0.125f; w[st][q][4 + e] = w1[e] * 0.125f; } } }
#define IDX_LOADB(BF, tl_) do { const int s_ = (tile0 + (tl_)) * 32 + lr; \
            if (!SAMPLE) { _Pragma("unroll") for (int ks = 0; ks < 4; ++ks) BF[ks] = *(const bf16x8*)(KIB + ((size_t)b * 4096 + s_) * 64 + 16 * ks + 8 * lh); } \
            else { const float* kp = p->out + O_IKS + ((size_t)j * NS + b * 8) * 64; \
                if (s_ < PAST) kp = p->cache_ik + (((size_t)j * 2560 + p->page_table[b * 64 + (s_ >> 7)]) * 128 + (s_ & 127)) * 64; else kp += (size_t)min(s_ - PAST, 7) * 64; \
                _Pragma("unroll") for (int ks = 0; ks < 4; ++ks) { const f32x4 x0 = *(const f32x4*)(kp + 16 * ks + 8 * lh), x1 = *(const f32x4*)(kp + 16 * ks + 8 * lh + 4); \
                    const u32x4 wv = {pk_bf16(x0[0], x0[1]), pk_bf16(x0[2], x0[3]), pk_bf16(x1[0], x1[1]), pk_bf16(x1[2], x1[3])}; BF[ks] = __builtin_bit_cast(bf16x8, wv); } } } while (0)
        bf16x8 bnx[4];
        IDX_LOADB(bnx, 0);
        for (int tl = 0; tl < ntile; ++tl) {
            const int s = (tile0 + tl) * 32 + lr;
            bf16x8 bfr[4];
#pragma unroll
            for (int ks = 0; ks < 4; ++ks) bfr[ks] = bnx[ks];
            if (tl + 1 < ntile) IDX_LOADB(bnx, tl + 1);
            __builtin_amdgcn_sched_barrier(0);
#pragma unroll
            for (int st = 0; st < NST; ++st) {
                f32x16 acc;
#pragma unroll
                for (int r = 0; r < 16; ++r) acc[r] = 0.f;
#pragma unroll
                for (int ks = 0; ks < 4; ++ks) acc = __builtin_amdgcn_mfma_f32_32x32x16_bf16(af[st][ks], bfr[ks], acc, 0, 0, 0);
#pragma unroll
                for (int q = 0; q < 2; ++q) {
                    float sc = 0.f;
#pragma unroll
                    for (int hh = 0; hh < 2; ++hh)
#pragma unroll
                        for (int hl = 0; hl < 4; ++hl) sc += fmaxf(acc[4 * (2 * q + hh) + hl], 0.f) * w[st][q][hl + 4 * hh];
                    if (SAMPLE) WSP(float, WS_SCS)[(size_t)(b * 8 + 4 * st + 2 * lh + q) * SCS_LD + s] = sc;
                    else WSP(float, WS_SC)[((size_t)rowbase + 4 * st + 2 * lh + q) * 4096 + s] = sc;
                }
            }
        }
    }
#undef IDX_LOADB
}

__device__ __forceinline__ unsigned fkey(float f) { f = (f == 0.f) ? 0.f : f; const unsigned u = __float_as_uint(f); return (u & 0x80000000u) ? ~u : (u | 0x80000000u); }
__device__ __forceinline__ void phase_topk_prompt(KP p, LAS unsigned char* lds) {
    const float* SC = WSP(float, WS_SC); int* SEL = WSP(int, WS_SEL); int* CNT = WSP(int, WS_CNT);
    const int lane = TID() & 63, gw = BID() * 8 + (TID() >> 6), nw = gridDim.x * 8;
    for (int qi = gw; qi < NP; qi += nw) {
        const int b = qi & 3, tt = qi >> 2, t = (tt & 1) ? 4095 - (tt >> 1) : (tt >> 1), row = b * 4096 + t, n = t + 1;
        int* sel = SEL + (size_t)row * 256;
        if (n <= TOPK) { for (int s = lane; s < n; s += 64) sel[s] = s; if (lane == 0) CNT[row] = n; continue; }
        const float* base = SC + (size_t)row * 4096;
        const int nb = __builtin_amdgcn_readfirstlane((n + 511) >> 9);
        unsigned u[64];
#pragma unroll
        for (int kb = 0; kb < 8; ++kb) {
            if (kb < nb) {
#pragma unroll
                for (int m = 8 * kb; m < 8 * kb + 8; ++m) u[m] = __float_as_uint(base[lane + 64 * m]);
            } else {
#pragma unroll
                for (int m = 8 * kb; m < 8 * kb + 8; ++m) u[m] = 0u;
            }
        }
#define TKB(kb_, ...) _Pragma("unroll") for (int m = 8 * (kb_); m < 8 * (kb_) + 8; ++m) { __VA_ARGS__; }
#define TK_ALL(...) do { TKB(0, __VA_ARGS__) if (nb > 1) { TKB(1, __VA_ARGS__) if (nb > 2) { TKB(2, __VA_ARGS__) if (nb > 3) { TKB(3, __VA_ARGS__) if (nb > 4) { TKB(4, __VA_ARGS__) \
            if (nb > 5) { TKB(5, __VA_ARGS__) if (nb > 6) { TKB(6, __VA_ARGS__) if (nb > 7) { TKB(7, __VA_ARGS__) } } } } } } } } while (0)
        TK_ALL({ const unsigned k_ = fkey(__uint_as_float(u[m])); u[m] = (lane + 64 * m < n) ? k_ : 0u; });
        unsigned tau = 0u; bool fin = false;
#pragma unroll 1
        for (int bit = 31; bit >= 20; --bit) {
            const unsigned cand = tau | (1u << bit); int c = 0;
            TK_ALL(c += (u[m] >= cand) ? 1 : 0);
            c = wave_sum_i(c);
            if (c >= TOPK) tau = cand;
            if (c == TOPK) { fin = true; break; }
        }
        if (!fin) {
            int cge = 0, cbl = 0;
            TK_ALL(cge += (u[m] >= tau) ? 1 : 0; cbl += (u[m] - tau < (1u << 20)) ? 1 : 0);
            const int totB = wave_sum_i(cbl), cA = wave_sum_i(cge) - totB;
            if (totB <= 1024) {
                int incl = cbl;
#pragma unroll
                for (int d = 1; d < 64; d <<= 1) { const int o = __shfl_up(incl, d); if (lane >= d) incl += o; }
                int off = incl - cbl;
                LAS unsigned* cl = (LAS unsigned*)(lds + 32768) + (TID() >> 6) * 1024;
                TK_ALL({ const unsigned d_ = u[m] - tau; if (d_ < (1u << 20)) { cl[off] = d_ + 1u; ++off; } });
                wave_lds_fence();
                const int nrb = __builtin_amdgcn_readfirstlane((totB + 255) >> 8);
                unsigned kc[16];
#pragma unroll
                for (int kb2 = 0; kb2 < 4; ++kb2) {
                    if (kb2 < nrb) {
#pragma unroll
                        for (int r = 4 * kb2; r < 4 * kb2 + 4; ++r) { const int s_ = lane + 64 * r; const unsigned v_ = cl[s_]; kc[r] = s_ < totB ? v_ : 0u; }
                    } else {
#pragma unroll
                        for (int r = 4 * kb2; r < 4 * kb2 + 4; ++r) kc[r] = 0u;
                    }
                }
                wave_lds_fence();
                unsigned tl = 0u;
#pragma unroll 1
                for (int b2 = 19; b2 >= 0; --b2) {
                    const unsigned candl = tl | (1u << b2); int c = 0;
#pragma unroll
                    for (int r = 0; r < 4; ++r) c += (kc[r] > candl) ? 1 : 0;
                    if (nrb > 1) {
#pragma unroll
                        for (int r = 4; r < 8; ++r) c += (kc[r] > candl) ? 1 : 0;
                        if (nrb > 2) {
#pragma unroll
                            for (int r = 8; r < 12; ++r) c += (kc[r] > candl) ? 1 : 0;
                            if (nrb > 3) {
#pragma unroll
                                for (int r = 12; r < 16; ++r) c += (kc[r] > candl) ? 1 : 0;
                            }
                        }
                    }
                    c = wave_sum_i(c) + cA;
                    if (c >= TOPK) tl = candl;
                    if (c == TOPK) break;
                }
                tau |= tl;
            } else {
#pragma unroll 1
                for (int bit = 19; bit >= 0; --bit) {
                    const unsigned cand = tau | (1u << bit); int c = 0;
                    TK_ALL(c += (u[m] >= cand) ? 1 : 0);
                    c = wave_sum_i(c);
                    if (c >= TOPK) tau = cand;
                    if (c == TOPK) break;
                }
            }
        }
        int cg = 0, ct = 0; unsigned long long tmask = 0ull;
#define TK_TIE(kb_) do { unsigned t8_ = 0u; _Pragma("unroll") for (int m = 8 * (kb_) + 7; m >= 8 * (kb_); --m) { cg += (u[m] > tau) ? 1 : 0; const unsigned tie = (u[m] == tau) ? 1u : 0u; ct += (int)tie; t8_ = (t8_ << 1) | tie; } \
            tmask |= (unsigned long long)t8_ << (8 * (kb_)); } while (0)
        TK_TIE(0); if (nb > 1) { TK_TIE(1); if (nb > 2) { TK_TIE(2); if (nb > 3) { TK_TIE(3); if (nb > 4) { TK_TIE(4); if (nb > 5) { TK_TIE(5); if (nb > 6) { TK_TIE(6); if (nb > 7) { TK_TIE(7); } } } } } } }
#undef TK_TIE
        const int totg = wave_sum_i(cg), tott = wave_sum_i(ct);
        const int need = TOPK - totg;
        unsigned long long smask = 0ull;
        if (tott == need) smask = tmask;
        else {
#pragma unroll 1
            for (int it = 0; it < need; ++it) {
                const int m0 = tmask ? (int)__builtin_ctzll(tmask) : 64;
                const int cand = tmask ? (lane + 64 * m0) : 0x7fffffff, best = wave_min_i(cand);
                if (cand == best && tmask) { smask |= (1ull << m0); tmask &= ~(1ull << m0); }
            }
        }
        const int mine = cg + __popcll(smask);
        int incl = mine;
#pragma unroll
        for (int d = 1; d < 64; d <<= 1) { const int o = __shfl_up(incl, d); if (lane >= d) incl += o; }
        int off = incl - mine;
        LAS int* ol = (LAS int*)(lds + 32768) + (TID() >> 6) * 1024;
        TK_ALL({ if ((u[m] > tau) || ((smask >> m) & 1ull)) { ol[off] = lane + 64 * m; ++off; } });
        wave_lds_fence();
        *(u32x4*)(sel + 4 * lane) = *(const LAS u32x4*)(ol + 4 * lane);
        wave_lds_fence();
        if (lane == 0) CNT[row] = TOPK;
#undef TK_ALL
#undef TKB
    }
}
__device__ __forceinline__ void phase_topk_sample(KP p, LAS unsigned char* lds) {
    LAS unsigned* ckey = (LAS unsigned*)lds;
    LAS int* cidx = (LAS int*)(lds + 8192);
    const float* SCS = WSP(float, WS_SCS); int* SEL = WSP(int, WS_SEL); int* CNT = WSP(int, WS_CNT);
    for (int qq = BID(); qq < NS; qq += gridDim.x) {
        const int tid = TID(), lane = tid & 63, wave = tid >> 6;
        const int n = PAST + 1 + (qq & 7), row = NP + qq, s0 = 1088 * wave;
        const float* base = SCS + (size_t)qq * SCS_LD;
        unsigned u[17];
#pragma unroll
        for (int m = 0; m < 17; ++m) { const int s = s0 + lane + 64 * m; u[m] = __float_as_uint(base[s < SCS_LD ? s : 0]); }
#pragma unroll
        for (int m = 0; m < 17; ++m) { const unsigned k_ = fkey(__uint_as_float(u[m])); u[m] = (s0 + lane + 64 * m < n) ? k_ : 0u; }
        __syncthreads();
        {
            int nvalid = 0;
#pragma unroll
            for (int m = 0; m < 17; ++m) nvalid += (u[m] != 0u) ? 1 : 0;
            nvalid = wave_sum_i(nvalid);
            unsigned tau = 0u; int need = 0; unsigned tmask = 0u, smask = 0u;
            if (nvalid > TOPK) {
#pragma unroll 1
                for (int bit = 31; bit >= 0; --bit) {
                    const unsigned cand = tau | (1u << bit); int c = 0;
#pragma unroll
                    for (int m = 0; m < 17; ++m) c += (u[m] >= cand) ? 1 : 0;
                    c = wave_sum_i(c);
                    if (c >= TOPK) tau = cand;
                    if (c == TOPK) break;
                }
                int cg = 0, ct = 0;
#pragma unroll
                for (int m = 0; m < 17; ++m) { cg += (u[m] > tau) ? 1 : 0; const bool tie = (u[m] == tau); ct += tie ? 1 : 0; tmask |= tie ? (1u << m) : 0u; }
                cg = wave_sum_i(cg); ct = wave_sum_i(ct);
                need = TOPK - cg;
                if (ct == need) smask = tmask;
                else {
#pragma unroll 1
                    for (int it = 0; it < need; ++it) {
                        const int m0 = tmask ? (int)__builtin_ctz(tmask) : 32;
                        const int cand = tmask ? (lane + 64 * m0) : 0x7fffffff, best = wave_min_i(cand);
                        if (cand == best && tmask) { smask |= (1u << m0); tmask &= ~(1u << m0); }
                    }
                }
            } else { tau = 0u; smask = 0u; }
            int mine = 0;
#pragma unroll
            for (int m = 0; m < 17; ++m) mine += ((u[m] > tau) || ((smask >> m) & 1u)) ? 1 : 0;
            int incl = mine;
#pragma unroll
            for (int d = 1; d < 64; d <<= 1) { const int o = __shfl_up(incl, d); if (lane >= d) incl += o; }
            int off = incl - mine;
            const int total = __builtin_amdgcn_readlane(incl, 63);
#pragma unroll
            for (int m = 0; m < 17; ++m) { if ((u[m] > tau) || ((smask >> m) & 1u)) { ckey[wave * 256 + off] = u[m]; cidx[wave * 256 + off] = s0 + lane + 64 * m; ++off; } }
            for (int e = total + lane; e < 256; e += 64) { ckey[wave * 256 + e] = 0u; cidx[wave * 256 + e] = 0x7fffffff; }
        }
        __syncthreads();
        if (wave == 0) {
            unsigned v[32]; int ix[32];
#pragma unroll
            for (int m = 0; m < 32; ++m) { v[m] = ckey[lane + 64 * m]; ix[m] = cidx[lane + 64 * m]; }
            unsigned tau = 0u;
#pragma unroll 1
            for (int bit = 31; bit >= 0; --bit) {
                const unsigned cand = tau | (1u << bit); int c = 0;
#pragma unroll
                for (int m = 0; m < 32; ++m) c += (v[m] >= cand) ? 1 : 0;
                c = wave_sum_i(c);
                if (c >= TOPK) tau = cand;
                if (c == TOPK) break;
            }
            int cg = 0, ct = 0; unsigned tmask = 0u, smask = 0u;
#pragma unroll
            for (int m = 31; m >= 0; --m) { cg += (v[m] > tau) ? 1 : 0; const unsigned tie = (v[m] == tau) ? 1u : 0u; ct += (int)tie; tmask = (tmask << 1) | tie; }
            cg = wave_sum_i(cg); ct = wave_sum_i(ct);
            const int need = TOPK - cg;
            if (ct == need) smask = tmask;
            else {
#pragma unroll 1
                for (int it = 0; it < need; ++it) {
                    int bi = 0x7fffffff, bm = 0;
#pragma unroll
                    for (int m = 0; m < 32; ++m) { const bool t_ = (tmask >> m) & 1u; if (t_ && ix[m] < bi) { bi = ix[m]; bm = m; } }
                    const int best = wave_min_i(bi);
                    if (bi == best && bi != 0x7fffffff) { smask |= (1u << bm); tmask &= ~(1u << bm); }
                }
            }
            int mine = 0;
#pragma unroll
            for (int m = 0; m < 32; ++m) mine += ((v[m] > tau) || ((smask >> m) & 1u)) ? 1 : 0;
            int incl = mine;
#pragma unroll
            for (int d = 1; d < 64; d <<= 1) { const int o = __shfl_up(incl, d); if (lane >= d) incl += o; }
            int off = incl - mine;
            int* sel = SEL + (size_t)row * 256;
#pragma unroll
            for (int m = 0; m < 32; ++m) { if ((v[m] > tau) || ((smask >> m) & 1u)) { if (off < TOPK) sel[off] = ix[m]; ++off; } }
            if (lane == 0) CNT[row] = TOPK;
        }
    }
    __syncthreads();
}

template <bool SAMPLE>
__device__ __forceinline__ void phase_attn(KP p, int j, LAS unsigned char* lds) {
    const int tid = TID(), lane = tid & 63, wave = tid >> 6, n16 = lane & 15, c4 = lane >> 4;
    LAS bf16_t* ps = (LAS bf16_t*)(lds + wave * 16384);
    LAS int* is = (LAS int*)(lds + wave * 16384 + 8192);
    LAS bf16_t* qs = (LAS bf16_t*)(lds + wave * 16384 + 9216);
    LAS float* invs = (LAS float*)(lds + wave * 16384 + 11264);
    const float* Q = WSP(float, WS_Q); const int* SEL = WSP(int, WS_SEL); const int* CNT = WSP(int, WS_CNT); bf16_t* O = WSP(bf16_t, WS_YG);
    const bf16_t *KBF = WSP(bf16_t, WS_KBF), *VBF = WSP(bf16_t, WS_VBF);
    const float* kc = p->cache_k + (size_t)j * 2560 * 128 * 256; const float* vc = p->cache_v + (size_t)j * 2560 * 128 * 256;
    const float* knew = p->out + O_KS + (size_t)j * NS * 256; const float* vnew = p->out + O_VS + (size_t)j * NS * 256;
    const int gw = BID() * 8 + wave, nw = gridDim.x * 8, nq = SAMPLE ? NS : NP;
    unsigned* qctr = WSP(unsigned, WS_BAR + 40960) + (size_t)j * 256;
    int qb = 0, qnext = 0, qsub = 2, qcur = 0;
    int pf_row = -1, pf_n = 0, pf_s[4] = {0, 0, 0, 0}; u32x2 pf_q[4] = {{0u, 0u}, {0u, 0u}, {0u, 0u}, {0u, 0u}};
    if (!SAMPLE) { unsigned v_ = 0u; if (lane == 0) v_ = __hip_atomic_fetch_add(qctr + 16 * ((BID() + qb) & 3), 2u, __ATOMIC_RELAXED, __HIP_MEMORY_SCOPE_AGENT); qnext = (int)__builtin_amdgcn_readfirstlane(v_); }
    for (int qi = gw; SAMPLE ? (qi < nq) : true; qi += nw) {
        int row;
        if (SAMPLE) row = NP + qi;
        else {
            if (qsub == 2) {
                for (;;) {
                    qcur = qnext; qsub = 0;
                    if (qcur < 4096 || qb == 3) break;
                    ++qb; unsigned v_ = 0u; if (lane == 0) v_ = __hip_atomic_fetch_add(qctr + 16 * ((BID() + qb) & 3), 2u, __ATOMIC_RELAXED, __HIP_MEMORY_SCOPE_AGENT); qnext = (int)__builtin_amdgcn_readfirstlane(v_);
                }
                if (qcur >= 4096) break;
                { unsigned v_ = 0u; if (lane == 0) v_ = __hip_atomic_fetch_add(qctr + 16 * ((BID() + qb) & 3), 2u, __ATOMIC_RELAXED, __HIP_MEMORY_SCOPE_AGENT); qnext = (int)__builtin_amdgcn_readfirstlane(v_); }
            }
            row = ((BID() + qb) & 3) * 4096 + (4095 - (qcur + qsub)); ++qsub;
        }
        int n, sraw[4]; u32x2 qraw[4];
        if (!SAMPLE && pf_row == row) { n = pf_n;
#pragma unroll
            for (int c = 0; c < 4; ++c) { sraw[c] = pf_s[c]; qraw[c] = pf_q[c]; }
        } else { n = CNT[row];
#pragma unroll
            for (int c = 0; c < 4; ++c) { sraw[c] = SEL[(size_t)row * 256 + lane + 64 * c]; qraw[c] = *(const u32x2*)((const bf16_t*)Q + (size_t)row * D + 256 * c + 4 * lane); }
        }
        if (!SAMPLE) {
            int nrow = -1;
            if (qsub < 2) nrow = row - 1; else if (qnext < 4096) nrow = ((BID() + qb) & 3) * 4096 + (4095 - qnext);
            pf_row = nrow;
            if (nrow >= 0) { pf_n = CNT[nrow];
#pragma unroll
                for (int c = 0; c < 4; ++c) { pf_s[c] = SEL[(size_t)nrow * 256 + lane + 64 * c]; pf_q[c] = *(const u32x2*)((const bf16_t*)Q + (size_t)nrow * D + 256 * c + 4 * lane); }
            }
        }
        wave_lds_fence();
#pragma unroll
        for (int c = 0; c < 4; ++c) { const int slot = lane + 64 * c;
            int s = sraw[c]; const bool ok = slot < n;
            int r;
            if (SAMPLE) { const int bb = (row - NP) >> 3; s = ok ? s : 0; const int sp = min(max(s, 0), PAST - 1); const int pg = p->page_table[bb * 64 + (sp >> 7)];
                r = (s < PAST) ? pg * 128 + (s & 127) : (0x40000000 | (bb * 8 + min(s - PAST, 7))); }
            else r = (row & ~4095) + (ok ? s : 0);
            is[slot] = r; }
#pragma unroll
        for (int i = 0; i < 4; ++i) { const f32x4 q4 = (f32x4){bflo(qraw[i].x), bfhi(qraw[i].x), bflo(qraw[i].y), bfhi(qraw[i].y)};
            if (SAMPLE) { const f32x4 q8 = q4 * 0.125f; u32x2 w; w.x = pk_bf16(q8[0], q8[1]); w.y = pk_bf16(q8[2], q8[3]); *(LAS u32x2*)(qs + 256 * i + 4 * lane) = w; }
            else *(LAS unsigned*)((LAS unsigned char*)qs + 256 * i + 4 * lane) = pk_fp8x4(q4); }
        wave_lds_fence();
        {
            float mx = -__builtin_huge_valf();
#define ATT_EMIT(t_, acc_) do { f32x4 l_ = (acc_); _Pragma("unroll") for (int r = 0; r < 4; ++r) { if (16 * (t_) + 4 * c4 + r >= n) l_[r] = -__builtin_huge_valf(); mx = fmaxf(mx, l_[r]); } \
                u32x2 w_; w_.x = pk_bf16(l_[0], l_[1]); w_.y = pk_bf16(l_[2], l_[3]); *(LAS u32x2*)(ps + n16 * 256 + 16 * (t_) + 4 * c4) = w_; } while (0)
            if (SAMPLE) {
                const u32x4 qf0 = *(const LAS u32x4*)(qs + n16 * 64 + 8 * c4), qf1 = *(const LAS u32x4*)(qs + n16 * 64 + 32 + 8 * c4);
                u32x4 bq[8];
#pragma unroll
                for (int ks = 0; ks < 8; ++ks) { const bool on = (n16 >> 2) == (ks >> 1); const u32x4 qv = (ks & 1) ? qf1 : qf0; bq[ks] = (u32x4){on ? qv.x : 0u, on ? qv.y : 0u, on ? qv.z : 0u, on ? qv.w : 0u}; }
#pragma unroll 2
                for (int t = 0; t < 16; ++t) {
                    const int r = is[16 * t + n16];
                    const float* kp = ((r & 0x40000000) ? knew + (size_t)(r & 0xffff) * 256 : kc + (size_t)r * 256) + 8 * c4;
                    f32x4 acc = {0.f, 0.f, 0.f, 0.f};
#pragma unroll
                    for (int ks = 0; ks < 8; ++ks) { const f32x4 x0 = *(const f32x4*)(kp + 32 * ks), x1 = *(const f32x4*)(kp + 32 * ks + 4);
                        const u32x4 ka = {pk_bf16(x0[0], x0[1]), pk_bf16(x0[2], x0[3]), pk_bf16(x1[0], x1[1]), pk_bf16(x1[2], x1[3])};
                        acc = __builtin_amdgcn_mfma_f32_16x16x32_bf16(__builtin_bit_cast(bf16x8, ka), __builtin_bit_cast(bf16x8, bq[ks]), acc, 0, 0, 0); }
                    ATT_EMIT(t, acc);
                }
            } else {
                const LAS unsigned char* q8 = (const LAS unsigned char*)qs;
                long bq[8];
                { const bool on = (n16 >> 2) == c4;
#pragma unroll
                  for (int h2 = 0; h2 < 4; ++h2) { const u32x4 qv = *(const LAS u32x4*)(q8 + n16 * 64 + 16 * h2);
                      const u32x2 z0 = {on ? qv.x : 0u, on ? qv.y : 0u}, z1 = {on ? qv.z : 0u, on ? qv.w : 0u}; bq[2 * h2] = __builtin_bit_cast(long, z0); bq[2 * h2 + 1] = __builtin_bit_cast(long, z1); } }
                const unsigned char* K8 = WSP(unsigned char, WS_K8);
#pragma unroll
                for (int th = 0; th < 2; ++th) {
                    if (th) asm volatile("" ::: "memory");
                    u32x4 ka[8][4];
#pragma unroll
                    for (int t8 = 0; t8 < 8; ++t8) {
                        const int r = is[16 * (8 * th + t8) + n16];
                        const unsigned char* kp = K8 + (size_t)r * 256 + 64 * c4;
#pragma unroll
                        for (int h2 = 0; h2 < 4; ++h2) ka[t8][h2] = *(const u32x4*)(kp + 16 * h2);
                    }
                    __builtin_amdgcn_sched_barrier(0);
#pragma unroll
                    for (int t8 = 0; t8 < 8; ++t8) {
                        f32x4 acc = {0.f, 0.f, 0.f, 0.f};
#pragma unroll
                        for (int h2 = 0; h2 < 4; ++h2) { const u32x2 lo = {ka[t8][h2].x, ka[t8][h2].y}, hi = {ka[t8][h2].z, ka[t8][h2].w};
                            acc = __builtin_amdgcn_mfma_f32_16x16x32_fp8_fp8(__builtin_bit_cast(long, lo), bq[2 * h2], acc, 0, 0, 0);
                            acc = __builtin_amdgcn_mfma_f32_16x16x32_fp8_fp8(__builtin_bit_cast(long, hi), bq[2 * h2 + 1], acc, 0, 0, 0); }
                        ATT_EMIT(8 * th + t8, acc * 0.125f);
                    }
                }
            }
#undef ATT_EMIT
            mx = fmaxf(mx, __shfl_xor(mx, 16)); mx = fmaxf(mx, __shfl_xor(mx, 32));
            float sm = 0.f;
            u32x2 lw_[16];
#pragma unroll
            for (int t = 0; t < 16; ++t) lw_[t] = *(const LAS u32x2*)(ps + n16 * 256 + 16 * t + 4 * c4);
#pragma unroll
            for (int t = 0; t < 16; ++t) {
                const u32x2 w = lw_[t];
                const float e0 = __expf(bflo(w.x) - mx), e1 = __expf(bfhi(w.x) - mx), e2 = __expf(bflo(w.y) - mx), e3 = __expf(bfhi(w.y) - mx);
                sm += (e0 + e1) + (e2 + e3);
                u32x2 o_; o_.x = pk_bf16(e0, e1); o_.y = pk_bf16(e2, e3); *(LAS u32x2*)(ps + n16 * 256 + 16 * t + 4 * c4) = o_;
            }
            sm += __shfl_xor(sm, 16); sm += __shfl_xor(sm, 32);
            if (c4 == 0) invs[n16] = 1.0f / sm;
        }
        wave_lds_fence();
        if (!SAMPLE) {
            const unsigned char* V8 = WSP(unsigned char, WS_V8);
            const int rs = c4, kvh = n16 >> 2, nst = n > 64 ? 64 : n;
            f32x4 oa[4][4];
#pragma unroll
            for (int g = 0; g < 4; ++g)
#pragma unroll
                for (int q = 0; q < 4; ++q) oa[g][q] = (f32x4){0.f, 0.f, 0.f, 0.f};
            u32x4 vr[8], vn[8];
#pragma unroll
            for (int i = 0; i < 8; ++i) vn[i] = *(const u32x4*)(V8 + (size_t)is[64 * rs + i] * 256 + 16 * n16);
            for (int m0 = 0; m0 < nst; m0 += 8) {
#pragma unroll
                for (int i = 0; i < 8; ++i) vr[i] = vn[i];
                if (m0 + 8 < nst) {
#pragma unroll
                    for (int i = 0; i < 8; ++i) vn[i] = *(const u32x4*)(V8 + (size_t)is[64 * rs + m0 + 8 + i] * 256 + 16 * n16);
                }
                __builtin_amdgcn_sched_barrier(0);
#pragma unroll
                for (int h4 = 0; h4 < 2; ++h4) {
                    u32x2 pg[4];
#pragma unroll
                    for (int g = 0; g < 4; ++g) pg[g] = *(const LAS u32x2*)(ps + (kvh * 4 + g) * 256 + 64 * rs + m0 + 4 * h4);
#pragma unroll
                    for (int i = 0; i < 4; ++i) {
                        const u32x4 v_ = vr[4 * h4 + i];
                        const f32x4 v0 = fp8x4_f32(v_.x), v1 = fp8x4_f32(v_.y), v2 = fp8x4_f32(v_.z), v3 = fp8x4_f32(v_.w);
#pragma unroll
                        for (int g = 0; g < 4; ++g) { const unsigned pw = (i < 2) ? pg[g].x : pg[g].y; const float pf = (i & 1) ? bfhi(pw) : bflo(pw);
                            oa[g][0] += pf * v0; oa[g][1] += pf * v1; oa[g][2] += pf * v2; oa[g][3] += pf * v3; }
                    }
                }
            }
#pragma unroll
            for (int g = 0; g < 4; ++g)
#pragma unroll
                for (int q = 0; q < 4; ++q)
#pragma unroll
                    for (int e_ = 0; e_ < 4; ++e_) { float x = oa[g][q][e_]; x += __shfl_xor(x, 16); x += __shfl_xor(x, 32); oa[g][q][e_] = x; }
            if (rs == 0) {
                const f32x4 iv = *(const LAS f32x4*)(invs + 4 * kvh);
#pragma unroll
                for (int g = 0; g < 4; ++g) { bf16_t* op = O + (size_t)row * D + (kvh * 4 + g) * 64 + 16 * (n16 & 3);
                    u32x4 w0, w1; const float sc_ = iv[g];
                    w0.x = pk_bf16(oa[g][0][0] * sc_, oa[g][0][1] * sc_); w0.y = pk_bf16(oa[g][0][2] * sc_, oa[g][0][3] * sc_); w0.z = pk_bf16(oa[g][1][0] * sc_, oa[g][1][1] * sc_); w0.w = pk_bf16(oa[g][1][2] * sc_, oa[g][1][3] * sc_);
                    w1.x = pk_bf16(oa[g][2][0] * sc_, oa[g][2][1] * sc_); w1.y = pk_bf16(oa[g][2][2] * sc_, oa[g][2][3] * sc_); w1.z = pk_bf16(oa[g][3][0] * sc_, oa[g][3][1] * sc_); w1.w = pk_bf16(oa[g][3][2] * sc_, oa[g][3][3] * sc_);
                    *(u32x4*)op = w0; *(u32x4*)(op + 8) = w1; }
            }
        } else {
        f32x4 o0 = {0.f, 0.f, 0.f, 0.f}, o1 = o0, o2 = o0, o3 = o0;
        constexpr int GV = SAMPLE ? 16 : 32;
        const int ng = (n + GV - 1) / GV;
        unsigned vb[SAMPLE ? 1 : GV], vbn[SAMPLE ? 1 : GV]; f32x4 vf[SAMPLE ? GV : 1];
        const unsigned char* V8 = WSP(unsigned char, WS_V8);
        if (!SAMPLE) {
#pragma unroll
            for (int i = 0; i < GV; ++i) vbn[i] = *(const unsigned*)(V8 + (size_t)is[i] * 256 + 4 * lane);
        }
#pragma unroll 1
        for (int g = 0; g < ng; ++g) {
            if (!SAMPLE) {
#pragma unroll
                for (int i = 0; i < GV; ++i) vb[i] = vbn[i];
                if (g + 1 < ng) {
#pragma unroll
                    for (int i = 0; i < GV; ++i) vbn[i] = *(const unsigned*)(V8 + (size_t)is[GV * (g + 1) + i] * 256 + 4 * lane);
                }
                __builtin_amdgcn_sched_barrier(0);
            } else {
#pragma unroll
                for (int i = 0; i < GV; ++i) { const int r = is[GV * g + i]; vf[i] = *(const f32x4*)(((r & 0x40000000) ? vnew + (size_t)(r & 0xffff) * 256 : vc + (size_t)r * 256) + 4 * lane); }
            }
#pragma unroll
            for (int i4 = 0; i4 < GV / 4; ++i4) {
                const u32x2 p0 = *(const LAS u32x2*)(ps + (c4 * 4 + 0) * 256 + GV * g + 4 * i4), p1 = *(const LAS u32x2*)(ps + (c4 * 4 + 1) * 256 + GV * g + 4 * i4),
                            p2 = *(const LAS u32x2*)(ps + (c4 * 4 + 2) * 256 + GV * g + 4 * i4), p3 = *(const LAS u32x2*)(ps + (c4 * 4 + 3) * 256 + GV * g + 4 * i4);
                f32x4 v0, v1, v2, v3;
                if (!SAMPLE) { v0 = fp8x4_f32(vb[4 * i4]); v1 = fp8x4_f32(vb[4 * i4 + 1]); v2 = fp8x4_f32(vb[4 * i4 + 2]); v3 = fp8x4_f32(vb[4 * i4 + 3]); }
                else { v0 = vf[4 * i4]; v1 = vf[4 * i4 + 1]; v2 = vf[4 * i4 + 2]; v3 = vf[4 * i4 + 3]; }
                o0 += bflo(p0.x) * v0 + bfhi(p0.x) * v1 + bflo(p0.y) * v2 + bfhi(p0.y) * v3;
                o1 += bflo(p1.x) * v0 + bfhi(p1.x) * v1 + bflo(p1.y) * v2 + bfhi(p1.y) * v3;
                o2 += bflo(p2.x) * v0 + bfhi(p2.x) * v1 + bflo(p2.y) * v2 + bfhi(p2.y) * v3;
                o3 += bflo(p3.x) * v0 + bfhi(p3.x) * v1 + bflo(p3.y) * v2 + bfhi(p3.y) * v3;
            }
        }
        { const f32x4 iv = *(const LAS f32x4*)(invs + 4 * c4); bf16_t* op = O + (size_t)row * D + c4 * 256 + 4 * n16; st_bf4(op, o0 * iv[0]); st_bf4(op + 64, o1 * iv[1]); st_bf4(op + 128, o2 * iv[2]); st_bf4(op + 192, o3 * iv[3]); }
        }
    }
}

__global__ void __launch_bounds__(512, 2) mega(P p_unused) {
    extern __shared__ __attribute__((aligned(16))) unsigned char lds_raw[];
    LAS unsigned char* lds = (LAS unsigned char*)lds_raw;
    volatile LAS unsigned* misc = (volatile LAS unsigned*)(lds + LDS_MISC);
    if (TID() < 4) misc[TID()] = 0u;
    __syncthreads();
    KP p = kargs();
    const bool multi = (p->ph_hi - p->ph_lo) > 1;
    XcdBarrier bar; bar.bar = WSP(unsigned, WS_BAR); bar.x = 0; bar.st = misc;
    if (multi) bar = xcd_barrier_post(WSP(unsigned, WS_BAR), misc);
    int ph = 0;
    const int lo = p->ph_lo, hi = p->ph_hi;
#ifndef REPMASK
#define REPMASK 0ull
#endif
#define PH_BEGIN if (ph >= lo && ph < hi) { KP p = kargs(); const int nrep_ = ((REPMASK >> ph) & 1ull) ? 3 : 1; for (int rep_ = 0; rep_ < nrep_; ++rep_) {
#define PH_END   if (ph + 1 < hi || rep_ + 1 < nrep_) xcd_barrier(bar); } } ++ph;

    PH_BEGIN phase_ada(p, lds); phase_weights(p, lds); phase_rope_table(p); PH_END

    for (int layer = 0; layer < 4; ++layer) {
        const int j = layer >> 1;
        if ((layer & 1) == 0) {
            PH_BEGIN phase_prep<true>(p, layer, 0, j, layer == 0); PH_END
            PH_BEGIN {
                FRwkvIn f{WSP(bf16_t, WS_RB), WSP(bf16_t, WS_KB), WSP(bf16_t, WS_VB), WSP(bf16_t, WS_TW), WSP(bf16_t, WS_TA), WSP(bf16_t, WS_TV), WSP(bf16_t, WS_TG)};
                pg8::Gemm g{WSP(bf16_t, WS_XR), WSP(bf16_t, WS_WRW_T) + (size_t)j * 4096 * D, NP, j == 0 ? 3840 : 4096, D, j == 0 ? 2 : 1, XR_STRIDE};
                pg8::StaticOrder S; S.init(NP, g.N, (int)gridDim.x, BID());
                pg8::EpiAdapt<FRwkvIn, true> E{f};
                pg8::gemm_phase(lds, g, S, E);
                wgemm_ks<true>(lds, WSP(bf16_t, WS_XR), D, XR_STRIDE, NP, NS, WSP(bf16_t, WS_WRW_T) + (size_t)j * 4096 * D, D, 4096, f, ((NP / 256) * (g.N / 256)) % (int)gridDim.x);
            } PH_END
            PH_BEGIN {
                FStoreF32 fw{WSP(float, WS_WP), D, D}, fa{WSP(float, WS_AP), D, D}, fv{WSP(float, WS_VP), D, D}, fg{WSP(float, WS_GG), D, D};
                wgemm_w<64>(WSP(bf16_t, WS_TW), 64, NP, NS, WSP(bf16_t, WS_W2T) + (size_t)j * D * 64, D, fw, 0);
                wgemm_w<64>(WSP(bf16_t, WS_TA), 64, NP, NS, WSP(bf16_t, WS_A2T) + (size_t)j * D * 64, D, fa, 1);
                if (j == 1) wgemm_w<32>(WSP(bf16_t, WS_TV), 32, NP, NS, WSP(bf16_t, WS_V2T), D, fv, 2);
                wgemm_w<160>(WSP(bf16_t, WS_TG), 160, NP, NS, WSP(bf16_t, WS_G2T) + (size_t)j * D * 160, D, fg, 3);
                phase_chunk(p, j, lds);
            } PH_END
            PH_BEGIN phase_carry(p, j, lds); PH_END
            PH_BEGIN phase_post2(p, j, lds); PH_END
        } else {
            PH_BEGIN phase_prep<false>(p, layer, 0, j); PH_END
            PH_BEGIN {
                FStoreBf16 f{WSP(bf16_t, WS_PR), PINP, PINP};
                pg8::Gemm g{WSP(bf16_t, WS_XR), WSP(bf16_t, WS_WIN_T) + (size_t)j * PINP * D, NP, PINP, D, 0, 0};
                pg8::StaticOrder S; S.init(NP, PINP, (int)gridDim.x, BID());
                pg8::EpiAdapt<FStoreBf16, true> E{f};
                pg8::gemm_phase(lds, g, S, E);
                FStoreBf16 fs{WSP(bf16_t, WS_PR), PINP, PIN};
                wgemm_ks<false>(lds, WSP(bf16_t, WS_XR), D, 0, NP, NS, WSP(bf16_t, WS_WIN_T) + (size_t)j * PINP * D, D, PINP, fs, ((NP / 256) * (PINP / 256)) % (int)gridDim.x);
            } PH_END
            PH_BEGIN phase_dsapost(p, j); PH_END
            PH_BEGIN phase_idx2<false>(p, j); phase_idx2<true>(p, j); PH_END
            PH_BEGIN phase_topk_prompt(p, lds); phase_topk_sample(p, lds); PH_END
            PH_BEGIN phase_attn<true>(p, j, lds); phase_attn<false>(p, j, lds); PH_END
        }
        PH_BEGIN {
            FResid f{p->out, WSP(float, WS_MODS) + (size_t)layer * 36 * 6144 + 2 * D, layer == 0 ? p->x_prompt : nullptr, layer == 0 ? p->x_sample : nullptr};
            const bf16_t* Wt = ((layer & 1) == 0 ? WSP(bf16_t, WS_WO_T) : WSP(bf16_t, WS_WAO_T)) + (size_t)j * D * D;
            pg8::Gemm g{WSP(bf16_t, WS_YG), Wt, NP, D, D, 0, 0};
            pg8::StaticOrder S; S.init(NP, D, (int)gridDim.x, BID());
            pg8::EpiAdapt<FResid, false> E{f};
            pg8::gemm_phase(lds, g, S, E);
            wgemm_ks<false>(lds, WSP(bf16_t, WS_YG), D, 0, NP, NS, Wt, D, D, f);
        } PH_END
        PH_BEGIN phase_prep<false>(p, layer, 1, j); PH_END
        PH_BEGIN {
            FRelu2 f{WSP(bf16_t, WS_U)};
            pg8::Gemm g{WSP(bf16_t, WS_XR), WSP(bf16_t, WS_WUP_T) + (size_t)layer * DFF * D, NP, DFF, D, 0, 0};
            pg8::StaticOrder S; S.init(NP, DFF, (int)gridDim.x, BID());
            pg8::EpiAdapt<FRelu2, true> E{f};
            pg8::gemm_phase(lds, g, S, E);
            wgemm_ks<false>(lds, WSP(bf16_t, WS_XR), D, 0, NP, NS, WSP(bf16_t, WS_WUP_T) + (size_t)layer * DFF * D, D, DFF, f);
        } PH_END
        PH_BEGIN {
            FResid f{p->out, WSP(float, WS_MODS) + (size_t)layer * 36 * 6144 + 5 * D, nullptr, nullptr};
            pg8::Gemm g{WSP(bf16_t, WS_U), WSP(bf16_t, WS_WDN_T) + (size_t)layer * DFF * D, NP, D, DFF, 0, 0};
            pg8::StaticOrder S; S.init(NP, D, (int)gridDim.x, BID());
            pg8::EpiAdapt<FResid, false> E{f};
            pg8::gemm_phase(lds, g, S, E);
            wgemm_ks<false>(lds, WSP(bf16_t, WS_U), DFF, 0, NP, NS, WSP(bf16_t, WS_WDN_T) + (size_t)layer * DFF * D, DFF, D, f);
        } PH_END
    }
#undef PH_BEGIN
#undef PH_END
}

static int count_phases() { int n = 1; for (int layer = 0; layer < 4; ++layer) { n += ((layer & 1) == 0) ? 5 : 6; n += 4; } return n; }

extern "C" void kernel_launch(void* const* d_in, const int* in_sizes, int n_in, void* d_out, int out_size, void* d_ws, size_t ws_size, hipStream_t stream) {
    static int grid = 0;
    if (grid == 0) {
        if (n_in != 39 || out_size != (int)O_END || ws_size < WS_END) { fprintf(stderr, "kernel_launch: unexpected shapes n_in %d out %d ws %zu (need %zu)\n", n_in, out_size, ws_size, (size_t)WS_END); grid = -1; return; }
        int dev = 0, cus = 0, per_cu = 0;
        if (hipGetDevice(&dev) != hipSuccess || hipDeviceGetAttribute(&cus, hipDeviceAttributeMultiprocessorCount, dev) != hipSuccess) { grid = -1; return; }
        if (hipFuncSetAttribute((const void*)mega, hipFuncAttributeMaxDynamicSharedMemorySize, LDS_BYTES) != hipSuccess) { fprintf(stderr, "kernel_launch: hipFuncSetAttribute failed\n"); grid = -1; return; }
        if (hipOccupancyMaxActiveBlocksPerMultiprocessor(&per_cu, (const void*)mega, 512, LDS_BYTES) != hipSuccess || per_cu < 1) fprintf(stderr, "kernel_launch: occupancy query says %d\n", per_cu);
        (void)hipGetLastError();
        grid = cus;
    }
    if (grid < 0) return;
    (void)hipMemsetAsync((char*)d_ws + WS_BAR, 0, 65536, stream);
    P p{};
    memcpy((void*)&p, (const void*)d_in, 39 * sizeof(void*));
    p.out = (float*)d_out; p.ws = (unsigned char*)d_ws;
#ifndef STOP_PH
#define STOP_PH 1000
#endif
    const int nph = count_phases() < STOP_PH ? count_phases() : STOP_PH;
#ifndef ONE_LAUNCH
    for (int ph = 0; ph < nph; ++ph) { p.ph_lo = ph; p.ph_hi = ph + 1; hipLaunchKernelGGL(mega, dim3(grid), dim3(512), LDS_BYTES, stream, p); }
#else
    p.ph_lo = 0; p.ph_hi = nph; hipLaunchKernelGGL(mega, dim3(grid), dim3(512), LDS_BYTES, stream, p);
#endif
}
```
